# Optimizing an MI355X kernel written in HIP

```python
import math
import jax, jax.numpy as jnp
from jax import lax
import numpy as np

D_MODEL = 1024
BATCH = 8
SEQ = 4096
DEPTH = 4

PLE_DIM = 256
DIFF_HEADS = 8
DIFF_HEAD_DIM = 64
DIFF_V_DIM = 2 * DIFF_HEAD_DIM
MLA_HEADS = 8
MLA_Q_RANK = 384
MLA_KV_RANK = 256
MLA_NOPE_DIM = 64
MLA_ROPE_DIM = 32
MLA_V_DIM = 64
ROPE_THETA = 10000.0
REL_BUCKETS = 32
REL_MAX_DIST = 128
DENSE_FF = 2816
N_EXPERTS = 8
TOP_K = 2
EXPERT_FF = 3584
EXPERT_BLOCK = 128
Q_BLOCK = 128
EPS = 1e-5
DEEPNORM_ALPHA = (2.0 * DEPTH) ** 0.25
DEEPNORM_BETA = (8.0 * DEPTH) ** -0.25
N_DENSE = (DEPTH + 1) // 2
N_MOE = DEPTH // 2

DIFF_Q_COLS = DIFF_HEADS * 2 * DIFF_HEAD_DIM
DIFF_K_COLS = DIFF_HEADS * 2 * DIFF_HEAD_DIM
DIFF_V_COLS = DIFF_HEADS * DIFF_V_DIM
GATE_COLS = 2 * D_MODEL
IN_SIZES = (DIFF_Q_COLS, DIFF_K_COLS, DIFF_V_COLS, MLA_Q_RANK, MLA_KV_RANK, MLA_ROPE_DIM, GATE_COLS)
IN_SPLIT_IDX = [sum(IN_SIZES[:j + 1]) for j in range(len(IN_SIZES) - 1)]
IN_COLS = sum(IN_SIZES)

kernel_name = "hybrid_diffattn_mla_gated_moe_deepnorm"


def _layernorm(x, g, b):
    xf = x.astype(jnp.float32)
    mu = jnp.mean(xf, axis=-1, keepdims=True)
    var = jnp.mean(jnp.square(xf - mu), axis=-1, keepdims=True)
    y = (xf - mu) * lax.rsqrt(var + EPS) * g.astype(jnp.float32) + b.astype(jnp.float32)
    return y.astype(x.dtype)


def _rmsnorm(x, g):
    xf = x.astype(jnp.float32)
    y = xf * lax.rsqrt(jnp.mean(jnp.square(xf), axis=-1, keepdims=True) + EPS) * g.astype(jnp.float32)
    return y.astype(x.dtype)


def _rope(x, pos):
    half = x.shape[-1] // 2
    inv_freq = ROPE_THETA ** (-jnp.arange(half, dtype=jnp.float32) / half)
    ang = pos.astype(jnp.float32)[:, :, None] * inv_freq
    c = jnp.cos(ang)[:, :, None, :]
    s = jnp.sin(ang)[:, :, None, :]
    xf = x.astype(jnp.float32)
    x1, x2 = xf[..., :half], xf[..., half:]
    return jnp.concatenate([x1 * c - x2 * s, x1 * s + x2 * c], axis=-1).astype(x.dtype)


def _t5_bucket(dist):
    n = jnp.maximum(dist, 0)
    max_exact = REL_BUCKETS // 2
    large = max_exact + (jnp.log(jnp.maximum(n, 1).astype(jnp.float32) / max_exact)
                         / math.log(REL_MAX_DIST / max_exact) * (REL_BUCKETS - max_exact)).astype(jnp.int32)
    large = jnp.minimum(large, REL_BUCKETS - 1)
    return jnp.where(n < max_exact, n, large)


def _t5_bias(table, q_pos, k_pos):
    bucket = _t5_bucket(q_pos[:, :, None] - k_pos[:, None, :])
    return jnp.transpose(table[bucket].astype(jnp.float32), (0, 3, 1, 2))


def _causal_mask(q0, kend):
    return jnp.arange(kend)[None, :] <= (q0 + jnp.arange(Q_BLOCK))[:, None]


def _diff_attention(q, k, v, pos, rel_table, lam, lam_init, subln_g):
    B, S, H = q.shape[0], q.shape[1], q.shape[2]
    scale = DIFF_HEAD_DIM ** -0.5
    outs = []
    for q0 in range(0, S, Q_BLOCK):
        kend = q0 + Q_BLOCK
        s = jnp.einsum('bqhmd,bkhmd->bhmqk', q[:, q0:kend], k[:, :kend]).astype(jnp.float32) * scale
        s = s + _t5_bias(rel_table, pos[:, q0:kend], pos[:, :kend])[:, :, None]
        s = jnp.where(_causal_mask(q0, kend), s, -jnp.inf)
        a = jax.nn.softmax(s, axis=-1)
        w = a[:, :, 0] - lam * a[:, :, 1]
        outs.append(jnp.einsum('bhqk,bkhe->bqhe', w.astype(v.dtype), v[:, :kend]))
    o = jnp.concatenate(outs, axis=1)
    o = _rmsnorm(o, subln_g) * (1.0 - lam_init)
    return o.reshape(B, S, H * DIFF_V_DIM)


def _mla(c_q, c_kv, k_r, pos, q_norm_g, w_uq, kv_norm_g, w_ukv):
    B, S = c_q.shape[0], c_q.shape[1]
    q = (_rmsnorm(c_q, q_norm_g) @ w_uq).reshape(B, S, MLA_HEADS, MLA_NOPE_DIM + MLA_ROPE_DIM)
    q_nope, q_rope = q[..., :MLA_NOPE_DIM], _rope(q[..., MLA_NOPE_DIM:], pos)
    kv = (_rmsnorm(c_kv, kv_norm_g) @ w_ukv).reshape(B, S, MLA_HEADS, MLA_NOPE_DIM + MLA_V_DIM)
    k_nope, v = kv[..., :MLA_NOPE_DIM], kv[..., MLA_NOPE_DIM:]
    k_rope = _rope(k_r[:, :, None, :], pos)[:, :, 0]
    scale = (MLA_NOPE_DIM + MLA_ROPE_DIM) ** -0.5
    outs = []
    for q0 in range(0, S, Q_BLOCK):
        kend = q0 + Q_BLOCK
        s = (jnp.einsum('bqhd,bkhd->bhqk', q_nope[:, q0:kend], k_nope[:, :kend])
             + jnp.einsum('bqhr,bkr->bhqk', q_rope[:, q0:kend], k_rope[:, :kend])).astype(jnp.float32) * scale
        s = jnp.where(_causal_mask(q0, kend), s, -jnp.inf)
        a = jax.nn.softmax(s, axis=-1)
        outs.append(jnp.einsum('bhqk,bkhd->bqhd', a.astype(v.dtype), v[:, :kend]))
    return jnp.concatenate(outs, axis=1).reshape(B, S, MLA_HEADS * MLA_V_DIM)


def _mixer(h, pos, rel_table, w_in, b_gate, lq1, lk1, lq2, lk2, lam_init, diff_subln_g,
           mla_q_norm_g, w_uq, mla_kv_norm_g, w_ukv, w_branch_diff, w_branch_mla, w_out):
    B, S, _ = h.shape
    z = h @ w_in
    dq, dk, dv, cq, ckv, kr, gl = jnp.split(z, IN_SPLIT_IDX, axis=-1)
    lam = (jnp.exp(jnp.sum(lq1.astype(jnp.float32) * lk1.astype(jnp.float32)))
           - jnp.exp(jnp.sum(lq2.astype(jnp.float32) * lk2.astype(jnp.float32))) + lam_init)
    o_a = _diff_attention(dq.reshape(B, S, DIFF_HEADS, 2, DIFF_HEAD_DIM),
                          dk.reshape(B, S, DIFF_HEADS, 2, DIFF_HEAD_DIM),
                          dv.reshape(B, S, DIFF_HEADS, DIFF_V_DIM),
                          pos, rel_table, lam, lam_init, diff_subln_g)
    o_b = _mla(cq, ckv, kr, pos, mla_q_norm_g, w_uq, mla_kv_norm_g, w_ukv)
    g = jax.nn.sigmoid(gl + b_gate)
    g_a, g_b = g[..., :D_MODEL], g[..., D_MODEL:]
    m = g_a * (o_a @ w_branch_diff) + g_b * (o_b @ w_branch_mla)
    return m @ w_out


def _swiglu(x, w1, w3, w2):
    return (jax.nn.silu(x @ w1) * (x @ w3)) @ w2


def _moe(x, w_router, w1, w3, w2):
    B, S, D = x.shape
    xt = x.reshape(-1, D)
    T = xt.shape[0]
    M = T * TOP_K
    logits = (xt @ w_router).astype(jnp.float32)
    top_v, top_e = lax.top_k(logits, TOP_K)
    gates = jax.nn.softmax(top_v, axis=-1)
    flat_e = top_e.reshape(-1)
    flat_tok = jnp.repeat(jnp.arange(T, dtype=jnp.int32), TOP_K)
    order = jnp.argsort(flat_e, stable=True)
    se, stok, sg = flat_e[order], flat_tok[order], gates.reshape(-1)[order]
    counts = jnp.bincount(flat_e, length=N_EXPERTS)
    padded = ((counts + EXPERT_BLOCK - 1) // EXPERT_BLOCK) * EXPERT_BLOCK
    start = jnp.cumsum(counts) - counts
    pstart = jnp.cumsum(padded) - padded
    dest = pstart[se] + jnp.arange(M, dtype=jnp.int32) - start[se]
    n_blocks = -(-M // EXPERT_BLOCK) + N_EXPERTS
    P = n_blocks * EXPERT_BLOCK
    buf = jnp.zeros((P, D), x.dtype).at[dest].set(xt[stok])
    block_e = jnp.minimum(jnp.searchsorted(jnp.cumsum(padded), jnp.arange(n_blocks) * EXPERT_BLOCK,
                                           side='right'), N_EXPERTS - 1)

    def run(args):
        xb, e = args
        return _swiglu(xb, w1[e], w3[e], w2[e])

    yb = lax.map(run, (buf.reshape(n_blocks, EXPERT_BLOCK, D), block_e)).reshape(P, D)
    y = jnp.zeros((T, D), x.dtype).at[stok].add(yb[dest] * sg[:, None].astype(x.dtype))
    return y.reshape(B, S, D)


def setup_inputs(seed: int = 0) -> dict:
    key = jax.random.key(seed)
    ks = jax.random.split(key, 32)
    f32 = jnp.float32

    def nrm(k, shape, scale):
        return jax.random.normal(k, shape, f32) * scale

    beta = DEEPNORM_BETA
    return {
        "x": nrm(ks[0], (BATCH, SEQ, D_MODEL), 1.0),
        "p": nrm(ks[1], (DEPTH, BATCH, SEQ, PLE_DIM), 1.0),
        "positions": jnp.broadcast_to(jnp.arange(SEQ, dtype=jnp.int32), (BATCH, SEQ)),
        "rel_bias_table": nrm(ks[2], (REL_BUCKETS, DIFF_HEADS), 0.5),
        "w_in": nrm(ks[3], (DEPTH, D_MODEL, IN_COLS), D_MODEL ** -0.5),
        "b_gate": nrm(ks[4], (DEPTH, GATE_COLS), 0.02),
        "lambda_q1": nrm(ks[5], (DEPTH, DIFF_HEAD_DIM), 0.1),
        "lambda_k1": nrm(ks[6], (DEPTH, DIFF_HEAD_DIM), 0.1),
        "lambda_q2": nrm(ks[7], (DEPTH, DIFF_HEAD_DIM), 0.1),
        "lambda_k2": nrm(ks[8], (DEPTH, DIFF_HEAD_DIM), 0.1),
        "diff_subln_g": 1.0 + nrm(ks[9], (DEPTH, DIFF_V_DIM), 0.02),
        "mla_q_norm_g": 1.0 + nrm(ks[10], (DEPTH, MLA_Q_RANK), 0.02),
        "w_uq": nrm(ks[11], (DEPTH, MLA_Q_RANK, MLA_HEADS * (MLA_NOPE_DIM + MLA_ROPE_DIM)), MLA_Q_RANK ** -0.5),
        "mla_kv_norm_g": 1.0 + nrm(ks[12], (DEPTH, MLA_KV_RANK), 0.02),
        "w_ukv": nrm(ks[13], (DEPTH, MLA_KV_RANK, MLA_HEADS * (MLA_NOPE_DIM + MLA_V_DIM)), MLA_KV_RANK ** -0.5),
        "w_branch_diff": nrm(ks[14], (DEPTH, DIFF_HEADS * DIFF_V_DIM, D_MODEL), (DIFF_HEADS * DIFF_V_DIM) ** -0.5),
        "w_branch_mla": nrm(ks[15], (DEPTH, MLA_HEADS * MLA_V_DIM, D_MODEL), (MLA_HEADS * MLA_V_DIM) ** -0.5),
        "w_out": nrm(ks[16], (DEPTH, D_MODEL, D_MODEL), beta * D_MODEL ** -0.5),
        "ln_mix_g": 1.0 + nrm(ks[17], (DEPTH, D_MODEL), 0.02),
        "ln_mix_b": nrm(ks[18], (DEPTH, D_MODEL), 0.02),
        "dense_w1": nrm(ks[19], (N_DENSE, D_MODEL, DENSE_FF), D_MODEL ** -0.5),
        "dense_w3": nrm(ks[20], (N_DENSE, D_MODEL, DENSE_FF), D_MODEL ** -0.5),
        "dense_w2": nrm(ks[21], (N_DENSE, DENSE_FF, D_MODEL), beta * DENSE_FF ** -0.5),
        "router_w": nrm(ks[22], (N_MOE, D_MODEL, N_EXPERTS), D_MODEL ** -0.5),
        "expert_w1": nrm(ks[23], (N_MOE, N_EXPERTS, D_MODEL, EXPERT_FF), D_MODEL ** -0.5),
        "expert_w3": nrm(ks[24], (N_MOE, N_EXPERTS, D_MODEL, EXPERT_FF), D_MODEL ** -0.5),
        "expert_w2": nrm(ks[25], (N_MOE, N_EXPERTS, EXPERT_FF, D_MODEL), beta * EXPERT_FF ** -0.5),
        "w_ple_gate": nrm(ks[26], (DEPTH, D_MODEL, D_MODEL), D_MODEL ** -0.5),
        "w_ple_proj": nrm(ks[27], (DEPTH, PLE_DIM, D_MODEL), beta * PLE_DIM ** -0.5),
        "ln_ffn_g": 1.0 + nrm(ks[28], (DEPTH, D_MODEL), 0.02),
        "ln_ffn_b": nrm(ks[29], (DEPTH, D_MODEL), 0.02),
    }


def reference(x, p, positions, rel_bias_table, w_in, b_gate, lambda_q1, lambda_k1, lambda_q2, lambda_k2,
              diff_subln_g, mla_q_norm_g, w_uq, mla_kv_norm_g, w_ukv, w_branch_diff, w_branch_mla, w_out,
              ln_mix_g, ln_mix_b, dense_w1, dense_w3, dense_w2, router_w, expert_w1, expert_w3, expert_w2,
              w_ple_gate, w_ple_proj, ln_ffn_g, ln_ffn_b):
    for i in range(DEPTH):
        lam_init = 0.8 - 0.6 * math.exp(-0.3 * i)
        y = _mixer(x, positions, rel_bias_table, w_in[i], b_gate[i], lambda_q1[i], lambda_k1[i],
                   lambda_q2[i], lambda_k2[i], lam_init, diff_subln_g[i], mla_q_norm_g[i], w_uq[i],
                   mla_kv_norm_g[i], w_ukv[i], w_branch_diff[i], w_branch_mla[i], w_out[i])
        x = _layernorm(DEEPNORM_ALPHA * x + y, ln_mix_g[i], ln_mix_b[i])
        j = i // 2
        if i % 2 == 0:
            f = _swiglu(x, dense_w1[j], dense_w3[j], dense_w2[j])
        else:
            f = _moe(x, router_w[j], expert_w1[j], expert_w3[j], expert_w2[j])
        e = jax.nn.sigmoid(x @ w_ple_gate[i]) * (p[i] @ w_ple_proj[i])
        x = _layernorm(DEEPNORM_ALPHA * x + f + e, ln_ffn_g[i], ln_ffn_b[i])
    return x
```

```cpp
#include <hip/hip_runtime.h>
#include <cstdio>
#include <cstdint>
#include <cmath>

#ifndef MK_PER_PHASE
#define MK_PER_PHASE 1
#endif

constexpr int BATCH = 8, SEQ = 4096, T = BATCH * SEQ, D = 1024, DEPTH = 4, PLE = 256;
constexpr int IN_COLS = 5792, NIN = 5888;
constexpr int QR = 384, KVR = 256, ROPE_D = 32;
constexpr int DENSE_FF = 2816, EXPERT_FF = 3584, NEXP = 8;
constexpr float LN_EPS = 1e-5f;
constexpr float LOG2E = 1.4426950408889634f;
constexpr int MOE_ROWS = 2 * T + NEXP * 256;
constexpr int MOE_CHUNK_TILES = 128;
constexpr int MOE_NCHUNK = 3;

#define GAS __attribute__((address_space(1)))
#define LAS __attribute__((address_space(3)))
typedef unsigned short bf16;
typedef unsigned v4u __attribute__((ext_vector_type(4)));
typedef unsigned v2u __attribute__((ext_vector_type(2)));
typedef float f32x4 __attribute__((ext_vector_type(4)));
typedef float f32x2 __attribute__((ext_vector_type(2)));
typedef float f32x16 __attribute__((ext_vector_type(16)));
typedef short bf16x8 __attribute__((ext_vector_type(8)));
typedef short s16x4 __attribute__((ext_vector_type(4)));
typedef __bf16 bf16x2_t __attribute__((ext_vector_type(2)));
typedef GAS unsigned gu32;
#define RLX_AGENT __ATOMIC_RELAXED, __HIP_MEMORY_SCOPE_AGENT
#define LDS_WAIT() asm volatile("s_waitcnt lgkmcnt(0)" ::: "memory")
#define VM_WAIT() asm volatile("s_waitcnt vmcnt(0)" ::: "memory")

__device__ __forceinline__ unsigned pk2(float lo, float hi) { f32x2 v = {lo, hi}; bf16x2_t b = __builtin_convertvector(v, bf16x2_t); return __builtin_bit_cast(unsigned, b); }
__device__ __forceinline__ float bflo(unsigned u) { return __uint_as_float(u << 16); }
__device__ __forceinline__ float bfhi(unsigned u) { return __uint_as_float(u & 0xffff0000u); }
__device__ __forceinline__ float sigmoidf_(float x) { return __builtin_amdgcn_rcpf(1.0f + __builtin_amdgcn_exp2f(-x * LOG2E)); }
__device__ __forceinline__ float wave_sum(float v) {
#pragma unroll
    for (int o = 1; o < 64; o <<= 1) v += __shfl_xor(v, o);
    return v;
}

namespace pg8 {
#define PG8_LAS __attribute__((address_space(3)))
typedef unsigned short bf16_t;
typedef unsigned u32x4 __attribute__((ext_vector_type(4)));
typedef unsigned u32x2 __attribute__((ext_vector_type(2)));
constexpr int BM = 256, BK = 64, HALF = 128, HTB = HALF * BK * 2  , STAGE_BYTES = 8 * HTB, NXCD = 8, WGM = 8;

__host__ __device__ __forceinline__ int lds_byte(int r, int c) { const int st = (r >> 4) * 2 + (c >> 5), rr = r & 15, cc = c & 31, ob = rr * 64 + cc * 2; return st * 1024 + (ob ^ (((ob >> 9) & 1) << 5)); }
__host__ __device__ __forceinline__ void stage_rc(int b, int& R, int& C) { const int st = b / 1024, sb = b % 1024, swz = sb ^ (((sb >> 9) & 1) << 5); R = (st >> 1) * 16 + swz / 64; C = (st & 1) * 32 + (swz % 64) / 2; }
__host__ __device__ __forceinline__ int perm32(int rho) { const int n = rho >> 4, i = rho & 15; return 8 * (i >> 2) + 4 * n + (i & 3); }

struct Unit { int pm, pn; };
struct Gemm { const bf16_t* A; const bf16_t* Bt; int M, N, K; };

struct StaticOrder {
    int nM, nN, nwg, G, c;
    __host__ __device__ void init(int M, int N, int G_, int c_) { nM = M / BM; nN = N / BM; nwg = nM * nN; G = G_; c = c_; }
    __host__ __device__ bool next(int i, Unit& u) const {
        const long L = (long)i * G + c; if (L >= nwg) return false;
        int wgid = (int)L; { const int q = nwg / NXCD, r = nwg % NXCD, xcd = wgid % NXCD, off = wgid / NXCD; wgid = (xcd < r ? xcd * (q + 1) : r * (q + 1) + (xcd - r) * q) + off; }
        const int nig = WGM * nN, gid = wgid / nig, fm = gid * WGM, gsz = (nM - fm) < WGM ? (nM - fm) : WGM;
        u.pm = fm + ((wgid % nig) % gsz); u.pn = (wgid % nig) / gsz; return true;
    }
    __device__ __forceinline__ size_t bofs(const Unit&) const { return 0; }
    __device__ __forceinline__ void a_ready(const Unit&) const {}
    __device__ __forceinline__ void done(const Unit&) const {}
};
struct GroupedOrder : StaticOrder {
    int tile_lo; int pend0, pend1, pend2, pend3, pend4, pend5, pend6, pend7; size_t estride;
    __device__ __forceinline__ size_t bofs(const Unit& u) const {
        const int t = u.pm + tile_lo;
        const int e = (t >= pend0) + (t >= pend1) + (t >= pend2) + (t >= pend3) + (t >= pend4) + (t >= pend5) + (t >= pend6);
        return (size_t)e * estride;
    }
};

typedef f32x4 Acc[2][2][4][2];

struct EpiL1 {
    static constexpr bool PERM = true, AFTER_DRAIN = false;
    bf16_t* QKV; bf16_t* Gt; float* CQ; const float* bgate; float qscale;
    __device__ __forceinline__ void operator()(const Acc& acc, const Unit& u, int wr, int wc, int fr, int fq) const {
        const int row0 = u.pm * BM + wr * 64 + fr; const int pn = u.pn;
        if (pn < 12) {
            bf16_t* base = QKV + (size_t)(pn >> 2) * ((size_t)T * 1024); const int col0 = (pn & 3) * 256 + wc * 32 + 8 * fq; const float sc = pn < 4 ? qscale : 1.f;
#pragma unroll
            for (int ai = 0; ai < 2; ++ai)
#pragma unroll
                for (int m = 0; m < 4; ++m) { bf16_t* rowp = base + (size_t)(row0 + ai * HALF + m * 16) * 1024 + col0;
#pragma unroll
                    for (int bj = 0; bj < 2; ++bj) { const f32x4 v0 = acc[ai][bj][m][0] * sc, v1 = acc[ai][bj][m][1] * sc;
                        u32x4 w; w.x = pk2(v0[0], v0[1]); w.y = pk2(v0[2], v0[3]); w.z = pk2(v1[0], v1[1]); w.w = pk2(v1[2], v1[3]);
                        *(u32x4*)(rowp + bj * HALF) = w; } }
        } else if (pn < 20) {
            const int col0 = (pn - 12) * 256 + wc * 32 + 8 * fq;
            f32x4 bv[2][2];
#pragma unroll
            for (int bj = 0; bj < 2; ++bj)
#pragma unroll
                for (int n = 0; n < 2; ++n) bv[bj][n] = *(const f32x4*)(bgate + col0 + bj * HALF + 4 * n);
#pragma unroll
            for (int ai = 0; ai < 2; ++ai)
#pragma unroll
                for (int m = 0; m < 4; ++m) { bf16_t* rowp = Gt + (size_t)(row0 + ai * HALF + m * 16) * 2048 + col0;
#pragma unroll
                    for (int bj = 0; bj < 2; ++bj) { const f32x4 v0 = acc[ai][bj][m][0] + bv[bj][0], v1 = acc[ai][bj][m][1] + bv[bj][1];
                        u32x4 w; w.x = pk2(sigmoidf_(v0[0]), sigmoidf_(v0[1])); w.y = pk2(sigmoidf_(v0[2]), sigmoidf_(v0[3])); w.z = pk2(sigmoidf_(v1[0]), sigmoidf_(v1[1])); w.w = pk2(sigmoidf_(v1[2]), sigmoidf_(v1[3]));
                        *(u32x4*)(rowp + bj * HALF) = w; } }
        } else {
            const int col0 = (pn - 20) * 256 + wc * 32 + 8 * fq;
#pragma unroll
            for (int ai = 0; ai < 2; ++ai)
#pragma unroll
                for (int m = 0; m < 4; ++m) { float* rowp = CQ + (size_t)(row0 + ai * HALF + m * 16) * 768 + col0;
#pragma unroll
                    for (int bj = 0; bj < 2; ++bj) { *(f32x4*)(rowp + bj * HALF) = acc[ai][bj][m][0]; *(f32x4*)(rowp + bj * HALF + 4) = acc[ai][bj][m][1]; } }
        }
    }
};
struct EpiRopeQ {
    static constexpr bool PERM = false, AFTER_DRAIN = false;
    bf16_t* O; const float* rope; float qscale;
    __device__ __forceinline__ void operator()(const Acc& acc, const Unit& u, int wr, int wc, int fr, int fq) const {
        const int row0 = u.pm * BM + wr * 64 + fr;
#pragma unroll
        for (int ai = 0; ai < 2; ++ai)
#pragma unroll
            for (int m = 0; m < 4; ++m) { const int row = row0 + ai * HALF + m * 16;
                const f32x4 cs0 = *(const f32x4*)(rope + (size_t)row * 32 + fq * 8), cs1 = *(const f32x4*)(rope + (size_t)row * 32 + fq * 8 + 4);
                const f32x4 cc = {cs0[0], cs0[2], cs1[0], cs1[2]}, ss = {cs0[1], cs0[3], cs1[1], cs1[3]};
#pragma unroll
                for (int bj = 0; bj < 2; ++bj) { const int colg = u.pn * BM + bj * HALF + wc * 32; const bool isr = ((colg >> 5) % 3) == 2;
                    const f32x4 x1 = acc[ai][bj][m][0], x2 = acc[ai][bj][m][1];
                    f32x4 o1 = x1, o2 = x2; if (isr) { o1 = x1 * cc - x2 * ss; o2 = x1 * ss + x2 * cc; }
                    o1 = o1 * qscale; o2 = o2 * qscale;
                    bf16_t* p = O + (size_t)row * 768 + colg + 4 * fq;
                    u32x2 w1; w1.x = pk2(o1[0], o1[1]); w1.y = pk2(o1[2], o1[3]); u32x2 w2; w2.x = pk2(o2[0], o2[1]); w2.y = pk2(o2[2], o2[3]);
                    *(u32x2*)p = w1; *(u32x2*)(p + 16) = w2; } }
    }
};
struct EpiBf16 {
    static constexpr bool PERM = true, AFTER_DRAIN = false;
    bf16_t* O; int ldc;
    __device__ __forceinline__ void operator()(const Acc& acc, const Unit& u, int wr, int wc, int fr, int fq) const {
        const int row0 = u.pm * BM + wr * 64 + fr, col0 = u.pn * BM + wc * 32 + 8 * fq;
#pragma unroll
        for (int ai = 0; ai < 2; ++ai)
#pragma unroll
            for (int m = 0; m < 4; ++m) { bf16_t* rowp = O + (size_t)(row0 + ai * HALF + m * 16) * ldc + col0;
#pragma unroll
                for (int bj = 0; bj < 2; ++bj) { const f32x4 v0 = acc[ai][bj][m][0], v1 = acc[ai][bj][m][1];
                    u32x4 w; w.x = pk2(v0[0], v0[1]); w.y = pk2(v0[2], v0[3]); w.z = pk2(v1[0], v1[1]); w.w = pk2(v1[2], v1[3]);
                    *(u32x4*)(rowp + bj * HALF) = w; } }
    }
};
template <bool ADD> struct EpiGate {
    static constexpr bool PERM = true, AFTER_DRAIN = false;
    bf16_t* O; const bf16_t* Gt; const bf16_t* MT; int goff;
    __device__ __forceinline__ void operator()(const Acc& acc, const Unit& u, int wr, int wc, int fr, int fq) const {
        const int row0 = u.pm * BM + wr * 64 + fr, col0 = u.pn * BM + wc * 32 + 8 * fq;
#pragma unroll
        for (int ai = 0; ai < 2; ++ai)
#pragma unroll
            for (int m = 0; m < 4; ++m) { const size_t row = (size_t)(row0 + ai * HALF + m * 16);
#pragma unroll
                for (int bj = 0; bj < 2; ++bj) { const int col = col0 + bj * HALF;
                    const u32x4 gv = *(const u32x4*)(Gt + row * 2048 + goff + col);
                    f32x4 v0 = acc[ai][bj][m][0], v1 = acc[ai][bj][m][1];
                    v0[0] *= bflo(gv.x); v0[1] *= bfhi(gv.x); v0[2] *= bflo(gv.y); v0[3] *= bfhi(gv.y); v1[0] *= bflo(gv.z); v1[1] *= bfhi(gv.z); v1[2] *= bflo(gv.w); v1[3] *= bfhi(gv.w);
                    if (ADD) { const u32x4 mv = *(const u32x4*)(MT + row * 1024 + col);
                        v0[0] += bflo(mv.x); v0[1] += bfhi(mv.x); v0[2] += bflo(mv.y); v0[3] += bfhi(mv.y); v1[0] += bflo(mv.z); v1[1] += bfhi(mv.z); v1[2] += bflo(mv.w); v1[3] += bfhi(mv.w); }
                    u32x4 w; w.x = pk2(v0[0], v0[1]); w.y = pk2(v0[2], v0[3]); w.z = pk2(v1[0], v1[1]); w.w = pk2(v1[2], v1[3]);
                    *(u32x4*)(O + row * 1024 + col) = w; } }
    }
};
template <int MODE> struct EpiF32 {
    static constexpr bool PERM = false, AFTER_DRAIN = false;
    float* P; const float* X; float alpha;
    __device__ __forceinline__ void operator()(const Acc& acc, const Unit& u, int wr, int wc, int fr, int fq) const {
        const int row0 = u.pm * BM + wr * 64 + fr, col0 = u.pn * BM + wc * 32 + 4 * fq;
#pragma unroll
        for (int ai = 0; ai < 2; ++ai)
#pragma unroll
            for (int m = 0; m < 4; ++m) { const size_t off = (size_t)(row0 + ai * HALF + m * 16) * 1024 + col0;
#pragma unroll
                for (int bj = 0; bj < 2; ++bj)
#pragma unroll
                    for (int n = 0; n < 2; ++n) { const size_t o = off + bj * HALF + n * 16; const f32x4 a = acc[ai][bj][m][n]; f32x4 r;
                        if (MODE == 0) r = a;
                        else if (MODE == 1) r = *(const f32x4*)(X + o) * alpha + a;
                        else if (MODE == 2) { const f32x4 pv = *(const f32x4*)(P + o); const f32x4 xv = *(const f32x4*)(X + o);
                            r[0] = xv[0] * alpha + sigmoidf_(a[0]) * pv[0]; r[1] = xv[1] * alpha + sigmoidf_(a[1]) * pv[1]; r[2] = xv[2] * alpha + sigmoidf_(a[2]) * pv[2]; r[3] = xv[3] * alpha + sigmoidf_(a[3]) * pv[3]; }
                        else r = *(const f32x4*)(P + o) + a;
                        *(f32x4*)(P + o) = r; } }
    }
};
struct EpiSwiGLU {
    static constexpr bool PERM = true, AFTER_DRAIN = false;
    bf16_t* H; int ldc;
    __device__ __forceinline__ void operator()(const Acc& acc, const Unit& u, int wr, int wc, int fr, int fq) const {
        const int row0 = u.pm * BM + wr * 64 + fr, col0 = (u.pn * BM + wc * 32 + 8 * fq) >> 1;
#pragma unroll
        for (int ai = 0; ai < 2; ++ai)
#pragma unroll
            for (int m = 0; m < 4; ++m) { bf16_t* rowp = H + (size_t)(row0 + ai * HALF + m * 16) * ldc + col0;
#pragma unroll
                for (int bj = 0; bj < 2; ++bj) { const f32x4 v0 = acc[ai][bj][m][0], v1 = acc[ai][bj][m][1];
                    const float h0 = v0[0] * sigmoidf_(v0[0]) * v0[1], h1 = v0[2] * sigmoidf_(v0[2]) * v0[3], h2 = v1[0] * sigmoidf_(v1[0]) * v1[1], h3 = v1[2] * sigmoidf_(v1[2]) * v1[3];
                    u32x2 w; w.x = pk2(h0, h1); w.y = pk2(h2, h3);
                    *(u32x2*)(rowp + bj * (HALF / 2)) = w; } }
    }
};

template <class Epi, class Sched, bool ALIGN_EPI = false, bool SP2 = false>
__device__ __forceinline__ void gemm_phase(PG8_LAS unsigned char* lds, const Gemm g, const Sched& S, const Epi& E) {
    int tid_ = threadIdx.x; asm volatile("" : "+v"(tid_));
    const int tid = tid_, wid = __builtin_amdgcn_readfirstlane(tid >> 6), lane = tid & 63, wr = wid >> 2, wc = wid & 3, fr = lane & 15, fq = lane >> 4;
    int K_ = g.K; asm volatile("" : "+s"(K_)); const int K = K_, nt = K / BK;
    unsigned voffA[2], voffB[2];
#pragma unroll
    for (int i = 0; i < 2; ++i) { int R, C; stage_rc(tid * 16 + i * 8192, R, C); const int Rb = Epi::PERM ? ((R & ~31) + perm32(R & 31)) : R;
        voffA[i] = (unsigned)(R * K + C) * 2u; voffB[i] = (unsigned)(Rb * K + C) * 2u; }
    const size_t kstep = (size_t)(BK * 2);
    const size_t hstep = (size_t)HALF * K * 2;
    const size_t tstep = 2 * hstep;
    const unsigned ldsw = (unsigned)wid * 1024u;
    const int aoff = lds_byte(wr * 64 + fr, fq * 8), boff = lds_byte(wc * 32 + fr, fq * 8);
#define PG8_SA(b, h) (((b) * 2 + (h)) * HTB)
#define PG8_SB(b, h) ((4 + (b) * 2 + (h)) * HTB)
#define PG8_STAGE(bufoff, gbase, voff) do { _Pragma("unroll") for (int _i = 0; _i < 2; ++_i) \
        __builtin_amdgcn_global_load_lds((const unsigned*)((const char*)(gbase) + (voff)[_i]), (PG8_LAS unsigned*)(lds + (bufoff) + ldsw + _i * 8192), 16, 0, 0); } while (0)
#define PG8_LDA(dst, b, h) do { _Pragma("unroll") for (int m = 0; m < 4; ++m) _Pragma("unroll") for (int k = 0; k < 2; ++k) dst[m][k] = *(const PG8_LAS bf16x8*)(lds + PG8_SA(b, h) + aoff + m * 2048 + k * 1024); } while (0)
#define PG8_LDB(dst, b, h) do { _Pragma("unroll") for (int n = 0; n < 2; ++n) _Pragma("unroll") for (int k = 0; k < 2; ++k) dst[n][k] = *(const PG8_LAS bf16x8*)(lds + PG8_SB(b, h) + boff + n * 2048 + k * 1024); } while (0)
#define PG8_MMA(ai, bj, At, Bt) do { __builtin_amdgcn_s_setprio(1); _Pragma("unroll") for (int m = 0; m < 4; ++m) _Pragma("unroll") for (int n = 0; n < 2; ++n) _Pragma("unroll") for (int k = 0; k < 2; ++k) \
        acc[ai][bj][m][n] = __builtin_amdgcn_mfma_f32_16x16x32_bf16(Bt[n][k], At[m][k], acc[ai][bj][m][n], 0, 0, 0); __builtin_amdgcn_s_setprio(0); } while (0)
#define PG8_WAIT_V(n) asm volatile("s_waitcnt vmcnt(" #n ")" ::: "memory")
#define PG8_WAIT_L(n) asm volatile("s_waitcnt lgkmcnt(" #n ")" ::: "memory")
#define PG8_BAR __builtin_amdgcn_s_barrier()
#define PG8_SCHED __builtin_amdgcn_sched_barrier(0)
    Unit cur, nxt; int ui = 0;
    if (!S.next(0, cur)) return;
    f32x4 acc[2][2][4][2];
#pragma unroll
    for (int a = 0; a < 2; ++a)
#pragma unroll
        for (int b = 0; b < 2; ++b)
#pragma unroll
            for (int m = 0; m < 4; ++m)
#pragma unroll
                for (int n = 0; n < 2; ++n) acc[a][b][m][n] = (f32x4){0.f, 0.f, 0.f, 0.f};
    bf16x8 At[4][2], B0[2][2], B1[2][2];
    const char* cA = (const char*)g.A + (size_t)cur.pm * tstep; const char* cB = (const char*)g.Bt + (size_t)cur.pn * tstep + S.bofs(cur);
    S.a_ready(cur);
    if constexpr (SP2) {
        PG8_STAGE(PG8_SB(0, 0), cB, voffB); PG8_STAGE(PG8_SB(0, 1), cB + hstep, voffB); PG8_STAGE(PG8_SA(0, 0), cA, voffA); PG8_STAGE(PG8_SA(0, 1), cA + hstep, voffA);
        if (wr == 1) PG8_BAR;
        PG8_WAIT_V(2); PG8_BAR;
        PG8_STAGE(PG8_SB(1, 0), cB + kstep, voffB); PG8_STAGE(PG8_SA(1, 0), cA + kstep, voffA); PG8_STAGE(PG8_SB(1, 1), cB + hstep + kstep, voffB);
        PG8_WAIT_V(6); PG8_BAR;
    } else {
        PG8_STAGE(PG8_SB(0, 0), cB, voffB); PG8_STAGE(PG8_SA(0, 0), cA, voffA); PG8_STAGE(PG8_SB(0, 1), cB + hstep, voffB); PG8_STAGE(PG8_SA(0, 1), cA + hstep, voffA);
        if (wr == 1) PG8_BAR;
        PG8_WAIT_V(4); PG8_BAR;
        PG8_STAGE(PG8_SB(1, 0), cB + kstep, voffB); PG8_STAGE(PG8_SA(1, 0), cA + kstep, voffA); PG8_STAGE(PG8_SB(1, 1), cB + hstep + kstep, voffB);
        PG8_WAIT_V(6); PG8_BAR;
    }
    for (;;) {
        const bool has_next = S.next(ui + 1, nxt);
        const char* nA = has_next ? (const char*)g.A + (size_t)nxt.pm * tstep : cA; const char* nB = has_next ? (const char*)g.Bt + (size_t)nxt.pn * tstep + S.bofs(nxt) : cB;
#pragma nounroll
        for (int t = 0; t < nt; t += 2) {
            const bool last = (t == nt - 2);
            const char* a1 = cA + (size_t)(t + 1) * kstep;
            const char* a2 = last ? nA : cA + (size_t)(t + 2) * kstep; const char* b2 = last ? nB : cB + (size_t)(t + 2) * kstep;
            const char* a3 = a2 + kstep; const char* b3 = b2 + kstep;
            if (last && has_next) S.a_ready(nxt);
            if constexpr (SP2) {
            PG8_LDB(B0, 0, 0); PG8_LDB(B1, 0, 1); PG8_SCHED; PG8_LDA(At, 0, 0); PG8_STAGE(PG8_SA(1, 1), a1 + hstep, voffA);
            PG8_WAIT_V(8); PG8_WAIT_L(0); PG8_BAR; PG8_MMA(0, 0, At, B0); PG8_MMA(0, 1, At, B1); PG8_BAR; PG8_SCHED;
            PG8_LDA(At, 0, 1); PG8_STAGE(PG8_SB(0, 0), b2, voffB); PG8_STAGE(PG8_SB(0, 1), b2 + hstep, voffB); PG8_STAGE(PG8_SA(0, 0), a2, voffA);
            PG8_WAIT_V(8); PG8_WAIT_L(0); PG8_BAR; PG8_MMA(1, 0, At, B0); PG8_MMA(1, 1, At, B1); PG8_BAR; PG8_SCHED;
            PG8_LDB(B0, 1, 0); PG8_LDB(B1, 1, 1); PG8_SCHED; PG8_LDA(At, 1, 0); PG8_STAGE(PG8_SA(0, 1), a2 + hstep, voffA);
            PG8_WAIT_V(8); PG8_WAIT_L(0); PG8_BAR; PG8_MMA(0, 0, At, B0); PG8_MMA(0, 1, At, B1); PG8_BAR; PG8_SCHED;
            PG8_LDA(At, 1, 1); PG8_STAGE(PG8_SB(1, 0), b3, voffB); PG8_STAGE(PG8_SB(1, 1), b3 + hstep, voffB); PG8_STAGE(PG8_SA(1, 0), a3, voffA);
            PG8_WAIT_V(8); PG8_WAIT_L(0); PG8_BAR; PG8_MMA(1, 0, At, B0); PG8_MMA(1, 1, At, B1); PG8_BAR; PG8_SCHED;
            } else {
            PG8_LDB(B0, 0, 0); PG8_SCHED; PG8_LDA(At, 0, 0); PG8_STAGE(PG8_SA(1, 1), a1 + hstep, voffA);
            PG8_WAIT_L(8); PG8_BAR; PG8_WAIT_L(0); PG8_MMA(0, 0, At, B0); PG8_BAR; PG8_SCHED;
            PG8_LDB(B1, 0, 1); PG8_STAGE(PG8_SB(0, 0), b2, voffB);
            PG8_BAR; PG8_WAIT_L(0); PG8_MMA(0, 1, At, B1); PG8_BAR;
            PG8_LDA(At, 0, 1); PG8_STAGE(PG8_SA(0, 0), a2, voffA);
            PG8_BAR; PG8_WAIT_L(0); PG8_MMA(1, 0, At, B0); PG8_BAR; PG8_SCHED;
            PG8_STAGE(PG8_SB(0, 1), b2 + hstep, voffB);
            PG8_WAIT_V(6); PG8_BAR; PG8_MMA(1, 1, At, B1); PG8_BAR;
            PG8_LDB(B0, 1, 0); PG8_SCHED; PG8_LDA(At, 1, 0); PG8_STAGE(PG8_SA(0, 1), a2 + hstep, voffA);
            PG8_WAIT_L(8); PG8_BAR; PG8_WAIT_L(0); PG8_MMA(0, 0, At, B0); PG8_BAR; PG8_SCHED;
            PG8_LDB(B1, 1, 1); PG8_STAGE(PG8_SB(1, 0), b3, voffB);
            PG8_BAR; PG8_WAIT_L(0); PG8_MMA(0, 1, At, B1); PG8_BAR;
            PG8_LDA(At, 1, 1); PG8_STAGE(PG8_SA(1, 0), a3, voffA);
            PG8_BAR; PG8_WAIT_L(0); PG8_MMA(1, 0, At, B0); PG8_BAR; PG8_SCHED;
            PG8_STAGE(PG8_SB(1, 1), b3 + hstep, voffB);
            PG8_WAIT_V(6); PG8_BAR; PG8_MMA(1, 1, At, B1); PG8_BAR;
            }
        }
        if constexpr (ALIGN_EPI) { if (wr == 0) PG8_BAR; }
        if constexpr (!Epi::AFTER_DRAIN) { E(acc, cur, wr, wc, fr, fq); S.done(cur); }
        if (!has_next) break;
#pragma unroll
        for (int a = 0; a < 2; ++a)
#pragma unroll
            for (int b = 0; b < 2; ++b)
#pragma unroll
                for (int m = 0; m < 4; ++m)
#pragma unroll
                    for (int n = 0; n < 2; ++n) acc[a][b][m][n] = (f32x4){0.f, 0.f, 0.f, 0.f};
        cur = nxt; cA = nA; cB = nB; ++ui;
        if constexpr (ALIGN_EPI) { if (wr == 1) PG8_BAR; }
    }
    PG8_WAIT_V(0);
    if constexpr (!ALIGN_EPI) { if (wr == 0) PG8_BAR; }
    PG8_BAR;
    if constexpr (Epi::AFTER_DRAIN) { E.fused(acc, cur, wr, wc, fr, fq, lds, wid, lane); S.done(cur); }
#undef PG8_SA
#undef PG8_SB
#undef PG8_STAGE
#undef PG8_LDA
#undef PG8_LDB
#undef PG8_MMA
#undef PG8_WAIT_V
#undef PG8_WAIT_L
#undef PG8_BAR
#undef PG8_SCHED
}
}

namespace att {
#define MFMA32(a, b, c) __builtin_amdgcn_mfma_f32_32x32x16_bf16((a), (b), (c), 0, 0, 0)
typedef short v4i16_t __attribute__((ext_vector_type(4)));
struct AttnP {
    const bf16* Q; int ldq;
    const bf16* K1; int ldk1;
    const bf16* K2; int ldk2;
    const bf16* V; int ldv;
    bf16* O; int ldo;
    const int* pos;
    const int* blkmax;
    const float* lut;
};
__device__ __forceinline__ s16x4 vtr(const LAS unsigned char* p) { return __builtin_bit_cast(s16x4, __builtin_amdgcn_ds_read_tr16_b64_v4i16((LAS v4i16_t*)p)); }

template <int DQK, int KSPLIT, int DV, bool BIAS>
__device__ __forceinline__ void attn_unit(const AttnP& P, int b, int qt, int qcol, int kcol, int vcol, int ocol, int hb, LAS unsigned char* lds) {
    constexpr int KROWB = DQK * 2 + 16;
    constexpr int VROWB = (DV == 128) ? 320 : 192;
    constexpr int KBYTES = 64 * KROWB, VBYTES = 64 * VROWB, STAGE = KBYTES + VBYTES + 256, LUT_OFF = 2 * STAGE;
    constexpr int ND = DQK / 16, NDB = DV / 32, KCH = DQK / 8, VCH = DV / 8, NKC = 64 * KCH, NVC = 64 * VCH, KL = (NKC + 511) / 512, VL = (NVC + 511) / 512;
    int tid_ = threadIdx.x; asm volatile("" : "+v"(tid_));
    const int tid = tid_, lane = tid & 63, wid = __builtin_amdgcn_readfirstlane(tid >> 6), r = lane & 31, h = lane >> 5;
    const long tok0 = (long)b * SEQ; const int q0 = qt * 256; const int qrow = q0 + wid * 32 + r;
    bf16x8 qf[ND];
    { const bf16* qp = P.Q + (tok0 + qrow) * (long)P.ldq + qcol + 8 * h;
#pragma unroll
      for (int d = 0; d < ND; ++d) qf[d] = *(const bf16x8*)(qp + 16 * d); }
    int posq = 0, posq_min = 0;
    LAS float* lut = (LAS float*)(lds + LUT_OFF);
    if (BIAS) { posq = P.pos[tok0 + qrow]; int mn = posq;
#pragma unroll
        for (int o = 1; o < 64; o <<= 1) { const int t2 = __shfl_xor(mn, o); mn = t2 < mn ? t2 : mn; }
        posq_min = mn;
        if (tid < 132) lut[tid] = P.lut[hb * 132 + tid]; }
    v4u kreg[KL], vreg[VL]; int preg = 0;
#define ATT_ISSUE(t) do { const long trow = tok0 + 64 * (long)(t); \
        _Pragma("unroll") for (int i = 0; i < KL; ++i) { const int c = tid + 512 * i; if (c < NKC) { const int row = c / KCH, col = (c % KCH) * 8; \
            const bf16* src = (col < KSPLIT) ? P.K1 + (trow + row) * (long)P.ldk1 + kcol + col : P.K2 + (trow + row) * (long)P.ldk2 + (col - KSPLIT); kreg[i] = *(const v4u*)src; } } \
        _Pragma("unroll") for (int i = 0; i < VL; ++i) { const int c = tid + 512 * i; if (c < NVC) { const int row = c / VCH, col = (c % VCH) * 8; vreg[i] = *(const v4u*)(P.V + (trow + row) * (long)P.ldv + vcol + col); } } \
        if (BIAS && tid < 64) preg = P.pos[trow + tid]; } while (0)
#define ATT_WRITE(t) do { LAS unsigned char* sb = lds + ((t) & 1) * STAGE; \
        _Pragma("unroll") for (int i = 0; i < KL; ++i) { const int c = tid + 512 * i; if (c < NKC) { const int row = c / KCH, cc = c % KCH; *(LAS v4u*)(sb + row * KROWB + cc * 16) = kreg[i]; } } \
        _Pragma("unroll") for (int i = 0; i < VL; ++i) { const int c = tid + 512 * i; if (c < NVC) { const int row = c / VCH, cc = c % VCH; *(LAS v4u*)(sb + KBYTES + row * VROWB + cc * 16) = vreg[i]; } } \
        if (BIAS && tid < 64) *(LAS int*)(sb + KBYTES + VBYTES + 4 * tid) = preg; } while (0)
    f32x16 o[NDB];
#pragma unroll
    for (int i = 0; i < NDB; ++i)
#pragma unroll
        for (int j = 0; j < 16; ++j) o[i][j] = 0.f;
    float m_run = -INFINITY, l_run = 0.f;
    const int ntiles = (q0 + 256) / 64, my_last = (q0 + wid * 32 + 31) / 64;
    ATT_ISSUE(0); ATT_WRITE(0); __syncthreads();
    const int kbase = r * KROWB + 16 * h;
    const int vbase = KBYTES + (4 * h + ((lane & 15) >> 2)) * VROWB + (((lane >> 4) & 1) * 16 + (lane & 3) * 4) * 2;
    for (int t = 0; t < ntiles; ++t) {
        const bool more = (t + 1 < ntiles);
        if (more) ATT_ISSUE(t + 1);
        if (t <= my_last) {
            const LAS unsigned char* sb = lds + (t & 1) * STAGE;
            bool plain = (64 * t + 63 <= q0 + wid * 32);
            float cinit = 0.f;
            if (BIAS) { const int kmax = P.blkmax[(int)(tok0 >> 6) + t]; if (plain && (posq_min - kmax >= 113)) cinit = lut[128]; else plain = false; }
            f32x16 x0, x1;
#pragma unroll
            for (int j = 0; j < 16; ++j) { x0[j] = cinit; x1[j] = cinit; }
#pragma unroll
            for (int d = 0; d < ND; ++d) {
                const bf16x8 k0 = *(const LAS bf16x8*)(sb + kbase + d * 32), k1 = *(const LAS bf16x8*)(sb + kbase + 32 * KROWB + d * 32);
                x0 = MFMA32(k0, qf[d], x0); x1 = MFMA32(k1, qf[d], x1);
            }
            if (!plain) {
#pragma unroll
                for (int g = 0; g < 4; ++g) {
                    int pk0[4] = {0, 0, 0, 0}, pk1[4] = {0, 0, 0, 0};
                    if (BIAS) { const LAS int* pp = (const LAS int*)(sb + KBYTES + VBYTES) + 8 * g + 4 * h;
                        const v4u a = *(const LAS v4u*)pp, c = *(const LAS v4u*)(pp + 32);
                        pk0[0] = a.x; pk0[1] = a.y; pk0[2] = a.z; pk0[3] = a.w; pk1[0] = c.x; pk1[1] = c.y; pk1[2] = c.z; pk1[3] = c.w; }
#pragma unroll
                    for (int j = 0; j < 4; ++j) { const int i = 4 * g + j; const int kidx = 64 * t + 8 * g + 4 * h + j;
                        float v0 = x0[i], v1 = x1[i];
                        if (BIAS) { int n0 = posq - pk0[j]; n0 = n0 < 0 ? 0 : (n0 > 128 ? 128 : n0); int n1 = posq - pk1[j]; n1 = n1 < 0 ? 0 : (n1 > 128 ? 128 : n1); v0 += lut[n0]; v1 += lut[n1]; }
                        if (kidx > qrow) v0 = -INFINITY; if (kidx + 32 > qrow) v1 = -INFINITY;
                        x0[i] = v0; x1[i] = v1; }
                }
            }
            float mx = x0[0];
#pragma unroll
            for (int j = 1; j < 16; ++j) mx = fmaxf(mx, x0[j]);
#pragma unroll
            for (int j = 0; j < 16; ++j) mx = fmaxf(mx, x1[j]);
            mx = fmaxf(mx, __shfl_xor(mx, 32));
            const float mn = fmaxf(m_run, mx), alpha = __builtin_amdgcn_exp2f(m_run - mn); m_run = mn;
            float ls = 0.f;
#pragma unroll
            for (int j = 0; j < 16; ++j) { x0[j] = __builtin_amdgcn_exp2f(x0[j] - mn); x1[j] = __builtin_amdgcn_exp2f(x1[j] - mn); ls += x0[j] + x1[j]; }
            l_run = l_run * alpha + ls;
#pragma unroll
            for (int i = 0; i < NDB; ++i) o[i] = o[i] * alpha;
            bf16x8 pf[4];
            { v4u w;
              w.x = pk2(x0[0], x0[1]); w.y = pk2(x0[2], x0[3]); w.z = pk2(x0[4], x0[5]); w.w = pk2(x0[6], x0[7]); pf[0] = __builtin_bit_cast(bf16x8, w);
              w.x = pk2(x0[8], x0[9]); w.y = pk2(x0[10], x0[11]); w.z = pk2(x0[12], x0[13]); w.w = pk2(x0[14], x0[15]); pf[1] = __builtin_bit_cast(bf16x8, w);
              w.x = pk2(x1[0], x1[1]); w.y = pk2(x1[2], x1[3]); w.z = pk2(x1[4], x1[5]); w.w = pk2(x1[6], x1[7]); pf[2] = __builtin_bit_cast(bf16x8, w);
              w.x = pk2(x1[8], x1[9]); w.y = pk2(x1[10], x1[11]); w.z = pk2(x1[12], x1[13]); w.w = pk2(x1[14], x1[15]); pf[3] = __builtin_bit_cast(bf16x8, w); }
#pragma unroll
            for (int db = 0; db < NDB; ++db)
#pragma unroll
                for (int s = 0; s < 4; ++s) {
                    const s16x4 lo = vtr(sb + vbase + (16 * s) * VROWB + 64 * db), hi = vtr(sb + vbase + (16 * s + 8) * VROWB + 64 * db);
                    const bf16x8 vf = __builtin_shufflevector(lo, hi, 0, 1, 2, 3, 4, 5, 6, 7);
                    o[db] = MFMA32(vf, pf[s], o[db]);
                }
        }
        if (more) ATT_WRITE(t + 1);
        __syncthreads();
    }
#undef ATT_ISSUE
#undef ATT_WRITE
    const float lt = l_run + __shfl_xor(l_run, 32), inv = 1.0f / lt;
    bf16* op = P.O + (tok0 + qrow) * (long)P.ldo + ocol + 4 * h;
#pragma unroll
    for (int db = 0; db < NDB; ++db)
#pragma unroll
        for (int g = 0; g < 4; ++g) { v2u w; w.x = pk2(o[db][4 * g] * inv, o[db][4 * g + 1] * inv); w.y = pk2(o[db][4 * g + 2] * inv, o[db][4 * g + 3] * inv);
            *(v2u*)(op + 32 * db + 8 * g) = w; }
}
#undef MFMA32
}

constexpr size_t MiB = 1u << 20;
constexpr size_t WS_CTL = 0, CTL_ZERO_BYTES = 1 * MiB;
constexpr size_t WS_ROPE = 1 * MiB;
constexpr size_t WS_MISC = 5 * MiB;
constexpr size_t WS_XB = 6 * MiB;
constexpr size_t WS_PB = 70 * MiB;
constexpr size_t WS_W = 86 * MiB;
constexpr size_t W_IN = WS_W, W_UQ = WS_W + 12 * MiB, W_UKV = WS_W + 13 * MiB, W_BD = WS_W + 14 * MiB, W_BM = WS_W + 16 * MiB, W_OUT = WS_W + 17 * MiB,
                 W_PG = WS_W + 19 * MiB, W_PP = WS_W + 21 * MiB, W_F13 = WS_W + 22 * MiB, W_F2D = WS_W + 33 * MiB, W_F2E = WS_W + 134 * MiB;
constexpr size_t WS_ACT = 276 * MiB;
constexpr size_t A_DQ = WS_ACT, A_DK = WS_ACT + 64 * MiB, A_DV = WS_ACT + 128 * MiB, A_G = WS_ACT + 192 * MiB, A_C = WS_ACT + 320 * MiB;
constexpr size_t A_OA = A_DQ, A_MT = A_DK, A_M = A_DV, A_CQ = A_C, A_OA2 = A_C, A_PRE = A_C;
constexpr size_t A_CQN = WS_ACT + 448 * MiB, A_CKVN = WS_ACT + 472 * MiB, A_OB = A_CQN, A_MKR = WS_ACT + 488 * MiB, A_MQ = WS_ACT + 490 * MiB, A_MKV = WS_ACT + 538 * MiB;
constexpr size_t A_H = WS_ACT;
constexpr size_t A_XG = WS_ACT, A_YG = WS_ACT + 132 * MiB, A_TOK = WS_ACT + 264 * MiB, A_HG = WS_ACT + 448 * MiB;
constexpr size_t WS_END = WS_ACT + 672 * MiB;
constexpr int CW_BAR = 4096, CW_MOE = 8192;

constexpr int RING_BYTES = 131072, MISC_OFF = RING_BYTES + 320, LDS_BYTES = 147456;
constexpr int NWAVES = 8;

#define XB_TMO      128
#define XB_XCNT(j)  (256  + 64 * (j))
#define XB_XSUB(j)  (1280 + 64 * (j))
#define XB_XGEN(j)  (2304 + 64 * (j))
#define XB_TOP      3328
#define XB_TOPGEN   3392
#define XCD_BAR_WORDS 3456
#define XB_SPIN_CAP (1u << 18)

__device__ __forceinline__ unsigned xb_ld(unsigned* p)              { return __hip_atomic_load(p, __ATOMIC_RELAXED, __HIP_MEMORY_SCOPE_AGENT); }
__device__ __forceinline__ unsigned xb_add(unsigned* p, unsigned v) { return __hip_atomic_fetch_add(p, v, __ATOMIC_RELAXED, __HIP_MEMORY_SCOPE_AGENT); }
__device__ __forceinline__ unsigned xb_xcc_id() { return (unsigned)__builtin_amdgcn_s_getreg((3 << 11) | 20) & 0xFu; }
#define XB_SPIN(cond, bar) do { unsigned _sp = 0; while (cond) { __builtin_amdgcn_s_sleep(1); \
    if ((++_sp & 255u) == 0u) { if (xb_ld(&(bar)[XB_TMO])) break; if (_sp > XB_SPIN_CAP) { atomicAdd(&(bar)[XB_TMO], 1u); break; } } } } while (0)

struct XcdBarrier {
    unsigned* bar; unsigned x;
    volatile LAS unsigned* st;
};

__device__ __forceinline__ XcdBarrier xcd_barrier_post(unsigned* bar, volatile LAS unsigned* st) {
    XcdBarrier b; b.bar = bar; b.x = xb_xcc_id(); b.st = st;
    if (threadIdx.x == 0) (void)xb_add(&bar[XB_XCNT(b.x)], 1u);
    return b;
}
__device__ __forceinline__ void xcd_barrier_complete(unsigned* bar, unsigned x, unsigned& nloc, unsigned& nx) {
    const unsigned G = gridDim.x * gridDim.y * gridDim.z;
    unsigned sum, cnt, mine, sp = 0u;
    for (;;) {
        sum = 0u; cnt = 0u; mine = 0u;
#pragma unroll
        for (unsigned j = 0; j < 16; ++j) { const unsigned c = xb_ld(&bar[XB_XCNT(j)]); sum += c; cnt += (c > 0u) ? 1u : 0u; mine = (j == x) ? c : mine; }
        if (sum == G) break;
        __builtin_amdgcn_s_sleep(1);
        if ((++sp & 255u) == 0u) { if (xb_ld(&bar[XB_TMO])) break; if (sp > XB_SPIN_CAP) { atomicAdd(&bar[XB_TMO], 1u); break; } }
    }
    nloc = mine > 0u ? mine : 1u; nx = cnt > 0u ? cnt : 1u;
}

__device__ __forceinline__ void xcd_barrier(const XcdBarrier& b) {
    asm volatile("s_waitcnt vmcnt(0)" ::: "memory");
    __syncthreads();
    if (threadIdx.x == 0) {
        unsigned* bar = b.bar;
        __builtin_amdgcn_s_waitcnt(0);
        unsigned nloc = b.st[0], nx = b.st[1];
        if (nloc == 0u) { xcd_barrier_complete(bar, b.x, nloc, nx); b.st[0] = nloc; b.st[1] = nx; }
        const unsigned old = xb_add(&bar[XB_XSUB(b.x)], 1u);
        const unsigned gen = old / nloc;
        if (old + 1u == (gen + 1u) * nloc) {
            __builtin_amdgcn_fence(__ATOMIC_RELEASE, "agent");
            asm volatile("s_waitcnt vmcnt(0)" ::: "memory");
            const unsigned og = xb_add(&bar[XB_TOP], 1u);
            const unsigned tg = og / nx;
            if (og + 1u == (tg + 1u) * nx) xb_add(&bar[XB_TOPGEN], 1u);
            else XB_SPIN(xb_ld(&bar[XB_TOPGEN]) == tg, bar);
            __builtin_amdgcn_fence(__ATOMIC_ACQUIRE, "agent");
            xb_add(&bar[XB_XGEN(b.x)], 1u);
            asm volatile("s_waitcnt vmcnt(0)" ::: "memory");
        } else {
            XB_SPIN(xb_ld(&bar[XB_XGEN(b.x)]) == gen, bar);
            __builtin_amdgcn_fence(__ATOMIC_ACQUIRE, "agent");
            asm volatile("s_waitcnt vmcnt(0)" ::: "memory");
        }
    }
    __syncthreads();
}

struct Args { const void* in[31]; float* out; unsigned char* ws; int ph_lo, ph_hi; };

struct Frame {
    LAS unsigned char* lds;
    int tid, lane, wave, gw, NGW, G, vcu;
    const Args* a;
    unsigned char* ws;
};
#define INF(i) ((const float*)F.a->in[i])
#define WSP(T_, off) ((T_*)(F.ws + (off)))

__device__ __forceinline__ void conv_w(const Frame& F, const float* src, int ldn, int K, int ncols, int nbatch, size_t sbs, bf16* dst, int rmul, int roff, size_t dbs, const float* kscale) {
    LAS float* scr = (LAS float*)(F.lds + F.wave * 16384);
    const int lane = F.lane, nblk = ncols / 32, kblk = K / 64, per = nblk * kblk, total = per * nbatch;
    for (int it = F.gw; it < total; it += F.NGW) {
        const int bt = it / per, r = it % per, kb = r / nblk, nb = r % nblk, k0 = kb * 64, n0 = nb * 32;
        const float* W = src + (size_t)bt * sbs; bf16* WT = dst + (size_t)bt * dbs;
#pragma unroll 8
        for (int i = 0; i < 32; ++i) { const int kk = 2 * i + (lane >> 5); scr[kk * 33 + (lane & 31)] = W[(size_t)(k0 + kk) * ldn + n0 + (lane & 31)]; }
        LDS_WAIT(); asm volatile("" ::: "memory");
        const int c = lane & 7;
        float ks[8];
#pragma unroll
        for (int i = 0; i < 8; ++i) ks[i] = kscale ? kscale[k0 + 8 * c + i] : 1.0f;
#pragma unroll
        for (int j = 0; j < 4; ++j) { const int n = (lane >> 3) + 8 * j; const LAS float* s = scr + (8 * c) * 33 + n;
            v4u o; o.x = pk2(s[0 * 33] * ks[0], s[1 * 33] * ks[1]); o.y = pk2(s[2 * 33] * ks[2], s[3 * 33] * ks[3]); o.z = pk2(s[4 * 33] * ks[4], s[5 * 33] * ks[5]); o.w = pk2(s[6 * 33] * ks[6], s[7 * 33] * ks[7]);
            *(v4u*)(WT + (size_t)(rmul * (n0 + n) + roff) * K + k0 + 8 * c) = o; }
        LDS_WAIT(); asm volatile("" ::: "memory");
    }
}
__device__ __forceinline__ void phase_convert(const Frame& F, int L) {
    const int j = L >> 1;
    const float* win = INF(4) + (size_t)L * D * IN_COLS;
    conv_w(F, win, IN_COLS, D, 3072, 1, 0, WSP(bf16, W_IN), 1, 0, 0, nullptr);
    conv_w(F, win + 3744, IN_COLS, D, 2048, 1, 0, WSP(bf16, W_IN), 1, 3072, 0, nullptr);
    conv_w(F, win + 3072, IN_COLS, D, 672, 1, 0, WSP(bf16, W_IN), 1, 5120, 0, nullptr);
    { bf16* padr = WSP(bf16, W_IN) + (size_t)IN_COLS * D;
      for (int i = F.gw * 64 + F.lane; i < (NIN - IN_COLS) * D / 8; i += F.NGW * 64) ((v4u*)padr)[i] = (v4u){0u, 0u, 0u, 0u}; }
    conv_w(F, INF(12) + (size_t)L * QR * 768, 768, QR, 768, 1, 0, WSP(bf16, W_UQ), 1, 0, 0, INF(11) + L * QR);
    conv_w(F, INF(14) + (size_t)L * KVR * 1024, 1024, KVR, 1024, 1, 0, WSP(bf16, W_UKV), 1, 0, 0, INF(13) + L * KVR);
    conv_w(F, INF(15) + (size_t)L * D * D, D, D, D, 1, 0, WSP(bf16, W_BD), 1, 0, 0, nullptr);
    conv_w(F, INF(16) + (size_t)L * 512 * D, D, 512, D, 1, 0, WSP(bf16, W_BM), 1, 0, 0, nullptr);
    conv_w(F, INF(17) + (size_t)L * D * D, D, D, D, 1, 0, WSP(bf16, W_OUT), 1, 0, 0, nullptr);
    conv_w(F, INF(27) + (size_t)L * D * D, D, D, D, 1, 0, WSP(bf16, W_PG), 1, 0, 0, nullptr);
    conv_w(F, INF(28) + (size_t)L * PLE * D, D, PLE, D, 1, 0, WSP(bf16, W_PP), 1, 0, 0, nullptr);
    if ((L & 1) == 0) {
        conv_w(F, INF(20) + (size_t)j * D * DENSE_FF, DENSE_FF, D, DENSE_FF, 1, 0, WSP(bf16, W_F13), 2, 0, 0, nullptr);
        conv_w(F, INF(21) + (size_t)j * D * DENSE_FF, DENSE_FF, D, DENSE_FF, 1, 0, WSP(bf16, W_F13), 2, 1, 0, nullptr);
        conv_w(F, INF(22) + (size_t)j * DENSE_FF * D, D, DENSE_FF, D, 1, 0, WSP(bf16, W_F2D), 1, 0, 0, nullptr);
    } else {
        const size_t eo = (size_t)j * NEXP * D * EXPERT_FF;
        conv_w(F, INF(24) + eo, EXPERT_FF, D, EXPERT_FF, NEXP, (size_t)D * EXPERT_FF, WSP(bf16, W_F13), 2, 0, (size_t)2 * EXPERT_FF * D, nullptr);
        conv_w(F, INF(25) + eo, EXPERT_FF, D, EXPERT_FF, NEXP, (size_t)D * EXPERT_FF, WSP(bf16, W_F13), 2, 1, (size_t)2 * EXPERT_FF * D, nullptr);
        conv_w(F, INF(26) + eo, D, EXPERT_FF, D, NEXP, (size_t)EXPERT_FF * D, WSP(bf16, W_F2E), 1, 0, (size_t)D * EXPERT_FF, nullptr);
    }
    { const f32x4* ps = (const f32x4*)(INF(1) + (size_t)L * T * PLE); v2u* pd = WSP(v2u, WS_PB);
      for (int i = F.gw * 64 + F.lane; i < T * PLE / 4; i += F.NGW * 64) { const f32x4 v = ps[i]; v2u o; o.x = pk2(v[0], v[1]); o.y = pk2(v[2], v[3]); pd[i] = o; } }
}

__device__ __forceinline__ void phase_prologue(const Frame& F) {
    const int* pos = (const int*)F.a->in[2];
    for (int m = F.gw; m < T; m += F.NGW) {
        const f32x4* xr = (const f32x4*)(INF(0) + (size_t)m * D) + F.lane; f32x4* orow = (f32x4*)(F.a->out + (size_t)m * D) + F.lane; v2u* br = WSP(v2u, WS_XB) + (size_t)m * (D / 4) + F.lane;
#pragma unroll
        for (int j = 0; j < 4; ++j) { const f32x4 v = xr[64 * j]; orow[64 * j] = v; v2u o; o.x = pk2(v[0], v[1]); o.y = pk2(v[2], v[3]); br[64 * j] = o; }
    }
    { float* rope = WSP(float, WS_ROPE);
      for (int idx = F.gw * 64 + F.lane; idx < T * 16; idx += F.NGW * 64) {
          const int t = idx >> 4, j = idx & 15;
          double inv = 1.0; for (int i = 0; i < j; ++i) inv *= 0.5623413251903491;
          const double ang = (double)pos[t] * inv;
          const double nq = __builtin_rint(ang * 0.6366197723675814);
          double y = __builtin_fma(-nq, 1.5707963267948966, ang); y = __builtin_fma(-nq, 6.123233995736766e-17, y);
          const double y2 = y * y;
          double sp = 1.0 / 6227020800.0; sp = sp * y2 - 1.0 / 39916800.0; sp = sp * y2 + 1.0 / 362880.0; sp = sp * y2 - 1.0 / 5040.0; sp = sp * y2 + 1.0 / 120.0; sp = sp * y2 - 1.0 / 6.0;
          const double sn = y + y * y2 * sp;
          double cp = -1.0 / 87178291200.0; cp = cp * y2 + 1.0 / 479001600.0; cp = cp * y2 - 1.0 / 3628800.0; cp = cp * y2 + 1.0 / 40320.0; cp = cp * y2 - 1.0 / 720.0; cp = cp * y2 + 1.0 / 24.0; cp = cp * y2 - 0.5;
          const double cs = 1.0 + y2 * cp;
          const int q = ((int)nq) & 3;
          const double c = (q == 0) ? cs : (q == 1) ? -sn : (q == 2) ? -cs : sn;
          const double s = (q == 0) ? sn : (q == 1) ? cs : (q == 2) ? -sn : -cs;
          rope[2 * idx] = (float)c; rope[2 * idx + 1] = (float)s;
      } }
    { int* bm = WSP(int, WS_MISC);
      for (int blk = F.gw; blk < T / 64; blk += F.NGW) { int v = pos[blk * 64 + F.lane];
#pragma unroll
          for (int o = 1; o < 64; o <<= 1) { const int t2 = __shfl_xor(v, o); v = t2 > v ? t2 : v; }
          if (F.lane == 0) bm[blk] = v; } }
    { float* lut = WSP(float, WS_MISC + 4096); const float* tab = INF(3);
      for (int idx = F.gw * 64 + F.lane; idx < 8 * 132; idx += F.NGW * 64) { const int hh = idx / 132, n = idx % 132;
          int bk = n;
          if (n >= 16) bk = 16 + (n >= 19) + (n >= 21) + (n >= 24) + (n >= 27) + (n >= 31) + (n >= 35) + (n >= 40) + (n >= 46) + (n >= 52) + (n >= 59) + (n >= 67) + (n >= 77) + (n >= 87) + (n >= 99) + (n >= 113);
          lut[idx] = tab[bk * 8 + hh] * LOG2E; } }
    phase_convert(F, 0);
}

__device__ __forceinline__ void phase_rms_rope(const Frame& F) {
    const float* CQ = WSP(float, A_CQ); const float* rope = WSP(float, WS_ROPE);
    bf16* CQN = WSP(bf16, A_CQN); bf16* CKVN = WSP(bf16, A_CKVN); bf16* MKR = WSP(bf16, A_MKR);
    const int l = F.lane;
    for (int m = F.gw; m < T; m += F.NGW) {
        const float* c = CQ + (size_t)m * 768;
        const f32x2 a0 = *(const f32x2*)(c + 6 * l), a1 = *(const f32x2*)(c + 6 * l + 2), a2 = *(const f32x2*)(c + 6 * l + 4);
        const f32x4 kv = *(const f32x4*)(c + QR + 4 * l);
        float x1 = 0.f, x2 = 0.f, rc = 0.f, rs = 0.f;
        if (l < 16) { x1 = c[QR + KVR + l]; x2 = c[QR + KVR + 16 + l]; rc = rope[(size_t)m * 32 + 2 * l]; rs = rope[(size_t)m * 32 + 2 * l + 1]; }
        const float sq = wave_sum(a0[0] * a0[0] + a0[1] * a0[1] + a1[0] * a1[0] + a1[1] * a1[1] + a2[0] * a2[0] + a2[1] * a2[1]);
        const float sk = wave_sum(kv[0] * kv[0] + kv[1] * kv[1] + kv[2] * kv[2] + kv[3] * kv[3]);
        const float rq = 1.0f / sqrtf(sq * (1.0f / QR) + LN_EPS), rk = 1.0f / sqrtf(sk * (1.0f / KVR) + LN_EPS);
        unsigned* qo = (unsigned*)(CQN + (size_t)m * QR + 6 * l);
        qo[0] = pk2(a0[0] * rq, a0[1] * rq); qo[1] = pk2(a1[0] * rq, a1[1] * rq); qo[2] = pk2(a2[0] * rq, a2[1] * rq);
        v2u ko; ko.x = pk2(kv[0] * rk, kv[1] * rk); ko.y = pk2(kv[2] * rk, kv[3] * rk);
        *(v2u*)(CKVN + (size_t)m * KVR + 4 * l) = ko;
        if (l < 16) { const float o1 = x1 * rc - x2 * rs, o2 = x1 * rs + x2 * rc; const unsigned w = pk2(o1, o2);
            MKR[(size_t)m * 32 + l] = (bf16)(w & 0xffffu); MKR[(size_t)m * 32 + 16 + l] = (bf16)(w >> 16); }
    }
}

__device__ __forceinline__ void phase_combine(const Frame& F, int L) {
    const float lam_init = 0.8f - 0.6f * expf(-0.3f * (float)L);
    const int l = F.lane;
    const float d1 = wave_sum(INF(6)[L * 64 + l] * INF(7)[L * 64 + l]), d2 = wave_sum(INF(8)[L * 64 + l] * INF(9)[L * 64 + l]);
    const float lam = expf(d1) - expf(d2) + lam_init;
    const bf16* OA2 = WSP(bf16, A_OA2); bf16* OA = WSP(bf16, A_OA);
    const int hh = l >> 3, d0 = (l & 7) * 16;
    float gsc[16];
#pragma unroll
    for (int i = 0; i < 16; ++i) gsc[i] = INF(10)[L * 128 + d0 + i] * (1.0f - lam_init);
    for (int m = F.gw; m < T; m += F.NGW) {
        const bf16* p0 = OA2 + (size_t)m * 2048 + (hh * 2) * 128 + d0;
        const v4u a0 = *(const v4u*)p0, a1 = *(const v4u*)(p0 + 8), b0 = *(const v4u*)(p0 + 128), b1 = *(const v4u*)(p0 + 136);
        float o[16];
        o[0] = bflo(a0.x) - lam * bflo(b0.x); o[1] = bfhi(a0.x) - lam * bfhi(b0.x); o[2] = bflo(a0.y) - lam * bflo(b0.y); o[3] = bfhi(a0.y) - lam * bfhi(b0.y);
        o[4] = bflo(a0.z) - lam * bflo(b0.z); o[5] = bfhi(a0.z) - lam * bfhi(b0.z); o[6] = bflo(a0.w) - lam * bflo(b0.w); o[7] = bfhi(a0.w) - lam * bfhi(b0.w);
        o[8] = bflo(a1.x) - lam * bflo(b1.x); o[9] = bfhi(a1.x) - lam * bfhi(b1.x); o[10] = bflo(a1.y) - lam * bflo(b1.y); o[11] = bfhi(a1.y) - lam * bfhi(b1.y);
        o[12] = bflo(a1.z) - lam * bflo(b1.z); o[13] = bfhi(a1.z) - lam * bfhi(b1.z); o[14] = bflo(a1.w) - lam * bflo(b1.w); o[15] = bfhi(a1.w) - lam * bfhi(b1.w);
        float ss = 0.f;
#pragma unroll
        for (int i = 0; i < 16; ++i) ss += o[i] * o[i];
        ss += __shfl_xor(ss, 1); ss += __shfl_xor(ss, 2); ss += __shfl_xor(ss, 4);
        const float rr = 1.0f / sqrtf(ss * (1.0f / 128.0f) + LN_EPS);
        v4u w0, w1;
        w0.x = pk2(o[0] * rr * gsc[0], o[1] * rr * gsc[1]); w0.y = pk2(o[2] * rr * gsc[2], o[3] * rr * gsc[3]); w0.z = pk2(o[4] * rr * gsc[4], o[5] * rr * gsc[5]); w0.w = pk2(o[6] * rr * gsc[6], o[7] * rr * gsc[7]);
        w1.x = pk2(o[8] * rr * gsc[8], o[9] * rr * gsc[9]); w1.y = pk2(o[10] * rr * gsc[10], o[11] * rr * gsc[11]); w1.z = pk2(o[12] * rr * gsc[12], o[13] * rr * gsc[13]); w1.w = pk2(o[14] * rr * gsc[14], o[15] * rr * gsc[15]);
        bf16* po = OA + (size_t)m * 1024 + hh * 128 + d0;
        *(v4u*)po = w0; *(v4u*)(po + 8) = w1;
    }
}

template <bool ROUTE, bool GATHER>
__device__ __forceinline__ void phase_ln(const Frame& F, const float* gam, const float* bet, const float* wr, int moe_j) {
    const float* PRE = WSP(float, A_PRE); const int l = F.lane;
    const bf16* YG = WSP(bf16, A_YG); int* TOKE = WSP(int, A_TOK); float* TOKG = WSP(float, A_TOK + 1 * MiB); const int* TOKR = WSP(int, A_TOK + 2 * MiB);
    unsigned* cnt = WSP(unsigned, WS_CTL) + CW_MOE + 64 * moe_j;
    f32x4 gv[4], bv[4];
#pragma unroll
    for (int j = 0; j < 4; ++j) { gv[j] = *(const f32x4*)(gam + 4 * l + 256 * j); bv[j] = *(const f32x4*)(bet + 4 * l + 256 * j); }
    for (int m = F.gw; m < T; m += F.NGW) {
        const f32x4* xr = (const f32x4*)(PRE + (size_t)m * D) + l;
        f32x4 v[4]; float s = 0.f;
#pragma unroll
        for (int j = 0; j < 4; ++j) v[j] = xr[64 * j];
        if (GATHER) { const int r0 = TOKR[2 * m], r1 = TOKR[2 * m + 1]; const float g0 = TOKG[2 * m], g1 = TOKG[2 * m + 1];
            const v2u* y0 = (const v2u*)(YG + (size_t)r0 * D) + l; const v2u* y1 = (const v2u*)(YG + (size_t)r1 * D) + l;
#pragma unroll
            for (int j = 0; j < 4; ++j) { const v2u a = y0[64 * j], b = y1[64 * j];
                v[j][0] += g0 * bflo(a.x) + g1 * bflo(b.x); v[j][1] += g0 * bfhi(a.x) + g1 * bfhi(b.x); v[j][2] += g0 * bflo(a.y) + g1 * bflo(b.y); v[j][3] += g0 * bfhi(a.y) + g1 * bfhi(b.y); } }
#pragma unroll
        for (int j = 0; j < 4; ++j) s += (v[j][0] + v[j][1]) + (v[j][2] + v[j][3]);
        const float mean = wave_sum(s) * (1.f / D); float s2 = 0.f;
#pragma unroll
        for (int j = 0; j < 4; ++j) { v[j] = v[j] - mean; s2 += (v[j][0] * v[j][0] + v[j][1] * v[j][1]) + (v[j][2] * v[j][2] + v[j][3] * v[j][3]); }
        const float rstd = 1.f / sqrtf(wave_sum(s2) * (1.f / D) + LN_EPS);
        f32x4* orow = (f32x4*)(F.a->out + (size_t)m * D) + l; v2u* br = WSP(v2u, WS_XB) + (size_t)m * (D / 4) + l;
#pragma unroll
        for (int j = 0; j < 4; ++j) { v[j] = v[j] * rstd * gv[j] + bv[j]; orow[64 * j] = v[j]; v2u o; o.x = pk2(v[j][0], v[j][1]); o.y = pk2(v[j][2], v[j][3]); br[64 * j] = o; }
        if (ROUTE) {
            float lg[8];
#pragma unroll
            for (int e = 0; e < 8; ++e) lg[e] = 0.f;
#pragma unroll
            for (int j = 0; j < 4; ++j)
#pragma unroll
                for (int c = 0; c < 4; ++c) { const float* w = wr + (size_t)(4 * l + 256 * j + c) * 8; const f32x4 w0 = *(const f32x4*)w, w1 = *(const f32x4*)(w + 4); const float xv = v[j][c];
                    lg[0] += xv * w0[0]; lg[1] += xv * w0[1]; lg[2] += xv * w0[2]; lg[3] += xv * w0[3]; lg[4] += xv * w1[0]; lg[5] += xv * w1[1]; lg[6] += xv * w1[2]; lg[7] += xv * w1[3]; }
#pragma unroll
            for (int e = 0; e < 8; ++e) lg[e] = wave_sum(lg[e]);
            int e0 = 0; float v0 = lg[0];
#pragma unroll
            for (int e = 1; e < 8; ++e) if (lg[e] > v0) { v0 = lg[e]; e0 = e; }
            int e1 = -1; float v1 = -INFINITY;
#pragma unroll
            for (int e = 0; e < 8; ++e) if (e != e0 && lg[e] > v1) { v1 = lg[e]; e1 = e; }
            const float g1 = 1.0f / (1.0f + expf(v0 - v1)), g0 = 1.0f - g1;
            if (l == 0) { TOKE[2 * m] = e0; TOKE[2 * m + 1] = e1; TOKG[2 * m] = g0; TOKG[2 * m + 1] = g1;
                __hip_atomic_fetch_add(cnt + e0, 1u, RLX_AGENT); __hip_atomic_fetch_add(cnt + e1, 1u, RLX_AGENT); }
        }
    }
}

struct MoeTiles { int pend[8]; int total; };
__device__ __forceinline__ void moe_tiles(const Frame& F, int moe_j, MoeTiles& mt) {
    const unsigned* cnt = WSP(unsigned, WS_CTL) + CW_MOE + 64 * moe_j; int acc = 0;
#pragma unroll
    for (int e = 0; e < 8; ++e) { const unsigned c = __hip_atomic_load(cnt + e, RLX_AGENT); acc += (int)((c + 255u) >> 8); mt.pend[e] = acc; }
    mt.total = acc;
}
__device__ __forceinline__ void phase_scatter(const Frame& F, int moe_j) {
    MoeTiles mt; moe_tiles(F, moe_j, mt);
    unsigned* cur = WSP(unsigned, WS_CTL) + CW_MOE + 128 + 64 * moe_j;
    const int* TOKE = WSP(int, A_TOK); int* TOKR = WSP(int, A_TOK + 2 * MiB);
    const v4u* XB = WSP(v4u, WS_XB); v4u* XG = WSP(v4u, A_XG); const int l = F.lane;
    for (int m = F.gw; m < T; m += F.NGW) {
        int rows[2];
#pragma unroll
        for (int k = 0; k < 2; ++k) { const int e = TOKE[2 * m + k]; int slot = 0;
            if (l == 0) slot = (int)__hip_atomic_fetch_add(cur + e, 1u, RLX_AGENT);
            slot = __shfl(slot, 0);
            int st = 0;
#pragma unroll
            for (int q = 0; q < 7; ++q) st = (e > q) ? mt.pend[q] : st;
            rows[k] = st * 256 + slot; }
        const v4u a = XB[(size_t)m * 128 + l], b = XB[(size_t)m * 128 + 64 + l];
        XG[(size_t)rows[0] * 128 + l] = a; XG[(size_t)rows[0] * 128 + 64 + l] = b; XG[(size_t)rows[1] * 128 + l] = a; XG[(size_t)rows[1] * 128 + 64 + l] = b;
        if (l == 0) { TOKR[2 * m] = rows[0]; TOKR[2 * m + 1] = rows[1]; }
    }
}

__device__ __forceinline__ void phase_attn_diff(const Frame& F) {
    att::AttnP P; P.Q = WSP(bf16, A_DQ); P.ldq = 1024; P.K1 = WSP(bf16, A_DK); P.ldk1 = 1024; P.K2 = P.K1; P.ldk2 = 1024; P.V = WSP(bf16, A_DV); P.ldv = 1024; P.O = WSP(bf16, A_OA2); P.ldo = 2048;
    P.pos = (const int*)F.a->in[2]; P.blkmax = WSP(int, WS_MISC); P.lut = WSP(float, WS_MISC + 4096);
    for (int p = F.vcu; p < BATCH * 16 * 8; p += F.G) {
        const int bh = p >> 3, i = p & 7, b = bh >> 4, vh = bh & 15;
        att::attn_unit<64, 64, 128, true>(P, b, 15 - i, vh * 64, vh * 64, (vh >> 1) * 128, vh * 128, vh >> 1, F.lds);
        att::attn_unit<64, 64, 128, true>(P, b, i, vh * 64, vh * 64, (vh >> 1) * 128, vh * 128, vh >> 1, F.lds);
    }
}
__device__ __forceinline__ void phase_attn_mla(const Frame& F) {
    att::AttnP P; P.Q = WSP(bf16, A_MQ); P.ldq = 768; P.K1 = WSP(bf16, A_MKV); P.ldk1 = 1024; P.K2 = WSP(bf16, A_MKR); P.ldk2 = 32; P.V = WSP(bf16, A_MKV); P.ldv = 1024; P.O = WSP(bf16, A_OB); P.ldo = 512;
    P.pos = (const int*)F.a->in[2]; P.blkmax = WSP(int, WS_MISC); P.lut = WSP(float, WS_MISC + 4096);
    for (int p = F.vcu; p < BATCH * 8 * 8; p += F.G) {
        const int bh = p >> 3, i = p & 7, b = bh >> 3, hh = bh & 7;
        att::attn_unit<96, 64, 64, false>(P, b, 15 - i, hh * 96, hh * 128, hh * 128 + 64, hh * 64, 0, F.lds);
        att::attn_unit<96, 64, 64, false>(P, b, i, hh * 96, hh * 128, hh * 128 + 64, hh * 64, 0, F.lds);
    }
}

constexpr int NPH_DENSE = 10, NPH_MOE = 9 + 2 * MOE_NCHUNK, NPH_TOTAL = 1 + 2 * NPH_DENSE + 2 * NPH_MOE;
#define GEMM_CALL(EPI, SCHED, gm, S_, E_) pg8::gemm_phase<EPI, SCHED, true, true>(F.lds, gm, S_, E_)

__global__ void __launch_bounds__(NWAVES * 64, 2) mega_fwd(Args args) {
    extern __shared__ __attribute__((aligned(16))) unsigned char lds_raw[];
    Frame F;
    F.lds = (LAS unsigned char*)lds_raw; F.a = &args; F.ws = args.ws;
    F.tid = threadIdx.x; F.lane = F.tid & 63; F.wave = __builtin_amdgcn_readfirstlane(F.tid >> 6);
    F.G = gridDim.x; { const int bx = blockIdx.x; F.vcu = (F.G % 8 == 0) ? (bx % 8) * (F.G / 8) + bx / 8 : bx; }
    F.gw = F.vcu * NWAVES + F.wave; F.NGW = F.G * NWAVES;
    volatile LAS unsigned* MISC = (volatile LAS unsigned*)(F.lds + MISC_OFF);
    for (int u = F.tid; u < (LDS_BYTES - RING_BYTES) / 4; u += NWAVES * 64) ((LAS unsigned*)(F.lds + RING_BYTES))[u] = 0u;
    __syncthreads();
    const int lo = args.ph_lo, hi = args.ph_hi;
    XcdBarrier bar; bar.bar = WSP(unsigned, WS_CTL) + CW_BAR; bar.x = 0; bar.st = nullptr;
    if (hi - lo > 1) bar = xcd_barrier_post(WSP(unsigned, WS_CTL) + CW_BAR, MISC + 8);
    int pc = 0;
#define PH_BEGIN if (pc >= lo && pc < hi) { { int t_ = threadIdx.x; asm volatile("" : "+v"(t_)); F.tid = t_; F.lane = t_ & 63; F.wave = __builtin_amdgcn_readfirstlane(t_ >> 6); F.gw = F.vcu * NWAVES + F.wave; }
#define PH_END if (pc + 1 < hi) xcd_barrier(bar); } ++pc;
    const int bx = (int)blockIdx.x;
    const float ALPHA = 1.6817928305074290f;

    PH_BEGIN phase_prologue(F); PH_END

    for (int L = 0; L < DEPTH; ++L) {
        const int mj = L >> 1;
        PH_BEGIN {
            pg8::Gemm g{WSP(bf16, WS_XB), WSP(bf16, W_IN), T, NIN, D}; pg8::StaticOrder S; S.init(T, NIN, F.G, bx);
            pg8::EpiL1 E{WSP(bf16, A_DQ), WSP(bf16, A_G), WSP(float, A_CQ), INF(5) + L * 2048, 0.125f * LOG2E};
            GEMM_CALL(pg8::EpiL1, pg8::StaticOrder, g, S, E);
        } PH_END
        PH_BEGIN phase_rms_rope(F); PH_END
        PH_BEGIN {
            { pg8::Gemm g{WSP(bf16, A_CQN), WSP(bf16, W_UQ), T, 768, QR}; pg8::StaticOrder S; S.init(T, 768, F.G, bx);
              pg8::EpiRopeQ E{WSP(bf16, A_MQ), WSP(float, WS_ROPE), 0.10206207261596577f * LOG2E};
              GEMM_CALL(pg8::EpiRopeQ, pg8::StaticOrder, g, S, E); }
            { pg8::Gemm g{WSP(bf16, A_CKVN), WSP(bf16, W_UKV), T, 1024, KVR}; pg8::StaticOrder S; S.init(T, 1024, F.G, bx);
              pg8::EpiBf16 E{WSP(bf16, A_MKV), 1024};
              GEMM_CALL(pg8::EpiBf16, pg8::StaticOrder, g, S, E); }
            phase_attn_diff(F);
        } PH_END
        PH_BEGIN { phase_attn_mla(F); phase_combine(F, L); } PH_END
        PH_BEGIN {
            { pg8::Gemm g{WSP(bf16, A_OB), WSP(bf16, W_BM), T, D, 512}; pg8::StaticOrder S; S.init(T, D, F.G, bx);
              pg8::EpiGate<false> E{WSP(bf16, A_MT), WSP(bf16, A_G), nullptr, 1024};
              GEMM_CALL(pg8::EpiGate<false>, pg8::StaticOrder, g, S, E); }
            { pg8::Gemm g{WSP(bf16, A_OA), WSP(bf16, W_BD), T, D, D}; pg8::StaticOrder S; S.init(T, D, F.G, bx);
              pg8::EpiGate<true> E{WSP(bf16, A_M), WSP(bf16, A_G), WSP(bf16, A_MT), 0};
              GEMM_CALL(pg8::EpiGate<true>, pg8::StaticOrder, g, S, E); }
        } PH_END
        PH_BEGIN {
            pg8::Gemm g{WSP(bf16, A_M), WSP(bf16, W_OUT), T, D, D}; pg8::StaticOrder S; S.init(T, D, F.G, bx);
            pg8::EpiF32<1> E{WSP(float, A_PRE), args.out, ALPHA};
            GEMM_CALL(pg8::EpiF32<1>, pg8::StaticOrder, g, S, E);
        } PH_END
        PH_BEGIN {
            if (L & 1) phase_ln<true, false>(F, INF(18) + L * D, INF(19) + L * D, INF(23) + (size_t)mj * D * NEXP, mj);
            else phase_ln<false, false>(F, INF(18) + L * D, INF(19) + L * D, nullptr, 0);
        } PH_END
        if ((L & 1) == 0) {
            PH_BEGIN {
                { pg8::Gemm g{WSP(bf16, WS_XB), WSP(bf16, W_F13), T, 2 * DENSE_FF, D}; pg8::StaticOrder S; S.init(T, 2 * DENSE_FF, F.G, bx);
                  pg8::EpiSwiGLU E{WSP(bf16, A_H), DENSE_FF};
                  GEMM_CALL(pg8::EpiSwiGLU, pg8::StaticOrder, g, S, E); }
                { pg8::Gemm g{WSP(bf16, WS_PB), WSP(bf16, W_PP), T, D, PLE}; pg8::StaticOrder S; S.init(T, D, F.G, bx);
                  pg8::EpiF32<0> E{WSP(float, A_PRE), nullptr, 0.f};
                  GEMM_CALL(pg8::EpiF32<0>, pg8::StaticOrder, g, S, E); }
                { pg8::Gemm g{WSP(bf16, WS_XB), WSP(bf16, W_PG), T, D, D}; pg8::StaticOrder S; S.init(T, D, F.G, bx);
                  pg8::EpiF32<2> E{WSP(float, A_PRE), args.out, ALPHA};
                  GEMM_CALL(pg8::EpiF32<2>, pg8::StaticOrder, g, S, E); }
            } PH_END
            PH_BEGIN {
                pg8::Gemm g{WSP(bf16, A_H), WSP(bf16, W_F2D), T, D, DENSE_FF}; pg8::StaticOrder S; S.init(T, D, F.G, bx);
                pg8::EpiF32<3> E{WSP(float, A_PRE), nullptr, 0.f};
                GEMM_CALL(pg8::EpiF32<3>, pg8::StaticOrder, g, S, E);
            } PH_END
            PH_BEGIN { phase_ln<false, false>(F, INF(29) + L * D, INF(30) + L * D, nullptr, 0); if (L + 1 < DEPTH) phase_convert(F, L + 1); } PH_END
        } else {
            PH_BEGIN {
                phase_scatter(F, mj);
                { pg8::Gemm g{WSP(bf16, WS_PB), WSP(bf16, W_PP), T, D, PLE}; pg8::StaticOrder S; S.init(T, D, F.G, bx);
                  pg8::EpiF32<0> E{WSP(float, A_PRE), nullptr, 0.f};
                  GEMM_CALL(pg8::EpiF32<0>, pg8::StaticOrder, g, S, E); }
                { pg8::Gemm g{WSP(bf16, WS_XB), WSP(bf16, W_PG), T, D, D}; pg8::StaticOrder S; S.init(T, D, F.G, bx);
                  pg8::EpiF32<2> E{WSP(float, A_PRE), args.out, ALPHA};
                  GEMM_CALL(pg8::EpiF32<2>, pg8::StaticOrder, g, S, E); }
            } PH_END
            for (int ch = 0; ch < MOE_NCHUNK; ++ch) {
                PH_BEGIN {
                    MoeTiles mt; moe_tiles(F, mj, mt);
                    const int tlo = ch * MOE_CHUNK_TILES; int ntc = mt.total - tlo; ntc = ntc > MOE_CHUNK_TILES ? MOE_CHUNK_TILES : ntc;
                    if (ntc > 0) {
                        pg8::Gemm g{WSP(bf16, A_XG) + (size_t)tlo * 256 * D, WSP(bf16, W_F13), ntc * 256, 2 * EXPERT_FF, D};
                        pg8::GroupedOrder S; S.init(ntc * 256, 2 * EXPERT_FF, F.G, bx); S.tile_lo = tlo; S.estride = (size_t)2 * EXPERT_FF * D * 2;
                        S.pend0 = mt.pend[0]; S.pend1 = mt.pend[1]; S.pend2 = mt.pend[2]; S.pend3 = mt.pend[3]; S.pend4 = mt.pend[4]; S.pend5 = mt.pend[5]; S.pend6 = mt.pend[6]; S.pend7 = mt.pend[7];
                        pg8::EpiSwiGLU E{WSP(bf16, A_HG), EXPERT_FF};
                        GEMM_CALL(pg8::EpiSwiGLU, pg8::GroupedOrder, g, S, E);
                    }
                } PH_END
                PH_BEGIN {
                    MoeTiles mt; moe_tiles(F, mj, mt);
                    const int tlo = ch * MOE_CHUNK_TILES; int ntc = mt.total - tlo; ntc = ntc > MOE_CHUNK_TILES ? MOE_CHUNK_TILES : ntc;
                    if (ntc > 0) {
                        pg8::Gemm g{WSP(bf16, A_HG), WSP(bf16, W_F2E), ntc * 256, D, EXPERT_FF};
                        pg8::GroupedOrder S; S.init(ntc * 256, D, F.G, bx); S.tile_lo = tlo; S.estride = (size_t)D * EXPERT_FF * 2;
                        S.pend0 = mt.pend[0]; S.pend1 = mt.pend[1]; S.pend2 = mt.pend[2]; S.pend3 = mt.pend[3]; S.pend4 = mt.pend[4]; S.pend5 = mt.pend[5]; S.pend6 = mt.pend[6]; S.pend7 = mt.pend[7];
                        pg8::EpiBf16 E{WSP(bf16, A_YG) + (size_t)tlo * 256 * D, D};
                        GEMM_CALL(pg8::EpiBf16, pg8::GroupedOrder, g, S, E);
                    }
                } PH_END
            }
            PH_BEGIN { phase_ln<false, true>(F, INF(29) + L * D, INF(30) + L * D, nullptr, 0); if (L + 1 < DEPTH) phase_convert(F, L + 1); } PH_END
        }
    }
#undef PH_BEGIN
#undef PH_END
}

extern "C" void kernel_launch(void* const* d_in, const int* in_sizes, int n_in, void* d_out, int out_size, void* d_ws, size_t ws_size, hipStream_t stream) {
    static int grid = 0;
    if (grid == 0) {
        if (n_in != 31 || in_sizes[0] != T * D || out_size != T * D || ws_size < WS_END) { fprintf(stderr, "kernel_launch: unexpected shapes / workspace (n_in %d, ws %zu < %zu)\n", n_in, ws_size, (size_t)WS_END); grid = -1; return; }
        int dev = 0, cus = 0, per_cu = 0;
        if (hipGetDevice(&dev) != hipSuccess || hipDeviceGetAttribute(&cus, hipDeviceAttributeMultiprocessorCount, dev) != hipSuccess) { grid = -1; return; }
        if (hipFuncSetAttribute((const void*)mega_fwd, hipFuncAttributeMaxDynamicSharedMemorySize, LDS_BYTES) != hipSuccess) { fprintf(stderr, "kernel_launch: hipFuncSetAttribute failed\n"); grid = -1; return; }
        if (hipOccupancyMaxActiveBlocksPerMultiprocessor(&per_cu, (const void*)mega_fwd, NWAVES * 64, LDS_BYTES) != hipSuccess || per_cu < 1) { fprintf(stderr, "kernel_launch: occupancy query says %d\n", per_cu); (void)hipGetLastError(); grid = -1; return; }
        grid = cus;
    }
    if (grid < 0) return;
    if (hipMemsetAsync((char*)d_ws + WS_CTL, 0, CTL_ZERO_BYTES, stream) != hipSuccess) return;
    Args a{};
    for (int i = 0; i < 31; ++i) a.in[i] = d_in[i];
    a.out = (float*)d_out; a.ws = (unsigned char*)d_ws;
#if MK_PER_PHASE
    for (int p = 0; p < NPH_TOTAL; ++p) { a.ph_lo = p; a.ph_hi = p + 1; hipLaunchKernelGGL(mega_fwd, dim3(grid), dim3(NWAVES * 64), LDS_BYTES, stream, a); }
#else
    a.ph_lo = 0; a.ph_hi = NPH_TOTAL;
    hipLaunchKernelGGL(mega_fwd, dim3(grid), dim3(NWAVES * 64), LDS_BYTES, stream, a);
#endif
}
```

```cpp
#include <hip/hip_runtime.h>
#include <cstdio>
#include <cstdint>
#include <cmath>

#ifndef MK_PER_PHASE
#define MK_PER_PHASE 0
#endif

constexpr int BATCH = 8, SEQ = 4096, T = BATCH * SEQ, D = 1024, DEPTH = 4, PLE = 256;
constexpr int IN_COLS = 5792, NIN = 5888;
constexpr int QR = 384, KVR = 256, ROPE_D = 32;
constexpr int DENSE_FF = 2816, EXPERT_FF = 3584, NEXP = 8;
constexpr float LN_EPS = 1e-5f;
constexpr float LOG2E = 1.4426950408889634f;
constexpr int MOE_ROWS = 2 * T + NEXP * 256;
constexpr int MOE_CHUNK_TILES = 128;
constexpr int MOE_NCHUNK = 3;

#define GAS __attribute__((address_space(1)))
#define LAS __attribute__((address_space(3)))
typedef unsigned short bf16;
typedef unsigned v4u __attribute__((ext_vector_type(4)));
typedef unsigned v2u __attribute__((ext_vector_type(2)));
typedef float f32x4 __attribute__((ext_vector_type(4)));
typedef float f32x2 __attribute__((ext_vector_type(2)));
typedef float f32x16 __attribute__((ext_vector_type(16)));
typedef short bf16x8 __attribute__((ext_vector_type(8)));
typedef short s16x4 __attribute__((ext_vector_type(4)));
typedef __bf16 bf16x2_t __attribute__((ext_vector_type(2)));
typedef GAS unsigned gu32;
#define RLX_AGENT __ATOMIC_RELAXED, __HIP_MEMORY_SCOPE_AGENT
#define LDS_WAIT() asm volatile("s_waitcnt lgkmcnt(0)" ::: "memory")
#define VM_WAIT() asm volatile("s_waitcnt vmcnt(0)" ::: "memory")

__device__ __forceinline__ unsigned pk2(float lo, float hi) { f32x2 v = {lo, hi}; bf16x2_t b = __builtin_convertvector(v, bf16x2_t); return __builtin_bit_cast(unsigned, b); }
__device__ __forceinline__ float bflo(unsigned u) { return __uint_as_float(u << 16); }
__device__ __forceinline__ float bfhi(unsigned u) { return __uint_as_float(u & 0xffff0000u); }
__device__ __forceinline__ float sigmoidf_(float x) { return __builtin_amdgcn_rcpf(1.0f + __builtin_amdgcn_exp2f(-x * LOG2E)); }
__device__ __forceinline__ float wave_sum(float v) {
#pragma unroll
    for (int o = 1; o < 64; o <<= 1) v += __shfl_xor(v, o);
    return v;
}

namespace pg8 {
#define PG8_LAS __attribute__((address_space(3)))
typedef unsigned short bf16_t;
typedef unsigned u32x4 __attribute__((ext_vector_type(4)));
typedef unsigned u32x2 __attribute__((ext_vector_type(2)));
constexpr int BM = 256, BK = 64, HALF = 128, HTB = HALF * BK * 2  , STAGE_BYTES = 8 * HTB, NXCD = 8, WGM = 8;

__host__ __device__ __forceinline__ int lds_byte(int r, int c) { const int st = (r >> 4) * 2 + (c >> 5), rr = r & 15, cc = c & 31, ob = rr * 64 + cc * 2; return st * 1024 + (ob ^ (((ob >> 9) & 1) << 5)); }
__host__ __device__ __forceinline__ void stage_rc(int b, int& R, int& C) { const int st = b / 1024, sb = b % 1024, swz = sb ^ (((sb >> 9) & 1) << 5); R = (st >> 1) * 16 + swz / 64; C = (st & 1) * 32 + (swz % 64) / 2; }
__host__ __device__ __forceinline__ int perm32(int rho) { const int n = rho >> 4, i = rho & 15; return 8 * (i >> 2) + 4 * n + (i & 3); }

struct Unit { int pm, pn; };
struct Gemm { const bf16_t* A; const bf16_t* Bt; int M, N, K; };

struct StaticOrder {
    int nM, nN, nwg, G, c;
    __host__ __device__ void init(int M, int N, int G_, int c_) { nM = M / BM; nN = N / BM; nwg = nM * nN; G = G_; c = c_; }
    __host__ __device__ bool next(int i, Unit& u) const {
        const long L = (long)i * G + c; if (L >= nwg) return false;
        int wgid = (int)L; { const int q = nwg / NXCD, r = nwg % NXCD, xcd = wgid % NXCD, off = wgid / NXCD; wgid = (xcd < r ? xcd * (q + 1) : r * (q + 1) + (xcd - r) * q) + off; }
        const int nig = WGM * nN, gid = wgid / nig, fm = gid * WGM, gsz = (nM - fm) < WGM ? (nM - fm) : WGM;
        u.pm = fm + ((wgid % nig) % gsz); u.pn = (wgid % nig) / gsz; return true;
    }
    __device__ __forceinline__ size_t bofs(const Unit&) const { return 0; }
    __device__ __forceinline__ void a_ready(const Unit&) const {}
    __device__ __forceinline__ void done(const Unit&) const {}
};
struct GroupedOrder : StaticOrder {
    int tile_lo; int pend0, pend1, pend2, pend3, pend4, pend5, pend6, pend7; size_t estride;
    __device__ __forceinline__ size_t bofs(const Unit& u) const {
        const int t = u.pm + tile_lo;
        const int e = (t >= pend0) + (t >= pend1) + (t >= pend2) + (t >= pend3) + (t >= pend4) + (t >= pend5) + (t >= pend6);
        return (size_t)e * estride;
    }
};

typedef f32x4 Acc[2][2][4][2];

struct EpiL1 {
    static constexpr bool PERM = true, AFTER_DRAIN = false;
    bf16_t* QKV; bf16_t* Gt; float* CQ; const float* bgate; float qscale;
    __device__ __forceinline__ void operator()(const Acc& acc, const Unit& u, int wr, int wc, int fr, int fq) const {
        const int row0 = u.pm * BM + wr * 64 + fr; const int pn = u.pn;
        if (pn < 12) {
            bf16_t* base = QKV + (size_t)(pn >> 2) * ((size_t)T * 1024); const int col0 = (pn & 3) * 256 + wc * 32 + 8 * fq; const float sc = pn < 4 ? qscale : 1.f;
#pragma unroll
            for (int ai = 0; ai < 2; ++ai)
#pragma unroll
                for (int m = 0; m < 4; ++m) { bf16_t* rowp = base + (size_t)(row0 + ai * HALF + m * 16) * 1024 + col0;
#pragma unroll
                    for (int bj = 0; bj < 2; ++bj) { const f32x4 v0 = acc[ai][bj][m][0] * sc, v1 = acc[ai][bj][m][1] * sc;
                        u32x4 w; w.x = pk2(v0[0], v0[1]); w.y = pk2(v0[2], v0[3]); w.z = pk2(v1[0], v1[1]); w.w = pk2(v1[2], v1[3]);
                        *(u32x4*)(rowp + bj * HALF) = w; } }
        } else if (pn < 20) {
            const int col0 = (pn - 12) * 256 + wc * 32 + 8 * fq;
            f32x4 bv[2][2];
#pragma unroll
            for (int bj = 0; bj < 2; ++bj)
#pragma unroll
                for (int n = 0; n < 2; ++n) bv[bj][n] = *(const f32x4*)(bgate + col0 + bj * HALF + 4 * n);
#pragma unroll
            for (int ai = 0; ai < 2; ++ai)
#pragma unroll
                for (int m = 0; m < 4; ++m) { bf16_t* rowp = Gt + (size_t)(row0 + ai * HALF + m * 16) * 2048 + col0;
#pragma unroll
                    for (int bj = 0; bj < 2; ++bj) { const f32x4 v0 = acc[ai][bj][m][0] + bv[bj][0], v1 = acc[ai][bj][m][1] + bv[bj][1];
                        u32x4 w; w.x = pk2(sigmoidf_(v0[0]), sigmoidf_(v0[1])); w.y = pk2(sigmoidf_(v0[2]), sigmoidf_(v0[3])); w.z = pk2(sigmoidf_(v1[0]), sigmoidf_(v1[1])); w.w = pk2(sigmoidf_(v1[2]), sigmoidf_(v1[3]));
                        *(u32x4*)(rowp + bj * HALF) = w; } }
        } else {
            const int col0 = (pn - 20) * 256 + wc * 32 + 8 * fq;
#pragma unroll
            for (int ai = 0; ai < 2; ++ai)
#pragma unroll
                for (int m = 0; m < 4; ++m) { float* rowp = CQ + (size_t)(row0 + ai * HALF + m * 16) * 768 + col0;
#pragma unroll
                    for (int bj = 0; bj < 2; ++bj) { *(f32x4*)(rowp + bj * HALF) = acc[ai][bj][m][0]; *(f32x4*)(rowp + bj * HALF + 4) = acc[ai][bj][m][1]; } }
        }
    }
};
struct EpiRopeQ {
    static constexpr bool PERM = false, AFTER_DRAIN = false;
    bf16_t* O; const float* rope; float qscale;
    __device__ __forceinline__ void operator()(const Acc& acc, const Unit& u, int wr, int wc, int fr, int fq) const {
        const int row0 = u.pm * BM + wr * 64 + fr;
#pragma unroll
        for (int ai = 0; ai < 2; ++ai)
#pragma unroll
            for (int m = 0; m < 4; ++m) { const int row = row0 + ai * HALF + m * 16;
                const f32x4 cs0 = *(const f32x4*)(rope + (size_t)row * 32 + fq * 8), cs1 = *(const f32x4*)(rope + (size_t)row * 32 + fq * 8 + 4);
                const f32x4 cc = {cs0[0], cs0[2], cs1[0], cs1[2]}, ss = {cs0[1], cs0[3], cs1[1], cs1[3]};
#pragma unroll
                for (int bj = 0; bj < 2; ++bj) { const int colg = u.pn * BM + bj * HALF + wc * 32; const bool isr = ((colg >> 5) % 3) == 2;
                    const f32x4 x1 = acc[ai][bj][m][0], x2 = acc[ai][bj][m][1];
                    f32x4 o1 = x1, o2 = x2; if (isr) { o1 = x1 * cc - x2 * ss; o2 = x1 * ss + x2 * cc; }
                    o1 = o1 * qscale; o2 = o2 * qscale;
                    bf16_t* p = O + (size_t)row * 768 + colg + 4 * fq;
                    u32x2 w1; w1.x = pk2(o1[0], o1[1]); w1.y = pk2(o1[2], o1[3]); u32x2 w2; w2.x = pk2(o2[0], o2[1]); w2.y = pk2(o2[2], o2[3]);
                    *(u32x2*)p = w1; *(u32x2*)(p + 16) = w2; } }
    }
};
struct EpiBf16 {
    static constexpr bool PERM = true, AFTER_DRAIN = false;
    bf16_t* O; int ldc;
    __device__ __forceinline__ void operator()(const Acc& acc, const Unit& u, int wr, int wc, int fr, int fq) const {
        const int row0 = u.pm * BM + wr * 64 + fr, col0 = u.pn * BM + wc * 32 + 8 * fq;
#pragma unroll
        for (int ai = 0; ai < 2; ++ai)
#pragma unroll
            for (int m = 0; m < 4; ++m) { bf16_t* rowp = O + (size_t)(row0 + ai * HALF + m * 16) * ldc + col0;
#pragma unroll
                for (int bj = 0; bj < 2; ++bj) { const f32x4 v0 = acc[ai][bj][m][0], v1 = acc[ai][bj][m][1];
                    u32x4 w; w.x = pk2(v0[0], v0[1]); w.y = pk2(v0[2], v0[3]); w.z = pk2(v1[0], v1[1]); w.w = pk2(v1[2], v1[3]);
                    *(u32x4*)(rowp + bj * HALF) = w; } }
    }
};
template <bool ADD> struct EpiGate {
    static constexpr bool PERM = true, AFTER_DRAIN = false;
    bf16_t* O; const bf16_t* Gt; const bf16_t* MT; int goff;
    __device__ __forceinline__ void operator()(const Acc& acc, const Unit& u, int wr, int wc, int fr, int fq) const {
        const int row0 = u.pm * BM + wr * 64 + fr, col0 = u.pn * BM + wc * 32 + 8 * fq;
#pragma unroll
        for (int ai = 0; ai < 2; ++ai)
#pragma unroll
            for (int m = 0; m < 4; ++m) { const size_t row = (size_t)(row0 + ai * HALF + m * 16);
#pragma unroll
                for (int bj = 0; bj < 2; ++bj) { const int col = col0 + bj * HALF;
                    const u32x4 gv = *(const u32x4*)(Gt + row * 2048 + goff + col);
                    f32x4 v0 = acc[ai][bj][m][0], v1 = acc[ai][bj][m][1];
                    v0[0] *= bflo(gv.x); v0[1] *= bfhi(gv.x); v0[2] *= bflo(gv.y); v0[3] *= bfhi(gv.y); v1[0] *= bflo(gv.z); v1[1] *= bfhi(gv.z); v1[2] *= bflo(gv.w); v1[3] *= bfhi(gv.w);
                    if (ADD) { const u32x4 mv = *(const u32x4*)(MT + row * 1024 + col);
                        v0[0] += bflo(mv.x); v0[1] += bfhi(mv.x); v0[2] += bflo(mv.y); v0[3] += bfhi(mv.y); v1[0] += bflo(mv.z); v1[1] += bfhi(mv.z); v1[2] += bflo(mv.w); v1[3] += bfhi(mv.w); }
                    u32x4 w; w.x = pk2(v0[0], v0[1]); w.y = pk2(v0[2], v0[3]); w.z = pk2(v1[0], v1[1]); w.w = pk2(v1[2], v1[3]);
                    *(u32x4*)(O + row * 1024 + col) = w; } }
    }
};
template <int MODE> struct EpiF32 {
    static constexpr bool PERM = false, AFTER_DRAIN = false;
    float* P; const float* X; float alpha;
    __device__ __forceinline__ void operator()(const Acc& acc, const Unit& u, int wr, int wc, int fr, int fq) const {
        const int row0 = u.pm * BM + wr * 64 + fr, col0 = u.pn * BM + wc * 32 + 4 * fq;
#pragma unroll
        for (int ai = 0; ai < 2; ++ai)
#pragma unroll
            for (int m = 0; m < 4; ++m) { const size_t off = (size_t)(row0 + ai * HALF + m * 16) * 1024 + col0;
#pragma unroll
                for (int bj = 0; bj < 2; ++bj)
#pragma unroll
                    for (int n = 0; n < 2; ++n) { const size_t o = off + bj * HALF + n * 16; const f32x4 a = acc[ai][bj][m][n]; f32x4 r;
                        if (MODE == 0) r = a;
                        else if (MODE == 1) r = *(const f32x4*)(X + o) * alpha + a;
                        else if (MODE == 2) { const f32x4 pv = *(const f32x4*)(P + o); const f32x4 xv = *(const f32x4*)(X + o);
                            r[0] = xv[0] * alpha + sigmoidf_(a[0]) * pv[0]; r[1] = xv[1] * alpha + sigmoidf_(a[1]) * pv[1]; r[2] = xv[2] * alpha + sigmoidf_(a[2]) * pv[2]; r[3] = xv[3] * alpha + sigmoidf_(a[3]) * pv[3]; }
                        else r = *(const f32x4*)(P + o) + a;
                        *(f32x4*)(P + o) = r; } }
    }
};
struct EpiSwiGLU {
    static constexpr bool PERM = true, AFTER_DRAIN = false;
    bf16_t* H; int ldc;
    __device__ __forceinline__ void operator()(const Acc& acc, const Unit& u, int wr, int wc, int fr, int fq) const {
        const int row0 = u.pm * BM + wr * 64 + fr, col0 = (u.pn * BM + wc * 32 + 8 * fq) >> 1;
#pragma unroll
        for (int ai = 0; ai < 2; ++ai)
#pragma unroll
            for (int m = 0; m < 4; ++m) { bf16_t* rowp = H + (size_t)(row0 + ai * HALF + m * 16) * ldc + col0;
#pragma unroll
                for (int bj = 0; bj < 2; ++bj) { const f32x4 v0 = acc[ai][bj][m][0], v1 = acc[ai][bj][m][1];
                    const float h0 = v0[0] * sigmoidf_(v0[0]) * v0[1], h1 = v0[2] * sigmoidf_(v0[2]) * v0[3], h2 = v1[0] * sigmoidf_(v1[0]) * v1[1], h3 = v1[2] * sigmoidf_(v1[2]) * v1[3];
                    u32x2 w; w.x = pk2(h0, h1); w.y = pk2(h2, h3);
                    *(u32x2*)(rowp + bj * (HALF / 2)) = w; } }
    }
};

template <class Epi, class Sched, bool ALIGN_EPI = false, bool SP2 = false>
__device__ __forceinline__ void gemm_phase(PG8_LAS unsigned char* lds, const Gemm g, const Sched& S, const Epi& E) {
    int tid_ = threadIdx.x; asm volatile("" : "+v"(tid_));
    const int tid = tid_, wid = __builtin_amdgcn_readfirstlane(tid >> 6), lane = tid & 63, wr = wid >> 2, wc = wid & 3, fr = lane & 15, fq = lane >> 4;
    int K_ = g.K; asm volatile("" : "+s"(K_)); const int K = K_, nt = K / BK;
    unsigned voffA[2], voffB[2];
#pragma unroll
    for (int i = 0; i < 2; ++i) { int R, C; stage_rc(tid * 16 + i * 8192, R, C); const int Rb = Epi::PERM ? ((R & ~31) + perm32(R & 31)) : R;
        voffA[i] = (unsigned)(R * K + C) * 2u; voffB[i] = (unsigned)(Rb * K + C) * 2u; }
    const size_t kstep = (size_t)(BK * 2);
    const size_t hstep = (size_t)HALF * K * 2;
    const size_t tstep = 2 * hstep;
    const unsigned ldsw = (unsigned)wid * 1024u;
    const int aoff = lds_byte(wr * 64 + fr, fq * 8), boff = lds_byte(wc * 32 + fr, fq * 8);
#define PG8_SA(b, h) (((b) * 2 + (h)) * HTB)
#define PG8_SB(b, h) ((4 + (b) * 2 + (h)) * HTB)
#define PG8_STAGE(bufoff, gbase, voff) do { _Pragma("unroll") for (int _i = 0; _i < 2; ++_i) \
        __builtin_amdgcn_global_load_lds((const unsigned*)((const char*)(gbase) + (voff)[_i]), (PG8_LAS unsigned*)(lds + (bufoff) + ldsw + _i * 8192), 16, 0, 0); } while (0)
#define PG8_LDA(dst, b, h) do { _Pragma("unroll") for (int m = 0; m < 4; ++m) _Pragma("unroll") for (int k = 0; k < 2; ++k) dst[m][k] = *(const PG8_LAS bf16x8*)(lds + PG8_SA(b, h) + aoff + m * 2048 + k * 1024); } while (0)
#define PG8_LDB(dst, b, h) do { _Pragma("unroll") for (int n = 0; n < 2; ++n) _Pragma("unroll") for (int k = 0; k < 2; ++k) dst[n][k] = *(const PG8_LAS bf16x8*)(lds + PG8_SB(b, h) + boff + n * 2048 + k * 1024); } while (0)
#define PG8_MMA(ai, bj, At, Bt) do { __builtin_amdgcn_s_setprio(1); _Pragma("unroll") for (int m = 0; m < 4; ++m) _Pragma("unroll") for (int n = 0; n < 2; ++n) _Pragma("unroll") for (int k = 0; k < 2; ++k) \
        acc[ai][bj][m][n] = __builtin_amdgcn_mfma_f32_16x16x32_bf16(Bt[n][k], At[m][k], acc[ai][bj][m][n], 0, 0, 0); __builtin_amdgcn_s_setprio(0); } while (0)
#define PG8_WAIT_V(n) asm volatile("s_waitcnt vmcnt(" #n ")" ::: "memory")
#define PG8_WAIT_L(n) asm volatile("s_waitcnt lgkmcnt(" #n ")" ::: "memory")
#define PG8_BAR __builtin_amdgcn_s_barrier()
#define PG8_SCHED __builtin_amdgcn_sched_barrier(0)
    Unit cur, nxt; int ui = 0;
    if (!S.next(0, cur)) return;
    f32x4 acc[2][2][4][2];
#pragma unroll
    for (int a = 0; a < 2; ++a)
#pragma unroll
        for (int b = 0; b < 2; ++b)
#pragma unroll
            for (int m = 0; m < 4; ++m)
#pragma unroll
                for (int n = 0; n < 2; ++n) acc[a][b][m][n] = (f32x4){0.f, 0.f, 0.f, 0.f};
    bf16x8 At[4][2], B0[2][2], B1[2][2];
    const char* cA = (const char*)g.A + (size_t)cur.pm * tstep; const char* cB = (const char*)g.Bt + (size_t)cur.pn * tstep + S.bofs(cur);
    S.a_ready(cur);
    if constexpr (SP2) {
        PG8_STAGE(PG8_SB(0, 0), cB, voffB); PG8_STAGE(PG8_SB(0, 1), cB + hstep, voffB); PG8_STAGE(PG8_SA(0, 0), cA, voffA); PG8_STAGE(PG8_SA(0, 1), cA + hstep, voffA);
        if (wr == 1) PG8_BAR;
        PG8_WAIT_V(2); PG8_BAR;
        PG8_STAGE(PG8_SB(1, 0), cB + kstep, voffB); PG8_STAGE(PG8_SA(1, 0), cA + kstep, voffA); PG8_STAGE(PG8_SB(1, 1), cB + hstep + kstep, voffB);
        PG8_WAIT_V(6); PG8_BAR;
    } else {
        PG8_STAGE(PG8_SB(0, 0), cB, voffB); PG8_STAGE(PG8_SA(0, 0), cA, voffA); PG8_STAGE(PG8_SB(0, 1), cB + hstep, voffB); PG8_STAGE(PG8_SA(0, 1), cA + hstep, voffA);
        if (wr == 1) PG8_BAR;
        PG8_WAIT_V(4); PG8_BAR;
        PG8_STAGE(PG8_SB(1, 0), cB + kstep, voffB); PG8_STAGE(PG8_SA(1, 0), cA + kstep, voffA); PG8_STAGE(PG8_SB(1, 1), cB + hstep + kstep, voffB);
        PG8_WAIT_V(6); PG8_BAR;
    }
    for (;;) {
        const bool has_next = S.next(ui + 1, nxt);
        const char* nA = has_next ? (const char*)g.A + (size_t)nxt.pm * tstep : cA; const char* nB = has_next ? (const char*)g.Bt + (size_t)nxt.pn * tstep + S.bofs(nxt) : cB;
#pragma nounroll
        for (int t = 0; t < nt; t += 2) {
            const bool last = (t == nt - 2);
            const char* a1 = cA + (size_t)(t + 1) * kstep;
            const char* a2 = last ? nA : cA + (size_t)(t + 2) * kstep; const char* b2 = last ? nB : cB + (size_t)(t + 2) * kstep;
            const char* a3 = a2 + kstep; const char* b3 = b2 + kstep;
            if (last && has_next) S.a_ready(nxt);
            if constexpr (SP2) {
            PG8_LDB(B0, 0, 0); PG8_LDB(B1, 0, 1); PG8_SCHED; PG8_LDA(At, 0, 0); PG8_STAGE(PG8_SA(1, 1), a1 + hstep, voffA);
            PG8_WAIT_V(8); PG8_WAIT_L(0); PG8_BAR; PG8_MMA(0, 0, At, B0); PG8_MMA(0, 1, At, B1); PG8_BAR; PG8_SCHED;
            PG8_LDA(At, 0, 1); PG8_STAGE(PG8_SB(0, 0), b2, voffB); PG8_STAGE(PG8_SB(0, 1), b2 + hstep, voffB); PG8_STAGE(PG8_SA(0, 0), a2, voffA);
            PG8_WAIT_V(8); PG8_WAIT_L(0); PG8_BAR; PG8_MMA(1, 0, At, B0); PG8_MMA(1, 1, At, B1); PG8_BAR; PG8_SCHED;
            PG8_LDB(B0, 1, 0); PG8_LDB(B1, 1, 1); PG8_SCHED; PG8_LDA(At, 1, 0); PG8_STAGE(PG8_SA(0, 1), a2 + hstep, voffA);
            PG8_WAIT_V(8); PG8_WAIT_L(0); PG8_BAR; PG8_MMA(0, 0, At, B0); PG8_MMA(0, 1, At, B1); PG8_BAR; PG8_SCHED;
            PG8_LDA(At, 1, 1); PG8_STAGE(PG8_SB(1, 0), b3, voffB); PG8_STAGE(PG8_SB(1, 1), b3 + hstep, voffB); PG8_STAGE(PG8_SA(1, 0), a3, voffA);
            PG8_WAIT_V(8); PG8_WAIT_L(0); PG8_BAR; PG8_MMA(1, 0, At, B0); PG8_MMA(1, 1, At, B1); PG8_BAR; PG8_SCHED;
            } else {
            PG8_LDB(B0, 0, 0); PG8_SCHED; PG8_LDA(At, 0, 0); PG8_STAGE(PG8_SA(1, 1), a1 + hstep, voffA);
            PG8_WAIT_L(8); PG8_BAR; PG8_WAIT_L(0); PG8_MMA(0, 0, At, B0); PG8_BAR; PG8_SCHED;
            PG8_LDB(B1, 0, 1); PG8_STAGE(PG8_SB(0, 0), b2, voffB);
            PG8_BAR; PG8_WAIT_L(0); PG8_MMA(0, 1, At, B1); PG8_BAR;
            PG8_LDA(At, 0, 1); PG8_STAGE(PG8_SA(0, 0), a2, voffA);
            PG8_BAR; PG8_WAIT_L(0); PG8_MMA(1, 0, At, B0); PG8_BAR; PG8_SCHED;
            PG8_STAGE(PG8_SB(0, 1), b2 + hstep, voffB);
            PG8_WAIT_V(6); PG8_BAR; PG8_MMA(1, 1, At, B1); PG8_BAR;
            PG8_LDB(B0, 1, 0); PG8_SCHED; PG8_LDA(At, 1, 0); PG8_STAGE(PG8_SA(0, 1), a2 + hstep, voffA);
            PG8_WAIT_L(8); PG8_BAR; PG8_WAIT_L(0); PG8_MMA(0, 0, At, B0); PG8_BAR; PG8_SCHED;
            PG8_LDB(B1, 1, 1); PG8_STAGE(PG8_SB(1, 0), b3, voffB);
            PG8_BAR; PG8_WAIT_L(0); PG8_MMA(0, 1, At, B1); PG8_BAR;
            PG8_LDA(At, 1, 1); PG8_STAGE(PG8_SA(1, 0), a3, voffA);
            PG8_BAR; PG8_WAIT_L(0); PG8_MMA(1, 0, At, B0); PG8_BAR; PG8_SCHED;
            PG8_STAGE(PG8_SB(1, 1), b3 + hstep, voffB);
            PG8_WAIT_V(6); PG8_BAR; PG8_MMA(1, 1, At, B1); PG8_BAR;
            }
        }
        if constexpr (ALIGN_EPI) { if (wr == 0) PG8_BAR; }
        if constexpr (!Epi::AFTER_DRAIN) { E(acc, cur, wr, wc, fr, fq); S.done(cur); }
        if (!has_next) break;
#pragma unroll
        for (int a = 0; a < 2; ++a)
#pragma unroll
            for (int b = 0; b < 2; ++b)
#pragma unroll
                for (int m = 0; m < 4; ++m)
#pragma unroll
                    for (int n = 0; n < 2; ++n) acc[a][b][m][n] = (f32x4){0.f, 0.f, 0.f, 0.f};
        cur = nxt; cA = nA; cB = nB; ++ui;
        if constexpr (ALIGN_EPI) { if (wr == 1) PG8_BAR; }
    }
    PG8_WAIT_V(0);
    if constexpr (!ALIGN_EPI) { if (wr == 0) PG8_BAR; }
    PG8_BAR;
    if constexpr (Epi::AFTER_DRAIN) { E.fused(acc, cur, wr, wc, fr, fq, lds, wid, lane); S.done(cur); }
#undef PG8_SA
#undef PG8_SB
#undef PG8_STAGE
#undef PG8_LDA
#undef PG8_LDB
#undef PG8_MMA
#undef PG8_WAIT_V
#undef PG8_WAIT_L
#undef PG8_BAR
#undef PG8_SCHED
}
}

namespace att {
#define MFMA32(a, b, c) __builtin_amdgcn_mfma_f32_32x32x16_bf16((a), (b), (c), 0, 0, 0)
typedef short v4i16_t __attribute__((ext_vector_type(4)));
struct AttnP {
    const bf16* Q; int ldq;
    const bf16* K1; int ldk1;
    const bf16* K2; int ldk2;
    const bf16* V; int ldv;
    bf16* O; int ldo;
    const int* pos;
    const int* blkmax;
    const float* lut;
};
__device__ __forceinline__ s16x4 vtr(const LAS unsigned char* p) { return __builtin_bit_cast(s16x4, __builtin_amdgcn_ds_read_tr16_b64_v4i16((LAS v4i16_t*)p)); }

template <int DQK, int KSPLIT, int DV, bool BIAS>
__device__ __forceinline__ void attn_unit(const AttnP& P, int b, int qt, int qcol, int kcol, int vcol, int ocol, int hb, LAS unsigned char* lds) {
    constexpr int KROWB = DQK * 2 + 16;
    constexpr int VROWB = (DV == 128) ? 320 : 192;
    constexpr int KBYTES = 64 * KROWB, VBYTES = 64 * VROWB, STAGE = KBYTES + VBYTES + 256, LUT_OFF = 2 * STAGE;
    constexpr int ND = DQK / 16, NDB = DV / 32, KCH = DQK / 8, VCH = DV / 8, NKC = 64 * KCH, NVC = 64 * VCH, KL = (NKC + 511) / 512, VL = (NVC + 511) / 512;
    int tid_ = threadIdx.x; asm volatile("" : "+v"(tid_));
    const int tid = tid_, lane = tid & 63, wid = __builtin_amdgcn_readfirstlane(tid >> 6), r = lane & 31, h = lane >> 5;
    const long tok0 = (long)b * SEQ; const int q0 = qt * 256; const int qrow = q0 + wid * 32 + r;
    bf16x8 qf[ND];
    { const bf16* qp = P.Q + (tok0 + qrow) * (long)P.ldq + qcol + 8 * h;
#pragma unroll
      for (int d = 0; d < ND; ++d) qf[d] = *(const bf16x8*)(qp + 16 * d); }
    int posq = 0, posq_min = 0;
    LAS float* lut = (LAS float*)(lds + LUT_OFF);
    if (BIAS) { posq = P.pos[tok0 + qrow]; int mn = posq;
#pragma unroll
        for (int o = 1; o < 64; o <<= 1) { const int t2 = __shfl_xor(mn, o); mn = t2 < mn ? t2 : mn; }
        posq_min = mn;
        if (tid < 132) lut[tid] = P.lut[hb * 132 + tid]; }
    v4u kreg[KL], vreg[VL]; int preg = 0;
#define ATT_ISSUE(t) do { const long trow = tok0 + 64 * (long)(t); \
        _Pragma("unroll") for (int i = 0; i < KL; ++i) { const int c = tid + 512 * i; if (c < NKC) { const int row = c / KCH, col = (c % KCH) * 8; \
            const bf16* src = (col < KSPLIT) ? P.K1 + (trow + row) * (long)P.ldk1 + kcol + col : P.K2 + (trow + row) * (long)P.ldk2 + (col - KSPLIT); kreg[i] = *(const v4u*)src; } } \
        _Pragma("unroll") for (int i = 0; i < VL; ++i) { const int c = tid + 512 * i; if (c < NVC) { const int row = c / VCH, col = (c % VCH) * 8; vreg[i] = *(const v4u*)(P.V + (trow + row) * (long)P.ldv + vcol + col); } } \
        if (BIAS && tid < 64) preg = P.pos[trow + tid]; } while (0)
#define ATT_WRITE(t) do { LAS unsigned char* sb = lds + ((t) & 1) * STAGE; \
        _Pragma("unroll") for (int i = 0; i < KL; ++i) { const int c = tid + 512 * i; if (c < NKC) { const int row = c / KCH, cc = c % KCH; *(LAS v4u*)(sb + row * KROWB + cc * 16) = kreg[i]; } } \
        _Pragma("unroll") for (int i = 0; i < VL; ++i) { const int c = tid + 512 * i; if (c < NVC) { const int row = c / VCH, cc = c % VCH; *(LAS v4u*)(sb + KBYTES + row * VROWB + cc * 16) = vreg[i]; } } \
        if (BIAS && tid < 64) *(LAS int*)(sb + KBYTES + VBYTES + 4 * tid) = preg; } while (0)
    f32x16 o[NDB];
#pragma unroll
    for (int i = 0; i < NDB; ++i)
#pragma unroll
        for (int j = 0; j < 16; ++j) o[i][j] = 0.f;
    float m_run = -INFINITY, l_run = 0.f;
    const int ntiles = (q0 + 256) / 64, my_last = (q0 + wid * 32 + 31) / 64;
    ATT_ISSUE(0); ATT_WRITE(0); __syncthreads();
    const int kbase = r * KROWB + 16 * h;
    const int vbase = KBYTES + (4 * h + ((lane & 15) >> 2)) * VROWB + (((lane >> 4) & 1) * 16 + (lane & 3) * 4) * 2;
    for (int t = 0; t < ntiles; ++t) {
        const bool more = (t + 1 < ntiles);
        if (more) ATT_ISSUE(t + 1);
        if (t <= my_last) {
            const LAS unsigned char* sb = lds + (t & 1) * STAGE;
            bool plain = (64 * t + 63 <= q0 + wid * 32);
            float cinit = 0.f;
            if (BIAS) { const int kmax = P.blkmax[(int)(tok0 >> 6) + t]; if (plain && (posq_min - kmax >= 113)) cinit = lut[128]; else plain = false; }
            f32x16 x0, x1;
#pragma unroll
            for (int j = 0; j < 16; ++j) { x0[j] = cinit; x1[j] = cinit; }
#pragma unroll
            for (int d = 0; d < ND; ++d) {
                const bf16x8 k0 = *(const LAS bf16x8*)(sb + kbase + d * 32), k1 = *(const LAS bf16x8*)(sb + kbase + 32 * KROWB + d * 32);
                x0 = MFMA32(k0, qf[d], x0); x1 = MFMA32(k1, qf[d], x1);
            }
            if (!plain) {
#pragma unroll
                for (int g = 0; g < 4; ++g) {
                    int pk0[4] = {0, 0, 0, 0}, pk1[4] = {0, 0, 0, 0};
                    if (BIAS) { const LAS int* pp = (const LAS int*)(sb + KBYTES + VBYTES) + 8 * g + 4 * h;
                        const v4u a = *(const LAS v4u*)pp, c = *(const LAS v4u*)(pp + 32);
                        pk0[0] = a.x; pk0[1] = a.y; pk0[2] = a.z; pk0[3] = a.w; pk1[0] = c.x; pk1[1] = c.y; pk1[2] = c.z; pk1[3] = c.w; }
#pragma unroll
                    for (int j = 0; j < 4; ++j) { const int i = 4 * g + j; const int kidx = 64 * t + 8 * g + 4 * h + j;
                        float v0 = x0[i], v1 = x1[i];
                        if (BIAS) { int n0 = posq - pk0[j]; n0 = n0 < 0 ? 0 : (n0 > 128 ? 128 : n0); int n1 = posq - pk1[j]; n1 = n1 < 0 ? 0 : (n1 > 128 ? 128 : n1); v0 += lut[n0]; v1 += lut[n1]; }
                        if (kidx > qrow) v0 = -INFINITY; if (kidx + 32 > qrow) v1 = -INFINITY;
                        x0[i] = v0; x1[i] = v1; }
                }
            }
            float mx = x0[0];
#pragma unroll
            for (int j = 1; j < 16; ++j) mx = fmaxf(mx, x0[j]);
#pragma unroll
            for (int j = 0; j < 16; ++j) mx = fmaxf(mx, x1[j]);
            mx = fmaxf(mx, __shfl_xor(mx, 32));
            const float mn = fmaxf(m_run, mx), alpha = __builtin_amdgcn_exp2f(m_run - mn); m_run = mn;
            float ls = 0.f;
#pragma unroll
            for (int j = 0; j < 16; ++j) { x0[j] = __builtin_amdgcn_exp2f(x0[j] - mn); x1[j] = __builtin_amdgcn_exp2f(x1[j] - mn); ls += x0[j] + x1[j]; }
            l_run = l_run * alpha + ls;
#pragma unroll
            for (int i = 0; i < NDB; ++i) o[i] = o[i] * alpha;
            bf16x8 pf[4];
            { v4u w;
              w.x = pk2(x0[0], x0[1]); w.y = pk2(x0[2], x0[3]); w.z = pk2(x0[4], x0[5]); w.w = pk2(x0[6], x0[7]); pf[0] = __builtin_bit_cast(bf16x8, w);
              w.x = pk2(x0[8], x0[9]); w.y = pk2(x0[10], x0[11]); w.z = pk2(x0[12], x0[13]); w.w = pk2(x0[14], x0[15]); pf[1] = __builtin_bit_cast(bf16x8, w);
              w.x = pk2(x1[0], x1[1]); w.y = pk2(x1[2], x1[3]); w.z = pk2(x1[4], x1[5]); w.w = pk2(x1[6], x1[7]); pf[2] = __builtin_bit_cast(bf16x8, w);
              w.x = pk2(x1[8], x1[9]); w.y = pk2(x1[10], x1[11]); w.z = pk2(x1[12], x1[13]); w.w = pk2(x1[14], x1[15]); pf[3] = __builtin_bit_cast(bf16x8, w); }
#pragma unroll
            for (int db = 0; db < NDB; ++db)
#pragma unroll
                for (int s = 0; s < 4; ++s) {
                    const s16x4 lo = vtr(sb + vbase + (16 * s) * VROWB + 64 * db), hi = vtr(sb + vbase + (16 * s + 8) * VROWB + 64 * db);
                    const bf16x8 vf = __builtin_shufflevector(lo, hi, 0, 1, 2, 3, 4, 5, 6, 7);
                    o[db] = MFMA32(vf, pf[s], o[db]);
                }
        }
        if (more) ATT_WRITE(t + 1);
        __syncthreads();
    }
#undef ATT_ISSUE
#undef ATT_WRITE
    const float lt = l_run + __shfl_xor(l_run, 32), inv = 1.0f / lt;
    bf16* op = P.O + (tok0 + qrow) * (long)P.ldo + ocol + 4 * h;
#pragma unroll
    for (int db = 0; db < NDB; ++db)
#pragma unroll
        for (int g = 0; g < 4; ++g) { v2u w; w.x = pk2(o[db][4 * g] * inv, o[db][4 * g + 1] * inv); w.y = pk2(o[db][4 * g + 2] * inv, o[db][4 * g + 3] * inv);
            *(v2u*)(op + 32 * db + 8 * g) = w; }
}
#undef MFMA32
}

constexpr size_t MiB = 1u << 20;
constexpr size_t WS_CTL = 0, CTL_ZERO_BYTES = 1 * MiB;
constexpr size_t WS_ROPE = 1 * MiB;
constexpr size_t WS_MISC = 5 * MiB;
constexpr size_t WS_XB = 6 * MiB;
constexpr size_t WS_PB = 70 * MiB;
constexpr size_t WS_W = 86 * MiB;
constexpr size_t W_IN = WS_W, W_UQ = WS_W + 12 * MiB, W_UKV = WS_W + 13 * MiB, W_BD = WS_W + 14 * MiB, W_BM = WS_W + 16 * MiB, W_OUT = WS_W + 17 * MiB,
                 W_PG = WS_W + 19 * MiB, W_PP = WS_W + 21 * MiB, W_F13 = WS_W + 22 * MiB, W_F2D = WS_W + 33 * MiB, W_F2E = WS_W + 134 * MiB;
constexpr size_t WS_ACT = 276 * MiB;
constexpr size_t A_DQ = WS_ACT, A_DK = WS_ACT + 64 * MiB, A_DV = WS_ACT + 128 * MiB, A_G = WS_ACT + 192 * MiB, A_C = WS_ACT + 320 * MiB;
constexpr size_t A_OA = A_DQ, A_MT = A_DK, A_M = A_DV, A_CQ = A_C, A_OA2 = A_C, A_PRE = A_C;
constexpr size_t A_CQN = WS_ACT + 448 * MiB, A_CKVN = WS_ACT + 472 * MiB, A_OB = A_CQN, A_MKR = WS_ACT + 488 * MiB, A_MQ = WS_ACT + 490 * MiB, A_MKV = WS_ACT + 538 * MiB;
constexpr size_t A_H = WS_ACT;
constexpr size_t A_XG = WS_ACT, A_YG = WS_ACT + 132 * MiB, A_TOK = WS_ACT + 264 * MiB, A_HG = WS_ACT + 448 * MiB;
constexpr size_t WS_END = WS_ACT + 672 * MiB;
constexpr int CW_BAR = 4096, CW_MOE = 8192;

constexpr int RING_BYTES = 131072, MISC_OFF = RING_BYTES + 320, LDS_BYTES = 147456;
constexpr int NWAVES = 8;

#define XB_TMO      128
#define XB_XCNT(j)  (256  + 64 * (j))
#define XB_XSUB(j)  (1280 + 64 * (j))
#define XB_XGEN(j)  (2304 + 64 * (j))
#define XB_TOP      3328
#define XB_TOPGEN   3392
#define XCD_BAR_WORDS 3456
#define XB_SPIN_CAP (1u << 18)

__device__ __forceinline__ unsigned xb_ld(unsigned* p)              { return __hip_atomic_load(p, __ATOMIC_RELAXED, __HIP_MEMORY_SCOPE_AGENT); }
__device__ __forceinline__ unsigned xb_add(unsigned* p, unsigned v) { return __hip_atomic_fetch_add(p, v, __ATOMIC_RELAXED, __HIP_MEMORY_SCOPE_AGENT); }
__device__ __forceinline__ unsigned xb_xcc_id() { return (unsigned)__builtin_amdgcn_s_getreg((3 << 11) | 20) & 0xFu; }
#define XB_SPIN(cond, bar) do { unsigned _sp = 0; while (cond) { __builtin_amdgcn_s_sleep(1); \
    if ((++_sp & 255u) == 0u) { if (xb_ld(&(bar)[XB_TMO])) break; if (_sp > XB_SPIN_CAP) { atomicAdd(&(bar)[XB_TMO], 1u); break; } } } } while (0)

struct XcdBarrier {
    unsigned* bar; unsigned x;
    volatile LAS unsigned* st;
};

__device__ __forceinline__ XcdBarrier xcd_barrier_post(unsigned* bar, volatile LAS unsigned* st) {
    XcdBarrier b; b.bar = bar; b.x = xb_xcc_id(); b.st = st;
    if (threadIdx.x == 0) (void)xb_add(&bar[XB_XCNT(b.x)], 1u);
    return b;
}
__device__ __forceinline__ void xcd_barrier_complete(unsigned* bar, unsigned x, unsigned& nloc, unsigned& nx) {
    const unsigned G = gridDim.x * gridDim.y * gridDim.z;
    unsigned sum, cnt, mine, sp = 0u;
    for (;;) {
        sum = 0u; cnt = 0u; mine = 0u;
#pragma unroll
        for (unsigned j = 0; j < 16; ++j) { const unsigned c = xb_ld(&bar[XB_XCNT(j)]); sum += c; cnt += (c > 0u) ? 1u : 0u; mine = (j == x) ? c : mine; }
        if (sum == G) break;
        __builtin_amdgcn_s_sleep(1);
        if ((++sp & 255u) == 0u) { if (xb_ld(&bar[XB_TMO])) break; if (sp > XB_SPIN_CAP) { atomicAdd(&bar[XB_TMO], 1u); break; } }
    }
    nloc = mine > 0u ? mine : 1u; nx = cnt > 0u ? cnt : 1u;
}

__device__ __forceinline__ void xcd_barrier(const XcdBarrier& b) {
    asm volatile("s_waitcnt vmcnt(0)" ::: "memory");
    __syncthreads();
    if (threadIdx.x == 0) {
        unsigned* bar = b.bar;
        __builtin_amdgcn_s_waitcnt(0);
        unsigned nloc = b.st[0], nx = b.st[1];
        if (nloc == 0u) { xcd_barrier_complete(bar, b.x, nloc, nx); b.st[0] = nloc; b.st[1] = nx; }
        const unsigned old = xb_add(&bar[XB_XSUB(b.x)], 1u);
        const unsigned gen = old / nloc;
        if (old + 1u == (gen + 1u) * nloc) {
            __builtin_amdgcn_fence(__ATOMIC_RELEASE, "agent");
            asm volatile("s_waitcnt vmcnt(0)" ::: "memory");
            const unsigned og = xb_add(&bar[XB_TOP], 1u);
            const unsigned tg = og / nx;
            if (og + 1u == (tg + 1u) * nx) xb_add(&bar[XB_TOPGEN], 1u);
            else XB_SPIN(xb_ld(&bar[XB_TOPGEN]) == tg, bar);
            __builtin_amdgcn_fence(__ATOMIC_ACQUIRE, "agent");
            xb_add(&bar[XB_XGEN(b.x)], 1u);
            asm volatile("s_waitcnt vmcnt(0)" ::: "memory");
        } else {
            XB_SPIN(xb_ld(&bar[XB_XGEN(b.x)]) == gen, bar);
            __builtin_amdgcn_fence(__ATOMIC_ACQUIRE, "agent");
            asm volatile("s_waitcnt vmcnt(0)" ::: "memory");
        }
    }
    __syncthreads();
}

struct Args { const void* in[31]; float* out; unsigned char* ws; int ph_lo, ph_hi; };

struct Frame {
    LAS unsigned char* lds;
    int tid, lane, wave, gw, NGW, G, vcu;
    const Args* a;
    unsigned char* ws;
};
#define INF(i) ((const float*)F.a->in[i])
#define WSP(T_, off) ((T_*)(F.ws + (off)))

__device__ __forceinline__ void conv_w(const Frame& F, const float* src, int ldn, int K, int ncols, int nbatch, size_t sbs, bf16* dst, int rmul, int roff, size_t dbs, const float* kscale) {
    LAS float* scr = (LAS float*)(F.lds + F.wave * 16384);
    const int lane = F.lane, nblk = ncols / 32, kblk = K / 64, per = nblk * kblk, total = per * nbatch;
    for (int it = F.gw; it < total; it += F.NGW) {
        const int bt = it / per, r = it % per, kb = r / nblk, nb = r % nblk, k0 = kb * 64, n0 = nb * 32;
        const float* W = src + (size_t)bt * sbs; bf16* WT = dst + (size_t)bt * dbs;
#pragma unroll 8
        for (int i = 0; i < 32; ++i) { const int kk = 2 * i + (lane >> 5); scr[kk * 33 + (lane & 31)] = W[(size_t)(k0 + kk) * ldn + n0 + (lane & 31)]; }
        LDS_WAIT(); asm volatile("" ::: "memory");
        const int c = lane & 7;
        float ks[8];
#pragma unroll
        for (int i = 0; i < 8; ++i) ks[i] = kscale ? kscale[k0 + 8 * c + i] : 1.0f;
#pragma unroll
        for (int j = 0; j < 4; ++j) { const int n = (lane >> 3) + 8 * j; const LAS float* s = scr + (8 * c) * 33 + n;
            v4u o; o.x = pk2(s[0 * 33] * ks[0], s[1 * 33] * ks[1]); o.y = pk2(s[2 * 33] * ks[2], s[3 * 33] * ks[3]); o.z = pk2(s[4 * 33] * ks[4], s[5 * 33] * ks[5]); o.w = pk2(s[6 * 33] * ks[6], s[7 * 33] * ks[7]);
            *(v4u*)(WT + (size_t)(rmul * (n0 + n) + roff) * K + k0 + 8 * c) = o; }
        LDS_WAIT(); asm volatile("" ::: "memory");
    }
}
__device__ __forceinline__ void phase_convert(const Frame& F, int L) {
    const int j = L >> 1;
    const float* win = INF(4) + (size_t)L * D * IN_COLS;
    conv_w(F, win, IN_COLS, D, 3072, 1, 0, WSP(bf16, W_IN), 1, 0, 0, nullptr);
    conv_w(F, win + 3744, IN_COLS, D, 2048, 1, 0, WSP(bf16, W_IN), 1, 3072, 0, nullptr);
    conv_w(F, win + 3072, IN_COLS, D, 672, 1, 0, WSP(bf16, W_IN), 1, 5120, 0, nullptr);
    { bf16* padr = WSP(bf16, W_IN) + (size_t)IN_COLS * D;
      for (int i = F.gw * 64 + F.lane; i < (NIN - IN_COLS) * D / 8; i += F.NGW * 64) ((v4u*)padr)[i] = (v4u){0u, 0u, 0u, 0u}; }
    conv_w(F, INF(12) + (size_t)L * QR * 768, 768, QR, 768, 1, 0, WSP(bf16, W_UQ), 1, 0, 0, INF(11) + L * QR);
    conv_w(F, INF(14) + (size_t)L * KVR * 1024, 1024, KVR, 1024, 1, 0, WSP(bf16, W_UKV), 1, 0, 0, INF(13) + L * KVR);
    conv_w(F, INF(15) + (size_t)L * D * D, D, D, D, 1, 0, WSP(bf16, W_BD), 1, 0, 0, nullptr);
    conv_w(F, INF(16) + (size_t)L * 512 * D, D, 512, D, 1, 0, WSP(bf16, W_BM), 1, 0, 0, nullptr);
    conv_w(F, INF(17) + (size_t)L * D * D, D, D, D, 1, 0, WSP(bf16, W_OUT), 1, 0, 0, nullptr);
    conv_w(F, INF(27) + (size_t)L * D * D, D, D, D, 1, 0, WSP(bf16, W_PG), 1, 0, 0, nullptr);
    conv_w(F, INF(28) + (size_t)L * PLE * D, D, PLE, D, 1, 0, WSP(bf16, W_PP), 1, 0, 0, nullptr);
    if ((L & 1) == 0) {
        conv_w(F, INF(20) + (size_t)j * D * DENSE_FF, DENSE_FF, D, DENSE_FF, 1, 0, WSP(bf16, W_F13), 2, 0, 0, nullptr);
        conv_w(F, INF(21) + (size_t)j * D * DENSE_FF, DENSE_FF, D, DENSE_FF, 1, 0, WSP(bf16, W_F13), 2, 1, 0, nullptr);
        conv_w(F, INF(22) + (size_t)j * DENSE_FF * D, D, DENSE_FF, D, 1, 0, WSP(bf16, W_F2D), 1, 0, 0, nullptr);
    } else {
        const size_t eo = (size_t)j * NEXP * D * EXPERT_FF;
        conv_w(F, INF(24) + eo, EXPERT_FF, D, EXPERT_FF, NEXP, (size_t)D * EXPERT_FF, WSP(bf16, W_F13), 2, 0, (size_t)2 * EXPERT_FF * D, nullptr);
        conv_w(F, INF(25) + eo, EXPERT_FF, D, EXPERT_FF, NEXP, (size_t)D * EXPERT_FF, WSP(bf16, W_F13), 2, 1, (size_t)2 * EXPERT_FF * D, nullptr);
        conv_w(F, INF(26) + eo, D, EXPERT_FF, D, NEXP, (size_t)EXPERT_FF * D, WSP(bf16, W_F2E), 1, 0, (size_t)D * EXPERT_FF, nullptr);
    }
    { const f32x4* ps = (const f32x4*)(INF(1) + (size_t)L * T * PLE); v2u* pd = WSP(v2u, WS_PB);
      for (int i = F.gw * 64 + F.lane; i < T * PLE / 4; i += F.NGW * 64) { const f32x4 v = ps[i]; v2u o; o.x = pk2(v[0], v[1]); o.y = pk2(v[2], v[3]); pd[i] = o; } }
}

__device__ __forceinline__ void phase_prologue(const Frame& F) {
    const int* pos = (const int*)F.a->in[2];
    for (int m = F.gw; m < T; m += F.NGW) {
        const f32x4* xr = (const f32x4*)(INF(0) + (size_t)m * D) + F.lane; f32x4* orow = (f32x4*)(F.a->out + (size_t)m * D) + F.lane; v2u* br = WSP(v2u, WS_XB) + (size_t)m * (D / 4) + F.lane;
#pragma unroll
        for (int j = 0; j < 4; ++j) { const f32x4 v = xr[64 * j]; orow[64 * j] = v; v2u o; o.x = pk2(v[0], v[1]); o.y = pk2(v[2], v[3]); br[64 * j] = o; }
    }
    { float* rope = WSP(float, WS_ROPE);
      for (int idx = F.gw * 64 + F.lane; idx < T * 16; idx += F.NGW * 64) {
          const int t = idx >> 4, j = idx & 15;
          double inv = 1.0; for (int i = 0; i < j; ++i) inv *= 0.5623413251903491;
          const double ang = (double)pos[t] * inv;
          const double nq = __builtin_rint(ang * 0.6366197723675814);
          double y = __builtin_fma(-nq, 1.5707963267948966, ang); y = __builtin_fma(-nq, 6.123233995736766e-17, y);
          const double y2 = y * y;
          double sp = 1.0 / 6227020800.0; sp = sp * y2 - 1.0 / 39916800.0; sp = sp * y2 + 1.0 / 362880.0; sp = sp * y2 - 1.0 / 5040.0; sp = sp * y2 + 1.0 / 120.0; sp = sp * y2 - 1.0 / 6.0;
          const double sn = y + y * y2 * sp;
          double cp = -1.0 / 87178291200.0; cp = cp * y2 + 1.0 / 479001600.0; cp = cp * y2 - 1.0 / 3628800.0; cp = cp * y2 + 1.0 / 40320.0; cp = cp * y2 - 1.0 / 720.0; cp = cp * y2 + 1.0 / 24.0; cp = cp * y2 - 0.5;
          const double cs = 1.0 + y2 * cp;
          const int q = ((int)nq) & 3;
          const double c = (q == 0) ? cs : (q == 1) ? -sn : (q == 2) ? -cs : sn;
          const double s = (q == 0) ? sn : (q == 1) ? cs : (q == 2) ? -sn : -cs;
          rope[2 * idx] = (float)c; rope[2 * idx + 1] = (float)s;
      } }
    { int* bm = WSP(int, WS_MISC);
      for (int blk = F.gw; blk < T / 64; blk += F.NGW) { int v = pos[blk * 64 + F.lane];
#pragma unroll
          for (int o = 1; o < 64; o <<= 1) { const int t2 = __shfl_xor(v, o); v = t2 > v ? t2 : v; }
          if (F.lane == 0) bm[blk] = v; } }
    { float* lut = WSP(float, WS_MISC + 4096); const float* tab = INF(3);
      for (int idx = F.gw * 64 + F.lane; idx < 8 * 132; idx += F.NGW * 64) { const int hh = idx / 132, n = idx % 132;
          int bk = n;
          if (n >= 16) bk = 16 + (n >= 19) + (n >= 21) + (n >= 24) + (n >= 27) + (n >= 31) + (n >= 35) + (n >= 40) + (n >= 46) + (n >= 52) + (n >= 59) + (n >= 67) + (n >= 77) + (n >= 87) + (n >= 99) + (n >= 113);
          lut[idx] = tab[bk * 8 + hh] * LOG2E; } }
    phase_convert(F, 0);
}

__device__ __forceinline__ void phase_rms_rope(const Frame& F) {
    const float* CQ = WSP(float, A_CQ); const float* rope = WSP(float, WS_ROPE);
    bf16* CQN = WSP(bf16, A_CQN); bf16* CKVN = WSP(bf16, A_CKVN); bf16* MKR = WSP(bf16, A_MKR);
    const int l = F.lane;
    for (int m = F.gw; m < T; m += F.NGW) {
        const float* c = CQ + (size_t)m * 768;
        const f32x2 a0 = *(const f32x2*)(c + 6 * l), a1 = *(const f32x2*)(c + 6 * l + 2), a2 = *(const f32x2*)(c + 6 * l + 4);
        const f32x4 kv = *(const f32x4*)(c + QR + 4 * l);
        float x1 = 0.f, x2 = 0.f, rc = 0.f, rs = 0.f;
        if (l < 16) { x1 = c[QR + KVR + l]; x2 = c[QR + KVR + 16 + l]; rc = rope[(size_t)m * 32 + 2 * l]; rs = rope[(size_t)m * 32 + 2 * l + 1]; }
        const float sq = wave_sum(a0[0] * a0[0] + a0[1] * a0[1] + a1[0] * a1[0] + a1[1] * a1[1] + a2[0] * a2[0] + a2[1] * a2[1]);
        const float sk = wave_sum(kv[0] * kv[0] + kv[1] * kv[1] + kv[2] * kv[2] + kv[3] * kv[3]);
        const float rq = 1.0f / sqrtf(sq * (1.0f / QR) + LN_EPS), rk = 1.0f / sqrtf(sk * (1.0f / KVR) + LN_EPS);
        unsigned* qo = (unsigned*)(CQN + (size_t)m * QR + 6 * l);
        qo[0] = pk2(a0[0] * rq, a0[1] * rq); qo[1] = pk2(a1[0] * rq, a1[1] * rq); qo[2] = pk2(a2[0] * rq, a2[1] * rq);
        v2u ko; ko.x = pk2(kv[0] * rk, kv[1] * rk); ko.y = pk2(kv[2] * rk, kv[3] * rk);
        *(v2u*)(CKVN + (size_t)m * KVR + 4 * l) = ko;
        if (l < 16) { const float o1 = x1 * rc - x2 * rs, o2 = x1 * rs + x2 * rc; const unsigned w = pk2(o1, o2);
            MKR[(size_t)m * 32 + l] = (bf16)(w & 0xffffu); MKR[(size_t)m * 32 + 16 + l] = (bf16)(w >> 16); }
    }
}

__device__ __forceinline__ void phase_combine(const Frame& F, int L) {
    const float lam_init = 0.8f - 0.6f * expf(-0.3f * (float)L);
    const int l = F.lane;
    const float d1 = wave_sum(INF(6)[L * 64 + l] * INF(7)[L * 64 + l]), d2 = wave_sum(INF(8)[L * 64 + l] * INF(9)[L * 64 + l]);
    const float lam = expf(d1) - expf(d2) + lam_init;
    const bf16* OA2 = WSP(bf16, A_OA2); bf16* OA = WSP(bf16, A_OA);
    const int hh = l >> 3, d0 = (l & 7) * 16;
    float gsc[16];
#pragma unroll
    for (int i = 0; i < 16; ++i) gsc[i] = INF(10)[L * 128 + d0 + i] * (1.0f - lam_init);
    for (int m = F.gw; m < T; m += F.NGW) {
        const bf16* p0 = OA2 + (size_t)m * 2048 + (hh * 2) * 128 + d0;
        const v4u a0 = *(const v4u*)p0, a1 = *(const v4u*)(p0 + 8), b0 = *(const v4u*)(p0 + 128), b1 = *(const v4u*)(p0 + 136);
        float o[16];
        o[0] = bflo(a0.x) - lam * bflo(b0.x); o[1] = bfhi(a0.x) - lam * bfhi(b0.x); o[2] = bflo(a0.y) - lam * bflo(b0.y); o[3] = bfhi(a0.y) - lam * bfhi(b0.y);
        o[4] = bflo(a0.z) - lam * bflo(b0.z); o[5] = bfhi(a0.z) - lam * bfhi(b0.z); o[6] = bflo(a0.w) - lam * bflo(b0.w); o[7] = bfhi(a0.w) - lam * bfhi(b0.w);
        o[8] = bflo(a1.x) - lam * bflo(b1.x); o[9] = bfhi(a1.x) - lam * bfhi(b1.x); o[10] = bflo(a1.y) - lam * bflo(b1.y); o[11] = bfhi(a1.y) - lam * bfhi(b1.y);
        o[12] = bflo(a1.z) - lam * bflo(b1.z); o[13] = bfhi(a1.z) - lam * bfhi(b1.z); o[14] = bflo(a1.w) - lam * bflo(b1.w); o[15] = bfhi(a1.w) - lam * bfhi(b1.w);
        float ss = 0.f;
#pragma unroll
        for (int i = 0; i < 16; ++i) ss += o[i] * o[i];
        ss += __shfl_xor(ss, 1); ss += __shfl_xor(ss, 2); ss += __shfl_xor(ss, 4);
        const float rr = 1.0f / sqrtf(ss * (1.0f / 128.0f) + LN_EPS);
        v4u w0, w1;
        w0.x = pk2(o[0] * rr * gsc[0], o[1] * rr * gsc[1]); w0.y = pk2(o[2] * rr * gsc[2], o[3] * rr * gsc[3]); w0.z = pk2(o[4] * rr * gsc[4], o[5] * rr * gsc[5]); w0.w = pk2(o[6] * rr * gsc[6], o[7] * rr * gsc[7]);
        w1.x = pk2(o[8] * rr * gsc[8], o[9] * rr * gsc[9]); w1.y = pk2(o[10] * rr * gsc[10], o[11] * rr * gsc[11]); w1.z = pk2(o[12] * rr * gsc[12], o[13] * rr * gsc[13]); w1.w = pk2(o[14] * rr * gsc[14], o[15] * rr * gsc[15]);
        bf16* po = OA + (size_t)m * 1024 + hh * 128 + d0;
        *(v4u*)po = w0; *(v4u*)(po + 8) = w1;
    }
}

template <bool ROUTE, bool GATHER>
__device__ __forceinline__ void phase_ln(const Frame& F, const float* gam, const float* bet, const float* wr, int moe_j) {
    const float* PRE = WSP(float, A_PRE); const int l = F.lane;
    const bf16* YG = WSP(bf16, A_YG); int* TOKE = WSP(int, A_TOK); float* TOKG = WSP(float, A_TOK + 1 * MiB); const int* TOKR = WSP(int, A_TOK + 2 * MiB);
    unsigned* cnt = WSP(unsigned, WS_CTL) + CW_MOE + 64 * moe_j;
    f32x4 gv[4], bv[4];
#pragma unroll
    for (int j = 0; j < 4; ++j) { gv[j] = *(const f32x4*)(gam + 4 * l + 256 * j); bv[j] = *(const f32x4*)(bet + 4 * l + 256 * j); }
    for (int m = F.gw; m < T; m += F.NGW) {
        const f32x4* xr = (const f32x4*)(PRE + (size_t)m * D) + l;
        f32x4 v[4]; float s = 0.f;
#pragma unroll
        for (int j = 0; j < 4; ++j) v[j] = xr[64 * j];
        if (GATHER) { const int r0 = TOKR[2 * m], r1 = TOKR[2 * m + 1]; const float g0 = TOKG[2 * m], g1 = TOKG[2 * m + 1];
            const v2u* y0 = (const v2u*)(YG + (size_t)r0 * D) + l; const v2u* y1 = (const v2u*)(YG + (size_t)r1 * D) + l;
#pragma unroll
            for (int j = 0; j < 4; ++j) { const v2u a = y0[64 * j], b = y1[64 * j];
                v[j][0] += g0 * bflo(a.x) + g1 * bflo(b.x); v[j][1] += g0 * bfhi(a.x) + g1 * bfhi(b.x); v[j][2] += g0 * bflo(a.y) + g1 * bflo(b.y); v[j][3] += g0 * bfhi(a.y) + g1 * bfhi(b.y); } }
#pragma unroll
        for (int j = 0; j < 4; ++j) s += (v[j][0] + v[j][1]) + (v[j][2] + v[j][3]);
        const float mean = wave_sum(s) * (1.f / D); float s2 = 0.f;
#pragma unroll
        for (int j = 0; j < 4; ++j) { v[j] = v[j] - mean; s2 += (v[j][0] * v[j][0] + v[j][1] * v[j][1]) + (v[j][2] * v[j][2] + v[j][3] * v[j][3]); }
        const float rstd = 1.f / sqrtf(wave_sum(s2) * (1.f / D) + LN_EPS);
        f32x4* orow = (f32x4*)(F.a->out + (size_t)m * D) + l; v2u* br = WSP(v2u, WS_XB) + (size_t)m * (D / 4) + l;
#pragma unroll
        for (int j = 0; j < 4; ++j) { v[j] = v[j] * rstd * gv[j] + bv[j]; orow[64 * j] = v[j]; v2u o; o.x = pk2(v[j][0], v[j][1]); o.y = pk2(v[j][2], v[j][3]); br[64 * j] = o; }
        if (ROUTE) {
            float lg[8];
#pragma unroll
            for (int e = 0; e < 8; ++e) lg[e] = 0.f;
#pragma unroll
            for (int j = 0; j < 4; ++j)
#pragma unroll
                for (int c = 0; c < 4; ++c) { const float* w = wr + (size_t)(4 * l + 256 * j + c) * 8; const f32x4 w0 = *(const f32x4*)w, w1 = *(const f32x4*)(w + 4); const float xv = v[j][c];
                    lg[0] += xv * w0[0]; lg[1] += xv * w0[1]; lg[2] += xv * w0[2]; lg[3] += xv * w0[3]; lg[4] += xv * w1[0]; lg[5] += xv * w1[1]; lg[6] += xv * w1[2]; lg[7] += xv * w1[3]; }
#pragma unroll
            for (int e = 0; e < 8; ++e) lg[e] = wave_sum(lg[e]);
            int e0 = 0; float v0 = lg[0];
#pragma unroll
            for (int e = 1; e < 8; ++e) if (lg[e] > v0) { v0 = lg[e]; e0 = e; }
            int e1 = -1; float v1 = -INFINITY;
#pragma unroll
            for (int e = 0; e < 8; ++e) if (e != e0 && lg[e] > v1) { v1 = lg[e]; e1 = e; }
            const float g1 = 1.0f / (1.0f + expf(v0 - v1)), g0 = 1.0f - g1;
            if (l == 0) { TOKE[2 * m] = e0; TOKE[2 * m + 1] = e1; TOKG[2 * m] = g0; TOKG[2 * m + 1] = g1;
                __hip_atomic_fetch_add(cnt + e0, 1u, RLX_AGENT); __hip_atomic_fetch_add(cnt + e1, 1u, RLX_AGENT); }
        }
    }
}

struct MoeTiles { int pend[8]; int total; };
__device__ __forceinline__ void moe_tiles(const Frame& F, int moe_j, MoeTiles& mt) {
    const unsigned* cnt = WSP(unsigned, WS_CTL) + CW_MOE + 64 * moe_j; int acc = 0;
#pragma unroll
    for (int e = 0; e < 8; ++e) { const unsigned c = __hip_atomic_load(cnt + e, RLX_AGENT); acc += (int)((c + 255u) >> 8); mt.pend[e] = acc; }
    mt.total = acc;
}
__device__ __forceinline__ void phase_scatter(const Frame& F, int moe_j) {
    MoeTiles mt; moe_tiles(F, moe_j, mt);
    unsigned* cur = WSP(unsigned, WS_CTL) + CW_MOE + 128 + 64 * moe_j;
    const int* TOKE = WSP(int, A_TOK); int* TOKR = WSP(int, A_TOK + 2 * MiB);
    const v4u* XB = WSP(v4u, WS_XB); v4u* XG = WSP(v4u, A_XG); const int l = F.lane;
    for (int m = F.gw; m < T; m += F.NGW) {
        int rows[2];
#pragma unroll
        for (int k = 0; k < 2; ++k) { const int e = TOKE[2 * m + k]; int slot = 0;
            if (l == 0) slot = (int)__hip_atomic_fetch_add(cur + e, 1u, RLX_AGENT);
            slot = __shfl(slot, 0);
            int st = 0;
#pragma unroll
            for (int q = 0; q < 7; ++q) st = (e > q) ? mt.pend[q] : st;
            rows[k] = st * 256 + slot; }
        const v4u a = XB[(size_t)m * 128 + l], b = XB[(size_t)m * 128 + 64 + l];
        XG[(size_t)rows[0] * 128 + l] = a; XG[(size_t)rows[0] * 128 + 64 + l] = b; XG[(size_t)rows[1] * 128 + l] = a; XG[(size_t)rows[1] * 128 + 64 + l] = b;
        if (l == 0) { TOKR[2 * m] = rows[0]; TOKR[2 * m + 1] = rows[1]; }
    }
}

__device__ __forceinline__ void phase_attn_diff(const Frame& F) {
    att::AttnP P; P.Q = WSP(bf16, A_DQ); P.ldq = 1024; P.K1 = WSP(bf16, A_DK); P.ldk1 = 1024; P.K2 = P.K1; P.ldk2 = 1024; P.V = WSP(bf16, A_DV); P.ldv = 1024; P.O = WSP(bf16, A_OA2); P.ldo = 2048;
    P.pos = (const int*)F.a->in[2]; P.blkmax = WSP(int, WS_MISC); P.lut = WSP(float, WS_MISC + 4096);
    for (int p = F.vcu; p < BATCH * 16 * 8; p += F.G) {
        const int bh = p >> 3, i = p & 7, b = bh >> 4, vh = bh & 15;
        att::attn_unit<64, 64, 128, true>(P, b, 15 - i, vh * 64, vh * 64, (vh >> 1) * 128, vh * 128, vh >> 1, F.lds);
        att::attn_unit<64, 64, 128, true>(P, b, i, vh * 64, vh * 64, (vh >> 1) * 128, vh * 128, vh >> 1, F.lds);
    }
}
__device__ __forceinline__ void phase_attn_mla(const Frame& F) {
    att::AttnP P; P.Q = WSP(bf16, A_MQ); P.ldq = 768; P.K1 = WSP(bf16, A_MKV); P.ldk1 = 1024; P.K2 = WSP(bf16, A_MKR); P.ldk2 = 32; P.V = WSP(bf16, A_MKV); P.ldv = 1024; P.O = WSP(bf16, A_OB); P.ldo = 512;
    P.pos = (const int*)F.a->in[2]; P.blkmax = WSP(int, WS_MISC); P.lut = WSP(float, WS_MISC + 4096);
    for (int p = F.vcu; p < BATCH * 8 * 8; p += F.G) {
        const int bh = p >> 3, i = p & 7, b = bh >> 3, hh = bh & 7;
        att::attn_unit<96, 64, 64, false>(P, b, 15 - i, hh * 96, hh * 128, hh * 128 + 64, hh * 64, 0, F.lds);
        att::attn_unit<96, 64, 64, false>(P, b, i, hh * 96, hh * 128, hh * 128 + 64, hh * 64, 0, F.lds);
    }
}

constexpr int NPH_DENSE = 10, NPH_MOE = 9 + 2 * MOE_NCHUNK, NPH_TOTAL = 1 + 2 * NPH_DENSE + 2 * NPH_MOE;
#define GEMM_CALL(EPI, SCHED, gm, S_, E_) pg8::gemm_phase<EPI, SCHED, true, true>(F.lds, gm, S_, E_)

__global__ void __launch_bounds__(NWAVES * 64, 2) mega_fwd(Args args) {
    extern __shared__ __attribute__((aligned(16))) unsigned char lds_raw[];
    Frame F;
    F.lds = (LAS unsigned char*)lds_raw; F.a = &args; F.ws = args.ws;
    F.tid = threadIdx.x; F.lane = F.tid & 63; F.wave = __builtin_amdgcn_readfirstlane(F.tid >> 6);
    F.G = gridDim.x; { const int bx = blockIdx.x; F.vcu = (F.G % 8 == 0) ? (bx % 8) * (F.G / 8) + bx / 8 : bx; }
    F.gw = F.vcu * NWAVES + F.wave; F.NGW = F.G * NWAVES;
    volatile LAS unsigned* MISC = (volatile LAS unsigned*)(F.lds + MISC_OFF);
    for (int u = F.tid; u < (LDS_BYTES - RING_BYTES) / 4; u += NWAVES * 64) ((LAS unsigned*)(F.lds + RING_BYTES))[u] = 0u;
    __syncthreads();
    const int lo = args.ph_lo, hi = args.ph_hi;
    XcdBarrier bar; bar.bar = WSP(unsigned, WS_CTL) + CW_BAR; bar.x = 0; bar.st = nullptr;
    if (hi - lo > 1) bar = xcd_barrier_post(WSP(unsigned, WS_CTL) + CW_BAR, MISC + 8);
    int pc = 0;
#define PH_BEGIN if (pc >= lo && pc < hi) { { int t_ = threadIdx.x; asm volatile("" : "+v"(t_)); F.tid = t_; F.lane = t_ & 63; F.wave = __builtin_amdgcn_readfirstlane(t_ >> 6); F.gw = F.vcu * NWAVES + F.wave; }
#define PH_END if (pc + 1 < hi) xcd_barrier(bar); } ++pc;
    const int bx = (int)blockIdx.x;
    const float ALPHA = 1.6817928305074290f;

    PH_BEGIN phase_prologue(F); PH_END

    for (int L = 0; L < DEPTH; ++L) {
        const int mj = L >> 1;
        PH_BEGIN {
            pg8::Gemm g{WSP(bf16, WS_XB), WSP(bf16, W_IN), T, NIN, D}; pg8::StaticOrder S; S.init(T, NIN, F.G, bx);
            pg8::EpiL1 E{WSP(bf16, A_DQ), WSP(bf16, A_G), WSP(float, A_CQ), INF(5) + L * 2048, 0.125f * LOG2E};
            GEMM_CALL(pg8::EpiL1, pg8::StaticOrder, g, S, E);
        } PH_END
        PH_BEGIN phase_rms_rope(F); PH_END
        PH_BEGIN {
            { pg8::Gemm g{WSP(bf16, A_CQN), WSP(bf16, W_UQ), T, 768, QR}; pg8::StaticOrder S; S.init(T, 768, F.G, bx);
              pg8::EpiRopeQ E{WSP(bf16, A_MQ), WSP(float, WS_ROPE), 0.10206207261596577f * LOG2E};
              GEMM_CALL(pg8::EpiRopeQ, pg8::StaticOrder, g, S, E); }
            { pg8::Gemm g{WSP(bf16, A_CKVN), WSP(bf16, W_UKV), T, 1024, KVR}; pg8::StaticOrder S; S.init(T, 1024, F.G, bx);
              pg8::EpiBf16 E{WSP(bf16, A_MKV), 1024};
              GEMM_CALL(pg8::EpiBf16, pg8::StaticOrder, g, S, E); }
            phase_attn_diff(F);
        } PH_END
        PH_BEGIN { phase_attn_mla(F); phase_combine(F, L); } PH_END
        PH_BEGIN {
            { pg8::Gemm g{WSP(bf16, A_OB), WSP(bf16, W_BM), T, D, 512}; pg8::StaticOrder S; S.init(T, D, F.G, bx);
              pg8::EpiGate<false> E{WSP(bf16, A_MT), WSP(bf16, A_G), nullptr, 1024};
              GEMM_CALL(pg8::EpiGate<false>, pg8::StaticOrder, g, S, E); }
            { pg8::Gemm g{WSP(bf16, A_OA), WSP(bf16, W_BD), T, D, D}; pg8::StaticOrder S; S.init(T, D, F.G, bx);
              pg8::EpiGate<true> E{WSP(bf16, A_M), WSP(bf16, A_G), WSP(bf16, A_MT), 0};
              GEMM_CALL(pg8::EpiGate<true>, pg8::StaticOrder, g, S, E); }
        } PH_END
        PH_BEGIN {
            pg8::Gemm g{WSP(bf16, A_M), WSP(bf16, W_OUT), T, D, D}; pg8::StaticOrder S; S.init(T, D, F.G, bx);
            pg8::EpiF32<1> E{WSP(float, A_PRE), args.out, ALPHA};
            GEMM_CALL(pg8::EpiF32<1>, pg8::StaticOrder, g, S, E);
        } PH_END
        PH_BEGIN {
            if (L & 1) phase_ln<true, false>(F, INF(18) + L * D, INF(19) + L * D, INF(23) + (size_t)mj * D * NEXP, mj);
            else phase_ln<false, false>(F, INF(18) + L * D, INF(19) + L * D, nullptr, 0);
        } PH_END
        if ((L & 1) == 0) {
            PH_BEGIN {
                { pg8::Gemm g{WSP(bf16, WS_XB), WSP(bf16, W_F13), T, 2 * DENSE_FF, D}; pg8::StaticOrder S; S.init(T, 2 * DENSE_FF, F.G, bx);
                  pg8::EpiSwiGLU E{WSP(bf16, A_H), DENSE_FF};
                  GEMM_CALL(pg8::EpiSwiGLU, pg8::StaticOrder, g, S, E); }
                { pg8::Gemm g{WSP(bf16, WS_PB), WSP(bf16, W_PP), T, D, PLE}; pg8::StaticOrder S; S.init(T, D, F.G, bx);
                  pg8::EpiF32<0> E{WSP(float, A_PRE), nullptr, 0.f};
                  GEMM_CALL(pg8::EpiF32<0>, pg8::StaticOrder, g, S, E); }
                { pg8::Gemm g{WSP(bf16, WS_XB), WSP(bf16, W_PG), T, D, D}; pg8::StaticOrder S; S.init(T, D, F.G, bx);
                  pg8::EpiF32<2> E{WSP(float, A_PRE), args.out, ALPHA};
                  GEMM_CALL(pg8::EpiF32<2>, pg8::StaticOrder, g, S, E); }
            } PH_END
            PH_BEGIN {
                pg8::Gemm g{WSP(bf16, A_H), WSP(bf16, W_F2D), T, D, DENSE_FF}; pg8::StaticOrder S; S.init(T, D, F.G, bx);
                pg8::EpiF32<3> E{WSP(float, A_PRE), nullptr, 0.f};
                GEMM_CALL(pg8::EpiF32<3>, pg8::StaticOrder, g, S, E);
            } PH_END
            PH_BEGIN { phase_ln<false, false>(F, INF(29) + L * D, INF(30) + L * D, nullptr, 0); if (L + 1 < DEPTH) phase_convert(F, L + 1); } PH_END
        } else {
            PH_BEGIN {
                phase_scatter(F, mj);
                { pg8::Gemm g{WSP(bf16, WS_PB), WSP(bf16, W_PP), T, D, PLE}; pg8::StaticOrder S; S.init(T, D, F.G, bx);
                  pg8::EpiF32<0> E{WSP(float, A_PRE), nullptr, 0.f};
                  GEMM_CALL(pg8::EpiF32<0>, pg8::StaticOrder, g, S, E); }
                { pg8::Gemm g{WSP(bf16, WS_XB), WSP(bf16, W_PG), T, D, D}; pg8::StaticOrder S; S.init(T, D, F.G, bx);
                  pg8::EpiF32<2> E{WSP(float, A_PRE), args.out, ALPHA};
                  GEMM_CALL(pg8::EpiF32<2>, pg8::StaticOrder, g, S, E); }
            } PH_END
            for (int ch = 0; ch < MOE_NCHUNK; ++ch) {
                PH_BEGIN {
                    MoeTiles mt; moe_tiles(F, mj, mt);
                    const int tlo = ch * MOE_CHUNK_TILES; int ntc = mt.total - tlo; ntc = ntc > MOE_CHUNK_TILES ? MOE_CHUNK_TILES : ntc;
                    if (ntc > 0) {
                        pg8::Gemm g{WSP(bf16, A_XG) + (size_t)tlo * 256 * D, WSP(bf16, W_F13), ntc * 256, 2 * EXPERT_FF, D};
                        pg8::GroupedOrder S; S.init(ntc * 256, 2 * EXPERT_FF, F.G, bx); S.tile_lo = tlo; S.estride = (size_t)2 * EXPERT_FF * D * 2;
                        S.pend0 = mt.pend[0]; S.pend1 = mt.pend[1]; S.pend2 = mt.pend[2]; S.pend3 = mt.pend[3]; S.pend4 = mt.pend[4]; S.pend5 = mt.pend[5]; S.pend6 = mt.pend[6]; S.pend7 = mt.pend[7];
                        pg8::EpiSwiGLU E{WSP(bf16, A_HG), EXPERT_FF};
                        GEMM_CALL(pg8::EpiSwiGLU, pg8::GroupedOrder, g, S, E);
                    }
                } PH_END
                PH_BEGIN {
                    MoeTiles mt; moe_tiles(F, mj, mt);
                    const int tlo = ch * MOE_CHUNK_TILES; int ntc = mt.total - tlo; ntc = ntc > MOE_CHUNK_TILES ? MOE_CHUNK_TILES : ntc;
                    if (ntc > 0) {
                        pg8::Gemm g{WSP(bf16, A_HG), WSP(bf16, W_F2E), ntc * 256, D, EXPERT_FF};
                        pg8::GroupedOrder S; S.init(ntc * 256, D, F.G, bx); S.tile_lo = tlo; S.estride = (size_t)D * EXPERT_FF * 2;
                        S.pend0 = mt.pend[0]; S.pend1 = mt.pend[1]; S.pend2 = mt.pend[2]; S.pend3 = mt.pend[3]; S.pend4 = mt.pend[4]; S.pend5 = mt.pend[5]; S.pend6 = mt.pend[6]; S.pend7 = mt.pend[7];
                        pg8::EpiBf16 E{WSP(bf16, A_YG) + (size_t)tlo * 256 * D, D};
                        GEMM_CALL(pg8::EpiBf16, pg8::GroupedOrder, g, S, E);
                    }
                } PH_END
            }
            PH_BEGIN { phase_ln<false, true>(F, INF(29) + L * D, INF(30) + L * D, nullptr, 0); if (L + 1 < DEPTH) phase_convert(F, L + 1); } PH_END
        }
    }
#undef PH_BEGIN
#undef PH_END
}

extern "C" void kernel_launch(void* const* d_in, const int* in_sizes, int n_in, void* d_out, int out_size, void* d_ws, size_t ws_size, hipStream_t stream) {
    static int grid = 0;
    if (grid == 0) {
        if (n_in != 31 || in_sizes[0] != T * D || out_size != T * D || ws_size < WS_END) { fprintf(stderr, "kernel_launch: unexpected shapes / workspace (n_in %d, ws %zu < %zu)\n", n_in, ws_size, (size_t)WS_END); grid = -1; return; }
        int dev = 0, cus = 0, per_cu = 0;
        if (hipGetDevice(&dev) != hipSuccess || hipDeviceGetAttribute(&cus, hipDeviceAttributeMultiprocessorCount, dev) != hipSuccess) { grid = -1; return; }
        if (hipFuncSetAttribute((const void*)mega_fwd, hipFuncAttributeMaxDynamicSharedMemorySize, LDS_BYTES) != hipSuccess) { fprintf(stderr, "kernel_launch: hipFuncSetAttribute failed\n"); grid = -1; return; }
        if (hipOccupancyMaxActiveBlocksPerMultiprocessor(&per_cu, (const void*)mega_fwd, NWAVES * 64, LDS_BYTES) != hipSuccess || per_cu < 1) { fprintf(stderr, "kernel_launch: occupancy query says %d\n", per_cu); (void)hipGetLastError(); grid = -1; return; }
        grid = cus;
    }
    if (grid < 0) return;
    if (hipMemsetAsync((char*)d_ws + WS_CTL, 0, CTL_ZERO_BYTES, stream) != hipSuccess) return;
    Args a{};
    for (int i = 0; i < 31; ++i) a.in[i] = d_in[i];
    a.out = (float*)d_out; a.ws = (unsigned char*)d_ws;
#if MK_PER_PHASE
    for (int p = 0; p < NPH_TOTAL; ++p) { a.ph_lo = p; a.ph_hi = p + 1; hipLaunchKernelGGL(mega_fwd, dim3(grid), dim3(NWAVES * 64), LDS_BYTES, stream, a); }
#else
    a.ph_lo = 0; a.ph_hi = NPH_TOTAL;
    hipLaunchKernelGGL(mega_fwd, dim3(grid), dim3(NWAVES * 64), LDS_BYTES, stream, a);
#endif
}
```

```cpp
#include <hip/hip_runtime.h>
#include <cstdio>
#include <cstdint>
#include <cmath>

#ifndef MK_PER_PHASE
#define MK_PER_PHASE 0
#endif

constexpr int BATCH = 8, SEQ = 4096, T = BATCH * SEQ, D = 1024, DEPTH = 4, PLE = 256;
constexpr int IN_COLS = 5792, NIN = 5888;
constexpr int QR = 384, KVR = 256, ROPE_D = 32;
constexpr int DENSE_FF = 2816, EXPERT_FF = 3584, NEXP = 8;
constexpr float LN_EPS = 1e-5f;
constexpr float LOG2E = 1.4426950408889634f;
constexpr int MOE_ROWS = 2 * T + NEXP * 256;
constexpr int MOE_CHUNK_TILES = 128;
constexpr int MOE_NCHUNK = 3;

#define GAS __attribute__((address_space(1)))
#define LAS __attribute__((address_space(3)))
typedef unsigned short bf16;
typedef unsigned v4u __attribute__((ext_vector_type(4)));
typedef unsigned v2u __attribute__((ext_vector_type(2)));
typedef float f32x4 __attribute__((ext_vector_type(4)));
typedef float f32x2 __attribute__((ext_vector_type(2)));
typedef float f32x16 __attribute__((ext_vector_type(16)));
typedef short bf16x8 __attribute__((ext_vector_type(8)));
typedef short s16x4 __attribute__((ext_vector_type(4)));
typedef __bf16 bf16x2_t __attribute__((ext_vector_type(2)));
typedef GAS unsigned gu32;
#define RLX_AGENT __ATOMIC_RELAXED, __HIP_MEMORY_SCOPE_AGENT
#define LDS_WAIT() asm volatile("s_waitcnt lgkmcnt(0)" ::: "memory")
#define VM_WAIT() asm volatile("s_waitcnt vmcnt(0)" ::: "memory")

__device__ __forceinline__ unsigned pk2(float lo, float hi) { f32x2 v = {lo, hi}; bf16x2_t b = __builtin_convertvector(v, bf16x2_t); return __builtin_bit_cast(unsigned, b); }
__device__ __forceinline__ float bflo(unsigned u) { return __uint_as_float(u << 16); }
__device__ __forceinline__ float bfhi(unsigned u) { return __uint_as_float(u & 0xffff0000u); }
__device__ __forceinline__ float sigmoidf_(float x) { return __builtin_amdgcn_rcpf(1.0f + __builtin_amdgcn_exp2f(-x * LOG2E)); }
__device__ __forceinline__ float wave_sum(float v) {
#pragma unroll
    for (int o = 1; o < 64; o <<= 1) v += __shfl_xor(v, o);
    return v;
}

namespace pg8 {
#define PG8_LAS __attribute__((address_space(3)))
typedef unsigned short bf16_t;
typedef unsigned u32x4 __attribute__((ext_vector_type(4)));
typedef unsigned u32x2 __attribute__((ext_vector_type(2)));
constexpr int BM = 256, BK = 64, HALF = 128, HTB = HALF * BK * 2  , STAGE_BYTES = 8 * HTB, NXCD = 8, WGM = 8;

__host__ __device__ __forceinline__ int lds_byte(int r, int c) { const int st = (r >> 4) * 2 + (c >> 5), rr = r & 15, cc = c & 31, ob = rr * 64 + cc * 2; return st * 1024 + (ob ^ (((ob >> 9) & 1) << 5)); }
__host__ __device__ __forceinline__ void stage_rc(int b, int& R, int& C) { const int st = b / 1024, sb = b % 1024, swz = sb ^ (((sb >> 9) & 1) << 5); R = (st >> 1) * 16 + swz / 64; C = (st & 1) * 32 + (swz % 64) / 2; }
__host__ __device__ __forceinline__ int perm32(int rho) { const int n = rho >> 4, i = rho & 15; return 8 * (i >> 2) + 4 * n + (i & 3); }

struct Unit { int pm, pn; };
struct Gemm { const bf16_t* A; const bf16_t* Bt; int M, N, K; };

struct StaticOrder {
    int nM, nN, nwg, G, c;
    __host__ __device__ void init(int M, int N, int G_, int c_) { nM = M / BM; nN = N / BM; nwg = nM * nN; G = G_; c = c_; }
    __host__ __device__ bool next(int i, Unit& u) const {
        const long L = (long)i * G + c; if (L >= nwg) return false;
        int wgid = (int)L; { const int q = nwg / NXCD, r = nwg % NXCD, xcd = wgid % NXCD, off = wgid / NXCD; wgid = (xcd < r ? xcd * (q + 1) : r * (q + 1) + (xcd - r) * q) + off; }
        const int nig = WGM * nN, gid = wgid / nig, fm = gid * WGM, gsz = (nM - fm) < WGM ? (nM - fm) : WGM;
        u.pm = fm + ((wgid % nig) % gsz); u.pn = (wgid % nig) / gsz; return true;
    }
    __device__ __forceinline__ size_t bofs(const Unit&) const { return 0; }
    __device__ __forceinline__ void a_ready(const Unit&) const {}
    __device__ __forceinline__ void done(const Unit&) const {}
};
struct GroupedOrder : StaticOrder {
    int tile_lo; int pend0, pend1, pend2, pend3, pend4, pend5, pend6, pend7; size_t estride;
    __device__ __forceinline__ size_t bofs(const Unit& u) const {
        const int t = u.pm + tile_lo;
        const int e = (t >= pend0) + (t >= pend1) + (t >= pend2) + (t >= pend3) + (t >= pend4) + (t >= pend5) + (t >= pend6);
        return (size_t)e * estride;
    }
};

typedef f32x4 Acc[2][2][4][2];

struct EpiL1 {
    static constexpr bool PERM = true, AFTER_DRAIN = false;
    bf16_t* QKV; bf16_t* Gt; float* CQ; const float* bgate; float qscale;
    __device__ __forceinline__ void operator()(const Acc& acc, const Unit& u, int wr, int wc, int fr, int fq) const {
        const int row0 = u.pm * BM + wr * 64 + fr; const int pn = u.pn;
        if (pn < 12) {
            bf16_t* base = QKV + (size_t)(pn >> 2) * ((size_t)T * 1024); const int col0 = (pn & 3) * 256 + wc * 32 + 8 * fq; const float sc = pn < 4 ? qscale : 1.f;
#pragma unroll
            for (int ai = 0; ai < 2; ++ai)
#pragma unroll
                for (int m = 0; m < 4; ++m) { bf16_t* rowp = base + (size_t)(row0 + ai * HALF + m * 16) * 1024 + col0;
#pragma unroll
                    for (int bj = 0; bj < 2; ++bj) { const f32x4 v0 = acc[ai][bj][m][0] * sc, v1 = acc[ai][bj][m][1] * sc;
                        u32x4 w; w.x = pk2(v0[0], v0[1]); w.y = pk2(v0[2], v0[3]); w.z = pk2(v1[0], v1[1]); w.w = pk2(v1[2], v1[3]);
                        *(u32x4*)(rowp + bj * HALF) = w; } }
        } else if (pn < 20) {
            const int col0 = (pn - 12) * 256 + wc * 32 + 8 * fq;
            f32x4 bv[2][2];
#pragma unroll
            for (int bj = 0; bj < 2; ++bj)
#pragma unroll
                for (int n = 0; n < 2; ++n) bv[bj][n] = *(const f32x4*)(bgate + col0 + bj * HALF + 4 * n);
#pragma unroll
            for (int ai = 0; ai < 2; ++ai)
#pragma unroll
                for (int m = 0; m < 4; ++m) { bf16_t* rowp = Gt + (size_t)(row0 + ai * HALF + m * 16) * 2048 + col0;
#pragma unroll
                    for (int bj = 0; bj < 2; ++bj) { const f32x4 v0 = acc[ai][bj][m][0] + bv[bj][0], v1 = acc[ai][bj][m][1] + bv[bj][1];
                        u32x4 w; w.x = pk2(sigmoidf_(v0[0]), sigmoidf_(v0[1])); w.y = pk2(sigmoidf_(v0[2]), sigmoidf_(v0[3])); w.z = pk2(sigmoidf_(v1[0]), sigmoidf_(v1[1])); w.w = pk2(sigmoidf_(v1[2]), sigmoidf_(v1[3]));
                        *(u32x4*)(rowp + bj * HALF) = w; } }
        } else {
            const int col0 = (pn - 20) * 256 + wc * 32 + 8 * fq;
#pragma unroll
            for (int ai = 0; ai < 2; ++ai)
#pragma unroll
                for (int m = 0; m < 4; ++m) { float* rowp = CQ + (size_t)(row0 + ai * HALF + m * 16) * 768 + col0;
#pragma unroll
                    for (int bj = 0; bj < 2; ++bj) { *(f32x4*)(rowp + bj * HALF) = acc[ai][bj][m][0]; *(f32x4*)(rowp + bj * HALF + 4) = acc[ai][bj][m][1]; } }
        }
    }
};
struct EpiRopeQ {
    static constexpr bool PERM = false, AFTER_DRAIN = false;
    bf16_t* O; const float* rope; float qscale;
    __device__ __forceinline__ void operator()(const Acc& acc, const Unit& u, int wr, int wc, int fr, int fq) const {
        const int row0 = u.pm * BM + wr * 64 + fr;
#pragma unroll
        for (int ai = 0; ai < 2; ++ai)
#pragma unroll
            for (int m = 0; m < 4; ++m) { const int row = row0 + ai * HALF + m * 16;
                const f32x4 cs0 = *(const f32x4*)(rope + (size_t)row * 32 + fq * 8), cs1 = *(const f32x4*)(rope + (size_t)row * 32 + fq * 8 + 4);
                const f32x4 cc = {cs0[0], cs0[2], cs1[0], cs1[2]}, ss = {cs0[1], cs0[3], cs1[1], cs1[3]};
#pragma unroll
                for (int bj = 0; bj < 2; ++bj) { const int colg = u.pn * BM + bj * HALF + wc * 32; const bool isr = ((colg >> 5) % 3) == 2;
                    const f32x4 x1 = acc[ai][bj][m][0], x2 = acc[ai][bj][m][1];
                    f32x4 o1 = x1, o2 = x2; if (isr) { o1 = x1 * cc - x2 * ss; o2 = x1 * ss + x2 * cc; }
                    o1 = o1 * qscale; o2 = o2 * qscale;
                    bf16_t* p = O + (size_t)row * 768 + colg + 4 * fq;
                    u32x2 w1; w1.x = pk2(o1[0], o1[1]); w1.y = pk2(o1[2], o1[3]); u32x2 w2; w2.x = pk2(o2[0], o2[1]); w2.y = pk2(o2[2], o2[3]);
                    *(u32x2*)p = w1; *(u32x2*)(p + 16) = w2; } }
    }
};
struct EpiBf16 {
    static constexpr bool PERM = true, AFTER_DRAIN = false;
    bf16_t* O; int ldc;
    __device__ __forceinline__ void operator()(const Acc& acc, const Unit& u, int wr, int wc, int fr, int fq) const {
        const int row0 = u.pm * BM + wr * 64 + fr, col0 = u.pn * BM + wc * 32 + 8 * fq;
#pragma unroll
        for (int ai = 0; ai < 2; ++ai)
#pragma unroll
            for (int m = 0; m < 4; ++m) { bf16_t* rowp = O + (size_t)(row0 + ai * HALF + m * 16) * ldc + col0;
#pragma unroll
                for (int bj = 0; bj < 2; ++bj) { const f32x4 v0 = acc[ai][bj][m][0], v1 = acc[ai][bj][m][1];
                    u32x4 w; w.x = pk2(v0[0], v0[1]); w.y = pk2(v0[2], v0[3]); w.z = pk2(v1[0], v1[1]); w.w = pk2(v1[2], v1[3]);
                    *(u32x4*)(rowp + bj * HALF) = w; } }
    }
};
template <bool ADD> struct EpiGate {
    static constexpr bool PERM = true, AFTER_DRAIN = false;
    bf16_t* O; const bf16_t* Gt; const bf16_t* MT; int goff;
    __device__ __forceinline__ void operator()(const Acc& acc, const Unit& u, int wr, int wc, int fr, int fq) const {
        const int row0 = u.pm * BM + wr * 64 + fr, col0 = u.pn * BM + wc * 32 + 8 * fq;
#pragma unroll
        for (int ai = 0; ai < 2; ++ai)
#pragma unroll
            for (int m = 0; m < 4; ++m) { const size_t row = (size_t)(row0 + ai * HALF + m * 16);
#pragma unroll
                for (int bj = 0; bj < 2; ++bj) { const int col = col0 + bj * HALF;
                    const u32x4 gv = *(const u32x4*)(Gt + row * 2048 + goff + col);
                    f32x4 v0 = acc[ai][bj][m][0], v1 = acc[ai][bj][m][1];
                    v0[0] *= bflo(gv.x); v0[1] *= bfhi(gv.x); v0[2] *= bflo(gv.y); v0[3] *= bfhi(gv.y); v1[0] *= bflo(gv.z); v1[1] *= bfhi(gv.z); v1[2] *= bflo(gv.w); v1[3] *= bfhi(gv.w);
                    if (ADD) { const u32x4 mv = *(const u32x4*)(MT + row * 1024 + col);
                        v0[0] += bflo(mv.x); v0[1] += bfhi(mv.x); v0[2] += bflo(mv.y); v0[3] += bfhi(mv.y); v1[0] += bflo(mv.z); v1[1] += bfhi(mv.z); v1[2] += bflo(mv.w); v1[3] += bfhi(mv.w); }
                    u32x4 w; w.x = pk2(v0[0], v0[1]); w.y = pk2(v0[2], v0[3]); w.z = pk2(v1[0], v1[1]); w.w = pk2(v1[2], v1[3]);
                    *(u32x4*)(O + row * 1024 + col) = w; } }
    }
};
template <int MODE> struct EpiF32 {
    static constexpr bool PERM = false, AFTER_DRAIN = false;
    float* P; const float* X; float alpha;
    __device__ __forceinline__ void operator()(const Acc& acc, const Unit& u, int wr, int wc, int fr, int fq) const {
        const int row0 = u.pm * BM + wr * 64 + fr, col0 = u.pn * BM + wc * 32 + 4 * fq;
#pragma unroll
        for (int ai = 0; ai < 2; ++ai)
#pragma unroll
            for (int m = 0; m < 4; ++m) { const size_t off = (size_t)(row0 + ai * HALF + m * 16) * 1024 + col0;
#pragma unroll
                for (int bj = 0; bj < 2; ++bj)
#pragma unroll
                    for (int n = 0; n < 2; ++n) { const size_t o = off + bj * HALF + n * 16; const f32x4 a = acc[ai][bj][m][n]; f32x4 r;
                        if (MODE == 0) r = a;
                        else if (MODE == 1) r = *(const f32x4*)(X + o) * alpha + a;
                        else if (MODE == 2) { const f32x4 pv = *(const f32x4*)(P + o); const f32x4 xv = *(const f32x4*)(X + o);
                            r[0] = xv[0] * alpha + sigmoidf_(a[0]) * pv[0]; r[1] = xv[1] * alpha + sigmoidf_(a[1]) * pv[1]; r[2] = xv[2] * alpha + sigmoidf_(a[2]) * pv[2]; r[3] = xv[3] * alpha + sigmoidf_(a[3]) * pv[3]; }
                        else r = *(const f32x4*)(P + o) + a;
                        *(f32x4*)(P + o) = r; } }
    }
};
struct EpiSwiGLU {
    static constexpr bool PERM = true, AFTER_DRAIN = false;
    bf16_t* H; int ldc;
    __device__ __forceinline__ void operator()(const Acc& acc, const Unit& u, int wr, int wc, int fr, int fq) const {
        const int row0 = u.pm * BM + wr * 64 + fr, col0 = (u.pn * BM + wc * 32 + 8 * fq) >> 1;
#pragma unroll
        for (int ai = 0; ai < 2; ++ai)
#pragma unroll
            for (int m = 0; m < 4; ++m) { bf16_t* rowp = H + (size_t)(row0 + ai * HALF + m * 16) * ldc + col0;
#pragma unroll
                for (int bj = 0; bj < 2; ++bj) { const f32x4 v0 = acc[ai][bj][m][0], v1 = acc[ai][bj][m][1];
                    const float h0 = v0[0] * sigmoidf_(v0[0]) * v0[1], h1 = v0[2] * sigmoidf_(v0[2]) * v0[3], h2 = v1[0] * sigmoidf_(v1[0]) * v1[1], h3 = v1[2] * sigmoidf_(v1[2]) * v1[3];
                    u32x2 w; w.x = pk2(h0, h1); w.y = pk2(h2, h3);
                    *(u32x2*)(rowp + bj * (HALF / 2)) = w; } }
    }
};

template <class Epi, class Sched, bool ALIGN_EPI = false, bool SP2 = false>
__device__ __forceinline__ void gemm_phase(PG8_LAS unsigned char* lds, const Gemm g, const Sched& S, const Epi& E) {
    int tid_ = threadIdx.x; asm volatile("" : "+v"(tid_));
    const int tid = tid_, wid = __builtin_amdgcn_readfirstlane(tid >> 6), lane = tid & 63, wr = wid >> 2, wc = wid & 3, fr = lane & 15, fq = lane >> 4;
    int K_ = g.K; asm volatile("" : "+s"(K_)); const int K = K_, nt = K / BK;
    unsigned voffA[2], voffB[2];
#pragma unroll
    for (int i = 0; i < 2; ++i) { int R, C; stage_rc(tid * 16 + i * 8192, R, C); const int Rb = Epi::PERM ? ((R & ~31) + perm32(R & 31)) : R;
        voffA[i] = (unsigned)(R * K + C) * 2u; voffB[i] = (unsigned)(Rb * K + C) * 2u; }
    const size_t kstep = (size_t)(BK * 2);
    const size_t hstep = (size_t)HALF * K * 2;
    const size_t tstep = 2 * hstep;
    const unsigned ldsw = (unsigned)wid * 1024u;
    const int aoff = lds_byte(wr * 64 + fr, fq * 8), boff = lds_byte(wc * 32 + fr, fq * 8);
#define PG8_SA(b, h) (((b) * 2 + (h)) * HTB)
#define PG8_SB(b, h) ((4 + (b) * 2 + (h)) * HTB)
#define PG8_STAGE(bufoff, gbase, voff) do { _Pragma("unroll") for (int _i = 0; _i < 2; ++_i) \
        __builtin_amdgcn_global_load_lds((const unsigned*)((const char*)(gbase) + (voff)[_i]), (PG8_LAS unsigned*)(lds + (bufoff) + ldsw + _i * 8192), 16, 0, 0); } while (0)
#define PG8_LDA(dst, b, h) do { _Pragma("unroll") for (int m = 0; m < 4; ++m) _Pragma("unroll") for (int k = 0; k < 2; ++k) dst[m][k] = *(const PG8_LAS bf16x8*)(lds + PG8_SA(b, h) + aoff + m * 2048 + k * 1024); } while (0)
#define PG8_LDB(dst, b, h) do { _Pragma("unroll") for (int n = 0; n < 2; ++n) _Pragma("unroll") for (int k = 0; k < 2; ++k) dst[n][k] = *(const PG8_LAS bf16x8*)(lds + PG8_SB(b, h) + boff + n * 2048 + k * 1024); } while (0)
#define PG8_MMA(ai, bj, At, Bt) do { __builtin_amdgcn_s_setprio(1); _Pragma("unroll") for (int m = 0; m < 4; ++m) _Pragma("unroll") for (int n = 0; n < 2; ++n) _Pragma("unroll") for (int k = 0; k < 2; ++k) \
        acc[ai][bj][m][n] = __builtin_amdgcn_mfma_f32_16x16x32_bf16(Bt[n][k], At[m][k], acc[ai][bj][m][n], 0, 0, 0); __builtin_amdgcn_s_setprio(0); } while (0)
#define PG8_WAIT_V(n) asm volatile("s_waitcnt vmcnt(" #n ")" ::: "memory")
#define PG8_WAIT_L(n) asm volatile("s_waitcnt lgkmcnt(" #n ")" ::: "memory")
#define PG8_BAR __builtin_amdgcn_s_barrier()
#define PG8_SCHED __builtin_amdgcn_sched_barrier(0)
    Unit cur, nxt; int ui = 0;
    if (!S.next(0, cur)) return;
    f32x4 acc[2][2][4][2];
#pragma unroll
    for (int a = 0; a < 2; ++a)
#pragma unroll
        for (int b = 0; b < 2; ++b)
#pragma unroll
            for (int m = 0; m < 4; ++m)
#pragma unroll
                for (int n = 0; n < 2; ++n) acc[a][b][m][n] = (f32x4){0.f, 0.f, 0.f, 0.f};
    bf16x8 At[4][2], B0[2][2], B1[2][2];
    const char* cA = (const char*)g.A + (size_t)cur.pm * tstep; const char* cB = (const char*)g.Bt + (size_t)cur.pn * tstep + S.bofs(cur);
    S.a_ready(cur);
    if constexpr (SP2) {
        PG8_STAGE(PG8_SB(0, 0), cB, voffB); PG8_STAGE(PG8_SB(0, 1), cB + hstep, voffB); PG8_STAGE(PG8_SA(0, 0), cA, voffA); PG8_STAGE(PG8_SA(0, 1), cA + hstep, voffA);
        if (wr == 1) PG8_BAR;
        PG8_WAIT_V(2); PG8_BAR;
        PG8_STAGE(PG8_SB(1, 0), cB + kstep, voffB); PG8_STAGE(PG8_SA(1, 0), cA + kstep, voffA); PG8_STAGE(PG8_SB(1, 1), cB + hstep + kstep, voffB);
        PG8_WAIT_V(6); PG8_BAR;
    } else {
        PG8_STAGE(PG8_SB(0, 0), cB, voffB); PG8_STAGE(PG8_SA(0, 0), cA, voffA); PG8_STAGE(PG8_SB(0, 1), cB + hstep, voffB); PG8_STAGE(PG8_SA(0, 1), cA + hstep, voffA);
        if (wr == 1) PG8_BAR;
        PG8_WAIT_V(4); PG8_BAR;
        PG8_STAGE(PG8_SB(1, 0), cB + kstep, voffB); PG8_STAGE(PG8_SA(1, 0), cA + kstep, voffA); PG8_STAGE(PG8_SB(1, 1), cB + hstep + kstep, voffB);
        PG8_WAIT_V(6); PG8_BAR;
    }
    for (;;) {
        const bool has_next = S.next(ui + 1, nxt);
        const char* nA = has_next ? (const char*)g.A + (size_t)nxt.pm * tstep : cA; const char* nB = has_next ? (const char*)g.Bt + (size_t)nxt.pn * tstep + S.bofs(nxt) : cB;
#pragma nounroll
        for (int t = 0; t < nt; t += 2) {
            const bool last = (t == nt - 2);
            const char* a1 = cA + (size_t)(t + 1) * kstep;
            const char* a2 = last ? nA : cA + (size_t)(t + 2) * kstep; const char* b2 = last ? nB : cB + (size_t)(t + 2) * kstep;
            const char* a3 = a2 + kstep; const char* b3 = b2 + kstep;
            if (last && has_next) S.a_ready(nxt);
            if constexpr (SP2) {
            PG8_LDB(B0, 0, 0); PG8_LDB(B1, 0, 1); PG8_SCHED; PG8_LDA(At, 0, 0); PG8_STAGE(PG8_SA(1, 1), a1 + hstep, voffA);
            PG8_WAIT_V(8); PG8_WAIT_L(0); PG8_BAR; PG8_MMA(0, 0, At, B0); PG8_MMA(0, 1, At, B1); PG8_BAR; PG8_SCHED;
            PG8_LDA(At, 0, 1); PG8_STAGE(PG8_SB(0, 0), b2, voffB); PG8_STAGE(PG8_SB(0, 1), b2 + hstep, voffB); PG8_STAGE(PG8_SA(0, 0), a2, voffA);
            PG8_WAIT_V(8); PG8_WAIT_L(0); PG8_BAR; PG8_MMA(1, 0, At, B0); PG8_MMA(1, 1, At, B1); PG8_BAR; PG8_SCHED;
            PG8_LDB(B0, 1, 0); PG8_LDB(B1, 1, 1); PG8_SCHED; PG8_LDA(At, 1, 0); PG8_STAGE(PG8_SA(0, 1), a2 + hstep, voffA);
            PG8_WAIT_V(8); PG8_WAIT_L(0); PG8_BAR; PG8_MMA(0, 0, At, B0); PG8_MMA(0, 1, At, B1); PG8_BAR; PG8_SCHED;
            PG8_LDA(At, 1, 1); PG8_STAGE(PG8_SB(1, 0), b3, voffB); PG8_STAGE(PG8_SB(1, 1), b3 + hstep, voffB); PG8_STAGE(PG8_SA(1, 0), a3, voffA);
            PG8_WAIT_V(8); PG8_WAIT_L(0); PG8_BAR; PG8_MMA(1, 0, At, B0); PG8_MMA(1, 1, At, B1); PG8_BAR; PG8_SCHED;
            } else {
            PG8_LDB(B0, 0, 0); PG8_SCHED; PG8_LDA(At, 0, 0); PG8_STAGE(PG8_SA(1, 1), a1 + hstep, voffA);
            PG8_WAIT_L(8); PG8_BAR; PG8_WAIT_L(0); PG8_MMA(0, 0, At, B0); PG8_BAR; PG8_SCHED;
            PG8_LDB(B1, 0, 1); PG8_STAGE(PG8_SB(0, 0), b2, voffB);
            PG8_BAR; PG8_WAIT_L(0); PG8_MMA(0, 1, At, B1); PG8_BAR;
            PG8_LDA(At, 0, 1); PG8_STAGE(PG8_SA(0, 0), a2, voffA);
            PG8_BAR; PG8_WAIT_L(0); PG8_MMA(1, 0, At, B0); PG8_BAR; PG8_SCHED;
            PG8_STAGE(PG8_SB(0, 1), b2 + hstep, voffB);
            PG8_WAIT_V(6); PG8_BAR; PG8_MMA(1, 1, At, B1); PG8_BAR;
            PG8_LDB(B0, 1, 0); PG8_SCHED; PG8_LDA(At, 1, 0); PG8_STAGE(PG8_SA(0, 1), a2 + hstep, voffA);
            PG8_WAIT_L(8); PG8_BAR; PG8_WAIT_L(0); PG8_MMA(0, 0, At, B0); PG8_BAR; PG8_SCHED;
            PG8_LDB(B1, 1, 1); PG8_STAGE(PG8_SB(1, 0), b3, voffB);
            PG8_BAR; PG8_WAIT_L(0); PG8_MMA(0, 1, At, B1); PG8_BAR;
            PG8_LDA(At, 1, 1); PG8_STAGE(PG8_SA(1, 0), a3, voffA);
            PG8_BAR; PG8_WAIT_L(0); PG8_MMA(1, 0, At, B0); PG8_BAR; PG8_SCHED;
            PG8_STAGE(PG8_SB(1, 1), b3 + hstep, voffB);
            PG8_WAIT_V(6); PG8_BAR; PG8_MMA(1, 1, At, B1); PG8_BAR;
            }
        }
        if constexpr (ALIGN_EPI) { if (wr == 0) PG8_BAR; }
        if constexpr (!Epi::AFTER_DRAIN) { E(acc, cur, wr, wc, fr, fq); S.done(cur); }
        if (!has_next) break;
#pragma unroll
        for (int a = 0; a < 2; ++a)
#pragma unroll
            for (int b = 0; b < 2; ++b)
#pragma unroll
                for (int m = 0; m < 4; ++m)
#pragma unroll
                    for (int n = 0; n < 2; ++n) acc[a][b][m][n] = (f32x4){0.f, 0.f, 0.f, 0.f};
        cur = nxt; cA = nA; cB = nB; ++ui;
        if constexpr (ALIGN_EPI) { if (wr == 1) PG8_BAR; }
    }
    PG8_WAIT_V(0);
    if constexpr (!ALIGN_EPI) { if (wr == 0) PG8_BAR; }
    PG8_BAR;
    if constexpr (Epi::AFTER_DRAIN) { E.fused(acc, cur, wr, wc, fr, fq, lds, wid, lane); S.done(cur); }
#undef PG8_SA
#undef PG8_SB
#undef PG8_STAGE
#undef PG8_LDA
#undef PG8_LDB
#undef PG8_MMA
#undef PG8_WAIT_V
#undef PG8_WAIT_L
#undef PG8_BAR
#undef PG8_SCHED
}
}

namespace att {
#define MFMA32(a, b, c) __builtin_amdgcn_mfma_f32_32x32x16_bf16((a), (b), (c), 0, 0, 0)
typedef short v4i16_t __attribute__((ext_vector_type(4)));
struct AttnP {
    const bf16* Q; int ldq;
    const bf16* K1; int ldk1;
    const bf16* K2; int ldk2;
    const bf16* V; int ldv;
    bf16* O; int ldo;
    const int* pos;
    const int* blkmax;
    const float* lut;
};
__device__ __forceinline__ s16x4 vtr(const LAS unsigned char* p) { return __builtin_bit_cast(s16x4, __builtin_amdgcn_ds_read_tr16_b64_v4i16((LAS v4i16_t*)p)); }

template <int DQK, int KSPLIT, int DV, bool BIAS>
__device__ __forceinline__ void attn_unit(const AttnP& P, int b, int qt, int qcol, int kcol, int vcol, int ocol, int hb, LAS unsigned char* lds) {
    constexpr int KROWB = DQK * 2 + 16;
    constexpr int VROWB = (DV == 128) ? 320 : 192;
    constexpr int KBYTES = 64 * KROWB, VBYTES = 64 * VROWB, STAGE = KBYTES + VBYTES + 256, LUT_OFF = 2 * STAGE;
    constexpr int ND = DQK / 16, NDB = DV / 32, KCH = DQK / 8, VCH = DV / 8, NKC = 64 * KCH, NVC = 64 * VCH, KL = (NKC + 511) / 512, VL = (NVC + 511) / 512;
    int tid_ = threadIdx.x; asm volatile("" : "+v"(tid_));
    const int tid = tid_, lane = tid & 63, wid = __builtin_amdgcn_readfirstlane(tid >> 6), r = lane & 31, h = lane >> 5;
    const long tok0 = (long)b * SEQ; const int q0 = qt * 256; const int qrow = q0 + wid * 32 + r;
    bf16x8 qf[ND];
    { const bf16* qp = P.Q + (tok0 + qrow) * (long)P.ldq + qcol + 8 * h;
#pragma unroll
      for (int d = 0; d < ND; ++d) qf[d] = *(const bf16x8*)(qp + 16 * d); }
    int posq = 0, posq_min = 0;
    LAS float* lut = (LAS float*)(lds + LUT_OFF);
    if (BIAS) { posq = P.pos[tok0 + qrow]; int mn = posq;
#pragma unroll
        for (int o = 1; o < 64; o <<= 1) { const int t2 = __shfl_xor(mn, o); mn = t2 < mn ? t2 : mn; }
        posq_min = mn;
        if (tid < 132) lut[tid] = P.lut[hb * 132 + tid]; }
    v4u kreg[KL], vreg[VL]; int preg = 0;
#define ATT_ISSUE(t) do { const long trow = tok0 + 64 * (long)(t); \
        _Pragma("unroll") for (int i = 0; i < KL; ++i) { const int c = tid + 512 * i; if (c < NKC) { const int row = c / KCH, col = (c % KCH) * 8; \
            const bf16* src = (col < KSPLIT) ? P.K1 + (trow + row) * (long)P.ldk1 + kcol + col : P.K2 + (trow + row) * (long)P.ldk2 + (col - KSPLIT); kreg[i] = *(const v4u*)src; } } \
        _Pragma("unroll") for (int i = 0; i < VL; ++i) { const int c = tid + 512 * i; if (c < NVC) { const int row = c / VCH, col = (c % VCH) * 8; vreg[i] = *(const v4u*)(P.V + (trow + row) * (long)P.ldv + vcol + col); } } \
        if (BIAS && tid < 64) preg = P.pos[trow + tid]; } while (0)
#define ATT_WRITE(t) do { LAS unsigned char* sb = lds + ((t) & 1) * STAGE; \
        _Pragma("unroll") for (int i = 0; i < KL; ++i) { const int c = tid + 512 * i; if (c < NKC) { const int row = c / KCH, cc = c % KCH; *(LAS v4u*)(sb + row * KROWB + cc * 16) = kreg[i]; } } \
        _Pragma("unroll") for (int i = 0; i < VL; ++i) { const int c = tid + 512 * i; if (c < NVC) { const int row = c / VCH, cc = c % VCH; *(LAS v4u*)(sb + KBYTES + row * VROWB + cc * 16) = vreg[i]; } } \
        if (BIAS && tid < 64) *(LAS int*)(sb + KBYTES + VBYTES + 4 * tid) = preg; } while (0)
    f32x16 o[NDB];
#pragma unroll
    for (int i = 0; i < NDB; ++i)
#pragma unroll
        for (int j = 0; j < 16; ++j) o[i][j] = 0.f;
    float m_run = -INFINITY, l_run = 0.f;
    const int ntiles = (q0 + 256) / 64, my_last = (q0 + wid * 32 + 31) / 64;
    ATT_ISSUE(0); ATT_WRITE(0); __syncthreads();
    const int kbase = r * KROWB + 16 * h;
    const int vbase = KBYTES + (4 * h + ((lane & 15) >> 2)) * VROWB + (((lane >> 4) & 1) * 16 + (lane & 3) * 4) * 2;
    for (int t = 0; t < ntiles; ++t) {
        const bool more = (t + 1 < ntiles);
        if (more) ATT_ISSUE(t + 1);
        if (t <= my_last) {
            const LAS unsigned char* sb = lds + (t & 1) * STAGE;
            bool plain = (64 * t + 63 <= q0 + wid * 32);
            float cinit = 0.f;
            if (BIAS) { const int kmax = P.blkmax[(int)(tok0 >> 6) + t]; if (plain && (posq_min - kmax >= 113)) cinit = lut[128]; else plain = false; }
            f32x16 x0, x1;
#pragma unroll
            for (int j = 0; j < 16; ++j) { x0[j] = cinit; x1[j] = cinit; }
#pragma unroll
            for (int d = 0; d < ND; ++d) {
                const bf16x8 k0 = *(const LAS bf16x8*)(sb + kbase + d * 32), k1 = *(const LAS bf16x8*)(sb + kbase + 32 * KROWB + d * 32);
                x0 = MFMA32(k0, qf[d], x0); x1 = MFMA32(k1, qf[d], x1);
            }
            if (!plain) {
#pragma unroll
                for (int g = 0; g < 4; ++g) {
                    int pk0[4] = {0, 0, 0, 0}, pk1[4] = {0, 0, 0, 0};
                    if (BIAS) { const LAS int* pp = (const LAS int*)(sb + KBYTES + VBYTES) + 8 * g + 4 * h;
                        const v4u a = *(const LAS v4u*)pp, c = *(const LAS v4u*)(pp + 32);
                        pk0[0] = a.x; pk0[1] = a.y; pk0[2] = a.z; pk0[3] = a.w; pk1[0] = c.x; pk1[1] = c.y; pk1[2] = c.z; pk1[3] = c.w; }
#pragma unroll
                    for (int j = 0; j < 4; ++j) { const int i = 4 * g + j; const int kidx = 64 * t + 8 * g + 4 * h + j;
                        float v0 = x0[i], v1 = x1[i];
                        if (BIAS) { int n0 = posq - pk0[j]; n0 = n0 < 0 ? 0 : (n0 > 128 ? 128 : n0); int n1 = posq - pk1[j]; n1 = n1 < 0 ? 0 : (n1 > 128 ? 128 : n1); v0 += lut[n0]; v1 += lut[n1]; }
                        if (kidx > qrow) v0 = -INFINITY; if (kidx + 32 > qrow) v1 = -INFINITY;
                        x0[i] = v0; x1[i] = v1; }
                }
            }
            float mx = x0[0];
#pragma unroll
            for (int j = 1; j < 16; ++j) mx = fmaxf(mx, x0[j]);
#pragma unroll
            for (int j = 0; j < 16; ++j) mx = fmaxf(mx, x1[j]);
            mx = fmaxf(mx, __shfl_xor(mx, 32));
            const float mn = fmaxf(m_run, mx), alpha = __builtin_amdgcn_exp2f(m_run - mn); m_run = mn;
            float ls = 0.f;
#pragma unroll
            for (int j = 0; j < 16; ++j) { x0[j] = __builtin_amdgcn_exp2f(x0[j] - mn); x1[j] = __builtin_amdgcn_exp2f(x1[j] - mn); ls += x0[j] + x1[j]; }
            l_run = l_run * alpha + ls;
#pragma unroll
            for (int i = 0; i < NDB; ++i) o[i] = o[i] * alpha;
            bf16x8 pf[4];
            { v4u w;
              w.x = pk2(x0[0], x0[1]); w.y = pk2(x0[2], x0[3]); w.z = pk2(x0[4], x0[5]); w.w = pk2(x0[6], x0[7]); pf[0] = __builtin_bit_cast(bf16x8, w);
              w.x = pk2(x0[8], x0[9]); w.y = pk2(x0[10], x0[11]); w.z = pk2(x0[12], x0[13]); w.w = pk2(x0[14], x0[15]); pf[1] = __builtin_bit_cast(bf16x8, w);
              w.x = pk2(x1[0], x1[1]); w.y = pk2(x1[2], x1[3]); w.z = pk2(x1[4], x1[5]); w.w = pk2(x1[6], x1[7]); pf[2] = __builtin_bit_cast(bf16x8, w);
              w.x = pk2(x1[8], x1[9]); w.y = pk2(x1[10], x1[11]); w.z = pk2(x1[12], x1[13]); w.w = pk2(x1[14], x1[15]); pf[3] = __builtin_bit_cast(bf16x8, w); }
#pragma unroll
            for (int db = 0; db < NDB; ++db)
#pragma unroll
                for (int s = 0; s < 4; ++s) {
                    const s16x4 lo = vtr(sb + vbase + (16 * s) * VROWB + 64 * db), hi = vtr(sb + vbase + (16 * s + 8) * VROWB + 64 * db);
                    const bf16x8 vf = __builtin_shufflevector(lo, hi, 0, 1, 2, 3, 4, 5, 6, 7);
                    o[db] = MFMA32(vf, pf[s], o[db]);
                }
        }
        if (more) ATT_WRITE(t + 1);
        __syncthreads();
    }
#undef ATT_ISSUE
#undef ATT_WRITE
    const float lt = l_run + __shfl_xor(l_run, 32), inv = 1.0f / lt;
    bf16* op = P.O + (tok0 + qrow) * (long)P.ldo + ocol + 4 * h;
#pragma unroll
    for (int db = 0; db < NDB; ++db)
#pragma unroll
        for (int g = 0; g < 4; ++g) { v2u w; w.x = pk2(o[db][4 * g] * inv, o[db][4 * g + 1] * inv); w.y = pk2(o[db][4 * g + 2] * inv, o[db][4 * g + 3] * inv);
            *(v2u*)(op + 32 * db + 8 * g) = w; }
}
#undef MFMA32
}

constexpr size_t MiB = 1u << 20;
constexpr size_t WS_CTL = 0, CTL_ZERO_BYTES = 1 * MiB;
constexpr size_t WS_ROPE = 1 * MiB;
constexpr size_t WS_MISC = 5 * MiB;
constexpr size_t WS_XB = 6 * MiB;
constexpr size_t WS_PB = 70 * MiB;
constexpr size_t WS_W = 86 * MiB;
constexpr size_t W_IN = WS_W, W_UQ = WS_W + 12 * MiB, W_UKV = WS_W + 13 * MiB, W_BD = WS_W + 14 * MiB, W_BM = WS_W + 16 * MiB, W_OUT = WS_W + 17 * MiB,
                 W_PG = WS_W + 19 * MiB, W_PP = WS_W + 21 * MiB, W_F13 = WS_W + 22 * MiB, W_F2D = WS_W + 33 * MiB, W_F2E = WS_W + 134 * MiB;
constexpr size_t WS_ACT = 276 * MiB;
constexpr size_t A_DQ = WS_ACT, A_DK = WS_ACT + 64 * MiB, A_DV = WS_ACT + 128 * MiB, A_G = WS_ACT + 192 * MiB, A_C = WS_ACT + 320 * MiB;
constexpr size_t A_OA = A_DQ, A_MT = A_DK, A_M = A_DV, A_CQ = A_C, A_OA2 = A_C, A_PRE = A_C;
constexpr size_t A_CQN = WS_ACT + 448 * MiB, A_CKVN = WS_ACT + 472 * MiB, A_OB = A_CQN, A_MKR = WS_ACT + 488 * MiB, A_MQ = WS_ACT + 490 * MiB, A_MKV = WS_ACT + 538 * MiB;
constexpr size_t A_H = WS_ACT;
constexpr size_t A_XG = WS_ACT, A_YG = WS_ACT + 132 * MiB, A_TOK = WS_ACT + 264 * MiB, A_HG = WS_ACT + 448 * MiB;
constexpr size_t WS_END = WS_ACT + 672 * MiB;
constexpr int CW_BAR = 4096, CW_MOE = 8192;

constexpr int RING_BYTES = 131072, MISC_OFF = RING_BYTES + 320, LDS_BYTES = 147456;
constexpr int NWAVES = 8;

#ifndef REP_ATTN_D
#define REP_ATTN_D 1
#endif
#ifndef REP_ATTN_M
#define REP_ATTN_M 1
#endif
#ifndef REP_CONV
#define REP_CONV 1
#endif
#ifndef REP_L1
#define REP_L1 1
#endif
#ifndef REP_EW
#define REP_EW 1
#endif
#ifndef REP_BAR
#define REP_BAR 1
#endif
#ifndef REP_LN
#define REP_LN 1
#endif
#ifndef REP_MOE
#define REP_MOE 1
#endif
#ifndef REP_MIX
#define REP_MIX 1
#endif
#ifndef REP_FFN
#define REP_FFN 1
#endif
#ifndef REP_P0
#define REP_P0 1
#endif
#ifndef REP_PPE
#define REP_PPE 1
#endif
#define XB_TMO      128
#define XB_XCNT(j)  (256  + 64 * (j))
#define XB_XSUB(j)  (1280 + 64 * (j))
#define XB_XGEN(j)  (2304 + 64 * (j))
#define XB_TOP      3328
#define XB_TOPGEN   3392
#define XCD_BAR_WORDS 3456
#define XB_SPIN_CAP (1u << 18)

__device__ __forceinline__ unsigned xb_ld(unsigned* p)              { return __hip_atomic_load(p, __ATOMIC_RELAXED, __HIP_MEMORY_SCOPE_AGENT); }
__device__ __forceinline__ unsigned xb_add(unsigned* p, unsigned v) { return __hip_atomic_fetch_add(p, v, __ATOMIC_RELAXED, __HIP_MEMORY_SCOPE_AGENT); }
__device__ __forceinline__ unsigned xb_xcc_id() { return (unsigned)__builtin_amdgcn_s_getreg((3 << 11) | 20) & 0xFu; }
#define XB_SPIN(cond, bar) do { unsigned _sp = 0; while (cond) { __builtin_amdgcn_s_sleep(1); \
    if ((++_sp & 255u) == 0u) { if (xb_ld(&(bar)[XB_TMO])) break; if (_sp > XB_SPIN_CAP) { atomicAdd(&(bar)[XB_TMO], 1u); break; } } } } while (0)

struct XcdBarrier {
    unsigned* bar; unsigned x;
    volatile LAS unsigned* st;
};

__device__ __forceinline__ XcdBarrier xcd_barrier_post(unsigned* bar, volatile LAS unsigned* st) {
    XcdBarrier b; b.bar = bar; b.x = xb_xcc_id(); b.st = st;
    if (threadIdx.x == 0) (void)xb_add(&bar[XB_XCNT(b.x)], 1u);
    return b;
}
__device__ __forceinline__ void xcd_barrier_complete(unsigned* bar, unsigned x, unsigned& nloc, unsigned& nx) {
    const unsigned G = gridDim.x * gridDim.y * gridDim.z;
    unsigned sum, cnt, mine, sp = 0u;
    for (;;) {
        sum = 0u; cnt = 0u; mine = 0u;
#pragma unroll
        for (unsigned j = 0; j < 16; ++j) { const unsigned c = xb_ld(&bar[XB_XCNT(j)]); sum += c; cnt += (c > 0u) ? 1u : 0u; mine = (j == x) ? c : mine; }
        if (sum == G) break;
        __builtin_amdgcn_s_sleep(1);
        if ((++sp & 255u) == 0u) { if (xb_ld(&bar[XB_TMO])) break; if (sp > XB_SPIN_CAP) { atomicAdd(&bar[XB_TMO], 1u); break; } }
    }
    nloc = mine > 0u ? mine : 1u; nx = cnt > 0u ? cnt : 1u;
}

__device__ __forceinline__ void xcd_barrier(const XcdBarrier& b) {
    asm volatile("s_waitcnt vmcnt(0)" ::: "memory");
    __syncthreads();
    if (threadIdx.x == 0) {
        unsigned* bar = b.bar;
        __builtin_amdgcn_s_waitcnt(0);
        unsigned nloc = b.st[0], nx = b.st[1];
        if (nloc == 0u) { xcd_barrier_complete(bar, b.x, nloc, nx); b.st[0] = nloc; b.st[1] = nx; }
        const unsigned old = xb_add(&bar[XB_XSUB(b.x)], 1u);
        const unsigned gen = old / nloc;
        if (old + 1u == (gen + 1u) * nloc) {
            __builtin_amdgcn_fence(__ATOMIC_RELEASE, "agent");
            asm volatile("s_waitcnt vmcnt(0)" ::: "memory");
            const unsigned og = xb_add(&bar[XB_TOP], 1u);
            const unsigned tg = og / nx;
            if (og + 1u == (tg + 1u) * nx) xb_add(&bar[XB_TOPGEN], 1u);
            else XB_SPIN(xb_ld(&bar[XB_TOPGEN]) == tg, bar);
            __builtin_amdgcn_fence(__ATOMIC_ACQUIRE, "agent");
            xb_add(&bar[XB_XGEN(b.x)], 1u);
            asm volatile("s_waitcnt vmcnt(0)" ::: "memory");
        } else {
            XB_SPIN(xb_ld(&bar[XB_XGEN(b.x)]) == gen, bar);
            __builtin_amdgcn_fence(__ATOMIC_ACQUIRE, "agent");
            asm volatile("s_waitcnt vmcnt(0)" ::: "memory");
        }
    }
    __syncthreads();
}

struct Args { const void* in[31]; float* out; unsigned char* ws; int ph_lo, ph_hi; };

struct Frame {
    LAS unsigned char* lds;
    int tid, lane, wave, gw, NGW, G, vcu;
    const Args* a;
    unsigned char* ws;
};
#define INF(i) ((const float*)F.a->in[i])
#define WSP(T_, off) ((T_*)(F.ws + (off)))

__device__ __forceinline__ void conv_w(const Frame& F, const float* src, int ldn, int K, int ncols, int nbatch, size_t sbs, bf16* dst, int rmul, int roff, size_t dbs, const float* kscale) {
    LAS float* scr = (LAS float*)(F.lds + F.wave * 16384);
    const int lane = F.lane, nblk = ncols / 32, kblk = K / 64, per = nblk * kblk, total = per * nbatch;
    for (int it = F.gw; it < total; it += F.NGW) {
        const int bt = it / per, r = it % per, kb = r / nblk, nb = r % nblk, k0 = kb * 64, n0 = nb * 32;
        const float* W = src + (size_t)bt * sbs; bf16* WT = dst + (size_t)bt * dbs;
#pragma unroll 8
        for (int i = 0; i < 32; ++i) { const int kk = 2 * i + (lane >> 5); scr[kk * 33 + (lane & 31)] = W[(size_t)(k0 + kk) * ldn + n0 + (lane & 31)]; }
        LDS_WAIT(); asm volatile("" ::: "memory");
        const int c = lane & 7;
        float ks[8];
#pragma unroll
        for (int i = 0; i < 8; ++i) ks[i] = kscale ? kscale[k0 + 8 * c + i] : 1.0f;
#pragma unroll
        for (int j = 0; j < 4; ++j) { const int n = (lane >> 3) + 8 * j; const LAS float* s = scr + (8 * c) * 33 + n;
            v4u o; o.x = pk2(s[0 * 33] * ks[0], s[1 * 33] * ks[1]); o.y = pk2(s[2 * 33] * ks[2], s[3 * 33] * ks[3]); o.z = pk2(s[4 * 33] * ks[4], s[5 * 33] * ks[5]); o.w = pk2(s[6 * 33] * ks[6], s[7 * 33] * ks[7]);
            *(v4u*)(WT + (size_t)(rmul * (n0 + n) + roff) * K + k0 + 8 * c) = o; }
        LDS_WAIT(); asm volatile("" ::: "memory");
    }
}
__device__ __forceinline__ void phase_convert(const Frame& F, int L) {
    const int j = L >> 1;
    const float* win = INF(4) + (size_t)L * D * IN_COLS;
    conv_w(F, win, IN_COLS, D, 3072, 1, 0, WSP(bf16, W_IN), 1, 0, 0, nullptr);
    conv_w(F, win + 3744, IN_COLS, D, 2048, 1, 0, WSP(bf16, W_IN), 1, 3072, 0, nullptr);
    conv_w(F, win + 3072, IN_COLS, D, 672, 1, 0, WSP(bf16, W_IN), 1, 5120, 0, nullptr);
    { bf16* padr = WSP(bf16, W_IN) + (size_t)IN_COLS * D;
      for (int i = F.gw * 64 + F.lane; i < (NIN - IN_COLS) * D / 8; i += F.NGW * 64) ((v4u*)padr)[i] = (v4u){0u, 0u, 0u, 0u}; }
    conv_w(F, INF(12) + (size_t)L * QR * 768, 768, QR, 768, 1, 0, WSP(bf16, W_UQ), 1, 0, 0, INF(11) + L * QR);
    conv_w(F, INF(14) + (size_t)L * KVR * 1024, 1024, KVR, 1024, 1, 0, WSP(bf16, W_UKV), 1, 0, 0, INF(13) + L * KVR);
    conv_w(F, INF(15) + (size_t)L * D * D, D, D, D, 1, 0, WSP(bf16, W_BD), 1, 0, 0, nullptr);
    conv_w(F, INF(16) + (size_t)L * 512 * D, D, 512, D, 1, 0, WSP(bf16, W_BM), 1, 0, 0, nullptr);
    conv_w(F, INF(17) + (size_t)L * D * D, D, D, D, 1, 0, WSP(bf16, W_OUT), 1, 0, 0, nullptr);
    conv_w(F, INF(27) + (size_t)L * D * D, D, D, D, 1, 0, WSP(bf16, W_PG), 1, 0, 0, nullptr);
    conv_w(F, INF(28) + (size_t)L * PLE * D, D, PLE, D, 1, 0, WSP(bf16, W_PP), 1, 0, 0, nullptr);
    if ((L & 1) == 0) {
        conv_w(F, INF(20) + (size_t)j * D * DENSE_FF, DENSE_FF, D, DENSE_FF, 1, 0, WSP(bf16, W_F13), 2, 0, 0, nullptr);
        conv_w(F, INF(21) + (size_t)j * D * DENSE_FF, DENSE_FF, D, DENSE_FF, 1, 0, WSP(bf16, W_F13), 2, 1, 0, nullptr);
        conv_w(F, INF(22) + (size_t)j * DENSE_FF * D, D, DENSE_FF, D, 1, 0, WSP(bf16, W_F2D), 1, 0, 0, nullptr);
    } else {
        const size_t eo = (size_t)j * NEXP * D * EXPERT_FF;
        conv_w(F, INF(24) + eo, EXPERT_FF, D, EXPERT_FF, NEXP, (size_t)D * EXPERT_FF, WSP(bf16, W_F13), 2, 0, (size_t)2 * EXPERT_FF * D, nullptr);
        conv_w(F, INF(25) + eo, EXPERT_FF, D, EXPERT_FF, NEXP, (size_t)D * EXPERT_FF, WSP(bf16, W_F13), 2, 1, (size_t)2 * EXPERT_FF * D, nullptr);
        conv_w(F, INF(26) + eo, D, EXPERT_FF, D, NEXP, (size_t)EXPERT_FF * D, WSP(bf16, W_F2E), 1, 0, (size_t)D * EXPERT_FF, nullptr);
    }
    { const f32x4* ps = (const f32x4*)(INF(1) + (size_t)L * T * PLE); v2u* pd = WSP(v2u, WS_PB);
      for (int i = F.gw * 64 + F.lane; i < T * PLE / 4; i += F.NGW * 64) { const f32x4 v = ps[i]; v2u o; o.x = pk2(v[0], v[1]); o.y = pk2(v[2], v[3]); pd[i] = o; } }
}

__device__ __forceinline__ void phase_prologue(const Frame& F) {
    const int* pos = (const int*)F.a->in[2];
    for (int m = F.gw; m < T; m += F.NGW) {
        const f32x4* xr = (const f32x4*)(INF(0) + (size_t)m * D) + F.lane; f32x4* orow = (f32x4*)(F.a->out + (size_t)m * D) + F.lane; v2u* br = WSP(v2u, WS_XB) + (size_t)m * (D / 4) + F.lane;
#pragma unroll
        for (int j = 0; j < 4; ++j) { const f32x4 v = xr[64 * j]; orow[64 * j] = v; v2u o; o.x = pk2(v[0], v[1]); o.y = pk2(v[2], v[3]); br[64 * j] = o; }
    }
    { float* rope = WSP(float, WS_ROPE);
      for (int idx = F.gw * 64 + F.lane; idx < T * 16; idx += F.NGW * 64) {
          const int t = idx >> 4, j = idx & 15;
          double inv = 1.0; for (int i = 0; i < j; ++i) inv *= 0.5623413251903491;
          const double ang = (double)pos[t] * inv;
          const double nq = __builtin_rint(ang * 0.6366197723675814);
          double y = __builtin_fma(-nq, 1.5707963267948966, ang); y = __builtin_fma(-nq, 6.123233995736766e-17, y);
          const double y2 = y * y;
          double sp = 1.0 / 6227020800.0; sp = sp * y2 - 1.0 / 39916800.0; sp = sp * y2 + 1.0 / 362880.0; sp = sp * y2 - 1.0 / 5040.0; sp = sp * y2 + 1.0 / 120.0; sp = sp * y2 - 1.0 / 6.0;
          const double sn = y + y * y2 * sp;
          double cp = -1.0 / 87178291200.0; cp = cp * y2 + 1.0 / 479001600.0; cp = cp * y2 - 1.0 / 3628800.0; cp = cp * y2 + 1.0 / 40320.0; cp = cp * y2 - 1.0 / 720.0; cp = cp * y2 + 1.0 / 24.0; cp = cp * y2 - 0.5;
          const double cs = 1.0 + y2 * cp;
          const int q = ((int)nq) & 3;
          const double c = (q == 0) ? cs : (q == 1) ? -sn : (q == 2) ? -cs : sn;
          const double s = (q == 0) ? sn : (q == 1) ? cs : (q == 2) ? -sn : -cs;
          rope[2 * idx] = (float)c; rope[2 * idx + 1] = (float)s;
      } }
    { int* bm = WSP(int, WS_MISC);
      for (int blk = F.gw; blk < T / 64; blk += F.NGW) { int v = pos[blk * 64 + F.lane];
#pragma unroll
          for (int o = 1; o < 64; o <<= 1) { const int t2 = __shfl_xor(v, o); v = t2 > v ? t2 : v; }
          if (F.lane == 0) bm[blk] = v; } }
    { float* lut = WSP(float, WS_MISC + 4096); const float* tab = INF(3);
      for (int idx = F.gw * 64 + F.lane; idx < 8 * 132; idx += F.NGW * 64) { const int hh = idx / 132, n = idx % 132;
          int bk = n;
          if (n >= 16) bk = 16 + (n >= 19) + (n >= 21) + (n >= 24) + (n >= 27) + (n >= 31) + (n >= 35) + (n >= 40) + (n >= 46) + (n >= 52) + (n >= 59) + (n >= 67) + (n >= 77) + (n >= 87) + (n >= 99) + (n >= 113);
          lut[idx] = tab[bk * 8 + hh] * LOG2E; } }
    for (int rep = 0; rep < REP_CONV; ++rep) phase_convert(F, 0);
}

__device__ __forceinline__ void phase_rms_rope(const Frame& F) {
    const float* CQ = WSP(float, A_CQ); const float* rope = WSP(float, WS_ROPE);
    bf16* CQN = WSP(bf16, A_CQN); bf16* CKVN = WSP(bf16, A_CKVN); bf16* MKR = WSP(bf16, A_MKR);
    const int l = F.lane;
    for (int m = F.gw; m < T; m += F.NGW) {
        const float* c = CQ + (size_t)m * 768;
        const f32x2 a0 = *(const f32x2*)(c + 6 * l), a1 = *(const f32x2*)(c + 6 * l + 2), a2 = *(const f32x2*)(c + 6 * l + 4);
        const f32x4 kv = *(const f32x4*)(c + QR + 4 * l);
        float x1 = 0.f, x2 = 0.f, rc = 0.f, rs = 0.f;
        if (l < 16) { x1 = c[QR + KVR + l]; x2 = c[QR + KVR + 16 + l]; rc = rope[(size_t)m * 32 + 2 * l]; rs = rope[(size_t)m * 32 + 2 * l + 1]; }
        const float sq = wave_sum(a0[0] * a0[0] + a0[1] * a0[1] + a1[0] * a1[0] + a1[1] * a1[1] + a2[0] * a2[0] + a2[1] * a2[1]);
        const float sk = wave_sum(kv[0] * kv[0] + kv[1] * kv[1] + kv[2] * kv[2] + kv[3] * kv[3]);
        const float rq = 1.0f / sqrtf(sq * (1.0f / QR) + LN_EPS), rk = 1.0f / sqrtf(sk * (1.0f / KVR) + LN_EPS);
        unsigned* qo = (unsigned*)(CQN + (size_t)m * QR + 6 * l);
        qo[0] = pk2(a0[0] * rq, a0[1] * rq); qo[1] = pk2(a1[0] * rq, a1[1] * rq); qo[2] = pk2(a2[0] * rq, a2[1] * rq);
        v2u ko; ko.x = pk2(kv[0] * rk, kv[1] * rk); ko.y = pk2(kv[2] * rk, kv[3] * rk);
        *(v2u*)(CKVN + (size_t)m * KVR + 4 * l) = ko;
        if (l < 16) { const float o1 = x1 * rc - x2 * rs, o2 = x1 * rs + x2 * rc; const unsigned w = pk2(o1, o2);
            MKR[(size_t)m * 32 + l] = (bf16)(w & 0xffffu); MKR[(size_t)m * 32 + 16 + l] = (bf16)(w >> 16); }
    }
}

__device__ __forceinline__ void phase_combine(const Frame& F, int L) {
    const float lam_init = 0.8f - 0.6f * expf(-0.3f * (float)L);
    const int l = F.lane;
    const float d1 = wave_sum(INF(6)[L * 64 + l] * INF(7)[L * 64 + l]), d2 = wave_sum(INF(8)[L * 64 + l] * INF(9)[L * 64 + l]);
    const float lam = expf(d1) - expf(d2) + lam_init;
    const bf16* OA2 = WSP(bf16, A_OA2); bf16* OA = WSP(bf16, A_OA);
    const int hh = l >> 3, d0 = (l & 7) * 16;
    float gsc[16];
#pragma unroll
    for (int i = 0; i < 16; ++i) gsc[i] = INF(10)[L * 128 + d0 + i] * (1.0f - lam_init);
    for (int m = F.gw; m < T; m += F.NGW) {
        const bf16* p0 = OA2 + (size_t)m * 2048 + (hh * 2) * 128 + d0;
        const v4u a0 = *(const v4u*)p0, a1 = *(const v4u*)(p0 + 8), b0 = *(const v4u*)(p0 + 128), b1 = *(const v4u*)(p0 + 136);
        float o[16];
        o[0] = bflo(a0.x) - lam * bflo(b0.x); o[1] = bfhi(a0.x) - lam * bfhi(b0.x); o[2] = bflo(a0.y) - lam * bflo(b0.y); o[3] = bfhi(a0.y) - lam * bfhi(b0.y);
        o[4] = bflo(a0.z) - lam * bflo(b0.z); o[5] = bfhi(a0.z) - lam * bfhi(b0.z); o[6] = bflo(a0.w) - lam * bflo(b0.w); o[7] = bfhi(a0.w) - lam * bfhi(b0.w);
        o[8] = bflo(a1.x) - lam * bflo(b1.x); o[9] = bfhi(a1.x) - lam * bfhi(b1.x); o[10] = bflo(a1.y) - lam * bflo(b1.y); o[11] = bfhi(a1.y) - lam * bfhi(b1.y);
        o[12] = bflo(a1.z) - lam * bflo(b1.z); o[13] = bfhi(a1.z) - lam * bfhi(b1.z); o[14] = bflo(a1.w) - lam * bflo(b1.w); o[15] = bfhi(a1.w) - lam * bfhi(b1.w);
        float ss = 0.f;
#pragma unroll
        for (int i = 0; i < 16; ++i) ss += o[i] * o[i];
        ss += __shfl_xor(ss, 1); ss += __shfl_xor(ss, 2); ss += __shfl_xor(ss, 4);
        const float rr = 1.0f / sqrtf(ss * (1.0f / 128.0f) + LN_EPS);
        v4u w0, w1;
        w0.x = pk2(o[0] * rr * gsc[0], o[1] * rr * gsc[1]); w0.y = pk2(o[2] * rr * gsc[2], o[3] * rr * gsc[3]); w0.z = pk2(o[4] * rr * gsc[4], o[5] * rr * gsc[5]); w0.w = pk2(o[6] * rr * gsc[6], o[7] * rr * gsc[7]);
        w1.x = pk2(o[8] * rr * gsc[8], o[9] * rr * gsc[9]); w1.y = pk2(o[10] * rr * gsc[10], o[11] * rr * gsc[11]); w1.z = pk2(o[12] * rr * gsc[12], o[13] * rr * gsc[13]); w1.w = pk2(o[14] * rr * gsc[14], o[15] * rr * gsc[15]);
        bf16* po = OA + (size_t)m * 1024 + hh * 128 + d0;
        *(v4u*)po = w0; *(v4u*)(po + 8) = w1;
    }
}

template <bool ROUTE, bool GATHER>
__device__ __forceinline__ void phase_ln(const Frame& F, const float* gam, const float* bet, const float* wr, int moe_j) {
    const float* PRE = WSP(float, A_PRE); const int l = F.lane;
    const bf16* YG = WSP(bf16, A_YG); int* TOKE = WSP(int, A_TOK); float* TOKG = WSP(float, A_TOK + 1 * MiB); const int* TOKR = WSP(int, A_TOK + 2 * MiB);
    int* TOKS = WSP(int, A_TOK + 3 * MiB); int* CNTW = WSP(int, A_TOK + 4 * MiB);
    int rc0 = 0, rc1 = 0, rc2 = 0, rc3 = 0, rc4 = 0, rc5 = 0, rc6 = 0, rc7 = 0; (void)moe_j;
    f32x4 gv[4], bv[4];
#pragma unroll
    for (int j = 0; j < 4; ++j) { gv[j] = *(const f32x4*)(gam + 4 * l + 256 * j); bv[j] = *(const f32x4*)(bet + 4 * l + 256 * j); }
    for (int m = F.gw; m < T; m += F.NGW) {
        const f32x4* xr = (const f32x4*)(PRE + (size_t)m * D) + l;
        f32x4 v[4]; float s = 0.f;
#pragma unroll
        for (int j = 0; j < 4; ++j) v[j] = xr[64 * j];
        if (GATHER) { const int r0 = TOKR[2 * m], r1 = TOKR[2 * m + 1]; const float g0 = TOKG[2 * m], g1 = TOKG[2 * m + 1];
            const v2u* y0 = (const v2u*)(YG + (size_t)r0 * D) + l; const v2u* y1 = (const v2u*)(YG + (size_t)r1 * D) + l;
#pragma unroll
            for (int j = 0; j < 4; ++j) { const v2u a = y0[64 * j], b = y1[64 * j];
                v[j][0] += g0 * bflo(a.x) + g1 * bflo(b.x); v[j][1] += g0 * bfhi(a.x) + g1 * bfhi(b.x); v[j][2] += g0 * bflo(a.y) + g1 * bflo(b.y); v[j][3] += g0 * bfhi(a.y) + g1 * bfhi(b.y); } }
#pragma unroll
        for (int j = 0; j < 4; ++j) s += (v[j][0] + v[j][1]) + (v[j][2] + v[j][3]);
        const float mean = wave_sum(s) * (1.f / D); float s2 = 0.f;
#pragma unroll
        for (int j = 0; j < 4; ++j) { v[j] = v[j] - mean; s2 += (v[j][0] * v[j][0] + v[j][1] * v[j][1]) + (v[j][2] * v[j][2] + v[j][3] * v[j][3]); }
        const float rstd = 1.f / sqrtf(wave_sum(s2) * (1.f / D) + LN_EPS);
        f32x4* orow = (f32x4*)(F.a->out + (size_t)m * D) + l; v2u* br = WSP(v2u, WS_XB) + (size_t)m * (D / 4) + l;
#pragma unroll
        for (int j = 0; j < 4; ++j) { v[j] = v[j] * rstd * gv[j] + bv[j]; orow[64 * j] = v[j]; v2u o; o.x = pk2(v[j][0], v[j][1]); o.y = pk2(v[j][2], v[j][3]); br[64 * j] = o; }
        if (ROUTE) {
            float lg[8];
#pragma unroll
            for (int e = 0; e < 8; ++e) lg[e] = 0.f;
#pragma unroll
            for (int j = 0; j < 4; ++j)
#pragma unroll
                for (int c = 0; c < 4; ++c) { const float* w = wr + (size_t)(4 * l + 256 * j + c) * 8; const f32x4 w0 = *(const f32x4*)w, w1 = *(const f32x4*)(w + 4); const float xv = v[j][c];
                    lg[0] += xv * w0[0]; lg[1] += xv * w0[1]; lg[2] += xv * w0[2]; lg[3] += xv * w0[3]; lg[4] += xv * w1[0]; lg[5] += xv * w1[1]; lg[6] += xv * w1[2]; lg[7] += xv * w1[3]; }
#pragma unroll
            for (int e = 0; e < 8; ++e) lg[e] = wave_sum(lg[e]);
            int e0 = 0; float v0 = lg[0];
#pragma unroll
            for (int e = 1; e < 8; ++e) if (lg[e] > v0) { v0 = lg[e]; e0 = e; }
            int e1 = -1; float v1 = -INFINITY;
#pragma unroll
            for (int e = 0; e < 8; ++e) if (e != e0 && lg[e] > v1) { v1 = lg[e]; e1 = e; }
            const float g1 = 1.0f / (1.0f + expf(v0 - v1)), g0 = 1.0f - g1;
            const int s0 = (e0 == 0) ? rc0 : (e0 == 1) ? rc1 : (e0 == 2) ? rc2 : (e0 == 3) ? rc3 : (e0 == 4) ? rc4 : (e0 == 5) ? rc5 : (e0 == 6) ? rc6 : rc7;
            const int s1 = (e1 == 0) ? rc0 : (e1 == 1) ? rc1 : (e1 == 2) ? rc2 : (e1 == 3) ? rc3 : (e1 == 4) ? rc4 : (e1 == 5) ? rc5 : (e1 == 6) ? rc6 : rc7;
            rc0 += (e0 == 0) + (e1 == 0); rc1 += (e0 == 1) + (e1 == 1); rc2 += (e0 == 2) + (e1 == 2); rc3 += (e0 == 3) + (e1 == 3);
            rc4 += (e0 == 4) + (e1 == 4); rc5 += (e0 == 5) + (e1 == 5); rc6 += (e0 == 6) + (e1 == 6); rc7 += (e0 == 7) + (e1 == 7);
            if (l == 0) { TOKE[2 * m] = e0; TOKE[2 * m + 1] = e1; TOKG[2 * m] = g0; TOKG[2 * m + 1] = g1; TOKS[2 * m] = s0; TOKS[2 * m + 1] = s1; }
        }
    }
    if (ROUTE && l == 0) { int* cw = CNTW + (size_t)F.gw * 8; cw[0] = rc0; cw[1] = rc1; cw[2] = rc2; cw[3] = rc3; cw[4] = rc4; cw[5] = rc5; cw[6] = rc6; cw[7] = rc7; }
}

struct MoeTiles { int pend[8]; int total; };
__device__ __forceinline__ void moe_tiles(const Frame& F, int moe_j, MoeTiles& mt) {
    const int* tot = WSP(int, A_TOK + 5 * MiB); int acc = 0; (void)moe_j;
#pragma unroll
    for (int e = 0; e < 8; ++e) { const int c = tot[e]; acc += (c + 255) >> 8; mt.pend[e] = acc; }
    mt.total = acc;
}
__device__ __forceinline__ void phase_scatter(const Frame& F, int moe_j) {
    (void)moe_j;
    const int* CNTW = WSP(int, A_TOK + 4 * MiB); const int* TOKS = WSP(int, A_TOK + 3 * MiB); int* TOT = WSP(int, A_TOK + 5 * MiB);
    const int* TOKE = WSP(int, A_TOK); int* TOKR = WSP(int, A_TOK + 2 * MiB);
    const v4u* XB = WSP(v4u, WS_XB); v4u* XG = WSP(v4u, A_XG); const int l = F.lane;
    LAS int* red = (LAS int*)F.lds;
    int tot[8], pre[8];
#pragma unroll
    for (int e = 0; e < 8; ++e) { tot[e] = 0; pre[e] = 0; }
    const int wg0 = F.vcu * NWAVES;
    for (int w = F.tid; w < F.NGW; w += NWAVES * 64) { const v4u a = *(const v4u*)(CNTW + (size_t)w * 8), b = *(const v4u*)(CNTW + (size_t)w * 8 + 4); const int below = (w < wg0) ? 1 : 0;
        tot[0] += a.x; tot[1] += a.y; tot[2] += a.z; tot[3] += a.w; tot[4] += b.x; tot[5] += b.y; tot[6] += b.z; tot[7] += b.w;
        pre[0] += below * (int)a.x; pre[1] += below * (int)a.y; pre[2] += below * (int)a.z; pre[3] += below * (int)a.w; pre[4] += below * (int)b.x; pre[5] += below * (int)b.y; pre[6] += below * (int)b.z; pre[7] += below * (int)b.w; }
#pragma unroll
    for (int e = 0; e < 8; ++e) {
#pragma unroll
        for (int o = 1; o < 64; o <<= 1) { tot[e] += __shfl_xor(tot[e], o); pre[e] += __shfl_xor(pre[e], o); } }
    if (l == 0) {
#pragma unroll
        for (int e = 0; e < 8; ++e) { red[F.wave * 16 + e] = tot[e]; red[F.wave * 16 + 8 + e] = pre[e]; } }
    __syncthreads();
    int base[8]; int acc = 0;
#pragma unroll
    for (int e = 0; e < 8; ++e) { int t = 0, p = 0;
#pragma unroll
        for (int w = 0; w < NWAVES; ++w) { t += red[w * 16 + e]; p += red[w * 16 + 8 + e]; }
        int mine = 0;
#pragma unroll
        for (int w = 0; w < NWAVES; ++w) { const int c = CNTW[(size_t)(wg0 + w) * 8 + e]; mine += (w < F.wave) ? c : 0; }
        base[e] = acc * 256 + p + mine; acc += (t + 255) >> 8;
        if (F.vcu == 0 && F.tid == 0) TOT[e] = t; }
    __syncthreads();
    for (int m = F.gw; m < T; m += F.NGW) {
        int rows[2];
#pragma unroll
        for (int k = 0; k < 2; ++k) { const int e = TOKE[2 * m + k]; const int sl = TOKS[2 * m + k];
            const int bs = (e == 0) ? base[0] : (e == 1) ? base[1] : (e == 2) ? base[2] : (e == 3) ? base[3] : (e == 4) ? base[4] : (e == 5) ? base[5] : (e == 6) ? base[6] : base[7];
            rows[k] = bs + sl; }
        const v4u a = XB[(size_t)m * 128 + l], b = XB[(size_t)m * 128 + 64 + l];
        XG[(size_t)rows[0] * 128 + l] = a; XG[(size_t)rows[0] * 128 + 64 + l] = b; XG[(size_t)rows[1] * 128 + l] = a; XG[(size_t)rows[1] * 128 + 64 + l] = b;
        if (l == 0) { TOKR[2 * m] = rows[0]; TOKR[2 * m + 1] = rows[1]; }
    }
}

__device__ __forceinline__ void phase_attn_diff(const Frame& F) {
    att::AttnP P; P.Q = WSP(bf16, A_DQ); P.ldq = 1024; P.K1 = WSP(bf16, A_DK); P.ldk1 = 1024; P.K2 = P.K1; P.ldk2 = 1024; P.V = WSP(bf16, A_DV); P.ldv = 1024; P.O = WSP(bf16, A_OA2); P.ldo = 2048;
    P.pos = (const int*)F.a->in[2]; P.blkmax = WSP(int, WS_MISC); P.lut = WSP(float, WS_MISC + 4096);
    for (int p = F.vcu; p < BATCH * 16 * 8; p += F.G) {
        const int bh = p >> 3, i = p & 7, b = bh >> 4, vh = bh & 15;
        att::attn_unit<64, 64, 128, true>(P, b, 15 - i, vh * 64, vh * 64, (vh >> 1) * 128, vh * 128, vh >> 1, F.lds);
        att::attn_unit<64, 64, 128, true>(P, b, i, vh * 64, vh * 64, (vh >> 1) * 128, vh * 128, vh >> 1, F.lds);
    }
}
__device__ __forceinline__ void phase_attn_mla(const Frame& F) {
    att::AttnP P; P.Q = WSP(bf16, A_MQ); P.ldq = 768; P.K1 = WSP(bf16, A_MKV); P.ldk1 = 1024; P.K2 = WSP(bf16, A_MKR); P.ldk2 = 32; P.V = WSP(bf16, A_MKV); P.ldv = 1024; P.O = WSP(bf16, A_OB); P.ldo = 512;
    P.pos = (const int*)F.a->in[2]; P.blkmax = WSP(int, WS_MISC); P.lut = WSP(float, WS_MISC + 4096);
    for (int p = F.vcu; p < BATCH * 8 * 8; p += F.G) {
        const int bh = p >> 3, i = p & 7, b = bh >> 3, hh = bh & 7;
        att::attn_unit<96, 64, 64, false>(P, b, 15 - i, hh * 96, hh * 128, hh * 128 + 64, hh * 64, 0, F.lds);
        att::attn_unit<96, 64, 64, false>(P, b, i, hh * 96, hh * 128, hh * 128 + 64, hh * 64, 0, F.lds);
    }
}

constexpr int NPH_DENSE = 10, NPH_MOE = 9 + 2 * MOE_NCHUNK, NPH_TOTAL = 1 + 2 * NPH_DENSE + 2 * NPH_MOE;
#define GEMM_CALL(EPI, SCHED, gm, S_, E_) pg8::gemm_phase<EPI, SCHED, true, true>(F.lds, gm, S_, E_)

__global__ void __launch_bounds__(NWAVES * 64, 2) mega_fwd(Args args) {
    extern __shared__ __attribute__((aligned(16))) unsigned char lds_raw[];
    Frame F;
    F.lds = (LAS unsigned char*)lds_raw; F.a = &args; F.ws = args.ws;
    F.tid = threadIdx.x; F.lane = F.tid & 63; F.wave = __builtin_amdgcn_readfirstlane(F.tid >> 6);
    F.G = gridDim.x; { const int bx = blockIdx.x; F.vcu = (F.G % 8 == 0) ? (bx % 8) * (F.G / 8) + bx / 8 : bx; }
    F.gw = F.vcu * NWAVES + F.wave; F.NGW = F.G * NWAVES;
    volatile LAS unsigned* MISC = (volatile LAS unsigned*)(F.lds + MISC_OFF);
    for (int u = F.tid; u < (LDS_BYTES - RING_BYTES) / 4; u += NWAVES * 64) ((LAS unsigned*)(F.lds + RING_BYTES))[u] = 0u;
    __syncthreads();
    const int lo = args.ph_lo, hi = args.ph_hi;
    XcdBarrier bar; bar.bar = WSP(unsigned, WS_CTL) + CW_BAR; bar.x = 0; bar.st = nullptr;
    if (hi - lo > 1) bar = xcd_barrier_post(WSP(unsigned, WS_CTL) + CW_BAR, MISC + 8);
    int pc = 0;
#define PH_BEGIN if (pc >= lo && pc < hi) { { int t_ = threadIdx.x; asm volatile("" : "+v"(t_)); F.tid = t_; F.lane = t_ & 63; F.wave = __builtin_amdgcn_readfirstlane(t_ >> 6); F.gw = F.vcu * NWAVES + F.wave; }
#define PH_END if (pc + 1 < hi) { for (int rb = 0; rb < REP_BAR; ++rb) xcd_barrier(bar); } } ++pc;
    const int bx = (int)blockIdx.x;
    const float ALPHA = 1.6817928305074290f;

    PH_BEGIN for (int rep = 0; rep < REP_P0; ++rep) phase_prologue(F); PH_END

    for (int L = 0; L < DEPTH; ++L) {
        const int mj = L >> 1;
        PH_BEGIN {
            pg8::Gemm g{WSP(bf16, WS_XB), WSP(bf16, W_IN), T, NIN, D}; pg8::StaticOrder S; S.init(T, NIN, F.G, bx);
            pg8::EpiL1 E{WSP(bf16, A_DQ), WSP(bf16, A_G), WSP(float, A_CQ), INF(5) + L * 2048, 0.125f * LOG2E};
            for (int rep = 0; rep < REP_L1; ++rep) GEMM_CALL(pg8::EpiL1, pg8::StaticOrder, g, S, E);
        } PH_END
        PH_BEGIN for (int rep = 0; rep < REP_EW; ++rep) phase_rms_rope(F); PH_END
        PH_BEGIN {
            for (int rep = 0; rep < REP_MIX; ++rep) {
            { pg8::Gemm g{WSP(bf16, A_CQN), WSP(bf16, W_UQ), T, 768, QR}; pg8::StaticOrder S; S.init(T, 768, F.G, bx);
              pg8::EpiRopeQ E{WSP(bf16, A_MQ), WSP(float, WS_ROPE), 0.10206207261596577f * LOG2E};
              GEMM_CALL(pg8::EpiRopeQ, pg8::StaticOrder, g, S, E); }
            { pg8::Gemm g{WSP(bf16, A_CKVN), WSP(bf16, W_UKV), T, 1024, KVR}; pg8::StaticOrder S; S.init(T, 1024, F.G, bx);
              pg8::EpiBf16 E{WSP(bf16, A_MKV), 1024};
              GEMM_CALL(pg8::EpiBf16, pg8::StaticOrder, g, S, E); }
            }
            for (int rep = 0; rep < REP_ATTN_D; ++rep) phase_attn_diff(F);
        } PH_END
        PH_BEGIN { for (int rep = 0; rep < REP_ATTN_M; ++rep) phase_attn_mla(F); for (int rep = 0; rep < REP_EW; ++rep) phase_combine(F, L); } PH_END
        PH_BEGIN {
            for (int rep = 0; rep < REP_MIX; ++rep) {
            { pg8::Gemm g{WSP(bf16, A_OB), WSP(bf16, W_BM), T, D, 512}; pg8::StaticOrder S; S.init(T, D, F.G, bx);
              pg8::EpiGate<false> E{WSP(bf16, A_MT), WSP(bf16, A_G), nullptr, 1024};
              GEMM_CALL(pg8::EpiGate<false>, pg8::StaticOrder, g, S, E); }
            { pg8::Gemm g{WSP(bf16, A_OA), WSP(bf16, W_BD), T, D, D}; pg8::StaticOrder S; S.init(T, D, F.G, bx);
              pg8::EpiGate<true> E{WSP(bf16, A_M), WSP(bf16, A_G), WSP(bf16, A_MT), 0};
              GEMM_CALL(pg8::EpiGate<true>, pg8::StaticOrder, g, S, E); }
            }
        } PH_END
        PH_BEGIN {
            pg8::Gemm g{WSP(bf16, A_M), WSP(bf16, W_OUT), T, D, D}; pg8::StaticOrder S; S.init(T, D, F.G, bx);
            pg8::EpiF32<1> E{WSP(float, A_PRE), args.out, ALPHA};
            for (int rep = 0; rep < REP_MIX; ++rep) GEMM_CALL(pg8::EpiF32<1>, pg8::StaticOrder, g, S, E);
        } PH_END
        PH_BEGIN {
            if (L & 1) phase_ln<true, false>(F, INF(18) + L * D, INF(19) + L * D, INF(23) + (size_t)mj * D * NEXP, mj);
            else for (int rep = 0; rep < REP_LN; ++rep) phase_ln<false, false>(F, INF(18) + L * D, INF(19) + L * D, nullptr, 0);
        } PH_END
        if ((L & 1) == 0) {
            PH_BEGIN {
                for (int rep = 0; rep < REP_FFN; ++rep) {
                { pg8::Gemm g{WSP(bf16, WS_XB), WSP(bf16, W_F13), T, 2 * DENSE_FF, D}; pg8::StaticOrder S; S.init(T, 2 * DENSE_FF, F.G, bx);
                  pg8::EpiSwiGLU E{WSP(bf16, A_H), DENSE_FF};
                  GEMM_CALL(pg8::EpiSwiGLU, pg8::StaticOrder, g, S, E); }
                { pg8::Gemm g{WSP(bf16, WS_PB), WSP(bf16, W_PP), T, D, PLE}; pg8::StaticOrder S; S.init(T, D, F.G, bx);
                  pg8::EpiF32<0> E{WSP(float, A_PRE), nullptr, 0.f};
                  GEMM_CALL(pg8::EpiF32<0>, pg8::StaticOrder, g, S, E); }
                { pg8::Gemm g{WSP(bf16, WS_XB), WSP(bf16, W_PG), T, D, D}; pg8::StaticOrder S; S.init(T, D, F.G, bx);
                  pg8::EpiF32<2> E{WSP(float, A_PRE), args.out, ALPHA};
                  GEMM_CALL(pg8::EpiF32<2>, pg8::StaticOrder, g, S, E); }
                }
            } PH_END
            PH_BEGIN {
                pg8::Gemm g{WSP(bf16, A_H), WSP(bf16, W_F2D), T, D, DENSE_FF}; pg8::StaticOrder S; S.init(T, D, F.G, bx);
                pg8::EpiF32<3> E{WSP(float, A_PRE), nullptr, 0.f};
                GEMM_CALL(pg8::EpiF32<3>, pg8::StaticOrder, g, S, E);
            } PH_END
            PH_BEGIN { for (int rep = 0; rep < REP_LN; ++rep) phase_ln<false, false>(F, INF(29) + L * D, INF(30) + L * D, nullptr, 0); if (L + 1 < DEPTH) for (int rep = 0; rep < REP_CONV; ++rep) phase_convert(F, L + 1); } PH_END
        } else {
            PH_BEGIN {
                phase_scatter(F, mj);
                for (int rep = 0; rep < REP_PPE; ++rep) {
                { pg8::Gemm g{WSP(bf16, WS_PB), WSP(bf16, W_PP), T, D, PLE}; pg8::StaticOrder S; S.init(T, D, F.G, bx);
                  pg8::EpiF32<0> E{WSP(float, A_PRE), nullptr, 0.f};
                  GEMM_CALL(pg8::EpiF32<0>, pg8::StaticOrder, g, S, E); }
                { pg8::Gemm g{WSP(bf16, WS_XB), WSP(bf16, W_PG), T, D, D}; pg8::StaticOrder S; S.init(T, D, F.G, bx);
                  pg8::EpiF32<2> E{WSP(float, A_PRE), args.out, ALPHA};
                  GEMM_CALL(pg8::EpiF32<2>, pg8::StaticOrder, g, S, E); }
                }
            } PH_END
            for (int ch = 0; ch < MOE_NCHUNK; ++ch) {
                PH_BEGIN {
                    MoeTiles mt; moe_tiles(F, mj, mt);
                    const int tlo = ch * MOE_CHUNK_TILES; int ntc = mt.total - tlo; ntc = ntc > MOE_CHUNK_TILES ? MOE_CHUNK_TILES : ntc;
                    if (ntc > 0) {
                        pg8::Gemm g{WSP(bf16, A_XG) + (size_t)tlo * 256 * D, WSP(bf16, W_F13), ntc * 256, 2 * EXPERT_FF, D};
                        pg8::GroupedOrder S; S.init(ntc * 256, 2 * EXPERT_FF, F.G, bx); S.tile_lo = tlo; S.estride = (size_t)2 * EXPERT_FF * D * 2;
                        S.pend0 = mt.pend[0]; S.pend1 = mt.pend[1]; S.pend2 = mt.pend[2]; S.pend3 = mt.pend[3]; S.pend4 = mt.pend[4]; S.pend5 = mt.pend[5]; S.pend6 = mt.pend[6]; S.pend7 = mt.pend[7];
                        pg8::EpiSwiGLU E{WSP(bf16, A_HG), EXPERT_FF};
                        for (int rep = 0; rep < REP_MOE; ++rep) GEMM_CALL(pg8::EpiSwiGLU, pg8::GroupedOrder, g, S, E);
                    }
                } PH_END
                PH_BEGIN {
                    MoeTiles mt; moe_tiles(F, mj, mt);
                    const int tlo = ch * MOE_CHUNK_TILES; int ntc = mt.total - tlo; ntc = ntc > MOE_CHUNK_TILES ? MOE_CHUNK_TILES : ntc;
                    if (ntc > 0) {
                        pg8::Gemm g{WSP(bf16, A_HG), WSP(bf16, W_F2E), ntc * 256, D, EXPERT_FF};
                        pg8::GroupedOrder S; S.init(ntc * 256, D, F.G, bx); S.tile_lo = tlo; S.estride = (size_t)D * EXPERT_FF * 2;
                        S.pend0 = mt.pend[0]; S.pend1 = mt.pend[1]; S.pend2 = mt.pend[2]; S.pend3 = mt.pend[3]; S.pend4 = mt.pend[4]; S.pend5 = mt.pend[5]; S.pend6 = mt.pend[6]; S.pend7 = mt.pend[7];
                        pg8::EpiBf16 E{WSP(bf16, A_YG) + (size_t)tlo * 256 * D, D};
                        for (int rep = 0; rep < REP_MOE; ++rep) GEMM_CALL(pg8::EpiBf16, pg8::GroupedOrder, g, S, E);
                    }
                } PH_END
            }
            PH_BEGIN { for (int rep = 0; rep < REP_LN; ++rep) phase_ln<false, true>(F, INF(29) + L * D, INF(30) + L * D, nullptr, 0); if (L + 1 < DEPTH) for (int rep = 0; rep < REP_CONV; ++rep) phase_convert(F, L + 1); } PH_END
        }
    }
#undef PH_BEGIN
#undef PH_END
}

extern "C" void kernel_launch(void* const* d_in, const int* in_sizes, int n_in, void* d_out, int out_size, void* d_ws, size_t ws_size, hipStream_t stream) {
    static int grid = 0;
    if (grid == 0) {
        if (n_in != 31 || in_sizes[0] != T * D || out_size != T * D || ws_size < WS_END) { fprintf(stderr, "kernel_launch: unexpected shapes / workspace (n_in %d, ws %zu < %zu)\n", n_in, ws_size, (size_t)WS_END); grid = -1; return; }
        int dev = 0, cus = 0, per_cu = 0;
        if (hipGetDevice(&dev) != hipSuccess || hipDeviceGetAttribute(&cus, hipDeviceAttributeMultiprocessorCount, dev) != hipSuccess) { grid = -1; return; }
        if (hipFuncSetAttribute((const void*)mega_fwd, hipFuncAttributeMaxDynamicSharedMemorySize, LDS_BYTES) != hipSuccess) { fprintf(stderr, "kernel_launch: hipFuncSetAttribute failed\n"); grid = -1; return; }
        if (hipOccupancyMaxActiveBlocksPerMultiprocessor(&per_cu, (const void*)mega_fwd, NWAVES * 64, LDS_BYTES) != hipSuccess || per_cu < 1) { fprintf(stderr, "kernel_launch: occupancy query says %d\n", per_cu); (void)hipGetLastError(); grid = -1; return; }
        grid = cus;
    }
    if (grid < 0) return;
    if (hipMemsetAsync((char*)d_ws + WS_CTL, 0, CTL_ZERO_BYTES, stream) != hipSuccess) return;
    Args a{};
    for (int i = 0; i < 31; ++i) a.in[i] = d_in[i];
    a.out = (float*)d_out; a.ws = (unsigned char*)d_ws;
#if MK_PER_PHASE
    for (int p = 0; p < NPH_TOTAL; ++p) { a.ph_lo = p; a.ph_hi = p + 1; hipLaunchKernelGGL(mega_fwd, dim3(grid), dim3(NWAVES * 64), LDS_BYTES, stream, a); }
#else
    a.ph_lo = 0; a.ph_hi = NPH_TOTAL;
    hipLaunchKernelGGL(mega_fwd, dim3(grid), dim3(NWAVES * 64), LDS_BYTES, stream, a);
#endif
}
```

```cpp
#include <hip/hip_runtime.h>
#include <cstdio>
#include <cstdint>
#include <cmath>

#ifndef MK_PER_PHASE
#define MK_PER_PHASE 0
#endif

constexpr int BATCH = 8, SEQ = 4096, T = BATCH * SEQ, D = 1024, DEPTH = 4, PLE = 256;
constexpr int IN_COLS = 5792, NIN = 5888;
constexpr int QR = 384, KVR = 256, ROPE_D = 32;
constexpr int DENSE_FF = 2816, EXPERT_FF = 3584, NEXP = 8;
constexpr float LN_EPS = 1e-5f;
constexpr float LOG2E = 1.4426950408889634f;
constexpr int MOE_ROWS = 2 * T + NEXP * 256;
constexpr int MOE_CHUNK_TILES = 128;
constexpr int MOE_NCHUNK = 3;

#define GAS __attribute__((address_space(1)))
#define LAS __attribute__((address_space(3)))
typedef unsigned short bf16;
typedef unsigned v4u __attribute__((ext_vector_type(4)));
typedef unsigned v2u __attribute__((ext_vector_type(2)));
typedef float f32x4 __attribute__((ext_vector_type(4)));
typedef float f32x2 __attribute__((ext_vector_type(2)));
typedef float f32x16 __attribute__((ext_vector_type(16)));
typedef short bf16x8 __attribute__((ext_vector_type(8)));
typedef short s16x4 __attribute__((ext_vector_type(4)));
typedef __bf16 bf16x2_t __attribute__((ext_vector_type(2)));
typedef GAS unsigned gu32;
#define RLX_AGENT __ATOMIC_RELAXED, __HIP_MEMORY_SCOPE_AGENT
#define LDS_WAIT() asm volatile("s_waitcnt lgkmcnt(0)" ::: "memory")
#define VM_WAIT() asm volatile("s_waitcnt vmcnt(0)" ::: "memory")

__device__ __forceinline__ unsigned pk2(float lo, float hi) { f32x2 v = {lo, hi}; bf16x2_t b = __builtin_convertvector(v, bf16x2_t); return __builtin_bit_cast(unsigned, b); }
__device__ __forceinline__ float bflo(unsigned u) { return __uint_as_float(u << 16); }
__device__ __forceinline__ float bfhi(unsigned u) { return __uint_as_float(u & 0xffff0000u); }
__device__ __forceinline__ float sigmoidf_(float x) { return __builtin_amdgcn_rcpf(1.0f + __builtin_amdgcn_exp2f(-x * LOG2E)); }
__device__ __forceinline__ float wave_sum(float v) {
#pragma unroll
    for (int o = 1; o < 64; o <<= 1) v += __shfl_xor(v, o);
    return v;
}

namespace pg8 {
#define PG8_LAS __attribute__((address_space(3)))
typedef unsigned short bf16_t;
typedef unsigned u32x4 __attribute__((ext_vector_type(4)));
typedef unsigned u32x2 __attribute__((ext_vector_type(2)));
constexpr int BM = 256, BK = 64, HALF = 128, HTB = HALF * BK * 2  , STAGE_BYTES = 8 * HTB, NXCD = 8, WGM = 8;

__host__ __device__ __forceinline__ int lds_byte(int r, int c) { const int st = (r >> 4) * 2 + (c >> 5), rr = r & 15, cc = c & 31, ob = rr * 64 + cc * 2; return st * 1024 + (ob ^ (((ob >> 9) & 1) << 5)); }
__host__ __device__ __forceinline__ void stage_rc(int b, int& R, int& C) { const int st = b / 1024, sb = b % 1024, swz = sb ^ (((sb >> 9) & 1) << 5); R = (st >> 1) * 16 + swz / 64; C = (st & 1) * 32 + (swz % 64) / 2; }
__host__ __device__ __forceinline__ int perm32(int rho) { const int n = rho >> 4, i = rho & 15; return 8 * (i >> 2) + 4 * n + (i & 3); }

struct Unit { int pm, pn; };
struct Gemm { const bf16_t* A; const bf16_t* Bt; int M, N, K; };

struct StaticOrder {
    int nM, nN, nwg, G, c;
    __host__ __device__ void init(int M, int N, int G_, int c_) { nM = M / BM; nN = N / BM; nwg = nM * nN; G = G_; c = c_; }
    __host__ __device__ bool next(int i, Unit& u) const {
        const long L = (long)i * G + c; if (L >= nwg) return false;
        int wgid = (int)L; { const int q = nwg / NXCD, r = nwg % NXCD, xcd = wgid % NXCD, off = wgid / NXCD; wgid = (xcd < r ? xcd * (q + 1) : r * (q + 1) + (xcd - r) * q) + off; }
        const int nig = WGM * nN, gid = wgid / nig, fm = gid * WGM, gsz = (nM - fm) < WGM ? (nM - fm) : WGM;
        u.pm = fm + ((wgid % nig) % gsz); u.pn = (wgid % nig) / gsz; return true;
    }
    __device__ __forceinline__ size_t bofs(const Unit&) const { return 0; }
    __device__ __forceinline__ void a_ready(const Unit&) const {}
    __device__ __forceinline__ void done(const Unit&) const {}
};
struct GroupedOrder : StaticOrder {
    int tile_lo; int pend0, pend1, pend2, pend3, pend4, pend5, pend6, pend7; size_t estride;
    __device__ __forceinline__ size_t bofs(const Unit& u) const {
        const int t = u.pm + tile_lo;
        const int e = (t >= pend0) + (t >= pend1) + (t >= pend2) + (t >= pend3) + (t >= pend4) + (t >= pend5) + (t >= pend6);
        return (size_t)e * estride;
    }
};

typedef f32x4 Acc[2][2][4][2];

struct EpiL1 {
    static constexpr bool PERM = true, AFTER_DRAIN = false;
    bf16_t* QKV; bf16_t* Gt; float* CQ; const float* bgate; float qscale;
    __device__ __forceinline__ void operator()(const Acc& acc, const Unit& u, int wr, int wc, int fr, int fq) const {
        const int row0 = u.pm * BM + wr * 64 + fr; const int pn = u.pn;
        if (pn < 12) {
            bf16_t* base = QKV + (size_t)(pn >> 2) * ((size_t)T * 1024); const int col0 = (pn & 3) * 256 + wc * 32 + 8 * fq; const float sc = pn < 4 ? qscale : 1.f;
#pragma unroll
            for (int ai = 0; ai < 2; ++ai)
#pragma unroll
                for (int m = 0; m < 4; ++m) { bf16_t* rowp = base + (size_t)(row0 + ai * HALF + m * 16) * 1024 + col0;
#pragma unroll
                    for (int bj = 0; bj < 2; ++bj) { const f32x4 v0 = acc[ai][bj][m][0] * sc, v1 = acc[ai][bj][m][1] * sc;
                        u32x4 w; w.x = pk2(v0[0], v0[1]); w.y = pk2(v0[2], v0[3]); w.z = pk2(v1[0], v1[1]); w.w = pk2(v1[2], v1[3]);
                        *(u32x4*)(rowp + bj * HALF) = w; } }
        } else if (pn < 20) {
            const int col0 = (pn - 12) * 256 + wc * 32 + 8 * fq;
            f32x4 bv[2][2];
#pragma unroll
            for (int bj = 0; bj < 2; ++bj)
#pragma unroll
                for (int n = 0; n < 2; ++n) bv[bj][n] = *(const f32x4*)(bgate + col0 + bj * HALF + 4 * n);
#pragma unroll
            for (int ai = 0; ai < 2; ++ai)
#pragma unroll
                for (int m = 0; m < 4; ++m) { bf16_t* rowp = Gt + (size_t)(row0 + ai * HALF + m * 16) * 2048 + col0;
#pragma unroll
                    for (int bj = 0; bj < 2; ++bj) { const f32x4 v0 = acc[ai][bj][m][0] + bv[bj][0], v1 = acc[ai][bj][m][1] + bv[bj][1];
                        u32x4 w; w.x = pk2(sigmoidf_(v0[0]), sigmoidf_(v0[1])); w.y = pk2(sigmoidf_(v0[2]), sigmoidf_(v0[3])); w.z = pk2(sigmoidf_(v1[0]), sigmoidf_(v1[1])); w.w = pk2(sigmoidf_(v1[2]), sigmoidf_(v1[3]));
                        *(u32x4*)(rowp + bj * HALF) = w; } }
        } else {
            const int col0 = (pn - 20) * 256 + wc * 32 + 8 * fq;
#pragma unroll
            for (int ai = 0; ai < 2; ++ai)
#pragma unroll
                for (int m = 0; m < 4; ++m) { float* rowp = CQ + (size_t)(row0 + ai * HALF + m * 16) * 768 + col0;
#pragma unroll
                    for (int bj = 0; bj < 2; ++bj) { *(f32x4*)(rowp + bj * HALF) = acc[ai][bj][m][0]; *(f32x4*)(rowp + bj * HALF + 4) = acc[ai][bj][m][1]; } }
        }
    }
};
struct EpiRopeQ {
    static constexpr bool PERM = false, AFTER_DRAIN = false;
    bf16_t* O; const float* rope; float qscale;
    __device__ __forceinline__ void operator()(const Acc& acc, const Unit& u, int wr, int wc, int fr, int fq) const {
        const int row0 = u.pm * BM + wr * 64 + fr;
#pragma unroll
        for (int ai = 0; ai < 2; ++ai)
#pragma unroll
            for (int m = 0; m < 4; ++m) { const int row = row0 + ai * HALF + m * 16;
                const f32x4 cs0 = *(const f32x4*)(rope + (size_t)row * 32 + fq * 8), cs1 = *(const f32x4*)(rope + (size_t)row * 32 + fq * 8 + 4);
                const f32x4 cc = {cs0[0], cs0[2], cs1[0], cs1[2]}, ss = {cs0[1], cs0[3], cs1[1], cs1[3]};
#pragma unroll
                for (int bj = 0; bj < 2; ++bj) { const int colg = u.pn * BM + bj * HALF + wc * 32; const bool isr = ((colg >> 5) % 3) == 2;
                    const f32x4 x1 = acc[ai][bj][m][0], x2 = acc[ai][bj][m][1];
                    f32x4 o1 = x1, o2 = x2; if (isr) { o1 = x1 * cc - x2 * ss; o2 = x1 * ss + x2 * cc; }
                    o1 = o1 * qscale; o2 = o2 * qscale;
                    bf16_t* p = O + (size_t)row * 768 + colg + 4 * fq;
                    u32x2 w1; w1.x = pk2(o1[0], o1[1]); w1.y = pk2(o1[2], o1[3]); u32x2 w2; w2.x = pk2(o2[0], o2[1]); w2.y = pk2(o2[2], o2[3]);
                    *(u32x2*)p = w1; *(u32x2*)(p + 16) = w2; } }
    }
};
struct EpiBf16 {
    static constexpr bool PERM = true, AFTER_DRAIN = false;
    bf16_t* O; int ldc;
    __device__ __forceinline__ void operator()(const Acc& acc, const Unit& u, int wr, int wc, int fr, int fq) const {
        const int row0 = u.pm * BM + wr * 64 + fr, col0 = u.pn * BM + wc * 32 + 8 * fq;
#pragma unroll
        for (int ai = 0; ai < 2; ++ai)
#pragma unroll
            for (int m = 0; m < 4; ++m) { bf16_t* rowp = O + (size_t)(row0 + ai * HALF + m * 16) * ldc + col0;
#pragma unroll
                for (int bj = 0; bj < 2; ++bj) { const f32x4 v0 = acc[ai][bj][m][0], v1 = acc[ai][bj][m][1];
                    u32x4 w; w.x = pk2(v0[0], v0[1]); w.y = pk2(v0[2], v0[3]); w.z = pk2(v1[0], v1[1]); w.w = pk2(v1[2], v1[3]);
                    *(u32x4*)(rowp + bj * HALF) = w; } }
    }
};
template <bool ADD> struct EpiGate {
    static constexpr bool PERM = true, AFTER_DRAIN = false;
    bf16_t* O; const bf16_t* Gt; const bf16_t* MT; int goff;
    __device__ __forceinline__ void operator()(const Acc& acc, const Unit& u, int wr, int wc, int fr, int fq) const {
        const int row0 = u.pm * BM + wr * 64 + fr, col0 = u.pn * BM + wc * 32 + 8 * fq;
#pragma unroll
        for (int ai = 0; ai < 2; ++ai)
#pragma unroll
            for (int m = 0; m < 4; ++m) { const size_t row = (size_t)(row0 + ai * HALF + m * 16);
#pragma unroll
                for (int bj = 0; bj < 2; ++bj) { const int col = col0 + bj * HALF;
                    const u32x4 gv = *(const u32x4*)(Gt + row * 2048 + goff + col);
                    f32x4 v0 = acc[ai][bj][m][0], v1 = acc[ai][bj][m][1];
                    v0[0] *= bflo(gv.x); v0[1] *= bfhi(gv.x); v0[2] *= bflo(gv.y); v0[3] *= bfhi(gv.y); v1[0] *= bflo(gv.z); v1[1] *= bfhi(gv.z); v1[2] *= bflo(gv.w); v1[3] *= bfhi(gv.w);
                    if (ADD) { const u32x4 mv = *(const u32x4*)(MT + row * 1024 + col);
                        v0[0] += bflo(mv.x); v0[1] += bfhi(mv.x); v0[2] += bflo(mv.y); v0[3] += bfhi(mv.y); v1[0] += bflo(mv.z); v1[1] += bfhi(mv.z); v1[2] += bflo(mv.w); v1[3] += bfhi(mv.w); }
                    u32x4 w; w.x = pk2(v0[0], v0[1]); w.y = pk2(v0[2], v0[3]); w.z = pk2(v1[0], v1[1]); w.w = pk2(v1[2], v1[3]);
                    *(u32x4*)(O + row * 1024 + col) = w; } }
    }
};
template <int MODE> struct EpiF32 {
    static constexpr bool PERM = false, AFTER_DRAIN = false;
    float* P; const float* X; float alpha;
    __device__ __forceinline__ void operator()(const Acc& acc, const Unit& u, int wr, int wc, int fr, int fq) const {
        const int row0 = u.pm * BM + wr * 64 + fr, col0 = u.pn * BM + wc * 32 + 4 * fq;
#pragma unroll
        for (int ai = 0; ai < 2; ++ai)
#pragma unroll
            for (int m = 0; m < 4; ++m) { const size_t off = (size_t)(row0 + ai * HALF + m * 16) * 1024 + col0;
#pragma unroll
                for (int bj = 0; bj < 2; ++bj)
#pragma unroll
                    for (int n = 0; n < 2; ++n) { const size_t o = off + bj * HALF + n * 16; const f32x4 a = acc[ai][bj][m][n]; f32x4 r;
                        if (MODE == 0) r = a;
                        else if (MODE == 1) r = *(const f32x4*)(X + o) * alpha + a;
                        else if (MODE == 2) { const f32x4 pv = *(const f32x4*)(P + o); const f32x4 xv = *(const f32x4*)(X + o);
                            r[0] = xv[0] * alpha + sigmoidf_(a[0]) * pv[0]; r[1] = xv[1] * alpha + sigmoidf_(a[1]) * pv[1]; r[2] = xv[2] * alpha + sigmoidf_(a[2]) * pv[2]; r[3] = xv[3] * alpha + sigmoidf_(a[3]) * pv[3]; }
                        else r = *(const f32x4*)(P + o) + a;
                        *(f32x4*)(P + o) = r; } }
    }
};
struct EpiSwiGLU {
    static constexpr bool PERM = true, AFTER_DRAIN = false;
    bf16_t* H; int ldc;
    __device__ __forceinline__ void operator()(const Acc& acc, const Unit& u, int wr, int wc, int fr, int fq) const {
        const int row0 = u.pm * BM + wr * 64 + fr, col0 = (u.pn * BM + wc * 32 + 8 * fq) >> 1;
#pragma unroll
        for (int ai = 0; ai < 2; ++ai)
#pragma unroll
            for (int m = 0; m < 4; ++m) { bf16_t* rowp = H + (size_t)(row0 + ai * HALF + m * 16) * ldc + col0;
#pragma unroll
                for (int bj = 0; bj < 2; ++bj) { const f32x4 v0 = acc[ai][bj][m][0], v1 = acc[ai][bj][m][1];
                    const float h0 = v0[0] * sigmoidf_(v0[0]) * v0[1], h1 = v0[2] * sigmoidf_(v0[2]) * v0[3], h2 = v1[0] * sigmoidf_(v1[0]) * v1[1], h3 = v1[2] * sigmoidf_(v1[2]) * v1[3];
                    u32x2 w; w.x = pk2(h0, h1); w.y = pk2(h2, h3);
                    *(u32x2*)(rowp + bj * (HALF / 2)) = w; } }
    }
};

template <class Epi, class Sched, bool ALIGN_EPI = false, bool SP2 = false>
__device__ __forceinline__ void gemm_phase(PG8_LAS unsigned char* lds, const Gemm g, const Sched& S, const Epi& E) {
    int tid_ = threadIdx.x; asm volatile("" : "+v"(tid_));
    const int tid = tid_, wid = __builtin_amdgcn_readfirstlane(tid >> 6), lane = tid & 63, wr = wid >> 2, wc = wid & 3, fr = lane & 15, fq = lane >> 4;
    int K_ = g.K; asm volatile("" : "+s"(K_)); const int K = K_, nt = K / BK;
    unsigned voffA[2], voffB[2];
#pragma unroll
    for (int i = 0; i < 2; ++i) { int R, C; stage_rc(tid * 16 + i * 8192, R, C); const int Rb = Epi::PERM ? ((R & ~31) + perm32(R & 31)) : R;
        voffA[i] = (unsigned)(R * K + C) * 2u; voffB[i] = (unsigned)(Rb * K + C) * 2u; }
    const size_t kstep = (size_t)(BK * 2);
    const size_t hstep = (size_t)HALF * K * 2;
    const size_t tstep = 2 * hstep;
    const unsigned ldsw = (unsigned)wid * 1024u;
    const int aoff = lds_byte(wr * 64 + fr, fq * 8), boff = lds_byte(wc * 32 + fr, fq * 8);
#define PG8_SA(b, h) (((b) * 2 + (h)) * HTB)
#define PG8_SB(b, h) ((4 + (b) * 2 + (h)) * HTB)
#define PG8_STAGE(bufoff, gbase, voff) do { _Pragma("unroll") for (int _i = 0; _i < 2; ++_i) \
        __builtin_amdgcn_global_load_lds((const unsigned*)((const char*)(gbase) + (voff)[_i]), (PG8_LAS unsigned*)(lds + (bufoff) + ldsw + _i * 8192), 16, 0, 0); } while (0)
#define PG8_LDA(dst, b, h) do { _Pragma("unroll") for (int m = 0; m < 4; ++m) _Pragma("unroll") for (int k = 0; k < 2; ++k) dst[m][k] = *(const PG8_LAS bf16x8*)(lds + PG8_SA(b, h) + aoff + m * 2048 + k * 1024); } while (0)
#define PG8_LDB(dst, b, h) do { _Pragma("unroll") for (int n = 0; n < 2; ++n) _Pragma("unroll") for (int k = 0; k < 2; ++k) dst[n][k] = *(const PG8_LAS bf16x8*)(lds + PG8_SB(b, h) + boff + n * 2048 + k * 1024); } while (0)
#define PG8_MMA(ai, bj, At, Bt) do { __builtin_amdgcn_s_setprio(1); _Pragma("unroll") for (int m = 0; m < 4; ++m) _Pragma("unroll") for (int n = 0; n < 2; ++n) _Pragma("unroll") for (int k = 0; k < 2; ++k) \
        acc[ai][bj][m][n] = __builtin_amdgcn_mfma_f32_16x16x32_bf16(Bt[n][k], At[m][k], acc[ai][bj][m][n], 0, 0, 0); __builtin_amdgcn_s_setprio(0); } while (0)
#define PG8_WAIT_V(n) asm volatile("s_waitcnt vmcnt(" #n ")" ::: "memory")
#define PG8_WAIT_L(n) asm volatile("s_waitcnt lgkmcnt(" #n ")" ::: "memory")
#define PG8_BAR __builtin_amdgcn_s_barrier()
#define PG8_SCHED __builtin_amdgcn_sched_barrier(0)
    Unit cur, nxt; int ui = 0;
    if (!S.next(0, cur)) return;
    f32x4 acc[2][2][4][2];
#pragma unroll
    for (int a = 0; a < 2; ++a)
#pragma unroll
        for (int b = 0; b < 2; ++b)
#pragma unroll
            for (int m = 0; m < 4; ++m)
#pragma unroll
                for (int n = 0; n < 2; ++n) acc[a][b][m][n] = (f32x4){0.f, 0.f, 0.f, 0.f};
    bf16x8 At[4][2], B0[2][2], B1[2][2];
    const char* cA = (const char*)g.A + (size_t)cur.pm * tstep; const char* cB = (const char*)g.Bt + (size_t)cur.pn * tstep + S.bofs(cur);
    S.a_ready(cur);
    if constexpr (SP2) {
        PG8_STAGE(PG8_SB(0, 0), cB, voffB); PG8_STAGE(PG8_SB(0, 1), cB + hstep, voffB); PG8_STAGE(PG8_SA(0, 0), cA, voffA); PG8_STAGE(PG8_SA(0, 1), cA + hstep, voffA);
        if (wr == 1) PG8_BAR;
        PG8_WAIT_V(2); PG8_BAR;
        PG8_STAGE(PG8_SB(1, 0), cB + kstep, voffB); PG8_STAGE(PG8_SA(1, 0), cA + kstep, voffA); PG8_STAGE(PG8_SB(1, 1), cB + hstep + kstep, voffB);
        PG8_WAIT_V(6); PG8_BAR;
    } else {
        PG8_STAGE(PG8_SB(0, 0), cB, voffB); PG8_STAGE(PG8_SA(0, 0), cA, voffA); PG8_STAGE(PG8_SB(0, 1), cB + hstep, voffB); PG8_STAGE(PG8_SA(0, 1), cA + hstep, voffA);
        if (wr == 1) PG8_BAR;
        PG8_WAIT_V(4); PG8_BAR;
        PG8_STAGE(PG8_SB(1, 0), cB + kstep, voffB); PG8_STAGE(PG8_SA(1, 0), cA + kstep, voffA); PG8_STAGE(PG8_SB(1, 1), cB + hstep + kstep, voffB);
        PG8_WAIT_V(6); PG8_BAR;
    }
    for (;;) {
        const bool has_next = S.next(ui + 1, nxt);
        const char* nA = has_next ? (const char*)g.A + (size_t)nxt.pm * tstep : cA; const char* nB = has_next ? (const char*)g.Bt + (size_t)nxt.pn * tstep + S.bofs(nxt) : cB;
#pragma nounroll
        for (int t = 0; t < nt; t += 2) {
            const bool last = (t == nt - 2);
            const char* a1 = cA + (size_t)(t + 1) * kstep;
            const char* a2 = last ? nA : cA + (size_t)(t + 2) * kstep; const char* b2 = last ? nB : cB + (size_t)(t + 2) * kstep;
            const char* a3 = a2 + kstep; const char* b3 = b2 + kstep;
            if (last && has_next) S.a_ready(nxt);
            if constexpr (SP2) {
            PG8_LDB(B0, 0, 0); PG8_LDB(B1, 0, 1); PG8_SCHED; PG8_LDA(At, 0, 0); PG8_STAGE(PG8_SA(1, 1), a1 + hstep, voffA);
            PG8_WAIT_V(8); PG8_WAIT_L(0); PG8_BAR; PG8_MMA(0, 0, At, B0); PG8_MMA(0, 1, At, B1); PG8_BAR; PG8_SCHED;
            PG8_LDA(At, 0, 1); PG8_STAGE(PG8_SB(0, 0), b2, voffB); PG8_STAGE(PG8_SB(0, 1), b2 + hstep, voffB); PG8_STAGE(PG8_SA(0, 0), a2, voffA);
            PG8_WAIT_V(8); PG8_WAIT_L(0); PG8_BAR; PG8_MMA(1, 0, At, B0); PG8_MMA(1, 1, At, B1); PG8_BAR; PG8_SCHED;
            PG8_LDB(B0, 1, 0); PG8_LDB(B1, 1, 1); PG8_SCHED; PG8_LDA(At, 1, 0); PG8_STAGE(PG8_SA(0, 1), a2 + hstep, voffA);
            PG8_WAIT_V(8); PG8_WAIT_L(0); PG8_BAR; PG8_MMA(0, 0, At, B0); PG8_MMA(0, 1, At, B1); PG8_BAR; PG8_SCHED;
            PG8_LDA(At, 1, 1); PG8_STAGE(PG8_SB(1, 0), b3, voffB); PG8_STAGE(PG8_SB(1, 1), b3 + hstep, voffB); PG8_STAGE(PG8_SA(1, 0), a3, voffA);
            PG8_WAIT_V(8); PG8_WAIT_L(0); PG8_BAR; PG8_MMA(1, 0, At, B0); PG8_MMA(1, 1, At, B1); PG8_BAR; PG8_SCHED;
            } else {
            PG8_LDB(B0, 0, 0); PG8_SCHED; PG8_LDA(At, 0, 0); PG8_STAGE(PG8_SA(1, 1), a1 + hstep, voffA);
            PG8_WAIT_L(8); PG8_BAR; PG8_WAIT_L(0); PG8_MMA(0, 0, At, B0); PG8_BAR; PG8_SCHED;
            PG8_LDB(B1, 0, 1); PG8_STAGE(PG8_SB(0, 0), b2, voffB);
            PG8_BAR; PG8_WAIT_L(0); PG8_MMA(0, 1, At, B1); PG8_BAR;
            PG8_LDA(At, 0, 1); PG8_STAGE(PG8_SA(0, 0), a2, voffA);
            PG8_BAR; PG8_WAIT_L(0); PG8_MMA(1, 0, At, B0); PG8_BAR; PG8_SCHED;
            PG8_STAGE(PG8_SB(0, 1), b2 + hstep, voffB);
            PG8_WAIT_V(6); PG8_BAR; PG8_MMA(1, 1, At, B1); PG8_BAR;
            PG8_LDB(B0, 1, 0); PG8_SCHED; PG8_LDA(At, 1, 0); PG8_STAGE(PG8_SA(0, 1), a2 + hstep, voffA);
            PG8_WAIT_L(8); PG8_BAR; PG8_WAIT_L(0); PG8_MMA(0, 0, At, B0); PG8_BAR; PG8_SCHED;
            PG8_LDB(B1, 1, 1); PG8_STAGE(PG8_SB(1, 0), b3, voffB);
            PG8_BAR; PG8_WAIT_L(0); PG8_MMA(0, 1, At, B1); PG8_BAR;
            PG8_LDA(At, 1, 1); PG8_STAGE(PG8_SA(1, 0), a3, voffA);
            PG8_BAR; PG8_WAIT_L(0); PG8_MMA(1, 0, At, B0); PG8_BAR; PG8_SCHED;
            PG8_STAGE(PG8_SB(1, 1), b3 + hstep, voffB);
            PG8_WAIT_V(6); PG8_BAR; PG8_MMA(1, 1, At, B1); PG8_BAR;
            }
        }
        if constexpr (ALIGN_EPI) { if (wr == 0) PG8_BAR; }
        if constexpr (!Epi::AFTER_DRAIN) { E(acc, cur, wr, wc, fr, fq); S.done(cur); }
        if (!has_next) break;
#pragma unroll
        for (int a = 0; a < 2; ++a)
#pragma unroll
            for (int b = 0; b < 2; ++b)
#pragma unroll
                for (int m = 0; m < 4; ++m)
#pragma unroll
                    for (int n = 0; n < 2; ++n) acc[a][b][m][n] = (f32x4){0.f, 0.f, 0.f, 0.f};
        cur = nxt; cA = nA; cB = nB; ++ui;
        if constexpr (ALIGN_EPI) { if (wr == 1) PG8_BAR; }
    }
    PG8_WAIT_V(0);
    if constexpr (!ALIGN_EPI) { if (wr == 0) PG8_BAR; }
    PG8_BAR;
    if constexpr (Epi::AFTER_DRAIN) { E.fused(acc, cur, wr, wc, fr, fq, lds, wid, lane); S.done(cur); }
#undef PG8_SA
#undef PG8_SB
#undef PG8_STAGE
#undef PG8_LDA
#undef PG8_LDB
#undef PG8_MMA
#undef PG8_WAIT_V
#undef PG8_WAIT_L
#undef PG8_BAR
#undef PG8_SCHED
}
}

namespace att {
#define MFMA32(a, b, c) __builtin_amdgcn_mfma_f32_32x32x16_bf16((a), (b), (c), 0, 0, 0)
typedef short v4i16_t __attribute__((ext_vector_type(4)));
struct AttnP {
    const bf16* Q; int ldq;
    const bf16* K1; int ldk1;
    const bf16* K2; int ldk2;
    const bf16* V; int ldv;
    bf16* O; int ldo;
    const int* pos;
    const int* blkmax;
    const float* lut;
};
__device__ __forceinline__ s16x4 vtr(const LAS unsigned char* p) { return __builtin_bit_cast(s16x4, __builtin_amdgcn_ds_read_tr16_b64_v4i16((LAS v4i16_t*)p)); }

template <int DQK, int KSPLIT, int DV, bool BIAS>
__device__ __forceinline__ void attn_unit(const AttnP& P, int b, int qt, int qcol, int kcol, int vcol, int ocol, int hb, LAS unsigned char* lds) {
    constexpr int KROWB = DQK * 2 + 16;
    constexpr int VROWB = (DV == 128) ? 320 : 192;
    constexpr int KBYTES = 64 * KROWB, VBYTES = 64 * VROWB, STAGE = KBYTES + VBYTES + 256, LUT_OFF = 2 * STAGE;
    constexpr int ND = DQK / 16, NDB = DV / 32, KCH = DQK / 8, VCH = DV / 8, NKC = 64 * KCH, NVC = 64 * VCH, KL = (NKC + 511) / 512, VL = (NVC + 511) / 512;
    int tid_ = threadIdx.x; asm volatile("" : "+v"(tid_));
    const int tid = tid_, lane = tid & 63, wid = __builtin_amdgcn_readfirstlane(tid >> 6), r = lane & 31, h = lane >> 5;
    const long tok0 = (long)b * SEQ; const int q0 = qt * 256; const int qrow = q0 + wid * 32 + r;
    bf16x8 qf[ND];
    { const bf16* qp = P.Q + (tok0 + qrow) * (long)P.ldq + qcol + 8 * h;
#pragma unroll
      for (int d = 0; d < ND; ++d) qf[d] = *(const bf16x8*)(qp + 16 * d); }
    int posq = 0, posq_min = 0;
    LAS float* lut = (LAS float*)(lds + LUT_OFF);
    if (BIAS) { posq = P.pos[tok0 + qrow]; int mn = posq;
#pragma unroll
        for (int o = 1; o < 64; o <<= 1) { const int t2 = __shfl_xor(mn, o); mn = t2 < mn ? t2 : mn; }
        posq_min = mn;
        if (tid < 132) lut[tid] = P.lut[hb * 132 + tid]; }
    v4u kreg[KL], vreg[VL]; int preg = 0;
#define ATT_ISSUE(t) do { const long trow = tok0 + 64 * (long)(t); \
        _Pragma("unroll") for (int i = 0; i < KL; ++i) { const int c = tid + 512 * i; if (NKC % 512 == 0 || c < NKC) { const int row = c / KCH, col = (c % KCH) * 8; \
            const bf16* src = (col < KSPLIT) ? P.K1 + (trow + row) * (long)P.ldk1 + kcol + col : P.K2 + (trow + row) * (long)P.ldk2 + (col - KSPLIT); kreg[i] = *(const v4u*)src; } } \
        _Pragma("unroll") for (int i = 0; i < VL; ++i) { const int c = tid + 512 * i; if (NVC % 512 == 0 || c < NVC) { const int row = c / VCH, col = (c % VCH) * 8; vreg[i] = *(const v4u*)(P.V + (trow + row) * (long)P.ldv + vcol + col); } } \
        if (BIAS && tid < 64) preg = P.pos[trow + tid]; } while (0)
#define ATT_WRITE(t) do { LAS unsigned char* sb = lds + ((t) & 1) * STAGE; \
        _Pragma("unroll") for (int i = 0; i < KL; ++i) { const int c = tid + 512 * i; if (NKC % 512 == 0 || c < NKC) { const int row = c / KCH, cc = c % KCH; *(LAS v4u*)(sb + row * KROWB + cc * 16) = kreg[i]; } } \
        _Pragma("unroll") for (int i = 0; i < VL; ++i) { const int c = tid + 512 * i; if (NVC % 512 == 0 || c < NVC) { const int row = c / VCH, cc = c % VCH; *(LAS v4u*)(sb + KBYTES + row * VROWB + cc * 16) = vreg[i]; } } \
        if (BIAS && tid < 64) *(LAS int*)(sb + KBYTES + VBYTES + 4 * tid) = preg; } while (0)
    f32x16 o[NDB];
#pragma unroll
    for (int i = 0; i < NDB; ++i)
#pragma unroll
        for (int j = 0; j < 16; ++j) o[i][j] = 0.f;
    float m_run = 0.f, l_run = 0.f;
    const int ntiles = (q0 + 256) / 64, my_last = (q0 + wid * 32 + 31) / 64;
    ATT_ISSUE(0); ATT_WRITE(0); __syncthreads();
    const int kbase = r * KROWB + 16 * h;
    const int vbase = KBYTES + (4 * h + ((lane & 15) >> 2)) * VROWB + (((lane >> 4) & 1) * 16 + (lane & 3) * 4) * 2;
    for (int t = 0; t < ntiles; ++t) {
        const bool more = (t + 1 < ntiles);
        if (more) ATT_ISSUE(t + 1);
        if (t <= my_last) {
            const LAS unsigned char* sb = lds + (t & 1) * STAGE;
            bool plain = (64 * t + 63 <= q0 + wid * 32);
            float cinit = -m_run;
            if (BIAS) { const int kmax = P.blkmax[(int)(tok0 >> 6) + t]; if (plain && (posq_min - kmax >= 113)) cinit += lut[128]; else plain = false; }
            f32x16 x0, x1;
#pragma unroll
            for (int j = 0; j < 16; ++j) { x0[j] = cinit; x1[j] = cinit; }
            __builtin_amdgcn_s_setprio(1);
            { bf16x8 kf0[ND], kf1[ND];
#pragma unroll
              for (int d = 0; d < ND; ++d) { kf0[d] = *(const LAS bf16x8*)(sb + kbase + d * 32); kf1[d] = *(const LAS bf16x8*)(sb + kbase + 32 * KROWB + d * 32); }
              __builtin_amdgcn_sched_barrier(0);
#pragma unroll
              for (int d = 0; d < ND; ++d) { x0 = MFMA32(kf0[d], qf[d], x0); x1 = MFMA32(kf1[d], qf[d], x1); } }
            __builtin_amdgcn_s_setprio(0);
            if (!plain) {
#pragma unroll
                for (int g = 0; g < 4; ++g) {
                    int pk0[4] = {0, 0, 0, 0}, pk1[4] = {0, 0, 0, 0};
                    if (BIAS) { const LAS int* pp = (const LAS int*)(sb + KBYTES + VBYTES) + 8 * g + 4 * h;
                        const v4u a = *(const LAS v4u*)pp, c = *(const LAS v4u*)(pp + 32);
                        pk0[0] = a.x; pk0[1] = a.y; pk0[2] = a.z; pk0[3] = a.w; pk1[0] = c.x; pk1[1] = c.y; pk1[2] = c.z; pk1[3] = c.w; }
#pragma unroll
                    for (int j = 0; j < 4; ++j) { const int i = 4 * g + j; const int kidx = 64 * t + 8 * g + 4 * h + j;
                        float v0 = x0[i], v1 = x1[i];
                        if (BIAS) { int n0 = posq - pk0[j]; n0 = n0 < 0 ? 0 : (n0 > 128 ? 128 : n0); int n1 = posq - pk1[j]; n1 = n1 < 0 ? 0 : (n1 > 128 ? 128 : n1); v0 += lut[n0]; v1 += lut[n1]; }
                        if (kidx > qrow) v0 = -INFINITY; if (kidx + 32 > qrow) v1 = -INFINITY;
                        x0[i] = v0; x1[i] = v1; }
                }
            }
            float ma = fmaxf(fmaxf(x0[0], x0[1]), x0[2]), mb = fmaxf(fmaxf(x1[0], x1[1]), x1[2]);
#pragma unroll
            for (int j = 3; j < 15; j += 2) { ma = fmaxf(fmaxf(ma, x0[j]), x0[j + 1]); mb = fmaxf(fmaxf(mb, x1[j]), x1[j + 1]); }
            float mx = fmaxf(fmaxf(ma, mb), fmaxf(x0[15], x1[15]));
            { const auto rr = __builtin_amdgcn_permlane32_swap(__float_as_uint(mx), __float_as_uint(mx), false, false); mx = fmaxf(__uint_as_float(rr[0]), __uint_as_float(rr[1])); }
            if (t == 0 || __any(mx > 8.0f)) {
                const float delta = (t == 0) ? mx : fmaxf(mx, 0.f);
                if (t != 0) { const float alpha = __builtin_amdgcn_exp2f(-delta); l_run *= alpha;
#pragma unroll
                    for (int i = 0; i < NDB; ++i) o[i] = o[i] * alpha; }
                m_run += delta;
#pragma unroll
                for (int j = 0; j < 16; ++j) { x0[j] -= delta; x1[j] -= delta; }
            }
            f32x2 ls2 = {0.f, 0.f};
#pragma unroll
            for (int j = 0; j < 16; j += 2) { x0[j] = __builtin_amdgcn_exp2f(x0[j]); x0[j + 1] = __builtin_amdgcn_exp2f(x0[j + 1]); x1[j] = __builtin_amdgcn_exp2f(x1[j]); x1[j + 1] = __builtin_amdgcn_exp2f(x1[j + 1]);
                ls2 += (f32x2){x0[j], x0[j + 1]}; ls2 += (f32x2){x1[j], x1[j + 1]}; }
            l_run += ls2[0] + ls2[1];
            bf16x8 pf[4];
            { v4u w;
              w.x = pk2(x0[0], x0[1]); w.y = pk2(x0[2], x0[3]); w.z = pk2(x0[4], x0[5]); w.w = pk2(x0[6], x0[7]); pf[0] = __builtin_bit_cast(bf16x8, w);
              w.x = pk2(x0[8], x0[9]); w.y = pk2(x0[10], x0[11]); w.z = pk2(x0[12], x0[13]); w.w = pk2(x0[14], x0[15]); pf[1] = __builtin_bit_cast(bf16x8, w);
              w.x = pk2(x1[0], x1[1]); w.y = pk2(x1[2], x1[3]); w.z = pk2(x1[4], x1[5]); w.w = pk2(x1[6], x1[7]); pf[2] = __builtin_bit_cast(bf16x8, w);
              w.x = pk2(x1[8], x1[9]); w.y = pk2(x1[10], x1[11]); w.z = pk2(x1[12], x1[13]); w.w = pk2(x1[14], x1[15]); pf[3] = __builtin_bit_cast(bf16x8, w); }
            __builtin_amdgcn_s_setprio(1);
            { s16x4 vlo[2][4], vhi[2][4];
#define ATT_VLOAD(buf, db) do { _Pragma("unroll") for (int s = 0; s < 4; ++s) { vlo[buf][s] = vtr(sb + vbase + (16 * s) * VROWB + 64 * (db)); vhi[buf][s] = vtr(sb + vbase + (16 * s + 8) * VROWB + 64 * (db)); } } while (0)
              ATT_VLOAD(0, 0);
#pragma unroll
              for (int db = 0; db < NDB; ++db) {
                  if (db + 1 < NDB) ATT_VLOAD((db + 1) & 1, db + 1);
                  __builtin_amdgcn_sched_barrier(0);
#pragma unroll
                  for (int s = 0; s < 4; ++s) { const bf16x8 vf = __builtin_shufflevector(vlo[db & 1][s], vhi[db & 1][s], 0, 1, 2, 3, 4, 5, 6, 7); o[db] = MFMA32(vf, pf[s], o[db]); }
                  __builtin_amdgcn_sched_barrier(0);
              }
#undef ATT_VLOAD
            }
            __builtin_amdgcn_s_setprio(0);
        }
        if (more) ATT_WRITE(t + 1);
        __syncthreads();
    }
#undef ATT_ISSUE
#undef ATT_WRITE
    const float lt = l_run + __shfl_xor(l_run, 32), inv = 1.0f / lt;
    bf16* op = P.O + (tok0 + qrow) * (long)P.ldo + ocol + 4 * h;
#pragma unroll
    for (int db = 0; db < NDB; ++db)
#pragma unroll
        for (int g = 0; g < 4; ++g) { v2u w; w.x = pk2(o[db][4 * g] * inv, o[db][4 * g + 1] * inv); w.y = pk2(o[db][4 * g + 2] * inv, o[db][4 * g + 3] * inv);
            *(v2u*)(op + 32 * db + 8 * g) = w; }
}
#undef MFMA32
}

constexpr size_t MiB = 1u << 20;
constexpr size_t WS_CTL = 0, CTL_ZERO_BYTES = 1 * MiB;
constexpr size_t WS_ROPE = 1 * MiB;
constexpr size_t WS_MISC = 5 * MiB;
constexpr size_t WS_XB = 6 * MiB;
constexpr size_t WS_PB = 70 * MiB;
constexpr size_t WS_W = 86 * MiB;
constexpr size_t W_IN = WS_W, W_UQ = WS_W + 12 * MiB, W_UKV = WS_W + 13 * MiB, W_BD = WS_W + 14 * MiB, W_BM = WS_W + 16 * MiB, W_OUT = WS_W + 17 * MiB,
                 W_PG = WS_W + 19 * MiB, W_PP = WS_W + 21 * MiB, W_F13 = WS_W + 22 * MiB, W_F2D = WS_W + 33 * MiB, W_F2E = WS_W + 134 * MiB;
constexpr size_t WS_ACT = 276 * MiB;
constexpr size_t A_DQ = WS_ACT, A_DK = WS_ACT + 64 * MiB, A_DV = WS_ACT + 128 * MiB, A_G = WS_ACT + 192 * MiB, A_C = WS_ACT + 320 * MiB;
constexpr size_t A_OA = A_DQ, A_MT = A_DK, A_M = A_DV, A_CQ = A_C, A_OA2 = A_C, A_PRE = A_C;
constexpr size_t A_CQN = WS_ACT + 448 * MiB, A_CKVN = WS_ACT + 472 * MiB, A_OB = A_CQN, A_MKR = WS_ACT + 488 * MiB, A_MQ = WS_ACT + 490 * MiB, A_MKV = WS_ACT + 538 * MiB;
constexpr size_t A_H = WS_ACT;
constexpr size_t A_XG = WS_ACT, A_YG = WS_ACT + 132 * MiB, A_TOK = WS_ACT + 264 * MiB, A_HG = WS_ACT + 448 * MiB;
constexpr size_t WS_END = WS_ACT + 672 * MiB;
constexpr int CW_BAR = 4096, CW_MOE = 8192;

constexpr int RING_BYTES = 131072, MISC_OFF = RING_BYTES + 320, LDS_BYTES = 147456;
constexpr int NWAVES = 8;

#ifndef REP_ATTN_D
#define REP_ATTN_D 1
#endif
#ifndef REP_ATTN_M
#define REP_ATTN_M 1
#endif
#ifndef REP_CONV
#define REP_CONV 1
#endif
#ifndef REP_L1
#define REP_L1 1
#endif
#ifndef REP_EW
#define REP_EW 1
#endif
#ifndef REP_BAR
#define REP_BAR 1
#endif
#ifndef REP_LN
#define REP_LN 1
#endif
#ifndef REP_MOE
#define REP_MOE 1
#endif
#ifndef REP_MIX
#define REP_MIX 1
#endif
#ifndef REP_FFN
#define REP_FFN 1
#endif
#ifndef REP_P0
#define REP_P0 1
#endif
#ifndef REP_PPE
#define REP_PPE 1
#endif
#define XB_TMO      128
#define XB_XCNT(j)  (256  + 64 * (j))
#define XB_XSUB(j)  (1280 + 64 * (j))
#define XB_XGEN(j)  (2304 + 64 * (j))
#define XB_TOP      3328
#define XB_TOPGEN   3392
#define XCD_BAR_WORDS 3456
#define XB_SPIN_CAP (1u << 18)

__device__ __forceinline__ unsigned xb_ld(unsigned* p)              { return __hip_atomic_load(p, __ATOMIC_RELAXED, __HIP_MEMORY_SCOPE_AGENT); }
__device__ __forceinline__ unsigned xb_add(unsigned* p, unsigned v) { return __hip_atomic_fetch_add(p, v, __ATOMIC_RELAXED, __HIP_MEMORY_SCOPE_AGENT); }
__device__ __forceinline__ unsigned xb_xcc_id() { return (unsigned)__builtin_amdgcn_s_getreg((3 << 11) | 20) & 0xFu; }
#define XB_SPIN(cond, bar) do { unsigned _sp = 0; while (cond) { __builtin_amdgcn_s_sleep(1); \
    if ((++_sp & 255u) == 0u) { if (xb_ld(&(bar)[XB_TMO])) break; if (_sp > XB_SPIN_CAP) { atomicAdd(&(bar)[XB_TMO], 1u); break; } } } } while (0)

struct XcdBarrier {
    unsigned* bar; unsigned x;
    volatile LAS unsigned* st;
};

__device__ __forceinline__ XcdBarrier xcd_barrier_post(unsigned* bar, volatile LAS unsigned* st) {
    XcdBarrier b; b.bar = bar; b.x = xb_xcc_id(); b.st = st;
    if (threadIdx.x == 0) (void)xb_add(&bar[XB_XCNT(b.x)], 1u);
    return b;
}
__device__ __forceinline__ void xcd_barrier_complete(unsigned* bar, unsigned x, unsigned& nloc, unsigned& nx) {
    const unsigned G = gridDim.x * gridDim.y * gridDim.z;
    unsigned sum, cnt, mine, sp = 0u;
    for (;;) {
        sum = 0u; cnt = 0u; mine = 0u;
#pragma unroll
        for (unsigned j = 0; j < 16; ++j) { const unsigned c = xb_ld(&bar[XB_XCNT(j)]); sum += c; cnt += (c > 0u) ? 1u : 0u; mine = (j == x) ? c : mine; }
        if (sum == G) break;
        __builtin_amdgcn_s_sleep(1);
        if ((++sp & 255u) == 0u) { if (xb_ld(&bar[XB_TMO])) break; if (sp > XB_SPIN_CAP) { atomicAdd(&bar[XB_TMO], 1u); break; } }
    }
    nloc = mine > 0u ? mine : 1u; nx = cnt > 0u ? cnt : 1u;
}

__device__ __forceinline__ void xcd_barrier(const XcdBarrier& b) {
    asm volatile("s_waitcnt vmcnt(0)" ::: "memory");
    __syncthreads();
    if (threadIdx.x == 0) {
        unsigned* bar = b.bar;
        __builtin_amdgcn_s_waitcnt(0);
        unsigned nloc = b.st[0], nx = b.st[1];
        if (nloc == 0u) { xcd_barrier_complete(bar, b.x, nloc, nx); b.st[0] = nloc; b.st[1] = nx; }
        const unsigned old = xb_add(&bar[XB_XSUB(b.x)], 1u);
        const unsigned gen = old / nloc;
        if (old + 1u == (gen + 1u) * nloc) {
            __builtin_amdgcn_fence(__ATOMIC_RELEASE, "agent");
            asm volatile("s_waitcnt vmcnt(0)" ::: "memory");
            const unsigned og = xb_add(&bar[XB_TOP], 1u);
            const unsigned tg = og / nx;
            if (og + 1u == (tg + 1u) * nx) xb_add(&bar[XB_TOPGEN], 1u);
            else XB_SPIN(xb_ld(&bar[XB_TOPGEN]) == tg, bar);
            __builtin_amdgcn_fence(__ATOMIC_ACQUIRE, "agent");
            xb_add(&bar[XB_XGEN(b.x)], 1u);
            asm volatile("s_waitcnt vmcnt(0)" ::: "memory");
        } else {
            XB_SPIN(xb_ld(&bar[XB_XGEN(b.x)]) == gen, bar);
            __builtin_amdgcn_fence(__ATOMIC_ACQUIRE, "agent");
            asm volatile("s_waitcnt vmcnt(0)" ::: "memory");
        }
    }
    __syncthreads();
}

struct Args { const void* in[31]; float* out; unsigned char* ws; int ph_lo, ph_hi; };

struct Frame {
    LAS unsigned char* lds;
    int tid, lane, wave, gw, NGW, G, vcu;
    const Args* a;
    unsigned char* ws;
};
#define INF(i) ((const float*)F.a->in[i])
#define WSP(T_, off) ((T_*)(F.ws + (off)))

__device__ __forceinline__ void conv_w(const Frame& F, const float* src, int ldn, int K, int ncols, int nbatch, size_t sbs, bf16* dst, int rmul, int roff, size_t dbs, const float* kscale) {
    LAS float* scr = (LAS float*)(F.lds + F.wave * 16384);
    const int lane = F.lane, nblk = ncols / 32, kblk = K / 64, per = nblk * kblk, total = per * nbatch;
    for (int it = F.gw; it < total; it += F.NGW) {
        const int bt = it / per, r = it % per, kb = r / nblk, nb = r % nblk, k0 = kb * 64, n0 = nb * 32;
        const float* W = src + (size_t)bt * sbs; bf16* WT = dst + (size_t)bt * dbs;
#pragma unroll 8
        for (int i = 0; i < 32; ++i) { const int kk = 2 * i + (lane >> 5); scr[kk * 33 + (lane & 31)] = W[(size_t)(k0 + kk) * ldn + n0 + (lane & 31)]; }
        LDS_WAIT(); asm volatile("" ::: "memory");
        const int c = lane & 7;
        float ks[8];
#pragma unroll
        for (int i = 0; i < 8; ++i) ks[i] = kscale ? kscale[k0 + 8 * c + i] : 1.0f;
#pragma unroll
        for (int j = 0; j < 4; ++j) { const int n = (lane >> 3) + 8 * j; const LAS float* s = scr + (8 * c) * 33 + n;
            v4u o; o.x = pk2(s[0 * 33] * ks[0], s[1 * 33] * ks[1]); o.y = pk2(s[2 * 33] * ks[2], s[3 * 33] * ks[3]); o.z = pk2(s[4 * 33] * ks[4], s[5 * 33] * ks[5]); o.w = pk2(s[6 * 33] * ks[6], s[7 * 33] * ks[7]);
            *(v4u*)(WT + (size_t)(rmul * (n0 + n) + roff) * K + k0 + 8 * c) = o; }
        LDS_WAIT(); asm volatile("" ::: "memory");
    }
}
__device__ __forceinline__ void phase_convert(const Frame& F, int L) {
    const int j = L >> 1;
    const float* win = INF(4) + (size_t)L * D * IN_COLS;
    conv_w(F, win, IN_COLS, D, 3072, 1, 0, WSP(bf16, W_IN), 1, 0, 0, nullptr);
    conv_w(F, win + 3744, IN_COLS, D, 2048, 1, 0, WSP(bf16, W_IN), 1, 3072, 0, nullptr);
    conv_w(F, win + 3072, IN_COLS, D, 672, 1, 0, WSP(bf16, W_IN), 1, 5120, 0, nullptr);
    { bf16* padr = WSP(bf16, W_IN) + (size_t)IN_COLS * D;
      for (int i = F.gw * 64 + F.lane; i < (NIN - IN_COLS) * D / 8; i += F.NGW * 64) ((v4u*)padr)[i] = (v4u){0u, 0u, 0u, 0u}; }
    conv_w(F, INF(12) + (size_t)L * QR * 768, 768, QR, 768, 1, 0, WSP(bf16, W_UQ), 1, 0, 0, INF(11) + L * QR);
    conv_w(F, INF(14) + (size_t)L * KVR * 1024, 1024, KVR, 1024, 1, 0, WSP(bf16, W_UKV), 1, 0, 0, INF(13) + L * KVR);
    conv_w(F, INF(15) + (size_t)L * D * D, D, D, D, 1, 0, WSP(bf16, W_BD), 1, 0, 0, nullptr);
    conv_w(F, INF(16) + (size_t)L * 512 * D, D, 512, D, 1, 0, WSP(bf16, W_BM), 1, 0, 0, nullptr);
    conv_w(F, INF(17) + (size_t)L * D * D, D, D, D, 1, 0, WSP(bf16, W_OUT), 1, 0, 0, nullptr);
    conv_w(F, INF(27) + (size_t)L * D * D, D, D, D, 1, 0, WSP(bf16, W_PG), 1, 0, 0, nullptr);
    conv_w(F, INF(28) + (size_t)L * PLE * D, D, PLE, D, 1, 0, WSP(bf16, W_PP), 1, 0, 0, nullptr);
    if ((L & 1) == 0) {
        conv_w(F, INF(20) + (size_t)j * D * DENSE_FF, DENSE_FF, D, DENSE_FF, 1, 0, WSP(bf16, W_F13), 2, 0, 0, nullptr);
        conv_w(F, INF(21) + (size_t)j * D * DENSE_FF, DENSE_FF, D, DENSE_FF, 1, 0, WSP(bf16, W_F13), 2, 1, 0, nullptr);
        conv_w(F, INF(22) + (size_t)j * DENSE_FF * D, D, DENSE_FF, D, 1, 0, WSP(bf16, W_F2D), 1, 0, 0, nullptr);
    } else {
        const size_t eo = (size_t)j * NEXP * D * EXPERT_FF;
        conv_w(F, INF(24) + eo, EXPERT_FF, D, EXPERT_FF, NEXP, (size_t)D * EXPERT_FF, WSP(bf16, W_F13), 2, 0, (size_t)2 * EXPERT_FF * D, nullptr);
        conv_w(F, INF(25) + eo, EXPERT_FF, D, EXPERT_FF, NEXP, (size_t)D * EXPERT_FF, WSP(bf16, W_F13), 2, 1, (size_t)2 * EXPERT_FF * D, nullptr);
        conv_w(F, INF(26) + eo, D, EXPERT_FF, D, NEXP, (size_t)EXPERT_FF * D, WSP(bf16, W_F2E), 1, 0, (size_t)D * EXPERT_FF, nullptr);
    }
    { const f32x4* ps = (const f32x4*)(INF(1) + (size_t)L * T * PLE); v2u* pd = WSP(v2u, WS_PB);
      for (int i = F.gw * 64 + F.lane; i < T * PLE / 4; i += F.NGW * 64) { const f32x4 v = ps[i]; v2u o; o.x = pk2(v[0], v[1]); o.y = pk2(v[2], v[3]); pd[i] = o; } }
}

__device__ __forceinline__ void phase_prologue(const Frame& F) {
    const int* pos = (const int*)F.a->in[2];
    for (int m = F.gw; m < T; m += F.NGW) {
        const f32x4* xr = (const f32x4*)(INF(0) + (size_t)m * D) + F.lane; f32x4* orow = (f32x4*)(F.a->out + (size_t)m * D) + F.lane; v2u* br = WSP(v2u, WS_XB) + (size_t)m * (D / 4) + F.lane;
#pragma unroll
        for (int j = 0; j < 4; ++j) { const f32x4 v = xr[64 * j]; orow[64 * j] = v; v2u o; o.x = pk2(v[0], v[1]); o.y = pk2(v[2], v[3]); br[64 * j] = o; }
    }
    { float* rope = WSP(float, WS_ROPE);
      for (int idx = F.gw * 64 + F.lane; idx < T * 16; idx += F.NGW * 64) {
          const int t = idx >> 4, j = idx & 15;
          double inv = 1.0; for (int i = 0; i < j; ++i) inv *= 0.5623413251903491;
          const double ang = (double)pos[t] * inv;
          const double nq = __builtin_rint(ang * 0.6366197723675814);
          double y = __builtin_fma(-nq, 1.5707963267948966, ang); y = __builtin_fma(-nq, 6.123233995736766e-17, y);
          const double y2 = y * y;
          double sp = 1.0 / 6227020800.0; sp = sp * y2 - 1.0 / 39916800.0; sp = sp * y2 + 1.0 / 362880.0; sp = sp * y2 - 1.0 / 5040.0; sp = sp * y2 + 1.0 / 120.0; sp = sp * y2 - 1.0 / 6.0;
          const double sn = y + y * y2 * sp;
          double cp = -1.0 / 87178291200.0; cp = cp * y2 + 1.0 / 479001600.0; cp = cp * y2 - 1.0 / 3628800.0; cp = cp * y2 + 1.0 / 40320.0; cp = cp * y2 - 1.0 / 720.0; cp = cp * y2 + 1.0 / 24.0; cp = cp * y2 - 0.5;
          const double cs = 1.0 + y2 * cp;
          const int q = ((int)nq) & 3;
          const double c = (q == 0) ? cs : (q == 1) ? -sn : (q == 2) ? -cs : sn;
          const double s = (q == 0) ? sn : (q == 1) ? cs : (q == 2) ? -sn : -cs;
          rope[2 * idx] = (float)c; rope[2 * idx + 1] = (float)s;
      } }
    { int* bm = WSP(int, WS_MISC);
      for (int blk = F.gw; blk < T / 64; blk += F.NGW) { int v = pos[blk * 64 + F.lane];
#pragma unroll
          for (int o = 1; o < 64; o <<= 1) { const int t2 = __shfl_xor(v, o); v = t2 > v ? t2 : v; }
          if (F.lane == 0) bm[blk] = v; } }
    { float* lut = WSP(float, WS_MISC + 4096); const float* tab = INF(3);
      for (int idx = F.gw * 64 + F.lane; idx < 8 * 132; idx += F.NGW * 64) { const int hh = idx / 132, n = idx % 132;
          int bk = n;
          if (n >= 16) bk = 16 + (n >= 19) + (n >= 21) + (n >= 24) + (n >= 27) + (n >= 31) + (n >= 35) + (n >= 40) + (n >= 46) + (n >= 52) + (n >= 59) + (n >= 67) + (n >= 77) + (n >= 87) + (n >= 99) + (n >= 113);
          lut[idx] = tab[bk * 8 + hh] * LOG2E; } }
    for (int rep = 0; rep < REP_CONV; ++rep) phase_convert(F, 0);
}

__device__ __forceinline__ void phase_rms_rope(const Frame& F) {
    const float* CQ = WSP(float, A_CQ); const float* rope = WSP(float, WS_ROPE);
    bf16* CQN = WSP(bf16, A_CQN); bf16* CKVN = WSP(bf16, A_CKVN); bf16* MKR = WSP(bf16, A_MKR);
    const int l = F.lane;
    for (int m = F.gw; m < T; m += F.NGW) {
        const float* c = CQ + (size_t)m * 768;
        const f32x2 a0 = *(const f32x2*)(c + 6 * l), a1 = *(const f32x2*)(c + 6 * l + 2), a2 = *(const f32x2*)(c + 6 * l + 4);
        const f32x4 kv = *(const f32x4*)(c + QR + 4 * l);
        float x1 = 0.f, x2 = 0.f, rc = 0.f, rs = 0.f;
        if (l < 16) { x1 = c[QR + KVR + l]; x2 = c[QR + KVR + 16 + l]; rc = rope[(size_t)m * 32 + 2 * l]; rs = rope[(size_t)m * 32 + 2 * l + 1]; }
        const float sq = wave_sum(a0[0] * a0[0] + a0[1] * a0[1] + a1[0] * a1[0] + a1[1] * a1[1] + a2[0] * a2[0] + a2[1] * a2[1]);
        const float sk = wave_sum(kv[0] * kv[0] + kv[1] * kv[1] + kv[2] * kv[2] + kv[3] * kv[3]);
        const float rq = 1.0f / sqrtf(sq * (1.0f / QR) + LN_EPS), rk = 1.0f / sqrtf(sk * (1.0f / KVR) + LN_EPS);
        unsigned* qo = (unsigned*)(CQN + (size_t)m * QR + 6 * l);
        qo[0] = pk2(a0[0] * rq, a0[1] * rq); qo[1] = pk2(a1[0] * rq, a1[1] * rq); qo[2] = pk2(a2[0] * rq, a2[1] * rq);
        v2u ko; ko.x = pk2(kv[0] * rk, kv[1] * rk); ko.y = pk2(kv[2] * rk, kv[3] * rk);
        *(v2u*)(CKVN + (size_t)m * KVR + 4 * l) = ko;
        if (l < 16) { const float o1 = x1 * rc - x2 * rs, o2 = x1 * rs + x2 * rc; const unsigned w = pk2(o1, o2);
            MKR[(size_t)m * 32 + l] = (bf16)(w & 0xffffu); MKR[(size_t)m * 32 + 16 + l] = (bf16)(w >> 16); }
    }
}

__device__ __forceinline__ void phase_combine(const Frame& F, int L) {
    const float lam_init = 0.8f - 0.6f * expf(-0.3f * (float)L);
    const int l = F.lane;
    const float d1 = wave_sum(INF(6)[L * 64 + l] * INF(7)[L * 64 + l]), d2 = wave_sum(INF(8)[L * 64 + l] * INF(9)[L * 64 + l]);
    const float lam = expf(d1) - expf(d2) + lam_init;
    const bf16* OA2 = WSP(bf16, A_OA2); bf16* OA = WSP(bf16, A_OA);
    const int hh = l >> 3, d0 = (l & 7) * 16;
    float gsc[16];
#pragma unroll
    for (int i = 0; i < 16; ++i) gsc[i] = INF(10)[L * 128 + d0 + i] * (1.0f - lam_init);
    for (int m = F.gw; m < T; m += F.NGW) {
        const bf16* p0 = OA2 + (size_t)m * 2048 + (hh * 2) * 128 + d0;
        const v4u a0 = *(const v4u*)p0, a1 = *(const v4u*)(p0 + 8), b0 = *(const v4u*)(p0 + 128), b1 = *(const v4u*)(p0 + 136);
        float o[16];
        o[0] = bflo(a0.x) - lam * bflo(b0.x); o[1] = bfhi(a0.x) - lam * bfhi(b0.x); o[2] = bflo(a0.y) - lam * bflo(b0.y); o[3] = bfhi(a0.y) - lam * bfhi(b0.y);
        o[4] = bflo(a0.z) - lam * bflo(b0.z); o[5] = bfhi(a0.z) - lam * bfhi(b0.z); o[6] = bflo(a0.w) - lam * bflo(b0.w); o[7] = bfhi(a0.w) - lam * bfhi(b0.w);
        o[8] = bflo(a1.x) - lam * bflo(b1.x); o[9] = bfhi(a1.x) - lam * bfhi(b1.x); o[10] = bflo(a1.y) - lam * bflo(b1.y); o[11] = bfhi(a1.y) - lam * bfhi(b1.y);
        o[12] = bflo(a1.z) - lam * bflo(b1.z); o[13] = bfhi(a1.z) - lam * bfhi(b1.z); o[14] = bflo(a1.w) - lam * bflo(b1.w); o[15] = bfhi(a1.w) - lam * bfhi(b1.w);
        float ss = 0.f;
#pragma unroll
        for (int i = 0; i < 16; ++i) ss += o[i] * o[i];
        ss += __shfl_xor(ss, 1); ss += __shfl_xor(ss, 2); ss += __shfl_xor(ss, 4);
        const float rr = 1.0f / sqrtf(ss * (1.0f / 128.0f) + LN_EPS);
        v4u w0, w1;
        w0.x = pk2(o[0] * rr * gsc[0], o[1] * rr * gsc[1]); w0.y = pk2(o[2] * rr * gsc[2], o[3] * rr * gsc[3]); w0.z = pk2(o[4] * rr * gsc[4], o[5] * rr * gsc[5]); w0.w = pk2(o[6] * rr * gsc[6], o[7] * rr * gsc[7]);
        w1.x = pk2(o[8] * rr * gsc[8], o[9] * rr * gsc[9]); w1.y = pk2(o[10] * rr * gsc[10], o[11] * rr * gsc[11]); w1.z = pk2(o[12] * rr * gsc[12], o[13] * rr * gsc[13]); w1.w = pk2(o[14] * rr * gsc[14], o[15] * rr * gsc[15]);
        bf16* po = OA + (size_t)m * 1024 + hh * 128 + d0;
        *(v4u*)po = w0; *(v4u*)(po + 8) = w1;
    }
}

template <bool ROUTE, bool GATHER>
__device__ __forceinline__ void phase_ln(const Frame& F, const float* gam, const float* bet, const float* wr, int moe_j) {
    const float* PRE = WSP(float, A_PRE); const int l = F.lane;
    const bf16* YG = WSP(bf16, A_YG); int* TOKE = WSP(int, A_TOK); float* TOKG = WSP(float, A_TOK + 1 * MiB); const int* TOKR = WSP(int, A_TOK + 2 * MiB);
    int* TOKS = WSP(int, A_TOK + 3 * MiB); int* CNTW = WSP(int, A_TOK + 4 * MiB);
    int rc0 = 0, rc1 = 0, rc2 = 0, rc3 = 0, rc4 = 0, rc5 = 0, rc6 = 0, rc7 = 0; (void)moe_j;
    f32x4 gv[4], bv[4];
#pragma unroll
    for (int j = 0; j < 4; ++j) { gv[j] = *(const f32x4*)(gam + 4 * l + 256 * j); bv[j] = *(const f32x4*)(bet + 4 * l + 256 * j); }
    for (int m = F.gw; m < T; m += F.NGW) {
        const f32x4* xr = (const f32x4*)(PRE + (size_t)m * D) + l;
        f32x4 v[4]; float s = 0.f;
#pragma unroll
        for (int j = 0; j < 4; ++j) v[j] = xr[64 * j];
        if (GATHER) { const int r0 = TOKR[2 * m], r1 = TOKR[2 * m + 1]; const float g0 = TOKG[2 * m], g1 = TOKG[2 * m + 1];
            const v2u* y0 = (const v2u*)(YG + (size_t)r0 * D) + l; const v2u* y1 = (const v2u*)(YG + (size_t)r1 * D) + l;
#pragma unroll
            for (int j = 0; j < 4; ++j) { const v2u a = y0[64 * j], b = y1[64 * j];
                v[j][0] += g0 * bflo(a.x) + g1 * bflo(b.x); v[j][1] += g0 * bfhi(a.x) + g1 * bfhi(b.x); v[j][2] += g0 * bflo(a.y) + g1 * bflo(b.y); v[j][3] += g0 * bfhi(a.y) + g1 * bfhi(b.y); } }
#pragma unroll
        for (int j = 0; j < 4; ++j) s += (v[j][0] + v[j][1]) + (v[j][2] + v[j][3]);
        const float mean = wave_sum(s) * (1.f / D); float s2 = 0.f;
#pragma unroll
        for (int j = 0; j < 4; ++j) { v[j] = v[j] - mean; s2 += (v[j][0] * v[j][0] + v[j][1] * v[j][1]) + (v[j][2] * v[j][2] + v[j][3] * v[j][3]); }
        const float rstd = 1.f / sqrtf(wave_sum(s2) * (1.f / D) + LN_EPS);
        f32x4* orow = (f32x4*)(F.a->out + (size_t)m * D) + l; v2u* br = WSP(v2u, WS_XB) + (size_t)m * (D / 4) + l;
#pragma unroll
        for (int j = 0; j < 4; ++j) { v[j] = v[j] * rstd * gv[j] + bv[j]; orow[64 * j] = v[j]; v2u o; o.x = pk2(v[j][0], v[j][1]); o.y = pk2(v[j][2], v[j][3]); br[64 * j] = o; }
        if (ROUTE) {
            float lg[8];
#pragma unroll
            for (int e = 0; e < 8; ++e) lg[e] = 0.f;
#pragma unroll
            for (int j = 0; j < 4; ++j)
#pragma unroll
                for (int c = 0; c < 4; ++c) { const float* w = wr + (size_t)(4 * l + 256 * j + c) * 8; const f32x4 w0 = *(const f32x4*)w, w1 = *(const f32x4*)(w + 4); const float xv = v[j][c];
                    lg[0] += xv * w0[0]; lg[1] += xv * w0[1]; lg[2] += xv * w0[2]; lg[3] += xv * w0[3]; lg[4] += xv * w1[0]; lg[5] += xv * w1[1]; lg[6] += xv * w1[2]; lg[7] += xv * w1[3]; }
#pragma unroll
            for (int e = 0; e < 8; ++e) lg[e] = wave_sum(lg[e]);
            int e0 = 0; float v0 = lg[0];
#pragma unroll
            for (int e = 1; e < 8; ++e) if (lg[e] > v0) { v0 = lg[e]; e0 = e; }
            int e1 = -1; float v1 = -INFINITY;
#pragma unroll
            for (int e = 0; e < 8; ++e) if (e != e0 && lg[e] > v1) { v1 = lg[e]; e1 = e; }
            const float g1 = 1.0f / (1.0f + expf(v0 - v1)), g0 = 1.0f - g1;
            const int s0 = (e0 == 0) ? rc0 : (e0 == 1) ? rc1 : (e0 == 2) ? rc2 : (e0 == 3) ? rc3 : (e0 == 4) ? rc4 : (e0 == 5) ? rc5 : (e0 == 6) ? rc6 : rc7;
            const int s1 = (e1 == 0) ? rc0 : (e1 == 1) ? rc1 : (e1 == 2) ? rc2 : (e1 == 3) ? rc3 : (e1 == 4) ? rc4 : (e1 == 5) ? rc5 : (e1 == 6) ? rc6 : rc7;
            rc0 += (e0 == 0) + (e1 == 0); rc1 += (e0 == 1) + (e1 == 1); rc2 += (e0 == 2) + (e1 == 2); rc3 += (e0 == 3) + (e1 == 3);
            rc4 += (e0 == 4) + (e1 == 4); rc5 += (e0 == 5) + (e1 == 5); rc6 += (e0 == 6) + (e1 == 6); rc7 += (e0 == 7) + (e1 == 7);
            if (l == 0) { TOKE[2 * m] = e0; TOKE[2 * m + 1] = e1; TOKG[2 * m] = g0; TOKG[2 * m + 1] = g1; TOKS[2 * m] = s0; TOKS[2 * m + 1] = s1; }
        }
    }
    if (ROUTE && l == 0) { int* cw = CNTW + (size_t)F.gw * 8; cw[0] = rc0; cw[1] = rc1; cw[2] = rc2; cw[3] = rc3; cw[4] = rc4; cw[5] = rc5; cw[6] = rc6; cw[7] = rc7; }
}

struct MoeTiles { int pend[8]; int total; };
__device__ __forceinline__ void moe_tiles(const Frame& F, int moe_j, MoeTiles& mt) {
    const int* tot = WSP(int, A_TOK + 5 * MiB); int acc = 0; (void)moe_j;
#pragma unroll
    for (int e = 0; e < 8; ++e) { const int c = tot[e]; acc += (c + 255) >> 8; mt.pend[e] = acc; }
    mt.total = acc;
}
__device__ __forceinline__ void phase_scatter(const Frame& F, int moe_j) {
    (void)moe_j;
    const int* CNTW = WSP(int, A_TOK + 4 * MiB); const int* TOKS = WSP(int, A_TOK + 3 * MiB); int* TOT = WSP(int, A_TOK + 5 * MiB);
    const int* TOKE = WSP(int, A_TOK); int* TOKR = WSP(int, A_TOK + 2 * MiB);
    const v4u* XB = WSP(v4u, WS_XB); v4u* XG = WSP(v4u, A_XG); const int l = F.lane;
    LAS int* red = (LAS int*)F.lds;
    int tot[8], pre[8];
#pragma unroll
    for (int e = 0; e < 8; ++e) { tot[e] = 0; pre[e] = 0; }
    const int wg0 = F.vcu * NWAVES;
    for (int w = F.tid; w < F.NGW; w += NWAVES * 64) { const v4u a = *(const v4u*)(CNTW + (size_t)w * 8), b = *(const v4u*)(CNTW + (size_t)w * 8 + 4); const int below = (w < wg0) ? 1 : 0;
        tot[0] += a.x; tot[1] += a.y; tot[2] += a.z; tot[3] += a.w; tot[4] += b.x; tot[5] += b.y; tot[6] += b.z; tot[7] += b.w;
        pre[0] += below * (int)a.x; pre[1] += below * (int)a.y; pre[2] += below * (int)a.z; pre[3] += below * (int)a.w; pre[4] += below * (int)b.x; pre[5] += below * (int)b.y; pre[6] += below * (int)b.z; pre[7] += below * (int)b.w; }
#pragma unroll
    for (int e = 0; e < 8; ++e) {
#pragma unroll
        for (int o = 1; o < 64; o <<= 1) { tot[e] += __shfl_xor(tot[e], o); pre[e] += __shfl_xor(pre[e], o); } }
    if (l == 0) {
#pragma unroll
        for (int e = 0; e < 8; ++e) { red[F.wave * 16 + e] = tot[e]; red[F.wave * 16 + 8 + e] = pre[e]; } }
    __syncthreads();
    int base[8]; int acc = 0;
#pragma unroll
    for (int e = 0; e < 8; ++e) { int t = 0, p = 0;
#pragma unroll
        for (int w = 0; w < NWAVES; ++w) { t += red[w * 16 + e]; p += red[w * 16 + 8 + e]; }
        int mine = 0;
#pragma unroll
        for (int w = 0; w < NWAVES; ++w) { const int c = CNTW[(size_t)(wg0 + w) * 8 + e]; mine += (w < F.wave) ? c : 0; }
        base[e] = acc * 256 + p + mine; acc += (t + 255) >> 8;
        if (F.vcu == 0 && F.tid == 0) TOT[e] = t; }
    __syncthreads();
    for (int m = F.gw; m < T; m += F.NGW) {
        int rows[2];
#pragma unroll
        for (int k = 0; k < 2; ++k) { const int e = TOKE[2 * m + k]; const int sl = TOKS[2 * m + k];
            const int bs = (e == 0) ? base[0] : (e == 1) ? base[1] : (e == 2) ? base[2] : (e == 3) ? base[3] : (e == 4) ? base[4] : (e == 5) ? base[5] : (e == 6) ? base[6] : base[7];
            rows[k] = bs + sl; }
        const v4u a = XB[(size_t)m * 128 + l], b = XB[(size_t)m * 128 + 64 + l];
        XG[(size_t)rows[0] * 128 + l] = a; XG[(size_t)rows[0] * 128 + 64 + l] = b; XG[(size_t)rows[1] * 128 + l] = a; XG[(size_t)rows[1] * 128 + 64 + l] = b;
        if (l == 0) { TOKR[2 * m] = rows[0]; TOKR[2 * m + 1] = rows[1]; }
    }
}

__device__ __forceinline__ void phase_attn_diff(const Frame& F) {
    att::AttnP P; P.Q = WSP(bf16, A_DQ); P.ldq = 1024; P.K1 = WSP(bf16, A_DK); P.ldk1 = 1024; P.K2 = P.K1; P.ldk2 = 1024; P.V = WSP(bf16, A_DV); P.ldv = 1024; P.O = WSP(bf16, A_OA2); P.ldo = 2048;
    P.pos = (const int*)F.a->in[2]; P.blkmax = WSP(int, WS_MISC); P.lut = WSP(float, WS_MISC + 4096);
    for (int p = F.vcu; p < BATCH * 16 * 8; p += F.G) {
        const int bh = p >> 3, i = p & 7, b = bh >> 4, vh = bh & 15;
        att::attn_unit<64, 64, 128, true>(P, b, 15 - i, vh * 64, vh * 64, (vh >> 1) * 128, vh * 128, vh >> 1, F.lds);
        att::attn_unit<64, 64, 128, true>(P, b, i, vh * 64, vh * 64, (vh >> 1) * 128, vh * 128, vh >> 1, F.lds);
    }
}
__device__ __forceinline__ void phase_attn_mla(const Frame& F) {
    att::AttnP P; P.Q = WSP(bf16, A_MQ); P.ldq = 768; P.K1 = WSP(bf16, A_MKV); P.ldk1 = 1024; P.K2 = WSP(bf16, A_MKR); P.ldk2 = 32; P.V = WSP(bf16, A_MKV); P.ldv = 1024; P.O = WSP(bf16, A_OB); P.ldo = 512;
    P.pos = (const int*)F.a->in[2]; P.blkmax = WSP(int, WS_MISC); P.lut = WSP(float, WS_MISC + 4096);
    for (int p = F.vcu; p < BATCH * 8 * 8; p += F.G) {
        const int bh = p >> 3, i = p & 7, b = bh >> 3, hh = bh & 7;
        att::attn_unit<96, 64, 64, false>(P, b, 15 - i, hh * 96, hh * 128, hh * 128 + 64, hh * 64, 0, F.lds);
        att::attn_unit<96, 64, 64, false>(P, b, i, hh * 96, hh * 128, hh * 128 + 64, hh * 64, 0, F.lds);
    }
}

constexpr int NPH_DENSE = 10, NPH_MOE = 9 + 2 * MOE_NCHUNK, NPH_TOTAL = 1 + 2 * NPH_DENSE + 2 * NPH_MOE;
#define GEMM_CALL(EPI, SCHED, gm, S_, E_) pg8::gemm_phase<EPI, SCHED, true, true>(F.lds, gm, S_, E_)

__global__ void __launch_bounds__(NWAVES * 64, 2) mega_fwd(Args args) {
    extern __shared__ __attribute__((aligned(16))) unsigned char lds_raw[];
    Frame F;
    F.lds = (LAS unsigned char*)lds_raw; F.a = &args; F.ws = args.ws;
    F.tid = threadIdx.x; F.lane = F.tid & 63; F.wave = __builtin_amdgcn_readfirstlane(F.tid >> 6);
    F.G = gridDim.x; { const int bx = blockIdx.x; F.vcu = (F.G % 8 == 0) ? (bx % 8) * (F.G / 8) + bx / 8 : bx; }
    F.gw = F.vcu * NWAVES + F.wave; F.NGW = F.G * NWAVES;
    volatile LAS unsigned* MISC = (volatile LAS unsigned*)(F.lds + MISC_OFF);
    for (int u = F.tid; u < (LDS_BYTES - RING_BYTES) / 4; u += NWAVES * 64) ((LAS unsigned*)(F.lds + RING_BYTES))[u] = 0u;
    __syncthreads();
    const int lo = args.ph_lo, hi = args.ph_hi;
    XcdBarrier bar; bar.bar = WSP(unsigned, WS_CTL) + CW_BAR; bar.x = 0; bar.st = nullptr;
    if (hi - lo > 1) bar = xcd_barrier_post(WSP(unsigned, WS_CTL) + CW_BAR, MISC + 8);
    int pc = 0;
#define PH_BEGIN if (pc >= lo && pc < hi) { { int t_ = threadIdx.x; asm volatile("" : "+v"(t_)); F.tid = t_; F.lane = t_ & 63; F.wave = __builtin_amdgcn_readfirstlane(t_ >> 6); F.gw = F.vcu * NWAVES + F.wave; }
#define PH_END if (pc + 1 < hi) { for (int rb = 0; rb < REP_BAR; ++rb) xcd_barrier(bar); } } ++pc;
    const int bx = (int)blockIdx.x;
    const float ALPHA = 1.6817928305074290f;

    PH_BEGIN for (int rep = 0; rep < REP_P0; ++rep) phase_prologue(F); PH_END

    for (int L = 0; L < DEPTH; ++L) {
        const int mj = L >> 1;
        PH_BEGIN {
            pg8::Gemm g{WSP(bf16, WS_XB), WSP(bf16, W_IN), T, NIN, D}; pg8::StaticOrder S; S.init(T, NIN, F.G, bx);
            pg8::EpiL1 E{WSP(bf16, A_DQ), WSP(bf16, A_G), WSP(float, A_CQ), INF(5) + L * 2048, 0.125f * LOG2E};
            for (int rep = 0; rep < REP_L1; ++rep) GEMM_CALL(pg8::EpiL1, pg8::StaticOrder, g, S, E);
        } PH_END
        PH_BEGIN for (int rep = 0; rep < REP_EW; ++rep) phase_rms_rope(F); PH_END
        PH_BEGIN {
            for (int rep = 0; rep < REP_MIX; ++rep) {
            { pg8::Gemm g{WSP(bf16, A_CQN), WSP(bf16, W_UQ), T, 768, QR}; pg8::StaticOrder S; S.init(T, 768, F.G, bx);
              pg8::EpiRopeQ E{WSP(bf16, A_MQ), WSP(float, WS_ROPE), 0.10206207261596577f * LOG2E};
              GEMM_CALL(pg8::EpiRopeQ, pg8::StaticOrder, g, S, E); }
            { pg8::Gemm g{WSP(bf16, A_CKVN), WSP(bf16, W_UKV), T, 1024, KVR}; pg8::StaticOrder S; S.init(T, 1024, F.G, bx);
              pg8::EpiBf16 E{WSP(bf16, A_MKV), 1024};
              GEMM_CALL(pg8::EpiBf16, pg8::StaticOrder, g, S, E); }
            }
            for (int rep = 0; rep < REP_ATTN_D; ++rep) phase_attn_diff(F);
        } PH_END
        PH_BEGIN { for (int rep = 0; rep < REP_ATTN_M; ++rep) phase_attn_mla(F); for (int rep = 0; rep < REP_EW; ++rep) phase_combine(F, L); } PH_END
        PH_BEGIN {
            for (int rep = 0; rep < REP_MIX; ++rep) {
            { pg8::Gemm g{WSP(bf16, A_OB), WSP(bf16, W_BM), T, D, 512}; pg8::StaticOrder S; S.init(T, D, F.G, bx);
              pg8::EpiGate<false> E{WSP(bf16, A_MT), WSP(bf16, A_G), nullptr, 1024};
              GEMM_CALL(pg8::EpiGate<false>, pg8::StaticOrder, g, S, E); }
            { pg8::Gemm g{WSP(bf16, A_OA), WSP(bf16, W_BD), T, D, D}; pg8::StaticOrder S; S.init(T, D, F.G, bx);
              pg8::EpiGate<true> E{WSP(bf16, A_M), WSP(bf16, A_G), WSP(bf16, A_MT), 0};
              GEMM_CALL(pg8::EpiGate<true>, pg8::StaticOrder, g, S, E); }
            }
        } PH_END
        PH_BEGIN {
            pg8::Gemm g{WSP(bf16, A_M), WSP(bf16, W_OUT), T, D, D}; pg8::StaticOrder S; S.init(T, D, F.G, bx);
            pg8::EpiF32<1> E{WSP(float, A_PRE), args.out, ALPHA};
            for (int rep = 0; rep < REP_MIX; ++rep) GEMM_CALL(pg8::EpiF32<1>, pg8::StaticOrder, g, S, E);
        } PH_END
        PH_BEGIN {
            if (L & 1) phase_ln<true, false>(F, INF(18) + L * D, INF(19) + L * D, INF(23) + (size_t)mj * D * NEXP, mj);
            else for (int rep = 0; rep < REP_LN; ++rep) phase_ln<false, false>(F, INF(18) + L * D, INF(19) + L * D, nullptr, 0);
        } PH_END
        if ((L & 1) == 0) {
            PH_BEGIN {
                for (int rep = 0; rep < REP_FFN; ++rep) {
                { pg8::Gemm g{WSP(bf16, WS_XB), WSP(bf16, W_F13), T, 2 * DENSE_FF, D}; pg8::StaticOrder S; S.init(T, 2 * DENSE_FF, F.G, bx);
                  pg8::EpiSwiGLU E{WSP(bf16, A_H), DENSE_FF};
                  GEMM_CALL(pg8::EpiSwiGLU, pg8::StaticOrder, g, S, E); }
                { pg8::Gemm g{WSP(bf16, WS_PB), WSP(bf16, W_PP), T, D, PLE}; pg8::StaticOrder S; S.init(T, D, F.G, bx);
                  pg8::EpiF32<0> E{WSP(float, A_PRE), nullptr, 0.f};
                  GEMM_CALL(pg8::EpiF32<0>, pg8::StaticOrder, g, S, E); }
                { pg8::Gemm g{WSP(bf16, WS_XB), WSP(bf16, W_PG), T, D, D}; pg8::StaticOrder S; S.init(T, D, F.G, bx);
                  pg8::EpiF32<2> E{WSP(float, A_PRE), args.out, ALPHA};
                  GEMM_CALL(pg8::EpiF32<2>, pg8::StaticOrder, g, S, E); }
                }
            } PH_END
            PH_BEGIN {
                pg8::Gemm g{WSP(bf16, A_H), WSP(bf16, W_F2D), T, D, DENSE_FF}; pg8::StaticOrder S; S.init(T, D, F.G, bx);
                pg8::EpiF32<3> E{WSP(float, A_PRE), nullptr, 0.f};
                GEMM_CALL(pg8::EpiF32<3>, pg8::StaticOrder, g, S, E);
            } PH_END
            PH_BEGIN { for (int rep = 0; rep < REP_LN; ++rep) phase_ln<false, false>(F, INF(29) + L * D, INF(30) + L * D, nullptr, 0); if (L + 1 < DEPTH) for (int rep = 0; rep < REP_CONV; ++rep) phase_convert(F, L + 1); } PH_END
        } else {
            PH_BEGIN {
                phase_scatter(F, mj);
                for (int rep = 0; rep < REP_PPE; ++rep) {
                { pg8::Gemm g{WSP(bf16, WS_PB), WSP(bf16, W_PP), T, D, PLE}; pg8::StaticOrder S; S.init(T, D, F.G, bx);
                  pg8::EpiF32<0> E{WSP(float, A_PRE), nullptr, 0.f};
                  GEMM_CALL(pg8::EpiF32<0>, pg8::StaticOrder, g, S, E); }
                { pg8::Gemm g{WSP(bf16, WS_XB), WSP(bf16, W_PG), T, D, D}; pg8::StaticOrder S; S.init(T, D, F.G, bx);
                  pg8::EpiF32<2> E{WSP(float, A_PRE), args.out, ALPHA};
                  GEMM_CALL(pg8::EpiF32<2>, pg8::StaticOrder, g, S, E); }
                }
            } PH_END
            for (int ch = 0; ch < MOE_NCHUNK; ++ch) {
                PH_BEGIN {
                    MoeTiles mt; moe_tiles(F, mj, mt);
                    const int tlo = ch * MOE_CHUNK_TILES; int ntc = mt.total - tlo; ntc = ntc > MOE_CHUNK_TILES ? MOE_CHUNK_TILES : ntc;
                    if (ntc > 0) {
                        pg8::Gemm g{WSP(bf16, A_XG) + (size_t)tlo * 256 * D, WSP(bf16, W_F13), ntc * 256, 2 * EXPERT_FF, D};
                        pg8::GroupedOrder S; S.init(ntc * 256, 2 * EXPERT_FF, F.G, bx); S.tile_lo = tlo; S.estride = (size_t)2 * EXPERT_FF * D * 2;
                        S.pend0 = mt.pend[0]; S.pend1 = mt.pend[1]; S.pend2 = mt.pend[2]; S.pend3 = mt.pend[3]; S.pend4 = mt.pend[4]; S.pend5 = mt.pend[5]; S.pend6 = mt.pend[6]; S.pend7 = mt.pend[7];
                        pg8::EpiSwiGLU E{WSP(bf16, A_HG), EXPERT_FF};
                        for (int rep = 0; rep < REP_MOE; ++rep) GEMM_CALL(pg8::EpiSwiGLU, pg8::GroupedOrder, g, S, E);
                    }
                } PH_END
                PH_BEGIN {
                    MoeTiles mt; moe_tiles(F, mj, mt);
                    const int tlo = ch * MOE_CHUNK_TILES; int ntc = mt.total - tlo; ntc = ntc > MOE_CHUNK_TILES ? MOE_CHUNK_TILES : ntc;
                    if (ntc > 0) {
                        pg8::Gemm g{WSP(bf16, A_HG), WSP(bf16, W_F2E), ntc * 256, D, EXPERT_FF};
                        pg8::GroupedOrder S; S.init(ntc * 256, D, F.G, bx); S.tile_lo = tlo; S.estride = (size_t)D * EXPERT_FF * 2;
                        S.pend0 = mt.pend[0]; S.pend1 = mt.pend[1]; S.pend2 = mt.pend[2]; S.pend3 = mt.pend[3]; S.pend4 = mt.pend[4]; S.pend5 = mt.pend[5]; S.pend6 = mt.pend[6]; S.pend7 = mt.pend[7];
                        pg8::EpiBf16 E{WSP(bf16, A_YG) + (size_t)tlo * 256 * D, D};
                        for (int rep = 0; rep < REP_MOE; ++rep) GEMM_CALL(pg8::EpiBf16, pg8::GroupedOrder, g, S, E);
                    }
                } PH_END
            }
            PH_BEGIN { for (int rep = 0; rep < REP_LN; ++rep) phase_ln<false, true>(F, INF(29) + L * D, INF(30) + L * D, nullptr, 0); if (L + 1 < DEPTH) for (int rep = 0; rep < REP_CONV; ++rep) phase_convert(F, L + 1); } PH_END
        }
    }
#undef PH_BEGIN
#undef PH_END
}

extern "C" void kernel_launch(void* const* d_in, const int* in_sizes, int n_in, void* d_out, int out_size, void* d_ws, size_t ws_size, hipStream_t stream) {
    static int grid = 0;
    if (grid == 0) {
        if (n_in != 31 || in_sizes[0] != T * D || out_size != T * D || ws_size < WS_END) { fprintf(stderr, "kernel_launch: unexpected shapes / workspace (n_in %d, ws %zu < %zu)\n", n_in, ws_size, (size_t)WS_END); grid = -1; return; }
        int dev = 0, cus = 0, per_cu = 0;
        if (hipGetDevice(&dev) != hipSuccess || hipDeviceGetAttribute(&cus, hipDeviceAttributeMultiprocessorCount, dev) != hipSuccess) { grid = -1; return; }
        if (hipFuncSetAttribute((const void*)mega_fwd, hipFuncAttributeMaxDynamicSharedMemorySize, LDS_BYTES) != hipSuccess) { fprintf(stderr, "kernel_launch: hipFuncSetAttribute failed\n"); grid = -1; return; }
        if (hipOccupancyMaxActiveBlocksPerMultiprocessor(&per_cu, (const void*)mega_fwd, NWAVES * 64, LDS_BYTES) != hipSuccess || per_cu < 1) { fprintf(stderr, "kernel_launch: occupancy query says %d\n", per_cu); (void)hipGetLastError(); grid = -1; return; }
        grid = cus;
    }
    if (grid < 0) return;
    if (hipMemsetAsync((char*)d_ws + WS_CTL, 0, CTL_ZERO_BYTES, stream) != hipSuccess) return;
    Args a{};
    for (int i = 0; i < 31; ++i) a.in[i] = d_in[i];
    a.out = (float*)d_out; a.ws = (unsigned char*)d_ws;
#if MK_PER_PHASE
    for (int p = 0; p < NPH_TOTAL; ++p) { a.ph_lo = p; a.ph_hi = p + 1; hipLaunchKernelGGL(mega_fwd, dim3(grid), dim3(NWAVES * 64), LDS_BYTES, stream, a); }
#else
    a.ph_lo = 0; a.ph_hi = NPH_TOTAL;
    hipLaunchKernelGGL(mega_fwd, dim3(grid), dim3(NWAVES * 64), LDS_BYTES, stream, a);
#endif
}
```

```cpp
#define ATT_UNIT attn_unit
#define ATT_PRIO 0
#include <hip/hip_runtime.h>
#include <cstdio>
#include <cstdint>
#include <cmath>

#ifndef MK_PER_PHASE
#define MK_PER_PHASE 0
#endif

constexpr int BATCH = 8, SEQ = 4096, T = BATCH * SEQ, D = 1024, DEPTH = 4, PLE = 256;
constexpr int IN_COLS = 5792, NIN = 5888;
constexpr int QR = 384, KVR = 256, ROPE_D = 32;
constexpr int DENSE_FF = 2816, EXPERT_FF = 3584, NEXP = 8;
constexpr float LN_EPS = 1e-5f;
constexpr float LOG2E = 1.4426950408889634f;
constexpr int MOE_ROWS = 2 * T + NEXP * 256;
constexpr int MOE_CHUNK_TILES = 128;
constexpr int MOE_NCHUNK = 3;

#define GAS __attribute__((address_space(1)))
#define LAS __attribute__((address_space(3)))
typedef unsigned short bf16;
typedef unsigned v4u __attribute__((ext_vector_type(4)));
typedef unsigned v2u __attribute__((ext_vector_type(2)));
typedef float f32x4 __attribute__((ext_vector_type(4)));
typedef float f32x2 __attribute__((ext_vector_type(2)));
typedef float f32x16 __attribute__((ext_vector_type(16)));
typedef short bf16x8 __attribute__((ext_vector_type(8)));
typedef short s16x4 __attribute__((ext_vector_type(4)));
typedef __bf16 bf16x2_t __attribute__((ext_vector_type(2)));
typedef GAS unsigned gu32;
#define RLX_AGENT __ATOMIC_RELAXED, __HIP_MEMORY_SCOPE_AGENT
#define LDS_WAIT() asm volatile("s_waitcnt lgkmcnt(0)" ::: "memory")
#define VM_WAIT() asm volatile("s_waitcnt vmcnt(0)" ::: "memory")

__device__ __forceinline__ unsigned pk2(float lo, float hi) { f32x2 v = {lo, hi}; bf16x2_t b = __builtin_convertvector(v, bf16x2_t); return __builtin_bit_cast(unsigned, b); }
__device__ __forceinline__ float bflo(unsigned u) { return __uint_as_float(u << 16); }
__device__ __forceinline__ float bfhi(unsigned u) { return __uint_as_float(u & 0xffff0000u); }
__device__ __forceinline__ float sigmoidf_(float x) { return __builtin_amdgcn_rcpf(1.0f + __builtin_amdgcn_exp2f(-x * LOG2E)); }
__device__ __forceinline__ float shx(float v, int o, int lane) { return __uint_as_float((unsigned)__builtin_amdgcn_ds_bpermute((lane ^ o) << 2, (int)__float_as_uint(v))); }
__device__ __forceinline__ int shxi(int v, int o, int lane) { return __builtin_amdgcn_ds_bpermute((lane ^ o) << 2, v); }
__device__ __forceinline__ float wave_sum(int lane, float v) {
#pragma unroll
    for (int o = 1; o < 64; o <<= 1) v += shx(v, o, lane);
    return v;
}

namespace pg8 {
#define PG8_LAS __attribute__((address_space(3)))
typedef unsigned short bf16_t;
typedef unsigned u32x4 __attribute__((ext_vector_type(4)));
typedef unsigned u32x2 __attribute__((ext_vector_type(2)));
constexpr int BM = 256, BK = 64, HALF = 128, HTB = HALF * BK * 2  , STAGE_BYTES = 8 * HTB, NXCD = 8, WGM = 8;

__host__ __device__ __forceinline__ int lds_byte(int r, int c) { const int st = (r >> 4) * 2 + (c >> 5), rr = r & 15, cc = c & 31, ob = rr * 64 + cc * 2; return st * 1024 + (ob ^ (((ob >> 9) & 1) << 5)); }
__host__ __device__ __forceinline__ void stage_rc(int b, int& R, int& C) { const int st = b / 1024, sb = b % 1024, swz = sb ^ (((sb >> 9) & 1) << 5); R = (st >> 1) * 16 + swz / 64; C = (st & 1) * 32 + (swz % 64) / 2; }
__host__ __device__ __forceinline__ int perm32(int rho) { const int n = rho >> 4, i = rho & 15; return 8 * (i >> 2) + 4 * n + (i & 3); }

struct Unit { int pm, pn; };
struct Gemm { const bf16_t* A; const bf16_t* Bt; int M, N, K; };

struct StaticOrder {
    int nM, nN, nwg, G, c;
    __host__ __device__ void init(int M, int N, int G_, int c_) { nM = M / BM; nN = N / BM; nwg = nM * nN; G = G_; c = c_; }
    __host__ __device__ bool next(int i, Unit& u) const {
        const long L = (long)i * G + c; if (L >= nwg) return false;
        int wgid = (int)L; { const int q = nwg / NXCD, r = nwg % NXCD, xcd = wgid % NXCD, off = wgid / NXCD; wgid = (xcd < r ? xcd * (q + 1) : r * (q + 1) + (xcd - r) * q) + off; }
        const int nig = WGM * nN, gid = wgid / nig, fm = gid * WGM, gsz = (nM - fm) < WGM ? (nM - fm) : WGM;
        u.pm = fm + ((wgid % nig) % gsz); u.pn = (wgid % nig) / gsz; return true;
    }
    __device__ __forceinline__ size_t bofs(const Unit&) const { return 0; }
    __device__ __forceinline__ void a_ready(const Unit&) const {}
    __device__ __forceinline__ void done(const Unit&) const {}
};
struct GroupedOrder : StaticOrder {
    int tile_lo; int pend0, pend1, pend2, pend3, pend4, pend5, pend6, pend7; size_t estride;
    __device__ __forceinline__ size_t bofs(const Unit& u) const {
        const int t = u.pm + tile_lo;
        const int e = (t >= pend0) + (t >= pend1) + (t >= pend2) + (t >= pend3) + (t >= pend4) + (t >= pend5) + (t >= pend6);
        return (size_t)e * estride;
    }
};

typedef f32x4 Acc[2][2][4][2];

struct EpiL1 {
    static constexpr bool PERM = true, AFTER_DRAIN = false;
    bf16_t* QKV; bf16_t* Gt; float* CQ; const float* bgate; float qscale;
    __device__ __forceinline__ void operator()(const Acc& acc, const Unit& u, int wr, int wc, int fr, int fq) const {
        const int row0 = u.pm * BM + wr * 64 + fr; const int pn = u.pn;
        if (pn < 12) {
            bf16_t* base = QKV + (size_t)(pn >> 2) * ((size_t)T * 1024); const int col0 = (pn & 3) * 256 + wc * 32 + 8 * fq; const float sc = pn < 4 ? qscale : 1.f;
#pragma unroll
            for (int ai = 0; ai < 2; ++ai)
#pragma unroll
                for (int m = 0; m < 4; ++m) { bf16_t* rowp = base + (size_t)(row0 + ai * HALF + m * 16) * 1024 + col0;
#pragma unroll
                    for (int bj = 0; bj < 2; ++bj) { const f32x4 v0 = acc[ai][bj][m][0] * sc, v1 = acc[ai][bj][m][1] * sc;
                        u32x4 w; w.x = pk2(v0[0], v0[1]); w.y = pk2(v0[2], v0[3]); w.z = pk2(v1[0], v1[1]); w.w = pk2(v1[2], v1[3]);
                        *(u32x4*)(rowp + bj * HALF) = w; } }
        } else if (pn < 20) {
            const int col0 = (pn - 12) * 256 + wc * 32 + 8 * fq;
            f32x4 bv[2][2];
#pragma unroll
            for (int bj = 0; bj < 2; ++bj)
#pragma unroll
                for (int n = 0; n < 2; ++n) bv[bj][n] = *(const f32x4*)(bgate + col0 + bj * HALF + 4 * n);
#pragma unroll
            for (int ai = 0; ai < 2; ++ai)
#pragma unroll
                for (int m = 0; m < 4; ++m) { bf16_t* rowp = Gt + (size_t)(row0 + ai * HALF + m * 16) * 2048 + col0;
#pragma unroll
                    for (int bj = 0; bj < 2; ++bj) { const f32x4 v0 = acc[ai][bj][m][0] + bv[bj][0], v1 = acc[ai][bj][m][1] + bv[bj][1];
                        u32x4 w; w.x = pk2(sigmoidf_(v0[0]), sigmoidf_(v0[1])); w.y = pk2(sigmoidf_(v0[2]), sigmoidf_(v0[3])); w.z = pk2(sigmoidf_(v1[0]), sigmoidf_(v1[1])); w.w = pk2(sigmoidf_(v1[2]), sigmoidf_(v1[3]));
                        *(u32x4*)(rowp + bj * HALF) = w; } }
        } else {
            const int col0 = (pn - 20) * 256 + wc * 32 + 8 * fq;
#pragma unroll
            for (int ai = 0; ai < 2; ++ai)
#pragma unroll
                for (int m = 0; m < 4; ++m) { float* rowp = CQ + (size_t)(row0 + ai * HALF + m * 16) * 768 + col0;
#pragma unroll
                    for (int bj = 0; bj < 2; ++bj) { *(f32x4*)(rowp + bj * HALF) = acc[ai][bj][m][0]; *(f32x4*)(rowp + bj * HALF + 4) = acc[ai][bj][m][1]; } }
        }
    }
};
struct EpiRopeQ {
    static constexpr bool PERM = false, AFTER_DRAIN = false;
    bf16_t* O; const float* rope; float qscale;
    __device__ __forceinline__ void operator()(const Acc& acc, const Unit& u, int wr, int wc, int fr, int fq) const {
        const int row0 = u.pm * BM + wr * 64 + fr;
#pragma unroll
        for (int ai = 0; ai < 2; ++ai)
#pragma unroll
            for (int m = 0; m < 4; ++m) { const int row = row0 + ai * HALF + m * 16;
                const f32x4 cs0 = *(const f32x4*)(rope + (size_t)row * 32 + fq * 8), cs1 = *(const f32x4*)(rope + (size_t)row * 32 + fq * 8 + 4);
                const f32x4 cc = {cs0[0], cs0[2], cs1[0], cs1[2]}, ss = {cs0[1], cs0[3], cs1[1], cs1[3]};
#pragma unroll
                for (int bj = 0; bj < 2; ++bj) { const int colg = u.pn * BM + bj * HALF + wc * 32; const bool isr = ((colg >> 5) % 3) == 2;
                    const f32x4 x1 = acc[ai][bj][m][0], x2 = acc[ai][bj][m][1];
                    f32x4 o1 = x1, o2 = x2; if (isr) { o1 = x1 * cc - x2 * ss; o2 = x1 * ss + x2 * cc; }
                    o1 = o1 * qscale; o2 = o2 * qscale;
                    bf16_t* p = O + (size_t)row * 768 + colg + 4 * fq;
                    u32x2 w1; w1.x = pk2(o1[0], o1[1]); w1.y = pk2(o1[2], o1[3]); u32x2 w2; w2.x = pk2(o2[0], o2[1]); w2.y = pk2(o2[2], o2[3]);
                    *(u32x2*)p = w1; *(u32x2*)(p + 16) = w2; } }
    }
};
struct EpiBf16 {
    static constexpr bool PERM = true, AFTER_DRAIN = false;
    bf16_t* O; int ldc;
    __device__ __forceinline__ void operator()(const Acc& acc, const Unit& u, int wr, int wc, int fr, int fq) const {
        const int row0 = u.pm * BM + wr * 64 + fr, col0 = u.pn * BM + wc * 32 + 8 * fq;
#pragma unroll
        for (int ai = 0; ai < 2; ++ai)
#pragma unroll
            for (int m = 0; m < 4; ++m) { bf16_t* rowp = O + (size_t)(row0 + ai * HALF + m * 16) * ldc + col0;
#pragma unroll
                for (int bj = 0; bj < 2; ++bj) { const f32x4 v0 = acc[ai][bj][m][0], v1 = acc[ai][bj][m][1];
                    u32x4 w; w.x = pk2(v0[0], v0[1]); w.y = pk2(v0[2], v0[3]); w.z = pk2(v1[0], v1[1]); w.w = pk2(v1[2], v1[3]);
                    *(u32x4*)(rowp + bj * HALF) = w; } }
    }
};
template <bool ADD> struct EpiGate {
    static constexpr bool PERM = true, AFTER_DRAIN = false;
    bf16_t* O; const bf16_t* Gt; const bf16_t* MT; int goff;
    __device__ __forceinline__ void operator()(const Acc& acc, const Unit& u, int wr, int wc, int fr, int fq) const {
        const int row0 = u.pm * BM + wr * 64 + fr, col0 = u.pn * BM + wc * 32 + 8 * fq;
#pragma unroll
        for (int ai = 0; ai < 2; ++ai)
#pragma unroll
            for (int m = 0; m < 4; ++m) { const size_t row = (size_t)(row0 + ai * HALF + m * 16);
#pragma unroll
                for (int bj = 0; bj < 2; ++bj) { const int col = col0 + bj * HALF;
                    const u32x4 gv = *(const u32x4*)(Gt + row * 2048 + goff + col);
                    f32x4 v0 = acc[ai][bj][m][0], v1 = acc[ai][bj][m][1];
                    v0[0] *= bflo(gv.x); v0[1] *= bfhi(gv.x); v0[2] *= bflo(gv.y); v0[3] *= bfhi(gv.y); v1[0] *= bflo(gv.z); v1[1] *= bfhi(gv.z); v1[2] *= bflo(gv.w); v1[3] *= bfhi(gv.w);
                    if (ADD) { const u32x4 mv = *(const u32x4*)(MT + row * 1024 + col);
                        v0[0] += bflo(mv.x); v0[1] += bfhi(mv.x); v0[2] += bflo(mv.y); v0[3] += bfhi(mv.y); v1[0] += bflo(mv.z); v1[1] += bfhi(mv.z); v1[2] += bflo(mv.w); v1[3] += bfhi(mv.w); }
                    u32x4 w; w.x = pk2(v0[0], v0[1]); w.y = pk2(v0[2], v0[3]); w.z = pk2(v1[0], v1[1]); w.w = pk2(v1[2], v1[3]);
                    *(u32x4*)(O + row * 1024 + col) = w; } }
    }
};
template <int MODE> struct EpiF32 {
    static constexpr bool PERM = false, AFTER_DRAIN = false;
    float* P; const float* X; float alpha;
    __device__ __forceinline__ void operator()(const Acc& acc, const Unit& u, int wr, int wc, int fr, int fq) const {
        const int row0 = u.pm * BM + wr * 64 + fr, col0 = u.pn * BM + wc * 32 + 4 * fq;
#pragma unroll
        for (int ai = 0; ai < 2; ++ai)
#pragma unroll
            for (int m = 0; m < 4; ++m) { const size_t off = (size_t)(row0 + ai * HALF + m * 16) * 1024 + col0;
#pragma unroll
                for (int bj = 0; bj < 2; ++bj)
#pragma unroll
                    for (int n = 0; n < 2; ++n) { const size_t o = off + bj * HALF + n * 16; const f32x4 a = acc[ai][bj][m][n]; f32x4 r;
                        if (MODE == 0) r = a;
                        else if (MODE == 1) r = *(const f32x4*)(X + o) * alpha + a;
                        else if (MODE == 2) { const f32x4 pv = *(const f32x4*)(P + o); const f32x4 xv = *(const f32x4*)(X + o);
                            r[0] = xv[0] * alpha + sigmoidf_(a[0]) * pv[0]; r[1] = xv[1] * alpha + sigmoidf_(a[1]) * pv[1]; r[2] = xv[2] * alpha + sigmoidf_(a[2]) * pv[2]; r[3] = xv[3] * alpha + sigmoidf_(a[3]) * pv[3]; }
                        else r = *(const f32x4*)(P + o) + a;
                        *(f32x4*)(P + o) = r; } }
    }
};
struct EpiSwiGLU {
    static constexpr bool PERM = true, AFTER_DRAIN = false;
    bf16_t* H; int ldc;
    __device__ __forceinline__ void operator()(const Acc& acc, const Unit& u, int wr, int wc, int fr, int fq) const {
        const int row0 = u.pm * BM + wr * 64 + fr, col0 = (u.pn * BM + wc * 32 + 8 * fq) >> 1;
#pragma unroll
        for (int ai = 0; ai < 2; ++ai)
#pragma unroll
            for (int m = 0; m < 4; ++m) { bf16_t* rowp = H + (size_t)(row0 + ai * HALF + m * 16) * ldc + col0;
#pragma unroll
                for (int bj = 0; bj < 2; ++bj) { const f32x4 v0 = acc[ai][bj][m][0], v1 = acc[ai][bj][m][1];
                    const float h0 = v0[0] * sigmoidf_(v0[0]) * v0[1], h1 = v0[2] * sigmoidf_(v0[2]) * v0[3], h2 = v1[0] * sigmoidf_(v1[0]) * v1[1], h3 = v1[2] * sigmoidf_(v1[2]) * v1[3];
                    u32x2 w; w.x = pk2(h0, h1); w.y = pk2(h2, h3);
                    *(u32x2*)(rowp + bj * (HALF / 2)) = w; } }
    }
};

template <class Epi, class Sched, bool ALIGN_EPI = false, bool SP2 = false>
__device__ __forceinline__ void gemm_phase(PG8_LAS unsigned char* lds, const Gemm g, const Sched& S, const Epi& E) {
    int tid_ = threadIdx.x; asm volatile("" : "+v"(tid_));
    const int tid = tid_, wid = __builtin_amdgcn_readfirstlane(tid >> 6), lane = tid & 63, wr = wid >> 2, wc = wid & 3, fr = lane & 15, fq = lane >> 4;
    int K_ = g.K; asm volatile("" : "+s"(K_)); const int K = K_, nt = K / BK;
    unsigned voffA[2], voffB[2];
#pragma unroll
    for (int i = 0; i < 2; ++i) { int R, C; stage_rc(tid * 16 + i * 8192, R, C); const int Rb = Epi::PERM ? ((R & ~31) + perm32(R & 31)) : R;
        voffA[i] = (unsigned)(R * K + C) * 2u; voffB[i] = (unsigned)(Rb * K + C) * 2u; }
    const size_t kstep = (size_t)(BK * 2);
    const size_t hstep = (size_t)HALF * K * 2;
    const size_t tstep = 2 * hstep;
    const unsigned ldsw = (unsigned)wid * 1024u;
    const int aoff = lds_byte(wr * 64 + fr, fq * 8), boff = lds_byte(wc * 32 + fr, fq * 8);
#define PG8_SA(b, h) (((b) * 2 + (h)) * HTB)
#define PG8_SB(b, h) ((4 + (b) * 2 + (h)) * HTB)
#define PG8_STAGE(bufoff, gbase, voff) do { _Pragma("unroll") for (int _i = 0; _i < 2; ++_i) \
        __builtin_amdgcn_global_load_lds((const unsigned*)((const char*)(gbase) + (voff)[_i]), (PG8_LAS unsigned*)(lds + (bufoff) + ldsw + _i * 8192), 16, 0, 0); } while (0)
#define PG8_LDA(dst, b, h) do { _Pragma("unroll") for (int m = 0; m < 4; ++m) _Pragma("unroll") for (int k = 0; k < 2; ++k) dst[m][k] = *(const PG8_LAS bf16x8*)(lds + PG8_SA(b, h) + aoff + m * 2048 + k * 1024); } while (0)
#define PG8_LDB(dst, b, h) do { _Pragma("unroll") for (int n = 0; n < 2; ++n) _Pragma("unroll") for (int k = 0; k < 2; ++k) dst[n][k] = *(const PG8_LAS bf16x8*)(lds + PG8_SB(b, h) + boff + n * 2048 + k * 1024); } while (0)
#define PG8_MMA(ai, bj, At, Bt) do { __builtin_amdgcn_s_setprio(1); _Pragma("unroll") for (int m = 0; m < 4; ++m) _Pragma("unroll") for (int n = 0; n < 2; ++n) _Pragma("unroll") for (int k = 0; k < 2; ++k) \
        acc[ai][bj][m][n] = __builtin_amdgcn_mfma_f32_16x16x32_bf16(Bt[n][k], At[m][k], acc[ai][bj][m][n], 0, 0, 0); __builtin_amdgcn_s_setprio(0); } while (0)
#define PG8_WAIT_V(n) asm volatile("s_waitcnt vmcnt(" #n ")" ::: "memory")
#define PG8_WAIT_L(n) asm volatile("s_waitcnt lgkmcnt(" #n ")" ::: "memory")
#define PG8_BAR __builtin_amdgcn_s_barrier()
#define PG8_SCHED __builtin_amdgcn_sched_barrier(0)
    Unit cur, nxt; int ui = 0;
    if (!S.next(0, cur)) return;
    f32x4 acc[2][2][4][2];
#pragma unroll
    for (int a = 0; a < 2; ++a)
#pragma unroll
        for (int b = 0; b < 2; ++b)
#pragma unroll
            for (int m = 0; m < 4; ++m)
#pragma unroll
                for (int n = 0; n < 2; ++n) acc[a][b][m][n] = (f32x4){0.f, 0.f, 0.f, 0.f};
    bf16x8 At[4][2], B0[2][2], B1[2][2];
    const char* cA = (const char*)g.A + (size_t)cur.pm * tstep; const char* cB = (const char*)g.Bt + (size_t)cur.pn * tstep + S.bofs(cur);
    S.a_ready(cur);
    if constexpr (SP2) {
        PG8_STAGE(PG8_SB(0, 0), cB, voffB); PG8_STAGE(PG8_SB(0, 1), cB + hstep, voffB); PG8_STAGE(PG8_SA(0, 0), cA, voffA); PG8_STAGE(PG8_SA(0, 1), cA + hstep, voffA);
        if (wr == 1) PG8_BAR;
        PG8_WAIT_V(2); PG8_BAR;
        PG8_STAGE(PG8_SB(1, 0), cB + kstep, voffB); PG8_STAGE(PG8_SA(1, 0), cA + kstep, voffA); PG8_STAGE(PG8_SB(1, 1), cB + hstep + kstep, voffB);
        PG8_WAIT_V(6); PG8_BAR;
    } else {
        PG8_STAGE(PG8_SB(0, 0), cB, voffB); PG8_STAGE(PG8_SA(0, 0), cA, voffA); PG8_STAGE(PG8_SB(0, 1), cB + hstep, voffB); PG8_STAGE(PG8_SA(0, 1), cA + hstep, voffA);
        if (wr == 1) PG8_BAR;
        PG8_WAIT_V(4); PG8_BAR;
        PG8_STAGE(PG8_SB(1, 0), cB + kstep, voffB); PG8_STAGE(PG8_SA(1, 0), cA + kstep, voffA); PG8_STAGE(PG8_SB(1, 1), cB + hstep + kstep, voffB);
        PG8_WAIT_V(6); PG8_BAR;
    }
    for (;;) {
        const bool has_next = S.next(ui + 1, nxt);
        const char* nA = has_next ? (const char*)g.A + (size_t)nxt.pm * tstep : cA; const char* nB = has_next ? (const char*)g.Bt + (size_t)nxt.pn * tstep + S.bofs(nxt) : cB;
#pragma nounroll
        for (int t = 0; t < nt; t += 2) {
            const bool last = (t == nt - 2);
            const char* a1 = cA + (size_t)(t + 1) * kstep;
            const char* a2 = last ? nA : cA + (size_t)(t + 2) * kstep; const char* b2 = last ? nB : cB + (size_t)(t + 2) * kstep;
            const char* a3 = a2 + kstep; const char* b3 = b2 + kstep;
            if (last && has_next) S.a_ready(nxt);
            if constexpr (SP2) {
            PG8_LDB(B0, 0, 0); PG8_LDB(B1, 0, 1); PG8_SCHED; PG8_LDA(At, 0, 0); PG8_STAGE(PG8_SA(1, 1), a1 + hstep, voffA);
            PG8_WAIT_V(8); PG8_WAIT_L(0); PG8_BAR; PG8_MMA(0, 0, At, B0); PG8_MMA(0, 1, At, B1); PG8_BAR; PG8_SCHED;
            PG8_LDA(At, 0, 1); PG8_STAGE(PG8_SB(0, 0), b2, voffB); PG8_STAGE(PG8_SB(0, 1), b2 + hstep, voffB); PG8_STAGE(PG8_SA(0, 0), a2, voffA);
            PG8_WAIT_V(8); PG8_WAIT_L(0); PG8_BAR; PG8_MMA(1, 0, At, B0); PG8_MMA(1, 1, At, B1); PG8_BAR; PG8_SCHED;
            PG8_LDB(B0, 1, 0); PG8_LDB(B1, 1, 1); PG8_SCHED; PG8_LDA(At, 1, 0); PG8_STAGE(PG8_SA(0, 1), a2 + hstep, voffA);
            PG8_WAIT_V(8); PG8_WAIT_L(0); PG8_BAR; PG8_MMA(0, 0, At, B0); PG8_MMA(0, 1, At, B1); PG8_BAR; PG8_SCHED;
            PG8_LDA(At, 1, 1); PG8_STAGE(PG8_SB(1, 0), b3, voffB); PG8_STAGE(PG8_SB(1, 1), b3 + hstep, voffB); PG8_STAGE(PG8_SA(1, 0), a3, voffA);
            PG8_WAIT_V(8); PG8_WAIT_L(0); PG8_BAR; PG8_MMA(1, 0, At, B0); PG8_MMA(1, 1, At, B1); PG8_BAR; PG8_SCHED;
            } else {
            PG8_LDB(B0, 0, 0); PG8_SCHED; PG8_LDA(At, 0, 0); PG8_STAGE(PG8_SA(1, 1), a1 + hstep, voffA);
            PG8_WAIT_L(8); PG8_BAR; PG8_WAIT_L(0); PG8_MMA(0, 0, At, B0); PG8_BAR; PG8_SCHED;
            PG8_LDB(B1, 0, 1); PG8_STAGE(PG8_SB(0, 0), b2, voffB);
            PG8_BAR; PG8_WAIT_L(0); PG8_MMA(0, 1, At, B1); PG8_BAR;
            PG8_LDA(At, 0, 1); PG8_STAGE(PG8_SA(0, 0), a2, voffA);
            PG8_BAR; PG8_WAIT_L(0); PG8_MMA(1, 0, At, B0); PG8_BAR; PG8_SCHED;
            PG8_STAGE(PG8_SB(0, 1), b2 + hstep, voffB);
            PG8_WAIT_V(6); PG8_BAR; PG8_MMA(1, 1, At, B1); PG8_BAR;
            PG8_LDB(B0, 1, 0); PG8_SCHED; PG8_LDA(At, 1, 0); PG8_STAGE(PG8_SA(0, 1), a2 + hstep, voffA);
            PG8_WAIT_L(8); PG8_BAR; PG8_WAIT_L(0); PG8_MMA(0, 0, At, B0); PG8_BAR; PG8_SCHED;
            PG8_LDB(B1, 1, 1); PG8_STAGE(PG8_SB(1, 0), b3, voffB);
            PG8_BAR; PG8_WAIT_L(0); PG8_MMA(0, 1, At, B1); PG8_BAR;
            PG8_LDA(At, 1, 1); PG8_STAGE(PG8_SA(1, 0), a3, voffA);
            PG8_BAR; PG8_WAIT_L(0); PG8_MMA(1, 0, At, B0); PG8_BAR; PG8_SCHED;
            PG8_STAGE(PG8_SB(1, 1), b3 + hstep, voffB);
            PG8_WAIT_V(6); PG8_BAR; PG8_MMA(1, 1, At, B1); PG8_BAR;
            }
        }
        if constexpr (ALIGN_EPI) { if (wr == 0) PG8_BAR; }
        if constexpr (!Epi::AFTER_DRAIN) { E(acc, cur, wr, wc, fr, fq); S.done(cur); }
        if (!has_next) break;
#pragma unroll
        for (int a = 0; a < 2; ++a)
#pragma unroll
            for (int b = 0; b < 2; ++b)
#pragma unroll
                for (int m = 0; m < 4; ++m)
#pragma unroll
                    for (int n = 0; n < 2; ++n) acc[a][b][m][n] = (f32x4){0.f, 0.f, 0.f, 0.f};
        cur = nxt; cA = nA; cB = nB; ++ui;
        if constexpr (ALIGN_EPI) { if (wr == 1) PG8_BAR; }
    }
    PG8_WAIT_V(0);
    if constexpr (!ALIGN_EPI) { if (wr == 0) PG8_BAR; }
    PG8_BAR;
    if constexpr (Epi::AFTER_DRAIN) { E.fused(acc, cur, wr, wc, fr, fq, lds, wid, lane); S.done(cur); }
#undef PG8_SA
#undef PG8_SB
#undef PG8_STAGE
#undef PG8_LDA
#undef PG8_LDB
#undef PG8_MMA
#undef PG8_WAIT_V
#undef PG8_WAIT_L
#undef PG8_BAR
#undef PG8_SCHED
}
}

namespace att {
#ifndef ATT2_PINGPONG
#define ATT2_PINGPONG 1
#endif
#ifndef ATT_PRIO
#define ATT_PRIO 1
#endif
#if ATT_PRIO
#define ATT_SETPRIO(x) __builtin_amdgcn_s_setprio(x)
#else
#define ATT_SETPRIO(x) do {} while (0)
#endif
#define MFMA32(a, b, c) __builtin_amdgcn_mfma_f32_32x32x16_bf16((a), (b), (c), 0, 0, 0)
typedef short v4i16_t __attribute__((ext_vector_type(4)));
struct AttnP {
    const bf16* Q; int ldq;
    const bf16* K1; int ldk1;
    const bf16* K2; int ldk2;
    const bf16* V; int ldv;
    bf16* O; int ldo;
    const int* pos;
    const int* blkmax;
    const float* lut;
};
__device__ __forceinline__ s16x4 vtr(const LAS unsigned char* p) { return __builtin_bit_cast(s16x4, __builtin_amdgcn_ds_read_tr16_b64_v4i16((LAS v4i16_t*)p)); }

template <int DQK, int KSPLIT, int DV, bool BIAS>
__device__ __forceinline__ void attn_unit(const AttnP& P, int b, int qt, int qcol, int kcol, int vcol, int ocol, int hb, LAS unsigned char* lds) {
    constexpr int KROWB = DQK * 2 + 16;
    constexpr int VROWB = (DV == 128) ? 320 : 192;
    constexpr int KBYTES = 64 * KROWB, VBYTES = 64 * VROWB, STAGE = KBYTES + VBYTES + 256, LUT_OFF = 2 * STAGE;
    constexpr int ND = DQK / 16, NDB = DV / 32, KCH = DQK / 8, VCH = DV / 8, NKC = 64 * KCH, NVC = 64 * VCH, KL = (NKC + 511) / 512, VL = (NVC + 511) / 512;
    int tid_ = threadIdx.x; asm volatile("" : "+v"(tid_));
    const int tid = tid_, lane = tid & 63, wid = __builtin_amdgcn_readfirstlane(tid >> 6), r = lane & 31, h = lane >> 5;
    const long tok0 = (long)b * SEQ; const int q0 = qt * 256; const int qrow = q0 + wid * 32 + r;
    bf16x8 qf[ND];
    { const bf16* qp = P.Q + (tok0 + qrow) * (long)P.ldq + qcol + 8 * h;
#pragma unroll
      for (int d = 0; d < ND; ++d) qf[d] = *(const bf16x8*)(qp + 16 * d); }
    int posq = 0, posq_min = 0;
    LAS float* lut = (LAS float*)(lds + LUT_OFF);
    if (BIAS) { posq = P.pos[tok0 + qrow]; int mn = posq;
#pragma unroll
        for (int o = 1; o < 64; o <<= 1) { const int t2 = shxi(mn, o, lane); mn = t2 < mn ? t2 : mn; }
        posq_min = mn;
        if (tid < 132) lut[tid] = P.lut[hb * 132 + tid]; }
    v4u kreg[KL], vreg[VL]; int preg = 0;
#define ATT_ISSUE(t) do { const long trow = tok0 + 64 * (long)(t); \
        _Pragma("unroll") for (int i = 0; i < KL; ++i) { const int c = tid + 512 * i; if (NKC % 512 == 0 || c < NKC) { const int row = c / KCH, col = (c % KCH) * 8; \
            const bf16* src = (col < KSPLIT) ? P.K1 + (trow + row) * (long)P.ldk1 + kcol + col : P.K2 + (trow + row) * (long)P.ldk2 + (col - KSPLIT); kreg[i] = *(const v4u*)src; } } \
        _Pragma("unroll") for (int i = 0; i < VL; ++i) { const int c = tid + 512 * i; if (NVC % 512 == 0 || c < NVC) { const int row = c / VCH, col = (c % VCH) * 8; vreg[i] = *(const v4u*)(P.V + (trow + row) * (long)P.ldv + vcol + col); } } \
        if (BIAS && tid < 64) preg = P.pos[trow + tid]; } while (0)
#define ATT_WRITE(t) do { LAS unsigned char* sb = lds + ((t) & 1) * STAGE; \
        _Pragma("unroll") for (int i = 0; i < KL; ++i) { const int c = tid + 512 * i; if (NKC % 512 == 0 || c < NKC) { const int row = c / KCH, cc = c % KCH; *(LAS v4u*)(sb + row * KROWB + cc * 16) = kreg[i]; } } \
        _Pragma("unroll") for (int i = 0; i < VL; ++i) { const int c = tid + 512 * i; if (NVC % 512 == 0 || c < NVC) { const int row = c / VCH, cc = c % VCH; *(LAS v4u*)(sb + KBYTES + row * VROWB + cc * 16) = vreg[i]; } } \
        if (BIAS && tid < 64) *(LAS int*)(sb + KBYTES + VBYTES + 4 * tid) = preg; } while (0)
    f32x16 o[NDB];
#pragma unroll
    for (int i = 0; i < NDB; ++i)
#pragma unroll
        for (int j = 0; j < 16; ++j) o[i][j] = 0.f;
    float m_run = 0.f, l_run = 0.f;
    const int ntiles = (q0 + 256) / 64, my_last = (q0 + wid * 32 + 31) / 64;
    ATT_ISSUE(0); ATT_WRITE(0); __syncthreads();
    const int kbase = r * KROWB + 16 * h;
    const int vbase = KBYTES + (4 * h + ((lane & 15) >> 2)) * VROWB + (((lane >> 4) & 1) * 16 + (lane & 3) * 4) * 2;
    for (int t = 0; t < ntiles; ++t) {
        const bool more = (t + 1 < ntiles);
        if (more) ATT_ISSUE(t + 1);
        if (t <= my_last) {
            const LAS unsigned char* sb = lds + (t & 1) * STAGE;
            bool plain = (64 * t + 63 <= q0 + wid * 32);
            float cinit = -m_run;
            if (BIAS) { const int kmax = P.blkmax[(int)(tok0 >> 6) + t]; if (plain && (posq_min - kmax >= 113)) cinit += lut[128]; else plain = false; }
            f32x16 x0, x1;
#pragma unroll
            for (int j = 0; j < 16; ++j) { x0[j] = cinit; x1[j] = cinit; }
            ATT_SETPRIO(1);
            { bf16x8 kf0[ND], kf1[ND];
#pragma unroll
              for (int d = 0; d < ND; ++d) { kf0[d] = *(const LAS bf16x8*)(sb + kbase + d * 32); kf1[d] = *(const LAS bf16x8*)(sb + kbase + 32 * KROWB + d * 32); }
              __builtin_amdgcn_sched_barrier(0);
#pragma unroll
              for (int d = 0; d < ND; ++d) { x0 = MFMA32(kf0[d], qf[d], x0); x1 = MFMA32(kf1[d], qf[d], x1); } }
            ATT_SETPRIO(0);
            if (!plain) {
#pragma unroll
                for (int g = 0; g < 4; ++g) {
                    int pk0[4] = {0, 0, 0, 0}, pk1[4] = {0, 0, 0, 0};
                    if (BIAS) { const LAS int* pp = (const LAS int*)(sb + KBYTES + VBYTES) + 8 * g + 4 * h;
                        const v4u a = *(const LAS v4u*)pp, c = *(const LAS v4u*)(pp + 32);
                        pk0[0] = a.x; pk0[1] = a.y; pk0[2] = a.z; pk0[3] = a.w; pk1[0] = c.x; pk1[1] = c.y; pk1[2] = c.z; pk1[3] = c.w; }
#pragma unroll
                    for (int j = 0; j < 4; ++j) { const int i = 4 * g + j; const int kidx = 64 * t + 8 * g + 4 * h + j;
                        float v0 = x0[i], v1 = x1[i];
                        if (BIAS) { int n0 = posq - pk0[j]; n0 = n0 < 0 ? 0 : (n0 > 128 ? 128 : n0); int n1 = posq - pk1[j]; n1 = n1 < 0 ? 0 : (n1 > 128 ? 128 : n1); v0 += lut[n0]; v1 += lut[n1]; }
                        if (kidx > qrow) v0 = -INFINITY; if (kidx + 32 > qrow) v1 = -INFINITY;
                        x0[i] = v0; x1[i] = v1; }
                }
            }
            float ma = fmaxf(fmaxf(x0[0], x0[1]), x0[2]), mb = fmaxf(fmaxf(x1[0], x1[1]), x1[2]);
#pragma unroll
            for (int j = 3; j < 15; j += 2) { ma = fmaxf(fmaxf(ma, x0[j]), x0[j + 1]); mb = fmaxf(fmaxf(mb, x1[j]), x1[j + 1]); }
            float mx = fmaxf(fmaxf(ma, mb), fmaxf(x0[15], x1[15]));
            { const auto rr = __builtin_amdgcn_permlane32_swap(__float_as_uint(mx), __float_as_uint(mx), false, false); mx = fmaxf(__uint_as_float(rr[0]), __uint_as_float(rr[1])); }
            if (t == 0 || __any(mx > 8.0f)) {
                const float delta = (t == 0) ? mx : fmaxf(mx, 0.f);
                if (t != 0) { const float alpha = __builtin_amdgcn_exp2f(-delta); l_run *= alpha;
#pragma unroll
                    for (int i = 0; i < NDB; ++i) o[i] = o[i] * alpha; }
                m_run += delta;
#pragma unroll
                for (int j = 0; j < 16; ++j) { x0[j] -= delta; x1[j] -= delta; }
            }
            f32x2 ls2 = {0.f, 0.f};
#pragma unroll
            for (int j = 0; j < 16; j += 2) { x0[j] = __builtin_amdgcn_exp2f(x0[j]); x0[j + 1] = __builtin_amdgcn_exp2f(x0[j + 1]); x1[j] = __builtin_amdgcn_exp2f(x1[j]); x1[j + 1] = __builtin_amdgcn_exp2f(x1[j + 1]);
                ls2 += (f32x2){x0[j], x0[j + 1]}; ls2 += (f32x2){x1[j], x1[j + 1]}; }
            l_run += ls2[0] + ls2[1];
            bf16x8 pf[4];
            { v4u w;
              w.x = pk2(x0[0], x0[1]); w.y = pk2(x0[2], x0[3]); w.z = pk2(x0[4], x0[5]); w.w = pk2(x0[6], x0[7]); pf[0] = __builtin_bit_cast(bf16x8, w);
              w.x = pk2(x0[8], x0[9]); w.y = pk2(x0[10], x0[11]); w.z = pk2(x0[12], x0[13]); w.w = pk2(x0[14], x0[15]); pf[1] = __builtin_bit_cast(bf16x8, w);
              w.x = pk2(x1[0], x1[1]); w.y = pk2(x1[2], x1[3]); w.z = pk2(x1[4], x1[5]); w.w = pk2(x1[6], x1[7]); pf[2] = __builtin_bit_cast(bf16x8, w);
              w.x = pk2(x1[8], x1[9]); w.y = pk2(x1[10], x1[11]); w.z = pk2(x1[12], x1[13]); w.w = pk2(x1[14], x1[15]); pf[3] = __builtin_bit_cast(bf16x8, w); }
            ATT_SETPRIO(1);
            { s16x4 vlo[2][4], vhi[2][4];
#define ATT_VLOAD(buf, db) do { _Pragma("unroll") for (int s = 0; s < 4; ++s) { vlo[buf][s] = vtr(sb + vbase + (16 * s) * VROWB + 64 * (db)); vhi[buf][s] = vtr(sb + vbase + (16 * s + 8) * VROWB + 64 * (db)); } } while (0)
              ATT_VLOAD(0, 0);
#pragma unroll
              for (int db = 0; db < NDB; ++db) {
                  if (db + 1 < NDB) ATT_VLOAD((db + 1) & 1, db + 1);
                  __builtin_amdgcn_sched_barrier(0);
#pragma unroll
                  for (int s = 0; s < 4; ++s) { const bf16x8 vf = __builtin_shufflevector(vlo[db & 1][s], vhi[db & 1][s], 0, 1, 2, 3, 4, 5, 6, 7); o[db] = MFMA32(vf, pf[s], o[db]); }
                  __builtin_amdgcn_sched_barrier(0);
              }
#undef ATT_VLOAD
            }
            ATT_SETPRIO(0);
        }
        if (more) ATT_WRITE(t + 1);
        __syncthreads();
    }
#undef ATT_ISSUE
#undef ATT_WRITE
    const float lt = l_run + shx(l_run, 32, lane), inv = 1.0f / lt;
    bf16* op = P.O + (tok0 + qrow) * (long)P.ldo + ocol + 4 * h;
#pragma unroll
    for (int db = 0; db < NDB; ++db)
#pragma unroll
        for (int g = 0; g < 4; ++g) { v2u w; w.x = pk2(o[db][4 * g] * inv, o[db][4 * g + 1] * inv); w.y = pk2(o[db][4 * g + 2] * inv, o[db][4 * g + 3] * inv);
            *(v2u*)(op + 32 * db + 8 * g) = w; }
}

#define ATT_WAITV(n) asm volatile("s_waitcnt vmcnt(" #n ")" ::: "memory")
#define ATT_BAR() do { asm volatile("" ::: "memory"); __builtin_amdgcn_s_barrier(); asm volatile("" ::: "memory"); } while (0)
template <int DQK, int KSPLIT, int DV, bool BIAS>
__device__ __forceinline__ void attn_unit2(const AttnP& P, int b, int qt, int qcol, int kcol, int vcol, int ocol, int hb, LAS unsigned char* lds) {
    constexpr int KROWB = DQK * 2, VROWB = DV * 2, KBYTES = 64 * KROWB, VBYTES = 64 * VROWB, STAGE = KBYTES + VBYTES + 256, NST = 4, LUT_OFF = NST * STAGE, BMX_OFF = LUT_OFF + 1024;
    constexpr int ND = DQK / 16, NDB = DV / 32, KCH = DQK / 8, VCH = DV / 8, NKP = KBYTES / 1024, NVP = VBYTES / 1024, KPW = (NKP + 7) / 8, VPW = (NVP + 7) / 8;
    static_assert(BMX_OFF + 256 <= 131072, "attention LDS");
    int tid_ = threadIdx.x; asm volatile("" : "+v"(tid_));
    const int tid = tid_, lane = tid & 63, wid = __builtin_amdgcn_readfirstlane(tid >> 6), r = lane & 31, h = lane >> 5, grpB = ATT2_PINGPONG ? (wid >> 2) : 0;
    const long tok0 = (long)b * SEQ; const int q0 = qt * 256; const int qrow = q0 + wid * 32 + r;
    const bf16* ksrc[KPW]; int kinc[KPW]; const bf16* vsrc[VPW];
#pragma unroll
    for (int i = 0; i < KPW; ++i) { const int ci = 64 * (wid + 8 * i) + lane, row = (ci / KCH) & 63, cp = ci % KCH; const int c = (DQK == 64) ? (cp ^ ((row >> 1) & 7)) : (cp ^ ((row >> 2) & 3)); const int col = 8 * c;
        if (col < KSPLIT) { ksrc[i] = P.K1 + (tok0 + row) * (long)P.ldk1 + kcol + col; kinc[i] = 64 * P.ldk1; } else { ksrc[i] = P.K2 + (tok0 + row) * (long)P.ldk2 + (col - KSPLIT); kinc[i] = 64 * P.ldk2; } }
#pragma unroll
    for (int i = 0; i < VPW; ++i) { const int ci = 64 * (wid + 8 * i) + lane, row = (ci / VCH) & 63, cp = ci % VCH; const int c = (DV == 128) ? (cp ^ (4 * (row & 3))) : (cp ^ (4 * ((row >> 1) & 1)));
        vsrc[i] = P.V + (tok0 + row) * (long)P.ldv + vcol + 8 * c; }
    const int vinc = 64 * P.ldv;
    const int nops = ((KPW == 2) ? ((wid + 8 < NKP) ? 2 : 1) : 1) + ((VPW == 2) ? ((wid + 8 < NVP) ? 2 : 1) : 1) + ((BIAS && wid == 7) ? 1 : 0);
#define ATT2_ISSUE(t) do { LAS unsigned char* sb_ = lds + ((t) & 3) * STAGE; \
        _Pragma("unroll") for (int i = 0; i < KPW; ++i) if (wid + 8 * i < NKP) __builtin_amdgcn_global_load_lds((const unsigned*)(ksrc[i] + (long)(t) * kinc[i]), (LAS unsigned*)(sb_ + (wid + 8 * i) * 1024), 16, 0, 0); \
        _Pragma("unroll") for (int i = 0; i < VPW; ++i) if (wid + 8 * i < NVP) __builtin_amdgcn_global_load_lds((const unsigned*)(vsrc[i] + (long)(t) * vinc), (LAS unsigned*)(sb_ + KBYTES + (wid + 8 * i) * 1024), 16, 0, 0); \
        if (BIAS && wid == 7) { if (lane < 16) __builtin_amdgcn_global_load_lds((const unsigned*)(P.pos + tok0 + 64 * (long)(t) + 4 * lane), (LAS unsigned*)(sb_ + KBYTES + VBYTES), 16, 0, 0); } } while (0)
#define ATT2_WAIT(n) do { if ((n) == 0) ATT_WAITV(0); else if ((n) == 2) ATT_WAITV(2); else if ((n) == 3) ATT_WAITV(3); else ATT_WAITV(4); } while (0)
    ATT_BAR();
    bf16x8 qf[ND];
    { const bf16* qp = P.Q + (tok0 + qrow) * (long)P.ldq + qcol + 8 * h;
#pragma unroll
      for (int d = 0; d < ND; ++d) qf[d] = *(const bf16x8*)(qp + 16 * d); }
    int posq = 0, posq_min = 0;
    LAS float* lut = (LAS float*)(lds + LUT_OFF); LAS int* bmx = (LAS int*)(lds + BMX_OFF);
    const int ntiles = (q0 + 256) / 64, my_last = (q0 + wid * 32 + 31) / 64;
    if (BIAS) { posq = P.pos[tok0 + qrow]; int mn = posq;
#pragma unroll
        for (int o = 1; o < 64; o <<= 1) { const int t2 = shxi(mn, o, lane); mn = t2 < mn ? t2 : mn; }
        posq_min = mn;
        if (tid < 132) lut[tid] = P.lut[hb * 132 + tid];
        if (tid >= 192 && tid < 256) bmx[tid - 192] = P.blkmax[(int)(tok0 >> 6) + (tid - 192)]; }
    asm volatile("s_waitcnt vmcnt(0)" ::: "memory");
    ATT2_ISSUE(0); ATT2_ISSUE(1);
    f32x16 o[NDB];
#pragma unroll
    for (int i = 0; i < NDB; ++i)
#pragma unroll
        for (int j = 0; j < 16; ++j) o[i][j] = 0.f;
    float m_run = 0.f, l_run = 0.f;
    bf16x8 pf[4];
    int kaddr[ND], vaddr[NDB];
    { const int sw = (DQK == 64) ? ((r >> 1) & 7) : ((r >> 2) & 3);
#pragma unroll
      for (int d = 0; d < ND; ++d) kaddr[d] = r * KROWB + 16 * ((2 * d + h) ^ sw);
      const int qq = (lane & 15) >> 2, pp = lane & 3, g16 = (lane >> 4) & 1, swv = (DV == 128) ? qq : ((qq >> 1) & 1);
#pragma unroll
      for (int db = 0; db < NDB; ++db) vaddr[db] = KBYTES + (4 * h + qq) * VROWB + 64 * (db ^ swv) + 32 * g16 + 8 * pp; }
    for (int hs = 0; hs <= 2 * ntiles; ++hs) {
        const int te = hs >> 1;
        if (!(hs & 1) && te < ntiles) { if (te + 1 < ntiles) ATT2_WAIT(nops); else ATT2_WAIT(0); }
        ATT_BAR();
        if (!(hs & 1) && te + 2 < ntiles) ATT2_ISSUE(te + 2);
        const int k = hs - grpB;
        if (k < 0 || k >= 2 * ntiles) continue;
        const int t = k >> 1;
        if (t > my_last) continue;
        const LAS unsigned char* sb = lds + (t & 3) * STAGE;
        if (!(k & 1)) {
            bool plain = (64 * t + 63 <= q0 + wid * 32);
            float cinit = -m_run;
            if (BIAS) { const int kmax = bmx[t]; if (plain && (posq_min - kmax >= 113)) cinit += lut[128]; else plain = false; }
            f32x16 x0, x1;
#pragma unroll
            for (int j = 0; j < 16; ++j) { x0[j] = cinit; x1[j] = cinit; }
            { bf16x8 kf0[ND], kf1[ND];
#pragma unroll
              for (int d = 0; d < ND; ++d) { kf0[d] = *(const LAS bf16x8*)(sb + kaddr[d]); kf1[d] = *(const LAS bf16x8*)(sb + kaddr[d] + 32 * KROWB); }
              __builtin_amdgcn_sched_barrier(0);
              ATT_SETPRIO(1);
#pragma unroll
              for (int d = 0; d < ND; ++d) { x0 = MFMA32(kf0[d], qf[d], x0); x1 = MFMA32(kf1[d], qf[d], x1); }
              ATT_SETPRIO(0); }
            if (!plain) {
#pragma unroll
                for (int g = 0; g < 4; ++g) {
                    int pk0[4] = {0, 0, 0, 0}, pk1[4] = {0, 0, 0, 0};
                    if (BIAS) { const LAS int* ppq = (const LAS int*)(sb + KBYTES + VBYTES) + 8 * g + 4 * h;
                        const v4u a = *(const LAS v4u*)ppq, c = *(const LAS v4u*)(ppq + 32);
                        pk0[0] = a.x; pk0[1] = a.y; pk0[2] = a.z; pk0[3] = a.w; pk1[0] = c.x; pk1[1] = c.y; pk1[2] = c.z; pk1[3] = c.w; }
#pragma unroll
                    for (int j = 0; j < 4; ++j) { const int i = 4 * g + j; const int kidx = 64 * t + 8 * g + 4 * h + j;
                        float v0 = x0[i], v1 = x1[i];
                        if (BIAS) { int n0 = posq - pk0[j]; n0 = n0 < 0 ? 0 : (n0 > 128 ? 128 : n0); int n1 = posq - pk1[j]; n1 = n1 < 0 ? 0 : (n1 > 128 ? 128 : n1); v0 += lut[n0]; v1 += lut[n1]; }
                        if (kidx > qrow) v0 = -INFINITY; if (kidx + 32 > qrow) v1 = -INFINITY;
                        x0[i] = v0; x1[i] = v1; }
                }
            }
            float ma = fmaxf(fmaxf(x0[0], x0[1]), x0[2]), mb = fmaxf(fmaxf(x1[0], x1[1]), x1[2]);
#pragma unroll
            for (int j = 3; j < 15; j += 2) { ma = fmaxf(fmaxf(ma, x0[j]), x0[j + 1]); mb = fmaxf(fmaxf(mb, x1[j]), x1[j + 1]); }
            float mx = fmaxf(fmaxf(ma, mb), fmaxf(x0[15], x1[15]));
            { const auto rr = __builtin_amdgcn_permlane32_swap(__float_as_uint(mx), __float_as_uint(mx), false, false); mx = fmaxf(__uint_as_float(rr[0]), __uint_as_float(rr[1])); }
            if (t == 0 || __any(mx > 8.0f)) {
                const float delta = (t == 0) ? mx : fmaxf(mx, 0.f);
                if (t != 0) { const float alpha = __builtin_amdgcn_exp2f(-delta); l_run *= alpha;
#pragma unroll
                    for (int i = 0; i < NDB; ++i) o[i] = o[i] * alpha; }
                m_run += delta;
#pragma unroll
                for (int j = 0; j < 16; ++j) { x0[j] -= delta; x1[j] -= delta; }
            }
            f32x2 ls2 = {0.f, 0.f};
#pragma unroll
            for (int j = 0; j < 16; j += 2) { x0[j] = __builtin_amdgcn_exp2f(x0[j]); x0[j + 1] = __builtin_amdgcn_exp2f(x0[j + 1]); x1[j] = __builtin_amdgcn_exp2f(x1[j]); x1[j + 1] = __builtin_amdgcn_exp2f(x1[j + 1]);
                ls2 += (f32x2){x0[j], x0[j + 1]}; ls2 += (f32x2){x1[j], x1[j + 1]}; }
            l_run += ls2[0] + ls2[1];
            { v4u w;
              w.x = pk2(x0[0], x0[1]); w.y = pk2(x0[2], x0[3]); w.z = pk2(x0[4], x0[5]); w.w = pk2(x0[6], x0[7]); pf[0] = __builtin_bit_cast(bf16x8, w);
              w.x = pk2(x0[8], x0[9]); w.y = pk2(x0[10], x0[11]); w.z = pk2(x0[12], x0[13]); w.w = pk2(x0[14], x0[15]); pf[1] = __builtin_bit_cast(bf16x8, w);
              w.x = pk2(x1[0], x1[1]); w.y = pk2(x1[2], x1[3]); w.z = pk2(x1[4], x1[5]); w.w = pk2(x1[6], x1[7]); pf[2] = __builtin_bit_cast(bf16x8, w);
              w.x = pk2(x1[8], x1[9]); w.y = pk2(x1[10], x1[11]); w.z = pk2(x1[12], x1[13]); w.w = pk2(x1[14], x1[15]); pf[3] = __builtin_bit_cast(bf16x8, w); }
        } else {
            s16x4 vlo[2][4], vhi[2][4];
            const unsigned sbu = (unsigned)(unsigned long)sb;
#define ATT2_TR(dst, a, imm) asm volatile("ds_read_b64_tr_b16 %0, %1 offset:%2" : "=&v"(dst) : "v"(a), "n"(imm) : "memory")
#define ATT2_VLOAD(buf, db) do { const unsigned a_ = sbu + (unsigned)vaddr[db]; \
        ATT2_TR(vlo[buf][0], a_, 0 * VROWB); ATT2_TR(vhi[buf][0], a_, 8 * VROWB); ATT2_TR(vlo[buf][1], a_, 16 * VROWB); ATT2_TR(vhi[buf][1], a_, 24 * VROWB); \
        ATT2_TR(vlo[buf][2], a_, 32 * VROWB); ATT2_TR(vhi[buf][2], a_, 40 * VROWB); ATT2_TR(vlo[buf][3], a_, 48 * VROWB); ATT2_TR(vhi[buf][3], a_, 56 * VROWB); } while (0)
#define ATT2_VWAIT(n, buf) asm volatile("s_waitcnt lgkmcnt(" #n ")" : "+v"(vlo[buf][0]), "+v"(vhi[buf][0]), "+v"(vlo[buf][1]), "+v"(vhi[buf][1]), "+v"(vlo[buf][2]), "+v"(vhi[buf][2]), "+v"(vlo[buf][3]), "+v"(vhi[buf][3]) :: "memory")
            ATT2_VLOAD(0, 0);
            ATT_SETPRIO(1);
#pragma unroll
            for (int db = 0; db < NDB; ++db) {
                if (db + 1 < NDB) { ATT2_VLOAD((db + 1) & 1, db + 1); if (db & 1) ATT2_VWAIT(8, 1); else ATT2_VWAIT(8, 0); }
                else { if (db & 1) ATT2_VWAIT(0, 1); else ATT2_VWAIT(0, 0); }
#pragma unroll
                for (int s = 0; s < 4; ++s) { const bf16x8 vf = __builtin_shufflevector(vlo[db & 1][s], vhi[db & 1][s], 0, 1, 2, 3, 4, 5, 6, 7); o[db] = MFMA32(vf, pf[s], o[db]); }
            }
            ATT_SETPRIO(0);
#undef ATT2_TR
#undef ATT2_VWAIT
#undef ATT2_VLOAD
        }
    }
#undef ATT2_ISSUE
#undef ATT2_WAIT
    const float lt = l_run + shx(l_run, 32, lane), inv = 1.0f / lt;
    bf16* op = P.O + (tok0 + qrow) * (long)P.ldo + ocol + 4 * h;
#pragma unroll
    for (int db = 0; db < NDB; ++db)
#pragma unroll
        for (int g = 0; g < 4; ++g) { v2u w; w.x = pk2(o[db][4 * g] * inv, o[db][4 * g + 1] * inv); w.y = pk2(o[db][4 * g + 2] * inv, o[db][4 * g + 3] * inv);
            *(v2u*)(op + 32 * db + 8 * g) = w; }
}
#undef MFMA32
}

constexpr size_t MiB = 1u << 20;
constexpr size_t WS_CTL = 0, CTL_ZERO_BYTES = 1 * MiB;
constexpr size_t WS_ROPE = 1 * MiB;
constexpr size_t WS_MISC = 5 * MiB;
constexpr size_t WS_XB = 6 * MiB;
constexpr size_t WS_PB = 70 * MiB;
constexpr size_t WS_W = 86 * MiB;
constexpr size_t W_IN = WS_W, W_UQ = WS_W + 12 * MiB, W_UKV = WS_W + 13 * MiB, W_BD = WS_W + 14 * MiB, W_BM = WS_W + 16 * MiB, W_OUT = WS_W + 17 * MiB,
                 W_PG = WS_W + 19 * MiB, W_PP = WS_W + 21 * MiB, W_F13 = WS_W + 22 * MiB, W_F2D = WS_W + 33 * MiB, W_F2E = WS_W + 134 * MiB;
constexpr size_t WS_ACT = 276 * MiB;
constexpr size_t A_DQ = WS_ACT, A_DK = WS_ACT + 64 * MiB, A_DV = WS_ACT + 128 * MiB, A_G = WS_ACT + 192 * MiB, A_C = WS_ACT + 320 * MiB;
constexpr size_t A_OA = A_DQ, A_MT = A_DK, A_M = A_DV, A_CQ = A_C, A_OA2 = A_C, A_PRE = A_C;
constexpr size_t A_CQN = WS_ACT + 448 * MiB, A_CKVN = WS_ACT + 472 * MiB, A_OB = A_CQN, A_MKR = WS_ACT + 488 * MiB, A_MQ = WS_ACT + 490 * MiB, A_MKV = WS_ACT + 538 * MiB;
constexpr size_t A_H = WS_ACT;
constexpr size_t A_XG = WS_ACT, A_YG = WS_ACT + 132 * MiB, A_TOK = WS_ACT + 264 * MiB, A_HG = WS_ACT + 448 * MiB;
constexpr size_t WS_END = WS_ACT + 672 * MiB;
constexpr int CW_BAR = 4096, CW_MOE = 8192;

constexpr int RING_BYTES = 131072, MISC_OFF = RING_BYTES + 320, LDS_BYTES = 147456;
constexpr int NWAVES = 8;

#ifndef REP_ATTN_D
#define REP_ATTN_D 1
#endif
#ifndef REP_ATTN_M
#define REP_ATTN_M 1
#endif
#ifndef REP_CONV
#define REP_CONV 1
#endif
#ifndef REP_L1
#define REP_L1 1
#endif
#ifndef REP_EW
#define REP_EW 1
#endif
#ifndef REP_BAR
#define REP_BAR 1
#endif
#ifndef REP_LN
#define REP_LN 1
#endif
#ifndef REP_MOE
#define REP_MOE 1
#endif
#ifndef REP_MIX
#define REP_MIX 1
#endif
#ifndef REP_FFN
#define REP_FFN 1
#endif
#ifndef REP_P0
#define REP_P0 1
#endif
#ifndef REP_PPE
#define REP_PPE 1
#endif
#ifndef ATT_UNIT
#define ATT_UNIT attn_unit2
#endif
#define XB_TMO      128
#define XB_XCNT(j)  (256  + 64 * (j))
#define XB_XSUB(j)  (1280 + 64 * (j))
#define XB_XGEN(j)  (2304 + 64 * (j))
#define XB_TOP      3328
#define XB_TOPGEN   3392
#define XCD_BAR_WORDS 3456
#define XB_SPIN_CAP (1u << 18)

__device__ __forceinline__ unsigned xb_ld(unsigned* p)              { return __hip_atomic_load(p, __ATOMIC_RELAXED, __HIP_MEMORY_SCOPE_AGENT); }
__device__ __forceinline__ unsigned xb_add(unsigned* p, unsigned v) { return __hip_atomic_fetch_add(p, v, __ATOMIC_RELAXED, __HIP_MEMORY_SCOPE_AGENT); }
__device__ __forceinline__ unsigned xb_xcc_id() { return (unsigned)__builtin_amdgcn_s_getreg((3 << 11) | 20) & 0xFu; }
#define XB_SPIN(cond, bar) do { unsigned _sp = 0; while (cond) { __builtin_amdgcn_s_sleep(1); \
    if ((++_sp & 255u) == 0u) { if (xb_ld(&(bar)[XB_TMO])) break; if (_sp > XB_SPIN_CAP) { atomicAdd(&(bar)[XB_TMO], 1u); break; } } } } while (0)

struct XcdBarrier {
    unsigned* bar; unsigned x;
    volatile LAS unsigned* st;
};

__device__ __forceinline__ XcdBarrier xcd_barrier_post(unsigned* bar, volatile LAS unsigned* st) {
    XcdBarrier b; b.bar = bar; b.x = xb_xcc_id(); b.st = st;
    if (threadIdx.x == 0) (void)xb_add(&bar[XB_XCNT(b.x)], 1u);
    return b;
}
__device__ __forceinline__ void xcd_barrier_complete(unsigned* bar, unsigned x, unsigned& nloc, unsigned& nx) {
    const unsigned G = gridDim.x * gridDim.y * gridDim.z;
    unsigned sum, cnt, mine, sp = 0u;
    for (;;) {
        sum = 0u; cnt = 0u; mine = 0u;
#pragma unroll
        for (unsigned j = 0; j < 16; ++j) { const unsigned c = xb_ld(&bar[XB_XCNT(j)]); sum += c; cnt += (c > 0u) ? 1u : 0u; mine = (j == x) ? c : mine; }
        if (sum == G) break;
        __builtin_amdgcn_s_sleep(1);
        if ((++sp & 255u) == 0u) { if (xb_ld(&bar[XB_TMO])) break; if (sp > XB_SPIN_CAP) { atomicAdd(&bar[XB_TMO], 1u); break; } }
    }
    nloc = mine > 0u ? mine : 1u; nx = cnt > 0u ? cnt : 1u;
}

__device__ __forceinline__ void xcd_barrier(const XcdBarrier& b) {
    asm volatile("s_waitcnt vmcnt(0)" ::: "memory");
    __syncthreads();
    if (threadIdx.x == 0) {
        unsigned* bar = b.bar;
        __builtin_amdgcn_s_waitcnt(0);
        unsigned nloc = b.st[0], nx = b.st[1];
        if (nloc == 0u) { xcd_barrier_complete(bar, b.x, nloc, nx); b.st[0] = nloc; b.st[1] = nx; }
        const unsigned old = xb_add(&bar[XB_XSUB(b.x)], 1u);
        const unsigned gen = old / nloc;
        if (old + 1u == (gen + 1u) * nloc) {
            __builtin_amdgcn_fence(__ATOMIC_RELEASE, "agent");
            asm volatile("s_waitcnt vmcnt(0)" ::: "memory");
            const unsigned og = xb_add(&bar[XB_TOP], 1u);
            const unsigned tg = og / nx;
            if (og + 1u == (tg + 1u) * nx) xb_add(&bar[XB_TOPGEN], 1u);
            else XB_SPIN(xb_ld(&bar[XB_TOPGEN]) == tg, bar);
            __builtin_amdgcn_fence(__ATOMIC_ACQUIRE, "agent");
            xb_add(&bar[XB_XGEN(b.x)], 1u);
            asm volatile("s_waitcnt vmcnt(0)" ::: "memory");
        } else {
            XB_SPIN(xb_ld(&bar[XB_XGEN(b.x)]) == gen, bar);
            __builtin_amdgcn_fence(__ATOMIC_ACQUIRE, "agent");
            asm volatile("s_waitcnt vmcnt(0)" ::: "memory");
        }
    }
    __syncthreads();
}

struct Args { const void* in[31]; float* out; unsigned char* ws; int ph_lo, ph_hi; };

struct Frame {
    LAS unsigned char* lds;
    int tid, lane, wave, gw, NGW, G, vcu;
    const Args* a;
    unsigned char* ws;
};
#define INF(i) ((const float*)F.a->in[i])
#define WSP(T_, off) ((T_*)(F.ws + (off)))

__device__ __forceinline__ void conv_w(const Frame& F, const float* src, int ldn, int K, int ncols, int nbatch, size_t sbs, bf16* dst, int rmul, int roff, size_t dbs, const float* kscale) {
    LAS float* scr = (LAS float*)(F.lds + F.wave * 16384);
    const int lane = F.lane, nblk = ncols / 32, kblk = K / 64, per = nblk * kblk, total = per * nbatch;
    for (int it = F.gw; it < total; it += F.NGW) {
        const int bt = it / per, r = it % per, kb = r / nblk, nb = r % nblk, k0 = kb * 64, n0 = nb * 32;
        const float* W = src + (size_t)bt * sbs; bf16* WT = dst + (size_t)bt * dbs;
#pragma unroll 8
        for (int i = 0; i < 32; ++i) { const int kk = 2 * i + (lane >> 5); scr[kk * 33 + (lane & 31)] = W[(size_t)(k0 + kk) * ldn + n0 + (lane & 31)]; }
        LDS_WAIT(); asm volatile("" ::: "memory");
        const int c = lane & 7;
        float ks[8];
#pragma unroll
        for (int i = 0; i < 8; ++i) ks[i] = kscale ? kscale[k0 + 8 * c + i] : 1.0f;
#pragma unroll
        for (int j = 0; j < 4; ++j) { const int n = (lane >> 3) + 8 * j; const LAS float* s = scr + (8 * c) * 33 + n;
            v4u o; o.x = pk2(s[0 * 33] * ks[0], s[1 * 33] * ks[1]); o.y = pk2(s[2 * 33] * ks[2], s[3 * 33] * ks[3]); o.z = pk2(s[4 * 33] * ks[4], s[5 * 33] * ks[5]); o.w = pk2(s[6 * 33] * ks[6], s[7 * 33] * ks[7]);
            *(v4u*)(WT + (size_t)(rmul * (n0 + n) + roff) * K + k0 + 8 * c) = o; }
        LDS_WAIT(); asm volatile("" ::: "memory");
    }
}
__device__ __forceinline__ void phase_convert(const Frame& F, int L) {
    const int j = L >> 1;
    const float* win = INF(4) + (size_t)L * D * IN_COLS;
    conv_w(F, win, IN_COLS, D, 3072, 1, 0, WSP(bf16, W_IN), 1, 0, 0, nullptr);
    conv_w(F, win + 3744, IN_COLS, D, 2048, 1, 0, WSP(bf16, W_IN), 1, 3072, 0, nullptr);
    conv_w(F, win + 3072, IN_COLS, D, 672, 1, 0, WSP(bf16, W_IN), 1, 5120, 0, nullptr);
    { bf16* padr = WSP(bf16, W_IN) + (size_t)IN_COLS * D;
      unsigned z_ = 0u; asm volatile("" : "+v"(z_));
      for (int i = F.gw * 64 + F.lane; i < (NIN - IN_COLS) * D / 8; i += F.NGW * 64) ((v4u*)padr)[i] = (v4u){z_, z_, z_, z_}; }
    conv_w(F, INF(12) + (size_t)L * QR * 768, 768, QR, 768, 1, 0, WSP(bf16, W_UQ), 1, 0, 0, INF(11) + L * QR);
    conv_w(F, INF(14) + (size_t)L * KVR * 1024, 1024, KVR, 1024, 1, 0, WSP(bf16, W_UKV), 1, 0, 0, INF(13) + L * KVR);
    conv_w(F, INF(15) + (size_t)L * D * D, D, D, D, 1, 0, WSP(bf16, W_BD), 1, 0, 0, nullptr);
    conv_w(F, INF(16) + (size_t)L * 512 * D, D, 512, D, 1, 0, WSP(bf16, W_BM), 1, 0, 0, nullptr);
    conv_w(F, INF(17) + (size_t)L * D * D, D, D, D, 1, 0, WSP(bf16, W_OUT), 1, 0, 0, nullptr);
    conv_w(F, INF(27) + (size_t)L * D * D, D, D, D, 1, 0, WSP(bf16, W_PG), 1, 0, 0, nullptr);
    conv_w(F, INF(28) + (size_t)L * PLE * D, D, PLE, D, 1, 0, WSP(bf16, W_PP), 1, 0, 0, nullptr);
    if ((L & 1) == 0) {
        conv_w(F, INF(20) + (size_t)j * D * DENSE_FF, DENSE_FF, D, DENSE_FF, 1, 0, WSP(bf16, W_F13), 2, 0, 0, nullptr);
        conv_w(F, INF(21) + (size_t)j * D * DENSE_FF, DENSE_FF, D, DENSE_FF, 1, 0, WSP(bf16, W_F13), 2, 1, 0, nullptr);
        conv_w(F, INF(22) + (size_t)j * DENSE_FF * D, D, DENSE_FF, D, 1, 0, WSP(bf16, W_F2D), 1, 0, 0, nullptr);
    } else {
        const size_t eo = (size_t)j * NEXP * D * EXPERT_FF;
        conv_w(F, INF(24) + eo, EXPERT_FF, D, EXPERT_FF, NEXP, (size_t)D * EXPERT_FF, WSP(bf16, W_F13), 2, 0, (size_t)2 * EXPERT_FF * D, nullptr);
        conv_w(F, INF(25) + eo, EXPERT_FF, D, EXPERT_FF, NEXP, (size_t)D * EXPERT_FF, WSP(bf16, W_F13), 2, 1, (size_t)2 * EXPERT_FF * D, nullptr);
        conv_w(F, INF(26) + eo, D, EXPERT_FF, D, NEXP, (size_t)EXPERT_FF * D, WSP(bf16, W_F2E), 1, 0, (size_t)D * EXPERT_FF, nullptr);
    }
    { const f32x4* ps = (const f32x4*)(INF(1) + (size_t)L * T * PLE); v2u* pd = WSP(v2u, WS_PB);
      for (int i = F.gw * 64 + F.lane; i < T * PLE / 4; i += F.NGW * 64) { const f32x4 v = ps[i]; v2u o; o.x = pk2(v[0], v[1]); o.y = pk2(v[2], v[3]); pd[i] = o; } }
}

__device__ __forceinline__ void phase_prologue(const Frame& F) {
    const int* pos = (const int*)F.a->in[2];
    for (int m = F.gw; m < T; m += F.NGW) {
        const f32x4* xr = (const f32x4*)(INF(0) + (size_t)m * D) + F.lane; f32x4* orow = (f32x4*)(F.a->out + (size_t)m * D) + F.lane; v2u* br = WSP(v2u, WS_XB) + (size_t)m * (D / 4) + F.lane;
#pragma unroll
        for (int j = 0; j < 4; ++j) { const f32x4 v = xr[64 * j]; orow[64 * j] = v; v2u o; o.x = pk2(v[0], v[1]); o.y = pk2(v[2], v[3]); br[64 * j] = o; }
    }
    { float* rope = WSP(float, WS_ROPE);
      for (int idx = F.gw * 64 + F.lane; idx < T * 16; idx += F.NGW * 64) {
          const int t = idx >> 4, j = idx & 15;
          double inv = 1.0; for (int i = 0; i < j; ++i) inv *= 0.5623413251903491;
          const double ang = (double)pos[t] * inv;
          const double nq = __builtin_rint(ang * 0.6366197723675814);
          double y = __builtin_fma(-nq, 1.5707963267948966, ang); y = __builtin_fma(-nq, 6.123233995736766e-17, y);
          const double y2 = y * y;
          double sp = 1.0 / 6227020800.0; sp = sp * y2 - 1.0 / 39916800.0; sp = sp * y2 + 1.0 / 362880.0; sp = sp * y2 - 1.0 / 5040.0; sp = sp * y2 + 1.0 / 120.0; sp = sp * y2 - 1.0 / 6.0;
          const double sn = y + y * y2 * sp;
          double cp = -1.0 / 87178291200.0; cp = cp * y2 + 1.0 / 479001600.0; cp = cp * y2 - 1.0 / 3628800.0; cp = cp * y2 + 1.0 / 40320.0; cp = cp * y2 - 1.0 / 720.0; cp = cp * y2 + 1.0 / 24.0; cp = cp * y2 - 0.5;
          const double cs = 1.0 + y2 * cp;
          const int q = ((int)nq) & 3;
          const double c = (q == 0) ? cs : (q == 1) ? -sn : (q == 2) ? -cs : sn;
          const double s = (q == 0) ? sn : (q == 1) ? cs : (q == 2) ? -sn : -cs;
          rope[2 * idx] = (float)c; rope[2 * idx + 1] = (float)s;
      } }
    { int* bm = WSP(int, WS_MISC);
      for (int blk = F.gw; blk < T / 64; blk += F.NGW) { int v = pos[blk * 64 + F.lane];
#pragma unroll
          for (int o = 1; o < 64; o <<= 1) { const int t2 = shxi(v, o, F.lane); v = t2 > v ? t2 : v; }
          if (F.lane == 0) bm[blk] = v; } }
    { float* lut = WSP(float, WS_MISC + 4096); const float* tab = INF(3);
      for (int idx = F.gw * 64 + F.lane; idx < 8 * 132; idx += F.NGW * 64) { const int hh = idx / 132, n = idx % 132;
          int bk = n;
          if (n >= 16) bk = 16 + (n >= 19) + (n >= 21) + (n >= 24) + (n >= 27) + (n >= 31) + (n >= 35) + (n >= 40) + (n >= 46) + (n >= 52) + (n >= 59) + (n >= 67) + (n >= 77) + (n >= 87) + (n >= 99) + (n >= 113);
          lut[idx] = tab[bk * 8 + hh] * LOG2E; } }
    for (int rep = 0; rep < REP_CONV; ++rep) phase_convert(F, 0);
}

__device__ __forceinline__ void phase_rms_rope(const Frame& F) {
    const float* CQ = WSP(float, A_CQ); const float* rope = WSP(float, WS_ROPE);
    bf16* CQN = WSP(bf16, A_CQN); bf16* CKVN = WSP(bf16, A_CKVN); bf16* MKR = WSP(bf16, A_MKR);
    const int l = F.lane;
    for (int m = F.gw; m < T; m += F.NGW) {
        const float* c = CQ + (size_t)m * 768;
        const f32x2 a0 = *(const f32x2*)(c + 6 * l), a1 = *(const f32x2*)(c + 6 * l + 2), a2 = *(const f32x2*)(c + 6 * l + 4);
        const f32x4 kv = *(const f32x4*)(c + QR + 4 * l);
        float x1 = 0.f, x2 = 0.f, rc = 0.f, rs = 0.f;
        if (l < 16) { x1 = c[QR + KVR + l]; x2 = c[QR + KVR + 16 + l]; rc = rope[(size_t)m * 32 + 2 * l]; rs = rope[(size_t)m * 32 + 2 * l + 1]; }
        const float sq = wave_sum(l, a0[0] * a0[0] + a0[1] * a0[1] + a1[0] * a1[0] + a1[1] * a1[1] + a2[0] * a2[0] + a2[1] * a2[1]);
        const float sk = wave_sum(l, kv[0] * kv[0] + kv[1] * kv[1] + kv[2] * kv[2] + kv[3] * kv[3]);
        const float rq = 1.0f / sqrtf(sq * (1.0f / QR) + LN_EPS), rk = 1.0f / sqrtf(sk * (1.0f / KVR) + LN_EPS);
        unsigned* qo = (unsigned*)(CQN + (size_t)m * QR + 6 * l);
        qo[0] = pk2(a0[0] * rq, a0[1] * rq); qo[1] = pk2(a1[0] * rq, a1[1] * rq); qo[2] = pk2(a2[0] * rq, a2[1] * rq);
        v2u ko; ko.x = pk2(kv[0] * rk, kv[1] * rk); ko.y = pk2(kv[2] * rk, kv[3] * rk);
        *(v2u*)(CKVN + (size_t)m * KVR + 4 * l) = ko;
        if (l < 16) { const float o1 = x1 * rc - x2 * rs, o2 = x1 * rs + x2 * rc; const unsigned w = pk2(o1, o2);
            MKR[(size_t)m * 32 + l] = (bf16)(w & 0xffffu); MKR[(size_t)m * 32 + 16 + l] = (bf16)(w >> 16); }
    }
}

__device__ __forceinline__ void phase_combine(const Frame& F, int L) {
    const float lam_init = 0.8f - 0.6f * expf(-0.3f * (float)L);
    const int l = F.lane;
    const float d1 = wave_sum(l, INF(6)[L * 64 + l] * INF(7)[L * 64 + l]), d2 = wave_sum(l, INF(8)[L * 64 + l] * INF(9)[L * 64 + l]);
    const float lam = expf(d1) - expf(d2) + lam_init;
    const bf16* OA2 = WSP(bf16, A_OA2); bf16* OA = WSP(bf16, A_OA);
    const int hh = l >> 3, d0 = (l & 7) * 16;
    float gsc[16];
#pragma unroll
    for (int i = 0; i < 16; ++i) gsc[i] = INF(10)[L * 128 + d0 + i] * (1.0f - lam_init);
    for (int m = F.gw; m < T; m += F.NGW) {
        const bf16* p0 = OA2 + (size_t)m * 2048 + (hh * 2) * 128 + d0;
        const v4u a0 = *(const v4u*)p0, a1 = *(const v4u*)(p0 + 8), b0 = *(const v4u*)(p0 + 128), b1 = *(const v4u*)(p0 + 136);
        float o[16];
        o[0] = bflo(a0.x) - lam * bflo(b0.x); o[1] = bfhi(a0.x) - lam * bfhi(b0.x); o[2] = bflo(a0.y) - lam * bflo(b0.y); o[3] = bfhi(a0.y) - lam * bfhi(b0.y);
        o[4] = bflo(a0.z) - lam * bflo(b0.z); o[5] = bfhi(a0.z) - lam * bfhi(b0.z); o[6] = bflo(a0.w) - lam * bflo(b0.w); o[7] = bfhi(a0.w) - lam * bfhi(b0.w);
        o[8] = bflo(a1.x) - lam * bflo(b1.x); o[9] = bfhi(a1.x) - lam * bfhi(b1.x); o[10] = bflo(a1.y) - lam * bflo(b1.y); o[11] = bfhi(a1.y) - lam * bfhi(b1.y);
        o[12] = bflo(a1.z) - lam * bflo(b1.z); o[13] = bfhi(a1.z) - lam * bfhi(b1.z); o[14] = bflo(a1.w) - lam * bflo(b1.w); o[15] = bfhi(a1.w) - lam * bfhi(b1.w);
        float ss = 0.f;
#pragma unroll
        for (int i = 0; i < 16; ++i) ss += o[i] * o[i];
        ss += shx(ss, 1, l); ss += shx(ss, 2, l); ss += shx(ss, 4, l);
        const float rr = 1.0f / sqrtf(ss * (1.0f / 128.0f) + LN_EPS);
        v4u w0, w1;
        w0.x = pk2(o[0] * rr * gsc[0], o[1] * rr * gsc[1]); w0.y = pk2(o[2] * rr * gsc[2], o[3] * rr * gsc[3]); w0.z = pk2(o[4] * rr * gsc[4], o[5] * rr * gsc[5]); w0.w = pk2(o[6] * rr * gsc[6], o[7] * rr * gsc[7]);
        w1.x = pk2(o[8] * rr * gsc[8], o[9] * rr * gsc[9]); w1.y = pk2(o[10] * rr * gsc[10], o[11] * rr * gsc[11]); w1.z = pk2(o[12] * rr * gsc[12], o[13] * rr * gsc[13]); w1.w = pk2(o[14] * rr * gsc[14], o[15] * rr * gsc[15]);
        bf16* po = OA + (size_t)m * 1024 + hh * 128 + d0;
        *(v4u*)po = w0; *(v4u*)(po + 8) = w1;
    }
}

template <bool ROUTE, bool GATHER>
__device__ __forceinline__ void phase_ln(const Frame& F, const float* gam, const float* bet, const float* wr, int moe_j) {
    const float* PRE = WSP(float, A_PRE); const int l = F.lane;
    const bf16* YG = WSP(bf16, A_YG); int* TOKE = WSP(int, A_TOK); float* TOKG = WSP(float, A_TOK + 1 * MiB); const int* TOKR = WSP(int, A_TOK + 2 * MiB);
    int* TOKS = WSP(int, A_TOK + 3 * MiB); int* CNTW = WSP(int, A_TOK + 4 * MiB);
    int rc0 = 0, rc1 = 0, rc2 = 0, rc3 = 0, rc4 = 0, rc5 = 0, rc6 = 0, rc7 = 0; (void)moe_j;
    f32x4 gv[4], bv[4];
#pragma unroll
    for (int j = 0; j < 4; ++j) { gv[j] = *(const f32x4*)(gam + 4 * l + 256 * j); bv[j] = *(const f32x4*)(bet + 4 * l + 256 * j); }
    for (int m = F.gw; m < T; m += F.NGW) {
        const f32x4* xr = (const f32x4*)(PRE + (size_t)m * D) + l;
        f32x4 v[4]; float s = 0.f;
#pragma unroll
        for (int j = 0; j < 4; ++j) v[j] = xr[64 * j];
        if (GATHER) { const int r0 = TOKR[2 * m], r1 = TOKR[2 * m + 1]; const float g0 = TOKG[2 * m], g1 = TOKG[2 * m + 1];
            const v2u* y0 = (const v2u*)(YG + (size_t)r0 * D) + l; const v2u* y1 = (const v2u*)(YG + (size_t)r1 * D) + l;
#pragma unroll
            for (int j = 0; j < 4; ++j) { const v2u a = y0[64 * j], b = y1[64 * j];
                v[j][0] += g0 * bflo(a.x) + g1 * bflo(b.x); v[j][1] += g0 * bfhi(a.x) + g1 * bfhi(b.x); v[j][2] += g0 * bflo(a.y) + g1 * bflo(b.y); v[j][3] += g0 * bfhi(a.y) + g1 * bfhi(b.y); } }
#pragma unroll
        for (int j = 0; j < 4; ++j) s += (v[j][0] + v[j][1]) + (v[j][2] + v[j][3]);
        const float mean = wave_sum(l, s) * (1.f / D); float s2 = 0.f;
#pragma unroll
        for (int j = 0; j < 4; ++j) { v[j] = v[j] - mean; s2 += (v[j][0] * v[j][0] + v[j][1] * v[j][1]) + (v[j][2] * v[j][2] + v[j][3] * v[j][3]); }
        const float rstd = 1.f / sqrtf(wave_sum(l, s2) * (1.f / D) + LN_EPS);
        f32x4* orow = (f32x4*)(F.a->out + (size_t)m * D) + l; v2u* br = WSP(v2u, WS_XB) + (size_t)m * (D / 4) + l;
#pragma unroll
        for (int j = 0; j < 4; ++j) { v[j] = v[j] * rstd * gv[j] + bv[j]; orow[64 * j] = v[j]; v2u o; o.x = pk2(v[j][0], v[j][1]); o.y = pk2(v[j][2], v[j][3]); br[64 * j] = o; }
        if (ROUTE) {
            float lg[8];
#pragma unroll
            for (int e = 0; e < 8; ++e) lg[e] = 0.f;
#pragma unroll
            for (int j = 0; j < 4; ++j)
#pragma unroll
                for (int c = 0; c < 4; ++c) { const float* w = wr + (size_t)(4 * l + 256 * j + c) * 8; const f32x4 w0 = *(const f32x4*)w, w1 = *(const f32x4*)(w + 4); const float xv = v[j][c];
                    lg[0] += xv * w0[0]; lg[1] += xv * w0[1]; lg[2] += xv * w0[2]; lg[3] += xv * w0[3]; lg[4] += xv * w1[0]; lg[5] += xv * w1[1]; lg[6] += xv * w1[2]; lg[7] += xv * w1[3]; }
#pragma unroll
            for (int e = 0; e < 8; ++e) lg[e] = wave_sum(l, lg[e]);
            int e0 = 0; float v0 = lg[0];
#pragma unroll
            for (int e = 1; e < 8; ++e) if (lg[e] > v0) { v0 = lg[e]; e0 = e; }
            int e1 = -1; float v1 = -INFINITY;
#pragma unroll
            for (int e = 0; e < 8; ++e) if (e != e0 && lg[e] > v1) { v1 = lg[e]; e1 = e; }
            const float g1 = 1.0f / (1.0f + expf(v0 - v1)), g0 = 1.0f - g1;
            const int s0 = (e0 == 0) ? rc0 : (e0 == 1) ? rc1 : (e0 == 2) ? rc2 : (e0 == 3) ? rc3 : (e0 == 4) ? rc4 : (e0 == 5) ? rc5 : (e0 == 6) ? rc6 : rc7;
            const int s1 = (e1 == 0) ? rc0 : (e1 == 1) ? rc1 : (e1 == 2) ? rc2 : (e1 == 3) ? rc3 : (e1 == 4) ? rc4 : (e1 == 5) ? rc5 : (e1 == 6) ? rc6 : rc7;
            rc0 += (e0 == 0) + (e1 == 0); rc1 += (e0 == 1) + (e1 == 1); rc2 += (e0 == 2) + (e1 == 2); rc3 += (e0 == 3) + (e1 == 3);
            rc4 += (e0 == 4) + (e1 == 4); rc5 += (e0 == 5) + (e1 == 5); rc6 += (e0 == 6) + (e1 == 6); rc7 += (e0 == 7) + (e1 == 7);
            if (l == 0) { TOKE[2 * m] = e0; TOKE[2 * m + 1] = e1; TOKG[2 * m] = g0; TOKG[2 * m + 1] = g1; TOKS[2 * m] = s0; TOKS[2 * m + 1] = s1; }
        }
    }
    if (ROUTE && l == 0) { int* cw = CNTW + (size_t)F.gw * 8; cw[0] = rc0; cw[1] = rc1; cw[2] = rc2; cw[3] = rc3; cw[4] = rc4; cw[5] = rc5; cw[6] = rc6; cw[7] = rc7; }
}

struct MoeTiles { int pend[8]; int total; };
__device__ __forceinline__ void moe_tiles(const Frame& F, int moe_j, MoeTiles& mt) {
    const int* tot = WSP(int, A_TOK + 5 * MiB); int acc = 0; (void)moe_j;
#pragma unroll
    for (int e = 0; e < 8; ++e) { const int c = tot[e]; acc += (c + 255) >> 8; mt.pend[e] = acc; }
    mt.total = acc;
}
__device__ __forceinline__ void phase_scatter(const Frame& F, int moe_j) {
    (void)moe_j;
    const int* CNTW = WSP(int, A_TOK + 4 * MiB); const int* TOKS = WSP(int, A_TOK + 3 * MiB); int* TOT = WSP(int, A_TOK + 5 * MiB);
    const int* TOKE = WSP(int, A_TOK); int* TOKR = WSP(int, A_TOK + 2 * MiB);
    const v4u* XB = WSP(v4u, WS_XB); v4u* XG = WSP(v4u, A_XG); const int l = F.lane;
    LAS int* red = (LAS int*)F.lds;
    int tot[8], pre[8];
#pragma unroll
    for (int e = 0; e < 8; ++e) { tot[e] = 0; pre[e] = 0; }
    const int wg0 = F.vcu * NWAVES;
    for (int w = F.tid; w < F.NGW; w += NWAVES * 64) { const v4u a = *(const v4u*)(CNTW + (size_t)w * 8), b = *(const v4u*)(CNTW + (size_t)w * 8 + 4); const int below = (w < wg0) ? 1 : 0;
        tot[0] += a.x; tot[1] += a.y; tot[2] += a.z; tot[3] += a.w; tot[4] += b.x; tot[5] += b.y; tot[6] += b.z; tot[7] += b.w;
        pre[0] += below * (int)a.x; pre[1] += below * (int)a.y; pre[2] += below * (int)a.z; pre[3] += below * (int)a.w; pre[4] += below * (int)b.x; pre[5] += below * (int)b.y; pre[6] += below * (int)b.z; pre[7] += below * (int)b.w; }
#pragma unroll
    for (int e = 0; e < 8; ++e) {
#pragma unroll
        for (int o = 1; o < 64; o <<= 1) { tot[e] += shxi(tot[e], o, l); pre[e] += shxi(pre[e], o, l); } }
    if (l == 0) {
#pragma unroll
        for (int e = 0; e < 8; ++e) { red[F.wave * 16 + e] = tot[e]; red[F.wave * 16 + 8 + e] = pre[e]; } }
    __syncthreads();
    int base[8]; int acc = 0;
#pragma unroll
    for (int e = 0; e < 8; ++e) { int t = 0, p = 0;
#pragma unroll
        for (int w = 0; w < NWAVES; ++w) { t += red[w * 16 + e]; p += red[w * 16 + 8 + e]; }
        int mine = 0;
#pragma unroll
        for (int w = 0; w < NWAVES; ++w) { const int c = CNTW[(size_t)(wg0 + w) * 8 + e]; mine += (w < F.wave) ? c : 0; }
        base[e] = acc * 256 + p + mine; acc += (t + 255) >> 8;
        if (F.vcu == 0 && F.tid == 0) TOT[e] = t; }
    __syncthreads();
    for (int m = F.gw; m < T; m += F.NGW) {
        int rows[2];
#pragma unroll
        for (int k = 0; k < 2; ++k) { const int e = TOKE[2 * m + k]; const int sl = TOKS[2 * m + k];
            const int bs = (e == 0) ? base[0] : (e == 1) ? base[1] : (e == 2) ? base[2] : (e == 3) ? base[3] : (e == 4) ? base[4] : (e == 5) ? base[5] : (e == 6) ? base[6] : base[7];
            rows[k] = bs + sl; }
        const v4u a = XB[(size_t)m * 128 + l], b = XB[(size_t)m * 128 + 64 + l];
        XG[(size_t)rows[0] * 128 + l] = a; XG[(size_t)rows[0] * 128 + 64 + l] = b; XG[(size_t)rows[1] * 128 + l] = a; XG[(size_t)rows[1] * 128 + 64 + l] = b;
        if (l == 0) { TOKR[2 * m] = rows[0]; TOKR[2 * m + 1] = rows[1]; }
    }
}

__device__ __forceinline__ void phase_attn_diff(const Frame& F) {
    att::AttnP P; P.Q = WSP(bf16, A_DQ); P.ldq = 1024; P.K1 = WSP(bf16, A_DK); P.ldk1 = 1024; P.K2 = P.K1; P.ldk2 = 1024; P.V = WSP(bf16, A_DV); P.ldv = 1024; P.O = WSP(bf16, A_OA2); P.ldo = 2048;
    P.pos = (const int*)F.a->in[2]; P.blkmax = WSP(int, WS_MISC); P.lut = WSP(float, WS_MISC + 4096);
    for (int p = F.vcu; p < BATCH * 16 * 8; p += F.G) {
        const int bh = p >> 3, i = p & 7, b = bh >> 4, vh = bh & 15;
        att::ATT_UNIT<64, 64, 128, true>(P, b, 15 - i, vh * 64, vh * 64, (vh >> 1) * 128, vh * 128, vh >> 1, F.lds);
        att::ATT_UNIT<64, 64, 128, true>(P, b, i, vh * 64, vh * 64, (vh >> 1) * 128, vh * 128, vh >> 1, F.lds);
    }
}
__device__ __forceinline__ void phase_attn_mla(const Frame& F) {
    att::AttnP P; P.Q = WSP(bf16, A_MQ); P.ldq = 768; P.K1 = WSP(bf16, A_MKV); P.ldk1 = 1024; P.K2 = WSP(bf16, A_MKR); P.ldk2 = 32; P.V = WSP(bf16, A_MKV); P.ldv = 1024; P.O = WSP(bf16, A_OB); P.ldo = 512;
    P.pos = (const int*)F.a->in[2]; P.blkmax = WSP(int, WS_MISC); P.lut = WSP(float, WS_MISC + 4096);
    for (int p = F.vcu; p < BATCH * 8 * 8; p += F.G) {
        const int bh = p >> 3, i = p & 7, b = bh >> 3, hh = bh & 7;
        att::ATT_UNIT<96, 64, 64, false>(P, b, 15 - i, hh * 96, hh * 128, hh * 128 + 64, hh * 64, 0, F.lds);
        att::ATT_UNIT<96, 64, 64, false>(P, b, i, hh * 96, hh * 128, hh * 128 + 64, hh * 64, 0, F.lds);
    }
}

constexpr int NPH_DENSE = 10, NPH_MOE = 9 + 2 * MOE_NCHUNK, NPH_TOTAL = 1 + 2 * NPH_DENSE + 2 * NPH_MOE;
#define GEMM_CALL(EPI, SCHED, gm, S_, E_) pg8::gemm_phase<EPI, SCHED, true, true>(F.lds, gm, S_, E_)

__global__ void __launch_bounds__(NWAVES * 64, 2) mega_fwd(Args args) {
    extern __shared__ __attribute__((aligned(16))) unsigned char lds_raw[];
    Frame F;
    F.lds = (LAS unsigned char*)lds_raw; F.a = &args; F.ws = args.ws;
    F.tid = threadIdx.x; F.lane = F.tid & 63; F.wave = __builtin_amdgcn_readfirstlane(F.tid >> 6);
    F.G = gridDim.x; { const int bx = blockIdx.x; F.vcu = (F.G % 8 == 0) ? (bx % 8) * (F.G / 8) + bx / 8 : bx; }
    F.gw = F.vcu * NWAVES + F.wave; F.NGW = F.G * NWAVES;
    volatile LAS unsigned* MISC = (volatile LAS unsigned*)(F.lds + MISC_OFF);
    for (int u = F.tid; u < (LDS_BYTES - RING_BYTES) / 4; u += NWAVES * 64) ((LAS unsigned*)(F.lds + RING_BYTES))[u] = 0u;
    __syncthreads();
    const int lo = args.ph_lo, hi = args.ph_hi;
    XcdBarrier bar; bar.bar = WSP(unsigned, WS_CTL) + CW_BAR; bar.x = 0; bar.st = nullptr;
    if (hi - lo > 1) bar = xcd_barrier_post(WSP(unsigned, WS_CTL) + CW_BAR, MISC + 8);
    int pc = 0;
#define PH_BEGIN if (pc >= lo && pc < hi) { { int t_ = threadIdx.x; asm volatile("" : "+v"(t_)); F.tid = t_; F.lane = t_ & 63; F.wave = __builtin_amdgcn_readfirstlane(t_ >> 6); F.gw = F.vcu * NWAVES + F.wave; }
#define PH_END if (pc + 1 < hi) { for (int rb = 0; rb < REP_BAR; ++rb) xcd_barrier(bar); } } ++pc;
    const int bx = (int)blockIdx.x;
    const float ALPHA = 1.6817928305074290f;

    PH_BEGIN for (int rep = 0; rep < REP_P0; ++rep) phase_prologue(F); PH_END

    for (int L = 0; L < DEPTH; ++L) {
        const int mj = L >> 1;
        PH_BEGIN {
            pg8::Gemm g{WSP(bf16, WS_XB), WSP(bf16, W_IN), T, NIN, D}; pg8::StaticOrder S; S.init(T, NIN, F.G, bx);
            pg8::EpiL1 E{WSP(bf16, A_DQ), WSP(bf16, A_G), WSP(float, A_CQ), INF(5) + L * 2048, 0.125f * LOG2E};
            for (int rep = 0; rep < REP_L1; ++rep) GEMM_CALL(pg8::EpiL1, pg8::StaticOrder, g, S, E);
        } PH_END
        PH_BEGIN for (int rep = 0; rep < REP_EW; ++rep) phase_rms_rope(F); PH_END
        PH_BEGIN {
            for (int rep = 0; rep < REP_MIX; ++rep) {
            { pg8::Gemm g{WSP(bf16, A_CQN), WSP(bf16, W_UQ), T, 768, QR}; pg8::StaticOrder S; S.init(T, 768, F.G, bx);
              pg8::EpiRopeQ E{WSP(bf16, A_MQ), WSP(float, WS_ROPE), 0.10206207261596577f * LOG2E};
              GEMM_CALL(pg8::EpiRopeQ, pg8::StaticOrder, g, S, E); }
            { pg8::Gemm g{WSP(bf16, A_CKVN), WSP(bf16, W_UKV), T, 1024, KVR}; pg8::StaticOrder S; S.init(T, 1024, F.G, bx);
              pg8::EpiBf16 E{WSP(bf16, A_MKV), 1024};
              GEMM_CALL(pg8::EpiBf16, pg8::StaticOrder, g, S, E); }
            }
            for (int rep = 0; rep < REP_ATTN_D; ++rep) phase_attn_diff(F);
        } PH_END
        PH_BEGIN { for (int rep = 0; rep < REP_ATTN_M; ++rep) phase_attn_mla(F); for (int rep = 0; rep < REP_EW; ++rep) phase_combine(F, L); } PH_END
        PH_BEGIN {
            for (int rep = 0; rep < REP_MIX; ++rep) {
            { pg8::Gemm g{WSP(bf16, A_OB), WSP(bf16, W_BM), T, D, 512}; pg8::StaticOrder S; S.init(T, D, F.G, bx);
              pg8::EpiGate<false> E{WSP(bf16, A_MT), WSP(bf16, A_G), nullptr, 1024};
              GEMM_CALL(pg8::EpiGate<false>, pg8::StaticOrder, g, S, E); }
            { pg8::Gemm g{WSP(bf16, A_OA), WSP(bf16, W_BD), T, D, D}; pg8::StaticOrder S; S.init(T, D, F.G, bx);
              pg8::EpiGate<true> E{WSP(bf16, A_M), WSP(bf16, A_G), WSP(bf16, A_MT), 0};
              GEMM_CALL(pg8::EpiGate<true>, pg8::StaticOrder, g, S, E); }
            }
        } PH_END
        PH_BEGIN {
            pg8::Gemm g{WSP(bf16, A_M), WSP(bf16, W_OUT), T, D, D}; pg8::StaticOrder S; S.init(T, D, F.G, bx);
            pg8::EpiF32<1> E{WSP(float, A_PRE), args.out, ALPHA};
            for (int rep = 0; rep < REP_MIX; ++rep) GEMM_CALL(pg8::EpiF32<1>, pg8::StaticOrder, g, S, E);
        } PH_END
        PH_BEGIN {
            if (L & 1) phase_ln<true, false>(F, INF(18) + L * D, INF(19) + L * D, INF(23) + (size_t)mj * D * NEXP, mj);
            else for (int rep = 0; rep < REP_LN; ++rep) phase_ln<false, false>(F, INF(18) + L * D, INF(19) + L * D, nullptr, 0);
        } PH_END
        if ((L & 1) == 0) {
            PH_BEGIN {
                for (int rep = 0; rep < REP_FFN; ++rep) {
                { pg8::Gemm g{WSP(bf16, WS_XB), WSP(bf16, W_F13), T, 2 * DENSE_FF, D}; pg8::StaticOrder S; S.init(T, 2 * DENSE_FF, F.G, bx);
                  pg8::EpiSwiGLU E{WSP(bf16, A_H), DENSE_FF};
                  GEMM_CALL(pg8::EpiSwiGLU, pg8::StaticOrder, g, S, E); }
                { pg8::Gemm g{WSP(bf16, WS_PB), WSP(bf16, W_PP), T, D, PLE}; pg8::StaticOrder S; S.init(T, D, F.G, bx);
                  pg8::EpiF32<0> E{WSP(float, A_PRE), nullptr, 0.f};
                  GEMM_CALL(pg8::EpiF32<0>, pg8::StaticOrder, g, S, E); }
                { pg8::Gemm g{WSP(bf16, WS_XB), WSP(bf16, W_PG), T, D, D}; pg8::StaticOrder S; S.init(T, D, F.G, bx);
                  pg8::EpiF32<2> E{WSP(float, A_PRE), args.out, ALPHA};
                  GEMM_CALL(pg8::EpiF32<2>, pg8::StaticOrder, g, S, E); }
                }
            } PH_END
            PH_BEGIN {
                pg8::Gemm g{WSP(bf16, A_H), WSP(bf16, W_F2D), T, D, DENSE_FF}; pg8::StaticOrder S; S.init(T, D, F.G, bx);
                pg8::EpiF32<3> E{WSP(float, A_PRE), nullptr, 0.f};
                GEMM_CALL(pg8::EpiF32<3>, pg8::StaticOrder, g, S, E);
            } PH_END
            PH_BEGIN { for (int rep = 0; rep < REP_LN; ++rep) phase_ln<false, false>(F, INF(29) + L * D, INF(30) + L * D, nullptr, 0); if (L + 1 < DEPTH) for (int rep = 0; rep < REP_CONV; ++rep) phase_convert(F, L + 1); } PH_END
        } else {
            PH_BEGIN {
                phase_scatter(F, mj);
                for (int rep = 0; rep < REP_PPE; ++rep) {
                { pg8::Gemm g{WSP(bf16, WS_PB), WSP(bf16, W_PP), T, D, PLE}; pg8::StaticOrder S; S.init(T, D, F.G, bx);
                  pg8::EpiF32<0> E{WSP(float, A_PRE), nullptr, 0.f};
                  GEMM_CALL(pg8::EpiF32<0>, pg8::StaticOrder, g, S, E); }
                { pg8::Gemm g{WSP(bf16, WS_XB), WSP(bf16, W_PG), T, D, D}; pg8::StaticOrder S; S.init(T, D, F.G, bx);
                  pg8::EpiF32<2> E{WSP(float, A_PRE), args.out, ALPHA};
                  GEMM_CALL(pg8::EpiF32<2>, pg8::StaticOrder, g, S, E); }
                }
            } PH_END
            for (int ch = 0; ch < MOE_NCHUNK; ++ch) {
                PH_BEGIN {
                    MoeTiles mt; moe_tiles(F, mj, mt);
                    const int tlo = ch * MOE_CHUNK_TILES; int ntc = mt.total - tlo; ntc = ntc > MOE_CHUNK_TILES ? MOE_CHUNK_TILES : ntc;
                    if (ntc > 0) {
                        pg8::Gemm g{WSP(bf16, A_XG) + (size_t)tlo * 256 * D, WSP(bf16, W_F13), ntc * 256, 2 * EXPERT_FF, D};
                        pg8::GroupedOrder S; S.init(ntc * 256, 2 * EXPERT_FF, F.G, bx); S.tile_lo = tlo; S.estride = (size_t)2 * EXPERT_FF * D * 2;
                        S.pend0 = mt.pend[0]; S.pend1 = mt.pend[1]; S.pend2 = mt.pend[2]; S.pend3 = mt.pend[3]; S.pend4 = mt.pend[4]; S.pend5 = mt.pend[5]; S.pend6 = mt.pend[6]; S.pend7 = mt.pend[7];
                        pg8::EpiSwiGLU E{WSP(bf16, A_HG), EXPERT_FF};
                        for (int rep = 0; rep < REP_MOE; ++rep) GEMM_CALL(pg8::EpiSwiGLU, pg8::GroupedOrder, g, S, E);
                    }
                } PH_END
                PH_BEGIN {
                    MoeTiles mt; moe_tiles(F, mj, mt);
                    const int tlo = ch * MOE_CHUNK_TILES; int ntc = mt.total - tlo; ntc = ntc > MOE_CHUNK_TILES ? MOE_CHUNK_TILES : ntc;
                    if (ntc > 0) {
                        pg8::Gemm g{WSP(bf16, A_HG), WSP(bf16, W_F2E), ntc * 256, D, EXPERT_FF};
                        pg8::GroupedOrder S; S.init(ntc * 256, D, F.G, bx); S.tile_lo = tlo; S.estride = (size_t)D * EXPERT_FF * 2;
                        S.pend0 = mt.pend[0]; S.pend1 = mt.pend[1]; S.pend2 = mt.pend[2]; S.pend3 = mt.pend[3]; S.pend4 = mt.pend[4]; S.pend5 = mt.pend[5]; S.pend6 = mt.pend[6]; S.pend7 = mt.pend[7];
                        pg8::EpiBf16 E{WSP(bf16, A_YG) + (size_t)tlo * 256 * D, D};
                        for (int rep = 0; rep < REP_MOE; ++rep) GEMM_CALL(pg8::EpiBf16, pg8::GroupedOrder, g, S, E);
                    }
                } PH_END
            }
            PH_BEGIN { for (int rep = 0; rep < REP_LN; ++rep) phase_ln<false, true>(F, INF(29) + L * D, INF(30) + L * D, nullptr, 0); if (L + 1 < DEPTH) for (int rep = 0; rep < REP_CONV; ++rep) phase_convert(F, L + 1); } PH_END
        }
    }
#undef PH_BEGIN
#undef PH_END
}

extern "C" void kernel_launch(void* const* d_in, const int* in_sizes, int n_in, void* d_out, int out_size, void* d_ws, size_t ws_size, hipStream_t stream) {
    static int grid = 0;
    if (grid == 0) {
        if (n_in != 31 || in_sizes[0] != T * D || out_size != T * D || ws_size < WS_END) { fprintf(stderr, "kernel_launch: unexpected shapes / workspace (n_in %d, ws %zu < %zu)\n", n_in, ws_size, (size_t)WS_END); grid = -1; return; }
        int dev = 0, cus = 0, per_cu = 0;
        if (hipGetDevice(&dev) != hipSuccess || hipDeviceGetAttribute(&cus, hipDeviceAttributeMultiprocessorCount, dev) != hipSuccess) { grid = -1; return; }
        if (hipFuncSetAttribute((const void*)mega_fwd, hipFuncAttributeMaxDynamicSharedMemorySize, LDS_BYTES) != hipSuccess) { fprintf(stderr, "kernel_launch: hipFuncSetAttribute failed\n"); grid = -1; return; }
        if (hipOccupancyMaxActiveBlocksPerMultiprocessor(&per_cu, (const void*)mega_fwd, NWAVES * 64, LDS_BYTES) != hipSuccess || per_cu < 1) { fprintf(stderr, "kernel_launch: occupancy query says %d\n", per_cu); (void)hipGetLastError(); grid = -1; return; }
        grid = cus;
    }
    if (grid < 0) return;
    if (hipMemsetAsync((char*)d_ws + WS_CTL, 0, CTL_ZERO_BYTES, stream) != hipSuccess) return;
    Args a{};
    for (int i = 0; i < 31; ++i) a.in[i] = d_in[i];
    a.out = (float*)d_out; a.ws = (unsigned char*)d_ws;
#if MK_PER_PHASE
    for (int p = 0; p < NPH_TOTAL; ++p) { a.ph_lo = p; a.ph_hi = p + 1; hipLaunchKernelGGL(mega_fwd, dim3(grid), dim3(NWAVES * 64), LDS_BYTES, stream, a); }
#else
    a.ph_lo = 0; a.ph_hi = NPH_TOTAL;
    hipLaunchKernelGGL(mega_fwd, dim3(grid), dim3(NWAVES * 64), LDS_BYTES, stream, a);
#endif
}
```

```cpp
#include <hip/hip_runtime.h>
#include <cstdio>
#include <cstdint>
#include <cmath>

#ifndef MK_PER_PHASE
#define MK_PER_PHASE 0
#endif

constexpr int BATCH = 8, SEQ = 4096, T = BATCH * SEQ, D = 1024, DEPTH = 4, PLE = 256;
constexpr int IN_COLS = 5792, NIN = 5888;
constexpr int QR = 384, KVR = 256, ROPE_D = 32;
constexpr int DENSE_FF = 2816, EXPERT_FF = 3584, NEXP = 8;
constexpr float LN_EPS = 1e-5f;
constexpr float LOG2E = 1.4426950408889634f;
constexpr int MOE_ROWS = 2 * T + NEXP * 256;
constexpr int MOE_CHUNK_TILES = MOE_ROWS / 256;
constexpr int MOE_NCHUNK = 1;
#ifndef MOE_FP8
#define MOE_FP8 1
#endif

#define GAS __attribute__((address_space(1)))
#define LAS __attribute__((address_space(3)))
typedef unsigned short bf16;
typedef unsigned v4u __attribute__((ext_vector_type(4)));
typedef unsigned v2u __attribute__((ext_vector_type(2)));
typedef float f32x4 __attribute__((ext_vector_type(4)));
typedef float f32x2 __attribute__((ext_vector_type(2)));
typedef float f32x16 __attribute__((ext_vector_type(16)));
typedef short bf16x8 __attribute__((ext_vector_type(8)));
typedef short s16x4 __attribute__((ext_vector_type(4)));
typedef __bf16 bf16x2_t __attribute__((ext_vector_type(2)));
typedef GAS unsigned gu32;
#define RLX_AGENT __ATOMIC_RELAXED, __HIP_MEMORY_SCOPE_AGENT
#define LDS_WAIT() asm volatile("s_waitcnt lgkmcnt(0)" ::: "memory")
#define VM_WAIT() asm volatile("s_waitcnt vmcnt(0)" ::: "memory")

__device__ __forceinline__ unsigned pk2(float lo, float hi) { f32x2 v = {lo, hi}; bf16x2_t b = __builtin_convertvector(v, bf16x2_t); return __builtin_bit_cast(unsigned, b); }
__device__ __forceinline__ float bflo(unsigned u) { return __uint_as_float(u << 16); }
__device__ __forceinline__ float bfhi(unsigned u) { return __uint_as_float(u & 0xffff0000u); }
__device__ __forceinline__ float sigmoidf_(float x) { return __builtin_amdgcn_rcpf(1.0f + __builtin_amdgcn_exp2f(-x * LOG2E)); }
__device__ __forceinline__ float shx(float v, int o, int lane) { return __uint_as_float((unsigned)__builtin_amdgcn_ds_bpermute((lane ^ o) << 2, (int)__float_as_uint(v))); }
__device__ __forceinline__ int shxi(int v, int o, int lane) { return __builtin_amdgcn_ds_bpermute((lane ^ o) << 2, v); }
__device__ __forceinline__ float wave_sum(int lane, float v) {
#pragma unroll
    for (int o = 1; o < 64; o <<= 1) v += shx(v, o, lane);
    return v;
}

namespace pg8 {
#define PG8_LAS __attribute__((address_space(3)))
typedef unsigned short bf16_t;
typedef unsigned u32x4 __attribute__((ext_vector_type(4)));
typedef unsigned u32x2 __attribute__((ext_vector_type(2)));
constexpr int BM = 256, BK = 64, HALF = 128, HTB = HALF * BK * 2  , STAGE_BYTES = 8 * HTB, NXCD = 8, WGM = 8;

__host__ __device__ __forceinline__ int lds_byte(int r, int c) { const int st = (r >> 4) * 2 + (c >> 5), rr = r & 15, cc = c & 31, ob = rr * 64 + cc * 2; return st * 1024 + (ob ^ (((ob >> 9) & 1) << 5)); }
__host__ __device__ __forceinline__ void stage_rc(int b, int& R, int& C) { const int st = b / 1024, sb = b % 1024, swz = sb ^ (((sb >> 9) & 1) << 5); R = (st >> 1) * 16 + swz / 64; C = (st & 1) * 32 + (swz % 64) / 2; }
__host__ __device__ __forceinline__ int perm32(int rho) { const int n = rho >> 4, i = rho & 15; return 8 * (i >> 2) + 4 * n + (i & 3); }

struct Unit { int pm, pn; };
struct Gemm { const bf16_t* A; const bf16_t* Bt; int M, N, K; };

struct StaticOrder {
    int nM, nN, nwg, G, c;
    __host__ __device__ void init(int M, int N, int G_, int c_) { nM = M / BM; nN = N / BM; nwg = nM * nN; G = G_; c = c_; }
    __host__ __device__ bool next(int i, Unit& u) const {
        const long L = (long)i * G + c; if (L >= nwg) return false;
        int wgid = (int)L; { const int q = nwg / NXCD, r = nwg % NXCD, xcd = wgid % NXCD, off = wgid / NXCD; wgid = (xcd < r ? xcd * (q + 1) : r * (q + 1) + (xcd - r) * q) + off; }
        const int nig = WGM * nN, gid = wgid / nig, fm = gid * WGM, gsz = (nM - fm) < WGM ? (nM - fm) : WGM;
        u.pm = fm + ((wgid % nig) % gsz); u.pn = (wgid % nig) / gsz; return true;
    }
    __device__ __forceinline__ size_t bofs(const Unit&) const { return 0; }
    __device__ __forceinline__ void a_ready(const Unit&) const {}
    __device__ __forceinline__ void done(const Unit&) const {}
};
struct GroupedOrder : StaticOrder {
    int tile_lo; int pend0, pend1, pend2, pend3, pend4, pend5, pend6, pend7; size_t estride;
    __device__ __forceinline__ size_t bofs(const Unit& u) const {
        const int t = u.pm + tile_lo;
        const int e = (t >= pend0) + (t >= pend1) + (t >= pend2) + (t >= pend3) + (t >= pend4) + (t >= pend5) + (t >= pend6);
        return (size_t)e * estride;
    }
};

typedef f32x4 Acc[2][2][4][2];

struct EpiL1 {
    static constexpr bool PERM = true, AFTER_DRAIN = false;
    bf16_t* QKV; bf16_t* Gt; float* CQ; const float* bgate; float qscale;
    __device__ __forceinline__ void operator()(const Acc& acc, const Unit& u, int wr, int wc, int fr, int fq) const {
        const int row0 = u.pm * BM + wr * 64 + fr; const int pn = u.pn;
        if (pn < 12) {
            bf16_t* base = QKV + (size_t)(pn >> 2) * ((size_t)T * 1024); const int col0 = (pn & 3) * 256 + wc * 32 + 8 * fq; const float sc = pn < 4 ? qscale : 1.f;
#pragma unroll
            for (int ai = 0; ai < 2; ++ai)
#pragma unroll
                for (int m = 0; m < 4; ++m) { bf16_t* rowp = base + (size_t)(row0 + ai * HALF + m * 16) * 1024 + col0;
#pragma unroll
                    for (int bj = 0; bj < 2; ++bj) { const f32x4 v0 = acc[ai][bj][m][0] * sc, v1 = acc[ai][bj][m][1] * sc;
                        u32x4 w; w.x = pk2(v0[0], v0[1]); w.y = pk2(v0[2], v0[3]); w.z = pk2(v1[0], v1[1]); w.w = pk2(v1[2], v1[3]);
                        *(u32x4*)(rowp + bj * HALF) = w; } }
        } else if (pn < 20) {
            const int col0 = (pn - 12) * 256 + wc * 32 + 8 * fq;
            f32x4 bv[2][2];
#pragma unroll
            for (int bj = 0; bj < 2; ++bj)
#pragma unroll
                for (int n = 0; n < 2; ++n) bv[bj][n] = *(const f32x4*)(bgate + col0 + bj * HALF + 4 * n);
#pragma unroll
            for (int ai = 0; ai < 2; ++ai)
#pragma unroll
                for (int m = 0; m < 4; ++m) { bf16_t* rowp = Gt + (size_t)(row0 + ai * HALF + m * 16) * 2048 + col0;
#pragma unroll
                    for (int bj = 0; bj < 2; ++bj) { const f32x4 v0 = acc[ai][bj][m][0] + bv[bj][0], v1 = acc[ai][bj][m][1] + bv[bj][1];
                        u32x4 w; w.x = pk2(sigmoidf_(v0[0]), sigmoidf_(v0[1])); w.y = pk2(sigmoidf_(v0[2]), sigmoidf_(v0[3])); w.z = pk2(sigmoidf_(v1[0]), sigmoidf_(v1[1])); w.w = pk2(sigmoidf_(v1[2]), sigmoidf_(v1[3]));
                        *(u32x4*)(rowp + bj * HALF) = w; } }
        } else {
            const int col0 = (pn - 20) * 256 + wc * 32 + 8 * fq;
#pragma unroll
            for (int ai = 0; ai < 2; ++ai)
#pragma unroll
                for (int m = 0; m < 4; ++m) { float* rowp = CQ + (size_t)(row0 + ai * HALF + m * 16) * 768 + col0;
#pragma unroll
                    for (int bj = 0; bj < 2; ++bj) { *(f32x4*)(rowp + bj * HALF) = acc[ai][bj][m][0]; *(f32x4*)(rowp + bj * HALF + 4) = acc[ai][bj][m][1]; } }
        }
    }
};
struct EpiRopeQ {
    static constexpr bool PERM = false, AFTER_DRAIN = false;
    bf16_t* O; const float* rope; float qscale;
    __device__ __forceinline__ void operator()(const Acc& acc, const Unit& u, int wr, int wc, int fr, int fq) const {
        const int row0 = u.pm * BM + wr * 64 + fr;
#pragma unroll
        for (int ai = 0; ai < 2; ++ai)
#pragma unroll
            for (int m = 0; m < 4; ++m) { const int row = row0 + ai * HALF + m * 16;
                const f32x4 cs0 = *(const f32x4*)(rope + (size_t)row * 32 + fq * 8), cs1 = *(const f32x4*)(rope + (size_t)row * 32 + fq * 8 + 4);
                const f32x4 cc = {cs0[0], cs0[2], cs1[0], cs1[2]}, ss = {cs0[1], cs0[3], cs1[1], cs1[3]};
#pragma unroll
                for (int bj = 0; bj < 2; ++bj) { const int colg = u.pn * BM + bj * HALF + wc * 32; const bool isr = ((colg >> 5) % 3) == 2;
                    const f32x4 x1 = acc[ai][bj][m][0], x2 = acc[ai][bj][m][1];
                    f32x4 o1 = x1, o2 = x2; if (isr) { o1 = x1 * cc - x2 * ss; o2 = x1 * ss + x2 * cc; }
                    o1 = o1 * qscale; o2 = o2 * qscale;
                    bf16_t* p = O + (size_t)row * 768 + colg + 4 * fq;
                    u32x2 w1; w1.x = pk2(o1[0], o1[1]); w1.y = pk2(o1[2], o1[3]); u32x2 w2; w2.x = pk2(o2[0], o2[1]); w2.y = pk2(o2[2], o2[3]);
                    *(u32x2*)p = w1; *(u32x2*)(p + 16) = w2; } }
    }
};
struct EpiBf16 {
    static constexpr bool PERM = true, AFTER_DRAIN = false;
    bf16_t* O; int ldc; float osc;
    __device__ __forceinline__ void operator()(const Acc& acc, const Unit& u, int wr, int wc, int fr, int fq) const {
        const int row0 = u.pm * BM + wr * 64 + fr, col0 = u.pn * BM + wc * 32 + 8 * fq;
#pragma unroll
        for (int ai = 0; ai < 2; ++ai)
#pragma unroll
            for (int m = 0; m < 4; ++m) { bf16_t* rowp = O + (size_t)(row0 + ai * HALF + m * 16) * ldc + col0;
#pragma unroll
                for (int bj = 0; bj < 2; ++bj) { const f32x4 v0 = acc[ai][bj][m][0] * osc, v1 = acc[ai][bj][m][1] * osc;
                    u32x4 w; w.x = pk2(v0[0], v0[1]); w.y = pk2(v0[2], v0[3]); w.z = pk2(v1[0], v1[1]); w.w = pk2(v1[2], v1[3]);
                    *(u32x4*)(rowp + bj * HALF) = w; } }
    }
};
template <bool ADD> struct EpiGate {
    static constexpr bool PERM = true, AFTER_DRAIN = false;
    bf16_t* O; const bf16_t* Gt; const bf16_t* MT; int goff;
    __device__ __forceinline__ void operator()(const Acc& acc, const Unit& u, int wr, int wc, int fr, int fq) const {
        const int row0 = u.pm * BM + wr * 64 + fr, col0 = u.pn * BM + wc * 32 + 8 * fq;
#pragma unroll
        for (int ai = 0; ai < 2; ++ai)
#pragma unroll
            for (int m = 0; m < 4; ++m) { const size_t row = (size_t)(row0 + ai * HALF + m * 16);
#pragma unroll
                for (int bj = 0; bj < 2; ++bj) { const int col = col0 + bj * HALF;
                    const u32x4 gv = *(const u32x4*)(Gt + row * 2048 + goff + col);
                    f32x4 v0 = acc[ai][bj][m][0], v1 = acc[ai][bj][m][1];
                    v0[0] *= bflo(gv.x); v0[1] *= bfhi(gv.x); v0[2] *= bflo(gv.y); v0[3] *= bfhi(gv.y); v1[0] *= bflo(gv.z); v1[1] *= bfhi(gv.z); v1[2] *= bflo(gv.w); v1[3] *= bfhi(gv.w);
                    if (ADD) { const u32x4 mv = *(const u32x4*)(MT + row * 1024 + col);
                        v0[0] += bflo(mv.x); v0[1] += bfhi(mv.x); v0[2] += bflo(mv.y); v0[3] += bfhi(mv.y); v1[0] += bflo(mv.z); v1[1] += bfhi(mv.z); v1[2] += bflo(mv.w); v1[3] += bfhi(mv.w); }
                    u32x4 w; w.x = pk2(v0[0], v0[1]); w.y = pk2(v0[2], v0[3]); w.z = pk2(v1[0], v1[1]); w.w = pk2(v1[2], v1[3]);
                    *(u32x4*)(O + row * 1024 + col) = w; } }
    }
};
template <int MODE> struct EpiF32 {
    static constexpr bool PERM = false, AFTER_DRAIN = false;
    float* P; const float* X; float alpha;
    __device__ __forceinline__ void operator()(const Acc& acc, const Unit& u, int wr, int wc, int fr, int fq) const {
        const int row0 = u.pm * BM + wr * 64 + fr, col0 = u.pn * BM + wc * 32 + 4 * fq;
#pragma unroll
        for (int ai = 0; ai < 2; ++ai)
#pragma unroll
            for (int m = 0; m < 4; ++m) { const size_t off = (size_t)(row0 + ai * HALF + m * 16) * 1024 + col0;
#pragma unroll
                for (int bj = 0; bj < 2; ++bj)
#pragma unroll
                    for (int n = 0; n < 2; ++n) { const size_t o = off + bj * HALF + n * 16; const f32x4 a = acc[ai][bj][m][n]; f32x4 r;
                        if (MODE == 0) r = a;
                        else if (MODE == 1) r = *(const f32x4*)(X + o) * alpha + a;
                        else if (MODE == 2) { const f32x4 pv = *(const f32x4*)(P + o); const f32x4 xv = *(const f32x4*)(X + o);
                            r[0] = xv[0] * alpha + sigmoidf_(a[0]) * pv[0]; r[1] = xv[1] * alpha + sigmoidf_(a[1]) * pv[1]; r[2] = xv[2] * alpha + sigmoidf_(a[2]) * pv[2]; r[3] = xv[3] * alpha + sigmoidf_(a[3]) * pv[3]; }
                        else r = *(const f32x4*)(P + o) + a;
                        *(f32x4*)(P + o) = r; } }
    }
};
struct EpiSwiGLU {
    static constexpr bool PERM = true, AFTER_DRAIN = false;
    bf16_t* H; int ldc;
    __device__ __forceinline__ void operator()(const Acc& acc, const Unit& u, int wr, int wc, int fr, int fq) const {
        const int row0 = u.pm * BM + wr * 64 + fr, col0 = (u.pn * BM + wc * 32 + 8 * fq) >> 1;
#pragma unroll
        for (int ai = 0; ai < 2; ++ai)
#pragma unroll
            for (int m = 0; m < 4; ++m) { bf16_t* rowp = H + (size_t)(row0 + ai * HALF + m * 16) * ldc + col0;
#pragma unroll
                for (int bj = 0; bj < 2; ++bj) { const f32x4 v0 = acc[ai][bj][m][0], v1 = acc[ai][bj][m][1];
                    const float h0 = v0[0] * sigmoidf_(v0[0]) * v0[1], h1 = v0[2] * sigmoidf_(v0[2]) * v0[3], h2 = v1[0] * sigmoidf_(v1[0]) * v1[1], h3 = v1[2] * sigmoidf_(v1[2]) * v1[3];
                    u32x2 w; w.x = pk2(h0, h1); w.y = pk2(h2, h3);
                    *(u32x2*)(rowp + bj * (HALF / 2)) = w; } }
    }
};

struct EpiSwiGLU8 {
    static constexpr bool PERM = true, AFTER_DRAIN = false;
    unsigned char* H; int ldc; float isc;
    __device__ __forceinline__ void operator()(const Acc& acc, const Unit& u, int wr, int wc, int fr, int fq) const {
        const int row0 = u.pm * BM + wr * 64 + fr, col0 = (u.pn * BM + wc * 32 + 8 * fq) >> 1;
#pragma unroll
        for (int ai = 0; ai < 2; ++ai)
#pragma unroll
            for (int m = 0; m < 4; ++m) { unsigned char* rowp = H + (size_t)(row0 + ai * HALF + m * 16) * ldc + col0;
#pragma unroll
                for (int bj = 0; bj < 2; ++bj) { const f32x4 v0 = acc[ai][bj][m][0] * isc, v1 = acc[ai][bj][m][1] * isc;
                    const float h0 = v0[0] * sigmoidf_(v0[0]) * v0[1], h1 = v0[2] * sigmoidf_(v0[2]) * v0[3], h2 = v1[0] * sigmoidf_(v1[0]) * v1[1], h3 = v1[2] * sigmoidf_(v1[2]) * v1[3];
                    int w = __builtin_amdgcn_cvt_pk_fp8_f32(h0, h1, 0, false); w = __builtin_amdgcn_cvt_pk_fp8_f32(h2, h3, w, true);
                    *(int*)(rowp + bj * (HALF / 2)) = w; } }
    }
};

template <class Epi, class Sched, bool ALIGN_EPI = false, bool SP2 = false>
__device__ __forceinline__ void gemm_phase(PG8_LAS unsigned char* lds, const Gemm g, const Sched& S, const Epi& E, const int tid_in) {
    int tid_ = tid_in; asm volatile("" : "+v"(tid_));
    const int tid = tid_, wid = __builtin_amdgcn_readfirstlane(tid >> 6), lane = tid & 63, wr = wid >> 2, wc = wid & 3, fr = lane & 15, fq = lane >> 4;
    int K_ = g.K; asm volatile("" : "+s"(K_)); const int K = K_, nt = K / BK;
    unsigned voffA[2], voffB[2];
#pragma unroll
    for (int i = 0; i < 2; ++i) { int R, C; stage_rc(tid * 16 + i * 8192, R, C); const int Rb = Epi::PERM ? ((R & ~31) + perm32(R & 31)) : R;
        voffA[i] = (unsigned)(R * K + C) * 2u; voffB[i] = (unsigned)(Rb * K + C) * 2u; }
    const size_t kstep = (size_t)(BK * 2);
    const size_t hstep = (size_t)HALF * K * 2;
    const size_t tstep = 2 * hstep;
    const unsigned ldsw = (unsigned)wid * 1024u;
    const int aoff = lds_byte(wr * 64 + fr, fq * 8), boff = lds_byte(wc * 32 + fr, fq * 8);
#define PG8_SA(b, h) (((b) * 2 + (h)) * HTB)
#define PG8_SB(b, h) ((4 + (b) * 2 + (h)) * HTB)
#define PG8_STAGE(bufoff, gbase, voff) do { _Pragma("unroll") for (int _i = 0; _i < 2; ++_i) \
        __builtin_amdgcn_global_load_lds((const unsigned*)((const char*)(gbase) + (voff)[_i]), (PG8_LAS unsigned*)(lds + (bufoff) + ldsw + _i * 8192), 16, 0, 0); } while (0)
#define PG8_LDA(dst, b, h) do { _Pragma("unroll") for (int m = 0; m < 4; ++m) _Pragma("unroll") for (int k = 0; k < 2; ++k) dst[m][k] = *(const PG8_LAS bf16x8*)(lds + PG8_SA(b, h) + aoff + m * 2048 + k * 1024); } while (0)
#define PG8_LDB(dst, b, h) do { _Pragma("unroll") for (int n = 0; n < 2; ++n) _Pragma("unroll") for (int k = 0; k < 2; ++k) dst[n][k] = *(const PG8_LAS bf16x8*)(lds + PG8_SB(b, h) + boff + n * 2048 + k * 1024); } while (0)
#define PG8_MMA(ai, bj, At, Bt) do { __builtin_amdgcn_s_setprio(1); _Pragma("unroll") for (int m = 0; m < 4; ++m) _Pragma("unroll") for (int n = 0; n < 2; ++n) _Pragma("unroll") for (int k = 0; k < 2; ++k) \
        acc[ai][bj][m][n] = __builtin_amdgcn_mfma_f32_16x16x32_bf16(Bt[n][k], At[m][k], acc[ai][bj][m][n], 0, 0, 0); __builtin_amdgcn_s_setprio(0); } while (0)
#define PG8_WAIT_V(n) asm volatile("s_waitcnt vmcnt(" #n ")" ::: "memory")
#define PG8_WAIT_L(n) asm volatile("s_waitcnt lgkmcnt(" #n ")" ::: "memory")
#define PG8_BAR __builtin_amdgcn_s_barrier()
#define PG8_SCHED __builtin_amdgcn_sched_barrier(0)
    Unit cur, nxt; int ui = 0;
    if (!S.next(0, cur)) return;
    f32x4 acc[2][2][4][2];
#pragma unroll
    for (int a = 0; a < 2; ++a)
#pragma unroll
        for (int b = 0; b < 2; ++b)
#pragma unroll
            for (int m = 0; m < 4; ++m)
#pragma unroll
                for (int n = 0; n < 2; ++n) acc[a][b][m][n] = (f32x4){0.f, 0.f, 0.f, 0.f};
    bf16x8 At[4][2], B0[2][2], B1[2][2];
    const char* cA = (const char*)g.A + (size_t)cur.pm * tstep; const char* cB = (const char*)g.Bt + (size_t)cur.pn * tstep + S.bofs(cur);
    S.a_ready(cur);
    if constexpr (SP2) {
        PG8_STAGE(PG8_SB(0, 0), cB, voffB); PG8_STAGE(PG8_SB(0, 1), cB + hstep, voffB); PG8_STAGE(PG8_SA(0, 0), cA, voffA); PG8_STAGE(PG8_SA(0, 1), cA + hstep, voffA);
        if (wr == 1) PG8_BAR;
        PG8_WAIT_V(2); PG8_BAR;
        PG8_STAGE(PG8_SB(1, 0), cB + kstep, voffB); PG8_STAGE(PG8_SA(1, 0), cA + kstep, voffA); PG8_STAGE(PG8_SB(1, 1), cB + hstep + kstep, voffB);
        PG8_WAIT_V(6); PG8_BAR;
    } else {
        PG8_STAGE(PG8_SB(0, 0), cB, voffB); PG8_STAGE(PG8_SA(0, 0), cA, voffA); PG8_STAGE(PG8_SB(0, 1), cB + hstep, voffB); PG8_STAGE(PG8_SA(0, 1), cA + hstep, voffA);
        if (wr == 1) PG8_BAR;
        PG8_WAIT_V(4); PG8_BAR;
        PG8_STAGE(PG8_SB(1, 0), cB + kstep, voffB); PG8_STAGE(PG8_SA(1, 0), cA + kstep, voffA); PG8_STAGE(PG8_SB(1, 1), cB + hstep + kstep, voffB);
        PG8_WAIT_V(6); PG8_BAR;
    }
    for (;;) {
        const bool has_next = S.next(ui + 1, nxt);
        const char* nA = has_next ? (const char*)g.A + (size_t)nxt.pm * tstep : cA; const char* nB = has_next ? (const char*)g.Bt + (size_t)nxt.pn * tstep + S.bofs(nxt) : cB;
#pragma nounroll
        for (int t = 0; t < nt; t += 2) {
            const bool last = (t == nt - 2);
            const char* a1 = cA + (size_t)(t + 1) * kstep;
            const char* a2 = last ? nA : cA + (size_t)(t + 2) * kstep; const char* b2 = last ? nB : cB + (size_t)(t + 2) * kstep;
            const char* a3 = a2 + kstep; const char* b3 = b2 + kstep;
            if (last && has_next) S.a_ready(nxt);
            if constexpr (SP2) {
            PG8_LDB(B0, 0, 0); PG8_LDB(B1, 0, 1); PG8_SCHED; PG8_LDA(At, 0, 0); PG8_STAGE(PG8_SA(1, 1), a1 + hstep, voffA);
            PG8_WAIT_V(8); PG8_WAIT_L(0); PG8_BAR; PG8_MMA(0, 0, At, B0); PG8_MMA(0, 1, At, B1); PG8_BAR; PG8_SCHED;
            PG8_LDA(At, 0, 1); PG8_STAGE(PG8_SB(0, 0), b2, voffB); PG8_STAGE(PG8_SB(0, 1), b2 + hstep, voffB); PG8_STAGE(PG8_SA(0, 0), a2, voffA);
            PG8_WAIT_V(8); PG8_WAIT_L(0); PG8_BAR; PG8_MMA(1, 0, At, B0); PG8_MMA(1, 1, At, B1); PG8_BAR; PG8_SCHED;
            PG8_LDB(B0, 1, 0); PG8_LDB(B1, 1, 1); PG8_SCHED; PG8_LDA(At, 1, 0); PG8_STAGE(PG8_SA(0, 1), a2 + hstep, voffA);
            PG8_WAIT_V(8); PG8_WAIT_L(0); PG8_BAR; PG8_MMA(0, 0, At, B0); PG8_MMA(0, 1, At, B1); PG8_BAR; PG8_SCHED;
            PG8_LDA(At, 1, 1); PG8_STAGE(PG8_SB(1, 0), b3, voffB); PG8_STAGE(PG8_SB(1, 1), b3 + hstep, voffB); PG8_STAGE(PG8_SA(1, 0), a3, voffA);
            PG8_WAIT_V(8); PG8_WAIT_L(0); PG8_BAR; PG8_MMA(1, 0, At, B0); PG8_MMA(1, 1, At, B1); PG8_BAR; PG8_SCHED;
            } else {
            PG8_LDB(B0, 0, 0); PG8_SCHED; PG8_LDA(At, 0, 0); PG8_STAGE(PG8_SA(1, 1), a1 + hstep, voffA);
            PG8_WAIT_L(8); PG8_BAR; PG8_WAIT_L(0); PG8_MMA(0, 0, At, B0); PG8_BAR; PG8_SCHED;
            PG8_LDB(B1, 0, 1); PG8_STAGE(PG8_SB(0, 0), b2, voffB);
            PG8_BAR; PG8_WAIT_L(0); PG8_MMA(0, 1, At, B1); PG8_BAR;
            PG8_LDA(At, 0, 1); PG8_STAGE(PG8_SA(0, 0), a2, voffA);
            PG8_BAR; PG8_WAIT_L(0); PG8_MMA(1, 0, At, B0); PG8_BAR; PG8_SCHED;
            PG8_STAGE(PG8_SB(0, 1), b2 + hstep, voffB);
            PG8_WAIT_V(6); PG8_BAR; PG8_MMA(1, 1, At, B1); PG8_BAR;
            PG8_LDB(B0, 1, 0); PG8_SCHED; PG8_LDA(At, 1, 0); PG8_STAGE(PG8_SA(0, 1), a2 + hstep, voffA);
            PG8_WAIT_L(8); PG8_BAR; PG8_WAIT_L(0); PG8_MMA(0, 0, At, B0); PG8_BAR; PG8_SCHED;
            PG8_LDB(B1, 1, 1); PG8_STAGE(PG8_SB(1, 0), b3, voffB);
            PG8_BAR; PG8_WAIT_L(0); PG8_MMA(0, 1, At, B1); PG8_BAR;
            PG8_LDA(At, 1, 1); PG8_STAGE(PG8_SA(1, 0), a3, voffA);
            PG8_BAR; PG8_WAIT_L(0); PG8_MMA(1, 0, At, B0); PG8_BAR; PG8_SCHED;
            PG8_STAGE(PG8_SB(1, 1), b3 + hstep, voffB);
            PG8_WAIT_V(6); PG8_BAR; PG8_MMA(1, 1, At, B1); PG8_BAR;
            }
        }
        if constexpr (ALIGN_EPI) { if (wr == 0) PG8_BAR; }
        if constexpr (!Epi::AFTER_DRAIN) { E(acc, cur, wr, wc, fr, fq); S.done(cur); }
        if (!has_next) break;
#pragma unroll
        for (int a = 0; a < 2; ++a)
#pragma unroll
            for (int b = 0; b < 2; ++b)
#pragma unroll
                for (int m = 0; m < 4; ++m)
#pragma unroll
                    for (int n = 0; n < 2; ++n) acc[a][b][m][n] = (f32x4){0.f, 0.f, 0.f, 0.f};
        cur = nxt; cA = nA; cB = nB; ++ui;
        if constexpr (ALIGN_EPI) { if (wr == 1) PG8_BAR; }
    }
    PG8_WAIT_V(0);
    if constexpr (!ALIGN_EPI) { if (wr == 0) PG8_BAR; }
    PG8_BAR;
    if constexpr (Epi::AFTER_DRAIN) { E.fused(acc, cur, wr, wc, fr, fq, lds, wid, lane); S.done(cur); }
#undef PG8_SA
#undef PG8_SB
#undef PG8_STAGE
#undef PG8_LDA
#undef PG8_LDB
#undef PG8_MMA
#undef PG8_WAIT_V
#undef PG8_WAIT_L
#undef PG8_BAR
#undef PG8_SCHED
}
typedef int i32x4_ __attribute__((ext_vector_type(4)));
typedef int i32x8_ __attribute__((ext_vector_type(8)));
template <class Epi, class Sched, bool ALIGN_EPI = false, bool SP2 = false>
__device__ __forceinline__ void gemm_phase8(PG8_LAS unsigned char* lds, const Gemm g, const Sched& S, const Epi& E, const int sc1, const int tid_in) {
    int tid_ = tid_in; asm volatile("" : "+v"(tid_));
    const int tid = tid_, wid = __builtin_amdgcn_readfirstlane(tid >> 6), lane = tid & 63, wr = wid >> 2, wc = wid & 3, fr = lane & 15, fq = lane >> 4;
    int K_ = g.K; asm volatile("" : "+s"(K_)); const int K = K_, nt = K / BK;
    unsigned voffA[2], voffB[2];
#pragma unroll
    for (int i = 0; i < 2; ++i) { int R, C; stage_rc(tid * 16 + i * 8192, R, C); const int Rb = Epi::PERM ? ((R & ~31) + perm32(R & 31)) : R;
        voffA[i] = (unsigned)(R * K + C) * 2u; voffB[i] = (unsigned)(Rb * K + C) * 2u; }
    const size_t kstep = (size_t)(BK * 2);
    const size_t hstep = (size_t)HALF * K * 2;
    const size_t tstep = 2 * hstep;
    const unsigned ldsw = (unsigned)wid * 1024u;
    const int cq8 = (fq >> 1) * 32 + 16 * (fq & 1);
    const int aoff = lds_byte(wr * 64 + fr, cq8), boff = lds_byte(wc * 32 + fr, cq8);
#define PG8_SA(b, h) (((b) * 2 + (h)) * HTB)
#define PG8_SB(b, h) ((4 + (b) * 2 + (h)) * HTB)
#define PG8_STAGE(bufoff, gbase, voff) do { _Pragma("unroll") for (int _i = 0; _i < 2; ++_i) \
        __builtin_amdgcn_global_load_lds((const unsigned*)((const char*)(gbase) + (voff)[_i]), (PG8_LAS unsigned*)(lds + (bufoff) + ldsw + _i * 8192), 16, 0, 0); } while (0)
#define PG8_LD16(off) (*(const PG8_LAS i32x4_*)(lds + (off)))
#define PG8_LDA(dst, b, h) do { _Pragma("unroll") for (int m = 0; m < 4; ++m) dst[m] = __builtin_shufflevector(PG8_LD16(PG8_SA(b, h) + aoff + m * 2048), PG8_LD16(PG8_SA(b, h) + aoff + m * 2048 + 16), 0, 1, 2, 3, 4, 5, 6, 7); } while (0)
#define PG8_LDB(dst, b, h) do { _Pragma("unroll") for (int n = 0; n < 2; ++n) dst[n] = __builtin_shufflevector(PG8_LD16(PG8_SB(b, h) + boff + n * 2048), PG8_LD16(PG8_SB(b, h) + boff + n * 2048 + 16), 0, 1, 2, 3, 4, 5, 6, 7); } while (0)
#define PG8_MMA(ai, bj, At, Bt) do { __builtin_amdgcn_s_setprio(1); _Pragma("unroll") for (int m = 0; m < 4; ++m) _Pragma("unroll") for (int n = 0; n < 2; ++n) \
        asm volatile("v_mfma_scale_f32_16x16x128_f8f6f4 %0, %1, %2, %0, %3, %3 op_sel_hi:[0,0,0]" : "+v"(acc[ai][bj][m][n]) : "v"(Bt[n]), "v"(At[m]), "v"(sc1)); __builtin_amdgcn_s_setprio(0); } while (0)
#define PG8_WAIT_V(n) asm volatile("s_waitcnt vmcnt(" #n ")" ::: "memory")
#define PG8_WAIT_L(n) asm volatile("s_waitcnt lgkmcnt(" #n ")" ::: "memory")
#define PG8_BAR __builtin_amdgcn_s_barrier()
#define PG8_SCHED __builtin_amdgcn_sched_barrier(0)
    Unit cur, nxt; int ui = 0;
    if (!S.next(0, cur)) return;
    f32x4 acc[2][2][4][2];
#pragma unroll
    for (int a = 0; a < 2; ++a)
#pragma unroll
        for (int b = 0; b < 2; ++b)
#pragma unroll
            for (int m = 0; m < 4; ++m)
#pragma unroll
                for (int n = 0; n < 2; ++n) acc[a][b][m][n] = (f32x4){0.f, 0.f, 0.f, 0.f};
    i32x8_ At[4], B0[2], B1[2];
    const char* cA = (const char*)g.A + (size_t)cur.pm * tstep; const char* cB = (const char*)g.Bt + (size_t)cur.pn * tstep + S.bofs(cur);
    S.a_ready(cur);
    if constexpr (SP2) {
        PG8_STAGE(PG8_SB(0, 0), cB, voffB); PG8_STAGE(PG8_SB(0, 1), cB + hstep, voffB); PG8_STAGE(PG8_SA(0, 0), cA, voffA); PG8_STAGE(PG8_SA(0, 1), cA + hstep, voffA);
        if (wr == 1) PG8_BAR;
        PG8_WAIT_V(2); PG8_BAR;
        PG8_STAGE(PG8_SB(1, 0), cB + kstep, voffB); PG8_STAGE(PG8_SA(1, 0), cA + kstep, voffA); PG8_STAGE(PG8_SB(1, 1), cB + hstep + kstep, voffB);
        PG8_WAIT_V(6); PG8_BAR;
    } else {
        PG8_STAGE(PG8_SB(0, 0), cB, voffB); PG8_STAGE(PG8_SA(0, 0), cA, voffA); PG8_STAGE(PG8_SB(0, 1), cB + hstep, voffB); PG8_STAGE(PG8_SA(0, 1), cA + hstep, voffA);
        if (wr == 1) PG8_BAR;
        PG8_WAIT_V(4); PG8_BAR;
        PG8_STAGE(PG8_SB(1, 0), cB + kstep, voffB); PG8_STAGE(PG8_SA(1, 0), cA + kstep, voffA); PG8_STAGE(PG8_SB(1, 1), cB + hstep + kstep, voffB);
        PG8_WAIT_V(6); PG8_BAR;
    }
    for (;;) {
        const bool has_next = S.next(ui + 1, nxt);
        const char* nA = has_next ? (const char*)g.A + (size_t)nxt.pm * tstep : cA; const char* nB = has_next ? (const char*)g.Bt + (size_t)nxt.pn * tstep + S.bofs(nxt) : cB;
#pragma nounroll
        for (int t = 0; t < nt; t += 2) {
            const bool last = (t == nt - 2);
            const char* a1 = cA + (size_t)(t + 1) * kstep;
            const char* a2 = last ? nA : cA + (size_t)(t + 2) * kstep; const char* b2 = last ? nB : cB + (size_t)(t + 2) * kstep;
            const char* a3 = a2 + kstep; const char* b3 = b2 + kstep;
            if (last && has_next) S.a_ready(nxt);
            if constexpr (SP2) {
            PG8_LDB(B0, 0, 0); PG8_LDB(B1, 0, 1); PG8_SCHED; PG8_LDA(At, 0, 0); PG8_STAGE(PG8_SA(1, 1), a1 + hstep, voffA);
            PG8_WAIT_V(8); PG8_WAIT_L(0); PG8_BAR; PG8_MMA(0, 0, At, B0); PG8_MMA(0, 1, At, B1); PG8_BAR; PG8_SCHED;
            PG8_LDA(At, 0, 1); PG8_STAGE(PG8_SB(0, 0), b2, voffB); PG8_STAGE(PG8_SB(0, 1), b2 + hstep, voffB); PG8_STAGE(PG8_SA(0, 0), a2, voffA);
            PG8_WAIT_V(8); PG8_WAIT_L(0); PG8_BAR; PG8_MMA(1, 0, At, B0); PG8_MMA(1, 1, At, B1); PG8_BAR; PG8_SCHED;
            PG8_LDB(B0, 1, 0); PG8_LDB(B1, 1, 1); PG8_SCHED; PG8_LDA(At, 1, 0); PG8_STAGE(PG8_SA(0, 1), a2 + hstep, voffA);
            PG8_WAIT_V(8); PG8_WAIT_L(0); PG8_BAR; PG8_MMA(0, 0, At, B0); PG8_MMA(0, 1, At, B1); PG8_BAR; PG8_SCHED;
            PG8_LDA(At, 1, 1); PG8_STAGE(PG8_SB(1, 0), b3, voffB); PG8_STAGE(PG8_SB(1, 1), b3 + hstep, voffB); PG8_STAGE(PG8_SA(1, 0), a3, voffA);
            PG8_WAIT_V(8); PG8_WAIT_L(0); PG8_BAR; PG8_MMA(1, 0, At, B0); PG8_MMA(1, 1, At, B1); PG8_BAR; PG8_SCHED;
            } else {
            PG8_LDB(B0, 0, 0); PG8_SCHED; PG8_LDA(At, 0, 0); PG8_STAGE(PG8_SA(1, 1), a1 + hstep, voffA);
            PG8_WAIT_L(8); PG8_BAR; PG8_WAIT_L(0); PG8_MMA(0, 0, At, B0); PG8_BAR; PG8_SCHED;
            PG8_LDB(B1, 0, 1); PG8_STAGE(PG8_SB(0, 0), b2, voffB);
            PG8_BAR; PG8_WAIT_L(0); PG8_MMA(0, 1, At, B1); PG8_BAR;
            PG8_LDA(At, 0, 1); PG8_STAGE(PG8_SA(0, 0), a2, voffA);
            PG8_BAR; PG8_WAIT_L(0); PG8_MMA(1, 0, At, B0); PG8_BAR; PG8_SCHED;
            PG8_STAGE(PG8_SB(0, 1), b2 + hstep, voffB);
            PG8_WAIT_V(6); PG8_BAR; PG8_MMA(1, 1, At, B1); PG8_BAR;
            PG8_LDB(B0, 1, 0); PG8_SCHED; PG8_LDA(At, 1, 0); PG8_STAGE(PG8_SA(0, 1), a2 + hstep, voffA);
            PG8_WAIT_L(8); PG8_BAR; PG8_WAIT_L(0); PG8_MMA(0, 0, At, B0); PG8_BAR; PG8_SCHED;
            PG8_LDB(B1, 1, 1); PG8_STAGE(PG8_SB(1, 0), b3, voffB);
            PG8_BAR; PG8_WAIT_L(0); PG8_MMA(0, 1, At, B1); PG8_BAR;
            PG8_LDA(At, 1, 1); PG8_STAGE(PG8_SA(1, 0), a3, voffA);
            PG8_BAR; PG8_WAIT_L(0); PG8_MMA(1, 0, At, B0); PG8_BAR; PG8_SCHED;
            PG8_STAGE(PG8_SB(1, 1), b3 + hstep, voffB);
            PG8_WAIT_V(6); PG8_BAR; PG8_MMA(1, 1, At, B1); PG8_BAR;
            }
        }
        if constexpr (ALIGN_EPI) { if (wr == 0) PG8_BAR; }
        asm volatile("s_nop 15\n\ts_nop 15" ::: "memory");
        if constexpr (!Epi::AFTER_DRAIN) { E(acc, cur, wr, wc, fr, fq); S.done(cur); }
        if (!has_next) break;
#pragma unroll
        for (int a = 0; a < 2; ++a)
#pragma unroll
            for (int b = 0; b < 2; ++b)
#pragma unroll
                for (int m = 0; m < 4; ++m)
#pragma unroll
                    for (int n = 0; n < 2; ++n) acc[a][b][m][n] = (f32x4){0.f, 0.f, 0.f, 0.f};
        cur = nxt; cA = nA; cB = nB; ++ui;
        if constexpr (ALIGN_EPI) { if (wr == 1) PG8_BAR; }
    }
    PG8_WAIT_V(0);
    if constexpr (!ALIGN_EPI) { if (wr == 0) PG8_BAR; }
    PG8_BAR;
    if constexpr (Epi::AFTER_DRAIN) { E.fused(acc, cur, wr, wc, fr, fq, lds, wid, lane); S.done(cur); }
#undef PG8_SA
#undef PG8_SB
#undef PG8_STAGE
#undef PG8_LDA
#undef PG8_LD16
#undef PG8_LDB
#undef PG8_MMA
#undef PG8_WAIT_V
#undef PG8_WAIT_L
#undef PG8_BAR
#undef PG8_SCHED
}
}

namespace att {
#ifndef ATT2_PINGPONG
#define ATT2_PINGPONG 1
#endif
#ifndef ATT_PRIO
#define ATT_PRIO 0
#endif
#if ATT_PRIO
#define ATT_SETPRIO(x) __builtin_amdgcn_s_setprio(x)
#else
#define ATT_SETPRIO(x) do {} while (0)
#endif
#define MFMA32(a, b, c) __builtin_amdgcn_mfma_f32_32x32x16_bf16((a), (b), (c), 0, 0, 0)
typedef short v4i16_t __attribute__((ext_vector_type(4)));
struct AttnP {
    const bf16* Q; int ldq;
    const bf16* K1; int ldk1;
    const bf16* K2; int ldk2;
    const bf16* V; int ldv;
    bf16* O; int ldo;
    const int* pos;
    const int* blkmax;
    const float* lut;
};
__device__ __forceinline__ s16x4 vtr(const LAS unsigned char* p) { return __builtin_bit_cast(s16x4, __builtin_amdgcn_ds_read_tr16_b64_v4i16((LAS v4i16_t*)p)); }

template <int DQK, int KSPLIT, int DV, bool BIAS>
__device__ __forceinline__ void attn_unit(const AttnP& P, int b, int qt, int qcol, int kcol, int vcol, int ocol, int hb, LAS unsigned char* lds, const int tid_in) {
    constexpr int KROWB = DQK * 2 + 16;
    constexpr int VROWB = (DV == 128) ? 320 : 192;
    constexpr int KBYTES = 64 * KROWB, VBYTES = 64 * VROWB, STAGE = KBYTES + VBYTES + 256, LUT_OFF = 2 * STAGE;
    constexpr int ND = DQK / 16, NDB = DV / 32, KCH = DQK / 8, VCH = DV / 8, NKC = 64 * KCH, NVC = 64 * VCH, KL = (NKC + 511) / 512, VL = (NVC + 511) / 512;
    int tid_ = tid_in; asm volatile("" : "+v"(tid_));
    const int tid = tid_, lane = tid & 63, wid = __builtin_amdgcn_readfirstlane(tid >> 6), r = lane & 31, h = lane >> 5;
    const long tok0 = (long)b * SEQ; const int q0 = qt * 256; const int qrow = q0 + wid * 32 + r;
    bf16x8 qf[ND];
    { const bf16* qp = P.Q + (tok0 + qrow) * (long)P.ldq + qcol + 8 * h;
#pragma unroll
      for (int d = 0; d < ND; ++d) qf[d] = *(const bf16x8*)(qp + 16 * d); }
    int posq = 0, posq_min = 0;
    LAS float* lut = (LAS float*)(lds + LUT_OFF);
    if (BIAS) { posq = P.pos[tok0 + qrow]; int mn = posq;
#pragma unroll
        for (int o = 1; o < 64; o <<= 1) { const int t2 = shxi(mn, o, lane); mn = t2 < mn ? t2 : mn; }
        posq_min = mn;
        if (tid < 132) lut[tid] = P.lut[hb * 132 + tid]; }
    v4u kreg[KL], vreg[VL]; int preg = 0;
#define ATT_ISSUE(t) do { const long trow = tok0 + 64 * (long)(t); \
        _Pragma("unroll") for (int i = 0; i < KL; ++i) { const int c = tid + 512 * i; if (NKC % 512 == 0 || c < NKC) { const int row = c / KCH, col = (c % KCH) * 8; \
            const bf16* src = (col < KSPLIT) ? P.K1 + (trow + row) * (long)P.ldk1 + kcol + col : P.K2 + (trow + row) * (long)P.ldk2 + (col - KSPLIT); kreg[i] = *(const v4u*)src; } } \
        _Pragma("unroll") for (int i = 0; i < VL; ++i) { const int c = tid + 512 * i; if (NVC % 512 == 0 || c < NVC) { const int row = c / VCH, col = (c % VCH) * 8; vreg[i] = *(const v4u*)(P.V + (trow + row) * (long)P.ldv + vcol + col); } } \
        if (BIAS && tid < 64) preg = P.pos[trow + tid]; } while (0)
#define ATT_WRITE(t) do { LAS unsigned char* sb = lds + ((t) & 1) * STAGE; \
        _Pragma("unroll") for (int i = 0; i < KL; ++i) { const int c = tid + 512 * i; if (NKC % 512 == 0 || c < NKC) { const int row = c / KCH, cc = c % KCH; *(LAS v4u*)(sb + row * KROWB + cc * 16) = kreg[i]; } } \
        _Pragma("unroll") for (int i = 0; i < VL; ++i) { const int c = tid + 512 * i; if (NVC % 512 == 0 || c < NVC) { const int row = c / VCH, cc = c % VCH; *(LAS v4u*)(sb + KBYTES + row * VROWB + cc * 16) = vreg[i]; } } \
        if (BIAS && tid < 64) *(LAS int*)(sb + KBYTES + VBYTES + 4 * tid) = preg; } while (0)
    f32x16 o[NDB];
#pragma unroll
    for (int i = 0; i < NDB; ++i)
#pragma unroll
        for (int j = 0; j < 16; ++j) o[i][j] = 0.f;
    float m_run = 0.f, l_run = 0.f;
    const int ntiles = (q0 + 256) / 64, my_last = (q0 + wid * 32 + 31) / 64;
    ATT_ISSUE(0); ATT_WRITE(0); __syncthreads();
    const int kbase = r * KROWB + 16 * h;
    const int vbase = KBYTES + (4 * h + ((lane & 15) >> 2)) * VROWB + (((lane >> 4) & 1) * 16 + (lane & 3) * 4) * 2;
    for (int t = 0; t < ntiles; ++t) {
        const bool more = (t + 1 < ntiles);
        if (more) ATT_ISSUE(t + 1);
        if (t <= my_last) {
            const LAS unsigned char* sb = lds + (t & 1) * STAGE;
            bool plain = (64 * t + 63 <= q0 + wid * 32);
            float cinit = -m_run;
            if (BIAS) { const int kmax = P.blkmax[(int)(tok0 >> 6) + t]; if (plain && (posq_min - kmax >= 113)) cinit += lut[128]; else plain = false; }
            f32x16 x0, x1;
#pragma unroll
            for (int j = 0; j < 16; ++j) { x0[j] = cinit; x1[j] = cinit; }
            ATT_SETPRIO(1);
            { bf16x8 kf0[ND], kf1[ND];
#pragma unroll
              for (int d = 0; d < ND; ++d) { kf0[d] = *(const LAS bf16x8*)(sb + kbase + d * 32); kf1[d] = *(const LAS bf16x8*)(sb + kbase + 32 * KROWB + d * 32); }
              __builtin_amdgcn_sched_barrier(0);
#pragma unroll
              for (int d = 0; d < ND; ++d) { x0 = MFMA32(kf0[d], qf[d], x0); x1 = MFMA32(kf1[d], qf[d], x1); } }
            ATT_SETPRIO(0);
            if (!plain) {
#pragma unroll
                for (int g = 0; g < 4; ++g) {
                    int pk0[4] = {0, 0, 0, 0}, pk1[4] = {0, 0, 0, 0};
                    if (BIAS) { const LAS int* pp = (const LAS int*)(sb + KBYTES + VBYTES) + 8 * g + 4 * h;
                        const v4u a = *(const LAS v4u*)pp, c = *(const LAS v4u*)(pp + 32);
                        pk0[0] = a.x; pk0[1] = a.y; pk0[2] = a.z; pk0[3] = a.w; pk1[0] = c.x; pk1[1] = c.y; pk1[2] = c.z; pk1[3] = c.w; }
#pragma unroll
                    for (int j = 0; j < 4; ++j) { const int i = 4 * g + j; const int kidx = 64 * t + 8 * g + 4 * h + j;
                        float v0 = x0[i], v1 = x1[i];
                        if (BIAS) { int n0 = posq - pk0[j]; n0 = n0 < 0 ? 0 : (n0 > 128 ? 128 : n0); int n1 = posq - pk1[j]; n1 = n1 < 0 ? 0 : (n1 > 128 ? 128 : n1); v0 += lut[n0]; v1 += lut[n1]; }
                        if (kidx > qrow) v0 = -INFINITY; if (kidx + 32 > qrow) v1 = -INFINITY;
                        x0[i] = v0; x1[i] = v1; }
                }
            }
            float ma = fmaxf(fmaxf(x0[0], x0[1]), x0[2]), mb = fmaxf(fmaxf(x1[0], x1[1]), x1[2]);
#pragma unroll
            for (int j = 3; j < 15; j += 2) { ma = fmaxf(fmaxf(ma, x0[j]), x0[j + 1]); mb = fmaxf(fmaxf(mb, x1[j]), x1[j + 1]); }
            float mx = fmaxf(fmaxf(ma, mb), fmaxf(x0[15], x1[15]));
            { const auto rr = __builtin_amdgcn_permlane32_swap(__float_as_uint(mx), __float_as_uint(mx), false, false); mx = fmaxf(__uint_as_float(rr[0]), __uint_as_float(rr[1])); }
            if (t == 0 || __any(mx > 8.0f)) {
                const float delta = (t == 0) ? mx : fmaxf(mx, 0.f);
                if (t != 0) { const float alpha = __builtin_amdgcn_exp2f(-delta); l_run *= alpha;
#pragma unroll
                    for (int i = 0; i < NDB; ++i) o[i] = o[i] * alpha; }
                m_run += delta;
#pragma unroll
                for (int j = 0; j < 16; ++j) { x0[j] -= delta; x1[j] -= delta; }
            }
            f32x2 ls2 = {0.f, 0.f};
#pragma unroll
            for (int j = 0; j < 16; j += 2) { x0[j] = __builtin_amdgcn_exp2f(x0[j]); x0[j + 1] = __builtin_amdgcn_exp2f(x0[j + 1]); x1[j] = __builtin_amdgcn_exp2f(x1[j]); x1[j + 1] = __builtin_amdgcn_exp2f(x1[j + 1]);
                ls2 += (f32x2){x0[j], x0[j + 1]}; ls2 += (f32x2){x1[j], x1[j + 1]}; }
            l_run += ls2[0] + ls2[1];
            bf16x8 pf[4];
            { v4u w;
              w.x = pk2(x0[0], x0[1]); w.y = pk2(x0[2], x0[3]); w.z = pk2(x0[4], x0[5]); w.w = pk2(x0[6], x0[7]); pf[0] = __builtin_bit_cast(bf16x8, w);
              w.x = pk2(x0[8], x0[9]); w.y = pk2(x0[10], x0[11]); w.z = pk2(x0[12], x0[13]); w.w = pk2(x0[14], x0[15]); pf[1] = __builtin_bit_cast(bf16x8, w);
              w.x = pk2(x1[0], x1[1]); w.y = pk2(x1[2], x1[3]); w.z = pk2(x1[4], x1[5]); w.w = pk2(x1[6], x1[7]); pf[2] = __builtin_bit_cast(bf16x8, w);
              w.x = pk2(x1[8], x1[9]); w.y = pk2(x1[10], x1[11]); w.z = pk2(x1[12], x1[13]); w.w = pk2(x1[14], x1[15]); pf[3] = __builtin_bit_cast(bf16x8, w); }
            ATT_SETPRIO(1);
            { s16x4 vlo[2][4], vhi[2][4];
#define ATT_VLOAD(buf, db) do { _Pragma("unroll") for (int s = 0; s < 4; ++s) { vlo[buf][s] = vtr(sb + vbase + (16 * s) * VROWB + 64 * (db)); vhi[buf][s] = vtr(sb + vbase + (16 * s + 8) * VROWB + 64 * (db)); } } while (0)
              ATT_VLOAD(0, 0);
#pragma unroll
              for (int db = 0; db < NDB; ++db) {
                  if (db + 1 < NDB) ATT_VLOAD((db + 1) & 1, db + 1);
                  __builtin_amdgcn_sched_barrier(0);
#pragma unroll
                  for (int s = 0; s < 4; ++s) { const bf16x8 vf = __builtin_shufflevector(vlo[db & 1][s], vhi[db & 1][s], 0, 1, 2, 3, 4, 5, 6, 7); o[db] = MFMA32(vf, pf[s], o[db]); }
                  __builtin_amdgcn_sched_barrier(0);
              }
#undef ATT_VLOAD
            }
            ATT_SETPRIO(0);
        }
        if (more) ATT_WRITE(t + 1);
        __syncthreads();
    }
#undef ATT_ISSUE
#undef ATT_WRITE
    const float lt = l_run + shx(l_run, 32, lane), inv = 1.0f / lt;
    bf16* op = P.O + (tok0 + qrow) * (long)P.ldo + ocol + 4 * h;
#pragma unroll
    for (int db = 0; db < NDB; ++db)
#pragma unroll
        for (int g = 0; g < 4; ++g) { v2u w; w.x = pk2(o[db][4 * g] * inv, o[db][4 * g + 1] * inv); w.y = pk2(o[db][4 * g + 2] * inv, o[db][4 * g + 3] * inv);
            *(v2u*)(op + 32 * db + 8 * g) = w; }
}

#define ATT_WAITV(n) asm volatile("s_waitcnt vmcnt(" #n ")" ::: "memory")
#define ATT_BAR() do { asm volatile("" ::: "memory"); __builtin_amdgcn_s_barrier(); asm volatile("" ::: "memory"); } while (0)
template <int DQK, int KSPLIT, int DV, bool BIAS>
__device__ __forceinline__ void attn_unit2(const AttnP& P, int b, int qt, int qcol, int kcol, int vcol, int ocol, int hb, LAS unsigned char* lds, const int tid_in) {
    constexpr int KROWB = DQK * 2, VROWB = DV * 2, KBYTES = 64 * KROWB, VBYTES = 64 * VROWB, STAGE = KBYTES + VBYTES + 256, NST = 4, LUT_OFF = NST * STAGE, BMX_OFF = LUT_OFF + 1024;
    constexpr int ND = DQK / 16, NDB = DV / 32, KCH = DQK / 8, VCH = DV / 8, NKP = KBYTES / 1024, NVP = VBYTES / 1024, KPW = (NKP + 7) / 8, VPW = (NVP + 7) / 8;
    static_assert(BMX_OFF + 256 <= 131072, "attention LDS");
    int tid_ = tid_in; asm volatile("" : "+v"(tid_));
    const int tid = tid_, lane = tid & 63, wid = __builtin_amdgcn_readfirstlane(tid >> 6), r = lane & 31, h = lane >> 5, grpB = ATT2_PINGPONG ? (wid >> 2) : 0;
    const long tok0 = (long)b * SEQ; const int q0 = qt * 256; const int qrow = q0 + wid * 32 + r;
    const bf16* ksrc[KPW]; int kinc[KPW]; const bf16* vsrc[VPW];
#pragma unroll
    for (int i = 0; i < KPW; ++i) { const int ci = 64 * (wid + 8 * i) + lane, row = (ci / KCH) & 63, cp = ci % KCH; const int c = (DQK == 64) ? (cp ^ ((row >> 1) & 7)) : (cp ^ ((row >> 2) & 3)); const int col = 8 * c;
        if (col < KSPLIT) { ksrc[i] = P.K1 + (tok0 + row) * (long)P.ldk1 + kcol + col; kinc[i] = 64 * P.ldk1; } else { ksrc[i] = P.K2 + (tok0 + row) * (long)P.ldk2 + (col - KSPLIT); kinc[i] = 64 * P.ldk2; } }
#pragma unroll
    for (int i = 0; i < VPW; ++i) { const int ci = 64 * (wid + 8 * i) + lane, row = (ci / VCH) & 63, cp = ci % VCH; const int c = (DV == 128) ? (cp ^ (4 * (row & 3))) : (cp ^ (4 * ((row >> 1) & 1)));
        vsrc[i] = P.V + (tok0 + row) * (long)P.ldv + vcol + 8 * c; }
    const int vinc = 64 * P.ldv;
    const int nops = ((KPW == 2) ? ((wid + 8 < NKP) ? 2 : 1) : 1) + ((VPW == 2) ? ((wid + 8 < NVP) ? 2 : 1) : 1) + ((BIAS && wid == 7) ? 1 : 0);
#define ATT2_ISSUE(t) do { LAS unsigned char* sb_ = lds + ((t) & 3) * STAGE; \
        _Pragma("unroll") for (int i = 0; i < KPW; ++i) if (wid + 8 * i < NKP) __builtin_amdgcn_global_load_lds((const unsigned*)(ksrc[i] + (long)(t) * kinc[i]), (LAS unsigned*)(sb_ + (wid + 8 * i) * 1024), 16, 0, 0); \
        _Pragma("unroll") for (int i = 0; i < VPW; ++i) if (wid + 8 * i < NVP) __builtin_amdgcn_global_load_lds((const unsigned*)(vsrc[i] + (long)(t) * vinc), (LAS unsigned*)(sb_ + KBYTES + (wid + 8 * i) * 1024), 16, 0, 0); \
        if (BIAS && wid == 7) { if (lane < 16) __builtin_amdgcn_global_load_lds((const unsigned*)(P.pos + tok0 + 64 * (long)(t) + 4 * lane), (LAS unsigned*)(sb_ + KBYTES + VBYTES), 16, 0, 0); } } while (0)
#define ATT2_WAIT(n) do { if ((n) == 0) ATT_WAITV(0); else if ((n) == 2) ATT_WAITV(2); else if ((n) == 3) ATT_WAITV(3); else ATT_WAITV(4); } while (0)
    ATT_BAR();
    bf16x8 qf[ND];
    { const bf16* qp = P.Q + (tok0 + qrow) * (long)P.ldq + qcol + 8 * h;
#pragma unroll
      for (int d = 0; d < ND; ++d) qf[d] = *(const bf16x8*)(qp + 16 * d); }
    int posq = 0, posq_min = 0;
    LAS float* lut = (LAS float*)(lds + LUT_OFF); LAS int* bmx = (LAS int*)(lds + BMX_OFF);
    const int ntiles = (q0 + 256) / 64, my_last = (q0 + wid * 32 + 31) / 64;
    if (BIAS) { posq = P.pos[tok0 + qrow]; int mn = posq;
#pragma unroll
        for (int o = 1; o < 64; o <<= 1) { const int t2 = shxi(mn, o, lane); mn = t2 < mn ? t2 : mn; }
        posq_min = mn;
        if (tid < 132) lut[tid] = P.lut[hb * 132 + tid];
        if (tid >= 192 && tid < 256) bmx[tid - 192] = P.blkmax[(int)(tok0 >> 6) + (tid - 192)]; }
    asm volatile("s_waitcnt vmcnt(0)" ::: "memory");
    ATT2_ISSUE(0); ATT2_ISSUE(1);
    f32x16 o[NDB];
#pragma unroll
    for (int i = 0; i < NDB; ++i)
#pragma unroll
        for (int j = 0; j < 16; ++j) o[i][j] = 0.f;
    float m_run = 0.f, l_run = 0.f;
    bf16x8 pf[4];
    int kaddr[ND], vaddr[NDB];
    { const int sw = (DQK == 64) ? ((r >> 1) & 7) : ((r >> 2) & 3);
#pragma unroll
      for (int d = 0; d < ND; ++d) kaddr[d] = r * KROWB + 16 * ((2 * d + h) ^ sw);
      const int qq = (lane & 15) >> 2, pp = lane & 3, g16 = (lane >> 4) & 1, swv = (DV == 128) ? qq : ((qq >> 1) & 1);
#pragma unroll
      for (int db = 0; db < NDB; ++db) vaddr[db] = KBYTES + (4 * h + qq) * VROWB + 64 * (db ^ swv) + 32 * g16 + 8 * pp; }
    for (int hs = 0; hs <= 2 * ntiles; ++hs) {
        const int te = hs >> 1;
        if (!(hs & 1) && te < ntiles) { if (te + 1 < ntiles) ATT2_WAIT(nops); else ATT2_WAIT(0); }
        ATT_BAR();
        if (!(hs & 1) && te + 2 < ntiles) ATT2_ISSUE(te + 2);
        const int k = hs - grpB;
        if (k < 0 || k >= 2 * ntiles) continue;
        const int t = k >> 1;
        if (t > my_last) continue;
        const LAS unsigned char* sb = lds + (t & 3) * STAGE;
        if (!(k & 1)) {
            bool plain = (64 * t + 63 <= q0 + wid * 32);
            float cinit = -m_run;
            if (BIAS) { const int kmax = bmx[t]; if (plain && (posq_min - kmax >= 113)) cinit += lut[128]; else plain = false; }
            f32x16 x0, x1;
#pragma unroll
            for (int j = 0; j < 16; ++j) { x0[j] = cinit; x1[j] = cinit; }
            { bf16x8 kf0[ND], kf1[ND];
#pragma unroll
              for (int d = 0; d < ND; ++d) { kf0[d] = *(const LAS bf16x8*)(sb + kaddr[d]); kf1[d] = *(const LAS bf16x8*)(sb + kaddr[d] + 32 * KROWB); }
              __builtin_amdgcn_sched_barrier(0);
              ATT_SETPRIO(1);
#pragma unroll
              for (int d = 0; d < ND; ++d) { x0 = MFMA32(kf0[d], qf[d], x0); x1 = MFMA32(kf1[d], qf[d], x1); }
              ATT_SETPRIO(0); }
            if (!plain) {
#pragma unroll
                for (int g = 0; g < 4; ++g) {
                    int pk0[4] = {0, 0, 0, 0}, pk1[4] = {0, 0, 0, 0};
                    if (BIAS) { const LAS int* ppq = (const LAS int*)(sb + KBYTES + VBYTES) + 8 * g + 4 * h;
                        const v4u a = *(const LAS v4u*)ppq, c = *(const LAS v4u*)(ppq + 32);
                        pk0[0] = a.x; pk0[1] = a.y; pk0[2] = a.z; pk0[3] = a.w; pk1[0] = c.x; pk1[1] = c.y; pk1[2] = c.z; pk1[3] = c.w; }
#pragma unroll
                    for (int j = 0; j < 4; ++j) { const int i = 4 * g + j; const int kidx = 64 * t + 8 * g + 4 * h + j;
                        float v0 = x0[i], v1 = x1[i];
                        if (BIAS) { int n0 = posq - pk0[j]; n0 = n0 < 0 ? 0 : (n0 > 128 ? 128 : n0); int n1 = posq - pk1[j]; n1 = n1 < 0 ? 0 : (n1 > 128 ? 128 : n1); v0 += lut[n0]; v1 += lut[n1]; }
                        if (kidx > qrow) v0 = -INFINITY; if (kidx + 32 > qrow) v1 = -INFINITY;
                        x0[i] = v0; x1[i] = v1; }
                }
            }
            float ma = fmaxf(fmaxf(x0[0], x0[1]), x0[2]), mb = fmaxf(fmaxf(x1[0], x1[1]), x1[2]);
#pragma unroll
            for (int j = 3; j < 15; j += 2) { ma = fmaxf(fmaxf(ma, x0[j]), x0[j + 1]); mb = fmaxf(fmaxf(mb, x1[j]), x1[j + 1]); }
            float mx = fmaxf(fmaxf(ma, mb), fmaxf(x0[15], x1[15]));
            { const auto rr = __builtin_amdgcn_permlane32_swap(__float_as_uint(mx), __float_as_uint(mx), false, false); mx = fmaxf(__uint_as_float(rr[0]), __uint_as_float(rr[1])); }
            if (t == 0 || __any(mx > 8.0f)) {
                const float delta = (t == 0) ? mx : fmaxf(mx, 0.f);
                if (t != 0) { const float alpha = __builtin_amdgcn_exp2f(-delta); l_run *= alpha;
#pragma unroll
                    for (int i = 0; i < NDB; ++i) o[i] = o[i] * alpha; }
                m_run += delta;
#pragma unroll
                for (int j = 0; j < 16; ++j) { x0[j] -= delta; x1[j] -= delta; }
            }
            f32x2 ls2 = {0.f, 0.f};
#pragma unroll
            for (int j = 0; j < 16; j += 2) { x0[j] = __builtin_amdgcn_exp2f(x0[j]); x0[j + 1] = __builtin_amdgcn_exp2f(x0[j + 1]); x1[j] = __builtin_amdgcn_exp2f(x1[j]); x1[j + 1] = __builtin_amdgcn_exp2f(x1[j + 1]);
                ls2 += (f32x2){x0[j], x0[j + 1]}; ls2 += (f32x2){x1[j], x1[j + 1]}; }
            l_run += ls2[0] + ls2[1];
            { v4u w;
              w.x = pk2(x0[0], x0[1]); w.y = pk2(x0[2], x0[3]); w.z = pk2(x0[4], x0[5]); w.w = pk2(x0[6], x0[7]); pf[0] = __builtin_bit_cast(bf16x8, w);
              w.x = pk2(x0[8], x0[9]); w.y = pk2(x0[10], x0[11]); w.z = pk2(x0[12], x0[13]); w.w = pk2(x0[14], x0[15]); pf[1] = __builtin_bit_cast(bf16x8, w);
              w.x = pk2(x1[0], x1[1]); w.y = pk2(x1[2], x1[3]); w.z = pk2(x1[4], x1[5]); w.w = pk2(x1[6], x1[7]); pf[2] = __builtin_bit_cast(bf16x8, w);
              w.x = pk2(x1[8], x1[9]); w.y = pk2(x1[10], x1[11]); w.z = pk2(x1[12], x1[13]); w.w = pk2(x1[14], x1[15]); pf[3] = __builtin_bit_cast(bf16x8, w); }
        } else {
            s16x4 vlo[2][4], vhi[2][4];
            const unsigned sbu = (unsigned)(unsigned long)sb;
#define ATT2_TR(dst, a, imm) asm volatile("ds_read_b64_tr_b16 %0, %1 offset:%2" : "=&v"(dst) : "v"(a), "n"(imm) : "memory")
#define ATT2_VLOAD(buf, db) do { const unsigned a_ = sbu + (unsigned)vaddr[db]; \
        ATT2_TR(vlo[buf][0], a_, 0 * VROWB); ATT2_TR(vhi[buf][0], a_, 8 * VROWB); ATT2_TR(vlo[buf][1], a_, 16 * VROWB); ATT2_TR(vhi[buf][1], a_, 24 * VROWB); \
        ATT2_TR(vlo[buf][2], a_, 32 * VROWB); ATT2_TR(vhi[buf][2], a_, 40 * VROWB); ATT2_TR(vlo[buf][3], a_, 48 * VROWB); ATT2_TR(vhi[buf][3], a_, 56 * VROWB); } while (0)
#define ATT2_VWAIT(n, buf) asm volatile("s_waitcnt lgkmcnt(" #n ")" : "+v"(vlo[buf][0]), "+v"(vhi[buf][0]), "+v"(vlo[buf][1]), "+v"(vhi[buf][1]), "+v"(vlo[buf][2]), "+v"(vhi[buf][2]), "+v"(vlo[buf][3]), "+v"(vhi[buf][3]) :: "memory")
            ATT2_VLOAD(0, 0);
            ATT_SETPRIO(1);
#pragma unroll
            for (int db = 0; db < NDB; ++db) {
                if (db + 1 < NDB) { ATT2_VLOAD((db + 1) & 1, db + 1); if (db & 1) ATT2_VWAIT(8, 1); else ATT2_VWAIT(8, 0); }
                else { if (db & 1) ATT2_VWAIT(0, 1); else ATT2_VWAIT(0, 0); }
#pragma unroll
                for (int s = 0; s < 4; ++s) { const bf16x8 vf = __builtin_shufflevector(vlo[db & 1][s], vhi[db & 1][s], 0, 1, 2, 3, 4, 5, 6, 7); o[db] = MFMA32(vf, pf[s], o[db]); }
            }
            ATT_SETPRIO(0);
#undef ATT2_TR
#undef ATT2_VWAIT
#undef ATT2_VLOAD
        }
    }
#undef ATT2_ISSUE
#undef ATT2_WAIT
    const float lt = l_run + shx(l_run, 32, lane), inv = 1.0f / lt;
    bf16* op = P.O + (tok0 + qrow) * (long)P.ldo + ocol + 4 * h;
#pragma unroll
    for (int db = 0; db < NDB; ++db)
#pragma unroll
        for (int g = 0; g < 4; ++g) { v2u w; w.x = pk2(o[db][4 * g] * inv, o[db][4 * g + 1] * inv); w.y = pk2(o[db][4 * g + 2] * inv, o[db][4 * g + 3] * inv);
            *(v2u*)(op + 32 * db + 8 * g) = w; }
}
#undef MFMA32
}

constexpr size_t MiB = 1u << 20;
constexpr size_t WS_CTL = 0, CTL_ZERO_BYTES = 1 * MiB;
constexpr size_t WS_ROPE = 1 * MiB;
constexpr size_t WS_MISC = 5 * MiB;
constexpr size_t WS_XB = 6 * MiB;
constexpr size_t WS_PB = 70 * MiB;
constexpr size_t WS_W = 86 * MiB;
constexpr size_t W_IN = WS_W, W_UQ = WS_W + 12 * MiB, W_UKV = WS_W + 13 * MiB, W_BD = WS_W + 14 * MiB, W_BM = WS_W + 16 * MiB, W_OUT = WS_W + 17 * MiB,
                 W_PG = WS_W + 19 * MiB, W_PP = WS_W + 21 * MiB, W_F13 = WS_W + 22 * MiB, W_F2D = WS_W + 33 * MiB, W_F2E = WS_W + 134 * MiB;
constexpr size_t WS_ACT = 276 * MiB;
constexpr size_t A_DQ = WS_ACT, A_DK = WS_ACT + 64 * MiB, A_DV = WS_ACT + 128 * MiB, A_G = WS_ACT + 192 * MiB, A_C = WS_ACT + 320 * MiB;
constexpr size_t A_OA = A_DQ, A_MT = A_DK, A_M = A_DV, A_CQ = A_C, A_OA2 = A_C, A_PRE = A_C;
constexpr size_t A_CQN = WS_ACT + 448 * MiB, A_CKVN = WS_ACT + 472 * MiB, A_OB = A_CQN, A_MKR = WS_ACT + 488 * MiB, A_MQ = WS_ACT + 490 * MiB, A_MKV = WS_ACT + 538 * MiB;
constexpr size_t A_H = WS_ACT;
constexpr size_t A_XG = WS_ACT, A_YG = A_XG  , A_TOK = WS_ACT + 264 * MiB, A_HG = WS_ACT + 270 * MiB, A_PREM = WS_ACT + 732 * MiB;
constexpr size_t WS_END = WS_ACT + 860 * MiB;
constexpr int CW_BAR = 4096, CW_MOE = 8192;

constexpr int RING_BYTES = 131072, MISC_OFF = RING_BYTES + 320, LDS_BYTES = 147456;
constexpr int NWAVES = 8;

#ifndef REP_ATTN_D
#define REP_ATTN_D 1
#endif
#ifndef REP_ATTN_M
#define REP_ATTN_M 1
#endif
#ifndef REP_CONV
#define REP_CONV 1
#endif
#ifndef REP_L1
#define REP_L1 1
#endif
#ifndef REP_EW
#define REP_EW 1
#endif
#ifndef REP_BAR
#define REP_BAR 1
#endif
#ifndef REP_LN
#define REP_LN 1
#endif
#ifndef REP_MOE
#define REP_MOE 1
#endif
#ifndef REP_MIX
#define REP_MIX 1
#endif
#ifndef REP_FFN
#define REP_FFN 1
#endif
#ifndef REP_P0
#define REP_P0 1
#endif
#ifndef REP_PPE
#define REP_PPE 1
#endif
#ifndef ATT_UNIT
#define ATT_UNIT attn_unit
#endif
#ifndef F8_SP2
#define F8_SP2 true
#endif
#define XB_TMO      128
#define XB_XCNT(j)  (256  + 64 * (j))
#define XB_XSUB(j)  (1280 + 64 * (j))
#define XB_XGEN(j)  (2304 + 64 * (j))
#define XB_TOP      3328
#define XB_TOPGEN   3392
#define XCD_BAR_WORDS 3456
#define XB_SPIN_CAP (1u << 18)

__device__ __forceinline__ unsigned xb_ld(unsigned* p)              { return __hip_atomic_load(p, __ATOMIC_RELAXED, __HIP_MEMORY_SCOPE_AGENT); }
__device__ __forceinline__ unsigned xb_add(unsigned* p, unsigned v) { return __hip_atomic_fetch_add(p, v, __ATOMIC_RELAXED, __HIP_MEMORY_SCOPE_AGENT); }
__device__ __forceinline__ unsigned xb_xcc_id() { return (unsigned)__builtin_amdgcn_s_getreg((3 << 11) | 20) & 0xFu; }
#define XB_SPIN(cond, bar) do { unsigned _sp = 0; while (cond) { __builtin_amdgcn_s_sleep(1); \
    if ((++_sp & 255u) == 0u) { if (xb_ld(&(bar)[XB_TMO])) break; if (_sp > XB_SPIN_CAP) { atomicAdd(&(bar)[XB_TMO], 1u); break; } } } } while (0)

struct XcdBarrier {
    unsigned* bar; unsigned x;
    volatile LAS unsigned* st;
};

__device__ __forceinline__ XcdBarrier xcd_barrier_post(unsigned* bar, volatile LAS unsigned* st, const bool t0  ) {
    XcdBarrier b; b.bar = bar; b.x = xb_xcc_id(); b.st = st;
    if (t0) (void)xb_add(&bar[XB_XCNT(b.x)], 1u);
    return b;
}
__device__ __forceinline__ void xcd_barrier_complete(unsigned* bar, unsigned x, unsigned& nloc, unsigned& nx) {
    const unsigned G = gridDim.x * gridDim.y * gridDim.z;
    unsigned sum, cnt, mine, sp = 0u;
    for (;;) {
        sum = 0u; cnt = 0u; mine = 0u;
#pragma unroll
        for (unsigned j = 0; j < 16; ++j) { const unsigned c = xb_ld(&bar[XB_XCNT(j)]); sum += c; cnt += (c > 0u) ? 1u : 0u; mine = (j == x) ? c : mine; }
        if (sum == G) break;
        __builtin_amdgcn_s_sleep(1);
        if ((++sp & 255u) == 0u) { if (xb_ld(&bar[XB_TMO])) break; if (sp > XB_SPIN_CAP) { atomicAdd(&bar[XB_TMO], 1u); break; } }
    }
    nloc = mine > 0u ? mine : 1u; nx = cnt > 0u ? cnt : 1u;
}

__device__ __forceinline__ void xcd_barrier(const XcdBarrier& b, const bool t0) {
    asm volatile("s_waitcnt vmcnt(0)" ::: "memory");
    __syncthreads();
    if (t0) {
        unsigned* bar = b.bar;
        __builtin_amdgcn_s_waitcnt(0);
        unsigned nloc = b.st[0], nx = b.st[1];
        if (nloc == 0u) { xcd_barrier_complete(bar, b.x, nloc, nx); b.st[0] = nloc; b.st[1] = nx; }
        const unsigned old = xb_add(&bar[XB_XSUB(b.x)], 1u);
        const unsigned gen = old / nloc;
        if (old + 1u == (gen + 1u) * nloc) {
            __builtin_amdgcn_fence(__ATOMIC_RELEASE, "agent");
            asm volatile("s_waitcnt vmcnt(0)" ::: "memory");
            const unsigned og = xb_add(&bar[XB_TOP], 1u);
            const unsigned tg = og / nx;
            if (og + 1u == (tg + 1u) * nx) xb_add(&bar[XB_TOPGEN], 1u);
            else XB_SPIN(xb_ld(&bar[XB_TOPGEN]) == tg, bar);
            __builtin_amdgcn_fence(__ATOMIC_ACQUIRE, "agent");
            xb_add(&bar[XB_XGEN(b.x)], 1u);
            asm volatile("s_waitcnt vmcnt(0)" ::: "memory");
        } else {
            XB_SPIN(xb_ld(&bar[XB_XGEN(b.x)]) == gen, bar);
            __builtin_amdgcn_fence(__ATOMIC_ACQUIRE, "agent");
            asm volatile("s_waitcnt vmcnt(0)" ::: "memory");
        }
    }
    __syncthreads();
}

struct Args { const void* in[31]; float* out; unsigned char* ws; int ph_lo, ph_hi; };

struct Frame {
    LAS unsigned char* lds;
    int tid, lane, wave, gw, NGW, G, vcu;
    const Args* a;
    unsigned char* ws;
};
#define INF(i) ((const float*)F.a->in[i])
#define WSP(T_, off) ((T_*)(F.ws + (off)))

__device__ __forceinline__ void conv_w(const Frame& F, const float* src, int ldn, int K, int ncols, int nbatch, size_t sbs, bf16* dst, int rmul, int roff, size_t dbs, const float* kscale) {
    LAS float* scr = (LAS float*)(F.lds + F.wave * 16384);
    const int lane = F.lane, nblk = ncols / 32, kblk = K / 64, per = nblk * kblk, total = per * nbatch;
    for (int it = F.gw; it < total; it += F.NGW) {
        const int bt = it / per, r = it % per, kb = r / nblk, nb = r % nblk, k0 = kb * 64, n0 = nb * 32;
        const float* W = src + (size_t)bt * sbs; bf16* WT = dst + (size_t)bt * dbs;
#pragma unroll 8
        for (int i = 0; i < 32; ++i) { const int kk = 2 * i + (lane >> 5); scr[kk * 33 + (lane & 31)] = W[(size_t)(k0 + kk) * ldn + n0 + (lane & 31)]; }
        LDS_WAIT(); asm volatile("" ::: "memory");
        const int c = lane & 7;
        float ks[8];
#pragma unroll
        for (int i = 0; i < 8; ++i) ks[i] = kscale ? kscale[k0 + 8 * c + i] : 1.0f;
#pragma unroll
        for (int j = 0; j < 4; ++j) { const int n = (lane >> 3) + 8 * j; const LAS float* s = scr + (8 * c) * 33 + n;
            v4u o; o.x = pk2(s[0 * 33] * ks[0], s[1 * 33] * ks[1]); o.y = pk2(s[2 * 33] * ks[2], s[3 * 33] * ks[3]); o.z = pk2(s[4 * 33] * ks[4], s[5 * 33] * ks[5]); o.w = pk2(s[6 * 33] * ks[6], s[7 * 33] * ks[7]);
            *(v4u*)(WT + (size_t)(rmul * (n0 + n) + roff) * K + k0 + 8 * c) = o; }
        LDS_WAIT(); asm volatile("" ::: "memory");
    }
}
__device__ __forceinline__ void conv_w8(const Frame& F, const float* src, int ldn, int K, int ncols, int nbatch, size_t sbs, unsigned char* dst, int rmul, int roff, size_t dbs, float scale) {
    LAS float* scr = (LAS float*)(F.lds + F.wave * 16384);
    const int lane = F.lane, nblk = ncols / 32, kblk = K / 64, per = nblk * kblk, total = per * nbatch;
    for (int it = F.gw; it < total; it += F.NGW) {
        const int bt = it / per, r = it % per, kb = r / nblk, nb = r % nblk, k0 = kb * 64, n0 = nb * 32;
        const float* W = src + (size_t)bt * sbs; unsigned char* WT = dst + (size_t)bt * dbs;
#pragma unroll 8
        for (int i = 0; i < 32; ++i) { const int kk = 2 * i + (lane >> 5); scr[kk * 33 + (lane & 31)] = W[(size_t)(k0 + kk) * ldn + n0 + (lane & 31)]; }
        LDS_WAIT(); asm volatile("" ::: "memory");
        const int c = lane & 7;
#pragma unroll
        for (int j = 0; j < 4; ++j) { const int n = (lane >> 3) + 8 * j; const LAS float* s = scr + (8 * c) * 33 + n;
            int lo = __builtin_amdgcn_cvt_pk_fp8_f32(s[0 * 33] * scale, s[1 * 33] * scale, 0, false); lo = __builtin_amdgcn_cvt_pk_fp8_f32(s[2 * 33] * scale, s[3 * 33] * scale, lo, true);
            int hi = __builtin_amdgcn_cvt_pk_fp8_f32(s[4 * 33] * scale, s[5 * 33] * scale, 0, false); hi = __builtin_amdgcn_cvt_pk_fp8_f32(s[6 * 33] * scale, s[7 * 33] * scale, hi, true);
            v2u o; o.x = (unsigned)lo; o.y = (unsigned)hi;
            *(v2u*)(WT + (size_t)(rmul * (n0 + n) + roff) * K + k0 + 8 * c) = o; }
        LDS_WAIT(); asm volatile("" ::: "memory");
    }
}
__device__ __forceinline__ void phase_convert(const Frame& F, int L) {
    const int j = L >> 1;
    const float* win = INF(4) + (size_t)L * D * IN_COLS;
    conv_w(F, win, IN_COLS, D, 3072, 1, 0, WSP(bf16, W_IN), 1, 0, 0, nullptr);
    conv_w(F, win + 3744, IN_COLS, D, 2048, 1, 0, WSP(bf16, W_IN), 1, 3072, 0, nullptr);
    conv_w(F, win + 3072, IN_COLS, D, 672, 1, 0, WSP(bf16, W_IN), 1, 5120, 0, nullptr);
    { bf16* padr = WSP(bf16, W_IN) + (size_t)IN_COLS * D;
      unsigned z_ = 0u; asm volatile("" : "+v"(z_));
      for (int i = F.gw * 64 + F.lane; i < (NIN - IN_COLS) * D / 8; i += F.NGW * 64) ((v4u*)padr)[i] = (v4u){z_, z_, z_, z_}; }
    conv_w(F, INF(12) + (size_t)L * QR * 768, 768, QR, 768, 1, 0, WSP(bf16, W_UQ), 1, 0, 0, INF(11) + L * QR);
    conv_w(F, INF(14) + (size_t)L * KVR * 1024, 1024, KVR, 1024, 1, 0, WSP(bf16, W_UKV), 1, 0, 0, INF(13) + L * KVR);
    conv_w(F, INF(15) + (size_t)L * D * D, D, D, D, 1, 0, WSP(bf16, W_BD), 1, 0, 0, nullptr);
    conv_w(F, INF(16) + (size_t)L * 512 * D, D, 512, D, 1, 0, WSP(bf16, W_BM), 1, 0, 0, nullptr);
    conv_w(F, INF(17) + (size_t)L * D * D, D, D, D, 1, 0, WSP(bf16, W_OUT), 1, 0, 0, nullptr);
    conv_w(F, INF(27) + (size_t)L * D * D, D, D, D, 1, 0, WSP(bf16, W_PG), 1, 0, 0, nullptr);
    conv_w(F, INF(28) + (size_t)L * PLE * D, D, PLE, D, 1, 0, WSP(bf16, W_PP), 1, 0, 0, nullptr);
    if ((L & 1) == 0) {
        conv_w(F, INF(20) + (size_t)j * D * DENSE_FF, DENSE_FF, D, DENSE_FF, 1, 0, WSP(bf16, W_F13), 2, 0, 0, nullptr);
        conv_w(F, INF(21) + (size_t)j * D * DENSE_FF, DENSE_FF, D, DENSE_FF, 1, 0, WSP(bf16, W_F13), 2, 1, 0, nullptr);
        conv_w(F, INF(22) + (size_t)j * DENSE_FF * D, D, DENSE_FF, D, 1, 0, WSP(bf16, W_F2D), 1, 0, 0, nullptr);
    } else {
        const size_t eo = (size_t)j * NEXP * D * EXPERT_FF;
#if MOE_FP8
        conv_w8(F, INF(24) + eo, EXPERT_FF, D, EXPERT_FF, NEXP, (size_t)D * EXPERT_FF, WSP(unsigned char, W_F13), 2, 0, (size_t)2 * EXPERT_FF * D, 32.0f);
        conv_w8(F, INF(25) + eo, EXPERT_FF, D, EXPERT_FF, NEXP, (size_t)D * EXPERT_FF, WSP(unsigned char, W_F13), 2, 1, (size_t)2 * EXPERT_FF * D, 32.0f);
        conv_w8(F, INF(26) + eo, D, EXPERT_FF, D, NEXP, (size_t)EXPERT_FF * D, WSP(unsigned char, W_F2E), 1, 0, (size_t)D * EXPERT_FF, 128.0f);
#else
        conv_w(F, INF(24) + eo, EXPERT_FF, D, EXPERT_FF, NEXP, (size_t)D * EXPERT_FF, WSP(bf16, W_F13), 2, 0, (size_t)2 * EXPERT_FF * D, nullptr);
        conv_w(F, INF(25) + eo, EXPERT_FF, D, EXPERT_FF, NEXP, (size_t)D * EXPERT_FF, WSP(bf16, W_F13), 2, 1, (size_t)2 * EXPERT_FF * D, nullptr);
        conv_w(F, INF(26) + eo, D, EXPERT_FF, D, NEXP, (size_t)EXPERT_FF * D, WSP(bf16, W_F2E), 1, 0, (size_t)D * EXPERT_FF, nullptr);
#endif
    }
    { const f32x4* ps = (const f32x4*)(INF(1) + (size_t)L * T * PLE); v2u* pd = WSP(v2u, WS_PB);
      for (int i = F.gw * 64 + F.lane; i < T * PLE / 4; i += F.NGW * 64) { const f32x4 v = ps[i]; v2u o; o.x = pk2(v[0], v[1]); o.y = pk2(v[2], v[3]); pd[i] = o; } }
}

__device__ __forceinline__ void phase_prologue(const Frame& F) {
    const int* pos = (const int*)F.a->in[2];
    for (int m = F.gw; m < T; m += F.NGW) {
        const f32x4* xr = (const f32x4*)(INF(0) + (size_t)m * D) + F.lane; f32x4* orow = (f32x4*)(F.a->out + (size_t)m * D) + F.lane; v2u* br = WSP(v2u, WS_XB) + (size_t)m * (D / 4) + F.lane;
#pragma unroll
        for (int j = 0; j < 4; ++j) { const f32x4 v = xr[64 * j]; orow[64 * j] = v; v2u o; o.x = pk2(v[0], v[1]); o.y = pk2(v[2], v[3]); br[64 * j] = o; }
    }
    { float* rope = WSP(float, WS_ROPE);
      for (int idx = F.gw * 64 + F.lane; idx < T * 16; idx += F.NGW * 64) {
          const int t = idx >> 4, j = idx & 15;
          double inv = 1.0; for (int i = 0; i < j; ++i) inv *= 0.5623413251903491;
          const double ang = (double)pos[t] * inv;
          const double nq = __builtin_rint(ang * 0.6366197723675814);
          double y = __builtin_fma(-nq, 1.5707963267948966, ang); y = __builtin_fma(-nq, 6.123233995736766e-17, y);
          const double y2 = y * y;
          double sp = 1.0 / 6227020800.0; sp = sp * y2 - 1.0 / 39916800.0; sp = sp * y2 + 1.0 / 362880.0; sp = sp * y2 - 1.0 / 5040.0; sp = sp * y2 + 1.0 / 120.0; sp = sp * y2 - 1.0 / 6.0;
          const double sn = y + y * y2 * sp;
          double cp = -1.0 / 87178291200.0; cp = cp * y2 + 1.0 / 479001600.0; cp = cp * y2 - 1.0 / 3628800.0; cp = cp * y2 + 1.0 / 40320.0; cp = cp * y2 - 1.0 / 720.0; cp = cp * y2 + 1.0 / 24.0; cp = cp * y2 - 0.5;
          const double cs = 1.0 + y2 * cp;
          const int q = ((int)nq) & 3;
          const double c = (q == 0) ? cs : (q == 1) ? -sn : (q == 2) ? -cs : sn;
          const double s = (q == 0) ? sn : (q == 1) ? cs : (q == 2) ? -sn : -cs;
          rope[2 * idx] = (float)c; rope[2 * idx + 1] = (float)s;
      } }
    { int* bm = WSP(int, WS_MISC);
      for (int blk = F.gw; blk < T / 64; blk += F.NGW) { int v = pos[blk * 64 + F.lane];
#pragma unroll
          for (int o = 1; o < 64; o <<= 1) { const int t2 = shxi(v, o, F.lane); v = t2 > v ? t2 : v; }
          if (F.lane == 0) bm[blk] = v; } }
    { float* lut = WSP(float, WS_MISC + 4096); const float* tab = INF(3);
      for (int idx = F.gw * 64 + F.lane; idx < 8 * 132; idx += F.NGW * 64) { const int hh = idx / 132, n = idx % 132;
          int bk = n;
          if (n >= 16) bk = 16 + (n >= 19) + (n >= 21) + (n >= 24) + (n >= 27) + (n >= 31) + (n >= 35) + (n >= 40) + (n >= 46) + (n >= 52) + (n >= 59) + (n >= 67) + (n >= 77) + (n >= 87) + (n >= 99) + (n >= 113);
          lut[idx] = tab[bk * 8 + hh] * LOG2E; } }
    for (int rep = 0; rep < REP_CONV; ++rep) phase_convert(F, 0);
}

__device__ __forceinline__ void phase_rms_rope(const Frame& F) {
    const float* CQ = WSP(float, A_CQ); const float* rope = WSP(float, WS_ROPE);
    bf16* CQN = WSP(bf16, A_CQN); bf16* CKVN = WSP(bf16, A_CKVN); bf16* MKR = WSP(bf16, A_MKR);
    const int l = F.lane;
    for (int m = F.gw; m < T; m += F.NGW) {
        const float* c = CQ + (size_t)m * 768;
        const f32x2 a0 = *(const f32x2*)(c + 6 * l), a1 = *(const f32x2*)(c + 6 * l + 2), a2 = *(const f32x2*)(c + 6 * l + 4);
        const f32x4 kv = *(const f32x4*)(c + QR + 4 * l);
        float x1 = 0.f, x2 = 0.f, rc = 0.f, rs = 0.f;
        if (l < 16) { x1 = c[QR + KVR + l]; x2 = c[QR + KVR + 16 + l]; rc = rope[(size_t)m * 32 + 2 * l]; rs = rope[(size_t)m * 32 + 2 * l + 1]; }
        const float sq = wave_sum(l, a0[0] * a0[0] + a0[1] * a0[1] + a1[0] * a1[0] + a1[1] * a1[1] + a2[0] * a2[0] + a2[1] * a2[1]);
        const float sk = wave_sum(l, kv[0] * kv[0] + kv[1] * kv[1] + kv[2] * kv[2] + kv[3] * kv[3]);
        const float rq = 1.0f / sqrtf(sq * (1.0f / QR) + LN_EPS), rk = 1.0f / sqrtf(sk * (1.0f / KVR) + LN_EPS);
        unsigned* qo = (unsigned*)(CQN + (size_t)m * QR + 6 * l);
        qo[0] = pk2(a0[0] * rq, a0[1] * rq); qo[1] = pk2(a1[0] * rq, a1[1] * rq); qo[2] = pk2(a2[0] * rq, a2[1] * rq);
        v2u ko; ko.x = pk2(kv[0] * rk, kv[1] * rk); ko.y = pk2(kv[2] * rk, kv[3] * rk);
        *(v2u*)(CKVN + (size_t)m * KVR + 4 * l) = ko;
        if (l < 16) { const float o1 = x1 * rc - x2 * rs, o2 = x1 * rs + x2 * rc; const unsigned w = pk2(o1, o2);
            MKR[(size_t)m * 32 + l] = (bf16)(w & 0xffffu); MKR[(size_t)m * 32 + 16 + l] = (bf16)(w >> 16); }
    }
}

__device__ __forceinline__ void phase_combine(const Frame& F, int L) {
    const float lam_init = 0.8f - 0.6f * expf(-0.3f * (float)L);
    const int l = F.lane;
    const float d1 = wave_sum(l, INF(6)[L * 64 + l] * INF(7)[L * 64 + l]), d2 = wave_sum(l, INF(8)[L * 64 + l] * INF(9)[L * 64 + l]);
    const float lam = expf(d1) - expf(d2) + lam_init;
    const bf16* OA2 = WSP(bf16, A_OA2); bf16* OA = WSP(bf16, A_OA);
    const int hh = l >> 3, d0 = (l & 7) * 16;
    float gsc[16];
#pragma unroll
    for (int i = 0; i < 16; ++i) gsc[i] = INF(10)[L * 128 + d0 + i] * (1.0f - lam_init);
    for (int m = F.gw; m < T; m += F.NGW) {
        const bf16* p0 = OA2 + (size_t)m * 2048 + (hh * 2) * 128 + d0;
        const v4u a0 = *(const v4u*)p0, a1 = *(const v4u*)(p0 + 8), b0 = *(const v4u*)(p0 + 128), b1 = *(const v4u*)(p0 + 136);
        float o[16];
        o[0] = bflo(a0.x) - lam * bflo(b0.x); o[1] = bfhi(a0.x) - lam * bfhi(b0.x); o[2] = bflo(a0.y) - lam * bflo(b0.y); o[3] = bfhi(a0.y) - lam * bfhi(b0.y);
        o[4] = bflo(a0.z) - lam * bflo(b0.z); o[5] = bfhi(a0.z) - lam * bfhi(b0.z); o[6] = bflo(a0.w) - lam * bflo(b0.w); o[7] = bfhi(a0.w) - lam * bfhi(b0.w);
        o[8] = bflo(a1.x) - lam * bflo(b1.x); o[9] = bfhi(a1.x) - lam * bfhi(b1.x); o[10] = bflo(a1.y) - lam * bflo(b1.y); o[11] = bfhi(a1.y) - lam * bfhi(b1.y);
        o[12] = bflo(a1.z) - lam * bflo(b1.z); o[13] = bfhi(a1.z) - lam * bfhi(b1.z); o[14] = bflo(a1.w) - lam * bflo(b1.w); o[15] = bfhi(a1.w) - lam * bfhi(b1.w);
        float ss = 0.f;
#pragma unroll
        for (int i = 0; i < 16; ++i) ss += o[i] * o[i];
        ss += shx(ss, 1, l); ss += shx(ss, 2, l); ss += shx(ss, 4, l);
        const float rr = 1.0f / sqrtf(ss * (1.0f / 128.0f) + LN_EPS);
        v4u w0, w1;
        w0.x = pk2(o[0] * rr * gsc[0], o[1] * rr * gsc[1]); w0.y = pk2(o[2] * rr * gsc[2], o[3] * rr * gsc[3]); w0.z = pk2(o[4] * rr * gsc[4], o[5] * rr * gsc[5]); w0.w = pk2(o[6] * rr * gsc[6], o[7] * rr * gsc[7]);
        w1.x = pk2(o[8] * rr * gsc[8], o[9] * rr * gsc[9]); w1.y = pk2(o[10] * rr * gsc[10], o[11] * rr * gsc[11]); w1.z = pk2(o[12] * rr * gsc[12], o[13] * rr * gsc[13]); w1.w = pk2(o[14] * rr * gsc[14], o[15] * rr * gsc[15]);
        bf16* po = OA + (size_t)m * 1024 + hh * 128 + d0;
        *(v4u*)po = w0; *(v4u*)(po + 8) = w1;
    }
}

template <bool ROUTE, bool GATHER>
__device__ __forceinline__ void phase_ln(const Frame& F, const float* PRE, const float* gam, const float* bet, const float* wr, int moe_j) {
    const int l = F.lane;
    const bf16* YG = WSP(bf16, A_YG); int* TOKE = WSP(int, A_TOK); float* TOKG = WSP(float, A_TOK + 1 * MiB); const int* TOKR = WSP(int, A_TOK + 2 * MiB);
    int* TOKS = WSP(int, A_TOK + 3 * MiB); int* CNTW = WSP(int, A_TOK + 4 * MiB);
    int rc0 = 0, rc1 = 0, rc2 = 0, rc3 = 0, rc4 = 0, rc5 = 0, rc6 = 0, rc7 = 0; (void)moe_j;
    f32x4 gv[4], bv[4];
#pragma unroll
    for (int j = 0; j < 4; ++j) { gv[j] = *(const f32x4*)(gam + 4 * l + 256 * j); bv[j] = *(const f32x4*)(bet + 4 * l + 256 * j); }
    for (int m = F.gw; m < T; m += F.NGW) {
        const f32x4* xr = (const f32x4*)(PRE + (size_t)m * D) + l;
        f32x4 v[4]; float s = 0.f;
#pragma unroll
        for (int j = 0; j < 4; ++j) v[j] = xr[64 * j];
        if (GATHER) { const int r0 = TOKR[2 * m], r1 = TOKR[2 * m + 1]; const float g0 = TOKG[2 * m], g1 = TOKG[2 * m + 1];
            const v2u* y0 = (const v2u*)(YG + (size_t)r0 * D) + l; const v2u* y1 = (const v2u*)(YG + (size_t)r1 * D) + l;
#pragma unroll
            for (int j = 0; j < 4; ++j) { const v2u a = y0[64 * j], b = y1[64 * j];
                v[j][0] += g0 * bflo(a.x) + g1 * bflo(b.x); v[j][1] += g0 * bfhi(a.x) + g1 * bfhi(b.x); v[j][2] += g0 * bflo(a.y) + g1 * bflo(b.y); v[j][3] += g0 * bfhi(a.y) + g1 * bfhi(b.y); } }
#pragma unroll
        for (int j = 0; j < 4; ++j) s += (v[j][0] + v[j][1]) + (v[j][2] + v[j][3]);
        const float mean = wave_sum(l, s) * (1.f / D); float s2 = 0.f;
#pragma unroll
        for (int j = 0; j < 4; ++j) { v[j] = v[j] - mean; s2 += (v[j][0] * v[j][0] + v[j][1] * v[j][1]) + (v[j][2] * v[j][2] + v[j][3] * v[j][3]); }
        const float rstd = 1.f / sqrtf(wave_sum(l, s2) * (1.f / D) + LN_EPS);
        f32x4* orow = (f32x4*)(F.a->out + (size_t)m * D) + l; v2u* br = WSP(v2u, WS_XB) + (size_t)m * (D / 4) + l;
#pragma unroll
        for (int j = 0; j < 4; ++j) { v[j] = v[j] * rstd * gv[j] + bv[j]; orow[64 * j] = v[j]; v2u o; o.x = pk2(v[j][0], v[j][1]); o.y = pk2(v[j][2], v[j][3]); br[64 * j] = o; }
        if (ROUTE) {
            float lg[8];
#pragma unroll
            for (int e = 0; e < 8; ++e) lg[e] = 0.f;
#pragma unroll
            for (int j = 0; j < 4; ++j)
#pragma unroll
                for (int c = 0; c < 4; ++c) { const float* w = wr + (size_t)(4 * l + 256 * j + c) * 8; const f32x4 w0 = *(const f32x4*)w, w1 = *(const f32x4*)(w + 4); const float xv = v[j][c];
                    lg[0] += xv * w0[0]; lg[1] += xv * w0[1]; lg[2] += xv * w0[2]; lg[3] += xv * w0[3]; lg[4] += xv * w1[0]; lg[5] += xv * w1[1]; lg[6] += xv * w1[2]; lg[7] += xv * w1[3]; }
#pragma unroll
            for (int e = 0; e < 8; ++e) lg[e] = wave_sum(l, lg[e]);
            int e0 = 0; float v0 = lg[0];
#pragma unroll
            for (int e = 1; e < 8; ++e) if (lg[e] > v0) { v0 = lg[e]; e0 = e; }
            int e1 = -1; float v1 = -INFINITY;
#pragma unroll
            for (int e = 0; e < 8; ++e) if (e != e0 && lg[e] > v1) { v1 = lg[e]; e1 = e; }
            const float g1 = 1.0f / (1.0f + expf(v0 - v1)), g0 = 1.0f - g1;
            const int s0 = (e0 == 0) ? rc0 : (e0 == 1) ? rc1 : (e0 == 2) ? rc2 : (e0 == 3) ? rc3 : (e0 == 4) ? rc4 : (e0 == 5) ? rc5 : (e0 == 6) ? rc6 : rc7;
            const int s1 = (e1 == 0) ? rc0 : (e1 == 1) ? rc1 : (e1 == 2) ? rc2 : (e1 == 3) ? rc3 : (e1 == 4) ? rc4 : (e1 == 5) ? rc5 : (e1 == 6) ? rc6 : rc7;
            rc0 += (e0 == 0) + (e1 == 0); rc1 += (e0 == 1) + (e1 == 1); rc2 += (e0 == 2) + (e1 == 2); rc3 += (e0 == 3) + (e1 == 3);
            rc4 += (e0 == 4) + (e1 == 4); rc5 += (e0 == 5) + (e1 == 5); rc6 += (e0 == 6) + (e1 == 6); rc7 += (e0 == 7) + (e1 == 7);
            if (l == 0) { TOKE[2 * m] = e0; TOKE[2 * m + 1] = e1; TOKG[2 * m] = g0; TOKG[2 * m + 1] = g1; TOKS[2 * m] = s0; TOKS[2 * m + 1] = s1; }
        }
    }
    if (ROUTE && l == 0) { int* cw = CNTW + (size_t)F.gw * 8; cw[0] = rc0; cw[1] = rc1; cw[2] = rc2; cw[3] = rc3; cw[4] = rc4; cw[5] = rc5; cw[6] = rc6; cw[7] = rc7; }
}

struct MoeTiles { int pend[8]; int total; };
__device__ __forceinline__ void moe_tiles(const Frame& F, int moe_j, MoeTiles& mt) {
    const int* tot = WSP(int, A_TOK + 5 * MiB); int acc = 0; (void)moe_j;
#pragma unroll
    for (int e = 0; e < 8; ++e) { const int c = tot[e]; acc += (c + 255) >> 8; mt.pend[e] = acc; }
    mt.total = acc;
}
__device__ __forceinline__ void phase_scatter(const Frame& F, int moe_j) {
    (void)moe_j;
    const int* CNTW = WSP(int, A_TOK + 4 * MiB); const int* TOKS = WSP(int, A_TOK + 3 * MiB); int* TOT = WSP(int, A_TOK + 5 * MiB);
    const int* TOKE = WSP(int, A_TOK); int* TOKR = WSP(int, A_TOK + 2 * MiB);
    const v4u* XB = WSP(v4u, WS_XB); v4u* XG = WSP(v4u, A_XG); const int l = F.lane;
    LAS int* red = (LAS int*)F.lds;
    int tot[8], pre[8];
#pragma unroll
    for (int e = 0; e < 8; ++e) { tot[e] = 0; pre[e] = 0; }
    const int wg0 = F.vcu * NWAVES;
    for (int w = F.tid; w < F.NGW; w += NWAVES * 64) { const v4u a = *(const v4u*)(CNTW + (size_t)w * 8), b = *(const v4u*)(CNTW + (size_t)w * 8 + 4); const int below = (w < wg0) ? 1 : 0;
        tot[0] += a.x; tot[1] += a.y; tot[2] += a.z; tot[3] += a.w; tot[4] += b.x; tot[5] += b.y; tot[6] += b.z; tot[7] += b.w;
        pre[0] += below * (int)a.x; pre[1] += below * (int)a.y; pre[2] += below * (int)a.z; pre[3] += below * (int)a.w; pre[4] += below * (int)b.x; pre[5] += below * (int)b.y; pre[6] += below * (int)b.z; pre[7] += below * (int)b.w; }
#pragma unroll
    for (int e = 0; e < 8; ++e) {
#pragma unroll
        for (int o = 1; o < 64; o <<= 1) { tot[e] += shxi(tot[e], o, l); pre[e] += shxi(pre[e], o, l); } }
    if (l == 0) {
#pragma unroll
        for (int e = 0; e < 8; ++e) { red[F.wave * 16 + e] = tot[e]; red[F.wave * 16 + 8 + e] = pre[e]; } }
    __syncthreads();
    int base[8]; int acc = 0;
#pragma unroll
    for (int e = 0; e < 8; ++e) { int t = 0, p = 0;
#pragma unroll
        for (int w = 0; w < NWAVES; ++w) { t += red[w * 16 + e]; p += red[w * 16 + 8 + e]; }
        int mine = 0;
#pragma unroll
        for (int w = 0; w < NWAVES; ++w) { const int c = CNTW[(size_t)(wg0 + w) * 8 + e]; mine += (w < F.wave) ? c : 0; }
        base[e] = acc * 256 + p + mine; acc += (t + 255) >> 8;
        if (F.vcu == 0 && F.tid == 0) TOT[e] = t; }
    __syncthreads();
    for (int m = F.gw; m < T; m += F.NGW) {
        int rows[2];
#pragma unroll
        for (int k = 0; k < 2; ++k) { const int e = TOKE[2 * m + k]; const int sl = TOKS[2 * m + k];
            const int bs = (e == 0) ? base[0] : (e == 1) ? base[1] : (e == 2) ? base[2] : (e == 3) ? base[3] : (e == 4) ? base[4] : (e == 5) ? base[5] : (e == 6) ? base[6] : base[7];
            rows[k] = bs + sl; }
#if MOE_FP8
        { const f32x4* xr = (const f32x4*)(F.a->out + (size_t)m * D) + l; int* g0 = (int*)((unsigned char*)XG + (size_t)rows[0] * D) + l; int* g1 = (int*)((unsigned char*)XG + (size_t)rows[1] * D) + l;
#pragma unroll
          for (int j = 0; j < 4; ++j) { const f32x4 v = xr[64 * j]; int w = __builtin_amdgcn_cvt_pk_fp8_f32(v[0], v[1], 0, false); w = __builtin_amdgcn_cvt_pk_fp8_f32(v[2], v[3], w, true); g0[64 * j] = w; g1[64 * j] = w; } }
#else
        const v4u a = XB[(size_t)m * 128 + l], b = XB[(size_t)m * 128 + 64 + l];
        XG[(size_t)rows[0] * 128 + l] = a; XG[(size_t)rows[0] * 128 + 64 + l] = b; XG[(size_t)rows[1] * 128 + l] = a; XG[(size_t)rows[1] * 128 + 64 + l] = b;
#endif
        if (l == 0) { TOKR[2 * m] = rows[0]; TOKR[2 * m + 1] = rows[1]; }
    }
}

__device__ __forceinline__ void phase_attn_diff(const Frame& F) {
    att::AttnP P; P.Q = WSP(bf16, A_DQ); P.ldq = 1024; P.K1 = WSP(bf16, A_DK); P.ldk1 = 1024; P.K2 = P.K1; P.ldk2 = 1024; P.V = WSP(bf16, A_DV); P.ldv = 1024; P.O = WSP(bf16, A_OA2); P.ldo = 2048;
    P.pos = (const int*)F.a->in[2]; P.blkmax = WSP(int, WS_MISC); P.lut = WSP(float, WS_MISC + 4096);
    for (int p = F.vcu; p < BATCH * 16 * 8; p += F.G) {
        const int bh = p >> 3, i = p & 7, b = bh >> 4, vh = bh & 15;
        att::ATT_UNIT<64, 64, 128, true>(P, b, 15 - i, vh * 64, vh * 64, (vh >> 1) * 128, vh * 128, vh >> 1, F.lds, F.tid);
        att::ATT_UNIT<64, 64, 128, true>(P, b, i, vh * 64, vh * 64, (vh >> 1) * 128, vh * 128, vh >> 1, F.lds, F.tid);
    }
}
__device__ __forceinline__ void phase_attn_mla(const Frame& F) {
    att::AttnP P; P.Q = WSP(bf16, A_MQ); P.ldq = 768; P.K1 = WSP(bf16, A_MKV); P.ldk1 = 1024; P.K2 = WSP(bf16, A_MKR); P.ldk2 = 32; P.V = WSP(bf16, A_MKV); P.ldv = 1024; P.O = WSP(bf16, A_OB); P.ldo = 512;
    P.pos = (const int*)F.a->in[2]; P.blkmax = WSP(int, WS_MISC); P.lut = WSP(float, WS_MISC + 4096);
    for (int p = F.vcu; p < BATCH * 8 * 8; p += F.G) {
        const int bh = p >> 3, i = p & 7, b = bh >> 3, hh = bh & 7;
        att::ATT_UNIT<96, 64, 64, false>(P, b, 15 - i, hh * 96, hh * 128, hh * 128 + 64, hh * 64, 0, F.lds, F.tid);
        att::ATT_UNIT<96, 64, 64, false>(P, b, i, hh * 96, hh * 128, hh * 128 + 64, hh * 64, 0, F.lds, F.tid);
    }
}

constexpr int NPH_DENSE = 10, NPH_MOE = 9 + 2 * MOE_NCHUNK, NPH_TOTAL = 1 + 2 * NPH_DENSE + 2 * NPH_MOE;
#define GEMM_CALL(EPI, SCHED, gm, S_, E_) pg8::gemm_phase<EPI, SCHED, true, true>(F.lds, gm, S_, E_, F.tid)

__global__ void __launch_bounds__(NWAVES * 64, 2) mega_fwd(Args args) {
    extern __shared__ __attribute__((aligned(16))) unsigned char lds_raw[];
    Frame F;
    F.lds = (LAS unsigned char*)lds_raw; F.a = &args; F.ws = args.ws;
    const int wave_s = __builtin_amdgcn_readfirstlane((int)threadIdx.x >> 6);
#define MY_TID() ({ unsigned m1_ = ~0u; asm volatile("" : "+s"(m1_)); ((wave_s << 6) | (int)__builtin_amdgcn_mbcnt_hi(m1_, __builtin_amdgcn_mbcnt_lo(m1_, 0u))); })
    F.tid = MY_TID(); F.lane = F.tid & 63; F.wave = wave_s;
    F.G = gridDim.x; { const int bx = blockIdx.x; F.vcu = (F.G % 8 == 0) ? (bx % 8) * (F.G / 8) + bx / 8 : bx; }
    F.gw = F.vcu * NWAVES + F.wave; F.NGW = F.G * NWAVES;
    volatile LAS unsigned* MISC = (volatile LAS unsigned*)(F.lds + MISC_OFF);
    for (int u = F.tid; u < (LDS_BYTES - RING_BYTES) / 4; u += NWAVES * 64) ((LAS unsigned*)(F.lds + RING_BYTES))[u] = 0u;
    __syncthreads();
    const int lo = args.ph_lo, hi = args.ph_hi;
    XcdBarrier bar; bar.bar = WSP(unsigned, WS_CTL) + CW_BAR; bar.x = 0; bar.st = nullptr;
    if (hi - lo > 1) bar = xcd_barrier_post(WSP(unsigned, WS_CTL) + CW_BAR, MISC + 8, F.tid == 0);
    int pc = 0;
#define PH_BEGIN if (pc >= lo && pc < hi) { { int t_ = MY_TID(); asm volatile("" : "+v"(t_)); F.tid = t_; F.lane = t_ & 63; F.wave = wave_s; F.gw = F.vcu * NWAVES + F.wave; }
#define PH_END if (pc + 1 < hi) { for (int rb = 0; rb < REP_BAR; ++rb) xcd_barrier(bar, F.tid == 0); } } ++pc;
    const int bx = (int)blockIdx.x;
    const float ALPHA = 1.6817928305074290f;

    PH_BEGIN for (int rep = 0; rep < REP_P0; ++rep) phase_prologue(F); PH_END

    for (int L = 0; L < DEPTH; ++L) {
        const int mj = L >> 1;
        PH_BEGIN {
            pg8::Gemm g{WSP(bf16, WS_XB), WSP(bf16, W_IN), T, NIN, D}; pg8::StaticOrder S; S.init(T, NIN, F.G, bx);
            pg8::EpiL1 E{WSP(bf16, A_DQ), WSP(bf16, A_G), WSP(float, A_CQ), INF(5) + L * 2048, 0.125f * LOG2E};
            for (int rep = 0; rep < REP_L1; ++rep) GEMM_CALL(pg8::EpiL1, pg8::StaticOrder, g, S, E);
        } PH_END
        PH_BEGIN for (int rep = 0; rep < REP_EW; ++rep) phase_rms_rope(F); PH_END
        PH_BEGIN {
            for (int rep = 0; rep < REP_MIX; ++rep) {
            { pg8::Gemm g{WSP(bf16, A_CQN), WSP(bf16, W_UQ), T, 768, QR}; pg8::StaticOrder S; S.init(T, 768, F.G, bx);
              pg8::EpiRopeQ E{WSP(bf16, A_MQ), WSP(float, WS_ROPE), 0.10206207261596577f * LOG2E};
              GEMM_CALL(pg8::EpiRopeQ, pg8::StaticOrder, g, S, E); }
            { pg8::Gemm g{WSP(bf16, A_CKVN), WSP(bf16, W_UKV), T, 1024, KVR}; pg8::StaticOrder S; S.init(T, 1024, F.G, bx);
              pg8::EpiBf16 E{WSP(bf16, A_MKV), 1024, 1.0f};
              GEMM_CALL(pg8::EpiBf16, pg8::StaticOrder, g, S, E); }
            }
            for (int rep = 0; rep < REP_ATTN_D; ++rep) phase_attn_diff(F);
        } PH_END
        PH_BEGIN { for (int rep = 0; rep < REP_ATTN_M; ++rep) phase_attn_mla(F); for (int rep = 0; rep < REP_EW; ++rep) phase_combine(F, L); } PH_END
        PH_BEGIN {
            for (int rep = 0; rep < REP_MIX; ++rep) {
            { pg8::Gemm g{WSP(bf16, A_OB), WSP(bf16, W_BM), T, D, 512}; pg8::StaticOrder S; S.init(T, D, F.G, bx);
              pg8::EpiGate<false> E{WSP(bf16, A_MT), WSP(bf16, A_G), nullptr, 1024};
              GEMM_CALL(pg8::EpiGate<false>, pg8::StaticOrder, g, S, E); }
            { pg8::Gemm g{WSP(bf16, A_OA), WSP(bf16, W_BD), T, D, D}; pg8::StaticOrder S; S.init(T, D, F.G, bx);
              pg8::EpiGate<true> E{WSP(bf16, A_M), WSP(bf16, A_G), WSP(bf16, A_MT), 0};
              GEMM_CALL(pg8::EpiGate<true>, pg8::StaticOrder, g, S, E); }
            }
        } PH_END
        PH_BEGIN {
            pg8::Gemm g{WSP(bf16, A_M), WSP(bf16, W_OUT), T, D, D}; pg8::StaticOrder S; S.init(T, D, F.G, bx);
            pg8::EpiF32<1> E{WSP(float, A_PRE), args.out, ALPHA};
            for (int rep = 0; rep < REP_MIX; ++rep) GEMM_CALL(pg8::EpiF32<1>, pg8::StaticOrder, g, S, E);
        } PH_END
        PH_BEGIN {
            if (L & 1) phase_ln<true, false>(F, WSP(float, A_PRE), INF(18) + L * D, INF(19) + L * D, INF(23) + (size_t)mj * D * NEXP, mj);
            else for (int rep = 0; rep < REP_LN; ++rep) phase_ln<false, false>(F, WSP(float, A_PRE), INF(18) + L * D, INF(19) + L * D, nullptr, 0);
        } PH_END
        if ((L & 1) == 0) {
            PH_BEGIN {
                for (int rep = 0; rep < REP_FFN; ++rep) {
                { pg8::Gemm g{WSP(bf16, WS_XB), WSP(bf16, W_F13), T, 2 * DENSE_FF, D}; pg8::StaticOrder S; S.init(T, 2 * DENSE_FF, F.G, bx);
                  pg8::EpiSwiGLU E{WSP(bf16, A_H), DENSE_FF};
                  GEMM_CALL(pg8::EpiSwiGLU, pg8::StaticOrder, g, S, E); }
                { pg8::Gemm g{WSP(bf16, WS_PB), WSP(bf16, W_PP), T, D, PLE}; pg8::StaticOrder S; S.init(T, D, F.G, bx);
                  pg8::EpiF32<0> E{WSP(float, A_PRE), nullptr, 0.f};
                  GEMM_CALL(pg8::EpiF32<0>, pg8::StaticOrder, g, S, E); }
                { pg8::Gemm g{WSP(bf16, WS_XB), WSP(bf16, W_PG), T, D, D}; pg8::StaticOrder S; S.init(T, D, F.G, bx);
                  pg8::EpiF32<2> E{WSP(float, A_PRE), args.out, ALPHA};
                  GEMM_CALL(pg8::EpiF32<2>, pg8::StaticOrder, g, S, E); }
                }
            } PH_END
            PH_BEGIN {
                pg8::Gemm g{WSP(bf16, A_H), WSP(bf16, W_F2D), T, D, DENSE_FF}; pg8::StaticOrder S; S.init(T, D, F.G, bx);
                pg8::EpiF32<3> E{WSP(float, A_PRE), nullptr, 0.f};
                GEMM_CALL(pg8::EpiF32<3>, pg8::StaticOrder, g, S, E);
            } PH_END
            PH_BEGIN { for (int rep = 0; rep < REP_LN; ++rep) phase_ln<false, false>(F, WSP(float, A_PRE), INF(29) + L * D, INF(30) + L * D, nullptr, 0); if (L + 1 < DEPTH) for (int rep = 0; rep < REP_CONV; ++rep) phase_convert(F, L + 1); } PH_END
        } else {
            PH_BEGIN {
                phase_scatter(F, mj);
                for (int rep = 0; rep < REP_PPE; ++rep) {
                { pg8::Gemm g{WSP(bf16, WS_PB), WSP(bf16, W_PP), T, D, PLE}; pg8::StaticOrder S; S.init(T, D, F.G, bx);
                  pg8::EpiF32<0> E{WSP(float, A_PREM), nullptr, 0.f};
                  GEMM_CALL(pg8::EpiF32<0>, pg8::StaticOrder, g, S, E); }
                { pg8::Gemm g{WSP(bf16, WS_XB), WSP(bf16, W_PG), T, D, D}; pg8::StaticOrder S; S.init(T, D, F.G, bx);
                  pg8::EpiF32<2> E{WSP(float, A_PREM), args.out, ALPHA};
                  GEMM_CALL(pg8::EpiF32<2>, pg8::StaticOrder, g, S, E); }
                }
            } PH_END
            for (int ch = 0; ch < MOE_NCHUNK; ++ch) {
                PH_BEGIN {
                    MoeTiles mt; moe_tiles(F, mj, mt);
                    const int tlo = ch * MOE_CHUNK_TILES; int ntc = mt.total - tlo; ntc = ntc > MOE_CHUNK_TILES ? MOE_CHUNK_TILES : ntc;
                    if (ntc > 0) {
#if MOE_FP8
                        pg8::Gemm g{WSP(bf16, A_XG), WSP(bf16, W_F13), ntc * 256, 2 * EXPERT_FF, D / 2};
                        pg8::GroupedOrder S; S.init(ntc * 256, 2 * EXPERT_FF, F.G, bx); S.tile_lo = tlo; S.estride = (size_t)2 * EXPERT_FF * D;
#else
                        pg8::Gemm g{WSP(bf16, A_XG) + (size_t)tlo * 256 * D, WSP(bf16, W_F13), ntc * 256, 2 * EXPERT_FF, D};
                        pg8::GroupedOrder S; S.init(ntc * 256, 2 * EXPERT_FF, F.G, bx); S.tile_lo = tlo; S.estride = (size_t)2 * EXPERT_FF * D * 2;
#endif
                        S.pend0 = mt.pend[0]; S.pend1 = mt.pend[1]; S.pend2 = mt.pend[2]; S.pend3 = mt.pend[3]; S.pend4 = mt.pend[4]; S.pend5 = mt.pend[5]; S.pend6 = mt.pend[6]; S.pend7 = mt.pend[7];
#if MOE_FP8
                        pg8::EpiSwiGLU8 E{WSP(unsigned char, A_HG), EXPERT_FF, 1.0f / 32.0f};
                        for (int rep = 0; rep < REP_MOE; ++rep) pg8::gemm_phase8<pg8::EpiSwiGLU8, pg8::GroupedOrder, true, F8_SP2>(F.lds, g, S, E, 0x7F7F7F7F, F.tid);
#else
                        pg8::EpiSwiGLU E{WSP(bf16, A_HG), EXPERT_FF};
                        for (int rep = 0; rep < REP_MOE; ++rep) GEMM_CALL(pg8::EpiSwiGLU, pg8::GroupedOrder, g, S, E);
#endif
                    }
                } PH_END
                PH_BEGIN {
                    MoeTiles mt; moe_tiles(F, mj, mt);
                    const int tlo = ch * MOE_CHUNK_TILES; int ntc = mt.total - tlo; ntc = ntc > MOE_CHUNK_TILES ? MOE_CHUNK_TILES : ntc;
                    if (ntc > 0) {
#if MOE_FP8
                        pg8::Gemm g{WSP(bf16, A_HG), WSP(bf16, W_F2E), ntc * 256, D, EXPERT_FF / 2};
                        pg8::GroupedOrder S; S.init(ntc * 256, D, F.G, bx); S.tile_lo = tlo; S.estride = (size_t)D * EXPERT_FF;
#else
                        pg8::Gemm g{WSP(bf16, A_HG), WSP(bf16, W_F2E), ntc * 256, D, EXPERT_FF};
                        pg8::GroupedOrder S; S.init(ntc * 256, D, F.G, bx); S.tile_lo = tlo; S.estride = (size_t)D * EXPERT_FF * 2;
#endif
                        S.pend0 = mt.pend[0]; S.pend1 = mt.pend[1]; S.pend2 = mt.pend[2]; S.pend3 = mt.pend[3]; S.pend4 = mt.pend[4]; S.pend5 = mt.pend[5]; S.pend6 = mt.pend[6]; S.pend7 = mt.pend[7];
                        pg8::EpiBf16 E{WSP(bf16, A_YG) + (size_t)tlo * 256 * D, D, MOE_FP8 ? 1.0f / 128.0f : 1.0f};
#if MOE_FP8
                        for (int rep = 0; rep < REP_MOE; ++rep) pg8::gemm_phase8<pg8::EpiBf16, pg8::GroupedOrder, true, F8_SP2>(F.lds, g, S, E, 0x7F7F7F7F, F.tid);
#else
                        for (int rep = 0; rep < REP_MOE; ++rep) GEMM_CALL(pg8::EpiBf16, pg8::GroupedOrder, g, S, E);
#endif
                    }
                } PH_END
            }
            PH_BEGIN { for (int rep = 0; rep < REP_LN; ++rep) phase_ln<false, true>(F, WSP(float, A_PREM), INF(29) + L * D, INF(30) + L * D, nullptr, 0); if (L + 1 < DEPTH) for (int rep = 0; rep < REP_CONV; ++rep) phase_convert(F, L + 1); } PH_END
        }
    }
#undef PH_BEGIN
#undef PH_END
}

extern "C" void kernel_launch(void* const* d_in, const int* in_sizes, int n_in, void* d_out, int out_size, void* d_ws, size_t ws_size, hipStream_t stream) {
    static int grid = 0;
    if (grid == 0) {
        if (n_in != 31 || in_sizes[0] != T * D || out_size != T * D || ws_size < WS_END) { fprintf(stderr, "kernel_launch: unexpected shapes / workspace (n_in %d, ws %zu < %zu)\n", n_in, ws_size, (size_t)WS_END); grid = -1; return; }
        int dev = 0, cus = 0, per_cu = 0;
        if (hipGetDevice(&dev) != hipSuccess || hipDeviceGetAttribute(&cus, hipDeviceAttributeMultiprocessorCount, dev) != hipSuccess) { grid = -1; return; }
        if (hipFuncSetAttribute((const void*)mega_fwd, hipFuncAttributeMaxDynamicSharedMemorySize, LDS_BYTES) != hipSuccess) { fprintf(stderr, "kernel_launch: hipFuncSetAttribute failed\n"); grid = -1; return; }
        if (hipOccupancyMaxActiveBlocksPerMultiprocessor(&per_cu, (const void*)mega_fwd, NWAVES * 64, LDS_BYTES) != hipSuccess || per_cu < 1) { fprintf(stderr, "kernel_launch: occupancy query says %d\n", per_cu); (void)hipGetLastError(); grid = -1; return; }
        grid = cus;
    }
    if (grid < 0) return;
    if (hipMemsetAsync((char*)d_ws + WS_CTL, 0, CTL_ZERO_BYTES, stream) != hipSuccess) return;
    Args a{};
    for (int i = 0; i < 31; ++i) a.in[i] = d_in[i];
    a.out = (float*)d_out; a.ws = (unsigned char*)d_ws;
#if MK_PER_PHASE
    for (int p = 0; p < NPH_TOTAL; ++p) { a.ph_lo = p; a.ph_hi = p + 1; hipLaunchKernelGGL(mega_fwd, dim3(grid), dim3(NWAVES * 64), LDS_BYTES, stream, a); }
#else
    a.ph_lo = 0; a.ph_hi = NPH_TOTAL;
    hipLaunchKernelGGL(mega_fwd, dim3(grid), dim3(NWAVES * 64), LDS_BYTES, stream, a);
#endif
}
```

```cpp
#include <hip/hip_runtime.h>
#include <cstdio>
#include <cstdint>
#include <cmath>

#ifndef MK_PER_PHASE
#define MK_PER_PHASE 0
#endif

constexpr int BATCH = 8, SEQ = 4096, T = BATCH * SEQ, D = 1024, DEPTH = 4, PLE = 256;
constexpr int IN_COLS = 5792, NIN = 5888, NIN_B = 3840;
constexpr int QR = 384, KVR = 256, ROPE_D = 32;
constexpr int DENSE_FF = 2816, EXPERT_FF = 3584, NEXP = 8;
constexpr float LN_EPS = 1e-5f;
constexpr float LOG2E = 1.4426950408889634f;
constexpr int MOE_ROWS = 2 * T + NEXP * 256;
constexpr int MOE_CHUNK_TILES = MOE_ROWS / 256;
constexpr int MOE_NCHUNK = 1;
#ifndef MOE_FP8
#define MOE_FP8 1
#endif

#define GAS __attribute__((address_space(1)))
#define LAS __attribute__((address_space(3)))
typedef unsigned short bf16;
typedef unsigned v4u __attribute__((ext_vector_type(4)));
typedef unsigned v2u __attribute__((ext_vector_type(2)));
typedef float f32x4 __attribute__((ext_vector_type(4)));
typedef float f32x2 __attribute__((ext_vector_type(2)));
typedef float f32x16 __attribute__((ext_vector_type(16)));
typedef short bf16x8 __attribute__((ext_vector_type(8)));
typedef short s16x4 __attribute__((ext_vector_type(4)));
typedef __bf16 bf16x2_t __attribute__((ext_vector_type(2)));
typedef GAS unsigned gu32;
#define RLX_AGENT __ATOMIC_RELAXED, __HIP_MEMORY_SCOPE_AGENT
#define LDS_WAIT() asm volatile("s_waitcnt lgkmcnt(0)" ::: "memory")
#define VM_WAIT() asm volatile("s_waitcnt vmcnt(0)" ::: "memory")

__device__ __forceinline__ unsigned pk2(float lo, float hi) { f32x2 v = {lo, hi}; bf16x2_t b = __builtin_convertvector(v, bf16x2_t); return __builtin_bit_cast(unsigned, b); }
__device__ __forceinline__ float bflo(unsigned u) { return __uint_as_float(u << 16); }
__device__ __forceinline__ float bfhi(unsigned u) { return __uint_as_float(u & 0xffff0000u); }
__device__ __forceinline__ float sigmoidf_(float x) { return __builtin_amdgcn_rcpf(1.0f + __builtin_amdgcn_exp2f(-x * LOG2E)); }
__device__ __forceinline__ float shx(float v, int o, int lane) { return __uint_as_float((unsigned)__builtin_amdgcn_ds_bpermute((lane ^ o) << 2, (int)__float_as_uint(v))); }
__device__ __forceinline__ int shxi(int v, int o, int lane) { return __builtin_amdgcn_ds_bpermute((lane ^ o) << 2, v); }
__device__ __forceinline__ float wave_sum(int lane, float v) {
#pragma unroll
    for (int o = 1; o < 64; o <<= 1) v += shx(v, o, lane);
    return v;
}

#ifndef GATE_U8
#define GATE_U8 1
#endif
#define PG8_PAIR16(A_, B_) do { const auto r0_ = __builtin_amdgcn_permlane16_swap((A_).x, (B_).x, false, false); (A_).x = r0_[0]; (B_).x = r0_[1]; \
                               const auto r1_ = __builtin_amdgcn_permlane16_swap((A_).y, (B_).y, false, false); (A_).y = r1_[0]; (B_).y = r1_[1]; } while (0)
namespace pg8 {
#define PG8_LAS __attribute__((address_space(3)))
typedef unsigned short bf16_t;
typedef unsigned u32x4 __attribute__((ext_vector_type(4)));
typedef unsigned u32x2 __attribute__((ext_vector_type(2)));
constexpr int BM = 256, BK = 64, HALF = 128, HTB = HALF * BK * 2  , STAGE_BYTES = 8 * HTB, NXCD = 8, WGM = 8;

__host__ __device__ __forceinline__ int lds_byte(int r, int c) { const int st = (r >> 4) * 2 + (c >> 5), rr = r & 15, cc = c & 31, ob = rr * 64 + cc * 2; return st * 1024 + (ob ^ (((ob >> 9) & 1) << 5)); }
__host__ __device__ __forceinline__ void stage_rc(int b, int& R, int& C) { const int st = b / 1024, sb = b % 1024, swz = sb ^ (((sb >> 9) & 1) << 5); R = (st >> 1) * 16 + swz / 64; C = (st & 1) * 32 + (swz % 64) / 2; }
__host__ __device__ __forceinline__ int perm32(int rho) { const int n = rho >> 4, i = rho & 15; return 8 * (i >> 2) + 4 * n + (i & 3); }

struct Unit { int pm, pn; };
struct Gemm { const bf16_t* A; const bf16_t* Bt; int M, N, K; };

struct StaticOrder {
    int nM, nN, nwg, G, c;
    __host__ __device__ void init(int M, int N, int G_, int c_) { nM = M / BM; nN = N / BM; nwg = nM * nN; G = G_; c = c_; }
    __host__ __device__ bool next(int i, Unit& u) const {
        const long L = (long)i * G + c; if (L >= nwg) return false;
        int wgid = (int)L; { const int q = nwg / NXCD, r = nwg % NXCD, xcd = wgid % NXCD, off = wgid / NXCD; wgid = (xcd < r ? xcd * (q + 1) : r * (q + 1) + (xcd - r) * q) + off; }
        const int nig = WGM * nN, gid = wgid / nig, fm = gid * WGM, gsz = (nM - fm) < WGM ? (nM - fm) : WGM;
        u.pm = fm + ((wgid % nig) % gsz); u.pn = (wgid % nig) / gsz; return true;
    }
    __device__ __forceinline__ size_t bofs(const Unit&) const { return 0; }
    __device__ __forceinline__ void a_ready(const Unit&) const {}
    __device__ __forceinline__ void done(const Unit&) const {}
};
struct UnevenOrder : StaticOrder {
    int cut, lo, hi;
    __host__ __device__ bool next(int i, Unit& u) const {
        long L;
        if (i < lo) L = (long)i * G + c;
        else if (c >= cut && i < hi) L = (long)lo * G + (long)(c - cut) * (hi - lo) + (i - lo);
        else return false;
        if (L >= nwg) return false;
        int wgid = (int)L; { const int q = nwg / NXCD, r = nwg % NXCD, xcd = wgid % NXCD, off = wgid / NXCD; wgid = (xcd < r ? xcd * (q + 1) : r * (q + 1) + (xcd - r) * q) + off; }
        const int nig = WGM * nN, gid = wgid / nig, fm = gid * WGM, gsz = (nM - fm) < WGM ? (nM - fm) : WGM;
        u.pm = fm + ((wgid % nig) % gsz); u.pn = (wgid % nig) / gsz; return true;
    }
};
struct GroupedOrder : StaticOrder {
    int tile_lo; int pend0, pend1, pend2, pend3, pend4, pend5, pend6, pend7; size_t estride;
    __device__ __forceinline__ size_t bofs(const Unit& u) const {
        const int t = u.pm + tile_lo;
        const int e = (t >= pend0) + (t >= pend1) + (t >= pend2) + (t >= pend3) + (t >= pend4) + (t >= pend5) + (t >= pend6);
        return (size_t)e * estride;
    }
};

typedef f32x4 Acc[2][2][4][2];

struct EpiL1 {
    static constexpr bool PERM = true, AFTER_DRAIN = false;
    bf16_t* QKV; bf16_t* CQR; bf16_t* CKVR; bf16_t* MKR; float* SSP; const float* rope; float qscale; int pn_off;
    __device__ __forceinline__ void operator()(const Acc& acc, const Unit& u, int wr, int wc, int fr, int fq) const {
        const int row0 = u.pm * BM + wr * 64 + fr; const int pn = u.pn + pn_off;
        if (pn < 12) {
            bf16_t* base = QKV + (size_t)(pn >> 2) * ((size_t)T * 1024); const int col0 = (pn & 3) * 256 + wc * 32 + 8 * fq; const float sc = pn < 4 ? qscale : 1.f;
#pragma unroll
            for (int ai = 0; ai < 2; ++ai)
#pragma unroll
                for (int m = 0; m < 4; ++m) { bf16_t* rowp = base + (size_t)(row0 + ai * HALF + m * 16) * 1024 + col0;
#pragma unroll
                    for (int bj = 0; bj < 2; ++bj) { const f32x4 v0 = acc[ai][bj][m][0] * sc, v1 = acc[ai][bj][m][1] * sc;
                        u32x4 w; w.x = pk2(v0[0], v0[1]); w.y = pk2(v0[2], v0[3]); w.z = pk2(v1[0], v1[1]); w.w = pk2(v1[2], v1[3]);
                        *(u32x4*)(rowp + bj * HALF) = w; } }
            return;
        }
        const int lane = fr | (fq << 4), cl = wc * 32 + 8 * fq;
#pragma unroll
        for (int ai = 0; ai < 2; ++ai)
#pragma unroll
            for (int m = 0; m < 4; ++m) { const size_t row = (size_t)(row0 + ai * HALF + m * 16);
                float p[2];
#pragma unroll
                for (int bj = 0; bj < 2; ++bj) { const f32x4 v0 = acc[ai][bj][m][0], v1 = acc[ai][bj][m][1];
                    p[bj] = ((v0[0] * v0[0] + v0[1] * v0[1]) + (v0[2] * v0[2] + v0[3] * v0[3])) + ((v1[0] * v1[0] + v1[1] * v1[1]) + (v1[2] * v1[2] + v1[3] * v1[3]));
                    u32x4 w; w.x = pk2(v0[0], v0[1]); w.y = pk2(v0[2], v0[3]); w.z = pk2(v1[0], v1[1]); w.w = pk2(v1[2], v1[3]);
                    if (pn == 12) *(u32x4*)(CQR + row * 384 + bj * HALF + cl) = w;
                    else if (pn == 13) { if (bj == 0) *(u32x4*)(CQR + row * 384 + 256 + cl) = w; else *(u32x4*)(CKVR + row * 256 + cl) = w; }
                    else if (bj == 0) *(u32x4*)(CKVR + row * 256 + HALF + cl) = w; }
                if (pn == 12) { p[0] += p[1]; p[1] = 0.f; }
                p[0] += shx(p[0], 16, lane); p[0] += shx(p[0], 32, lane);
                if (pn == 13) { p[1] += shx(p[1], 16, lane); p[1] += shx(p[1], 32, lane); }
                if (fq == 0) { float* sp = SSP + row * 16 + wc;
                    if (pn == 12) sp[0] = p[0]; else if (pn == 13) { sp[4] = p[0]; sp[8] = p[1]; } else sp[12] = p[0]; }
                if (pn == 14 && wc == 0) {
                    const f32x4 v0 = acc[ai][1][m][0], v1 = acc[ai][1][m][1]; float mine[8] = {v0[0], v0[1], v0[2], v0[3], v1[0], v1[1], v1[2], v1[3]}, oth[8];
#pragma unroll
                    for (int i = 0; i < 8; ++i) oth[i] = shx(mine[i], 32, lane);
                    const float* rp = rope + row * 32 + 16 * (fq & 1);
                    const f32x4 r0 = *(const f32x4*)rp, r1 = *(const f32x4*)(rp + 4), r2 = *(const f32x4*)(rp + 8), r3 = *(const f32x4*)(rp + 12);
                    const float cs[8] = {r0[0], r0[2], r1[0], r1[2], r2[0], r2[2], r3[0], r3[2]}, sn[8] = {r0[1], r0[3], r1[1], r1[3], r2[1], r2[3], r3[1], r3[3]};
                    float o[8];
#pragma unroll
                    for (int i = 0; i < 8; ++i) o[i] = (fq < 2) ? mine[i] * cs[i] - oth[i] * sn[i] : oth[i] * sn[i] + mine[i] * cs[i];
                    u32x4 w; w.x = pk2(o[0], o[1]); w.y = pk2(o[2], o[3]); w.z = pk2(o[4], o[5]); w.w = pk2(o[6], o[7]);
                    *(u32x4*)(MKR + row * 32 + 8 * fq) = w; }
            }
    }
};
struct EpiGates8 {
    static constexpr bool PERM = true, AFTER_DRAIN = false;
    bf16_t* Gt; const float* bgate; float isc;
    __device__ __forceinline__ void operator()(const Acc& acc, const Unit& u, int wr, int wc, int fr, int fq) const {
        const int row0 = u.pm * BM + wr * 64 + fr; const int col0 = u.pn * 256 + wc * 32 + 8 * fq;
        f32x4 bv[2][2];
#pragma unroll
        for (int bj = 0; bj < 2; ++bj)
#pragma unroll
            for (int n = 0; n < 2; ++n) bv[bj][n] = *(const f32x4*)(bgate + col0 + bj * HALF + 4 * n);
#pragma unroll
        for (int ai = 0; ai < 2; ++ai)
#pragma unroll
            for (int m = 0; m < 4; ++m) { bf16_t* rowp = Gt + (size_t)(row0 + ai * HALF + m * 16) * 2048 + col0;
#pragma unroll
                for (int bj = 0; bj < 2; ++bj) { const f32x4 v0 = acc[ai][bj][m][0] * isc + bv[bj][0], v1 = acc[ai][bj][m][1] * isc + bv[bj][1];
                    u32x4 w; w.x = pk2(sigmoidf_(v0[0]), sigmoidf_(v0[1])); w.y = pk2(sigmoidf_(v0[2]), sigmoidf_(v0[3])); w.z = pk2(sigmoidf_(v1[0]), sigmoidf_(v1[1])); w.w = pk2(sigmoidf_(v1[2]), sigmoidf_(v1[3]));
                    *(u32x4*)(rowp + bj * HALF) = w; } }
    }
};
struct EpiQkvG8 {
    static constexpr bool PERM = true, AFTER_DRAIN = false;
    bf16_t* QKV; bf16_t* Gt; const float* bgate; float qscale, isc;
    __device__ __forceinline__ void operator()(const Acc& acc, const Unit& u, int wr, int wc, int fr, int fq) const {
        const int row0 = u.pm * BM + wr * 64 + fr; const int pn = u.pn;
        if (pn < 12) {
            bf16_t* base = QKV + (size_t)(pn >> 2) * ((size_t)T * 1024); const int col0 = (pn & 3) * 256 + wc * 32 + 8 * fq; const float sc = (pn < 4 ? qscale : 1.f) * isc;
#pragma unroll
            for (int ai = 0; ai < 2; ++ai)
#pragma unroll
                for (int m = 0; m < 4; ++m) { bf16_t* rowp = base + (size_t)(row0 + ai * HALF + m * 16) * 1024 + col0;
#pragma unroll
                    for (int bj = 0; bj < 2; ++bj) { const f32x4 v0 = acc[ai][bj][m][0] * sc, v1 = acc[ai][bj][m][1] * sc;
                        u32x4 w; w.x = pk2(v0[0], v0[1]); w.y = pk2(v0[2], v0[3]); w.z = pk2(v1[0], v1[1]); w.w = pk2(v1[2], v1[3]);
                        *(u32x4*)(rowp + bj * HALF) = w; } }
            return;
        }
        const int col0 = (pn - 12) * 256 + wc * 32 + 8 * fq;
        f32x4 bv[2][2];
#pragma unroll
        for (int bj = 0; bj < 2; ++bj)
#pragma unroll
            for (int n = 0; n < 2; ++n) bv[bj][n] = *(const f32x4*)(bgate + col0 + bj * HALF + 4 * n);
#if GATE_U8
        unsigned char* G8 = (unsigned char*)Gt;
        const int rowg = row0 + (fq & 1) * 16, colg = (pn - 12) * 256 + wc * 32 + 8 * (fq & ~1);
#define G8Q_(x) ((unsigned)(sigmoidf_(x) * 255.0f + 0.5f))
#pragma unroll
        for (int ai = 0; ai < 2; ++ai)
#pragma unroll
            for (int mp = 0; mp < 2; ++mp)
#pragma unroll
                for (int bj = 0; bj < 2; ++bj) { u32x2 w[2];
#pragma unroll
                    for (int e = 0; e < 2; ++e) { const int m = 2 * mp + e; const f32x4 v0 = acc[ai][bj][m][0] * isc + bv[bj][0], v1 = acc[ai][bj][m][1] * isc + bv[bj][1];
                        w[e].x = G8Q_(v0[0]) | (G8Q_(v0[1]) << 8) | (G8Q_(v0[2]) << 16) | (G8Q_(v0[3]) << 24); w[e].y = G8Q_(v1[0]) | (G8Q_(v1[1]) << 8) | (G8Q_(v1[2]) << 16) | (G8Q_(v1[3]) << 24); }
                    PG8_PAIR16(w[0], w[1]);
                    u32x4 q; q.x = w[0].x; q.y = w[0].y; q.z = w[1].x; q.w = w[1].y;
                    *(u32x4*)(G8 + (size_t)(rowg + ai * HALF + mp * 32) * 2048 + colg + bj * HALF) = q; }
#undef G8Q_
#else
#pragma unroll
        for (int ai = 0; ai < 2; ++ai)
#pragma unroll
            for (int m = 0; m < 4; ++m) { bf16_t* rowp = Gt + (size_t)(row0 + ai * HALF + m * 16) * 2048 + col0;
#pragma unroll
                for (int bj = 0; bj < 2; ++bj) { const f32x4 v0 = acc[ai][bj][m][0] * isc + bv[bj][0], v1 = acc[ai][bj][m][1] * isc + bv[bj][1];
                    u32x4 w; w.x = pk2(sigmoidf_(v0[0]), sigmoidf_(v0[1])); w.y = pk2(sigmoidf_(v0[2]), sigmoidf_(v0[3])); w.z = pk2(sigmoidf_(v1[0]), sigmoidf_(v1[1])); w.w = pk2(sigmoidf_(v1[2]), sigmoidf_(v1[3]));
                    *(u32x4*)(rowp + bj * HALF) = w; } }
#endif
    }
};
struct EpiRopeQ {
    static constexpr bool PERM = false, AFTER_DRAIN = false;
    bf16_t* O; const float* rope; float qscale; const float* SSP;
    __device__ __forceinline__ void operator()(const Acc& acc, const Unit& u, int wr, int wc, int fr, int fq) const {
        const int row0 = u.pm * BM + wr * 64 + fr;
        float rsq[2][4];
#pragma unroll
        for (int ai = 0; ai < 2; ++ai) { f32x4 sa[4], sb[4];
#pragma unroll
            for (int m = 0; m < 4; ++m) { const float* sp = SSP + (size_t)(row0 + ai * HALF + m * 16) * 16; sa[m] = *(const f32x4*)sp; sb[m] = *(const f32x4*)(sp + 4); }
#pragma unroll
            for (int m = 0; m < 4; ++m) { const f32x4 t = sa[m] + sb[m]; rsq[ai][m] = qscale / sqrtf(((t[0] + t[1]) + (t[2] + t[3])) * (1.0f / 384.0f) + LN_EPS); } }
        f32x4 c0[2][4], c1[2][4];
#pragma unroll
        for (int ai = 0; ai < 2; ++ai)
#pragma unroll
            for (int m = 0; m < 4; ++m) { const int row = row0 + ai * HALF + m * 16; c0[ai][m] = *(const f32x4*)(rope + (size_t)row * 32 + fq * 8); c1[ai][m] = *(const f32x4*)(rope + (size_t)row * 32 + fq * 8 + 4); }
#pragma unroll
        for (int ai = 0; ai < 2; ++ai)
#pragma unroll
            for (int m = 0; m < 4; ++m) { const int row = row0 + ai * HALF + m * 16;
                const f32x4 cs0 = c0[ai][m], cs1 = c1[ai][m];
                const f32x4 cc = {cs0[0], cs0[2], cs1[0], cs1[2]}, ss = {cs0[1], cs0[3], cs1[1], cs1[3]};
#pragma unroll
                for (int bj = 0; bj < 2; ++bj) { const int colg = u.pn * BM + bj * HALF + wc * 32; const bool isr = ((colg >> 5) % 3) == 2;
                    const f32x4 x1 = acc[ai][bj][m][0], x2 = acc[ai][bj][m][1];
                    f32x4 o1 = x1, o2 = x2; if (isr) { o1 = x1 * cc - x2 * ss; o2 = x1 * ss + x2 * cc; }
                    o1 = o1 * rsq[ai][m]; o2 = o2 * rsq[ai][m];
                    bf16_t* p = O + (size_t)row * 768 + colg + 4 * fq;
                    u32x2 w1; w1.x = pk2(o1[0], o1[1]); w1.y = pk2(o1[2], o1[3]); u32x2 w2; w2.x = pk2(o2[0], o2[1]); w2.y = pk2(o2[2], o2[3]);
                    *(u32x2*)p = w1; *(u32x2*)(p + 16) = w2; } }
    }
};
struct EpiBf16 {
    static constexpr bool PERM = true, AFTER_DRAIN = false;
    bf16_t* O; int ldc; float osc;
    __device__ __forceinline__ void operator()(const Acc& acc, const Unit& u, int wr, int wc, int fr, int fq) const {
        const int row0 = u.pm * BM + wr * 64 + fr, col0 = u.pn * BM + wc * 32 + 8 * fq;
#pragma unroll
        for (int ai = 0; ai < 2; ++ai)
#pragma unroll
            for (int m = 0; m < 4; ++m) { bf16_t* rowp = O + (size_t)(row0 + ai * HALF + m * 16) * ldc + col0;
#pragma unroll
                for (int bj = 0; bj < 2; ++bj) { const f32x4 v0 = acc[ai][bj][m][0] * osc, v1 = acc[ai][bj][m][1] * osc;
                    u32x4 w; w.x = pk2(v0[0], v0[1]); w.y = pk2(v0[2], v0[3]); w.z = pk2(v1[0], v1[1]); w.w = pk2(v1[2], v1[3]);
                    *(u32x4*)(rowp + bj * HALF) = w; } }
    }
};
struct EpiBf16Rs {
    static constexpr bool PERM = true, AFTER_DRAIN = false;
    bf16_t* O; int ldc; const float* SSP;
    __device__ __forceinline__ void operator()(const Acc& acc, const Unit& u, int wr, int wc, int fr, int fq) const {
        const int row0 = u.pm * BM + wr * 64 + fr, col0 = u.pn * BM + wc * 32 + 8 * fq;
        float rsq[2][4];
#pragma unroll
        for (int ai = 0; ai < 2; ++ai) { f32x4 sa[4], sb[4];
#pragma unroll
            for (int m = 0; m < 4; ++m) { const float* sp = SSP + (size_t)(row0 + ai * HALF + m * 16) * 16 + 8; sa[m] = *(const f32x4*)sp; sb[m] = *(const f32x4*)(sp + 4); }
#pragma unroll
            for (int m = 0; m < 4; ++m) { const f32x4 t = sa[m] + sb[m]; rsq[ai][m] = 1.0f / sqrtf(((t[0] + t[1]) + (t[2] + t[3])) * (1.0f / 256.0f) + LN_EPS); } }
#pragma unroll
        for (int ai = 0; ai < 2; ++ai)
#pragma unroll
            for (int m = 0; m < 4; ++m) { bf16_t* rowp = O + (size_t)(row0 + ai * HALF + m * 16) * ldc + col0; const float osc = rsq[ai][m];
#pragma unroll
                for (int bj = 0; bj < 2; ++bj) { const f32x4 v0 = acc[ai][bj][m][0] * osc, v1 = acc[ai][bj][m][1] * osc;
                    u32x4 w; w.x = pk2(v0[0], v0[1]); w.y = pk2(v0[2], v0[3]); w.z = pk2(v1[0], v1[1]); w.w = pk2(v1[2], v1[3]);
                    *(u32x4*)(rowp + bj * HALF) = w; } }
    }
};
template <bool ADD> struct EpiGate {
    static constexpr bool PERM = true, AFTER_DRAIN = false;
    bf16_t* O; const bf16_t* Gt; const bf16_t* MT; int goff;
    __device__ __forceinline__ void operator()(const Acc& acc, const Unit& u, int wr, int wc, int fr, int fq) const {
        const int row0 = u.pm * BM + wr * 64 + fr, col0 = u.pn * BM + wc * 32 + 8 * fq;
#pragma unroll
        for (int ai = 0; ai < 2; ++ai) {
#if GATE_U8
            u32x2 gq[4][2]; u32x4 mq[4][2];
#else
            u32x4 gq[4][2], mq[4][2];
#endif
#pragma unroll
            for (int m = 0; m < 4; ++m)
#pragma unroll
                for (int bj = 0; bj < 2; ++bj) { const size_t row = (size_t)(row0 + ai * HALF + m * 16); const int col = col0 + bj * HALF;
#if GATE_U8
                    gq[m][bj] = *(const u32x2*)((const unsigned char*)Gt + row * 2048 + goff + col);
#else
                    gq[m][bj] = *(const u32x4*)(Gt + row * 2048 + goff + col);
#endif
                    if (ADD) mq[m][bj] = *(const u32x4*)(MT + row * 1024 + col); }
#pragma unroll
            for (int m = 0; m < 4; ++m)
#pragma unroll
                for (int bj = 0; bj < 2; ++bj) { const size_t row = (size_t)(row0 + ai * HALF + m * 16); const int col = col0 + bj * HALF;
                    f32x4 v0 = acc[ai][bj][m][0], v1 = acc[ai][bj][m][1];
#if GATE_U8
                    { const u32x2 gv = gq[m][bj]; const float k255 = 1.0f / 255.0f;
                      v0[0] *= (float)(gv.x & 0xffu) * k255; v0[1] *= (float)((gv.x >> 8) & 0xffu) * k255; v0[2] *= (float)((gv.x >> 16) & 0xffu) * k255; v0[3] *= (float)(gv.x >> 24) * k255;
                      v1[0] *= (float)(gv.y & 0xffu) * k255; v1[1] *= (float)((gv.y >> 8) & 0xffu) * k255; v1[2] *= (float)((gv.y >> 16) & 0xffu) * k255; v1[3] *= (float)(gv.y >> 24) * k255; }
#else
                    { const u32x4 gv = gq[m][bj];
                      v0[0] *= bflo(gv.x); v0[1] *= bfhi(gv.x); v0[2] *= bflo(gv.y); v0[3] *= bfhi(gv.y); v1[0] *= bflo(gv.z); v1[1] *= bfhi(gv.z); v1[2] *= bflo(gv.w); v1[3] *= bfhi(gv.w); }
#endif
                    if (ADD) { const u32x4 mv = mq[m][bj];
                        v0[0] += bflo(mv.x); v0[1] += bfhi(mv.x); v0[2] += bflo(mv.y); v0[3] += bfhi(mv.y); v1[0] += bflo(mv.z); v1[1] += bfhi(mv.z); v1[2] += bflo(mv.w); v1[3] += bfhi(mv.w); }
                    u32x4 w; w.x = pk2(v0[0], v0[1]); w.y = pk2(v0[2], v0[3]); w.z = pk2(v1[0], v1[1]); w.w = pk2(v1[2], v1[3]);
                    *(u32x4*)(O + row * 1024 + col) = w; }
        }
    }
};
template <int MODE> struct EpiPre {
    static constexpr bool PERM = true, AFTER_DRAIN = false;
    bf16_t* P; const bf16_t* XB; float alpha; float asc;
    __device__ __forceinline__ void operator()(const Acc& acc, const Unit& u, int wr, int wc, int fr, int fq) const {
        const int row0 = u.pm * BM + wr * 64 + fr, col0 = u.pn * BM + wc * 32 + 8 * fq;
        const float kk_ = -asc * LOG2E;
#define SG_(x) __builtin_amdgcn_rcpf(1.0f + __builtin_amdgcn_exp2f((x) * kk_))
#pragma unroll
        for (int ai = 0; ai < 2; ++ai)
#pragma unroll
          for (int mh = 0; mh < 2; ++mh) {
            u32x4 xq[2][2], pq[2][2];
#pragma unroll
            for (int mm = 0; mm < 2; ++mm)
#pragma unroll
                for (int bj = 0; bj < 2; ++bj) { const int m = 2 * mh + mm; const size_t o = (size_t)(row0 + ai * HALF + m * 16) * 1024 + col0 + bj * HALF;
                    if (MODE == 1 || MODE == 2) xq[mm][bj] = *(const u32x4*)(XB + o);
                    if (MODE == 2 || MODE == 3) pq[mm][bj] = *(const u32x4*)(P + o); }
            __builtin_amdgcn_sched_barrier(0);
#pragma unroll
            for (int mm = 0; mm < 2; ++mm)
#pragma unroll
                for (int bj = 0; bj < 2; ++bj) { const int m = 2 * mh + mm; const size_t o = (size_t)(row0 + ai * HALF + m * 16) * 1024 + col0 + bj * HALF; const f32x4 a0 = acc[ai][bj][m][0], a1 = acc[ai][bj][m][1]; float r[8];
                    if (MODE == 0) { r[0] = a0[0]; r[1] = a0[1]; r[2] = a0[2]; r[3] = a0[3]; r[4] = a1[0]; r[5] = a1[1]; r[6] = a1[2]; r[7] = a1[3]; }
                    else if (MODE == 1) { const u32x4 xv = xq[mm][bj];
                        r[0] = bflo(xv.x) * alpha + a0[0]; r[1] = bfhi(xv.x) * alpha + a0[1]; r[2] = bflo(xv.y) * alpha + a0[2]; r[3] = bfhi(xv.y) * alpha + a0[3];
                        r[4] = bflo(xv.z) * alpha + a1[0]; r[5] = bfhi(xv.z) * alpha + a1[1]; r[6] = bflo(xv.w) * alpha + a1[2]; r[7] = bfhi(xv.w) * alpha + a1[3]; }
                    else if (MODE == 2) { const u32x4 xv = xq[mm][bj]; const u32x4 pv = pq[mm][bj];
                        r[0] = bflo(xv.x) * alpha + SG_(a0[0]) * bflo(pv.x); r[1] = bfhi(xv.x) * alpha + SG_(a0[1]) * bfhi(pv.x); r[2] = bflo(xv.y) * alpha + SG_(a0[2]) * bflo(pv.y); r[3] = bfhi(xv.y) * alpha + SG_(a0[3]) * bfhi(pv.y);
                        r[4] = bflo(xv.z) * alpha + SG_(a1[0]) * bflo(pv.z); r[5] = bfhi(xv.z) * alpha + SG_(a1[1]) * bfhi(pv.z); r[6] = bflo(xv.w) * alpha + SG_(a1[2]) * bflo(pv.w); r[7] = bfhi(xv.w) * alpha + SG_(a1[3]) * bfhi(pv.w); }
                    else { const u32x4 pv = pq[mm][bj];
                        r[0] = bflo(pv.x) + a0[0]; r[1] = bfhi(pv.x) + a0[1]; r[2] = bflo(pv.y) + a0[2]; r[3] = bfhi(pv.y) + a0[3]; r[4] = bflo(pv.z) + a1[0]; r[5] = bfhi(pv.z) + a1[1]; r[6] = bflo(pv.w) + a1[2]; r[7] = bfhi(pv.w) + a1[3]; }
                    u32x4 w; w.x = pk2(r[0], r[1]); w.y = pk2(r[2], r[3]); w.z = pk2(r[4], r[5]); w.w = pk2(r[6], r[7]);
                    *(u32x4*)(P + o) = w; }
            __builtin_amdgcn_sched_barrier(0);
          }
    }
};
#undef SG_

template <int MODE> struct EpiPreLn {
    static constexpr bool PERM = true, AFTER_DRAIN = false;
    const bf16_t* P; bf16_t* XB; unsigned char* XB8; float alpha; const float* gam; const float* bet;
    unsigned long long* ST; unsigned* FLAG; LAS unsigned char* sl;
    __device__ __forceinline__ void operator()(const Acc& acc, const Unit& u, int wr, int wc, int fr, int fq) const {
        const int lane = fr | (fq << 4), t = ((wr * 4 + wc) << 6) | lane;
        const int row0 = u.pm * BM + wr * 64 + fr, col0 = u.pn * BM + wc * 32 + 8 * fq;
        Acc pre; float s1[2][4], s2[2][4];
#pragma unroll
        for (int ai = 0; ai < 2; ++ai)
#pragma unroll
          for (int mh = 0; mh < 2; ++mh) {
            u32x4 xq[2][2];
#pragma unroll
            for (int mm = 0; mm < 2; ++mm)
#pragma unroll
                for (int bj = 0; bj < 2; ++bj) { const int m = 2 * mh + mm; const size_t o = (size_t)(row0 + ai * HALF + m * 16) * 1024 + col0 + bj * HALF;
                    xq[mm][bj] = *(const u32x4*)((MODE == 1 ? (const bf16_t*)XB : P) + o); }
            __builtin_amdgcn_sched_barrier(0);
#pragma unroll
            for (int mm = 0; mm < 2; ++mm) { const int m = 2 * mh + mm; float a1 = 0.f, a2 = 0.f;
#pragma unroll
                for (int bj = 0; bj < 2; ++bj) { const f32x4 a0 = acc[ai][bj][m][0], b0 = acc[ai][bj][m][1]; const u32x4 xv = xq[mm][bj]; const float ka = (MODE == 1) ? alpha : 1.0f;
                    f32x4 r0, r1;
                    r0[0] = bflo(xv.x) * ka + a0[0]; r0[1] = bfhi(xv.x) * ka + a0[1]; r0[2] = bflo(xv.y) * ka + a0[2]; r0[3] = bfhi(xv.y) * ka + a0[3];
                    r1[0] = bflo(xv.z) * ka + b0[0]; r1[1] = bfhi(xv.z) * ka + b0[1]; r1[2] = bflo(xv.w) * ka + b0[2]; r1[3] = bfhi(xv.w) * ka + b0[3];
                    asm volatile("" : "+v"(r0), "+v"(r1));
                    pre[ai][bj][m][0] = r0; pre[ai][bj][m][1] = r1;
                    a1 += ((r0[0] + r0[1]) + (r0[2] + r0[3])) + ((r1[0] + r1[1]) + (r1[2] + r1[3]));
                    a2 += ((r0[0] * r0[0] + r0[1] * r0[1]) + (r0[2] * r0[2] + r0[3] * r0[3])) + ((r1[0] * r1[0] + r1[1] * r1[1]) + (r1[2] * r1[2] + r1[3] * r1[3])); }
                asm volatile("" : "+v"(a1), "+v"(a2)); s1[ai][m] = a1; s2[ai][m] = a2; }
            __builtin_amdgcn_sched_barrier(0);
          }
#pragma unroll
        for (int ai = 0; ai < 2; ++ai)
#pragma unroll
            for (int m = 0; m < 4; ++m) { float a = s1[ai][m], b = s2[ai][m]; a += shx(a, 16, lane); b += shx(b, 16, lane); a += shx(a, 32, lane); b += shx(b, 32, lane);
                if (fq == 0) { const int rl = ai * HALF + wr * 64 + m * 16 + fr; f32x2 w = {a, b}; *(LAS f32x2*)(sl + (rl * 4 + wc) * 8) = w; } }
        int row0b = row0, col0b = col0; asm volatile("" : "+v"(row0b), "+v"(col0b));
        f32x4 gv[2][2], bv[2][2];
#pragma unroll
        for (int bj = 0; bj < 2; ++bj)
#pragma unroll
            for (int n = 0; n < 2; ++n) { gv[bj][n] = *(const f32x4*)(gam + col0b + bj * HALF + 4 * n); bv[bj][n] = *(const f32x4*)(bet + col0b + bj * HALF + 4 * n); }
        __syncthreads();
        unsigned long long* stp = ST + ((size_t)u.pm * 4) * 256 + t;
        if (t < 256) { const LAS f32x2* p = (const LAS f32x2*)(sl + t * 32); const f32x2 w = (p[0] + p[1]) + (p[2] + p[3]);
            __hip_atomic_store(stp + (size_t)u.pn * 256, __builtin_bit_cast(unsigned long long, w), __ATOMIC_RELAXED, __HIP_MEMORY_SCOPE_AGENT); }
        asm volatile("s_waitcnt vmcnt(0)" ::: "memory");
        __syncthreads();
        if (t == 0) { __hip_atomic_fetch_add(FLAG + u.pm, 1u, __ATOMIC_RELAXED, __HIP_MEMORY_SCOPE_AGENT);
            for (int spin = 0; spin < (1 << 20) && __hip_atomic_load(FLAG + u.pm, __ATOMIC_RELAXED, __HIP_MEMORY_SCOPE_AGENT) < 4u; ++spin) __builtin_amdgcn_s_sleep(1); }
        __syncthreads();
        if (t < 256) {
            const unsigned long long q0 = __hip_atomic_load(stp, __ATOMIC_RELAXED, __HIP_MEMORY_SCOPE_AGENT), q1 = __hip_atomic_load(stp + 256, __ATOMIC_RELAXED, __HIP_MEMORY_SCOPE_AGENT),
                                     q2 = __hip_atomic_load(stp + 512, __ATOMIC_RELAXED, __HIP_MEMORY_SCOPE_AGENT), q3 = __hip_atomic_load(stp + 768, __ATOMIC_RELAXED, __HIP_MEMORY_SCOPE_AGENT);
            const f32x2 w = (__builtin_bit_cast(f32x2, q0) + __builtin_bit_cast(f32x2, q1)) + (__builtin_bit_cast(f32x2, q2) + __builtin_bit_cast(f32x2, q3));
            const float mean = w[0] * (1.0f / 1024.0f); float var = w[1] * (1.0f / 1024.0f) - mean * mean; var = var < 0.f ? 0.f : var;
            f32x2 mr = {mean, 1.0f / sqrtf(var + LN_EPS)}; *(LAS f32x2*)(sl + 8192 + t * 8) = mr; }
        __syncthreads();
        const int fqe = (col0b >> 3) & 1;
#pragma unroll
        for (int ai = 0; ai < 2; ++ai)
#pragma unroll
            for (int mp = 0; mp < 2; ++mp) { f32x2 mr[2];
#pragma unroll
                for (int e = 0; e < 2; ++e) mr[e] = *(const LAS f32x2*)(sl + 8192 + (ai * HALF + wr * 64 + (2 * mp + e) * 16 + fr) * 8);
#pragma unroll
                for (int bj = 0; bj < 2; ++bj) { u32x2 w8[2];
#pragma unroll
                    for (int e = 0; e < 2; ++e) { const int m = 2 * mp + e; const size_t o = (size_t)(row0b + ai * HALF + m * 16) * 1024 + col0b;
                        const f32x4 y0 = (pre[ai][bj][m][0] - mr[e][0]) * mr[e][1] * gv[bj][0] + bv[bj][0], y1 = (pre[ai][bj][m][1] - mr[e][0]) * mr[e][1] * gv[bj][1] + bv[bj][1];
                        u32x4 w; w.x = pk2(y0[0], y0[1]); w.y = pk2(y0[2], y0[3]); w.z = pk2(y1[0], y1[1]); w.w = pk2(y1[2], y1[3]);
                        *(u32x4*)(XB + o + bj * HALF) = w;
                        int q0 = __builtin_amdgcn_cvt_pk_fp8_f32(y0[0], y0[1], 0, false); q0 = __builtin_amdgcn_cvt_pk_fp8_f32(y0[2], y0[3], q0, true);
                        int q1 = __builtin_amdgcn_cvt_pk_fp8_f32(y1[0], y1[1], 0, false); q1 = __builtin_amdgcn_cvt_pk_fp8_f32(y1[2], y1[3], q1, true);
                        w8[e].x = (unsigned)q0; w8[e].y = (unsigned)q1; }
                    PG8_PAIR16(w8[0], w8[1]);
                    u32x4 q; q.x = w8[0].x; q.y = w8[0].y; q.z = w8[1].x; q.w = w8[1].y;
                    *(u32x4*)(XB8 + (size_t)(row0b + ai * HALF + (2 * mp + fqe) * 16) * 1024 + (col0b - 8 * fqe) + bj * HALF) = q; } }
    }
};
struct EpiSwiGLU {
    static constexpr bool PERM = true, AFTER_DRAIN = false;
    bf16_t* H; int ldc;
    __device__ __forceinline__ void operator()(const Acc& acc, const Unit& u, int wr, int wc, int fr, int fq) const {
        const int rowb = u.pm * BM + wr * 64 + fr + (fq & 1) * 16, colb = (u.pn * BM + wc * 32 + 8 * (fq & ~1)) >> 1;
#pragma unroll
        for (int ai = 0; ai < 2; ++ai)
#pragma unroll
            for (int mp = 0; mp < 2; ++mp)
#pragma unroll
                for (int bj = 0; bj < 2; ++bj) { u32x2 w[2];
#pragma unroll
                    for (int e = 0; e < 2; ++e) { const int m = 2 * mp + e; const f32x4 v0 = acc[ai][bj][m][0], v1 = acc[ai][bj][m][1];
                        const float h0 = v0[0] * sigmoidf_(v0[0]) * v0[1], h1 = v0[2] * sigmoidf_(v0[2]) * v0[3], h2 = v1[0] * sigmoidf_(v1[0]) * v1[1], h3 = v1[2] * sigmoidf_(v1[2]) * v1[3];
                        w[e].x = pk2(h0, h1); w[e].y = pk2(h2, h3); }
                    PG8_PAIR16(w[0], w[1]);
                    u32x4 q; q.x = w[0].x; q.y = w[0].y; q.z = w[1].x; q.w = w[1].y;
                    *(u32x4*)(H + (size_t)(rowb + ai * HALF + mp * 32) * ldc + colb + bj * (HALF / 2)) = q; }
    }
};

struct EpiSwiGLU8 {
    static constexpr bool PERM = true, AFTER_DRAIN = false;
    unsigned char* H; int ldc; float isc;
    __device__ __forceinline__ void operator()(const Acc& acc, const Unit& u, int wr, int wc, int fr, int fq) const {
        const int rowb = u.pm * BM + wr * 64 + fr + fq * 16, colb = (u.pn * BM + wc * 32) >> 1;
#pragma unroll
        for (int ai = 0; ai < 2; ++ai)
#pragma unroll
            for (int bj = 0; bj < 2; ++bj) { unsigned d[4];
#pragma unroll
                for (int m = 0; m < 4; ++m) { const f32x4 v0 = acc[ai][bj][m][0] * isc, v1 = acc[ai][bj][m][1] * isc;
                    const float h0 = v0[0] * sigmoidf_(v0[0]) * v0[1], h1 = v0[2] * sigmoidf_(v0[2]) * v0[3], h2 = v1[0] * sigmoidf_(v1[0]) * v1[1], h3 = v1[2] * sigmoidf_(v1[2]) * v1[3];
                    int w = __builtin_amdgcn_cvt_pk_fp8_f32(h0, h1, 0, false); w = __builtin_amdgcn_cvt_pk_fp8_f32(h2, h3, w, true); d[m] = (unsigned)w; }
                { const auto r = __builtin_amdgcn_permlane32_swap(d[0], d[2], false, false); d[0] = r[0]; d[2] = r[1]; }
                { const auto r = __builtin_amdgcn_permlane32_swap(d[1], d[3], false, false); d[1] = r[0]; d[3] = r[1]; }
                { const auto r = __builtin_amdgcn_permlane16_swap(d[0], d[1], false, false); d[0] = r[0]; d[1] = r[1]; }
                { const auto r = __builtin_amdgcn_permlane16_swap(d[2], d[3], false, false); d[2] = r[0]; d[3] = r[1]; }
                u32x4 q; q.x = d[0]; q.y = d[1]; q.z = d[2]; q.w = d[3];
                *(u32x4*)(H + (size_t)(rowb + ai * HALF) * ldc + colb + bj * (HALF / 2)) = q; }
    }
};

template <class Epi, class Sched, bool ALIGN_EPI = false, bool SP2 = false, int STAGGER_TICKS = 0>
__device__ __forceinline__ void gemm_phase(PG8_LAS unsigned char* lds, const Gemm g, const Sched& S, const Epi& E, const int tid_in) {
    int tid_ = tid_in; asm volatile("" : "+v"(tid_));
    const int tid = tid_, wid = __builtin_amdgcn_readfirstlane(tid >> 6), lane = tid & 63, wr = wid >> 2, wc = wid & 3, fr = lane & 15, fq = lane >> 4;
    int K_ = g.K; asm volatile("" : "+s"(K_)); const int K = K_, nt = K / BK;
    unsigned voffA[2], voffB[2];
#pragma unroll
    for (int i = 0; i < 2; ++i) { int R, C; stage_rc(tid * 16 + i * 8192, R, C); const int Rb = Epi::PERM ? ((R & ~31) + perm32(R & 31)) : R;
        voffA[i] = (unsigned)(R * K + C) * 2u; voffB[i] = (unsigned)(Rb * K + C) * 2u; }
    const size_t kstep = (size_t)(BK * 2);
    const size_t hstep = (size_t)HALF * K * 2;
    const size_t tstep = 2 * hstep;
    const unsigned ldsw = (unsigned)wid * 1024u;
    const int aoff = lds_byte(wr * 64 + fr, fq * 8), boff = lds_byte(wc * 32 + fr, fq * 8);
#define PG8_SA(b, h) (((b) * 2 + (h)) * HTB)
#define PG8_SB(b, h) ((4 + (b) * 2 + (h)) * HTB)
#define PG8_STAGE(bufoff, gbase, voff) do { _Pragma("unroll") for (int _i = 0; _i < 2; ++_i) \
        __builtin_amdgcn_global_load_lds((const unsigned*)((const char*)(gbase) + (voff)[_i]), (PG8_LAS unsigned*)(lds + (bufoff) + ldsw + _i * 8192), 16, 0, 0); } while (0)
#define PG8_LDA(dst, b, h) do { _Pragma("unroll") for (int m = 0; m < 4; ++m) _Pragma("unroll") for (int k = 0; k < 2; ++k) dst[m][k] = *(const PG8_LAS bf16x8*)(lds + PG8_SA(b, h) + aoff + m * 2048 + k * 1024); } while (0)
#define PG8_LDB(dst, b, h) do { _Pragma("unroll") for (int n = 0; n < 2; ++n) _Pragma("unroll") for (int k = 0; k < 2; ++k) dst[n][k] = *(const PG8_LAS bf16x8*)(lds + PG8_SB(b, h) + boff + n * 2048 + k * 1024); } while (0)
#define PG8_MMA(ai, bj, At, Bt) do { __builtin_amdgcn_s_setprio(1); _Pragma("unroll") for (int m = 0; m < 4; ++m) _Pragma("unroll") for (int n = 0; n < 2; ++n) _Pragma("unroll") for (int k = 0; k < 2; ++k) \
        acc[ai][bj][m][n] = __builtin_amdgcn_mfma_f32_16x16x32_bf16(Bt[n][k], At[m][k], acc[ai][bj][m][n], 0, 0, 0); __builtin_amdgcn_s_setprio(0); } while (0)
#define PG8_WAIT_V(n) asm volatile("s_waitcnt vmcnt(" #n ")" ::: "memory")
#define PG8_WAIT_L(n) asm volatile("s_waitcnt lgkmcnt(" #n ")" ::: "memory")
#define PG8_BAR __builtin_amdgcn_s_barrier()
#define PG8_SCHED __builtin_amdgcn_sched_barrier(0)
    Unit cur, nxt; int ui = 0;
    if (!S.next(0, cur)) return;
#if GEMM_STAGGER
    if (STAGGER_TICKS > 0 && ((blockIdx.x >> 3) & 1)) {
        const unsigned long long t0_ = __builtin_amdgcn_s_memrealtime(); while (__builtin_amdgcn_s_memrealtime() - t0_ < (unsigned long long)STAGGER_TICKS) __builtin_amdgcn_s_sleep(8); }
#endif
    f32x4 acc[2][2][4][2];
#pragma unroll
    for (int a = 0; a < 2; ++a)
#pragma unroll
        for (int b = 0; b < 2; ++b)
#pragma unroll
            for (int m = 0; m < 4; ++m)
#pragma unroll
                for (int n = 0; n < 2; ++n) acc[a][b][m][n] = (f32x4){0.f, 0.f, 0.f, 0.f};
    bf16x8 At[4][2], B0[2][2], B1[2][2];
    const char* cA = (const char*)g.A + (size_t)cur.pm * tstep; const char* cB = (const char*)g.Bt + (size_t)cur.pn * tstep + S.bofs(cur);
    S.a_ready(cur);
    if constexpr (SP2) {
        PG8_STAGE(PG8_SB(0, 0), cB, voffB); PG8_STAGE(PG8_SB(0, 1), cB + hstep, voffB); PG8_STAGE(PG8_SA(0, 0), cA, voffA); PG8_STAGE(PG8_SA(0, 1), cA + hstep, voffA);
        if (wr == 1) PG8_BAR;
        PG8_WAIT_V(2); PG8_BAR;
        PG8_STAGE(PG8_SB(1, 0), cB + kstep, voffB); PG8_STAGE(PG8_SA(1, 0), cA + kstep, voffA); PG8_STAGE(PG8_SB(1, 1), cB + hstep + kstep, voffB);
        PG8_WAIT_V(6); PG8_BAR;
    } else {
        PG8_STAGE(PG8_SB(0, 0), cB, voffB); PG8_STAGE(PG8_SA(0, 0), cA, voffA); PG8_STAGE(PG8_SB(0, 1), cB + hstep, voffB); PG8_STAGE(PG8_SA(0, 1), cA + hstep, voffA);
        if (wr == 1) PG8_BAR;
        PG8_WAIT_V(4); PG8_BAR;
        PG8_STAGE(PG8_SB(1, 0), cB + kstep, voffB); PG8_STAGE(PG8_SA(1, 0), cA + kstep, voffA); PG8_STAGE(PG8_SB(1, 1), cB + hstep + kstep, voffB);
        PG8_WAIT_V(6); PG8_BAR;
    }
    for (;;) {
        const bool has_next = S.next(ui + 1, nxt);
        const char* nA = has_next ? (const char*)g.A + (size_t)nxt.pm * tstep : cA; const char* nB = has_next ? (const char*)g.Bt + (size_t)nxt.pn * tstep + S.bofs(nxt) : cB;
#pragma nounroll
        for (int t = 0; t < nt; t += 2) {
            const bool last = (t == nt - 2);
            const char* a1 = cA + (size_t)(t + 1) * kstep;
            const char* a2 = last ? nA : cA + (size_t)(t + 2) * kstep; const char* b2 = last ? nB : cB + (size_t)(t + 2) * kstep;
            const char* a3 = a2 + kstep; const char* b3 = b2 + kstep;
            if (last && has_next) S.a_ready(nxt);
            if constexpr (SP2) {
            PG8_LDB(B0, 0, 0); PG8_LDB(B1, 0, 1); PG8_SCHED; PG8_LDA(At, 0, 0); PG8_STAGE(PG8_SA(1, 1), a1 + hstep, voffA);
            PG8_WAIT_V(8); PG8_WAIT_L(0); PG8_BAR; PG8_MMA(0, 0, At, B0); PG8_MMA(0, 1, At, B1); PG8_BAR; PG8_SCHED;
            PG8_LDA(At, 0, 1); PG8_STAGE(PG8_SB(0, 0), b2, voffB); PG8_STAGE(PG8_SB(0, 1), b2 + hstep, voffB); PG8_STAGE(PG8_SA(0, 0), a2, voffA);
            PG8_WAIT_V(8); PG8_WAIT_L(0); PG8_BAR; PG8_MMA(1, 0, At, B0); PG8_MMA(1, 1, At, B1); PG8_BAR; PG8_SCHED;
            PG8_LDB(B0, 1, 0); PG8_LDB(B1, 1, 1); PG8_SCHED; PG8_LDA(At, 1, 0); PG8_STAGE(PG8_SA(0, 1), a2 + hstep, voffA);
            PG8_WAIT_V(8); PG8_WAIT_L(0); PG8_BAR; PG8_MMA(0, 0, At, B0); PG8_MMA(0, 1, At, B1); PG8_BAR; PG8_SCHED;
            PG8_LDA(At, 1, 1); PG8_STAGE(PG8_SB(1, 0), b3, voffB); PG8_STAGE(PG8_SB(1, 1), b3 + hstep, voffB); PG8_STAGE(PG8_SA(1, 0), a3, voffA);
            PG8_WAIT_V(8); PG8_WAIT_L(0); PG8_BAR; PG8_MMA(1, 0, At, B0); PG8_MMA(1, 1, At, B1); PG8_BAR; PG8_SCHED;
            } else {
            PG8_LDB(B0, 0, 0); PG8_SCHED; PG8_LDA(At, 0, 0); PG8_STAGE(PG8_SA(1, 1), a1 + hstep, voffA);
            PG8_WAIT_L(8); PG8_BAR; PG8_WAIT_L(0); PG8_MMA(0, 0, At, B0); PG8_BAR; PG8_SCHED;
            PG8_LDB(B1, 0, 1); PG8_STAGE(PG8_SB(0, 0), b2, voffB);
            PG8_BAR; PG8_WAIT_L(0); PG8_MMA(0, 1, At, B1); PG8_BAR;
            PG8_LDA(At, 0, 1); PG8_STAGE(PG8_SA(0, 0), a2, voffA);
            PG8_BAR; PG8_WAIT_L(0); PG8_MMA(1, 0, At, B0); PG8_BAR; PG8_SCHED;
            PG8_STAGE(PG8_SB(0, 1), b2 + hstep, voffB);
            PG8_WAIT_V(6); PG8_BAR; PG8_MMA(1, 1, At, B1); PG8_BAR;
            PG8_LDB(B0, 1, 0); PG8_SCHED; PG8_LDA(At, 1, 0); PG8_STAGE(PG8_SA(0, 1), a2 + hstep, voffA);
            PG8_WAIT_L(8); PG8_BAR; PG8_WAIT_L(0); PG8_MMA(0, 0, At, B0); PG8_BAR; PG8_SCHED;
            PG8_LDB(B1, 1, 1); PG8_STAGE(PG8_SB(1, 0), b3, voffB);
            PG8_BAR; PG8_WAIT_L(0); PG8_MMA(0, 1, At, B1); PG8_BAR;
            PG8_LDA(At, 1, 1); PG8_STAGE(PG8_SA(1, 0), a3, voffA);
            PG8_BAR; PG8_WAIT_L(0); PG8_MMA(1, 0, At, B0); PG8_BAR; PG8_SCHED;
            PG8_STAGE(PG8_SB(1, 1), b3 + hstep, voffB);
            PG8_WAIT_V(6); PG8_BAR; PG8_MMA(1, 1, At, B1); PG8_BAR;
            }
        }
        if constexpr (ALIGN_EPI) { if (wr == 0) PG8_BAR; }
        if constexpr (!Epi::AFTER_DRAIN) { unsigned m1_ = ~0u; asm volatile("" : "+s"(m1_)); const int le_ = (int)__builtin_amdgcn_mbcnt_hi(m1_, __builtin_amdgcn_mbcnt_lo(m1_, 0u));
            E(acc, cur, wr, wc, le_ & 15, le_ >> 4); S.done(cur); }
        if (!has_next) break;
#pragma unroll
        for (int a = 0; a < 2; ++a)
#pragma unroll
            for (int b = 0; b < 2; ++b)
#pragma unroll
                for (int m = 0; m < 4; ++m)
#pragma unroll
                    for (int n = 0; n < 2; ++n) acc[a][b][m][n] = (f32x4){0.f, 0.f, 0.f, 0.f};
        cur = nxt; cA = nA; cB = nB; ++ui;
        if constexpr (ALIGN_EPI) { if (wr == 1) PG8_BAR; }
    }
    PG8_WAIT_V(0);
    if constexpr (!ALIGN_EPI) { if (wr == 0) PG8_BAR; }
    PG8_BAR;
    if constexpr (Epi::AFTER_DRAIN) { E.fused(acc, cur, wr, wc, fr, fq, lds, wid, lane); S.done(cur); }
#undef PG8_SA
#undef PG8_SB
#undef PG8_STAGE
#undef PG8_LDA
#undef PG8_LDB
#undef PG8_MMA
#undef PG8_WAIT_V
#undef PG8_WAIT_L
#undef PG8_BAR
#undef PG8_SCHED
}
typedef int i32x4_ __attribute__((ext_vector_type(4)));
typedef int i32x8_ __attribute__((ext_vector_type(8)));
template <class Epi, class Sched, bool ALIGN_EPI = false, bool SP2 = false, int STAGGER_TICKS = 0>
__device__ __forceinline__ void gemm_phase8(PG8_LAS unsigned char* lds, const Gemm g, const Sched& S, const Epi& E, const int sc1, const int tid_in) {
    int tid_ = tid_in; asm volatile("" : "+v"(tid_));
    const int tid = tid_, wid = __builtin_amdgcn_readfirstlane(tid >> 6), lane = tid & 63, wr = wid >> 2, wc = wid & 3, fr = lane & 15, fq = lane >> 4;
    int K_ = g.K; asm volatile("" : "+s"(K_)); const int K = K_, nt = K / BK;
    unsigned voffA[2], voffB[2];
#pragma unroll
    for (int i = 0; i < 2; ++i) { int R, C; stage_rc(tid * 16 + i * 8192, R, C); const int Rb = Epi::PERM ? ((R & ~31) + perm32(R & 31)) : R;
        voffA[i] = (unsigned)(R * K + C) * 2u; voffB[i] = (unsigned)(Rb * K + C) * 2u; }
    const size_t kstep = (size_t)(BK * 2);
    const size_t hstep = (size_t)HALF * K * 2;
    const size_t tstep = 2 * hstep;
    const unsigned ldsw = (unsigned)wid * 1024u;
    const int cq8 = (fq >> 1) * 32 + 16 * (fq & 1);
    const int aoff = lds_byte(wr * 64 + fr, cq8), boff = lds_byte(wc * 32 + fr, cq8);
#define PG8_SA(b, h) (((b) * 2 + (h)) * HTB)
#define PG8_SB(b, h) ((4 + (b) * 2 + (h)) * HTB)
#define PG8_STAGE(bufoff, gbase, voff) do { _Pragma("unroll") for (int _i = 0; _i < 2; ++_i) \
        __builtin_amdgcn_global_load_lds((const unsigned*)((const char*)(gbase) + (voff)[_i]), (PG8_LAS unsigned*)(lds + (bufoff) + ldsw + _i * 8192), 16, 0, 0); } while (0)
#define PG8_LD16(off) (*(const PG8_LAS i32x4_*)(lds + (off)))
#define PG8_LDA(dst, b, h) do { _Pragma("unroll") for (int m = 0; m < 4; ++m) dst[m] = __builtin_shufflevector(PG8_LD16(PG8_SA(b, h) + aoff + m * 2048), PG8_LD16(PG8_SA(b, h) + aoff + m * 2048 + 16), 0, 1, 2, 3, 4, 5, 6, 7); } while (0)
#define PG8_LDB(dst, b, h) do { _Pragma("unroll") for (int n = 0; n < 2; ++n) dst[n] = __builtin_shufflevector(PG8_LD16(PG8_SB(b, h) + boff + n * 2048), PG8_LD16(PG8_SB(b, h) + boff + n * 2048 + 16), 0, 1, 2, 3, 4, 5, 6, 7); } while (0)
#define PG8_MMA(ai, bj, At, Bt) do { __builtin_amdgcn_s_setprio(1); _Pragma("unroll") for (int m = 0; m < 4; ++m) _Pragma("unroll") for (int n = 0; n < 2; ++n) \
        asm volatile("v_mfma_scale_f32_16x16x128_f8f6f4 %0, %1, %2, %0, %3, %3 op_sel_hi:[0,0,0]" : "+v"(acc[ai][bj][m][n]) : "v"(Bt[n]), "v"(At[m]), "v"(sc1)); __builtin_amdgcn_s_setprio(0); } while (0)
#define PG8_WAIT_V(n) asm volatile("s_waitcnt vmcnt(" #n ")" ::: "memory")
#define PG8_WAIT_L(n) asm volatile("s_waitcnt lgkmcnt(" #n ")" ::: "memory")
#define PG8_BAR __builtin_amdgcn_s_barrier()
#define PG8_SCHED __builtin_amdgcn_sched_barrier(0)
    Unit cur, nxt; int ui = 0;
    if (!S.next(0, cur)) return;
#if GEMM_STAGGER
    if (STAGGER_TICKS > 0 && ((blockIdx.x >> 3) & 1)) {
        const unsigned long long t0_ = __builtin_amdgcn_s_memrealtime(); while (__builtin_amdgcn_s_memrealtime() - t0_ < (unsigned long long)STAGGER_TICKS) __builtin_amdgcn_s_sleep(8); }
#endif
    f32x4 acc[2][2][4][2];
#pragma unroll
    for (int a = 0; a < 2; ++a)
#pragma unroll
        for (int b = 0; b < 2; ++b)
#pragma unroll
            for (int m = 0; m < 4; ++m)
#pragma unroll
                for (int n = 0; n < 2; ++n) acc[a][b][m][n] = (f32x4){0.f, 0.f, 0.f, 0.f};
    i32x8_ At[4], B0[2], B1[2];
    const char* cA = (const char*)g.A + (size_t)cur.pm * tstep; const char* cB = (const char*)g.Bt + (size_t)cur.pn * tstep + S.bofs(cur);
    S.a_ready(cur);
    if constexpr (SP2) {
        PG8_STAGE(PG8_SB(0, 0), cB, voffB); PG8_STAGE(PG8_SB(0, 1), cB + hstep, voffB); PG8_STAGE(PG8_SA(0, 0), cA, voffA); PG8_STAGE(PG8_SA(0, 1), cA + hstep, voffA);
        if (wr == 1) PG8_BAR;
        PG8_WAIT_V(2); PG8_BAR;
        PG8_STAGE(PG8_SB(1, 0), cB + kstep, voffB); PG8_STAGE(PG8_SA(1, 0), cA + kstep, voffA); PG8_STAGE(PG8_SB(1, 1), cB + hstep + kstep, voffB);
        PG8_WAIT_V(6); PG8_BAR;
    } else {
        PG8_STAGE(PG8_SB(0, 0), cB, voffB); PG8_STAGE(PG8_SA(0, 0), cA, voffA); PG8_STAGE(PG8_SB(0, 1), cB + hstep, voffB); PG8_STAGE(PG8_SA(0, 1), cA + hstep, voffA);
        if (wr == 1) PG8_BAR;
        PG8_WAIT_V(4); PG8_BAR;
        PG8_STAGE(PG8_SB(1, 0), cB + kstep, voffB); PG8_STAGE(PG8_SA(1, 0), cA + kstep, voffA); PG8_STAGE(PG8_SB(1, 1), cB + hstep + kstep, voffB);
        PG8_WAIT_V(6); PG8_BAR;
    }
    for (;;) {
        const bool has_next = S.next(ui + 1, nxt);
        const char* nA = has_next ? (const char*)g.A + (size_t)nxt.pm * tstep : cA; const char* nB = has_next ? (const char*)g.Bt + (size_t)nxt.pn * tstep + S.bofs(nxt) : cB;
#pragma nounroll
        for (int t = 0; t < nt; t += 2) {
            const bool last = (t == nt - 2);
            const char* a1 = cA + (size_t)(t + 1) * kstep;
            const char* a2 = last ? nA : cA + (size_t)(t + 2) * kstep; const char* b2 = last ? nB : cB + (size_t)(t + 2) * kstep;
            const char* a3 = a2 + kstep; const char* b3 = b2 + kstep;
            if (last && has_next) S.a_ready(nxt);
            if constexpr (SP2) {
            PG8_LDB(B0, 0, 0); PG8_LDB(B1, 0, 1); PG8_SCHED; PG8_LDA(At, 0, 0); PG8_STAGE(PG8_SA(1, 1), a1 + hstep, voffA);
            PG8_WAIT_V(8); PG8_WAIT_L(0); PG8_BAR; PG8_MMA(0, 0, At, B0); PG8_MMA(0, 1, At, B1); PG8_BAR; PG8_SCHED;
            PG8_LDA(At, 0, 1); PG8_STAGE(PG8_SB(0, 0), b2, voffB); PG8_STAGE(PG8_SB(0, 1), b2 + hstep, voffB); PG8_STAGE(PG8_SA(0, 0), a2, voffA);
            PG8_WAIT_V(8); PG8_WAIT_L(0); PG8_BAR; PG8_MMA(1, 0, At, B0); PG8_MMA(1, 1, At, B1); PG8_BAR; PG8_SCHED;
            PG8_LDB(B0, 1, 0); PG8_LDB(B1, 1, 1); PG8_SCHED; PG8_LDA(At, 1, 0); PG8_STAGE(PG8_SA(0, 1), a2 + hstep, voffA);
            PG8_WAIT_V(8); PG8_WAIT_L(0); PG8_BAR; PG8_MMA(0, 0, At, B0); PG8_MMA(0, 1, At, B1); PG8_BAR; PG8_SCHED;
            PG8_LDA(At, 1, 1); PG8_STAGE(PG8_SB(1, 0), b3, voffB); PG8_STAGE(PG8_SB(1, 1), b3 + hstep, voffB); PG8_STAGE(PG8_SA(1, 0), a3, voffA);
            PG8_WAIT_V(8); PG8_WAIT_L(0); PG8_BAR; PG8_MMA(1, 0, At, B0); PG8_MMA(1, 1, At, B1); PG8_BAR; PG8_SCHED;
            } else {
            PG8_LDB(B0, 0, 0); PG8_SCHED; PG8_LDA(At, 0, 0); PG8_STAGE(PG8_SA(1, 1), a1 + hstep, voffA);
            PG8_WAIT_L(8); PG8_BAR; PG8_WAIT_L(0); PG8_MMA(0, 0, At, B0); PG8_BAR; PG8_SCHED;
            PG8_LDB(B1, 0, 1); PG8_STAGE(PG8_SB(0, 0), b2, voffB);
            PG8_BAR; PG8_WAIT_L(0); PG8_MMA(0, 1, At, B1); PG8_BAR;
            PG8_LDA(At, 0, 1); PG8_STAGE(PG8_SA(0, 0), a2, voffA);
            PG8_BAR; PG8_WAIT_L(0); PG8_MMA(1, 0, At, B0); PG8_BAR; PG8_SCHED;
            PG8_STAGE(PG8_SB(0, 1), b2 + hstep, voffB);
            PG8_WAIT_V(6); PG8_BAR; PG8_MMA(1, 1, At, B1); PG8_BAR;
            PG8_LDB(B0, 1, 0); PG8_SCHED; PG8_LDA(At, 1, 0); PG8_STAGE(PG8_SA(0, 1), a2 + hstep, voffA);
            PG8_WAIT_L(8); PG8_BAR; PG8_WAIT_L(0); PG8_MMA(0, 0, At, B0); PG8_BAR; PG8_SCHED;
            PG8_LDB(B1, 1, 1); PG8_STAGE(PG8_SB(1, 0), b3, voffB);
            PG8_BAR; PG8_WAIT_L(0); PG8_MMA(0, 1, At, B1); PG8_BAR;
            PG8_LDA(At, 1, 1); PG8_STAGE(PG8_SA(1, 0), a3, voffA);
            PG8_BAR; PG8_WAIT_L(0); PG8_MMA(1, 0, At, B0); PG8_BAR; PG8_SCHED;
            PG8_STAGE(PG8_SB(1, 1), b3 + hstep, voffB);
            PG8_WAIT_V(6); PG8_BAR; PG8_MMA(1, 1, At, B1); PG8_BAR;
            }
        }
        if constexpr (ALIGN_EPI) { if (wr == 0) PG8_BAR; }
        asm volatile("s_nop 15\n\ts_nop 15" ::: "memory");
        if constexpr (!Epi::AFTER_DRAIN) { unsigned m1_ = ~0u; asm volatile("" : "+s"(m1_)); const int le_ = (int)__builtin_amdgcn_mbcnt_hi(m1_, __builtin_amdgcn_mbcnt_lo(m1_, 0u));
            E(acc, cur, wr, wc, le_ & 15, le_ >> 4); S.done(cur); }
        if (!has_next) break;
#pragma unroll
        for (int a = 0; a < 2; ++a)
#pragma unroll
            for (int b = 0; b < 2; ++b)
#pragma unroll
                for (int m = 0; m < 4; ++m)
#pragma unroll
                    for (int n = 0; n < 2; ++n) acc[a][b][m][n] = (f32x4){0.f, 0.f, 0.f, 0.f};
        cur = nxt; cA = nA; cB = nB; ++ui;
        if constexpr (ALIGN_EPI) { if (wr == 1) PG8_BAR; }
    }
    PG8_WAIT_V(0);
    if constexpr (!ALIGN_EPI) { if (wr == 0) PG8_BAR; }
    PG8_BAR;
    if constexpr (Epi::AFTER_DRAIN) { E.fused(acc, cur, wr, wc, fr, fq, lds, wid, lane); S.done(cur); }
#undef PG8_SA
#undef PG8_SB
#undef PG8_STAGE
#undef PG8_LDA
#undef PG8_LD16
#undef PG8_LDB
#undef PG8_MMA
#undef PG8_WAIT_V
#undef PG8_WAIT_L
#undef PG8_BAR
#undef PG8_SCHED
}
}

namespace att {
#ifndef ATT_UNROLL_U
#define ATT_UNROLL_U "unroll 1"
#endif
#ifndef A6_VMASK
#define A6_VMASK 0x402
#endif
#ifndef ATT2_PINGPONG
#define ATT2_PINGPONG 1
#endif
#ifndef ATT_STATIC_PRIO
#define ATT_STATIC_PRIO 1
#endif
#ifndef ATT_PRIO
#define ATT_PRIO 0
#endif
#if ATT_PRIO
#define ATT_SETPRIO(x) __builtin_amdgcn_s_setprio(x)
#else
#define ATT_SETPRIO(x) do {} while (0)
#endif
#define MFMA32(a, b, c) __builtin_amdgcn_mfma_f32_32x32x16_bf16((a), (b), (c), 0, 0, 0)
typedef short v4i16_t __attribute__((ext_vector_type(4)));
struct AttnP {
    const bf16* Q; int ldq;
    const bf16* K1; int ldk1;
    const bf16* K2; int ldk2;
    const bf16* V; int ldv;
    bf16* O; int ldo;
    const int* pos;
    const int* blkmax;
    const float* lut;
    const bf16* TI; float lam, osc; const float* gsub;
};
__device__ __forceinline__ s16x4 vtr(const LAS unsigned char* p) { return __builtin_bit_cast(s16x4, __builtin_amdgcn_ds_read_tr16_b64_v4i16((LAS v4i16_t*)p)); }

template <int DQK, int KSPLIT, int DV, bool BIAS, int COMB = 0>
__device__ __forceinline__ void attn_unit(const AttnP& P, int b, int qt, int qcol, int kcol, int vcol, int ocol, int hb, LAS unsigned char* lds, const int tid_in) {
    constexpr int KROWB = DQK * 2 + 16;
    constexpr int VROWB = (DV == 128) ? 320 : 192;
    constexpr int KBYTES = 64 * KROWB, VBYTES = 64 * VROWB, STAGE = KBYTES + VBYTES + 256, LUT_OFF = 2 * STAGE;
    constexpr int ND = DQK / 16, NDB = DV / 32, KCH = DQK / 8, VCH = DV / 8, NKC = 64 * KCH, NVC = 64 * VCH, KL = (NKC + 511) / 512, VL = (NVC + 511) / 512;
    int tid_ = tid_in; asm volatile("" : "+v"(tid_));
    const int tid = tid_, lane = tid & 63, wid = __builtin_amdgcn_readfirstlane(tid >> 6), r = lane & 31, h = lane >> 5;
    const long tok0 = (long)b * SEQ; const int q0 = qt * 256; const int qrow = q0 + wid * 32 + r;
    bf16x8 qf[ND];
    { const bf16* qp = P.Q + (tok0 + qrow) * (long)P.ldq + qcol + 8 * h;
#pragma unroll
      for (int d = 0; d < ND; ++d) qf[d] = *(const bf16x8*)(qp + 16 * d); }
    int posq = 0, posq_min = 0;
    LAS float* lut = (LAS float*)(lds + LUT_OFF);
    if (BIAS) { posq = P.pos[tok0 + qrow]; int mn = posq;
#pragma unroll
        for (int o = 1; o < 64; o <<= 1) { const int t2 = shxi(mn, o, lane); mn = t2 < mn ? t2 : mn; }
        posq_min = mn;
        if (tid < 132) lut[tid] = P.lut[hb * 132 + tid]; }
    v4u kreg[KL], vreg[VL]; int preg = 0;
#define ATT_ISSUE(t) do { const long trow = tok0 + 64 * (long)(t); \
        _Pragma("unroll") for (int i = 0; i < KL; ++i) { const int c = tid + 512 * i; if (NKC % 512 == 0 || c < NKC) { const int row = c / KCH, col = (c % KCH) * 8; \
            const bf16* src = (col < KSPLIT) ? P.K1 + (trow + row) * (long)P.ldk1 + kcol + col : P.K2 + (trow + row) * (long)P.ldk2 + (col - KSPLIT); kreg[i] = *(const v4u*)src; } } \
        _Pragma("unroll") for (int i = 0; i < VL; ++i) { const int c = tid + 512 * i; if (NVC % 512 == 0 || c < NVC) { const int row = c / VCH, col = (c % VCH) * 8; vreg[i] = *(const v4u*)(P.V + (trow + row) * (long)P.ldv + vcol + col); } } \
        if (BIAS && tid < 64) preg = P.pos[trow + tid]; } while (0)
#define ATT_WRITE(t) do { LAS unsigned char* sb = lds + ((t) & 1) * STAGE; \
        _Pragma("unroll") for (int i = 0; i < KL; ++i) { const int c = tid + 512 * i; if (NKC % 512 == 0 || c < NKC) { const int row = c / KCH, cc = c % KCH; *(LAS v4u*)(sb + row * KROWB + cc * 16) = kreg[i]; } } \
        _Pragma("unroll") for (int i = 0; i < VL; ++i) { const int c = tid + 512 * i; if (NVC % 512 == 0 || c < NVC) { const int row = c / VCH, cc = c % VCH; *(LAS v4u*)(sb + KBYTES + row * VROWB + cc * 16) = vreg[i]; } } \
        if (BIAS && tid < 64) *(LAS int*)(sb + KBYTES + VBYTES + 4 * tid) = preg; } while (0)
    f32x16 o[NDB];
#pragma unroll
    for (int i = 0; i < NDB; ++i)
#pragma unroll
        for (int j = 0; j < 16; ++j) o[i][j] = 0.f;
    float m_run = 0.f, l_run = 0.f;
    const int ntiles = (q0 + 256) / 64, my_last = (q0 + wid * 32 + 31) / 64;
#if ATT_STATIC_PRIO
    if (wid >= 4) __builtin_amdgcn_s_setprio(1);
#endif
    ATT_ISSUE(0); ATT_WRITE(0); __syncthreads();
    const int kbase = r * KROWB + 16 * h;
    const int vbase = KBYTES + (4 * h + ((lane & 15) >> 2)) * VROWB + (((lane >> 4) & 1) * 16 + (lane & 3) * 4) * 2;
    for (int t = 0; t < ntiles; ++t) {
        const bool more = (t + 1 < ntiles);
        if (more) ATT_ISSUE(t + 1);
        if (t <= my_last) {
            const LAS unsigned char* sb = lds + (t & 1) * STAGE;
            bool plain = (64 * t + 63 <= q0 + wid * 32);
            float cinit = -m_run;
            if (BIAS) { const int kmax = P.blkmax[(int)(tok0 >> 6) + t]; if (plain && (posq_min - kmax >= 113)) cinit += lut[128]; else plain = false; }
            f32x16 x0, x1;
#pragma unroll
            for (int j = 0; j < 16; ++j) { x0[j] = cinit; x1[j] = cinit; }
            ATT_SETPRIO(1);
            { bf16x8 kf0[ND], kf1[ND];
#pragma unroll
              for (int d = 0; d < ND; ++d) { kf0[d] = *(const LAS bf16x8*)(sb + kbase + d * 32); kf1[d] = *(const LAS bf16x8*)(sb + kbase + 32 * KROWB + d * 32); }
              __builtin_amdgcn_sched_barrier(0);
#pragma unroll
              for (int d = 0; d < ND; ++d) { x0 = MFMA32(kf0[d], qf[d], x0); x1 = MFMA32(kf1[d], qf[d], x1); } }
            ATT_SETPRIO(0);
            if (!plain) {
#pragma unroll
                for (int g = 0; g < 4; ++g) {
                    int pk0[4] = {0, 0, 0, 0}, pk1[4] = {0, 0, 0, 0};
                    if (BIAS) { const LAS int* pp = (const LAS int*)(sb + KBYTES + VBYTES) + 8 * g + 4 * h;
                        const v4u a = *(const LAS v4u*)pp, c = *(const LAS v4u*)(pp + 32);
                        pk0[0] = a.x; pk0[1] = a.y; pk0[2] = a.z; pk0[3] = a.w; pk1[0] = c.x; pk1[1] = c.y; pk1[2] = c.z; pk1[3] = c.w; }
#pragma unroll
                    for (int j = 0; j < 4; ++j) { const int i = 4 * g + j; const int kidx = 64 * t + 8 * g + 4 * h + j;
                        float v0 = x0[i], v1 = x1[i];
                        if (BIAS) { int n0 = posq - pk0[j]; n0 = n0 < 0 ? 0 : (n0 > 128 ? 128 : n0); int n1 = posq - pk1[j]; n1 = n1 < 0 ? 0 : (n1 > 128 ? 128 : n1); v0 += lut[n0]; v1 += lut[n1]; }
                        if (kidx > qrow) v0 = -INFINITY; if (kidx + 32 > qrow) v1 = -INFINITY;
                        x0[i] = v0; x1[i] = v1; }
                }
            }
            float ma = fmaxf(fmaxf(x0[0], x0[1]), x0[2]), mb = fmaxf(fmaxf(x1[0], x1[1]), x1[2]);
#pragma unroll
            for (int j = 3; j < 15; j += 2) { ma = fmaxf(fmaxf(ma, x0[j]), x0[j + 1]); mb = fmaxf(fmaxf(mb, x1[j]), x1[j + 1]); }
            float mx = fmaxf(fmaxf(ma, mb), fmaxf(x0[15], x1[15]));
            { const auto rr = __builtin_amdgcn_permlane32_swap(__float_as_uint(mx), __float_as_uint(mx), false, false); mx = fmaxf(__uint_as_float(rr[0]), __uint_as_float(rr[1])); }
            if (t == 0 || __any(mx > 8.0f)) {
                const float delta = (t == 0) ? mx : fmaxf(mx, 0.f);
                if (t != 0) { const float alpha = __builtin_amdgcn_exp2f(-delta); l_run *= alpha;
#pragma unroll
                    for (int i = 0; i < NDB; ++i) o[i] = o[i] * alpha; }
                m_run += delta;
#pragma unroll
                for (int j = 0; j < 16; ++j) { x0[j] -= delta; x1[j] -= delta; }
            }
            f32x2 ls2 = {0.f, 0.f};
#pragma unroll
            for (int j = 0; j < 16; j += 2) { x0[j] = __builtin_amdgcn_exp2f(x0[j]); x0[j + 1] = __builtin_amdgcn_exp2f(x0[j + 1]); x1[j] = __builtin_amdgcn_exp2f(x1[j]); x1[j + 1] = __builtin_amdgcn_exp2f(x1[j + 1]);
                ls2 += (f32x2){x0[j], x0[j + 1]}; ls2 += (f32x2){x1[j], x1[j + 1]}; }
            l_run += ls2[0] + ls2[1];
            bf16x8 pf[4];
            { v4u w;
              w.x = pk2(x0[0], x0[1]); w.y = pk2(x0[2], x0[3]); w.z = pk2(x0[4], x0[5]); w.w = pk2(x0[6], x0[7]); pf[0] = __builtin_bit_cast(bf16x8, w);
              w.x = pk2(x0[8], x0[9]); w.y = pk2(x0[10], x0[11]); w.z = pk2(x0[12], x0[13]); w.w = pk2(x0[14], x0[15]); pf[1] = __builtin_bit_cast(bf16x8, w);
              w.x = pk2(x1[0], x1[1]); w.y = pk2(x1[2], x1[3]); w.z = pk2(x1[4], x1[5]); w.w = pk2(x1[6], x1[7]); pf[2] = __builtin_bit_cast(bf16x8, w);
              w.x = pk2(x1[8], x1[9]); w.y = pk2(x1[10], x1[11]); w.z = pk2(x1[12], x1[13]); w.w = pk2(x1[14], x1[15]); pf[3] = __builtin_bit_cast(bf16x8, w); }
            ATT_SETPRIO(1);
            { s16x4 vlo[2][4], vhi[2][4];
#define ATT_VLOAD(buf, db) do { _Pragma("unroll") for (int s = 0; s < 4; ++s) { vlo[buf][s] = vtr(sb + vbase + (16 * s) * VROWB + 64 * (db)); vhi[buf][s] = vtr(sb + vbase + (16 * s + 8) * VROWB + 64 * (db)); } } while (0)
              ATT_VLOAD(0, 0);
#pragma unroll
              for (int db = 0; db < NDB; ++db) {
                  if (db + 1 < NDB) ATT_VLOAD((db + 1) & 1, db + 1);
                  __builtin_amdgcn_sched_barrier(0);
#pragma unroll
                  for (int s = 0; s < 4; ++s) { const bf16x8 vf = __builtin_shufflevector(vlo[db & 1][s], vhi[db & 1][s], 0, 1, 2, 3, 4, 5, 6, 7); o[db] = MFMA32(vf, pf[s], o[db]); }
                  __builtin_amdgcn_sched_barrier(0);
              }
#undef ATT_VLOAD
            }
            ATT_SETPRIO(0);
        }
        if (more) ATT_WRITE(t + 1);
        __syncthreads();
    }
#undef ATT_ISSUE
#undef ATT_WRITE
#if ATT_STATIC_PRIO
    __builtin_amdgcn_s_setprio(0);
#endif
    const float lt = l_run + shx(l_run, 32, lane), inv = 1.0f / lt;
    if (COMB == 2) {
        const bf16* ip = P.TI + (tok0 + qrow) * (long)P.ldo + ocol + 4 * h; float ss = 0.f;
#pragma unroll
        for (int db = 0; db < NDB; ++db)
#pragma unroll
            for (int g = 0; g < 4; ++g) { const v2u a = *(const v2u*)(ip + 32 * db + 8 * g);
                const float c0 = bflo(a.x) - P.lam * (o[db][4 * g] * inv), c1 = bfhi(a.x) - P.lam * (o[db][4 * g + 1] * inv), c2 = bflo(a.y) - P.lam * (o[db][4 * g + 2] * inv), c3 = bfhi(a.y) - P.lam * (o[db][4 * g + 3] * inv);
                o[db][4 * g] = c0; o[db][4 * g + 1] = c1; o[db][4 * g + 2] = c2; o[db][4 * g + 3] = c3; ss += (c0 * c0 + c1 * c1) + (c2 * c2 + c3 * c3); }
        ss += shx(ss, 32, lane);
        const float rr = P.osc / sqrtf(ss * (1.0f / 128.0f) + LN_EPS);
        bf16* op = P.O + (tok0 + qrow) * (long)P.ldo + ocol + 4 * h;
#pragma unroll
        for (int db = 0; db < NDB; ++db)
#pragma unroll
            for (int g = 0; g < 4; ++g) { const f32x4 gg = *(const f32x4*)(P.gsub + 32 * db + 8 * g + 4 * h);
                v2u w; w.x = pk2(o[db][4 * g] * rr * gg[0], o[db][4 * g + 1] * rr * gg[1]); w.y = pk2(o[db][4 * g + 2] * rr * gg[2], o[db][4 * g + 3] * rr * gg[3]);
                *(v2u*)(op + 32 * db + 8 * g) = w; }
        return;
    }
    bf16* op = P.O + (tok0 + qrow) * (long)P.ldo + ocol + 4 * h;
#pragma unroll
    for (int db = 0; db < NDB; ++db)
#pragma unroll
        for (int g = 0; g < 4; ++g) { v2u w; w.x = pk2(o[db][4 * g] * inv, o[db][4 * g + 1] * inv); w.y = pk2(o[db][4 * g + 2] * inv, o[db][4 * g + 3] * inv);
            *(v2u*)(op + 32 * db + 8 * g) = w; }
}

template <int DQK, int KSPLIT, int DV, bool BIAS, int COMB = 0>
__device__ __forceinline__ void attn_unit6(const AttnP& P, int b, int qt, int qcol, int kcol, int vcol, int ocol, int hb, LAS unsigned char* lds, const int tid_in) {
    constexpr int KROWB = DQK * 2 + 16;
    constexpr int VROWB = (DV == 128) ? 320 : 192;
    constexpr int KBYTES = 64 * KROWB, VBYTES = 64 * VROWB, STAGE = KBYTES + VBYTES + 256, LUT_OFF = 2 * STAGE;
    constexpr int ND = DQK / 16, NDB = DV / 32, KCH = DQK / 8, VCH = DV / 8, NKC = 64 * KCH, NVC = 64 * VCH, KL = (NKC + 511) / 512, VL = (NVC + 511) / 512;
    int tid_ = tid_in; asm volatile("" : "+v"(tid_));
    const int tid = tid_, lane = tid & 63, wid = __builtin_amdgcn_readfirstlane(tid >> 6), r = lane & 31, h = lane >> 5;
    const long tok0 = (long)b * SEQ; const int q0 = qt * 256; const int qrow = q0 + wid * 32 + r;
    bf16x8 qf[ND];
    { const bf16* qp = P.Q + (tok0 + qrow) * (long)P.ldq + qcol + 8 * h;
#pragma unroll
      for (int d = 0; d < ND; ++d) qf[d] = *(const bf16x8*)(qp + 16 * d); }
    int posq = 0, posq_min = 0;
    LAS float* lut = (LAS float*)(lds + LUT_OFF);
    if (BIAS) { posq = P.pos[tok0 + qrow]; int mn = posq;
#pragma unroll
        for (int o = 1; o < 64; o <<= 1) { const int t2 = shxi(mn, o, lane); mn = t2 < mn ? t2 : mn; }
        posq_min = mn;
        if (tid < 132) lut[tid] = P.lut[hb * 132 + tid]; }
    v4u kreg[KL], vreg[VL]; int preg = 0;
#define ATT_ISSUE(t) do { const long trow = tok0 + 64 * (long)(t); \
        _Pragma("unroll") for (int i = 0; i < KL; ++i) { const int c = tid + 512 * i; if (NKC % 512 == 0 || c < NKC) { const int row = c / KCH, col = (c % KCH) * 8; \
            const bf16* src = (col < KSPLIT) ? P.K1 + (trow + row) * (long)P.ldk1 + kcol + col : P.K2 + (trow + row) * (long)P.ldk2 + (col - KSPLIT); kreg[i] = *(const v4u*)src; } } \
        _Pragma("unroll") for (int i = 0; i < VL; ++i) { const int c = tid + 512 * i; if (NVC % 512 == 0 || c < NVC) { const int row = c / VCH, col = (c % VCH) * 8; vreg[i] = *(const v4u*)(P.V + (trow + row) * (long)P.ldv + vcol + col); } } \
        if (BIAS && tid < 64) preg = P.pos[trow + tid]; } while (0)
#define ATT_WRITE(t) do { LAS unsigned char* sb = lds + ((t) & 1) * STAGE; \
        _Pragma("unroll") for (int i = 0; i < KL; ++i) { const int c = tid + 512 * i; if (NKC % 512 == 0 || c < NKC) { const int row = c / KCH, cc = c % KCH; *(LAS v4u*)(sb + row * KROWB + cc * 16) = kreg[i]; } } \
        _Pragma("unroll") for (int i = 0; i < VL; ++i) { const int c = tid + 512 * i; if (NVC % 512 == 0 || c < NVC) { const int row = c / VCH, cc = c % VCH; *(LAS v4u*)(sb + KBYTES + row * VROWB + cc * 16) = vreg[i]; } } \
        if (BIAS && tid < 64) *(LAS int*)(sb + KBYTES + VBYTES + 4 * tid) = preg; } while (0)
    f32x16 o[NDB];
#pragma unroll
    for (int i = 0; i < NDB; ++i)
#pragma unroll
        for (int j = 0; j < 16; ++j) o[i][j] = 0.f;
    float m_run = 0.f, l_run = 0.f;
    const int ntiles = (q0 + 256) / 64, my_last = (q0 + wid * 32 + 31) / 64;
#if ATT_STATIC_PRIO
    if (wid >= 4) __builtin_amdgcn_s_setprio(1);
#endif
    ATT_ISSUE(0); ATT_WRITE(0); __syncthreads();
    const int kbase = r * KROWB + 16 * h;
    const int vbase = KBYTES + (4 * h + ((lane & 15) >> 2)) * VROWB + (((lane >> 4) & 1) * 16 + (lane & 3) * 4) * 2;
    for (int t = 0; t < ntiles; ++t) {
        const bool more = (t + 1 < ntiles);
        if (more) ATT_ISSUE(t + 1);
        if (t <= my_last) {
            const LAS unsigned char* sb = lds + (t & 1) * STAGE;
            bool plain = (64 * t + 63 <= q0 + wid * 32);
            float cinit = -m_run;
            if (BIAS) { const int kmax = P.blkmax[(int)(tok0 >> 6) + t]; if (plain && (posq_min - kmax >= 113)) cinit += lut[128]; else plain = false; }
            f32x16 x0, x1;
#pragma unroll
            for (int j = 0; j < 16; ++j) { x0[j] = cinit; x1[j] = cinit; }
            ATT_SETPRIO(1);
            { bf16x8 kf0[ND], kf1[ND];
#pragma unroll
              for (int d = 0; d < ND; ++d) { kf0[d] = *(const LAS bf16x8*)(sb + kbase + d * 32); kf1[d] = *(const LAS bf16x8*)(sb + kbase + 32 * KROWB + d * 32); }
              __builtin_amdgcn_sched_barrier(0);
#pragma unroll
              for (int d = 0; d < ND; ++d) { x0 = MFMA32(kf0[d], qf[d], x0); x1 = MFMA32(kf1[d], qf[d], x1); } }
            ATT_SETPRIO(0);
            if (!plain) {
#pragma unroll
                for (int g = 0; g < 4; ++g) {
                    int pk0[4] = {0, 0, 0, 0}, pk1[4] = {0, 0, 0, 0};
                    if (BIAS) { const LAS int* pp = (const LAS int*)(sb + KBYTES + VBYTES) + 8 * g + 4 * h;
                        const v4u a = *(const LAS v4u*)pp, c = *(const LAS v4u*)(pp + 32);
                        pk0[0] = a.x; pk0[1] = a.y; pk0[2] = a.z; pk0[3] = a.w; pk1[0] = c.x; pk1[1] = c.y; pk1[2] = c.z; pk1[3] = c.w; }
#pragma unroll
                    for (int j = 0; j < 4; ++j) { const int i = 4 * g + j; const int kidx = 64 * t + 8 * g + 4 * h + j;
                        float v0 = x0[i], v1 = x1[i];
                        if (BIAS) { int n0 = posq - pk0[j]; n0 = n0 < 0 ? 0 : (n0 > 128 ? 128 : n0); int n1 = posq - pk1[j]; n1 = n1 < 0 ? 0 : (n1 > 128 ? 128 : n1); v0 += lut[n0]; v1 += lut[n1]; }
                        if (kidx > qrow) v0 = -INFINITY; if (kidx + 32 > qrow) v1 = -INFINITY;
                        x0[i] = v0; x1[i] = v1; }
                }
            }
            float ma = fmaxf(fmaxf(x0[0], x0[1]), x0[2]), mb = fmaxf(fmaxf(x1[0], x1[1]), x1[2]);
#pragma unroll
            for (int j = 3; j < 15; j += 2) { ma = fmaxf(fmaxf(ma, x0[j]), x0[j + 1]); mb = fmaxf(fmaxf(mb, x1[j]), x1[j + 1]); }
            float mx = fmaxf(fmaxf(ma, mb), fmaxf(x0[15], x1[15]));
            { const auto rr = __builtin_amdgcn_permlane32_swap(__float_as_uint(mx), __float_as_uint(mx), false, false); mx = fmaxf(__uint_as_float(rr[0]), __uint_as_float(rr[1])); }
            if (t == 0 || __any(mx > 8.0f)) {
                const float delta = (t == 0) ? mx : fmaxf(mx, 0.f);
                if (t != 0) { const float alpha = __builtin_amdgcn_exp2f(-delta); l_run *= alpha;
#pragma unroll
                    for (int i = 0; i < NDB; ++i) o[i] = o[i] * alpha; }
                m_run += delta;
#pragma unroll
                for (int j = 0; j < 16; ++j) { x0[j] -= delta; x1[j] -= delta; }
            }
            f32x2 ls2 = {0.f, 0.f};
            bf16x8 pf[4];
            s16x4 vl[2][NDB], vh[2][NDB];
#define A6_EXP(X, bb, PF) do { \
        X[bb + 0] = __builtin_amdgcn_exp2f(X[bb + 0]); X[bb + 1] = __builtin_amdgcn_exp2f(X[bb + 1]); X[bb + 2] = __builtin_amdgcn_exp2f(X[bb + 2]); X[bb + 3] = __builtin_amdgcn_exp2f(X[bb + 3]); \
        X[bb + 4] = __builtin_amdgcn_exp2f(X[bb + 4]); X[bb + 5] = __builtin_amdgcn_exp2f(X[bb + 5]); X[bb + 6] = __builtin_amdgcn_exp2f(X[bb + 6]); X[bb + 7] = __builtin_amdgcn_exp2f(X[bb + 7]); \
        ls2 += (f32x2){X[bb + 0], X[bb + 1]}; ls2 += (f32x2){X[bb + 2], X[bb + 3]}; ls2 += (f32x2){X[bb + 4], X[bb + 5]}; ls2 += (f32x2){X[bb + 6], X[bb + 7]}; \
        { v4u w_; w_.x = pk2(X[bb + 0], X[bb + 1]); w_.y = pk2(X[bb + 2], X[bb + 3]); w_.z = pk2(X[bb + 4], X[bb + 5]); w_.w = pk2(X[bb + 6], X[bb + 7]); PF = __builtin_bit_cast(bf16x8, w_); } } while (0)
#define A6_VLD(buf, ss) do { _Pragma("unroll") for (int db = 0; db < NDB; ++db) { vl[buf][db] = vtr(sb + vbase + (16 * (ss)) * VROWB + 64 * db); vh[buf][db] = vtr(sb + vbase + (16 * (ss) + 8) * VROWB + 64 * db); } } while (0)
#define A6_MMA(buf, ss) do { _Pragma("unroll") for (int db = 0; db < NDB; ++db) { const bf16x8 vf_ = __builtin_shufflevector(vl[buf][db], vh[buf][db], 0, 1, 2, 3, 4, 5, 6, 7); o[db] = MFMA32(vf_, pf[ss], o[db]); } } while (0)
#define A6_SGB(nv) do { _Pragma("unroll") for (int db = 0; db < NDB; ++db) { __builtin_amdgcn_sched_group_barrier(0x008, 1, 0); __builtin_amdgcn_sched_group_barrier(A6_VMASK, (nv), 0); __builtin_amdgcn_sched_group_barrier(0x100, 2, 0); } } while (0)
            A6_VLD(0, 0);
            A6_EXP(x0, 0, pf[0]);
            __builtin_amdgcn_sched_barrier(0);
            A6_VLD(1, 1); A6_EXP(x0, 8, pf[1]); A6_MMA(0, 0); A6_SGB(16 / NDB);
            __builtin_amdgcn_sched_barrier(0);
            A6_VLD(0, 2); A6_EXP(x1, 0, pf[2]); A6_MMA(1, 1); A6_SGB(16 / NDB);
            __builtin_amdgcn_sched_barrier(0);
            A6_VLD(1, 3); A6_EXP(x1, 8, pf[3]); A6_MMA(0, 2); A6_SGB(16 / NDB);
            __builtin_amdgcn_sched_barrier(0);
            A6_MMA(1, 3);
            __builtin_amdgcn_sched_barrier(0);
            l_run += ls2[0] + ls2[1];
#undef A6_EXP
#undef A6_VLD
#undef A6_MMA
#undef A6_SGB
            ATT_SETPRIO(0);
        }
        if (more) ATT_WRITE(t + 1);
        __syncthreads();
    }
#undef ATT_ISSUE
#undef ATT_WRITE
#if ATT_STATIC_PRIO
    __builtin_amdgcn_s_setprio(0);
#endif
    const float lt = l_run + shx(l_run, 32, lane), inv = 1.0f / lt;
    if (COMB == 2) {
        const bf16* ip = P.TI + (tok0 + qrow) * (long)P.ldo + ocol + 4 * h; float ss = 0.f;
#pragma unroll
        for (int db = 0; db < NDB; ++db)
#pragma unroll
            for (int g = 0; g < 4; ++g) { const v2u a = *(const v2u*)(ip + 32 * db + 8 * g);
                const float c0 = bflo(a.x) - P.lam * (o[db][4 * g] * inv), c1 = bfhi(a.x) - P.lam * (o[db][4 * g + 1] * inv), c2 = bflo(a.y) - P.lam * (o[db][4 * g + 2] * inv), c3 = bfhi(a.y) - P.lam * (o[db][4 * g + 3] * inv);
                o[db][4 * g] = c0; o[db][4 * g + 1] = c1; o[db][4 * g + 2] = c2; o[db][4 * g + 3] = c3; ss += (c0 * c0 + c1 * c1) + (c2 * c2 + c3 * c3); }
        ss += shx(ss, 32, lane);
        const float rr = P.osc / sqrtf(ss * (1.0f / 128.0f) + LN_EPS);
        bf16* op = P.O + (tok0 + qrow) * (long)P.ldo + ocol + 4 * h;
#pragma unroll
        for (int db = 0; db < NDB; ++db)
#pragma unroll
            for (int g = 0; g < 4; ++g) { const f32x4 gg = *(const f32x4*)(P.gsub + 32 * db + 8 * g + 4 * h);
                v2u w; w.x = pk2(o[db][4 * g] * rr * gg[0], o[db][4 * g + 1] * rr * gg[1]); w.y = pk2(o[db][4 * g + 2] * rr * gg[2], o[db][4 * g + 3] * rr * gg[3]);
                *(v2u*)(op + 32 * db + 8 * g) = w; }
        return;
    }
    bf16* op = P.O + (tok0 + qrow) * (long)P.ldo + ocol + 4 * h;
#pragma unroll
    for (int db = 0; db < NDB; ++db)
#pragma unroll
        for (int g = 0; g < 4; ++g) { v2u w; w.x = pk2(o[db][4 * g] * inv, o[db][4 * g + 1] * inv); w.y = pk2(o[db][4 * g + 2] * inv, o[db][4 * g + 3] * inv);
            *(v2u*)(op + 32 * db + 8 * g) = w; }
}

template <int DQK, int KSPLIT, int DV, bool BIAS, int COMB = 0>
__device__ __forceinline__ void attn_unit7(const AttnP& P, int b, int qt, int qcol, int kcol, int vcol, int ocol, int hb, LAS unsigned char* lds, const int tid_in) {
    constexpr int KROWB = DQK * 2 + 16;
    constexpr int VROWB = (DV == 128) ? 320 : 192;
    constexpr int KBYTES = 64 * KROWB, VBYTES = 64 * VROWB, STAGE = KBYTES + VBYTES + 256, LUT_OFF = 2 * STAGE;
    constexpr int ND = DQK / 16, NDB = DV / 32, KCH = DQK / 8, VCH = DV / 8, NKC = 64 * KCH, NVC = 64 * VCH, KL = (NKC + 511) / 512, VL = (NVC + 511) / 512;
    int tid_ = tid_in; asm volatile("" : "+v"(tid_));
    const int tid = tid_, lane = tid & 63, wid = __builtin_amdgcn_readfirstlane(tid >> 6), r = lane & 31, h = lane >> 5;
    const long tok0 = (long)b * SEQ; const int q0 = qt * 256; const int qrow = q0 + wid * 32 + r;
    bf16x8 qf[ND];
    { const bf16* qp = P.Q + (tok0 + qrow) * (long)P.ldq + qcol + 8 * h;
#pragma unroll
      for (int d = 0; d < ND; ++d) qf[d] = *(const bf16x8*)(qp + 16 * d); }
    int posq = 0, posq_min = 0;
    LAS float* lut = (LAS float*)(lds + LUT_OFF);
    if (BIAS) { posq = P.pos[tok0 + qrow]; int mn = posq;
#pragma unroll
        for (int o = 1; o < 64; o <<= 1) { const int t2 = shxi(mn, o, lane); mn = t2 < mn ? t2 : mn; }
        posq_min = mn;
        if (tid < 132) lut[tid] = P.lut[hb * 132 + tid] - P.lut[hb * 132 + 128]; }
    v4u kreg[KL], vreg[VL]; int preg = 0;
#define ATT_ISSUE(t) do { const long trow = tok0 + 64 * (long)(t); \
        _Pragma("unroll") for (int i = 0; i < KL; ++i) { const int c = tid + 512 * i; if (NKC % 512 == 0 || c < NKC) { const int row = c / KCH, col = (c % KCH) * 8; \
            const bf16* src = (col < KSPLIT) ? P.K1 + (trow + row) * (long)P.ldk1 + kcol + col : P.K2 + (trow + row) * (long)P.ldk2 + (col - KSPLIT); kreg[i] = *(const v4u*)src; } } \
        _Pragma("unroll") for (int i = 0; i < VL; ++i) { const int c = tid + 512 * i; if (NVC % 512 == 0 || c < NVC) { const int row = c / VCH, col = (c % VCH) * 8; vreg[i] = *(const v4u*)(P.V + (trow + row) * (long)P.ldv + vcol + col); } } \
        if (BIAS && tid < 64) preg = P.pos[trow + tid]; } while (0)
#define ATT_WRITE(t) do { LAS unsigned char* sb = lds + ((t) & 1) * STAGE; \
        _Pragma("unroll") for (int i = 0; i < KL; ++i) { const int c = tid + 512 * i; if (NKC % 512 == 0 || c < NKC) { const int row = c / KCH, cc = c % KCH; *(LAS v4u*)(sb + row * KROWB + cc * 16) = kreg[i]; } } \
        _Pragma("unroll") for (int i = 0; i < VL; ++i) { const int c = tid + 512 * i; if (NVC % 512 == 0 || c < NVC) { const int row = c / VCH, cc = c % VCH; *(LAS v4u*)(sb + KBYTES + row * VROWB + cc * 16) = vreg[i]; } } \
        if (BIAS && tid < 64) *(LAS int*)(sb + KBYTES + VBYTES + 4 * tid) = preg; } while (0)
    f32x16 o[NDB];
#pragma unroll
    for (int i = 0; i < NDB; ++i)
#pragma unroll
        for (int j = 0; j < 16; ++j) o[i][j] = 0.f;
    float m_run = 0.f, l_run = 0.f;
    f32x16 csp;
    { const float c0_ = BIAS ? P.lut[hb * 132 + 128] : 0.f;
#pragma unroll
      for (int j = 0; j < 16; ++j) csp[j] = c0_; }
    const int ntiles = (q0 + 256) / 64, my_last = (q0 + wid * 32 + 31) / 64;
#if ATT_STATIC_PRIO
    if (wid >= 4) __builtin_amdgcn_s_setprio(1);
#endif
    ATT_ISSUE(0); ATT_WRITE(0); __syncthreads();
    const int kbase = r * KROWB + 16 * h;
    const int vbase = KBYTES + (4 * h + ((lane & 15) >> 2)) * VROWB + (((lane >> 4) & 1) * 16 + (lane & 3) * 4) * 2;
    for (int t = 0; t < ntiles; ++t) {
        const bool more = (t + 1 < ntiles);
        if (more) ATT_ISSUE(t + 1);
        if (t <= my_last) {
            const LAS unsigned char* sb = lds + (t & 1) * STAGE;
            bool plain = (64 * t + 63 <= q0 + wid * 32);
            if (BIAS) { const int kmax = P.blkmax[(int)(tok0 >> 6) + t]; if (!(plain && (posq_min - kmax >= 113))) plain = false; }
            f32x16 x0 = csp, x1 = csp;
            ATT_SETPRIO(1);
            { bf16x8 kf0[ND], kf1[ND];
#pragma unroll
              for (int d = 0; d < ND; ++d) { kf0[d] = *(const LAS bf16x8*)(sb + kbase + d * 32); kf1[d] = *(const LAS bf16x8*)(sb + kbase + 32 * KROWB + d * 32); }
              __builtin_amdgcn_sched_barrier(0);
#pragma unroll
              for (int d = 0; d < ND; ++d) { x0 = MFMA32(kf0[d], qf[d], x0); x1 = MFMA32(kf1[d], qf[d], x1); } }
            ATT_SETPRIO(0);
            if (!plain) {
#pragma unroll
                for (int g = 0; g < 4; ++g) {
                    int pk0[4] = {0, 0, 0, 0}, pk1[4] = {0, 0, 0, 0};
                    if (BIAS) { const LAS int* pp = (const LAS int*)(sb + KBYTES + VBYTES) + 8 * g + 4 * h;
                        const v4u a = *(const LAS v4u*)pp, c = *(const LAS v4u*)(pp + 32);
                        pk0[0] = a.x; pk0[1] = a.y; pk0[2] = a.z; pk0[3] = a.w; pk1[0] = c.x; pk1[1] = c.y; pk1[2] = c.z; pk1[3] = c.w; }
#pragma unroll
                    for (int j = 0; j < 4; ++j) { const int i = 4 * g + j; const int kidx = 64 * t + 8 * g + 4 * h + j;
                        float v0 = x0[i], v1 = x1[i];
                        if (BIAS) { int n0 = posq - pk0[j]; n0 = n0 < 0 ? 0 : (n0 > 128 ? 128 : n0); int n1 = posq - pk1[j]; n1 = n1 < 0 ? 0 : (n1 > 128 ? 128 : n1); v0 += lut[n0]; v1 += lut[n1]; }
                        if (kidx > qrow) v0 = -INFINITY; if (kidx + 32 > qrow) v1 = -INFINITY;
                        x0[i] = v0; x1[i] = v1; }
                }
            }
            float ma = fmaxf(fmaxf(x0[0], x0[1]), x0[2]), mb = fmaxf(fmaxf(x1[0], x1[1]), x1[2]);
#pragma unroll
            for (int j = 3; j < 15; j += 2) { ma = fmaxf(fmaxf(ma, x0[j]), x0[j + 1]); mb = fmaxf(fmaxf(mb, x1[j]), x1[j + 1]); }
            float mx = fmaxf(fmaxf(ma, mb), fmaxf(x0[15], x1[15]));
            { const auto rr = __builtin_amdgcn_permlane32_swap(__float_as_uint(mx), __float_as_uint(mx), false, false); mx = fmaxf(__uint_as_float(rr[0]), __uint_as_float(rr[1])); }
            if (t == 0 || __any(mx > 8.0f)) {
                const float delta = (t == 0) ? mx : fmaxf(mx, 0.f);
                if (t != 0) { const float alpha = __builtin_amdgcn_exp2f(-delta); l_run *= alpha;
#pragma unroll
                    for (int i = 0; i < NDB; ++i) o[i] = o[i] * alpha; }
                m_run += delta;
#pragma unroll
                for (int j = 0; j < 16; ++j) { x0[j] -= delta; x1[j] -= delta; csp[j] -= delta; }
            }
            f32x2 ls2 = {0.f, 0.f};
            bf16x8 pf[4];
            s16x4 vl[2][NDB], vh[2][NDB];
#define A6_EXP(X, bb, PF) do { \
        X[bb + 0] = __builtin_amdgcn_exp2f(X[bb + 0]); X[bb + 1] = __builtin_amdgcn_exp2f(X[bb + 1]); X[bb + 2] = __builtin_amdgcn_exp2f(X[bb + 2]); X[bb + 3] = __builtin_amdgcn_exp2f(X[bb + 3]); \
        X[bb + 4] = __builtin_amdgcn_exp2f(X[bb + 4]); X[bb + 5] = __builtin_amdgcn_exp2f(X[bb + 5]); X[bb + 6] = __builtin_amdgcn_exp2f(X[bb + 6]); X[bb + 7] = __builtin_amdgcn_exp2f(X[bb + 7]); \
        ls2 += (f32x2){X[bb + 0], X[bb + 1]}; ls2 += (f32x2){X[bb + 2], X[bb + 3]}; ls2 += (f32x2){X[bb + 4], X[bb + 5]}; ls2 += (f32x2){X[bb + 6], X[bb + 7]}; \
        { v4u w_; w_.x = pk2(X[bb + 0], X[bb + 1]); w_.y = pk2(X[bb + 2], X[bb + 3]); w_.z = pk2(X[bb + 4], X[bb + 5]); w_.w = pk2(X[bb + 6], X[bb + 7]); PF = __builtin_bit_cast(bf16x8, w_); } } while (0)
#define A6_VLD(buf, ss) do { _Pragma("unroll") for (int db = 0; db < NDB; ++db) { vl[buf][db] = vtr(sb + vbase + (16 * (ss)) * VROWB + 64 * db); vh[buf][db] = vtr(sb + vbase + (16 * (ss) + 8) * VROWB + 64 * db); } } while (0)
#define A6_MMA(buf, ss) do { _Pragma("unroll") for (int db = 0; db < NDB; ++db) { const bf16x8 vf_ = __builtin_shufflevector(vl[buf][db], vh[buf][db], 0, 1, 2, 3, 4, 5, 6, 7); o[db] = MFMA32(vf_, pf[ss], o[db]); } } while (0)
#define A6_SGB(nv) do { _Pragma("unroll") for (int db = 0; db < NDB; ++db) { __builtin_amdgcn_sched_group_barrier(0x008, 1, 0); __builtin_amdgcn_sched_group_barrier(A6_VMASK, (nv), 0); __builtin_amdgcn_sched_group_barrier(0x100, 2, 0); } } while (0)
            A6_VLD(0, 0);
            A6_EXP(x0, 0, pf[0]);
            __builtin_amdgcn_sched_barrier(0);
            A6_VLD(1, 1); A6_EXP(x0, 8, pf[1]); A6_MMA(0, 0); A6_SGB(16 / NDB);
            __builtin_amdgcn_sched_barrier(0);
            A6_VLD(0, 2); A6_EXP(x1, 0, pf[2]); A6_MMA(1, 1); A6_SGB(16 / NDB);
            __builtin_amdgcn_sched_barrier(0);
            A6_VLD(1, 3); A6_EXP(x1, 8, pf[3]); A6_MMA(0, 2); A6_SGB(16 / NDB);
            __builtin_amdgcn_sched_barrier(0);
            A6_MMA(1, 3);
            __builtin_amdgcn_sched_barrier(0);
            l_run += ls2[0] + ls2[1];
#undef A6_EXP
#undef A6_VLD
#undef A6_MMA
#undef A6_SGB
            ATT_SETPRIO(0);
        }
        if (more) ATT_WRITE(t + 1);
        __syncthreads();
    }
#undef ATT_ISSUE
#undef ATT_WRITE
#if ATT_STATIC_PRIO
    __builtin_amdgcn_s_setprio(0);
#endif
    const float lt = l_run + shx(l_run, 32, lane), inv = 1.0f / lt;
    if (COMB == 2) {
        const bf16* ip = P.TI + (tok0 + qrow) * (long)P.ldo + ocol + 4 * h; float ss = 0.f;
#pragma unroll
        for (int db = 0; db < NDB; ++db)
#pragma unroll
            for (int g = 0; g < 4; ++g) { const v2u a = *(const v2u*)(ip + 32 * db + 8 * g);
                const float c0 = bflo(a.x) - P.lam * (o[db][4 * g] * inv), c1 = bfhi(a.x) - P.lam * (o[db][4 * g + 1] * inv), c2 = bflo(a.y) - P.lam * (o[db][4 * g + 2] * inv), c3 = bfhi(a.y) - P.lam * (o[db][4 * g + 3] * inv);
                o[db][4 * g] = c0; o[db][4 * g + 1] = c1; o[db][4 * g + 2] = c2; o[db][4 * g + 3] = c3; ss += (c0 * c0 + c1 * c1) + (c2 * c2 + c3 * c3); }
        ss += shx(ss, 32, lane);
        const float rr = P.osc / sqrtf(ss * (1.0f / 128.0f) + LN_EPS);
        bf16* op = P.O + (tok0 + qrow) * (long)P.ldo + ocol + 4 * h;
#pragma unroll
        for (int db = 0; db < NDB; ++db)
#pragma unroll
            for (int g = 0; g < 4; ++g) { const f32x4 gg = *(const f32x4*)(P.gsub + 32 * db + 8 * g + 4 * h);
                v2u w; w.x = pk2(o[db][4 * g] * rr * gg[0], o[db][4 * g + 1] * rr * gg[1]); w.y = pk2(o[db][4 * g + 2] * rr * gg[2], o[db][4 * g + 3] * rr * gg[3]);
                *(v2u*)(op + 32 * db + 8 * g) = w; }
        return;
    }
    bf16* op = P.O + (tok0 + qrow) * (long)P.ldo + ocol + 4 * h;
#pragma unroll
    for (int db = 0; db < NDB; ++db)
#pragma unroll
        for (int g = 0; g < 4; ++g) { v2u w; w.x = pk2(o[db][4 * g] * inv, o[db][4 * g + 1] * inv); w.y = pk2(o[db][4 * g + 2] * inv, o[db][4 * g + 3] * inv);
            *(v2u*)(op + 32 * db + 8 * g) = w; }
}

template <int DQK, int KSPLIT, int DV, bool BIAS, int COMB = 0>
__device__ __forceinline__ void attn_unit8(const AttnP& P, int b, int qt, int qcol, int kcol, int vcol, int ocol, int hb, LAS unsigned char* lds, const int tid_in) {
    constexpr int KROWB = DQK * 2 + 16;
    constexpr int VROWB = (DV == 128) ? 320 : 192;
    constexpr int KBYTES = 64 * KROWB, VBYTES = 64 * VROWB, STAGE = KBYTES + VBYTES + 256, LUT_OFF = 2 * STAGE;
    constexpr int ND = DQK / 16, NDB = DV / 32, KCH = DQK / 8, VCH = DV / 8, NKC = 64 * KCH, NVC = 64 * VCH, KL = (NKC + 511) / 512, VL = (NVC + 511) / 512;
    int tid_ = tid_in; asm volatile("" : "+v"(tid_));
    const int tid = tid_, lane = tid & 63, wid = __builtin_amdgcn_readfirstlane(tid >> 6), r = lane & 31, h = lane >> 5;
    const long tok0 = (long)b * SEQ; const int q0 = qt * 256; const int qrow = q0 + wid * 32 + r;
    bf16x8 qf[ND];
    { const bf16* qp = P.Q + (tok0 + qrow) * (long)P.ldq + qcol + 8 * h;
#pragma unroll
      for (int d = 0; d < ND; ++d) qf[d] = *(const bf16x8*)(qp + 16 * d); }
    int posq = 0, posq_min = 0;
    LAS float* lut = (LAS float*)(lds + LUT_OFF);
    if (BIAS) { posq = P.pos[tok0 + qrow]; int mn = posq;
#pragma unroll
        for (int o = 1; o < 64; o <<= 1) { const int t2 = shxi(mn, o, lane); mn = t2 < mn ? t2 : mn; }
        posq_min = mn;
        if (tid < 132) lut[tid] = P.lut[hb * 132 + tid] - P.lut[hb * 132 + 128]; }
    v4u kreg[KL], vreg[VL]; int preg = 0;
#define ATT_ISSUE(t) do { const long trow = tok0 + 64 * (long)(t); \
        _Pragma("unroll") for (int i = 0; i < KL; ++i) { const int c = tid + 512 * i; if (NKC % 512 == 0 || c < NKC) { const int row = c / KCH, col = (c % KCH) * 8; \
            const bf16* src = (col < KSPLIT) ? P.K1 + (trow + row) * (long)P.ldk1 + kcol + col : P.K2 + (trow + row) * (long)P.ldk2 + (col - KSPLIT); kreg[i] = *(const v4u*)src; } } \
        _Pragma("unroll") for (int i = 0; i < VL; ++i) { const int c = tid + 512 * i; if (NVC % 512 == 0 || c < NVC) { const int row = c / VCH, col = (c % VCH) * 8; vreg[i] = *(const v4u*)(P.V + (trow + row) * (long)P.ldv + vcol + col); } } \
        if (BIAS && tid < 64) preg = P.pos[trow + tid]; } while (0)
#define ATT_WRITE(t) do { LAS unsigned char* sb = lds + ((t) & 1) * STAGE; \
        _Pragma("unroll") for (int i = 0; i < KL; ++i) { const int c = tid + 512 * i; if (NKC % 512 == 0 || c < NKC) { const int row = c / KCH, cc = c % KCH; *(LAS v4u*)(sb + row * KROWB + cc * 16) = kreg[i]; } } \
        _Pragma("unroll") for (int i = 0; i < VL; ++i) { const int c = tid + 512 * i; if (NVC % 512 == 0 || c < NVC) { const int row = c / VCH, cc = c % VCH; *(LAS v4u*)(sb + KBYTES + row * VROWB + cc * 16) = vreg[i]; } } \
        if (BIAS && tid < 64) *(LAS int*)(sb + KBYTES + VBYTES + 4 * tid) = preg; } while (0)
    f32x16 o[NDB];
#pragma unroll
    for (int i = 0; i < NDB; ++i)
#pragma unroll
        for (int j = 0; j < 16; ++j) o[i][j] = 0.f;
    float m_run = 0.f, l_run = 0.f;
    f32x16 csp;
    { const float c0_ = BIAS ? P.lut[hb * 132 + 128] : 0.f;
#pragma unroll
      for (int j = 0; j < 16; ++j) csp[j] = c0_; }
    const int ntiles = (q0 + 256) / 64, my_last = (q0 + wid * 32 + 31) / 64;
#if ATT_STATIC_PRIO
    if (wid >= 4) __builtin_amdgcn_s_setprio(1);
#endif
    ATT_ISSUE(0); ATT_WRITE(0); __syncthreads();
    const int kbase = r * KROWB + 16 * h;
    const int vbase = KBYTES + (4 * h + ((lane & 15) >> 2)) * VROWB + (((lane >> 4) & 1) * 16 + (lane & 3) * 4) * 2;
    for (int t = 0; t < ntiles; ++t) {
        const bool more = (t + 1 < ntiles);
        if (more) ATT_ISSUE(t + 1);
        if (t <= my_last) {
            const LAS unsigned char* sb = lds + (t & 1) * STAGE;
            bool plain = (64 * t + 63 <= q0 + wid * 32);
            if (BIAS) { const int kmax = P.blkmax[(int)(tok0 >> 6) + t]; if (!(plain && (posq_min - kmax >= 113))) plain = false; }
            f32x16 x0 = csp, x1 = csp;
            ATT_SETPRIO(1);
            { bf16x8 kf0[ND], kf1[ND];
#pragma unroll
              for (int d = 0; d < ND; ++d) { kf0[d] = *(const LAS bf16x8*)(sb + kbase + d * 32); kf1[d] = *(const LAS bf16x8*)(sb + kbase + 32 * KROWB + d * 32); }
              __builtin_amdgcn_sched_barrier(0);
#pragma unroll
              for (int d = 0; d < ND; ++d) { x0 = MFMA32(kf0[d], qf[d], x0); x1 = MFMA32(kf1[d], qf[d], x1); } }
            ATT_SETPRIO(0);
            if (!plain) {
                const int qrel = qrow - 64 * t - 4 * h;
#pragma unroll
                for (int g = 0; g < 4; ++g) {
                    int pk0[4] = {0, 0, 0, 0}, pk1[4] = {0, 0, 0, 0};
                    if (BIAS) { const LAS int* pp = (const LAS int*)(sb + KBYTES + VBYTES) + 8 * g + 4 * h;
                        const v4u a = *(const LAS v4u*)pp, c = *(const LAS v4u*)(pp + 32);
                        pk0[0] = a.x; pk0[1] = a.y; pk0[2] = a.z; pk0[3] = a.w; pk1[0] = c.x; pk1[1] = c.y; pk1[2] = c.z; pk1[3] = c.w; }
#pragma unroll
                    for (int j = 0; j < 4; ++j) { const int i = 4 * g + j;
                        float v0 = x0[i], v1 = x1[i];
                        if (BIAS) { int n0 = posq - pk0[j]; n0 = n0 < 0 ? 0 : (n0 > 128 ? 128 : n0); int n1 = posq - pk1[j]; n1 = n1 < 0 ? 0 : (n1 > 128 ? 128 : n1); v0 += lut[n0]; v1 += lut[n1]; }
                        if (8 * g + j > qrel) v0 = -INFINITY; if (8 * g + j + 32 > qrel) v1 = -INFINITY;
                        x0[i] = v0; x1[i] = v1; }
                }
            }
            if (t == 0) {
                float ma = fmaxf(fmaxf(x0[0], x0[1]), x0[2]), mb = fmaxf(fmaxf(x1[0], x1[1]), x1[2]);
#pragma unroll
                for (int j = 3; j < 15; j += 2) { ma = fmaxf(fmaxf(ma, x0[j]), x0[j + 1]); mb = fmaxf(fmaxf(mb, x1[j]), x1[j + 1]); }
                float mx = fmaxf(fmaxf(ma, mb), fmaxf(x0[15], x1[15]));
                { const auto rr = __builtin_amdgcn_permlane32_swap(__float_as_uint(mx), __float_as_uint(mx), false, false); mx = fmaxf(__uint_as_float(rr[0]), __uint_as_float(rr[1])); }
                m_run += mx;
#pragma unroll
                for (int j = 0; j < 16; ++j) { x0[j] -= mx; x1[j] -= mx; csp[j] -= mx; }
            }
            f32x2 ls2 = {0.f, 0.f};
            bf16x8 pf[4];
            s16x4 vl[2][NDB], vh[2][NDB];
#define A6_EXP(X, bb, PF) do { \
        X[bb + 0] = __builtin_amdgcn_exp2f(X[bb + 0]); X[bb + 1] = __builtin_amdgcn_exp2f(X[bb + 1]); X[bb + 2] = __builtin_amdgcn_exp2f(X[bb + 2]); X[bb + 3] = __builtin_amdgcn_exp2f(X[bb + 3]); \
        X[bb + 4] = __builtin_amdgcn_exp2f(X[bb + 4]); X[bb + 5] = __builtin_amdgcn_exp2f(X[bb + 5]); X[bb + 6] = __builtin_amdgcn_exp2f(X[bb + 6]); X[bb + 7] = __builtin_amdgcn_exp2f(X[bb + 7]); \
        ls2 += (f32x2){X[bb + 0], X[bb + 1]}; ls2 += (f32x2){X[bb + 2], X[bb + 3]}; ls2 += (f32x2){X[bb + 4], X[bb + 5]}; ls2 += (f32x2){X[bb + 6], X[bb + 7]}; \
        { v4u w_; w_.x = pk2(X[bb + 0], X[bb + 1]); w_.y = pk2(X[bb + 2], X[bb + 3]); w_.z = pk2(X[bb + 4], X[bb + 5]); w_.w = pk2(X[bb + 6], X[bb + 7]); PF = __builtin_bit_cast(bf16x8, w_); } } while (0)
#define A6_VLD(buf, ss) do { _Pragma("unroll") for (int db = 0; db < NDB; ++db) { vl[buf][db] = vtr(sb + vbase + (16 * (ss)) * VROWB + 64 * db); vh[buf][db] = vtr(sb + vbase + (16 * (ss) + 8) * VROWB + 64 * db); } } while (0)
#define A6_MMA(buf, ss) do { _Pragma("unroll") for (int db = 0; db < NDB; ++db) { const bf16x8 vf_ = __builtin_shufflevector(vl[buf][db], vh[buf][db], 0, 1, 2, 3, 4, 5, 6, 7); o[db] = MFMA32(vf_, pf[ss], o[db]); } } while (0)
#define A6_SGB(nv) do { _Pragma("unroll") for (int db = 0; db < NDB; ++db) { __builtin_amdgcn_sched_group_barrier(0x008, 1, 0); __builtin_amdgcn_sched_group_barrier(A6_VMASK, (nv), 0); __builtin_amdgcn_sched_group_barrier(0x100, 2, 0); } } while (0)
            A6_VLD(0, 0);
            A6_EXP(x0, 0, pf[0]);
            __builtin_amdgcn_sched_barrier(0);
            A6_VLD(1, 1); A6_EXP(x0, 8, pf[1]); A6_MMA(0, 0); A6_SGB(16 / NDB);
            __builtin_amdgcn_sched_barrier(0);
            A6_VLD(0, 2); A6_EXP(x1, 0, pf[2]); A6_MMA(1, 1); A6_SGB(16 / NDB);
            __builtin_amdgcn_sched_barrier(0);
            A6_VLD(1, 3); A6_EXP(x1, 8, pf[3]); A6_MMA(0, 2); A6_SGB(16 / NDB);
            __builtin_amdgcn_sched_barrier(0);
            A6_MMA(1, 3);
            __builtin_amdgcn_sched_barrier(0);
            { const float ls = ls2[0] + ls2[1];
              l_run += ls;
              if (t != 0 && __any(ls > 256.0f)) {
                  float ma = fmaxf(fmaxf(x0[0], x0[1]), x0[2]), mb = fmaxf(fmaxf(x1[0], x1[1]), x1[2]);
#pragma unroll
                  for (int j = 3; j < 15; j += 2) { ma = fmaxf(fmaxf(ma, x0[j]), x0[j + 1]); mb = fmaxf(fmaxf(mb, x1[j]), x1[j + 1]); }
                  float mp = fmaxf(fmaxf(ma, mb), fmaxf(x0[15], x1[15]));
                  { const auto rr = __builtin_amdgcn_permlane32_swap(__float_as_uint(mp), __float_as_uint(mp), false, false); mp = fmaxf(__uint_as_float(rr[0]), __uint_as_float(rr[1])); }
                  const float delta = fmaxf(__builtin_amdgcn_logf(mp), 0.f), alpha = __builtin_amdgcn_exp2f(-delta);
                  l_run *= alpha; m_run += delta;
#pragma unroll
                  for (int i = 0; i < NDB; ++i) o[i] = o[i] * alpha;
#pragma unroll
                  for (int j = 0; j < 16; ++j) csp[j] -= delta;
              } }
#undef A6_EXP
#undef A6_VLD
#undef A6_MMA
#undef A6_SGB
            ATT_SETPRIO(0);
        }
        if (more) ATT_WRITE(t + 1);
        __syncthreads();
    }
#undef ATT_ISSUE
#undef ATT_WRITE
#if ATT_STATIC_PRIO
    __builtin_amdgcn_s_setprio(0);
#endif
    const float lt = l_run + shx(l_run, 32, lane), inv = 1.0f / lt;
    if (COMB == 2) {
        const bf16* ip = P.TI + (tok0 + qrow) * (long)P.ldo + ocol + 4 * h; float ss = 0.f;
#pragma unroll
        for (int db = 0; db < NDB; ++db)
#pragma unroll
            for (int g = 0; g < 4; ++g) { const v2u a = *(const v2u*)(ip + 32 * db + 8 * g);
                const float c0 = bflo(a.x) - P.lam * (o[db][4 * g] * inv), c1 = bfhi(a.x) - P.lam * (o[db][4 * g + 1] * inv), c2 = bflo(a.y) - P.lam * (o[db][4 * g + 2] * inv), c3 = bfhi(a.y) - P.lam * (o[db][4 * g + 3] * inv);
                o[db][4 * g] = c0; o[db][4 * g + 1] = c1; o[db][4 * g + 2] = c2; o[db][4 * g + 3] = c3; ss += (c0 * c0 + c1 * c1) + (c2 * c2 + c3 * c3); }
        ss += shx(ss, 32, lane);
        const float rr = P.osc / sqrtf(ss * (1.0f / 128.0f) + LN_EPS);
        bf16* op = P.O + (tok0 + qrow) * (long)P.ldo + ocol + 4 * h;
#pragma unroll
        for (int db = 0; db < NDB; ++db)
#pragma unroll
            for (int g = 0; g < 4; ++g) { const f32x4 gg = *(const f32x4*)(P.gsub + 32 * db + 8 * g + 4 * h);
                v2u w; w.x = pk2(o[db][4 * g] * rr * gg[0], o[db][4 * g + 1] * rr * gg[1]); w.y = pk2(o[db][4 * g + 2] * rr * gg[2], o[db][4 * g + 3] * rr * gg[3]);
                *(v2u*)(op + 32 * db + 8 * g) = w; }
        return;
    }
    bf16* op = P.O + (tok0 + qrow) * (long)P.ldo + ocol + 4 * h;
#pragma unroll
    for (int db = 0; db < NDB; ++db)
#pragma unroll
        for (int g = 0; g < 4; ++g) { v2u w; w.x = pk2(o[db][4 * g] * inv, o[db][4 * g + 1] * inv); w.y = pk2(o[db][4 * g + 2] * inv, o[db][4 * g + 3] * inv);
            *(v2u*)(op + 32 * db + 8 * g) = w; }
}

template <int KL, int VL, int ND> struct AttPre { v4u kA[KL], vA[VL], kB[KL], vB[VL]; int pA, pB; bf16x8 q[ND]; int posq; float lv, c0; int bv; bool valid; };
template <int DQK, int DV> struct AttPreOf { static constexpr int KCH = DQK / 8, VCH = DV / 8; typedef AttPre<(64 * KCH + 511) / 512, (64 * VCH + 511) / 512, DQK / 16> type; };
template <int DQK, int KSPLIT, int DV, bool BIAS, int COMB = 0, int VAR = 0>
__device__ __forceinline__ void attn_unit10(const AttnP& P, int b, int qt, int qcol, int kcol, int vcol, int ocol, int hb, LAS unsigned char* lds, const int tid_in,
                                            typename AttPreOf<DQK, DV>::type& pre, const bool has_next, const int nb, const int nqt, const int nqcol, const int nkcol, const int nvcol, const int nhb) {
    constexpr int KROWB = DQK * 2 + 16;
    constexpr int VROWB = (DV == 128) ? 320 : 192;
    constexpr int KBYTES = 64 * KROWB, VBYTES = 64 * VROWB, STAGE = KBYTES + VBYTES + 256, LUT_OFF = 4 * STAGE;
    constexpr int ND = DQK / 16, NDB = DV / 32, KCH = DQK / 8, VCH = DV / 8, NKC = 64 * KCH, NVC = 64 * VCH, KL = (NKC + 511) / 512, VL = (NVC + 511) / 512;
    int tid_ = tid_in; asm volatile("" : "+v"(tid_));
    const int tid = tid_, lane = tid & 63, wid = __builtin_amdgcn_readfirstlane(tid >> 6), r = lane & 31, h = lane >> 5;
    const long tok0 = (long)b * SEQ; const int q0 = qt * 256; const int qrow = q0 + wid * 32 + r;
    v4u (&kregA)[KL] = pre.kA; v4u (&vregA)[VL] = pre.vA; v4u (&kregB)[KL] = pre.kB; v4u (&vregB)[VL] = pre.vB; int& pregA = pre.pA; int& pregB = pre.pB;
#define ATT_ISSUE1X(t, kreg, vreg, preg, TOK0_, KCOL_, VCOL_) do { const long trow = (TOK0_) + 64 * (long)(t); \
        _Pragma("unroll") for (int i = 0; i < KL; ++i) { const int c = tid + 512 * i; if (NKC % 512 == 0 || c < NKC) { const int row = c / KCH, col = (c % KCH) * 8; \
            const bf16* src = (col < KSPLIT) ? P.K1 + (trow + row) * (long)P.ldk1 + (KCOL_) + col : P.K2 + (trow + row) * (long)P.ldk2 + (col - KSPLIT); kreg[i] = *(const v4u*)src; } } \
        _Pragma("unroll") for (int i = 0; i < VL; ++i) { const int c = tid + 512 * i; if (NVC % 512 == 0 || c < NVC) { const int row = c / VCH, col = (c % VCH) * 8; vreg[i] = *(const v4u*)(P.V + (trow + row) * (long)P.ldv + (VCOL_) + col); } } \
        if (BIAS && tid < 64) preg = P.pos[trow + tid]; } while (0)
#define ATT_ISSUE1(t, kreg, vreg, preg) ATT_ISSUE1X(t, kreg, vreg, preg, tok0, kcol, vcol)
#define ATT_PRELOAD(TOK0_, QROW_, QCOL_, KCOL_, VCOL_, HB_) do { ATT_ISSUE1X(0, kregA, vregA, pregA, TOK0_, KCOL_, VCOL_); ATT_ISSUE1X(1, kregB, vregB, pregB, TOK0_, KCOL_, VCOL_); \
        { const bf16* qp = P.Q + ((TOK0_) + (QROW_)) * (long)P.ldq + (QCOL_) + 8 * h; _Pragma("unroll") for (int d = 0; d < ND; ++d) pre.q[d] = *(const bf16x8*)(qp + 16 * d); } \
        pre.posq = 0; pre.lv = 0.f; pre.bv = 0; pre.c0 = 0.f; \
        if (BIAS) { pre.posq = P.pos[(TOK0_) + (QROW_)]; if (tid < 132) pre.lv = P.lut[(HB_) * 132 + tid]; if (tid >= 192 && tid < 256) pre.bv = P.blkmax[(int)((TOK0_) >> 6) + (tid - 192)]; \
                    pre.c0 = P.lut[(HB_) * 132 + 128]; } } while (0)
#define ATT_WRITE1(t, kreg, vreg, preg) do { LAS unsigned char* sb = lds + ((t) & 3) * STAGE; \
        _Pragma("unroll") for (int i = 0; i < KL; ++i) { const int c = tid + 512 * i; if (NKC % 512 == 0 || c < NKC) { const int row = c / KCH, cc = c % KCH; *(LAS v4u*)(sb + row * KROWB + cc * 16) = kreg[i]; } } \
        _Pragma("unroll") for (int i = 0; i < VL; ++i) { const int c = tid + 512 * i; if (NVC % 512 == 0 || c < NVC) { const int row = c / VCH, cc = c % VCH; *(LAS v4u*)(sb + KBYTES + row * VROWB + cc * 16) = vreg[i]; } } \
        if (BIAS && tid < 64) *(LAS int*)(sb + KBYTES + VBYTES + 4 * tid) = preg; } while (0)
#define ATT_ISSUE(T2) do { ATT_ISSUE1(2 * (T2), kregA, vregA, pregA); ATT_ISSUE1(2 * (T2) + 1, kregB, vregB, pregB); } while (0)
#define ATT_WRITE(T2) do { ATT_WRITE1(2 * (T2), kregA, vregA, pregA); ATT_WRITE1(2 * (T2) + 1, kregB, vregB, pregB); } while (0)
    if (!pre.valid) ATT_PRELOAD(tok0, qrow, qcol, kcol, vcol, hb);
    bf16x8 (&qf)[ND] = pre.q;
    int posq = 0, posq_min = 0;
    LAS float* lut = (LAS float*)(lds + LUT_OFF); LAS int* bmx = (LAS int*)(lds + LUT_OFF + 1024);
    if (BIAS) { posq = pre.posq; int mn = posq;
#pragma unroll
        for (int o = 1; o < 64; o <<= 1) { const int t2 = shxi(mn, o, lane); mn = t2 < mn ? t2 : mn; }
        posq_min = mn;
        if (tid < 132) lut[tid] = pre.lv - pre.c0;
        if (tid >= 192 && tid < 256) bmx[tid - 192] = pre.bv; }
    f32x16 o[NDB];
#pragma unroll
    for (int i = 0; i < NDB; ++i)
#pragma unroll
        for (int j = 0; j < 16; ++j) o[i][j] = 0.f;
    float m_run = 0.f, l_run = 0.f;
    f32x16 csp;
    { const float c0_ = BIAS ? pre.c0 : 0.f;
#pragma unroll
      for (int j = 0; j < 16; ++j) csp[j] = c0_; }
    const int ntiles = (q0 + 256) / 64, my_last = (q0 + wid * 32 + 31) / 64;
#if ATT_STATIC_PRIO
    if (wid >= 4) __builtin_amdgcn_s_setprio(1);
#endif
    ATT_WRITE(0); __syncthreads();
    const int kbase = r * KROWB + 16 * h;
    const int vbase = KBYTES + (4 * h + ((lane & 15) >> 2)) * VROWB + (((lane >> 4) & 1) * 16 + (lane & 3) * 4) * 2;
    for (int T2 = 0; T2 < ntiles / 2; ++T2) {
        const bool more = (2 * T2 + 2 < ntiles);
        if (more && !(VAR & 8)) ATT_ISSUE(T2 + 1);
#pragma unroll 1
        for (int u_ = 0; u_ < 2; ++u_) {
        const int t = 2 * T2 + u_;
        if (t <= my_last) {
            const LAS unsigned char* sb = lds + (t & 3) * STAGE;
            bool plain = (64 * t + 63 <= q0 + wid * 32);
            if (BIAS) { const int kmax = bmx[t]; if (!(plain && (posq_min - kmax >= 113))) plain = false; }
            f32x16 x0 = csp, x1 = csp;
            ATT_SETPRIO(1);
            if (!(VAR & 4)) { bf16x8 kf0[ND], kf1[ND];
#pragma unroll
              for (int d = 0; d < ND; ++d) { kf0[d] = *(const LAS bf16x8*)(sb + kbase + d * 32); kf1[d] = *(const LAS bf16x8*)(sb + kbase + 32 * KROWB + d * 32); }
              __builtin_amdgcn_sched_barrier(0);
#pragma unroll
              for (int d = 0; d < ND; ++d) { x0 = MFMA32(kf0[d], qf[d], x0); x1 = MFMA32(kf1[d], qf[d], x1); } }
            ATT_SETPRIO(0);
            if (!plain) {
                const int qrel = qrow - 64 * t - 4 * h;
#pragma unroll
                for (int g = 0; g < 4; ++g) {
                    int pk0[4] = {0, 0, 0, 0}, pk1[4] = {0, 0, 0, 0};
                    if (BIAS) { const LAS int* pp = (const LAS int*)(sb + KBYTES + VBYTES) + 8 * g + 4 * h;
                        const v4u a = *(const LAS v4u*)pp, c = *(const LAS v4u*)(pp + 32);
                        pk0[0] = a.x; pk0[1] = a.y; pk0[2] = a.z; pk0[3] = a.w; pk1[0] = c.x; pk1[1] = c.y; pk1[2] = c.z; pk1[3] = c.w; }
#pragma unroll
                    for (int j = 0; j < 4; ++j) { const int i = 4 * g + j;
                        float v0 = x0[i], v1 = x1[i];
                        if (BIAS) { int n0 = posq - pk0[j]; n0 = n0 < 0 ? 0 : (n0 > 128 ? 128 : n0); int n1 = posq - pk1[j]; n1 = n1 < 0 ? 0 : (n1 > 128 ? 128 : n1); v0 += lut[n0]; v1 += lut[n1]; }
                        if (8 * g + j > qrel) v0 = -INFINITY; if (8 * g + j + 32 > qrel) v1 = -INFINITY;
                        x0[i] = v0; x1[i] = v1; }
                }
            }
            if (t == 0) {
                float ma = fmaxf(fmaxf(x0[0], x0[1]), x0[2]), mb = fmaxf(fmaxf(x1[0], x1[1]), x1[2]);
#pragma unroll
                for (int j = 3; j < 15; j += 2) { ma = fmaxf(fmaxf(ma, x0[j]), x0[j + 1]); mb = fmaxf(fmaxf(mb, x1[j]), x1[j + 1]); }
                float mx = fmaxf(fmaxf(ma, mb), fmaxf(x0[15], x1[15]));
                { const auto rr = __builtin_amdgcn_permlane32_swap(__float_as_uint(mx), __float_as_uint(mx), false, false); mx = fmaxf(__uint_as_float(rr[0]), __uint_as_float(rr[1])); }
                m_run += mx;
#pragma unroll
                for (int j = 0; j < 16; ++j) { x0[j] -= mx; x1[j] -= mx; csp[j] -= mx; }
            }
            f32x2 ls2 = {0.f, 0.f};
            bf16x8 pf[4];
            s16x4 vl[2][NDB], vh[2][NDB];
#define A6_E2(v_) ((VAR & 1) ? (v_) : __builtin_amdgcn_exp2f(v_))
#define A6_EXP(X, bb, PF) do { \
        X[bb + 0] = A6_E2(X[bb + 0]); X[bb + 1] = A6_E2(X[bb + 1]); X[bb + 2] = A6_E2(X[bb + 2]); X[bb + 3] = A6_E2(X[bb + 3]); \
        X[bb + 4] = A6_E2(X[bb + 4]); X[bb + 5] = A6_E2(X[bb + 5]); X[bb + 6] = A6_E2(X[bb + 6]); X[bb + 7] = A6_E2(X[bb + 7]); \
        ls2 += (f32x2){X[bb + 0], X[bb + 1]}; ls2 += (f32x2){X[bb + 2], X[bb + 3]}; ls2 += (f32x2){X[bb + 4], X[bb + 5]}; ls2 += (f32x2){X[bb + 6], X[bb + 7]}; \
        { v4u w_; w_.x = pk2(X[bb + 0], X[bb + 1]); w_.y = pk2(X[bb + 2], X[bb + 3]); w_.z = pk2(X[bb + 4], X[bb + 5]); w_.w = pk2(X[bb + 6], X[bb + 7]); PF = __builtin_bit_cast(bf16x8, w_); } } while (0)
#define A6_VLD(buf, ss) do { _Pragma("unroll") for (int db = 0; db < NDB; ++db) { vl[buf][db] = vtr(sb + vbase + (16 * (ss)) * VROWB + 64 * db); vh[buf][db] = vtr(sb + vbase + (16 * (ss) + 8) * VROWB + 64 * db); } } while (0)
#define A6_MMA(buf, ss) do { if (VAR & 2) break; _Pragma("unroll") for (int db = 0; db < NDB; ++db) { const bf16x8 vf_ = __builtin_shufflevector(vl[buf][db], vh[buf][db], 0, 1, 2, 3, 4, 5, 6, 7); o[db] = MFMA32(vf_, pf[ss], o[db]); } } while (0)
#define A6_SGB(nv) do { _Pragma("unroll") for (int db = 0; db < NDB; ++db) { __builtin_amdgcn_sched_group_barrier(0x008, 1, 0); __builtin_amdgcn_sched_group_barrier(A6_VMASK, (nv), 0); __builtin_amdgcn_sched_group_barrier(0x100, 2, 0); } } while (0)
            A6_VLD(0, 0);
            A6_EXP(x0, 0, pf[0]);
            __builtin_amdgcn_sched_barrier(0);
            A6_VLD(1, 1); A6_EXP(x0, 8, pf[1]); A6_MMA(0, 0); A6_SGB(16 / NDB);
            __builtin_amdgcn_sched_barrier(0);
            A6_VLD(0, 2); A6_EXP(x1, 0, pf[2]); A6_MMA(1, 1); A6_SGB(16 / NDB);
            __builtin_amdgcn_sched_barrier(0);
            A6_VLD(1, 3); A6_EXP(x1, 8, pf[3]); A6_MMA(0, 2); A6_SGB(16 / NDB);
            __builtin_amdgcn_sched_barrier(0);
            A6_MMA(1, 3);
            __builtin_amdgcn_sched_barrier(0);
            { const float ls = ls2[0] + ls2[1];
              l_run += ls;
              if (t != 0 && __any(ls > 256.0f)) {
                  float ma = fmaxf(fmaxf(x0[0], x0[1]), x0[2]), mb = fmaxf(fmaxf(x1[0], x1[1]), x1[2]);
#pragma unroll
                  for (int j = 3; j < 15; j += 2) { ma = fmaxf(fmaxf(ma, x0[j]), x0[j + 1]); mb = fmaxf(fmaxf(mb, x1[j]), x1[j + 1]); }
                  float mp = fmaxf(fmaxf(ma, mb), fmaxf(x0[15], x1[15]));
                  { const auto rr = __builtin_amdgcn_permlane32_swap(__float_as_uint(mp), __float_as_uint(mp), false, false); mp = fmaxf(__uint_as_float(rr[0]), __uint_as_float(rr[1])); }
                  const float delta = fmaxf(__builtin_amdgcn_logf(mp), 0.f), alpha = __builtin_amdgcn_exp2f(-delta);
                  l_run *= alpha; m_run += delta;
#pragma unroll
                  for (int i = 0; i < NDB; ++i) o[i] = o[i] * alpha;
#pragma unroll
                  for (int j = 0; j < 16; ++j) csp[j] -= delta;
              } }
#undef A6_EXP
#undef A6_E2
#undef A6_VLD
#undef A6_MMA
#undef A6_SGB
            ATT_SETPRIO(0);
        }
        }
        if (more && !(VAR & 8)) ATT_WRITE(T2 + 1);
        if (!(VAR & 16)) __syncthreads();
    }
#if ATT_STATIC_PRIO
    __builtin_amdgcn_s_setprio(0);
#endif
    const long rowoff = (tok0 + qrow) * (long)P.ldo + ocol + 8 * h;
    v4u tiq[NDB][2];
    if (COMB == 2) { const bf16* ip = P.TI + rowoff;
#pragma unroll
        for (int db = 0; db < NDB; ++db)
#pragma unroll
            for (int gp = 0; gp < 2; ++gp) tiq[db][gp] = *(const v4u*)(ip + 32 * db + 16 * gp); }
    __builtin_amdgcn_sched_barrier(0);
    if (has_next) { const long ntok0 = (long)nb * SEQ; const int nqrow = nqt * 256 + wid * 32 + r;
        ATT_PRELOAD(ntok0, nqrow, nqcol, nkcol, nvcol, nhb); pre.valid = true; }
    else pre.valid = false;
    __builtin_amdgcn_sched_barrier(0);
#undef ATT_PRELOAD
#undef ATT_ISSUE
#undef ATT_ISSUE1
#undef ATT_ISSUE1X
#undef ATT_WRITE
#undef ATT_WRITE1
    const float lt = l_run + shx(l_run, 32, lane), inv = 1.0f / lt;
#define A10_SWAP(A_, B_) do { const auto r0_ = __builtin_amdgcn_permlane32_swap((A_).x, (B_).x, false, false); (A_).x = r0_[0]; (B_).x = r0_[1]; \
                              const auto r1_ = __builtin_amdgcn_permlane32_swap((A_).y, (B_).y, false, false); (A_).y = r1_[0]; (B_).y = r1_[1]; } while (0)
    if (COMB == 2) {
        float ss = 0.f;
#pragma unroll
        for (int db = 0; db < NDB; ++db)
#pragma unroll
            for (int gp = 0; gp < 2; ++gp) { const v4u q = tiq[db][gp]; v2u a, c; a.x = q.x; a.y = q.y; c.x = q.z; c.y = q.w; A10_SWAP(a, c);
#pragma unroll
                for (int e = 0; e < 2; ++e) { const int g = 2 * gp + e; const v2u t = e ? c : a;
                    const float c0 = bflo(t.x) - P.lam * (o[db][4 * g] * inv), c1 = bfhi(t.x) - P.lam * (o[db][4 * g + 1] * inv), c2 = bflo(t.y) - P.lam * (o[db][4 * g + 2] * inv), c3 = bfhi(t.y) - P.lam * (o[db][4 * g + 3] * inv);
                    o[db][4 * g] = c0; o[db][4 * g + 1] = c1; o[db][4 * g + 2] = c2; o[db][4 * g + 3] = c3; ss += (c0 * c0 + c1 * c1) + (c2 * c2 + c3 * c3); } }
        ss += shx(ss, 32, lane);
        const float rr = 1.0f / sqrtf(ss * (1.0f / 128.0f) + LN_EPS);
        bf16* op = P.O + rowoff;
#pragma unroll
        for (int db = 0; db < NDB; ++db)
#pragma unroll
            for (int gp = 0; gp < 2; ++gp) { v2u w[2];
#pragma unroll
                for (int e = 0; e < 2; ++e) { const int g = 2 * gp + e; const f32x4 gg = *(const f32x4*)(P.gsub + 32 * db + 8 * g + 4 * h);
                    w[e].x = pk2(o[db][4 * g] * rr * gg[0], o[db][4 * g + 1] * rr * gg[1]); w[e].y = pk2(o[db][4 * g + 2] * rr * gg[2], o[db][4 * g + 3] * rr * gg[3]); }
                A10_SWAP(w[0], w[1]);
                v4u q; q.x = w[0].x; q.y = w[0].y; q.z = w[1].x; q.w = w[1].y; *(v4u*)(op + 32 * db + 16 * gp) = q; }
        return;
    }
    bf16* op = P.O + rowoff;
#pragma unroll
    for (int db = 0; db < NDB; ++db)
#pragma unroll
        for (int gp = 0; gp < 2; ++gp) { v2u w[2];
#pragma unroll
            for (int e = 0; e < 2; ++e) { const int g = 2 * gp + e; w[e].x = pk2(o[db][4 * g] * inv, o[db][4 * g + 1] * inv); w[e].y = pk2(o[db][4 * g + 2] * inv, o[db][4 * g + 3] * inv); }
            A10_SWAP(w[0], w[1]);
            v4u q; q.x = w[0].x; q.y = w[0].y; q.z = w[1].x; q.w = w[1].y; *(v4u*)(op + 32 * db + 16 * gp) = q; }
#undef A10_SWAP
}

template <int DQK, int KSPLIT, int DV, bool BIAS, int COMB = 0>
__device__ __forceinline__ void attn_unit9(const AttnP& P, int b, int qt, int qcol, int kcol, int vcol, int ocol, int hb, LAS unsigned char* lds, const int tid_in) {
    constexpr int KROWB = DQK * 2 + 16;
    constexpr int VROWB = (DV == 128) ? 320 : 192;
    constexpr int KBYTES = 64 * KROWB, VBYTES = 64 * VROWB, STAGE = KBYTES + VBYTES + 256, LUT_OFF = 2 * STAGE;
    constexpr int ND = DQK / 16, NDB = DV / 32, KCH = DQK / 8, VCH = DV / 8, NKC = 64 * KCH, NVC = 64 * VCH, KL = (NKC + 511) / 512, VL = (NVC + 511) / 512;
    int tid_ = tid_in; asm volatile("" : "+v"(tid_));
    const int tid = tid_, lane = tid & 63, wid = __builtin_amdgcn_readfirstlane(tid >> 6), r = lane & 31, h = lane >> 5;
    const long tok0 = (long)b * SEQ; const int q0 = qt * 256; const int qrow = q0 + wid * 32 + r;
    bf16x8 qf[ND];
    { const bf16* qp = P.Q + (tok0 + qrow) * (long)P.ldq + qcol + 8 * h;
#pragma unroll
      for (int d = 0; d < ND; ++d) qf[d] = *(const bf16x8*)(qp + 16 * d); }
    int posq = 0, posq_min = 0;
    LAS float* lut = (LAS float*)(lds + LUT_OFF);
    if (BIAS) { posq = P.pos[tok0 + qrow]; int mn = posq;
#pragma unroll
        for (int o = 1; o < 64; o <<= 1) { const int t2 = shxi(mn, o, lane); mn = t2 < mn ? t2 : mn; }
        posq_min = mn;
        if (tid < 132) lut[tid] = P.lut[hb * 132 + tid] - P.lut[hb * 132 + 128]; }
    v4u kreg[KL], vreg[VL]; int preg = 0;
#define ATT_ISSUE(t) do { const long trow = tok0 + 64 * (long)(t); \
        _Pragma("unroll") for (int i = 0; i < KL; ++i) { const int c = tid + 512 * i; if (NKC % 512 == 0 || c < NKC) { const int row = c / KCH, col = (c % KCH) * 8; \
            const bf16* src = (col < KSPLIT) ? P.K1 + (trow + row) * (long)P.ldk1 + kcol + col : P.K2 + (trow + row) * (long)P.ldk2 + (col - KSPLIT); kreg[i] = *(const v4u*)src; } } \
        _Pragma("unroll") for (int i = 0; i < VL; ++i) { const int c = tid + 512 * i; if (NVC % 512 == 0 || c < NVC) { const int row = c / VCH, col = (c % VCH) * 8; vreg[i] = *(const v4u*)(P.V + (trow + row) * (long)P.ldv + vcol + col); } } \
        if (BIAS && tid < 64) preg = P.pos[trow + tid]; } while (0)
#define ATT_WRITE(t) do { LAS unsigned char* sb = lds + ((t) & 1) * STAGE; \
        _Pragma("unroll") for (int i = 0; i < KL; ++i) { const int c = tid + 512 * i; if (NKC % 512 == 0 || c < NKC) { const int row = c / KCH, cc = c % KCH; *(LAS v4u*)(sb + row * KROWB + cc * 16) = kreg[i]; } } \
        _Pragma("unroll") for (int i = 0; i < VL; ++i) { const int c = tid + 512 * i; if (NVC % 512 == 0 || c < NVC) { const int row = c / VCH, cc = c % VCH; *(LAS v4u*)(sb + KBYTES + row * VROWB + cc * 16) = vreg[i]; } } \
        if (BIAS && tid < 64) *(LAS int*)(sb + KBYTES + VBYTES + 4 * tid) = preg; } while (0)
    f32x16 o[NDB];
#pragma unroll
    for (int i = 0; i < NDB; ++i)
#pragma unroll
        for (int j = 0; j < 16; ++j) o[i][j] = 0.f;
    float m_run = 0.f, l_run = 0.f;
    f32x16 lacc;
#pragma unroll
    for (int j = 0; j < 16; ++j) lacc[j] = 0.f;
    const bf16x8 ones8 = {0x3f80, 0x3f80, 0x3f80, 0x3f80, 0x3f80, 0x3f80, 0x3f80, 0x3f80};
    f32x16 csp;
    { const float c0_ = BIAS ? P.lut[hb * 132 + 128] : 0.f;
#pragma unroll
      for (int j = 0; j < 16; ++j) csp[j] = c0_; }
    const int ntiles = (q0 + 256) / 64, my_last = (q0 + wid * 32 + 31) / 64;
#if ATT_STATIC_PRIO
    if (wid >= 4) __builtin_amdgcn_s_setprio(1);
#endif
    ATT_ISSUE(0); ATT_WRITE(0); __syncthreads();
    const int kbase = r * KROWB + 16 * h;
    const int vbase = KBYTES + (4 * h + ((lane & 15) >> 2)) * VROWB + (((lane >> 4) & 1) * 16 + (lane & 3) * 4) * 2;
    for (int t = 0; t < ntiles; ++t) {
        const bool more = (t + 1 < ntiles);
        if (more) ATT_ISSUE(t + 1);
        if (t <= my_last) {
            const LAS unsigned char* sb = lds + (t & 1) * STAGE;
            bool plain = (64 * t + 63 <= q0 + wid * 32);
            if (t >= 2) {
                const float lnow = lacc[0], ls = lnow - l_run;
                if (__any(ls > 1024.0f)) {
                    const float delta = fmaxf(__builtin_amdgcn_logf(ls) - 4.0f, 0.f), alpha = __builtin_amdgcn_exp2f(-delta);
                    m_run += delta; lacc = lacc * alpha;
#pragma unroll
                    for (int i = 0; i < NDB; ++i) o[i] = o[i] * alpha;
#pragma unroll
                    for (int j = 0; j < 16; ++j) csp[j] -= delta;
                }
                l_run = lacc[0];
            } else if (t == 1) l_run = lacc[0];
            if (BIAS) { const int kmax = P.blkmax[(int)(tok0 >> 6) + t]; if (!(plain && (posq_min - kmax >= 113))) plain = false; }
            f32x16 x0 = csp, x1 = csp;
            ATT_SETPRIO(1);
            { bf16x8 kf0[ND], kf1[ND];
#pragma unroll
              for (int d = 0; d < ND; ++d) { kf0[d] = *(const LAS bf16x8*)(sb + kbase + d * 32); kf1[d] = *(const LAS bf16x8*)(sb + kbase + 32 * KROWB + d * 32); }
              __builtin_amdgcn_sched_barrier(0);
#pragma unroll
              for (int d = 0; d < ND; ++d) { x0 = MFMA32(kf0[d], qf[d], x0); x1 = MFMA32(kf1[d], qf[d], x1); } }
            ATT_SETPRIO(0);
            if (!plain) {
#pragma unroll
                for (int g = 0; g < 4; ++g) {
                    int pk0[4] = {0, 0, 0, 0}, pk1[4] = {0, 0, 0, 0};
                    if (BIAS) { const LAS int* pp = (const LAS int*)(sb + KBYTES + VBYTES) + 8 * g + 4 * h;
                        const v4u a = *(const LAS v4u*)pp, c = *(const LAS v4u*)(pp + 32);
                        pk0[0] = a.x; pk0[1] = a.y; pk0[2] = a.z; pk0[3] = a.w; pk1[0] = c.x; pk1[1] = c.y; pk1[2] = c.z; pk1[3] = c.w; }
#pragma unroll
                    for (int j = 0; j < 4; ++j) { const int i = 4 * g + j; const int kidx = 64 * t + 8 * g + 4 * h + j;
                        float v0 = x0[i], v1 = x1[i];
                        if (BIAS) { int n0 = posq - pk0[j]; n0 = n0 < 0 ? 0 : (n0 > 128 ? 128 : n0); int n1 = posq - pk1[j]; n1 = n1 < 0 ? 0 : (n1 > 128 ? 128 : n1); v0 += lut[n0]; v1 += lut[n1]; }
                        if (kidx > qrow) v0 = -INFINITY; if (kidx + 32 > qrow) v1 = -INFINITY;
                        x0[i] = v0; x1[i] = v1; }
                }
            }
            if (t == 0) {
                float ma = fmaxf(fmaxf(x0[0], x0[1]), x0[2]), mb = fmaxf(fmaxf(x1[0], x1[1]), x1[2]);
#pragma unroll
                for (int j = 3; j < 15; j += 2) { ma = fmaxf(fmaxf(ma, x0[j]), x0[j + 1]); mb = fmaxf(fmaxf(mb, x1[j]), x1[j + 1]); }
                float mx = fmaxf(fmaxf(ma, mb), fmaxf(x0[15], x1[15]));
                { const auto rr = __builtin_amdgcn_permlane32_swap(__float_as_uint(mx), __float_as_uint(mx), false, false); mx = fmaxf(__uint_as_float(rr[0]), __uint_as_float(rr[1])); }
                m_run += mx;
#pragma unroll
                for (int j = 0; j < 16; ++j) { x0[j] -= mx; x1[j] -= mx; csp[j] -= mx; }
            }
            bf16x8 pf[4];
            s16x4 vl[2][NDB], vh[2][NDB];
#define A6_EXP(X, bb, PF) do { \
        X[bb + 0] = __builtin_amdgcn_exp2f(X[bb + 0]); X[bb + 1] = __builtin_amdgcn_exp2f(X[bb + 1]); X[bb + 2] = __builtin_amdgcn_exp2f(X[bb + 2]); X[bb + 3] = __builtin_amdgcn_exp2f(X[bb + 3]); \
        X[bb + 4] = __builtin_amdgcn_exp2f(X[bb + 4]); X[bb + 5] = __builtin_amdgcn_exp2f(X[bb + 5]); X[bb + 6] = __builtin_amdgcn_exp2f(X[bb + 6]); X[bb + 7] = __builtin_amdgcn_exp2f(X[bb + 7]); \
        { v4u w_; w_.x = pk2(X[bb + 0], X[bb + 1]); w_.y = pk2(X[bb + 2], X[bb + 3]); w_.z = pk2(X[bb + 4], X[bb + 5]); w_.w = pk2(X[bb + 6], X[bb + 7]); PF = __builtin_bit_cast(bf16x8, w_); } } while (0)
#define A6_VLD(buf, ss) do { _Pragma("unroll") for (int db = 0; db < NDB; ++db) { vl[buf][db] = vtr(sb + vbase + (16 * (ss)) * VROWB + 64 * db); vh[buf][db] = vtr(sb + vbase + (16 * (ss) + 8) * VROWB + 64 * db); } } while (0)
#define A6_MMA(buf, ss) do { _Pragma("unroll") for (int db = 0; db < NDB; ++db) { const bf16x8 vf_ = __builtin_shufflevector(vl[buf][db], vh[buf][db], 0, 1, 2, 3, 4, 5, 6, 7); o[db] = MFMA32(vf_, pf[ss], o[db]); } lacc = MFMA32(ones8, pf[ss], lacc); } while (0)
#define A6_SGB(nv) do { _Pragma("unroll") for (int db = 0; db < NDB; ++db) { __builtin_amdgcn_sched_group_barrier(0x008, 1, 0); __builtin_amdgcn_sched_group_barrier(A6_VMASK, (nv), 0); __builtin_amdgcn_sched_group_barrier(0x100, 2, 0); } __builtin_amdgcn_sched_group_barrier(0x008, 1, 0); } while (0)
            A6_VLD(0, 0);
            A6_EXP(x0, 0, pf[0]);
            __builtin_amdgcn_sched_barrier(0);
            A6_VLD(1, 1); A6_EXP(x0, 8, pf[1]); A6_MMA(0, 0); A6_SGB(12 / NDB);
            __builtin_amdgcn_sched_barrier(0);
            A6_VLD(0, 2); A6_EXP(x1, 0, pf[2]); A6_MMA(1, 1); A6_SGB(12 / NDB);
            __builtin_amdgcn_sched_barrier(0);
            A6_VLD(1, 3); A6_EXP(x1, 8, pf[3]); A6_MMA(0, 2); A6_SGB(12 / NDB);
            __builtin_amdgcn_sched_barrier(0);
            A6_MMA(1, 3);
            __builtin_amdgcn_sched_barrier(0);
#undef A6_EXP
#undef A6_VLD
#undef A6_MMA
#undef A6_SGB
            ATT_SETPRIO(0);
        }
        if (more) ATT_WRITE(t + 1);
        __syncthreads();
    }
#undef ATT_ISSUE
#undef ATT_WRITE
#if ATT_STATIC_PRIO
    __builtin_amdgcn_s_setprio(0);
#endif
    const float lt = lacc[0], inv = 1.0f / lt;
    if (COMB == 2) {
        const bf16* ip = P.TI + (tok0 + qrow) * (long)P.ldo + ocol + 4 * h; float ss = 0.f;
#pragma unroll
        for (int db = 0; db < NDB; ++db)
#pragma unroll
            for (int g = 0; g < 4; ++g) { const v2u a = *(const v2u*)(ip + 32 * db + 8 * g);
                const float c0 = bflo(a.x) - P.lam * (o[db][4 * g] * inv), c1 = bfhi(a.x) - P.lam * (o[db][4 * g + 1] * inv), c2 = bflo(a.y) - P.lam * (o[db][4 * g + 2] * inv), c3 = bfhi(a.y) - P.lam * (o[db][4 * g + 3] * inv);
                o[db][4 * g] = c0; o[db][4 * g + 1] = c1; o[db][4 * g + 2] = c2; o[db][4 * g + 3] = c3; ss += (c0 * c0 + c1 * c1) + (c2 * c2 + c3 * c3); }
        ss += shx(ss, 32, lane);
        const float rr = P.osc / sqrtf(ss * (1.0f / 128.0f) + LN_EPS);
        bf16* op = P.O + (tok0 + qrow) * (long)P.ldo + ocol + 4 * h;
#pragma unroll
        for (int db = 0; db < NDB; ++db)
#pragma unroll
            for (int g = 0; g < 4; ++g) { const f32x4 gg = *(const f32x4*)(P.gsub + 32 * db + 8 * g + 4 * h);
                v2u w; w.x = pk2(o[db][4 * g] * rr * gg[0], o[db][4 * g + 1] * rr * gg[1]); w.y = pk2(o[db][4 * g + 2] * rr * gg[2], o[db][4 * g + 3] * rr * gg[3]);
                *(v2u*)(op + 32 * db + 8 * g) = w; }
        return;
    }
    bf16* op = P.O + (tok0 + qrow) * (long)P.ldo + ocol + 4 * h;
#pragma unroll
    for (int db = 0; db < NDB; ++db)
#pragma unroll
        for (int g = 0; g < 4; ++g) { v2u w; w.x = pk2(o[db][4 * g] * inv, o[db][4 * g + 1] * inv); w.y = pk2(o[db][4 * g + 2] * inv, o[db][4 * g + 3] * inv);
            *(v2u*)(op + 32 * db + 8 * g) = w; }
}

#undef MFMA32
}

constexpr size_t MiB = 1u << 20;
constexpr size_t WS_CTL = 0, CTL_ZERO_BYTES = 1 * MiB;
constexpr size_t WS_ROPE = 1 * MiB;
constexpr size_t WS_MISC = 5 * MiB;
constexpr size_t WS_XB = 6 * MiB;
constexpr size_t WS_XB8 = 70 * MiB + 16 * MiB;
constexpr size_t WS_PB = 70 * MiB;
constexpr size_t WS_W = 118 * MiB;
constexpr size_t W_IN = WS_W, W_G8 = WS_W + 8 * MiB, W_UQ = WS_W + 12 * MiB, W_UKV = WS_W + 13 * MiB, W_BD = WS_W + 14 * MiB, W_BM = WS_W + 16 * MiB, W_OUT = WS_W + 17 * MiB,
                 W_PG = WS_W + 19 * MiB, W_PP = WS_W + 21 * MiB, W_F13 = WS_W + 22 * MiB  , W_F2E = WS_W + 134 * MiB;
constexpr size_t WS_ACT = 308 * MiB;
constexpr size_t A_DQ = WS_ACT, A_DK = WS_ACT + 64 * MiB, A_DV = WS_ACT + 128 * MiB, A_G = WS_ACT + 192 * MiB, A_C = WS_ACT + 320 * MiB;
constexpr size_t A_OA = A_C + 64 * MiB  , A_MT = A_DK, A_M = A_DV, A_CQ = A_C, A_OA2 = A_C, A_PRE = A_C;
constexpr size_t A_CQN = WS_ACT + 448 * MiB, A_CKVN = WS_ACT + 472 * MiB, A_OB = A_CQN, A_MKR = WS_ACT + 488 * MiB, A_MQ = WS_ACT + 490 * MiB, A_MKV = WS_ACT + 538 * MiB;
constexpr size_t A_H = WS_ACT;
constexpr size_t A_XG = WS_ACT, A_YG = A_XG  , A_TOK = WS_ACT + 264 * MiB, A_HG = WS_ACT + 270 * MiB  , A_PREM = WS_ACT + 512 * MiB;
constexpr size_t W_F13D = WS_ACT + 602 * MiB, W_F2D = WS_ACT + 613 * MiB;
constexpr size_t W_QKV8 = WS_W + 3 * MiB;
constexpr size_t WS_SSP = WS_ACT + 620 * MiB;
constexpr size_t WS_END = WS_ACT + 640 * MiB;
static_assert(MOE_FP8 == 1, "the workspace map assumes fp8 expert activations");
constexpr int CW_BAR = 4096, CW_MOE = 8192, CW_LN = 16384;
constexpr size_t WS_LNST = WS_W + 10 * MiB;
constexpr int CW_DUMMY_ = 0;

constexpr int RING_BYTES = 131072, MISC_OFF = RING_BYTES + 320, LDS_BYTES = 147456;
constexpr int NWAVES = 8;

#ifndef REP_ATTN_D
#define REP_ATTN_D 1
#endif
#ifndef REP_ATTN_M
#define REP_ATTN_M 1
#endif
#ifndef REP_CONV
#define REP_CONV 1
#endif
#ifndef REP_L1
#define REP_L1 1
#endif
#ifndef REP_EW
#define REP_EW 1
#endif
#ifndef REP_BAR
#define REP_BAR 1
#endif
#ifndef REP_LN
#define REP_LN 1
#endif
#ifndef REP_MOE
#define REP_MOE 1
#endif
#ifndef REP_MIX
#define REP_MIX 1
#endif
#ifndef REP_FFN
#define REP_FFN 1
#endif
#ifndef REP_P0
#define REP_P0 1
#endif
#ifndef REP_PPE
#define REP_PPE 1
#endif
#ifndef ATT_UNIT_D
#define ATT_UNIT_D attn_unit10
#endif
#ifndef ATT_UNIT_M
#define ATT_UNIT_M attn_unit10
#endif
#ifndef F8_SP2
#define F8_SP2 true
#endif
#ifndef GEMM_STAGGER
#define GEMM_STAGGER 0
#endif
#ifndef STAG_L1
#define STAG_L1 1500
#endif
#ifndef STAG_H
#define STAG_H 1500
#endif
#ifndef STAG_UP
#define STAG_UP 1000
#endif
#ifndef GEMM_ALIGN
#define GEMM_ALIGN true
#endif
#ifndef UP_ALIGN
#define UP_ALIGN true
#endif
#ifndef PROBE_D
#define PROBE_D -1
#endif
#ifndef PROBE_M
#define PROBE_M -1
#endif
#ifndef LN_FUSE
#define LN_FUSE 1
#endif
#ifndef CONV_IN_DOWN
#define CONV_IN_DOWN 1
#endif
#ifndef CONV_IN_ATTN
#define CONV_IN_ATTN 1
#endif
#ifndef PROBE_NULL_L1
#define PROBE_NULL_L1 0
#endif
#ifndef QKV_FP8
#define QKV_FP8 1
#endif
#define XB_TMO      128
#define XB_XCNT(j)  (256  + 64 * (j))
#define XB_XSUB(j)  (1280 + 64 * (j))
#define XB_XGEN(j)  (2304 + 64 * (j))
#define XB_TOP      3328
#define XB_TOPGEN   3392
#define XCD_BAR_WORDS 3456
#define XB_SPIN_CAP (1u << 18)

__device__ __forceinline__ unsigned xb_ld(unsigned* p)              { return __hip_atomic_load(p, __ATOMIC_RELAXED, __HIP_MEMORY_SCOPE_AGENT); }
__device__ __forceinline__ unsigned xb_add(unsigned* p, unsigned v) { return __hip_atomic_fetch_add(p, v, __ATOMIC_RELAXED, __HIP_MEMORY_SCOPE_AGENT); }
__device__ __forceinline__ unsigned xb_xcc_id() { return (unsigned)__builtin_amdgcn_s_getreg((3 << 11) | 20) & 0xFu; }
#define XB_SPIN(cond, bar) do { unsigned _sp = 0; while (cond) { __builtin_amdgcn_s_sleep(1); \
    if ((++_sp & 255u) == 0u) { if (xb_ld(&(bar)[XB_TMO])) break; if (_sp > XB_SPIN_CAP) { atomicAdd(&(bar)[XB_TMO], 1u); break; } } } } while (0)

struct XcdBarrier {
    unsigned* bar; unsigned x;
    volatile LAS unsigned* st;
};

__device__ __forceinline__ XcdBarrier xcd_barrier_post(unsigned* bar, volatile LAS unsigned* st, const bool t0  ) {
    XcdBarrier b; b.bar = bar; b.x = xb_xcc_id(); b.st = st;
    if (t0) (void)xb_add(&bar[XB_XCNT(b.x)], 1u);
    return b;
}
__device__ __forceinline__ void xcd_barrier_complete(unsigned* bar, unsigned x, unsigned& nloc, unsigned& nx) {
    const unsigned G = gridDim.x * gridDim.y * gridDim.z;
    unsigned sum, cnt, mine, sp = 0u;
    for (;;) {
        sum = 0u; cnt = 0u; mine = 0u;
#pragma unroll
        for (unsigned j = 0; j < 16; ++j) { const unsigned c = xb_ld(&bar[XB_XCNT(j)]); sum += c; cnt += (c > 0u) ? 1u : 0u; mine = (j == x) ? c : mine; }
        if (sum == G) break;
        __builtin_amdgcn_s_sleep(1);
        if ((++sp & 255u) == 0u) { if (xb_ld(&bar[XB_TMO])) break; if (sp > XB_SPIN_CAP) { atomicAdd(&bar[XB_TMO], 1u); break; } }
    }
    nloc = mine > 0u ? mine : 1u; nx = cnt > 0u ? cnt : 1u;
}

__device__ __forceinline__ void xcd_barrier(const XcdBarrier& b, const bool t0) {
    asm volatile("s_waitcnt vmcnt(0)" ::: "memory");
    __syncthreads();
    if (t0) {
        unsigned* bar = b.bar;
        __builtin_amdgcn_s_waitcnt(0);
        unsigned nloc = b.st[0], nx = b.st[1];
        if (nloc == 0u) { xcd_barrier_complete(bar, b.x, nloc, nx); b.st[0] = nloc; b.st[1] = nx; }
        const unsigned old = xb_add(&bar[XB_XSUB(b.x)], 1u);
        const unsigned gen = old / nloc;
        if (old + 1u == (gen + 1u) * nloc) {
            __builtin_amdgcn_fence(__ATOMIC_RELEASE, "agent");
            asm volatile("s_waitcnt vmcnt(0)" ::: "memory");
            const unsigned og = xb_add(&bar[XB_TOP], 1u);
            const unsigned tg = og / nx;
            if (og + 1u == (tg + 1u) * nx) xb_add(&bar[XB_TOPGEN], 1u);
            else XB_SPIN(xb_ld(&bar[XB_TOPGEN]) == tg, bar);
            __builtin_amdgcn_fence(__ATOMIC_ACQUIRE, "agent");
            xb_add(&bar[XB_XGEN(b.x)], 1u);
            asm volatile("s_waitcnt vmcnt(0)" ::: "memory");
        } else {
            XB_SPIN(xb_ld(&bar[XB_XGEN(b.x)]) == gen, bar);
            __builtin_amdgcn_fence(__ATOMIC_ACQUIRE, "agent");
            asm volatile("s_waitcnt vmcnt(0)" ::: "memory");
        }
    }
    __syncthreads();
}

struct Args { const void* in[31]; float* out; unsigned char* ws; int ph_lo, ph_hi, fuse; };

struct Frame {
    LAS unsigned char* lds;
    int tid, lane, wave, gw, NGW, G, vcu;
    const Args* a;
    unsigned char* ws;
};
#define FR_TID(F_) ({ unsigned m1_ = ~0u; asm volatile("" : "+s"(m1_)); (((F_).wave << 6) | (int)__builtin_amdgcn_mbcnt_hi(m1_, __builtin_amdgcn_mbcnt_lo(m1_, 0u))); })
#define INF(i) ((const float*)F.a->in[i])
#define WSP(T_, off) ((T_*)(F.ws + (off)))

__device__ __forceinline__ void conv_w(const Frame& F, const float* src, int ldn, int K, int ncols, int nbatch, size_t sbs, bf16* dst, int rmul, int roff, size_t dbs, const float* kscale) {
    LAS float* scr = (LAS float*)(F.lds + F.wave * 16384);
    const int lane = F.lane, nblk = ncols / 32, kblk = K / 64, per = nblk * kblk, total = per * nbatch;
    for (int it = F.gw; it < total; it += F.NGW) {
        const int bt = it / per, r = it % per, kb = r / nblk, nb = r % nblk, k0 = kb * 64, n0 = nb * 32;
        const float* W = src + (size_t)bt * sbs; bf16* WT = dst + (size_t)bt * dbs;
        float ld_[32];
#pragma unroll
        for (int i = 0; i < 32; ++i) ld_[i] = __builtin_nontemporal_load(W + (size_t)(k0 + 2 * i + (lane >> 5)) * ldn + n0 + (lane & 31));
#pragma unroll
        for (int i = 0; i < 32; ++i) scr[(2 * i + (lane >> 5)) * 33 + (lane & 31)] = ld_[i];
        LDS_WAIT(); asm volatile("" ::: "memory");
        const int c = lane & 7;
        float ks[8];
#pragma unroll
        for (int i = 0; i < 8; ++i) ks[i] = kscale ? kscale[k0 + 8 * c + i] : 1.0f;
#pragma unroll
        for (int j = 0; j < 4; ++j) { const int n = (lane >> 3) + 8 * j; const LAS float* s = scr + (8 * c) * 33 + n;
            v4u o; o.x = pk2(s[0 * 33] * ks[0], s[1 * 33] * ks[1]); o.y = pk2(s[2 * 33] * ks[2], s[3 * 33] * ks[3]); o.z = pk2(s[4 * 33] * ks[4], s[5 * 33] * ks[5]); o.w = pk2(s[6 * 33] * ks[6], s[7 * 33] * ks[7]);
            *(v4u*)(WT + (size_t)(rmul * (n0 + n) + roff) * K + k0 + 8 * c) = o; }
        LDS_WAIT(); asm volatile("" ::: "memory");
    }
}
__device__ __forceinline__ void conv_w8(const Frame& F, const float* src, int ldn, int K, int ncols, int nbatch, size_t sbs, unsigned char* dst, int rmul, int roff, size_t dbs, float scale) {
    LAS float* scr = (LAS float*)(F.lds + F.wave * 16384);
    const int lane = F.lane, nblk = ncols / 32, kblk = K / 64, per = nblk * kblk, total = per * nbatch;
    for (int it = F.gw; it < total; it += F.NGW) {
        const int bt = it / per, r = it % per, kb = r / nblk, nb = r % nblk, k0 = kb * 64, n0 = nb * 32;
        const float* W = src + (size_t)bt * sbs; unsigned char* WT = dst + (size_t)bt * dbs;
        float ld_[32];
#pragma unroll
        for (int i = 0; i < 32; ++i) ld_[i] = __builtin_nontemporal_load(W + (size_t)(k0 + 2 * i + (lane >> 5)) * ldn + n0 + (lane & 31));
#pragma unroll
        for (int i = 0; i < 32; ++i) scr[(2 * i + (lane >> 5)) * 33 + (lane & 31)] = ld_[i];
        LDS_WAIT(); asm volatile("" ::: "memory");
        const int c = lane & 7;
#pragma unroll
        for (int j = 0; j < 4; ++j) { const int n = (lane >> 3) + 8 * j; const LAS float* s = scr + (8 * c) * 33 + n;
            int lo = __builtin_amdgcn_cvt_pk_fp8_f32(s[0 * 33] * scale, s[1 * 33] * scale, 0, false); lo = __builtin_amdgcn_cvt_pk_fp8_f32(s[2 * 33] * scale, s[3 * 33] * scale, lo, true);
            int hi = __builtin_amdgcn_cvt_pk_fp8_f32(s[4 * 33] * scale, s[5 * 33] * scale, 0, false); hi = __builtin_amdgcn_cvt_pk_fp8_f32(s[6 * 33] * scale, s[7 * 33] * scale, hi, true);
            v2u o; o.x = (unsigned)lo; o.y = (unsigned)hi;
            *(v2u*)(WT + (size_t)(rmul * (n0 + n) + roff) * K + k0 + 8 * c) = o; }
        LDS_WAIT(); asm volatile("" ::: "memory");
    }
}
__device__ __forceinline__ void phase_convert(const Frame& F, int L, const int which = 0) {
    const int j = L >> 1;
    if (which != 2) {
    const float* win = INF(4) + (size_t)L * D * IN_COLS;
#if QKV_FP8
    conv_w8(F, win, IN_COLS, D, 3072, 1, 0, WSP(unsigned char, W_QKV8), 1, 0, 0, 32.0f);
    conv_w8(F, win + 3744, IN_COLS, D, 2048, 1, 0, WSP(unsigned char, W_QKV8), 1, 3072, 0, 32.0f);
    conv_w(F, win + 3072, IN_COLS, D, 672, 1, 0, WSP(bf16, W_IN), 1, 0, 0, nullptr);
    { bf16* padr = WSP(bf16, W_IN) + (size_t)672 * D;
#else
    conv_w(F, win, IN_COLS, D, 3072, 1, 0, WSP(bf16, W_IN), 1, 0, 0, nullptr);
    conv_w8(F, win + 3744, IN_COLS, D, 2048, 1, 0, WSP(unsigned char, W_G8), 1, 0, 0, 32.0f);
    conv_w(F, win + 3072, IN_COLS, D, 672, 1, 0, WSP(bf16, W_IN), 1, 3072, 0, nullptr);
    { bf16* padr = WSP(bf16, W_IN) + (size_t)3744 * D;
#endif
      unsigned z_ = 0u; asm volatile("" : "+v"(z_));
      for (int i = F.gw * 64 + F.lane; i < (NIN - IN_COLS) * D / 8; i += F.NGW * 64) ((v4u*)padr)[i] = (v4u){z_, z_, z_, z_}; }
    conv_w(F, INF(12) + (size_t)L * QR * 768, 768, QR, 768, 1, 0, WSP(bf16, W_UQ), 1, 0, 0, INF(11) + L * QR);
    conv_w(F, INF(14) + (size_t)L * KVR * 1024, 1024, KVR, 1024, 1, 0, WSP(bf16, W_UKV), 1, 0, 0, INF(13) + L * KVR);
    conv_w(F, INF(15) + (size_t)L * D * D, D, D, D, 1, 0, WSP(bf16, W_BD), 1, 0, 0, nullptr);
    conv_w(F, INF(16) + (size_t)L * 512 * D, D, 512, D, 1, 0, WSP(bf16, W_BM), 1, 0, 0, nullptr);
    conv_w(F, INF(17) + (size_t)L * D * D, D, D, D, 1, 0, WSP(bf16, W_OUT), 1, 0, 0, nullptr);
    conv_w8(F, INF(27) + (size_t)L * D * D, D, D, D, 1, 0, WSP(unsigned char, W_PG), 1, 0, 0, 32.0f);
    conv_w(F, INF(28) + (size_t)L * PLE * D, D, PLE, D, 1, 0, WSP(bf16, W_PP), 1, 0, 0, nullptr);
    }
    if ((L & 1) == 0) { if (which != 2) {
        conv_w(F, INF(20) + (size_t)j * D * DENSE_FF, DENSE_FF, D, DENSE_FF, 1, 0, WSP(bf16, W_F13D), 2, 0, 0, nullptr);
        conv_w(F, INF(21) + (size_t)j * D * DENSE_FF, DENSE_FF, D, DENSE_FF, 1, 0, WSP(bf16, W_F13D), 2, 1, 0, nullptr);
        conv_w(F, INF(22) + (size_t)j * DENSE_FF * D, D, DENSE_FF, D, 1, 0, WSP(bf16, W_F2D), 1, 0, 0, nullptr); }
    } else if (which != 1) {
        const size_t eo = (size_t)j * NEXP * D * EXPERT_FF;
#if MOE_FP8
        conv_w8(F, INF(24) + eo, EXPERT_FF, D, EXPERT_FF, NEXP, (size_t)D * EXPERT_FF, WSP(unsigned char, W_F13), 2, 0, (size_t)2 * EXPERT_FF * D, 32.0f);
        conv_w8(F, INF(25) + eo, EXPERT_FF, D, EXPERT_FF, NEXP, (size_t)D * EXPERT_FF, WSP(unsigned char, W_F13), 2, 1, (size_t)2 * EXPERT_FF * D, 32.0f);
        conv_w8(F, INF(26) + eo, D, EXPERT_FF, D, NEXP, (size_t)EXPERT_FF * D, WSP(unsigned char, W_F2E), 1, 0, (size_t)D * EXPERT_FF, 128.0f);
#else
        conv_w(F, INF(24) + eo, EXPERT_FF, D, EXPERT_FF, NEXP, (size_t)D * EXPERT_FF, WSP(bf16, W_F13), 2, 0, (size_t)2 * EXPERT_FF * D, nullptr);
        conv_w(F, INF(25) + eo, EXPERT_FF, D, EXPERT_FF, NEXP, (size_t)D * EXPERT_FF, WSP(bf16, W_F13), 2, 1, (size_t)2 * EXPERT_FF * D, nullptr);
        conv_w(F, INF(26) + eo, D, EXPERT_FF, D, NEXP, (size_t)EXPERT_FF * D, WSP(bf16, W_F2E), 1, 0, (size_t)D * EXPERT_FF, nullptr);
#endif
    }
    if (which != 2) { const f32x4* ps = (const f32x4*)(INF(1) + (size_t)L * T * PLE); v2u* pd = WSP(v2u, WS_PB);
      for (int i = F.gw * 64 + F.lane; i < T * PLE / 4; i += F.NGW * 64) { const f32x4 v = __builtin_nontemporal_load(ps + i); v2u o; o.x = pk2(v[0], v[1]); o.y = pk2(v[2], v[3]); pd[i] = o; } }
}

__device__ __forceinline__ void phase_prologue(const Frame& F) {
    const int* pos = (const int*)F.a->in[2];
    for (int m = F.gw; m < T; m += F.NGW) {
        const f32x4* xr = (const f32x4*)(INF(0) + (size_t)m * D) + F.lane; v2u* br = WSP(v2u, WS_XB) + (size_t)m * (D / 4) + F.lane;
#pragma unroll
        for (int j = 0; j < 4; ++j) { const f32x4 v = __builtin_nontemporal_load(xr + 64 * j); v2u o; o.x = pk2(v[0], v[1]); o.y = pk2(v[2], v[3]); br[64 * j] = o;
            int w8 = __builtin_amdgcn_cvt_pk_fp8_f32(v[0], v[1], 0, false); w8 = __builtin_amdgcn_cvt_pk_fp8_f32(v[2], v[3], w8, true); (WSP(int, WS_XB8) + (size_t)m * (D / 4) + F.lane)[64 * j] = w8; }
    }
    { float* rope = WSP(float, WS_ROPE);
      for (int idx = F.gw * 64 + F.lane; idx < T * 16; idx += F.NGW * 64) {
          const int t = idx >> 4, j = idx & 15;
          double inv = 1.0; for (int i = 0; i < j; ++i) inv *= 0.5623413251903491;
          const double ang = (double)pos[t] * inv;
          const double nq = __builtin_rint(ang * 0.6366197723675814);
          double y = __builtin_fma(-nq, 1.5707963267948966, ang); y = __builtin_fma(-nq, 6.123233995736766e-17, y);
          const double y2 = y * y;
          double sp = 1.0 / 6227020800.0; sp = sp * y2 - 1.0 / 39916800.0; sp = sp * y2 + 1.0 / 362880.0; sp = sp * y2 - 1.0 / 5040.0; sp = sp * y2 + 1.0 / 120.0; sp = sp * y2 - 1.0 / 6.0;
          const double sn = y + y * y2 * sp;
          double cp = -1.0 / 87178291200.0; cp = cp * y2 + 1.0 / 479001600.0; cp = cp * y2 - 1.0 / 3628800.0; cp = cp * y2 + 1.0 / 40320.0; cp = cp * y2 - 1.0 / 720.0; cp = cp * y2 + 1.0 / 24.0; cp = cp * y2 - 0.5;
          const double cs = 1.0 + y2 * cp;
          const int q = ((int)nq) & 3;
          const double c = (q == 0) ? cs : (q == 1) ? -sn : (q == 2) ? -cs : sn;
          const double s = (q == 0) ? sn : (q == 1) ? cs : (q == 2) ? -sn : -cs;
          rope[2 * idx] = (float)c; rope[2 * idx + 1] = (float)s;
      } }
    { int* bm = WSP(int, WS_MISC);
      for (int blk = F.gw; blk < T / 64; blk += F.NGW) { int v = pos[blk * 64 + F.lane];
#pragma unroll
          for (int o = 1; o < 64; o <<= 1) { const int t2 = shxi(v, o, F.lane); v = t2 > v ? t2 : v; }
          if (F.lane == 0) bm[blk] = v; } }
    { float* lut = WSP(float, WS_MISC + 4096); const float* tab = INF(3);
      for (int idx = F.gw * 64 + F.lane; idx < 8 * 132; idx += F.NGW * 64) { const int hh = idx / 132, n = idx % 132;
          int bk = n;
          if (n >= 16) bk = 16 + (n >= 19) + (n >= 21) + (n >= 24) + (n >= 27) + (n >= 31) + (n >= 35) + (n >= 40) + (n >= 46) + (n >= 52) + (n >= 59) + (n >= 67) + (n >= 77) + (n >= 87) + (n >= 99) + (n >= 113);
          lut[idx] = tab[bk * 8 + hh] * LOG2E; } }
    { float* gt = WSP(float, WS_MISC + 32768); const float* gs = INF(10);
      for (int idx = F.gw * 64 + F.lane; idx < DEPTH * 128; idx += F.NGW * 64) { const int L_ = idx >> 7; gt[idx] = gs[idx] * (1.0f - (0.8f - 0.6f * expf(-0.3f * (float)L_))); } }
    for (int rep = 0; rep < REP_CONV; ++rep) phase_convert(F, 0);
}

__device__ __forceinline__ void phase_rms_rope(const Frame& F) {
    const bf16* CQ = WSP(bf16, A_CQ); const float* rope = WSP(float, WS_ROPE);
    bf16* CQN = WSP(bf16, A_CQN); bf16* CKVN = WSP(bf16, A_CKVN); bf16* MKR = WSP(bf16, A_MKR);
    const int l = F.lane;
    for (int m0 = F.gw; m0 < T; m0 += 4 * F.NGW) {
        unsigned q0[4], q1[4], q2[4]; v2u kvp[4]; unsigned short k1[4], k2[4]; float rc[4], rs[4];
#pragma unroll
        for (int q = 0; q < 4; ++q) { const int m = (m0 + q * F.NGW < T) ? m0 + q * F.NGW : m0; const bf16* c = CQ + (size_t)m * 768;
            q0[q] = *(const unsigned*)(c + 6 * l); q1[q] = *(const unsigned*)(c + 6 * l + 2); q2[q] = *(const unsigned*)(c + 6 * l + 4);
            kvp[q] = *(const v2u*)(c + QR + 4 * l);
            k1[q] = 0; k2[q] = 0; rc[q] = 0.f; rs[q] = 0.f;
            if (l < 16) { k1[q] = c[QR + KVR + l]; k2[q] = c[QR + KVR + 16 + l]; rc[q] = rope[(size_t)m * 32 + 2 * l]; rs[q] = rope[(size_t)m * 32 + 2 * l + 1]; } }
#pragma unroll
        for (int q = 0; q < 4; ++q) { const int m = m0 + q * F.NGW; if (m >= T) break;
            const f32x2 a0 = {bflo(q0[q]), bfhi(q0[q])}, a1 = {bflo(q1[q]), bfhi(q1[q])}, a2 = {bflo(q2[q]), bfhi(q2[q])};
            const f32x4 kv = {bflo(kvp[q].x), bfhi(kvp[q].x), bflo(kvp[q].y), bfhi(kvp[q].y)};
            const float x1 = bflo((unsigned)k1[q]), x2 = bflo((unsigned)k2[q]);
            const float sq = wave_sum(l, a0[0] * a0[0] + a0[1] * a0[1] + a1[0] * a1[0] + a1[1] * a1[1] + a2[0] * a2[0] + a2[1] * a2[1]);
            const float sk = wave_sum(l, kv[0] * kv[0] + kv[1] * kv[1] + kv[2] * kv[2] + kv[3] * kv[3]);
            const float rq = 1.0f / sqrtf(sq * (1.0f / QR) + LN_EPS), rk = 1.0f / sqrtf(sk * (1.0f / KVR) + LN_EPS);
            unsigned* qo = (unsigned*)(CQN + (size_t)m * QR + 6 * l);
            qo[0] = pk2(a0[0] * rq, a0[1] * rq); qo[1] = pk2(a1[0] * rq, a1[1] * rq); qo[2] = pk2(a2[0] * rq, a2[1] * rq);
            v2u ko; ko.x = pk2(kv[0] * rk, kv[1] * rk); ko.y = pk2(kv[2] * rk, kv[3] * rk);
            *(v2u*)(CKVN + (size_t)m * KVR + 4 * l) = ko;
            if (l < 16) { const float o1 = x1 * rc[q] - x2 * rs[q], o2 = x1 * rs[q] + x2 * rc[q]; const unsigned w = pk2(o1, o2);
                MKR[(size_t)m * 32 + l] = (bf16)(w & 0xffffu); MKR[(size_t)m * 32 + 16 + l] = (bf16)(w >> 16); }
        }
    }
}

template <bool ROUTE, bool GATHER>
__device__ __forceinline__ void phase_ln(const Frame& F, const bf16* PRE, const float* gam, const float* bet, const float* wr, int moe_j, const bool write_f32) {
    const int l = F.lane;
    const bf16* YG = WSP(bf16, A_YG); int* TOKE = WSP(int, A_TOK); float* TOKG = WSP(float, A_TOK + 1 * MiB); const int* TOKR = WSP(int, A_TOK + 2 * MiB);
    int* TOKS = WSP(int, A_TOK + 3 * MiB); int* CNTW = WSP(int, A_TOK + 4 * MiB);
    int rc0 = 0, rc1 = 0, rc2 = 0, rc3 = 0, rc4 = 0, rc5 = 0, rc6 = 0, rc7 = 0; (void)moe_j;
    f32x4 gv[4], bv[4];
#pragma unroll
    for (int j = 0; j < 4; ++j) { gv[j] = *(const f32x4*)(gam + 4 * l + 256 * j); bv[j] = *(const f32x4*)(bet + 4 * l + 256 * j); }
    f32x4 rw0[4][4], rw1[4][4];
    if (ROUTE) {
#pragma unroll
        for (int j = 0; j < 4; ++j)
#pragma unroll
            for (int c = 0; c < 4; ++c) { const float* w = wr + (size_t)(4 * l + 256 * j + c) * 8; rw0[j][c] = *(const f32x4*)w; rw1[j][c] = *(const f32x4*)(w + 4); }
    }
    int pr0[2] = {0, 0}, pr1[2] = {0, 0}; float pg0[2] = {0.f, 0.f}, pg1[2] = {0.f, 0.f};
    if (GATHER) {
#pragma unroll
        for (int q = 0; q < 2; ++q) { const int m = (F.gw + q * F.NGW < T) ? F.gw + q * F.NGW : F.gw; pr0[q] = TOKR[2 * m]; pr1[q] = TOKR[2 * m + 1]; pg0[q] = TOKG[2 * m]; pg1[q] = TOKG[2 * m + 1]; } }
    for (int m0 = F.gw; m0 < T; m0 += 2 * F.NGW) {
        v2u raw[2][4]; v2u y0[2][4], y1[2][4]; float g0[2] = {0.f, 0.f}, g1[2] = {0.f, 0.f};
#pragma unroll
        for (int q = 0; q < 2; ++q) { const int m = (m0 + q * F.NGW < T) ? m0 + q * F.NGW : m0;     const v2u* xr = (const v2u*)(PRE + (size_t)m * D) + l;
#pragma unroll
            for (int j = 0; j < 4; ++j) raw[q][j] = xr[64 * j];
            if (GATHER) { const int r0 = pr0[q], r1 = pr1[q]; g0[q] = pg0[q]; g1[q] = pg1[q];
                const v2u* p0 = (const v2u*)(YG + (size_t)r0 * D) + l; const v2u* p1 = (const v2u*)(YG + (size_t)r1 * D) + l;
#pragma unroll
                for (int j = 0; j < 4; ++j) { y0[q][j] = p0[64 * j]; y1[q][j] = p1[64 * j]; } } }
        if (GATHER && m0 + 2 * F.NGW < T) {
#pragma unroll
            for (int q = 0; q < 2; ++q) { const int mb = m0 + 2 * F.NGW, m = (mb + q * F.NGW < T) ? mb + q * F.NGW : mb; pr0[q] = TOKR[2 * m]; pr1[q] = TOKR[2 * m + 1]; pg0[q] = TOKG[2 * m]; pg1[q] = TOKG[2 * m + 1]; } }
#pragma unroll
        for (int q = 0; q < 2; ++q) { const int m = m0 + q * F.NGW; if (m >= T) break;
            f32x4 v[4]; float s = 0.f;
#pragma unroll
            for (int j = 0; j < 4; ++j) { const v2u a = raw[q][j]; v[j][0] = bflo(a.x); v[j][1] = bfhi(a.x); v[j][2] = bflo(a.y); v[j][3] = bfhi(a.y); }
            if (GATHER) {
#pragma unroll
                for (int j = 0; j < 4; ++j) { const v2u a = y0[q][j], b = y1[q][j];
                    v[j][0] += g0[q] * bflo(a.x) + g1[q] * bflo(b.x); v[j][1] += g0[q] * bfhi(a.x) + g1[q] * bfhi(b.x); v[j][2] += g0[q] * bflo(a.y) + g1[q] * bflo(b.y); v[j][3] += g0[q] * bfhi(a.y) + g1[q] * bfhi(b.y); } }
#pragma unroll
            for (int j = 0; j < 4; ++j) s += (v[j][0] + v[j][1]) + (v[j][2] + v[j][3]);
            const float mean = wave_sum(l, s) * (1.f / D); float s2 = 0.f;
#pragma unroll
            for (int j = 0; j < 4; ++j) { v[j] = v[j] - mean; s2 += (v[j][0] * v[j][0] + v[j][1] * v[j][1]) + (v[j][2] * v[j][2] + v[j][3] * v[j][3]); }
            const float rstd = 1.f / sqrtf(wave_sum(l, s2) * (1.f / D) + LN_EPS);
            f32x4* orow = (f32x4*)(F.a->out + (size_t)m * D) + l; v2u* br = WSP(v2u, WS_XB) + (size_t)m * (D / 4) + l;
#pragma unroll
            for (int j = 0; j < 4; ++j) { v[j] = v[j] * rstd * gv[j] + bv[j]; if (write_f32) { orow[64 * j] = v[j]; continue; }
                v2u o; o.x = pk2(v[j][0], v[j][1]); o.y = pk2(v[j][2], v[j][3]); br[64 * j] = o;
                int w8 = __builtin_amdgcn_cvt_pk_fp8_f32(v[j][0], v[j][1], 0, false); w8 = __builtin_amdgcn_cvt_pk_fp8_f32(v[j][2], v[j][3], w8, true); (WSP(int, WS_XB8) + (size_t)m * (D / 4) + l)[64 * j] = w8; }
            if (ROUTE) {
                float lg[8];
#pragma unroll
                for (int e = 0; e < 8; ++e) lg[e] = 0.f;
#pragma unroll
                for (int j = 0; j < 4; ++j)
#pragma unroll
                    for (int c = 0; c < 4; ++c) { const f32x4 w0 = rw0[j][c], w1 = rw1[j][c]; const float xv = v[j][c];
                        lg[0] += xv * w0[0]; lg[1] += xv * w0[1]; lg[2] += xv * w0[2]; lg[3] += xv * w0[3]; lg[4] += xv * w1[0]; lg[5] += xv * w1[1]; lg[6] += xv * w1[2]; lg[7] += xv * w1[3]; }
#pragma unroll
                for (int e = 0; e < 8; ++e) lg[e] = wave_sum(l, lg[e]);
                int e0 = 0; float v0 = lg[0];
#pragma unroll
                for (int e = 1; e < 8; ++e) if (lg[e] > v0) { v0 = lg[e]; e0 = e; }
                int e1 = -1; float v1 = -INFINITY;
#pragma unroll
                for (int e = 0; e < 8; ++e) if (e != e0 && lg[e] > v1) { v1 = lg[e]; e1 = e; }
                const float gg1 = 1.0f / (1.0f + expf(v0 - v1)), gg0 = 1.0f - gg1;
                const int s0 = (e0 == 0) ? rc0 : (e0 == 1) ? rc1 : (e0 == 2) ? rc2 : (e0 == 3) ? rc3 : (e0 == 4) ? rc4 : (e0 == 5) ? rc5 : (e0 == 6) ? rc6 : rc7;
                const int s1 = (e1 == 0) ? rc0 : (e1 == 1) ? rc1 : (e1 == 2) ? rc2 : (e1 == 3) ? rc3 : (e1 == 4) ? rc4 : (e1 == 5) ? rc5 : (e1 == 6) ? rc6 : rc7;
                rc0 += (e0 == 0) + (e1 == 0); rc1 += (e0 == 1) + (e1 == 1); rc2 += (e0 == 2) + (e1 == 2); rc3 += (e0 == 3) + (e1 == 3);
                rc4 += (e0 == 4) + (e1 == 4); rc5 += (e0 == 5) + (e1 == 5); rc6 += (e0 == 6) + (e1 == 6); rc7 += (e0 == 7) + (e1 == 7);
                if (l == 0) { TOKE[2 * m] = e0; TOKE[2 * m + 1] = e1; TOKG[2 * m] = gg0; TOKG[2 * m + 1] = gg1; TOKS[2 * m] = s0; TOKS[2 * m + 1] = s1; }
            }
        }
    }
    if (ROUTE && (FR_TID(F) & 63) == 0) { int* cw = CNTW + (size_t)F.gw * 8; cw[0] = rc0; cw[1] = rc1; cw[2] = rc2; cw[3] = rc3; cw[4] = rc4; cw[5] = rc5; cw[6] = rc6; cw[7] = rc7; }
}

struct MoeTiles { int pend[8]; int total; };
__device__ __forceinline__ void moe_tiles(const Frame& F, int moe_j, MoeTiles& mt) {
    const int* tot = WSP(int, A_TOK + 5 * MiB); int acc = 0; (void)moe_j;
#pragma unroll
    for (int e = 0; e < 8; ++e) { const int c = tot[e]; acc += (c + 255) >> 8; mt.pend[e] = acc; }
    mt.total = acc;
}
__device__ __forceinline__ void phase_scatter(const Frame& F, int moe_j) {
    (void)moe_j;
    const int* CNTW = WSP(int, A_TOK + 4 * MiB); const int* TOKS = WSP(int, A_TOK + 3 * MiB); int* TOT = WSP(int, A_TOK + 5 * MiB);
    const int* TOKE = WSP(int, A_TOK); int* TOKR = WSP(int, A_TOK + 2 * MiB);
    const v4u* XB = WSP(v4u, WS_XB); v4u* XG = WSP(v4u, A_XG); const int l = F.lane;
    LAS int* red = (LAS int*)F.lds;
    int tot[8], pre[8];
#pragma unroll
    for (int e = 0; e < 8; ++e) { tot[e] = 0; pre[e] = 0; }
    const int wg0 = F.vcu * NWAVES;
    for (int w = F.tid; w < F.NGW; w += NWAVES * 64) { const v4u a = *(const v4u*)(CNTW + (size_t)w * 8), b = *(const v4u*)(CNTW + (size_t)w * 8 + 4); const int below = (w < wg0) ? 1 : 0;
        tot[0] += a.x; tot[1] += a.y; tot[2] += a.z; tot[3] += a.w; tot[4] += b.x; tot[5] += b.y; tot[6] += b.z; tot[7] += b.w;
        pre[0] += below * (int)a.x; pre[1] += below * (int)a.y; pre[2] += below * (int)a.z; pre[3] += below * (int)a.w; pre[4] += below * (int)b.x; pre[5] += below * (int)b.y; pre[6] += below * (int)b.z; pre[7] += below * (int)b.w; }
#pragma unroll
    for (int e = 0; e < 8; ++e) {
#pragma unroll
        for (int o = 1; o < 64; o <<= 1) { tot[e] += shxi(tot[e], o, l); pre[e] += shxi(pre[e], o, l); } }
    if (l == 0) {
#pragma unroll
        for (int e = 0; e < 8; ++e) { red[F.wave * 16 + e] = tot[e]; red[F.wave * 16 + 8 + e] = pre[e]; } }
    __syncthreads();
    int base[8]; int acc = 0;
#pragma unroll
    for (int e = 0; e < 8; ++e) { int t = 0, p = 0;
#pragma unroll
        for (int w = 0; w < NWAVES; ++w) { t += red[w * 16 + e]; p += red[w * 16 + 8 + e]; }
        int mine = 0;
#pragma unroll
        for (int w = 0; w < NWAVES; ++w) { const int c = CNTW[(size_t)(wg0 + w) * 8 + e]; mine += (w < F.wave) ? c : 0; }
        base[e] = acc * 256 + p + mine; acc += (t + 255) >> 8;
        if (F.vcu == 0 && F.tid == 0) TOT[e] = t; }
    __syncthreads();
    static_assert(MOE_FP8 == 1, "scatter copies the fp8 rows");
    const v4u* X8 = WSP(v4u, WS_XB8);
    for (int m0 = F.gw; m0 < T; m0 += 4 * F.NGW) {
        int e_[4][2], s_[4][2]; v4u row_[4];
#pragma unroll
        for (int q = 0; q < 4; ++q) { const int m = (m0 + q * F.NGW < T) ? m0 + q * F.NGW : m0;
            e_[q][0] = TOKE[2 * m]; e_[q][1] = TOKE[2 * m + 1]; s_[q][0] = TOKS[2 * m]; s_[q][1] = TOKS[2 * m + 1]; row_[q] = X8[(size_t)m * 64 + l]; }
#pragma unroll
        for (int q = 0; q < 4; ++q) { const int m = m0 + q * F.NGW; if (m >= T) break;
            int rows[2];
#pragma unroll
            for (int k = 0; k < 2; ++k) { const int e = e_[q][k];
                const int bs = (e == 0) ? base[0] : (e == 1) ? base[1] : (e == 2) ? base[2] : (e == 3) ? base[3] : (e == 4) ? base[4] : (e == 5) ? base[5] : (e == 6) ? base[6] : base[7];
                rows[k] = bs + s_[q][k]; }
            ((v4u*)XG)[(size_t)rows[0] * 64 + l] = row_[q]; ((v4u*)XG)[(size_t)rows[1] * 64 + l] = row_[q];
            if (l == 0) { TOKR[2 * m] = rows[0]; TOKR[2 * m + 1] = rows[1]; } }
    }
}

template <int VAR>
__device__ __forceinline__ void phase_attn_diff(const Frame& F, int L) {
    const float lam_init = 0.8f - 0.6f * expf(-0.3f * (float)L);
    const int l = FR_TID(F) & 63;
    const float d1 = wave_sum(l, INF(6)[L * 64 + l] * INF(7)[L * 64 + l]), d2 = wave_sum(l, INF(8)[L * 64 + l] * INF(9)[L * 64 + l]);
    att::AttnP P; P.Q = WSP(bf16, A_DQ); P.ldq = 1024; P.K1 = WSP(bf16, A_DK); P.ldk1 = 1024; P.K2 = P.K1; P.ldk2 = 1024; P.V = WSP(bf16, A_DV); P.ldv = 1024; P.ldo = 1024;
    P.pos = (const int*)F.a->in[2]; P.blkmax = WSP(int, WS_MISC); P.lut = WSP(float, WS_MISC + 4096);
    P.TI = WSP(bf16, A_OA2); P.lam = expf(d1) - expf(d2) + lam_init; P.osc = 1.0f; P.gsub = WSP(float, WS_MISC + 32768) + L * 128;
    att::AttPreOf<64, 128>::type pre; pre.valid = false;
    for (int p = F.vcu; p < BATCH * 8 * 8; p += F.G) {
        const int bh = p >> 3, i = p & 7, b = bh >> 3, hh = bh & 7;
        const int p2 = p + F.G; const bool more_items = p2 < BATCH * 8 * 8; const int bh2 = p2 >> 3, i2 = p2 & 7, b2 = bh2 >> 3, hh2 = bh2 & 7;
#pragma unroll 1
        for (int s = 0; s < 2; ++s) { const int qt = s ? i : 15 - i;
            const bool hn = (s == 0) || more_items; const int nb = s == 0 ? b : b2, nqt = s == 0 ? i : 15 - i2, nhh = s == 0 ? hh : hh2;
            P.O = WSP(bf16, A_OA2); att::ATT_UNIT_D<64, 64, 128, true, 1, VAR>(P, b, qt, (2 * hh) * 64, (2 * hh) * 64, hh * 128, hh * 128, hh, F.lds, FR_TID(F),
                                                                               pre, true, b, qt, (2 * hh + 1) * 64, (2 * hh + 1) * 64, hh * 128, hh);
            P.O = WSP(bf16, A_OA);  att::ATT_UNIT_D<64, 64, 128, true, 2, VAR>(P, b, qt, (2 * hh + 1) * 64, (2 * hh + 1) * 64, hh * 128, hh * 128, hh, F.lds, FR_TID(F),
                                                                               pre, hn, nb, nqt, (2 * nhh) * 64, (2 * nhh) * 64, nhh * 128, nhh); }
    }
}
template <int VAR>
__device__ __forceinline__ void phase_attn_mla(const Frame& F) {
    att::AttnP P; P.Q = WSP(bf16, A_MQ); P.ldq = 768; P.K1 = WSP(bf16, A_MKV); P.ldk1 = 1024; P.K2 = WSP(bf16, A_MKR); P.ldk2 = 32; P.V = WSP(bf16, A_MKV); P.ldv = 1024; P.O = WSP(bf16, A_OB); P.ldo = 512;
    P.pos = (const int*)F.a->in[2]; P.blkmax = WSP(int, WS_MISC); P.lut = WSP(float, WS_MISC + 4096);
    att::AttPreOf<96, 64>::type pre; pre.valid = false;
    for (int p = F.vcu; p < BATCH * 8 * 8; p += F.G) {
        const int bh = p >> 3, i = p & 7, b = bh >> 3, hh = bh & 7;
        const int p2 = p + F.G; const bool more_items = p2 < BATCH * 8 * 8; const int bh2 = p2 >> 3, i2 = p2 & 7, b2 = bh2 >> 3, hh2 = bh2 & 7;
        att::ATT_UNIT_M<96, 64, 64, false, 0, VAR>(P, b, 15 - i, hh * 96, hh * 128, hh * 128 + 64, hh * 64, 0, F.lds, FR_TID(F), pre, true, b, i, hh * 96, hh * 128, hh * 128 + 64, 0);
        att::ATT_UNIT_M<96, 64, 64, false, 0, VAR>(P, b, i, hh * 96, hh * 128, hh * 128 + 64, hh * 64, 0, F.lds, FR_TID(F), pre, more_items, b2, 15 - i2, hh2 * 96, hh2 * 128, hh2 * 128 + 64, 0);
    }
}

constexpr int NPH_DENSE = 9, NPH_MOE = 8 + 2 * MOE_NCHUNK, NPH_TOTAL = 1 + 2 * NPH_DENSE + 2 * NPH_MOE;
#define GEMM_CALL(EPI, SCHED, gm, S_, E_) pg8::gemm_phase<EPI, SCHED, true, true>(F.lds, gm, S_, E_, MY_TID())

__global__ void __launch_bounds__(NWAVES * 64, 2) mega_fwd(Args args) {
    extern __shared__ __attribute__((aligned(16))) unsigned char lds_raw[];
    Frame F;
    F.lds = (LAS unsigned char*)lds_raw; F.a = &args; F.ws = args.ws;
    const int wave_s = __builtin_amdgcn_readfirstlane((int)threadIdx.x >> 6);
#define MY_TID() ({ unsigned m1_ = ~0u; asm volatile("" : "+s"(m1_)); ((wave_s << 6) | (int)__builtin_amdgcn_mbcnt_hi(m1_, __builtin_amdgcn_mbcnt_lo(m1_, 0u))); })
    F.tid = MY_TID(); F.lane = F.tid & 63; F.wave = wave_s;
    F.G = gridDim.x; { const int bx = blockIdx.x; F.vcu = (F.G % 8 == 0) ? (bx % 8) * (F.G / 8) + bx / 8 : bx; }
    F.gw = F.vcu * NWAVES + F.wave; F.NGW = F.G * NWAVES;
    volatile LAS unsigned* MISC = (volatile LAS unsigned*)(F.lds + MISC_OFF);
    for (int u = F.tid; u < (LDS_BYTES - RING_BYTES) / 4; u += NWAVES * 64) ((LAS unsigned*)(F.lds + RING_BYTES))[u] = 0u;
    __syncthreads();
    const int lo = args.ph_lo, hi = args.ph_hi; constexpr bool fuse_ln = (LN_FUSE != 0);
    XcdBarrier bar; bar.bar = WSP(unsigned, WS_CTL) + CW_BAR; bar.x = 0; bar.st = nullptr;
    if (hi - lo > 1) bar = xcd_barrier_post(WSP(unsigned, WS_CTL) + CW_BAR, MISC + 8, F.tid == 0);
    int pc = 0;
#define PH_BEGIN if (pc >= lo && pc < hi) { { int t_ = MY_TID(); asm volatile("" : "+v"(t_)); F.tid = t_; F.lane = t_ & 63; F.wave = wave_s; F.gw = F.vcu * NWAVES + F.wave; }
#define PH_END if (pc + 1 < hi) { for (int rb = 0; rb < REP_BAR; ++rb) xcd_barrier(bar, MY_TID() == 0); } } ++pc;
    const int bx = (int)blockIdx.x;
    const float ALPHA = 1.6817928305074290f;

    PH_BEGIN for (int rep = 0; rep < REP_P0; ++rep) phase_prologue(F); PH_END

    for (int L = 0; L < DEPTH; ++L) {
        const int mj = L >> 1;
        const int convL_ = (CONV_IN_ATTN && (L & 1) == 0 && L + 1 < DEPTH) ? L + 1 : -1;
        PH_BEGIN {
#if QKV_FP8
            int bxl = bx; asm volatile("" : "+s"(bxl));
            { pg8::Gemm g{WSP(bf16, WS_XB), WSP(bf16, W_IN), T, 768, D}; pg8::StaticOrder S; S.init(T, 768, F.G, bxl);
              pg8::EpiL1 E{WSP(bf16, A_DQ), WSP(bf16, A_CQN), WSP(bf16, A_CKVN), WSP(bf16, A_MKR), WSP(float, WS_SSP), WSP(float, WS_ROPE), 0.125f * LOG2E, 12};
              for (int rep = 0; rep < REP_L1; ++rep) pg8::gemm_phase<pg8::EpiL1, pg8::StaticOrder, true, true, 0>(F.lds, g, S, E, MY_TID()); }
            { pg8::Gemm g{WSP(bf16, WS_XB8), WSP(bf16, W_QKV8), T, 5120, D / 2};
              pg8::UnevenOrder S; S.init(T, 5120, F.G, bx);
              if (LN_FUSE || F.G == 256) { S.cut = 128; S.lo = 9; S.hi = 11; } else { S.cut = 0; S.lo = 0; S.hi = (S.nwg + F.G - 1) / F.G; }
              pg8::EpiQkvG8 E{WSP(bf16, A_DQ), WSP(bf16, A_G), INF(5) + L * 2048, 0.125f * LOG2E, 1.0f / 32.0f};
              for (int rep = 0; rep < REP_L1; ++rep) pg8::gemm_phase8<pg8::EpiQkvG8, pg8::UnevenOrder, true, F8_SP2, 0>(F.lds, g, S, E, 0x7F7F7F7F, MY_TID()); }
#else
            { pg8::Gemm g{WSP(bf16, WS_XB), WSP(bf16, W_IN), T, NIN_B, D}; pg8::StaticOrder S; S.init(T, NIN_B, F.G, bx);
              pg8::EpiL1 E{WSP(bf16, A_DQ), WSP(bf16, A_CQN), WSP(bf16, A_CKVN), WSP(bf16, A_MKR), WSP(float, WS_SSP), WSP(float, WS_ROPE), 0.125f * LOG2E};
              for (int rep = 0; rep < REP_L1; ++rep) pg8::gemm_phase<pg8::EpiL1, pg8::StaticOrder, true, true, STAG_L1>(F.lds, g, S, E, MY_TID()); }
            { pg8::Gemm g{WSP(bf16, WS_XB8), WSP(bf16, W_G8), T, 2048, D / 2};
              pg8::UnevenOrder S; S.init(T, 2048, F.G, bx);
              if (F.G == 256) { S.cut = 128; S.lo = 3; S.hi = 5; } else { S.cut = 0; S.lo = 0; S.hi = (S.nwg + F.G - 1) / F.G; }
              pg8::EpiGates8 E{WSP(bf16, A_G), INF(5) + L * 2048, 1.0f / 32.0f};
              for (int rep = 0; rep < REP_L1; ++rep) pg8::gemm_phase8<pg8::EpiGates8, pg8::UnevenOrder, true, F8_SP2, 0>(F.lds, g, S, E, 0x7F7F7F7F, MY_TID()); }
#endif
        } PH_END
        PH_BEGIN {
            for (int rep = 0; rep < REP_MIX; ++rep) {
            { pg8::Gemm g{WSP(bf16, A_CQN), WSP(bf16, W_UQ), T, 768, QR}; pg8::StaticOrder S; S.init(T, 768, F.G, bx);
              pg8::EpiRopeQ E{WSP(bf16, A_MQ), WSP(float, WS_ROPE), 0.10206207261596577f * LOG2E, WSP(float, WS_SSP)};
              GEMM_CALL(pg8::EpiRopeQ, pg8::StaticOrder, g, S, E); }
            { pg8::Gemm g{WSP(bf16, A_CKVN), WSP(bf16, W_UKV), T, 1024, KVR}; pg8::StaticOrder S; S.init(T, 1024, F.G, bx);
              pg8::EpiBf16Rs E{WSP(bf16, A_MKV), 1024, WSP(float, WS_SSP)};
              GEMM_CALL(pg8::EpiBf16Rs, pg8::StaticOrder, g, S, E); }
            }
#define CONV_HOOK() do { __syncthreads(); Frame F3 = F; { const int t3_ = MY_TID(); F3.tid = t3_; F3.lane = t3_ & 63; } phase_convert(F3, convL_, 2); __syncthreads(); } while (0)
            if (convL_ >= 0 && (bx & 1) == 0) CONV_HOOK();
            phase_attn_diff<0>(F, L);
            if (convL_ >= 0 && (bx & 1) != 0) CONV_HOOK();
#undef CONV_HOOK
        } PH_END
        PH_BEGIN { phase_attn_mla<0>(F); } PH_END
        PH_BEGIN {
            for (int rep = 0; rep < REP_MIX; ++rep) {
            { pg8::Gemm g{WSP(bf16, A_OB), WSP(bf16, W_BM), T, D, 512}; pg8::StaticOrder S; S.init(T, D, F.G, bx);
              pg8::EpiGate<false> E{WSP(bf16, A_MT), WSP(bf16, A_G), nullptr, 1024};
              GEMM_CALL(pg8::EpiGate<false>, pg8::StaticOrder, g, S, E); }
            { pg8::Gemm g{WSP(bf16, A_OA), WSP(bf16, W_BD), T, D, D}; pg8::StaticOrder S; S.init(T, D, F.G, bx);
              pg8::EpiGate<true> E{WSP(bf16, A_M), WSP(bf16, A_G), WSP(bf16, A_MT), 0};
              GEMM_CALL(pg8::EpiGate<true>, pg8::StaticOrder, g, S, E); }
            }
        } PH_END
        PH_BEGIN {
            pg8::Gemm g{WSP(bf16, A_M), WSP(bf16, W_OUT), T, D, D}; pg8::StaticOrder S; S.init(T, D, F.G, bx);
            if (fuse_ln && (L & 1) == 0) {
                pg8::EpiPreLn<1> E{nullptr, WSP(bf16, WS_XB), WSP(unsigned char, WS_XB8), ALPHA, INF(18) + L * D, INF(19) + L * D, WSP(unsigned long long, WS_LNST), WSP(unsigned, WS_CTL) + CW_LN + (2 * L) * 128, F.lds + RING_BYTES + 2048};
                GEMM_CALL(pg8::EpiPreLn<1>, pg8::StaticOrder, g, S, E);
            } else {
            pg8::EpiPre<1> E{WSP(bf16, A_PRE), WSP(bf16, WS_XB), ALPHA, 1.0f};
            for (int rep = 0; rep < REP_MIX; ++rep) GEMM_CALL(pg8::EpiPre<1>, pg8::StaticOrder, g, S, E);
            }
        } PH_END
        if (!(fuse_ln && (L & 1) == 0)) {
        PH_BEGIN {
            if (L & 1) phase_ln<true, false>(F, WSP(bf16, A_PRE), INF(18) + L * D, INF(19) + L * D, INF(23) + (size_t)mj * D * NEXP, mj, false);
            else for (int rep = 0; rep < REP_LN; ++rep) phase_ln<false, false>(F, WSP(bf16, A_PRE), INF(18) + L * D, INF(19) + L * D, nullptr, 0, false);
        } PH_END
        }
        if ((L & 1) == 0) {
            PH_BEGIN {
                for (int rep = 0; rep < REP_FFN; ++rep) {
                { pg8::Gemm g{WSP(bf16, WS_XB), WSP(bf16, W_F13D), T, 2 * DENSE_FF, D}; pg8::StaticOrder S; S.init(T, 2 * DENSE_FF, F.G, bx);
                  pg8::EpiSwiGLU E{WSP(bf16, A_H), DENSE_FF};
                  pg8::gemm_phase<pg8::EpiSwiGLU, pg8::StaticOrder, true, true, STAG_H>(F.lds, g, S, E, MY_TID()); }
                { pg8::Gemm g{WSP(bf16, WS_PB), WSP(bf16, W_PP), T, D, PLE}; pg8::StaticOrder S; S.init(T, D, F.G, bx);
                  pg8::EpiPre<0> E{WSP(bf16, A_PRE), nullptr, 0.f, 1.0f};
                  GEMM_CALL(pg8::EpiPre<0>, pg8::StaticOrder, g, S, E); }
                { pg8::Gemm g{WSP(bf16, WS_XB8), WSP(bf16, W_PG), T, D, D / 2}; pg8::StaticOrder S; S.init(T, D, F.G, bx);
                  pg8::EpiPre<2> E{WSP(bf16, A_PRE), WSP(bf16, WS_XB), ALPHA, 1.0f / 32.0f};
                  pg8::gemm_phase8<pg8::EpiPre<2>, pg8::StaticOrder, true, F8_SP2, 0>(F.lds, g, S, E, 0x7F7F7F7F, MY_TID()); }
                }
            } PH_END
            PH_BEGIN {
                pg8::Gemm g{WSP(bf16, A_H), WSP(bf16, W_F2D), T, D, DENSE_FF}; pg8::StaticOrder S; S.init(T, D, F.G, bx);
                if (fuse_ln) {
                    pg8::EpiPreLn<3> E{WSP(bf16, A_PRE), WSP(bf16, WS_XB), WSP(unsigned char, WS_XB8), 1.0f, INF(29) + L * D, INF(30) + L * D, WSP(unsigned long long, WS_LNST), WSP(unsigned, WS_CTL) + CW_LN + (2 * L + 1) * 128, F.lds + RING_BYTES + 2048};
                    GEMM_CALL(pg8::EpiPreLn<3>, pg8::StaticOrder, g, S, E);
                    if (L + 1 < DEPTH) { __syncthreads(); Frame F3 = F; { const int t3_ = MY_TID(); F3.tid = t3_; F3.lane = t3_ & 63; }
                        phase_convert(F3, L + 1, CONV_IN_ATTN ? 1 : 0); }
                } else {
                pg8::EpiPre<3> E{WSP(bf16, A_PRE), nullptr, 0.f, 1.0f};
                GEMM_CALL(pg8::EpiPre<3>, pg8::StaticOrder, g, S, E);
                }
            } PH_END
            if (!fuse_ln) {
            PH_BEGIN { if (!fuse_ln) for (int rep = 0; rep < REP_LN; ++rep) phase_ln<false, false>(F, WSP(bf16, A_PRE), INF(29) + L * D, INF(30) + L * D, nullptr, 0, L == DEPTH - 1); if (L + 1 < DEPTH) for (int rep = 0; rep < REP_CONV; ++rep) phase_convert(F, L + 1, CONV_IN_ATTN ? 1 : 0); } PH_END
            }
        } else {
            PH_BEGIN {
                phase_scatter(F, mj);
                for (int rep = 0; rep < REP_PPE; ++rep) {
                { pg8::Gemm g{WSP(bf16, WS_PB), WSP(bf16, W_PP), T, D, PLE}; pg8::StaticOrder S; S.init(T, D, F.G, bx);
                  pg8::EpiPre<0> E{WSP(bf16, A_PREM), nullptr, 0.f, 1.0f};
                  GEMM_CALL(pg8::EpiPre<0>, pg8::StaticOrder, g, S, E); }
                { pg8::Gemm g{WSP(bf16, WS_XB8), WSP(bf16, W_PG), T, D, D / 2}; pg8::StaticOrder S; S.init(T, D, F.G, bx);
                  pg8::EpiPre<2> E{WSP(bf16, A_PREM), WSP(bf16, WS_XB), ALPHA, 1.0f / 32.0f};
                  pg8::gemm_phase8<pg8::EpiPre<2>, pg8::StaticOrder, true, F8_SP2, 0>(F.lds, g, S, E, 0x7F7F7F7F, MY_TID()); }
                }
            } PH_END
            for (int ch = 0; ch < MOE_NCHUNK; ++ch) {
                PH_BEGIN {
                    MoeTiles mt; moe_tiles(F, mj, mt);
                    const int tlo = ch * MOE_CHUNK_TILES; int ntc = mt.total - tlo; ntc = ntc > MOE_CHUNK_TILES ? MOE_CHUNK_TILES : ntc;
                    if (ntc > 0) {
#if MOE_FP8
                        pg8::Gemm g{WSP(bf16, A_XG), WSP(bf16, W_F13), ntc * 256, 2 * EXPERT_FF, D / 2};
                        pg8::GroupedOrder S; S.init(ntc * 256, 2 * EXPERT_FF, F.G, bx); S.tile_lo = tlo; S.estride = (size_t)2 * EXPERT_FF * D;
#else
                        pg8::Gemm g{WSP(bf16, A_XG) + (size_t)tlo * 256 * D, WSP(bf16, W_F13), ntc * 256, 2 * EXPERT_FF, D};
                        pg8::GroupedOrder S; S.init(ntc * 256, 2 * EXPERT_FF, F.G, bx); S.tile_lo = tlo; S.estride = (size_t)2 * EXPERT_FF * D * 2;
#endif
                        S.pend0 = mt.pend[0]; S.pend1 = mt.pend[1]; S.pend2 = mt.pend[2]; S.pend3 = mt.pend[3]; S.pend4 = mt.pend[4]; S.pend5 = mt.pend[5]; S.pend6 = mt.pend[6]; S.pend7 = mt.pend[7];
#if MOE_FP8
                        pg8::EpiSwiGLU8 E{WSP(unsigned char, A_HG), EXPERT_FF, 1.0f / 32.0f};
                        for (int rep = 0; rep < REP_MOE; ++rep) pg8::gemm_phase8<pg8::EpiSwiGLU8, pg8::GroupedOrder, UP_ALIGN, F8_SP2, STAG_UP>(F.lds, g, S, E, 0x7F7F7F7F, MY_TID());
#else
                        pg8::EpiSwiGLU E{WSP(bf16, A_HG), EXPERT_FF};
                        for (int rep = 0; rep < REP_MOE; ++rep) GEMM_CALL(pg8::EpiSwiGLU, pg8::GroupedOrder, g, S, E);
#endif
                    }
                } PH_END
                PH_BEGIN {
                    MoeTiles mt; moe_tiles(F, mj, mt);
                    const int tlo = ch * MOE_CHUNK_TILES; int ntc = mt.total - tlo; ntc = ntc > MOE_CHUNK_TILES ? MOE_CHUNK_TILES : ntc;
                    if (ntc > 0) {
#if MOE_FP8
                        pg8::Gemm g{WSP(bf16, A_HG), WSP(bf16, W_F2E), ntc * 256, D, EXPERT_FF / 2};
                        pg8::GroupedOrder S; S.init(ntc * 256, D, F.G, bx); S.tile_lo = tlo; S.estride = (size_t)D * EXPERT_FF;
#else
                        pg8::Gemm g{WSP(bf16, A_HG), WSP(bf16, W_F2E), ntc * 256, D, EXPERT_FF};
                        pg8::GroupedOrder S; S.init(ntc * 256, D, F.G, bx); S.tile_lo = tlo; S.estride = (size_t)D * EXPERT_FF * 2;
#endif
                        S.pend0 = mt.pend[0]; S.pend1 = mt.pend[1]; S.pend2 = mt.pend[2]; S.pend3 = mt.pend[3]; S.pend4 = mt.pend[4]; S.pend5 = mt.pend[5]; S.pend6 = mt.pend[6]; S.pend7 = mt.pend[7];
                        pg8::EpiBf16 E{WSP(bf16, A_YG) + (size_t)tlo * 256 * D, D, MOE_FP8 ? 1.0f / 128.0f : 1.0f};
#if MOE_FP8
                        for (int rep = 0; rep < REP_MOE; ++rep) pg8::gemm_phase8<pg8::EpiBf16, pg8::GroupedOrder, true, F8_SP2>(F.lds, g, S, E, 0x7F7F7F7F, MY_TID());
#else
                        for (int rep = 0; rep < REP_MOE; ++rep) GEMM_CALL(pg8::EpiBf16, pg8::GroupedOrder, g, S, E);
#endif
                    }
                    if (CONV_IN_DOWN && ch == MOE_NCHUNK - 1 && L + 1 < DEPTH) {
                        const int nwg_ = (ntc > 0 ? ntc : 0) * (D / 256), r_ = nwg_ % F.G, nl_ = F.G - r_;
                        Frame F2 = F; { const int t2_ = MY_TID(); F2.tid = t2_; F2.lane = t2_ & 63; }
                        if (r_ != 0 && 2 * nl_ >= F.G) { if (bx >= r_) { F2.gw = (bx - r_) * NWAVES + F.wave; F2.NGW = nl_ * NWAVES; phase_convert(F2, L + 1); } }
                        else phase_convert(F2, L + 1);
                    }
                } PH_END
            }
            PH_BEGIN { for (int rep = 0; rep < REP_LN; ++rep) phase_ln<false, true>(F, WSP(bf16, A_PREM), INF(29) + L * D, INF(30) + L * D, nullptr, 0, L == DEPTH - 1); if (!CONV_IN_DOWN && L + 1 < DEPTH) for (int rep = 0; rep < REP_CONV; ++rep) phase_convert(F, L + 1); } PH_END
        }
    }
#undef PH_BEGIN
#undef PH_END
}

extern "C" void kernel_launch(void* const* d_in, const int* in_sizes, int n_in, void* d_out, int out_size, void* d_ws, size_t ws_size, hipStream_t stream) {
    static int grid = 0;
    if (grid == 0) {
        if (n_in != 31 || in_sizes[0] != T * D || out_size != T * D || ws_size < WS_END) { fprintf(stderr, "kernel_launch: unexpected shapes / workspace (n_in %d, ws %zu < %zu)\n", n_in, ws_size, (size_t)WS_END); grid = -1; return; }
        int dev = 0, cus = 0, per_cu = 0;
        if (hipGetDevice(&dev) != hipSuccess || hipDeviceGetAttribute(&cus, hipDeviceAttributeMultiprocessorCount, dev) != hipSuccess) { grid = -1; return; }
        if (hipFuncSetAttribute((const void*)mega_fwd, hipFuncAttributeMaxDynamicSharedMemorySize, LDS_BYTES) != hipSuccess) { fprintf(stderr, "kernel_launch: hipFuncSetAttribute failed\n"); grid = -1; return; }
        if (hipOccupancyMaxActiveBlocksPerMultiprocessor(&per_cu, (const void*)mega_fwd, NWAVES * 64, LDS_BYTES) != hipSuccess || per_cu < 1) { fprintf(stderr, "kernel_launch: occupancy query says %d\n", per_cu); (void)hipGetLastError(); grid = -1; return; }
        grid = cus;
    }
    if (grid < 0) return;
    if (hipMemsetAsync((char*)d_ws + WS_CTL, 0, CTL_ZERO_BYTES, stream) != hipSuccess) return;
    Args a{};
    for (int i = 0; i < 31; ++i) a.in[i] = d_in[i];
    a.out = (float*)d_out; a.ws = (unsigned char*)d_ws;
    a.fuse = LN_FUSE;
    if (LN_FUSE && grid != 256) { fprintf(stderr, "kernel_launch: the fused LayerNorm exchange needs a 256-workgroup grid (got %d); build with -DLN_FUSE=0\n", grid); return; }
    const int nph = NPH_TOTAL - (a.fuse ? 4 : 0);
#if MK_PER_PHASE
    for (int p = 0; p < nph; ++p) { a.ph_lo = p; a.ph_hi = p + 1; hipLaunchKernelGGL(mega_fwd, dim3(grid), dim3(NWAVES * 64), LDS_BYTES, stream, a); }
#else
    a.ph_lo = 0; a.ph_hi = nph;
    hipLaunchKernelGGL(mega_fwd, dim3(grid), dim3(NWAVES * 64), LDS_BYTES, stream, a);
#endif
}
```

```cpp
#include <hip/hip_runtime.h>
#include <cstdio>
#include <cstdint>
#include <cmath>

#ifndef MK_PER_PHASE
#define MK_PER_PHASE 0
#endif

constexpr int BATCH = 8, SEQ = 4096, T = BATCH * SEQ, D = 1024, DEPTH = 4, PLE = 256;
constexpr int IN_COLS = 5792, NIN = 5888, NIN_B = 3840;
constexpr int QR = 384, KVR = 256, ROPE_D = 32;
constexpr int DENSE_FF = 2816, EXPERT_FF = 3584, NEXP = 8;
constexpr float LN_EPS = 1e-5f;
constexpr float LOG2E = 1.4426950408889634f;
constexpr int MOE_ROWS = 2 * T + NEXP * 256;
constexpr int MOE_CHUNK_TILES = MOE_ROWS / 256;
constexpr int MOE_NCHUNK = 1;
#ifndef MOE_FP8
#define MOE_FP8 1
#endif

#define GAS __attribute__((address_space(1)))
#define LAS __attribute__((address_space(3)))
typedef unsigned short bf16;
typedef unsigned v4u __attribute__((ext_vector_type(4)));
typedef unsigned v2u __attribute__((ext_vector_type(2)));
typedef float f32x4 __attribute__((ext_vector_type(4)));
typedef float f32x2 __attribute__((ext_vector_type(2)));
typedef float f32x16 __attribute__((ext_vector_type(16)));
typedef short bf16x8 __attribute__((ext_vector_type(8)));
typedef short s16x4 __attribute__((ext_vector_type(4)));
typedef __bf16 bf16x2_t __attribute__((ext_vector_type(2)));
typedef GAS unsigned gu32;
#define RLX_AGENT __ATOMIC_RELAXED, __HIP_MEMORY_SCOPE_AGENT
#define LDS_WAIT() asm volatile("s_waitcnt lgkmcnt(0)" ::: "memory")
#define VM_WAIT() asm volatile("s_waitcnt vmcnt(0)" ::: "memory")

__device__ __forceinline__ unsigned pk2(float lo, float hi) { f32x2 v = {lo, hi}; bf16x2_t b = __builtin_convertvector(v, bf16x2_t); return __builtin_bit_cast(unsigned, b); }
__device__ __forceinline__ float bflo(unsigned u) { return __uint_as_float(u << 16); }
__device__ __forceinline__ float bfhi(unsigned u) { return __uint_as_float(u & 0xffff0000u); }
__device__ __forceinline__ float sigmoidf_(float x) { return __builtin_amdgcn_rcpf(1.0f + __builtin_amdgcn_exp2f(-x * LOG2E)); }
__device__ __forceinline__ float shx(float v, int o, int lane) { return __uint_as_float((unsigned)__builtin_amdgcn_ds_bpermute((lane ^ o) << 2, (int)__float_as_uint(v))); }
__device__ __forceinline__ int shxi(int v, int o, int lane) { return __builtin_amdgcn_ds_bpermute((lane ^ o) << 2, v); }
__device__ __forceinline__ float wave_sum(int lane, float v) {
#pragma unroll
    for (int o = 1; o < 64; o <<= 1) v += shx(v, o, lane);
    return v;
}

#ifndef GATE_U8
#define GATE_U8 1
#endif
#define PG8_PAIR16(A_, B_) do { const auto r0_ = __builtin_amdgcn_permlane16_swap((A_).x, (B_).x, false, false); (A_).x = r0_[0]; (B_).x = r0_[1]; \
                               const auto r1_ = __builtin_amdgcn_permlane16_swap((A_).y, (B_).y, false, false); (A_).y = r1_[0]; (B_).y = r1_[1]; } while (0)
namespace pg8 {
#define PG8_LAS __attribute__((address_space(3)))
typedef unsigned short bf16_t;
typedef unsigned u32x4 __attribute__((ext_vector_type(4)));
typedef unsigned u32x2 __attribute__((ext_vector_type(2)));
constexpr int BM = 256, BK = 64, HALF = 128, HTB = HALF * BK * 2  , STAGE_BYTES = 8 * HTB, NXCD = 8, WGM = 8;

__host__ __device__ __forceinline__ int lds_byte(int r, int c) { const int st = (r >> 4) * 2 + (c >> 5), rr = r & 15, cc = c & 31, ob = rr * 64 + cc * 2; return st * 1024 + (ob ^ (((ob >> 9) & 1) << 5)); }
__host__ __device__ __forceinline__ void stage_rc(int b, int& R, int& C) { const int st = b / 1024, sb = b % 1024, swz = sb ^ (((sb >> 9) & 1) << 5); R = (st >> 1) * 16 + swz / 64; C = (st & 1) * 32 + (swz % 64) / 2; }
__host__ __device__ __forceinline__ int perm32(int rho) { const int n = rho >> 4, i = rho & 15; return 8 * (i >> 2) + 4 * n + (i & 3); }

struct Unit { int pm, pn; };
struct Gemm { const bf16_t* A; const bf16_t* Bt; int M, N, K; };

struct StaticOrder {
    int nM, nN, nwg, G, c;
    __host__ __device__ void init(int M, int N, int G_, int c_) { nM = M / BM; nN = N / BM; nwg = nM * nN; G = G_; c = c_; }
    __host__ __device__ bool next(int i, Unit& u) const {
        const long L = (long)i * G + c; if (L >= nwg) return false;
        int wgid = (int)L; { const int q = nwg / NXCD, r = nwg % NXCD, xcd = wgid % NXCD, off = wgid / NXCD; wgid = (xcd < r ? xcd * (q + 1) : r * (q + 1) + (xcd - r) * q) + off; }
        const int nig = WGM * nN, gid = wgid / nig, fm = gid * WGM, gsz = (nM - fm) < WGM ? (nM - fm) : WGM;
        u.pm = fm + ((wgid % nig) % gsz); u.pn = (wgid % nig) / gsz; return true;
    }
    __device__ __forceinline__ size_t bofs(const Unit&) const { return 0; }
    __device__ __forceinline__ void a_ready(const Unit&) const {}
    __device__ __forceinline__ void done(const Unit&) const {}
};
struct UnevenOrder : StaticOrder {
    int cut, lo, hi;
    __host__ __device__ bool next(int i, Unit& u) const {
        long L;
        if (i < lo) L = (long)i * G + c;
        else if (c >= cut && i < hi) L = (long)lo * G + (long)(c - cut) * (hi - lo) + (i - lo);
        else return false;
        if (L >= nwg) return false;
        int wgid = (int)L; { const int q = nwg / NXCD, r = nwg % NXCD, xcd = wgid % NXCD, off = wgid / NXCD; wgid = (xcd < r ? xcd * (q + 1) : r * (q + 1) + (xcd - r) * q) + off; }
        const int nig = WGM * nN, gid = wgid / nig, fm = gid * WGM, gsz = (nM - fm) < WGM ? (nM - fm) : WGM;
        u.pm = fm + ((wgid % nig) % gsz); u.pn = (wgid % nig) / gsz; return true;
    }
};
struct GroupedOrder : StaticOrder {
    int tile_lo; int pend0, pend1, pend2, pend3, pend4, pend5, pend6, pend7; size_t estride;
    __device__ __forceinline__ size_t bofs(const Unit& u) const {
        const int t = u.pm + tile_lo;
        const int e = (t >= pend0) + (t >= pend1) + (t >= pend2) + (t >= pend3) + (t >= pend4) + (t >= pend5) + (t >= pend6);
        return (size_t)e * estride;
    }
};

typedef f32x4 Acc[2][2][4][2];

struct EpiL1 {
    static constexpr bool PERM = true, AFTER_DRAIN = false;
    bf16_t* QKV; bf16_t* CQR; bf16_t* CKVR; bf16_t* MKR; float* SSP; const float* rope; float qscale; int pn_off;
    __device__ __forceinline__ void operator()(const Acc& acc, const Unit& u, int wr, int wc, int fr, int fq) const {
        const int row0 = u.pm * BM + wr * 64 + fr; const int pn = u.pn + pn_off;
        if (pn < 12) {
            bf16_t* base = QKV + (size_t)(pn >> 2) * ((size_t)T * 1024); const int col0 = (pn & 3) * 256 + wc * 32 + 8 * fq; const float sc = pn < 4 ? qscale : 1.f;
#pragma unroll
            for (int ai = 0; ai < 2; ++ai)
#pragma unroll
                for (int m = 0; m < 4; ++m) { bf16_t* rowp = base + (size_t)(row0 + ai * HALF + m * 16) * 1024 + col0;
#pragma unroll
                    for (int bj = 0; bj < 2; ++bj) { const f32x4 v0 = acc[ai][bj][m][0] * sc, v1 = acc[ai][bj][m][1] * sc;
                        u32x4 w; w.x = pk2(v0[0], v0[1]); w.y = pk2(v0[2], v0[3]); w.z = pk2(v1[0], v1[1]); w.w = pk2(v1[2], v1[3]);
                        *(u32x4*)(rowp + bj * HALF) = w; } }
            return;
        }
        const int lane = fr | (fq << 4), cl = wc * 32 + 8 * fq;
#pragma unroll
        for (int ai = 0; ai < 2; ++ai)
#pragma unroll
            for (int m = 0; m < 4; ++m) { const size_t row = (size_t)(row0 + ai * HALF + m * 16);
                float p[2];
#pragma unroll
                for (int bj = 0; bj < 2; ++bj) { const f32x4 v0 = acc[ai][bj][m][0], v1 = acc[ai][bj][m][1];
                    p[bj] = ((v0[0] * v0[0] + v0[1] * v0[1]) + (v0[2] * v0[2] + v0[3] * v0[3])) + ((v1[0] * v1[0] + v1[1] * v1[1]) + (v1[2] * v1[2] + v1[3] * v1[3]));
                    u32x4 w; w.x = pk2(v0[0], v0[1]); w.y = pk2(v0[2], v0[3]); w.z = pk2(v1[0], v1[1]); w.w = pk2(v1[2], v1[3]);
                    if (pn == 12) *(u32x4*)(CQR + row * 384 + bj * HALF + cl) = w;
                    else if (pn == 13) { if (bj == 0) *(u32x4*)(CQR + row * 384 + 256 + cl) = w; else *(u32x4*)(CKVR + row * 256 + cl) = w; }
                    else if (bj == 0) *(u32x4*)(CKVR + row * 256 + HALF + cl) = w; }
                if (pn == 12) { p[0] += p[1]; p[1] = 0.f; }
                p[0] += shx(p[0], 16, lane); p[0] += shx(p[0], 32, lane);
                if (pn == 13) { p[1] += shx(p[1], 16, lane); p[1] += shx(p[1], 32, lane); }
                if (fq == 0) { float* sp = SSP + row * 16 + wc;
                    if (pn == 12) sp[0] = p[0]; else if (pn == 13) { sp[4] = p[0]; sp[8] = p[1]; } else sp[12] = p[0]; }
                if (pn == 14 && wc == 0) {
                    const f32x4 v0 = acc[ai][1][m][0], v1 = acc[ai][1][m][1]; float mine[8] = {v0[0], v0[1], v0[2], v0[3], v1[0], v1[1], v1[2], v1[3]}, oth[8];
#pragma unroll
                    for (int i = 0; i < 8; ++i) oth[i] = shx(mine[i], 32, lane);
                    const float* rp = rope + row * 32 + 16 * (fq & 1);
                    const f32x4 r0 = *(const f32x4*)rp, r1 = *(const f32x4*)(rp + 4), r2 = *(const f32x4*)(rp + 8), r3 = *(const f32x4*)(rp + 12);
                    const float cs[8] = {r0[0], r0[2], r1[0], r1[2], r2[0], r2[2], r3[0], r3[2]}, sn[8] = {r0[1], r0[3], r1[1], r1[3], r2[1], r2[3], r3[1], r3[3]};
                    float o[8];
#pragma unroll
                    for (int i = 0; i < 8; ++i) o[i] = (fq < 2) ? mine[i] * cs[i] - oth[i] * sn[i] : oth[i] * sn[i] + mine[i] * cs[i];
                    u32x4 w; w.x = pk2(o[0], o[1]); w.y = pk2(o[2], o[3]); w.z = pk2(o[4], o[5]); w.w = pk2(o[6], o[7]);
                    *(u32x4*)(MKR + row * 32 + 8 * fq) = w; }
            }
    }
};
struct EpiGates8 {
    static constexpr bool PERM = true, AFTER_DRAIN = false;
    bf16_t* Gt; const float* bgate; float isc;
    __device__ __forceinline__ void operator()(const Acc& acc, const Unit& u, int wr, int wc, int fr, int fq) const {
        const int row0 = u.pm * BM + wr * 64 + fr; const int col0 = u.pn * 256 + wc * 32 + 8 * fq;
        f32x4 bv[2][2];
#pragma unroll
        for (int bj = 0; bj < 2; ++bj)
#pragma unroll
            for (int n = 0; n < 2; ++n) bv[bj][n] = *(const f32x4*)(bgate + col0 + bj * HALF + 4 * n);
#pragma unroll
        for (int ai = 0; ai < 2; ++ai)
#pragma unroll
            for (int m = 0; m < 4; ++m) { bf16_t* rowp = Gt + (size_t)(row0 + ai * HALF + m * 16) * 2048 + col0;
#pragma unroll
                for (int bj = 0; bj < 2; ++bj) { const f32x4 v0 = acc[ai][bj][m][0] * isc + bv[bj][0], v1 = acc[ai][bj][m][1] * isc + bv[bj][1];
                    u32x4 w; w.x = pk2(sigmoidf_(v0[0]), sigmoidf_(v0[1])); w.y = pk2(sigmoidf_(v0[2]), sigmoidf_(v0[3])); w.z = pk2(sigmoidf_(v1[0]), sigmoidf_(v1[1])); w.w = pk2(sigmoidf_(v1[2]), sigmoidf_(v1[3]));
                    *(u32x4*)(rowp + bj * HALF) = w; } }
    }
};
struct EpiQkvG8 {
    static constexpr bool PERM = true, AFTER_DRAIN = false;
    bf16_t* QKV; bf16_t* Gt; const float* bgate; float qscale, isc;
    __device__ __forceinline__ void operator()(const Acc& acc, const Unit& u, int wr, int wc, int fr, int fq) const {
        const int row0 = u.pm * BM + wr * 64 + fr; const int pn = u.pn;
        if (pn < 12) {
            bf16_t* base = QKV + (size_t)(pn >> 2) * ((size_t)T * 1024); const int col0 = (pn & 3) * 256 + wc * 32 + 8 * fq; const float sc = (pn < 4 ? qscale : 1.f) * isc;
#pragma unroll
            for (int ai = 0; ai < 2; ++ai)
#pragma unroll
                for (int m = 0; m < 4; ++m) { bf16_t* rowp = base + (size_t)(row0 + ai * HALF + m * 16) * 1024 + col0;
#pragma unroll
                    for (int bj = 0; bj < 2; ++bj) { const f32x4 v0 = acc[ai][bj][m][0] * sc, v1 = acc[ai][bj][m][1] * sc;
                        u32x4 w; w.x = pk2(v0[0], v0[1]); w.y = pk2(v0[2], v0[3]); w.z = pk2(v1[0], v1[1]); w.w = pk2(v1[2], v1[3]);
                        *(u32x4*)(rowp + bj * HALF) = w; } }
            return;
        }
        const int col0 = (pn - 12) * 256 + wc * 32 + 8 * fq;
        f32x4 bv[2][2];
#pragma unroll
        for (int bj = 0; bj < 2; ++bj)
#pragma unroll
            for (int n = 0; n < 2; ++n) bv[bj][n] = *(const f32x4*)(bgate + col0 + bj * HALF + 4 * n);
#if GATE_U8
        unsigned char* G8 = (unsigned char*)Gt;
        const int rowg = row0 + (fq & 1) * 16, colg = (pn - 12) * 256 + wc * 32 + 8 * (fq & ~1);
#define G8Q_(x) ((unsigned)(sigmoidf_(x) * 255.0f + 0.5f))
#pragma unroll
        for (int ai = 0; ai < 2; ++ai)
#pragma unroll
            for (int mp = 0; mp < 2; ++mp)
#pragma unroll
                for (int bj = 0; bj < 2; ++bj) { u32x2 w[2];
#pragma unroll
                    for (int e = 0; e < 2; ++e) { const int m = 2 * mp + e; const f32x4 v0 = acc[ai][bj][m][0] * isc + bv[bj][0], v1 = acc[ai][bj][m][1] * isc + bv[bj][1];
                        w[e].x = G8Q_(v0[0]) | (G8Q_(v0[1]) << 8) | (G8Q_(v0[2]) << 16) | (G8Q_(v0[3]) << 24); w[e].y = G8Q_(v1[0]) | (G8Q_(v1[1]) << 8) | (G8Q_(v1[2]) << 16) | (G8Q_(v1[3]) << 24); }
                    PG8_PAIR16(w[0], w[1]);
                    u32x4 q; q.x = w[0].x; q.y = w[0].y; q.z = w[1].x; q.w = w[1].y;
                    *(u32x4*)(G8 + (size_t)(rowg + ai * HALF + mp * 32) * 2048 + colg + bj * HALF) = q; }
#undef G8Q_
#else
#pragma unroll
        for (int ai = 0; ai < 2; ++ai)
#pragma unroll
            for (int m = 0; m < 4; ++m) { bf16_t* rowp = Gt + (size_t)(row0 + ai * HALF + m * 16) * 2048 + col0;
#pragma unroll
                for (int bj = 0; bj < 2; ++bj) { const f32x4 v0 = acc[ai][bj][m][0] * isc + bv[bj][0], v1 = acc[ai][bj][m][1] * isc + bv[bj][1];
                    u32x4 w; w.x = pk2(sigmoidf_(v0[0]), sigmoidf_(v0[1])); w.y = pk2(sigmoidf_(v0[2]), sigmoidf_(v0[3])); w.z = pk2(sigmoidf_(v1[0]), sigmoidf_(v1[1])); w.w = pk2(sigmoidf_(v1[2]), sigmoidf_(v1[3]));
                    *(u32x4*)(rowp + bj * HALF) = w; } }
#endif
    }
};
struct EpiRopeQ {
    static constexpr bool PERM = false, AFTER_DRAIN = false;
    bf16_t* O; const float* rope; float qscale; const float* SSP;
    __device__ __forceinline__ void operator()(const Acc& acc, const Unit& u, int wr, int wc, int fr, int fq) const {
        const int row0 = u.pm * BM + wr * 64 + fr;
        float rsq[2][4];
#pragma unroll
        for (int ai = 0; ai < 2; ++ai) { f32x4 sa[4], sb[4];
#pragma unroll
            for (int m = 0; m < 4; ++m) { const float* sp = SSP + (size_t)(row0 + ai * HALF + m * 16) * 16; sa[m] = *(const f32x4*)sp; sb[m] = *(const f32x4*)(sp + 4); }
#pragma unroll
            for (int m = 0; m < 4; ++m) { const f32x4 t = sa[m] + sb[m]; rsq[ai][m] = qscale / sqrtf(((t[0] + t[1]) + (t[2] + t[3])) * (1.0f / 384.0f) + LN_EPS); } }
        f32x4 c0[2][4], c1[2][4];
#pragma unroll
        for (int ai = 0; ai < 2; ++ai)
#pragma unroll
            for (int m = 0; m < 4; ++m) { const int row = row0 + ai * HALF + m * 16; c0[ai][m] = *(const f32x4*)(rope + (size_t)row * 32 + fq * 8); c1[ai][m] = *(const f32x4*)(rope + (size_t)row * 32 + fq * 8 + 4); }
#pragma unroll
        for (int ai = 0; ai < 2; ++ai)
#pragma unroll
            for (int m = 0; m < 4; ++m) { const int row = row0 + ai * HALF + m * 16;
                const f32x4 cs0 = c0[ai][m], cs1 = c1[ai][m];
                const f32x4 cc = {cs0[0], cs0[2], cs1[0], cs1[2]}, ss = {cs0[1], cs0[3], cs1[1], cs1[3]};
#pragma unroll
                for (int bj = 0; bj < 2; ++bj) { const int colg = u.pn * BM + bj * HALF + wc * 32; const bool isr = ((colg >> 5) % 3) == 2;
                    const f32x4 x1 = acc[ai][bj][m][0], x2 = acc[ai][bj][m][1];
                    f32x4 o1 = x1, o2 = x2; if (isr) { o1 = x1 * cc - x2 * ss; o2 = x1 * ss + x2 * cc; }
                    o1 = o1 * rsq[ai][m]; o2 = o2 * rsq[ai][m];
                    bf16_t* p = O + (size_t)row * 768 + colg + 4 * fq;
                    u32x2 w1; w1.x = pk2(o1[0], o1[1]); w1.y = pk2(o1[2], o1[3]); u32x2 w2; w2.x = pk2(o2[0], o2[1]); w2.y = pk2(o2[2], o2[3]);
                    *(u32x2*)p = w1; *(u32x2*)(p + 16) = w2; } }
    }
};
struct EpiBf16 {
    static constexpr bool PERM = true, AFTER_DRAIN = false;
    bf16_t* O; int ldc; float osc;
    __device__ __forceinline__ void operator()(const Acc& acc, const Unit& u, int wr, int wc, int fr, int fq) const {
        const int row0 = u.pm * BM + wr * 64 + fr, col0 = u.pn * BM + wc * 32 + 8 * fq;
#pragma unroll
        for (int ai = 0; ai < 2; ++ai)
#pragma unroll
            for (int m = 0; m < 4; ++m) { bf16_t* rowp = O + (size_t)(row0 + ai * HALF + m * 16) * ldc + col0;
#pragma unroll
                for (int bj = 0; bj < 2; ++bj) { const f32x4 v0 = acc[ai][bj][m][0] * osc, v1 = acc[ai][bj][m][1] * osc;
                    u32x4 w; w.x = pk2(v0[0], v0[1]); w.y = pk2(v0[2], v0[3]); w.z = pk2(v1[0], v1[1]); w.w = pk2(v1[2], v1[3]);
                    *(u32x4*)(rowp + bj * HALF) = w; } }
    }
};
struct EpiBf16Rs {
    static constexpr bool PERM = true, AFTER_DRAIN = false;
    bf16_t* O; int ldc; const float* SSP;
    __device__ __forceinline__ void operator()(const Acc& acc, const Unit& u, int wr, int wc, int fr, int fq) const {
        const int row0 = u.pm * BM + wr * 64 + fr, col0 = u.pn * BM + wc * 32 + 8 * fq;
        float rsq[2][4];
#pragma unroll
        for (int ai = 0; ai < 2; ++ai) { f32x4 sa[4], sb[4];
#pragma unroll
            for (int m = 0; m < 4; ++m) { const float* sp = SSP + (size_t)(row0 + ai * HALF + m * 16) * 16 + 8; sa[m] = *(const f32x4*)sp; sb[m] = *(const f32x4*)(sp + 4); }
#pragma unroll
            for (int m = 0; m < 4; ++m) { const f32x4 t = sa[m] + sb[m]; rsq[ai][m] = 1.0f / sqrtf(((t[0] + t[1]) + (t[2] + t[3])) * (1.0f / 256.0f) + LN_EPS); } }
#pragma unroll
        for (int ai = 0; ai < 2; ++ai)
#pragma unroll
            for (int m = 0; m < 4; ++m) { bf16_t* rowp = O + (size_t)(row0 + ai * HALF + m * 16) * ldc + col0; const float osc = rsq[ai][m];
#pragma unroll
                for (int bj = 0; bj < 2; ++bj) { const f32x4 v0 = acc[ai][bj][m][0] * osc, v1 = acc[ai][bj][m][1] * osc;
                    u32x4 w; w.x = pk2(v0[0], v0[1]); w.y = pk2(v0[2], v0[3]); w.z = pk2(v1[0], v1[1]); w.w = pk2(v1[2], v1[3]);
                    *(u32x4*)(rowp + bj * HALF) = w; } }
    }
};
template <bool ADD> struct EpiGate {
    static constexpr bool PERM = true, AFTER_DRAIN = false;
    bf16_t* O; const bf16_t* Gt; const bf16_t* MT; int goff;
    __device__ __forceinline__ void operator()(const Acc& acc, const Unit& u, int wr, int wc, int fr, int fq) const {
        const int row0 = u.pm * BM + wr * 64 + fr, col0 = u.pn * BM + wc * 32 + 8 * fq;
#pragma unroll
        for (int ai = 0; ai < 2; ++ai) {
#if GATE_U8
            u32x2 gq[4][2]; u32x4 mq[4][2];
#else
            u32x4 gq[4][2], mq[4][2];
#endif
#pragma unroll
            for (int m = 0; m < 4; ++m)
#pragma unroll
                for (int bj = 0; bj < 2; ++bj) { const size_t row = (size_t)(row0 + ai * HALF + m * 16); const int col = col0 + bj * HALF;
#if GATE_U8
                    gq[m][bj] = *(const u32x2*)((const unsigned char*)Gt + row * 2048 + goff + col);
#else
                    gq[m][bj] = *(const u32x4*)(Gt + row * 2048 + goff + col);
#endif
                    if (ADD) mq[m][bj] = *(const u32x4*)(MT + row * 1024 + col); }
#pragma unroll
            for (int m = 0; m < 4; ++m)
#pragma unroll
                for (int bj = 0; bj < 2; ++bj) { const size_t row = (size_t)(row0 + ai * HALF + m * 16); const int col = col0 + bj * HALF;
                    f32x4 v0 = acc[ai][bj][m][0], v1 = acc[ai][bj][m][1];
#if GATE_U8
                    { const u32x2 gv = gq[m][bj]; const float k255 = 1.0f / 255.0f;
                      v0[0] *= (float)(gv.x & 0xffu) * k255; v0[1] *= (float)((gv.x >> 8) & 0xffu) * k255; v0[2] *= (float)((gv.x >> 16) & 0xffu) * k255; v0[3] *= (float)(gv.x >> 24) * k255;
                      v1[0] *= (float)(gv.y & 0xffu) * k255; v1[1] *= (float)((gv.y >> 8) & 0xffu) * k255; v1[2] *= (float)((gv.y >> 16) & 0xffu) * k255; v1[3] *= (float)(gv.y >> 24) * k255; }
#else
                    { const u32x4 gv = gq[m][bj];
                      v0[0] *= bflo(gv.x); v0[1] *= bfhi(gv.x); v0[2] *= bflo(gv.y); v0[3] *= bfhi(gv.y); v1[0] *= bflo(gv.z); v1[1] *= bfhi(gv.z); v1[2] *= bflo(gv.w); v1[3] *= bfhi(gv.w); }
#endif
                    if (ADD) { const u32x4 mv = mq[m][bj];
                        v0[0] += bflo(mv.x); v0[1] += bfhi(mv.x); v0[2] += bflo(mv.y); v0[3] += bfhi(mv.y); v1[0] += bflo(mv.z); v1[1] += bfhi(mv.z); v1[2] += bflo(mv.w); v1[3] += bfhi(mv.w); }
                    u32x4 w; w.x = pk2(v0[0], v0[1]); w.y = pk2(v0[2], v0[3]); w.z = pk2(v1[0], v1[1]); w.w = pk2(v1[2], v1[3]);
                    *(u32x4*)(O + row * 1024 + col) = w; }
        }
    }
};
template <int MODE> struct EpiPre {
    static constexpr bool PERM = true, AFTER_DRAIN = false;
    bf16_t* P; const bf16_t* XB; float alpha; float asc;
    __device__ __forceinline__ void operator()(const Acc& acc, const Unit& u, int wr, int wc, int fr, int fq) const {
        const int row0 = u.pm * BM + wr * 64 + fr, col0 = u.pn * BM + wc * 32 + 8 * fq;
        const float kk_ = -asc * LOG2E;
#define SG_(x) __builtin_amdgcn_rcpf(1.0f + __builtin_amdgcn_exp2f((x) * kk_))
#pragma unroll
        for (int ai = 0; ai < 2; ++ai)
#pragma unroll
          for (int mh = 0; mh < 2; ++mh) {
            u32x4 xq[2][2], pq[2][2];
#pragma unroll
            for (int mm = 0; mm < 2; ++mm)
#pragma unroll
                for (int bj = 0; bj < 2; ++bj) { const int m = 2 * mh + mm; const size_t o = (size_t)(row0 + ai * HALF + m * 16) * 1024 + col0 + bj * HALF;
                    if (MODE == 1 || MODE == 2) xq[mm][bj] = *(const u32x4*)(XB + o);
                    if (MODE == 2 || MODE == 3) pq[mm][bj] = *(const u32x4*)(P + o); }
            __builtin_amdgcn_sched_barrier(0);
#pragma unroll
            for (int mm = 0; mm < 2; ++mm)
#pragma unroll
                for (int bj = 0; bj < 2; ++bj) { const int m = 2 * mh + mm; const size_t o = (size_t)(row0 + ai * HALF + m * 16) * 1024 + col0 + bj * HALF; const f32x4 a0 = acc[ai][bj][m][0], a1 = acc[ai][bj][m][1]; float r[8];
                    if (MODE == 0) { r[0] = a0[0]; r[1] = a0[1]; r[2] = a0[2]; r[3] = a0[3]; r[4] = a1[0]; r[5] = a1[1]; r[6] = a1[2]; r[7] = a1[3]; }
                    else if (MODE == 1) { const u32x4 xv = xq[mm][bj];
                        r[0] = bflo(xv.x) * alpha + a0[0]; r[1] = bfhi(xv.x) * alpha + a0[1]; r[2] = bflo(xv.y) * alpha + a0[2]; r[3] = bfhi(xv.y) * alpha + a0[3];
                        r[4] = bflo(xv.z) * alpha + a1[0]; r[5] = bfhi(xv.z) * alpha + a1[1]; r[6] = bflo(xv.w) * alpha + a1[2]; r[7] = bfhi(xv.w) * alpha + a1[3]; }
                    else if (MODE == 2) { const u32x4 xv = xq[mm][bj]; const u32x4 pv = pq[mm][bj];
                        r[0] = bflo(xv.x) * alpha + SG_(a0[0]) * bflo(pv.x); r[1] = bfhi(xv.x) * alpha + SG_(a0[1]) * bfhi(pv.x); r[2] = bflo(xv.y) * alpha + SG_(a0[2]) * bflo(pv.y); r[3] = bfhi(xv.y) * alpha + SG_(a0[3]) * bfhi(pv.y);
                        r[4] = bflo(xv.z) * alpha + SG_(a1[0]) * bflo(pv.z); r[5] = bfhi(xv.z) * alpha + SG_(a1[1]) * bfhi(pv.z); r[6] = bflo(xv.w) * alpha + SG_(a1[2]) * bflo(pv.w); r[7] = bfhi(xv.w) * alpha + SG_(a1[3]) * bfhi(pv.w); }
                    else { const u32x4 pv = pq[mm][bj];
                        r[0] = bflo(pv.x) + a0[0]; r[1] = bfhi(pv.x) + a0[1]; r[2] = bflo(pv.y) + a0[2]; r[3] = bfhi(pv.y) + a0[3]; r[4] = bflo(pv.z) + a1[0]; r[5] = bfhi(pv.z) + a1[1]; r[6] = bflo(pv.w) + a1[2]; r[7] = bfhi(pv.w) + a1[3]; }
                    u32x4 w; w.x = pk2(r[0], r[1]); w.y = pk2(r[2], r[3]); w.z = pk2(r[4], r[5]); w.w = pk2(r[6], r[7]);
                    *(u32x4*)(P + o) = w; }
            __builtin_amdgcn_sched_barrier(0);
          }
    }
};
#undef SG_

template <int MODE> struct EpiPreLn {
    static constexpr bool PERM = true, AFTER_DRAIN = false;
    const bf16_t* P; bf16_t* XB; unsigned char* XB8; float alpha; const float* gam; const float* bet;
    unsigned long long* ST; unsigned* FLAG; LAS unsigned char* sl;
    __device__ __forceinline__ void operator()(const Acc& acc, const Unit& u, int wr, int wc, int fr, int fq) const {
        const int lane = fr | (fq << 4), t = ((wr * 4 + wc) << 6) | lane;
        const int row0 = u.pm * BM + wr * 64 + fr, col0 = u.pn * BM + wc * 32 + 8 * fq;
        Acc pre; float s1[2][4], s2[2][4];
#pragma unroll
        for (int ai = 0; ai < 2; ++ai)
#pragma unroll
          for (int mh = 0; mh < 2; ++mh) {
            u32x4 xq[2][2];
#pragma unroll
            for (int mm = 0; mm < 2; ++mm)
#pragma unroll
                for (int bj = 0; bj < 2; ++bj) { const int m = 2 * mh + mm; const size_t o = (size_t)(row0 + ai * HALF + m * 16) * 1024 + col0 + bj * HALF;
                    xq[mm][bj] = *(const u32x4*)((MODE == 1 ? (const bf16_t*)XB : P) + o); }
            __builtin_amdgcn_sched_barrier(0);
#pragma unroll
            for (int mm = 0; mm < 2; ++mm) { const int m = 2 * mh + mm; float a1 = 0.f, a2 = 0.f;
#pragma unroll
                for (int bj = 0; bj < 2; ++bj) { const f32x4 a0 = acc[ai][bj][m][0], b0 = acc[ai][bj][m][1]; const u32x4 xv = xq[mm][bj]; const float ka = (MODE == 1) ? alpha : 1.0f;
                    f32x4 r0, r1;
                    r0[0] = bflo(xv.x) * ka + a0[0]; r0[1] = bfhi(xv.x) * ka + a0[1]; r0[2] = bflo(xv.y) * ka + a0[2]; r0[3] = bfhi(xv.y) * ka + a0[3];
                    r1[0] = bflo(xv.z) * ka + b0[0]; r1[1] = bfhi(xv.z) * ka + b0[1]; r1[2] = bflo(xv.w) * ka + b0[2]; r1[3] = bfhi(xv.w) * ka + b0[3];
                    asm volatile("" : "+v"(r0), "+v"(r1));
                    pre[ai][bj][m][0] = r0; pre[ai][bj][m][1] = r1;
                    a1 += ((r0[0] + r0[1]) + (r0[2] + r0[3])) + ((r1[0] + r1[1]) + (r1[2] + r1[3]));
                    a2 += ((r0[0] * r0[0] + r0[1] * r0[1]) + (r0[2] * r0[2] + r0[3] * r0[3])) + ((r1[0] * r1[0] + r1[1] * r1[1]) + (r1[2] * r1[2] + r1[3] * r1[3])); }
                asm volatile("" : "+v"(a1), "+v"(a2)); s1[ai][m] = a1; s2[ai][m] = a2; }
            __builtin_amdgcn_sched_barrier(0);
          }
#pragma unroll
        for (int ai = 0; ai < 2; ++ai)
#pragma unroll
            for (int m = 0; m < 4; ++m) { float a = s1[ai][m], b = s2[ai][m]; a += shx(a, 16, lane); b += shx(b, 16, lane); a += shx(a, 32, lane); b += shx(b, 32, lane);
                if (fq == 0) { const int rl = ai * HALF + wr * 64 + m * 16 + fr; f32x2 w = {a, b}; *(LAS f32x2*)(sl + (rl * 4 + wc) * 8) = w; } }
        int row0b = row0, col0b = col0; asm volatile("" : "+v"(row0b), "+v"(col0b));
        f32x4 gv[2][2], bv[2][2];
#pragma unroll
        for (int bj = 0; bj < 2; ++bj)
#pragma unroll
            for (int n = 0; n < 2; ++n) { gv[bj][n] = *(const f32x4*)(gam + col0b + bj * HALF + 4 * n); bv[bj][n] = *(const f32x4*)(bet + col0b + bj * HALF + 4 * n); }
        __syncthreads();
        unsigned long long* stp = ST + ((size_t)u.pm * 4) * 256 + t;
        if (t < 256) { const LAS f32x2* p = (const LAS f32x2*)(sl + t * 32); const f32x2 w = (p[0] + p[1]) + (p[2] + p[3]);
            __hip_atomic_store(stp + (size_t)u.pn * 256, __builtin_bit_cast(unsigned long long, w), __ATOMIC_RELAXED, __HIP_MEMORY_SCOPE_AGENT); }
        asm volatile("s_waitcnt vmcnt(0)" ::: "memory");
        __syncthreads();
        if (t == 0) { __hip_atomic_fetch_add(FLAG + u.pm, 1u, __ATOMIC_RELAXED, __HIP_MEMORY_SCOPE_AGENT);
            for (int spin = 0; spin < (1 << 20) && __hip_atomic_load(FLAG + u.pm, __ATOMIC_RELAXED, __HIP_MEMORY_SCOPE_AGENT) < 4u; ++spin) __builtin_amdgcn_s_sleep(1); }
        __syncthreads();
        if (t < 256) {
            const unsigned long long q0 = __hip_atomic_load(stp, __ATOMIC_RELAXED, __HIP_MEMORY_SCOPE_AGENT), q1 = __hip_atomic_load(stp + 256, __ATOMIC_RELAXED, __HIP_MEMORY_SCOPE_AGENT),
                                     q2 = __hip_atomic_load(stp + 512, __ATOMIC_RELAXED, __HIP_MEMORY_SCOPE_AGENT), q3 = __hip_atomic_load(stp + 768, __ATOMIC_RELAXED, __HIP_MEMORY_SCOPE_AGENT);
            const f32x2 w = (__builtin_bit_cast(f32x2, q0) + __builtin_bit_cast(f32x2, q1)) + (__builtin_bit_cast(f32x2, q2) + __builtin_bit_cast(f32x2, q3));
            const float mean = w[0] * (1.0f / 1024.0f); float var = w[1] * (1.0f / 1024.0f) - mean * mean; var = var < 0.f ? 0.f : var;
            f32x2 mr = {mean, 1.0f / sqrtf(var + LN_EPS)}; *(LAS f32x2*)(sl + 8192 + t * 8) = mr; }
        __syncthreads();
        const int fqe = (col0b >> 3) & 1;
#pragma unroll
        for (int ai = 0; ai < 2; ++ai)
#pragma unroll
            for (int mp = 0; mp < 2; ++mp) { f32x2 mr[2];
#pragma unroll
                for (int e = 0; e < 2; ++e) mr[e] = *(const LAS f32x2*)(sl + 8192 + (ai * HALF + wr * 64 + (2 * mp + e) * 16 + fr) * 8);
#pragma unroll
                for (int bj = 0; bj < 2; ++bj) { u32x2 w8[2];
#pragma unroll
                    for (int e = 0; e < 2; ++e) { const int m = 2 * mp + e; const size_t o = (size_t)(row0b + ai * HALF + m * 16) * 1024 + col0b;
                        const f32x4 y0 = (pre[ai][bj][m][0] - mr[e][0]) * mr[e][1] * gv[bj][0] + bv[bj][0], y1 = (pre[ai][bj][m][1] - mr[e][0]) * mr[e][1] * gv[bj][1] + bv[bj][1];
                        u32x4 w; w.x = pk2(y0[0], y0[1]); w.y = pk2(y0[2], y0[3]); w.z = pk2(y1[0], y1[1]); w.w = pk2(y1[2], y1[3]);
                        *(u32x4*)(XB + o + bj * HALF) = w;
                        int q0 = __builtin_amdgcn_cvt_pk_fp8_f32(y0[0], y0[1], 0, false); q0 = __builtin_amdgcn_cvt_pk_fp8_f32(y0[2], y0[3], q0, true);
                        int q1 = __builtin_amdgcn_cvt_pk_fp8_f32(y1[0], y1[1], 0, false); q1 = __builtin_amdgcn_cvt_pk_fp8_f32(y1[2], y1[3], q1, true);
                        w8[e].x = (unsigned)q0; w8[e].y = (unsigned)q1; }
                    PG8_PAIR16(w8[0], w8[1]);
                    u32x4 q; q.x = w8[0].x; q.y = w8[0].y; q.z = w8[1].x; q.w = w8[1].y;
                    *(u32x4*)(XB8 + (size_t)(row0b + ai * HALF + (2 * mp + fqe) * 16) * 1024 + (col0b - 8 * fqe) + bj * HALF) = q; } }
    }
};
struct EpiSwiGLU {
    static constexpr bool PERM = true, AFTER_DRAIN = false;
    bf16_t* H; int ldc;
    __device__ __forceinline__ void operator()(const Acc& acc, const Unit& u, int wr, int wc, int fr, int fq) const {
        const int rowb = u.pm * BM + wr * 64 + fr + (fq & 1) * 16, colb = (u.pn * BM + wc * 32 + 8 * (fq & ~1)) >> 1;
#pragma unroll
        for (int ai = 0; ai < 2; ++ai)
#pragma unroll
            for (int mp = 0; mp < 2; ++mp)
#pragma unroll
                for (int bj = 0; bj < 2; ++bj) { u32x2 w[2];
#pragma unroll
                    for (int e = 0; e < 2; ++e) { const int m = 2 * mp + e; const f32x4 v0 = acc[ai][bj][m][0], v1 = acc[ai][bj][m][1];
                        const float h0 = v0[0] * sigmoidf_(v0[0]) * v0[1], h1 = v0[2] * sigmoidf_(v0[2]) * v0[3], h2 = v1[0] * sigmoidf_(v1[0]) * v1[1], h3 = v1[2] * sigmoidf_(v1[2]) * v1[3];
                        w[e].x = pk2(h0, h1); w[e].y = pk2(h2, h3); }
                    PG8_PAIR16(w[0], w[1]);
                    u32x4 q; q.x = w[0].x; q.y = w[0].y; q.z = w[1].x; q.w = w[1].y;
                    *(u32x4*)(H + (size_t)(rowb + ai * HALF + mp * 32) * ldc + colb + bj * (HALF / 2)) = q; }
    }
};

struct EpiSwiGLU8 {
    static constexpr bool PERM = true, AFTER_DRAIN = false;
    unsigned char* H; int ldc; float isc;
    __device__ __forceinline__ void operator()(const Acc& acc, const Unit& u, int wr, int wc, int fr, int fq) const {
        const int rowb = u.pm * BM + wr * 64 + fr + fq * 16, colb = (u.pn * BM + wc * 32) >> 1;
#pragma unroll
        for (int ai = 0; ai < 2; ++ai)
#pragma unroll
            for (int bj = 0; bj < 2; ++bj) { unsigned d[4];
#pragma unroll
                for (int m = 0; m < 4; ++m) { const f32x4 v0 = acc[ai][bj][m][0] * isc, v1 = acc[ai][bj][m][1] * isc;
                    const float h0 = v0[0] * sigmoidf_(v0[0]) * v0[1], h1 = v0[2] * sigmoidf_(v0[2]) * v0[3], h2 = v1[0] * sigmoidf_(v1[0]) * v1[1], h3 = v1[2] * sigmoidf_(v1[2]) * v1[3];
                    int w = __builtin_amdgcn_cvt_pk_fp8_f32(h0, h1, 0, false); w = __builtin_amdgcn_cvt_pk_fp8_f32(h2, h3, w, true); d[m] = (unsigned)w; }
                { const auto r = __builtin_amdgcn_permlane32_swap(d[0], d[2], false, false); d[0] = r[0]; d[2] = r[1]; }
                { const auto r = __builtin_amdgcn_permlane32_swap(d[1], d[3], false, false); d[1] = r[0]; d[3] = r[1]; }
                { const auto r = __builtin_amdgcn_permlane16_swap(d[0], d[1], false, false); d[0] = r[0]; d[1] = r[1]; }
                { const auto r = __builtin_amdgcn_permlane16_swap(d[2], d[3], false, false); d[2] = r[0]; d[3] = r[1]; }
                u32x4 q; q.x = d[0]; q.y = d[1]; q.z = d[2]; q.w = d[3];
                *(u32x4*)(H + (size_t)(rowb + ai * HALF) * ldc + colb + bj * (HALF / 2)) = q; }
    }
};

template <class Epi, class Sched, bool ALIGN_EPI = false, bool SP2 = false, int STAGGER_TICKS = 0>
__device__ __forceinline__ void gemm_phase(PG8_LAS unsigned char* lds, const Gemm g, const Sched& S, const Epi& E, const int tid_in) {
    int tid_ = tid_in; asm volatile("" : "+v"(tid_));
    const int tid = tid_, wid = __builtin_amdgcn_readfirstlane(tid >> 6), lane = tid & 63, wr = wid >> 2, wc = wid & 3, fr = lane & 15, fq = lane >> 4;
    int K_ = g.K; asm volatile("" : "+s"(K_)); const int K = K_, nt = K / BK;
    unsigned voffA[2], voffB[2];
#pragma unroll
    for (int i = 0; i < 2; ++i) { int R, C; stage_rc(tid * 16 + i * 8192, R, C); const int Rb = Epi::PERM ? ((R & ~31) + perm32(R & 31)) : R;
        voffA[i] = (unsigned)(R * K + C) * 2u; voffB[i] = (unsigned)(Rb * K + C) * 2u; }
    const size_t kstep = (size_t)(BK * 2);
    const size_t hstep = (size_t)HALF * K * 2;
    const size_t tstep = 2 * hstep;
    const unsigned ldsw = (unsigned)wid * 1024u;
    const int aoff = lds_byte(wr * 64 + fr, fq * 8), boff = lds_byte(wc * 32 + fr, fq * 8);
#define PG8_SA(b, h) (((b) * 2 + (h)) * HTB)
#define PG8_SB(b, h) ((4 + (b) * 2 + (h)) * HTB)
#define PG8_STAGE(bufoff, gbase, voff) do { _Pragma("unroll") for (int _i = 0; _i < 2; ++_i) \
        __builtin_amdgcn_global_load_lds((const unsigned*)((const char*)(gbase) + (voff)[_i]), (PG8_LAS unsigned*)(lds + (bufoff) + ldsw + _i * 8192), 16, 0, 0); } while (0)
#define PG8_LDA(dst, b, h) do { _Pragma("unroll") for (int m = 0; m < 4; ++m) _Pragma("unroll") for (int k = 0; k < 2; ++k) dst[m][k] = *(const PG8_LAS bf16x8*)(lds + PG8_SA(b, h) + aoff + m * 2048 + k * 1024); } while (0)
#define PG8_LDB(dst, b, h) do { _Pragma("unroll") for (int n = 0; n < 2; ++n) _Pragma("unroll") for (int k = 0; k < 2; ++k) dst[n][k] = *(const PG8_LAS bf16x8*)(lds + PG8_SB(b, h) + boff + n * 2048 + k * 1024); } while (0)
#define PG8_MMA(ai, bj, At, Bt) do { __builtin_amdgcn_s_setprio(1); _Pragma("unroll") for (int m = 0; m < 4; ++m) _Pragma("unroll") for (int n = 0; n < 2; ++n) _Pragma("unroll") for (int k = 0; k < 2; ++k) \
        acc[ai][bj][m][n] = __builtin_amdgcn_mfma_f32_16x16x32_bf16(Bt[n][k], At[m][k], acc[ai][bj][m][n], 0, 0, 0); __builtin_amdgcn_s_setprio(0); } while (0)
#define PG8_WAIT_V(n) asm volatile("s_waitcnt vmcnt(" #n ")" ::: "memory")
#define PG8_WAIT_L(n) asm volatile("s_waitcnt lgkmcnt(" #n ")" ::: "memory")
#define PG8_BAR __builtin_amdgcn_s_barrier()
#define PG8_SCHED __builtin_amdgcn_sched_barrier(0)
    Unit cur, nxt; int ui = 0;
    if (!S.next(0, cur)) return;
#if GEMM_STAGGER
    if (STAGGER_TICKS > 0 && ((blockIdx.x >> 3) & 1)) {
        const unsigned long long t0_ = __builtin_amdgcn_s_memrealtime(); while (__builtin_amdgcn_s_memrealtime() - t0_ < (unsigned long long)STAGGER_TICKS) __builtin_amdgcn_s_sleep(8); }
#endif
    f32x4 acc[2][2][4][2];
#pragma unroll
    for (int a = 0; a < 2; ++a)
#pragma unroll
        for (int b = 0; b < 2; ++b)
#pragma unroll
            for (int m = 0; m < 4; ++m)
#pragma unroll
                for (int n = 0; n < 2; ++n) acc[a][b][m][n] = (f32x4){0.f, 0.f, 0.f, 0.f};
    bf16x8 At[4][2], B0[2][2], B1[2][2];
    const char* cA = (const char*)g.A + (size_t)cur.pm * tstep; const char* cB = (const char*)g.Bt + (size_t)cur.pn * tstep + S.bofs(cur);
    S.a_ready(cur);
    if constexpr (SP2) {
        PG8_STAGE(PG8_SB(0, 0), cB, voffB); PG8_STAGE(PG8_SB(0, 1), cB + hstep, voffB); PG8_STAGE(PG8_SA(0, 0), cA, voffA); PG8_STAGE(PG8_SA(0, 1), cA + hstep, voffA);
        if (wr == 1) PG8_BAR;
        PG8_WAIT_V(2); PG8_BAR;
        PG8_STAGE(PG8_SB(1, 0), cB + kstep, voffB); PG8_STAGE(PG8_SA(1, 0), cA + kstep, voffA); PG8_STAGE(PG8_SB(1, 1), cB + hstep + kstep, voffB);
        PG8_WAIT_V(6); PG8_BAR;
    } else {
        PG8_STAGE(PG8_SB(0, 0), cB, voffB); PG8_STAGE(PG8_SA(0, 0), cA, voffA); PG8_STAGE(PG8_SB(0, 1), cB + hstep, voffB); PG8_STAGE(PG8_SA(0, 1), cA + hstep, voffA);
        if (wr == 1) PG8_BAR;
        PG8_WAIT_V(4); PG8_BAR;
        PG8_STAGE(PG8_SB(1, 0), cB + kstep, voffB); PG8_STAGE(PG8_SA(1, 0), cA + kstep, voffA); PG8_STAGE(PG8_SB(1, 1), cB + hstep + kstep, voffB);
        PG8_WAIT_V(6); PG8_BAR;
    }
    for (;;) {
        const bool has_next = S.next(ui + 1, nxt);
        const char* nA = has_next ? (const char*)g.A + (size_t)nxt.pm * tstep : cA; const char* nB = has_next ? (const char*)g.Bt + (size_t)nxt.pn * tstep + S.bofs(nxt) : cB;
#pragma nounroll
        for (int t = 0; t < nt; t += 2) {
            const bool last = (t == nt - 2);
            const char* a1 = cA + (size_t)(t + 1) * kstep;
            const char* a2 = last ? nA : cA + (size_t)(t + 2) * kstep; const char* b2 = last ? nB : cB + (size_t)(t + 2) * kstep;
            const char* a3 = a2 + kstep; const char* b3 = b2 + kstep;
            if (last && has_next) S.a_ready(nxt);
            if constexpr (SP2) {
            PG8_LDB(B0, 0, 0); PG8_LDB(B1, 0, 1); PG8_SCHED; PG8_LDA(At, 0, 0); PG8_STAGE(PG8_SA(1, 1), a1 + hstep, voffA);
            PG8_WAIT_V(8); PG8_WAIT_L(0); PG8_BAR; PG8_MMA(0, 0, At, B0); PG8_MMA(0, 1, At, B1); PG8_BAR; PG8_SCHED;
            PG8_LDA(At, 0, 1); PG8_STAGE(PG8_SB(0, 0), b2, voffB); PG8_STAGE(PG8_SB(0, 1), b2 + hstep, voffB); PG8_STAGE(PG8_SA(0, 0), a2, voffA);
            PG8_WAIT_V(8); PG8_WAIT_L(0); PG8_BAR; PG8_MMA(1, 0, At, B0); PG8_MMA(1, 1, At, B1); PG8_BAR; PG8_SCHED;
            PG8_LDB(B0, 1, 0); PG8_LDB(B1, 1, 1); PG8_SCHED; PG8_LDA(At, 1, 0); PG8_STAGE(PG8_SA(0, 1), a2 + hstep, voffA);
            PG8_WAIT_V(8); PG8_WAIT_L(0); PG8_BAR; PG8_MMA(0, 0, At, B0); PG8_MMA(0, 1, At, B1); PG8_BAR; PG8_SCHED;
            PG8_LDA(At, 1, 1); PG8_STAGE(PG8_SB(1, 0), b3, voffB); PG8_STAGE(PG8_SB(1, 1), b3 + hstep, voffB); PG8_STAGE(PG8_SA(1, 0), a3, voffA);
            PG8_WAIT_V(8); PG8_WAIT_L(0); PG8_BAR; PG8_MMA(1, 0, At, B0); PG8_MMA(1, 1, At, B1); PG8_BAR; PG8_SCHED;
            } else {
            PG8_LDB(B0, 0, 0); PG8_SCHED; PG8_LDA(At, 0, 0); PG8_STAGE(PG8_SA(1, 1), a1 + hstep, voffA);
            PG8_WAIT_L(8); PG8_BAR; PG8_WAIT_L(0); PG8_MMA(0, 0, At, B0); PG8_BAR; PG8_SCHED;
            PG8_LDB(B1, 0, 1); PG8_STAGE(PG8_SB(0, 0), b2, voffB);
            PG8_BAR; PG8_WAIT_L(0); PG8_MMA(0, 1, At, B1); PG8_BAR;
            PG8_LDA(At, 0, 1); PG8_STAGE(PG8_SA(0, 0), a2, voffA);
            PG8_BAR; PG8_WAIT_L(0); PG8_MMA(1, 0, At, B0); PG8_BAR; PG8_SCHED;
            PG8_STAGE(PG8_SB(0, 1), b2 + hstep, voffB);
            PG8_WAIT_V(6); PG8_BAR; PG8_MMA(1, 1, At, B1); PG8_BAR;
            PG8_LDB(B0, 1, 0); PG8_SCHED; PG8_LDA(At, 1, 0); PG8_STAGE(PG8_SA(0, 1), a2 + hstep, voffA);
            PG8_WAIT_L(8); PG8_BAR; PG8_WAIT_L(0); PG8_MMA(0, 0, At, B0); PG8_BAR; PG8_SCHED;
            PG8_LDB(B1, 1, 1); PG8_STAGE(PG8_SB(1, 0), b3, voffB);
            PG8_BAR; PG8_WAIT_L(0); PG8_MMA(0, 1, At, B1); PG8_BAR;
            PG8_LDA(At, 1, 1); PG8_STAGE(PG8_SA(1, 0), a3, voffA);
            PG8_BAR; PG8_WAIT_L(0); PG8_MMA(1, 0, At, B0); PG8_BAR; PG8_SCHED;
            PG8_STAGE(PG8_SB(1, 1), b3 + hstep, voffB);
            PG8_WAIT_V(6); PG8_BAR; PG8_MMA(1, 1, At, B1); PG8_BAR;
            }
        }
        if constexpr (ALIGN_EPI) { if (wr == 0) PG8_BAR; }
        if constexpr (!Epi::AFTER_DRAIN) { unsigned m1_ = ~0u; asm volatile("" : "+s"(m1_)); const int le_ = (int)__builtin_amdgcn_mbcnt_hi(m1_, __builtin_amdgcn_mbcnt_lo(m1_, 0u));
            E(acc, cur, wr, wc, le_ & 15, le_ >> 4); S.done(cur); }
        if (!has_next) break;
#pragma unroll
        for (int a = 0; a < 2; ++a)
#pragma unroll
            for (int b = 0; b < 2; ++b)
#pragma unroll
                for (int m = 0; m < 4; ++m)
#pragma unroll
                    for (int n = 0; n < 2; ++n) acc[a][b][m][n] = (f32x4){0.f, 0.f, 0.f, 0.f};
        cur = nxt; cA = nA; cB = nB; ++ui;
        if constexpr (ALIGN_EPI) { if (wr == 1) PG8_BAR; }
    }
    PG8_WAIT_V(0);
    if constexpr (!ALIGN_EPI) { if (wr == 0) PG8_BAR; }
    PG8_BAR;
    if constexpr (Epi::AFTER_DRAIN) { E.fused(acc, cur, wr, wc, fr, fq, lds, wid, lane); S.done(cur); }
#undef PG8_SA
#undef PG8_SB
#undef PG8_STAGE
#undef PG8_LDA
#undef PG8_LDB
#undef PG8_MMA
#undef PG8_WAIT_V
#undef PG8_WAIT_L
#undef PG8_BAR
#undef PG8_SCHED
}
typedef int i32x4_ __attribute__((ext_vector_type(4)));
typedef int i32x8_ __attribute__((ext_vector_type(8)));
template <class Epi, class Sched, bool ALIGN_EPI = false, bool SP2 = false, int STAGGER_TICKS = 0>
__device__ __forceinline__ void gemm_phase8(PG8_LAS unsigned char* lds, const Gemm g, const Sched& S, const Epi& E, const int sc1, const int tid_in) {
    int tid_ = tid_in; asm volatile("" : "+v"(tid_));
    const int tid = tid_, wid = __builtin_amdgcn_readfirstlane(tid >> 6), lane = tid & 63, wr = wid >> 2, wc = wid & 3, fr = lane & 15, fq = lane >> 4;
    int K_ = g.K; asm volatile("" : "+s"(K_)); const int K = K_, nt = K / BK;
    unsigned voffA[2], voffB[2];
#pragma unroll
    for (int i = 0; i < 2; ++i) { int R, C; stage_rc(tid * 16 + i * 8192, R, C); const int Rb = Epi::PERM ? ((R & ~31) + perm32(R & 31)) : R;
        voffA[i] = (unsigned)(R * K + C) * 2u; voffB[i] = (unsigned)(Rb * K + C) * 2u; }
    const size_t kstep = (size_t)(BK * 2);
    const size_t hstep = (size_t)HALF * K * 2;
    const size_t tstep = 2 * hstep;
    const unsigned ldsw = (unsigned)wid * 1024u;
    const int cq8 = (fq >> 1) * 32 + 16 * (fq & 1);
    const int aoff = lds_byte(wr * 64 + fr, cq8), boff = lds_byte(wc * 32 + fr, cq8);
#define PG8_SA(b, h) (((b) * 2 + (h)) * HTB)
#define PG8_SB(b, h) ((4 + (b) * 2 + (h)) * HTB)
#define PG8_STAGE(bufoff, gbase, voff) do { _Pragma("unroll") for (int _i = 0; _i < 2; ++_i) \
        __builtin_amdgcn_global_load_lds((const unsigned*)((const char*)(gbase) + (voff)[_i]), (PG8_LAS unsigned*)(lds + (bufoff) + ldsw + _i * 8192), 16, 0, 0); } while (0)
#define PG8_LD16(off) (*(const PG8_LAS i32x4_*)(lds + (off)))
#define PG8_LDA(dst, b, h) do { _Pragma("unroll") for (int m = 0; m < 4; ++m) dst[m] = __builtin_shufflevector(PG8_LD16(PG8_SA(b, h) + aoff + m * 2048), PG8_LD16(PG8_SA(b, h) + aoff + m * 2048 + 16), 0, 1, 2, 3, 4, 5, 6, 7); } while (0)
#define PG8_LDB(dst, b, h) do { _Pragma("unroll") for (int n = 0; n < 2; ++n) dst[n] = __builtin_shufflevector(PG8_LD16(PG8_SB(b, h) + boff + n * 2048), PG8_LD16(PG8_SB(b, h) + boff + n * 2048 + 16), 0, 1, 2, 3, 4, 5, 6, 7); } while (0)
#define PG8_MMA(ai, bj, At, Bt) do { __builtin_amdgcn_s_setprio(1); _Pragma("unroll") for (int m = 0; m < 4; ++m) _Pragma("unroll") for (int n = 0; n < 2; ++n) \
        asm volatile("v_mfma_scale_f32_16x16x128_f8f6f4 %0, %1, %2, %0, %3, %3 op_sel_hi:[0,0,0]" : "+v"(acc[ai][bj][m][n]) : "v"(Bt[n]), "v"(At[m]), "v"(sc1)); __builtin_amdgcn_s_setprio(0); } while (0)
#define PG8_WAIT_V(n) asm volatile("s_waitcnt vmcnt(" #n ")" ::: "memory")
#define PG8_WAIT_L(n) asm volatile("s_waitcnt lgkmcnt(" #n ")" ::: "memory")
#define PG8_BAR __builtin_amdgcn_s_barrier()
#define PG8_SCHED __builtin_amdgcn_sched_barrier(0)
    Unit cur, nxt; int ui = 0;
    if (!S.next(0, cur)) return;
#if GEMM_STAGGER
    if (STAGGER_TICKS > 0 && ((blockIdx.x >> 3) & 1)) {
        const unsigned long long t0_ = __builtin_amdgcn_s_memrealtime(); while (__builtin_amdgcn_s_memrealtime() - t0_ < (unsigned long long)STAGGER_TICKS) __builtin_amdgcn_s_sleep(8); }
#endif
    f32x4 acc[2][2][4][2];
#pragma unroll
    for (int a = 0; a < 2; ++a)
#pragma unroll
        for (int b = 0; b < 2; ++b)
#pragma unroll
            for (int m = 0; m < 4; ++m)
#pragma unroll
                for (int n = 0; n < 2; ++n) acc[a][b][m][n] = (f32x4){0.f, 0.f, 0.f, 0.f};
    i32x8_ At[4], B0[2], B1[2];
    const char* cA = (const char*)g.A + (size_t)cur.pm * tstep; const char* cB = (const char*)g.Bt + (size_t)cur.pn * tstep + S.bofs(cur);
    S.a_ready(cur);
    if constexpr (SP2) {
        PG8_STAGE(PG8_SB(0, 0), cB, voffB); PG8_STAGE(PG8_SB(0, 1), cB + hstep, voffB); PG8_STAGE(PG8_SA(0, 0), cA, voffA); PG8_STAGE(PG8_SA(0, 1), cA + hstep, voffA);
        if (wr == 1) PG8_BAR;
        PG8_WAIT_V(2); PG8_BAR;
        PG8_STAGE(PG8_SB(1, 0), cB + kstep, voffB); PG8_STAGE(PG8_SA(1, 0), cA + kstep, voffA); PG8_STAGE(PG8_SB(1, 1), cB + hstep + kstep, voffB);
        PG8_WAIT_V(6); PG8_BAR;
    } else {
        PG8_STAGE(PG8_SB(0, 0), cB, voffB); PG8_STAGE(PG8_SA(0, 0), cA, voffA); PG8_STAGE(PG8_SB(0, 1), cB + hstep, voffB); PG8_STAGE(PG8_SA(0, 1), cA + hstep, voffA);
        if (wr == 1) PG8_BAR;
        PG8_WAIT_V(4); PG8_BAR;
        PG8_STAGE(PG8_SB(1, 0), cB + kstep, voffB); PG8_STAGE(PG8_SA(1, 0), cA + kstep, voffA); PG8_STAGE(PG8_SB(1, 1), cB + hstep + kstep, voffB);
        PG8_WAIT_V(6); PG8_BAR;
    }
    for (;;) {
        const bool has_next = S.next(ui + 1, nxt);
        const char* nA = has_next ? (const char*)g.A + (size_t)nxt.pm * tstep : cA; const char* nB = has_next ? (const char*)g.Bt + (size_t)nxt.pn * tstep + S.bofs(nxt) : cB;
#pragma nounroll
        for (int t = 0; t < nt; t += 2) {
            const bool last = (t == nt - 2);
            const char* a1 = cA + (size_t)(t + 1) * kstep;
            const char* a2 = last ? nA : cA + (size_t)(t + 2) * kstep; const char* b2 = last ? nB : cB + (size_t)(t + 2) * kstep;
            const char* a3 = a2 + kstep; const char* b3 = b2 + kstep;
            if (last && has_next) S.a_ready(nxt);
            if constexpr (SP2) {
            PG8_LDB(B0, 0, 0); PG8_LDB(B1, 0, 1); PG8_SCHED; PG8_LDA(At, 0, 0); PG8_STAGE(PG8_SA(1, 1), a1 + hstep, voffA);
            PG8_WAIT_V(8); PG8_WAIT_L(0); PG8_BAR; PG8_MMA(0, 0, At, B0); PG8_MMA(0, 1, At, B1); PG8_BAR; PG8_SCHED;
            PG8_LDA(At, 0, 1); PG8_STAGE(PG8_SB(0, 0), b2, voffB); PG8_STAGE(PG8_SB(0, 1), b2 + hstep, voffB); PG8_STAGE(PG8_SA(0, 0), a2, voffA);
            PG8_WAIT_V(8); PG8_WAIT_L(0); PG8_BAR; PG8_MMA(1, 0, At, B0); PG8_MMA(1, 1, At, B1); PG8_BAR; PG8_SCHED;
            PG8_LDB(B0, 1, 0); PG8_LDB(B1, 1, 1); PG8_SCHED; PG8_LDA(At, 1, 0); PG8_STAGE(PG8_SA(0, 1), a2 + hstep, voffA);
            PG8_WAIT_V(8); PG8_WAIT_L(0); PG8_BAR; PG8_MMA(0, 0, At, B0); PG8_MMA(0, 1, At, B1); PG8_BAR; PG8_SCHED;
            PG8_LDA(At, 1, 1); PG8_STAGE(PG8_SB(1, 0), b3, voffB); PG8_STAGE(PG8_SB(1, 1), b3 + hstep, voffB); PG8_STAGE(PG8_SA(1, 0), a3, voffA);
            PG8_WAIT_V(8); PG8_WAIT_L(0); PG8_BAR; PG8_MMA(1, 0, At, B0); PG8_MMA(1, 1, At, B1); PG8_BAR; PG8_SCHED;
            } else {
            PG8_LDB(B0, 0, 0); PG8_SCHED; PG8_LDA(At, 0, 0); PG8_STAGE(PG8_SA(1, 1), a1 + hstep, voffA);
            PG8_WAIT_L(8); PG8_BAR; PG8_WAIT_L(0); PG8_MMA(0, 0, At, B0); PG8_BAR; PG8_SCHED;
            PG8_LDB(B1, 0, 1); PG8_STAGE(PG8_SB(0, 0), b2, voffB);
            PG8_BAR; PG8_WAIT_L(0); PG8_MMA(0, 1, At, B1); PG8_BAR;
            PG8_LDA(At, 0, 1); PG8_STAGE(PG8_SA(0, 0), a2, voffA);
            PG8_BAR; PG8_WAIT_L(0); PG8_MMA(1, 0, At, B0); PG8_BAR; PG8_SCHED;
            PG8_STAGE(PG8_SB(0, 1), b2 + hstep, voffB);
            PG8_WAIT_V(6); PG8_BAR; PG8_MMA(1, 1, At, B1); PG8_BAR;
            PG8_LDB(B0, 1, 0); PG8_SCHED; PG8_LDA(At, 1, 0); PG8_STAGE(PG8_SA(0, 1), a2 + hstep, voffA);
            PG8_WAIT_L(8); PG8_BAR; PG8_WAIT_L(0); PG8_MMA(0, 0, At, B0); PG8_BAR; PG8_SCHED;
            PG8_LDB(B1, 1, 1); PG8_STAGE(PG8_SB(1, 0), b3, voffB);
            PG8_BAR; PG8_WAIT_L(0); PG8_MMA(0, 1, At, B1); PG8_BAR;
            PG8_LDA(At, 1, 1); PG8_STAGE(PG8_SA(1, 0), a3, voffA);
            PG8_BAR; PG8_WAIT_L(0); PG8_MMA(1, 0, At, B0); PG8_BAR; PG8_SCHED;
            PG8_STAGE(PG8_SB(1, 1), b3 + hstep, voffB);
            PG8_WAIT_V(6); PG8_BAR; PG8_MMA(1, 1, At, B1); PG8_BAR;
            }
        }
        if constexpr (ALIGN_EPI) { if (wr == 0) PG8_BAR; }
        asm volatile("s_nop 15\n\ts_nop 15" ::: "memory");
        if constexpr (!Epi::AFTER_DRAIN) { unsigned m1_ = ~0u; asm volatile("" : "+s"(m1_)); const int le_ = (int)__builtin_amdgcn_mbcnt_hi(m1_, __builtin_amdgcn_mbcnt_lo(m1_, 0u));
            E(acc, cur, wr, wc, le_ & 15, le_ >> 4); S.done(cur); }
        if (!has_next) break;
#pragma unroll
        for (int a = 0; a < 2; ++a)
#pragma unroll
            for (int b = 0; b < 2; ++b)
#pragma unroll
                for (int m = 0; m < 4; ++m)
#pragma unroll
                    for (int n = 0; n < 2; ++n) acc[a][b][m][n] = (f32x4){0.f, 0.f, 0.f, 0.f};
        cur = nxt; cA = nA; cB = nB; ++ui;
        if constexpr (ALIGN_EPI) { if (wr == 1) PG8_BAR; }
    }
    PG8_WAIT_V(0);
    if constexpr (!ALIGN_EPI) { if (wr == 0) PG8_BAR; }
    PG8_BAR;
    if constexpr (Epi::AFTER_DRAIN) { E.fused(acc, cur, wr, wc, fr, fq, lds, wid, lane); S.done(cur); }
#undef PG8_SA
#undef PG8_SB
#undef PG8_STAGE
#undef PG8_LDA
#undef PG8_LD16
#undef PG8_LDB
#undef PG8_MMA
#undef PG8_WAIT_V
#undef PG8_WAIT_L
#undef PG8_BAR
#undef PG8_SCHED
}
}

namespace att {
#ifndef ATT_UNROLL_U
#define ATT_UNROLL_U "unroll 1"
#endif
#ifndef A6_VMASK
#define A6_VMASK 0x402
#endif
#ifndef ATT2_PINGPONG
#define ATT2_PINGPONG 1
#endif
#ifndef ATT_STATIC_PRIO
#define ATT_STATIC_PRIO 1
#endif
#ifndef ATT_PRIO
#define ATT_PRIO 0
#endif
#if ATT_PRIO
#define ATT_SETPRIO(x) __builtin_amdgcn_s_setprio(x)
#else
#define ATT_SETPRIO(x) do {} while (0)
#endif
#define MFMA32(a, b, c) __builtin_amdgcn_mfma_f32_32x32x16_bf16((a), (b), (c), 0, 0, 0)
typedef short v4i16_t __attribute__((ext_vector_type(4)));
struct AttnP {
    const bf16* Q; int ldq;
    const bf16* K1; int ldk1;
    const bf16* K2; int ldk2;
    const bf16* V; int ldv;
    bf16* O; int ldo;
    const int* pos;
    const int* blkmax;
    const float* lut;
    const bf16* TI; float lam, osc; const float* gsub;
};
__device__ __forceinline__ s16x4 vtr(const LAS unsigned char* p) { return __builtin_bit_cast(s16x4, __builtin_amdgcn_ds_read_tr16_b64_v4i16((LAS v4i16_t*)p)); }

template <int DQK, int KSPLIT, int DV, bool BIAS, int COMB = 0>
__device__ __forceinline__ void attn_unit(const AttnP& P, int b, int qt, int qcol, int kcol, int vcol, int ocol, int hb, LAS unsigned char* lds, const int tid_in) {
    constexpr int KROWB = DQK * 2 + 16;
    constexpr int VROWB = (DV == 128) ? 320 : 192;
    constexpr int KBYTES = 64 * KROWB, VBYTES = 64 * VROWB, STAGE = KBYTES + VBYTES + 256, LUT_OFF = 2 * STAGE;
    constexpr int ND = DQK / 16, NDB = DV / 32, KCH = DQK / 8, VCH = DV / 8, NKC = 64 * KCH, NVC = 64 * VCH, KL = (NKC + 511) / 512, VL = (NVC + 511) / 512;
    int tid_ = tid_in; asm volatile("" : "+v"(tid_));
    const int tid = tid_, lane = tid & 63, wid = __builtin_amdgcn_readfirstlane(tid >> 6), r = lane & 31, h = lane >> 5;
    const long tok0 = (long)b * SEQ; const int q0 = qt * 256; const int qrow = q0 + wid * 32 + r;
    bf16x8 qf[ND];
    { const bf16* qp = P.Q + (tok0 + qrow) * (long)P.ldq + qcol + 8 * h;
#pragma unroll
      for (int d = 0; d < ND; ++d) qf[d] = *(const bf16x8*)(qp + 16 * d); }
    int posq = 0, posq_min = 0;
    LAS float* lut = (LAS float*)(lds + LUT_OFF);
    if (BIAS) { posq = P.pos[tok0 + qrow]; int mn = posq;
#pragma unroll
        for (int o = 1; o < 64; o <<= 1) { const int t2 = shxi(mn, o, lane); mn = t2 < mn ? t2 : mn; }
        posq_min = mn;
        if (tid < 132) lut[tid] = P.lut[hb * 132 + tid]; }
    v4u kreg[KL], vreg[VL]; int preg = 0;
#define ATT_ISSUE(t) do { const long trow = tok0 + 64 * (long)(t); \
        _Pragma("unroll") for (int i = 0; i < KL; ++i) { const int c = tid + 512 * i; if (NKC % 512 == 0 || c < NKC) { const int row = c / KCH, col = (c % KCH) * 8; \
            const bf16* src = (col < KSPLIT) ? P.K1 + (trow + row) * (long)P.ldk1 + kcol + col : P.K2 + (trow + row) * (long)P.ldk2 + (col - KSPLIT); kreg[i] = *(const v4u*)src; } } \
        _Pragma("unroll") for (int i = 0; i < VL; ++i) { const int c = tid + 512 * i; if (NVC % 512 == 0 || c < NVC) { const int row = c / VCH, col = (c % VCH) * 8; vreg[i] = *(const v4u*)(P.V + (trow + row) * (long)P.ldv + vcol + col); } } \
        if (BIAS && tid < 64) preg = P.pos[trow + tid]; } while (0)
#define ATT_WRITE(t) do { LAS unsigned char* sb = lds + ((t) & 1) * STAGE; \
        _Pragma("unroll") for (int i = 0; i < KL; ++i) { const int c = tid + 512 * i; if (NKC % 512 == 0 || c < NKC) { const int row = c / KCH, cc = c % KCH; *(LAS v4u*)(sb + row * KROWB + cc * 16) = kreg[i]; } } \
        _Pragma("unroll") for (int i = 0; i < VL; ++i) { const int c = tid + 512 * i; if (NVC % 512 == 0 || c < NVC) { const int row = c / VCH, cc = c % VCH; *(LAS v4u*)(sb + KBYTES + row * VROWB + cc * 16) = vreg[i]; } } \
        if (BIAS && tid < 64) *(LAS int*)(sb + KBYTES + VBYTES + 4 * tid) = preg; } while (0)
    f32x16 o[NDB];
#pragma unroll
    for (int i = 0; i < NDB; ++i)
#pragma unroll
        for (int j = 0; j < 16; ++j) o[i][j] = 0.f;
    float m_run = 0.f, l_run = 0.f;
    const int ntiles = (q0 + 256) / 64, my_last = (q0 + wid * 32 + 31) / 64;
#if ATT_STATIC_PRIO
    if (wid >= 4) __builtin_amdgcn_s_setprio(1);
#endif
    ATT_ISSUE(0); ATT_WRITE(0); __syncthreads();
    const int kbase = r * KROWB + 16 * h;
    const int vbase = KBYTES + (4 * h + ((lane & 15) >> 2)) * VROWB + (((lane >> 4) & 1) * 16 + (lane & 3) * 4) * 2;
    for (int t = 0; t < ntiles; ++t) {
        const bool more = (t + 1 < ntiles);
        if (more) ATT_ISSUE(t + 1);
        if (t <= my_last) {
            const LAS unsigned char* sb = lds + (t & 1) * STAGE;
            bool plain = (64 * t + 63 <= q0 + wid * 32);
            float cinit = -m_run;
            if (BIAS) { const int kmax = P.blkmax[(int)(tok0 >> 6) + t]; if (plain && (posq_min - kmax >= 113)) cinit += lut[128]; else plain = false; }
            f32x16 x0, x1;
#pragma unroll
            for (int j = 0; j < 16; ++j) { x0[j] = cinit; x1[j] = cinit; }
            ATT_SETPRIO(1);
            { bf16x8 kf0[ND], kf1[ND];
#pragma unroll
              for (int d = 0; d < ND; ++d) { kf0[d] = *(const LAS bf16x8*)(sb + kbase + d * 32); kf1[d] = *(const LAS bf16x8*)(sb + kbase + 32 * KROWB + d * 32); }
              __builtin_amdgcn_sched_barrier(0);
#pragma unroll
              for (int d = 0; d < ND; ++d) { x0 = MFMA32(kf0[d], qf[d], x0); x1 = MFMA32(kf1[d], qf[d], x1); } }
            ATT_SETPRIO(0);
            if (!plain) {
#pragma unroll
                for (int g = 0; g < 4; ++g) {
                    int pk0[4] = {0, 0, 0, 0}, pk1[4] = {0, 0, 0, 0};
                    if (BIAS) { const LAS int* pp = (const LAS int*)(sb + KBYTES + VBYTES) + 8 * g + 4 * h;
                        const v4u a = *(const LAS v4u*)pp, c = *(const LAS v4u*)(pp + 32);
                        pk0[0] = a.x; pk0[1] = a.y; pk0[2] = a.z; pk0[3] = a.w; pk1[0] = c.x; pk1[1] = c.y; pk1[2] = c.z; pk1[3] = c.w; }
#pragma unroll
                    for (int j = 0; j < 4; ++j) { const int i = 4 * g + j; const int kidx = 64 * t + 8 * g + 4 * h + j;
                        float v0 = x0[i], v1 = x1[i];
                        if (BIAS) { int n0 = posq - pk0[j]; n0 = n0 < 0 ? 0 : (n0 > 128 ? 128 : n0); int n1 = posq - pk1[j]; n1 = n1 < 0 ? 0 : (n1 > 128 ? 128 : n1); v0 += lut[n0]; v1 += lut[n1]; }
                        if (kidx > qrow) v0 = -INFINITY; if (kidx + 32 > qrow) v1 = -INFINITY;
                        x0[i] = v0; x1[i] = v1; }
                }
            }
            float ma = fmaxf(fmaxf(x0[0], x0[1]), x0[2]), mb = fmaxf(fmaxf(x1[0], x1[1]), x1[2]);
#pragma unroll
            for (int j = 3; j < 15; j += 2) { ma = fmaxf(fmaxf(ma, x0[j]), x0[j + 1]); mb = fmaxf(fmaxf(mb, x1[j]), x1[j + 1]); }
            float mx = fmaxf(fmaxf(ma, mb), fmaxf(x0[15], x1[15]));
            { const auto rr = __builtin_amdgcn_permlane32_swap(__float_as_uint(mx), __float_as_uint(mx), false, false); mx = fmaxf(__uint_as_float(rr[0]), __uint_as_float(rr[1])); }
            if (t == 0 || __any(mx > 8.0f)) {
                const float delta = (t == 0) ? mx : fmaxf(mx, 0.f);
                if (t != 0) { const float alpha = __builtin_amdgcn_exp2f(-delta); l_run *= alpha;
#pragma unroll
                    for (int i = 0; i < NDB; ++i) o[i] = o[i] * alpha; }
                m_run += delta;
#pragma unroll
                for (int j = 0; j < 16; ++j) { x0[j] -= delta; x1[j] -= delta; }
            }
            f32x2 ls2 = {0.f, 0.f};
#pragma unroll
            for (int j = 0; j < 16; j += 2) { x0[j] = __builtin_amdgcn_exp2f(x0[j]); x0[j + 1] = __builtin_amdgcn_exp2f(x0[j + 1]); x1[j] = __builtin_amdgcn_exp2f(x1[j]); x1[j + 1] = __builtin_amdgcn_exp2f(x1[j + 1]);
                ls2 += (f32x2){x0[j], x0[j + 1]}; ls2 += (f32x2){x1[j], x1[j + 1]}; }
            l_run += ls2[0] + ls2[1];
            bf16x8 pf[4];
            { v4u w;
              w.x = pk2(x0[0], x0[1]); w.y = pk2(x0[2], x0[3]); w.z = pk2(x0[4], x0[5]); w.w = pk2(x0[6], x0[7]); pf[0] = __builtin_bit_cast(bf16x8, w);
              w.x = pk2(x0[8], x0[9]); w.y = pk2(x0[10], x0[11]); w.z = pk2(x0[12], x0[13]); w.w = pk2(x0[14], x0[15]); pf[1] = __builtin_bit_cast(bf16x8, w);
              w.x = pk2(x1[0], x1[1]); w.y = pk2(x1[2], x1[3]); w.z = pk2(x1[4], x1[5]); w.w = pk2(x1[6], x1[7]); pf[2] = __builtin_bit_cast(bf16x8, w);
              w.x = pk2(x1[8], x1[9]); w.y = pk2(x1[10], x1[11]); w.z = pk2(x1[12], x1[13]); w.w = pk2(x1[14], x1[15]); pf[3] = __builtin_bit_cast(bf16x8, w); }
            ATT_SETPRIO(1);
            { s16x4 vlo[2][4], vhi[2][4];
#define ATT_VLOAD(buf, db) do { _Pragma("unroll") for (int s = 0; s < 4; ++s) { vlo[buf][s] = vtr(sb + vbase + (16 * s) * VROWB + 64 * (db)); vhi[buf][s] = vtr(sb + vbase + (16 * s + 8) * VROWB + 64 * (db)); } } while (0)
              ATT_VLOAD(0, 0);
#pragma unroll
              for (int db = 0; db < NDB; ++db) {
                  if (db + 1 < NDB) ATT_VLOAD((db + 1) & 1, db + 1);
                  __builtin_amdgcn_sched_barrier(0);
#pragma unroll
                  for (int s = 0; s < 4; ++s) { const bf16x8 vf = __builtin_shufflevector(vlo[db & 1][s], vhi[db & 1][s], 0, 1, 2, 3, 4, 5, 6, 7); o[db] = MFMA32(vf, pf[s], o[db]); }
                  __builtin_amdgcn_sched_barrier(0);
              }
#undef ATT_VLOAD
            }
            ATT_SETPRIO(0);
        }
        if (more) ATT_WRITE(t + 1);
        __syncthreads();
    }
#undef ATT_ISSUE
#undef ATT_WRITE
#if ATT_STATIC_PRIO
    __builtin_amdgcn_s_setprio(0);
#endif
    const float lt = l_run + shx(l_run, 32, lane), inv = 1.0f / lt;
    if (COMB == 2) {
        const bf16* ip = P.TI + (tok0 + qrow) * (long)P.ldo + ocol + 4 * h; float ss = 0.f;
#pragma unroll
        for (int db = 0; db < NDB; ++db)
#pragma unroll
            for (int g = 0; g < 4; ++g) { const v2u a = *(const v2u*)(ip + 32 * db + 8 * g);
                const float c0 = bflo(a.x) - P.lam * (o[db][4 * g] * inv), c1 = bfhi(a.x) - P.lam * (o[db][4 * g + 1] * inv), c2 = bflo(a.y) - P.lam * (o[db][4 * g + 2] * inv), c3 = bfhi(a.y) - P.lam * (o[db][4 * g + 3] * inv);
                o[db][4 * g] = c0; o[db][4 * g + 1] = c1; o[db][4 * g + 2] = c2; o[db][4 * g + 3] = c3; ss += (c0 * c0 + c1 * c1) + (c2 * c2 + c3 * c3); }
        ss += shx(ss, 32, lane);
        const float rr = P.osc / sqrtf(ss * (1.0f / 128.0f) + LN_EPS);
        bf16* op = P.O + (tok0 + qrow) * (long)P.ldo + ocol + 4 * h;
#pragma unroll
        for (int db = 0; db < NDB; ++db)
#pragma unroll
            for (int g = 0; g < 4; ++g) { const f32x4 gg = *(const f32x4*)(P.gsub + 32 * db + 8 * g + 4 * h);
                v2u w; w.x = pk2(o[db][4 * g] * rr * gg[0], o[db][4 * g + 1] * rr * gg[1]); w.y = pk2(o[db][4 * g + 2] * rr * gg[2], o[db][4 * g + 3] * rr * gg[3]);
                *(v2u*)(op + 32 * db + 8 * g) = w; }
        return;
    }
    bf16* op = P.O + (tok0 + qrow) * (long)P.ldo + ocol + 4 * h;
#pragma unroll
    for (int db = 0; db < NDB; ++db)
#pragma unroll
        for (int g = 0; g < 4; ++g) { v2u w; w.x = pk2(o[db][4 * g] * inv, o[db][4 * g + 1] * inv); w.y = pk2(o[db][4 * g + 2] * inv, o[db][4 * g + 3] * inv);
            *(v2u*)(op + 32 * db + 8 * g) = w; }
}

template <int DQK, int KSPLIT, int DV, bool BIAS, int COMB = 0>
__device__ __forceinline__ void attn_unit6(const AttnP& P, int b, int qt, int qcol, int kcol, int vcol, int ocol, int hb, LAS unsigned char* lds, const int tid_in) {
    constexpr int KROWB = DQK * 2 + 16;
    constexpr int VROWB = (DV == 128) ? 320 : 192;
    constexpr int KBYTES = 64 * KROWB, VBYTES = 64 * VROWB, STAGE = KBYTES + VBYTES + 256, LUT_OFF = 2 * STAGE;
    constexpr int ND = DQK / 16, NDB = DV / 32, KCH = DQK / 8, VCH = DV / 8, NKC = 64 * KCH, NVC = 64 * VCH, KL = (NKC + 511) / 512, VL = (NVC + 511) / 512;
    int tid_ = tid_in; asm volatile("" : "+v"(tid_));
    const int tid = tid_, lane = tid & 63, wid = __builtin_amdgcn_readfirstlane(tid >> 6), r = lane & 31, h = lane >> 5;
    const long tok0 = (long)b * SEQ; const int q0 = qt * 256; const int qrow = q0 + wid * 32 + r;
    bf16x8 qf[ND];
    { const bf16* qp = P.Q + (tok0 + qrow) * (long)P.ldq + qcol + 8 * h;
#pragma unroll
      for (int d = 0; d < ND; ++d) qf[d] = *(const bf16x8*)(qp + 16 * d); }
    int posq = 0, posq_min = 0;
    LAS float* lut = (LAS float*)(lds + LUT_OFF);
    if (BIAS) { posq = P.pos[tok0 + qrow]; int mn = posq;
#pragma unroll
        for (int o = 1; o < 64; o <<= 1) { const int t2 = shxi(mn, o, lane); mn = t2 < mn ? t2 : mn; }
        posq_min = mn;
        if (tid < 132) lut[tid] = P.lut[hb * 132 + tid]; }
    v4u kreg[KL], vreg[VL]; int preg = 0;
#define ATT_ISSUE(t) do { const long trow = tok0 + 64 * (long)(t); \
        _Pragma("unroll") for (int i = 0; i < KL; ++i) { const int c = tid + 512 * i; if (NKC % 512 == 0 || c < NKC) { const int row = c / KCH, col = (c % KCH) * 8; \
            const bf16* src = (col < KSPLIT) ? P.K1 + (trow + row) * (long)P.ldk1 + kcol + col : P.K2 + (trow + row) * (long)P.ldk2 + (col - KSPLIT); kreg[i] = *(const v4u*)src; } } \
        _Pragma("unroll") for (int i = 0; i < VL; ++i) { const int c = tid + 512 * i; if (NVC % 512 == 0 || c < NVC) { const int row = c / VCH, col = (c % VCH) * 8; vreg[i] = *(const v4u*)(P.V + (trow + row) * (long)P.ldv + vcol + col); } } \
        if (BIAS && tid < 64) preg = P.pos[trow + tid]; } while (0)
#define ATT_WRITE(t) do { LAS unsigned char* sb = lds + ((t) & 1) * STAGE; \
        _Pragma("unroll") for (int i = 0; i < KL; ++i) { const int c = tid + 512 * i; if (NKC % 512 == 0 || c < NKC) { const int row = c / KCH, cc = c % KCH; *(LAS v4u*)(sb + row * KROWB + cc * 16) = kreg[i]; } } \
        _Pragma("unroll") for (int i = 0; i < VL; ++i) { const int c = tid + 512 * i; if (NVC % 512 == 0 || c < NVC) { const int row = c / VCH, cc = c % VCH; *(LAS v4u*)(sb + KBYTES + row * VROWB + cc * 16) = vreg[i]; } } \
        if (BIAS && tid < 64) *(LAS int*)(sb + KBYTES + VBYTES + 4 * tid) = preg; } while (0)
    f32x16 o[NDB];
#pragma unroll
    for (int i = 0; i < NDB; ++i)
#pragma unroll
        for (int j = 0; j < 16; ++j) o[i][j] = 0.f;
    float m_run = 0.f, l_run = 0.f;
    const int ntiles = (q0 + 256) / 64, my_last = (q0 + wid * 32 + 31) / 64;
#if ATT_STATIC_PRIO
    if (wid >= 4) __builtin_amdgcn_s_setprio(1);
#endif
    ATT_ISSUE(0); ATT_WRITE(0); __syncthreads();
    const int kbase = r * KROWB + 16 * h;
    const int vbase = KBYTES + (4 * h + ((lane & 15) >> 2)) * VROWB + (((lane >> 4) & 1) * 16 + (lane & 3) * 4) * 2;
    for (int t = 0; t < ntiles; ++t) {
        const bool more = (t + 1 < ntiles);
        if (more) ATT_ISSUE(t + 1);
        if (t <= my_last) {
            const LAS unsigned char* sb = lds + (t & 1) * STAGE;
            bool plain = (64 * t + 63 <= q0 + wid * 32);
            float cinit = -m_run;
            if (BIAS) { const int kmax = P.blkmax[(int)(tok0 >> 6) + t]; if (plain && (posq_min - kmax >= 113)) cinit += lut[128]; else plain = false; }
            f32x16 x0, x1;
#pragma unroll
            for (int j = 0; j < 16; ++j) { x0[j] = cinit; x1[j] = cinit; }
            ATT_SETPRIO(1);
            { bf16x8 kf0[ND], kf1[ND];
#pragma unroll
              for (int d = 0; d < ND; ++d) { kf0[d] = *(const LAS bf16x8*)(sb + kbase + d * 32); kf1[d] = *(const LAS bf16x8*)(sb + kbase + 32 * KROWB + d * 32); }
              __builtin_amdgcn_sched_barrier(0);
#pragma unroll
              for (int d = 0; d < ND; ++d) { x0 = MFMA32(kf0[d], qf[d], x0); x1 = MFMA32(kf1[d], qf[d], x1); } }
            ATT_SETPRIO(0);
            if (!plain) {
#pragma unroll
                for (int g = 0; g < 4; ++g) {
                    int pk0[4] = {0, 0, 0, 0}, pk1[4] = {0, 0, 0, 0};
                    if (BIAS) { const LAS int* pp = (const LAS int*)(sb + KBYTES + VBYTES) + 8 * g + 4 * h;
                        const v4u a = *(const LAS v4u*)pp, c = *(const LAS v4u*)(pp + 32);
                        pk0[0] = a.x; pk0[1] = a.y; pk0[2] = a.z; pk0[3] = a.w; pk1[0] = c.x; pk1[1] = c.y; pk1[2] = c.z; pk1[3] = c.w; }
#pragma unroll
                    for (int j = 0; j < 4; ++j) { const int i = 4 * g + j; const int kidx = 64 * t + 8 * g + 4 * h + j;
                        float v0 = x0[i], v1 = x1[i];
                        if (BIAS) { int n0 = posq - pk0[j]; n0 = n0 < 0 ? 0 : (n0 > 128 ? 128 : n0); int n1 = posq - pk1[j]; n1 = n1 < 0 ? 0 : (n1 > 128 ? 128 : n1); v0 += lut[n0]; v1 += lut[n1]; }
                        if (kidx > qrow) v0 = -INFINITY; if (kidx + 32 > qrow) v1 = -INFINITY;
                        x0[i] = v0; x1[i] = v1; }
                }
            }
            float ma = fmaxf(fmaxf(x0[0], x0[1]), x0[2]), mb = fmaxf(fmaxf(x1[0], x1[1]), x1[2]);
#pragma unroll
            for (int j = 3; j < 15; j += 2) { ma = fmaxf(fmaxf(ma, x0[j]), x0[j + 1]); mb = fmaxf(fmaxf(mb, x1[j]), x1[j + 1]); }
            float mx = fmaxf(fmaxf(ma, mb), fmaxf(x0[15], x1[15]));
            { const auto rr = __builtin_amdgcn_permlane32_swap(__float_as_uint(mx), __float_as_uint(mx), false, false); mx = fmaxf(__uint_as_float(rr[0]), __uint_as_float(rr[1])); }
            if (t == 0 || __any(mx > 8.0f)) {
                const float delta = (t == 0) ? mx : fmaxf(mx, 0.f);
                if (t != 0) { const float alpha = __builtin_amdgcn_exp2f(-delta); l_run *= alpha;
#pragma unroll
                    for (int i = 0; i < NDB; ++i) o[i] = o[i] * alpha; }
                m_run += delta;
#pragma unroll
                for (int j = 0; j < 16; ++j) { x0[j] -= delta; x1[j] -= delta; }
            }
            f32x2 ls2 = {0.f, 0.f};
            bf16x8 pf[4];
            s16x4 vl[2][NDB], vh[2][NDB];
#define A6_EXP(X, bb, PF) do { \
        X[bb + 0] = __builtin_amdgcn_exp2f(X[bb + 0]); X[bb + 1] = __builtin_amdgcn_exp2f(X[bb + 1]); X[bb + 2] = __builtin_amdgcn_exp2f(X[bb + 2]); X[bb + 3] = __builtin_amdgcn_exp2f(X[bb + 3]); \
        X[bb + 4] = __builtin_amdgcn_exp2f(X[bb + 4]); X[bb + 5] = __builtin_amdgcn_exp2f(X[bb + 5]); X[bb + 6] = __builtin_amdgcn_exp2f(X[bb + 6]); X[bb + 7] = __builtin_amdgcn_exp2f(X[bb + 7]); \
        ls2 += (f32x2){X[bb + 0], X[bb + 1]}; ls2 += (f32x2){X[bb + 2], X[bb + 3]}; ls2 += (f32x2){X[bb + 4], X[bb + 5]}; ls2 += (f32x2){X[bb + 6], X[bb + 7]}; \
        { v4u w_; w_.x = pk2(X[bb + 0], X[bb + 1]); w_.y = pk2(X[bb + 2], X[bb + 3]); w_.z = pk2(X[bb + 4], X[bb + 5]); w_.w = pk2(X[bb + 6], X[bb + 7]); PF = __builtin_bit_cast(bf16x8, w_); } } while (0)
#define A6_VLD(buf, ss) do { _Pragma("unroll") for (int db = 0; db < NDB; ++db) { vl[buf][db] = vtr(sb + vbase + (16 * (ss)) * VROWB + 64 * db); vh[buf][db] = vtr(sb + vbase + (16 * (ss) + 8) * VROWB + 64 * db); } } while (0)
#define A6_MMA(buf, ss) do { _Pragma("unroll") for (int db = 0; db < NDB; ++db) { const bf16x8 vf_ = __builtin_shufflevector(vl[buf][db], vh[buf][db], 0, 1, 2, 3, 4, 5, 6, 7); o[db] = MFMA32(vf_, pf[ss], o[db]); } } while (0)
#define A6_SGB(nv) do { _Pragma("unroll") for (int db = 0; db < NDB; ++db) { __builtin_amdgcn_sched_group_barrier(0x008, 1, 0); __builtin_amdgcn_sched_group_barrier(A6_VMASK, (nv), 0); __builtin_amdgcn_sched_group_barrier(0x100, 2, 0); } } while (0)
            A6_VLD(0, 0);
            A6_EXP(x0, 0, pf[0]);
            __builtin_amdgcn_sched_barrier(0);
            A6_VLD(1, 1); A6_EXP(x0, 8, pf[1]); A6_MMA(0, 0); A6_SGB(16 / NDB);
            __builtin_amdgcn_sched_barrier(0);
            A6_VLD(0, 2); A6_EXP(x1, 0, pf[2]); A6_MMA(1, 1); A6_SGB(16 / NDB);
            __builtin_amdgcn_sched_barrier(0);
            A6_VLD(1, 3); A6_EXP(x1, 8, pf[3]); A6_MMA(0, 2); A6_SGB(16 / NDB);
            __builtin_amdgcn_sched_barrier(0);
            A6_MMA(1, 3);
            __builtin_amdgcn_sched_barrier(0);
            l_run += ls2[0] + ls2[1];
#undef A6_EXP
#undef A6_VLD
#undef A6_MMA
#undef A6_SGB
            ATT_SETPRIO(0);
        }
        if (more) ATT_WRITE(t + 1);
        __syncthreads();
    }
#undef ATT_ISSUE
#undef ATT_WRITE
#if ATT_STATIC_PRIO
    __builtin_amdgcn_s_setprio(0);
#endif
    const float lt = l_run + shx(l_run, 32, lane), inv = 1.0f / lt;
    if (COMB == 2) {
        const bf16* ip = P.TI + (tok0 + qrow) * (long)P.ldo + ocol + 4 * h; float ss = 0.f;
#pragma unroll
        for (int db = 0; db < NDB; ++db)
#pragma unroll
            for (int g = 0; g < 4; ++g) { const v2u a = *(const v2u*)(ip + 32 * db + 8 * g);
                const float c0 = bflo(a.x) - P.lam * (o[db][4 * g] * inv), c1 = bfhi(a.x) - P.lam * (o[db][4 * g + 1] * inv), c2 = bflo(a.y) - P.lam * (o[db][4 * g + 2] * inv), c3 = bfhi(a.y) - P.lam * (o[db][4 * g + 3] * inv);
                o[db][4 * g] = c0; o[db][4 * g + 1] = c1; o[db][4 * g + 2] = c2; o[db][4 * g + 3] = c3; ss += (c0 * c0 + c1 * c1) + (c2 * c2 + c3 * c3); }
        ss += shx(ss, 32, lane);
        const float rr = P.osc / sqrtf(ss * (1.0f / 128.0f) + LN_EPS);
        bf16* op = P.O + (tok0 + qrow) * (long)P.ldo + ocol + 4 * h;
#pragma unroll
        for (int db = 0; db < NDB; ++db)
#pragma unroll
            for (int g = 0; g < 4; ++g) { const f32x4 gg = *(const f32x4*)(P.gsub + 32 * db + 8 * g + 4 * h);
                v2u w; w.x = pk2(o[db][4 * g] * rr * gg[0], o[db][4 * g + 1] * rr * gg[1]); w.y = pk2(o[db][4 * g + 2] * rr * gg[2], o[db][4 * g + 3] * rr * gg[3]);
                *(v2u*)(op + 32 * db + 8 * g) = w; }
        return;
    }
    bf16* op = P.O + (tok0 + qrow) * (long)P.ldo + ocol + 4 * h;
#pragma unroll
    for (int db = 0; db < NDB; ++db)
#pragma unroll
        for (int g = 0; g < 4; ++g) { v2u w; w.x = pk2(o[db][4 * g] * inv, o[db][4 * g + 1] * inv); w.y = pk2(o[db][4 * g + 2] * inv, o[db][4 * g + 3] * inv);
            *(v2u*)(op + 32 * db + 8 * g) = w; }
}

template <int DQK, int KSPLIT, int DV, bool BIAS, int COMB = 0>
__device__ __forceinline__ void attn_unit7(const AttnP& P, int b, int qt, int qcol, int kcol, int vcol, int ocol, int hb, LAS unsigned char* lds, const int tid_in) {
    constexpr int KROWB = DQK * 2 + 16;
    constexpr int VROWB = (DV == 128) ? 320 : 192;
    constexpr int KBYTES = 64 * KROWB, VBYTES = 64 * VROWB, STAGE = KBYTES + VBYTES + 256, LUT_OFF = 2 * STAGE;
    constexpr int ND = DQK / 16, NDB = DV / 32, KCH = DQK / 8, VCH = DV / 8, NKC = 64 * KCH, NVC = 64 * VCH, KL = (NKC + 511) / 512, VL = (NVC + 511) / 512;
    int tid_ = tid_in; asm volatile("" : "+v"(tid_));
    const int tid = tid_, lane = tid & 63, wid = __builtin_amdgcn_readfirstlane(tid >> 6), r = lane & 31, h = lane >> 5;
    const long tok0 = (long)b * SEQ; const int q0 = qt * 256; const int qrow = q0 + wid * 32 + r;
    bf16x8 qf[ND];
    { const bf16* qp = P.Q + (tok0 + qrow) * (long)P.ldq + qcol + 8 * h;
#pragma unroll
      for (int d = 0; d < ND; ++d) qf[d] = *(const bf16x8*)(qp + 16 * d); }
    int posq = 0, posq_min = 0;
    LAS float* lut = (LAS float*)(lds + LUT_OFF);
    if (BIAS) { posq = P.pos[tok0 + qrow]; int mn = posq;
#pragma unroll
        for (int o = 1; o < 64; o <<= 1) { const int t2 = shxi(mn, o, lane); mn = t2 < mn ? t2 : mn; }
        posq_min = mn;
        if (tid < 132) lut[tid] = P.lut[hb * 132 + tid] - P.lut[hb * 132 + 128]; }
    v4u kreg[KL], vreg[VL]; int preg = 0;
#define ATT_ISSUE(t) do { const long trow = tok0 + 64 * (long)(t); \
        _Pragma("unroll") for (int i = 0; i < KL; ++i) { const int c = tid + 512 * i; if (NKC % 512 == 0 || c < NKC) { const int row = c / KCH, col = (c % KCH) * 8; \
            const bf16* src = (col < KSPLIT) ? P.K1 + (trow + row) * (long)P.ldk1 + kcol + col : P.K2 + (trow + row) * (long)P.ldk2 + (col - KSPLIT); kreg[i] = *(const v4u*)src; } } \
        _Pragma("unroll") for (int i = 0; i < VL; ++i) { const int c = tid + 512 * i; if (NVC % 512 == 0 || c < NVC) { const int row = c / VCH, col = (c % VCH) * 8; vreg[i] = *(const v4u*)(P.V + (trow + row) * (long)P.ldv + vcol + col); } } \
        if (BIAS && tid < 64) preg = P.pos[trow + tid]; } while (0)
#define ATT_WRITE(t) do { LAS unsigned char* sb = lds + ((t) & 1) * STAGE; \
        _Pragma("unroll") for (int i = 0; i < KL; ++i) { const int c = tid + 512 * i; if (NKC % 512 == 0 || c < NKC) { const int row = c / KCH, cc = c % KCH; *(LAS v4u*)(sb + row * KROWB + cc * 16) = kreg[i]; } } \
        _Pragma("unroll") for (int i = 0; i < VL; ++i) { const int c = tid + 512 * i; if (NVC % 512 == 0 || c < NVC) { const int row = c / VCH, cc = c % VCH; *(LAS v4u*)(sb + KBYTES + row * VROWB + cc * 16) = vreg[i]; } } \
        if (BIAS && tid < 64) *(LAS int*)(sb + KBYTES + VBYTES + 4 * tid) = preg; } while (0)
    f32x16 o[NDB];
#pragma unroll
    for (int i = 0; i < NDB; ++i)
#pragma unroll
        for (int j = 0; j < 16; ++j) o[i][j] = 0.f;
    float m_run = 0.f, l_run = 0.f;
    f32x16 csp;
    { const float c0_ = BIAS ? P.lut[hb * 132 + 128] : 0.f;
#pragma unroll
      for (int j = 0; j < 16; ++j) csp[j] = c0_; }
    const int ntiles = (q0 + 256) / 64, my_last = (q0 + wid * 32 + 31) / 64;
#if ATT_STATIC_PRIO
    if (wid >= 4) __builtin_amdgcn_s_setprio(1);
#endif
    ATT_ISSUE(0); ATT_WRITE(0); __syncthreads();
    const int kbase = r * KROWB + 16 * h;
    const int vbase = KBYTES + (4 * h + ((lane & 15) >> 2)) * VROWB + (((lane >> 4) & 1) * 16 + (lane & 3) * 4) * 2;
    for (int t = 0; t < ntiles; ++t) {
        const bool more = (t + 1 < ntiles);
        if (more) ATT_ISSUE(t + 1);
        if (t <= my_last) {
            const LAS unsigned char* sb = lds + (t & 1) * STAGE;
            bool plain = (64 * t + 63 <= q0 + wid * 32);
            if (BIAS) { const int kmax = P.blkmax[(int)(tok0 >> 6) + t]; if (!(plain && (posq_min - kmax >= 113))) plain = false; }
            f32x16 x0 = csp, x1 = csp;
            ATT_SETPRIO(1);
            { bf16x8 kf0[ND], kf1[ND];
#pragma unroll
              for (int d = 0; d < ND; ++d) { kf0[d] = *(const LAS bf16x8*)(sb + kbase + d * 32); kf1[d] = *(const LAS bf16x8*)(sb + kbase + 32 * KROWB + d * 32); }
              __builtin_amdgcn_sched_barrier(0);
#pragma unroll
              for (int d = 0; d < ND; ++d) { x0 = MFMA32(kf0[d], qf[d], x0); x1 = MFMA32(kf1[d], qf[d], x1); } }
            ATT_SETPRIO(0);
            if (!plain) {
#pragma unroll
                for (int g = 0; g < 4; ++g) {
                    int pk0[4] = {0, 0, 0, 0}, pk1[4] = {0, 0, 0, 0};
                    if (BIAS) { const LAS int* pp = (const LAS int*)(sb + KBYTES + VBYTES) + 8 * g + 4 * h;
                        const v4u a = *(const LAS v4u*)pp, c = *(const LAS v4u*)(pp + 32);
                        pk0[0] = a.x; pk0[1] = a.y; pk0[2] = a.z; pk0[3] = a.w; pk1[0] = c.x; pk1[1] = c.y; pk1[2] = c.z; pk1[3] = c.w; }
#pragma unroll
                    for (int j = 0; j < 4; ++j) { const int i = 4 * g + j; const int kidx = 64 * t + 8 * g + 4 * h + j;
                        float v0 = x0[i], v1 = x1[i];
                        if (BIAS) { int n0 = posq - pk0[j]; n0 = n0 < 0 ? 0 : (n0 > 128 ? 128 : n0); int n1 = posq - pk1[j]; n1 = n1 < 0 ? 0 : (n1 > 128 ? 128 : n1); v0 += lut[n0]; v1 += lut[n1]; }
                        if (kidx > qrow) v0 = -INFINITY; if (kidx + 32 > qrow) v1 = -INFINITY;
                        x0[i] = v0; x1[i] = v1; }
                }
            }
            float ma = fmaxf(fmaxf(x0[0], x0[1]), x0[2]), mb = fmaxf(fmaxf(x1[0], x1[1]), x1[2]);
#pragma unroll
            for (int j = 3; j < 15; j += 2) { ma = fmaxf(fmaxf(ma, x0[j]), x0[j + 1]); mb = fmaxf(fmaxf(mb, x1[j]), x1[j + 1]); }
            float mx = fmaxf(fmaxf(ma, mb), fmaxf(x0[15], x1[15]));
            { const auto rr = __builtin_amdgcn_permlane32_swap(__float_as_uint(mx), __float_as_uint(mx), false, false); mx = fmaxf(__uint_as_float(rr[0]), __uint_as_float(rr[1])); }
            if (t == 0 || __any(mx > 8.0f)) {
                const float delta = (t == 0) ? mx : fmaxf(mx, 0.f);
                if (t != 0) { const float alpha = __builtin_amdgcn_exp2f(-delta); l_run *= alpha;
#pragma unroll
                    for (int i = 0; i < NDB; ++i) o[i] = o[i] * alpha; }
                m_run += delta;
#pragma unroll
                for (int j = 0; j < 16; ++j) { x0[j] -= delta; x1[j] -= delta; csp[j] -= delta; }
            }
            f32x2 ls2 = {0.f, 0.f};
            bf16x8 pf[4];
            s16x4 vl[2][NDB], vh[2][NDB];
#define A6_EXP(X, bb, PF) do { \
        X[bb + 0] = __builtin_amdgcn_exp2f(X[bb + 0]); X[bb + 1] = __builtin_amdgcn_exp2f(X[bb + 1]); X[bb + 2] = __builtin_amdgcn_exp2f(X[bb + 2]); X[bb + 3] = __builtin_amdgcn_exp2f(X[bb + 3]); \
        X[bb + 4] = __builtin_amdgcn_exp2f(X[bb + 4]); X[bb + 5] = __builtin_amdgcn_exp2f(X[bb + 5]); X[bb + 6] = __builtin_amdgcn_exp2f(X[bb + 6]); X[bb + 7] = __builtin_amdgcn_exp2f(X[bb + 7]); \
        ls2 += (f32x2){X[bb + 0], X[bb + 1]}; ls2 += (f32x2){X[bb + 2], X[bb + 3]}; ls2 += (f32x2){X[bb + 4], X[bb + 5]}; ls2 += (f32x2){X[bb + 6], X[bb + 7]}; \
        { v4u w_; w_.x = pk2(X[bb + 0], X[bb + 1]); w_.y = pk2(X[bb + 2], X[bb + 3]); w_.z = pk2(X[bb + 4], X[bb + 5]); w_.w = pk2(X[bb + 6], X[bb + 7]); PF = __builtin_bit_cast(bf16x8, w_); } } while (0)
#define A6_VLD(buf, ss) do { _Pragma("unroll") for (int db = 0; db < NDB; ++db) { vl[buf][db] = vtr(sb + vbase + (16 * (ss)) * VROWB + 64 * db); vh[buf][db] = vtr(sb + vbase + (16 * (ss) + 8) * VROWB + 64 * db); } } while (0)
#define A6_MMA(buf, ss) do { _Pragma("unroll") for (int db = 0; db < NDB; ++db) { const bf16x8 vf_ = __builtin_shufflevector(vl[buf][db], vh[buf][db], 0, 1, 2, 3, 4, 5, 6, 7); o[db] = MFMA32(vf_, pf[ss], o[db]); } } while (0)
#define A6_SGB(nv) do { _Pragma("unroll") for (int db = 0; db < NDB; ++db) { __builtin_amdgcn_sched_group_barrier(0x008, 1, 0); __builtin_amdgcn_sched_group_barrier(A6_VMASK, (nv), 0); __builtin_amdgcn_sched_group_barrier(0x100, 2, 0); } } while (0)
            A6_VLD(0, 0);
            A6_EXP(x0, 0, pf[0]);
            __builtin_amdgcn_sched_barrier(0);
            A6_VLD(1, 1); A6_EXP(x0, 8, pf[1]); A6_MMA(0, 0); A6_SGB(16 / NDB);
            __builtin_amdgcn_sched_barrier(0);
            A6_VLD(0, 2); A6_EXP(x1, 0, pf[2]); A6_MMA(1, 1); A6_SGB(16 / NDB);
            __builtin_amdgcn_sched_barrier(0);
            A6_VLD(1, 3); A6_EXP(x1, 8, pf[3]); A6_MMA(0, 2); A6_SGB(16 / NDB);
            __builtin_amdgcn_sched_barrier(0);
            A6_MMA(1, 3);
            __builtin_amdgcn_sched_barrier(0);
            l_run += ls2[0] + ls2[1];
#undef A6_EXP
#undef A6_VLD
#undef A6_MMA
#undef A6_SGB
            ATT_SETPRIO(0);
        }
        if (more) ATT_WRITE(t + 1);
        __syncthreads();
    }
#undef ATT_ISSUE
#undef ATT_WRITE
#if ATT_STATIC_PRIO
    __builtin_amdgcn_s_setprio(0);
#endif
    const float lt = l_run + shx(l_run, 32, lane), inv = 1.0f / lt;
    if (COMB == 2) {
        const bf16* ip = P.TI + (tok0 + qrow) * (long)P.ldo + ocol + 4 * h; float ss = 0.f;
#pragma unroll
        for (int db = 0; db < NDB; ++db)
#pragma unroll
            for (int g = 0; g < 4; ++g) { const v2u a = *(const v2u*)(ip + 32 * db + 8 * g);
                const float c0 = bflo(a.x) - P.lam * (o[db][4 * g] * inv), c1 = bfhi(a.x) - P.lam * (o[db][4 * g + 1] * inv), c2 = bflo(a.y) - P.lam * (o[db][4 * g + 2] * inv), c3 = bfhi(a.y) - P.lam * (o[db][4 * g + 3] * inv);
                o[db][4 * g] = c0; o[db][4 * g + 1] = c1; o[db][4 * g + 2] = c2; o[db][4 * g + 3] = c3; ss += (c0 * c0 + c1 * c1) + (c2 * c2 + c3 * c3); }
        ss += shx(ss, 32, lane);
        const float rr = P.osc / sqrtf(ss * (1.0f / 128.0f) + LN_EPS);
        bf16* op = P.O + (tok0 + qrow) * (long)P.ldo + ocol + 4 * h;
#pragma unroll
        for (int db = 0; db < NDB; ++db)
#pragma unroll
            for (int g = 0; g < 4; ++g) { const f32x4 gg = *(const f32x4*)(P.gsub + 32 * db + 8 * g + 4 * h);
                v2u w; w.x = pk2(o[db][4 * g] * rr * gg[0], o[db][4 * g + 1] * rr * gg[1]); w.y = pk2(o[db][4 * g + 2] * rr * gg[2], o[db][4 * g + 3] * rr * gg[3]);
                *(v2u*)(op + 32 * db + 8 * g) = w; }
        return;
    }
    bf16* op = P.O + (tok0 + qrow) * (long)P.ldo + ocol + 4 * h;
#pragma unroll
    for (int db = 0; db < NDB; ++db)
#pragma unroll
        for (int g = 0; g < 4; ++g) { v2u w; w.x = pk2(o[db][4 * g] * inv, o[db][4 * g + 1] * inv); w.y = pk2(o[db][4 * g + 2] * inv, o[db][4 * g + 3] * inv);
            *(v2u*)(op + 32 * db + 8 * g) = w; }
}

template <int DQK, int KSPLIT, int DV, bool BIAS, int COMB = 0>
__device__ __forceinline__ void attn_unit8(const AttnP& P, int b, int qt, int qcol, int kcol, int vcol, int ocol, int hb, LAS unsigned char* lds, const int tid_in) {
    constexpr int KROWB = DQK * 2 + 16;
    constexpr int VROWB = (DV == 128) ? 320 : 192;
    constexpr int KBYTES = 64 * KROWB, VBYTES = 64 * VROWB, STAGE = KBYTES + VBYTES + 256, LUT_OFF = 2 * STAGE;
    constexpr int ND = DQK / 16, NDB = DV / 32, KCH = DQK / 8, VCH = DV / 8, NKC = 64 * KCH, NVC = 64 * VCH, KL = (NKC + 511) / 512, VL = (NVC + 511) / 512;
    int tid_ = tid_in; asm volatile("" : "+v"(tid_));
    const int tid = tid_, lane = tid & 63, wid = __builtin_amdgcn_readfirstlane(tid >> 6), r = lane & 31, h = lane >> 5;
    const long tok0 = (long)b * SEQ; const int q0 = qt * 256; const int qrow = q0 + wid * 32 + r;
    bf16x8 qf[ND];
    { const bf16* qp = P.Q + (tok0 + qrow) * (long)P.ldq + qcol + 8 * h;
#pragma unroll
      for (int d = 0; d < ND; ++d) qf[d] = *(const bf16x8*)(qp + 16 * d); }
    int posq = 0, posq_min = 0;
    LAS float* lut = (LAS float*)(lds + LUT_OFF);
    if (BIAS) { posq = P.pos[tok0 + qrow]; int mn = posq;
#pragma unroll
        for (int o = 1; o < 64; o <<= 1) { const int t2 = shxi(mn, o, lane); mn = t2 < mn ? t2 : mn; }
        posq_min = mn;
        if (tid < 132) lut[tid] = P.lut[hb * 132 + tid] - P.lut[hb * 132 + 128]; }
    v4u kreg[KL], vreg[VL]; int preg = 0;
#define ATT_ISSUE(t) do { const long trow = tok0 + 64 * (long)(t); \
        _Pragma("unroll") for (int i = 0; i < KL; ++i) { const int c = tid + 512 * i; if (NKC % 512 == 0 || c < NKC) { const int row = c / KCH, col = (c % KCH) * 8; \
            const bf16* src = (col < KSPLIT) ? P.K1 + (trow + row) * (long)P.ldk1 + kcol + col : P.K2 + (trow + row) * (long)P.ldk2 + (col - KSPLIT); kreg[i] = *(const v4u*)src; } } \
        _Pragma("unroll") for (int i = 0; i < VL; ++i) { const int c = tid + 512 * i; if (NVC % 512 == 0 || c < NVC) { const int row = c / VCH, col = (c % VCH) * 8; vreg[i] = *(const v4u*)(P.V + (trow + row) * (long)P.ldv + vcol + col); } } \
        if (BIAS && tid < 64) preg = P.pos[trow + tid]; } while (0)
#define ATT_WRITE(t) do { LAS unsigned char* sb = lds + ((t) & 1) * STAGE; \
        _Pragma("unroll") for (int i = 0; i < KL; ++i) { const int c = tid + 512 * i; if (NKC % 512 == 0 || c < NKC) { const int row = c / KCH, cc = c % KCH; *(LAS v4u*)(sb + row * KROWB + cc * 16) = kreg[i]; } } \
        _Pragma("unroll") for (int i = 0; i < VL; ++i) { const int c = tid + 512 * i; if (NVC % 512 == 0 || c < NVC) { const int row = c / VCH, cc = c % VCH; *(LAS v4u*)(sb + KBYTES + row * VROWB + cc * 16) = vreg[i]; } } \
        if (BIAS && tid < 64) *(LAS int*)(sb + KBYTES + VBYTES + 4 * tid) = preg; } while (0)
    f32x16 o[NDB];
#pragma unroll
    for (int i = 0; i < NDB; ++i)
#pragma unroll
        for (int j = 0; j < 16; ++j) o[i][j] = 0.f;
    float m_run = 0.f, l_run = 0.f;
    f32x16 csp;
    { const float c0_ = BIAS ? P.lut[hb * 132 + 128] : 0.f;
#pragma unroll
      for (int j = 0; j < 16; ++j) csp[j] = c0_; }
    const int ntiles = (q0 + 256) / 64, my_last = (q0 + wid * 32 + 31) / 64;
#if ATT_STATIC_PRIO
    if (wid >= 4) __builtin_amdgcn_s_setprio(1);
#endif
    ATT_ISSUE(0); ATT_WRITE(0); __syncthreads();
    const int kbase = r * KROWB + 16 * h;
    const int vbase = KBYTES + (4 * h + ((lane & 15) >> 2)) * VROWB + (((lane >> 4) & 1) * 16 + (lane & 3) * 4) * 2;
    for (int t = 0; t < ntiles; ++t) {
        const bool more = (t + 1 < ntiles);
        if (more) ATT_ISSUE(t + 1);
        if (t <= my_last) {
            const LAS unsigned char* sb = lds + (t & 1) * STAGE;
            bool plain = (64 * t + 63 <= q0 + wid * 32);
            if (BIAS) { const int kmax = P.blkmax[(int)(tok0 >> 6) + t]; if (!(plain && (posq_min - kmax >= 113))) plain = false; }
            f32x16 x0 = csp, x1 = csp;
            ATT_SETPRIO(1);
            { bf16x8 kf0[ND], kf1[ND];
#pragma unroll
              for (int d = 0; d < ND; ++d) { kf0[d] = *(const LAS bf16x8*)(sb + kbase + d * 32); kf1[d] = *(const LAS bf16x8*)(sb + kbase + 32 * KROWB + d * 32); }
              __builtin_amdgcn_sched_barrier(0);
#pragma unroll
              for (int d = 0; d < ND; ++d) { x0 = MFMA32(kf0[d], qf[d], x0); x1 = MFMA32(kf1[d], qf[d], x1); } }
            ATT_SETPRIO(0);
            if (!plain) {
                const int qrel = qrow - 64 * t - 4 * h;
#pragma unroll
                for (int g = 0; g < 4; ++g) {
                    int pk0[4] = {0, 0, 0, 0}, pk1[4] = {0, 0, 0, 0};
                    if (BIAS) { const LAS int* pp = (const LAS int*)(sb + KBYTES + VBYTES) + 8 * g + 4 * h;
                        const v4u a = *(const LAS v4u*)pp, c = *(const LAS v4u*)(pp + 32);
                        pk0[0] = a.x; pk0[1] = a.y; pk0[2] = a.z; pk0[3] = a.w; pk1[0] = c.x; pk1[1] = c.y; pk1[2] = c.z; pk1[3] = c.w; }
#pragma unroll
                    for (int j = 0; j < 4; ++j) { const int i = 4 * g + j;
                        float v0 = x0[i], v1 = x1[i];
                        if (BIAS) { int n0 = posq - pk0[j]; n0 = n0 < 0 ? 0 : (n0 > 128 ? 128 : n0); int n1 = posq - pk1[j]; n1 = n1 < 0 ? 0 : (n1 > 128 ? 128 : n1); v0 += lut[n0]; v1 += lut[n1]; }
                        if (8 * g + j > qrel) v0 = -INFINITY; if (8 * g + j + 32 > qrel) v1 = -INFINITY;
                        x0[i] = v0; x1[i] = v1; }
                }
            }
            if (t == 0) {
                float ma = fmaxf(fmaxf(x0[0], x0[1]), x0[2]), mb = fmaxf(fmaxf(x1[0], x1[1]), x1[2]);
#pragma unroll
                for (int j = 3; j < 15; j += 2) { ma = fmaxf(fmaxf(ma, x0[j]), x0[j + 1]); mb = fmaxf(fmaxf(mb, x1[j]), x1[j + 1]); }
                float mx = fmaxf(fmaxf(ma, mb), fmaxf(x0[15], x1[15]));
                { const auto rr = __builtin_amdgcn_permlane32_swap(__float_as_uint(mx), __float_as_uint(mx), false, false); mx = fmaxf(__uint_as_float(rr[0]), __uint_as_float(rr[1])); }
                m_run += mx;
#pragma unroll
                for (int j = 0; j < 16; ++j) { x0[j] -= mx; x1[j] -= mx; csp[j] -= mx; }
            }
            f32x2 ls2 = {0.f, 0.f};
            bf16x8 pf[4];
            s16x4 vl[2][NDB], vh[2][NDB];
#define A6_EXP(X, bb, PF) do { \
        X[bb + 0] = __builtin_amdgcn_exp2f(X[bb + 0]); X[bb + 1] = __builtin_amdgcn_exp2f(X[bb + 1]); X[bb + 2] = __builtin_amdgcn_exp2f(X[bb + 2]); X[bb + 3] = __builtin_amdgcn_exp2f(X[bb + 3]); \
        X[bb + 4] = __builtin_amdgcn_exp2f(X[bb + 4]); X[bb + 5] = __builtin_amdgcn_exp2f(X[bb + 5]); X[bb + 6] = __builtin_amdgcn_exp2f(X[bb + 6]); X[bb + 7] = __builtin_amdgcn_exp2f(X[bb + 7]); \
        ls2 += (f32x2){X[bb + 0], X[bb + 1]}; ls2 += (f32x2){X[bb + 2], X[bb + 3]}; ls2 += (f32x2){X[bb + 4], X[bb + 5]}; ls2 += (f32x2){X[bb + 6], X[bb + 7]}; \
        { v4u w_; w_.x = pk2(X[bb + 0], X[bb + 1]); w_.y = pk2(X[bb + 2], X[bb + 3]); w_.z = pk2(X[bb + 4], X[bb + 5]); w_.w = pk2(X[bb + 6], X[bb + 7]); PF = __builtin_bit_cast(bf16x8, w_); } } while (0)
#define A6_VLD(buf, ss) do { _Pragma("unroll") for (int db = 0; db < NDB; ++db) { vl[buf][db] = vtr(sb + vbase + (16 * (ss)) * VROWB + 64 * db); vh[buf][db] = vtr(sb + vbase + (16 * (ss) + 8) * VROWB + 64 * db); } } while (0)
#define A6_MMA(buf, ss) do { _Pragma("unroll") for (int db = 0; db < NDB; ++db) { const bf16x8 vf_ = __builtin_shufflevector(vl[buf][db], vh[buf][db], 0, 1, 2, 3, 4, 5, 6, 7); o[db] = MFMA32(vf_, pf[ss], o[db]); } } while (0)
#define A6_SGB(nv) do { _Pragma("unroll") for (int db = 0; db < NDB; ++db) { __builtin_amdgcn_sched_group_barrier(0x008, 1, 0); __builtin_amdgcn_sched_group_barrier(A6_VMASK, (nv), 0); __builtin_amdgcn_sched_group_barrier(0x100, 2, 0); } } while (0)
            A6_VLD(0, 0);
            A6_EXP(x0, 0, pf[0]);
            __builtin_amdgcn_sched_barrier(0);
            A6_VLD(1, 1); A6_EXP(x0, 8, pf[1]); A6_MMA(0, 0); A6_SGB(16 / NDB);
            __builtin_amdgcn_sched_barrier(0);
            A6_VLD(0, 2); A6_EXP(x1, 0, pf[2]); A6_MMA(1, 1); A6_SGB(16 / NDB);
            __builtin_amdgcn_sched_barrier(0);
            A6_VLD(1, 3); A6_EXP(x1, 8, pf[3]); A6_MMA(0, 2); A6_SGB(16 / NDB);
            __builtin_amdgcn_sched_barrier(0);
            A6_MMA(1, 3);
            __builtin_amdgcn_sched_barrier(0);
            { const float ls = ls2[0] + ls2[1];
              l_run += ls;
              if (t != 0 && __any(ls > 256.0f)) {
                  float ma = fmaxf(fmaxf(x0[0], x0[1]), x0[2]), mb = fmaxf(fmaxf(x1[0], x1[1]), x1[2]);
#pragma unroll
                  for (int j = 3; j < 15; j += 2) { ma = fmaxf(fmaxf(ma, x0[j]), x0[j + 1]); mb = fmaxf(fmaxf(mb, x1[j]), x1[j + 1]); }
                  float mp = fmaxf(fmaxf(ma, mb), fmaxf(x0[15], x1[15]));
                  { const auto rr = __builtin_amdgcn_permlane32_swap(__float_as_uint(mp), __float_as_uint(mp), false, false); mp = fmaxf(__uint_as_float(rr[0]), __uint_as_float(rr[1])); }
                  const float delta = fmaxf(__builtin_amdgcn_logf(mp), 0.f), alpha = __builtin_amdgcn_exp2f(-delta);
                  l_run *= alpha; m_run += delta;
#pragma unroll
                  for (int i = 0; i < NDB; ++i) o[i] = o[i] * alpha;
#pragma unroll
                  for (int j = 0; j < 16; ++j) csp[j] -= delta;
              } }
#undef A6_EXP
#undef A6_VLD
#undef A6_MMA
#undef A6_SGB
            ATT_SETPRIO(0);
        }
        if (more) ATT_WRITE(t + 1);
        __syncthreads();
    }
#undef ATT_ISSUE
#undef ATT_WRITE
#if ATT_STATIC_PRIO
    __builtin_amdgcn_s_setprio(0);
#endif
    const float lt = l_run + shx(l_run, 32, lane), inv = 1.0f / lt;
    if (COMB == 2) {
        const bf16* ip = P.TI + (tok0 + qrow) * (long)P.ldo + ocol + 4 * h; float ss = 0.f;
#pragma unroll
        for (int db = 0; db < NDB; ++db)
#pragma unroll
            for (int g = 0; g < 4; ++g) { const v2u a = *(const v2u*)(ip + 32 * db + 8 * g);
                const float c0 = bflo(a.x) - P.lam * (o[db][4 * g] * inv), c1 = bfhi(a.x) - P.lam * (o[db][4 * g + 1] * inv), c2 = bflo(a.y) - P.lam * (o[db][4 * g + 2] * inv), c3 = bfhi(a.y) - P.lam * (o[db][4 * g + 3] * inv);
                o[db][4 * g] = c0; o[db][4 * g + 1] = c1; o[db][4 * g + 2] = c2; o[db][4 * g + 3] = c3; ss += (c0 * c0 + c1 * c1) + (c2 * c2 + c3 * c3); }
        ss += shx(ss, 32, lane);
        const float rr = P.osc / sqrtf(ss * (1.0f / 128.0f) + LN_EPS);
        bf16* op = P.O + (tok0 + qrow) * (long)P.ldo + ocol + 4 * h;
#pragma unroll
        for (int db = 0; db < NDB; ++db)
#pragma unroll
            for (int g = 0; g < 4; ++g) { const f32x4 gg = *(const f32x4*)(P.gsub + 32 * db + 8 * g + 4 * h);
                v2u w; w.x = pk2(o[db][4 * g] * rr * gg[0], o[db][4 * g + 1] * rr * gg[1]); w.y = pk2(o[db][4 * g + 2] * rr * gg[2], o[db][4 * g + 3] * rr * gg[3]);
                *(v2u*)(op + 32 * db + 8 * g) = w; }
        return;
    }
    bf16* op = P.O + (tok0 + qrow) * (long)P.ldo + ocol + 4 * h;
#pragma unroll
    for (int db = 0; db < NDB; ++db)
#pragma unroll
        for (int g = 0; g < 4; ++g) { v2u w; w.x = pk2(o[db][4 * g] * inv, o[db][4 * g + 1] * inv); w.y = pk2(o[db][4 * g + 2] * inv, o[db][4 * g + 3] * inv);
            *(v2u*)(op + 32 * db + 8 * g) = w; }
}

template <int DQK, int KSPLIT, int DV, bool BIAS, int COMB = 0, int VAR = 0>
__device__ __forceinline__ void attn_unit10(const AttnP& P, int b, int qt, int qcol, int kcol, int vcol, int ocol, int hb, LAS unsigned char* lds, const int tid_in) {
    constexpr int KROWB = DQK * 2 + 16;
    constexpr int VROWB = (DV == 128) ? 320 : 192;
    constexpr int KBYTES = 64 * KROWB, VBYTES = 64 * VROWB, STAGE = KBYTES + VBYTES + 256, LUT_OFF = 4 * STAGE;
    constexpr int ND = DQK / 16, NDB = DV / 32, KCH = DQK / 8, VCH = DV / 8, NKC = 64 * KCH, NVC = 64 * VCH, KL = (NKC + 511) / 512, VL = (NVC + 511) / 512;
    int tid_ = tid_in; asm volatile("" : "+v"(tid_));
    const int tid = tid_, lane = tid & 63, wid = __builtin_amdgcn_readfirstlane(tid >> 6), r = lane & 31, h = lane >> 5;
    const long tok0 = (long)b * SEQ; const int q0 = qt * 256; const int qrow = q0 + wid * 32 + r;
    v4u kregA[KL], vregA[VL], kregB[KL], vregB[VL]; int pregA = 0, pregB = 0;
#define ATT_ISSUE1(t, kreg, vreg, preg) do { const long trow = tok0 + 64 * (long)(t); \
        _Pragma("unroll") for (int i = 0; i < KL; ++i) { const int c = tid + 512 * i; if (NKC % 512 == 0 || c < NKC) { const int row = c / KCH, col = (c % KCH) * 8; \
            const bf16* src = (col < KSPLIT) ? P.K1 + (trow + row) * (long)P.ldk1 + kcol + col : P.K2 + (trow + row) * (long)P.ldk2 + (col - KSPLIT); kreg[i] = *(const v4u*)src; } } \
        _Pragma("unroll") for (int i = 0; i < VL; ++i) { const int c = tid + 512 * i; if (NVC % 512 == 0 || c < NVC) { const int row = c / VCH, col = (c % VCH) * 8; vreg[i] = *(const v4u*)(P.V + (trow + row) * (long)P.ldv + vcol + col); } } \
        if (BIAS && tid < 64) preg = P.pos[trow + tid]; } while (0)
#define ATT_WRITE1(t, kreg, vreg, preg) do { LAS unsigned char* sb = lds + ((t) & 3) * STAGE; \
        _Pragma("unroll") for (int i = 0; i < KL; ++i) { const int c = tid + 512 * i; if (NKC % 512 == 0 || c < NKC) { const int row = c / KCH, cc = c % KCH; *(LAS v4u*)(sb + row * KROWB + cc * 16) = kreg[i]; } } \
        _Pragma("unroll") for (int i = 0; i < VL; ++i) { const int c = tid + 512 * i; if (NVC % 512 == 0 || c < NVC) { const int row = c / VCH, cc = c % VCH; *(LAS v4u*)(sb + KBYTES + row * VROWB + cc * 16) = vreg[i]; } } \
        if (BIAS && tid < 64) *(LAS int*)(sb + KBYTES + VBYTES + 4 * tid) = preg; } while (0)
#define ATT_ISSUE(T2) do { ATT_ISSUE1(2 * (T2), kregA, vregA, pregA); ATT_ISSUE1(2 * (T2) + 1, kregB, vregB, pregB); } while (0)
#define ATT_WRITE(T2) do { ATT_WRITE1(2 * (T2), kregA, vregA, pregA); ATT_WRITE1(2 * (T2) + 1, kregB, vregB, pregB); } while (0)
    ATT_ISSUE(0);
    bf16x8 qf[ND];
    { const bf16* qp = P.Q + (tok0 + qrow) * (long)P.ldq + qcol + 8 * h;
#pragma unroll
      for (int d = 0; d < ND; ++d) qf[d] = *(const bf16x8*)(qp + 16 * d); }
    int posq = 0, posq_min = 0;
    LAS float* lut = (LAS float*)(lds + LUT_OFF); LAS int* bmx = (LAS int*)(lds + LUT_OFF + 1024);
    if (BIAS) { posq = P.pos[tok0 + qrow]; int mn = posq;
#pragma unroll
        for (int o = 1; o < 64; o <<= 1) { const int t2 = shxi(mn, o, lane); mn = t2 < mn ? t2 : mn; }
        posq_min = mn;
        { float lv_ = 0.f, l128_ = 0.f; int bv_ = 0;
          if (tid < 132) { lv_ = P.lut[hb * 132 + tid]; l128_ = P.lut[hb * 132 + 128]; }
          if (tid >= 192 && tid < 256) bv_ = P.blkmax[(int)(tok0 >> 6) + (tid - 192)];
          if (tid < 132) lut[tid] = lv_ - l128_;
          if (tid >= 192 && tid < 256) bmx[tid - 192] = bv_; } }
    f32x16 o[NDB];
#pragma unroll
    for (int i = 0; i < NDB; ++i)
#pragma unroll
        for (int j = 0; j < 16; ++j) o[i][j] = 0.f;
    float m_run = 0.f, l_run = 0.f;
    f32x16 csp;
    { const float c0_ = BIAS ? P.lut[hb * 132 + 128] : 0.f;
#pragma unroll
      for (int j = 0; j < 16; ++j) csp[j] = c0_; }
    const int ntiles = (q0 + 256) / 64, my_last = (q0 + wid * 32 + 31) / 64;
#if ATT_STATIC_PRIO
    if (wid >= 4) __builtin_amdgcn_s_setprio(1);
#endif
    ATT_WRITE(0); __syncthreads();
    const int kbase = r * KROWB + 16 * h;
    const int vbase = KBYTES + (4 * h + ((lane & 15) >> 2)) * VROWB + (((lane >> 4) & 1) * 16 + (lane & 3) * 4) * 2;
    for (int T2 = 0; T2 < ntiles / 2; ++T2) {
        const bool more = (2 * T2 + 2 < ntiles);
        if (more && !(VAR & 8)) ATT_ISSUE(T2 + 1);
#pragma unroll 1
        for (int u_ = 0; u_ < 2; ++u_) {
        const int t = 2 * T2 + u_;
        if (t <= my_last) {
            const LAS unsigned char* sb = lds + (t & 3) * STAGE;
            bool plain = (64 * t + 63 <= q0 + wid * 32);
            if (BIAS) { const int kmax = bmx[t]; if (!(plain && (posq_min - kmax >= 113))) plain = false; }
            f32x16 x0 = csp, x1 = csp;
            ATT_SETPRIO(1);
            if (!(VAR & 4)) { bf16x8 kf0[ND], kf1[ND];
#pragma unroll
              for (int d = 0; d < ND; ++d) { kf0[d] = *(const LAS bf16x8*)(sb + kbase + d * 32); kf1[d] = *(const LAS bf16x8*)(sb + kbase + 32 * KROWB + d * 32); }
              __builtin_amdgcn_sched_barrier(0);
#pragma unroll
              for (int d = 0; d < ND; ++d) { x0 = MFMA32(kf0[d], qf[d], x0); x1 = MFMA32(kf1[d], qf[d], x1); } }
            ATT_SETPRIO(0);
            if (!plain) {
                const int qrel = qrow - 64 * t - 4 * h;
#pragma unroll
                for (int g = 0; g < 4; ++g) {
                    int pk0[4] = {0, 0, 0, 0}, pk1[4] = {0, 0, 0, 0};
                    if (BIAS) { const LAS int* pp = (const LAS int*)(sb + KBYTES + VBYTES) + 8 * g + 4 * h;
                        const v4u a = *(const LAS v4u*)pp, c = *(const LAS v4u*)(pp + 32);
                        pk0[0] = a.x; pk0[1] = a.y; pk0[2] = a.z; pk0[3] = a.w; pk1[0] = c.x; pk1[1] = c.y; pk1[2] = c.z; pk1[3] = c.w; }
#pragma unroll
                    for (int j = 0; j < 4; ++j) { const int i = 4 * g + j;
                        float v0 = x0[i], v1 = x1[i];
                        if (BIAS) { int n0 = posq - pk0[j]; n0 = n0 < 0 ? 0 : (n0 > 128 ? 128 : n0); int n1 = posq - pk1[j]; n1 = n1 < 0 ? 0 : (n1 > 128 ? 128 : n1); v0 += lut[n0]; v1 += lut[n1]; }
                        if (8 * g + j > qrel) v0 = -INFINITY; if (8 * g + j + 32 > qrel) v1 = -INFINITY;
                        x0[i] = v0; x1[i] = v1; }
                }
            }
            if (t == 0) {
                float ma = fmaxf(fmaxf(x0[0], x0[1]), x0[2]), mb = fmaxf(fmaxf(x1[0], x1[1]), x1[2]);
#pragma unroll
                for (int j = 3; j < 15; j += 2) { ma = fmaxf(fmaxf(ma, x0[j]), x0[j + 1]); mb = fmaxf(fmaxf(mb, x1[j]), x1[j + 1]); }
                float mx = fmaxf(fmaxf(ma, mb), fmaxf(x0[15], x1[15]));
                { const auto rr = __builtin_amdgcn_permlane32_swap(__float_as_uint(mx), __float_as_uint(mx), false, false); mx = fmaxf(__uint_as_float(rr[0]), __uint_as_float(rr[1])); }
                m_run += mx;
#pragma unroll
                for (int j = 0; j < 16; ++j) { x0[j] -= mx; x1[j] -= mx; csp[j] -= mx; }
            }
            f32x2 ls2 = {0.f, 0.f};
            bf16x8 pf[4];
            s16x4 vl[2][NDB], vh[2][NDB];
#define A6_E2(v_) ((VAR & 1) ? (v_) : __builtin_amdgcn_exp2f(v_))
#define A6_EXP(X, bb, PF) do { \
        X[bb + 0] = A6_E2(X[bb + 0]); X[bb + 1] = A6_E2(X[bb + 1]); X[bb + 2] = A6_E2(X[bb + 2]); X[bb + 3] = A6_E2(X[bb + 3]); \
        X[bb + 4] = A6_E2(X[bb + 4]); X[bb + 5] = A6_E2(X[bb + 5]); X[bb + 6] = A6_E2(X[bb + 6]); X[bb + 7] = A6_E2(X[bb + 7]); \
        ls2 += (f32x2){X[bb + 0], X[bb + 1]}; ls2 += (f32x2){X[bb + 2], X[bb + 3]}; ls2 += (f32x2){X[bb + 4], X[bb + 5]}; ls2 += (f32x2){X[bb + 6], X[bb + 7]}; \
        { v4u w_; w_.x = pk2(X[bb + 0], X[bb + 1]); w_.y = pk2(X[bb + 2], X[bb + 3]); w_.z = pk2(X[bb + 4], X[bb + 5]); w_.w = pk2(X[bb + 6], X[bb + 7]); PF = __builtin_bit_cast(bf16x8, w_); } } while (0)
#define A6_VLD(buf, ss) do { _Pragma("unroll") for (int db = 0; db < NDB; ++db) { vl[buf][db] = vtr(sb + vbase + (16 * (ss)) * VROWB + 64 * db); vh[buf][db] = vtr(sb + vbase + (16 * (ss) + 8) * VROWB + 64 * db); } } while (0)
#define A6_MMA(buf, ss) do { if (VAR & 2) break; _Pragma("unroll") for (int db = 0; db < NDB; ++db) { const bf16x8 vf_ = __builtin_shufflevector(vl[buf][db], vh[buf][db], 0, 1, 2, 3, 4, 5, 6, 7); o[db] = MFMA32(vf_, pf[ss], o[db]); } } while (0)
#define A6_SGB(nv) do { _Pragma("unroll") for (int db = 0; db < NDB; ++db) { __builtin_amdgcn_sched_group_barrier(0x008, 1, 0); __builtin_amdgcn_sched_group_barrier(A6_VMASK, (nv), 0); __builtin_amdgcn_sched_group_barrier(0x100, 2, 0); } } while (0)
            A6_VLD(0, 0);
            A6_EXP(x0, 0, pf[0]);
            __builtin_amdgcn_sched_barrier(0);
            A6_VLD(1, 1); A6_EXP(x0, 8, pf[1]); A6_MMA(0, 0); A6_SGB(16 / NDB);
            __builtin_amdgcn_sched_barrier(0);
            A6_VLD(0, 2); A6_EXP(x1, 0, pf[2]); A6_MMA(1, 1); A6_SGB(16 / NDB);
            __builtin_amdgcn_sched_barrier(0);
            A6_VLD(1, 3); A6_EXP(x1, 8, pf[3]); A6_MMA(0, 2); A6_SGB(16 / NDB);
            __builtin_amdgcn_sched_barrier(0);
            A6_MMA(1, 3);
            __builtin_amdgcn_sched_barrier(0);
            { const float ls = ls2[0] + ls2[1];
              l_run += ls;
              if (t != 0 && __any(ls > 256.0f)) {
                  float ma = fmaxf(fmaxf(x0[0], x0[1]), x0[2]), mb = fmaxf(fmaxf(x1[0], x1[1]), x1[2]);
#pragma unroll
                  for (int j = 3; j < 15; j += 2) { ma = fmaxf(fmaxf(ma, x0[j]), x0[j + 1]); mb = fmaxf(fmaxf(mb, x1[j]), x1[j + 1]); }
                  float mp = fmaxf(fmaxf(ma, mb), fmaxf(x0[15], x1[15]));
                  { const auto rr = __builtin_amdgcn_permlane32_swap(__float_as_uint(mp), __float_as_uint(mp), false, false); mp = fmaxf(__uint_as_float(rr[0]), __uint_as_float(rr[1])); }
                  const float delta = fmaxf(__builtin_amdgcn_logf(mp), 0.f), alpha = __builtin_amdgcn_exp2f(-delta);
                  l_run *= alpha; m_run += delta;
#pragma unroll
                  for (int i = 0; i < NDB; ++i) o[i] = o[i] * alpha;
#pragma unroll
                  for (int j = 0; j < 16; ++j) csp[j] -= delta;
              } }
#undef A6_EXP
#undef A6_E2
#undef A6_VLD
#undef A6_MMA
#undef A6_SGB
            ATT_SETPRIO(0);
        }
        }
        if (more && !(VAR & 8)) ATT_WRITE(T2 + 1);
        if (!(VAR & 16)) __syncthreads();
    }
#undef ATT_ISSUE
#undef ATT_ISSUE1
#undef ATT_WRITE
#undef ATT_WRITE1
#if ATT_STATIC_PRIO
    __builtin_amdgcn_s_setprio(0);
#endif
    const float lt = l_run + shx(l_run, 32, lane), inv = 1.0f / lt;
#define A10_SWAP(A_, B_) do { const auto r0_ = __builtin_amdgcn_permlane32_swap((A_).x, (B_).x, false, false); (A_).x = r0_[0]; (B_).x = r0_[1]; \
                              const auto r1_ = __builtin_amdgcn_permlane32_swap((A_).y, (B_).y, false, false); (A_).y = r1_[0]; (B_).y = r1_[1]; } while (0)
    const long rowoff = (tok0 + qrow) * (long)P.ldo + ocol + 8 * h;
    if (COMB == 2) {
        const bf16* ip = P.TI + rowoff; float ss = 0.f;
#pragma unroll
        for (int db = 0; db < NDB; ++db)
#pragma unroll
            for (int gp = 0; gp < 2; ++gp) { const v4u q = *(const v4u*)(ip + 32 * db + 16 * gp); v2u a, c; a.x = q.x; a.y = q.y; c.x = q.z; c.y = q.w; A10_SWAP(a, c);
#pragma unroll
                for (int e = 0; e < 2; ++e) { const int g = 2 * gp + e; const v2u t = e ? c : a;
                    const float c0 = bflo(t.x) - P.lam * (o[db][4 * g] * inv), c1 = bfhi(t.x) - P.lam * (o[db][4 * g + 1] * inv), c2 = bflo(t.y) - P.lam * (o[db][4 * g + 2] * inv), c3 = bfhi(t.y) - P.lam * (o[db][4 * g + 3] * inv);
                    o[db][4 * g] = c0; o[db][4 * g + 1] = c1; o[db][4 * g + 2] = c2; o[db][4 * g + 3] = c3; ss += (c0 * c0 + c1 * c1) + (c2 * c2 + c3 * c3); } }
        ss += shx(ss, 32, lane);
        const float rr = P.osc / sqrtf(ss * (1.0f / 128.0f) + LN_EPS);
        bf16* op = P.O + rowoff;
#pragma unroll
        for (int db = 0; db < NDB; ++db)
#pragma unroll
            for (int gp = 0; gp < 2; ++gp) { v2u w[2];
#pragma unroll
                for (int e = 0; e < 2; ++e) { const int g = 2 * gp + e; const f32x4 gg = *(const f32x4*)(P.gsub + 32 * db + 8 * g + 4 * h);
                    w[e].x = pk2(o[db][4 * g] * rr * gg[0], o[db][4 * g + 1] * rr * gg[1]); w[e].y = pk2(o[db][4 * g + 2] * rr * gg[2], o[db][4 * g + 3] * rr * gg[3]); }
                A10_SWAP(w[0], w[1]);
                v4u q; q.x = w[0].x; q.y = w[0].y; q.z = w[1].x; q.w = w[1].y; *(v4u*)(op + 32 * db + 16 * gp) = q; }
        return;
    }
    bf16* op = P.O + rowoff;
#pragma unroll
    for (int db = 0; db < NDB; ++db)
#pragma unroll
        for (int gp = 0; gp < 2; ++gp) { v2u w[2];
#pragma unroll
            for (int e = 0; e < 2; ++e) { const int g = 2 * gp + e; w[e].x = pk2(o[db][4 * g] * inv, o[db][4 * g + 1] * inv); w[e].y = pk2(o[db][4 * g + 2] * inv, o[db][4 * g + 3] * inv); }
            A10_SWAP(w[0], w[1]);
            v4u q; q.x = w[0].x; q.y = w[0].y; q.z = w[1].x; q.w = w[1].y; *(v4u*)(op + 32 * db + 16 * gp) = q; }
#undef A10_SWAP
}

template <int DQK, int KSPLIT, int DV, bool BIAS, int COMB = 0>
__device__ __forceinline__ void attn_unit9(const AttnP& P, int b, int qt, int qcol, int kcol, int vcol, int ocol, int hb, LAS unsigned char* lds, const int tid_in) {
    constexpr int KROWB = DQK * 2 + 16;
    constexpr int VROWB = (DV == 128) ? 320 : 192;
    constexpr int KBYTES = 64 * KROWB, VBYTES = 64 * VROWB, STAGE = KBYTES + VBYTES + 256, LUT_OFF = 2 * STAGE;
    constexpr int ND = DQK / 16, NDB = DV / 32, KCH = DQK / 8, VCH = DV / 8, NKC = 64 * KCH, NVC = 64 * VCH, KL = (NKC + 511) / 512, VL = (NVC + 511) / 512;
    int tid_ = tid_in; asm volatile("" : "+v"(tid_));
    const int tid = tid_, lane = tid & 63, wid = __builtin_amdgcn_readfirstlane(tid >> 6), r = lane & 31, h = lane >> 5;
    const long tok0 = (long)b * SEQ; const int q0 = qt * 256; const int qrow = q0 + wid * 32 + r;
    bf16x8 qf[ND];
    { const bf16* qp = P.Q + (tok0 + qrow) * (long)P.ldq + qcol + 8 * h;
#pragma unroll
      for (int d = 0; d < ND; ++d) qf[d] = *(const bf16x8*)(qp + 16 * d); }
    int posq = 0, posq_min = 0;
    LAS float* lut = (LAS float*)(lds + LUT_OFF);
    if (BIAS) { posq = P.pos[tok0 + qrow]; int mn = posq;
#pragma unroll
        for (int o = 1; o < 64; o <<= 1) { const int t2 = shxi(mn, o, lane); mn = t2 < mn ? t2 : mn; }
        posq_min = mn;
        if (tid < 132) lut[tid] = P.lut[hb * 132 + tid] - P.lut[hb * 132 + 128]; }
    v4u kreg[KL], vreg[VL]; int preg = 0;
#define ATT_ISSUE(t) do { const long trow = tok0 + 64 * (long)(t); \
        _Pragma("unroll") for (int i = 0; i < KL; ++i) { const int c = tid + 512 * i; if (NKC % 512 == 0 || c < NKC) { const int row = c / KCH, col = (c % KCH) * 8; \
            const bf16* src = (col < KSPLIT) ? P.K1 + (trow + row) * (long)P.ldk1 + kcol + col : P.K2 + (trow + row) * (long)P.ldk2 + (col - KSPLIT); kreg[i] = *(const v4u*)src; } } \
        _Pragma("unroll") for (int i = 0; i < VL; ++i) { const int c = tid + 512 * i; if (NVC % 512 == 0 || c < NVC) { const int row = c / VCH, col = (c % VCH) * 8; vreg[i] = *(const v4u*)(P.V + (trow + row) * (long)P.ldv + vcol + col); } } \
        if (BIAS && tid < 64) preg = P.pos[trow + tid]; } while (0)
#define ATT_WRITE(t) do { LAS unsigned char* sb = lds + ((t) & 1) * STAGE; \
        _Pragma("unroll") for (int i = 0; i < KL; ++i) { const int c = tid + 512 * i; if (NKC % 512 == 0 || c < NKC) { const int row = c / KCH, cc = c % KCH; *(LAS v4u*)(sb + row * KROWB + cc * 16) = kreg[i]; } } \
        _Pragma("unroll") for (int i = 0; i < VL; ++i) { const int c = tid + 512 * i; if (NVC % 512 == 0 || c < NVC) { const int row = c / VCH, cc = c % VCH; *(LAS v4u*)(sb + KBYTES + row * VROWB + cc * 16) = vreg[i]; } } \
        if (BIAS && tid < 64) *(LAS int*)(sb + KBYTES + VBYTES + 4 * tid) = preg; } while (0)
    f32x16 o[NDB];
#pragma unroll
    for (int i = 0; i < NDB; ++i)
#pragma unroll
        for (int j = 0; j < 16; ++j) o[i][j] = 0.f;
    float m_run = 0.f, l_run = 0.f;
    f32x16 lacc;
#pragma unroll
    for (int j = 0; j < 16; ++j) lacc[j] = 0.f;
    const bf16x8 ones8 = {0x3f80, 0x3f80, 0x3f80, 0x3f80, 0x3f80, 0x3f80, 0x3f80, 0x3f80};
    f32x16 csp;
    { const float c0_ = BIAS ? P.lut[hb * 132 + 128] : 0.f;
#pragma unroll
      for (int j = 0; j < 16; ++j) csp[j] = c0_; }
    const int ntiles = (q0 + 256) / 64, my_last = (q0 + wid * 32 + 31) / 64;
#if ATT_STATIC_PRIO
    if (wid >= 4) __builtin_amdgcn_s_setprio(1);
#endif
    ATT_ISSUE(0); ATT_WRITE(0); __syncthreads();
    const int kbase = r * KROWB + 16 * h;
    const int vbase = KBYTES + (4 * h + ((lane & 15) >> 2)) * VROWB + (((lane >> 4) & 1) * 16 + (lane & 3) * 4) * 2;
    for (int t = 0; t < ntiles; ++t) {
        const bool more = (t + 1 < ntiles);
        if (more) ATT_ISSUE(t + 1);
        if (t <= my_last) {
            const LAS unsigned char* sb = lds + (t & 1) * STAGE;
            bool plain = (64 * t + 63 <= q0 + wid * 32);
            if (t >= 2) {
                const float lnow = lacc[0], ls = lnow - l_run;
                if (__any(ls > 1024.0f)) {
                    const float delta = fmaxf(__builtin_amdgcn_logf(ls) - 4.0f, 0.f), alpha = __builtin_amdgcn_exp2f(-delta);
                    m_run += delta; lacc = lacc * alpha;
#pragma unroll
                    for (int i = 0; i < NDB; ++i) o[i] = o[i] * alpha;
#pragma unroll
                    for (int j = 0; j < 16; ++j) csp[j] -= delta;
                }
                l_run = lacc[0];
            } else if (t == 1) l_run = lacc[0];
            if (BIAS) { const int kmax = P.blkmax[(int)(tok0 >> 6) + t]; if (!(plain && (posq_min - kmax >= 113))) plain = false; }
            f32x16 x0 = csp, x1 = csp;
            ATT_SETPRIO(1);
            { bf16x8 kf0[ND], kf1[ND];
#pragma unroll
              for (int d = 0; d < ND; ++d) { kf0[d] = *(const LAS bf16x8*)(sb + kbase + d * 32); kf1[d] = *(const LAS bf16x8*)(sb + kbase + 32 * KROWB + d * 32); }
              __builtin_amdgcn_sched_barrier(0);
#pragma unroll
              for (int d = 0; d < ND; ++d) { x0 = MFMA32(kf0[d], qf[d], x0); x1 = MFMA32(kf1[d], qf[d], x1); } }
            ATT_SETPRIO(0);
            if (!plain) {
#pragma unroll
                for (int g = 0; g < 4; ++g) {
                    int pk0[4] = {0, 0, 0, 0}, pk1[4] = {0, 0, 0, 0};
                    if (BIAS) { const LAS int* pp = (const LAS int*)(sb + KBYTES + VBYTES) + 8 * g + 4 * h;
                        const v4u a = *(const LAS v4u*)pp, c = *(const LAS v4u*)(pp + 32);
                        pk0[0] = a.x; pk0[1] = a.y; pk0[2] = a.z; pk0[3] = a.w; pk1[0] = c.x; pk1[1] = c.y; pk1[2] = c.z; pk1[3] = c.w; }
#pragma unroll
                    for (int j = 0; j < 4; ++j) { const int i = 4 * g + j; const int kidx = 64 * t + 8 * g + 4 * h + j;
                        float v0 = x0[i], v1 = x1[i];
                        if (BIAS) { int n0 = posq - pk0[j]; n0 = n0 < 0 ? 0 : (n0 > 128 ? 128 : n0); int n1 = posq - pk1[j]; n1 = n1 < 0 ? 0 : (n1 > 128 ? 128 : n1); v0 += lut[n0]; v1 += lut[n1]; }
                        if (kidx > qrow) v0 = -INFINITY; if (kidx + 32 > qrow) v1 = -INFINITY;
                        x0[i] = v0; x1[i] = v1; }
                }
            }
            if (t == 0) {
                float ma = fmaxf(fmaxf(x0[0], x0[1]), x0[2]), mb = fmaxf(fmaxf(x1[0], x1[1]), x1[2]);
#pragma unroll
                for (int j = 3; j < 15; j += 2) { ma = fmaxf(fmaxf(ma, x0[j]), x0[j + 1]); mb = fmaxf(fmaxf(mb, x1[j]), x1[j + 1]); }
                float mx = fmaxf(fmaxf(ma, mb), fmaxf(x0[15], x1[15]));
                { const auto rr = __builtin_amdgcn_permlane32_swap(__float_as_uint(mx), __float_as_uint(mx), false, false); mx = fmaxf(__uint_as_float(rr[0]), __uint_as_float(rr[1])); }
                m_run += mx;
#pragma unroll
                for (int j = 0; j < 16; ++j) { x0[j] -= mx; x1[j] -= mx; csp[j] -= mx; }
            }
            bf16x8 pf[4];
            s16x4 vl[2][NDB], vh[2][NDB];
#define A6_EXP(X, bb, PF) do { \
        X[bb + 0] = __builtin_amdgcn_exp2f(X[bb + 0]); X[bb + 1] = __builtin_amdgcn_exp2f(X[bb + 1]); X[bb + 2] = __builtin_amdgcn_exp2f(X[bb + 2]); X[bb + 3] = __builtin_amdgcn_exp2f(X[bb + 3]); \
        X[bb + 4] = __builtin_amdgcn_exp2f(X[bb + 4]); X[bb + 5] = __builtin_amdgcn_exp2f(X[bb + 5]); X[bb + 6] = __builtin_amdgcn_exp2f(X[bb + 6]); X[bb + 7] = __builtin_amdgcn_exp2f(X[bb + 7]); \
        { v4u w_; w_.x = pk2(X[bb + 0], X[bb + 1]); w_.y = pk2(X[bb + 2], X[bb + 3]); w_.z = pk2(X[bb + 4], X[bb + 5]); w_.w = pk2(X[bb + 6], X[bb + 7]); PF = __builtin_bit_cast(bf16x8, w_); } } while (0)
#define A6_VLD(buf, ss) do { _Pragma("unroll") for (int db = 0; db < NDB; ++db) { vl[buf][db] = vtr(sb + vbase + (16 * (ss)) * VROWB + 64 * db); vh[buf][db] = vtr(sb + vbase + (16 * (ss) + 8) * VROWB + 64 * db); } } while (0)
#define A6_MMA(buf, ss) do { _Pragma("unroll") for (int db = 0; db < NDB; ++db) { const bf16x8 vf_ = __builtin_shufflevector(vl[buf][db], vh[buf][db], 0, 1, 2, 3, 4, 5, 6, 7); o[db] = MFMA32(vf_, pf[ss], o[db]); } lacc = MFMA32(ones8, pf[ss], lacc); } while (0)
#define A6_SGB(nv) do { _Pragma("unroll") for (int db = 0; db < NDB; ++db) { __builtin_amdgcn_sched_group_barrier(0x008, 1, 0); __builtin_amdgcn_sched_group_barrier(A6_VMASK, (nv), 0); __builtin_amdgcn_sched_group_barrier(0x100, 2, 0); } __builtin_amdgcn_sched_group_barrier(0x008, 1, 0); } while (0)
            A6_VLD(0, 0);
            A6_EXP(x0, 0, pf[0]);
            __builtin_amdgcn_sched_barrier(0);
            A6_VLD(1, 1); A6_EXP(x0, 8, pf[1]); A6_MMA(0, 0); A6_SGB(12 / NDB);
            __builtin_amdgcn_sched_barrier(0);
            A6_VLD(0, 2); A6_EXP(x1, 0, pf[2]); A6_MMA(1, 1); A6_SGB(12 / NDB);
            __builtin_amdgcn_sched_barrier(0);
            A6_VLD(1, 3); A6_EXP(x1, 8, pf[3]); A6_MMA(0, 2); A6_SGB(12 / NDB);
            __builtin_amdgcn_sched_barrier(0);
            A6_MMA(1, 3);
            __builtin_amdgcn_sched_barrier(0);
#undef A6_EXP
#undef A6_VLD
#undef A6_MMA
#undef A6_SGB
            ATT_SETPRIO(0);
        }
        if (more) ATT_WRITE(t + 1);
        __syncthreads();
    }
#undef ATT_ISSUE
#undef ATT_WRITE
#if ATT_STATIC_PRIO
    __builtin_amdgcn_s_setprio(0);
#endif
    const float lt = lacc[0], inv = 1.0f / lt;
    if (COMB == 2) {
        const bf16* ip = P.TI + (tok0 + qrow) * (long)P.ldo + ocol + 4 * h; float ss = 0.f;
#pragma unroll
        for (int db = 0; db < NDB; ++db)
#pragma unroll
            for (int g = 0; g < 4; ++g) { const v2u a = *(const v2u*)(ip + 32 * db + 8 * g);
                const float c0 = bflo(a.x) - P.lam * (o[db][4 * g] * inv), c1 = bfhi(a.x) - P.lam * (o[db][4 * g + 1] * inv), c2 = bflo(a.y) - P.lam * (o[db][4 * g + 2] * inv), c3 = bfhi(a.y) - P.lam * (o[db][4 * g + 3] * inv);
                o[db][4 * g] = c0; o[db][4 * g + 1] = c1; o[db][4 * g + 2] = c2; o[db][4 * g + 3] = c3; ss += (c0 * c0 + c1 * c1) + (c2 * c2 + c3 * c3); }
        ss += shx(ss, 32, lane);
        const float rr = P.osc / sqrtf(ss * (1.0f / 128.0f) + LN_EPS);
        bf16* op = P.O + (tok0 + qrow) * (long)P.ldo + ocol + 4 * h;
#pragma unroll
        for (int db = 0; db < NDB; ++db)
#pragma unroll
            for (int g = 0; g < 4; ++g) { const f32x4 gg = *(const f32x4*)(P.gsub + 32 * db + 8 * g + 4 * h);
                v2u w; w.x = pk2(o[db][4 * g] * rr * gg[0], o[db][4 * g + 1] * rr * gg[1]); w.y = pk2(o[db][4 * g + 2] * rr * gg[2], o[db][4 * g + 3] * rr * gg[3]);
                *(v2u*)(op + 32 * db + 8 * g) = w; }
        return;
    }
    bf16* op = P.O + (tok0 + qrow) * (long)P.ldo + ocol + 4 * h;
#pragma unroll
    for (int db = 0; db < NDB; ++db)
#pragma unroll
        for (int g = 0; g < 4; ++g) { v2u w; w.x = pk2(o[db][4 * g] * inv, o[db][4 * g + 1] * inv); w.y = pk2(o[db][4 * g + 2] * inv, o[db][4 * g + 3] * inv);
            *(v2u*)(op + 32 * db + 8 * g) = w; }
}

#undef MFMA32
}

constexpr size_t MiB = 1u << 20;
constexpr size_t WS_CTL = 0, CTL_ZERO_BYTES = 1 * MiB;
constexpr size_t WS_ROPE = 1 * MiB;
constexpr size_t WS_MISC = 5 * MiB;
constexpr size_t WS_XB = 6 * MiB;
constexpr size_t WS_XB8 = 70 * MiB + 16 * MiB;
constexpr size_t WS_PB = 70 * MiB;
constexpr size_t WS_W = 118 * MiB;
constexpr size_t W_IN = WS_W, W_G8 = WS_W + 8 * MiB, W_UQ = WS_W + 12 * MiB, W_UKV = WS_W + 13 * MiB, W_BD = WS_W + 14 * MiB, W_BM = WS_W + 16 * MiB, W_OUT = WS_W + 17 * MiB,
                 W_PG = WS_W + 19 * MiB, W_PP = WS_W + 21 * MiB, W_F13 = WS_W + 22 * MiB  , W_F2E = WS_W + 134 * MiB;
constexpr size_t WS_ACT = 308 * MiB;
constexpr size_t A_DQ = WS_ACT, A_DK = WS_ACT + 64 * MiB, A_DV = WS_ACT + 128 * MiB, A_G = WS_ACT + 192 * MiB, A_C = WS_ACT + 320 * MiB;
constexpr size_t A_OA = A_C + 64 * MiB  , A_MT = A_DK, A_M = A_DV, A_CQ = A_C, A_OA2 = A_C, A_PRE = A_C;
constexpr size_t A_CQN = WS_ACT + 448 * MiB, A_CKVN = WS_ACT + 472 * MiB, A_OB = A_CQN, A_MKR = WS_ACT + 488 * MiB, A_MQ = WS_ACT + 490 * MiB, A_MKV = WS_ACT + 538 * MiB;
constexpr size_t A_H = WS_ACT;
constexpr size_t A_XG = WS_ACT, A_YG = A_XG  , A_TOK = WS_ACT + 264 * MiB, A_HG = WS_ACT + 270 * MiB  , A_PREM = WS_ACT + 512 * MiB;
constexpr size_t W_F13D = WS_ACT + 602 * MiB, W_F2D = WS_ACT + 613 * MiB;
constexpr size_t W_QKV8 = WS_W + 3 * MiB;
constexpr size_t WS_SSP = WS_ACT + 620 * MiB;
constexpr size_t WS_END = WS_ACT + 640 * MiB;
static_assert(MOE_FP8 == 1, "the workspace map assumes fp8 expert activations");
constexpr int CW_BAR = 4096, CW_MOE = 8192, CW_LN = 16384;
constexpr size_t WS_LNST = WS_W + 10 * MiB;
constexpr int CW_DUMMY_ = 0;

constexpr int RING_BYTES = 131072, MISC_OFF = RING_BYTES + 320, LDS_BYTES = 147456;
constexpr int NWAVES = 8;

#ifndef REP_ATTN_D
#define REP_ATTN_D 1
#endif
#ifndef REP_ATTN_M
#define REP_ATTN_M 1
#endif
#ifndef REP_CONV
#define REP_CONV 1
#endif
#ifndef REP_L1
#define REP_L1 1
#endif
#ifndef REP_EW
#define REP_EW 1
#endif
#ifndef REP_BAR
#define REP_BAR 1
#endif
#ifndef REP_LN
#define REP_LN 1
#endif
#ifndef REP_MOE
#define REP_MOE 1
#endif
#ifndef REP_MIX
#define REP_MIX 1
#endif
#ifndef REP_FFN
#define REP_FFN 1
#endif
#ifndef REP_P0
#define REP_P0 1
#endif
#ifndef REP_PPE
#define REP_PPE 1
#endif
#ifndef ATT_UNIT_D
#define ATT_UNIT_D attn_unit10
#endif
#ifndef ATT_UNIT_M
#define ATT_UNIT_M attn_unit10
#endif
#ifndef F8_SP2
#define F8_SP2 true
#endif
#ifndef GEMM_STAGGER
#define GEMM_STAGGER 0
#endif
#ifndef STAG_L1
#define STAG_L1 1500
#endif
#ifndef STAG_H
#define STAG_H 1500
#endif
#ifndef STAG_UP
#define STAG_UP 1000
#endif
#ifndef GEMM_ALIGN
#define GEMM_ALIGN true
#endif
#ifndef UP_ALIGN
#define UP_ALIGN true
#endif
#ifndef PROBE_D
#define PROBE_D -1
#endif
#ifndef PROBE_M
#define PROBE_M -1
#endif
#ifndef LN_FUSE
#define LN_FUSE 1
#endif
#ifndef CONV_IN_DOWN
#define CONV_IN_DOWN 1
#endif
#ifndef CONV_IN_ATTN
#define CONV_IN_ATTN 1
#endif
#ifndef PROBE_NULL_L1
#define PROBE_NULL_L1 0
#endif
#ifndef QKV_FP8
#define QKV_FP8 1
#endif
#define XB_TMO      128
#define XB_XCNT(j)  (256  + 64 * (j))
#define XB_XSUB(j)  (1280 + 64 * (j))
#define XB_XGEN(j)  (2304 + 64 * (j))
#define XB_TOP      3328
#define XB_TOPGEN   3392
#define XCD_BAR_WORDS 3456
#define XB_SPIN_CAP (1u << 18)

__device__ __forceinline__ unsigned xb_ld(unsigned* p)              { return __hip_atomic_load(p, __ATOMIC_RELAXED, __HIP_MEMORY_SCOPE_AGENT); }
__device__ __forceinline__ unsigned xb_add(unsigned* p, unsigned v) { return __hip_atomic_fetch_add(p, v, __ATOMIC_RELAXED, __HIP_MEMORY_SCOPE_AGENT); }
__device__ __forceinline__ unsigned xb_xcc_id() { return (unsigned)__builtin_amdgcn_s_getreg((3 << 11) | 20) & 0xFu; }
#define XB_SPIN(cond, bar) do { unsigned _sp = 0; while (cond) { __builtin_amdgcn_s_sleep(1); \
    if ((++_sp & 255u) == 0u) { if (xb_ld(&(bar)[XB_TMO])) break; if (_sp > XB_SPIN_CAP) { atomicAdd(&(bar)[XB_TMO], 1u); break; } } } } while (0)

struct XcdBarrier {
    unsigned* bar; unsigned x;
    volatile LAS unsigned* st;
};

__device__ __forceinline__ XcdBarrier xcd_barrier_post(unsigned* bar, volatile LAS unsigned* st, const bool t0  ) {
    XcdBarrier b; b.bar = bar; b.x = xb_xcc_id(); b.st = st;
    if (t0) (void)xb_add(&bar[XB_XCNT(b.x)], 1u);
    return b;
}
__device__ __forceinline__ void xcd_barrier_complete(unsigned* bar, unsigned x, unsigned& nloc, unsigned& nx) {
    const unsigned G = gridDim.x * gridDim.y * gridDim.z;
    unsigned sum, cnt, mine, sp = 0u;
    for (;;) {
        sum = 0u; cnt = 0u; mine = 0u;
#pragma unroll
        for (unsigned j = 0; j < 16; ++j) { const unsigned c = xb_ld(&bar[XB_XCNT(j)]); sum += c; cnt += (c > 0u) ? 1u : 0u; mine = (j == x) ? c : mine; }
        if (sum == G) break;
        __builtin_amdgcn_s_sleep(1);
        if ((++sp & 255u) == 0u) { if (xb_ld(&bar[XB_TMO])) break; if (sp > XB_SPIN_CAP) { atomicAdd(&bar[XB_TMO], 1u); break; } }
    }
    nloc = mine > 0u ? mine : 1u; nx = cnt > 0u ? cnt : 1u;
}

__device__ __forceinline__ void xcd_barrier(const XcdBarrier& b, const bool t0) {
    asm volatile("s_waitcnt vmcnt(0)" ::: "memory");
    __syncthreads();
    if (t0) {
        unsigned* bar = b.bar;
        __builtin_amdgcn_s_waitcnt(0);
        unsigned nloc = b.st[0], nx = b.st[1];
        if (nloc == 0u) { xcd_barrier_complete(bar, b.x, nloc, nx); b.st[0] = nloc; b.st[1] = nx; }
        const unsigned old = xb_add(&bar[XB_XSUB(b.x)], 1u);
        const unsigned gen = old / nloc;
        if (old + 1u == (gen + 1u) * nloc) {
            __builtin_amdgcn_fence(__ATOMIC_RELEASE, "agent");
            asm volatile("s_waitcnt vmcnt(0)" ::: "memory");
            const unsigned og = xb_add(&bar[XB_TOP], 1u);
            const unsigned tg = og / nx;
            if (og + 1u == (tg + 1u) * nx) xb_add(&bar[XB_TOPGEN], 1u);
            else XB_SPIN(xb_ld(&bar[XB_TOPGEN]) == tg, bar);
            __builtin_amdgcn_fence(__ATOMIC_ACQUIRE, "agent");
            xb_add(&bar[XB_XGEN(b.x)], 1u);
            asm volatile("s_waitcnt vmcnt(0)" ::: "memory");
        } else {
            XB_SPIN(xb_ld(&bar[XB_XGEN(b.x)]) == gen, bar);
            __builtin_amdgcn_fence(__ATOMIC_ACQUIRE, "agent");
            asm volatile("s_waitcnt vmcnt(0)" ::: "memory");
        }
    }
    __syncthreads();
}

struct Args { const void* in[31]; float* out; unsigned char* ws; int ph_lo, ph_hi, fuse; };

struct Frame {
    LAS unsigned char* lds;
    int tid, lane, wave, gw, NGW, G, vcu;
    const Args* a;
    unsigned char* ws;
};
#define FR_TID(F_) ({ unsigned m1_ = ~0u; asm volatile("" : "+s"(m1_)); (((F_).wave << 6) | (int)__builtin_amdgcn_mbcnt_hi(m1_, __builtin_amdgcn_mbcnt_lo(m1_, 0u))); })
#define INF(i) ((const float*)F.a->in[i])
#define WSP(T_, off) ((T_*)(F.ws + (off)))

__device__ __forceinline__ void conv_w(const Frame& F, const float* src, int ldn, int K, int ncols, int nbatch, size_t sbs, bf16* dst, int rmul, int roff, size_t dbs, const float* kscale) {
    LAS float* scr = (LAS float*)(F.lds + F.wave * 16384);
    const int lane = F.lane, nblk = ncols / 32, kblk = K / 64, per = nblk * kblk, total = per * nbatch;
    for (int it = F.gw; it < total; it += F.NGW) {
        const int bt = it / per, r = it % per, kb = r / nblk, nb = r % nblk, k0 = kb * 64, n0 = nb * 32;
        const float* W = src + (size_t)bt * sbs; bf16* WT = dst + (size_t)bt * dbs;
        float ld_[32];
#pragma unroll
        for (int i = 0; i < 32; ++i) ld_[i] = __builtin_nontemporal_load(W + (size_t)(k0 + 2 * i + (lane >> 5)) * ldn + n0 + (lane & 31));
#pragma unroll
        for (int i = 0; i < 32; ++i) scr[(2 * i + (lane >> 5)) * 33 + (lane & 31)] = ld_[i];
        LDS_WAIT(); asm volatile("" ::: "memory");
        const int c = lane & 7;
        float ks[8];
#pragma unroll
        for (int i = 0; i < 8; ++i) ks[i] = kscale ? kscale[k0 + 8 * c + i] : 1.0f;
#pragma unroll
        for (int j = 0; j < 4; ++j) { const int n = (lane >> 3) + 8 * j; const LAS float* s = scr + (8 * c) * 33 + n;
            v4u o; o.x = pk2(s[0 * 33] * ks[0], s[1 * 33] * ks[1]); o.y = pk2(s[2 * 33] * ks[2], s[3 * 33] * ks[3]); o.z = pk2(s[4 * 33] * ks[4], s[5 * 33] * ks[5]); o.w = pk2(s[6 * 33] * ks[6], s[7 * 33] * ks[7]);
            *(v4u*)(WT + (size_t)(rmul * (n0 + n) + roff) * K + k0 + 8 * c) = o; }
        LDS_WAIT(); asm volatile("" ::: "memory");
    }
}
__device__ __forceinline__ void conv_w8(const Frame& F, const float* src, int ldn, int K, int ncols, int nbatch, size_t sbs, unsigned char* dst, int rmul, int roff, size_t dbs, float scale) {
    LAS float* scr = (LAS float*)(F.lds + F.wave * 16384);
    const int lane = F.lane, nblk = ncols / 32, kblk = K / 64, per = nblk * kblk, total = per * nbatch;
    for (int it = F.gw; it < total; it += F.NGW) {
        const int bt = it / per, r = it % per, kb = r / nblk, nb = r % nblk, k0 = kb * 64, n0 = nb * 32;
        const float* W = src + (size_t)bt * sbs; unsigned char* WT = dst + (size_t)bt * dbs;
        float ld_[32];
#pragma unroll
        for (int i = 0; i < 32; ++i) ld_[i] = __builtin_nontemporal_load(W + (size_t)(k0 + 2 * i + (lane >> 5)) * ldn + n0 + (lane & 31));
#pragma unroll
        for (int i = 0; i < 32; ++i) scr[(2 * i + (lane >> 5)) * 33 + (lane & 31)] = ld_[i];
        LDS_WAIT(); asm volatile("" ::: "memory");
        const int c = lane & 7;
#pragma unroll
        for (int j = 0; j < 4; ++j) { const int n = (lane >> 3) + 8 * j; const LAS float* s = scr + (8 * c) * 33 + n;
            int lo = __builtin_amdgcn_cvt_pk_fp8_f32(s[0 * 33] * scale, s[1 * 33] * scale, 0, false); lo = __builtin_amdgcn_cvt_pk_fp8_f32(s[2 * 33] * scale, s[3 * 33] * scale, lo, true);
            int hi = __builtin_amdgcn_cvt_pk_fp8_f32(s[4 * 33] * scale, s[5 * 33] * scale, 0, false); hi = __builtin_amdgcn_cvt_pk_fp8_f32(s[6 * 33] * scale, s[7 * 33] * scale, hi, true);
            v2u o; o.x = (unsigned)lo; o.y = (unsigned)hi;
            *(v2u*)(WT + (size_t)(rmul * (n0 + n) + roff) * K + k0 + 8 * c) = o; }
        LDS_WAIT(); asm volatile("" ::: "memory");
    }
}
__device__ __forceinline__ void phase_convert(const Frame& F, int L, const int which = 0) {
    const int j = L >> 1;
    if (which != 2) {
    const float* win = INF(4) + (size_t)L * D * IN_COLS;
#if QKV_FP8
    conv_w8(F, win, IN_COLS, D, 3072, 1, 0, WSP(unsigned char, W_QKV8), 1, 0, 0, 32.0f);
    conv_w8(F, win + 3744, IN_COLS, D, 2048, 1, 0, WSP(unsigned char, W_QKV8), 1, 3072, 0, 32.0f);
    conv_w(F, win + 3072, IN_COLS, D, 672, 1, 0, WSP(bf16, W_IN), 1, 0, 0, nullptr);
    { bf16* padr = WSP(bf16, W_IN) + (size_t)672 * D;
#else
    conv_w(F, win, IN_COLS, D, 3072, 1, 0, WSP(bf16, W_IN), 1, 0, 0, nullptr);
    conv_w8(F, win + 3744, IN_COLS, D, 2048, 1, 0, WSP(unsigned char, W_G8), 1, 0, 0, 32.0f);
    conv_w(F, win + 3072, IN_COLS, D, 672, 1, 0, WSP(bf16, W_IN), 1, 3072, 0, nullptr);
    { bf16* padr = WSP(bf16, W_IN) + (size_t)3744 * D;
#endif
      unsigned z_ = 0u; asm volatile("" : "+v"(z_));
      for (int i = F.gw * 64 + F.lane; i < (NIN - IN_COLS) * D / 8; i += F.NGW * 64) ((v4u*)padr)[i] = (v4u){z_, z_, z_, z_}; }
    conv_w(F, INF(12) + (size_t)L * QR * 768, 768, QR, 768, 1, 0, WSP(bf16, W_UQ), 1, 0, 0, INF(11) + L * QR);
    conv_w(F, INF(14) + (size_t)L * KVR * 1024, 1024, KVR, 1024, 1, 0, WSP(bf16, W_UKV), 1, 0, 0, INF(13) + L * KVR);
    conv_w(F, INF(15) + (size_t)L * D * D, D, D, D, 1, 0, WSP(bf16, W_BD), 1, 0, 0, nullptr);
    conv_w(F, INF(16) + (size_t)L * 512 * D, D, 512, D, 1, 0, WSP(bf16, W_BM), 1, 0, 0, nullptr);
    conv_w(F, INF(17) + (size_t)L * D * D, D, D, D, 1, 0, WSP(bf16, W_OUT), 1, 0, 0, nullptr);
    conv_w8(F, INF(27) + (size_t)L * D * D, D, D, D, 1, 0, WSP(unsigned char, W_PG), 1, 0, 0, 32.0f);
    conv_w(F, INF(28) + (size_t)L * PLE * D, D, PLE, D, 1, 0, WSP(bf16, W_PP), 1, 0, 0, nullptr);
    }
    if ((L & 1) == 0) { if (which != 2) {
        conv_w(F, INF(20) + (size_t)j * D * DENSE_FF, DENSE_FF, D, DENSE_FF, 1, 0, WSP(bf16, W_F13D), 2, 0, 0, nullptr);
        conv_w(F, INF(21) + (size_t)j * D * DENSE_FF, DENSE_FF, D, DENSE_FF, 1, 0, WSP(bf16, W_F13D), 2, 1, 0, nullptr);
        conv_w(F, INF(22) + (size_t)j * DENSE_FF * D, D, DENSE_FF, D, 1, 0, WSP(bf16, W_F2D), 1, 0, 0, nullptr); }
    } else if (which != 1) {
        const size_t eo = (size_t)j * NEXP * D * EXPERT_FF;
#if MOE_FP8
        conv_w8(F, INF(24) + eo, EXPERT_FF, D, EXPERT_FF, NEXP, (size_t)D * EXPERT_FF, WSP(unsigned char, W_F13), 2, 0, (size_t)2 * EXPERT_FF * D, 32.0f);
        conv_w8(F, INF(25) + eo, EXPERT_FF, D, EXPERT_FF, NEXP, (size_t)D * EXPERT_FF, WSP(unsigned char, W_F13), 2, 1, (size_t)2 * EXPERT_FF * D, 32.0f);
        conv_w8(F, INF(26) + eo, D, EXPERT_FF, D, NEXP, (size_t)EXPERT_FF * D, WSP(unsigned char, W_F2E), 1, 0, (size_t)D * EXPERT_FF, 128.0f);
#else
        conv_w(F, INF(24) + eo, EXPERT_FF, D, EXPERT_FF, NEXP, (size_t)D * EXPERT_FF, WSP(bf16, W_F13), 2, 0, (size_t)2 * EXPERT_FF * D, nullptr);
        conv_w(F, INF(25) + eo, EXPERT_FF, D, EXPERT_FF, NEXP, (size_t)D * EXPERT_FF, WSP(bf16, W_F13), 2, 1, (size_t)2 * EXPERT_FF * D, nullptr);
        conv_w(F, INF(26) + eo, D, EXPERT_FF, D, NEXP, (size_t)EXPERT_FF * D, WSP(bf16, W_F2E), 1, 0, (size_t)D * EXPERT_FF, nullptr);
#endif
    }
    if (which != 2) { const f32x4* ps = (const f32x4*)(INF(1) + (size_t)L * T * PLE); v2u* pd = WSP(v2u, WS_PB);
      for (int i = F.gw * 64 + F.lane; i < T * PLE / 4; i += F.NGW * 64) { const f32x4 v = __builtin_nontemporal_load(ps + i); v2u o; o.x = pk2(v[0], v[1]); o.y = pk2(v[2], v[3]); pd[i] = o; } }
}

__device__ __forceinline__ void phase_prologue(const Frame& F) {
    const int* pos = (const int*)F.a->in[2];
    for (int m = F.gw; m < T; m += F.NGW) {
        const f32x4* xr = (const f32x4*)(INF(0) + (size_t)m * D) + F.lane; v2u* br = WSP(v2u, WS_XB) + (size_t)m * (D / 4) + F.lane;
#pragma unroll
        for (int j = 0; j < 4; ++j) { const f32x4 v = __builtin_nontemporal_load(xr + 64 * j); v2u o; o.x = pk2(v[0], v[1]); o.y = pk2(v[2], v[3]); br[64 * j] = o;
            int w8 = __builtin_amdgcn_cvt_pk_fp8_f32(v[0], v[1], 0, false); w8 = __builtin_amdgcn_cvt_pk_fp8_f32(v[2], v[3], w8, true); (WSP(int, WS_XB8) + (size_t)m * (D / 4) + F.lane)[64 * j] = w8; }
    }
    { float* rope = WSP(float, WS_ROPE);
      for (int idx = F.gw * 64 + F.lane; idx < T * 16; idx += F.NGW * 64) {
          const int t = idx >> 4, j = idx & 15;
          double inv = 1.0; for (int i = 0; i < j; ++i) inv *= 0.5623413251903491;
          const double ang = (double)pos[t] * inv;
          const double nq = __builtin_rint(ang * 0.6366197723675814);
          double y = __builtin_fma(-nq, 1.5707963267948966, ang); y = __builtin_fma(-nq, 6.123233995736766e-17, y);
          const double y2 = y * y;
          double sp = 1.0 / 6227020800.0; sp = sp * y2 - 1.0 / 39916800.0; sp = sp * y2 + 1.0 / 362880.0; sp = sp * y2 - 1.0 / 5040.0; sp = sp * y2 + 1.0 / 120.0; sp = sp * y2 - 1.0 / 6.0;
          const double sn = y + y * y2 * sp;
          double cp = -1.0 / 87178291200.0; cp = cp * y2 + 1.0 / 479001600.0; cp = cp * y2 - 1.0 / 3628800.0; cp = cp * y2 + 1.0 / 40320.0; cp = cp * y2 - 1.0 / 720.0; cp = cp * y2 + 1.0 / 24.0; cp = cp * y2 - 0.5;
          const double cs = 1.0 + y2 * cp;
          const int q = ((int)nq) & 3;
          const double c = (q == 0) ? cs : (q == 1) ? -sn : (q == 2) ? -cs : sn;
          const double s = (q == 0) ? sn : (q == 1) ? cs : (q == 2) ? -sn : -cs;
          rope[2 * idx] = (float)c; rope[2 * idx + 1] = (float)s;
      } }
    { int* bm = WSP(int, WS_MISC);
      for (int blk = F.gw; blk < T / 64; blk += F.NGW) { int v = pos[blk * 64 + F.lane];
#pragma unroll
          for (int o = 1; o < 64; o <<= 1) { const int t2 = shxi(v, o, F.lane); v = t2 > v ? t2 : v; }
          if (F.lane == 0) bm[blk] = v; } }
    { float* lut = WSP(float, WS_MISC + 4096); const float* tab = INF(3);
      for (int idx = F.gw * 64 + F.lane; idx < 8 * 132; idx += F.NGW * 64) { const int hh = idx / 132, n = idx % 132;
          int bk = n;
          if (n >= 16) bk = 16 + (n >= 19) + (n >= 21) + (n >= 24) + (n >= 27) + (n >= 31) + (n >= 35) + (n >= 40) + (n >= 46) + (n >= 52) + (n >= 59) + (n >= 67) + (n >= 77) + (n >= 87) + (n >= 99) + (n >= 113);
          lut[idx] = tab[bk * 8 + hh] * LOG2E; } }
    for (int rep = 0; rep < REP_CONV; ++rep) phase_convert(F, 0);
}

__device__ __forceinline__ void phase_rms_rope(const Frame& F) {
    const bf16* CQ = WSP(bf16, A_CQ); const float* rope = WSP(float, WS_ROPE);
    bf16* CQN = WSP(bf16, A_CQN); bf16* CKVN = WSP(bf16, A_CKVN); bf16* MKR = WSP(bf16, A_MKR);
    const int l = F.lane;
    for (int m0 = F.gw; m0 < T; m0 += 4 * F.NGW) {
        unsigned q0[4], q1[4], q2[4]; v2u kvp[4]; unsigned short k1[4], k2[4]; float rc[4], rs[4];
#pragma unroll
        for (int q = 0; q < 4; ++q) { const int m = (m0 + q * F.NGW < T) ? m0 + q * F.NGW : m0; const bf16* c = CQ + (size_t)m * 768;
            q0[q] = *(const unsigned*)(c + 6 * l); q1[q] = *(const unsigned*)(c + 6 * l + 2); q2[q] = *(const unsigned*)(c + 6 * l + 4);
            kvp[q] = *(const v2u*)(c + QR + 4 * l);
            k1[q] = 0; k2[q] = 0; rc[q] = 0.f; rs[q] = 0.f;
            if (l < 16) { k1[q] = c[QR + KVR + l]; k2[q] = c[QR + KVR + 16 + l]; rc[q] = rope[(size_t)m * 32 + 2 * l]; rs[q] = rope[(size_t)m * 32 + 2 * l + 1]; } }
#pragma unroll
        for (int q = 0; q < 4; ++q) { const int m = m0 + q * F.NGW; if (m >= T) break;
            const f32x2 a0 = {bflo(q0[q]), bfhi(q0[q])}, a1 = {bflo(q1[q]), bfhi(q1[q])}, a2 = {bflo(q2[q]), bfhi(q2[q])};
            const f32x4 kv = {bflo(kvp[q].x), bfhi(kvp[q].x), bflo(kvp[q].y), bfhi(kvp[q].y)};
            const float x1 = bflo((unsigned)k1[q]), x2 = bflo((unsigned)k2[q]);
            const float sq = wave_sum(l, a0[0] * a0[0] + a0[1] * a0[1] + a1[0] * a1[0] + a1[1] * a1[1] + a2[0] * a2[0] + a2[1] * a2[1]);
            const float sk = wave_sum(l, kv[0] * kv[0] + kv[1] * kv[1] + kv[2] * kv[2] + kv[3] * kv[3]);
            const float rq = 1.0f / sqrtf(sq * (1.0f / QR) + LN_EPS), rk = 1.0f / sqrtf(sk * (1.0f / KVR) + LN_EPS);
            unsigned* qo = (unsigned*)(CQN + (size_t)m * QR + 6 * l);
            qo[0] = pk2(a0[0] * rq, a0[1] * rq); qo[1] = pk2(a1[0] * rq, a1[1] * rq); qo[2] = pk2(a2[0] * rq, a2[1] * rq);
            v2u ko; ko.x = pk2(kv[0] * rk, kv[1] * rk); ko.y = pk2(kv[2] * rk, kv[3] * rk);
            *(v2u*)(CKVN + (size_t)m * KVR + 4 * l) = ko;
            if (l < 16) { const float o1 = x1 * rc[q] - x2 * rs[q], o2 = x1 * rs[q] + x2 * rc[q]; const unsigned w = pk2(o1, o2);
                MKR[(size_t)m * 32 + l] = (bf16)(w & 0xffffu); MKR[(size_t)m * 32 + 16 + l] = (bf16)(w >> 16); }
        }
    }
}

template <bool ROUTE, bool GATHER>
__device__ __forceinline__ void phase_ln(const Frame& F, const bf16* PRE, const float* gam, const float* bet, const float* wr, int moe_j, const bool write_f32) {
    const int l = F.lane;
    const bf16* YG = WSP(bf16, A_YG); int* TOKE = WSP(int, A_TOK); float* TOKG = WSP(float, A_TOK + 1 * MiB); const int* TOKR = WSP(int, A_TOK + 2 * MiB);
    int* TOKS = WSP(int, A_TOK + 3 * MiB); int* CNTW = WSP(int, A_TOK + 4 * MiB);
    int rc0 = 0, rc1 = 0, rc2 = 0, rc3 = 0, rc4 = 0, rc5 = 0, rc6 = 0, rc7 = 0; (void)moe_j;
    f32x4 gv[4], bv[4];
#pragma unroll
    for (int j = 0; j < 4; ++j) { const int cj = 8 * l + 512 * (j >> 1) + 4 * (j & 1); gv[j] = *(const f32x4*)(gam + cj); bv[j] = *(const f32x4*)(bet + cj); }
    f32x4 rw0[4][4], rw1[4][4];
    if (ROUTE) {
#pragma unroll
        for (int j = 0; j < 4; ++j)
#pragma unroll
            for (int c = 0; c < 4; ++c) { const float* w = wr + (size_t)(8 * l + 512 * (j >> 1) + 4 * (j & 1) + c) * 8; rw0[j][c] = *(const f32x4*)w; rw1[j][c] = *(const f32x4*)(w + 4); }
    }
    int pr0[2] = {0, 0}, pr1[2] = {0, 0}; float pg0[2] = {0.f, 0.f}, pg1[2] = {0.f, 0.f};
    if (GATHER) {
#pragma unroll
        for (int q = 0; q < 2; ++q) { const int m = (F.gw + q * F.NGW < T) ? F.gw + q * F.NGW : F.gw; pr0[q] = TOKR[2 * m]; pr1[q] = TOKR[2 * m + 1]; pg0[q] = TOKG[2 * m]; pg1[q] = TOKG[2 * m + 1]; } }
    for (int m0 = F.gw; m0 < T; m0 += 2 * F.NGW) {
        v4u raw[2][2]; v4u y0[2][2], y1[2][2]; float g0[2] = {0.f, 0.f}, g1[2] = {0.f, 0.f};
#pragma unroll
        for (int q = 0; q < 2; ++q) { const int m = (m0 + q * F.NGW < T) ? m0 + q * F.NGW : m0;     const v4u* xr = (const v4u*)(PRE + (size_t)m * D) + l;
#pragma unroll
            for (int j = 0; j < 2; ++j) raw[q][j] = xr[64 * j];
            if (GATHER) { const int r0 = pr0[q], r1 = pr1[q]; g0[q] = pg0[q]; g1[q] = pg1[q];
                const v4u* p0 = (const v4u*)(YG + (size_t)r0 * D) + l; const v4u* p1 = (const v4u*)(YG + (size_t)r1 * D) + l;
#pragma unroll
                for (int j = 0; j < 2; ++j) { y0[q][j] = p0[64 * j]; y1[q][j] = p1[64 * j]; } } }
        if (GATHER && m0 + 2 * F.NGW < T) {
#pragma unroll
            for (int q = 0; q < 2; ++q) { const int mb = m0 + 2 * F.NGW, m = (mb + q * F.NGW < T) ? mb + q * F.NGW : mb; pr0[q] = TOKR[2 * m]; pr1[q] = TOKR[2 * m + 1]; pg0[q] = TOKG[2 * m]; pg1[q] = TOKG[2 * m + 1]; } }
#pragma unroll
        for (int q = 0; q < 2; ++q) { const int m = m0 + q * F.NGW; if (m >= T) break;
            f32x4 v[4]; float s = 0.f;
#pragma unroll
            for (int j = 0; j < 4; ++j) { const v4u a4 = raw[q][j >> 1]; v2u a; a.x = (j & 1) ? a4.z : a4.x; a.y = (j & 1) ? a4.w : a4.y; v[j][0] = bflo(a.x); v[j][1] = bfhi(a.x); v[j][2] = bflo(a.y); v[j][3] = bfhi(a.y); }
            if (GATHER) {
#pragma unroll
                for (int j = 0; j < 4; ++j) { const v4u a4 = y0[q][j >> 1], b4 = y1[q][j >> 1]; v2u a, b; a.x = (j & 1) ? a4.z : a4.x; a.y = (j & 1) ? a4.w : a4.y; b.x = (j & 1) ? b4.z : b4.x; b.y = (j & 1) ? b4.w : b4.y;
                    v[j][0] += g0[q] * bflo(a.x) + g1[q] * bflo(b.x); v[j][1] += g0[q] * bfhi(a.x) + g1[q] * bfhi(b.x); v[j][2] += g0[q] * bflo(a.y) + g1[q] * bflo(b.y); v[j][3] += g0[q] * bfhi(a.y) + g1[q] * bfhi(b.y); } }
#pragma unroll
            for (int j = 0; j < 4; ++j) s += (v[j][0] + v[j][1]) + (v[j][2] + v[j][3]);
            const float mean = wave_sum(l, s) * (1.f / D); float s2 = 0.f;
#pragma unroll
            for (int j = 0; j < 4; ++j) { v[j] = v[j] - mean; s2 += (v[j][0] * v[j][0] + v[j][1] * v[j][1]) + (v[j][2] * v[j][2] + v[j][3] * v[j][3]); }
            const float rstd = 1.f / sqrtf(wave_sum(l, s2) * (1.f / D) + LN_EPS);
            f32x4* orow = (f32x4*)(F.a->out + (size_t)m * D) + 2 * l; v4u* br = WSP(v4u, WS_XB) + (size_t)m * (D / 8) + l; v2u* br8 = WSP(v2u, WS_XB8) + (size_t)m * (D / 8) + l;
#pragma unroll
            for (int j = 0; j < 4; ++j) v[j] = v[j] * rstd * gv[j] + bv[j];
            if (write_f32) {
#pragma unroll
                for (int j = 0; j < 4; ++j) orow[128 * (j >> 1) + (j & 1)] = v[j];
            } else {
#pragma unroll
                for (int j2 = 0; j2 < 2; ++j2) { const f32x4 va = v[2 * j2], vb = v[2 * j2 + 1];
                    v4u o; o.x = pk2(va[0], va[1]); o.y = pk2(va[2], va[3]); o.z = pk2(vb[0], vb[1]); o.w = pk2(vb[2], vb[3]); br[64 * j2] = o;
                    int wa = __builtin_amdgcn_cvt_pk_fp8_f32(va[0], va[1], 0, false); wa = __builtin_amdgcn_cvt_pk_fp8_f32(va[2], va[3], wa, true);
                    int wb = __builtin_amdgcn_cvt_pk_fp8_f32(vb[0], vb[1], 0, false); wb = __builtin_amdgcn_cvt_pk_fp8_f32(vb[2], vb[3], wb, true);
                    v2u o8; o8.x = (unsigned)wa; o8.y = (unsigned)wb; br8[64 * j2] = o8; }
            }
            if (ROUTE) {
                float lg[8];
#pragma unroll
                for (int e = 0; e < 8; ++e) lg[e] = 0.f;
#pragma unroll
                for (int j = 0; j < 4; ++j)
#pragma unroll
                    for (int c = 0; c < 4; ++c) { const f32x4 w0 = rw0[j][c], w1 = rw1[j][c]; const float xv = v[j][c];
                        lg[0] += xv * w0[0]; lg[1] += xv * w0[1]; lg[2] += xv * w0[2]; lg[3] += xv * w0[3]; lg[4] += xv * w1[0]; lg[5] += xv * w1[1]; lg[6] += xv * w1[2]; lg[7] += xv * w1[3]; }
#pragma unroll
                for (int e = 0; e < 8; ++e) lg[e] = wave_sum(l, lg[e]);
                int e0 = 0; float v0 = lg[0];
#pragma unroll
                for (int e = 1; e < 8; ++e) if (lg[e] > v0) { v0 = lg[e]; e0 = e; }
                int e1 = -1; float v1 = -INFINITY;
#pragma unroll
                for (int e = 0; e < 8; ++e) if (e != e0 && lg[e] > v1) { v1 = lg[e]; e1 = e; }
                const float gg1 = 1.0f / (1.0f + expf(v0 - v1)), gg0 = 1.0f - gg1;
                const int s0 = (e0 == 0) ? rc0 : (e0 == 1) ? rc1 : (e0 == 2) ? rc2 : (e0 == 3) ? rc3 : (e0 == 4) ? rc4 : (e0 == 5) ? rc5 : (e0 == 6) ? rc6 : rc7;
                const int s1 = (e1 == 0) ? rc0 : (e1 == 1) ? rc1 : (e1 == 2) ? rc2 : (e1 == 3) ? rc3 : (e1 == 4) ? rc4 : (e1 == 5) ? rc5 : (e1 == 6) ? rc6 : rc7;
                rc0 += (e0 == 0) + (e1 == 0); rc1 += (e0 == 1) + (e1 == 1); rc2 += (e0 == 2) + (e1 == 2); rc3 += (e0 == 3) + (e1 == 3);
                rc4 += (e0 == 4) + (e1 == 4); rc5 += (e0 == 5) + (e1 == 5); rc6 += (e0 == 6) + (e1 == 6); rc7 += (e0 == 7) + (e1 == 7);
                if (l == 0) { TOKE[2 * m] = e0; TOKE[2 * m + 1] = e1; TOKG[2 * m] = gg0; TOKG[2 * m + 1] = gg1; TOKS[2 * m] = s0; TOKS[2 * m + 1] = s1; }
            }
        }
    }
    if (ROUTE && (FR_TID(F) & 63) == 0) { int* cw = CNTW + (size_t)F.gw * 8; cw[0] = rc0; cw[1] = rc1; cw[2] = rc2; cw[3] = rc3; cw[4] = rc4; cw[5] = rc5; cw[6] = rc6; cw[7] = rc7; }
}

struct MoeTiles { int pend[8]; int total; };
__device__ __forceinline__ void moe_tiles(const Frame& F, int moe_j, MoeTiles& mt) {
    const int* tot = WSP(int, A_TOK + 5 * MiB); int acc = 0; (void)moe_j;
#pragma unroll
    for (int e = 0; e < 8; ++e) { const int c = tot[e]; acc += (c + 255) >> 8; mt.pend[e] = acc; }
    mt.total = acc;
}
__device__ __forceinline__ void phase_scatter(const Frame& F, int moe_j) {
    (void)moe_j;
    const int* CNTW = WSP(int, A_TOK + 4 * MiB); const int* TOKS = WSP(int, A_TOK + 3 * MiB); int* TOT = WSP(int, A_TOK + 5 * MiB);
    const int* TOKE = WSP(int, A_TOK); int* TOKR = WSP(int, A_TOK + 2 * MiB);
    const v4u* XB = WSP(v4u, WS_XB); v4u* XG = WSP(v4u, A_XG); const int l = F.lane;
    LAS int* red = (LAS int*)F.lds;
    int tot[8], pre[8];
#pragma unroll
    for (int e = 0; e < 8; ++e) { tot[e] = 0; pre[e] = 0; }
    const int wg0 = F.vcu * NWAVES;
    for (int w = F.tid; w < F.NGW; w += NWAVES * 64) { const v4u a = *(const v4u*)(CNTW + (size_t)w * 8), b = *(const v4u*)(CNTW + (size_t)w * 8 + 4); const int below = (w < wg0) ? 1 : 0;
        tot[0] += a.x; tot[1] += a.y; tot[2] += a.z; tot[3] += a.w; tot[4] += b.x; tot[5] += b.y; tot[6] += b.z; tot[7] += b.w;
        pre[0] += below * (int)a.x; pre[1] += below * (int)a.y; pre[2] += below * (int)a.z; pre[3] += below * (int)a.w; pre[4] += below * (int)b.x; pre[5] += below * (int)b.y; pre[6] += below * (int)b.z; pre[7] += below * (int)b.w; }
#pragma unroll
    for (int e = 0; e < 8; ++e) {
#pragma unroll
        for (int o = 1; o < 64; o <<= 1) { tot[e] += shxi(tot[e], o, l); pre[e] += shxi(pre[e], o, l); } }
    if (l == 0) {
#pragma unroll
        for (int e = 0; e < 8; ++e) { red[F.wave * 16 + e] = tot[e]; red[F.wave * 16 + 8 + e] = pre[e]; } }
    __syncthreads();
    int base[8]; int acc = 0;
#pragma unroll
    for (int e = 0; e < 8; ++e) { int t = 0, p = 0;
#pragma unroll
        for (int w = 0; w < NWAVES; ++w) { t += red[w * 16 + e]; p += red[w * 16 + 8 + e]; }
        int mine = 0;
#pragma unroll
        for (int w = 0; w < NWAVES; ++w) { const int c = CNTW[(size_t)(wg0 + w) * 8 + e]; mine += (w < F.wave) ? c : 0; }
        base[e] = acc * 256 + p + mine; acc += (t + 255) >> 8;
        if (F.vcu == 0 && F.tid == 0) TOT[e] = t; }
    __syncthreads();
    static_assert(MOE_FP8 == 1, "scatter copies the fp8 rows");
    const v4u* X8 = WSP(v4u, WS_XB8);
    for (int m0 = F.gw; m0 < T; m0 += 4 * F.NGW) {
        int e_[4][2], s_[4][2]; v4u row_[4];
#pragma unroll
        for (int q = 0; q < 4; ++q) { const int m = (m0 + q * F.NGW < T) ? m0 + q * F.NGW : m0;
            e_[q][0] = TOKE[2 * m]; e_[q][1] = TOKE[2 * m + 1]; s_[q][0] = TOKS[2 * m]; s_[q][1] = TOKS[2 * m + 1]; row_[q] = X8[(size_t)m * 64 + l]; }
#pragma unroll
        for (int q = 0; q < 4; ++q) { const int m = m0 + q * F.NGW; if (m >= T) break;
            int rows[2];
#pragma unroll
            for (int k = 0; k < 2; ++k) { const int e = e_[q][k];
                const int bs = (e == 0) ? base[0] : (e == 1) ? base[1] : (e == 2) ? base[2] : (e == 3) ? base[3] : (e == 4) ? base[4] : (e == 5) ? base[5] : (e == 6) ? base[6] : base[7];
                rows[k] = bs + s_[q][k]; }
            ((v4u*)XG)[(size_t)rows[0] * 64 + l] = row_[q]; ((v4u*)XG)[(size_t)rows[1] * 64 + l] = row_[q];
            if (l == 0) { TOKR[2 * m] = rows[0]; TOKR[2 * m + 1] = rows[1]; } }
    }
}

template <int VAR>
__device__ __forceinline__ void phase_attn_diff(const Frame& F, int L) {
    const float lam_init = 0.8f - 0.6f * expf(-0.3f * (float)L);
    const int l = FR_TID(F) & 63;
    const float d1 = wave_sum(l, INF(6)[L * 64 + l] * INF(7)[L * 64 + l]), d2 = wave_sum(l, INF(8)[L * 64 + l] * INF(9)[L * 64 + l]);
    att::AttnP P; P.Q = WSP(bf16, A_DQ); P.ldq = 1024; P.K1 = WSP(bf16, A_DK); P.ldk1 = 1024; P.K2 = P.K1; P.ldk2 = 1024; P.V = WSP(bf16, A_DV); P.ldv = 1024; P.ldo = 1024;
    P.pos = (const int*)F.a->in[2]; P.blkmax = WSP(int, WS_MISC); P.lut = WSP(float, WS_MISC + 4096);
    P.TI = WSP(bf16, A_OA2); P.lam = expf(d1) - expf(d2) + lam_init; P.osc = 1.0f - lam_init; P.gsub = INF(10) + L * 128;
    for (int p = F.vcu; p < BATCH * 8 * 8; p += F.G) {
        const int bh = p >> 3, i = p & 7, b = bh >> 3, hh = bh & 7;
#pragma unroll 1
        for (int s = 0; s < 2; ++s) { const int qt = s ? i : 15 - i;
            P.O = WSP(bf16, A_OA2); att::ATT_UNIT_D<64, 64, 128, true, 1, VAR>(P, b, qt, (2 * hh) * 64, (2 * hh) * 64, hh * 128, hh * 128, hh, F.lds, FR_TID(F));
            P.O = WSP(bf16, A_OA);  att::ATT_UNIT_D<64, 64, 128, true, 2, VAR>(P, b, qt, (2 * hh + 1) * 64, (2 * hh + 1) * 64, hh * 128, hh * 128, hh, F.lds, FR_TID(F)); }
    }
}
template <int VAR>
__device__ __forceinline__ void phase_attn_mla(const Frame& F) {
    att::AttnP P; P.Q = WSP(bf16, A_MQ); P.ldq = 768; P.K1 = WSP(bf16, A_MKV); P.ldk1 = 1024; P.K2 = WSP(bf16, A_MKR); P.ldk2 = 32; P.V = WSP(bf16, A_MKV); P.ldv = 1024; P.O = WSP(bf16, A_OB); P.ldo = 512;
    P.pos = (const int*)F.a->in[2]; P.blkmax = WSP(int, WS_MISC); P.lut = WSP(float, WS_MISC + 4096);
    for (int p = F.vcu; p < BATCH * 8 * 8; p += F.G) {
        const int bh = p >> 3, i = p & 7, b = bh >> 3, hh = bh & 7;
        att::ATT_UNIT_M<96, 64, 64, false, 0, VAR>(P, b, 15 - i, hh * 96, hh * 128, hh * 128 + 64, hh * 64, 0, F.lds, FR_TID(F));
        att::ATT_UNIT_M<96, 64, 64, false, 0, VAR>(P, b, i, hh * 96, hh * 128, hh * 128 + 64, hh * 64, 0, F.lds, FR_TID(F));
    }
}

constexpr int NPH_DENSE = 9, NPH_MOE = 8 + 2 * MOE_NCHUNK, NPH_TOTAL = 1 + 2 * NPH_DENSE + 2 * NPH_MOE;
#define GEMM_CALL(EPI, SCHED, gm, S_, E_) pg8::gemm_phase<EPI, SCHED, true, true>(F.lds, gm, S_, E_, MY_TID())

__global__ void __launch_bounds__(NWAVES * 64, 2) mega_fwd(Args args) {
    extern __shared__ __attribute__((aligned(16))) unsigned char lds_raw[];
    Frame F;
    F.lds = (LAS unsigned char*)lds_raw; F.a = &args; F.ws = args.ws;
    const int wave_s = __builtin_amdgcn_readfirstlane((int)threadIdx.x >> 6);
#define MY_TID() ({ unsigned m1_ = ~0u; asm volatile("" : "+s"(m1_)); ((wave_s << 6) | (int)__builtin_amdgcn_mbcnt_hi(m1_, __builtin_amdgcn_mbcnt_lo(m1_, 0u))); })
    F.tid = MY_TID(); F.lane = F.tid & 63; F.wave = wave_s;
    F.G = gridDim.x; { const int bx = blockIdx.x; F.vcu = (F.G % 8 == 0) ? (bx % 8) * (F.G / 8) + bx / 8 : bx; }
    F.gw = F.vcu * NWAVES + F.wave; F.NGW = F.G * NWAVES;
    volatile LAS unsigned* MISC = (volatile LAS unsigned*)(F.lds + MISC_OFF);
    for (int u = F.tid; u < (LDS_BYTES - RING_BYTES) / 4; u += NWAVES * 64) ((LAS unsigned*)(F.lds + RING_BYTES))[u] = 0u;
    __syncthreads();
    const int lo = args.ph_lo, hi = args.ph_hi; constexpr bool fuse_ln = (LN_FUSE != 0);
    XcdBarrier bar; bar.bar = WSP(unsigned, WS_CTL) + CW_BAR; bar.x = 0; bar.st = nullptr;
    if (hi - lo > 1) bar = xcd_barrier_post(WSP(unsigned, WS_CTL) + CW_BAR, MISC + 8, F.tid == 0);
    int pc = 0;
#define PH_BEGIN if (pc >= lo && pc < hi) { { int t_ = MY_TID(); asm volatile("" : "+v"(t_)); F.tid = t_; F.lane = t_ & 63; F.wave = wave_s; F.gw = F.vcu * NWAVES + F.wave; }
#define PH_END if (pc + 1 < hi) { for (int rb = 0; rb < REP_BAR; ++rb) xcd_barrier(bar, MY_TID() == 0); } } ++pc;
    const int bx = (int)blockIdx.x;
    const float ALPHA = 1.6817928305074290f;

    PH_BEGIN for (int rep = 0; rep < REP_P0; ++rep) phase_prologue(F); PH_END

    for (int L = 0; L < DEPTH; ++L) {
        const int mj = L >> 1;
        const int convL_ = (CONV_IN_ATTN && (L & 1) == 0 && L + 1 < DEPTH) ? L + 1 : -1;
        PH_BEGIN {
#if QKV_FP8
            int bxl = bx; asm volatile("" : "+s"(bxl));
            { pg8::Gemm g{WSP(bf16, WS_XB), WSP(bf16, W_IN), T, 768, D}; pg8::StaticOrder S; S.init(T, 768, F.G, bxl);
              pg8::EpiL1 E{WSP(bf16, A_DQ), WSP(bf16, A_CQN), WSP(bf16, A_CKVN), WSP(bf16, A_MKR), WSP(float, WS_SSP), WSP(float, WS_ROPE), 0.125f * LOG2E, 12};
              for (int rep = 0; rep < REP_L1; ++rep) pg8::gemm_phase<pg8::EpiL1, pg8::StaticOrder, true, true, 0>(F.lds, g, S, E, MY_TID()); }
            { pg8::Gemm g{WSP(bf16, WS_XB8), WSP(bf16, W_QKV8), T, 5120, D / 2};
              pg8::UnevenOrder S; S.init(T, 5120, F.G, bx);
              if (LN_FUSE || F.G == 256) { S.cut = 128; S.lo = 9; S.hi = 11; } else { S.cut = 0; S.lo = 0; S.hi = (S.nwg + F.G - 1) / F.G; }
              pg8::EpiQkvG8 E{WSP(bf16, A_DQ), WSP(bf16, A_G), INF(5) + L * 2048, 0.125f * LOG2E, 1.0f / 32.0f};
              for (int rep = 0; rep < REP_L1; ++rep) pg8::gemm_phase8<pg8::EpiQkvG8, pg8::UnevenOrder, true, F8_SP2, 0>(F.lds, g, S, E, 0x7F7F7F7F, MY_TID()); }
#else
            { pg8::Gemm g{WSP(bf16, WS_XB), WSP(bf16, W_IN), T, NIN_B, D}; pg8::StaticOrder S; S.init(T, NIN_B, F.G, bx);
              pg8::EpiL1 E{WSP(bf16, A_DQ), WSP(bf16, A_CQN), WSP(bf16, A_CKVN), WSP(bf16, A_MKR), WSP(float, WS_SSP), WSP(float, WS_ROPE), 0.125f * LOG2E};
              for (int rep = 0; rep < REP_L1; ++rep) pg8::gemm_phase<pg8::EpiL1, pg8::StaticOrder, true, true, STAG_L1>(F.lds, g, S, E, MY_TID()); }
            { pg8::Gemm g{WSP(bf16, WS_XB8), WSP(bf16, W_G8), T, 2048, D / 2};
              pg8::UnevenOrder S; S.init(T, 2048, F.G, bx);
              if (F.G == 256) { S.cut = 128; S.lo = 3; S.hi = 5; } else { S.cut = 0; S.lo = 0; S.hi = (S.nwg + F.G - 1) / F.G; }
              pg8::EpiGates8 E{WSP(bf16, A_G), INF(5) + L * 2048, 1.0f / 32.0f};
              for (int rep = 0; rep < REP_L1; ++rep) pg8::gemm_phase8<pg8::EpiGates8, pg8::UnevenOrder, true, F8_SP2, 0>(F.lds, g, S, E, 0x7F7F7F7F, MY_TID()); }
#endif
        } PH_END
        PH_BEGIN {
            for (int rep = 0; rep < REP_MIX; ++rep) {
            { pg8::Gemm g{WSP(bf16, A_CQN), WSP(bf16, W_UQ), T, 768, QR}; pg8::StaticOrder S; S.init(T, 768, F.G, bx);
              pg8::EpiRopeQ E{WSP(bf16, A_MQ), WSP(float, WS_ROPE), 0.10206207261596577f * LOG2E, WSP(float, WS_SSP)};
              GEMM_CALL(pg8::EpiRopeQ, pg8::StaticOrder, g, S, E); }
            { pg8::Gemm g{WSP(bf16, A_CKVN), WSP(bf16, W_UKV), T, 1024, KVR}; pg8::StaticOrder S; S.init(T, 1024, F.G, bx);
              pg8::EpiBf16Rs E{WSP(bf16, A_MKV), 1024, WSP(float, WS_SSP)};
              GEMM_CALL(pg8::EpiBf16Rs, pg8::StaticOrder, g, S, E); }
            }
#define CONV_HOOK() do { __syncthreads(); Frame F3 = F; { const int t3_ = MY_TID(); F3.tid = t3_; F3.lane = t3_ & 63; } phase_convert(F3, convL_, 2); __syncthreads(); } while (0)
            if (convL_ >= 0 && (bx & 1) == 0) CONV_HOOK();
            phase_attn_diff<0>(F, L);
            if (convL_ >= 0 && (bx & 1) != 0) CONV_HOOK();
#undef CONV_HOOK
        } PH_END
        PH_BEGIN { phase_attn_mla<0>(F); } PH_END
        PH_BEGIN {
            for (int rep = 0; rep < REP_MIX; ++rep) {
            { pg8::Gemm g{WSP(bf16, A_OB), WSP(bf16, W_BM), T, D, 512}; pg8::StaticOrder S; S.init(T, D, F.G, bx);
              pg8::EpiGate<false> E{WSP(bf16, A_MT), WSP(bf16, A_G), nullptr, 1024};
              GEMM_CALL(pg8::EpiGate<false>, pg8::StaticOrder, g, S, E); }
            { pg8::Gemm g{WSP(bf16, A_OA), WSP(bf16, W_BD), T, D, D}; pg8::StaticOrder S; S.init(T, D, F.G, bx);
              pg8::EpiGate<true> E{WSP(bf16, A_M), WSP(bf16, A_G), WSP(bf16, A_MT), 0};
              GEMM_CALL(pg8::EpiGate<true>, pg8::StaticOrder, g, S, E); }
            }
        } PH_END
        PH_BEGIN {
            pg8::Gemm g{WSP(bf16, A_M), WSP(bf16, W_OUT), T, D, D}; pg8::StaticOrder S; S.init(T, D, F.G, bx);
            if (fuse_ln && (L & 1) == 0) {
                pg8::EpiPreLn<1> E{nullptr, WSP(bf16, WS_XB), WSP(unsigned char, WS_XB8), ALPHA, INF(18) + L * D, INF(19) + L * D, WSP(unsigned long long, WS_LNST), WSP(unsigned, WS_CTL) + CW_LN + (2 * L) * 128, F.lds + RING_BYTES + 2048};
                GEMM_CALL(pg8::EpiPreLn<1>, pg8::StaticOrder, g, S, E);
            } else {
            pg8::EpiPre<1> E{WSP(bf16, A_PRE), WSP(bf16, WS_XB), ALPHA, 1.0f};
            for (int rep = 0; rep < REP_MIX; ++rep) GEMM_CALL(pg8::EpiPre<1>, pg8::StaticOrder, g, S, E);
            }
        } PH_END
        if (!(fuse_ln && (L & 1) == 0)) {
        PH_BEGIN {
            if (L & 1) phase_ln<true, false>(F, WSP(bf16, A_PRE), INF(18) + L * D, INF(19) + L * D, INF(23) + (size_t)mj * D * NEXP, mj, false);
            else for (int rep = 0; rep < REP_LN; ++rep) phase_ln<false, false>(F, WSP(bf16, A_PRE), INF(18) + L * D, INF(19) + L * D, nullptr, 0, false);
        } PH_END
        }
        if ((L & 1) == 0) {
            PH_BEGIN {
                for (int rep = 0; rep < REP_FFN; ++rep) {
                { pg8::Gemm g{WSP(bf16, WS_XB), WSP(bf16, W_F13D), T, 2 * DENSE_FF, D}; pg8::StaticOrder S; S.init(T, 2 * DENSE_FF, F.G, bx);
                  pg8::EpiSwiGLU E{WSP(bf16, A_H), DENSE_FF};
                  pg8::gemm_phase<pg8::EpiSwiGLU, pg8::StaticOrder, true, true, STAG_H>(F.lds, g, S, E, MY_TID()); }
                { pg8::Gemm g{WSP(bf16, WS_PB), WSP(bf16, W_PP), T, D, PLE}; pg8::StaticOrder S; S.init(T, D, F.G, bx);
                  pg8::EpiPre<0> E{WSP(bf16, A_PRE), nullptr, 0.f, 1.0f};
                  GEMM_CALL(pg8::EpiPre<0>, pg8::StaticOrder, g, S, E); }
                { pg8::Gemm g{WSP(bf16, WS_XB8), WSP(bf16, W_PG), T, D, D / 2}; pg8::StaticOrder S; S.init(T, D, F.G, bx);
                  pg8::EpiPre<2> E{WSP(bf16, A_PRE), WSP(bf16, WS_XB), ALPHA, 1.0f / 32.0f};
                  pg8::gemm_phase8<pg8::EpiPre<2>, pg8::StaticOrder, true, F8_SP2, 0>(F.lds, g, S, E, 0x7F7F7F7F, MY_TID()); }
                }
            } PH_END
            PH_BEGIN {
                pg8::Gemm g{WSP(bf16, A_H), WSP(bf16, W_F2D), T, D, DENSE_FF}; pg8::StaticOrder S; S.init(T, D, F.G, bx);
                if (fuse_ln) {
                    pg8::EpiPreLn<3> E{WSP(bf16, A_PRE), WSP(bf16, WS_XB), WSP(unsigned char, WS_XB8), 1.0f, INF(29) + L * D, INF(30) + L * D, WSP(unsigned long long, WS_LNST), WSP(unsigned, WS_CTL) + CW_LN + (2 * L + 1) * 128, F.lds + RING_BYTES + 2048};
                    GEMM_CALL(pg8::EpiPreLn<3>, pg8::StaticOrder, g, S, E);
                    if (L + 1 < DEPTH) { __syncthreads(); Frame F3 = F; { const int t3_ = MY_TID(); F3.tid = t3_; F3.lane = t3_ & 63; }
                        phase_convert(F3, L + 1, CONV_IN_ATTN ? 1 : 0); }
                } else {
                pg8::EpiPre<3> E{WSP(bf16, A_PRE), nullptr, 0.f, 1.0f};
                GEMM_CALL(pg8::EpiPre<3>, pg8::StaticOrder, g, S, E);
                }
            } PH_END
            if (!fuse_ln) {
            PH_BEGIN { if (!fuse_ln) for (int rep = 0; rep < REP_LN; ++rep) phase_ln<false, false>(F, WSP(bf16, A_PRE), INF(29) + L * D, INF(30) + L * D, nullptr, 0, L == DEPTH - 1); if (L + 1 < DEPTH) for (int rep = 0; rep < REP_CONV; ++rep) phase_convert(F, L + 1, CONV_IN_ATTN ? 1 : 0); } PH_END
            }
        } else {
            PH_BEGIN {
                phase_scatter(F, mj);
                for (int rep = 0; rep < REP_PPE; ++rep) {
                { pg8::Gemm g{WSP(bf16, WS_PB), WSP(bf16, W_PP), T, D, PLE}; pg8::StaticOrder S; S.init(T, D, F.G, bx);
                  pg8::EpiPre<0> E{WSP(bf16, A_PREM), nullptr, 0.f, 1.0f};
                  GEMM_CALL(pg8::EpiPre<0>, pg8::StaticOrder, g, S, E); }
                { pg8::Gemm g{WSP(bf16, WS_XB8), WSP(bf16, W_PG), T, D, D / 2}; pg8::StaticOrder S; S.init(T, D, F.G, bx);
                  pg8::EpiPre<2> E{WSP(bf16, A_PREM), WSP(bf16, WS_XB), ALPHA, 1.0f / 32.0f};
                  pg8::gemm_phase8<pg8::EpiPre<2>, pg8::StaticOrder, true, F8_SP2, 0>(F.lds, g, S, E, 0x7F7F7F7F, MY_TID()); }
                }
            } PH_END
            for (int ch = 0; ch < MOE_NCHUNK; ++ch) {
                PH_BEGIN {
                    MoeTiles mt; moe_tiles(F, mj, mt);
                    const int tlo = ch * MOE_CHUNK_TILES; int ntc = mt.total - tlo; ntc = ntc > MOE_CHUNK_TILES ? MOE_CHUNK_TILES : ntc;
                    if (ntc > 0) {
#if MOE_FP8
                        pg8::Gemm g{WSP(bf16, A_XG), WSP(bf16, W_F13), ntc * 256, 2 * EXPERT_FF, D / 2};
                        pg8::GroupedOrder S; S.init(ntc * 256, 2 * EXPERT_FF, F.G, bx); S.tile_lo = tlo; S.estride = (size_t)2 * EXPERT_FF * D;
#else
                        pg8::Gemm g{WSP(bf16, A_XG) + (size_t)tlo * 256 * D, WSP(bf16, W_F13), ntc * 256, 2 * EXPERT_FF, D};
                        pg8::GroupedOrder S; S.init(ntc * 256, 2 * EXPERT_FF, F.G, bx); S.tile_lo = tlo; S.estride = (size_t)2 * EXPERT_FF * D * 2;
#endif
                        S.pend0 = mt.pend[0]; S.pend1 = mt.pend[1]; S.pend2 = mt.pend[2]; S.pend3 = mt.pend[3]; S.pend4 = mt.pend[4]; S.pend5 = mt.pend[5]; S.pend6 = mt.pend[6]; S.pend7 = mt.pend[7];
#if MOE_FP8
                        pg8::EpiSwiGLU8 E{WSP(unsigned char, A_HG), EXPERT_FF, 1.0f / 32.0f};
                        for (int rep = 0; rep < REP_MOE; ++rep) pg8::gemm_phase8<pg8::EpiSwiGLU8, pg8::GroupedOrder, UP_ALIGN, F8_SP2, STAG_UP>(F.lds, g, S, E, 0x7F7F7F7F, MY_TID());
#else
                        pg8::EpiSwiGLU E{WSP(bf16, A_HG), EXPERT_FF};
                        for (int rep = 0; rep < REP_MOE; ++rep) GEMM_CALL(pg8::EpiSwiGLU, pg8::GroupedOrder, g, S, E);
#endif
                    }
                } PH_END
                PH_BEGIN {
                    MoeTiles mt; moe_tiles(F, mj, mt);
                    const int tlo = ch * MOE_CHUNK_TILES; int ntc = mt.total - tlo; ntc = ntc > MOE_CHUNK_TILES ? MOE_CHUNK_TILES : ntc;
                    if (ntc > 0) {
#if MOE_FP8
                        pg8::Gemm g{WSP(bf16, A_HG), WSP(bf16, W_F2E), ntc * 256, D, EXPERT_FF / 2};
                        pg8::GroupedOrder S; S.init(ntc * 256, D, F.G, bx); S.tile_lo = tlo; S.estride = (size_t)D * EXPERT_FF;
#else
                        pg8::Gemm g{WSP(bf16, A_HG), WSP(bf16, W_F2E), ntc * 256, D, EXPERT_FF};
                        pg8::GroupedOrder S; S.init(ntc * 256, D, F.G, bx); S.tile_lo = tlo; S.estride = (size_t)D * EXPERT_FF * 2;
#endif
                        S.pend0 = mt.pend[0]; S.pend1 = mt.pend[1]; S.pend2 = mt.pend[2]; S.pend3 = mt.pend[3]; S.pend4 = mt.pend[4]; S.pend5 = mt.pend[5]; S.pend6 = mt.pend[6]; S.pend7 = mt.pend[7];
                        pg8::EpiBf16 E{WSP(bf16, A_YG) + (size_t)tlo * 256 * D, D, MOE_FP8 ? 1.0f / 128.0f : 1.0f};
#if MOE_FP8
                        for (int rep = 0; rep < REP_MOE; ++rep) pg8::gemm_phase8<pg8::EpiBf16, pg8::GroupedOrder, true, F8_SP2>(F.lds, g, S, E, 0x7F7F7F7F, MY_TID());
#else
                        for (int rep = 0; rep < REP_MOE; ++rep) GEMM_CALL(pg8::EpiBf16, pg8::GroupedOrder, g, S, E);
#endif
                    }
                    if (CONV_IN_DOWN && ch == MOE_NCHUNK - 1 && L + 1 < DEPTH) {
                        const int nwg_ = (ntc > 0 ? ntc : 0) * (D / 256), r_ = nwg_ % F.G, nl_ = F.G - r_;
                        Frame F2 = F; { const int t2_ = MY_TID(); F2.tid = t2_; F2.lane = t2_ & 63; }
                        if (r_ != 0 && 2 * nl_ >= F.G) { if (bx >= r_) { F2.gw = (bx - r_) * NWAVES + F.wave; F2.NGW = nl_ * NWAVES; phase_convert(F2, L + 1); } }
                        else phase_convert(F2, L + 1);
                    }
                } PH_END
            }
            PH_BEGIN { for (int rep = 0; rep < REP_LN; ++rep) phase_ln<false, true>(F, WSP(bf16, A_PREM), INF(29) + L * D, INF(30) + L * D, nullptr, 0, L == DEPTH - 1); if (!CONV_IN_DOWN && L + 1 < DEPTH) for (int rep = 0; rep < REP_CONV; ++rep) phase_convert(F, L + 1); } PH_END
        }
    }
#undef PH_BEGIN
#undef PH_END
}

extern "C" void kernel_launch(void* const* d_in, const int* in_sizes, int n_in, void* d_out, int out_size, void* d_ws, size_t ws_size, hipStream_t stream) {
    static int grid = 0;
    if (grid == 0) {
        if (n_in != 31 || in_sizes[0] != T * D || out_size != T * D || ws_size < WS_END) { fprintf(stderr, "kernel_launch: unexpected shapes / workspace (n_in %d, ws %zu < %zu)\n", n_in, ws_size, (size_t)WS_END); grid = -1; return; }
        int dev = 0, cus = 0, per_cu = 0;
        if (hipGetDevice(&dev) != hipSuccess || hipDeviceGetAttribute(&cus, hipDeviceAttributeMultiprocessorCount, dev) != hipSuccess) { grid = -1; return; }
        if (hipFuncSetAttribute((const void*)mega_fwd, hipFuncAttributeMaxDynamicSharedMemorySize, LDS_BYTES) != hipSuccess) { fprintf(stderr, "kernel_launch: hipFuncSetAttribute failed\n"); grid = -1; return; }
        if (hipOccupancyMaxActiveBlocksPerMultiprocessor(&per_cu, (const void*)mega_fwd, NWAVES * 64, LDS_BYTES) != hipSuccess || per_cu < 1) { fprintf(stderr, "kernel_launch: occupancy query says %d\n", per_cu); (void)hipGetLastError(); grid = -1; return; }
        grid = cus;
    }
    if (grid < 0) return;
    if (hipMemsetAsync((char*)d_ws + WS_CTL, 0, CTL_ZERO_BYTES, stream) != hipSuccess) return;
    Args a{};
    for (int i = 0; i < 31; ++i) a.in[i] = d_in[i];
    a.out = (float*)d_out; a.ws = (unsigned char*)d_ws;
    a.fuse = LN_FUSE;
    if (LN_FUSE && grid != 256) { fprintf(stderr, "kernel_launch: the fused LayerNorm exchange needs a 256-workgroup grid (got %d); build with -DLN_FUSE=0\n", grid); return; }
    const int nph = NPH_TOTAL - (a.fuse ? 4 : 0);
#if MK_PER_PHASE
    for (int p = 0; p < nph; ++p) { a.ph_lo = p; a.ph_hi = p + 1; hipLaunchKernelGGL(mega_fwd, dim3(grid), dim3(NWAVES * 64), LDS_BYTES, stream, a); }
#else
    a.ph_lo = 0; a.ph_hi = nph;
    hipLaunchKernelGGL(mega_fwd, dim3(grid), dim3(NWAVES * 64), LDS_BYTES, stream, a);
#endif
}
```

```cpp
#include <hip/hip_runtime.h>
#include <cstdio>
#include <cstdint>
#include <cmath>

#ifndef MK_PER_PHASE
#define MK_PER_PHASE 0
#endif

constexpr int BATCH = 8, SEQ = 4096, T = BATCH * SEQ, D = 1024, DEPTH = 4, PLE = 256;
constexpr int IN_COLS = 5792, NIN = 5888, NIN_B = 3840;
constexpr int QR = 384, KVR = 256, ROPE_D = 32;
constexpr int DENSE_FF = 2816, EXPERT_FF = 3584, NEXP = 8;
constexpr float LN_EPS = 1e-5f;
constexpr float LOG2E = 1.4426950408889634f;
constexpr int MOE_ROWS = 2 * T + NEXP * 256;
constexpr int MOE_CHUNK_TILES = MOE_ROWS / 256;
constexpr int MOE_NCHUNK = 1;
#ifndef MOE_FP8
#define MOE_FP8 1
#endif

#define GAS __attribute__((address_space(1)))
#define LAS __attribute__((address_space(3)))
typedef unsigned short bf16;
typedef unsigned v4u __attribute__((ext_vector_type(4)));
typedef unsigned v2u __attribute__((ext_vector_type(2)));
typedef float f32x4 __attribute__((ext_vector_type(4)));
typedef float f32x2 __attribute__((ext_vector_type(2)));
typedef float f32x16 __attribute__((ext_vector_type(16)));
typedef short bf16x8 __attribute__((ext_vector_type(8)));
typedef short s16x4 __attribute__((ext_vector_type(4)));
typedef __bf16 bf16x2_t __attribute__((ext_vector_type(2)));
typedef GAS unsigned gu32;
#define RLX_AGENT __ATOMIC_RELAXED, __HIP_MEMORY_SCOPE_AGENT
#define LDS_WAIT() asm volatile("s_waitcnt lgkmcnt(0)" ::: "memory")
#define VM_WAIT() asm volatile("s_waitcnt vmcnt(0)" ::: "memory")

__device__ __forceinline__ unsigned pk2(float lo, float hi) { f32x2 v = {lo, hi}; bf16x2_t b = __builtin_convertvector(v, bf16x2_t); return __builtin_bit_cast(unsigned, b); }
__device__ __forceinline__ float bflo(unsigned u) { return __uint_as_float(u << 16); }
__device__ __forceinline__ float bfhi(unsigned u) { return __uint_as_float(u & 0xffff0000u); }
__device__ __forceinline__ float sigmoidf_(float x) { return __builtin_amdgcn_rcpf(1.0f + __builtin_amdgcn_exp2f(-x * LOG2E)); }
__device__ __forceinline__ float shx(float v, int o, int lane) { return __uint_as_float((unsigned)__builtin_amdgcn_ds_bpermute((lane ^ o) << 2, (int)__float_as_uint(v))); }
__device__ __forceinline__ int shxi(int v, int o, int lane) { return __builtin_amdgcn_ds_bpermute((lane ^ o) << 2, v); }
__device__ __forceinline__ float wave_sum(int lane, float v) {
#pragma unroll
    for (int o = 1; o < 64; o <<= 1) v += shx(v, o, lane);
    return v;
}

#ifndef GATE_U8
#define GATE_U8 1
#endif
#define PG8_PAIR16(A_, B_) do { const auto r0_ = __builtin_amdgcn_permlane16_swap((A_).x, (B_).x, false, false); (A_).x = r0_[0]; (B_).x = r0_[1]; \
                               const auto r1_ = __builtin_amdgcn_permlane16_swap((A_).y, (B_).y, false, false); (A_).y = r1_[0]; (B_).y = r1_[1]; } while (0)
namespace pg8 {
#define PG8_LAS __attribute__((address_space(3)))
typedef unsigned short bf16_t;
typedef unsigned u32x4 __attribute__((ext_vector_type(4)));
typedef unsigned u32x2 __attribute__((ext_vector_type(2)));
constexpr int BM = 256, BK = 64, HALF = 128, HTB = HALF * BK * 2  , STAGE_BYTES = 8 * HTB, NXCD = 8, WGM = 8;

__host__ __device__ __forceinline__ int lds_byte(int r, int c) { const int st = (r >> 4) * 2 + (c >> 5), rr = r & 15, cc = c & 31, ob = rr * 64 + cc * 2; return st * 1024 + (ob ^ (((ob >> 9) & 1) << 5)); }
__host__ __device__ __forceinline__ void stage_rc(int b, int& R, int& C) { const int st = b / 1024, sb = b % 1024, swz = sb ^ (((sb >> 9) & 1) << 5); R = (st >> 1) * 16 + swz / 64; C = (st & 1) * 32 + (swz % 64) / 2; }
__host__ __device__ __forceinline__ int perm32(int rho) { const int n = rho >> 4, i = rho & 15; return 8 * (i >> 2) + 4 * n + (i & 3); }

struct Unit { int pm, pn; };
struct Gemm { const bf16_t* A; const bf16_t* Bt; int M, N, K; };

struct StaticOrder {
    int nM, nN, nwg, G, c;
    __host__ __device__ void init(int M, int N, int G_, int c_) { nM = M / BM; nN = N / BM; nwg = nM * nN; G = G_; c = c_; }
    __host__ __device__ bool next(int i, Unit& u) const {
        const long L = (long)i * G + c; if (L >= nwg) return false;
        int wgid = (int)L; { const int q = nwg / NXCD, r = nwg % NXCD, xcd = wgid % NXCD, off = wgid / NXCD; wgid = (xcd < r ? xcd * (q + 1) : r * (q + 1) + (xcd - r) * q) + off; }
        const int nig = WGM * nN, gid = wgid / nig, fm = gid * WGM, gsz = (nM - fm) < WGM ? (nM - fm) : WGM;
        u.pm = fm + ((wgid % nig) % gsz); u.pn = (wgid % nig) / gsz; return true;
    }
    __device__ __forceinline__ size_t bofs(const Unit&) const { return 0; }
    __device__ __forceinline__ void a_ready(const Unit&) const {}
    __device__ __forceinline__ void done(const Unit&) const {}
};
struct UnevenOrder : StaticOrder {
    int cut, lo, hi;
    __host__ __device__ bool next(int i, Unit& u) const {
        long L;
        if (i < lo) L = (long)i * G + c;
        else if (c >= cut && i < hi) L = (long)lo * G + (long)(c - cut) * (hi - lo) + (i - lo);
        else return false;
        if (L >= nwg) return false;
        int wgid = (int)L; { const int q = nwg / NXCD, r = nwg % NXCD, xcd = wgid % NXCD, off = wgid / NXCD; wgid = (xcd < r ? xcd * (q + 1) : r * (q + 1) + (xcd - r) * q) + off; }
        const int nig = WGM * nN, gid = wgid / nig, fm = gid * WGM, gsz = (nM - fm) < WGM ? (nM - fm) : WGM;
        u.pm = fm + ((wgid % nig) % gsz); u.pn = (wgid % nig) / gsz; return true;
    }
};
struct GroupedOrder : StaticOrder {
    int tile_lo; int pend0, pend1, pend2, pend3, pend4, pend5, pend6, pend7; size_t estride;
    __device__ __forceinline__ size_t bofs(const Unit& u) const {
        const int t = u.pm + tile_lo;
        const int e = (t >= pend0) + (t >= pend1) + (t >= pend2) + (t >= pend3) + (t >= pend4) + (t >= pend5) + (t >= pend6);
        return (size_t)e * estride;
    }
};

typedef f32x4 Acc[2][2][4][2];

struct EpiL1 {
    static constexpr bool PERM = true, AFTER_DRAIN = false;
    bf16_t* QKV; bf16_t* CQR; bf16_t* CKVR; bf16_t* MKR; float* SSP; const float* rope; float qscale; int pn_off;
    __device__ __forceinline__ void operator()(const Acc& acc, const Unit& u, int wr, int wc, int fr, int fq) const {
        const int row0 = u.pm * BM + wr * 64 + fr; const int pn = u.pn + pn_off;
        if (pn < 12) {
            bf16_t* base = QKV + (size_t)(pn >> 2) * ((size_t)T * 1024); const int col0 = (pn & 3) * 256 + wc * 32 + 8 * fq; const float sc = pn < 4 ? qscale : 1.f;
#pragma unroll
            for (int ai = 0; ai < 2; ++ai)
#pragma unroll
                for (int m = 0; m < 4; ++m) { bf16_t* rowp = base + (size_t)(row0 + ai * HALF + m * 16) * 1024 + col0;
#pragma unroll
                    for (int bj = 0; bj < 2; ++bj) { const f32x4 v0 = acc[ai][bj][m][0] * sc, v1 = acc[ai][bj][m][1] * sc;
                        u32x4 w; w.x = pk2(v0[0], v0[1]); w.y = pk2(v0[2], v0[3]); w.z = pk2(v1[0], v1[1]); w.w = pk2(v1[2], v1[3]);
                        *(u32x4*)(rowp + bj * HALF) = w; } }
            return;
        }
        const int lane = fr | (fq << 4), cl = wc * 32 + 8 * fq;
#pragma unroll
        for (int ai = 0; ai < 2; ++ai)
#pragma unroll
            for (int m = 0; m < 4; ++m) { const size_t row = (size_t)(row0 + ai * HALF + m * 16);
                float p[2];
#pragma unroll
                for (int bj = 0; bj < 2; ++bj) { const f32x4 v0 = acc[ai][bj][m][0], v1 = acc[ai][bj][m][1];
                    p[bj] = ((v0[0] * v0[0] + v0[1] * v0[1]) + (v0[2] * v0[2] + v0[3] * v0[3])) + ((v1[0] * v1[0] + v1[1] * v1[1]) + (v1[2] * v1[2] + v1[3] * v1[3]));
                    u32x4 w; w.x = pk2(v0[0], v0[1]); w.y = pk2(v0[2], v0[3]); w.z = pk2(v1[0], v1[1]); w.w = pk2(v1[2], v1[3]);
                    if (pn == 12) *(u32x4*)(CQR + row * 384 + bj * HALF + cl) = w;
                    else if (pn == 13) { if (bj == 0) *(u32x4*)(CQR + row * 384 + 256 + cl) = w; else *(u32x4*)(CKVR + row * 256 + cl) = w; }
                    else if (bj == 0) *(u32x4*)(CKVR + row * 256 + HALF + cl) = w; }
                if (pn == 12) { p[0] += p[1]; p[1] = 0.f; }
                p[0] += shx(p[0], 16, lane); p[0] += shx(p[0], 32, lane);
                if (pn == 13) { p[1] += shx(p[1], 16, lane); p[1] += shx(p[1], 32, lane); }
                if (fq == 0) { float* sp = SSP + row * 16 + wc;
                    if (pn == 12) sp[0] = p[0]; else if (pn == 13) { sp[4] = p[0]; sp[8] = p[1]; } else sp[12] = p[0]; }
                if (pn == 14 && wc == 0) {
                    const f32x4 v0 = acc[ai][1][m][0], v1 = acc[ai][1][m][1]; float mine[8] = {v0[0], v0[1], v0[2], v0[3], v1[0], v1[1], v1[2], v1[3]}, oth[8];
#pragma unroll
                    for (int i = 0; i < 8; ++i) oth[i] = shx(mine[i], 32, lane);
                    const float* rp = rope + row * 32 + 16 * (fq & 1);
                    const f32x4 r0 = *(const f32x4*)rp, r1 = *(const f32x4*)(rp + 4), r2 = *(const f32x4*)(rp + 8), r3 = *(const f32x4*)(rp + 12);
                    const float cs[8] = {r0[0], r0[2], r1[0], r1[2], r2[0], r2[2], r3[0], r3[2]}, sn[8] = {r0[1], r0[3], r1[1], r1[3], r2[1], r2[3], r3[1], r3[3]};
                    float o[8];
#pragma unroll
                    for (int i = 0; i < 8; ++i) o[i] = (fq < 2) ? mine[i] * cs[i] - oth[i] * sn[i] : oth[i] * sn[i] + mine[i] * cs[i];
                    u32x4 w; w.x = pk2(o[0], o[1]); w.y = pk2(o[2], o[3]); w.z = pk2(o[4], o[5]); w.w = pk2(o[6], o[7]);
                    *(u32x4*)(MKR + row * 32 + 8 * fq) = w; }
            }
    }
};
struct EpiGates8 {
    static constexpr bool PERM = true, AFTER_DRAIN = false;
    bf16_t* Gt; const float* bgate; float isc;
    __device__ __forceinline__ void operator()(const Acc& acc, const Unit& u, int wr, int wc, int fr, int fq) const {
        const int row0 = u.pm * BM + wr * 64 + fr; const int col0 = u.pn * 256 + wc * 32 + 8 * fq;
        f32x4 bv[2][2];
#pragma unroll
        for (int bj = 0; bj < 2; ++bj)
#pragma unroll
            for (int n = 0; n < 2; ++n) bv[bj][n] = *(const f32x4*)(bgate + col0 + bj * HALF + 4 * n);
#pragma unroll
        for (int ai = 0; ai < 2; ++ai)
#pragma unroll
            for (int m = 0; m < 4; ++m) { bf16_t* rowp = Gt + (size_t)(row0 + ai * HALF + m * 16) * 2048 + col0;
#pragma unroll
                for (int bj = 0; bj < 2; ++bj) { const f32x4 v0 = acc[ai][bj][m][0] * isc + bv[bj][0], v1 = acc[ai][bj][m][1] * isc + bv[bj][1];
                    u32x4 w; w.x = pk2(sigmoidf_(v0[0]), sigmoidf_(v0[1])); w.y = pk2(sigmoidf_(v0[2]), sigmoidf_(v0[3])); w.z = pk2(sigmoidf_(v1[0]), sigmoidf_(v1[1])); w.w = pk2(sigmoidf_(v1[2]), sigmoidf_(v1[3]));
                    *(u32x4*)(rowp + bj * HALF) = w; } }
    }
};
struct EpiQkvG8 {
    static constexpr bool PERM = true, AFTER_DRAIN = false;
    bf16_t* QKV; bf16_t* Gt; const float* bgate; float qscale, isc;
    __device__ __forceinline__ void operator()(const Acc& acc, const Unit& u, int wr, int wc, int fr, int fq) const {
        const int row0 = u.pm * BM + wr * 64 + fr; const int pn = u.pn;
        if (pn < 12) {
            bf16_t* base = QKV + (size_t)(pn >> 2) * ((size_t)T * 1024); const int col0 = (pn & 3) * 256 + wc * 32 + 8 * fq; const float sc = (pn < 4 ? qscale : 1.f) * isc;
#pragma unroll
            for (int ai = 0; ai < 2; ++ai)
#pragma unroll
                for (int m = 0; m < 4; ++m) { bf16_t* rowp = base + (size_t)(row0 + ai * HALF + m * 16) * 1024 + col0;
#pragma unroll
                    for (int bj = 0; bj < 2; ++bj) { const f32x4 v0 = acc[ai][bj][m][0] * sc, v1 = acc[ai][bj][m][1] * sc;
                        u32x4 w; w.x = pk2(v0[0], v0[1]); w.y = pk2(v0[2], v0[3]); w.z = pk2(v1[0], v1[1]); w.w = pk2(v1[2], v1[3]);
                        *(u32x4*)(rowp + bj * HALF) = w; } }
            return;
        }
        const int col0 = (pn - 12) * 256 + wc * 32 + 8 * fq;
        f32x4 bv[2][2];
#pragma unroll
        for (int bj = 0; bj < 2; ++bj)
#pragma unroll
            for (int n = 0; n < 2; ++n) bv[bj][n] = *(const f32x4*)(bgate + col0 + bj * HALF + 4 * n);
#if GATE_U8
        unsigned char* G8 = (unsigned char*)Gt;
        const int rowg = row0 + (fq & 1) * 16, colg = (pn - 12) * 256 + wc * 32 + 8 * (fq & ~1);
#define G8Q_(x) ((unsigned)(sigmoidf_(x) * 255.0f + 0.5f))
#pragma unroll
        for (int ai = 0; ai < 2; ++ai)
#pragma unroll
            for (int mp = 0; mp < 2; ++mp)
#pragma unroll
                for (int bj = 0; bj < 2; ++bj) { u32x2 w[2];
#pragma unroll
                    for (int e = 0; e < 2; ++e) { const int m = 2 * mp + e; const f32x4 v0 = acc[ai][bj][m][0] * isc + bv[bj][0], v1 = acc[ai][bj][m][1] * isc + bv[bj][1];
                        w[e].x = G8Q_(v0[0]) | (G8Q_(v0[1]) << 8) | (G8Q_(v0[2]) << 16) | (G8Q_(v0[3]) << 24); w[e].y = G8Q_(v1[0]) | (G8Q_(v1[1]) << 8) | (G8Q_(v1[2]) << 16) | (G8Q_(v1[3]) << 24); }
                    PG8_PAIR16(w[0], w[1]);
                    u32x4 q; q.x = w[0].x; q.y = w[0].y; q.z = w[1].x; q.w = w[1].y;
                    *(u32x4*)(G8 + (size_t)(rowg + ai * HALF + mp * 32) * 2048 + colg + bj * HALF) = q; }
#undef G8Q_
#else
#pragma unroll
        for (int ai = 0; ai < 2; ++ai)
#pragma unroll
            for (int m = 0; m < 4; ++m) { bf16_t* rowp = Gt + (size_t)(row0 + ai * HALF + m * 16) * 2048 + col0;
#pragma unroll
                for (int bj = 0; bj < 2; ++bj) { const f32x4 v0 = acc[ai][bj][m][0] * isc + bv[bj][0], v1 = acc[ai][bj][m][1] * isc + bv[bj][1];
                    u32x4 w; w.x = pk2(sigmoidf_(v0[0]), sigmoidf_(v0[1])); w.y = pk2(sigmoidf_(v0[2]), sigmoidf_(v0[3])); w.z = pk2(sigmoidf_(v1[0]), sigmoidf_(v1[1])); w.w = pk2(sigmoidf_(v1[2]), sigmoidf_(v1[3]));
                    *(u32x4*)(rowp + bj * HALF) = w; } }
#endif
    }
};
struct EpiRopeQ {
    static constexpr bool PERM = false, AFTER_DRAIN = false;
    bf16_t* O; const float* rope; float qscale; const float* SSP;
    __device__ __forceinline__ void operator()(const Acc& acc, const Unit& u, int wr, int wc, int fr, int fq) const {
        const int row0 = u.pm * BM + wr * 64 + fr;
        float rsq[2][4];
#pragma unroll
        for (int ai = 0; ai < 2; ++ai) { f32x4 sa[4], sb[4];
#pragma unroll
            for (int m = 0; m < 4; ++m) { const float* sp = SSP + (size_t)(row0 + ai * HALF + m * 16) * 16; sa[m] = *(const f32x4*)sp; sb[m] = *(const f32x4*)(sp + 4); }
#pragma unroll
            for (int m = 0; m < 4; ++m) { const f32x4 t = sa[m] + sb[m]; rsq[ai][m] = qscale / sqrtf(((t[0] + t[1]) + (t[2] + t[3])) * (1.0f / 384.0f) + LN_EPS); } }
        f32x4 c0[2][4], c1[2][4];
#pragma unroll
        for (int ai = 0; ai < 2; ++ai)
#pragma unroll
            for (int m = 0; m < 4; ++m) { const int row = row0 + ai * HALF + m * 16; c0[ai][m] = *(const f32x4*)(rope + (size_t)row * 32 + fq * 8); c1[ai][m] = *(const f32x4*)(rope + (size_t)row * 32 + fq * 8 + 4); }
#pragma unroll
        for (int ai = 0; ai < 2; ++ai)
#pragma unroll
            for (int mp = 0; mp < 2; ++mp)
#pragma unroll
                for (int bj = 0; bj < 2; ++bj) { const int colg = u.pn * BM + bj * HALF + wc * 32; const bool isr = ((colg >> 5) % 3) == 2;
                    u32x2 w1[2], w2[2];
#pragma unroll
                    for (int e = 0; e < 2; ++e) { const int m = 2 * mp + e;
                        const f32x4 cs0 = c0[ai][m], cs1 = c1[ai][m];
                        const f32x4 cc = {cs0[0], cs0[2], cs1[0], cs1[2]}, ss = {cs0[1], cs0[3], cs1[1], cs1[3]};
                        const f32x4 x1 = acc[ai][bj][m][0], x2 = acc[ai][bj][m][1];
                        f32x4 o1 = x1, o2 = x2; if (isr) { o1 = x1 * cc - x2 * ss; o2 = x1 * ss + x2 * cc; }
                        o1 = o1 * rsq[ai][m]; o2 = o2 * rsq[ai][m];
                        w1[e].x = pk2(o1[0], o1[1]); w1[e].y = pk2(o1[2], o1[3]); w2[e].x = pk2(o2[0], o2[1]); w2[e].y = pk2(o2[2], o2[3]); }
                    PG8_PAIR16(w1[0], w1[1]); PG8_PAIR16(w2[0], w2[1]);
                    bf16_t* p = O + (size_t)(row0 + ai * HALF + (2 * mp + (fq & 1)) * 16) * 768 + colg + 4 * (fq & ~1);
                    u32x4 q1; q1.x = w1[0].x; q1.y = w1[0].y; q1.z = w1[1].x; q1.w = w1[1].y; u32x4 q2; q2.x = w2[0].x; q2.y = w2[0].y; q2.z = w2[1].x; q2.w = w2[1].y;
                    *(u32x4*)p = q1; *(u32x4*)(p + 16) = q2; }
    }
};
struct EpiBf16 {
    static constexpr bool PERM = true, AFTER_DRAIN = false;
    bf16_t* O; int ldc; float osc;
    __device__ __forceinline__ void operator()(const Acc& acc, const Unit& u, int wr, int wc, int fr, int fq) const {
        const int row0 = u.pm * BM + wr * 64 + fr, col0 = u.pn * BM + wc * 32 + 8 * fq;
#pragma unroll
        for (int ai = 0; ai < 2; ++ai)
#pragma unroll
            for (int m = 0; m < 4; ++m) { bf16_t* rowp = O + (size_t)(row0 + ai * HALF + m * 16) * ldc + col0;
#pragma unroll
                for (int bj = 0; bj < 2; ++bj) { const f32x4 v0 = acc[ai][bj][m][0] * osc, v1 = acc[ai][bj][m][1] * osc;
                    u32x4 w; w.x = pk2(v0[0], v0[1]); w.y = pk2(v0[2], v0[3]); w.z = pk2(v1[0], v1[1]); w.w = pk2(v1[2], v1[3]);
                    *(u32x4*)(rowp + bj * HALF) = w; } }
    }
};
struct EpiBf16Rs {
    static constexpr bool PERM = true, AFTER_DRAIN = false;
    bf16_t* O; int ldc; const float* SSP;
    __device__ __forceinline__ void operator()(const Acc& acc, const Unit& u, int wr, int wc, int fr, int fq) const {
        const int row0 = u.pm * BM + wr * 64 + fr, col0 = u.pn * BM + wc * 32 + 8 * fq;
        float rsq[2][4];
#pragma unroll
        for (int ai = 0; ai < 2; ++ai) { f32x4 sa[4], sb[4];
#pragma unroll
            for (int m = 0; m < 4; ++m) { const float* sp = SSP + (size_t)(row0 + ai * HALF + m * 16) * 16 + 8; sa[m] = *(const f32x4*)sp; sb[m] = *(const f32x4*)(sp + 4); }
#pragma unroll
            for (int m = 0; m < 4; ++m) { const f32x4 t = sa[m] + sb[m]; rsq[ai][m] = 1.0f / sqrtf(((t[0] + t[1]) + (t[2] + t[3])) * (1.0f / 256.0f) + LN_EPS); } }
#pragma unroll
        for (int ai = 0; ai < 2; ++ai)
#pragma unroll
            for (int m = 0; m < 4; ++m) { bf16_t* rowp = O + (size_t)(row0 + ai * HALF + m * 16) * ldc + col0; const float osc = rsq[ai][m];
#pragma unroll
                for (int bj = 0; bj < 2; ++bj) { const f32x4 v0 = acc[ai][bj][m][0] * osc, v1 = acc[ai][bj][m][1] * osc;
                    u32x4 w; w.x = pk2(v0[0], v0[1]); w.y = pk2(v0[2], v0[3]); w.z = pk2(v1[0], v1[1]); w.w = pk2(v1[2], v1[3]);
                    *(u32x4*)(rowp + bj * HALF) = w; } }
    }
};
template <bool ADD> struct EpiGate {
    static constexpr bool PERM = true, AFTER_DRAIN = false;
    bf16_t* O; const bf16_t* Gt; const bf16_t* MT; int goff;
    __device__ __forceinline__ void operator()(const Acc& acc, const Unit& u, int wr, int wc, int fr, int fq) const {
        const int row0 = u.pm * BM + wr * 64 + fr, col0 = u.pn * BM + wc * 32 + 8 * fq;
#pragma unroll
        for (int ai = 0; ai < 2; ++ai) {
#if GATE_U8
            u32x2 gq[4][2]; u32x4 mq[4][2];
#else
            u32x4 gq[4][2], mq[4][2];
#endif
#pragma unroll
            for (int m = 0; m < 4; ++m)
#pragma unroll
                for (int bj = 0; bj < 2; ++bj) { const size_t row = (size_t)(row0 + ai * HALF + m * 16); const int col = col0 + bj * HALF;
#if GATE_U8
                    gq[m][bj] = *(const u32x2*)((const unsigned char*)Gt + row * 2048 + goff + col);
#else
                    gq[m][bj] = *(const u32x4*)(Gt + row * 2048 + goff + col);
#endif
                    if (ADD) mq[m][bj] = *(const u32x4*)(MT + row * 1024 + col); }
#pragma unroll
            for (int m = 0; m < 4; ++m)
#pragma unroll
                for (int bj = 0; bj < 2; ++bj) { const size_t row = (size_t)(row0 + ai * HALF + m * 16); const int col = col0 + bj * HALF;
                    f32x4 v0 = acc[ai][bj][m][0], v1 = acc[ai][bj][m][1];
#if GATE_U8
                    { const u32x2 gv = gq[m][bj]; const float k255 = 1.0f / 255.0f;
                      v0[0] *= (float)(gv.x & 0xffu) * k255; v0[1] *= (float)((gv.x >> 8) & 0xffu) * k255; v0[2] *= (float)((gv.x >> 16) & 0xffu) * k255; v0[3] *= (float)(gv.x >> 24) * k255;
                      v1[0] *= (float)(gv.y & 0xffu) * k255; v1[1] *= (float)((gv.y >> 8) & 0xffu) * k255; v1[2] *= (float)((gv.y >> 16) & 0xffu) * k255; v1[3] *= (float)(gv.y >> 24) * k255; }
#else
                    { const u32x4 gv = gq[m][bj];
                      v0[0] *= bflo(gv.x); v0[1] *= bfhi(gv.x); v0[2] *= bflo(gv.y); v0[3] *= bfhi(gv.y); v1[0] *= bflo(gv.z); v1[1] *= bfhi(gv.z); v1[2] *= bflo(gv.w); v1[3] *= bfhi(gv.w); }
#endif
                    if (ADD) { const u32x4 mv = mq[m][bj];
                        v0[0] += bflo(mv.x); v0[1] += bfhi(mv.x); v0[2] += bflo(mv.y); v0[3] += bfhi(mv.y); v1[0] += bflo(mv.z); v1[1] += bfhi(mv.z); v1[2] += bflo(mv.w); v1[3] += bfhi(mv.w); }
                    u32x4 w; w.x = pk2(v0[0], v0[1]); w.y = pk2(v0[2], v0[3]); w.z = pk2(v1[0], v1[1]); w.w = pk2(v1[2], v1[3]);
                    *(u32x4*)(O + row * 1024 + col) = w; }
        }
    }
};
template <int MODE> struct EpiPre {
    static constexpr bool PERM = true, AFTER_DRAIN = false;
    bf16_t* P; const bf16_t* XB; float alpha; float asc;
    __device__ __forceinline__ void operator()(const Acc& acc, const Unit& u, int wr, int wc, int fr, int fq) const {
        const int row0 = u.pm * BM + wr * 64 + fr, col0 = u.pn * BM + wc * 32 + 8 * fq;
        const float kk_ = -asc * LOG2E;
#define SG_(x) __builtin_amdgcn_rcpf(1.0f + __builtin_amdgcn_exp2f((x) * kk_))
#pragma unroll
        for (int ai = 0; ai < 2; ++ai)
#pragma unroll
          for (int mh = 0; mh < 2; ++mh) {
            u32x4 xq[2][2], pq[2][2];
#pragma unroll
            for (int mm = 0; mm < 2; ++mm)
#pragma unroll
                for (int bj = 0; bj < 2; ++bj) { const int m = 2 * mh + mm; const size_t o = (size_t)(row0 + ai * HALF + m * 16) * 1024 + col0 + bj * HALF;
                    if (MODE == 1 || MODE == 2) xq[mm][bj] = *(const u32x4*)(XB + o);
                    if (MODE == 2 || MODE == 3) pq[mm][bj] = *(const u32x4*)(P + o); }
            __builtin_amdgcn_sched_barrier(0);
#pragma unroll
            for (int mm = 0; mm < 2; ++mm)
#pragma unroll
                for (int bj = 0; bj < 2; ++bj) { const int m = 2 * mh + mm; const size_t o = (size_t)(row0 + ai * HALF + m * 16) * 1024 + col0 + bj * HALF; const f32x4 a0 = acc[ai][bj][m][0], a1 = acc[ai][bj][m][1]; float r[8];
                    if (MODE == 0) { r[0] = a0[0]; r[1] = a0[1]; r[2] = a0[2]; r[3] = a0[3]; r[4] = a1[0]; r[5] = a1[1]; r[6] = a1[2]; r[7] = a1[3]; }
                    else if (MODE == 1) { const u32x4 xv = xq[mm][bj];
                        r[0] = bflo(xv.x) * alpha + a0[0]; r[1] = bfhi(xv.x) * alpha + a0[1]; r[2] = bflo(xv.y) * alpha + a0[2]; r[3] = bfhi(xv.y) * alpha + a0[3];
                        r[4] = bflo(xv.z) * alpha + a1[0]; r[5] = bfhi(xv.z) * alpha + a1[1]; r[6] = bflo(xv.w) * alpha + a1[2]; r[7] = bfhi(xv.w) * alpha + a1[3]; }
                    else if (MODE == 2) { const u32x4 xv = xq[mm][bj]; const u32x4 pv = pq[mm][bj];
                        r[0] = bflo(xv.x) * alpha + SG_(a0[0]) * bflo(pv.x); r[1] = bfhi(xv.x) * alpha + SG_(a0[1]) * bfhi(pv.x); r[2] = bflo(xv.y) * alpha + SG_(a0[2]) * bflo(pv.y); r[3] = bfhi(xv.y) * alpha + SG_(a0[3]) * bfhi(pv.y);
                        r[4] = bflo(xv.z) * alpha + SG_(a1[0]) * bflo(pv.z); r[5] = bfhi(xv.z) * alpha + SG_(a1[1]) * bfhi(pv.z); r[6] = bflo(xv.w) * alpha + SG_(a1[2]) * bflo(pv.w); r[7] = bfhi(xv.w) * alpha + SG_(a1[3]) * bfhi(pv.w); }
                    else { const u32x4 pv = pq[mm][bj];
                        r[0] = bflo(pv.x) + a0[0]; r[1] = bfhi(pv.x) + a0[1]; r[2] = bflo(pv.y) + a0[2]; r[3] = bfhi(pv.y) + a0[3]; r[4] = bflo(pv.z) + a1[0]; r[5] = bfhi(pv.z) + a1[1]; r[6] = bflo(pv.w) + a1[2]; r[7] = bfhi(pv.w) + a1[3]; }
                    u32x4 w; w.x = pk2(r[0], r[1]); w.y = pk2(r[2], r[3]); w.z = pk2(r[4], r[5]); w.w = pk2(r[6], r[7]);
                    *(u32x4*)(P + o) = w; }
            __builtin_amdgcn_sched_barrier(0);
          }
    }
};
#undef SG_

template <int MODE> struct EpiPreLn {
    static constexpr bool PERM = true, AFTER_DRAIN = false;
    const bf16_t* P; bf16_t* XB; unsigned char* XB8; float alpha; const float* gam; const float* bet;
    unsigned long long* ST; unsigned* FLAG; LAS unsigned char* sl;
    __device__ __forceinline__ void operator()(const Acc& acc, const Unit& u, int wr, int wc, int fr, int fq) const {
        const int lane = fr | (fq << 4), t = ((wr * 4 + wc) << 6) | lane;
        const int row0 = u.pm * BM + wr * 64 + fr, col0 = u.pn * BM + wc * 32 + 8 * fq;
        Acc pre; float s1[2][4], s2[2][4];
#pragma unroll
        for (int ai = 0; ai < 2; ++ai)
#pragma unroll
          for (int mh = 0; mh < 2; ++mh) {
            u32x4 xq[2][2];
#pragma unroll
            for (int mm = 0; mm < 2; ++mm)
#pragma unroll
                for (int bj = 0; bj < 2; ++bj) { const int m = 2 * mh + mm; const size_t o = (size_t)(row0 + ai * HALF + m * 16) * 1024 + col0 + bj * HALF;
                    xq[mm][bj] = *(const u32x4*)((MODE == 1 ? (const bf16_t*)XB : P) + o); }
            __builtin_amdgcn_sched_barrier(0);
#pragma unroll
            for (int mm = 0; mm < 2; ++mm) { const int m = 2 * mh + mm; float a1 = 0.f, a2 = 0.f;
#pragma unroll
                for (int bj = 0; bj < 2; ++bj) { const f32x4 a0 = acc[ai][bj][m][0], b0 = acc[ai][bj][m][1]; const u32x4 xv = xq[mm][bj]; const float ka = (MODE == 1) ? alpha : 1.0f;
                    f32x4 r0, r1;
                    r0[0] = bflo(xv.x) * ka + a0[0]; r0[1] = bfhi(xv.x) * ka + a0[1]; r0[2] = bflo(xv.y) * ka + a0[2]; r0[3] = bfhi(xv.y) * ka + a0[3];
                    r1[0] = bflo(xv.z) * ka + b0[0]; r1[1] = bfhi(xv.z) * ka + b0[1]; r1[2] = bflo(xv.w) * ka + b0[2]; r1[3] = bfhi(xv.w) * ka + b0[3];
                    asm volatile("" : "+v"(r0), "+v"(r1));
                    pre[ai][bj][m][0] = r0; pre[ai][bj][m][1] = r1;
                    a1 += ((r0[0] + r0[1]) + (r0[2] + r0[3])) + ((r1[0] + r1[1]) + (r1[2] + r1[3]));
                    a2 += ((r0[0] * r0[0] + r0[1] * r0[1]) + (r0[2] * r0[2] + r0[3] * r0[3])) + ((r1[0] * r1[0] + r1[1] * r1[1]) + (r1[2] * r1[2] + r1[3] * r1[3])); }
                asm volatile("" : "+v"(a1), "+v"(a2)); s1[ai][m] = a1; s2[ai][m] = a2; }
            __builtin_amdgcn_sched_barrier(0);
          }
#pragma unroll
        for (int ai = 0; ai < 2; ++ai)
#pragma unroll
            for (int m = 0; m < 4; ++m) { float a = s1[ai][m], b = s2[ai][m]; a += shx(a, 16, lane); b += shx(b, 16, lane); a += shx(a, 32, lane); b += shx(b, 32, lane);
                if (fq == 0) { const int rl = ai * HALF + wr * 64 + m * 16 + fr; f32x2 w = {a, b}; *(LAS f32x2*)(sl + (rl * 4 + wc) * 8) = w; } }
        int row0b = row0, col0b = col0; asm volatile("" : "+v"(row0b), "+v"(col0b));
        f32x4 gv[2][2], bv[2][2];
#pragma unroll
        for (int bj = 0; bj < 2; ++bj)
#pragma unroll
            for (int n = 0; n < 2; ++n) { gv[bj][n] = *(const f32x4*)(gam + col0b + bj * HALF + 4 * n); bv[bj][n] = *(const f32x4*)(bet + col0b + bj * HALF + 4 * n); }
        __syncthreads();
        unsigned long long* stp = ST + ((size_t)u.pm * 4) * 256 + t;
        if (t < 256) { const LAS f32x2* p = (const LAS f32x2*)(sl + t * 32); const f32x2 w = (p[0] + p[1]) + (p[2] + p[3]);
            __hip_atomic_store(stp + (size_t)u.pn * 256, __builtin_bit_cast(unsigned long long, w), __ATOMIC_RELAXED, __HIP_MEMORY_SCOPE_AGENT); }
        asm volatile("s_waitcnt vmcnt(0)" ::: "memory");
        __syncthreads();
        if (t == 0) { __hip_atomic_fetch_add(FLAG + u.pm, 1u, __ATOMIC_RELAXED, __HIP_MEMORY_SCOPE_AGENT);
            for (int spin = 0; spin < (1 << 20) && __hip_atomic_load(FLAG + u.pm, __ATOMIC_RELAXED, __HIP_MEMORY_SCOPE_AGENT) < 4u; ++spin) __builtin_amdgcn_s_sleep(1); }
        __syncthreads();
        if (t < 256) {
            const unsigned long long q0 = __hip_atomic_load(stp, __ATOMIC_RELAXED, __HIP_MEMORY_SCOPE_AGENT), q1 = __hip_atomic_load(stp + 256, __ATOMIC_RELAXED, __HIP_MEMORY_SCOPE_AGENT),
                                     q2 = __hip_atomic_load(stp + 512, __ATOMIC_RELAXED, __HIP_MEMORY_SCOPE_AGENT), q3 = __hip_atomic_load(stp + 768, __ATOMIC_RELAXED, __HIP_MEMORY_SCOPE_AGENT);
            const f32x2 w = (__builtin_bit_cast(f32x2, q0) + __builtin_bit_cast(f32x2, q1)) + (__builtin_bit_cast(f32x2, q2) + __builtin_bit_cast(f32x2, q3));
            const float mean = w[0] * (1.0f / 1024.0f); float var = w[1] * (1.0f / 1024.0f) - mean * mean; var = var < 0.f ? 0.f : var;
            f32x2 mr = {mean, 1.0f / sqrtf(var + LN_EPS)}; *(LAS f32x2*)(sl + 8192 + t * 8) = mr; }
        __syncthreads();
        const int fqe = (col0b >> 3) & 1;
#pragma unroll
        for (int ai = 0; ai < 2; ++ai)
#pragma unroll
            for (int mp = 0; mp < 2; ++mp) { f32x2 mr[2];
#pragma unroll
                for (int e = 0; e < 2; ++e) mr[e] = *(const LAS f32x2*)(sl + 8192 + (ai * HALF + wr * 64 + (2 * mp + e) * 16 + fr) * 8);
#pragma unroll
                for (int bj = 0; bj < 2; ++bj) { u32x2 w8[2];
#pragma unroll
                    for (int e = 0; e < 2; ++e) { const int m = 2 * mp + e; const size_t o = (size_t)(row0b + ai * HALF + m * 16) * 1024 + col0b;
                        const f32x4 y0 = (pre[ai][bj][m][0] - mr[e][0]) * mr[e][1] * gv[bj][0] + bv[bj][0], y1 = (pre[ai][bj][m][1] - mr[e][0]) * mr[e][1] * gv[bj][1] + bv[bj][1];
                        u32x4 w; w.x = pk2(y0[0], y0[1]); w.y = pk2(y0[2], y0[3]); w.z = pk2(y1[0], y1[1]); w.w = pk2(y1[2], y1[3]);
                        *(u32x4*)(XB + o + bj * HALF) = w;
                        int q0 = __builtin_amdgcn_cvt_pk_fp8_f32(y0[0], y0[1], 0, false); q0 = __builtin_amdgcn_cvt_pk_fp8_f32(y0[2], y0[3], q0, true);
                        int q1 = __builtin_amdgcn_cvt_pk_fp8_f32(y1[0], y1[1], 0, false); q1 = __builtin_amdgcn_cvt_pk_fp8_f32(y1[2], y1[3], q1, true);
                        w8[e].x = (unsigned)q0; w8[e].y = (unsigned)q1; }
                    PG8_PAIR16(w8[0], w8[1]);
                    u32x4 q; q.x = w8[0].x; q.y = w8[0].y; q.z = w8[1].x; q.w = w8[1].y;
                    *(u32x4*)(XB8 + (size_t)(row0b + ai * HALF + (2 * mp + fqe) * 16) * 1024 + (col0b - 8 * fqe) + bj * HALF) = q; } }
    }
};
struct EpiSwiGLU {
    static constexpr bool PERM = true, AFTER_DRAIN = false;
    bf16_t* H; int ldc;
    __device__ __forceinline__ void operator()(const Acc& acc, const Unit& u, int wr, int wc, int fr, int fq) const {
        const int rowb = u.pm * BM + wr * 64 + fr + (fq & 1) * 16, colb = (u.pn * BM + wc * 32 + 8 * (fq & ~1)) >> 1;
#pragma unroll
        for (int ai = 0; ai < 2; ++ai)
#pragma unroll
            for (int mp = 0; mp < 2; ++mp)
#pragma unroll
                for (int bj = 0; bj < 2; ++bj) { u32x2 w[2];
#pragma unroll
                    for (int e = 0; e < 2; ++e) { const int m = 2 * mp + e; const f32x4 v0 = acc[ai][bj][m][0], v1 = acc[ai][bj][m][1];
                        const float h0 = v0[0] * sigmoidf_(v0[0]) * v0[1], h1 = v0[2] * sigmoidf_(v0[2]) * v0[3], h2 = v1[0] * sigmoidf_(v1[0]) * v1[1], h3 = v1[2] * sigmoidf_(v1[2]) * v1[3];
                        w[e].x = pk2(h0, h1); w[e].y = pk2(h2, h3); }
                    PG8_PAIR16(w[0], w[1]);
                    u32x4 q; q.x = w[0].x; q.y = w[0].y; q.z = w[1].x; q.w = w[1].y;
                    *(u32x4*)(H + (size_t)(rowb + ai * HALF + mp * 32) * ldc + colb + bj * (HALF / 2)) = q; }
    }
};

struct EpiSwiGLU8 {
    static constexpr bool PERM = true, AFTER_DRAIN = false;
    unsigned char* H; int ldc; float isc;
    __device__ __forceinline__ void operator()(const Acc& acc, const Unit& u, int wr, int wc, int fr, int fq) const {
        const int rowb = u.pm * BM + wr * 64 + fr + fq * 16, colb = (u.pn * BM + wc * 32) >> 1;
#pragma unroll
        for (int ai = 0; ai < 2; ++ai)
#pragma unroll
            for (int bj = 0; bj < 2; ++bj) { unsigned d[4];
#pragma unroll
                for (int m = 0; m < 4; ++m) { const f32x4 v0 = acc[ai][bj][m][0] * isc, v1 = acc[ai][bj][m][1] * isc;
                    const float h0 = v0[0] * sigmoidf_(v0[0]) * v0[1], h1 = v0[2] * sigmoidf_(v0[2]) * v0[3], h2 = v1[0] * sigmoidf_(v1[0]) * v1[1], h3 = v1[2] * sigmoidf_(v1[2]) * v1[3];
                    int w = __builtin_amdgcn_cvt_pk_fp8_f32(h0, h1, 0, false); w = __builtin_amdgcn_cvt_pk_fp8_f32(h2, h3, w, true); d[m] = (unsigned)w; }
                { const auto r = __builtin_amdgcn_permlane32_swap(d[0], d[2], false, false); d[0] = r[0]; d[2] = r[1]; }
                { const auto r = __builtin_amdgcn_permlane32_swap(d[1], d[3], false, false); d[1] = r[0]; d[3] = r[1]; }
                { const auto r = __builtin_amdgcn_permlane16_swap(d[0], d[1], false, false); d[0] = r[0]; d[1] = r[1]; }
                { const auto r = __builtin_amdgcn_permlane16_swap(d[2], d[3], false, false); d[2] = r[0]; d[3] = r[1]; }
                u32x4 q; q.x = d[0]; q.y = d[1]; q.z = d[2]; q.w = d[3];
                *(u32x4*)(H + (size_t)(rowb + ai * HALF) * ldc + colb + bj * (HALF / 2)) = q; }
    }
};

template <class Epi, class Sched, bool ALIGN_EPI = false, bool SP2 = false, int STAGGER_TICKS = 0>
__device__ __forceinline__ void gemm_phase(PG8_LAS unsigned char* lds, const Gemm g, const Sched& S, const Epi& E, const int tid_in) {
    int tid_ = tid_in; asm volatile("" : "+v"(tid_));
    const int tid = tid_, wid = __builtin_amdgcn_readfirstlane(tid >> 6), lane = tid & 63, wr = wid >> 2, wc = wid & 3, fr = lane & 15, fq = lane >> 4;
    int K_ = g.K; asm volatile("" : "+s"(K_)); const int K = K_, nt = K / BK;
    unsigned voffA[2], voffB[2];
#pragma unroll
    for (int i = 0; i < 2; ++i) { int R, C; stage_rc(tid * 16 + i * 8192, R, C); const int Rb = Epi::PERM ? ((R & ~31) + perm32(R & 31)) : R;
        voffA[i] = (unsigned)(R * K + C) * 2u; voffB[i] = (unsigned)(Rb * K + C) * 2u; }
    const size_t kstep = (size_t)(BK * 2);
    const size_t hstep = (size_t)HALF * K * 2;
    const size_t tstep = 2 * hstep;
    const unsigned ldsw = (unsigned)wid * 1024u;
    const int aoff = lds_byte(wr * 64 + fr, fq * 8), boff = lds_byte(wc * 32 + fr, fq * 8);
#define PG8_SA(b, h) (((b) * 2 + (h)) * HTB)
#define PG8_SB(b, h) ((4 + (b) * 2 + (h)) * HTB)
#define PG8_STAGE(bufoff, gbase, voff) do { _Pragma("unroll") for (int _i = 0; _i < 2; ++_i) \
        __builtin_amdgcn_global_load_lds((const unsigned*)((const char*)(gbase) + (voff)[_i]), (PG8_LAS unsigned*)(lds + (bufoff) + ldsw + _i * 8192), 16, 0, 0); } while (0)
#define PG8_LDA(dst, b, h) do { _Pragma("unroll") for (int m = 0; m < 4; ++m) _Pragma("unroll") for (int k = 0; k < 2; ++k) dst[m][k] = *(const PG8_LAS bf16x8*)(lds + PG8_SA(b, h) + aoff + m * 2048 + k * 1024); } while (0)
#define PG8_LDB(dst, b, h) do { _Pragma("unroll") for (int n = 0; n < 2; ++n) _Pragma("unroll") for (int k = 0; k < 2; ++k) dst[n][k] = *(const PG8_LAS bf16x8*)(lds + PG8_SB(b, h) + boff + n * 2048 + k * 1024); } while (0)
#define PG8_MMA(ai, bj, At, Bt) do { __builtin_amdgcn_s_setprio(1); _Pragma("unroll") for (int m = 0; m < 4; ++m) _Pragma("unroll") for (int n = 0; n < 2; ++n) _Pragma("unroll") for (int k = 0; k < 2; ++k) \
        acc[ai][bj][m][n] = __builtin_amdgcn_mfma_f32_16x16x32_bf16(Bt[n][k], At[m][k], acc[ai][bj][m][n], 0, 0, 0); __builtin_amdgcn_s_setprio(0); } while (0)
#define PG8_WAIT_V(n) asm volatile("s_waitcnt vmcnt(" #n ")" ::: "memory")
#define PG8_WAIT_L(n) asm volatile("s_waitcnt lgkmcnt(" #n ")" ::: "memory")
#define PG8_BAR __builtin_amdgcn_s_barrier()
#define PG8_SCHED __builtin_amdgcn_sched_barrier(0)
    Unit cur, nxt; int ui = 0;
    if (!S.next(0, cur)) return;
#if GEMM_STAGGER
    if (STAGGER_TICKS > 0 && ((blockIdx.x >> 3) & 1)) {
        const unsigned long long t0_ = __builtin_amdgcn_s_memrealtime(); while (__builtin_amdgcn_s_memrealtime() - t0_ < (unsigned long long)STAGGER_TICKS) __builtin_amdgcn_s_sleep(8); }
#endif
    f32x4 acc[2][2][4][2];
#pragma unroll
    for (int a = 0; a < 2; ++a)
#pragma unroll
        for (int b = 0; b < 2; ++b)
#pragma unroll
            for (int m = 0; m < 4; ++m)
#pragma unroll
                for (int n = 0; n < 2; ++n) acc[a][b][m][n] = (f32x4){0.f, 0.f, 0.f, 0.f};
    bf16x8 At[4][2], B0[2][2], B1[2][2];
    const char* cA = (const char*)g.A + (size_t)cur.pm * tstep; const char* cB = (const char*)g.Bt + (size_t)cur.pn * tstep + S.bofs(cur);
    S.a_ready(cur);
    if constexpr (SP2) {
        PG8_STAGE(PG8_SB(0, 0), cB, voffB); PG8_STAGE(PG8_SB(0, 1), cB + hstep, voffB); PG8_STAGE(PG8_SA(0, 0), cA, voffA); PG8_STAGE(PG8_SA(0, 1), cA + hstep, voffA);
        if (wr == 1) PG8_BAR;
        PG8_WAIT_V(2); PG8_BAR;
        PG8_STAGE(PG8_SB(1, 0), cB + kstep, voffB); PG8_STAGE(PG8_SA(1, 0), cA + kstep, voffA); PG8_STAGE(PG8_SB(1, 1), cB + hstep + kstep, voffB);
        PG8_WAIT_V(6); PG8_BAR;
    } else {
        PG8_STAGE(PG8_SB(0, 0), cB, voffB); PG8_STAGE(PG8_SA(0, 0), cA, voffA); PG8_STAGE(PG8_SB(0, 1), cB + hstep, voffB); PG8_STAGE(PG8_SA(0, 1), cA + hstep, voffA);
        if (wr == 1) PG8_BAR;
        PG8_WAIT_V(4); PG8_BAR;
        PG8_STAGE(PG8_SB(1, 0), cB + kstep, voffB); PG8_STAGE(PG8_SA(1, 0), cA + kstep, voffA); PG8_STAGE(PG8_SB(1, 1), cB + hstep + kstep, voffB);
        PG8_WAIT_V(6); PG8_BAR;
    }
    for (;;) {
        const bool has_next = S.next(ui + 1, nxt);
        const char* nA = has_next ? (const char*)g.A + (size_t)nxt.pm * tstep : cA; const char* nB = has_next ? (const char*)g.Bt + (size_t)nxt.pn * tstep + S.bofs(nxt) : cB;
#pragma nounroll
        for (int t = 0; t < nt; t += 2) {
            const bool last = (t == nt - 2);
            const char* a1 = cA + (size_t)(t + 1) * kstep;
            const char* a2 = last ? nA : cA + (size_t)(t + 2) * kstep; const char* b2 = last ? nB : cB + (size_t)(t + 2) * kstep;
            const char* a3 = a2 + kstep; const char* b3 = b2 + kstep;
            if (last && has_next) S.a_ready(nxt);
            if constexpr (SP2) {
            PG8_LDB(B0, 0, 0); PG8_LDB(B1, 0, 1); PG8_SCHED; PG8_LDA(At, 0, 0); PG8_STAGE(PG8_SA(1, 1), a1 + hstep, voffA);
            PG8_WAIT_V(8); PG8_WAIT_L(0); PG8_BAR; PG8_MMA(0, 0, At, B0); PG8_MMA(0, 1, At, B1); PG8_BAR; PG8_SCHED;
            PG8_LDA(At, 0, 1); PG8_STAGE(PG8_SB(0, 0), b2, voffB); PG8_STAGE(PG8_SB(0, 1), b2 + hstep, voffB); PG8_STAGE(PG8_SA(0, 0), a2, voffA);
            PG8_WAIT_V(8); PG8_WAIT_L(0); PG8_BAR; PG8_MMA(1, 0, At, B0); PG8_MMA(1, 1, At, B1); PG8_BAR; PG8_SCHED;
            PG8_LDB(B0, 1, 0); PG8_LDB(B1, 1, 1); PG8_SCHED; PG8_LDA(At, 1, 0); PG8_STAGE(PG8_SA(0, 1), a2 + hstep, voffA);
            PG8_WAIT_V(8); PG8_WAIT_L(0); PG8_BAR; PG8_MMA(0, 0, At, B0); PG8_MMA(0, 1, At, B1); PG8_BAR; PG8_SCHED;
            PG8_LDA(At, 1, 1); PG8_STAGE(PG8_SB(1, 0), b3, voffB); PG8_STAGE(PG8_SB(1, 1), b3 + hstep, voffB); PG8_STAGE(PG8_SA(1, 0), a3, voffA);
            PG8_WAIT_V(8); PG8_WAIT_L(0); PG8_BAR; PG8_MMA(1, 0, At, B0); PG8_MMA(1, 1, At, B1); PG8_BAR; PG8_SCHED;
            } else {
            PG8_LDB(B0, 0, 0); PG8_SCHED; PG8_LDA(At, 0, 0); PG8_STAGE(PG8_SA(1, 1), a1 + hstep, voffA);
            PG8_WAIT_L(8); PG8_BAR; PG8_WAIT_L(0); PG8_MMA(0, 0, At, B0); PG8_BAR; PG8_SCHED;
            PG8_LDB(B1, 0, 1); PG8_STAGE(PG8_SB(0, 0), b2, voffB);
            PG8_BAR; PG8_WAIT_L(0); PG8_MMA(0, 1, At, B1); PG8_BAR;
            PG8_LDA(At, 0, 1); PG8_STAGE(PG8_SA(0, 0), a2, voffA);
            PG8_BAR; PG8_WAIT_L(0); PG8_MMA(1, 0, At, B0); PG8_BAR; PG8_SCHED;
            PG8_STAGE(PG8_SB(0, 1), b2 + hstep, voffB);
            PG8_WAIT_V(6); PG8_BAR; PG8_MMA(1, 1, At, B1); PG8_BAR;
            PG8_LDB(B0, 1, 0); PG8_SCHED; PG8_LDA(At, 1, 0); PG8_STAGE(PG8_SA(0, 1), a2 + hstep, voffA);
            PG8_WAIT_L(8); PG8_BAR; PG8_WAIT_L(0); PG8_MMA(0, 0, At, B0); PG8_BAR; PG8_SCHED;
            PG8_LDB(B1, 1, 1); PG8_STAGE(PG8_SB(1, 0), b3, voffB);
            PG8_BAR; PG8_WAIT_L(0); PG8_MMA(0, 1, At, B1); PG8_BAR;
            PG8_LDA(At, 1, 1); PG8_STAGE(PG8_SA(1, 0), a3, voffA);
            PG8_BAR; PG8_WAIT_L(0); PG8_MMA(1, 0, At, B0); PG8_BAR; PG8_SCHED;
            PG8_STAGE(PG8_SB(1, 1), b3 + hstep, voffB);
            PG8_WAIT_V(6); PG8_BAR; PG8_MMA(1, 1, At, B1); PG8_BAR;
            }
        }
        if constexpr (ALIGN_EPI) { if (wr == 0) PG8_BAR; }
        if constexpr (!Epi::AFTER_DRAIN) { unsigned m1_ = ~0u; asm volatile("" : "+s"(m1_)); const int le_ = (int)__builtin_amdgcn_mbcnt_hi(m1_, __builtin_amdgcn_mbcnt_lo(m1_, 0u));
            E(acc, cur, wr, wc, le_ & 15, le_ >> 4); S.done(cur); }
        if (!has_next) break;
#pragma unroll
        for (int a = 0; a < 2; ++a)
#pragma unroll
            for (int b = 0; b < 2; ++b)
#pragma unroll
                for (int m = 0; m < 4; ++m)
#pragma unroll
                    for (int n = 0; n < 2; ++n) acc[a][b][m][n] = (f32x4){0.f, 0.f, 0.f, 0.f};
        cur = nxt; cA = nA; cB = nB; ++ui;
        if constexpr (ALIGN_EPI) { if (wr == 1) PG8_BAR; }
    }
    PG8_WAIT_V(0);
    if constexpr (!ALIGN_EPI) { if (wr == 0) PG8_BAR; }
    PG8_BAR;
    if constexpr (Epi::AFTER_DRAIN) { E.fused(acc, cur, wr, wc, fr, fq, lds, wid, lane); S.done(cur); }
#undef PG8_SA
#undef PG8_SB
#undef PG8_STAGE
#undef PG8_LDA
#undef PG8_LDB
#undef PG8_MMA
#undef PG8_WAIT_V
#undef PG8_WAIT_L
#undef PG8_BAR
#undef PG8_SCHED
}
typedef int i32x4_ __attribute__((ext_vector_type(4)));
typedef int i32x8_ __attribute__((ext_vector_type(8)));
template <class Epi, class Sched, bool ALIGN_EPI = false, bool SP2 = false, int STAGGER_TICKS = 0>
__device__ __forceinline__ void gemm_phase8(PG8_LAS unsigned char* lds, const Gemm g, const Sched& S, const Epi& E, const int sc1, const int tid_in) {
    int tid_ = tid_in; asm volatile("" : "+v"(tid_));
    const int tid = tid_, wid = __builtin_amdgcn_readfirstlane(tid >> 6), lane = tid & 63, wr = wid >> 2, wc = wid & 3, fr = lane & 15, fq = lane >> 4;
    int K_ = g.K; asm volatile("" : "+s"(K_)); const int K = K_, nt = K / BK;
    unsigned voffA[2], voffB[2];
#pragma unroll
    for (int i = 0; i < 2; ++i) { int R, C; stage_rc(tid * 16 + i * 8192, R, C); const int Rb = Epi::PERM ? ((R & ~31) + perm32(R & 31)) : R;
        voffA[i] = (unsigned)(R * K + C) * 2u; voffB[i] = (unsigned)(Rb * K + C) * 2u; }
    const size_t kstep = (size_t)(BK * 2);
    const size_t hstep = (size_t)HALF * K * 2;
    const size_t tstep = 2 * hstep;
    const unsigned ldsw = (unsigned)wid * 1024u;
    const int cq8 = (fq >> 1) * 32 + 16 * (fq & 1);
    const int aoff = lds_byte(wr * 64 + fr, cq8), boff = lds_byte(wc * 32 + fr, cq8);
#define PG8_SA(b, h) (((b) * 2 + (h)) * HTB)
#define PG8_SB(b, h) ((4 + (b) * 2 + (h)) * HTB)
#define PG8_STAGE(bufoff, gbase, voff) do { _Pragma("unroll") for (int _i = 0; _i < 2; ++_i) \
        __builtin_amdgcn_global_load_lds((const unsigned*)((const char*)(gbase) + (voff)[_i]), (PG8_LAS unsigned*)(lds + (bufoff) + ldsw + _i * 8192), 16, 0, 0); } while (0)
#define PG8_LD16(off) (*(const PG8_LAS i32x4_*)(lds + (off)))
#define PG8_LDA(dst, b, h) do { _Pragma("unroll") for (int m = 0; m < 4; ++m) dst[m] = __builtin_shufflevector(PG8_LD16(PG8_SA(b, h) + aoff + m * 2048), PG8_LD16(PG8_SA(b, h) + aoff + m * 2048 + 16), 0, 1, 2, 3, 4, 5, 6, 7); } while (0)
#define PG8_LDB(dst, b, h) do { _Pragma("unroll") for (int n = 0; n < 2; ++n) dst[n] = __builtin_shufflevector(PG8_LD16(PG8_SB(b, h) + boff + n * 2048), PG8_LD16(PG8_SB(b, h) + boff + n * 2048 + 16), 0, 1, 2, 3, 4, 5, 6, 7); } while (0)
#define PG8_MMA(ai, bj, At, Bt) do { __builtin_amdgcn_s_setprio(1); _Pragma("unroll") for (int m = 0; m < 4; ++m) _Pragma("unroll") for (int n = 0; n < 2; ++n) \
        asm volatile("v_mfma_scale_f32_16x16x128_f8f6f4 %0, %1, %2, %0, %3, %3 op_sel_hi:[0,0,0]" : "+v"(acc[ai][bj][m][n]) : "v"(Bt[n]), "v"(At[m]), "v"(sc1)); __builtin_amdgcn_s_setprio(0); } while (0)
#define PG8_WAIT_V(n) asm volatile("s_waitcnt vmcnt(" #n ")" ::: "memory")
#define PG8_WAIT_L(n) asm volatile("s_waitcnt lgkmcnt(" #n ")" ::: "memory")
#define PG8_BAR __builtin_amdgcn_s_barrier()
#define PG8_SCHED __builtin_amdgcn_sched_barrier(0)
    Unit cur, nxt; int ui = 0;
    if (!S.next(0, cur)) return;
#if GEMM_STAGGER
    if (STAGGER_TICKS > 0 && ((blockIdx.x >> 3) & 1)) {
        const unsigned long long t0_ = __builtin_amdgcn_s_memrealtime(); while (__builtin_amdgcn_s_memrealtime() - t0_ < (unsigned long long)STAGGER_TICKS) __builtin_amdgcn_s_sleep(8); }
#endif
    f32x4 acc[2][2][4][2];
#pragma unroll
    for (int a = 0; a < 2; ++a)
#pragma unroll
        for (int b = 0; b < 2; ++b)
#pragma unroll
            for (int m = 0; m < 4; ++m)
#pragma unroll
                for (int n = 0; n < 2; ++n) acc[a][b][m][n] = (f32x4){0.f, 0.f, 0.f, 0.f};
    i32x8_ At[4], B0[2], B1[2];
    const char* cA = (const char*)g.A + (size_t)cur.pm * tstep; const char* cB = (const char*)g.Bt + (size_t)cur.pn * tstep + S.bofs(cur);
    S.a_ready(cur);
    if constexpr (SP2) {
        PG8_STAGE(PG8_SB(0, 0), cB, voffB); PG8_STAGE(PG8_SB(0, 1), cB + hstep, voffB); PG8_STAGE(PG8_SA(0, 0), cA, voffA); PG8_STAGE(PG8_SA(0, 1), cA + hstep, voffA);
        if (wr == 1) PG8_BAR;
        PG8_WAIT_V(2); PG8_BAR;
        PG8_STAGE(PG8_SB(1, 0), cB + kstep, voffB); PG8_STAGE(PG8_SA(1, 0), cA + kstep, voffA); PG8_STAGE(PG8_SB(1, 1), cB + hstep + kstep, voffB);
        PG8_WAIT_V(6); PG8_BAR;
    } else {
        PG8_STAGE(PG8_SB(0, 0), cB, voffB); PG8_STAGE(PG8_SA(0, 0), cA, voffA); PG8_STAGE(PG8_SB(0, 1), cB + hstep, voffB); PG8_STAGE(PG8_SA(0, 1), cA + hstep, voffA);
        if (wr == 1) PG8_BAR;
        PG8_WAIT_V(4); PG8_BAR;
        PG8_STAGE(PG8_SB(1, 0), cB + kstep, voffB); PG8_STAGE(PG8_SA(1, 0), cA + kstep, voffA); PG8_STAGE(PG8_SB(1, 1), cB + hstep + kstep, voffB);
        PG8_WAIT_V(6); PG8_BAR;
    }
    for (;;) {
        const bool has_next = S.next(ui + 1, nxt);
        const char* nA = has_next ? (const char*)g.A + (size_t)nxt.pm * tstep : cA; const char* nB = has_next ? (const char*)g.Bt + (size_t)nxt.pn * tstep + S.bofs(nxt) : cB;
#pragma nounroll
        for (int t = 0; t < nt; t += 2) {
            const bool last = (t == nt - 2);
            const char* a1 = cA + (size_t)(t + 1) * kstep;
            const char* a2 = last ? nA : cA + (size_t)(t + 2) * kstep; const char* b2 = last ? nB : cB + (size_t)(t + 2) * kstep;
            const char* a3 = a2 + kstep; const char* b3 = b2 + kstep;
            if (last && has_next) S.a_ready(nxt);
            if constexpr (SP2) {
            PG8_LDB(B0, 0, 0); PG8_LDB(B1, 0, 1); PG8_SCHED; PG8_LDA(At, 0, 0); PG8_STAGE(PG8_SA(1, 1), a1 + hstep, voffA);
            PG8_WAIT_V(8); PG8_WAIT_L(0); PG8_BAR; PG8_MMA(0, 0, At, B0); PG8_MMA(0, 1, At, B1); PG8_BAR; PG8_SCHED;
            PG8_LDA(At, 0, 1); PG8_STAGE(PG8_SB(0, 0), b2, voffB); PG8_STAGE(PG8_SB(0, 1), b2 + hstep, voffB); PG8_STAGE(PG8_SA(0, 0), a2, voffA);
            PG8_WAIT_V(8); PG8_WAIT_L(0); PG8_BAR; PG8_MMA(1, 0, At, B0); PG8_MMA(1, 1, At, B1); PG8_BAR; PG8_SCHED;
            PG8_LDB(B0, 1, 0); PG8_LDB(B1, 1, 1); PG8_SCHED; PG8_LDA(At, 1, 0); PG8_STAGE(PG8_SA(0, 1), a2 + hstep, voffA);
            PG8_WAIT_V(8); PG8_WAIT_L(0); PG8_BAR; PG8_MMA(0, 0, At, B0); PG8_MMA(0, 1, At, B1); PG8_BAR; PG8_SCHED;
            PG8_LDA(At, 1, 1); PG8_STAGE(PG8_SB(1, 0), b3, voffB); PG8_STAGE(PG8_SB(1, 1), b3 + hstep, voffB); PG8_STAGE(PG8_SA(1, 0), a3, voffA);
            PG8_WAIT_V(8); PG8_WAIT_L(0); PG8_BAR; PG8_MMA(1, 0, At, B0); PG8_MMA(1, 1, At, B1); PG8_BAR; PG8_SCHED;
            } else {
            PG8_LDB(B0, 0, 0); PG8_SCHED; PG8_LDA(At, 0, 0); PG8_STAGE(PG8_SA(1, 1), a1 + hstep, voffA);
            PG8_WAIT_L(8); PG8_BAR; PG8_WAIT_L(0); PG8_MMA(0, 0, At, B0); PG8_BAR; PG8_SCHED;
            PG8_LDB(B1, 0, 1); PG8_STAGE(PG8_SB(0, 0), b2, voffB);
            PG8_BAR; PG8_WAIT_L(0); PG8_MMA(0, 1, At, B1); PG8_BAR;
            PG8_LDA(At, 0, 1); PG8_STAGE(PG8_SA(0, 0), a2, voffA);
            PG8_BAR; PG8_WAIT_L(0); PG8_MMA(1, 0, At, B0); PG8_BAR; PG8_SCHED;
            PG8_STAGE(PG8_SB(0, 1), b2 + hstep, voffB);
            PG8_WAIT_V(6); PG8_BAR; PG8_MMA(1, 1, At, B1); PG8_BAR;
            PG8_LDB(B0, 1, 0); PG8_SCHED; PG8_LDA(At, 1, 0); PG8_STAGE(PG8_SA(0, 1), a2 + hstep, voffA);
            PG8_WAIT_L(8); PG8_BAR; PG8_WAIT_L(0); PG8_MMA(0, 0, At, B0); PG8_BAR; PG8_SCHED;
            PG8_LDB(B1, 1, 1); PG8_STAGE(PG8_SB(1, 0), b3, voffB);
            PG8_BAR; PG8_WAIT_L(0); PG8_MMA(0, 1, At, B1); PG8_BAR;
            PG8_LDA(At, 1, 1); PG8_STAGE(PG8_SA(1, 0), a3, voffA);
            PG8_BAR; PG8_WAIT_L(0); PG8_MMA(1, 0, At, B0); PG8_BAR; PG8_SCHED;
            PG8_STAGE(PG8_SB(1, 1), b3 + hstep, voffB);
            PG8_WAIT_V(6); PG8_BAR; PG8_MMA(1, 1, At, B1); PG8_BAR;
            }
        }
        if constexpr (ALIGN_EPI) { if (wr == 0) PG8_BAR; }
        asm volatile("s_nop 15\n\ts_nop 15" ::: "memory");
        if constexpr (!Epi::AFTER_DRAIN) { unsigned m1_ = ~0u; asm volatile("" : "+s"(m1_)); const int le_ = (int)__builtin_amdgcn_mbcnt_hi(m1_, __builtin_amdgcn_mbcnt_lo(m1_, 0u));
            E(acc, cur, wr, wc, le_ & 15, le_ >> 4); S.done(cur); }
        if (!has_next) break;
#pragma unroll
        for (int a = 0; a < 2; ++a)
#pragma unroll
            for (int b = 0; b < 2; ++b)
#pragma unroll
                for (int m = 0; m < 4; ++m)
#pragma unroll
                    for (int n = 0; n < 2; ++n) acc[a][b][m][n] = (f32x4){0.f, 0.f, 0.f, 0.f};
        cur = nxt; cA = nA; cB = nB; ++ui;
        if constexpr (ALIGN_EPI) { if (wr == 1) PG8_BAR; }
    }
    PG8_WAIT_V(0);
    if constexpr (!ALIGN_EPI) { if (wr == 0) PG8_BAR; }
    PG8_BAR;
    if constexpr (Epi::AFTER_DRAIN) { E.fused(acc, cur, wr, wc, fr, fq, lds, wid, lane); S.done(cur); }
#undef PG8_SA
#undef PG8_SB
#undef PG8_STAGE
#undef PG8_LDA
#undef PG8_LD16
#undef PG8_LDB
#undef PG8_MMA
#undef PG8_WAIT_V
#undef PG8_WAIT_L
#undef PG8_BAR
#undef PG8_SCHED
}
}

namespace att {
#ifndef ATT_UNROLL_U
#define ATT_UNROLL_U "unroll 1"
#endif
#ifndef A6_VMASK
#define A6_VMASK 0x402
#endif
#ifndef ATT2_PINGPONG
#define ATT2_PINGPONG 1
#endif
#ifndef ATT_STATIC_PRIO
#define ATT_STATIC_PRIO 1
#endif
#ifndef ATT_PRIO
#define ATT_PRIO 0
#endif
#if ATT_PRIO
#define ATT_SETPRIO(x) __builtin_amdgcn_s_setprio(x)
#else
#define ATT_SETPRIO(x) do {} while (0)
#endif
#define MFMA32(a, b, c) __builtin_amdgcn_mfma_f32_32x32x16_bf16((a), (b), (c), 0, 0, 0)
typedef short v4i16_t __attribute__((ext_vector_type(4)));
struct AttnP {
    const bf16* Q; int ldq;
    const bf16* K1; int ldk1;
    const bf16* K2; int ldk2;
    const bf16* V; int ldv;
    bf16* O; int ldo;
    const int* pos;
    const int* blkmax;
    const float* lut;
    const bf16* TI; float lam, osc; const float* gsub;
};
__device__ __forceinline__ s16x4 vtr(const LAS unsigned char* p) { return __builtin_bit_cast(s16x4, __builtin_amdgcn_ds_read_tr16_b64_v4i16((LAS v4i16_t*)p)); }

template <int DQK, int KSPLIT, int DV, bool BIAS, int COMB = 0>
__device__ __forceinline__ void attn_unit(const AttnP& P, int b, int qt, int qcol, int kcol, int vcol, int ocol, int hb, LAS unsigned char* lds, const int tid_in) {
    constexpr int KROWB = DQK * 2 + 16;
    constexpr int VROWB = (DV == 128) ? 320 : 192;
    constexpr int KBYTES = 64 * KROWB, VBYTES = 64 * VROWB, STAGE = KBYTES + VBYTES + 256, LUT_OFF = 2 * STAGE;
    constexpr int ND = DQK / 16, NDB = DV / 32, KCH = DQK / 8, VCH = DV / 8, NKC = 64 * KCH, NVC = 64 * VCH, KL = (NKC + 511) / 512, VL = (NVC + 511) / 512;
    int tid_ = tid_in; asm volatile("" : "+v"(tid_));
    const int tid = tid_, lane = tid & 63, wid = __builtin_amdgcn_readfirstlane(tid >> 6), r = lane & 31, h = lane >> 5;
    const long tok0 = (long)b * SEQ; const int q0 = qt * 256; const int qrow = q0 + wid * 32 + r;
    bf16x8 qf[ND];
    { const bf16* qp = P.Q + (tok0 + qrow) * (long)P.ldq + qcol + 8 * h;
#pragma unroll
      for (int d = 0; d < ND; ++d) qf[d] = *(const bf16x8*)(qp + 16 * d); }
    int posq = 0, posq_min = 0;
    LAS float* lut = (LAS float*)(lds + LUT_OFF);
    if (BIAS) { posq = P.pos[tok0 + qrow]; int mn = posq;
#pragma unroll
        for (int o = 1; o < 64; o <<= 1) { const int t2 = shxi(mn, o, lane); mn = t2 < mn ? t2 : mn; }
        posq_min = mn;
        if (tid < 132) lut[tid] = P.lut[hb * 132 + tid]; }
    v4u kreg[KL], vreg[VL]; int preg = 0;
#define ATT_ISSUE(t) do { const long trow = tok0 + 64 * (long)(t); \
        _Pragma("unroll") for (int i = 0; i < KL; ++i) { const int c = tid + 512 * i; if (NKC % 512 == 0 || c < NKC) { const int row = c / KCH, col = (c % KCH) * 8; \
            const bf16* src = (col < KSPLIT) ? P.K1 + (trow + row) * (long)P.ldk1 + kcol + col : P.K2 + (trow + row) * (long)P.ldk2 + (col - KSPLIT); kreg[i] = *(const v4u*)src; } } \
        _Pragma("unroll") for (int i = 0; i < VL; ++i) { const int c = tid + 512 * i; if (NVC % 512 == 0 || c < NVC) { const int row = c / VCH, col = (c % VCH) * 8; vreg[i] = *(const v4u*)(P.V + (trow + row) * (long)P.ldv + vcol + col); } } \
        if (BIAS && tid < 64) preg = P.pos[trow + tid]; } while (0)
#define ATT_WRITE(t) do { LAS unsigned char* sb = lds + ((t) & 1) * STAGE; \
        _Pragma("unroll") for (int i = 0; i < KL; ++i) { const int c = tid + 512 * i; if (NKC % 512 == 0 || c < NKC) { const int row = c / KCH, cc = c % KCH; *(LAS v4u*)(sb + row * KROWB + cc * 16) = kreg[i]; } } \
        _Pragma("unroll") for (int i = 0; i < VL; ++i) { const int c = tid + 512 * i; if (NVC % 512 == 0 || c < NVC) { const int row = c / VCH, cc = c % VCH; *(LAS v4u*)(sb + KBYTES + row * VROWB + cc * 16) = vreg[i]; } } \
        if (BIAS && tid < 64) *(LAS int*)(sb + KBYTES + VBYTES + 4 * tid) = preg; } while (0)
    f32x16 o[NDB];
#pragma unroll
    for (int i = 0; i < NDB; ++i)
#pragma unroll
        for (int j = 0; j < 16; ++j) o[i][j] = 0.f;
    float m_run = 0.f, l_run = 0.f;
    const int ntiles = (q0 + 256) / 64, my_last = (q0 + wid * 32 + 31) / 64;
#if ATT_STATIC_PRIO
    if (wid >= 4) __builtin_amdgcn_s_setprio(1);
#endif
    ATT_ISSUE(0); ATT_WRITE(0); __syncthreads();
    const int kbase = r * KROWB + 16 * h;
    const int vbase = KBYTES + (4 * h + ((lane & 15) >> 2)) * VROWB + (((lane >> 4) & 1) * 16 + (lane & 3) * 4) * 2;
    for (int t = 0; t < ntiles; ++t) {
        const bool more = (t + 1 < ntiles);
        if (more) ATT_ISSUE(t + 1);
        if (t <= my_last) {
            const LAS unsigned char* sb = lds + (t & 1) * STAGE;
            bool plain = (64 * t + 63 <= q0 + wid * 32);
            float cinit = -m_run;
            if (BIAS) { const int kmax = P.blkmax[(int)(tok0 >> 6) + t]; if (plain && (posq_min - kmax >= 113)) cinit += lut[128]; else plain = false; }
            f32x16 x0, x1;
#pragma unroll
            for (int j = 0; j < 16; ++j) { x0[j] = cinit; x1[j] = cinit; }
            ATT_SETPRIO(1);
            { bf16x8 kf0[ND], kf1[ND];
#pragma unroll
              for (int d = 0; d < ND; ++d) { kf0[d] = *(const LAS bf16x8*)(sb + kbase + d * 32); kf1[d] = *(const LAS bf16x8*)(sb + kbase + 32 * KROWB + d * 32); }
              __builtin_amdgcn_sched_barrier(0);
#pragma unroll
              for (int d = 0; d < ND; ++d) { x0 = MFMA32(kf0[d], qf[d], x0); x1 = MFMA32(kf1[d], qf[d], x1); } }
            ATT_SETPRIO(0);
            if (!plain) {
#pragma unroll
                for (int g = 0; g < 4; ++g) {
                    int pk0[4] = {0, 0, 0, 0}, pk1[4] = {0, 0, 0, 0};
                    if (BIAS) { const LAS int* pp = (const LAS int*)(sb + KBYTES + VBYTES) + 8 * g + 4 * h;
                        const v4u a = *(const LAS v4u*)pp, c = *(const LAS v4u*)(pp + 32);
                        pk0[0] = a.x; pk0[1] = a.y; pk0[2] = a.z; pk0[3] = a.w; pk1[0] = c.x; pk1[1] = c.y; pk1[2] = c.z; pk1[3] = c.w; }
#pragma unroll
                    for (int j = 0; j < 4; ++j) { const int i = 4 * g + j; const int kidx = 64 * t + 8 * g + 4 * h + j;
                        float v0 = x0[i], v1 = x1[i];
                        if (BIAS) { int n0 = posq - pk0[j]; n0 = n0 < 0 ? 0 : (n0 > 128 ? 128 : n0); int n1 = posq - pk1[j]; n1 = n1 < 0 ? 0 : (n1 > 128 ? 128 : n1); v0 += lut[n0]; v1 += lut[n1]; }
                        if (kidx > qrow) v0 = -INFINITY; if (kidx + 32 > qrow) v1 = -INFINITY;
                        x0[i] = v0; x1[i] = v1; }
                }
            }
            float ma = fmaxf(fmaxf(x0[0], x0[1]), x0[2]), mb = fmaxf(fmaxf(x1[0], x1[1]), x1[2]);
#pragma unroll
            for (int j = 3; j < 15; j += 2) { ma = fmaxf(fmaxf(ma, x0[j]), x0[j + 1]); mb = fmaxf(fmaxf(mb, x1[j]), x1[j + 1]); }
            float mx = fmaxf(fmaxf(ma, mb), fmaxf(x0[15], x1[15]));
            { const auto rr = __builtin_amdgcn_permlane32_swap(__float_as_uint(mx), __float_as_uint(mx), false, false); mx = fmaxf(__uint_as_float(rr[0]), __uint_as_float(rr[1])); }
            if (t == 0 || __any(mx > 8.0f)) {
                const float delta = (t == 0) ? mx : fmaxf(mx, 0.f);
                if (t != 0) { const float alpha = __builtin_amdgcn_exp2f(-delta); l_run *= alpha;
#pragma unroll
                    for (int i = 0; i < NDB; ++i) o[i] = o[i] * alpha; }
                m_run += delta;
#pragma unroll
                for (int j = 0; j < 16; ++j) { x0[j] -= delta; x1[j] -= delta; }
            }
            f32x2 ls2 = {0.f, 0.f};
#pragma unroll
            for (int j = 0; j < 16; j += 2) { x0[j] = __builtin_amdgcn_exp2f(x0[j]); x0[j + 1] = __builtin_amdgcn_exp2f(x0[j + 1]); x1[j] = __builtin_amdgcn_exp2f(x1[j]); x1[j + 1] = __builtin_amdgcn_exp2f(x1[j + 1]);
                ls2 += (f32x2){x0[j], x0[j + 1]}; ls2 += (f32x2){x1[j], x1[j + 1]}; }
            l_run += ls2[0] + ls2[1];
            bf16x8 pf[4];
            { v4u w;
              w.x = pk2(x0[0], x0[1]); w.y = pk2(x0[2], x0[3]); w.z = pk2(x0[4], x0[5]); w.w = pk2(x0[6], x0[7]); pf[0] = __builtin_bit_cast(bf16x8, w);
              w.x = pk2(x0[8], x0[9]); w.y = pk2(x0[10], x0[11]); w.z = pk2(x0[12], x0[13]); w.w = pk2(x0[14], x0[15]); pf[1] = __builtin_bit_cast(bf16x8, w);
              w.x = pk2(x1[0], x1[1]); w.y = pk2(x1[2], x1[3]); w.z = pk2(x1[4], x1[5]); w.w = pk2(x1[6], x1[7]); pf[2] = __builtin_bit_cast(bf16x8, w);
              w.x = pk2(x1[8], x1[9]); w.y = pk2(x1[10], x1[11]); w.z = pk2(x1[12], x1[13]); w.w = pk2(x1[14], x1[15]); pf[3] = __builtin_bit_cast(bf16x8, w); }
            ATT_SETPRIO(1);
            { s16x4 vlo[2][4], vhi[2][4];
#define ATT_VLOAD(buf, db) do { _Pragma("unroll") for (int s = 0; s < 4; ++s) { vlo[buf][s] = vtr(sb + vbase + (16 * s) * VROWB + 64 * (db)); vhi[buf][s] = vtr(sb + vbase + (16 * s + 8) * VROWB + 64 * (db)); } } while (0)
              ATT_VLOAD(0, 0);
#pragma unroll
              for (int db = 0; db < NDB; ++db) {
                  if (db + 1 < NDB) ATT_VLOAD((db + 1) & 1, db + 1);
                  __builtin_amdgcn_sched_barrier(0);
#pragma unroll
                  for (int s = 0; s < 4; ++s) { const bf16x8 vf = __builtin_shufflevector(vlo[db & 1][s], vhi[db & 1][s], 0, 1, 2, 3, 4, 5, 6, 7); o[db] = MFMA32(vf, pf[s], o[db]); }
                  __builtin_amdgcn_sched_barrier(0);
              }
#undef ATT_VLOAD
            }
            ATT_SETPRIO(0);
        }
        if (more) ATT_WRITE(t + 1);
        __syncthreads();
    }
#undef ATT_ISSUE
#undef ATT_WRITE
#if ATT_STATIC_PRIO
    __builtin_amdgcn_s_setprio(0);
#endif
    const float lt = l_run + shx(l_run, 32, lane), inv = 1.0f / lt;
    if (COMB == 2) {
        const bf16* ip = P.TI + (tok0 + qrow) * (long)P.ldo + ocol + 4 * h; float ss = 0.f;
#pragma unroll
        for (int db = 0; db < NDB; ++db)
#pragma unroll
            for (int g = 0; g < 4; ++g) { const v2u a = *(const v2u*)(ip + 32 * db + 8 * g);
                const float c0 = bflo(a.x) - P.lam * (o[db][4 * g] * inv), c1 = bfhi(a.x) - P.lam * (o[db][4 * g + 1] * inv), c2 = bflo(a.y) - P.lam * (o[db][4 * g + 2] * inv), c3 = bfhi(a.y) - P.lam * (o[db][4 * g + 3] * inv);
                o[db][4 * g] = c0; o[db][4 * g + 1] = c1; o[db][4 * g + 2] = c2; o[db][4 * g + 3] = c3; ss += (c0 * c0 + c1 * c1) + (c2 * c2 + c3 * c3); }
        ss += shx(ss, 32, lane);
        const float rr = P.osc / sqrtf(ss * (1.0f / 128.0f) + LN_EPS);
        bf16* op = P.O + (tok0 + qrow) * (long)P.ldo + ocol + 4 * h;
#pragma unroll
        for (int db = 0; db < NDB; ++db)
#pragma unroll
            for (int g = 0; g < 4; ++g) { const f32x4 gg = *(const f32x4*)(P.gsub + 32 * db + 8 * g + 4 * h);
                v2u w; w.x = pk2(o[db][4 * g] * rr * gg[0], o[db][4 * g + 1] * rr * gg[1]); w.y = pk2(o[db][4 * g + 2] * rr * gg[2], o[db][4 * g + 3] * rr * gg[3]);
                *(v2u*)(op + 32 * db + 8 * g) = w; }
        return;
    }
    bf16* op = P.O + (tok0 + qrow) * (long)P.ldo + ocol + 4 * h;
#pragma unroll
    for (int db = 0; db < NDB; ++db)
#pragma unroll
        for (int g = 0; g < 4; ++g) { v2u w; w.x = pk2(o[db][4 * g] * inv, o[db][4 * g + 1] * inv); w.y = pk2(o[db][4 * g + 2] * inv, o[db][4 * g + 3] * inv);
            *(v2u*)(op + 32 * db + 8 * g) = w; }
}

template <int DQK, int KSPLIT, int DV, bool BIAS, int COMB = 0>
__device__ __forceinline__ void attn_unit6(const AttnP& P, int b, int qt, int qcol, int kcol, int vcol, int ocol, int hb, LAS unsigned char* lds, const int tid_in) {
    constexpr int KROWB = DQK * 2 + 16;
    constexpr int VROWB = (DV == 128) ? 320 : 192;
    constexpr int KBYTES = 64 * KROWB, VBYTES = 64 * VROWB, STAGE = KBYTES + VBYTES + 256, LUT_OFF = 2 * STAGE;
    constexpr int ND = DQK / 16, NDB = DV / 32, KCH = DQK / 8, VCH = DV / 8, NKC = 64 * KCH, NVC = 64 * VCH, KL = (NKC + 511) / 512, VL = (NVC + 511) / 512;
    int tid_ = tid_in; asm volatile("" : "+v"(tid_));
    const int tid = tid_, lane = tid & 63, wid = __builtin_amdgcn_readfirstlane(tid >> 6), r = lane & 31, h = lane >> 5;
    const long tok0 = (long)b * SEQ; const int q0 = qt * 256; const int qrow = q0 + wid * 32 + r;
    bf16x8 qf[ND];
    { const bf16* qp = P.Q + (tok0 + qrow) * (long)P.ldq + qcol + 8 * h;
#pragma unroll
      for (int d = 0; d < ND; ++d) qf[d] = *(const bf16x8*)(qp + 16 * d); }
    int posq = 0, posq_min = 0;
    LAS float* lut = (LAS float*)(lds + LUT_OFF);
    if (BIAS) { posq = P.pos[tok0 + qrow]; int mn = posq;
#pragma unroll
        for (int o = 1; o < 64; o <<= 1) { const int t2 = shxi(mn, o, lane); mn = t2 < mn ? t2 : mn; }
        posq_min = mn;
        if (tid < 132) lut[tid] = P.lut[hb * 132 + tid]; }
    v4u kreg[KL], vreg[VL]; int preg = 0;
#define ATT_ISSUE(t) do { const long trow = tok0 + 64 * (long)(t); \
        _Pragma("unroll") for (int i = 0; i < KL; ++i) { const int c = tid + 512 * i; if (NKC % 512 == 0 || c < NKC) { const int row = c / KCH, col = (c % KCH) * 8; \
            const bf16* src = (col < KSPLIT) ? P.K1 + (trow + row) * (long)P.ldk1 + kcol + col : P.K2 + (trow + row) * (long)P.ldk2 + (col - KSPLIT); kreg[i] = *(const v4u*)src; } } \
        _Pragma("unroll") for (int i = 0; i < VL; ++i) { const int c = tid + 512 * i; if (NVC % 512 == 0 || c < NVC) { const int row = c / VCH, col = (c % VCH) * 8; vreg[i] = *(const v4u*)(P.V + (trow + row) * (long)P.ldv + vcol + col); } } \
        if (BIAS && tid < 64) preg = P.pos[trow + tid]; } while (0)
#define ATT_WRITE(t) do { LAS unsigned char* sb = lds + ((t) & 1) * STAGE; \
        _Pragma("unroll") for (int i = 0; i < KL; ++i) { const int c = tid + 512 * i; if (NKC % 512 == 0 || c < NKC) { const int row = c / KCH, cc = c % KCH; *(LAS v4u*)(sb + row * KROWB + cc * 16) = kreg[i]; } } \
        _Pragma("unroll") for (int i = 0; i < VL; ++i) { const int c = tid + 512 * i; if (NVC % 512 == 0 || c < NVC) { const int row = c / VCH, cc = c % VCH; *(LAS v4u*)(sb + KBYTES + row * VROWB + cc * 16) = vreg[i]; } } \
        if (BIAS && tid < 64) *(LAS int*)(sb + KBYTES + VBYTES + 4 * tid) = preg; } while (0)
    f32x16 o[NDB];
#pragma unroll
    for (int i = 0; i < NDB; ++i)
#pragma unroll
        for (int j = 0; j < 16; ++j) o[i][j] = 0.f;
    float m_run = 0.f, l_run = 0.f;
    const int ntiles = (q0 + 256) / 64, my_last = (q0 + wid * 32 + 31) / 64;
#if ATT_STATIC_PRIO
    if (wid >= 4) __builtin_amdgcn_s_setprio(1);
#endif
    ATT_ISSUE(0); ATT_WRITE(0); __syncthreads();
    const int kbase = r * KROWB + 16 * h;
    const int vbase = KBYTES + (4 * h + ((lane & 15) >> 2)) * VROWB + (((lane >> 4) & 1) * 16 + (lane & 3) * 4) * 2;
    for (int t = 0; t < ntiles; ++t) {
        const bool more = (t + 1 < ntiles);
        if (more) ATT_ISSUE(t + 1);
        if (t <= my_last) {
            const LAS unsigned char* sb = lds + (t & 1) * STAGE;
            bool plain = (64 * t + 63 <= q0 + wid * 32);
            float cinit = -m_run;
            if (BIAS) { const int kmax = P.blkmax[(int)(tok0 >> 6) + t]; if (plain && (posq_min - kmax >= 113)) cinit += lut[128]; else plain = false; }
            f32x16 x0, x1;
#pragma unroll
            for (int j = 0; j < 16; ++j) { x0[j] = cinit; x1[j] = cinit; }
            ATT_SETPRIO(1);
            { bf16x8 kf0[ND], kf1[ND];
#pragma unroll
              for (int d = 0; d < ND; ++d) { kf0[d] = *(const LAS bf16x8*)(sb + kbase + d * 32); kf1[d] = *(const LAS bf16x8*)(sb + kbase + 32 * KROWB + d * 32); }
              __builtin_amdgcn_sched_barrier(0);
#pragma unroll
              for (int d = 0; d < ND; ++d) { x0 = MFMA32(kf0[d], qf[d], x0); x1 = MFMA32(kf1[d], qf[d], x1); } }
            ATT_SETPRIO(0);
            if (!plain) {
#pragma unroll
                for (int g = 0; g < 4; ++g) {
                    int pk0[4] = {0, 0, 0, 0}, pk1[4] = {0, 0, 0, 0};
                    if (BIAS) { const LAS int* pp = (const LAS int*)(sb + KBYTES + VBYTES) + 8 * g + 4 * h;
                        const v4u a = *(const LAS v4u*)pp, c = *(const LAS v4u*)(pp + 32);
                        pk0[0] = a.x; pk0[1] = a.y; pk0[2] = a.z; pk0[3] = a.w; pk1[0] = c.x; pk1[1] = c.y; pk1[2] = c.z; pk1[3] = c.w; }
#pragma unroll
                    for (int j = 0; j < 4; ++j) { const int i = 4 * g + j; const int kidx = 64 * t + 8 * g + 4 * h + j;
                        float v0 = x0[i], v1 = x1[i];
                        if (BIAS) { int n0 = posq - pk0[j]; n0 = n0 < 0 ? 0 : (n0 > 128 ? 128 : n0); int n1 = posq - pk1[j]; n1 = n1 < 0 ? 0 : (n1 > 128 ? 128 : n1); v0 += lut[n0]; v1 += lut[n1]; }
                        if (kidx > qrow) v0 = -INFINITY; if (kidx + 32 > qrow) v1 = -INFINITY;
                        x0[i] = v0; x1[i] = v1; }
                }
            }
            float ma = fmaxf(fmaxf(x0[0], x0[1]), x0[2]), mb = fmaxf(fmaxf(x1[0], x1[1]), x1[2]);
#pragma unroll
            for (int j = 3; j < 15; j += 2) { ma = fmaxf(fmaxf(ma, x0[j]), x0[j + 1]); mb = fmaxf(fmaxf(mb, x1[j]), x1[j + 1]); }
            float mx = fmaxf(fmaxf(ma, mb), fmaxf(x0[15], x1[15]));
            { const auto rr = __builtin_amdgcn_permlane32_swap(__float_as_uint(mx), __float_as_uint(mx), false, false); mx = fmaxf(__uint_as_float(rr[0]), __uint_as_float(rr[1])); }
            if (t == 0 || __any(mx > 8.0f)) {
                const float delta = (t == 0) ? mx : fmaxf(mx, 0.f);
                if (t != 0) { const float alpha = __builtin_amdgcn_exp2f(-delta); l_run *= alpha;
#pragma unroll
                    for (int i = 0; i < NDB; ++i) o[i] = o[i] * alpha; }
                m_run += delta;
#pragma unroll
                for (int j = 0; j < 16; ++j) { x0[j] -= delta; x1[j] -= delta; }
            }
            f32x2 ls2 = {0.f, 0.f};
            bf16x8 pf[4];
            s16x4 vl[2][NDB], vh[2][NDB];
#define A6_EXP(X, bb, PF) do { \
        X[bb + 0] = __builtin_amdgcn_exp2f(X[bb + 0]); X[bb + 1] = __builtin_amdgcn_exp2f(X[bb + 1]); X[bb + 2] = __builtin_amdgcn_exp2f(X[bb + 2]); X[bb + 3] = __builtin_amdgcn_exp2f(X[bb + 3]); \
        X[bb + 4] = __builtin_amdgcn_exp2f(X[bb + 4]); X[bb + 5] = __builtin_amdgcn_exp2f(X[bb + 5]); X[bb + 6] = __builtin_amdgcn_exp2f(X[bb + 6]); X[bb + 7] = __builtin_amdgcn_exp2f(X[bb + 7]); \
        ls2 += (f32x2){X[bb + 0], X[bb + 1]}; ls2 += (f32x2){X[bb + 2], X[bb + 3]}; ls2 += (f32x2){X[bb + 4], X[bb + 5]}; ls2 += (f32x2){X[bb + 6], X[bb + 7]}; \
        { v4u w_; w_.x = pk2(X[bb + 0], X[bb + 1]); w_.y = pk2(X[bb + 2], X[bb + 3]); w_.z = pk2(X[bb + 4], X[bb + 5]); w_.w = pk2(X[bb + 6], X[bb + 7]); PF = __builtin_bit_cast(bf16x8, w_); } } while (0)
#define A6_VLD(buf, ss) do { _Pragma("unroll") for (int db = 0; db < NDB; ++db) { vl[buf][db] = vtr(sb + vbase + (16 * (ss)) * VROWB + 64 * db); vh[buf][db] = vtr(sb + vbase + (16 * (ss) + 8) * VROWB + 64 * db); } } while (0)
#define A6_MMA(buf, ss) do { _Pragma("unroll") for (int db = 0; db < NDB; ++db) { const bf16x8 vf_ = __builtin_shufflevector(vl[buf][db], vh[buf][db], 0, 1, 2, 3, 4, 5, 6, 7); o[db] = MFMA32(vf_, pf[ss], o[db]); } } while (0)
#define A6_SGB(nv) do { _Pragma("unroll") for (int db = 0; db < NDB; ++db) { __builtin_amdgcn_sched_group_barrier(0x008, 1, 0); __builtin_amdgcn_sched_group_barrier(A6_VMASK, (nv), 0); __builtin_amdgcn_sched_group_barrier(0x100, 2, 0); } } while (0)
            A6_VLD(0, 0);
            A6_EXP(x0, 0, pf[0]);
            __builtin_amdgcn_sched_barrier(0);
            A6_VLD(1, 1); A6_EXP(x0, 8, pf[1]); A6_MMA(0, 0); A6_SGB(16 / NDB);
            __builtin_amdgcn_sched_barrier(0);
            A6_VLD(0, 2); A6_EXP(x1, 0, pf[2]); A6_MMA(1, 1); A6_SGB(16 / NDB);
            __builtin_amdgcn_sched_barrier(0);
            A6_VLD(1, 3); A6_EXP(x1, 8, pf[3]); A6_MMA(0, 2); A6_SGB(16 / NDB);
            __builtin_amdgcn_sched_barrier(0);
            A6_MMA(1, 3);
            __builtin_amdgcn_sched_barrier(0);
            l_run += ls2[0] + ls2[1];
#undef A6_EXP
#undef A6_VLD
#undef A6_MMA
#undef A6_SGB
            ATT_SETPRIO(0);
        }
        if (more) ATT_WRITE(t + 1);
        __syncthreads();
    }
#undef ATT_ISSUE
#undef ATT_WRITE
#if ATT_STATIC_PRIO
    __builtin_amdgcn_s_setprio(0);
#endif
    const float lt = l_run + shx(l_run, 32, lane), inv = 1.0f / lt;
    if (COMB == 2) {
        const bf16* ip = P.TI + (tok0 + qrow) * (long)P.ldo + ocol + 4 * h; float ss = 0.f;
#pragma unroll
        for (int db = 0; db < NDB; ++db)
#pragma unroll
            for (int g = 0; g < 4; ++g) { const v2u a = *(const v2u*)(ip + 32 * db + 8 * g);
                const float c0 = bflo(a.x) - P.lam * (o[db][4 * g] * inv), c1 = bfhi(a.x) - P.lam * (o[db][4 * g + 1] * inv), c2 = bflo(a.y) - P.lam * (o[db][4 * g + 2] * inv), c3 = bfhi(a.y) - P.lam * (o[db][4 * g + 3] * inv);
                o[db][4 * g] = c0; o[db][4 * g + 1] = c1; o[db][4 * g + 2] = c2; o[db][4 * g + 3] = c3; ss += (c0 * c0 + c1 * c1) + (c2 * c2 + c3 * c3); }
        ss += shx(ss, 32, lane);
        const float rr = P.osc / sqrtf(ss * (1.0f / 128.0f) + LN_EPS);
        bf16* op = P.O + (tok0 + qrow) * (long)P.ldo + ocol + 4 * h;
#pragma unroll
        for (int db = 0; db < NDB; ++db)
#pragma unroll
            for (int g = 0; g < 4; ++g) { const f32x4 gg = *(const f32x4*)(P.gsub + 32 * db + 8 * g + 4 * h);
                v2u w; w.x = pk2(o[db][4 * g] * rr * gg[0], o[db][4 * g + 1] * rr * gg[1]); w.y = pk2(o[db][4 * g + 2] * rr * gg[2], o[db][4 * g + 3] * rr * gg[3]);
                *(v2u*)(op + 32 * db + 8 * g) = w; }
        return;
    }
    bf16* op = P.O + (tok0 + qrow) * (long)P.ldo + ocol + 4 * h;
#pragma unroll
    for (int db = 0; db < NDB; ++db)
#pragma unroll
        for (int g = 0; g < 4; ++g) { v2u w; w.x = pk2(o[db][4 * g] * inv, o[db][4 * g + 1] * inv); w.y = pk2(o[db][4 * g + 2] * inv, o[db][4 * g + 3] * inv);
            *(v2u*)(op + 32 * db + 8 * g) = w; }
}

template <int DQK, int KSPLIT, int DV, bool BIAS, int COMB = 0>
__device__ __forceinline__ void attn_unit7(const AttnP& P, int b, int qt, int qcol, int kcol, int vcol, int ocol, int hb, LAS unsigned char* lds, const int tid_in) {
    constexpr int KROWB = DQK * 2 + 16;
    constexpr int VROWB = (DV == 128) ? 320 : 192;
    constexpr int KBYTES = 64 * KROWB, VBYTES = 64 * VROWB, STAGE = KBYTES + VBYTES + 256, LUT_OFF = 2 * STAGE;
    constexpr int ND = DQK / 16, NDB = DV / 32, KCH = DQK / 8, VCH = DV / 8, NKC = 64 * KCH, NVC = 64 * VCH, KL = (NKC + 511) / 512, VL = (NVC + 511) / 512;
    int tid_ = tid_in; asm volatile("" : "+v"(tid_));
    const int tid = tid_, lane = tid & 63, wid = __builtin_amdgcn_readfirstlane(tid >> 6), r = lane & 31, h = lane >> 5;
    const long tok0 = (long)b * SEQ; const int q0 = qt * 256; const int qrow = q0 + wid * 32 + r;
    bf16x8 qf[ND];
    { const bf16* qp = P.Q + (tok0 + qrow) * (long)P.ldq + qcol + 8 * h;
#pragma unroll
      for (int d = 0; d < ND; ++d) qf[d] = *(const bf16x8*)(qp + 16 * d); }
    int posq = 0, posq_min = 0;
    LAS float* lut = (LAS float*)(lds + LUT_OFF);
    if (BIAS) { posq = P.pos[tok0 + qrow]; int mn = posq;
#pragma unroll
        for (int o = 1; o < 64; o <<= 1) { const int t2 = shxi(mn, o, lane); mn = t2 < mn ? t2 : mn; }
        posq_min = mn;
        if (tid < 132) lut[tid] = P.lut[hb * 132 + tid] - P.lut[hb * 132 + 128]; }
    v4u kreg[KL], vreg[VL]; int preg = 0;
#define ATT_ISSUE(t) do { const long trow = tok0 + 64 * (long)(t); \
        _Pragma("unroll") for (int i = 0; i < KL; ++i) { const int c = tid + 512 * i; if (NKC % 512 == 0 || c < NKC) { const int row = c / KCH, col = (c % KCH) * 8; \
            const bf16* src = (col < KSPLIT) ? P.K1 + (trow + row) * (long)P.ldk1 + kcol + col : P.K2 + (trow + row) * (long)P.ldk2 + (col - KSPLIT); kreg[i] = *(const v4u*)src; } } \
        _Pragma("unroll") for (int i = 0; i < VL; ++i) { const int c = tid + 512 * i; if (NVC % 512 == 0 || c < NVC) { const int row = c / VCH, col = (c % VCH) * 8; vreg[i] = *(const v4u*)(P.V + (trow + row) * (long)P.ldv + vcol + col); } } \
        if (BIAS && tid < 64) preg = P.pos[trow + tid]; } while (0)
#define ATT_WRITE(t) do { LAS unsigned char* sb = lds + ((t) & 1) * STAGE; \
        _Pragma("unroll") for (int i = 0; i < KL; ++i) { const int c = tid + 512 * i; if (NKC % 512 == 0 || c < NKC) { const int row = c / KCH, cc = c % KCH; *(LAS v4u*)(sb + row * KROWB + cc * 16) = kreg[i]; } } \
        _Pragma("unroll") for (int i = 0; i < VL; ++i) { const int c = tid + 512 * i; if (NVC % 512 == 0 || c < NVC) { const int row = c / VCH, cc = c % VCH; *(LAS v4u*)(sb + KBYTES + row * VROWB + cc * 16) = vreg[i]; } } \
        if (BIAS && tid < 64) *(LAS int*)(sb + KBYTES + VBYTES + 4 * tid) = preg; } while (0)
    f32x16 o[NDB];
#pragma unroll
    for (int i = 0; i < NDB; ++i)
#pragma unroll
        for (int j = 0; j < 16; ++j) o[i][j] = 0.f;
    float m_run = 0.f, l_run = 0.f;
    f32x16 csp;
    { const float c0_ = BIAS ? P.lut[hb * 132 + 128] : 0.f;
#pragma unroll
      for (int j = 0; j < 16; ++j) csp[j] = c0_; }
    const int ntiles = (q0 + 256) / 64, my_last = (q0 + wid * 32 + 31) / 64;
#if ATT_STATIC_PRIO
    if (wid >= 4) __builtin_amdgcn_s_setprio(1);
#endif
    ATT_ISSUE(0); ATT_WRITE(0); __syncthreads();
    const int kbase = r * KROWB + 16 * h;
    const int vbase = KBYTES + (4 * h + ((lane & 15) >> 2)) * VROWB + (((lane >> 4) & 1) * 16 + (lane & 3) * 4) * 2;
    for (int t = 0; t < ntiles; ++t) {
        const bool more = (t + 1 < ntiles);
        if (more) ATT_ISSUE(t + 1);
        if (t <= my_last) {
            const LAS unsigned char* sb = lds + (t & 1) * STAGE;
            bool plain = (64 * t + 63 <= q0 + wid * 32);
            if (BIAS) { const int kmax = P.blkmax[(int)(tok0 >> 6) + t]; if (!(plain && (posq_min - kmax >= 113))) plain = false; }
            f32x16 x0 = csp, x1 = csp;
            ATT_SETPRIO(1);
            { bf16x8 kf0[ND], kf1[ND];
#pragma unroll
              for (int d = 0; d < ND; ++d) { kf0[d] = *(const LAS bf16x8*)(sb + kbase + d * 32); kf1[d] = *(const LAS bf16x8*)(sb + kbase + 32 * KROWB + d * 32); }
              __builtin_amdgcn_sched_barrier(0);
#pragma unroll
              for (int d = 0; d < ND; ++d) { x0 = MFMA32(kf0[d], qf[d], x0); x1 = MFMA32(kf1[d], qf[d], x1); } }
            ATT_SETPRIO(0);
            if (!plain) {
#pragma unroll
                for (int g = 0; g < 4; ++g) {
                    int pk0[4] = {0, 0, 0, 0}, pk1[4] = {0, 0, 0, 0};
                    if (BIAS) { const LAS int* pp = (const LAS int*)(sb + KBYTES + VBYTES) + 8 * g + 4 * h;
                        const v4u a = *(const LAS v4u*)pp, c = *(const LAS v4u*)(pp + 32);
                        pk0[0] = a.x; pk0[1] = a.y; pk0[2] = a.z; pk0[3] = a.w; pk1[0] = c.x; pk1[1] = c.y; pk1[2] = c.z; pk1[3] = c.w; }
#pragma unroll
                    for (int j = 0; j < 4; ++j) { const int i = 4 * g + j; const int kidx = 64 * t + 8 * g + 4 * h + j;
                        float v0 = x0[i], v1 = x1[i];
                        if (BIAS) { int n0 = posq - pk0[j]; n0 = n0 < 0 ? 0 : (n0 > 128 ? 128 : n0); int n1 = posq - pk1[j]; n1 = n1 < 0 ? 0 : (n1 > 128 ? 128 : n1); v0 += lut[n0]; v1 += lut[n1]; }
                        if (kidx > qrow) v0 = -INFINITY; if (kidx + 32 > qrow) v1 = -INFINITY;
                        x0[i] = v0; x1[i] = v1; }
                }
            }
            float ma = fmaxf(fmaxf(x0[0], x0[1]), x0[2]), mb = fmaxf(fmaxf(x1[0], x1[1]), x1[2]);
#pragma unroll
            for (int j = 3; j < 15; j += 2) { ma = fmaxf(fmaxf(ma, x0[j]), x0[j + 1]); mb = fmaxf(fmaxf(mb, x1[j]), x1[j + 1]); }
            float mx = fmaxf(fmaxf(ma, mb), fmaxf(x0[15], x1[15]));
            { const auto rr = __builtin_amdgcn_permlane32_swap(__float_as_uint(mx), __float_as_uint(mx), false, false); mx = fmaxf(__uint_as_float(rr[0]), __uint_as_float(rr[1])); }
            if (t == 0 || __any(mx > 8.0f)) {
                const float delta = (t == 0) ? mx : fmaxf(mx, 0.f);
                if (t != 0) { const float alpha = __builtin_amdgcn_exp2f(-delta); l_run *= alpha;
#pragma unroll
                    for (int i = 0; i < NDB; ++i) o[i] = o[i] * alpha; }
                m_run += delta;
#pragma unroll
                for (int j = 0; j < 16; ++j) { x0[j] -= delta; x1[j] -= delta; csp[j] -= delta; }
            }
            f32x2 ls2 = {0.f, 0.f};
            bf16x8 pf[4];
            s16x4 vl[2][NDB], vh[2][NDB];
#define A6_EXP(X, bb, PF) do { \
        X[bb + 0] = __builtin_amdgcn_exp2f(X[bb + 0]); X[bb + 1] = __builtin_amdgcn_exp2f(X[bb + 1]); X[bb + 2] = __builtin_amdgcn_exp2f(X[bb + 2]); X[bb + 3] = __builtin_amdgcn_exp2f(X[bb + 3]); \
        X[bb + 4] = __builtin_amdgcn_exp2f(X[bb + 4]); X[bb + 5] = __builtin_amdgcn_exp2f(X[bb + 5]); X[bb + 6] = __builtin_amdgcn_exp2f(X[bb + 6]); X[bb + 7] = __builtin_amdgcn_exp2f(X[bb + 7]); \
        ls2 += (f32x2){X[bb + 0], X[bb + 1]}; ls2 += (f32x2){X[bb + 2], X[bb + 3]}; ls2 += (f32x2){X[bb + 4], X[bb + 5]}; ls2 += (f32x2){X[bb + 6], X[bb + 7]}; \
        { v4u w_; w_.x = pk2(X[bb + 0], X[bb + 1]); w_.y = pk2(X[bb + 2], X[bb + 3]); w_.z = pk2(X[bb + 4], X[bb + 5]); w_.w = pk2(X[bb + 6], X[bb + 7]); PF = __builtin_bit_cast(bf16x8, w_); } } while (0)
#define A6_VLD(buf, ss) do { _Pragma("unroll") for (int db = 0; db < NDB; ++db) { vl[buf][db] = vtr(sb + vbase + (16 * (ss)) * VROWB + 64 * db); vh[buf][db] = vtr(sb + vbase + (16 * (ss) + 8) * VROWB + 64 * db); } } while (0)
#define A6_MMA(buf, ss) do { _Pragma("unroll") for (int db = 0; db < NDB; ++db) { const bf16x8 vf_ = __builtin_shufflevector(vl[buf][db], vh[buf][db], 0, 1, 2, 3, 4, 5, 6, 7); o[db] = MFMA32(vf_, pf[ss], o[db]); } } while (0)
#define A6_SGB(nv) do { _Pragma("unroll") for (int db = 0; db < NDB; ++db) { __builtin_amdgcn_sched_group_barrier(0x008, 1, 0); __builtin_amdgcn_sched_group_barrier(A6_VMASK, (nv), 0); __builtin_amdgcn_sched_group_barrier(0x100, 2, 0); } } while (0)
            A6_VLD(0, 0);
            A6_EXP(x0, 0, pf[0]);
            __builtin_amdgcn_sched_barrier(0);
            A6_VLD(1, 1); A6_EXP(x0, 8, pf[1]); A6_MMA(0, 0); A6_SGB(16 / NDB);
            __builtin_amdgcn_sched_barrier(0);
            A6_VLD(0, 2); A6_EXP(x1, 0, pf[2]); A6_MMA(1, 1); A6_SGB(16 / NDB);
            __builtin_amdgcn_sched_barrier(0);
            A6_VLD(1, 3); A6_EXP(x1, 8, pf[3]); A6_MMA(0, 2); A6_SGB(16 / NDB);
            __builtin_amdgcn_sched_barrier(0);
            A6_MMA(1, 3);
            __builtin_amdgcn_sched_barrier(0);
            l_run += ls2[0] + ls2[1];
#undef A6_EXP
#undef A6_VLD
#undef A6_MMA
#undef A6_SGB
            ATT_SETPRIO(0);
        }
        if (more) ATT_WRITE(t + 1);
        __syncthreads();
    }
#undef ATT_ISSUE
#undef ATT_WRITE
#if ATT_STATIC_PRIO
    __builtin_amdgcn_s_setprio(0);
#endif
    const float lt = l_run + shx(l_run, 32, lane), inv = 1.0f / lt;
    if (COMB == 2) {
        const bf16* ip = P.TI + (tok0 + qrow) * (long)P.ldo + ocol + 4 * h; float ss = 0.f;
#pragma unroll
        for (int db = 0; db < NDB; ++db)
#pragma unroll
            for (int g = 0; g < 4; ++g) { const v2u a = *(const v2u*)(ip + 32 * db + 8 * g);
                const float c0 = bflo(a.x) - P.lam * (o[db][4 * g] * inv), c1 = bfhi(a.x) - P.lam * (o[db][4 * g + 1] * inv), c2 = bflo(a.y) - P.lam * (o[db][4 * g + 2] * inv), c3 = bfhi(a.y) - P.lam * (o[db][4 * g + 3] * inv);
                o[db][4 * g] = c0; o[db][4 * g + 1] = c1; o[db][4 * g + 2] = c2; o[db][4 * g + 3] = c3; ss += (c0 * c0 + c1 * c1) + (c2 * c2 + c3 * c3); }
        ss += shx(ss, 32, lane);
        const float rr = P.osc / sqrtf(ss * (1.0f / 128.0f) + LN_EPS);
        bf16* op = P.O + (tok0 + qrow) * (long)P.ldo + ocol + 4 * h;
#pragma unroll
        for (int db = 0; db < NDB; ++db)
#pragma unroll
            for (int g = 0; g < 4; ++g) { const f32x4 gg = *(const f32x4*)(P.gsub + 32 * db + 8 * g + 4 * h);
                v2u w; w.x = pk2(o[db][4 * g] * rr * gg[0], o[db][4 * g + 1] * rr * gg[1]); w.y = pk2(o[db][4 * g + 2] * rr * gg[2], o[db][4 * g + 3] * rr * gg[3]);
                *(v2u*)(op + 32 * db + 8 * g) = w; }
        return;
    }
    bf16* op = P.O + (tok0 + qrow) * (long)P.ldo + ocol + 4 * h;
#pragma unroll
    for (int db = 0; db < NDB; ++db)
#pragma unroll
        for (int g = 0; g < 4; ++g) { v2u w; w.x = pk2(o[db][4 * g] * inv, o[db][4 * g + 1] * inv); w.y = pk2(o[db][4 * g + 2] * inv, o[db][4 * g + 3] * inv);
            *(v2u*)(op + 32 * db + 8 * g) = w; }
}

template <int DQK, int KSPLIT, int DV, bool BIAS, int COMB = 0>
__device__ __forceinline__ void attn_unit8(const AttnP& P, int b, int qt, int qcol, int kcol, int vcol, int ocol, int hb, LAS unsigned char* lds, const int tid_in) {
    constexpr int KROWB = DQK * 2 + 16;
    constexpr int VROWB = (DV == 128) ? 320 : 192;
    constexpr int KBYTES = 64 * KROWB, VBYTES = 64 * VROWB, STAGE = KBYTES + VBYTES + 256, LUT_OFF = 2 * STAGE;
    constexpr int ND = DQK / 16, NDB = DV / 32, KCH = DQK / 8, VCH = DV / 8, NKC = 64 * KCH, NVC = 64 * VCH, KL = (NKC + 511) / 512, VL = (NVC + 511) / 512;
    int tid_ = tid_in; asm volatile("" : "+v"(tid_));
    const int tid = tid_, lane = tid & 63, wid = __builtin_amdgcn_readfirstlane(tid >> 6), r = lane & 31, h = lane >> 5;
    const long tok0 = (long)b * SEQ; const int q0 = qt * 256; const int qrow = q0 + wid * 32 + r;
    bf16x8 qf[ND];
    { const bf16* qp = P.Q + (tok0 + qrow) * (long)P.ldq + qcol + 8 * h;
#pragma unroll
      for (int d = 0; d < ND; ++d) qf[d] = *(const bf16x8*)(qp + 16 * d); }
    int posq = 0, posq_min = 0;
    LAS float* lut = (LAS float*)(lds + LUT_OFF);
    if (BIAS) { posq = P.pos[tok0 + qrow]; int mn = posq;
#pragma unroll
        for (int o = 1; o < 64; o <<= 1) { const int t2 = shxi(mn, o, lane); mn = t2 < mn ? t2 : mn; }
        posq_min = mn;
        if (tid < 132) lut[tid] = P.lut[hb * 132 + tid] - P.lut[hb * 132 + 128]; }
    v4u kreg[KL], vreg[VL]; int preg = 0;
#define ATT_ISSUE(t) do { const long trow = tok0 + 64 * (long)(t); \
        _Pragma("unroll") for (int i = 0; i < KL; ++i) { const int c = tid + 512 * i; if (NKC % 512 == 0 || c < NKC) { const int row = c / KCH, col = (c % KCH) * 8; \
            const bf16* src = (col < KSPLIT) ? P.K1 + (trow + row) * (long)P.ldk1 + kcol + col : P.K2 + (trow + row) * (long)P.ldk2 + (col - KSPLIT); kreg[i] = *(const v4u*)src; } } \
        _Pragma("unroll") for (int i = 0; i < VL; ++i) { const int c = tid + 512 * i; if (NVC % 512 == 0 || c < NVC) { const int row = c / VCH, col = (c % VCH) * 8; vreg[i] = *(const v4u*)(P.V + (trow + row) * (long)P.ldv + vcol + col); } } \
        if (BIAS && tid < 64) preg = P.pos[trow + tid]; } while (0)
#define ATT_WRITE(t) do { LAS unsigned char* sb = lds + ((t) & 1) * STAGE; \
        _Pragma("unroll") for (int i = 0; i < KL; ++i) { const int c = tid + 512 * i; if (NKC % 512 == 0 || c < NKC) { const int row = c / KCH, cc = c % KCH; *(LAS v4u*)(sb + row * KROWB + cc * 16) = kreg[i]; } } \
        _Pragma("unroll") for (int i = 0; i < VL; ++i) { const int c = tid + 512 * i; if (NVC % 512 == 0 || c < NVC) { const int row = c / VCH, cc = c % VCH; *(LAS v4u*)(sb + KBYTES + row * VROWB + cc * 16) = vreg[i]; } } \
        if (BIAS && tid < 64) *(LAS int*)(sb + KBYTES + VBYTES + 4 * tid) = preg; } while (0)
    f32x16 o[NDB];
#pragma unroll
    for (int i = 0; i < NDB; ++i)
#pragma unroll
        for (int j = 0; j < 16; ++j) o[i][j] = 0.f;
    float m_run = 0.f, l_run = 0.f;
    f32x16 csp;
    { const float c0_ = BIAS ? P.lut[hb * 132 + 128] : 0.f;
#pragma unroll
      for (int j = 0; j < 16; ++j) csp[j] = c0_; }
    const int ntiles = (q0 + 256) / 64, my_last = (q0 + wid * 32 + 31) / 64;
#if ATT_STATIC_PRIO
    if (wid >= 4) __builtin_amdgcn_s_setprio(1);
#endif
    ATT_ISSUE(0); ATT_WRITE(0); __syncthreads();
    const int kbase = r * KROWB + 16 * h;
    const int vbase = KBYTES + (4 * h + ((lane & 15) >> 2)) * VROWB + (((lane >> 4) & 1) * 16 + (lane & 3) * 4) * 2;
    for (int t = 0; t < ntiles; ++t) {
        const bool more = (t + 1 < ntiles);
        if (more) ATT_ISSUE(t + 1);
        if (t <= my_last) {
            const LAS unsigned char* sb = lds + (t & 1) * STAGE;
            bool plain = (64 * t + 63 <= q0 + wid * 32);
            if (BIAS) { const int kmax = P.blkmax[(int)(tok0 >> 6) + t]; if (!(plain && (posq_min - kmax >= 113))) plain = false; }
            f32x16 x0 = csp, x1 = csp;
            ATT_SETPRIO(1);
            { bf16x8 kf0[ND], kf1[ND];
#pragma unroll
              for (int d = 0; d < ND; ++d) { kf0[d] = *(const LAS bf16x8*)(sb + kbase + d * 32); kf1[d] = *(const LAS bf16x8*)(sb + kbase + 32 * KROWB + d * 32); }
              __builtin_amdgcn_sched_barrier(0);
#pragma unroll
              for (int d = 0; d < ND; ++d) { x0 = MFMA32(kf0[d], qf[d], x0); x1 = MFMA32(kf1[d], qf[d], x1); } }
            ATT_SETPRIO(0);
            if (!plain) {
                const int qrel = qrow - 64 * t - 4 * h;
#pragma unroll
                for (int g = 0; g < 4; ++g) {
                    int pk0[4] = {0, 0, 0, 0}, pk1[4] = {0, 0, 0, 0};
                    if (BIAS) { const LAS int* pp = (const LAS int*)(sb + KBYTES + VBYTES) + 8 * g + 4 * h;
                        const v4u a = *(const LAS v4u*)pp, c = *(const LAS v4u*)(pp + 32);
                        pk0[0] = a.x; pk0[1] = a.y; pk0[2] = a.z; pk0[3] = a.w; pk1[0] = c.x; pk1[1] = c.y; pk1[2] = c.z; pk1[3] = c.w; }
#pragma unroll
                    for (int j = 0; j < 4; ++j) { const int i = 4 * g + j;
                        float v0 = x0[i], v1 = x1[i];
                        if (BIAS) { int n0 = posq - pk0[j]; n0 = n0 < 0 ? 0 : (n0 > 128 ? 128 : n0); int n1 = posq - pk1[j]; n1 = n1 < 0 ? 0 : (n1 > 128 ? 128 : n1); v0 += lut[n0]; v1 += lut[n1]; }
                        if (8 * g + j > qrel) v0 = -INFINITY; if (8 * g + j + 32 > qrel) v1 = -INFINITY;
                        x0[i] = v0; x1[i] = v1; }
                }
            }
            if (t == 0) {
                float ma = fmaxf(fmaxf(x0[0], x0[1]), x0[2]), mb = fmaxf(fmaxf(x1[0], x1[1]), x1[2]);
#pragma unroll
                for (int j = 3; j < 15; j += 2) { ma = fmaxf(fmaxf(ma, x0[j]), x0[j + 1]); mb = fmaxf(fmaxf(mb, x1[j]), x1[j + 1]); }
                float mx = fmaxf(fmaxf(ma, mb), fmaxf(x0[15], x1[15]));
                { const auto rr = __builtin_amdgcn_permlane32_swap(__float_as_uint(mx), __float_as_uint(mx), false, false); mx = fmaxf(__uint_as_float(rr[0]), __uint_as_float(rr[1])); }
                m_run += mx;
#pragma unroll
                for (int j = 0; j < 16; ++j) { x0[j] -= mx; x1[j] -= mx; csp[j] -= mx; }
            }
            f32x2 ls2 = {0.f, 0.f};
            bf16x8 pf[4];
            s16x4 vl[2][NDB], vh[2][NDB];
#define A6_EXP(X, bb, PF) do { \
        X[bb + 0] = __builtin_amdgcn_exp2f(X[bb + 0]); X[bb + 1] = __builtin_amdgcn_exp2f(X[bb + 1]); X[bb + 2] = __builtin_amdgcn_exp2f(X[bb + 2]); X[bb + 3] = __builtin_amdgcn_exp2f(X[bb + 3]); \
        X[bb + 4] = __builtin_amdgcn_exp2f(X[bb + 4]); X[bb + 5] = __builtin_amdgcn_exp2f(X[bb + 5]); X[bb + 6] = __builtin_amdgcn_exp2f(X[bb + 6]); X[bb + 7] = __builtin_amdgcn_exp2f(X[bb + 7]); \
        ls2 += (f32x2){X[bb + 0], X[bb + 1]}; ls2 += (f32x2){X[bb + 2], X[bb + 3]}; ls2 += (f32x2){X[bb + 4], X[bb + 5]}; ls2 += (f32x2){X[bb + 6], X[bb + 7]}; \
        { v4u w_; w_.x = pk2(X[bb + 0], X[bb + 1]); w_.y = pk2(X[bb + 2], X[bb + 3]); w_.z = pk2(X[bb + 4], X[bb + 5]); w_.w = pk2(X[bb + 6], X[bb + 7]); PF = __builtin_bit_cast(bf16x8, w_); } } while (0)
#define A6_VLD(buf, ss) do { _Pragma("unroll") for (int db = 0; db < NDB; ++db) { vl[buf][db] = vtr(sb + vbase + (16 * (ss)) * VROWB + 64 * db); vh[buf][db] = vtr(sb + vbase + (16 * (ss) + 8) * VROWB + 64 * db); } } while (0)
#define A6_MMA(buf, ss) do { _Pragma("unroll") for (int db = 0; db < NDB; ++db) { const bf16x8 vf_ = __builtin_shufflevector(vl[buf][db], vh[buf][db], 0, 1, 2, 3, 4, 5, 6, 7); o[db] = MFMA32(vf_, pf[ss], o[db]); } } while (0)
#define A6_SGB(nv) do { _Pragma("unroll") for (int db = 0; db < NDB; ++db) { __builtin_amdgcn_sched_group_barrier(0x008, 1, 0); __builtin_amdgcn_sched_group_barrier(A6_VMASK, (nv), 0); __builtin_amdgcn_sched_group_barrier(0x100, 2, 0); } } while (0)
            A6_VLD(0, 0);
            A6_EXP(x0, 0, pf[0]);
            __builtin_amdgcn_sched_barrier(0);
            A6_VLD(1, 1); A6_EXP(x0, 8, pf[1]); A6_MMA(0, 0); A6_SGB(16 / NDB);
            __builtin_amdgcn_sched_barrier(0);
            A6_VLD(0, 2); A6_EXP(x1, 0, pf[2]); A6_MMA(1, 1); A6_SGB(16 / NDB);
            __builtin_amdgcn_sched_barrier(0);
            A6_VLD(1, 3); A6_EXP(x1, 8, pf[3]); A6_MMA(0, 2); A6_SGB(16 / NDB);
            __builtin_amdgcn_sched_barrier(0);
            A6_MMA(1, 3);
            __builtin_amdgcn_sched_barrier(0);
            { const float ls = ls2[0] + ls2[1];
              l_run += ls;
              if (t != 0 && __any(ls > 256.0f)) {
                  float ma = fmaxf(fmaxf(x0[0], x0[1]), x0[2]), mb = fmaxf(fmaxf(x1[0], x1[1]), x1[2]);
#pragma unroll
                  for (int j = 3; j < 15; j += 2) { ma = fmaxf(fmaxf(ma, x0[j]), x0[j + 1]); mb = fmaxf(fmaxf(mb, x1[j]), x1[j + 1]); }
                  float mp = fmaxf(fmaxf(ma, mb), fmaxf(x0[15], x1[15]));
                  { const auto rr = __builtin_amdgcn_permlane32_swap(__float_as_uint(mp), __float_as_uint(mp), false, false); mp = fmaxf(__uint_as_float(rr[0]), __uint_as_float(rr[1])); }
                  const float delta = fmaxf(__builtin_amdgcn_logf(mp), 0.f), alpha = __builtin_amdgcn_exp2f(-delta);
                  l_run *= alpha; m_run += delta;
#pragma unroll
                  for (int i = 0; i < NDB; ++i) o[i] = o[i] * alpha;
#pragma unroll
                  for (int j = 0; j < 16; ++j) csp[j] -= delta;
              } }
#undef A6_EXP
#undef A6_VLD
#undef A6_MMA
#undef A6_SGB
            ATT_SETPRIO(0);
        }
        if (more) ATT_WRITE(t + 1);
        __syncthreads();
    }
#undef ATT_ISSUE
#undef ATT_WRITE
#if ATT_STATIC_PRIO
    __builtin_amdgcn_s_setprio(0);
#endif
    const float lt = l_run + shx(l_run, 32, lane), inv = 1.0f / lt;
    if (COMB == 2) {
        const bf16* ip = P.TI + (tok0 + qrow) * (long)P.ldo + ocol + 4 * h; float ss = 0.f;
#pragma unroll
        for (int db = 0; db < NDB; ++db)
#pragma unroll
            for (int g = 0; g < 4; ++g) { const v2u a = *(const v2u*)(ip + 32 * db + 8 * g);
                const float c0 = bflo(a.x) - P.lam * (o[db][4 * g] * inv), c1 = bfhi(a.x) - P.lam * (o[db][4 * g + 1] * inv), c2 = bflo(a.y) - P.lam * (o[db][4 * g + 2] * inv), c3 = bfhi(a.y) - P.lam * (o[db][4 * g + 3] * inv);
                o[db][4 * g] = c0; o[db][4 * g + 1] = c1; o[db][4 * g + 2] = c2; o[db][4 * g + 3] = c3; ss += (c0 * c0 + c1 * c1) + (c2 * c2 + c3 * c3); }
        ss += shx(ss, 32, lane);
        const float rr = P.osc / sqrtf(ss * (1.0f / 128.0f) + LN_EPS);
        bf16* op = P.O + (tok0 + qrow) * (long)P.ldo + ocol + 4 * h;
#pragma unroll
        for (int db = 0; db < NDB; ++db)
#pragma unroll
            for (int g = 0; g < 4; ++g) { const f32x4 gg = *(const f32x4*)(P.gsub + 32 * db + 8 * g + 4 * h);
                v2u w; w.x = pk2(o[db][4 * g] * rr * gg[0], o[db][4 * g + 1] * rr * gg[1]); w.y = pk2(o[db][4 * g + 2] * rr * gg[2], o[db][4 * g + 3] * rr * gg[3]);
                *(v2u*)(op + 32 * db + 8 * g) = w; }
        return;
    }
    bf16* op = P.O + (tok0 + qrow) * (long)P.ldo + ocol + 4 * h;
#pragma unroll
    for (int db = 0; db < NDB; ++db)
#pragma unroll
        for (int g = 0; g < 4; ++g) { v2u w; w.x = pk2(o[db][4 * g] * inv, o[db][4 * g + 1] * inv); w.y = pk2(o[db][4 * g + 2] * inv, o[db][4 * g + 3] * inv);
            *(v2u*)(op + 32 * db + 8 * g) = w; }
}

template <int DQK, int KSPLIT, int DV, bool BIAS, int COMB = 0, int VAR = 0>
__device__ __forceinline__ void attn_unit10(const AttnP& P, int b, int qt, int qcol, int kcol, int vcol, int ocol, int hb, LAS unsigned char* lds, const int tid_in) {
    constexpr int KROWB = DQK * 2 + 16;
    constexpr int VROWB = (DV == 128) ? 320 : 192;
    constexpr int KBYTES = 64 * KROWB, VBYTES = 64 * VROWB, STAGE = KBYTES + VBYTES + 256, LUT_OFF = 4 * STAGE;
    constexpr int ND = DQK / 16, NDB = DV / 32, KCH = DQK / 8, VCH = DV / 8, NKC = 64 * KCH, NVC = 64 * VCH, KL = (NKC + 511) / 512, VL = (NVC + 511) / 512;
    int tid_ = tid_in; asm volatile("" : "+v"(tid_));
    const int tid = tid_, lane = tid & 63, wid = __builtin_amdgcn_readfirstlane(tid >> 6), r = lane & 31, h = lane >> 5;
    const long tok0 = (long)b * SEQ; const int q0 = qt * 256; const int qrow = q0 + wid * 32 + r;
    v4u kregA[KL], vregA[VL], kregB[KL], vregB[VL]; int pregA = 0, pregB = 0;
#define ATT_ISSUE1(t, kreg, vreg, preg) do { const long trow = tok0 + 64 * (long)(t); \
        _Pragma("unroll") for (int i = 0; i < KL; ++i) { const int c = tid + 512 * i; if (NKC % 512 == 0 || c < NKC) { const int row = c / KCH, col = (c % KCH) * 8; \
            const bf16* src = (col < KSPLIT) ? P.K1 + (trow + row) * (long)P.ldk1 + kcol + col : P.K2 + (trow + row) * (long)P.ldk2 + (col - KSPLIT); kreg[i] = *(const v4u*)src; } } \
        _Pragma("unroll") for (int i = 0; i < VL; ++i) { const int c = tid + 512 * i; if (NVC % 512 == 0 || c < NVC) { const int row = c / VCH, col = (c % VCH) * 8; vreg[i] = *(const v4u*)(P.V + (trow + row) * (long)P.ldv + vcol + col); } } \
        if (BIAS && tid < 64) preg = P.pos[trow + tid]; } while (0)
#define ATT_WRITE1(t, kreg, vreg, preg) do { LAS unsigned char* sb = lds + ((t) & 3) * STAGE; \
        _Pragma("unroll") for (int i = 0; i < KL; ++i) { const int c = tid + 512 * i; if (NKC % 512 == 0 || c < NKC) { const int row = c / KCH, cc = c % KCH; *(LAS v4u*)(sb + row * KROWB + cc * 16) = kreg[i]; } } \
        _Pragma("unroll") for (int i = 0; i < VL; ++i) { const int c = tid + 512 * i; if (NVC % 512 == 0 || c < NVC) { const int row = c / VCH, cc = c % VCH; *(LAS v4u*)(sb + KBYTES + row * VROWB + cc * 16) = vreg[i]; } } \
        if (BIAS && tid < 64) *(LAS int*)(sb + KBYTES + VBYTES + 4 * tid) = preg; } while (0)
#define ATT_ISSUE(T2) do { ATT_ISSUE1(2 * (T2), kregA, vregA, pregA); ATT_ISSUE1(2 * (T2) + 1, kregB, vregB, pregB); } while (0)
#define ATT_WRITE(T2) do { ATT_WRITE1(2 * (T2), kregA, vregA, pregA); ATT_WRITE1(2 * (T2) + 1, kregB, vregB, pregB); } while (0)
    ATT_ISSUE(0);
    bf16x8 qf[ND];
    { const bf16* qp = P.Q + (tok0 + qrow) * (long)P.ldq + qcol + 8 * h;
#pragma unroll
      for (int d = 0; d < ND; ++d) qf[d] = *(const bf16x8*)(qp + 16 * d); }
    int posq = 0, posq_min = 0;
    LAS float* lut = (LAS float*)(lds + LUT_OFF); LAS int* bmx = (LAS int*)(lds + LUT_OFF + 1024);
    if (BIAS) { posq = P.pos[tok0 + qrow]; int mn = posq;
#pragma unroll
        for (int o = 1; o < 64; o <<= 1) { const int t2 = shxi(mn, o, lane); mn = t2 < mn ? t2 : mn; }
        posq_min = mn;
        { float lv_ = 0.f, l128_ = 0.f; int bv_ = 0;
          if (tid < 132) { lv_ = P.lut[hb * 132 + tid]; l128_ = P.lut[hb * 132 + 128]; }
          if (tid >= 192 && tid < 256) bv_ = P.blkmax[(int)(tok0 >> 6) + (tid - 192)];
          if (tid < 132) lut[tid] = lv_ - l128_;
          if (tid >= 192 && tid < 256) bmx[tid - 192] = bv_; } }
    f32x16 o[NDB];
#pragma unroll
    for (int i = 0; i < NDB; ++i)
#pragma unroll
        for (int j = 0; j < 16; ++j) o[i][j] = 0.f;
    float m_run = 0.f, l_run = 0.f;
    f32x16 csp;
    { const float c0_ = BIAS ? P.lut[hb * 132 + 128] : 0.f;
#pragma unroll
      for (int j = 0; j < 16; ++j) csp[j] = c0_; }
    const int ntiles = (q0 + 256) / 64, my_last = (q0 + wid * 32 + 31) / 64;
#if ATT_STATIC_PRIO
    if (wid >= 4) __builtin_amdgcn_s_setprio(1);
#endif
    ATT_WRITE(0); __syncthreads();
    const int kbase = r * KROWB + 16 * h;
    const int vbase = KBYTES + (4 * h + ((lane & 15) >> 2)) * VROWB + (((lane >> 4) & 1) * 16 + (lane & 3) * 4) * 2;
    for (int T2 = 0; T2 < ntiles / 2; ++T2) {
        const bool more = (2 * T2 + 2 < ntiles);
        if (more && !(VAR & 8)) ATT_ISSUE(T2 + 1);
#pragma unroll 1
        for (int u_ = 0; u_ < 2; ++u_) {
        const int t = 2 * T2 + u_;
        if (t <= my_last) {
            const LAS unsigned char* sb = lds + (t & 3) * STAGE;
            bool plain = (64 * t + 63 <= q0 + wid * 32);
            if (BIAS) { const int kmax = bmx[t]; if (!(plain && (posq_min - kmax >= 113))) plain = false; }
            f32x16 x0 = csp, x1 = csp;
            ATT_SETPRIO(1);
            if (!(VAR & 4)) { bf16x8 kf0[ND], kf1[ND];
#pragma unroll
              for (int d = 0; d < ND; ++d) { kf0[d] = *(const LAS bf16x8*)(sb + kbase + d * 32); kf1[d] = *(const LAS bf16x8*)(sb + kbase + 32 * KROWB + d * 32); }
              __builtin_amdgcn_sched_barrier(0);
#pragma unroll
              for (int d = 0; d < ND; ++d) { x0 = MFMA32(kf0[d], qf[d], x0); x1 = MFMA32(kf1[d], qf[d], x1); } }
            ATT_SETPRIO(0);
            if (!plain) {
                const int qrel = qrow - 64 * t - 4 * h;
#pragma unroll
                for (int g = 0; g < 4; ++g) {
                    int pk0[4] = {0, 0, 0, 0}, pk1[4] = {0, 0, 0, 0};
                    if (BIAS) { const LAS int* pp = (const LAS int*)(sb + KBYTES + VBYTES) + 8 * g + 4 * h;
                        const v4u a = *(const LAS v4u*)pp, c = *(const LAS v4u*)(pp + 32);
                        pk0[0] = a.x; pk0[1] = a.y; pk0[2] = a.z; pk0[3] = a.w; pk1[0] = c.x; pk1[1] = c.y; pk1[2] = c.z; pk1[3] = c.w; }
#pragma unroll
                    for (int j = 0; j < 4; ++j) { const int i = 4 * g + j;
                        float v0 = x0[i], v1 = x1[i];
                        if (BIAS) { int n0 = posq - pk0[j]; n0 = n0 < 0 ? 0 : (n0 > 128 ? 128 : n0); int n1 = posq - pk1[j]; n1 = n1 < 0 ? 0 : (n1 > 128 ? 128 : n1); v0 += lut[n0]; v1 += lut[n1]; }
                        if (8 * g + j > qrel) v0 = -INFINITY; if (8 * g + j + 32 > qrel) v1 = -INFINITY;
                        x0[i] = v0; x1[i] = v1; }
                }
            }
            if (t == 0) {
                float ma = fmaxf(fmaxf(x0[0], x0[1]), x0[2]), mb = fmaxf(fmaxf(x1[0], x1[1]), x1[2]);
#pragma unroll
                for (int j = 3; j < 15; j += 2) { ma = fmaxf(fmaxf(ma, x0[j]), x0[j + 1]); mb = fmaxf(fmaxf(mb, x1[j]), x1[j + 1]); }
                float mx = fmaxf(fmaxf(ma, mb), fmaxf(x0[15], x1[15]));
                { const auto rr = __builtin_amdgcn_permlane32_swap(__float_as_uint(mx), __float_as_uint(mx), false, false); mx = fmaxf(__uint_as_float(rr[0]), __uint_as_float(rr[1])); }
                m_run += mx;
#pragma unroll
                for (int j = 0; j < 16; ++j) { x0[j] -= mx; x1[j] -= mx; csp[j] -= mx; }
            }
            f32x2 ls2 = {0.f, 0.f};
            bf16x8 pf[4];
            s16x4 vl[2][NDB], vh[2][NDB];
#define A6_E2(v_) ((VAR & 1) ? (v_) : __builtin_amdgcn_exp2f(v_))
#define A6_EXP(X, bb, PF) do { \
        X[bb + 0] = A6_E2(X[bb + 0]); X[bb + 1] = A6_E2(X[bb + 1]); X[bb + 2] = A6_E2(X[bb + 2]); X[bb + 3] = A6_E2(X[bb + 3]); \
        X[bb + 4] = A6_E2(X[bb + 4]); X[bb + 5] = A6_E2(X[bb + 5]); X[bb + 6] = A6_E2(X[bb + 6]); X[bb + 7] = A6_E2(X[bb + 7]); \
        ls2 += (f32x2){X[bb + 0], X[bb + 1]}; ls2 += (f32x2){X[bb + 2], X[bb + 3]}; ls2 += (f32x2){X[bb + 4], X[bb + 5]}; ls2 += (f32x2){X[bb + 6], X[bb + 7]}; \
        { v4u w_; w_.x = pk2(X[bb + 0], X[bb + 1]); w_.y = pk2(X[bb + 2], X[bb + 3]); w_.z = pk2(X[bb + 4], X[bb + 5]); w_.w = pk2(X[bb + 6], X[bb + 7]); PF = __builtin_bit_cast(bf16x8, w_); } } while (0)
#define A6_VLD(buf, ss) do { _Pragma("unroll") for (int db = 0; db < NDB; ++db) { vl[buf][db] = vtr(sb + vbase + (16 * (ss)) * VROWB + 64 * db); vh[buf][db] = vtr(sb + vbase + (16 * (ss) + 8) * VROWB + 64 * db); } } while (0)
#define A6_MMA(buf, ss) do { if (VAR & 2) break; _Pragma("unroll") for (int db = 0; db < NDB; ++db) { const bf16x8 vf_ = __builtin_shufflevector(vl[buf][db], vh[buf][db], 0, 1, 2, 3, 4, 5, 6, 7); o[db] = MFMA32(vf_, pf[ss], o[db]); } } while (0)
#define A6_SGB(nv) do { _Pragma("unroll") for (int db = 0; db < NDB; ++db) { __builtin_amdgcn_sched_group_barrier(0x008, 1, 0); __builtin_amdgcn_sched_group_barrier(A6_VMASK, (nv), 0); __builtin_amdgcn_sched_group_barrier(0x100, 2, 0); } } while (0)
            A6_VLD(0, 0);
            A6_EXP(x0, 0, pf[0]);
            __builtin_amdgcn_sched_barrier(0);
            A6_VLD(1, 1); A6_EXP(x0, 8, pf[1]); A6_MMA(0, 0); A6_SGB(16 / NDB);
            __builtin_amdgcn_sched_barrier(0);
            A6_VLD(0, 2); A6_EXP(x1, 0, pf[2]); A6_MMA(1, 1); A6_SGB(16 / NDB);
            __builtin_amdgcn_sched_barrier(0);
            A6_VLD(1, 3); A6_EXP(x1, 8, pf[3]); A6_MMA(0, 2); A6_SGB(16 / NDB);
            __builtin_amdgcn_sched_barrier(0);
            A6_MMA(1, 3);
            __builtin_amdgcn_sched_barrier(0);
            { const float ls = ls2[0] + ls2[1];
              l_run += ls;
              if (t != 0 && __any(ls > 256.0f)) {
                  float ma = fmaxf(fmaxf(x0[0], x0[1]), x0[2]), mb = fmaxf(fmaxf(x1[0], x1[1]), x1[2]);
#pragma unroll
                  for (int j = 3; j < 15; j += 2) { ma = fmaxf(fmaxf(ma, x0[j]), x0[j + 1]); mb = fmaxf(fmaxf(mb, x1[j]), x1[j + 1]); }
                  float mp = fmaxf(fmaxf(ma, mb), fmaxf(x0[15], x1[15]));
                  { const auto rr = __builtin_amdgcn_permlane32_swap(__float_as_uint(mp), __float_as_uint(mp), false, false); mp = fmaxf(__uint_as_float(rr[0]), __uint_as_float(rr[1])); }
                  const float delta = fmaxf(__builtin_amdgcn_logf(mp), 0.f), alpha = __builtin_amdgcn_exp2f(-delta);
                  l_run *= alpha; m_run += delta;
#pragma unroll
                  for (int i = 0; i < NDB; ++i) o[i] = o[i] * alpha;
#pragma unroll
                  for (int j = 0; j < 16; ++j) csp[j] -= delta;
              } }
#undef A6_EXP
#undef A6_E2
#undef A6_VLD
#undef A6_MMA
#undef A6_SGB
            ATT_SETPRIO(0);
        }
        }
        if (more && !(VAR & 8)) ATT_WRITE(T2 + 1);
        if (!(VAR & 16)) __syncthreads();
    }
#undef ATT_ISSUE
#undef ATT_ISSUE1
#undef ATT_WRITE
#undef ATT_WRITE1
#if ATT_STATIC_PRIO
    __builtin_amdgcn_s_setprio(0);
#endif
    const float lt = l_run + shx(l_run, 32, lane), inv = 1.0f / lt;
#define A10_SWAP(A_, B_) do { const auto r0_ = __builtin_amdgcn_permlane32_swap((A_).x, (B_).x, false, false); (A_).x = r0_[0]; (B_).x = r0_[1]; \
                              const auto r1_ = __builtin_amdgcn_permlane32_swap((A_).y, (B_).y, false, false); (A_).y = r1_[0]; (B_).y = r1_[1]; } while (0)
    const long rowoff = (tok0 + qrow) * (long)P.ldo + ocol + 8 * h;
    if (COMB == 2) {
        const bf16* ip = P.TI + rowoff; float ss = 0.f;
#pragma unroll
        for (int db = 0; db < NDB; ++db)
#pragma unroll
            for (int gp = 0; gp < 2; ++gp) { const v4u q = *(const v4u*)(ip + 32 * db + 16 * gp); v2u a, c; a.x = q.x; a.y = q.y; c.x = q.z; c.y = q.w; A10_SWAP(a, c);
#pragma unroll
                for (int e = 0; e < 2; ++e) { const int g = 2 * gp + e; const v2u t = e ? c : a;
                    const float c0 = bflo(t.x) - P.lam * (o[db][4 * g] * inv), c1 = bfhi(t.x) - P.lam * (o[db][4 * g + 1] * inv), c2 = bflo(t.y) - P.lam * (o[db][4 * g + 2] * inv), c3 = bfhi(t.y) - P.lam * (o[db][4 * g + 3] * inv);
                    o[db][4 * g] = c0; o[db][4 * g + 1] = c1; o[db][4 * g + 2] = c2; o[db][4 * g + 3] = c3; ss += (c0 * c0 + c1 * c1) + (c2 * c2 + c3 * c3); } }
        ss += shx(ss, 32, lane);
        const float rr = P.osc / sqrtf(ss * (1.0f / 128.0f) + LN_EPS);
        bf16* op = P.O + rowoff;
#pragma unroll
        for (int db = 0; db < NDB; ++db)
#pragma unroll
            for (int gp = 0; gp < 2; ++gp) { v2u w[2];
#pragma unroll
                for (int e = 0; e < 2; ++e) { const int g = 2 * gp + e; const f32x4 gg = *(const f32x4*)(P.gsub + 32 * db + 8 * g + 4 * h);
                    w[e].x = pk2(o[db][4 * g] * rr * gg[0], o[db][4 * g + 1] * rr * gg[1]); w[e].y = pk2(o[db][4 * g + 2] * rr * gg[2], o[db][4 * g + 3] * rr * gg[3]); }
                A10_SWAP(w[0], w[1]);
                v4u q; q.x = w[0].x; q.y = w[0].y; q.z = w[1].x; q.w = w[1].y; *(v4u*)(op + 32 * db + 16 * gp) = q; }
        return;
    }
    bf16* op = P.O + rowoff;
#pragma unroll
    for (int db = 0; db < NDB; ++db)
#pragma unroll
        for (int gp = 0; gp < 2; ++gp) { v2u w[2];
#pragma unroll
            for (int e = 0; e < 2; ++e) { const int g = 2 * gp + e; w[e].x = pk2(o[db][4 * g] * inv, o[db][4 * g + 1] * inv); w[e].y = pk2(o[db][4 * g + 2] * inv, o[db][4 * g + 3] * inv); }
            A10_SWAP(w[0], w[1]);
            v4u q; q.x = w[0].x; q.y = w[0].y; q.z = w[1].x; q.w = w[1].y; *(v4u*)(op + 32 * db + 16 * gp) = q; }
#undef A10_SWAP
}

template <int DQK, int KSPLIT, int DV, bool BIAS, int COMB = 0>
__device__ __forceinline__ void attn_unit9(const AttnP& P, int b, int qt, int qcol, int kcol, int vcol, int ocol, int hb, LAS unsigned char* lds, const int tid_in) {
    constexpr int KROWB = DQK * 2 + 16;
    constexpr int VROWB = (DV == 128) ? 320 : 192;
    constexpr int KBYTES = 64 * KROWB, VBYTES = 64 * VROWB, STAGE = KBYTES + VBYTES + 256, LUT_OFF = 2 * STAGE;
    constexpr int ND = DQK / 16, NDB = DV / 32, KCH = DQK / 8, VCH = DV / 8, NKC = 64 * KCH, NVC = 64 * VCH, KL = (NKC + 511) / 512, VL = (NVC + 511) / 512;
    int tid_ = tid_in; asm volatile("" : "+v"(tid_));
    const int tid = tid_, lane = tid & 63, wid = __builtin_amdgcn_readfirstlane(tid >> 6), r = lane & 31, h = lane >> 5;
    const long tok0 = (long)b * SEQ; const int q0 = qt * 256; const int qrow = q0 + wid * 32 + r;
    bf16x8 qf[ND];
    { const bf16* qp = P.Q + (tok0 + qrow) * (long)P.ldq + qcol + 8 * h;
#pragma unroll
      for (int d = 0; d < ND; ++d) qf[d] = *(const bf16x8*)(qp + 16 * d); }
    int posq = 0, posq_min = 0;
    LAS float* lut = (LAS float*)(lds + LUT_OFF);
    if (BIAS) { posq = P.pos[tok0 + qrow]; int mn = posq;
#pragma unroll
        for (int o = 1; o < 64; o <<= 1) { const int t2 = shxi(mn, o, lane); mn = t2 < mn ? t2 : mn; }
        posq_min = mn;
        if (tid < 132) lut[tid] = P.lut[hb * 132 + tid] - P.lut[hb * 132 + 128]; }
    v4u kreg[KL], vreg[VL]; int preg = 0;
#define ATT_ISSUE(t) do { const long trow = tok0 + 64 * (long)(t); \
        _Pragma("unroll") for (int i = 0; i < KL; ++i) { const int c = tid + 512 * i; if (NKC % 512 == 0 || c < NKC) { const int row = c / KCH, col = (c % KCH) * 8; \
            const bf16* src = (col < KSPLIT) ? P.K1 + (trow + row) * (long)P.ldk1 + kcol + col : P.K2 + (trow + row) * (long)P.ldk2 + (col - KSPLIT); kreg[i] = *(const v4u*)src; } } \
        _Pragma("unroll") for (int i = 0; i < VL; ++i) { const int c = tid + 512 * i; if (NVC % 512 == 0 || c < NVC) { const int row = c / VCH, col = (c % VCH) * 8; vreg[i] = *(const v4u*)(P.V + (trow + row) * (long)P.ldv + vcol + col); } } \
        if (BIAS && tid < 64) preg = P.pos[trow + tid]; } while (0)
#define ATT_WRITE(t) do { LAS unsigned char* sb = lds + ((t) & 1) * STAGE; \
        _Pragma("unroll") for (int i = 0; i < KL; ++i) { const int c = tid + 512 * i; if (NKC % 512 == 0 || c < NKC) { const int row = c / KCH, cc = c % KCH; *(LAS v4u*)(sb + row * KROWB + cc * 16) = kreg[i]; } } \
        _Pragma("unroll") for (int i = 0; i < VL; ++i) { const int c = tid + 512 * i; if (NVC % 512 == 0 || c < NVC) { const int row = c / VCH, cc = c % VCH; *(LAS v4u*)(sb + KBYTES + row * VROWB + cc * 16) = vreg[i]; } } \
        if (BIAS && tid < 64) *(LAS int*)(sb + KBYTES + VBYTES + 4 * tid) = preg; } while (0)
    f32x16 o[NDB];
#pragma unroll
    for (int i = 0; i < NDB; ++i)
#pragma unroll
        for (int j = 0; j < 16; ++j) o[i][j] = 0.f;
    float m_run = 0.f, l_run = 0.f;
    f32x16 lacc;
#pragma unroll
    for (int j = 0; j < 16; ++j) lacc[j] = 0.f;
    const bf16x8 ones8 = {0x3f80, 0x3f80, 0x3f80, 0x3f80, 0x3f80, 0x3f80, 0x3f80, 0x3f80};
    f32x16 csp;
    { const float c0_ = BIAS ? P.lut[hb * 132 + 128] : 0.f;
#pragma unroll
      for (int j = 0; j < 16; ++j) csp[j] = c0_; }
    const int ntiles = (q0 + 256) / 64, my_last = (q0 + wid * 32 + 31) / 64;
#if ATT_STATIC_PRIO
    if (wid >= 4) __builtin_amdgcn_s_setprio(1);
#endif
    ATT_ISSUE(0); ATT_WRITE(0); __syncthreads();
    const int kbase = r * KROWB + 16 * h;
    const int vbase = KBYTES + (4 * h + ((lane & 15) >> 2)) * VROWB + (((lane >> 4) & 1) * 16 + (lane & 3) * 4) * 2;
    for (int t = 0; t < ntiles; ++t) {
        const bool more = (t + 1 < ntiles);
        if (more) ATT_ISSUE(t + 1);
        if (t <= my_last) {
            const LAS unsigned char* sb = lds + (t & 1) * STAGE;
            bool plain = (64 * t + 63 <= q0 + wid * 32);
            if (t >= 2) {
                const float lnow = lacc[0], ls = lnow - l_run;
                if (__any(ls > 1024.0f)) {
                    const float delta = fmaxf(__builtin_amdgcn_logf(ls) - 4.0f, 0.f), alpha = __builtin_amdgcn_exp2f(-delta);
                    m_run += delta; lacc = lacc * alpha;
#pragma unroll
                    for (int i = 0; i < NDB; ++i) o[i] = o[i] * alpha;
#pragma unroll
                    for (int j = 0; j < 16; ++j) csp[j] -= delta;
                }
                l_run = lacc[0];
            } else if (t == 1) l_run = lacc[0];
            if (BIAS) { const int kmax = P.blkmax[(int)(tok0 >> 6) + t]; if (!(plain && (posq_min - kmax >= 113))) plain = false; }
            f32x16 x0 = csp, x1 = csp;
            ATT_SETPRIO(1);
            { bf16x8 kf0[ND], kf1[ND];
#pragma unroll
              for (int d = 0; d < ND; ++d) { kf0[d] = *(const LAS bf16x8*)(sb + kbase + d * 32); kf1[d] = *(const LAS bf16x8*)(sb + kbase + 32 * KROWB + d * 32); }
              __builtin_amdgcn_sched_barrier(0);
#pragma unroll
              for (int d = 0; d < ND; ++d) { x0 = MFMA32(kf0[d], qf[d], x0); x1 = MFMA32(kf1[d], qf[d], x1); } }
            ATT_SETPRIO(0);
            if (!plain) {
#pragma unroll
                for (int g = 0; g < 4; ++g) {
                    int pk0[4] = {0, 0, 0, 0}, pk1[4] = {0, 0, 0, 0};
                    if (BIAS) { const LAS int* pp = (const LAS int*)(sb + KBYTES + VBYTES) + 8 * g + 4 * h;
                        const v4u a = *(const LAS v4u*)pp, c = *(const LAS v4u*)(pp + 32);
                        pk0[0] = a.x; pk0[1] = a.y; pk0[2] = a.z; pk0[3] = a.w; pk1[0] = c.x; pk1[1] = c.y; pk1[2] = c.z; pk1[3] = c.w; }
#pragma unroll
                    for (int j = 0; j < 4; ++j) { const int i = 4 * g + j; const int kidx = 64 * t + 8 * g + 4 * h + j;
                        float v0 = x0[i], v1 = x1[i];
                        if (BIAS) { int n0 = posq - pk0[j]; n0 = n0 < 0 ? 0 : (n0 > 128 ? 128 : n0); int n1 = posq - pk1[j]; n1 = n1 < 0 ? 0 : (n1 > 128 ? 128 : n1); v0 += lut[n0]; v1 += lut[n1]; }
                        if (kidx > qrow) v0 = -INFINITY; if (kidx + 32 > qrow) v1 = -INFINITY;
                        x0[i] = v0; x1[i] = v1; }
                }
            }
            if (t == 0) {
                float ma = fmaxf(fmaxf(x0[0], x0[1]), x0[2]), mb = fmaxf(fmaxf(x1[0], x1[1]), x1[2]);
#pragma unroll
                for (int j = 3; j < 15; j += 2) { ma = fmaxf(fmaxf(ma, x0[j]), x0[j + 1]); mb = fmaxf(fmaxf(mb, x1[j]), x1[j + 1]); }
                float mx = fmaxf(fmaxf(ma, mb), fmaxf(x0[15], x1[15]));
                { const auto rr = __builtin_amdgcn_permlane32_swap(__float_as_uint(mx), __float_as_uint(mx), false, false); mx = fmaxf(__uint_as_float(rr[0]), __uint_as_float(rr[1])); }
                m_run += mx;
#pragma unroll
                for (int j = 0; j < 16; ++j) { x0[j] -= mx; x1[j] -= mx; csp[j] -= mx; }
            }
            bf16x8 pf[4];
            s16x4 vl[2][NDB], vh[2][NDB];
#define A6_EXP(X, bb, PF) do { \
        X[bb + 0] = __builtin_amdgcn_exp2f(X[bb + 0]); X[bb + 1] = __builtin_amdgcn_exp2f(X[bb + 1]); X[bb + 2] = __builtin_amdgcn_exp2f(X[bb + 2]); X[bb + 3] = __builtin_amdgcn_exp2f(X[bb + 3]); \
        X[bb + 4] = __builtin_amdgcn_exp2f(X[bb + 4]); X[bb + 5] = __builtin_amdgcn_exp2f(X[bb + 5]); X[bb + 6] = __builtin_amdgcn_exp2f(X[bb + 6]); X[bb + 7] = __builtin_amdgcn_exp2f(X[bb + 7]); \
        { v4u w_; w_.x = pk2(X[bb + 0], X[bb + 1]); w_.y = pk2(X[bb + 2], X[bb + 3]); w_.z = pk2(X[bb + 4], X[bb + 5]); w_.w = pk2(X[bb + 6], X[bb + 7]); PF = __builtin_bit_cast(bf16x8, w_); } } while (0)
#define A6_VLD(buf, ss) do { _Pragma("unroll") for (int db = 0; db < NDB; ++db) { vl[buf][db] = vtr(sb + vbase + (16 * (ss)) * VROWB + 64 * db); vh[buf][db] = vtr(sb + vbase + (16 * (ss) + 8) * VROWB + 64 * db); } } while (0)
#define A6_MMA(buf, ss) do { _Pragma("unroll") for (int db = 0; db < NDB; ++db) { const bf16x8 vf_ = __builtin_shufflevector(vl[buf][db], vh[buf][db], 0, 1, 2, 3, 4, 5, 6, 7); o[db] = MFMA32(vf_, pf[ss], o[db]); } lacc = MFMA32(ones8, pf[ss], lacc); } while (0)
#define A6_SGB(nv) do { _Pragma("unroll") for (int db = 0; db < NDB; ++db) { __builtin_amdgcn_sched_group_barrier(0x008, 1, 0); __builtin_amdgcn_sched_group_barrier(A6_VMASK, (nv), 0); __builtin_amdgcn_sched_group_barrier(0x100, 2, 0); } __builtin_amdgcn_sched_group_barrier(0x008, 1, 0); } while (0)
            A6_VLD(0, 0);
            A6_EXP(x0, 0, pf[0]);
            __builtin_amdgcn_sched_barrier(0);
            A6_VLD(1, 1); A6_EXP(x0, 8, pf[1]); A6_MMA(0, 0); A6_SGB(12 / NDB);
            __builtin_amdgcn_sched_barrier(0);
            A6_VLD(0, 2); A6_EXP(x1, 0, pf[2]); A6_MMA(1, 1); A6_SGB(12 / NDB);
            __builtin_amdgcn_sched_barrier(0);
            A6_VLD(1, 3); A6_EXP(x1, 8, pf[3]); A6_MMA(0, 2); A6_SGB(12 / NDB);
            __builtin_amdgcn_sched_barrier(0);
            A6_MMA(1, 3);
            __builtin_amdgcn_sched_barrier(0);
#undef A6_EXP
#undef A6_VLD
#undef A6_MMA
#undef A6_SGB
            ATT_SETPRIO(0);
        }
        if (more) ATT_WRITE(t + 1);
        __syncthreads();
    }
#undef ATT_ISSUE
#undef ATT_WRITE
#if ATT_STATIC_PRIO
    __builtin_amdgcn_s_setprio(0);
#endif
    const float lt = lacc[0], inv = 1.0f / lt;
    if (COMB == 2) {
        const bf16* ip = P.TI + (tok0 + qrow) * (long)P.ldo + ocol + 4 * h; float ss = 0.f;
#pragma unroll
        for (int db = 0; db < NDB; ++db)
#pragma unroll
            for (int g = 0; g < 4; ++g) { const v2u a = *(const v2u*)(ip + 32 * db + 8 * g);
                const float c0 = bflo(a.x) - P.lam * (o[db][4 * g] * inv), c1 = bfhi(a.x) - P.lam * (o[db][4 * g + 1] * inv), c2 = bflo(a.y) - P.lam * (o[db][4 * g + 2] * inv), c3 = bfhi(a.y) - P.lam * (o[db][4 * g + 3] * inv);
                o[db][4 * g] = c0; o[db][4 * g + 1] = c1; o[db][4 * g + 2] = c2; o[db][4 * g + 3] = c3; ss += (c0 * c0 + c1 * c1) + (c2 * c2 + c3 * c3); }
        ss += shx(ss, 32, lane);
        const float rr = P.osc / sqrtf(ss * (1.0f / 128.0f) + LN_EPS);
        bf16* op = P.O + (tok0 + qrow) * (long)P.ldo + ocol + 4 * h;
#pragma unroll
        for (int db = 0; db < NDB; ++db)
#pragma unroll
            for (int g = 0; g < 4; ++g) { const f32x4 gg = *(const f32x4*)(P.gsub + 32 * db + 8 * g + 4 * h);
                v2u w; w.x = pk2(o[db][4 * g] * rr * gg[0], o[db][4 * g + 1] * rr * gg[1]); w.y = pk2(o[db][4 * g + 2] * rr * gg[2], o[db][4 * g + 3] * rr * gg[3]);
                *(v2u*)(op + 32 * db + 8 * g) = w; }
        return;
    }
    bf16* op = P.O + (tok0 + qrow) * (long)P.ldo + ocol + 4 * h;
#pragma unroll
    for (int db = 0; db < NDB; ++db)
#pragma unroll
        for (int g = 0; g < 4; ++g) { v2u w; w.x = pk2(o[db][4 * g] * inv, o[db][4 * g + 1] * inv); w.y = pk2(o[db][4 * g + 2] * inv, o[db][4 * g + 3] * inv);
            *(v2u*)(op + 32 * db + 8 * g) = w; }
}

#undef MFMA32
}

constexpr size_t MiB = 1u << 20;
constexpr size_t WS_CTL = 0, CTL_ZERO_BYTES = 1 * MiB;
constexpr size_t WS_ROPE = 1 * MiB;
constexpr size_t WS_MISC = 5 * MiB;
constexpr size_t WS_XB = 6 * MiB;
constexpr size_t WS_XB8 = 70 * MiB + 16 * MiB;
constexpr size_t WS_PB = 70 * MiB;
constexpr size_t WS_W = 118 * MiB;
constexpr size_t W_IN = WS_W, W_G8 = WS_W + 8 * MiB, W_UQ = WS_W + 12 * MiB, W_UKV = WS_W + 13 * MiB, W_BD = WS_W + 14 * MiB, W_BM = WS_W + 16 * MiB, W_OUT = WS_W + 17 * MiB,
                 W_PG = WS_W + 19 * MiB, W_PP = WS_W + 21 * MiB, W_F13 = WS_W + 22 * MiB  , W_F2E = WS_W + 134 * MiB;
constexpr size_t WS_ACT = 308 * MiB;
constexpr size_t A_DQ = WS_ACT, A_DK = WS_ACT + 64 * MiB, A_DV = WS_ACT + 128 * MiB, A_G = WS_ACT + 192 * MiB, A_C = WS_ACT + 320 * MiB;
constexpr size_t A_OA = A_C + 64 * MiB  , A_MT = A_DK, A_M = A_DV, A_CQ = A_C, A_OA2 = A_C, A_PRE = A_C;
constexpr size_t A_CQN = WS_ACT + 448 * MiB, A_CKVN = WS_ACT + 472 * MiB, A_OB = A_CQN, A_MKR = WS_ACT + 488 * MiB, A_MQ = WS_ACT + 490 * MiB, A_MKV = WS_ACT + 538 * MiB;
constexpr size_t A_H = WS_ACT;
constexpr size_t A_XG = WS_ACT, A_YG = A_XG  , A_TOK = WS_ACT + 264 * MiB, A_HG = WS_ACT + 270 * MiB  , A_PREM = WS_ACT + 512 * MiB;
constexpr size_t W_F13D = WS_ACT + 602 * MiB, W_F2D = WS_ACT + 613 * MiB;
constexpr size_t W_QKV8 = WS_W + 3 * MiB;
constexpr size_t WS_SSP = WS_ACT + 620 * MiB;
constexpr size_t WS_END = WS_ACT + 640 * MiB;
static_assert(MOE_FP8 == 1, "the workspace map assumes fp8 expert activations");
constexpr int CW_BAR = 4096, CW_MOE = 8192, CW_LN = 16384;
constexpr size_t WS_LNST = WS_W + 10 * MiB;
constexpr int CW_DUMMY_ = 0;

constexpr int RING_BYTES = 131072, MISC_OFF = RING_BYTES + 320, LDS_BYTES = 147456;
constexpr int NWAVES = 8;

#ifndef REP_ATTN_D
#define REP_ATTN_D 1
#endif
#ifndef REP_ATTN_M
#define REP_ATTN_M 1
#endif
#ifndef REP_CONV
#define REP_CONV 1
#endif
#ifndef REP_L1
#define REP_L1 1
#endif
#ifndef REP_EW
#define REP_EW 1
#endif
#ifndef REP_BAR
#define REP_BAR 1
#endif
#ifndef REP_LN
#define REP_LN 1
#endif
#ifndef REP_MOE
#define REP_MOE 1
#endif
#ifndef REP_MIX
#define REP_MIX 1
#endif
#ifndef REP_FFN
#define REP_FFN 1
#endif
#ifndef REP_P0
#define REP_P0 1
#endif
#ifndef REP_PPE
#define REP_PPE 1
#endif
#ifndef ATT_UNIT_D
#define ATT_UNIT_D attn_unit10
#endif
#ifndef ATT_UNIT_M
#define ATT_UNIT_M attn_unit10
#endif
#ifndef F8_SP2
#define F8_SP2 true
#endif
#ifndef GEMM_STAGGER
#define GEMM_STAGGER 0
#endif
#ifndef STAG_L1
#define STAG_L1 1500
#endif
#ifndef STAG_H
#define STAG_H 1500
#endif
#ifndef STAG_UP
#define STAG_UP 1000
#endif
#ifndef GEMM_ALIGN
#define GEMM_ALIGN true
#endif
#ifndef UP_ALIGN
#define UP_ALIGN true
#endif
#ifndef PROBE_D
#define PROBE_D -1
#endif
#ifndef PROBE_M
#define PROBE_M -1
#endif
#ifndef LN_FUSE
#define LN_FUSE 1
#endif
#ifndef CONV_IN_DOWN
#define CONV_IN_DOWN 1
#endif
#ifndef CONV_IN_ATTN
#define CONV_IN_ATTN 1
#endif
#ifndef PROBE_NULL_L1
#define PROBE_NULL_L1 0
#endif
#ifndef QKV_FP8
#define QKV_FP8 1
#endif
#define XB_TMO      128
#define XB_XCNT(j)  (256  + 64 * (j))
#define XB_XSUB(j)  (1280 + 64 * (j))
#define XB_XGEN(j)  (2304 + 64 * (j))
#define XB_TOP      3328
#define XB_TOPGEN   3392
#define XCD_BAR_WORDS 3456
#define XB_SPIN_CAP (1u << 18)

__device__ __forceinline__ unsigned xb_ld(unsigned* p)              { return __hip_atomic_load(p, __ATOMIC_RELAXED, __HIP_MEMORY_SCOPE_AGENT); }
__device__ __forceinline__ unsigned xb_add(unsigned* p, unsigned v) { return __hip_atomic_fetch_add(p, v, __ATOMIC_RELAXED, __HIP_MEMORY_SCOPE_AGENT); }
__device__ __forceinline__ unsigned xb_xcc_id() { return (unsigned)__builtin_amdgcn_s_getreg((3 << 11) | 20) & 0xFu; }
#define XB_SPIN(cond, bar) do { unsigned _sp = 0; while (cond) { __builtin_amdgcn_s_sleep(1); \
    if ((++_sp & 255u) == 0u) { if (xb_ld(&(bar)[XB_TMO])) break; if (_sp > XB_SPIN_CAP) { atomicAdd(&(bar)[XB_TMO], 1u); break; } } } } while (0)

struct XcdBarrier {
    unsigned* bar; unsigned x;
    volatile LAS unsigned* st;
};

__device__ __forceinline__ XcdBarrier xcd_barrier_post(unsigned* bar, volatile LAS unsigned* st, const bool t0  ) {
    XcdBarrier b; b.bar = bar; b.x = xb_xcc_id(); b.st = st;
    if (t0) (void)xb_add(&bar[XB_XCNT(b.x)], 1u);
    return b;
}
__device__ __forceinline__ void xcd_barrier_complete(unsigned* bar, unsigned x, unsigned& nloc, unsigned& nx) {
    const unsigned G = gridDim.x * gridDim.y * gridDim.z;
    unsigned sum, cnt, mine, sp = 0u;
    for (;;) {
        sum = 0u; cnt = 0u; mine = 0u;
#pragma unroll
        for (unsigned j = 0; j < 16; ++j) { const unsigned c = xb_ld(&bar[XB_XCNT(j)]); sum += c; cnt += (c > 0u) ? 1u : 0u; mine = (j == x) ? c : mine; }
        if (sum == G) break;
        __builtin_amdgcn_s_sleep(1);
        if ((++sp & 255u) == 0u) { if (xb_ld(&bar[XB_TMO])) break; if (sp > XB_SPIN_CAP) { atomicAdd(&bar[XB_TMO], 1u); break; } }
    }
    nloc = mine > 0u ? mine : 1u; nx = cnt > 0u ? cnt : 1u;
}

__device__ __forceinline__ void xcd_barrier(const XcdBarrier& b, const bool t0) {
    asm volatile("s_waitcnt vmcnt(0)" ::: "memory");
    __syncthreads();
    if (t0) {
        unsigned* bar = b.bar;
        __builtin_amdgcn_s_waitcnt(0);
        unsigned nloc = b.st[0], nx = b.st[1];
        if (nloc == 0u) { xcd_barrier_complete(bar, b.x, nloc, nx); b.st[0] = nloc; b.st[1] = nx; }
        const unsigned old = xb_add(&bar[XB_XSUB(b.x)], 1u);
        const unsigned gen = old / nloc;
        if (old + 1u == (gen + 1u) * nloc) {
            __builtin_amdgcn_fence(__ATOMIC_RELEASE, "agent");
            asm volatile("s_waitcnt vmcnt(0)" ::: "memory");
            const unsigned og = xb_add(&bar[XB_TOP], 1u);
            const unsigned tg = og / nx;
            if (og + 1u == (tg + 1u) * nx) xb_add(&bar[XB_TOPGEN], 1u);
            else XB_SPIN(xb_ld(&bar[XB_TOPGEN]) == tg, bar);
            __builtin_amdgcn_fence(__ATOMIC_ACQUIRE, "agent");
            xb_add(&bar[XB_XGEN(b.x)], 1u);
            asm volatile("s_waitcnt vmcnt(0)" ::: "memory");
        } else {
            XB_SPIN(xb_ld(&bar[XB_XGEN(b.x)]) == gen, bar);
            __builtin_amdgcn_fence(__ATOMIC_ACQUIRE, "agent");
            asm volatile("s_waitcnt vmcnt(0)" ::: "memory");
        }
    }
    __syncthreads();
}

struct Args { const void* in[31]; float* out; unsigned char* ws; int ph_lo, ph_hi, fuse; };

struct Frame {
    LAS unsigned char* lds;
    int tid, lane, wave, gw, NGW, G, vcu;
    const Args* a;
    unsigned char* ws;
};
#define FR_TID(F_) ({ unsigned m1_ = ~0u; asm volatile("" : "+s"(m1_)); (((F_).wave << 6) | (int)__builtin_amdgcn_mbcnt_hi(m1_, __builtin_amdgcn_mbcnt_lo(m1_, 0u))); })
#define INF(i) ((const float*)F.a->in[i])
#define WSP(T_, off) ((T_*)(F.ws + (off)))

__device__ __forceinline__ void conv_w(const Frame& F, const float* src, int ldn, int K, int ncols, int nbatch, size_t sbs, bf16* dst, int rmul, int roff, size_t dbs, const float* kscale) {
    LAS float* scr = (LAS float*)(F.lds + F.wave * 16384);
    const int lane = F.lane, nblk = ncols / 32, kblk = K / 64, per = nblk * kblk, total = per * nbatch;
    for (int it = F.gw; it < total; it += F.NGW) {
        const int bt = it / per, r = it % per, kb = r / nblk, nb = r % nblk, k0 = kb * 64, n0 = nb * 32;
        const float* W = src + (size_t)bt * sbs; bf16* WT = dst + (size_t)bt * dbs;
        float ld_[32];
#pragma unroll
        for (int i = 0; i < 32; ++i) ld_[i] = __builtin_nontemporal_load(W + (size_t)(k0 + 2 * i + (lane >> 5)) * ldn + n0 + (lane & 31));
#pragma unroll
        for (int i = 0; i < 32; ++i) scr[(2 * i + (lane >> 5)) * 33 + (lane & 31)] = ld_[i];
        LDS_WAIT(); asm volatile("" ::: "memory");
        const int c = lane & 7;
        float ks[8];
#pragma unroll
        for (int i = 0; i < 8; ++i) ks[i] = kscale ? kscale[k0 + 8 * c + i] : 1.0f;
#pragma unroll
        for (int j = 0; j < 4; ++j) { const int n = (lane >> 3) + 8 * j; const LAS float* s = scr + (8 * c) * 33 + n;
            v4u o; o.x = pk2(s[0 * 33] * ks[0], s[1 * 33] * ks[1]); o.y = pk2(s[2 * 33] * ks[2], s[3 * 33] * ks[3]); o.z = pk2(s[4 * 33] * ks[4], s[5 * 33] * ks[5]); o.w = pk2(s[6 * 33] * ks[6], s[7 * 33] * ks[7]);
            *(v4u*)(WT + (size_t)(rmul * (n0 + n) + roff) * K + k0 + 8 * c) = o; }
        LDS_WAIT(); asm volatile("" ::: "memory");
    }
}
__device__ __forceinline__ void conv_w8(const Frame& F, const float* src, int ldn, int K, int ncols, int nbatch, size_t sbs, unsigned char* dst, int rmul, int roff, size_t dbs, float scale) {
    LAS float* scr = (LAS float*)(F.lds + F.wave * 16384);
    const int lane = F.lane, nblk = ncols / 32, kblk = K / 64, per = nblk * kblk, total = per * nbatch;
    for (int it = F.gw; it < total; it += F.NGW) {
        const int bt = it / per, r = it % per, kb = r / nblk, nb = r % nblk, k0 = kb * 64, n0 = nb * 32;
        const float* W = src + (size_t)bt * sbs; unsigned char* WT = dst + (size_t)bt * dbs;
        float ld_[32];
#pragma unroll
        for (int i = 0; i < 32; ++i) ld_[i] = __builtin_nontemporal_load(W + (size_t)(k0 + 2 * i + (lane >> 5)) * ldn + n0 + (lane & 31));
#pragma unroll
        for (int i = 0; i < 32; ++i) scr[(2 * i + (lane >> 5)) * 33 + (lane & 31)] = ld_[i];
        LDS_WAIT(); asm volatile("" ::: "memory");
        const int c = lane & 7;
#pragma unroll
        for (int j = 0; j < 4; ++j) { const int n = (lane >> 3) + 8 * j; const LAS float* s = scr + (8 * c) * 33 + n;
            int lo = __builtin_amdgcn_cvt_pk_fp8_f32(s[0 * 33] * scale, s[1 * 33] * scale, 0, false); lo = __builtin_amdgcn_cvt_pk_fp8_f32(s[2 * 33] * scale, s[3 * 33] * scale, lo, true);
            int hi = __builtin_amdgcn_cvt_pk_fp8_f32(s[4 * 33] * scale, s[5 * 33] * scale, 0, false); hi = __builtin_amdgcn_cvt_pk_fp8_f32(s[6 * 33] * scale, s[7 * 33] * scale, hi, true);
            v2u o; o.x = (unsigned)lo; o.y = (unsigned)hi;
            *(v2u*)(WT + (size_t)(rmul * (n0 + n) + roff) * K + k0 + 8 * c) = o; }
        LDS_WAIT(); asm volatile("" ::: "memory");
    }
}
__device__ __forceinline__ void phase_convert(const Frame& F, int L, const int which = 0) {
    const int j = L >> 1;
    if (which != 2) {
    const float* win = INF(4) + (size_t)L * D * IN_COLS;
#if QKV_FP8
    conv_w8(F, win, IN_COLS, D, 3072, 1, 0, WSP(unsigned char, W_QKV8), 1, 0, 0, 32.0f);
    conv_w8(F, win + 3744, IN_COLS, D, 2048, 1, 0, WSP(unsigned char, W_QKV8), 1, 3072, 0, 32.0f);
    conv_w(F, win + 3072, IN_COLS, D, 672, 1, 0, WSP(bf16, W_IN), 1, 0, 0, nullptr);
    { bf16* padr = WSP(bf16, W_IN) + (size_t)672 * D;
#else
    conv_w(F, win, IN_COLS, D, 3072, 1, 0, WSP(bf16, W_IN), 1, 0, 0, nullptr);
    conv_w8(F, win + 3744, IN_COLS, D, 2048, 1, 0, WSP(unsigned char, W_G8), 1, 0, 0, 32.0f);
    conv_w(F, win + 3072, IN_COLS, D, 672, 1, 0, WSP(bf16, W_IN), 1, 3072, 0, nullptr);
    { bf16* padr = WSP(bf16, W_IN) + (size_t)3744 * D;
#endif
      unsigned z_ = 0u; asm volatile("" : "+v"(z_));
      for (int i = F.gw * 64 + F.lane; i < (NIN - IN_COLS) * D / 8; i += F.NGW * 64) ((v4u*)padr)[i] = (v4u){z_, z_, z_, z_}; }
    conv_w(F, INF(12) + (size_t)L * QR * 768, 768, QR, 768, 1, 0, WSP(bf16, W_UQ), 1, 0, 0, INF(11) + L * QR);
    conv_w(F, INF(14) + (size_t)L * KVR * 1024, 1024, KVR, 1024, 1, 0, WSP(bf16, W_UKV), 1, 0, 0, INF(13) + L * KVR);
    conv_w(F, INF(15) + (size_t)L * D * D, D, D, D, 1, 0, WSP(bf16, W_BD), 1, 0, 0, nullptr);
    conv_w(F, INF(16) + (size_t)L * 512 * D, D, 512, D, 1, 0, WSP(bf16, W_BM), 1, 0, 0, nullptr);
    conv_w(F, INF(17) + (size_t)L * D * D, D, D, D, 1, 0, WSP(bf16, W_OUT), 1, 0, 0, nullptr);
    conv_w8(F, INF(27) + (size_t)L * D * D, D, D, D, 1, 0, WSP(unsigned char, W_PG), 1, 0, 0, 32.0f);
    conv_w(F, INF(28) + (size_t)L * PLE * D, D, PLE, D, 1, 0, WSP(bf16, W_PP), 1, 0, 0, nullptr);
    }
    if ((L & 1) == 0) { if (which != 2) {
        conv_w(F, INF(20) + (size_t)j * D * DENSE_FF, DENSE_FF, D, DENSE_FF, 1, 0, WSP(bf16, W_F13D), 2, 0, 0, nullptr);
        conv_w(F, INF(21) + (size_t)j * D * DENSE_FF, DENSE_FF, D, DENSE_FF, 1, 0, WSP(bf16, W_F13D), 2, 1, 0, nullptr);
        conv_w(F, INF(22) + (size_t)j * DENSE_FF * D, D, DENSE_FF, D, 1, 0, WSP(bf16, W_F2D), 1, 0, 0, nullptr); }
    } else if (which != 1) {
        const size_t eo = (size_t)j * NEXP * D * EXPERT_FF;
#if MOE_FP8
        conv_w8(F, INF(24) + eo, EXPERT_FF, D, EXPERT_FF, NEXP, (size_t)D * EXPERT_FF, WSP(unsigned char, W_F13), 2, 0, (size_t)2 * EXPERT_FF * D, 32.0f);
        conv_w8(F, INF(25) + eo, EXPERT_FF, D, EXPERT_FF, NEXP, (size_t)D * EXPERT_FF, WSP(unsigned char, W_F13), 2, 1, (size_t)2 * EXPERT_FF * D, 32.0f);
        conv_w8(F, INF(26) + eo, D, EXPERT_FF, D, NEXP, (size_t)EXPERT_FF * D, WSP(unsigned char, W_F2E), 1, 0, (size_t)D * EXPERT_FF, 128.0f);
#else
        conv_w(F, INF(24) + eo, EXPERT_FF, D, EXPERT_FF, NEXP, (size_t)D * EXPERT_FF, WSP(bf16, W_F13), 2, 0, (size_t)2 * EXPERT_FF * D, nullptr);
        conv_w(F, INF(25) + eo, EXPERT_FF, D, EXPERT_FF, NEXP, (size_t)D * EXPERT_FF, WSP(bf16, W_F13), 2, 1, (size_t)2 * EXPERT_FF * D, nullptr);
        conv_w(F, INF(26) + eo, D, EXPERT_FF, D, NEXP, (size_t)EXPERT_FF * D, WSP(bf16, W_F2E), 1, 0, (size_t)D * EXPERT_FF, nullptr);
#endif
    }
    if (which != 2) { const f32x4* ps = (const f32x4*)(INF(1) + (size_t)L * T * PLE); v2u* pd = WSP(v2u, WS_PB);
      for (int i = F.gw * 64 + F.lane; i < T * PLE / 4; i += F.NGW * 64) { const f32x4 v = __builtin_nontemporal_load(ps + i); v2u o; o.x = pk2(v[0], v[1]); o.y = pk2(v[2], v[3]); pd[i] = o; } }
}

__device__ __forceinline__ void phase_prologue(const Frame& F) {
    const int* pos = (const int*)F.a->in[2];
    for (int m = F.gw; m < T; m += F.NGW) {
        const f32x4* xr = (const f32x4*)(INF(0) + (size_t)m * D) + 2 * F.lane; v4u* br = WSP(v4u, WS_XB) + (size_t)m * (D / 8) + F.lane; v2u* br8 = WSP(v2u, WS_XB8) + (size_t)m * (D / 8) + F.lane;
#pragma unroll
        for (int j = 0; j < 2; ++j) { const f32x4 va = __builtin_nontemporal_load(xr + 128 * j), vb = __builtin_nontemporal_load(xr + 128 * j + 1);
            v4u o; o.x = pk2(va[0], va[1]); o.y = pk2(va[2], va[3]); o.z = pk2(vb[0], vb[1]); o.w = pk2(vb[2], vb[3]); br[64 * j] = o;
            int wa = __builtin_amdgcn_cvt_pk_fp8_f32(va[0], va[1], 0, false); wa = __builtin_amdgcn_cvt_pk_fp8_f32(va[2], va[3], wa, true);
            int wb = __builtin_amdgcn_cvt_pk_fp8_f32(vb[0], vb[1], 0, false); wb = __builtin_amdgcn_cvt_pk_fp8_f32(vb[2], vb[3], wb, true);
            v2u o8; o8.x = (unsigned)wa; o8.y = (unsigned)wb; br8[64 * j] = o8; }
    }
    { float* rope = WSP(float, WS_ROPE);
      for (int idx = F.gw * 64 + F.lane; idx < T * 16; idx += F.NGW * 64) {
          const int t = idx >> 4, j = idx & 15;
          double inv = 1.0; for (int i = 0; i < j; ++i) inv *= 0.5623413251903491;
          const double ang = (double)pos[t] * inv;
          const double nq = __builtin_rint(ang * 0.6366197723675814);
          double y = __builtin_fma(-nq, 1.5707963267948966, ang); y = __builtin_fma(-nq, 6.123233995736766e-17, y);
          const double y2 = y * y;
          double sp = 1.0 / 6227020800.0; sp = sp * y2 - 1.0 / 39916800.0; sp = sp * y2 + 1.0 / 362880.0; sp = sp * y2 - 1.0 / 5040.0; sp = sp * y2 + 1.0 / 120.0; sp = sp * y2 - 1.0 / 6.0;
          const double sn = y + y * y2 * sp;
          double cp = -1.0 / 87178291200.0; cp = cp * y2 + 1.0 / 479001600.0; cp = cp * y2 - 1.0 / 3628800.0; cp = cp * y2 + 1.0 / 40320.0; cp = cp * y2 - 1.0 / 720.0; cp = cp * y2 + 1.0 / 24.0; cp = cp * y2 - 0.5;
          const double cs = 1.0 + y2 * cp;
          const int q = ((int)nq) & 3;
          const double c = (q == 0) ? cs : (q == 1) ? -sn : (q == 2) ? -cs : sn;
          const double s = (q == 0) ? sn : (q == 1) ? cs : (q == 2) ? -sn : -cs;
          rope[2 * idx] = (float)c; rope[2 * idx + 1] = (float)s;
      } }
    { int* bm = WSP(int, WS_MISC);
      for (int blk = F.gw; blk < T / 64; blk += F.NGW) { int v = pos[blk * 64 + F.lane];
#pragma unroll
          for (int o = 1; o < 64; o <<= 1) { const int t2 = shxi(v, o, F.lane); v = t2 > v ? t2 : v; }
          if (F.lane == 0) bm[blk] = v; } }
    { float* lut = WSP(float, WS_MISC + 4096); const float* tab = INF(3);
      for (int idx = F.gw * 64 + F.lane; idx < 8 * 132; idx += F.NGW * 64) { const int hh = idx / 132, n = idx % 132;
          int bk = n;
          if (n >= 16) bk = 16 + (n >= 19) + (n >= 21) + (n >= 24) + (n >= 27) + (n >= 31) + (n >= 35) + (n >= 40) + (n >= 46) + (n >= 52) + (n >= 59) + (n >= 67) + (n >= 77) + (n >= 87) + (n >= 99) + (n >= 113);
          lut[idx] = tab[bk * 8 + hh] * LOG2E; } }
    for (int rep = 0; rep < REP_CONV; ++rep) phase_convert(F, 0);
}

__device__ __forceinline__ void phase_rms_rope(const Frame& F) {
    const bf16* CQ = WSP(bf16, A_CQ); const float* rope = WSP(float, WS_ROPE);
    bf16* CQN = WSP(bf16, A_CQN); bf16* CKVN = WSP(bf16, A_CKVN); bf16* MKR = WSP(bf16, A_MKR);
    const int l = F.lane;
    for (int m0 = F.gw; m0 < T; m0 += 4 * F.NGW) {
        unsigned q0[4], q1[4], q2[4]; v2u kvp[4]; unsigned short k1[4], k2[4]; float rc[4], rs[4];
#pragma unroll
        for (int q = 0; q < 4; ++q) { const int m = (m0 + q * F.NGW < T) ? m0 + q * F.NGW : m0; const bf16* c = CQ + (size_t)m * 768;
            q0[q] = *(const unsigned*)(c + 6 * l); q1[q] = *(const unsigned*)(c + 6 * l + 2); q2[q] = *(const unsigned*)(c + 6 * l + 4);
            kvp[q] = *(const v2u*)(c + QR + 4 * l);
            k1[q] = 0; k2[q] = 0; rc[q] = 0.f; rs[q] = 0.f;
            if (l < 16) { k1[q] = c[QR + KVR + l]; k2[q] = c[QR + KVR + 16 + l]; rc[q] = rope[(size_t)m * 32 + 2 * l]; rs[q] = rope[(size_t)m * 32 + 2 * l + 1]; } }
#pragma unroll
        for (int q = 0; q < 4; ++q) { const int m = m0 + q * F.NGW; if (m >= T) break;
            const f32x2 a0 = {bflo(q0[q]), bfhi(q0[q])}, a1 = {bflo(q1[q]), bfhi(q1[q])}, a2 = {bflo(q2[q]), bfhi(q2[q])};
            const f32x4 kv = {bflo(kvp[q].x), bfhi(kvp[q].x), bflo(kvp[q].y), bfhi(kvp[q].y)};
            const float x1 = bflo((unsigned)k1[q]), x2 = bflo((unsigned)k2[q]);
            const float sq = wave_sum(l, a0[0] * a0[0] + a0[1] * a0[1] + a1[0] * a1[0] + a1[1] * a1[1] + a2[0] * a2[0] + a2[1] * a2[1]);
            const float sk = wave_sum(l, kv[0] * kv[0] + kv[1] * kv[1] + kv[2] * kv[2] + kv[3] * kv[3]);
            const float rq = 1.0f / sqrtf(sq * (1.0f / QR) + LN_EPS), rk = 1.0f / sqrtf(sk * (1.0f / KVR) + LN_EPS);
            unsigned* qo = (unsigned*)(CQN + (size_t)m * QR + 6 * l);
            qo[0] = pk2(a0[0] * rq, a0[1] * rq); qo[1] = pk2(a1[0] * rq, a1[1] * rq); qo[2] = pk2(a2[0] * rq, a2[1] * rq);
            v2u ko; ko.x = pk2(kv[0] * rk, kv[1] * rk); ko.y = pk2(kv[2] * rk, kv[3] * rk);
            *(v2u*)(CKVN + (size_t)m * KVR + 4 * l) = ko;
            if (l < 16) { const float o1 = x1 * rc[q] - x2 * rs[q], o2 = x1 * rs[q] + x2 * rc[q]; const unsigned w = pk2(o1, o2);
                MKR[(size_t)m * 32 + l] = (bf16)(w & 0xffffu); MKR[(size_t)m * 32 + 16 + l] = (bf16)(w >> 16); }
        }
    }
}

template <bool ROUTE, bool GATHER>
__device__ __forceinline__ void phase_ln(const Frame& F, const bf16* PRE, const float* gam, const float* bet, const float* wr, int moe_j, const bool write_f32) {
    const int l = F.lane;
    const bf16* YG = WSP(bf16, A_YG); int* TOKE = WSP(int, A_TOK); float* TOKG = WSP(float, A_TOK + 1 * MiB); const int* TOKR = WSP(int, A_TOK + 2 * MiB);
    int* TOKS = WSP(int, A_TOK + 3 * MiB); int* CNTW = WSP(int, A_TOK + 4 * MiB);
    int rc0 = 0, rc1 = 0, rc2 = 0, rc3 = 0, rc4 = 0, rc5 = 0, rc6 = 0, rc7 = 0; (void)moe_j;
    f32x4 gv[4], bv[4];
#pragma unroll
    for (int j = 0; j < 4; ++j) { const int cj = 8 * l + 512 * (j >> 1) + 4 * (j & 1); gv[j] = *(const f32x4*)(gam + cj); bv[j] = *(const f32x4*)(bet + cj); }
    f32x4 rw0[4][4], rw1[4][4];
    if (ROUTE) {
#pragma unroll
        for (int j = 0; j < 4; ++j)
#pragma unroll
            for (int c = 0; c < 4; ++c) { const float* w = wr + (size_t)(8 * l + 512 * (j >> 1) + 4 * (j & 1) + c) * 8; rw0[j][c] = *(const f32x4*)w; rw1[j][c] = *(const f32x4*)(w + 4); }
    }
    int pr0[2] = {0, 0}, pr1[2] = {0, 0}; float pg0[2] = {0.f, 0.f}, pg1[2] = {0.f, 0.f};
    if (GATHER) {
#pragma unroll
        for (int q = 0; q < 2; ++q) { const int m = (F.gw + q * F.NGW < T) ? F.gw + q * F.NGW : F.gw; pr0[q] = TOKR[2 * m]; pr1[q] = TOKR[2 * m + 1]; pg0[q] = TOKG[2 * m]; pg1[q] = TOKG[2 * m + 1]; } }
    for (int m0 = F.gw; m0 < T; m0 += 2 * F.NGW) {
        v4u raw[2][2]; v4u y0[2][2], y1[2][2]; float g0[2] = {0.f, 0.f}, g1[2] = {0.f, 0.f};
#pragma unroll
        for (int q = 0; q < 2; ++q) { const int m = (m0 + q * F.NGW < T) ? m0 + q * F.NGW : m0;     const v4u* xr = (const v4u*)(PRE + (size_t)m * D) + l;
#pragma unroll
            for (int j = 0; j < 2; ++j) raw[q][j] = xr[64 * j];
            if (GATHER) { const int r0 = pr0[q], r1 = pr1[q]; g0[q] = pg0[q]; g1[q] = pg1[q];
                const v4u* p0 = (const v4u*)(YG + (size_t)r0 * D) + l; const v4u* p1 = (const v4u*)(YG + (size_t)r1 * D) + l;
#pragma unroll
                for (int j = 0; j < 2; ++j) { y0[q][j] = p0[64 * j]; y1[q][j] = p1[64 * j]; } } }
        if (GATHER && m0 + 2 * F.NGW < T) {
#pragma unroll
            for (int q = 0; q < 2; ++q) { const int mb = m0 + 2 * F.NGW, m = (mb + q * F.NGW < T) ? mb + q * F.NGW : mb; pr0[q] = TOKR[2 * m]; pr1[q] = TOKR[2 * m + 1]; pg0[q] = TOKG[2 * m]; pg1[q] = TOKG[2 * m + 1]; } }
#pragma unroll
        for (int q = 0; q < 2; ++q) { const int m = m0 + q * F.NGW; if (m >= T) break;
            f32x4 v[4]; float s = 0.f;
#pragma unroll
            for (int j = 0; j < 4; ++j) { const v4u a4 = raw[q][j >> 1]; v2u a; a.x = (j & 1) ? a4.z : a4.x; a.y = (j & 1) ? a4.w : a4.y; v[j][0] = bflo(a.x); v[j][1] = bfhi(a.x); v[j][2] = bflo(a.y); v[j][3] = bfhi(a.y); }
            if (GATHER) {
#pragma unroll
                for (int j = 0; j < 4; ++j) { const v4u a4 = y0[q][j >> 1], b4 = y1[q][j >> 1]; v2u a, b; a.x = (j & 1) ? a4.z : a4.x; a.y = (j & 1) ? a4.w : a4.y; b.x = (j & 1) ? b4.z : b4.x; b.y = (j & 1) ? b4.w : b4.y;
                    v[j][0] += g0[q] * bflo(a.x) + g1[q] * bflo(b.x); v[j][1] += g0[q] * bfhi(a.x) + g1[q] * bfhi(b.x); v[j][2] += g0[q] * bflo(a.y) + g1[q] * bflo(b.y); v[j][3] += g0[q] * bfhi(a.y) + g1[q] * bfhi(b.y); } }
#pragma unroll
            for (int j = 0; j < 4; ++j) s += (v[j][0] + v[j][1]) + (v[j][2] + v[j][3]);
            const float mean = wave_sum(l, s) * (1.f / D); float s2 = 0.f;
#pragma unroll
            for (int j = 0; j < 4; ++j) { v[j] = v[j] - mean; s2 += (v[j][0] * v[j][0] + v[j][1] * v[j][1]) + (v[j][2] * v[j][2] + v[j][3] * v[j][3]); }
            const float rstd = 1.f / sqrtf(wave_sum(l, s2) * (1.f / D) + LN_EPS);
            f32x4* orow = (f32x4*)(F.a->out + (size_t)m * D) + 2 * l; v4u* br = WSP(v4u, WS_XB) + (size_t)m * (D / 8) + l; v2u* br8 = WSP(v2u, WS_XB8) + (size_t)m * (D / 8) + l;
#pragma unroll
            for (int j = 0; j < 4; ++j) v[j] = v[j] * rstd * gv[j] + bv[j];
            if (write_f32) {
#pragma unroll
                for (int j = 0; j < 4; ++j) orow[128 * (j >> 1) + (j & 1)] = v[j];
            } else {
#pragma unroll
                for (int j2 = 0; j2 < 2; ++j2) { const f32x4 va = v[2 * j2], vb = v[2 * j2 + 1];
                    v4u o; o.x = pk2(va[0], va[1]); o.y = pk2(va[2], va[3]); o.z = pk2(vb[0], vb[1]); o.w = pk2(vb[2], vb[3]); br[64 * j2] = o;
                    int wa = __builtin_amdgcn_cvt_pk_fp8_f32(va[0], va[1], 0, false); wa = __builtin_amdgcn_cvt_pk_fp8_f32(va[2], va[3], wa, true);
                    int wb = __builtin_amdgcn_cvt_pk_fp8_f32(vb[0], vb[1], 0, false); wb = __builtin_amdgcn_cvt_pk_fp8_f32(vb[2], vb[3], wb, true);
                    v2u o8; o8.x = (unsigned)wa; o8.y = (unsigned)wb; br8[64 * j2] = o8; }
            }
            if (ROUTE) {
                float lg[8];
#pragma unroll
                for (int e = 0; e < 8; ++e) lg[e] = 0.f;
#pragma unroll
                for (int j = 0; j < 4; ++j)
#pragma unroll
                    for (int c = 0; c < 4; ++c) { const f32x4 w0 = rw0[j][c], w1 = rw1[j][c]; const float xv = v[j][c];
                        lg[0] += xv * w0[0]; lg[1] += xv * w0[1]; lg[2] += xv * w0[2]; lg[3] += xv * w0[3]; lg[4] += xv * w1[0]; lg[5] += xv * w1[1]; lg[6] += xv * w1[2]; lg[7] += xv * w1[3]; }
#pragma unroll
                for (int e = 0; e < 8; ++e) lg[e] = wave_sum(l, lg[e]);
                int e0 = 0; float v0 = lg[0];
#pragma unroll
                for (int e = 1; e < 8; ++e) if (lg[e] > v0) { v0 = lg[e]; e0 = e; }
                int e1 = -1; float v1 = -INFINITY;
#pragma unroll
                for (int e = 0; e < 8; ++e) if (e != e0 && lg[e] > v1) { v1 = lg[e]; e1 = e; }
                const float gg1 = 1.0f / (1.0f + expf(v0 - v1)), gg0 = 1.0f - gg1;
                const int s0 = (e0 == 0) ? rc0 : (e0 == 1) ? rc1 : (e0 == 2) ? rc2 : (e0 == 3) ? rc3 : (e0 == 4) ? rc4 : (e0 == 5) ? rc5 : (e0 == 6) ? rc6 : rc7;
                const int s1 = (e1 == 0) ? rc0 : (e1 == 1) ? rc1 : (e1 == 2) ? rc2 : (e1 == 3) ? rc3 : (e1 == 4) ? rc4 : (e1 == 5) ? rc5 : (e1 == 6) ? rc6 : rc7;
                rc0 += (e0 == 0) + (e1 == 0); rc1 += (e0 == 1) + (e1 == 1); rc2 += (e0 == 2) + (e1 == 2); rc3 += (e0 == 3) + (e1 == 3);
                rc4 += (e0 == 4) + (e1 == 4); rc5 += (e0 == 5) + (e1 == 5); rc6 += (e0 == 6) + (e1 == 6); rc7 += (e0 == 7) + (e1 == 7);
                if (l == 0) { TOKE[2 * m] = e0; TOKE[2 * m + 1] = e1; TOKG[2 * m] = gg0; TOKG[2 * m + 1] = gg1; TOKS[2 * m] = s0; TOKS[2 * m + 1] = s1; }
            }
        }
    }
    if (ROUTE && (FR_TID(F) & 63) == 0) { int* cw = CNTW + (size_t)F.gw * 8; cw[0] = rc0; cw[1] = rc1; cw[2] = rc2; cw[3] = rc3; cw[4] = rc4; cw[5] = rc5; cw[6] = rc6; cw[7] = rc7; }
}

struct MoeTiles { int pend[8]; int total; };
__device__ __forceinline__ void moe_tiles(const Frame& F, int moe_j, MoeTiles& mt) {
    const int* tot = WSP(int, A_TOK + 5 * MiB); int acc = 0; (void)moe_j;
#pragma unroll
    for (int e = 0; e < 8; ++e) { const int c = tot[e]; acc += (c + 255) >> 8; mt.pend[e] = acc; }
    mt.total = acc;
}
__device__ __forceinline__ void phase_scatter(const Frame& F, int moe_j) {
    (void)moe_j;
    const int* CNTW = WSP(int, A_TOK + 4 * MiB); const int* TOKS = WSP(int, A_TOK + 3 * MiB); int* TOT = WSP(int, A_TOK + 5 * MiB);
    const int* TOKE = WSP(int, A_TOK); int* TOKR = WSP(int, A_TOK + 2 * MiB);
    const v4u* XB = WSP(v4u, WS_XB); v4u* XG = WSP(v4u, A_XG); const int l = F.lane;
    LAS int* red = (LAS int*)F.lds;
    int tot[8], pre[8];
#pragma unroll
    for (int e = 0; e < 8; ++e) { tot[e] = 0; pre[e] = 0; }
    const int wg0 = F.vcu * NWAVES;
    for (int w = F.tid; w < F.NGW; w += NWAVES * 64) { const v4u a = *(const v4u*)(CNTW + (size_t)w * 8), b = *(const v4u*)(CNTW + (size_t)w * 8 + 4); const int below = (w < wg0) ? 1 : 0;
        tot[0] += a.x; tot[1] += a.y; tot[2] += a.z; tot[3] += a.w; tot[4] += b.x; tot[5] += b.y; tot[6] += b.z; tot[7] += b.w;
        pre[0] += below * (int)a.x; pre[1] += below * (int)a.y; pre[2] += below * (int)a.z; pre[3] += below * (int)a.w; pre[4] += below * (int)b.x; pre[5] += below * (int)b.y; pre[6] += below * (int)b.z; pre[7] += below * (int)b.w; }
#pragma unroll
    for (int e = 0; e < 8; ++e) {
#pragma unroll
        for (int o = 1; o < 64; o <<= 1) { tot[e] += shxi(tot[e], o, l); pre[e] += shxi(pre[e], o, l); } }
    if (l == 0) {
#pragma unroll
        for (int e = 0; e < 8; ++e) { red[F.wave * 16 + e] = tot[e]; red[F.wave * 16 + 8 + e] = pre[e]; } }
    __syncthreads();
    int base[8]; int acc = 0;
#pragma unroll
    for (int e = 0; e < 8; ++e) { int t = 0, p = 0;
#pragma unroll
        for (int w = 0; w < NWAVES; ++w) { t += red[w * 16 + e]; p += red[w * 16 + 8 + e]; }
        int mine = 0;
#pragma unroll
        for (int w = 0; w < NWAVES; ++w) { const int c = CNTW[(size_t)(wg0 + w) * 8 + e]; mine += (w < F.wave) ? c : 0; }
        base[e] = acc * 256 + p + mine; acc += (t + 255) >> 8;
        if (F.vcu == 0 && F.tid == 0) TOT[e] = t; }
    __syncthreads();
    static_assert(MOE_FP8 == 1, "scatter copies the fp8 rows");
    const v4u* X8 = WSP(v4u, WS_XB8);
    for (int m0 = F.gw; m0 < T; m0 += 4 * F.NGW) {
        int e_[4][2], s_[4][2]; v4u row_[4];
#pragma unroll
        for (int q = 0; q < 4; ++q) { const int m = (m0 + q * F.NGW < T) ? m0 + q * F.NGW : m0;
            e_[q][0] = TOKE[2 * m]; e_[q][1] = TOKE[2 * m + 1]; s_[q][0] = TOKS[2 * m]; s_[q][1] = TOKS[2 * m + 1]; row_[q] = X8[(size_t)m * 64 + l]; }
#pragma unroll
        for (int q = 0; q < 4; ++q) { const int m = m0 + q * F.NGW; if (m >= T) break;
            int rows[2];
#pragma unroll
            for (int k = 0; k < 2; ++k) { const int e = e_[q][k];
                const int bs = (e == 0) ? base[0] : (e == 1) ? base[1] : (e == 2) ? base[2] : (e == 3) ? base[3] : (e == 4) ? base[4] : (e == 5) ? base[5] : (e == 6) ? base[6] : base[7];
                rows[k] = bs + s_[q][k]; }
            ((v4u*)XG)[(size_t)rows[0] * 64 + l] = row_[q]; ((v4u*)XG)[(size_t)rows[1] * 64 + l] = row_[q];
            if (l == 0) { TOKR[2 * m] = rows[0]; TOKR[2 * m + 1] = rows[1]; } }
    }
}

template <int VAR>
__device__ __forceinline__ void phase_attn_diff(const Frame& F, int L) {
    const float lam_init = 0.8f - 0.6f * expf(-0.3f * (float)L);
    const int l = FR_TID(F) & 63;
    const float d1 = wave_sum(l, INF(6)[L * 64 + l] * INF(7)[L * 64 + l]), d2 = wave_sum(l, INF(8)[L * 64 + l] * INF(9)[L * 64 + l]);
    att::AttnP P; P.Q = WSP(bf16, A_DQ); P.ldq = 1024; P.K1 = WSP(bf16, A_DK); P.ldk1 = 1024; P.K2 = P.K1; P.ldk2 = 1024; P.V = WSP(bf16, A_DV); P.ldv = 1024; P.ldo = 1024;
    P.pos = (const int*)F.a->in[2]; P.blkmax = WSP(int, WS_MISC); P.lut = WSP(float, WS_MISC + 4096);
    P.TI = WSP(bf16, A_OA2); P.lam = expf(d1) - expf(d2) + lam_init; P.osc = 1.0f - lam_init; P.gsub = INF(10) + L * 128;
    for (int p = F.vcu; p < BATCH * 8 * 8; p += F.G) {
        const int bh = p >> 3, i = p & 7, b = bh >> 3, hh = bh & 7;
#pragma unroll 1
        for (int s = 0; s < 2; ++s) { const int qt = s ? i : 15 - i;
            P.O = WSP(bf16, A_OA2); att::ATT_UNIT_D<64, 64, 128, true, 1, VAR>(P, b, qt, (2 * hh) * 64, (2 * hh) * 64, hh * 128, hh * 128, hh, F.lds, FR_TID(F));
            P.O = WSP(bf16, A_OA);  att::ATT_UNIT_D<64, 64, 128, true, 2, VAR>(P, b, qt, (2 * hh + 1) * 64, (2 * hh + 1) * 64, hh * 128, hh * 128, hh, F.lds, FR_TID(F)); }
    }
}
template <int VAR>
__device__ __forceinline__ void phase_attn_mla(const Frame& F) {
    att::AttnP P; P.Q = WSP(bf16, A_MQ); P.ldq = 768; P.K1 = WSP(bf16, A_MKV); P.ldk1 = 1024; P.K2 = WSP(bf16, A_MKR); P.ldk2 = 32; P.V = WSP(bf16, A_MKV); P.ldv = 1024; P.O = WSP(bf16, A_OB); P.ldo = 512;
    P.pos = (const int*)F.a->in[2]; P.blkmax = WSP(int, WS_MISC); P.lut = WSP(float, WS_MISC + 4096);
    for (int p = F.vcu; p < BATCH * 8 * 8; p += F.G) {
        const int bh = p >> 3, i = p & 7, b = bh >> 3, hh = bh & 7;
        att::ATT_UNIT_M<96, 64, 64, false, 0, VAR>(P, b, 15 - i, hh * 96, hh * 128, hh * 128 + 64, hh * 64, 0, F.lds, FR_TID(F));
        att::ATT_UNIT_M<96, 64, 64, false, 0, VAR>(P, b, i, hh * 96, hh * 128, hh * 128 + 64, hh * 64, 0, F.lds, FR_TID(F));
    }
}

constexpr int NPH_DENSE = 9, NPH_MOE = 8 + 2 * MOE_NCHUNK, NPH_TOTAL = 1 + 2 * NPH_DENSE + 2 * NPH_MOE;
#define GEMM_CALL(EPI, SCHED, gm, S_, E_) pg8::gemm_phase<EPI, SCHED, true, true>(F.lds, gm, S_, E_, MY_TID())

__global__ void __launch_bounds__(NWAVES * 64, 2) mega_fwd(Args args) {
    extern __shared__ __attribute__((aligned(16))) unsigned char lds_raw[];
    Frame F;
    F.lds = (LAS unsigned char*)lds_raw; F.a = &args; F.ws = args.ws;
    const int wave_s = __builtin_amdgcn_readfirstlane((int)threadIdx.x >> 6);
#define MY_TID() ({ unsigned m1_ = ~0u; asm volatile("" : "+s"(m1_)); ((wave_s << 6) | (int)__builtin_amdgcn_mbcnt_hi(m1_, __builtin_amdgcn_mbcnt_lo(m1_, 0u))); })
    F.tid = MY_TID(); F.lane = F.tid & 63; F.wave = wave_s;
    F.G = gridDim.x; { const int bx = blockIdx.x; F.vcu = (F.G % 8 == 0) ? (bx % 8) * (F.G / 8) + bx / 8 : bx; }
    F.gw = F.vcu * NWAVES + F.wave; F.NGW = F.G * NWAVES;
    volatile LAS unsigned* MISC = (volatile LAS unsigned*)(F.lds + MISC_OFF);
    for (int u = F.tid; u < (LDS_BYTES - RING_BYTES) / 4; u += NWAVES * 64) ((LAS unsigned*)(F.lds + RING_BYTES))[u] = 0u;
    __syncthreads();
    const int lo = args.ph_lo, hi = args.ph_hi; constexpr bool fuse_ln = (LN_FUSE != 0);
    XcdBarrier bar; bar.bar = WSP(unsigned, WS_CTL) + CW_BAR; bar.x = 0; bar.st = nullptr;
    if (hi - lo > 1) bar = xcd_barrier_post(WSP(unsigned, WS_CTL) + CW_BAR, MISC + 8, F.tid == 0);
    int pc = 0;
#define PH_BEGIN if (pc >= lo && pc < hi) { { int t_ = MY_TID(); asm volatile("" : "+v"(t_)); F.tid = t_; F.lane = t_ & 63; F.wave = wave_s; F.gw = F.vcu * NWAVES + F.wave; }
#define PH_END if (pc + 1 < hi) { for (int rb = 0; rb < REP_BAR; ++rb) xcd_barrier(bar, MY_TID() == 0); } } ++pc;
    const int bx = (int)blockIdx.x;
    const float ALPHA = 1.6817928305074290f;

    PH_BEGIN for (int rep = 0; rep < REP_P0; ++rep) phase_prologue(F); PH_END

    for (int L = 0; L < DEPTH; ++L) {
        const int mj = L >> 1;
        const int convL_ = (CONV_IN_ATTN && (L & 1) == 0 && L + 1 < DEPTH) ? L + 1 : -1;
        PH_BEGIN {
#if QKV_FP8
            int bxl = bx; asm volatile("" : "+s"(bxl));
            { pg8::Gemm g{WSP(bf16, WS_XB), WSP(bf16, W_IN), T, 768, D}; pg8::StaticOrder S; S.init(T, 768, F.G, bxl);
              pg8::EpiL1 E{WSP(bf16, A_DQ), WSP(bf16, A_CQN), WSP(bf16, A_CKVN), WSP(bf16, A_MKR), WSP(float, WS_SSP), WSP(float, WS_ROPE), 0.125f * LOG2E, 12};
              for (int rep = 0; rep < REP_L1; ++rep) pg8::gemm_phase<pg8::EpiL1, pg8::StaticOrder, true, true, 0>(F.lds, g, S, E, MY_TID()); }
            { pg8::Gemm g{WSP(bf16, WS_XB8), WSP(bf16, W_QKV8), T, 5120, D / 2};
              pg8::UnevenOrder S; S.init(T, 5120, F.G, bx);
              if (LN_FUSE || F.G == 256) { S.cut = 128; S.lo = 9; S.hi = 11; } else { S.cut = 0; S.lo = 0; S.hi = (S.nwg + F.G - 1) / F.G; }
              pg8::EpiQkvG8 E{WSP(bf16, A_DQ), WSP(bf16, A_G), INF(5) + L * 2048, 0.125f * LOG2E, 1.0f / 32.0f};
              for (int rep = 0; rep < REP_L1; ++rep) pg8::gemm_phase8<pg8::EpiQkvG8, pg8::UnevenOrder, true, F8_SP2, 0>(F.lds, g, S, E, 0x7F7F7F7F, MY_TID()); }
#else
            { pg8::Gemm g{WSP(bf16, WS_XB), WSP(bf16, W_IN), T, NIN_B, D}; pg8::StaticOrder S; S.init(T, NIN_B, F.G, bx);
              pg8::EpiL1 E{WSP(bf16, A_DQ), WSP(bf16, A_CQN), WSP(bf16, A_CKVN), WSP(bf16, A_MKR), WSP(float, WS_SSP), WSP(float, WS_ROPE), 0.125f * LOG2E};
              for (int rep = 0; rep < REP_L1; ++rep) pg8::gemm_phase<pg8::EpiL1, pg8::StaticOrder, true, true, STAG_L1>(F.lds, g, S, E, MY_TID()); }
            { pg8::Gemm g{WSP(bf16, WS_XB8), WSP(bf16, W_G8), T, 2048, D / 2};
              pg8::UnevenOrder S; S.init(T, 2048, F.G, bx);
              if (F.G == 256) { S.cut = 128; S.lo = 3; S.hi = 5; } else { S.cut = 0; S.lo = 0; S.hi = (S.nwg + F.G - 1) / F.G; }
              pg8::EpiGates8 E{WSP(bf16, A_G), INF(5) + L * 2048, 1.0f / 32.0f};
              for (int rep = 0; rep < REP_L1; ++rep) pg8::gemm_phase8<pg8::EpiGates8, pg8::UnevenOrder, true, F8_SP2, 0>(F.lds, g, S, E, 0x7F7F7F7F, MY_TID()); }
#endif
        } PH_END
        PH_BEGIN {
            for (int rep = 0; rep < REP_MIX; ++rep) {
            { pg8::Gemm g{WSP(bf16, A_CQN), WSP(bf16, W_UQ), T, 768, QR}; pg8::StaticOrder S; S.init(T, 768, F.G, bx);
              pg8::EpiRopeQ E{WSP(bf16, A_MQ), WSP(float, WS_ROPE), 0.10206207261596577f * LOG2E, WSP(float, WS_SSP)};
              GEMM_CALL(pg8::EpiRopeQ, pg8::StaticOrder, g, S, E); }
            { pg8::Gemm g{WSP(bf16, A_CKVN), WSP(bf16, W_UKV), T, 1024, KVR}; pg8::StaticOrder S; S.init(T, 1024, F.G, bx);
              pg8::EpiBf16Rs E{WSP(bf16, A_MKV), 1024, WSP(float, WS_SSP)};
              GEMM_CALL(pg8::EpiBf16Rs, pg8::StaticOrder, g, S, E); }
            }
#define CONV_HOOK() do { __syncthreads(); Frame F3 = F; { const int t3_ = MY_TID(); F3.tid = t3_; F3.lane = t3_ & 63; } phase_convert(F3, convL_, 2); __syncthreads(); } while (0)
            if (convL_ >= 0 && (bx & 1) == 0) CONV_HOOK();
            phase_attn_diff<0>(F, L);
            if (convL_ >= 0 && (bx & 1) != 0) CONV_HOOK();
#undef CONV_HOOK
        } PH_END
        PH_BEGIN { phase_attn_mla<0>(F); } PH_END
        PH_BEGIN {
            for (int rep = 0; rep < REP_MIX; ++rep) {
            { pg8::Gemm g{WSP(bf16, A_OB), WSP(bf16, W_BM), T, D, 512}; pg8::StaticOrder S; S.init(T, D, F.G, bx);
              pg8::EpiGate<false> E{WSP(bf16, A_MT), WSP(bf16, A_G), nullptr, 1024};
              GEMM_CALL(pg8::EpiGate<false>, pg8::StaticOrder, g, S, E); }
            { pg8::Gemm g{WSP(bf16, A_OA), WSP(bf16, W_BD), T, D, D}; pg8::StaticOrder S; S.init(T, D, F.G, bx);
              pg8::EpiGate<true> E{WSP(bf16, A_M), WSP(bf16, A_G), WSP(bf16, A_MT), 0};
              GEMM_CALL(pg8::EpiGate<true>, pg8::StaticOrder, g, S, E); }
            }
        } PH_END
        PH_BEGIN {
            pg8::Gemm g{WSP(bf16, A_M), WSP(bf16, W_OUT), T, D, D}; pg8::StaticOrder S; S.init(T, D, F.G, bx);
            if (fuse_ln && (L & 1) == 0) {
                pg8::EpiPreLn<1> E{nullptr, WSP(bf16, WS_XB), WSP(unsigned char, WS_XB8), ALPHA, INF(18) + L * D, INF(19) + L * D, WSP(unsigned long long, WS_LNST), WSP(unsigned, WS_CTL) + CW_LN + (2 * L) * 128, F.lds + RING_BYTES + 2048};
                GEMM_CALL(pg8::EpiPreLn<1>, pg8::StaticOrder, g, S, E);
            } else {
            pg8::EpiPre<1> E{WSP(bf16, A_PRE), WSP(bf16, WS_XB), ALPHA, 1.0f};
            for (int rep = 0; rep < REP_MIX; ++rep) GEMM_CALL(pg8::EpiPre<1>, pg8::StaticOrder, g, S, E);
            }
        } PH_END
        if (!(fuse_ln && (L & 1) == 0)) {
        PH_BEGIN {
            if (L & 1) phase_ln<true, false>(F, WSP(bf16, A_PRE), INF(18) + L * D, INF(19) + L * D, INF(23) + (size_t)mj * D * NEXP, mj, false);
            else for (int rep = 0; rep < REP_LN; ++rep) phase_ln<false, false>(F, WSP(bf16, A_PRE), INF(18) + L * D, INF(19) + L * D, nullptr, 0, false);
        } PH_END
        }
        if ((L & 1) == 0) {
            PH_BEGIN {
                for (int rep = 0; rep < REP_FFN; ++rep) {
                { pg8::Gemm g{WSP(bf16, WS_XB), WSP(bf16, W_F13D), T, 2 * DENSE_FF, D}; pg8::StaticOrder S; S.init(T, 2 * DENSE_FF, F.G, bx);
                  pg8::EpiSwiGLU E{WSP(bf16, A_H), DENSE_FF};
                  pg8::gemm_phase<pg8::EpiSwiGLU, pg8::StaticOrder, true, true, STAG_H>(F.lds, g, S, E, MY_TID()); }
                { pg8::Gemm g{WSP(bf16, WS_PB), WSP(bf16, W_PP), T, D, PLE}; pg8::StaticOrder S; S.init(T, D, F.G, bx);
                  pg8::EpiPre<0> E{WSP(bf16, A_PRE), nullptr, 0.f, 1.0f};
                  GEMM_CALL(pg8::EpiPre<0>, pg8::StaticOrder, g, S, E); }
                { pg8::Gemm g{WSP(bf16, WS_XB8), WSP(bf16, W_PG), T, D, D / 2}; pg8::StaticOrder S; S.init(T, D, F.G, bx);
                  pg8::EpiPre<2> E{WSP(bf16, A_PRE), WSP(bf16, WS_XB), ALPHA, 1.0f / 32.0f};
                  pg8::gemm_phase8<pg8::EpiPre<2>, pg8::StaticOrder, true, F8_SP2, 0>(F.lds, g, S, E, 0x7F7F7F7F, MY_TID()); }
                }
            } PH_END
            PH_BEGIN {
                pg8::Gemm g{WSP(bf16, A_H), WSP(bf16, W_F2D), T, D, DENSE_FF}; pg8::StaticOrder S; S.init(T, D, F.G, bx);
                if (fuse_ln) {
                    pg8::EpiPreLn<3> E{WSP(bf16, A_PRE), WSP(bf16, WS_XB), WSP(unsigned char, WS_XB8), 1.0f, INF(29) + L * D, INF(30) + L * D, WSP(unsigned long long, WS_LNST), WSP(unsigned, WS_CTL) + CW_LN + (2 * L + 1) * 128, F.lds + RING_BYTES + 2048};
                    GEMM_CALL(pg8::EpiPreLn<3>, pg8::StaticOrder, g, S, E);
                    if (L + 1 < DEPTH) { __syncthreads(); Frame F3 = F; { const int t3_ = MY_TID(); F3.tid = t3_; F3.lane = t3_ & 63; }
                        phase_convert(F3, L + 1, CONV_IN_ATTN ? 1 : 0); }
                } else {
                pg8::EpiPre<3> E{WSP(bf16, A_PRE), nullptr, 0.f, 1.0f};
                GEMM_CALL(pg8::EpiPre<3>, pg8::StaticOrder, g, S, E);
                }
            } PH_END
            if (!fuse_ln) {
            PH_BEGIN { if (!fuse_ln) for (int rep = 0; rep < REP_LN; ++rep) phase_ln<false, false>(F, WSP(bf16, A_PRE), INF(29) + L * D, INF(30) + L * D, nullptr, 0, L == DEPTH - 1); if (L + 1 < DEPTH) for (int rep = 0; rep < REP_CONV; ++rep) phase_convert(F, L + 1, CONV_IN_ATTN ? 1 : 0); } PH_END
            }
        } else {
            PH_BEGIN {
                phase_scatter(F, mj);
                for (int rep = 0; rep < REP_PPE; ++rep) {
                { pg8::Gemm g{WSP(bf16, WS_PB), WSP(bf16, W_PP), T, D, PLE}; pg8::StaticOrder S; S.init(T, D, F.G, bx);
                  pg8::EpiPre<0> E{WSP(bf16, A_PREM), nullptr, 0.f, 1.0f};
                  GEMM_CALL(pg8::EpiPre<0>, pg8::StaticOrder, g, S, E); }
                { pg8::Gemm g{WSP(bf16, WS_XB8), WSP(bf16, W_PG), T, D, D / 2}; pg8::StaticOrder S; S.init(T, D, F.G, bx);
                  pg8::EpiPre<2> E{WSP(bf16, A_PREM), WSP(bf16, WS_XB), ALPHA, 1.0f / 32.0f};
                  pg8::gemm_phase8<pg8::EpiPre<2>, pg8::StaticOrder, true, F8_SP2, 0>(F.lds, g, S, E, 0x7F7F7F7F, MY_TID()); }
                }
            } PH_END
            for (int ch = 0; ch < MOE_NCHUNK; ++ch) {
                PH_BEGIN {
                    MoeTiles mt; moe_tiles(F, mj, mt);
                    const int tlo = ch * MOE_CHUNK_TILES; int ntc = mt.total - tlo; ntc = ntc > MOE_CHUNK_TILES ? MOE_CHUNK_TILES : ntc;
                    if (ntc > 0) {
#if MOE_FP8
                        pg8::Gemm g{WSP(bf16, A_XG), WSP(bf16, W_F13), ntc * 256, 2 * EXPERT_FF, D / 2};
                        pg8::GroupedOrder S; S.init(ntc * 256, 2 * EXPERT_FF, F.G, bx); S.tile_lo = tlo; S.estride = (size_t)2 * EXPERT_FF * D;
#else
                        pg8::Gemm g{WSP(bf16, A_XG) + (size_t)tlo * 256 * D, WSP(bf16, W_F13), ntc * 256, 2 * EXPERT_FF, D};
                        pg8::GroupedOrder S; S.init(ntc * 256, 2 * EXPERT_FF, F.G, bx); S.tile_lo = tlo; S.estride = (size_t)2 * EXPERT_FF * D * 2;
#endif
                        S.pend0 = mt.pend[0]; S.pend1 = mt.pend[1]; S.pend2 = mt.pend[2]; S.pend3 = mt.pend[3]; S.pend4 = mt.pend[4]; S.pend5 = mt.pend[5]; S.pend6 = mt.pend[6]; S.pend7 = mt.pend[7];
#if MOE_FP8
                        pg8::EpiSwiGLU8 E{WSP(unsigned char, A_HG), EXPERT_FF, 1.0f / 32.0f};
                        for (int rep = 0; rep < REP_MOE; ++rep) pg8::gemm_phase8<pg8::EpiSwiGLU8, pg8::GroupedOrder, UP_ALIGN, F8_SP2, STAG_UP>(F.lds, g, S, E, 0x7F7F7F7F, MY_TID());
#else
                        pg8::EpiSwiGLU E{WSP(bf16, A_HG), EXPERT_FF};
                        for (int rep = 0; rep < REP_MOE; ++rep) GEMM_CALL(pg8::EpiSwiGLU, pg8::GroupedOrder, g, S, E);
#endif
                    }
                } PH_END
                PH_BEGIN {
                    MoeTiles mt; moe_tiles(F, mj, mt);
                    const int tlo = ch * MOE_CHUNK_TILES; int ntc = mt.total - tlo; ntc = ntc > MOE_CHUNK_TILES ? MOE_CHUNK_TILES : ntc;
                    if (ntc > 0) {
#if MOE_FP8
                        pg8::Gemm g{WSP(bf16, A_HG), WSP(bf16, W_F2E), ntc * 256, D, EXPERT_FF / 2};
                        pg8::GroupedOrder S; S.init(ntc * 256, D, F.G, bx); S.tile_lo = tlo; S.estride = (size_t)D * EXPERT_FF;
#else
                        pg8::Gemm g{WSP(bf16, A_HG), WSP(bf16, W_F2E), ntc * 256, D, EXPERT_FF};
                        pg8::GroupedOrder S; S.init(ntc * 256, D, F.G, bx); S.tile_lo = tlo; S.estride = (size_t)D * EXPERT_FF * 2;
#endif
                        S.pend0 = mt.pend[0]; S.pend1 = mt.pend[1]; S.pend2 = mt.pend[2]; S.pend3 = mt.pend[3]; S.pend4 = mt.pend[4]; S.pend5 = mt.pend[5]; S.pend6 = mt.pend[6]; S.pend7 = mt.pend[7];
                        pg8::EpiBf16 E{WSP(bf16, A_YG) + (size_t)tlo * 256 * D, D, MOE_FP8 ? 1.0f / 128.0f : 1.0f};
#if MOE_FP8
                        for (int rep = 0; rep < REP_MOE; ++rep) pg8::gemm_phase8<pg8::EpiBf16, pg8::GroupedOrder, true, F8_SP2>(F.lds, g, S, E, 0x7F7F7F7F, MY_TID());
#else
                        for (int rep = 0; rep < REP_MOE; ++rep) GEMM_CALL(pg8::EpiBf16, pg8::GroupedOrder, g, S, E);
#endif
                    }
                    if (CONV_IN_DOWN && ch == MOE_NCHUNK - 1 && L + 1 < DEPTH) {
                        const int nwg_ = (ntc > 0 ? ntc : 0) * (D / 256), r_ = nwg_ % F.G, nl_ = F.G - r_;
                        Frame F2 = F; { const int t2_ = MY_TID(); F2.tid = t2_; F2.lane = t2_ & 63; }
                        if (r_ != 0 && 2 * nl_ >= F.G) { if (bx >= r_) { F2.gw = (bx - r_) * NWAVES + F.wave; F2.NGW = nl_ * NWAVES; phase_convert(F2, L + 1); } }
                        else phase_convert(F2, L + 1);
                    }
                } PH_END
            }
            PH_BEGIN { for (int rep = 0; rep < REP_LN; ++rep) phase_ln<false, true>(F, WSP(bf16, A_PREM), INF(29) + L * D, INF(30) + L * D, nullptr, 0, L == DEPTH - 1); if (!CONV_IN_DOWN && L + 1 < DEPTH) for (int rep = 0; rep < REP_CONV; ++rep) phase_convert(F, L + 1); } PH_END
        }
    }
#undef PH_BEGIN
#undef PH_END
}

extern "C" void kernel_launch(void* const* d_in, const int* in_sizes, int n_in, void* d_out, int out_size, void* d_ws, size_t ws_size, hipStream_t stream) {
    static int grid = 0;
    if (grid == 0) {
        if (n_in != 31 || in_sizes[0] != T * D || out_size != T * D || ws_size < WS_END) { fprintf(stderr, "kernel_launch: unexpected shapes / workspace (n_in %d, ws %zu < %zu)\n", n_in, ws_size, (size_t)WS_END); grid = -1; return; }
        int dev = 0, cus = 0, per_cu = 0;
        if (hipGetDevice(&dev) != hipSuccess || hipDeviceGetAttribute(&cus, hipDeviceAttributeMultiprocessorCount, dev) != hipSuccess) { grid = -1; return; }
        if (hipFuncSetAttribute((const void*)mega_fwd, hipFuncAttributeMaxDynamicSharedMemorySize, LDS_BYTES) != hipSuccess) { fprintf(stderr, "kernel_launch: hipFuncSetAttribute failed\n"); grid = -1; return; }
        if (hipOccupancyMaxActiveBlocksPerMultiprocessor(&per_cu, (const void*)mega_fwd, NWAVES * 64, LDS_BYTES) != hipSuccess || per_cu < 1) { fprintf(stderr, "kernel_launch: occupancy query says %d\n", per_cu); (void)hipGetLastError(); grid = -1; return; }
        grid = cus;
    }
    if (grid < 0) return;
    if (hipMemsetAsync((char*)d_ws + WS_CTL, 0, CTL_ZERO_BYTES, stream) != hipSuccess) return;
    Args a{};
    for (int i = 0; i < 31; ++i) a.in[i] = d_in[i];
    a.out = (float*)d_out; a.ws = (unsigned char*)d_ws;
    a.fuse = LN_FUSE;
    if (LN_FUSE && grid != 256) { fprintf(stderr, "kernel_launch: the fused LayerNorm exchange needs a 256-workgroup grid (got %d); build with -DLN_FUSE=0\n", grid); return; }
    const int nph = NPH_TOTAL - (a.fuse ? 4 : 0);
#if MK_PER_PHASE
    for (int p = 0; p < nph; ++p) { a.ph_lo = p; a.ph_hi = p + 1; hipLaunchKernelGGL(mega_fwd, dim3(grid), dim3(NWAVES * 64), LDS_BYTES, stream, a); }
#else
    a.ph_lo = 0; a.ph_hi = nph;
    hipLaunchKernelGGL(mega_fwd, dim3(grid), dim3(NWAVES * 64), LDS_BYTES, stream, a);
#endif
}
```

```cpp
#include <hip/hip_runtime.h>
#include <cstdio>
#include <cstdint>
#include <cmath>

#ifndef MK_PER_PHASE
#define MK_PER_PHASE 0
#endif

constexpr int BATCH = 8, SEQ = 4096, T = BATCH * SEQ, D = 1024, DEPTH = 4, PLE = 256;
constexpr int IN_COLS = 5792, NIN = 5888, NIN_B = 3840;
constexpr int QR = 384, KVR = 256, ROPE_D = 32;
constexpr int DENSE_FF = 2816, EXPERT_FF = 3584, NEXP = 8;
constexpr float LN_EPS = 1e-5f;
constexpr float LOG2E = 1.4426950408889634f;
constexpr int MOE_ROWS = 2 * T + NEXP * 256;
constexpr int MOE_CHUNK_TILES = MOE_ROWS / 256;
constexpr int MOE_NCHUNK = 1;
#ifndef MOE_FP8
#define MOE_FP8 1
#endif

#define GAS __attribute__((address_space(1)))
#define LAS __attribute__((address_space(3)))
typedef unsigned short bf16;
typedef unsigned v4u __attribute__((ext_vector_type(4)));
typedef unsigned v2u __attribute__((ext_vector_type(2)));
typedef float f32x4 __attribute__((ext_vector_type(4)));
typedef float f32x2 __attribute__((ext_vector_type(2)));
typedef float f32x16 __attribute__((ext_vector_type(16)));
typedef short bf16x8 __attribute__((ext_vector_type(8)));
typedef short s16x4 __attribute__((ext_vector_type(4)));
typedef __bf16 bf16x2_t __attribute__((ext_vector_type(2)));
typedef GAS unsigned gu32;
#define RLX_AGENT __ATOMIC_RELAXED, __HIP_MEMORY_SCOPE_AGENT
#define LDS_WAIT() asm volatile("s_waitcnt lgkmcnt(0)" ::: "memory")
#define VM_WAIT() asm volatile("s_waitcnt vmcnt(0)" ::: "memory")

__device__ __forceinline__ unsigned pk2(float lo, float hi) { f32x2 v = {lo, hi}; bf16x2_t b = __builtin_convertvector(v, bf16x2_t); return __builtin_bit_cast(unsigned, b); }
__device__ __forceinline__ float bflo(unsigned u) { return __uint_as_float(u << 16); }
__device__ __forceinline__ float bfhi(unsigned u) { return __uint_as_float(u & 0xffff0000u); }
__device__ __forceinline__ float sigmoidf_(float x) { return __builtin_amdgcn_rcpf(1.0f + __builtin_amdgcn_exp2f(-x * LOG2E)); }
__device__ __forceinline__ float shx(float v, int o, int lane) { return __uint_as_float((unsigned)__builtin_amdgcn_ds_bpermute((lane ^ o) << 2, (int)__float_as_uint(v))); }
__device__ __forceinline__ int shxi(int v, int o, int lane) { return __builtin_amdgcn_ds_bpermute((lane ^ o) << 2, v); }
__device__ __forceinline__ float wave_sum(int lane, float v) {
#pragma unroll
    for (int o = 1; o < 64; o <<= 1) v += shx(v, o, lane);
    return v;
}

#ifndef GATE_U8
#define GATE_U8 1
#endif
#define PG8_PAIR16(A_, B_) do { const auto r0_ = __builtin_amdgcn_permlane16_swap((A_).x, (B_).x, false, false); (A_).x = r0_[0]; (B_).x = r0_[1]; \
                               const auto r1_ = __builtin_amdgcn_permlane16_swap((A_).y, (B_).y, false, false); (A_).y = r1_[0]; (B_).y = r1_[1]; } while (0)
namespace pg8 {
#define PG8_LAS __attribute__((address_space(3)))
typedef unsigned short bf16_t;
typedef unsigned u32x4 __attribute__((ext_vector_type(4)));
typedef unsigned u32x2 __attribute__((ext_vector_type(2)));
constexpr int BM = 256, BK = 64, HALF = 128, HTB = HALF * BK * 2  , STAGE_BYTES = 8 * HTB, NXCD = 8, WGM = 8;

__host__ __device__ __forceinline__ int lds_byte(int r, int c) { const int st = (r >> 4) * 2 + (c >> 5), rr = r & 15, cc = c & 31, ob = rr * 64 + cc * 2; return st * 1024 + (ob ^ (((ob >> 9) & 1) << 5)); }
__host__ __device__ __forceinline__ void stage_rc(int b, int& R, int& C) { const int st = b / 1024, sb = b % 1024, swz = sb ^ (((sb >> 9) & 1) << 5); R = (st >> 1) * 16 + swz / 64; C = (st & 1) * 32 + (swz % 64) / 2; }
__host__ __device__ __forceinline__ int perm32(int rho) { const int n = rho >> 4, i = rho & 15; return 8 * (i >> 2) + 4 * n + (i & 3); }

struct Unit { int pm, pn; };
struct Gemm { const bf16_t* A; const bf16_t* Bt; int M, N, K; };

struct StaticOrder {
    int nM, nN, nwg, G, c;
    __host__ __device__ void init(int M, int N, int G_, int c_) { nM = M / BM; nN = N / BM; nwg = nM * nN; G = G_; c = c_; }
    __host__ __device__ bool next(int i, Unit& u) const {
        const long L = (long)i * G + c; if (L >= nwg) return false;
        int wgid = (int)L; { const int q = nwg / NXCD, r = nwg % NXCD, xcd = wgid % NXCD, off = wgid / NXCD; wgid = (xcd < r ? xcd * (q + 1) : r * (q + 1) + (xcd - r) * q) + off; }
        const int nig = WGM * nN, gid = wgid / nig, fm = gid * WGM, gsz = (nM - fm) < WGM ? (nM - fm) : WGM;
        u.pm = fm + ((wgid % nig) % gsz); u.pn = (wgid % nig) / gsz; return true;
    }
    __device__ __forceinline__ size_t bofs(const Unit&) const { return 0; }
    __device__ __forceinline__ void a_ready(const Unit&) const {}
    __device__ __forceinline__ void done(const Unit&) const {}
};
struct UnevenOrder : StaticOrder {
    int cut, lo, hi;
    __host__ __device__ bool next(int i, Unit& u) const {
        long L;
        if (i < lo) L = (long)i * G + c;
        else if (c >= cut && i < hi) L = (long)lo * G + (long)(c - cut) * (hi - lo) + (i - lo);
        else return false;
        if (L >= nwg) return false;
        int wgid = (int)L; { const int q = nwg / NXCD, r = nwg % NXCD, xcd = wgid % NXCD, off = wgid / NXCD; wgid = (xcd < r ? xcd * (q + 1) : r * (q + 1) + (xcd - r) * q) + off; }
        const int nig = WGM * nN, gid = wgid / nig, fm = gid * WGM, gsz = (nM - fm) < WGM ? (nM - fm) : WGM;
        u.pm = fm + ((wgid % nig) % gsz); u.pn = (wgid % nig) / gsz; return true;
    }
};
struct GroupedOrder : StaticOrder {
    int tile_lo; int pend0, pend1, pend2, pend3, pend4, pend5, pend6, pend7; size_t estride;
    __device__ __forceinline__ size_t bofs(const Unit& u) const {
        const int t = u.pm + tile_lo;
        const int e = (t >= pend0) + (t >= pend1) + (t >= pend2) + (t >= pend3) + (t >= pend4) + (t >= pend5) + (t >= pend6);
        return (size_t)e * estride;
    }
};

typedef f32x4 Acc[2][2][4][2];

struct EpiL1 {
    static constexpr bool PERM = true, AFTER_DRAIN = false;
    bf16_t* QKV; bf16_t* CQR; bf16_t* CKVR; bf16_t* MKR; float* SSP; const float* rope; float qscale; int pn_off;
    __device__ __forceinline__ void operator()(const Acc& acc, const Unit& u, int wr, int wc, int fr, int fq) const {
        const int row0 = u.pm * BM + wr * 64 + fr; const int pn = u.pn + pn_off;
        if (pn < 12) {
            bf16_t* base = QKV + (size_t)(pn >> 2) * ((size_t)T * 1024); const int col0 = (pn & 3) * 256 + wc * 32 + 8 * fq; const float sc = pn < 4 ? qscale : 1.f;
#pragma unroll
            for (int ai = 0; ai < 2; ++ai)
#pragma unroll
                for (int m = 0; m < 4; ++m) { bf16_t* rowp = base + (size_t)(row0 + ai * HALF + m * 16) * 1024 + col0;
#pragma unroll
                    for (int bj = 0; bj < 2; ++bj) { const f32x4 v0 = acc[ai][bj][m][0] * sc, v1 = acc[ai][bj][m][1] * sc;
                        u32x4 w; w.x = pk2(v0[0], v0[1]); w.y = pk2(v0[2], v0[3]); w.z = pk2(v1[0], v1[1]); w.w = pk2(v1[2], v1[3]);
                        *(u32x4*)(rowp + bj * HALF) = w; } }
            return;
        }
        const int lane = fr | (fq << 4), cl = wc * 32 + 8 * fq;
#pragma unroll
        for (int ai = 0; ai < 2; ++ai)
#pragma unroll
            for (int m = 0; m < 4; ++m) { const size_t row = (size_t)(row0 + ai * HALF + m * 16);
                float p[2];
#pragma unroll
                for (int bj = 0; bj < 2; ++bj) { const f32x4 v0 = acc[ai][bj][m][0], v1 = acc[ai][bj][m][1];
                    p[bj] = ((v0[0] * v0[0] + v0[1] * v0[1]) + (v0[2] * v0[2] + v0[3] * v0[3])) + ((v1[0] * v1[0] + v1[1] * v1[1]) + (v1[2] * v1[2] + v1[3] * v1[3]));
                    u32x4 w; w.x = pk2(v0[0], v0[1]); w.y = pk2(v0[2], v0[3]); w.z = pk2(v1[0], v1[1]); w.w = pk2(v1[2], v1[3]);
                    if (pn == 12) *(u32x4*)(CQR + row * 384 + bj * HALF + cl) = w;
                    else if (pn == 13) { if (bj == 0) *(u32x4*)(CQR + row * 384 + 256 + cl) = w; else *(u32x4*)(CKVR + row * 256 + cl) = w; }
                    else if (bj == 0) *(u32x4*)(CKVR + row * 256 + HALF + cl) = w; }
                if (pn == 12) { p[0] += p[1]; p[1] = 0.f; }
                p[0] += shx(p[0], 16, lane); p[0] += shx(p[0], 32, lane);
                if (pn == 13) { p[1] += shx(p[1], 16, lane); p[1] += shx(p[1], 32, lane); }
                if (fq == 0) { float* sp = SSP + row * 16 + wc;
                    if (pn == 12) sp[0] = p[0]; else if (pn == 13) { sp[4] = p[0]; sp[8] = p[1]; } else sp[12] = p[0]; }
                if (pn == 14 && wc == 0) {
                    const f32x4 v0 = acc[ai][1][m][0], v1 = acc[ai][1][m][1]; float mine[8] = {v0[0], v0[1], v0[2], v0[3], v1[0], v1[1], v1[2], v1[3]}, oth[8];
#pragma unroll
                    for (int i = 0; i < 8; ++i) oth[i] = shx(mine[i], 32, lane);
                    const float* rp = rope + row * 32 + 16 * (fq & 1);
                    const f32x4 r0 = *(const f32x4*)rp, r1 = *(const f32x4*)(rp + 4), r2 = *(const f32x4*)(rp + 8), r3 = *(const f32x4*)(rp + 12);
                    const float cs[8] = {r0[0], r0[2], r1[0], r1[2], r2[0], r2[2], r3[0], r3[2]}, sn[8] = {r0[1], r0[3], r1[1], r1[3], r2[1], r2[3], r3[1], r3[3]};
                    float o[8];
#pragma unroll
                    for (int i = 0; i < 8; ++i) o[i] = (fq < 2) ? mine[i] * cs[i] - oth[i] * sn[i] : oth[i] * sn[i] + mine[i] * cs[i];
                    u32x4 w; w.x = pk2(o[0], o[1]); w.y = pk2(o[2], o[3]); w.z = pk2(o[4], o[5]); w.w = pk2(o[6], o[7]);
                    *(u32x4*)(MKR + row * 32 + 8 * fq) = w; }
            }
    }
};
struct EpiGates8 {
    static constexpr bool PERM = true, AFTER_DRAIN = false;
    bf16_t* Gt; const float* bgate; float isc;
    __device__ __forceinline__ void operator()(const Acc& acc, const Unit& u, int wr, int wc, int fr, int fq) const {
        const int row0 = u.pm * BM + wr * 64 + fr; const int col0 = u.pn * 256 + wc * 32 + 8 * fq;
        f32x4 bv[2][2];
#pragma unroll
        for (int bj = 0; bj < 2; ++bj)
#pragma unroll
            for (int n = 0; n < 2; ++n) bv[bj][n] = *(const f32x4*)(bgate + col0 + bj * HALF + 4 * n);
#pragma unroll
        for (int ai = 0; ai < 2; ++ai)
#pragma unroll
            for (int m = 0; m < 4; ++m) { bf16_t* rowp = Gt + (size_t)(row0 + ai * HALF + m * 16) * 2048 + col0;
#pragma unroll
                for (int bj = 0; bj < 2; ++bj) { const f32x4 v0 = acc[ai][bj][m][0] * isc + bv[bj][0], v1 = acc[ai][bj][m][1] * isc + bv[bj][1];
                    u32x4 w; w.x = pk2(sigmoidf_(v0[0]), sigmoidf_(v0[1])); w.y = pk2(sigmoidf_(v0[2]), sigmoidf_(v0[3])); w.z = pk2(sigmoidf_(v1[0]), sigmoidf_(v1[1])); w.w = pk2(sigmoidf_(v1[2]), sigmoidf_(v1[3]));
                    *(u32x4*)(rowp + bj * HALF) = w; } }
    }
};
struct EpiQkvG8 {
    static constexpr bool PERM = true, AFTER_DRAIN = false;
    bf16_t* QKV; bf16_t* Gt; const float* bgate; float qscale, isc;
    __device__ __forceinline__ void operator()(const Acc& acc, const Unit& u, int wr, int wc, int fr, int fq) const {
        const int row0 = u.pm * BM + wr * 64 + fr; const int pn = u.pn;
        if (pn < 12) {
            bf16_t* base = QKV + (size_t)(pn >> 2) * ((size_t)T * 1024); const int col0 = (pn & 3) * 256 + wc * 32 + 8 * fq; const float sc = (pn < 4 ? qscale : 1.f) * isc;
#pragma unroll
            for (int ai = 0; ai < 2; ++ai)
#pragma unroll
                for (int m = 0; m < 4; ++m) { bf16_t* rowp = base + (size_t)(row0 + ai * HALF + m * 16) * 1024 + col0;
#pragma unroll
                    for (int bj = 0; bj < 2; ++bj) { const f32x4 v0 = acc[ai][bj][m][0] * sc, v1 = acc[ai][bj][m][1] * sc;
                        u32x4 w; w.x = pk2(v0[0], v0[1]); w.y = pk2(v0[2], v0[3]); w.z = pk2(v1[0], v1[1]); w.w = pk2(v1[2], v1[3]);
                        *(u32x4*)(rowp + bj * HALF) = w; } }
            return;
        }
        const int col0 = (pn - 12) * 256 + wc * 32 + 8 * fq;
        f32x4 bv[2][2];
#pragma unroll
        for (int bj = 0; bj < 2; ++bj)
#pragma unroll
            for (int n = 0; n < 2; ++n) bv[bj][n] = *(const f32x4*)(bgate + col0 + bj * HALF + 4 * n);
#if GATE_U8
        unsigned char* G8 = (unsigned char*)Gt;
        const int rowg = row0 + (fq & 1) * 16, colg = (pn - 12) * 256 + wc * 32 + 8 * (fq & ~1);
#define G8Q_(x) ((unsigned)(sigmoidf_(x) * 255.0f + 0.5f))
#pragma unroll
        for (int ai = 0; ai < 2; ++ai)
#pragma unroll
            for (int mp = 0; mp < 2; ++mp)
#pragma unroll
                for (int bj = 0; bj < 2; ++bj) { u32x2 w[2];
#pragma unroll
                    for (int e = 0; e < 2; ++e) { const int m = 2 * mp + e; const f32x4 v0 = acc[ai][bj][m][0] * isc + bv[bj][0], v1 = acc[ai][bj][m][1] * isc + bv[bj][1];
                        w[e].x = G8Q_(v0[0]) | (G8Q_(v0[1]) << 8) | (G8Q_(v0[2]) << 16) | (G8Q_(v0[3]) << 24); w[e].y = G8Q_(v1[0]) | (G8Q_(v1[1]) << 8) | (G8Q_(v1[2]) << 16) | (G8Q_(v1[3]) << 24); }
                    PG8_PAIR16(w[0], w[1]);
                    u32x4 q; q.x = w[0].x; q.y = w[0].y; q.z = w[1].x; q.w = w[1].y;
                    *(u32x4*)(G8 + (size_t)(rowg + ai * HALF + mp * 32) * 2048 + colg + bj * HALF) = q; }
#undef G8Q_
#else
#pragma unroll
        for (int ai = 0; ai < 2; ++ai)
#pragma unroll
            for (int m = 0; m < 4; ++m) { bf16_t* rowp = Gt + (size_t)(row0 + ai * HALF + m * 16) * 2048 + col0;
#pragma unroll
                for (int bj = 0; bj < 2; ++bj) { const f32x4 v0 = acc[ai][bj][m][0] * isc + bv[bj][0], v1 = acc[ai][bj][m][1] * isc + bv[bj][1];
                    u32x4 w; w.x = pk2(sigmoidf_(v0[0]), sigmoidf_(v0[1])); w.y = pk2(sigmoidf_(v0[2]), sigmoidf_(v0[3])); w.z = pk2(sigmoidf_(v1[0]), sigmoidf_(v1[1])); w.w = pk2(sigmoidf_(v1[2]), sigmoidf_(v1[3]));
                    *(u32x4*)(rowp + bj * HALF) = w; } }
#endif
    }
};
struct EpiRopeQ {
    static constexpr bool PERM = false, AFTER_DRAIN = false;
    bf16_t* O; const float* rope; float qscale; const float* SSP;
    __device__ __forceinline__ void operator()(const Acc& acc, const Unit& u, int wr, int wc, int fr, int fq) const {
        const int row0 = u.pm * BM + wr * 64 + fr;
        float rsq[2][4];
#pragma unroll
        for (int ai = 0; ai < 2; ++ai) { f32x4 sa[4], sb[4];
#pragma unroll
            for (int m = 0; m < 4; ++m) { const float* sp = SSP + (size_t)(row0 + ai * HALF + m * 16) * 16; sa[m] = *(const f32x4*)sp; sb[m] = *(const f32x4*)(sp + 4); }
#pragma unroll
            for (int m = 0; m < 4; ++m) { const f32x4 t = sa[m] + sb[m]; rsq[ai][m] = qscale / sqrtf(((t[0] + t[1]) + (t[2] + t[3])) * (1.0f / 384.0f) + LN_EPS); } }
        f32x4 c0[2][4], c1[2][4];
#pragma unroll
        for (int ai = 0; ai < 2; ++ai)
#pragma unroll
            for (int m = 0; m < 4; ++m) { const int row = row0 + ai * HALF + m * 16; c0[ai][m] = *(const f32x4*)(rope + (size_t)row * 32 + fq * 8); c1[ai][m] = *(const f32x4*)(rope + (size_t)row * 32 + fq * 8 + 4); }
#pragma unroll
        for (int ai = 0; ai < 2; ++ai)
#pragma unroll
            for (int mp = 0; mp < 2; ++mp)
#pragma unroll
                for (int bj = 0; bj < 2; ++bj) { const int colg = u.pn * BM + bj * HALF + wc * 32; const bool isr = ((colg >> 5) % 3) == 2;
                    u32x2 w1[2], w2[2];
#pragma unroll
                    for (int e = 0; e < 2; ++e) { const int m = 2 * mp + e;
                        const f32x4 cs0 = c0[ai][m], cs1 = c1[ai][m];
                        const f32x4 cc = {cs0[0], cs0[2], cs1[0], cs1[2]}, ss = {cs0[1], cs0[3], cs1[1], cs1[3]};
                        const f32x4 x1 = acc[ai][bj][m][0], x2 = acc[ai][bj][m][1];
                        f32x4 o1 = x1, o2 = x2; if (isr) { o1 = x1 * cc - x2 * ss; o2 = x1 * ss + x2 * cc; }
                        o1 = o1 * rsq[ai][m]; o2 = o2 * rsq[ai][m];
                        w1[e].x = pk2(o1[0], o1[1]); w1[e].y = pk2(o1[2], o1[3]); w2[e].x = pk2(o2[0], o2[1]); w2[e].y = pk2(o2[2], o2[3]); }
                    PG8_PAIR16(w1[0], w1[1]); PG8_PAIR16(w2[0], w2[1]);
                    bf16_t* p = O + (size_t)(row0 + ai * HALF + (2 * mp + (fq & 1)) * 16) * 768 + colg + 4 * (fq & ~1);
                    u32x4 q1; q1.x = w1[0].x; q1.y = w1[0].y; q1.z = w1[1].x; q1.w = w1[1].y; u32x4 q2; q2.x = w2[0].x; q2.y = w2[0].y; q2.z = w2[1].x; q2.w = w2[1].y;
                    *(u32x4*)p = q1; *(u32x4*)(p + 16) = q2; }
    }
};
struct EpiBf16 {
    static constexpr bool PERM = true, AFTER_DRAIN = false;
    bf16_t* O; int ldc; float osc;
    __device__ __forceinline__ void operator()(const Acc& acc, const Unit& u, int wr, int wc, int fr, int fq) const {
        const int row0 = u.pm * BM + wr * 64 + fr, col0 = u.pn * BM + wc * 32 + 8 * fq;
#pragma unroll
        for (int ai = 0; ai < 2; ++ai)
#pragma unroll
            for (int m = 0; m < 4; ++m) { bf16_t* rowp = O + (size_t)(row0 + ai * HALF + m * 16) * ldc + col0;
#pragma unroll
                for (int bj = 0; bj < 2; ++bj) { const f32x4 v0 = acc[ai][bj][m][0] * osc, v1 = acc[ai][bj][m][1] * osc;
                    u32x4 w; w.x = pk2(v0[0], v0[1]); w.y = pk2(v0[2], v0[3]); w.z = pk2(v1[0], v1[1]); w.w = pk2(v1[2], v1[3]);
                    *(u32x4*)(rowp + bj * HALF) = w; } }
    }
};
struct EpiBf16Rs {
    static constexpr bool PERM = true, AFTER_DRAIN = false;
    bf16_t* O; int ldc; const float* SSP;
    __device__ __forceinline__ void operator()(const Acc& acc, const Unit& u, int wr, int wc, int fr, int fq) const {
        const int row0 = u.pm * BM + wr * 64 + fr, col0 = u.pn * BM + wc * 32 + 8 * fq;
        float rsq[2][4];
#pragma unroll
        for (int ai = 0; ai < 2; ++ai) { f32x4 sa[4], sb[4];
#pragma unroll
            for (int m = 0; m < 4; ++m) { const float* sp = SSP + (size_t)(row0 + ai * HALF + m * 16) * 16 + 8; sa[m] = *(const f32x4*)sp; sb[m] = *(const f32x4*)(sp + 4); }
#pragma unroll
            for (int m = 0; m < 4; ++m) { const f32x4 t = sa[m] + sb[m]; rsq[ai][m] = 1.0f / sqrtf(((t[0] + t[1]) + (t[2] + t[3])) * (1.0f / 256.0f) + LN_EPS); } }
#pragma unroll
        for (int ai = 0; ai < 2; ++ai)
#pragma unroll
            for (int m = 0; m < 4; ++m) { bf16_t* rowp = O + (size_t)(row0 + ai * HALF + m * 16) * ldc + col0; const float osc = rsq[ai][m];
#pragma unroll
                for (int bj = 0; bj < 2; ++bj) { const f32x4 v0 = acc[ai][bj][m][0] * osc, v1 = acc[ai][bj][m][1] * osc;
                    u32x4 w; w.x = pk2(v0[0], v0[1]); w.y = pk2(v0[2], v0[3]); w.z = pk2(v1[0], v1[1]); w.w = pk2(v1[2], v1[3]);
                    *(u32x4*)(rowp + bj * HALF) = w; } }
    }
};
template <bool ADD> struct EpiGate {
    static constexpr bool PERM = true, AFTER_DRAIN = false;
    bf16_t* O; const bf16_t* Gt; const bf16_t* MT; int goff;
    __device__ __forceinline__ void operator()(const Acc& acc, const Unit& u, int wr, int wc, int fr, int fq) const {
        const int row0 = u.pm * BM + wr * 64 + fr, col0 = u.pn * BM + wc * 32 + 8 * fq;
#pragma unroll
        for (int ai = 0; ai < 2; ++ai) {
#if GATE_U8
            u32x2 gq[4][2]; u32x4 mq[4][2];
#else
            u32x4 gq[4][2], mq[4][2];
#endif
#pragma unroll
            for (int m = 0; m < 4; ++m)
#pragma unroll
                for (int bj = 0; bj < 2; ++bj) { const size_t row = (size_t)(row0 + ai * HALF + m * 16); const int col = col0 + bj * HALF;
#if GATE_U8
                    gq[m][bj] = *(const u32x2*)((const unsigned char*)Gt + row * 2048 + goff + col);
#else
                    gq[m][bj] = *(const u32x4*)(Gt + row * 2048 + goff + col);
#endif
                    if (ADD) mq[m][bj] = *(const u32x4*)(MT + row * 1024 + col); }
#pragma unroll
            for (int m = 0; m < 4; ++m)
#pragma unroll
                for (int bj = 0; bj < 2; ++bj) { const size_t row = (size_t)(row0 + ai * HALF + m * 16); const int col = col0 + bj * HALF;
                    f32x4 v0 = acc[ai][bj][m][0], v1 = acc[ai][bj][m][1];
#if GATE_U8
                    { const u32x2 gv = gq[m][bj]; const float k255 = 1.0f / 255.0f;
                      v0[0] *= (float)(gv.x & 0xffu) * k255; v0[1] *= (float)((gv.x >> 8) & 0xffu) * k255; v0[2] *= (float)((gv.x >> 16) & 0xffu) * k255; v0[3] *= (float)(gv.x >> 24) * k255;
                      v1[0] *= (float)(gv.y & 0xffu) * k255; v1[1] *= (float)((gv.y >> 8) & 0xffu) * k255; v1[2] *= (float)((gv.y >> 16) & 0xffu) * k255; v1[3] *= (float)(gv.y >> 24) * k255; }
#else
                    { const u32x4 gv = gq[m][bj];
                      v0[0] *= bflo(gv.x); v0[1] *= bfhi(gv.x); v0[2] *= bflo(gv.y); v0[3] *= bfhi(gv.y); v1[0] *= bflo(gv.z); v1[1] *= bfhi(gv.z); v1[2] *= bflo(gv.w); v1[3] *= bfhi(gv.w); }
#endif
                    if (ADD) { const u32x4 mv = mq[m][bj];
                        v0[0] += bflo(mv.x); v0[1] += bfhi(mv.x); v0[2] += bflo(mv.y); v0[3] += bfhi(mv.y); v1[0] += bflo(mv.z); v1[1] += bfhi(mv.z); v1[2] += bflo(mv.w); v1[3] += bfhi(mv.w); }
                    u32x4 w; w.x = pk2(v0[0], v0[1]); w.y = pk2(v0[2], v0[3]); w.z = pk2(v1[0], v1[1]); w.w = pk2(v1[2], v1[3]);
                    *(u32x4*)(O + row * 1024 + col) = w; }
        }
    }
};
template <int MODE> struct EpiPre {
    static constexpr bool PERM = true, AFTER_DRAIN = false;
    bf16_t* P; const bf16_t* XB; float alpha; float asc;
    __device__ __forceinline__ void operator()(const Acc& acc, const Unit& u, int wr, int wc, int fr, int fq) const {
        const int row0 = u.pm * BM + wr * 64 + fr, col0 = u.pn * BM + wc * 32 + 8 * fq;
        const float kk_ = -asc * LOG2E;
#define SG_(x) __builtin_amdgcn_rcpf(1.0f + __builtin_amdgcn_exp2f((x) * kk_))
#pragma unroll
        for (int ai = 0; ai < 2; ++ai)
#pragma unroll
          for (int mh = 0; mh < 2; ++mh) {
            u32x4 xq[2][2], pq[2][2];
#pragma unroll
            for (int mm = 0; mm < 2; ++mm)
#pragma unroll
                for (int bj = 0; bj < 2; ++bj) { const int m = 2 * mh + mm; const size_t o = (size_t)(row0 + ai * HALF + m * 16) * 1024 + col0 + bj * HALF;
                    if (MODE == 1 || MODE == 2) xq[mm][bj] = *(const u32x4*)(XB + o);
                    if (MODE == 2 || MODE == 3) pq[mm][bj] = *(const u32x4*)(P + o); }
            __builtin_amdgcn_sched_barrier(0);
#pragma unroll
            for (int mm = 0; mm < 2; ++mm)
#pragma unroll
                for (int bj = 0; bj < 2; ++bj) { const int m = 2 * mh + mm; const size_t o = (size_t)(row0 + ai * HALF + m * 16) * 1024 + col0 + bj * HALF; const f32x4 a0 = acc[ai][bj][m][0], a1 = acc[ai][bj][m][1]; float r[8];
                    if (MODE == 0) { r[0] = a0[0]; r[1] = a0[1]; r[2] = a0[2]; r[3] = a0[3]; r[4] = a1[0]; r[5] = a1[1]; r[6] = a1[2]; r[7] = a1[3]; }
                    else if (MODE == 1) { const u32x4 xv = xq[mm][bj];
                        r[0] = bflo(xv.x) * alpha + a0[0]; r[1] = bfhi(xv.x) * alpha + a0[1]; r[2] = bflo(xv.y) * alpha + a0[2]; r[3] = bfhi(xv.y) * alpha + a0[3];
                        r[4] = bflo(xv.z) * alpha + a1[0]; r[5] = bfhi(xv.z) * alpha + a1[1]; r[6] = bflo(xv.w) * alpha + a1[2]; r[7] = bfhi(xv.w) * alpha + a1[3]; }
                    else if (MODE == 2) { const u32x4 xv = xq[mm][bj]; const u32x4 pv = pq[mm][bj];
                        r[0] = bflo(xv.x) * alpha + SG_(a0[0]) * bflo(pv.x); r[1] = bfhi(xv.x) * alpha + SG_(a0[1]) * bfhi(pv.x); r[2] = bflo(xv.y) * alpha + SG_(a0[2]) * bflo(pv.y); r[3] = bfhi(xv.y) * alpha + SG_(a0[3]) * bfhi(pv.y);
                        r[4] = bflo(xv.z) * alpha + SG_(a1[0]) * bflo(pv.z); r[5] = bfhi(xv.z) * alpha + SG_(a1[1]) * bfhi(pv.z); r[6] = bflo(xv.w) * alpha + SG_(a1[2]) * bflo(pv.w); r[7] = bfhi(xv.w) * alpha + SG_(a1[3]) * bfhi(pv.w); }
                    else { const u32x4 pv = pq[mm][bj];
                        r[0] = bflo(pv.x) + a0[0]; r[1] = bfhi(pv.x) + a0[1]; r[2] = bflo(pv.y) + a0[2]; r[3] = bfhi(pv.y) + a0[3]; r[4] = bflo(pv.z) + a1[0]; r[5] = bfhi(pv.z) + a1[1]; r[6] = bflo(pv.w) + a1[2]; r[7] = bfhi(pv.w) + a1[3]; }
                    u32x4 w; w.x = pk2(r[0], r[1]); w.y = pk2(r[2], r[3]); w.z = pk2(r[4], r[5]); w.w = pk2(r[6], r[7]);
                    *(u32x4*)(P + o) = w; }
            __builtin_amdgcn_sched_barrier(0);
          }
    }
};
#undef SG_

template <int MODE> struct EpiPreLn {
    static constexpr bool PERM = true, AFTER_DRAIN = false;
    const bf16_t* P; bf16_t* XB; unsigned char* XB8; float alpha; const float* gam; const float* bet;
    unsigned long long* ST; unsigned* FLAG; LAS unsigned char* sl;
    __device__ __forceinline__ void operator()(const Acc& acc, const Unit& u, int wr, int wc, int fr, int fq) const {
        const int lane = fr | (fq << 4), t = ((wr * 4 + wc) << 6) | lane;
        const int row0 = u.pm * BM + wr * 64 + fr, col0 = u.pn * BM + wc * 32 + 8 * fq;
        Acc pre; float s1[2][4], s2[2][4];
#pragma unroll
        for (int ai = 0; ai < 2; ++ai)
#pragma unroll
          for (int mh = 0; mh < 2; ++mh) {
            u32x4 xq[2][2];
#pragma unroll
            for (int mm = 0; mm < 2; ++mm)
#pragma unroll
                for (int bj = 0; bj < 2; ++bj) { const int m = 2 * mh + mm; const size_t o = (size_t)(row0 + ai * HALF + m * 16) * 1024 + col0 + bj * HALF;
                    xq[mm][bj] = *(const u32x4*)((MODE == 1 ? (const bf16_t*)XB : P) + o); }
            __builtin_amdgcn_sched_barrier(0);
#pragma unroll
            for (int mm = 0; mm < 2; ++mm) { const int m = 2 * mh + mm; float a1 = 0.f, a2 = 0.f;
#pragma unroll
                for (int bj = 0; bj < 2; ++bj) { const f32x4 a0 = acc[ai][bj][m][0], b0 = acc[ai][bj][m][1]; const u32x4 xv = xq[mm][bj]; const float ka = (MODE == 1) ? alpha : 1.0f;
                    f32x4 r0, r1;
                    r0[0] = bflo(xv.x) * ka + a0[0]; r0[1] = bfhi(xv.x) * ka + a0[1]; r0[2] = bflo(xv.y) * ka + a0[2]; r0[3] = bfhi(xv.y) * ka + a0[3];
                    r1[0] = bflo(xv.z) * ka + b0[0]; r1[1] = bfhi(xv.z) * ka + b0[1]; r1[2] = bflo(xv.w) * ka + b0[2]; r1[3] = bfhi(xv.w) * ka + b0[3];
                    asm volatile("" : "+v"(r0), "+v"(r1));
                    pre[ai][bj][m][0] = r0; pre[ai][bj][m][1] = r1;
                    a1 += ((r0[0] + r0[1]) + (r0[2] + r0[3])) + ((r1[0] + r1[1]) + (r1[2] + r1[3]));
                    a2 += ((r0[0] * r0[0] + r0[1] * r0[1]) + (r0[2] * r0[2] + r0[3] * r0[3])) + ((r1[0] * r1[0] + r1[1] * r1[1]) + (r1[2] * r1[2] + r1[3] * r1[3])); }
                asm volatile("" : "+v"(a1), "+v"(a2)); s1[ai][m] = a1; s2[ai][m] = a2; }
            __builtin_amdgcn_sched_barrier(0);
          }
#pragma unroll
        for (int ai = 0; ai < 2; ++ai)
#pragma unroll
            for (int m = 0; m < 4; ++m) { float a = s1[ai][m], b = s2[ai][m]; a += shx(a, 16, lane); b += shx(b, 16, lane); a += shx(a, 32, lane); b += shx(b, 32, lane);
                if (fq == 0) { const int rl = ai * HALF + wr * 64 + m * 16 + fr; f32x2 w = {a, b}; *(LAS f32x2*)(sl + (rl * 4 + wc) * 8) = w; } }
        int row0b = row0, col0b = col0; asm volatile("" : "+v"(row0b), "+v"(col0b));
        f32x4 gv[2][2], bv[2][2];
#pragma unroll
        for (int bj = 0; bj < 2; ++bj)
#pragma unroll
            for (int n = 0; n < 2; ++n) { gv[bj][n] = *(const f32x4*)(gam + col0b + bj * HALF + 4 * n); bv[bj][n] = *(const f32x4*)(bet + col0b + bj * HALF + 4 * n); }
        __syncthreads();
        unsigned long long* stp = ST + ((size_t)u.pm * 4) * 256 + t;
        if (t < 256) { const LAS f32x2* p = (const LAS f32x2*)(sl + t * 32); const f32x2 w = (p[0] + p[1]) + (p[2] + p[3]);
            __hip_atomic_store(stp + (size_t)u.pn * 256, __builtin_bit_cast(unsigned long long, w), __ATOMIC_RELAXED, __HIP_MEMORY_SCOPE_AGENT); }
        asm volatile("s_waitcnt vmcnt(0)" ::: "memory");
        __syncthreads();
        if (t == 0) { __hip_atomic_fetch_add(FLAG + u.pm, 1u, __ATOMIC_RELAXED, __HIP_MEMORY_SCOPE_AGENT);
            for (int spin = 0; spin < (1 << 20) && __hip_atomic_load(FLAG + u.pm, __ATOMIC_RELAXED, __HIP_MEMORY_SCOPE_AGENT) < 4u; ++spin) __builtin_amdgcn_s_sleep(1); }
        __syncthreads();
        if (t < 256) {
            const unsigned long long q0 = __hip_atomic_load(stp, __ATOMIC_RELAXED, __HIP_MEMORY_SCOPE_AGENT), q1 = __hip_atomic_load(stp + 256, __ATOMIC_RELAXED, __HIP_MEMORY_SCOPE_AGENT),
                                     q2 = __hip_atomic_load(stp + 512, __ATOMIC_RELAXED, __HIP_MEMORY_SCOPE_AGENT), q3 = __hip_atomic_load(stp + 768, __ATOMIC_RELAXED, __HIP_MEMORY_SCOPE_AGENT);
            const f32x2 w = (__builtin_bit_cast(f32x2, q0) + __builtin_bit_cast(f32x2, q1)) + (__builtin_bit_cast(f32x2, q2) + __builtin_bit_cast(f32x2, q3));
            const float mean = w[0] * (1.0f / 1024.0f); float var = w[1] * (1.0f / 1024.0f) - mean * mean; var = var < 0.f ? 0.f : var;
            f32x2 mr = {mean, 1.0f / sqrtf(var + LN_EPS)}; *(LAS f32x2*)(sl + 8192 + t * 8) = mr; }
        __syncthreads();
        const int fqe = (col0b >> 3) & 1;
#pragma unroll
        for (int ai = 0; ai < 2; ++ai)
#pragma unroll
            for (int mp = 0; mp < 2; ++mp) { f32x2 mr[2];
#pragma unroll
                for (int e = 0; e < 2; ++e) mr[e] = *(const LAS f32x2*)(sl + 8192 + (ai * HALF + wr * 64 + (2 * mp + e) * 16 + fr) * 8);
#pragma unroll
                for (int bj = 0; bj < 2; ++bj) { u32x2 w8[2];
#pragma unroll
                    for (int e = 0; e < 2; ++e) { const int m = 2 * mp + e; const size_t o = (size_t)(row0b + ai * HALF + m * 16) * 1024 + col0b;
                        const f32x4 y0 = (pre[ai][bj][m][0] - mr[e][0]) * mr[e][1] * gv[bj][0] + bv[bj][0], y1 = (pre[ai][bj][m][1] - mr[e][0]) * mr[e][1] * gv[bj][1] + bv[bj][1];
                        u32x4 w; w.x = pk2(y0[0], y0[1]); w.y = pk2(y0[2], y0[3]); w.z = pk2(y1[0], y1[1]); w.w = pk2(y1[2], y1[3]);
                        *(u32x4*)(XB + o + bj * HALF) = w;
                        int q0 = __builtin_amdgcn_cvt_pk_fp8_f32(y0[0], y0[1], 0, false); q0 = __builtin_amdgcn_cvt_pk_fp8_f32(y0[2], y0[3], q0, true);
                        int q1 = __builtin_amdgcn_cvt_pk_fp8_f32(y1[0], y1[1], 0, false); q1 = __builtin_amdgcn_cvt_pk_fp8_f32(y1[2], y1[3], q1, true);
                        w8[e].x = (unsigned)q0; w8[e].y = (unsigned)q1; }
                    PG8_PAIR16(w8[0], w8[1]);
                    u32x4 q; q.x = w8[0].x; q.y = w8[0].y; q.z = w8[1].x; q.w = w8[1].y;
                    *(u32x4*)(XB8 + (size_t)(row0b + ai * HALF + (2 * mp + fqe) * 16) * 1024 + (col0b - 8 * fqe) + bj * HALF) = q; } }
    }
};
struct EpiSwiGLU {
    static constexpr bool PERM = true, AFTER_DRAIN = false;
    bf16_t* H; int ldc;
    __device__ __forceinline__ void operator()(const Acc& acc, const Unit& u, int wr, int wc, int fr, int fq) const {
        const int rowb = u.pm * BM + wr * 64 + fr + (fq & 1) * 16, colb = (u.pn * BM + wc * 32 + 8 * (fq & ~1)) >> 1;
#pragma unroll
        for (int ai = 0; ai < 2; ++ai)
#pragma unroll
            for (int mp = 0; mp < 2; ++mp)
#pragma unroll
                for (int bj = 0; bj < 2; ++bj) { u32x2 w[2];
#pragma unroll
                    for (int e = 0; e < 2; ++e) { const int m = 2 * mp + e; const f32x4 v0 = acc[ai][bj][m][0], v1 = acc[ai][bj][m][1];
                        const float h0 = v0[0] * sigmoidf_(v0[0]) * v0[1], h1 = v0[2] * sigmoidf_(v0[2]) * v0[3], h2 = v1[0] * sigmoidf_(v1[0]) * v1[1], h3 = v1[2] * sigmoidf_(v1[2]) * v1[3];
                        w[e].x = pk2(h0, h1); w[e].y = pk2(h2, h3); }
                    PG8_PAIR16(w[0], w[1]);
                    u32x4 q; q.x = w[0].x; q.y = w[0].y; q.z = w[1].x; q.w = w[1].y;
                    *(u32x4*)(H + (size_t)(rowb + ai * HALF + mp * 32) * ldc + colb + bj * (HALF / 2)) = q; }
    }
};

struct EpiSwiGLU8 {
    static constexpr bool PERM = true, AFTER_DRAIN = false;
    unsigned char* H; int ldc; float isc;
    __device__ __forceinline__ void operator()(const Acc& acc, const Unit& u, int wr, int wc, int fr, int fq) const {
        const int rowb = u.pm * BM + wr * 64 + fr + fq * 16, colb = (u.pn * BM + wc * 32) >> 1;
#pragma unroll
        for (int ai = 0; ai < 2; ++ai)
#pragma unroll
            for (int bj = 0; bj < 2; ++bj) { unsigned d[4];
#pragma unroll
                for (int m = 0; m < 4; ++m) { const f32x4 v0 = acc[ai][bj][m][0] * isc, v1 = acc[ai][bj][m][1] * isc;
                    const float h0 = v0[0] * sigmoidf_(v0[0]) * v0[1], h1 = v0[2] * sigmoidf_(v0[2]) * v0[3], h2 = v1[0] * sigmoidf_(v1[0]) * v1[1], h3 = v1[2] * sigmoidf_(v1[2]) * v1[3];
                    int w = __builtin_amdgcn_cvt_pk_fp8_f32(h0, h1, 0, false); w = __builtin_amdgcn_cvt_pk_fp8_f32(h2, h3, w, true); d[m] = (unsigned)w; }
                { const auto r = __builtin_amdgcn_permlane32_swap(d[0], d[2], false, false); d[0] = r[0]; d[2] = r[1]; }
                { const auto r = __builtin_amdgcn_permlane32_swap(d[1], d[3], false, false); d[1] = r[0]; d[3] = r[1]; }
                { const auto r = __builtin_amdgcn_permlane16_swap(d[0], d[1], false, false); d[0] = r[0]; d[1] = r[1]; }
                { const auto r = __builtin_amdgcn_permlane16_swap(d[2], d[3], false, false); d[2] = r[0]; d[3] = r[1]; }
                u32x4 q; q.x = d[0]; q.y = d[1]; q.z = d[2]; q.w = d[3];
                *(u32x4*)(H + (size_t)(rowb + ai * HALF) * ldc + colb + bj * (HALF / 2)) = q; }
    }
};

template <class Epi, class Sched, bool ALIGN_EPI = false, bool SP2 = false, int STAGGER_TICKS = 0>
__device__ __forceinline__ void gemm_phase(PG8_LAS unsigned char* lds, const Gemm g, const Sched& S, const Epi& E, const int tid_in) {
    int tid_ = tid_in; asm volatile("" : "+v"(tid_));
    const int tid = tid_, wid = __builtin_amdgcn_readfirstlane(tid >> 6), lane = tid & 63, wr = wid >> 2, wc = wid & 3, fr = lane & 15, fq = lane >> 4;
    int K_ = g.K; asm volatile("" : "+s"(K_)); const int K = K_, nt = K / BK;
    unsigned voffA[2], voffB[2];
#pragma unroll
    for (int i = 0; i < 2; ++i) { int R, C; stage_rc(tid * 16 + i * 8192, R, C); const int Rb = Epi::PERM ? ((R & ~31) + perm32(R & 31)) : R;
        voffA[i] = (unsigned)(R * K + C) * 2u; voffB[i] = (unsigned)(Rb * K + C) * 2u; }
    const size_t kstep = (size_t)(BK * 2);
    const size_t hstep = (size_t)HALF * K * 2;
    const size_t tstep = 2 * hstep;
    const unsigned ldsw = (unsigned)wid * 1024u;
    const int aoff = lds_byte(wr * 64 + fr, fq * 8), boff = lds_byte(wc * 32 + fr, fq * 8);
#define PG8_SA(b, h) (((b) * 2 + (h)) * HTB)
#define PG8_SB(b, h) ((4 + (b) * 2 + (h)) * HTB)
#define PG8_STAGE(bufoff, gbase, voff) do { _Pragma("unroll") for (int _i = 0; _i < 2; ++_i) \
        __builtin_amdgcn_global_load_lds((const unsigned*)((const char*)(gbase) + (voff)[_i]), (PG8_LAS unsigned*)(lds + (bufoff) + ldsw + _i * 8192), 16, 0, 0); } while (0)
#define PG8_LDA(dst, b, h) do { _Pragma("unroll") for (int m = 0; m < 4; ++m) _Pragma("unroll") for (int k = 0; k < 2; ++k) dst[m][k] = *(const PG8_LAS bf16x8*)(lds + PG8_SA(b, h) + aoff + m * 2048 + k * 1024); } while (0)
#define PG8_LDB(dst, b, h) do { _Pragma("unroll") for (int n = 0; n < 2; ++n) _Pragma("unroll") for (int k = 0; k < 2; ++k) dst[n][k] = *(const PG8_LAS bf16x8*)(lds + PG8_SB(b, h) + boff + n * 2048 + k * 1024); } while (0)
#define PG8_MMA(ai, bj, At, Bt) do { __builtin_amdgcn_s_setprio(1); _Pragma("unroll") for (int m = 0; m < 4; ++m) _Pragma("unroll") for (int n = 0; n < 2; ++n) _Pragma("unroll") for (int k = 0; k < 2; ++k) \
        acc[ai][bj][m][n] = __builtin_amdgcn_mfma_f32_16x16x32_bf16(Bt[n][k], At[m][k], acc[ai][bj][m][n], 0, 0, 0); __builtin_amdgcn_s_setprio(0); } while (0)
#define PG8_WAIT_V(n) asm volatile("s_waitcnt vmcnt(" #n ")" ::: "memory")
#define PG8_WAIT_L(n) asm volatile("s_waitcnt lgkmcnt(" #n ")" ::: "memory")
#define PG8_BAR __builtin_amdgcn_s_barrier()
#define PG8_SCHED __builtin_amdgcn_sched_barrier(0)
    Unit cur, nxt; int ui = 0;
    if (!S.next(0, cur)) return;
#if GEMM_STAGGER
    if (STAGGER_TICKS > 0 && ((blockIdx.x >> 3) & 1)) {
        const unsigned long long t0_ = __builtin_amdgcn_s_memrealtime(); while (__builtin_amdgcn_s_memrealtime() - t0_ < (unsigned long long)STAGGER_TICKS) __builtin_amdgcn_s_sleep(8); }
#endif
    f32x4 acc[2][2][4][2];
#pragma unroll
    for (int a = 0; a < 2; ++a)
#pragma unroll
        for (int b = 0; b < 2; ++b)
#pragma unroll
            for (int m = 0; m < 4; ++m)
#pragma unroll
                for (int n = 0; n < 2; ++n) acc[a][b][m][n] = (f32x4){0.f, 0.f, 0.f, 0.f};
    bf16x8 At[4][2], B0[2][2], B1[2][2];
    const char* cA = (const char*)g.A + (size_t)cur.pm * tstep; const char* cB = (const char*)g.Bt + (size_t)cur.pn * tstep + S.bofs(cur);
    S.a_ready(cur);
    if constexpr (SP2) {
        PG8_STAGE(PG8_SB(0, 0), cB, voffB); PG8_STAGE(PG8_SB(0, 1), cB + hstep, voffB); PG8_STAGE(PG8_SA(0, 0), cA, voffA); PG8_STAGE(PG8_SA(0, 1), cA + hstep, voffA);
        if (wr == 1) PG8_BAR;
        PG8_WAIT_V(2); PG8_BAR;
        PG8_STAGE(PG8_SB(1, 0), cB + kstep, voffB); PG8_STAGE(PG8_SA(1, 0), cA + kstep, voffA); PG8_STAGE(PG8_SB(1, 1), cB + hstep + kstep, voffB);
        PG8_WAIT_V(6); PG8_BAR;
    } else {
        PG8_STAGE(PG8_SB(0, 0), cB, voffB); PG8_STAGE(PG8_SA(0, 0), cA, voffA); PG8_STAGE(PG8_SB(0, 1), cB + hstep, voffB); PG8_STAGE(PG8_SA(0, 1), cA + hstep, voffA);
        if (wr == 1) PG8_BAR;
        PG8_WAIT_V(4); PG8_BAR;
        PG8_STAGE(PG8_SB(1, 0), cB + kstep, voffB); PG8_STAGE(PG8_SA(1, 0), cA + kstep, voffA); PG8_STAGE(PG8_SB(1, 1), cB + hstep + kstep, voffB);
        PG8_WAIT_V(6); PG8_BAR;
    }
    for (;;) {
        const bool has_next = S.next(ui + 1, nxt);
        const char* nA = has_next ? (const char*)g.A + (size_t)nxt.pm * tstep : cA; const char* nB = has_next ? (const char*)g.Bt + (size_t)nxt.pn * tstep + S.bofs(nxt) : cB;
#pragma nounroll
        for (int t = 0; t < nt; t += 2) {
            const bool last = (t == nt - 2);
            const char* a1 = cA + (size_t)(t + 1) * kstep;
            const char* a2 = last ? nA : cA + (size_t)(t + 2) * kstep; const char* b2 = last ? nB : cB + (size_t)(t + 2) * kstep;
            const char* a3 = a2 + kstep; const char* b3 = b2 + kstep;
            if (last && has_next) S.a_ready(nxt);
            if constexpr (SP2) {
            PG8_LDB(B0, 0, 0); PG8_LDB(B1, 0, 1); PG8_SCHED; PG8_LDA(At, 0, 0); PG8_STAGE(PG8_SA(1, 1), a1 + hstep, voffA);
            PG8_WAIT_V(8); PG8_WAIT_L(0); PG8_BAR; PG8_MMA(0, 0, At, B0); PG8_MMA(0, 1, At, B1); PG8_BAR; PG8_SCHED;
            PG8_LDA(At, 0, 1); PG8_STAGE(PG8_SB(0, 0), b2, voffB); PG8_STAGE(PG8_SB(0, 1), b2 + hstep, voffB); PG8_STAGE(PG8_SA(0, 0), a2, voffA);
            PG8_WAIT_V(8); PG8_WAIT_L(0); PG8_BAR; PG8_MMA(1, 0, At, B0); PG8_MMA(1, 1, At, B1); PG8_BAR; PG8_SCHED;
            PG8_LDB(B0, 1, 0); PG8_LDB(B1, 1, 1); PG8_SCHED; PG8_LDA(At, 1, 0); PG8_STAGE(PG8_SA(0, 1), a2 + hstep, voffA);
            PG8_WAIT_V(8); PG8_WAIT_L(0); PG8_BAR; PG8_MMA(0, 0, At, B0); PG8_MMA(0, 1, At, B1); PG8_BAR; PG8_SCHED;
            PG8_LDA(At, 1, 1); PG8_STAGE(PG8_SB(1, 0), b3, voffB); PG8_STAGE(PG8_SB(1, 1), b3 + hstep, voffB); PG8_STAGE(PG8_SA(1, 0), a3, voffA);
            PG8_WAIT_V(8); PG8_WAIT_L(0); PG8_BAR; PG8_MMA(1, 0, At, B0); PG8_MMA(1, 1, At, B1); PG8_BAR; PG8_SCHED;
            } else {
            PG8_LDB(B0, 0, 0); PG8_SCHED; PG8_LDA(At, 0, 0); PG8_STAGE(PG8_SA(1, 1), a1 + hstep, voffA);
            PG8_WAIT_L(8); PG8_BAR; PG8_WAIT_L(0); PG8_MMA(0, 0, At, B0); PG8_BAR; PG8_SCHED;
            PG8_LDB(B1, 0, 1); PG8_STAGE(PG8_SB(0, 0), b2, voffB);
            PG8_BAR; PG8_WAIT_L(0); PG8_MMA(0, 1, At, B1); PG8_BAR;
            PG8_LDA(At, 0, 1); PG8_STAGE(PG8_SA(0, 0), a2, voffA);
            PG8_BAR; PG8_WAIT_L(0); PG8_MMA(1, 0, At, B0); PG8_BAR; PG8_SCHED;
            PG8_STAGE(PG8_SB(0, 1), b2 + hstep, voffB);
            PG8_WAIT_V(6); PG8_BAR; PG8_MMA(1, 1, At, B1); PG8_BAR;
            PG8_LDB(B0, 1, 0); PG8_SCHED; PG8_LDA(At, 1, 0); PG8_STAGE(PG8_SA(0, 1), a2 + hstep, voffA);
            PG8_WAIT_L(8); PG8_BAR; PG8_WAIT_L(0); PG8_MMA(0, 0, At, B0); PG8_BAR; PG8_SCHED;
            PG8_LDB(B1, 1, 1); PG8_STAGE(PG8_SB(1, 0), b3, voffB);
            PG8_BAR; PG8_WAIT_L(0); PG8_MMA(0, 1, At, B1); PG8_BAR;
            PG8_LDA(At, 1, 1); PG8_STAGE(PG8_SA(1, 0), a3, voffA);
            PG8_BAR; PG8_WAIT_L(0); PG8_MMA(1, 0, At, B0); PG8_BAR; PG8_SCHED;
            PG8_STAGE(PG8_SB(1, 1), b3 + hstep, voffB);
            PG8_WAIT_V(6); PG8_BAR; PG8_MMA(1, 1, At, B1); PG8_BAR;
            }
        }
        if constexpr (ALIGN_EPI) { if (wr == 0) PG8_BAR; }
        if constexpr (!Epi::AFTER_DRAIN) { unsigned m1_ = ~0u; asm volatile("" : "+s"(m1_)); const int le_ = (int)__builtin_amdgcn_mbcnt_hi(m1_, __builtin_amdgcn_mbcnt_lo(m1_, 0u));
            E(acc, cur, wr, wc, le_ & 15, le_ >> 4); S.done(cur); }
        if (!has_next) break;
#pragma unroll
        for (int a = 0; a < 2; ++a)
#pragma unroll
            for (int b = 0; b < 2; ++b)
#pragma unroll
                for (int m = 0; m < 4; ++m)
#pragma unroll
                    for (int n = 0; n < 2; ++n) acc[a][b][m][n] = (f32x4){0.f, 0.f, 0.f, 0.f};
        cur = nxt; cA = nA; cB = nB; ++ui;
        if constexpr (ALIGN_EPI) { if (wr == 1) PG8_BAR; }
    }
    PG8_WAIT_V(0);
    if constexpr (!ALIGN_EPI) { if (wr == 0) PG8_BAR; }
    PG8_BAR;
    if constexpr (Epi::AFTER_DRAIN) { E.fused(acc, cur, wr, wc, fr, fq, lds, wid, lane); S.done(cur); }
#undef PG8_SA
#undef PG8_SB
#undef PG8_STAGE
#undef PG8_LDA
#undef PG8_LDB
#undef PG8_MMA
#undef PG8_WAIT_V
#undef PG8_WAIT_L
#undef PG8_BAR
#undef PG8_SCHED
}
typedef int i32x4_ __attribute__((ext_vector_type(4)));
typedef int i32x8_ __attribute__((ext_vector_type(8)));
template <class Epi, class Sched, bool ALIGN_EPI = false, bool SP2 = false, int STAGGER_TICKS = 0>
__device__ __forceinline__ void gemm_phase8(PG8_LAS unsigned char* lds, const Gemm g, const Sched& S, const Epi& E, const int sc1, const int tid_in) {
    int tid_ = tid_in; asm volatile("" : "+v"(tid_));
    const int tid = tid_, wid = __builtin_amdgcn_readfirstlane(tid >> 6), lane = tid & 63, wr = wid >> 2, wc = wid & 3, fr = lane & 15, fq = lane >> 4;
    int K_ = g.K; asm volatile("" : "+s"(K_)); const int K = K_, nt = K / BK;
    unsigned voffA[2], voffB[2];
#pragma unroll
    for (int i = 0; i < 2; ++i) { int R, C; stage_rc(tid * 16 + i * 8192, R, C); const int Rb = Epi::PERM ? ((R & ~31) + perm32(R & 31)) : R;
        voffA[i] = (unsigned)(R * K + C) * 2u; voffB[i] = (unsigned)(Rb * K + C) * 2u; }
    const size_t kstep = (size_t)(BK * 2);
    const size_t hstep = (size_t)HALF * K * 2;
    const size_t tstep = 2 * hstep;
    const unsigned ldsw = (unsigned)wid * 1024u;
    const int cq8 = (fq >> 1) * 32 + 16 * (fq & 1);
    const int aoff = lds_byte(wr * 64 + fr, cq8), boff = lds_byte(wc * 32 + fr, cq8);
#define PG8_SA(b, h) (((b) * 2 + (h)) * HTB)
#define PG8_SB(b, h) ((4 + (b) * 2 + (h)) * HTB)
#define PG8_STAGE(bufoff, gbase, voff) do { _Pragma("unroll") for (int _i = 0; _i < 2; ++_i) \
        __builtin_amdgcn_global_load_lds((const unsigned*)((const char*)(gbase) + (voff)[_i]), (PG8_LAS unsigned*)(lds + (bufoff) + ldsw + _i * 8192), 16, 0, 0); } while (0)
#define PG8_LD16(off) (*(const PG8_LAS i32x4_*)(lds + (off)))
#define PG8_LDA(dst, b, h) do { _Pragma("unroll") for (int m = 0; m < 4; ++m) dst[m] = __builtin_shufflevector(PG8_LD16(PG8_SA(b, h) + aoff + m * 2048), PG8_LD16(PG8_SA(b, h) + aoff + m * 2048 + 16), 0, 1, 2, 3, 4, 5, 6, 7); } while (0)
#define PG8_LDB(dst, b, h) do { _Pragma("unroll") for (int n = 0; n < 2; ++n) dst[n] = __builtin_shufflevector(PG8_LD16(PG8_SB(b, h) + boff + n * 2048), PG8_LD16(PG8_SB(b, h) + boff + n * 2048 + 16), 0, 1, 2, 3, 4, 5, 6, 7); } while (0)
#define PG8_MMA(ai, bj, At, Bt) do { __builtin_amdgcn_s_setprio(1); _Pragma("unroll") for (int m = 0; m < 4; ++m) _Pragma("unroll") for (int n = 0; n < 2; ++n) \
        asm volatile("v_mfma_scale_f32_16x16x128_f8f6f4 %0, %1, %2, %0, %3, %3 op_sel_hi:[0,0,0]" : "+v"(acc[ai][bj][m][n]) : "v"(Bt[n]), "v"(At[m]), "v"(sc1)); __builtin_amdgcn_s_setprio(0); } while (0)
#define PG8_WAIT_V(n) asm volatile("s_waitcnt vmcnt(" #n ")" ::: "memory")
#define PG8_WAIT_L(n) asm volatile("s_waitcnt lgkmcnt(" #n ")" ::: "memory")
#define PG8_BAR __builtin_amdgcn_s_barrier()
#define PG8_SCHED __builtin_amdgcn_sched_barrier(0)
    Unit cur, nxt; int ui = 0;
    if (!S.next(0, cur)) return;
#if GEMM_STAGGER
    if (STAGGER_TICKS > 0 && ((blockIdx.x >> 3) & 1)) {
        const unsigned long long t0_ = __builtin_amdgcn_s_memrealtime(); while (__builtin_amdgcn_s_memrealtime() - t0_ < (unsigned long long)STAGGER_TICKS) __builtin_amdgcn_s_sleep(8); }
#endif
    f32x4 acc[2][2][4][2];
#pragma unroll
    for (int a = 0; a < 2; ++a)
#pragma unroll
        for (int b = 0; b < 2; ++b)
#pragma unroll
            for (int m = 0; m < 4; ++m)
#pragma unroll
                for (int n = 0; n < 2; ++n) acc[a][b][m][n] = (f32x4){0.f, 0.f, 0.f, 0.f};
    i32x8_ At[4], B0[2], B1[2];
    const char* cA = (const char*)g.A + (size_t)cur.pm * tstep; const char* cB = (const char*)g.Bt + (size_t)cur.pn * tstep + S.bofs(cur);
    S.a_ready(cur);
    if constexpr (SP2) {
        PG8_STAGE(PG8_SB(0, 0), cB, voffB); PG8_STAGE(PG8_SB(0, 1), cB + hstep, voffB); PG8_STAGE(PG8_SA(0, 0), cA, voffA); PG8_STAGE(PG8_SA(0, 1), cA + hstep, voffA);
        if (wr == 1) PG8_BAR;
        PG8_WAIT_V(2); PG8_BAR;
        PG8_STAGE(PG8_SB(1, 0), cB + kstep, voffB); PG8_STAGE(PG8_SA(1, 0), cA + kstep, voffA); PG8_STAGE(PG8_SB(1, 1), cB + hstep + kstep, voffB);
        PG8_WAIT_V(6); PG8_BAR;
    } else {
        PG8_STAGE(PG8_SB(0, 0), cB, voffB); PG8_STAGE(PG8_SA(0, 0), cA, voffA); PG8_STAGE(PG8_SB(0, 1), cB + hstep, voffB); PG8_STAGE(PG8_SA(0, 1), cA + hstep, voffA);
        if (wr == 1) PG8_BAR;
        PG8_WAIT_V(4); PG8_BAR;
        PG8_STAGE(PG8_SB(1, 0), cB + kstep, voffB); PG8_STAGE(PG8_SA(1, 0), cA + kstep, voffA); PG8_STAGE(PG8_SB(1, 1), cB + hstep + kstep, voffB);
        PG8_WAIT_V(6); PG8_BAR;
    }
    for (;;) {
        const bool has_next = S.next(ui + 1, nxt);
        const char* nA = has_next ? (const char*)g.A + (size_t)nxt.pm * tstep : cA; const char* nB = has_next ? (const char*)g.Bt + (size_t)nxt.pn * tstep + S.bofs(nxt) : cB;
#pragma nounroll
        for (int t = 0; t < nt; t += 2) {
            const bool last = (t == nt - 2);
            const char* a1 = cA + (size_t)(t + 1) * kstep;
            const char* a2 = last ? nA : cA + (size_t)(t + 2) * kstep; const char* b2 = last ? nB : cB + (size_t)(t + 2) * kstep;
            const char* a3 = a2 + kstep; const char* b3 = b2 + kstep;
            if (last && has_next) S.a_ready(nxt);
            if constexpr (SP2) {
            PG8_LDB(B0, 0, 0); PG8_LDB(B1, 0, 1); PG8_SCHED; PG8_LDA(At, 0, 0); PG8_STAGE(PG8_SA(1, 1), a1 + hstep, voffA);
            PG8_WAIT_V(8); PG8_WAIT_L(0); PG8_BAR; PG8_MMA(0, 0, At, B0); PG8_MMA(0, 1, At, B1); PG8_BAR; PG8_SCHED;
            PG8_LDA(At, 0, 1); PG8_STAGE(PG8_SB(0, 0), b2, voffB); PG8_STAGE(PG8_SB(0, 1), b2 + hstep, voffB); PG8_STAGE(PG8_SA(0, 0), a2, voffA);
            PG8_WAIT_V(8); PG8_WAIT_L(0); PG8_BAR; PG8_MMA(1, 0, At, B0); PG8_MMA(1, 1, At, B1); PG8_BAR; PG8_SCHED;
            PG8_LDB(B0, 1, 0); PG8_LDB(B1, 1, 1); PG8_SCHED; PG8_LDA(At, 1, 0); PG8_STAGE(PG8_SA(0, 1), a2 + hstep, voffA);
            PG8_WAIT_V(8); PG8_WAIT_L(0); PG8_BAR; PG8_MMA(0, 0, At, B0); PG8_MMA(0, 1, At, B1); PG8_BAR; PG8_SCHED;
            PG8_LDA(At, 1, 1); PG8_STAGE(PG8_SB(1, 0), b3, voffB); PG8_STAGE(PG8_SB(1, 1), b3 + hstep, voffB); PG8_STAGE(PG8_SA(1, 0), a3, voffA);
            PG8_WAIT_V(8); PG8_WAIT_L(0); PG8_BAR; PG8_MMA(1, 0, At, B0); PG8_MMA(1, 1, At, B1); PG8_BAR; PG8_SCHED;
            } else {
            PG8_LDB(B0, 0, 0); PG8_SCHED; PG8_LDA(At, 0, 0); PG8_STAGE(PG8_SA(1, 1), a1 + hstep, voffA);
            PG8_WAIT_L(8); PG8_BAR; PG8_WAIT_L(0); PG8_MMA(0, 0, At, B0); PG8_BAR; PG8_SCHED;
            PG8_LDB(B1, 0, 1); PG8_STAGE(PG8_SB(0, 0), b2, voffB);
            PG8_BAR; PG8_WAIT_L(0); PG8_MMA(0, 1, At, B1); PG8_BAR;
            PG8_LDA(At, 0, 1); PG8_STAGE(PG8_SA(0, 0), a2, voffA);
            PG8_BAR; PG8_WAIT_L(0); PG8_MMA(1, 0, At, B0); PG8_BAR; PG8_SCHED;
            PG8_STAGE(PG8_SB(0, 1), b2 + hstep, voffB);
            PG8_WAIT_V(6); PG8_BAR; PG8_MMA(1, 1, At, B1); PG8_BAR;
            PG8_LDB(B0, 1, 0); PG8_SCHED; PG8_LDA(At, 1, 0); PG8_STAGE(PG8_SA(0, 1), a2 + hstep, voffA);
            PG8_WAIT_L(8); PG8_BAR; PG8_WAIT_L(0); PG8_MMA(0, 0, At, B0); PG8_BAR; PG8_SCHED;
            PG8_LDB(B1, 1, 1); PG8_STAGE(PG8_SB(1, 0), b3, voffB);
            PG8_BAR; PG8_WAIT_L(0); PG8_MMA(0, 1, At, B1); PG8_BAR;
            PG8_LDA(At, 1, 1); PG8_STAGE(PG8_SA(1, 0), a3, voffA);
            PG8_BAR; PG8_WAIT_L(0); PG8_MMA(1, 0, At, B0); PG8_BAR; PG8_SCHED;
            PG8_STAGE(PG8_SB(1, 1), b3 + hstep, voffB);
            PG8_WAIT_V(6); PG8_BAR; PG8_MMA(1, 1, At, B1); PG8_BAR;
            }
        }
        if constexpr (ALIGN_EPI) { if (wr == 0) PG8_BAR; }
        asm volatile("s_nop 15\n\ts_nop 15" ::: "memory");
        if constexpr (!Epi::AFTER_DRAIN) { unsigned m1_ = ~0u; asm volatile("" : "+s"(m1_)); const int le_ = (int)__builtin_amdgcn_mbcnt_hi(m1_, __builtin_amdgcn_mbcnt_lo(m1_, 0u));
            E(acc, cur, wr, wc, le_ & 15, le_ >> 4); S.done(cur); }
        if (!has_next) break;
#pragma unroll
        for (int a = 0; a < 2; ++a)
#pragma unroll
            for (int b = 0; b < 2; ++b)
#pragma unroll
                for (int m = 0; m < 4; ++m)
#pragma unroll
                    for (int n = 0; n < 2; ++n) acc[a][b][m][n] = (f32x4){0.f, 0.f, 0.f, 0.f};
        cur = nxt; cA = nA; cB = nB; ++ui;
        if constexpr (ALIGN_EPI) { if (wr == 1) PG8_BAR; }
    }
    PG8_WAIT_V(0);
    if constexpr (!ALIGN_EPI) { if (wr == 0) PG8_BAR; }
    PG8_BAR;
    if constexpr (Epi::AFTER_DRAIN) { E.fused(acc, cur, wr, wc, fr, fq, lds, wid, lane); S.done(cur); }
#undef PG8_SA
#undef PG8_SB
#undef PG8_STAGE
#undef PG8_LDA
#undef PG8_LD16
#undef PG8_LDB
#undef PG8_MMA
#undef PG8_WAIT_V
#undef PG8_WAIT_L
#undef PG8_BAR
#undef PG8_SCHED
}
}

namespace att {
#ifndef ATT_UNROLL_U
#define ATT_UNROLL_U "unroll 1"
#endif
#ifndef A6_VMASK
#define A6_VMASK 0x402
#endif
#ifndef ATT2_PINGPONG
#define ATT2_PINGPONG 1
#endif
#ifndef ATT_STATIC_PRIO
#define ATT_STATIC_PRIO 1
#endif
#ifndef ATT_PRIO
#define ATT_PRIO 0
#endif
#if ATT_PRIO
#define ATT_SETPRIO(x) __builtin_amdgcn_s_setprio(x)
#else
#define ATT_SETPRIO(x) do {} while (0)
#endif
#define MFMA32(a, b, c) __builtin_amdgcn_mfma_f32_32x32x16_bf16((a), (b), (c), 0, 0, 0)
typedef short v4i16_t __attribute__((ext_vector_type(4)));
struct AttnP {
    const bf16* Q; int ldq;
    const bf16* K1; int ldk1;
    const bf16* K2; int ldk2;
    const bf16* V; int ldv;
    bf16* O; int ldo;
    const int* pos;
    const int* blkmax;
    const float* lut;
    const bf16* TI; float lam, osc; const float* gsub;
};
__device__ __forceinline__ s16x4 vtr(const LAS unsigned char* p) { return __builtin_bit_cast(s16x4, __builtin_amdgcn_ds_read_tr16_b64_v4i16((LAS v4i16_t*)p)); }

template <int DQK, int KSPLIT, int DV, bool BIAS, int COMB = 0>
__device__ __forceinline__ void attn_unit(const AttnP& P, int b, int qt, int qcol, int kcol, int vcol, int ocol, int hb, LAS unsigned char* lds, const int tid_in) {
    constexpr int KROWB = DQK * 2 + 16;
    constexpr int VROWB = (DV == 128) ? 320 : 192;
    constexpr int KBYTES = 64 * KROWB, VBYTES = 64 * VROWB, STAGE = KBYTES + VBYTES + 256, LUT_OFF = 2 * STAGE;
    constexpr int ND = DQK / 16, NDB = DV / 32, KCH = DQK / 8, VCH = DV / 8, NKC = 64 * KCH, NVC = 64 * VCH, KL = (NKC + 511) / 512, VL = (NVC + 511) / 512;
    int tid_ = tid_in; asm volatile("" : "+v"(tid_));
    const int tid = tid_, lane = tid & 63, wid = __builtin_amdgcn_readfirstlane(tid >> 6), r = lane & 31, h = lane >> 5;
    const long tok0 = (long)b * SEQ; const int q0 = qt * 256; const int qrow = q0 + wid * 32 + r;
    bf16x8 qf[ND];
    { const bf16* qp = P.Q + (tok0 + qrow) * (long)P.ldq + qcol + 8 * h;
#pragma unroll
      for (int d = 0; d < ND; ++d) qf[d] = *(const bf16x8*)(qp + 16 * d); }
    int posq = 0, posq_min = 0;
    LAS float* lut = (LAS float*)(lds + LUT_OFF);
    if (BIAS) { posq = P.pos[tok0 + qrow]; int mn = posq;
#pragma unroll
        for (int o = 1; o < 64; o <<= 1) { const int t2 = shxi(mn, o, lane); mn = t2 < mn ? t2 : mn; }
        posq_min = mn;
        if (tid < 132) lut[tid] = P.lut[hb * 132 + tid]; }
    v4u kreg[KL], vreg[VL]; int preg = 0;
#define ATT_ISSUE(t) do { const long trow = tok0 + 64 * (long)(t); \
        _Pragma("unroll") for (int i = 0; i < KL; ++i) { const int c = tid + 512 * i; if (NKC % 512 == 0 || c < NKC) { const int row = c / KCH, col = (c % KCH) * 8; \
            const bf16* src = (col < KSPLIT) ? P.K1 + (trow + row) * (long)P.ldk1 + kcol + col : P.K2 + (trow + row) * (long)P.ldk2 + (col - KSPLIT); kreg[i] = *(const v4u*)src; } } \
        _Pragma("unroll") for (int i = 0; i < VL; ++i) { const int c = tid + 512 * i; if (NVC % 512 == 0 || c < NVC) { const int row = c / VCH, col = (c % VCH) * 8; vreg[i] = *(const v4u*)(P.V + (trow + row) * (long)P.ldv + vcol + col); } } \
        if (BIAS && tid < 64) preg = P.pos[trow + tid]; } while (0)
#define ATT_WRITE(t) do { LAS unsigned char* sb = lds + ((t) & 1) * STAGE; \
        _Pragma("unroll") for (int i = 0; i < KL; ++i) { const int c = tid + 512 * i; if (NKC % 512 == 0 || c < NKC) { const int row = c / KCH, cc = c % KCH; *(LAS v4u*)(sb + row * KROWB + cc * 16) = kreg[i]; } } \
        _Pragma("unroll") for (int i = 0; i < VL; ++i) { const int c = tid + 512 * i; if (NVC % 512 == 0 || c < NVC) { const int row = c / VCH, cc = c % VCH; *(LAS v4u*)(sb + KBYTES + row * VROWB + cc * 16) = vreg[i]; } } \
        if (BIAS && tid < 64) *(LAS int*)(sb + KBYTES + VBYTES + 4 * tid) = preg; } while (0)
    f32x16 o[NDB];
#pragma unroll
    for (int i = 0; i < NDB; ++i)
#pragma unroll
        for (int j = 0; j < 16; ++j) o[i][j] = 0.f;
    float m_run = 0.f, l_run = 0.f;
    const int ntiles = (q0 + 256) / 64, my_last = (q0 + wid * 32 + 31) / 64;
#if ATT_STATIC_PRIO
    if (wid >= 4) __builtin_amdgcn_s_setprio(1);
#endif
    ATT_ISSUE(0); ATT_WRITE(0); __syncthreads();
    const int kbase = r * KROWB + 16 * h;
    const int vbase = KBYTES + (4 * h + ((lane & 15) >> 2)) * VROWB + (((lane >> 4) & 1) * 16 + (lane & 3) * 4) * 2;
    for (int t = 0; t < ntiles; ++t) {
        const bool more = (t + 1 < ntiles);
        if (more) ATT_ISSUE(t + 1);
        if (t <= my_last) {
            const LAS unsigned char* sb = lds + (t & 1) * STAGE;
            bool plain = (64 * t + 63 <= q0 + wid * 32);
            float cinit = -m_run;
            if (BIAS) { const int kmax = P.blkmax[(int)(tok0 >> 6) + t]; if (plain && (posq_min - kmax >= 113)) cinit += lut[128]; else plain = false; }
            f32x16 x0, x1;
#pragma unroll
            for (int j = 0; j < 16; ++j) { x0[j] = cinit; x1[j] = cinit; }
            ATT_SETPRIO(1);
            { bf16x8 kf0[ND], kf1[ND];
#pragma unroll
              for (int d = 0; d < ND; ++d) { kf0[d] = *(const LAS bf16x8*)(sb + kbase + d * 32); kf1[d] = *(const LAS bf16x8*)(sb + kbase + 32 * KROWB + d * 32); }
              __builtin_amdgcn_sched_barrier(0);
#pragma unroll
              for (int d = 0; d < ND; ++d) { x0 = MFMA32(kf0[d], qf[d], x0); x1 = MFMA32(kf1[d], qf[d], x1); } }
            ATT_SETPRIO(0);
            if (!plain) {
#pragma unroll
                for (int g = 0; g < 4; ++g) {
                    int pk0[4] = {0, 0, 0, 0}, pk1[4] = {0, 0, 0, 0};
                    if (BIAS) { const LAS int* pp = (const LAS int*)(sb + KBYTES + VBYTES) + 8 * g + 4 * h;
                        const v4u a = *(const LAS v4u*)pp, c = *(const LAS v4u*)(pp + 32);
                        pk0[0] = a.x; pk0[1] = a.y; pk0[2] = a.z; pk0[3] = a.w; pk1[0] = c.x; pk1[1] = c.y; pk1[2] = c.z; pk1[3] = c.w; }
#pragma unroll
                    for (int j = 0; j < 4; ++j) { const int i = 4 * g + j; const int kidx = 64 * t + 8 * g + 4 * h + j;
                        float v0 = x0[i], v1 = x1[i];
                        if (BIAS) { int n0 = posq - pk0[j]; n0 = n0 < 0 ? 0 : (n0 > 128 ? 128 : n0); int n1 = posq - pk1[j]; n1 = n1 < 0 ? 0 : (n1 > 128 ? 128 : n1); v0 += lut[n0]; v1 += lut[n1]; }
                        if (kidx > qrow) v0 = -INFINITY; if (kidx + 32 > qrow) v1 = -INFINITY;
                        x0[i] = v0; x1[i] = v1; }
                }
            }
            float ma = fmaxf(fmaxf(x0[0], x0[1]), x0[2]), mb = fmaxf(fmaxf(x1[0], x1[1]), x1[2]);
#pragma unroll
            for (int j = 3; j < 15; j += 2) { ma = fmaxf(fmaxf(ma, x0[j]), x0[j + 1]); mb = fmaxf(fmaxf(mb, x1[j]), x1[j + 1]); }
            float mx = fmaxf(fmaxf(ma, mb), fmaxf(x0[15], x1[15]));
            { const auto rr = __builtin_amdgcn_permlane32_swap(__float_as_uint(mx), __float_as_uint(mx), false, false); mx = fmaxf(__uint_as_float(rr[0]), __uint_as_float(rr[1])); }
            if (t == 0 || __any(mx > 8.0f)) {
                const float delta = (t == 0) ? mx : fmaxf(mx, 0.f);
                if (t != 0) { const float alpha = __builtin_amdgcn_exp2f(-delta); l_run *= alpha;
#pragma unroll
                    for (int i = 0; i < NDB; ++i) o[i] = o[i] * alpha; }
                m_run += delta;
#pragma unroll
                for (int j = 0; j < 16; ++j) { x0[j] -= delta; x1[j] -= delta; }
            }
            f32x2 ls2 = {0.f, 0.f};
#pragma unroll
            for (int j = 0; j < 16; j += 2) { x0[j] = __builtin_amdgcn_exp2f(x0[j]); x0[j + 1] = __builtin_amdgcn_exp2f(x0[j + 1]); x1[j] = __builtin_amdgcn_exp2f(x1[j]); x1[j + 1] = __builtin_amdgcn_exp2f(x1[j + 1]);
                ls2 += (f32x2){x0[j], x0[j + 1]}; ls2 += (f32x2){x1[j], x1[j + 1]}; }
            l_run += ls2[0] + ls2[1];
            bf16x8 pf[4];
            { v4u w;
              w.x = pk2(x0[0], x0[1]); w.y = pk2(x0[2], x0[3]); w.z = pk2(x0[4], x0[5]); w.w = pk2(x0[6], x0[7]); pf[0] = __builtin_bit_cast(bf16x8, w);
              w.x = pk2(x0[8], x0[9]); w.y = pk2(x0[10], x0[11]); w.z = pk2(x0[12], x0[13]); w.w = pk2(x0[14], x0[15]); pf[1] = __builtin_bit_cast(bf16x8, w);
              w.x = pk2(x1[0], x1[1]); w.y = pk2(x1[2], x1[3]); w.z = pk2(x1[4], x1[5]); w.w = pk2(x1[6], x1[7]); pf[2] = __builtin_bit_cast(bf16x8, w);
              w.x = pk2(x1[8], x1[9]); w.y = pk2(x1[10], x1[11]); w.z = pk2(x1[12], x1[13]); w.w = pk2(x1[14], x1[15]); pf[3] = __builtin_bit_cast(bf16x8, w); }
            ATT_SETPRIO(1);
            { s16x4 vlo[2][4], vhi[2][4];
#define ATT_VLOAD(buf, db) do { _Pragma("unroll") for (int s = 0; s < 4; ++s) { vlo[buf][s] = vtr(sb + vbase + (16 * s) * VROWB + 64 * (db)); vhi[buf][s] = vtr(sb + vbase + (16 * s + 8) * VROWB + 64 * (db)); } } while (0)
              ATT_VLOAD(0, 0);
#pragma unroll
              for (int db = 0; db < NDB; ++db) {
                  if (db + 1 < NDB) ATT_VLOAD((db + 1) & 1, db + 1);
                  __builtin_amdgcn_sched_barrier(0);
#pragma unroll
                  for (int s = 0; s < 4; ++s) { const bf16x8 vf = __builtin_shufflevector(vlo[db & 1][s], vhi[db & 1][s], 0, 1, 2, 3, 4, 5, 6, 7); o[db] = MFMA32(vf, pf[s], o[db]); }
                  __builtin_amdgcn_sched_barrier(0);
              }
#undef ATT_VLOAD
            }
            ATT_SETPRIO(0);
        }
        if (more) ATT_WRITE(t + 1);
        __syncthreads();
    }
#undef ATT_ISSUE
#undef ATT_WRITE
#if ATT_STATIC_PRIO
    __builtin_amdgcn_s_setprio(0);
#endif
    const float lt = l_run + shx(l_run, 32, lane), inv = 1.0f / lt;
    if (COMB == 2) {
        const bf16* ip = P.TI + (tok0 + qrow) * (long)P.ldo + ocol + 4 * h; float ss = 0.f;
#pragma unroll
        for (int db = 0; db < NDB; ++db)
#pragma unroll
            for (int g = 0; g < 4; ++g) { const v2u a = *(const v2u*)(ip + 32 * db + 8 * g);
                const float c0 = bflo(a.x) - P.lam * (o[db][4 * g] * inv), c1 = bfhi(a.x) - P.lam * (o[db][4 * g + 1] * inv), c2 = bflo(a.y) - P.lam * (o[db][4 * g + 2] * inv), c3 = bfhi(a.y) - P.lam * (o[db][4 * g + 3] * inv);
                o[db][4 * g] = c0; o[db][4 * g + 1] = c1; o[db][4 * g + 2] = c2; o[db][4 * g + 3] = c3; ss += (c0 * c0 + c1 * c1) + (c2 * c2 + c3 * c3); }
        ss += shx(ss, 32, lane);
        const float rr = P.osc / sqrtf(ss * (1.0f / 128.0f) + LN_EPS);
        bf16* op = P.O + (tok0 + qrow) * (long)P.ldo + ocol + 4 * h;
#pragma unroll
        for (int db = 0; db < NDB; ++db)
#pragma unroll
            for (int g = 0; g < 4; ++g) { const f32x4 gg = *(const f32x4*)(P.gsub + 32 * db + 8 * g + 4 * h);
                v2u w; w.x = pk2(o[db][4 * g] * rr * gg[0], o[db][4 * g + 1] * rr * gg[1]); w.y = pk2(o[db][4 * g + 2] * rr * gg[2], o[db][4 * g + 3] * rr * gg[3]);
                *(v2u*)(op + 32 * db + 8 * g) = w; }
        return;
    }
    bf16* op = P.O + (tok0 + qrow) * (long)P.ldo + ocol + 4 * h;
#pragma unroll
    for (int db = 0; db < NDB; ++db)
#pragma unroll
        for (int g = 0; g < 4; ++g) { v2u w; w.x = pk2(o[db][4 * g] * inv, o[db][4 * g + 1] * inv); w.y = pk2(o[db][4 * g + 2] * inv, o[db][4 * g + 3] * inv);
            *(v2u*)(op + 32 * db + 8 * g) = w; }
}

template <int DQK, int KSPLIT, int DV, bool BIAS, int COMB = 0>
__device__ __forceinline__ void attn_unit6(const AttnP& P, int b, int qt, int qcol, int kcol, int vcol, int ocol, int hb, LAS unsigned char* lds, const int tid_in) {
    constexpr int KROWB = DQK * 2 + 16;
    constexpr int VROWB = (DV == 128) ? 320 : 192;
    constexpr int KBYTES = 64 * KROWB, VBYTES = 64 * VROWB, STAGE = KBYTES + VBYTES + 256, LUT_OFF = 2 * STAGE;
    constexpr int ND = DQK / 16, NDB = DV / 32, KCH = DQK / 8, VCH = DV / 8, NKC = 64 * KCH, NVC = 64 * VCH, KL = (NKC + 511) / 512, VL = (NVC + 511) / 512;
    int tid_ = tid_in; asm volatile("" : "+v"(tid_));
    const int tid = tid_, lane = tid & 63, wid = __builtin_amdgcn_readfirstlane(tid >> 6), r = lane & 31, h = lane >> 5;
    const long tok0 = (long)b * SEQ; const int q0 = qt * 256; const int qrow = q0 + wid * 32 + r;
    bf16x8 qf[ND];
    { const bf16* qp = P.Q + (tok0 + qrow) * (long)P.ldq + qcol + 8 * h;
#pragma unroll
      for (int d = 0; d < ND; ++d) qf[d] = *(const bf16x8*)(qp + 16 * d); }
    int posq = 0, posq_min = 0;
    LAS float* lut = (LAS float*)(lds + LUT_OFF);
    if (BIAS) { posq = P.pos[tok0 + qrow]; int mn = posq;
#pragma unroll
        for (int o = 1; o < 64; o <<= 1) { const int t2 = shxi(mn, o, lane); mn = t2 < mn ? t2 : mn; }
        posq_min = mn;
        if (tid < 132) lut[tid] = P.lut[hb * 132 + tid]; }
    v4u kreg[KL], vreg[VL]; int preg = 0;
#define ATT_ISSUE(t) do { const long trow = tok0 + 64 * (long)(t); \
        _Pragma("unroll") for (int i = 0; i < KL; ++i) { const int c = tid + 512 * i; if (NKC % 512 == 0 || c < NKC) { const int row = c / KCH, col = (c % KCH) * 8; \
            const bf16* src = (col < KSPLIT) ? P.K1 + (trow + row) * (long)P.ldk1 + kcol + col : P.K2 + (trow + row) * (long)P.ldk2 + (col - KSPLIT); kreg[i] = *(const v4u*)src; } } \
        _Pragma("unroll") for (int i = 0; i < VL; ++i) { const int c = tid + 512 * i; if (NVC % 512 == 0 || c < NVC) { const int row = c / VCH, col = (c % VCH) * 8; vreg[i] = *(const v4u*)(P.V + (trow + row) * (long)P.ldv + vcol + col); } } \
        if (BIAS && tid < 64) preg = P.pos[trow + tid]; } while (0)
#define ATT_WRITE(t) do { LAS unsigned char* sb = lds + ((t) & 1) * STAGE; \
        _Pragma("unroll") for (int i = 0; i < KL; ++i) { const int c = tid + 512 * i; if (NKC % 512 == 0 || c < NKC) { const int row = c / KCH, cc = c % KCH; *(LAS v4u*)(sb + row * KROWB + cc * 16) = kreg[i]; } } \
        _Pragma("unroll") for (int i = 0; i < VL; ++i) { const int c = tid + 512 * i; if (NVC % 512 == 0 || c < NVC) { const int row = c / VCH, cc = c % VCH; *(LAS v4u*)(sb + KBYTES + row * VROWB + cc * 16) = vreg[i]; } } \
        if (BIAS && tid < 64) *(LAS int*)(sb + KBYTES + VBYTES + 4 * tid) = preg; } while (0)
    f32x16 o[NDB];
#pragma unroll
    for (int i = 0; i < NDB; ++i)
#pragma unroll
        for (int j = 0; j < 16; ++j) o[i][j] = 0.f;
    float m_run = 0.f, l_run = 0.f;
    const int ntiles = (q0 + 256) / 64, my_last = (q0 + wid * 32 + 31) / 64;
#if ATT_STATIC_PRIO
    if (wid >= 4) __builtin_amdgcn_s_setprio(1);
#endif
    ATT_ISSUE(0); ATT_WRITE(0); __syncthreads();
    const int kbase = r * KROWB + 16 * h;
    const int vbase = KBYTES + (4 * h + ((lane & 15) >> 2)) * VROWB + (((lane >> 4) & 1) * 16 + (lane & 3) * 4) * 2;
    for (int t = 0; t < ntiles; ++t) {
        const bool more = (t + 1 < ntiles);
        if (more) ATT_ISSUE(t + 1);
        if (t <= my_last) {
            const LAS unsigned char* sb = lds + (t & 1) * STAGE;
            bool plain = (64 * t + 63 <= q0 + wid * 32);
            float cinit = -m_run;
            if (BIAS) { const int kmax = P.blkmax[(int)(tok0 >> 6) + t]; if (plain && (posq_min - kmax >= 113)) cinit += lut[128]; else plain = false; }
            f32x16 x0, x1;
#pragma unroll
            for (int j = 0; j < 16; ++j) { x0[j] = cinit; x1[j] = cinit; }
            ATT_SETPRIO(1);
            { bf16x8 kf0[ND], kf1[ND];
#pragma unroll
              for (int d = 0; d < ND; ++d) { kf0[d] = *(const LAS bf16x8*)(sb + kbase + d * 32); kf1[d] = *(const LAS bf16x8*)(sb + kbase + 32 * KROWB + d * 32); }
              __builtin_amdgcn_sched_barrier(0);
#pragma unroll
              for (int d = 0; d < ND; ++d) { x0 = MFMA32(kf0[d], qf[d], x0); x1 = MFMA32(kf1[d], qf[d], x1); } }
            ATT_SETPRIO(0);
            if (!plain) {
#pragma unroll
                for (int g = 0; g < 4; ++g) {
                    int pk0[4] = {0, 0, 0, 0}, pk1[4] = {0, 0, 0, 0};
                    if (BIAS) { const LAS int* pp = (const LAS int*)(sb + KBYTES + VBYTES) + 8 * g + 4 * h;
                        const v4u a = *(const LAS v4u*)pp, c = *(const LAS v4u*)(pp + 32);
                        pk0[0] = a.x; pk0[1] = a.y; pk0[2] = a.z; pk0[3] = a.w; pk1[0] = c.x; pk1[1] = c.y; pk1[2] = c.z; pk1[3] = c.w; }
#pragma unroll
                    for (int j = 0; j < 4; ++j) { const int i = 4 * g + j; const int kidx = 64 * t + 8 * g + 4 * h + j;
                        float v0 = x0[i], v1 = x1[i];
                        if (BIAS) { int n0 = posq - pk0[j]; n0 = n0 < 0 ? 0 : (n0 > 128 ? 128 : n0); int n1 = posq - pk1[j]; n1 = n1 < 0 ? 0 : (n1 > 128 ? 128 : n1); v0 += lut[n0]; v1 += lut[n1]; }
                        if (kidx > qrow) v0 = -INFINITY; if (kidx + 32 > qrow) v1 = -INFINITY;
                        x0[i] = v0; x1[i] = v1; }
                }
            }
            float ma = fmaxf(fmaxf(x0[0], x0[1]), x0[2]), mb = fmaxf(fmaxf(x1[0], x1[1]), x1[2]);
#pragma unroll
            for (int j = 3; j < 15; j += 2) { ma = fmaxf(fmaxf(ma, x0[j]), x0[j + 1]); mb = fmaxf(fmaxf(mb, x1[j]), x1[j + 1]); }
            float mx = fmaxf(fmaxf(ma, mb), fmaxf(x0[15], x1[15]));
            { const auto rr = __builtin_amdgcn_permlane32_swap(__float_as_uint(mx), __float_as_uint(mx), false, false); mx = fmaxf(__uint_as_float(rr[0]), __uint_as_float(rr[1])); }
            if (t == 0 || __any(mx > 8.0f)) {
                const float delta = (t == 0) ? mx : fmaxf(mx, 0.f);
                if (t != 0) { const float alpha = __builtin_amdgcn_exp2f(-delta); l_run *= alpha;
#pragma unroll
                    for (int i = 0; i < NDB; ++i) o[i] = o[i] * alpha; }
                m_run += delta;
#pragma unroll
                for (int j = 0; j < 16; ++j) { x0[j] -= delta; x1[j] -= delta; }
            }
            f32x2 ls2 = {0.f, 0.f};
            bf16x8 pf[4];
            s16x4 vl[2][NDB], vh[2][NDB];
#define A6_EXP(X, bb, PF) do { \
        X[bb + 0] = __builtin_amdgcn_exp2f(X[bb + 0]); X[bb + 1] = __builtin_amdgcn_exp2f(X[bb + 1]); X[bb + 2] = __builtin_amdgcn_exp2f(X[bb + 2]); X[bb + 3] = __builtin_amdgcn_exp2f(X[bb + 3]); \
        X[bb + 4] = __builtin_amdgcn_exp2f(X[bb + 4]); X[bb + 5] = __builtin_amdgcn_exp2f(X[bb + 5]); X[bb + 6] = __builtin_amdgcn_exp2f(X[bb + 6]); X[bb + 7] = __builtin_amdgcn_exp2f(X[bb + 7]); \
        ls2 += (f32x2){X[bb + 0], X[bb + 1]}; ls2 += (f32x2){X[bb + 2], X[bb + 3]}; ls2 += (f32x2){X[bb + 4], X[bb + 5]}; ls2 += (f32x2){X[bb + 6], X[bb + 7]}; \
        { v4u w_; w_.x = pk2(X[bb + 0], X[bb + 1]); w_.y = pk2(X[bb + 2], X[bb + 3]); w_.z = pk2(X[bb + 4], X[bb + 5]); w_.w = pk2(X[bb + 6], X[bb + 7]); PF = __builtin_bit_cast(bf16x8, w_); } } while (0)
#define A6_VLD(buf, ss) do { _Pragma("unroll") for (int db = 0; db < NDB; ++db) { vl[buf][db] = vtr(sb + vbase + (16 * (ss)) * VROWB + 64 * db); vh[buf][db] = vtr(sb + vbase + (16 * (ss) + 8) * VROWB + 64 * db); } } while (0)
#define A6_MMA(buf, ss) do { _Pragma("unroll") for (int db = 0; db < NDB; ++db) { const bf16x8 vf_ = __builtin_shufflevector(vl[buf][db], vh[buf][db], 0, 1, 2, 3, 4, 5, 6, 7); o[db] = MFMA32(vf_, pf[ss], o[db]); } } while (0)
#define A6_SGB(nv) do { _Pragma("unroll") for (int db = 0; db < NDB; ++db) { __builtin_amdgcn_sched_group_barrier(0x008, 1, 0); __builtin_amdgcn_sched_group_barrier(A6_VMASK, (nv), 0); __builtin_amdgcn_sched_group_barrier(0x100, 2, 0); } } while (0)
            A6_VLD(0, 0);
            A6_EXP(x0, 0, pf[0]);
            __builtin_amdgcn_sched_barrier(0);
            A6_VLD(1, 1); A6_EXP(x0, 8, pf[1]); A6_MMA(0, 0); A6_SGB(16 / NDB);
            __builtin_amdgcn_sched_barrier(0);
            A6_VLD(0, 2); A6_EXP(x1, 0, pf[2]); A6_MMA(1, 1); A6_SGB(16 / NDB);
            __builtin_amdgcn_sched_barrier(0);
            A6_VLD(1, 3); A6_EXP(x1, 8, pf[3]); A6_MMA(0, 2); A6_SGB(16 / NDB);
            __builtin_amdgcn_sched_barrier(0);
            A6_MMA(1, 3);
            __builtin_amdgcn_sched_barrier(0);
            l_run += ls2[0] + ls2[1];
#undef A6_EXP
#undef A6_VLD
#undef A6_MMA
#undef A6_SGB
            ATT_SETPRIO(0);
        }
        if (more) ATT_WRITE(t + 1);
        __syncthreads();
    }
#undef ATT_ISSUE
#undef ATT_WRITE
#if ATT_STATIC_PRIO
    __builtin_amdgcn_s_setprio(0);
#endif
    const float lt = l_run + shx(l_run, 32, lane), inv = 1.0f / lt;
    if (COMB == 2) {
        const bf16* ip = P.TI + (tok0 + qrow) * (long)P.ldo + ocol + 4 * h; float ss = 0.f;
#pragma unroll
        for (int db = 0; db < NDB; ++db)
#pragma unroll
            for (int g = 0; g < 4; ++g) { const v2u a = *(const v2u*)(ip + 32 * db + 8 * g);
                const float c0 = bflo(a.x) - P.lam * (o[db][4 * g] * inv), c1 = bfhi(a.x) - P.lam * (o[db][4 * g + 1] * inv), c2 = bflo(a.y) - P.lam * (o[db][4 * g + 2] * inv), c3 = bfhi(a.y) - P.lam * (o[db][4 * g + 3] * inv);
                o[db][4 * g] = c0; o[db][4 * g + 1] = c1; o[db][4 * g + 2] = c2; o[db][4 * g + 3] = c3; ss += (c0 * c0 + c1 * c1) + (c2 * c2 + c3 * c3); }
        ss += shx(ss, 32, lane);
        const float rr = P.osc / sqrtf(ss * (1.0f / 128.0f) + LN_EPS);
        bf16* op = P.O + (tok0 + qrow) * (long)P.ldo + ocol + 4 * h;
#pragma unroll
        for (int db = 0; db < NDB; ++db)
#pragma unroll
            for (int g = 0; g < 4; ++g) { const f32x4 gg = *(const f32x4*)(P.gsub + 32 * db + 8 * g + 4 * h);
                v2u w; w.x = pk2(o[db][4 * g] * rr * gg[0], o[db][4 * g + 1] * rr * gg[1]); w.y = pk2(o[db][4 * g + 2] * rr * gg[2], o[db][4 * g + 3] * rr * gg[3]);
                *(v2u*)(op + 32 * db + 8 * g) = w; }
        return;
    }
    bf16* op = P.O + (tok0 + qrow) * (long)P.ldo + ocol + 4 * h;
#pragma unroll
    for (int db = 0; db < NDB; ++db)
#pragma unroll
        for (int g = 0; g < 4; ++g) { v2u w; w.x = pk2(o[db][4 * g] * inv, o[db][4 * g + 1] * inv); w.y = pk2(o[db][4 * g + 2] * inv, o[db][4 * g + 3] * inv);
            *(v2u*)(op + 32 * db + 8 * g) = w; }
}

template <int DQK, int KSPLIT, int DV, bool BIAS, int COMB = 0>
__device__ __forceinline__ void attn_unit7(const AttnP& P, int b, int qt, int qcol, int kcol, int vcol, int ocol, int hb, LAS unsigned char* lds, const int tid_in) {
    constexpr int KROWB = DQK * 2 + 16;
    constexpr int VROWB = (DV == 128) ? 320 : 192;
    constexpr int KBYTES = 64 * KROWB, VBYTES = 64 * VROWB, STAGE = KBYTES + VBYTES + 256, LUT_OFF = 2 * STAGE;
    constexpr int ND = DQK / 16, NDB = DV / 32, KCH = DQK / 8, VCH = DV / 8, NKC = 64 * KCH, NVC = 64 * VCH, KL = (NKC + 511) / 512, VL = (NVC + 511) / 512;
    int tid_ = tid_in; asm volatile("" : "+v"(tid_));
    const int tid = tid_, lane = tid & 63, wid = __builtin_amdgcn_readfirstlane(tid >> 6), r = lane & 31, h = lane >> 5;
    const long tok0 = (long)b * SEQ; const int q0 = qt * 256; const int qrow = q0 + wid * 32 + r;
    bf16x8 qf[ND];
    { const bf16* qp = P.Q + (tok0 + qrow) * (long)P.ldq + qcol + 8 * h;
#pragma unroll
      for (int d = 0; d < ND; ++d) qf[d] = *(const bf16x8*)(qp + 16 * d); }
    int posq = 0, posq_min = 0;
    LAS float* lut = (LAS float*)(lds + LUT_OFF);
    if (BIAS) { posq = P.pos[tok0 + qrow]; int mn = posq;
#pragma unroll
        for (int o = 1; o < 64; o <<= 1) { const int t2 = shxi(mn, o, lane); mn = t2 < mn ? t2 : mn; }
        posq_min = mn;
        if (tid < 132) lut[tid] = P.lut[hb * 132 + tid] - P.lut[hb * 132 + 128]; }
    v4u kreg[KL], vreg[VL]; int preg = 0;
#define ATT_ISSUE(t) do { const long trow = tok0 + 64 * (long)(t); \
        _Pragma("unroll") for (int i = 0; i < KL; ++i) { const int c = tid + 512 * i; if (NKC % 512 == 0 || c < NKC) { const int row = c / KCH, col = (c % KCH) * 8; \
            const bf16* src = (col < KSPLIT) ? P.K1 + (trow + row) * (long)P.ldk1 + kcol + col : P.K2 + (trow + row) * (long)P.ldk2 + (col - KSPLIT); kreg[i] = *(const v4u*)src; } } \
        _Pragma("unroll") for (int i = 0; i < VL; ++i) { const int c = tid + 512 * i; if (NVC % 512 == 0 || c < NVC) { const int row = c / VCH, col = (c % VCH) * 8; vreg[i] = *(const v4u*)(P.V + (trow + row) * (long)P.ldv + vcol + col); } } \
        if (BIAS && tid < 64) preg = P.pos[trow + tid]; } while (0)
#define ATT_WRITE(t) do { LAS unsigned char* sb = lds + ((t) & 1) * STAGE; \
        _Pragma("unroll") for (int i = 0; i < KL; ++i) { const int c = tid + 512 * i; if (NKC % 512 == 0 || c < NKC) { const int row = c / KCH, cc = c % KCH; *(LAS v4u*)(sb + row * KROWB + cc * 16) = kreg[i]; } } \
        _Pragma("unroll") for (int i = 0; i < VL; ++i) { const int c = tid + 512 * i; if (NVC % 512 == 0 || c < NVC) { const int row = c / VCH, cc = c % VCH; *(LAS v4u*)(sb + KBYTES + row * VROWB + cc * 16) = vreg[i]; } } \
        if (BIAS && tid < 64) *(LAS int*)(sb + KBYTES + VBYTES + 4 * tid) = preg; } while (0)
    f32x16 o[NDB];
#pragma unroll
    for (int i = 0; i < NDB; ++i)
#pragma unroll
        for (int j = 0; j < 16; ++j) o[i][j] = 0.f;
    float m_run = 0.f, l_run = 0.f;
    f32x16 csp;
    { const float c0_ = BIAS ? P.lut[hb * 132 + 128] : 0.f;
#pragma unroll
      for (int j = 0; j < 16; ++j) csp[j] = c0_; }
    const int ntiles = (q0 + 256) / 64, my_last = (q0 + wid * 32 + 31) / 64;
#if ATT_STATIC_PRIO
    if (wid >= 4) __builtin_amdgcn_s_setprio(1);
#endif
    ATT_ISSUE(0); ATT_WRITE(0); __syncthreads();
    const int kbase = r * KROWB + 16 * h;
    const int vbase = KBYTES + (4 * h + ((lane & 15) >> 2)) * VROWB + (((lane >> 4) & 1) * 16 + (lane & 3) * 4) * 2;
    for (int t = 0; t < ntiles; ++t) {
        const bool more = (t + 1 < ntiles);
        if (more) ATT_ISSUE(t + 1);
        if (t <= my_last) {
            const LAS unsigned char* sb = lds + (t & 1) * STAGE;
            bool plain = (64 * t + 63 <= q0 + wid * 32);
            if (BIAS) { const int kmax = P.blkmax[(int)(tok0 >> 6) + t]; if (!(plain && (posq_min - kmax >= 113))) plain = false; }
            f32x16 x0 = csp, x1 = csp;
            ATT_SETPRIO(1);
            { bf16x8 kf0[ND], kf1[ND];
#pragma unroll
              for (int d = 0; d < ND; ++d) { kf0[d] = *(const LAS bf16x8*)(sb + kbase + d * 32); kf1[d] = *(const LAS bf16x8*)(sb + kbase + 32 * KROWB + d * 32); }
              __builtin_amdgcn_sched_barrier(0);
#pragma unroll
              for (int d = 0; d < ND; ++d) { x0 = MFMA32(kf0[d], qf[d], x0); x1 = MFMA32(kf1[d], qf[d], x1); } }
            ATT_SETPRIO(0);
            if (!plain) {
#pragma unroll
                for (int g = 0; g < 4; ++g) {
                    int pk0[4] = {0, 0, 0, 0}, pk1[4] = {0, 0, 0, 0};
                    if (BIAS) { const LAS int* pp = (const LAS int*)(sb + KBYTES + VBYTES) + 8 * g + 4 * h;
                        const v4u a = *(const LAS v4u*)pp, c = *(const LAS v4u*)(pp + 32);
                        pk0[0] = a.x; pk0[1] = a.y; pk0[2] = a.z; pk0[3] = a.w; pk1[0] = c.x; pk1[1] = c.y; pk1[2] = c.z; pk1[3] = c.w; }
#pragma unroll
                    for (int j = 0; j < 4; ++j) { const int i = 4 * g + j; const int kidx = 64 * t + 8 * g + 4 * h + j;
                        float v0 = x0[i], v1 = x1[i];
                        if (BIAS) { int n0 = posq - pk0[j]; n0 = n0 < 0 ? 0 : (n0 > 128 ? 128 : n0); int n1 = posq - pk1[j]; n1 = n1 < 0 ? 0 : (n1 > 128 ? 128 : n1); v0 += lut[n0]; v1 += lut[n1]; }
                        if (kidx > qrow) v0 = -INFINITY; if (kidx + 32 > qrow) v1 = -INFINITY;
                        x0[i] = v0; x1[i] = v1; }
                }
            }
            float ma = fmaxf(fmaxf(x0[0], x0[1]), x0[2]), mb = fmaxf(fmaxf(x1[0], x1[1]), x1[2]);
#pragma unroll
            for (int j = 3; j < 15; j += 2) { ma = fmaxf(fmaxf(ma, x0[j]), x0[j + 1]); mb = fmaxf(fmaxf(mb, x1[j]), x1[j + 1]); }
            float mx = fmaxf(fmaxf(ma, mb), fmaxf(x0[15], x1[15]));
            { const auto rr = __builtin_amdgcn_permlane32_swap(__float_as_uint(mx), __float_as_uint(mx), false, false); mx = fmaxf(__uint_as_float(rr[0]), __uint_as_float(rr[1])); }
            if (t == 0 || __any(mx > 8.0f)) {
                const float delta = (t == 0) ? mx : fmaxf(mx, 0.f);
                if (t != 0) { const float alpha = __builtin_amdgcn_exp2f(-delta); l_run *= alpha;
#pragma unroll
                    for (int i = 0; i < NDB; ++i) o[i] = o[i] * alpha; }
                m_run += delta;
#pragma unroll
                for (int j = 0; j < 16; ++j) { x0[j] -= delta; x1[j] -= delta; csp[j] -= delta; }
            }
            f32x2 ls2 = {0.f, 0.f};
            bf16x8 pf[4];
            s16x4 vl[2][NDB], vh[2][NDB];
#define A6_EXP(X, bb, PF) do { \
        X[bb + 0] = __builtin_amdgcn_exp2f(X[bb + 0]); X[bb + 1] = __builtin_amdgcn_exp2f(X[bb + 1]); X[bb + 2] = __builtin_amdgcn_exp2f(X[bb + 2]); X[bb + 3] = __builtin_amdgcn_exp2f(X[bb + 3]); \
        X[bb + 4] = __builtin_amdgcn_exp2f(X[bb + 4]); X[bb + 5] = __builtin_amdgcn_exp2f(X[bb + 5]); X[bb + 6] = __builtin_amdgcn_exp2f(X[bb + 6]); X[bb + 7] = __builtin_amdgcn_exp2f(X[bb + 7]); \
        ls2 += (f32x2){X[bb + 0], X[bb + 1]}; ls2 += (f32x2){X[bb + 2], X[bb + 3]}; ls2 += (f32x2){X[bb + 4], X[bb + 5]}; ls2 += (f32x2){X[bb + 6], X[bb + 7]}; \
        { v4u w_; w_.x = pk2(X[bb + 0], X[bb + 1]); w_.y = pk2(X[bb + 2], X[bb + 3]); w_.z = pk2(X[bb + 4], X[bb + 5]); w_.w = pk2(X[bb + 6], X[bb + 7]); PF = __builtin_bit_cast(bf16x8, w_); } } while (0)
#define A6_VLD(buf, ss) do { _Pragma("unroll") for (int db = 0; db < NDB; ++db) { vl[buf][db] = vtr(sb + vbase + (16 * (ss)) * VROWB + 64 * db); vh[buf][db] = vtr(sb + vbase + (16 * (ss) + 8) * VROWB + 64 * db); } } while (0)
#define A6_MMA(buf, ss) do { _Pragma("unroll") for (int db = 0; db < NDB; ++db) { const bf16x8 vf_ = __builtin_shufflevector(vl[buf][db], vh[buf][db], 0, 1, 2, 3, 4, 5, 6, 7); o[db] = MFMA32(vf_, pf[ss], o[db]); } } while (0)
#define A6_SGB(nv) do { _Pragma("unroll") for (int db = 0; db < NDB; ++db) { __builtin_amdgcn_sched_group_barrier(0x008, 1, 0); __builtin_amdgcn_sched_group_barrier(A6_VMASK, (nv), 0); __builtin_amdgcn_sched_group_barrier(0x100, 2, 0); } } while (0)
            A6_VLD(0, 0);
            A6_EXP(x0, 0, pf[0]);
            __builtin_amdgcn_sched_barrier(0);
            A6_VLD(1, 1); A6_EXP(x0, 8, pf[1]); A6_MMA(0, 0); A6_SGB(16 / NDB);
            __builtin_amdgcn_sched_barrier(0);
            A6_VLD(0, 2); A6_EXP(x1, 0, pf[2]); A6_MMA(1, 1); A6_SGB(16 / NDB);
            __builtin_amdgcn_sched_barrier(0);
            A6_VLD(1, 3); A6_EXP(x1, 8, pf[3]); A6_MMA(0, 2); A6_SGB(16 / NDB);
            __builtin_amdgcn_sched_barrier(0);
            A6_MMA(1, 3);
            __builtin_amdgcn_sched_barrier(0);
            l_run += ls2[0] + ls2[1];
#undef A6_EXP
#undef A6_VLD
#undef A6_MMA
#undef A6_SGB
            ATT_SETPRIO(0);
        }
        if (more) ATT_WRITE(t + 1);
        __syncthreads();
    }
#undef ATT_ISSUE
#undef ATT_WRITE
#if ATT_STATIC_PRIO
    __builtin_amdgcn_s_setprio(0);
#endif
    const float lt = l_run + shx(l_run, 32, lane), inv = 1.0f / lt;
    if (COMB == 2) {
        const bf16* ip = P.TI + (tok0 + qrow) * (long)P.ldo + ocol + 4 * h; float ss = 0.f;
#pragma unroll
        for (int db = 0; db < NDB; ++db)
#pragma unroll
            for (int g = 0; g < 4; ++g) { const v2u a = *(const v2u*)(ip + 32 * db + 8 * g);
                const float c0 = bflo(a.x) - P.lam * (o[db][4 * g] * inv), c1 = bfhi(a.x) - P.lam * (o[db][4 * g + 1] * inv), c2 = bflo(a.y) - P.lam * (o[db][4 * g + 2] * inv), c3 = bfhi(a.y) - P.lam * (o[db][4 * g + 3] * inv);
                o[db][4 * g] = c0; o[db][4 * g + 1] = c1; o[db][4 * g + 2] = c2; o[db][4 * g + 3] = c3; ss += (c0 * c0 + c1 * c1) + (c2 * c2 + c3 * c3); }
        ss += shx(ss, 32, lane);
        const float rr = P.osc / sqrtf(ss * (1.0f / 128.0f) + LN_EPS);
        bf16* op = P.O + (tok0 + qrow) * (long)P.ldo + ocol + 4 * h;
#pragma unroll
        for (int db = 0; db < NDB; ++db)
#pragma unroll
            for (int g = 0; g < 4; ++g) { const f32x4 gg = *(const f32x4*)(P.gsub + 32 * db + 8 * g + 4 * h);
                v2u w; w.x = pk2(o[db][4 * g] * rr * gg[0], o[db][4 * g + 1] * rr * gg[1]); w.y = pk2(o[db][4 * g + 2] * rr * gg[2], o[db][4 * g + 3] * rr * gg[3]);
                *(v2u*)(op + 32 * db + 8 * g) = w; }
        return;
    }
    bf16* op = P.O + (tok0 + qrow) * (long)P.ldo + ocol + 4 * h;
#pragma unroll
    for (int db = 0; db < NDB; ++db)
#pragma unroll
        for (int g = 0; g < 4; ++g) { v2u w; w.x = pk2(o[db][4 * g] * inv, o[db][4 * g + 1] * inv); w.y = pk2(o[db][4 * g + 2] * inv, o[db][4 * g + 3] * inv);
            *(v2u*)(op + 32 * db + 8 * g) = w; }
}

template <int DQK, int KSPLIT, int DV, bool BIAS, int COMB = 0>
__device__ __forceinline__ void attn_unit8(const AttnP& P, int b, int qt, int qcol, int kcol, int vcol, int ocol, int hb, LAS unsigned char* lds, const int tid_in) {
    constexpr int KROWB = DQK * 2 + 16;
    constexpr int VROWB = (DV == 128) ? 320 : 192;
    constexpr int KBYTES = 64 * KROWB, VBYTES = 64 * VROWB, STAGE = KBYTES + VBYTES + 256, LUT_OFF = 2 * STAGE;
    constexpr int ND = DQK / 16, NDB = DV / 32, KCH = DQK / 8, VCH = DV / 8, NKC = 64 * KCH, NVC = 64 * VCH, KL = (NKC + 511) / 512, VL = (NVC + 511) / 512;
    int tid_ = tid_in; asm volatile("" : "+v"(tid_));
    const int tid = tid_, lane = tid & 63, wid = __builtin_amdgcn_readfirstlane(tid >> 6), r = lane & 31, h = lane >> 5;
    const long tok0 = (long)b * SEQ; const int q0 = qt * 256; const int qrow = q0 + wid * 32 + r;
    bf16x8 qf[ND];
    { const bf16* qp = P.Q + (tok0 + qrow) * (long)P.ldq + qcol + 8 * h;
#pragma unroll
      for (int d = 0; d < ND; ++d) qf[d] = *(const bf16x8*)(qp + 16 * d); }
    int posq = 0, posq_min = 0;
    LAS float* lut = (LAS float*)(lds + LUT_OFF);
    if (BIAS) { posq = P.pos[tok0 + qrow]; int mn = posq;
#pragma unroll
        for (int o = 1; o < 64; o <<= 1) { const int t2 = shxi(mn, o, lane); mn = t2 < mn ? t2 : mn; }
        posq_min = mn;
        if (tid < 132) lut[tid] = P.lut[hb * 132 + tid] - P.lut[hb * 132 + 128]; }
    v4u kreg[KL], vreg[VL]; int preg = 0;
#define ATT_ISSUE(t) do { const long trow = tok0 + 64 * (long)(t); \
        _Pragma("unroll") for (int i = 0; i < KL; ++i) { const int c = tid + 512 * i; if (NKC % 512 == 0 || c < NKC) { const int row = c / KCH, col = (c % KCH) * 8; \
            const bf16* src = (col < KSPLIT) ? P.K1 + (trow + row) * (long)P.ldk1 + kcol + col : P.K2 + (trow + row) * (long)P.ldk2 + (col - KSPLIT); kreg[i] = *(const v4u*)src; } } \
        _Pragma("unroll") for (int i = 0; i < VL; ++i) { const int c = tid + 512 * i; if (NVC % 512 == 0 || c < NVC) { const int row = c / VCH, col = (c % VCH) * 8; vreg[i] = *(const v4u*)(P.V + (trow + row) * (long)P.ldv + vcol + col); } } \
        if (BIAS && tid < 64) preg = P.pos[trow + tid]; } while (0)
#define ATT_WRITE(t) do { LAS unsigned char* sb = lds + ((t) & 1) * STAGE; \
        _Pragma("unroll") for (int i = 0; i < KL; ++i) { const int c = tid + 512 * i; if (NKC % 512 == 0 || c < NKC) { const int row = c / KCH, cc = c % KCH; *(LAS v4u*)(sb + row * KROWB + cc * 16) = kreg[i]; } } \
        _Pragma("unroll") for (int i = 0; i < VL; ++i) { const int c = tid + 512 * i; if (NVC % 512 == 0 || c < NVC) { const int row = c / VCH, cc = c % VCH; *(LAS v4u*)(sb + KBYTES + row * VROWB + cc * 16) = vreg[i]; } } \
        if (BIAS && tid < 64) *(LAS int*)(sb + KBYTES + VBYTES + 4 * tid) = preg; } while (0)
    f32x16 o[NDB];
#pragma unroll
    for (int i = 0; i < NDB; ++i)
#pragma unroll
        for (int j = 0; j < 16; ++j) o[i][j] = 0.f;
    float m_run = 0.f, l_run = 0.f;
    f32x16 csp;
    { const float c0_ = BIAS ? P.lut[hb * 132 + 128] : 0.f;
#pragma unroll
      for (int j = 0; j < 16; ++j) csp[j] = c0_; }
    const int ntiles = (q0 + 256) / 64, my_last = (q0 + wid * 32 + 31) / 64;
#if ATT_STATIC_PRIO
    if (wid >= 4) __builtin_amdgcn_s_setprio(1);
#endif
    ATT_ISSUE(0); ATT_WRITE(0); __syncthreads();
    const int kbase = r * KROWB + 16 * h;
    const int vbase = KBYTES + (4 * h + ((lane & 15) >> 2)) * VROWB + (((lane >> 4) & 1) * 16 + (lane & 3) * 4) * 2;
    for (int t = 0; t < ntiles; ++t) {
        const bool more = (t + 1 < ntiles);
        if (more) ATT_ISSUE(t + 1);
        if (t <= my_last) {
            const LAS unsigned char* sb = lds + (t & 1) * STAGE;
            bool plain = (64 * t + 63 <= q0 + wid * 32);
            if (BIAS) { const int kmax = P.blkmax[(int)(tok0 >> 6) + t]; if (!(plain && (posq_min - kmax >= 113))) plain = false; }
            f32x16 x0 = csp, x1 = csp;
            ATT_SETPRIO(1);
            { bf16x8 kf0[ND], kf1[ND];
#pragma unroll
              for (int d = 0; d < ND; ++d) { kf0[d] = *(const LAS bf16x8*)(sb + kbase + d * 32); kf1[d] = *(const LAS bf16x8*)(sb + kbase + 32 * KROWB + d * 32); }
              __builtin_amdgcn_sched_barrier(0);
#pragma unroll
              for (int d = 0; d < ND; ++d) { x0 = MFMA32(kf0[d], qf[d], x0); x1 = MFMA32(kf1[d], qf[d], x1); } }
            ATT_SETPRIO(0);
            if (!plain) {
                const int qrel = qrow - 64 * t - 4 * h;
#pragma unroll
                for (int g = 0; g < 4; ++g) {
                    int pk0[4] = {0, 0, 0, 0}, pk1[4] = {0, 0, 0, 0};
                    if (BIAS) { const LAS int* pp = (const LAS int*)(sb + KBYTES + VBYTES) + 8 * g + 4 * h;
                        const v4u a = *(const LAS v4u*)pp, c = *(const LAS v4u*)(pp + 32);
                        pk0[0] = a.x; pk0[1] = a.y; pk0[2] = a.z; pk0[3] = a.w; pk1[0] = c.x; pk1[1] = c.y; pk1[2] = c.z; pk1[3] = c.w; }
#pragma unroll
                    for (int j = 0; j < 4; ++j) { const int i = 4 * g + j;
                        float v0 = x0[i], v1 = x1[i];
                        if (BIAS) { int n0 = posq - pk0[j]; n0 = n0 < 0 ? 0 : (n0 > 128 ? 128 : n0); int n1 = posq - pk1[j]; n1 = n1 < 0 ? 0 : (n1 > 128 ? 128 : n1); v0 += lut[n0]; v1 += lut[n1]; }
                        if (8 * g + j > qrel) v0 = -INFINITY; if (8 * g + j + 32 > qrel) v1 = -INFINITY;
                        x0[i] = v0; x1[i] = v1; }
                }
            }
            if (t == 0) {
                float ma = fmaxf(fmaxf(x0[0], x0[1]), x0[2]), mb = fmaxf(fmaxf(x1[0], x1[1]), x1[2]);
#pragma unroll
                for (int j = 3; j < 15; j += 2) { ma = fmaxf(fmaxf(ma, x0[j]), x0[j + 1]); mb = fmaxf(fmaxf(mb, x1[j]), x1[j + 1]); }
                float mx = fmaxf(fmaxf(ma, mb), fmaxf(x0[15], x1[15]));
                { const auto rr = __builtin_amdgcn_permlane32_swap(__float_as_uint(mx), __float_as_uint(mx), false, false); mx = fmaxf(__uint_as_float(rr[0]), __uint_as_float(rr[1])); }
                m_run += mx;
#pragma unroll
                for (int j = 0; j < 16; ++j) { x0[j] -= mx; x1[j] -= mx; csp[j] -= mx; }
            }
            f32x2 ls2 = {0.f, 0.f};
            bf16x8 pf[4];
            s16x4 vl[2][NDB], vh[2][NDB];
#define A6_EXP(X, bb, PF) do { \
        X[bb + 0] = __builtin_amdgcn_exp2f(X[bb + 0]); X[bb + 1] = __builtin_amdgcn_exp2f(X[bb + 1]); X[bb + 2] = __builtin_amdgcn_exp2f(X[bb + 2]); X[bb + 3] = __builtin_amdgcn_exp2f(X[bb + 3]); \
        X[bb + 4] = __builtin_amdgcn_exp2f(X[bb + 4]); X[bb + 5] = __builtin_amdgcn_exp2f(X[bb + 5]); X[bb + 6] = __builtin_amdgcn_exp2f(X[bb + 6]); X[bb + 7] = __builtin_amdgcn_exp2f(X[bb + 7]); \
        ls2 += (f32x2){X[bb + 0], X[bb + 1]}; ls2 += (f32x2){X[bb + 2], X[bb + 3]}; ls2 += (f32x2){X[bb + 4], X[bb + 5]}; ls2 += (f32x2){X[bb + 6], X[bb + 7]}; \
        { v4u w_; w_.x = pk2(X[bb + 0], X[bb + 1]); w_.y = pk2(X[bb + 2], X[bb + 3]); w_.z = pk2(X[bb + 4], X[bb + 5]); w_.w = pk2(X[bb + 6], X[bb + 7]); PF = __builtin_bit_cast(bf16x8, w_); } } while (0)
#define A6_VLD(buf, ss) do { _Pragma("unroll") for (int db = 0; db < NDB; ++db) { vl[buf][db] = vtr(sb + vbase + (16 * (ss)) * VROWB + 64 * db); vh[buf][db] = vtr(sb + vbase + (16 * (ss) + 8) * VROWB + 64 * db); } } while (0)
#define A6_MMA(buf, ss) do { _Pragma("unroll") for (int db = 0; db < NDB; ++db) { const bf16x8 vf_ = __builtin_shufflevector(vl[buf][db], vh[buf][db], 0, 1, 2, 3, 4, 5, 6, 7); o[db] = MFMA32(vf_, pf[ss], o[db]); } } while (0)
#define A6_SGB(nv) do { _Pragma("unroll") for (int db = 0; db < NDB; ++db) { __builtin_amdgcn_sched_group_barrier(0x008, 1, 0); __builtin_amdgcn_sched_group_barrier(A6_VMASK, (nv), 0); __builtin_amdgcn_sched_group_barrier(0x100, 2, 0); } } while (0)
            A6_VLD(0, 0);
            A6_EXP(x0, 0, pf[0]);
            __builtin_amdgcn_sched_barrier(0);
            A6_VLD(1, 1); A6_EXP(x0, 8, pf[1]); A6_MMA(0, 0); A6_SGB(16 / NDB);
            __builtin_amdgcn_sched_barrier(0);
            A6_VLD(0, 2); A6_EXP(x1, 0, pf[2]); A6_MMA(1, 1); A6_SGB(16 / NDB);
            __builtin_amdgcn_sched_barrier(0);
            A6_VLD(1, 3); A6_EXP(x1, 8, pf[3]); A6_MMA(0, 2); A6_SGB(16 / NDB);
            __builtin_amdgcn_sched_barrier(0);
            A6_MMA(1, 3);
            __builtin_amdgcn_sched_barrier(0);
            { const float ls = ls2[0] + ls2[1];
              l_run += ls;
              if (t != 0 && __any(ls > 256.0f)) {
                  float ma = fmaxf(fmaxf(x0[0], x0[1]), x0[2]), mb = fmaxf(fmaxf(x1[0], x1[1]), x1[2]);
#pragma unroll
                  for (int j = 3; j < 15; j += 2) { ma = fmaxf(fmaxf(ma, x0[j]), x0[j + 1]); mb = fmaxf(fmaxf(mb, x1[j]), x1[j + 1]); }
                  float mp = fmaxf(fmaxf(ma, mb), fmaxf(x0[15], x1[15]));
                  { const auto rr = __builtin_amdgcn_permlane32_swap(__float_as_uint(mp), __float_as_uint(mp), false, false); mp = fmaxf(__uint_as_float(rr[0]), __uint_as_float(rr[1])); }
                  const float delta = fmaxf(__builtin_amdgcn_logf(mp), 0.f), alpha = __builtin_amdgcn_exp2f(-delta);
                  l_run *= alpha; m_run += delta;
#pragma unroll
                  for (int i = 0; i < NDB; ++i) o[i] = o[i] * alpha;
#pragma unroll
                  for (int j = 0; j < 16; ++j) csp[j] -= delta;
              } }
#undef A6_EXP
#undef A6_VLD
#undef A6_MMA
#undef A6_SGB
            ATT_SETPRIO(0);
        }
        if (more) ATT_WRITE(t + 1);
        __syncthreads();
    }
#undef ATT_ISSUE
#undef ATT_WRITE
#if ATT_STATIC_PRIO
    __builtin_amdgcn_s_setprio(0);
#endif
    const float lt = l_run + shx(l_run, 32, lane), inv = 1.0f / lt;
    if (COMB == 2) {
        const bf16* ip = P.TI + (tok0 + qrow) * (long)P.ldo + ocol + 4 * h; float ss = 0.f;
#pragma unroll
        for (int db = 0; db < NDB; ++db)
#pragma unroll
            for (int g = 0; g < 4; ++g) { const v2u a = *(const v2u*)(ip + 32 * db + 8 * g);
                const float c0 = bflo(a.x) - P.lam * (o[db][4 * g] * inv), c1 = bfhi(a.x) - P.lam * (o[db][4 * g + 1] * inv), c2 = bflo(a.y) - P.lam * (o[db][4 * g + 2] * inv), c3 = bfhi(a.y) - P.lam * (o[db][4 * g + 3] * inv);
                o[db][4 * g] = c0; o[db][4 * g + 1] = c1; o[db][4 * g + 2] = c2; o[db][4 * g + 3] = c3; ss += (c0 * c0 + c1 * c1) + (c2 * c2 + c3 * c3); }
        ss += shx(ss, 32, lane);
        const float rr = P.osc / sqrtf(ss * (1.0f / 128.0f) + LN_EPS);
        bf16* op = P.O + (tok0 + qrow) * (long)P.ldo + ocol + 4 * h;
#pragma unroll
        for (int db = 0; db < NDB; ++db)
#pragma unroll
            for (int g = 0; g < 4; ++g) { const f32x4 gg = *(const f32x4*)(P.gsub + 32 * db + 8 * g + 4 * h);
                v2u w; w.x = pk2(o[db][4 * g] * rr * gg[0], o[db][4 * g + 1] * rr * gg[1]); w.y = pk2(o[db][4 * g + 2] * rr * gg[2], o[db][4 * g + 3] * rr * gg[3]);
                *(v2u*)(op + 32 * db + 8 * g) = w; }
        return;
    }
    bf16* op = P.O + (tok0 + qrow) * (long)P.ldo + ocol + 4 * h;
#pragma unroll
    for (int db = 0; db < NDB; ++db)
#pragma unroll
        for (int g = 0; g < 4; ++g) { v2u w; w.x = pk2(o[db][4 * g] * inv, o[db][4 * g + 1] * inv); w.y = pk2(o[db][4 * g + 2] * inv, o[db][4 * g + 3] * inv);
            *(v2u*)(op + 32 * db + 8 * g) = w; }
}

template <int KL, int VL, int ND> struct AttPre { v4u kA[KL], vA[VL], kB[KL], vB[VL]; int pA, pB; bf16x8 q[ND]; int posq; float lv, c0; int bv; bool valid; };
template <int DQK, int DV> struct AttPreOf { static constexpr int KCH = DQK / 8, VCH = DV / 8; typedef AttPre<(64 * KCH + 511) / 512, (64 * VCH + 511) / 512, DQK / 16> type; };
template <int DQK, int KSPLIT, int DV, bool BIAS, int COMB = 0, int VAR = 0>
__device__ __forceinline__ void attn_unit10(const AttnP& P, int b, int qt, int qcol, int kcol, int vcol, int ocol, int hb, LAS unsigned char* lds, const int tid_in,
                                            typename AttPreOf<DQK, DV>::type& pre, const bool has_next, const int nb, const int nqt, const int nqcol, const int nkcol, const int nvcol, const int nhb) {
    constexpr int KROWB = DQK * 2 + 16;
    constexpr int VROWB = (DV == 128) ? 320 : 192;
    constexpr int KBYTES = 64 * KROWB, VBYTES = 64 * VROWB, STAGE = KBYTES + VBYTES + 256, LUT_OFF = 4 * STAGE;
    constexpr int ND = DQK / 16, NDB = DV / 32, KCH = DQK / 8, VCH = DV / 8, NKC = 64 * KCH, NVC = 64 * VCH, KL = (NKC + 511) / 512, VL = (NVC + 511) / 512;
    int tid_ = tid_in; asm volatile("" : "+v"(tid_));
    const int tid = tid_, lane = tid & 63, wid = __builtin_amdgcn_readfirstlane(tid >> 6), r = lane & 31, h = lane >> 5;
    const long tok0 = (long)b * SEQ; const int q0 = qt * 256; const int qrow = q0 + wid * 32 + r;
    v4u (&kregA)[KL] = pre.kA; v4u (&vregA)[VL] = pre.vA; v4u (&kregB)[KL] = pre.kB; v4u (&vregB)[VL] = pre.vB; int& pregA = pre.pA; int& pregB = pre.pB;
#define ATT_ISSUE1X(t, kreg, vreg, preg, TOK0_, KCOL_, VCOL_) do { const long trow = (TOK0_) + 64 * (long)(t); \
        _Pragma("unroll") for (int i = 0; i < KL; ++i) { const int c = tid + 512 * i; if (NKC % 512 == 0 || c < NKC) { const int row = c / KCH, col = (c % KCH) * 8; \
            const bf16* src = (col < KSPLIT) ? P.K1 + (trow + row) * (long)P.ldk1 + (KCOL_) + col : P.K2 + (trow + row) * (long)P.ldk2 + (col - KSPLIT); kreg[i] = *(const v4u*)src; } } \
        _Pragma("unroll") for (int i = 0; i < VL; ++i) { const int c = tid + 512 * i; if (NVC % 512 == 0 || c < NVC) { const int row = c / VCH, col = (c % VCH) * 8; vreg[i] = *(const v4u*)(P.V + (trow + row) * (long)P.ldv + (VCOL_) + col); } } \
        if (BIAS && tid < 64) preg = P.pos[trow + tid]; } while (0)
#define ATT_ISSUE1(t, kreg, vreg, preg) ATT_ISSUE1X(t, kreg, vreg, preg, tok0, kcol, vcol)
#define ATT_PRELOAD(TOK0_, QROW_, QCOL_, KCOL_, VCOL_, HB_) do { ATT_ISSUE1X(0, kregA, vregA, pregA, TOK0_, KCOL_, VCOL_); ATT_ISSUE1X(1, kregB, vregB, pregB, TOK0_, KCOL_, VCOL_); \
        { const bf16* qp = P.Q + ((TOK0_) + (QROW_)) * (long)P.ldq + (QCOL_) + 8 * h; _Pragma("unroll") for (int d = 0; d < ND; ++d) pre.q[d] = *(const bf16x8*)(qp + 16 * d); } \
        pre.posq = 0; pre.lv = 0.f; pre.bv = 0; pre.c0 = 0.f; \
        if (BIAS) { pre.posq = P.pos[(TOK0_) + (QROW_)]; if (tid < 132) pre.lv = P.lut[(HB_) * 132 + tid]; if (tid >= 192 && tid < 256) pre.bv = P.blkmax[(int)((TOK0_) >> 6) + (tid - 192)]; \
                    pre.c0 = P.lut[(HB_) * 132 + 128]; } } while (0)
#define ATT_WRITE1(t, kreg, vreg, preg) do { LAS unsigned char* sb = lds + ((t) & 3) * STAGE; \
        _Pragma("unroll") for (int i = 0; i < KL; ++i) { const int c = tid + 512 * i; if (NKC % 512 == 0 || c < NKC) { const int row = c / KCH, cc = c % KCH; *(LAS v4u*)(sb + row * KROWB + cc * 16) = kreg[i]; } } \
        _Pragma("unroll") for (int i = 0; i < VL; ++i) { const int c = tid + 512 * i; if (NVC % 512 == 0 || c < NVC) { const int row = c / VCH, cc = c % VCH; *(LAS v4u*)(sb + KBYTES + row * VROWB + cc * 16) = vreg[i]; } } \
        if (BIAS && tid < 64) *(LAS int*)(sb + KBYTES + VBYTES + 4 * tid) = preg; } while (0)
#define ATT_ISSUE(T2) do { ATT_ISSUE1(2 * (T2), kregA, vregA, pregA); ATT_ISSUE1(2 * (T2) + 1, kregB, vregB, pregB); } while (0)
#define ATT_WRITE(T2) do { ATT_WRITE1(2 * (T2), kregA, vregA, pregA); ATT_WRITE1(2 * (T2) + 1, kregB, vregB, pregB); } while (0)
    if (!pre.valid) ATT_PRELOAD(tok0, qrow, qcol, kcol, vcol, hb);
    bf16x8 (&qf)[ND] = pre.q;
    int posq = 0, posq_min = 0;
    LAS float* lut = (LAS float*)(lds + LUT_OFF); LAS int* bmx = (LAS int*)(lds + LUT_OFF + 1024);
    if (BIAS) { posq = pre.posq; int mn = posq;
#pragma unroll
        for (int o = 1; o < 64; o <<= 1) { const int t2 = shxi(mn, o, lane); mn = t2 < mn ? t2 : mn; }
        posq_min = mn;
        if (tid < 132) lut[tid] = pre.lv - pre.c0;
        if (tid >= 192 && tid < 256) bmx[tid - 192] = pre.bv; }
    f32x16 o[NDB];
#pragma unroll
    for (int i = 0; i < NDB; ++i)
#pragma unroll
        for (int j = 0; j < 16; ++j) o[i][j] = 0.f;
    float m_run = 0.f, l_run = 0.f;
    f32x16 csp;
    { const float c0_ = BIAS ? pre.c0 : 0.f;
#pragma unroll
      for (int j = 0; j < 16; ++j) csp[j] = c0_; }
    const int ntiles = (q0 + 256) / 64, my_last = (q0 + wid * 32 + 31) / 64;
#if ATT_STATIC_PRIO
    if (wid >= 4) __builtin_amdgcn_s_setprio(1);
#endif
    ATT_WRITE(0); __syncthreads();
    const int kbase = r * KROWB + 16 * h;
    const int vbase = KBYTES + (4 * h + ((lane & 15) >> 2)) * VROWB + (((lane >> 4) & 1) * 16 + (lane & 3) * 4) * 2;
    for (int T2 = 0; T2 < ntiles / 2; ++T2) {
        const bool more = (2 * T2 + 2 < ntiles);
        if (more && !(VAR & 8)) ATT_ISSUE(T2 + 1);
#pragma unroll 1
        for (int u_ = 0; u_ < 2; ++u_) {
        const int t = 2 * T2 + u_;
        if (t <= my_last) {
            const LAS unsigned char* sb = lds + (t & 3) * STAGE;
            bool plain = (64 * t + 63 <= q0 + wid * 32);
            if (BIAS) { const int kmax = bmx[t]; if (!(plain && (posq_min - kmax >= 113))) plain = false; }
            f32x16 x0 = csp, x1 = csp;
            ATT_SETPRIO(1);
            if (!(VAR & 4)) { bf16x8 kf0[ND], kf1[ND];
#pragma unroll
              for (int d = 0; d < ND; ++d) { kf0[d] = *(const LAS bf16x8*)(sb + kbase + d * 32); kf1[d] = *(const LAS bf16x8*)(sb + kbase + 32 * KROWB + d * 32); }
              __builtin_amdgcn_sched_barrier(0);
#pragma unroll
              for (int d = 0; d < ND; ++d) { x0 = MFMA32(kf0[d], qf[d], x0); x1 = MFMA32(kf1[d], qf[d], x1); } }
            ATT_SETPRIO(0);
            if (!plain) {
                const int qrel = qrow - 64 * t - 4 * h;
#pragma unroll
                for (int g = 0; g < 4; ++g) {
                    int pk0[4] = {0, 0, 0, 0}, pk1[4] = {0, 0, 0, 0};
                    if (BIAS) { const LAS int* pp = (const LAS int*)(sb + KBYTES + VBYTES) + 8 * g + 4 * h;
                        const v4u a = *(const LAS v4u*)pp, c = *(const LAS v4u*)(pp + 32);
                        pk0[0] = a.x; pk0[1] = a.y; pk0[2] = a.z; pk0[3] = a.w; pk1[0] = c.x; pk1[1] = c.y; pk1[2] = c.z; pk1[3] = c.w; }
#pragma unroll
                    for (int j = 0; j < 4; ++j) { const int i = 4 * g + j;
                        float v0 = x0[i], v1 = x1[i];
                        if (BIAS) { int n0 = posq - pk0[j]; n0 = n0 < 0 ? 0 : (n0 > 128 ? 128 : n0); int n1 = posq - pk1[j]; n1 = n1 < 0 ? 0 : (n1 > 128 ? 128 : n1); v0 += lut[n0]; v1 += lut[n1]; }
                        if (8 * g + j > qrel) v0 = -INFINITY; if (8 * g + j + 32 > qrel) v1 = -INFINITY;
                        x0[i] = v0; x1[i] = v1; }
                }
            }
            if (t == 0) {
                float ma = fmaxf(fmaxf(x0[0], x0[1]), x0[2]), mb = fmaxf(fmaxf(x1[0], x1[1]), x1[2]);
#pragma unroll
                for (int j = 3; j < 15; j += 2) { ma = fmaxf(fmaxf(ma, x0[j]), x0[j + 1]); mb = fmaxf(fmaxf(mb, x1[j]), x1[j + 1]); }
                float mx = fmaxf(fmaxf(ma, mb), fmaxf(x0[15], x1[15]));
                { const auto rr = __builtin_amdgcn_permlane32_swap(__float_as_uint(mx), __float_as_uint(mx), false, false); mx = fmaxf(__uint_as_float(rr[0]), __uint_as_float(rr[1])); }
                m_run += mx;
#pragma unroll
                for (int j = 0; j < 16; ++j) { x0[j] -= mx; x1[j] -= mx; csp[j] -= mx; }
            }
            f32x2 ls2 = {0.f, 0.f};
            bf16x8 pf[4];
            s16x4 vl[2][NDB], vh[2][NDB];
#define A6_E2(v_) ((VAR & 1) ? (v_) : __builtin_amdgcn_exp2f(v_))
#define A6_EXP(X, bb, PF) do { \
        X[bb + 0] = A6_E2(X[bb + 0]); X[bb + 1] = A6_E2(X[bb + 1]); X[bb + 2] = A6_E2(X[bb + 2]); X[bb + 3] = A6_E2(X[bb + 3]); \
        X[bb + 4] = A6_E2(X[bb + 4]); X[bb + 5] = A6_E2(X[bb + 5]); X[bb + 6] = A6_E2(X[bb + 6]); X[bb + 7] = A6_E2(X[bb + 7]); \
        ls2 += (f32x2){X[bb + 0], X[bb + 1]}; ls2 += (f32x2){X[bb + 2], X[bb + 3]}; ls2 += (f32x2){X[bb + 4], X[bb + 5]}; ls2 += (f32x2){X[bb + 6], X[bb + 7]}; \
        { v4u w_; w_.x = pk2(X[bb + 0], X[bb + 1]); w_.y = pk2(X[bb + 2], X[bb + 3]); w_.z = pk2(X[bb + 4], X[bb + 5]); w_.w = pk2(X[bb + 6], X[bb + 7]); PF = __builtin_bit_cast(bf16x8, w_); } } while (0)
#define A6_VLD(buf, ss) do { _Pragma("unroll") for (int db = 0; db < NDB; ++db) { vl[buf][db] = vtr(sb + vbase + (16 * (ss)) * VROWB + 64 * db); vh[buf][db] = vtr(sb + vbase + (16 * (ss) + 8) * VROWB + 64 * db); } } while (0)
#define A6_MMA(buf, ss) do { if (VAR & 2) break; _Pragma("unroll") for (int db = 0; db < NDB; ++db) { const bf16x8 vf_ = __builtin_shufflevector(vl[buf][db], vh[buf][db], 0, 1, 2, 3, 4, 5, 6, 7); o[db] = MFMA32(vf_, pf[ss], o[db]); } } while (0)
#define A6_SGB(nv) do { _Pragma("unroll") for (int db = 0; db < NDB; ++db) { __builtin_amdgcn_sched_group_barrier(0x008, 1, 0); __builtin_amdgcn_sched_group_barrier(A6_VMASK, (nv), 0); __builtin_amdgcn_sched_group_barrier(0x100, 2, 0); } } while (0)
            A6_VLD(0, 0);
            A6_EXP(x0, 0, pf[0]);
            __builtin_amdgcn_sched_barrier(0);
            A6_VLD(1, 1); A6_EXP(x0, 8, pf[1]); A6_MMA(0, 0); A6_SGB(16 / NDB);
            __builtin_amdgcn_sched_barrier(0);
            A6_VLD(0, 2); A6_EXP(x1, 0, pf[2]); A6_MMA(1, 1); A6_SGB(16 / NDB);
            __builtin_amdgcn_sched_barrier(0);
            A6_VLD(1, 3); A6_EXP(x1, 8, pf[3]); A6_MMA(0, 2); A6_SGB(16 / NDB);
            __builtin_amdgcn_sched_barrier(0);
            A6_MMA(1, 3);
            __builtin_amdgcn_sched_barrier(0);
            { const float ls = ls2[0] + ls2[1];
              l_run += ls;
              if (t != 0 && __any(ls > 256.0f)) {
                  float ma = fmaxf(fmaxf(x0[0], x0[1]), x0[2]), mb = fmaxf(fmaxf(x1[0], x1[1]), x1[2]);
#pragma unroll
                  for (int j = 3; j < 15; j += 2) { ma = fmaxf(fmaxf(ma, x0[j]), x0[j + 1]); mb = fmaxf(fmaxf(mb, x1[j]), x1[j + 1]); }
                  float mp = fmaxf(fmaxf(ma, mb), fmaxf(x0[15], x1[15]));
                  { const auto rr = __builtin_amdgcn_permlane32_swap(__float_as_uint(mp), __float_as_uint(mp), false, false); mp = fmaxf(__uint_as_float(rr[0]), __uint_as_float(rr[1])); }
                  const float delta = fmaxf(__builtin_amdgcn_logf(mp), 0.f), alpha = __builtin_amdgcn_exp2f(-delta);
                  l_run *= alpha; m_run += delta;
#pragma unroll
                  for (int i = 0; i < NDB; ++i) o[i] = o[i] * alpha;
#pragma unroll
                  for (int j = 0; j < 16; ++j) csp[j] -= delta;
              } }
#undef A6_EXP
#undef A6_E2
#undef A6_VLD
#undef A6_MMA
#undef A6_SGB
            ATT_SETPRIO(0);
        }
        }
        if (more && !(VAR & 8)) ATT_WRITE(T2 + 1);
        if (!(VAR & 16)) __syncthreads();
    }
#if ATT_STATIC_PRIO
    __builtin_amdgcn_s_setprio(0);
#endif
    const long rowoff = (tok0 + qrow) * (long)P.ldo + ocol + 8 * h;
    v4u tiq[NDB][2];
    if (COMB == 2) { const bf16* ip = P.TI + rowoff;
#pragma unroll
        for (int db = 0; db < NDB; ++db)
#pragma unroll
            for (int gp = 0; gp < 2; ++gp) tiq[db][gp] = *(const v4u*)(ip + 32 * db + 16 * gp); }
    __builtin_amdgcn_sched_barrier(0);
    if (has_next) { const long ntok0 = (long)nb * SEQ; const int nqrow = nqt * 256 + wid * 32 + r;
        ATT_PRELOAD(ntok0, nqrow, nqcol, nkcol, nvcol, nhb); pre.valid = true; }
    else pre.valid = false;
    __builtin_amdgcn_sched_barrier(0);
#undef ATT_PRELOAD
#undef ATT_ISSUE
#undef ATT_ISSUE1
#undef ATT_ISSUE1X
#undef ATT_WRITE
#undef ATT_WRITE1
    const float lt = l_run + shx(l_run, 32, lane), inv = 1.0f / lt;
#define A10_SWAP(A_, B_) do { const auto r0_ = __builtin_amdgcn_permlane32_swap((A_).x, (B_).x, false, false); (A_).x = r0_[0]; (B_).x = r0_[1]; \
                              const auto r1_ = __builtin_amdgcn_permlane32_swap((A_).y, (B_).y, false, false); (A_).y = r1_[0]; (B_).y = r1_[1]; } while (0)
    if (COMB == 2) {
        float ss = 0.f;
#pragma unroll
        for (int db = 0; db < NDB; ++db)
#pragma unroll
            for (int gp = 0; gp < 2; ++gp) { const v4u q = tiq[db][gp]; v2u a, c; a.x = q.x; a.y = q.y; c.x = q.z; c.y = q.w; A10_SWAP(a, c);
#pragma unroll
                for (int e = 0; e < 2; ++e) { const int g = 2 * gp + e; const v2u t = e ? c : a;
                    const float c0 = bflo(t.x) - P.lam * (o[db][4 * g] * inv), c1 = bfhi(t.x) - P.lam * (o[db][4 * g + 1] * inv), c2 = bflo(t.y) - P.lam * (o[db][4 * g + 2] * inv), c3 = bfhi(t.y) - P.lam * (o[db][4 * g + 3] * inv);
                    o[db][4 * g] = c0; o[db][4 * g + 1] = c1; o[db][4 * g + 2] = c2; o[db][4 * g + 3] = c3; ss += (c0 * c0 + c1 * c1) + (c2 * c2 + c3 * c3); } }
        ss += shx(ss, 32, lane);
        const float rr = 1.0f / sqrtf(ss * (1.0f / 128.0f) + LN_EPS);
        bf16* op = P.O + rowoff;
#pragma unroll
        for (int db = 0; db < NDB; ++db)
#pragma unroll
            for (int gp = 0; gp < 2; ++gp) { v2u w[2];
#pragma unroll
                for (int e = 0; e < 2; ++e) { const int g = 2 * gp + e; const f32x4 gg = *(const f32x4*)(P.gsub + 32 * db + 8 * g + 4 * h);
                    w[e].x = pk2(o[db][4 * g] * rr * gg[0], o[db][4 * g + 1] * rr * gg[1]); w[e].y = pk2(o[db][4 * g + 2] * rr * gg[2], o[db][4 * g + 3] * rr * gg[3]); }
                A10_SWAP(w[0], w[1]);
                v4u q; q.x = w[0].x; q.y = w[0].y; q.z = w[1].x; q.w = w[1].y; *(v4u*)(op + 32 * db + 16 * gp) = q; }
        return;
    }
    bf16* op = P.O + rowoff;
#pragma unroll
    for (int db = 0; db < NDB; ++db)
#pragma unroll
        for (int gp = 0; gp < 2; ++gp) { v2u w[2];
#pragma unroll
            for (int e = 0; e < 2; ++e) { const int g = 2 * gp + e; w[e].x = pk2(o[db][4 * g] * inv, o[db][4 * g + 1] * inv); w[e].y = pk2(o[db][4 * g + 2] * inv, o[db][4 * g + 3] * inv); }
            A10_SWAP(w[0], w[1]);
            v4u q; q.x = w[0].x; q.y = w[0].y; q.z = w[1].x; q.w = w[1].y; *(v4u*)(op + 32 * db + 16 * gp) = q; }
#undef A10_SWAP
}

template <int DQK, int KSPLIT, int DV, bool BIAS, int COMB = 0>
__device__ __forceinline__ void attn_unit9(const AttnP& P, int b, int qt, int qcol, int kcol, int vcol, int ocol, int hb, LAS unsigned char* lds, const int tid_in) {
    constexpr int KROWB = DQK * 2 + 16;
    constexpr int VROWB = (DV == 128) ? 320 : 192;
    constexpr int KBYTES = 64 * KROWB, VBYTES = 64 * VROWB, STAGE = KBYTES + VBYTES + 256, LUT_OFF = 2 * STAGE;
    constexpr int ND = DQK / 16, NDB = DV / 32, KCH = DQK / 8, VCH = DV / 8, NKC = 64 * KCH, NVC = 64 * VCH, KL = (NKC + 511) / 512, VL = (NVC + 511) / 512;
    int tid_ = tid_in; asm volatile("" : "+v"(tid_));
    const int tid = tid_, lane = tid & 63, wid = __builtin_amdgcn_readfirstlane(tid >> 6), r = lane & 31, h = lane >> 5;
    const long tok0 = (long)b * SEQ; const int q0 = qt * 256; const int qrow = q0 + wid * 32 + r;
    bf16x8 qf[ND];
    { const bf16* qp = P.Q + (tok0 + qrow) * (long)P.ldq + qcol + 8 * h;
#pragma unroll
      for (int d = 0; d < ND; ++d) qf[d] = *(const bf16x8*)(qp + 16 * d); }
    int posq = 0, posq_min = 0;
    LAS float* lut = (LAS float*)(lds + LUT_OFF);
    if (BIAS) { posq = P.pos[tok0 + qrow]; int mn = posq;
#pragma unroll
        for (int o = 1; o < 64; o <<= 1) { const int t2 = shxi(mn, o, lane); mn = t2 < mn ? t2 : mn; }
        posq_min = mn;
        if (tid < 132) lut[tid] = P.lut[hb * 132 + tid] - P.lut[hb * 132 + 128]; }
    v4u kreg[KL], vreg[VL]; int preg = 0;
#define ATT_ISSUE(t) do { const long trow = tok0 + 64 * (long)(t); \
        _Pragma("unroll") for (int i = 0; i < KL; ++i) { const int c = tid + 512 * i; if (NKC % 512 == 0 || c < NKC) { const int row = c / KCH, col = (c % KCH) * 8; \
            const bf16* src = (col < KSPLIT) ? P.K1 + (trow + row) * (long)P.ldk1 + kcol + col : P.K2 + (trow + row) * (long)P.ldk2 + (col - KSPLIT); kreg[i] = *(const v4u*)src; } } \
        _Pragma("unroll") for (int i = 0; i < VL; ++i) { const int c = tid + 512 * i; if (NVC % 512 == 0 || c < NVC) { const int row = c / VCH, col = (c % VCH) * 8; vreg[i] = *(const v4u*)(P.V + (trow + row) * (long)P.ldv + vcol + col); } } \
        if (BIAS && tid < 64) preg = P.pos[trow + tid]; } while (0)
#define ATT_WRITE(t) do { LAS unsigned char* sb = lds + ((t) & 1) * STAGE; \
        _Pragma("unroll") for (int i = 0; i < KL; ++i) { const int c = tid + 512 * i; if (NKC % 512 == 0 || c < NKC) { const int row = c / KCH, cc = c % KCH; *(LAS v4u*)(sb + row * KROWB + cc * 16) = kreg[i]; } } \
        _Pragma("unroll") for (int i = 0; i < VL; ++i) { const int c = tid + 512 * i; if (NVC % 512 == 0 || c < NVC) { const int row = c / VCH, cc = c % VCH; *(LAS v4u*)(sb + KBYTES + row * VROWB + cc * 16) = vreg[i]; } } \
        if (BIAS && tid < 64) *(LAS int*)(sb + KBYTES + VBYTES + 4 * tid) = preg; } while (0)
    f32x16 o[NDB];
#pragma unroll
    for (int i = 0; i < NDB; ++i)
#pragma unroll
        for (int j = 0; j < 16; ++j) o[i][j] = 0.f;
    float m_run = 0.f, l_run = 0.f;
    f32x16 lacc;
#pragma unroll
    for (int j = 0; j < 16; ++j) lacc[j] = 0.f;
    const bf16x8 ones8 = {0x3f80, 0x3f80, 0x3f80, 0x3f80, 0x3f80, 0x3f80, 0x3f80, 0x3f80};
    f32x16 csp;
    { const float c0_ = BIAS ? P.lut[hb * 132 + 128] : 0.f;
#pragma unroll
      for (int j = 0; j < 16; ++j) csp[j] = c0_; }
    const int ntiles = (q0 + 256) / 64, my_last = (q0 + wid * 32 + 31) / 64;
#if ATT_STATIC_PRIO
    if (wid >= 4) __builtin_amdgcn_s_setprio(1);
#endif
    ATT_ISSUE(0); ATT_WRITE(0); __syncthreads();
    const int kbase = r * KROWB + 16 * h;
    const int vbase = KBYTES + (4 * h + ((lane & 15) >> 2)) * VROWB + (((lane >> 4) & 1) * 16 + (lane & 3) * 4) * 2;
    for (int t = 0; t < ntiles; ++t) {
        const bool more = (t + 1 < ntiles);
        if (more) ATT_ISSUE(t + 1);
        if (t <= my_last) {
            const LAS unsigned char* sb = lds + (t & 1) * STAGE;
            bool plain = (64 * t + 63 <= q0 + wid * 32);
            if (t >= 2) {
                const float lnow = lacc[0], ls = lnow - l_run;
                if (__any(ls > 1024.0f)) {
                    const float delta = fmaxf(__builtin_amdgcn_logf(ls) - 4.0f, 0.f), alpha = __builtin_amdgcn_exp2f(-delta);
                    m_run += delta; lacc = lacc * alpha;
#pragma unroll
                    for (int i = 0; i < NDB; ++i) o[i] = o[i] * alpha;
#pragma unroll
                    for (int j = 0; j < 16; ++j) csp[j] -= delta;
                }
                l_run = lacc[0];
            } else if (t == 1) l_run = lacc[0];
            if (BIAS) { const int kmax = P.blkmax[(int)(tok0 >> 6) + t]; if (!(plain && (posq_min - kmax >= 113))) plain = false; }
            f32x16 x0 = csp, x1 = csp;
            ATT_SETPRIO(1);
            { bf16x8 kf0[ND], kf1[ND];
#pragma unroll
              for (int d = 0; d < ND; ++d) { kf0[d] = *(const LAS bf16x8*)(sb + kbase + d * 32); kf1[d] = *(const LAS bf16x8*)(sb + kbase + 32 * KROWB + d * 32); }
              __builtin_amdgcn_sched_barrier(0);
#pragma unroll
              for (int d = 0; d < ND; ++d) { x0 = MFMA32(kf0[d], qf[d], x0); x1 = MFMA32(kf1[d], qf[d], x1); } }
            ATT_SETPRIO(0);
            if (!plain) {
#pragma unroll
                for (int g = 0; g < 4; ++g) {
                    int pk0[4] = {0, 0, 0, 0}, pk1[4] = {0, 0, 0, 0};
                    if (BIAS) { const LAS int* pp = (const LAS int*)(sb + KBYTES + VBYTES) + 8 * g + 4 * h;
                        const v4u a = *(const LAS v4u*)pp, c = *(const LAS v4u*)(pp + 32);
                        pk0[0] = a.x; pk0[1] = a.y; pk0[2] = a.z; pk0[3] = a.w; pk1[0] = c.x; pk1[1] = c.y; pk1[2] = c.z; pk1[3] = c.w; }
#pragma unroll
                    for (int j = 0; j < 4; ++j) { const int i = 4 * g + j; const int kidx = 64 * t + 8 * g + 4 * h + j;
                        float v0 = x0[i], v1 = x1[i];
                        if (BIAS) { int n0 = posq - pk0[j]; n0 = n0 < 0 ? 0 : (n0 > 128 ? 128 : n0); int n1 = posq - pk1[j]; n1 = n1 < 0 ? 0 : (n1 > 128 ? 128 : n1); v0 += lut[n0]; v1 += lut[n1]; }
                        if (kidx > qrow) v0 = -INFINITY; if (kidx + 32 > qrow) v1 = -INFINITY;
                        x0[i] = v0; x1[i] = v1; }
                }
            }
            if (t == 0) {
                float ma = fmaxf(fmaxf(x0[0], x0[1]), x0[2]), mb = fmaxf(fmaxf(x1[0], x1[1]), x1[2]);
#pragma unroll
                for (int j = 3; j < 15; j += 2) { ma = fmaxf(fmaxf(ma, x0[j]), x0[j + 1]); mb = fmaxf(fmaxf(mb, x1[j]), x1[j + 1]); }
                float mx = fmaxf(fmaxf(ma, mb), fmaxf(x0[15], x1[15]));
                { const auto rr = __builtin_amdgcn_permlane32_swap(__float_as_uint(mx), __float_as_uint(mx), false, false); mx = fmaxf(__uint_as_float(rr[0]), __uint_as_float(rr[1])); }
                m_run += mx;
#pragma unroll
                for (int j = 0; j < 16; ++j) { x0[j] -= mx; x1[j] -= mx; csp[j] -= mx; }
            }
            bf16x8 pf[4];
            s16x4 vl[2][NDB], vh[2][NDB];
#define A6_EXP(X, bb, PF) do { \
        X[bb + 0] = __builtin_amdgcn_exp2f(X[bb + 0]); X[bb + 1] = __builtin_amdgcn_exp2f(X[bb + 1]); X[bb + 2] = __builtin_amdgcn_exp2f(X[bb + 2]); X[bb + 3] = __builtin_amdgcn_exp2f(X[bb + 3]); \
        X[bb + 4] = __builtin_amdgcn_exp2f(X[bb + 4]); X[bb + 5] = __builtin_amdgcn_exp2f(X[bb + 5]); X[bb + 6] = __builtin_amdgcn_exp2f(X[bb + 6]); X[bb + 7] = __builtin_amdgcn_exp2f(X[bb + 7]); \
        { v4u w_; w_.x = pk2(X[bb + 0], X[bb + 1]); w_.y = pk2(X[bb + 2], X[bb + 3]); w_.z = pk2(X[bb + 4], X[bb + 5]); w_.w = pk2(X[bb + 6], X[bb + 7]); PF = __builtin_bit_cast(bf16x8, w_); } } while (0)
#define A6_VLD(buf, ss) do { _Pragma("unroll") for (int db = 0; db < NDB; ++db) { vl[buf][db] = vtr(sb + vbase + (16 * (ss)) * VROWB + 64 * db); vh[buf][db] = vtr(sb + vbase + (16 * (ss) + 8) * VROWB + 64 * db); } } while (0)
#define A6_MMA(buf, ss) do { _Pragma("unroll") for (int db = 0; db < NDB; ++db) { const bf16x8 vf_ = __builtin_shufflevector(vl[buf][db], vh[buf][db], 0, 1, 2, 3, 4, 5, 6, 7); o[db] = MFMA32(vf_, pf[ss], o[db]); } lacc = MFMA32(ones8, pf[ss], lacc); } while (0)
#define A6_SGB(nv) do { _Pragma("unroll") for (int db = 0; db < NDB; ++db) { __builtin_amdgcn_sched_group_barrier(0x008, 1, 0); __builtin_amdgcn_sched_group_barrier(A6_VMASK, (nv), 0); __builtin_amdgcn_sched_group_barrier(0x100, 2, 0); } __builtin_amdgcn_sched_group_barrier(0x008, 1, 0); } while (0)
            A6_VLD(0, 0);
            A6_EXP(x0, 0, pf[0]);
            __builtin_amdgcn_sched_barrier(0);
            A6_VLD(1, 1); A6_EXP(x0, 8, pf[1]); A6_MMA(0, 0); A6_SGB(12 / NDB);
            __builtin_amdgcn_sched_barrier(0);
            A6_VLD(0, 2); A6_EXP(x1, 0, pf[2]); A6_MMA(1, 1); A6_SGB(12 / NDB);
            __builtin_amdgcn_sched_barrier(0);
            A6_VLD(1, 3); A6_EXP(x1, 8, pf[3]); A6_MMA(0, 2); A6_SGB(12 / NDB);
            __builtin_amdgcn_sched_barrier(0);
            A6_MMA(1, 3);
            __builtin_amdgcn_sched_barrier(0);
#undef A6_EXP
#undef A6_VLD
#undef A6_MMA
#undef A6_SGB
            ATT_SETPRIO(0);
        }
        if (more) ATT_WRITE(t + 1);
        __syncthreads();
    }
#undef ATT_ISSUE
#undef ATT_WRITE
#if ATT_STATIC_PRIO
    __builtin_amdgcn_s_setprio(0);
#endif
    const float lt = lacc[0], inv = 1.0f / lt;
    if (COMB == 2) {
        const bf16* ip = P.TI + (tok0 + qrow) * (long)P.ldo + ocol + 4 * h; float ss = 0.f;
#pragma unroll
        for (int db = 0; db < NDB; ++db)
#pragma unroll
            for (int g = 0; g < 4; ++g) { const v2u a = *(const v2u*)(ip + 32 * db + 8 * g);
                const float c0 = bflo(a.x) - P.lam * (o[db][4 * g] * inv), c1 = bfhi(a.x) - P.lam * (o[db][4 * g + 1] * inv), c2 = bflo(a.y) - P.lam * (o[db][4 * g + 2] * inv), c3 = bfhi(a.y) - P.lam * (o[db][4 * g + 3] * inv);
                o[db][4 * g] = c0; o[db][4 * g + 1] = c1; o[db][4 * g + 2] = c2; o[db][4 * g + 3] = c3; ss += (c0 * c0 + c1 * c1) + (c2 * c2 + c3 * c3); }
        ss += shx(ss, 32, lane);
        const float rr = P.osc / sqrtf(ss * (1.0f / 128.0f) + LN_EPS);
        bf16* op = P.O + (tok0 + qrow) * (long)P.ldo + ocol + 4 * h;
#pragma unroll
        for (int db = 0; db < NDB; ++db)
#pragma unroll
            for (int g = 0; g < 4; ++g) { const f32x4 gg = *(const f32x4*)(P.gsub + 32 * db + 8 * g + 4 * h);
                v2u w; w.x = pk2(o[db][4 * g] * rr * gg[0], o[db][4 * g + 1] * rr * gg[1]); w.y = pk2(o[db][4 * g + 2] * rr * gg[2], o[db][4 * g + 3] * rr * gg[3]);
                *(v2u*)(op + 32 * db + 8 * g) = w; }
        return;
    }
    bf16* op = P.O + (tok0 + qrow) * (long)P.ldo + ocol + 4 * h;
#pragma unroll
    for (int db = 0; db < NDB; ++db)
#pragma unroll
        for (int g = 0; g < 4; ++g) { v2u w; w.x = pk2(o[db][4 * g] * inv, o[db][4 * g + 1] * inv); w.y = pk2(o[db][4 * g + 2] * inv, o[db][4 * g + 3] * inv);
            *(v2u*)(op + 32 * db + 8 * g) = w; }
}

#undef MFMA32
}

constexpr size_t MiB = 1u << 20;
constexpr size_t WS_CTL = 0, CTL_ZERO_BYTES = 1 * MiB;
constexpr size_t WS_ROPE = 1 * MiB;
constexpr size_t WS_MISC = 5 * MiB;
constexpr size_t WS_XB = 6 * MiB;
constexpr size_t WS_XB8 = 70 * MiB + 16 * MiB;
constexpr size_t WS_PB = 70 * MiB;
constexpr size_t WS_W = 118 * MiB;
constexpr size_t W_IN = WS_W, W_G8 = WS_W + 8 * MiB, W_UQ = WS_W + 12 * MiB, W_UKV = WS_W + 13 * MiB, W_BD = WS_W + 14 * MiB, W_BM = WS_W + 16 * MiB, W_OUT = WS_W + 17 * MiB,
                 W_PG = WS_W + 19 * MiB, W_PP = WS_W + 21 * MiB, W_F13 = WS_W + 22 * MiB  , W_F2E = WS_W + 134 * MiB;
constexpr size_t WS_ACT = 308 * MiB;
constexpr size_t A_DQ = WS_ACT, A_DK = WS_ACT + 64 * MiB, A_DV = WS_ACT + 128 * MiB, A_G = WS_ACT + 192 * MiB, A_C = WS_ACT + 320 * MiB;
constexpr size_t A_OA = A_C + 64 * MiB  , A_MT = A_DK, A_M = A_DV, A_CQ = A_C, A_OA2 = A_C, A_PRE = A_C;
constexpr size_t A_CQN = WS_ACT + 448 * MiB, A_CKVN = WS_ACT + 472 * MiB, A_OB = A_CQN, A_MKR = WS_ACT + 488 * MiB, A_MQ = WS_ACT + 490 * MiB, A_MKV = WS_ACT + 538 * MiB;
constexpr size_t A_H = WS_ACT;
constexpr size_t A_XG = WS_ACT, A_YG = A_XG  , A_TOK = WS_ACT + 264 * MiB, A_HG = WS_ACT + 270 * MiB  , A_PREM = WS_ACT + 512 * MiB;
constexpr size_t W_F13D = WS_ACT + 602 * MiB, W_F2D = WS_ACT + 613 * MiB;
constexpr size_t W_QKV8 = WS_W + 3 * MiB;
constexpr size_t WS_SSP = WS_ACT + 620 * MiB;
constexpr size_t WS_END = WS_ACT + 640 * MiB;
static_assert(MOE_FP8 == 1, "the workspace map assumes fp8 expert activations");
constexpr int CW_BAR = 4096, CW_MOE = 8192, CW_LN = 16384;
constexpr size_t WS_LNST = WS_W + 10 * MiB;
constexpr int CW_DUMMY_ = 0;

constexpr int RING_BYTES = 131072, MISC_OFF = RING_BYTES + 320, LDS_BYTES = 147456;
constexpr int NWAVES = 8;

#ifndef REP_ATTN_D
#define REP_ATTN_D 1
#endif
#ifndef REP_ATTN_M
#define REP_ATTN_M 1
#endif
#ifndef REP_CONV
#define REP_CONV 1
#endif
#ifndef REP_L1
#define REP_L1 1
#endif
#ifndef REP_EW
#define REP_EW 1
#endif
#ifndef REP_BAR
#define REP_BAR 1
#endif
#ifndef REP_LN
#define REP_LN 1
#endif
#ifndef REP_MOE
#define REP_MOE 1
#endif
#ifndef REP_MIX
#define REP_MIX 1
#endif
#ifndef REP_FFN
#define REP_FFN 1
#endif
#ifndef REP_P0
#define REP_P0 1
#endif
#ifndef REP_PPE
#define REP_PPE 1
#endif
#ifndef ATT_UNIT_D
#define ATT_UNIT_D attn_unit10
#endif
#ifndef ATT_UNIT_M
#define ATT_UNIT_M attn_unit10
#endif
#ifndef F8_SP2
#define F8_SP2 true
#endif
#ifndef GEMM_STAGGER
#define GEMM_STAGGER 0
#endif
#ifndef STAG_L1
#define STAG_L1 1500
#endif
#ifndef STAG_H
#define STAG_H 1500
#endif
#ifndef STAG_UP
#define STAG_UP 1000
#endif
#ifndef GEMM_ALIGN
#define GEMM_ALIGN true
#endif
#ifndef UP_ALIGN
#define UP_ALIGN true
#endif
#ifndef PROBE_D
#define PROBE_D -1
#endif
#ifndef PROBE_M
#define PROBE_M -1
#endif
#ifndef LN_FUSE
#define LN_FUSE 1
#endif
#ifndef CONV_IN_DOWN
#define CONV_IN_DOWN 1
#endif
#ifndef CONV_IN_ATTN
#define CONV_IN_ATTN 1
#endif
#ifndef PROBE_NULL_L1
#define PROBE_NULL_L1 0
#endif
#ifndef QKV_FP8
#define QKV_FP8 1
#endif
#define XB_TMO      128
#define XB_XCNT(j)  (256  + 64 * (j))
#define XB_XSUB(j)  (1280 + 64 * (j))
#define XB_XGEN(j)  (2304 + 64 * (j))
#define XB_TOP      3328
#define XB_TOPGEN   3392
#define XCD_BAR_WORDS 3456
#define XB_SPIN_CAP (1u << 18)

__device__ __forceinline__ unsigned xb_ld(unsigned* p)              { return __hip_atomic_load(p, __ATOMIC_RELAXED, __HIP_MEMORY_SCOPE_AGENT); }
__device__ __forceinline__ unsigned xb_add(unsigned* p, unsigned v) { return __hip_atomic_fetch_add(p, v, __ATOMIC_RELAXED, __HIP_MEMORY_SCOPE_AGENT); }
__device__ __forceinline__ unsigned xb_xcc_id() { return (unsigned)__builtin_amdgcn_s_getreg((3 << 11) | 20) & 0xFu; }
#define XB_SPIN(cond, bar) do { unsigned _sp = 0; while (cond) { __builtin_amdgcn_s_sleep(1); \
    if ((++_sp & 255u) == 0u) { if (xb_ld(&(bar)[XB_TMO])) break; if (_sp > XB_SPIN_CAP) { atomicAdd(&(bar)[XB_TMO], 1u); break; } } } } while (0)

struct XcdBarrier {
    unsigned* bar; unsigned x;
    volatile LAS unsigned* st;
};

__device__ __forceinline__ XcdBarrier xcd_barrier_post(unsigned* bar, volatile LAS unsigned* st, const bool t0  ) {
    XcdBarrier b; b.bar = bar; b.x = xb_xcc_id(); b.st = st;
    if (t0) (void)xb_add(&bar[XB_XCNT(b.x)], 1u);
    return b;
}
__device__ __forceinline__ void xcd_barrier_complete(unsigned* bar, unsigned x, unsigned& nloc, unsigned& nx) {
    const unsigned G = gridDim.x * gridDim.y * gridDim.z;
    unsigned sum, cnt, mine, sp = 0u;
    for (;;) {
        sum = 0u; cnt = 0u; mine = 0u;
#pragma unroll
        for (unsigned j = 0; j < 16; ++j) { const unsigned c = xb_ld(&bar[XB_XCNT(j)]); sum += c; cnt += (c > 0u) ? 1u : 0u; mine = (j == x) ? c : mine; }
        if (sum == G) break;
        __builtin_amdgcn_s_sleep(1);
        if ((++sp & 255u) == 0u) { if (xb_ld(&bar[XB_TMO])) break; if (sp > XB_SPIN_CAP) { atomicAdd(&bar[XB_TMO], 1u); break; } }
    }
    nloc = mine > 0u ? mine : 1u; nx = cnt > 0u ? cnt : 1u;
}

__device__ __forceinline__ void xcd_barrier(const XcdBarrier& b, const bool t0) {
    asm volatile("s_waitcnt vmcnt(0)" ::: "memory");
    __syncthreads();
    if (t0) {
        unsigned* bar = b.bar;
        __builtin_amdgcn_s_waitcnt(0);
        unsigned nloc = b.st[0], nx = b.st[1];
        if (nloc == 0u) { xcd_barrier_complete(bar, b.x, nloc, nx); b.st[0] = nloc; b.st[1] = nx; }
        const unsigned old = xb_add(&bar[XB_XSUB(b.x)], 1u);
        const unsigned gen = old / nloc;
        if (old + 1u == (gen + 1u) * nloc) {
            __builtin_amdgcn_fence(__ATOMIC_RELEASE, "agent");
            asm volatile("s_waitcnt vmcnt(0)" ::: "memory");
            const unsigned og = xb_add(&bar[XB_TOP], 1u);
            const unsigned tg = og / nx;
            if (og + 1u == (tg + 1u) * nx) xb_add(&bar[XB_TOPGEN], 1u);
            else XB_SPIN(xb_ld(&bar[XB_TOPGEN]) == tg, bar);
            __builtin_amdgcn_fence(__ATOMIC_ACQUIRE, "agent");
            xb_add(&bar[XB_XGEN(b.x)], 1u);
            asm volatile("s_waitcnt vmcnt(0)" ::: "memory");
        } else {
            XB_SPIN(xb_ld(&bar[XB_XGEN(b.x)]) == gen, bar);
            __builtin_amdgcn_fence(__ATOMIC_ACQUIRE, "agent");
            asm volatile("s_waitcnt vmcnt(0)" ::: "memory");
        }
    }
    __syncthreads();
}

struct Args { const void* in[31]; float* out; unsigned char* ws; int ph_lo, ph_hi, fuse; };

struct Frame {
    LAS unsigned char* lds;
    int tid, lane, wave, gw, NGW, G, vcu;
    const Args* a;
    unsigned char* ws;
};
#define FR_TID(F_) ({ unsigned m1_ = ~0u; asm volatile("" : "+s"(m1_)); (((F_).wave << 6) | (int)__builtin_amdgcn_mbcnt_hi(m1_, __builtin_amdgcn_mbcnt_lo(m1_, 0u))); })
#define INF(i) ((const float*)F.a->in[i])
#define WSP(T_, off) ((T_*)(F.ws + (off)))

__device__ __forceinline__ void conv_w(const Frame& F, const float* src, int ldn, int K, int ncols, int nbatch, size_t sbs, bf16* dst, int rmul, int roff, size_t dbs, const float* kscale) {
    LAS float* scr = (LAS float*)(F.lds + F.wave * 16384);
    const int lane = F.lane, nblk = ncols / 32, kblk = K / 64, per = nblk * kblk, total = per * nbatch;
    for (int it = F.gw; it < total; it += F.NGW) {
        const int bt = it / per, r = it % per, kb = r / nblk, nb = r % nblk, k0 = kb * 64, n0 = nb * 32;
        const float* W = src + (size_t)bt * sbs; bf16* WT = dst + (size_t)bt * dbs;
        float ld_[32];
#pragma unroll
        for (int i = 0; i < 32; ++i) ld_[i] = __builtin_nontemporal_load(W + (size_t)(k0 + 2 * i + (lane >> 5)) * ldn + n0 + (lane & 31));
#pragma unroll
        for (int i = 0; i < 32; ++i) scr[(2 * i + (lane >> 5)) * 33 + (lane & 31)] = ld_[i];
        LDS_WAIT(); asm volatile("" ::: "memory");
        const int c = lane & 7;
        float ks[8];
#pragma unroll
        for (int i = 0; i < 8; ++i) ks[i] = kscale ? kscale[k0 + 8 * c + i] : 1.0f;
#pragma unroll
        for (int j = 0; j < 4; ++j) { const int n = (lane >> 3) + 8 * j; const LAS float* s = scr + (8 * c) * 33 + n;
            v4u o; o.x = pk2(s[0 * 33] * ks[0], s[1 * 33] * ks[1]); o.y = pk2(s[2 * 33] * ks[2], s[3 * 33] * ks[3]); o.z = pk2(s[4 * 33] * ks[4], s[5 * 33] * ks[5]); o.w = pk2(s[6 * 33] * ks[6], s[7 * 33] * ks[7]);
            *(v4u*)(WT + (size_t)(rmul * (n0 + n) + roff) * K + k0 + 8 * c) = o; }
        LDS_WAIT(); asm volatile("" ::: "memory");
    }
}
__device__ __forceinline__ void conv_w8(const Frame& F, const float* src, int ldn, int K, int ncols, int nbatch, size_t sbs, unsigned char* dst, int rmul, int roff, size_t dbs, float scale) {
    LAS float* scr = (LAS float*)(F.lds + F.wave * 16384);
    const int lane = F.lane, nblk = ncols / 32, kblk = K / 64, per = nblk * kblk, total = per * nbatch;
    for (int it = F.gw; it < total; it += F.NGW) {
        const int bt = it / per, r = it % per, kb = r / nblk, nb = r % nblk, k0 = kb * 64, n0 = nb * 32;
        const float* W = src + (size_t)bt * sbs; unsigned char* WT = dst + (size_t)bt * dbs;
        float ld_[32];
#pragma unroll
        for (int i = 0; i < 32; ++i) ld_[i] = __builtin_nontemporal_load(W + (size_t)(k0 + 2 * i + (lane >> 5)) * ldn + n0 + (lane & 31));
#pragma unroll
        for (int i = 0; i < 32; ++i) scr[(2 * i + (lane >> 5)) * 33 + (lane & 31)] = ld_[i];
        LDS_WAIT(); asm volatile("" ::: "memory");
        const int c = lane & 7;
#pragma unroll
        for (int j = 0; j < 4; ++j) { const int n = (lane >> 3) + 8 * j; const LAS float* s = scr + (8 * c) * 33 + n;
            int lo = __builtin_amdgcn_cvt_pk_fp8_f32(s[0 * 33] * scale, s[1 * 33] * scale, 0, false); lo = __builtin_amdgcn_cvt_pk_fp8_f32(s[2 * 33] * scale, s[3 * 33] * scale, lo, true);
            int hi = __builtin_amdgcn_cvt_pk_fp8_f32(s[4 * 33] * scale, s[5 * 33] * scale, 0, false); hi = __builtin_amdgcn_cvt_pk_fp8_f32(s[6 * 33] * scale, s[7 * 33] * scale, hi, true);
            v2u o; o.x = (unsigned)lo; o.y = (unsigned)hi;
            *(v2u*)(WT + (size_t)(rmul * (n0 + n) + roff) * K + k0 + 8 * c) = o; }
        LDS_WAIT(); asm volatile("" ::: "memory");
    }
}
__device__ __forceinline__ void phase_convert(const Frame& F, int L, const int which = 0) {
    const int j = L >> 1;
    if (which != 2) {
    const float* win = INF(4) + (size_t)L * D * IN_COLS;
#if QKV_FP8
    conv_w8(F, win, IN_COLS, D, 3072, 1, 0, WSP(unsigned char, W_QKV8), 1, 0, 0, 32.0f);
    conv_w8(F, win + 3744, IN_COLS, D, 2048, 1, 0, WSP(unsigned char, W_QKV8), 1, 3072, 0, 32.0f);
    conv_w(F, win + 3072, IN_COLS, D, 672, 1, 0, WSP(bf16, W_IN), 1, 0, 0, nullptr);
    { bf16* padr = WSP(bf16, W_IN) + (size_t)672 * D;
#else
    conv_w(F, win, IN_COLS, D, 3072, 1, 0, WSP(bf16, W_IN), 1, 0, 0, nullptr);
    conv_w8(F, win + 3744, IN_COLS, D, 2048, 1, 0, WSP(unsigned char, W_G8), 1, 0, 0, 32.0f);
    conv_w(F, win + 3072, IN_COLS, D, 672, 1, 0, WSP(bf16, W_IN), 1, 3072, 0, nullptr);
    { bf16* padr = WSP(bf16, W_IN) + (size_t)3744 * D;
#endif
      unsigned z_ = 0u; asm volatile("" : "+v"(z_));
      for (int i = F.gw * 64 + F.lane; i < (NIN - IN_COLS) * D / 8; i += F.NGW * 64) ((v4u*)padr)[i] = (v4u){z_, z_, z_, z_}; }
    conv_w(F, INF(12) + (size_t)L * QR * 768, 768, QR, 768, 1, 0, WSP(bf16, W_UQ), 1, 0, 0, INF(11) + L * QR);
    conv_w(F, INF(14) + (size_t)L * KVR * 1024, 1024, KVR, 1024, 1, 0, WSP(bf16, W_UKV), 1, 0, 0, INF(13) + L * KVR);
    conv_w(F, INF(15) + (size_t)L * D * D, D, D, D, 1, 0, WSP(bf16, W_BD), 1, 0, 0, nullptr);
    conv_w(F, INF(16) + (size_t)L * 512 * D, D, 512, D, 1, 0, WSP(bf16, W_BM), 1, 0, 0, nullptr);
    conv_w(F, INF(17) + (size_t)L * D * D, D, D, D, 1, 0, WSP(bf16, W_OUT), 1, 0, 0, nullptr);
    conv_w8(F, INF(27) + (size_t)L * D * D, D, D, D, 1, 0, WSP(unsigned char, W_PG), 1, 0, 0, 32.0f);
    conv_w(F, INF(28) + (size_t)L * PLE * D, D, PLE, D, 1, 0, WSP(bf16, W_PP), 1, 0, 0, nullptr);
    }
    if ((L & 1) == 0) { if (which != 2) {
        conv_w(F, INF(20) + (size_t)j * D * DENSE_FF, DENSE_FF, D, DENSE_FF, 1, 0, WSP(bf16, W_F13D), 2, 0, 0, nullptr);
        conv_w(F, INF(21) + (size_t)j * D * DENSE_FF, DENSE_FF, D, DENSE_FF, 1, 0, WSP(bf16, W_F13D), 2, 1, 0, nullptr);
        conv_w(F, INF(22) + (size_t)j * DENSE_FF * D, D, DENSE_FF, D, 1, 0, WSP(bf16, W_F2D), 1, 0, 0, nullptr); }
    } else if (which != 1) {
        const size_t eo = (size_t)j * NEXP * D * EXPERT_FF;
#if MOE_FP8
        conv_w8(F, INF(24) + eo, EXPERT_FF, D, EXPERT_FF, NEXP, (size_t)D * EXPERT_FF, WSP(unsigned char, W_F13), 2, 0, (size_t)2 * EXPERT_FF * D, 32.0f);
        conv_w8(F, INF(25) + eo, EXPERT_FF, D, EXPERT_FF, NEXP, (size_t)D * EXPERT_FF, WSP(unsigned char, W_F13), 2, 1, (size_t)2 * EXPERT_FF * D, 32.0f);
        conv_w8(F, INF(26) + eo, D, EXPERT_FF, D, NEXP, (size_t)EXPERT_FF * D, WSP(unsigned char, W_F2E), 1, 0, (size_t)D * EXPERT_FF, 128.0f);
#else
        conv_w(F, INF(24) + eo, EXPERT_FF, D, EXPERT_FF, NEXP, (size_t)D * EXPERT_FF, WSP(bf16, W_F13), 2, 0, (size_t)2 * EXPERT_FF * D, nullptr);
        conv_w(F, INF(25) + eo, EXPERT_FF, D, EXPERT_FF, NEXP, (size_t)D * EXPERT_FF, WSP(bf16, W_F13), 2, 1, (size_t)2 * EXPERT_FF * D, nullptr);
        conv_w(F, INF(26) + eo, D, EXPERT_FF, D, NEXP, (size_t)EXPERT_FF * D, WSP(bf16, W_F2E), 1, 0, (size_t)D * EXPERT_FF, nullptr);
#endif
    }
    if (which != 2) { const f32x4* ps = (const f32x4*)(INF(1) + (size_t)L * T * PLE); v2u* pd = WSP(v2u, WS_PB);
      for (int i = F.gw * 64 + F.lane; i < T * PLE / 4; i += F.NGW * 64) { const f32x4 v = __builtin_nontemporal_load(ps + i); v2u o; o.x = pk2(v[0], v[1]); o.y = pk2(v[2], v[3]); pd[i] = o; } }
}

__device__ __forceinline__ void phase_prologue(const Frame& F) {
    const int* pos = (const int*)F.a->in[2];
    for (int m = F.gw; m < T; m += F.NGW) {
        const f32x4* xr = (const f32x4*)(INF(0) + (size_t)m * D) + 2 * F.lane; v4u* br = WSP(v4u, WS_XB) + (size_t)m * (D / 8) + F.lane; v2u* br8 = WSP(v2u, WS_XB8) + (size_t)m * (D / 8) + F.lane;
#pragma unroll
        for (int j = 0; j < 2; ++j) { const f32x4 va = __builtin_nontemporal_load(xr + 128 * j), vb = __builtin_nontemporal_load(xr + 128 * j + 1);
            v4u o; o.x = pk2(va[0], va[1]); o.y = pk2(va[2], va[3]); o.z = pk2(vb[0], vb[1]); o.w = pk2(vb[2], vb[3]); br[64 * j] = o;
            int wa = __builtin_amdgcn_cvt_pk_fp8_f32(va[0], va[1], 0, false); wa = __builtin_amdgcn_cvt_pk_fp8_f32(va[2], va[3], wa, true);
            int wb = __builtin_amdgcn_cvt_pk_fp8_f32(vb[0], vb[1], 0, false); wb = __builtin_amdgcn_cvt_pk_fp8_f32(vb[2], vb[3], wb, true);
            v2u o8; o8.x = (unsigned)wa; o8.y = (unsigned)wb; br8[64 * j] = o8; }
    }
    { float* rope = WSP(float, WS_ROPE);
      for (int idx = F.gw * 64 + F.lane; idx < T * 16; idx += F.NGW * 64) {
          const int t = idx >> 4, j = idx & 15;
          double inv = 1.0; for (int i = 0; i < j; ++i) inv *= 0.5623413251903491;
          const double ang = (double)pos[t] * inv;
          const double nq = __builtin_rint(ang * 0.6366197723675814);
          double y = __builtin_fma(-nq, 1.5707963267948966, ang); y = __builtin_fma(-nq, 6.123233995736766e-17, y);
          const double y2 = y * y;
          double sp = 1.0 / 6227020800.0; sp = sp * y2 - 1.0 / 39916800.0; sp = sp * y2 + 1.0 / 362880.0; sp = sp * y2 - 1.0 / 5040.0; sp = sp * y2 + 1.0 / 120.0; sp = sp * y2 - 1.0 / 6.0;
          const double sn = y + y * y2 * sp;
          double cp = -1.0 / 87178291200.0; cp = cp * y2 + 1.0 / 479001600.0; cp = cp * y2 - 1.0 / 3628800.0; cp = cp * y2 + 1.0 / 40320.0; cp = cp * y2 - 1.0 / 720.0; cp = cp * y2 + 1.0 / 24.0; cp = cp * y2 - 0.5;
          const double cs = 1.0 + y2 * cp;
          const int q = ((int)nq) & 3;
          const double c = (q == 0) ? cs : (q == 1) ? -sn : (q == 2) ? -cs : sn;
          const double s = (q == 0) ? sn : (q == 1) ? cs : (q == 2) ? -sn : -cs;
          rope[2 * idx] = (float)c; rope[2 * idx + 1] = (float)s;
      } }
    { int* bm = WSP(int, WS_MISC);
      for (int blk = F.gw; blk < T / 64; blk += F.NGW) { int v = pos[blk * 64 + F.lane];
#pragma unroll
          for (int o = 1; o < 64; o <<= 1) { const int t2 = shxi(v, o, F.lane); v = t2 > v ? t2 : v; }
          if (F.lane == 0) bm[blk] = v; } }
    { float* lut = WSP(float, WS_MISC + 4096); const float* tab = INF(3);
      for (int idx = F.gw * 64 + F.lane; idx < 8 * 132; idx += F.NGW * 64) { const int hh = idx / 132, n = idx % 132;
          int bk = n;
          if (n >= 16) bk = 16 + (n >= 19) + (n >= 21) + (n >= 24) + (n >= 27) + (n >= 31) + (n >= 35) + (n >= 40) + (n >= 46) + (n >= 52) + (n >= 59) + (n >= 67) + (n >= 77) + (n >= 87) + (n >= 99) + (n >= 113);
          lut[idx] = tab[bk * 8 + hh] * LOG2E; } }
    { float* gt = WSP(float, WS_MISC + 32768); const float* gs = INF(10);
      for (int idx = F.gw * 64 + F.lane; idx < DEPTH * 128; idx += F.NGW * 64) { const int L_ = idx >> 7; gt[idx] = gs[idx] * (1.0f - (0.8f - 0.6f * expf(-0.3f * (float)L_))); } }
    for (int rep = 0; rep < REP_CONV; ++rep) phase_convert(F, 0);
}

__device__ __forceinline__ void phase_rms_rope(const Frame& F) {
    const bf16* CQ = WSP(bf16, A_CQ); const float* rope = WSP(float, WS_ROPE);
    bf16* CQN = WSP(bf16, A_CQN); bf16* CKVN = WSP(bf16, A_CKVN); bf16* MKR = WSP(bf16, A_MKR);
    const int l = F.lane;
    for (int m0 = F.gw; m0 < T; m0 += 4 * F.NGW) {
        unsigned q0[4], q1[4], q2[4]; v2u kvp[4]; unsigned short k1[4], k2[4]; float rc[4], rs[4];
#pragma unroll
        for (int q = 0; q < 4; ++q) { const int m = (m0 + q * F.NGW < T) ? m0 + q * F.NGW : m0; const bf16* c = CQ + (size_t)m * 768;
            q0[q] = *(const unsigned*)(c + 6 * l); q1[q] = *(const unsigned*)(c + 6 * l + 2); q2[q] = *(const unsigned*)(c + 6 * l + 4);
            kvp[q] = *(const v2u*)(c + QR + 4 * l);
            k1[q] = 0; k2[q] = 0; rc[q] = 0.f; rs[q] = 0.f;
            if (l < 16) { k1[q] = c[QR + KVR + l]; k2[q] = c[QR + KVR + 16 + l]; rc[q] = rope[(size_t)m * 32 + 2 * l]; rs[q] = rope[(size_t)m * 32 + 2 * l + 1]; } }
#pragma unroll
        for (int q = 0; q < 4; ++q) { const int m = m0 + q * F.NGW; if (m >= T) break;
            const f32x2 a0 = {bflo(q0[q]), bfhi(q0[q])}, a1 = {bflo(q1[q]), bfhi(q1[q])}, a2 = {bflo(q2[q]), bfhi(q2[q])};
            const f32x4 kv = {bflo(kvp[q].x), bfhi(kvp[q].x), bflo(kvp[q].y), bfhi(kvp[q].y)};
            const float x1 = bflo((unsigned)k1[q]), x2 = bflo((unsigned)k2[q]);
            const float sq = wave_sum(l, a0[0] * a0[0] + a0[1] * a0[1] + a1[0] * a1[0] + a1[1] * a1[1] + a2[0] * a2[0] + a2[1] * a2[1]);
            const float sk = wave_sum(l, kv[0] * kv[0] + kv[1] * kv[1] + kv[2] * kv[2] + kv[3] * kv[3]);
            const float rq = 1.0f / sqrtf(sq * (1.0f / QR) + LN_EPS), rk = 1.0f / sqrtf(sk * (1.0f / KVR) + LN_EPS);
            unsigned* qo = (unsigned*)(CQN + (size_t)m * QR + 6 * l);
            qo[0] = pk2(a0[0] * rq, a0[1] * rq); qo[1] = pk2(a1[0] * rq, a1[1] * rq); qo[2] = pk2(a2[0] * rq, a2[1] * rq);
            v2u ko; ko.x = pk2(kv[0] * rk, kv[1] * rk); ko.y = pk2(kv[2] * rk, kv[3] * rk);
            *(v2u*)(CKVN + (size_t)m * KVR + 4 * l) = ko;
            if (l < 16) { const float o1 = x1 * rc[q] - x2 * rs[q], o2 = x1 * rs[q] + x2 * rc[q]; const unsigned w = pk2(o1, o2);
                MKR[(size_t)m * 32 + l] = (bf16)(w & 0xffffu); MKR[(size_t)m * 32 + 16 + l] = (bf16)(w >> 16); }
        }
    }
}

template <bool ROUTE, bool GATHER>
__device__ __forceinline__ void phase_ln(const Frame& F, const bf16* PRE, const float* gam, const float* bet, const float* wr, int moe_j, const bool write_f32) {
    const int l = F.lane;
    const bf16* YG = WSP(bf16, A_YG); int* TOKE = WSP(int, A_TOK); float* TOKG = WSP(float, A_TOK + 1 * MiB); const int* TOKR = WSP(int, A_TOK + 2 * MiB);
    int* TOKS = WSP(int, A_TOK + 3 * MiB); int* CNTW = WSP(int, A_TOK + 4 * MiB);
    int rc0 = 0, rc1 = 0, rc2 = 0, rc3 = 0, rc4 = 0, rc5 = 0, rc6 = 0, rc7 = 0; (void)moe_j;
    f32x4 gv[4], bv[4];
#pragma unroll
    for (int j = 0; j < 4; ++j) { const int cj = 8 * l + 512 * (j >> 1) + 4 * (j & 1); gv[j] = *(const f32x4*)(gam + cj); bv[j] = *(const f32x4*)(bet + cj); }
    f32x4 rw0[4][4], rw1[4][4];
    if (ROUTE) {
#pragma unroll
        for (int j = 0; j < 4; ++j)
#pragma unroll
            for (int c = 0; c < 4; ++c) { const float* w = wr + (size_t)(8 * l + 512 * (j >> 1) + 4 * (j & 1) + c) * 8; rw0[j][c] = *(const f32x4*)w; rw1[j][c] = *(const f32x4*)(w + 4); }
    }
    int pr0[2] = {0, 0}, pr1[2] = {0, 0}; float pg0[2] = {0.f, 0.f}, pg1[2] = {0.f, 0.f};
    if (GATHER) {
#pragma unroll
        for (int q = 0; q < 2; ++q) { const int m = (F.gw + q * F.NGW < T) ? F.gw + q * F.NGW : F.gw; pr0[q] = TOKR[2 * m]; pr1[q] = TOKR[2 * m + 1]; pg0[q] = TOKG[2 * m]; pg1[q] = TOKG[2 * m + 1]; } }
    for (int m0 = F.gw; m0 < T; m0 += 2 * F.NGW) {
        v4u raw[2][2]; v4u y0[2][2], y1[2][2]; float g0[2] = {0.f, 0.f}, g1[2] = {0.f, 0.f};
#pragma unroll
        for (int q = 0; q < 2; ++q) { const int m = (m0 + q * F.NGW < T) ? m0 + q * F.NGW : m0;     const v4u* xr = (const v4u*)(PRE + (size_t)m * D) + l;
#pragma unroll
            for (int j = 0; j < 2; ++j) raw[q][j] = xr[64 * j];
            if (GATHER) { const int r0 = pr0[q], r1 = pr1[q]; g0[q] = pg0[q]; g1[q] = pg1[q];
                const v4u* p0 = (const v4u*)(YG + (size_t)r0 * D) + l; const v4u* p1 = (const v4u*)(YG + (size_t)r1 * D) + l;
#pragma unroll
                for (int j = 0; j < 2; ++j) { y0[q][j] = p0[64 * j]; y1[q][j] = p1[64 * j]; } } }
        if (GATHER && m0 + 2 * F.NGW < T) {
#pragma unroll
            for (int q = 0; q < 2; ++q) { const int mb = m0 + 2 * F.NGW, m = (mb + q * F.NGW < T) ? mb + q * F.NGW : mb; pr0[q] = TOKR[2 * m]; pr1[q] = TOKR[2 * m + 1]; pg0[q] = TOKG[2 * m]; pg1[q] = TOKG[2 * m + 1]; } }
#pragma unroll
        for (int q = 0; q < 2; ++q) { const int m = m0 + q * F.NGW; if (m >= T) break;
            f32x4 v[4]; float s = 0.f;
#pragma unroll
            for (int j = 0; j < 4; ++j) { const v4u a4 = raw[q][j >> 1]; v2u a; a.x = (j & 1) ? a4.z : a4.x; a.y = (j & 1) ? a4.w : a4.y; v[j][0] = bflo(a.x); v[j][1] = bfhi(a.x); v[j][2] = bflo(a.y); v[j][3] = bfhi(a.y); }
            if (GATHER) {
#pragma unroll
                for (int j = 0; j < 4; ++j) { const v4u a4 = y0[q][j >> 1], b4 = y1[q][j >> 1]; v2u a, b; a.x = (j & 1) ? a4.z : a4.x; a.y = (j & 1) ? a4.w : a4.y; b.x = (j & 1) ? b4.z : b4.x; b.y = (j & 1) ? b4.w : b4.y;
                    v[j][0] += g0[q] * bflo(a.x) + g1[q] * bflo(b.x); v[j][1] += g0[q] * bfhi(a.x) + g1[q] * bfhi(b.x); v[j][2] += g0[q] * bflo(a.y) + g1[q] * bflo(b.y); v[j][3] += g0[q] * bfhi(a.y) + g1[q] * bfhi(b.y); } }
#pragma unroll
            for (int j = 0; j < 4; ++j) s += (v[j][0] + v[j][1]) + (v[j][2] + v[j][3]);
            const float mean = wave_sum(l, s) * (1.f / D); float s2 = 0.f;
#pragma unroll
            for (int j = 0; j < 4; ++j) { v[j] = v[j] - mean; s2 += (v[j][0] * v[j][0] + v[j][1] * v[j][1]) + (v[j][2] * v[j][2] + v[j][3] * v[j][3]); }
            const float rstd = 1.f / sqrtf(wave_sum(l, s2) * (1.f / D) + LN_EPS);
            f32x4* orow = (f32x4*)(F.a->out + (size_t)m * D) + 2 * l; v4u* br = WSP(v4u, WS_XB) + (size_t)m * (D / 8) + l; v2u* br8 = WSP(v2u, WS_XB8) + (size_t)m * (D / 8) + l;
#pragma unroll
            for (int j = 0; j < 4; ++j) v[j] = v[j] * rstd * gv[j] + bv[j];
            if (write_f32) {
#pragma unroll
                for (int j = 0; j < 4; ++j) orow[128 * (j >> 1) + (j & 1)] = v[j];
            } else {
#pragma unroll
                for (int j2 = 0; j2 < 2; ++j2) { const f32x4 va = v[2 * j2], vb = v[2 * j2 + 1];
                    v4u o; o.x = pk2(va[0], va[1]); o.y = pk2(va[2], va[3]); o.z = pk2(vb[0], vb[1]); o.w = pk2(vb[2], vb[3]); br[64 * j2] = o;
                    int wa = __builtin_amdgcn_cvt_pk_fp8_f32(va[0], va[1], 0, false); wa = __builtin_amdgcn_cvt_pk_fp8_f32(va[2], va[3], wa, true);
                    int wb = __builtin_amdgcn_cvt_pk_fp8_f32(vb[0], vb[1], 0, false); wb = __builtin_amdgcn_cvt_pk_fp8_f32(vb[2], vb[3], wb, true);
                    v2u o8; o8.x = (unsigned)wa; o8.y = (unsigned)wb; br8[64 * j2] = o8; }
            }
            if (ROUTE) {
                float lg[8];
#pragma unroll
                for (int e = 0; e < 8; ++e) lg[e] = 0.f;
#pragma unroll
                for (int j = 0; j < 4; ++j)
#pragma unroll
                    for (int c = 0; c < 4; ++c) { const f32x4 w0 = rw0[j][c], w1 = rw1[j][c]; const float xv = v[j][c];
                        lg[0] += xv * w0[0]; lg[1] += xv * w0[1]; lg[2] += xv * w0[2]; lg[3] += xv * w0[3]; lg[4] += xv * w1[0]; lg[5] += xv * w1[1]; lg[6] += xv * w1[2]; lg[7] += xv * w1[3]; }
#pragma unroll
                for (int e = 0; e < 8; ++e) lg[e] = wave_sum(l, lg[e]);
                int e0 = 0; float v0 = lg[0];
#pragma unroll
                for (int e = 1; e < 8; ++e) if (lg[e] > v0) { v0 = lg[e]; e0 = e; }
                int e1 = -1; float v1 = -INFINITY;
#pragma unroll
                for (int e = 0; e < 8; ++e) if (e != e0 && lg[e] > v1) { v1 = lg[e]; e1 = e; }
                const float gg1 = 1.0f / (1.0f + expf(v0 - v1)), gg0 = 1.0f - gg1;
                const int s0 = (e0 == 0) ? rc0 : (e0 == 1) ? rc1 : (e0 == 2) ? rc2 : (e0 == 3) ? rc3 : (e0 == 4) ? rc4 : (e0 == 5) ? rc5 : (e0 == 6) ? rc6 : rc7;
                const int s1 = (e1 == 0) ? rc0 : (e1 == 1) ? rc1 : (e1 == 2) ? rc2 : (e1 == 3) ? rc3 : (e1 == 4) ? rc4 : (e1 == 5) ? rc5 : (e1 == 6) ? rc6 : rc7;
                rc0 += (e0 == 0) + (e1 == 0); rc1 += (e0 == 1) + (e1 == 1); rc2 += (e0 == 2) + (e1 == 2); rc3 += (e0 == 3) + (e1 == 3);
                rc4 += (e0 == 4) + (e1 == 4); rc5 += (e0 == 5) + (e1 == 5); rc6 += (e0 == 6) + (e1 == 6); rc7 += (e0 == 7) + (e1 == 7);
                if (l == 0) { TOKE[2 * m] = e0; TOKE[2 * m + 1] = e1; TOKG[2 * m] = gg0; TOKG[2 * m + 1] = gg1; TOKS[2 * m] = s0; TOKS[2 * m + 1] = s1; }
            }
        }
    }
    if (ROUTE && (FR_TID(F) & 63) == 0) { int* cw = CNTW + (size_t)F.gw * 8; cw[0] = rc0; cw[1] = rc1; cw[2] = rc2; cw[3] = rc3; cw[4] = rc4; cw[5] = rc5; cw[6] = rc6; cw[7] = rc7; }
}

struct MoeTiles { int pend[8]; int total; };
__device__ __forceinline__ void moe_tiles(const Frame& F, int moe_j, MoeTiles& mt) {
    const int* tot = WSP(int, A_TOK + 5 * MiB); int acc = 0; (void)moe_j;
#pragma unroll
    for (int e = 0; e < 8; ++e) { const int c = tot[e]; acc += (c + 255) >> 8; mt.pend[e] = acc; }
    mt.total = acc;
}
__device__ __forceinline__ void phase_scatter(const Frame& F, int moe_j) {
    (void)moe_j;
    const int* CNTW = WSP(int, A_TOK + 4 * MiB); const int* TOKS = WSP(int, A_TOK + 3 * MiB); int* TOT = WSP(int, A_TOK + 5 * MiB);
    const int* TOKE = WSP(int, A_TOK); int* TOKR = WSP(int, A_TOK + 2 * MiB);
    const v4u* XB = WSP(v4u, WS_XB); v4u* XG = WSP(v4u, A_XG); const int l = F.lane;
    LAS int* red = (LAS int*)F.lds;
    int tot[8], pre[8];
#pragma unroll
    for (int e = 0; e < 8; ++e) { tot[e] = 0; pre[e] = 0; }
    const int wg0 = F.vcu * NWAVES;
    for (int w = F.tid; w < F.NGW; w += NWAVES * 64) { const v4u a = *(const v4u*)(CNTW + (size_t)w * 8), b = *(const v4u*)(CNTW + (size_t)w * 8 + 4); const int below = (w < wg0) ? 1 : 0;
        tot[0] += a.x; tot[1] += a.y; tot[2] += a.z; tot[3] += a.w; tot[4] += b.x; tot[5] += b.y; tot[6] += b.z; tot[7] += b.w;
        pre[0] += below * (int)a.x; pre[1] += below * (int)a.y; pre[2] += below * (int)a.z; pre[3] += below * (int)a.w; pre[4] += below * (int)b.x; pre[5] += below * (int)b.y; pre[6] += below * (int)b.z; pre[7] += below * (int)b.w; }
#pragma unroll
    for (int e = 0; e < 8; ++e) {
#pragma unroll
        for (int o = 1; o < 64; o <<= 1) { tot[e] += shxi(tot[e], o, l); pre[e] += shxi(pre[e], o, l); } }
    if (l == 0) {
#pragma unroll
        for (int e = 0; e < 8; ++e) { red[F.wave * 16 + e] = tot[e]; red[F.wave * 16 + 8 + e] = pre[e]; } }
    __syncthreads();
    int base[8]; int acc = 0;
#pragma unroll
    for (int e = 0; e < 8; ++e) { int t = 0, p = 0;
#pragma unroll
        for (int w = 0; w < NWAVES; ++w) { t += red[w * 16 + e]; p += red[w * 16 + 8 + e]; }
        int mine = 0;
#pragma unroll
        for (int w = 0; w < NWAVES; ++w) { const int c = CNTW[(size_t)(wg0 + w) * 8 + e]; mine += (w < F.wave) ? c : 0; }
        base[e] = acc * 256 + p + mine; acc += (t + 255) >> 8;
        if (F.vcu == 0 && F.tid == 0) TOT[e] = t; }
    __syncthreads();
    static_assert(MOE_FP8 == 1, "scatter copies the fp8 rows");
    const v4u* X8 = WSP(v4u, WS_XB8);
    for (int m0 = F.gw; m0 < T; m0 += 4 * F.NGW) {
        int e_[4][2], s_[4][2]; v4u row_[4];
#pragma unroll
        for (int q = 0; q < 4; ++q) { const int m = (m0 + q * F.NGW < T) ? m0 + q * F.NGW : m0;
            e_[q][0] = TOKE[2 * m]; e_[q][1] = TOKE[2 * m + 1]; s_[q][0] = TOKS[2 * m]; s_[q][1] = TOKS[2 * m + 1]; row_[q] = X8[(size_t)m * 64 + l]; }
#pragma unroll
        for (int q = 0; q < 4; ++q) { const int m = m0 + q * F.NGW; if (m >= T) break;
            int rows[2];
#pragma unroll
            for (int k = 0; k < 2; ++k) { const int e = e_[q][k];
                const int bs = (e == 0) ? base[0] : (e == 1) ? base[1] : (e == 2) ? base[2] : (e == 3) ? base[3] : (e == 4) ? base[4] : (e == 5) ? base[5] : (e == 6) ? base[6] : base[7];
                rows[k] = bs + s_[q][k]; }
            ((v4u*)XG)[(size_t)rows[0] * 64 + l] = row_[q]; ((v4u*)XG)[(size_t)rows[1] * 64 + l] = row_[q];
            if (l == 0) { TOKR[2 * m] = rows[0]; TOKR[2 * m + 1] = rows[1]; } }
    }
}

template <int VAR>
__device__ __forceinline__ void phase_attn_diff(const Frame& F, int L) {
    const float lam_init = 0.8f - 0.6f * expf(-0.3f * (float)L);
    const int l = FR_TID(F) & 63;
    const float d1 = wave_sum(l, INF(6)[L * 64 + l] * INF(7)[L * 64 + l]), d2 = wave_sum(l, INF(8)[L * 64 + l] * INF(9)[L * 64 + l]);
    att::AttnP P; P.Q = WSP(bf16, A_DQ); P.ldq = 1024; P.K1 = WSP(bf16, A_DK); P.ldk1 = 1024; P.K2 = P.K1; P.ldk2 = 1024; P.V = WSP(bf16, A_DV); P.ldv = 1024; P.ldo = 1024;
    P.pos = (const int*)F.a->in[2]; P.blkmax = WSP(int, WS_MISC); P.lut = WSP(float, WS_MISC + 4096);
    P.TI = WSP(bf16, A_OA2); P.lam = expf(d1) - expf(d2) + lam_init; P.osc = 1.0f; P.gsub = WSP(float, WS_MISC + 32768) + L * 128;
    att::AttPreOf<64, 128>::type pre; pre.valid = false;
    for (int p = F.vcu; p < BATCH * 8 * 8; p += F.G) {
        const int bh = p >> 3, i = p & 7, b = bh >> 3, hh = bh & 7;
        const int p2 = p + F.G; const bool more_items = p2 < BATCH * 8 * 8; const int bh2 = p2 >> 3, i2 = p2 & 7, b2 = bh2 >> 3, hh2 = bh2 & 7;
#pragma unroll 1
        for (int s = 0; s < 2; ++s) { const int qt = s ? i : 15 - i;
            const bool hn = (s == 0) || more_items; const int nb = s == 0 ? b : b2, nqt = s == 0 ? i : 15 - i2, nhh = s == 0 ? hh : hh2;
            P.O = WSP(bf16, A_OA2); att::ATT_UNIT_D<64, 64, 128, true, 1, VAR>(P, b, qt, (2 * hh) * 64, (2 * hh) * 64, hh * 128, hh * 128, hh, F.lds, FR_TID(F),
                                                                               pre, true, b, qt, (2 * hh + 1) * 64, (2 * hh + 1) * 64, hh * 128, hh);
            P.O = WSP(bf16, A_OA);  att::ATT_UNIT_D<64, 64, 128, true, 2, VAR>(P, b, qt, (2 * hh + 1) * 64, (2 * hh + 1) * 64, hh * 128, hh * 128, hh, F.lds, FR_TID(F),
                                                                               pre, hn, nb, nqt, (2 * nhh) * 64, (2 * nhh) * 64, nhh * 128, nhh); }
    }
}
template <int VAR>
__device__ __forceinline__ void phase_attn_mla(const Frame& F) {
    att::AttnP P; P.Q = WSP(bf16, A_MQ); P.ldq = 768; P.K1 = WSP(bf16, A_MKV); P.ldk1 = 1024; P.K2 = WSP(bf16, A_MKR); P.ldk2 = 32; P.V = WSP(bf16, A_MKV); P.ldv = 1024; P.O = WSP(bf16, A_OB); P.ldo = 512;
    P.pos = (const int*)F.a->in[2]; P.blkmax = WSP(int, WS_MISC); P.lut = WSP(float, WS_MISC + 4096);
    att::AttPreOf<96, 64>::type pre; pre.valid = false;
    for (int p = F.vcu; p < BATCH * 8 * 8; p += F.G) {
        const int bh = p >> 3, i = p & 7, b = bh >> 3, hh = bh & 7;
        const int p2 = p + F.G; const bool more_items = p2 < BATCH * 8 * 8; const int bh2 = p2 >> 3, i2 = p2 & 7, b2 = bh2 >> 3, hh2 = bh2 & 7;
        att::ATT_UNIT_M<96, 64, 64, false, 0, VAR>(P, b, 15 - i, hh * 96, hh * 128, hh * 128 + 64, hh * 64, 0, F.lds, FR_TID(F), pre, true, b, i, hh * 96, hh * 128, hh * 128 + 64, 0);
        att::ATT_UNIT_M<96, 64, 64, false, 0, VAR>(P, b, i, hh * 96, hh * 128, hh * 128 + 64, hh * 64, 0, F.lds, FR_TID(F), pre, more_items, b2, 15 - i2, hh2 * 96, hh2 * 128, hh2 * 128 + 64, 0);
    }
}

constexpr int NPH_DENSE = 9, NPH_MOE = 8 + 2 * MOE_NCHUNK, NPH_TOTAL = 1 + 2 * NPH_DENSE + 2 * NPH_MOE;
#define GEMM_CALL(EPI, SCHED, gm, S_, E_) pg8::gemm_phase<EPI, SCHED, true, true>(F.lds, gm, S_, E_, MY_TID())

__global__ void __launch_bounds__(NWAVES * 64, 2) mega_fwd(Args args) {
    extern __shared__ __attribute__((aligned(16))) unsigned char lds_raw[];
    Frame F;
    F.lds = (LAS unsigned char*)lds_raw; F.a = &args; F.ws = args.ws;
    const int wave_s = __builtin_amdgcn_readfirstlane((int)threadIdx.x >> 6);
#define MY_TID() ({ unsigned m1_ = ~0u; asm volatile("" : "+s"(m1_)); ((wave_s << 6) | (int)__builtin_amdgcn_mbcnt_hi(m1_, __builtin_amdgcn_mbcnt_lo(m1_, 0u))); })
    F.tid = MY_TID(); F.lane = F.tid & 63; F.wave = wave_s;
    F.G = gridDim.x; { const int bx = blockIdx.x; F.vcu = (F.G % 8 == 0) ? (bx % 8) * (F.G / 8) + bx / 8 : bx; }
    F.gw = F.vcu * NWAVES + F.wave; F.NGW = F.G * NWAVES;
    volatile LAS unsigned* MISC = (volatile LAS unsigned*)(F.lds + MISC_OFF);
    for (int u = F.tid; u < (LDS_BYTES - RING_BYTES) / 4; u += NWAVES * 64) ((LAS unsigned*)(F.lds + RING_BYTES))[u] = 0u;
    __syncthreads();
    const int lo = args.ph_lo, hi = args.ph_hi; constexpr bool fuse_ln = (LN_FUSE != 0);
    XcdBarrier bar; bar.bar = WSP(unsigned, WS_CTL) + CW_BAR; bar.x = 0; bar.st = nullptr;
    if (hi - lo > 1) bar = xcd_barrier_post(WSP(unsigned, WS_CTL) + CW_BAR, MISC + 8, F.tid == 0);
    int pc = 0;
#define PH_BEGIN if (pc >= lo && pc < hi) { { int t_ = MY_TID(); asm volatile("" : "+v"(t_)); F.tid = t_; F.lane = t_ & 63; F.wave = wave_s; F.gw = F.vcu * NWAVES + F.wave; }
#define PH_END if (pc + 1 < hi) { for (int rb = 0; rb < REP_BAR; ++rb) xcd_barrier(bar, MY_TID() == 0); } } ++pc;
    const int bx = (int)blockIdx.x;
    const float ALPHA = 1.6817928305074290f;

    PH_BEGIN for (int rep = 0; rep < REP_P0; ++rep) phase_prologue(F); PH_END

    for (int L = 0; L < DEPTH; ++L) {
        const int mj = L >> 1;
        const int convL_ = (CONV_IN_ATTN && (L & 1) == 0 && L + 1 < DEPTH) ? L + 1 : -1;
        PH_BEGIN {
#if QKV_FP8
            int bxl = bx; asm volatile("" : "+s"(bxl));
            { pg8::Gemm g{WSP(bf16, WS_XB), WSP(bf16, W_IN), T, 768, D}; pg8::StaticOrder S; S.init(T, 768, F.G, bxl);
              pg8::EpiL1 E{WSP(bf16, A_DQ), WSP(bf16, A_CQN), WSP(bf16, A_CKVN), WSP(bf16, A_MKR), WSP(float, WS_SSP), WSP(float, WS_ROPE), 0.125f * LOG2E, 12};
              for (int rep = 0; rep < REP_L1; ++rep) pg8::gemm_phase<pg8::EpiL1, pg8::StaticOrder, true, true, 0>(F.lds, g, S, E, MY_TID()); }
            { pg8::Gemm g{WSP(bf16, WS_XB8), WSP(bf16, W_QKV8), T, 5120, D / 2};
              pg8::UnevenOrder S; S.init(T, 5120, F.G, bx);
              if (LN_FUSE || F.G == 256) { S.cut = 128; S.lo = 9; S.hi = 11; } else { S.cut = 0; S.lo = 0; S.hi = (S.nwg + F.G - 1) / F.G; }
              pg8::EpiQkvG8 E{WSP(bf16, A_DQ), WSP(bf16, A_G), INF(5) + L * 2048, 0.125f * LOG2E, 1.0f / 32.0f};
              for (int rep = 0; rep < REP_L1; ++rep) pg8::gemm_phase8<pg8::EpiQkvG8, pg8::UnevenOrder, true, F8_SP2, 0>(F.lds, g, S, E, 0x7F7F7F7F, MY_TID()); }
#else
            { pg8::Gemm g{WSP(bf16, WS_XB), WSP(bf16, W_IN), T, NIN_B, D}; pg8::StaticOrder S; S.init(T, NIN_B, F.G, bx);
              pg8::EpiL1 E{WSP(bf16, A_DQ), WSP(bf16, A_CQN), WSP(bf16, A_CKVN), WSP(bf16, A_MKR), WSP(float, WS_SSP), WSP(float, WS_ROPE), 0.125f * LOG2E};
              for (int rep = 0; rep < REP_L1; ++rep) pg8::gemm_phase<pg8::EpiL1, pg8::StaticOrder, true, true, STAG_L1>(F.lds, g, S, E, MY_TID()); }
            { pg8::Gemm g{WSP(bf16, WS_XB8), WSP(bf16, W_G8), T, 2048, D / 2};
              pg8::UnevenOrder S; S.init(T, 2048, F.G, bx);
              if (F.G == 256) { S.cut = 128; S.lo = 3; S.hi = 5; } else { S.cut = 0; S.lo = 0; S.hi = (S.nwg + F.G - 1) / F.G; }
              pg8::EpiGates8 E{WSP(bf16, A_G), INF(5) + L * 2048, 1.0f / 32.0f};
              for (int rep = 0; rep < REP_L1; ++rep) pg8::gemm_phase8<pg8::EpiGates8, pg8::UnevenOrder, true, F8_SP2, 0>(F.lds, g, S, E, 0x7F7F7F7F, MY_TID()); }
#endif
        } PH_END
        PH_BEGIN {
            for (int rep = 0; rep < REP_MIX; ++rep) {
            { pg8::Gemm g{WSP(bf16, A_CQN), WSP(bf16, W_UQ), T, 768, QR}; pg8::StaticOrder S; S.init(T, 768, F.G, bx);
              pg8::EpiRopeQ E{WSP(bf16, A_MQ), WSP(float, WS_ROPE), 0.10206207261596577f * LOG2E, WSP(float, WS_SSP)};
              GEMM_CALL(pg8::EpiRopeQ, pg8::StaticOrder, g, S, E); }
            { pg8::Gemm g{WSP(bf16, A_CKVN), WSP(bf16, W_UKV), T, 1024, KVR}; pg8::StaticOrder S; S.init(T, 1024, F.G, bx);
              pg8::EpiBf16Rs E{WSP(bf16, A_MKV), 1024, WSP(float, WS_SSP)};
              GEMM_CALL(pg8::EpiBf16Rs, pg8::StaticOrder, g, S, E); }
            }
#define CONV_HOOK() do { __syncthreads(); Frame F3 = F; { const int t3_ = MY_TID(); F3.tid = t3_; F3.lane = t3_ & 63; } phase_convert(F3, convL_, 2); __syncthreads(); } while (0)
            if (convL_ >= 0 && (bx & 1) == 0) CONV_HOOK();
            phase_attn_diff<0>(F, L);
            if (convL_ >= 0 && (bx & 1) != 0) CONV_HOOK();
#undef CONV_HOOK
        } PH_END
        PH_BEGIN { phase_attn_mla<0>(F); } PH_END
        PH_BEGIN {
            for (int rep = 0; rep < REP_MIX; ++rep) {
            { pg8::Gemm g{WSP(bf16, A_OB), WSP(bf16, W_BM), T, D, 512}; pg8::StaticOrder S; S.init(T, D, F.G, bx);
              pg8::EpiGate<false> E{WSP(bf16, A_MT), WSP(bf16, A_G), nullptr, 1024};
              GEMM_CALL(pg8::EpiGate<false>, pg8::StaticOrder, g, S, E); }
            { pg8::Gemm g{WSP(bf16, A_OA), WSP(bf16, W_BD), T, D, D}; pg8::StaticOrder S; S.init(T, D, F.G, bx);
              pg8::EpiGate<true> E{WSP(bf16, A_M), WSP(bf16, A_G), WSP(bf16, A_MT), 0};
              GEMM_CALL(pg8::EpiGate<true>, pg8::StaticOrder, g, S, E); }
            }
        } PH_END
        PH_BEGIN {
            pg8::Gemm g{WSP(bf16, A_M), WSP(bf16, W_OUT), T, D, D}; pg8::StaticOrder S; S.init(T, D, F.G, bx);
            if (fuse_ln && (L & 1) == 0) {
                pg8::EpiPreLn<1> E{nullptr, WSP(bf16, WS_XB), WSP(unsigned char, WS_XB8), ALPHA, INF(18) + L * D, INF(19) + L * D, WSP(unsigned long long, WS_LNST), WSP(unsigned, WS_CTL) + CW_LN + (2 * L) * 128, F.lds + RING_BYTES + 2048};
                GEMM_CALL(pg8::EpiPreLn<1>, pg8::StaticOrder, g, S, E);
            } else {
            pg8::EpiPre<1> E{WSP(bf16, A_PRE), WSP(bf16, WS_XB), ALPHA, 1.0f};
            for (int rep = 0; rep < REP_MIX; ++rep) GEMM_CALL(pg8::EpiPre<1>, pg8::StaticOrder, g, S, E);
            }
        } PH_END
        if (!(fuse_ln && (L & 1) == 0)) {
        PH_BEGIN {
            if (L & 1) phase_ln<true, false>(F, WSP(bf16, A_PRE), INF(18) + L * D, INF(19) + L * D, INF(23) + (size_t)mj * D * NEXP, mj, false);
            else for (int rep = 0; rep < REP_LN; ++rep) phase_ln<false, false>(F, WSP(bf16, A_PRE), INF(18) + L * D, INF(19) + L * D, nullptr, 0, false);
        } PH_END
        }
        if ((L & 1) == 0) {
            PH_BEGIN {
                for (int rep = 0; rep < REP_FFN; ++rep) {
                { pg8::Gemm g{WSP(bf16, WS_XB), WSP(bf16, W_F13D), T, 2 * DENSE_FF, D}; pg8::StaticOrder S; S.init(T, 2 * DENSE_FF, F.G, bx);
                  pg8::EpiSwiGLU E{WSP(bf16, A_H), DENSE_FF};
                  pg8::gemm_phase<pg8::EpiSwiGLU, pg8::StaticOrder, true, true, STAG_H>(F.lds, g, S, E, MY_TID()); }
                { pg8::Gemm g{WSP(bf16, WS_PB), WSP(bf16, W_PP), T, D, PLE}; pg8::StaticOrder S; S.init(T, D, F.G, bx);
                  pg8::EpiPre<0> E{WSP(bf16, A_PRE), nullptr, 0.f, 1.0f};
                  GEMM_CALL(pg8::EpiPre<0>, pg8::StaticOrder, g, S, E); }
                { pg8::Gemm g{WSP(bf16, WS_XB8), WSP(bf16, W_PG), T, D, D / 2}; pg8::StaticOrder S; S.init(T, D, F.G, bx);
                  pg8::EpiPre<2> E{WSP(bf16, A_PRE), WSP(bf16, WS_XB), ALPHA, 1.0f / 32.0f};
                  pg8::gemm_phase8<pg8::EpiPre<2>, pg8::StaticOrder, true, F8_SP2, 0>(F.lds, g, S, E, 0x7F7F7F7F, MY_TID()); }
                }
            } PH_END
            PH_BEGIN {
                pg8::Gemm g{WSP(bf16, A_H), WSP(bf16, W_F2D), T, D, DENSE_FF}; pg8::StaticOrder S; S.init(T, D, F.G, bx);
                if (fuse_ln) {
                    pg8::EpiPreLn<3> E{WSP(bf16, A_PRE), WSP(bf16, WS_XB), WSP(unsigned char, WS_XB8), 1.0f, INF(29) + L * D, INF(30) + L * D, WSP(unsigned long long, WS_LNST), WSP(unsigned, WS_CTL) + CW_LN + (2 * L + 1) * 128, F.lds + RING_BYTES + 2048};
                    GEMM_CALL(pg8::EpiPreLn<3>, pg8::StaticOrder, g, S, E);
                    if (L + 1 < DEPTH) { __syncthreads(); Frame F3 = F; { const int t3_ = MY_TID(); F3.tid = t3_; F3.lane = t3_ & 63; }
                        phase_convert(F3, L + 1, CONV_IN_ATTN ? 1 : 0); }
                } else {
                pg8::EpiPre<3> E{WSP(bf16, A_PRE), nullptr, 0.f, 1.0f};
                GEMM_CALL(pg8::EpiPre<3>, pg8::StaticOrder, g, S, E);
                }
            } PH_END
            if (!fuse_ln) {
            PH_BEGIN { if (!fuse_ln) for (int rep = 0; rep < REP_LN; ++rep) phase_ln<false, false>(F, WSP(bf16, A_PRE), INF(29) + L * D, INF(30) + L * D, nullptr, 0, L == DEPTH - 1); if (L + 1 < DEPTH) for (int rep = 0; rep < REP_CONV; ++rep) phase_convert(F, L + 1, CONV_IN_ATTN ? 1 : 0); } PH_END
            }
        } else {
            PH_BEGIN {
                phase_scatter(F, mj);
                for (int rep = 0; rep < REP_PPE; ++rep) {
                { pg8::Gemm g{WSP(bf16, WS_PB), WSP(bf16, W_PP), T, D, PLE}; pg8::StaticOrder S; S.init(T, D, F.G, bx);
                  pg8::EpiPre<0> E{WSP(bf16, A_PREM), nullptr, 0.f, 1.0f};
                  GEMM_CALL(pg8::EpiPre<0>, pg8::StaticOrder, g, S, E); }
                { pg8::Gemm g{WSP(bf16, WS_XB8), WSP(bf16, W_PG), T, D, D / 2}; pg8::StaticOrder S; S.init(T, D, F.G, bx);
                  pg8::EpiPre<2> E{WSP(bf16, A_PREM), WSP(bf16, WS_XB), ALPHA, 1.0f / 32.0f};
                  pg8::gemm_phase8<pg8::EpiPre<2>, pg8::StaticOrder, true, F8_SP2, 0>(F.lds, g, S, E, 0x7F7F7F7F, MY_TID()); }
                }
            } PH_END
            for (int ch = 0; ch < MOE_NCHUNK; ++ch) {
                PH_BEGIN {
                    MoeTiles mt; moe_tiles(F, mj, mt);
                    const int tlo = ch * MOE_CHUNK_TILES; int ntc = mt.total - tlo; ntc = ntc > MOE_CHUNK_TILES ? MOE_CHUNK_TILES : ntc;
                    if (ntc > 0) {
#if MOE_FP8
                        pg8::Gemm g{WSP(bf16, A_XG), WSP(bf16, W_F13), ntc * 256, 2 * EXPERT_FF, D / 2};
                        pg8::GroupedOrder S; S.init(ntc * 256, 2 * EXPERT_FF, F.G, bx); S.tile_lo = tlo; S.estride = (size_t)2 * EXPERT_FF * D;
#else
                        pg8::Gemm g{WSP(bf16, A_XG) + (size_t)tlo * 256 * D, WSP(bf16, W_F13), ntc * 256, 2 * EXPERT_FF, D};
                        pg8::GroupedOrder S; S.init(ntc * 256, 2 * EXPERT_FF, F.G, bx); S.tile_lo = tlo; S.estride = (size_t)2 * EXPERT_FF * D * 2;
#endif
                        S.pend0 = mt.pend[0]; S.pend1 = mt.pend[1]; S.pend2 = mt.pend[2]; S.pend3 = mt.pend[3]; S.pend4 = mt.pend[4]; S.pend5 = mt.pend[5]; S.pend6 = mt.pend[6]; S.pend7 = mt.pend[7];
#if MOE_FP8
                        pg8::EpiSwiGLU8 E{WSP(unsigned char, A_HG), EXPERT_FF, 1.0f / 32.0f};
                        for (int rep = 0; rep < REP_MOE; ++rep) pg8::gemm_phase8<pg8::EpiSwiGLU8, pg8::GroupedOrder, UP_ALIGN, F8_SP2, STAG_UP>(F.lds, g, S, E, 0x7F7F7F7F, MY_TID());
#else
                        pg8::EpiSwiGLU E{WSP(bf16, A_HG), EXPERT_FF};
                        for (int rep = 0; rep < REP_MOE; ++rep) GEMM_CALL(pg8::EpiSwiGLU, pg8::GroupedOrder, g, S, E);
#endif
                    }
                } PH_END
                PH_BEGIN {
                    MoeTiles mt; moe_tiles(F, mj, mt);
                    const int tlo = ch * MOE_CHUNK_TILES; int ntc = mt.total - tlo; ntc = ntc > MOE_CHUNK_TILES ? MOE_CHUNK_TILES : ntc;
                    if (ntc > 0) {
#if MOE_FP8
                        pg8::Gemm g{WSP(bf16, A_HG), WSP(bf16, W_F2E), ntc * 256, D, EXPERT_FF / 2};
                        pg8::GroupedOrder S; S.init(ntc * 256, D, F.G, bx); S.tile_lo = tlo; S.estride = (size_t)D * EXPERT_FF;
#else
                        pg8::Gemm g{WSP(bf16, A_HG), WSP(bf16, W_F2E), ntc * 256, D, EXPERT_FF};
                        pg8::GroupedOrder S; S.init(ntc * 256, D, F.G, bx); S.tile_lo = tlo; S.estride = (size_t)D * EXPERT_FF * 2;
#endif
                        S.pend0 = mt.pend[0]; S.pend1 = mt.pend[1]; S.pend2 = mt.pend[2]; S.pend3 = mt.pend[3]; S.pend4 = mt.pend[4]; S.pend5 = mt.pend[5]; S.pend6 = mt.pend[6]; S.pend7 = mt.pend[7];
                        pg8::EpiBf16 E{WSP(bf16, A_YG) + (size_t)tlo * 256 * D, D, MOE_FP8 ? 1.0f / 128.0f : 1.0f};
#if MOE_FP8
                        for (int rep = 0; rep < REP_MOE; ++rep) pg8::gemm_phase8<pg8::EpiBf16, pg8::GroupedOrder, true, F8_SP2>(F.lds, g, S, E, 0x7F7F7F7F, MY_TID());
#else
                        for (int rep = 0; rep < REP_MOE; ++rep) GEMM_CALL(pg8::EpiBf16, pg8::GroupedOrder, g, S, E);
#endif
                    }
                    if (CONV_IN_DOWN && ch == MOE_NCHUNK - 1 && L + 1 < DEPTH) {
                        const int nwg_ = (ntc > 0 ? ntc : 0) * (D / 256), r_ = nwg_ % F.G, nl_ = F.G - r_;
                        Frame F2 = F; { const int t2_ = MY_TID(); F2.tid = t2_; F2.lane = t2_ & 63; }
                        if (r_ != 0 && 2 * nl_ >= F.G) { if (bx >= r_) { F2.gw = (bx - r_) * NWAVES + F.wave; F2.NGW = nl_ * NWAVES; phase_convert(F2, L + 1); } }
                        else phase_convert(F2, L + 1);
                    }
                } PH_END
            }
            PH_BEGIN { for (int rep = 0; rep < REP_LN; ++rep) phase_ln<false, true>(F, WSP(bf16, A_PREM), INF(29) + L * D, INF(30) + L * D, nullptr, 0, L == DEPTH - 1); if (!CONV_IN_DOWN && L + 1 < DEPTH) for (int rep = 0; rep < REP_CONV; ++rep) phase_convert(F, L + 1); } PH_END
        }
    }
#undef PH_BEGIN
#undef PH_END
}

extern "C" void kernel_launch(void* const* d_in, const int* in_sizes, int n_in, void* d_out, int out_size, void* d_ws, size_t ws_size, hipStream_t stream) {
    static int grid = 0;
    if (grid == 0) {
        if (n_in != 31 || in_sizes[0] != T * D || out_size != T * D || ws_size < WS_END) { fprintf(stderr, "kernel_launch: unexpected shapes / workspace (n_in %d, ws %zu < %zu)\n", n_in, ws_size, (size_t)WS_END); grid = -1; return; }
        int dev = 0, cus = 0, per_cu = 0;
        if (hipGetDevice(&dev) != hipSuccess || hipDeviceGetAttribute(&cus, hipDeviceAttributeMultiprocessorCount, dev) != hipSuccess) { grid = -1; return; }
        if (hipFuncSetAttribute((const void*)mega_fwd, hipFuncAttributeMaxDynamicSharedMemorySize, LDS_BYTES) != hipSuccess) { fprintf(stderr, "kernel_launch: hipFuncSetAttribute failed\n"); grid = -1; return; }
        if (hipOccupancyMaxActiveBlocksPerMultiprocessor(&per_cu, (const void*)mega_fwd, NWAVES * 64, LDS_BYTES) != hipSuccess || per_cu < 1) { fprintf(stderr, "kernel_launch: occupancy query says %d\n", per_cu); (void)hipGetLastError(); grid = -1; return; }
        grid = cus;
    }
    if (grid < 0) return;
    if (hipMemsetAsync((char*)d_ws + WS_CTL, 0, CTL_ZERO_BYTES, stream) != hipSuccess) return;
    Args a{};
    for (int i = 0; i < 31; ++i) a.in[i] = d_in[i];
    a.out = (float*)d_out; a.ws = (unsigned char*)d_ws;
    a.fuse = LN_FUSE;
    if (LN_FUSE && grid != 256) { fprintf(stderr, "kernel_launch: the fused LayerNorm exchange needs a 256-workgroup grid (got %d); build with -DLN_FUSE=0\n", grid); return; }
    const int nph = NPH_TOTAL - (a.fuse ? 4 : 0);
#if MK_PER_PHASE
    for (int p = 0; p < nph; ++p) { a.ph_lo = p; a.ph_hi = p + 1; hipLaunchKernelGGL(mega_fwd, dim3(grid), dim3(NWAVES * 64), LDS_BYTES, stream, a); }
#else
    a.ph_lo = 0; a.ph_hi = nph;
    hipLaunchKernelGGL(mega_fwd, dim3(grid), dim3(NWAVES * 64), LDS_BYTES, stream, a);
#endif
}
```

```cpp
#include <hip/hip_runtime.h>
#include <cstdio>
#include <cstdint>
#include <cmath>

#ifndef MK_PER_PHASE
#define MK_PER_PHASE 0
#endif

constexpr int BATCH = 8, SEQ = 4096, T = BATCH * SEQ, D = 1024, DEPTH = 4, PLE = 256;
constexpr int IN_COLS = 5792, NIN = 5888, NIN_B = 3840;
constexpr int QR = 384, KVR = 256, ROPE_D = 32;
constexpr int DENSE_FF = 2816, EXPERT_FF = 3584, NEXP = 8;
constexpr float LN_EPS = 1e-5f;
constexpr float LOG2E = 1.4426950408889634f;
constexpr int MOE_ROWS = 2 * T + NEXP * 256;
constexpr int MOE_CHUNK_TILES = MOE_ROWS / 256;
constexpr int MOE_NCHUNK = 1;
#ifndef MOE_FP8
#define MOE_FP8 1
#endif

#define GAS __attribute__((address_space(1)))
#define LAS __attribute__((address_space(3)))
typedef unsigned short bf16;
typedef unsigned v4u __attribute__((ext_vector_type(4)));
typedef unsigned v2u __attribute__((ext_vector_type(2)));
typedef float f32x4 __attribute__((ext_vector_type(4)));
typedef float f32x2 __attribute__((ext_vector_type(2)));
typedef float f32x16 __attribute__((ext_vector_type(16)));
typedef short bf16x8 __attribute__((ext_vector_type(8)));
typedef short s16x4 __attribute__((ext_vector_type(4)));
typedef __bf16 bf16x2_t __attribute__((ext_vector_type(2)));
typedef GAS unsigned gu32;
#define RLX_AGENT __ATOMIC_RELAXED, __HIP_MEMORY_SCOPE_AGENT
#define LDS_WAIT() asm volatile("s_waitcnt lgkmcnt(0)" ::: "memory")
#define VM_WAIT() asm volatile("s_waitcnt vmcnt(0)" ::: "memory")

__device__ __forceinline__ unsigned pk2(float lo, float hi) { f32x2 v = {lo, hi}; bf16x2_t b = __builtin_convertvector(v, bf16x2_t); return __builtin_bit_cast(unsigned, b); }
__device__ __forceinline__ float bflo(unsigned u) { return __uint_as_float(u << 16); }
__device__ __forceinline__ float bfhi(unsigned u) { return __uint_as_float(u & 0xffff0000u); }
__device__ __forceinline__ float sigmoidf_(float x) { return __builtin_amdgcn_rcpf(1.0f + __builtin_amdgcn_exp2f(-x * LOG2E)); }
__device__ __forceinline__ float shx(float v, int o, int lane) { return __uint_as_float((unsigned)__builtin_amdgcn_ds_bpermute((lane ^ o) << 2, (int)__float_as_uint(v))); }
__device__ __forceinline__ int shxi(int v, int o, int lane) { return __builtin_amdgcn_ds_bpermute((lane ^ o) << 2, v); }
__device__ __forceinline__ float wave_sum(int lane, float v) {
#pragma unroll
    for (int o = 1; o < 64; o <<= 1) v += shx(v, o, lane);
    return v;
}

#ifndef GATE_U8
#define GATE_U8 1
#endif
#define PG8_PAIR16(A_, B_) do { const auto r0_ = __builtin_amdgcn_permlane16_swap((A_).x, (B_).x, false, false); (A_).x = r0_[0]; (B_).x = r0_[1]; \
                               const auto r1_ = __builtin_amdgcn_permlane16_swap((A_).y, (B_).y, false, false); (A_).y = r1_[0]; (B_).y = r1_[1]; } while (0)
namespace pg8 {
#define PG8_LAS __attribute__((address_space(3)))
typedef unsigned short bf16_t;
typedef unsigned u32x4 __attribute__((ext_vector_type(4)));
typedef unsigned u32x2 __attribute__((ext_vector_type(2)));
constexpr int BM = 256, BK = 64, HALF = 128, HTB = HALF * BK * 2  , STAGE_BYTES = 8 * HTB, NXCD = 8, WGM = 8;

__host__ __device__ __forceinline__ int lds_byte(int r, int c) { const int st = (r >> 4) * 2 + (c >> 5), rr = r & 15, cc = c & 31, ob = rr * 64 + cc * 2; return st * 1024 + (ob ^ (((ob >> 9) & 1) << 5)); }
__host__ __device__ __forceinline__ void stage_rc(int b, int& R, int& C) { const int st = b / 1024, sb = b % 1024, swz = sb ^ (((sb >> 9) & 1) << 5); R = (st >> 1) * 16 + swz / 64; C = (st & 1) * 32 + (swz % 64) / 2; }
__host__ __device__ __forceinline__ int perm32(int rho) { const int n = rho >> 4, i = rho & 15; return 8 * (i >> 2) + 4 * n + (i & 3); }

struct Unit { int pm, pn; };
struct Gemm { const bf16_t* A; const bf16_t* Bt; int M, N, K; };

struct StaticOrder {
    int nM, nN, nwg, G, c;
    __host__ __device__ void init(int M, int N, int G_, int c_) { nM = M / BM; nN = N / BM; nwg = nM * nN; G = G_; c = c_; }
    __host__ __device__ bool next(int i, Unit& u) const {
        const long L = (long)i * G + c; if (L >= nwg) return false;
        int wgid = (int)L; { const int q = nwg / NXCD, r = nwg % NXCD, xcd = wgid % NXCD, off = wgid / NXCD; wgid = (xcd < r ? xcd * (q + 1) : r * (q + 1) + (xcd - r) * q) + off; }
        const int nig = WGM * nN, gid = wgid / nig, fm = gid * WGM, gsz = (nM - fm) < WGM ? (nM - fm) : WGM;
        u.pm = fm + ((wgid % nig) % gsz); u.pn = (wgid % nig) / gsz; return true;
    }
    __device__ __forceinline__ size_t bofs(const Unit&) const { return 0; }
    __device__ __forceinline__ void a_ready(const Unit&) const {}
    __device__ __forceinline__ void done(const Unit&) const {}
};
struct UnevenOrder : StaticOrder {
    int cut, lo, hi;
    __host__ __device__ bool next(int i, Unit& u) const {
        long L;
        if (i < lo) L = (long)i * G + c;
        else if (c >= cut && i < hi) L = (long)lo * G + (long)(c - cut) * (hi - lo) + (i - lo);
        else return false;
        if (L >= nwg) return false;
        int wgid = (int)L; { const int q = nwg / NXCD, r = nwg % NXCD, xcd = wgid % NXCD, off = wgid / NXCD; wgid = (xcd < r ? xcd * (q + 1) : r * (q + 1) + (xcd - r) * q) + off; }
        const int nig = WGM * nN, gid = wgid / nig, fm = gid * WGM, gsz = (nM - fm) < WGM ? (nM - fm) : WGM;
        u.pm = fm + ((wgid % nig) % gsz); u.pn = (wgid % nig) / gsz; return true;
    }
};
struct GroupedOrder : StaticOrder {
    int tile_lo; int pend0, pend1, pend2, pend3, pend4, pend5, pend6, pend7; size_t estride;
    __device__ __forceinline__ size_t bofs(const Unit& u) const {
        const int t = u.pm + tile_lo;
        const int e = (t >= pend0) + (t >= pend1) + (t >= pend2) + (t >= pend3) + (t >= pend4) + (t >= pend5) + (t >= pend6);
        return (size_t)e * estride;
    }
};

typedef f32x4 Acc[2][2][4][2];

struct EpiL1 {
    static constexpr bool PERM = true, AFTER_DRAIN = false;
    bf16_t* QKV; bf16_t* CQR; bf16_t* CKVR; bf16_t* MKR; float* SSP; const float* rope; float qscale; int pn_off;
    __device__ __forceinline__ void operator()(const Acc& acc, const Unit& u, int wr, int wc, int fr, int fq) const {
        const int row0 = u.pm * BM + wr * 64 + fr; const int pn = u.pn + pn_off;
        if (pn < 12) {
            bf16_t* base = QKV + (size_t)(pn >> 2) * ((size_t)T * 1024); const int col0 = (pn & 3) * 256 + wc * 32 + 8 * fq; const float sc = pn < 4 ? qscale : 1.f;
#pragma unroll
            for (int ai = 0; ai < 2; ++ai)
#pragma unroll
                for (int m = 0; m < 4; ++m) { bf16_t* rowp = base + (size_t)(row0 + ai * HALF + m * 16) * 1024 + col0;
#pragma unroll
                    for (int bj = 0; bj < 2; ++bj) { const f32x4 v0 = acc[ai][bj][m][0] * sc, v1 = acc[ai][bj][m][1] * sc;
                        u32x4 w; w.x = pk2(v0[0], v0[1]); w.y = pk2(v0[2], v0[3]); w.z = pk2(v1[0], v1[1]); w.w = pk2(v1[2], v1[3]);
                        *(u32x4*)(rowp + bj * HALF) = w; } }
            return;
        }
        const int lane = fr | (fq << 4), cl = wc * 32 + 8 * fq;
#pragma unroll
        for (int ai = 0; ai < 2; ++ai)
#pragma unroll
            for (int m = 0; m < 4; ++m) { const size_t row = (size_t)(row0 + ai * HALF + m * 16);
                float p[2];
#pragma unroll
                for (int bj = 0; bj < 2; ++bj) { const f32x4 v0 = acc[ai][bj][m][0], v1 = acc[ai][bj][m][1];
                    p[bj] = ((v0[0] * v0[0] + v0[1] * v0[1]) + (v0[2] * v0[2] + v0[3] * v0[3])) + ((v1[0] * v1[0] + v1[1] * v1[1]) + (v1[2] * v1[2] + v1[3] * v1[3]));
                    u32x4 w; w.x = pk2(v0[0], v0[1]); w.y = pk2(v0[2], v0[3]); w.z = pk2(v1[0], v1[1]); w.w = pk2(v1[2], v1[3]);
                    if (pn == 12) *(u32x4*)(CQR + row * 384 + bj * HALF + cl) = w;
                    else if (pn == 13) { if (bj == 0) *(u32x4*)(CQR + row * 384 + 256 + cl) = w; else *(u32x4*)(CKVR + row * 256 + cl) = w; }
                    else if (bj == 0) *(u32x4*)(CKVR + row * 256 + HALF + cl) = w; }
                if (pn == 12) { p[0] += p[1]; p[1] = 0.f; }
                p[0] += shx(p[0], 16, lane); p[0] += shx(p[0], 32, lane);
                if (pn == 13) { p[1] += shx(p[1], 16, lane); p[1] += shx(p[1], 32, lane); }
                if (fq == 0) { float* sp = SSP + row * 16 + wc;
                    if (pn == 12) sp[0] = p[0]; else if (pn == 13) { sp[4] = p[0]; sp[8] = p[1]; } else sp[12] = p[0]; }
                if (pn == 14 && wc == 0) {
                    const f32x4 v0 = acc[ai][1][m][0], v1 = acc[ai][1][m][1]; float mine[8] = {v0[0], v0[1], v0[2], v0[3], v1[0], v1[1], v1[2], v1[3]}, oth[8];
#pragma unroll
                    for (int i = 0; i < 8; ++i) oth[i] = shx(mine[i], 32, lane);
                    const float* rp = rope + row * 32 + 16 * (fq & 1);
                    const f32x4 r0 = *(const f32x4*)rp, r1 = *(const f32x4*)(rp + 4), r2 = *(const f32x4*)(rp + 8), r3 = *(const f32x4*)(rp + 12);
                    const float cs[8] = {r0[0], r0[2], r1[0], r1[2], r2[0], r2[2], r3[0], r3[2]}, sn[8] = {r0[1], r0[3], r1[1], r1[3], r2[1], r2[3], r3[1], r3[3]};
                    float o[8];
#pragma unroll
                    for (int i = 0; i < 8; ++i) o[i] = (fq < 2) ? mine[i] * cs[i] - oth[i] * sn[i] : oth[i] * sn[i] + mine[i] * cs[i];
                    u32x4 w; w.x = pk2(o[0], o[1]); w.y = pk2(o[2], o[3]); w.z = pk2(o[4], o[5]); w.w = pk2(o[6], o[7]);
                    *(u32x4*)(MKR + row * 32 + 8 * fq) = w; }
            }
    }
};
struct EpiGates8 {
    static constexpr bool PERM = true, AFTER_DRAIN = false;
    bf16_t* Gt; const float* bgate; float isc;
    __device__ __forceinline__ void operator()(const Acc& acc, const Unit& u, int wr, int wc, int fr, int fq) const {
        const int row0 = u.pm * BM + wr * 64 + fr; const int col0 = u.pn * 256 + wc * 32 + 8 * fq;
        f32x4 bv[2][2];
#pragma unroll
        for (int bj = 0; bj < 2; ++bj)
#pragma unroll
            for (int n = 0; n < 2; ++n) bv[bj][n] = *(const f32x4*)(bgate + col0 + bj * HALF + 4 * n);
#pragma unroll
        for (int ai = 0; ai < 2; ++ai)
#pragma unroll
            for (int m = 0; m < 4; ++m) { bf16_t* rowp = Gt + (size_t)(row0 + ai * HALF + m * 16) * 2048 + col0;
#pragma unroll
                for (int bj = 0; bj < 2; ++bj) { const f32x4 v0 = acc[ai][bj][m][0] * isc + bv[bj][0], v1 = acc[ai][bj][m][1] * isc + bv[bj][1];
                    u32x4 w; w.x = pk2(sigmoidf_(v0[0]), sigmoidf_(v0[1])); w.y = pk2(sigmoidf_(v0[2]), sigmoidf_(v0[3])); w.z = pk2(sigmoidf_(v1[0]), sigmoidf_(v1[1])); w.w = pk2(sigmoidf_(v1[2]), sigmoidf_(v1[3]));
                    *(u32x4*)(rowp + bj * HALF) = w; } }
    }
};
struct EpiQkvG8 {
    static constexpr bool PERM = true, AFTER_DRAIN = false;
    bf16_t* QKV; bf16_t* Gt; const float* bgate; float qscale, isc;
    __device__ __forceinline__ void operator()(const Acc& acc, const Unit& u, int wr, int wc, int fr, int fq) const {
        const int row0 = u.pm * BM + wr * 64 + fr; const int pn = u.pn;
        if (pn < 12) {
            bf16_t* base = QKV + (size_t)(pn >> 2) * ((size_t)T * 1024); const int col0 = (pn & 3) * 256 + wc * 32 + 8 * fq; const float sc = (pn < 4 ? qscale : 1.f) * isc;
#pragma unroll
            for (int ai = 0; ai < 2; ++ai)
#pragma unroll
                for (int m = 0; m < 4; ++m) { bf16_t* rowp = base + (size_t)(row0 + ai * HALF + m * 16) * 1024 + col0;
#pragma unroll
                    for (int bj = 0; bj < 2; ++bj) { const f32x4 v0 = acc[ai][bj][m][0] * sc, v1 = acc[ai][bj][m][1] * sc;
                        u32x4 w; w.x = pk2(v0[0], v0[1]); w.y = pk2(v0[2], v0[3]); w.z = pk2(v1[0], v1[1]); w.w = pk2(v1[2], v1[3]);
                        *(u32x4*)(rowp + bj * HALF) = w; } }
            return;
        }
        const int col0 = (pn - 12) * 256 + wc * 32 + 8 * fq;
        f32x4 bv[2][2];
#pragma unroll
        for (int bj = 0; bj < 2; ++bj)
#pragma unroll
            for (int n = 0; n < 2; ++n) bv[bj][n] = *(const f32x4*)(bgate + col0 + bj * HALF + 4 * n);
#if GATE_U8
        unsigned char* G8 = (unsigned char*)Gt;
        const int rowg = row0 + (fq & 1) * 16, colg = (pn - 12) * 256 + wc * 32 + 8 * (fq & ~1);
#define G8Q_(x) ((unsigned)(sigmoidf_(x) * 255.0f + 0.5f))
#pragma unroll
        for (int ai = 0; ai < 2; ++ai)
#pragma unroll
            for (int mp = 0; mp < 2; ++mp)
#pragma unroll
                for (int bj = 0; bj < 2; ++bj) { u32x2 w[2];
#pragma unroll
                    for (int e = 0; e < 2; ++e) { const int m = 2 * mp + e; const f32x4 v0 = acc[ai][bj][m][0] * isc + bv[bj][0], v1 = acc[ai][bj][m][1] * isc + bv[bj][1];
                        w[e].x = G8Q_(v0[0]) | (G8Q_(v0[1]) << 8) | (G8Q_(v0[2]) << 16) | (G8Q_(v0[3]) << 24); w[e].y = G8Q_(v1[0]) | (G8Q_(v1[1]) << 8) | (G8Q_(v1[2]) << 16) | (G8Q_(v1[3]) << 24); }
                    PG8_PAIR16(w[0], w[1]);
                    u32x4 q; q.x = w[0].x; q.y = w[0].y; q.z = w[1].x; q.w = w[1].y;
                    *(u32x4*)(G8 + (size_t)(rowg + ai * HALF + mp * 32) * 2048 + colg + bj * HALF) = q; }
#undef G8Q_
#else
#pragma unroll
        for (int ai = 0; ai < 2; ++ai)
#pragma unroll
            for (int m = 0; m < 4; ++m) { bf16_t* rowp = Gt + (size_t)(row0 + ai * HALF + m * 16) * 2048 + col0;
#pragma unroll
                for (int bj = 0; bj < 2; ++bj) { const f32x4 v0 = acc[ai][bj][m][0] * isc + bv[bj][0], v1 = acc[ai][bj][m][1] * isc + bv[bj][1];
                    u32x4 w; w.x = pk2(sigmoidf_(v0[0]), sigmoidf_(v0[1])); w.y = pk2(sigmoidf_(v0[2]), sigmoidf_(v0[3])); w.z = pk2(sigmoidf_(v1[0]), sigmoidf_(v1[1])); w.w = pk2(sigmoidf_(v1[2]), sigmoidf_(v1[3]));
                    *(u32x4*)(rowp + bj * HALF) = w; } }
#endif
    }
};
struct EpiRopeQ {
    static constexpr bool PERM = false, AFTER_DRAIN = false;
    bf16_t* O; const float* rope; float qscale; const float* SSP;
    __device__ __forceinline__ void operator()(const Acc& acc, const Unit& u, int wr, int wc, int fr, int fq) const {
        const int row0 = u.pm * BM + wr * 64 + fr;
        float rsq[2][4];
#pragma unroll
        for (int ai = 0; ai < 2; ++ai) { f32x4 sa[4], sb[4];
#pragma unroll
            for (int m = 0; m < 4; ++m) { const float* sp = SSP + (size_t)(row0 + ai * HALF + m * 16) * 16; sa[m] = *(const f32x4*)sp; sb[m] = *(const f32x4*)(sp + 4); }
#pragma unroll
            for (int m = 0; m < 4; ++m) { const f32x4 t = sa[m] + sb[m]; rsq[ai][m] = qscale / sqrtf(((t[0] + t[1]) + (t[2] + t[3])) * (1.0f / 384.0f) + LN_EPS); } }
        f32x4 c0[2][4], c1[2][4];
#pragma unroll
        for (int ai = 0; ai < 2; ++ai)
#pragma unroll
            for (int m = 0; m < 4; ++m) { const int row = row0 + ai * HALF + m * 16; c0[ai][m] = *(const f32x4*)(rope + (size_t)row * 32 + fq * 8); c1[ai][m] = *(const f32x4*)(rope + (size_t)row * 32 + fq * 8 + 4); }
#pragma unroll
        for (int ai = 0; ai < 2; ++ai)
#pragma unroll
            for (int mp = 0; mp < 2; ++mp)
#pragma unroll
                for (int bj = 0; bj < 2; ++bj) { const int colg = u.pn * BM + bj * HALF + wc * 32; const bool isr = ((colg >> 5) % 3) == 2;
                    u32x2 w1[2], w2[2];
#pragma unroll
                    for (int e = 0; e < 2; ++e) { const int m = 2 * mp + e;
                        const f32x4 cs0 = c0[ai][m], cs1 = c1[ai][m];
                        const f32x4 cc = {cs0[0], cs0[2], cs1[0], cs1[2]}, ss = {cs0[1], cs0[3], cs1[1], cs1[3]};
                        const f32x4 x1 = acc[ai][bj][m][0], x2 = acc[ai][bj][m][1];
                        f32x4 o1 = x1, o2 = x2; if (isr) { o1 = x1 * cc - x2 * ss; o2 = x1 * ss + x2 * cc; }
                        o1 = o1 * rsq[ai][m]; o2 = o2 * rsq[ai][m];
                        w1[e].x = pk2(o1[0], o1[1]); w1[e].y = pk2(o1[2], o1[3]); w2[e].x = pk2(o2[0], o2[1]); w2[e].y = pk2(o2[2], o2[3]); }
                    PG8_PAIR16(w1[0], w1[1]); PG8_PAIR16(w2[0], w2[1]);
                    bf16_t* p = O + (size_t)(row0 + ai * HALF + (2 * mp + (fq & 1)) * 16) * 768 + colg + 4 * (fq & ~1);
                    u32x4 q1; q1.x = w1[0].x; q1.y = w1[0].y; q1.z = w1[1].x; q1.w = w1[1].y; u32x4 q2; q2.x = w2[0].x; q2.y = w2[0].y; q2.z = w2[1].x; q2.w = w2[1].y;
                    *(u32x4*)p = q1; *(u32x4*)(p + 16) = q2; }
    }
};
struct EpiBf16 {
    static constexpr bool PERM = true, AFTER_DRAIN = false;
    bf16_t* O; int ldc; float osc;
    __device__ __forceinline__ void operator()(const Acc& acc, const Unit& u, int wr, int wc, int fr, int fq) const {
        const int row0 = u.pm * BM + wr * 64 + fr, col0 = u.pn * BM + wc * 32 + 8 * fq;
#pragma unroll
        for (int ai = 0; ai < 2; ++ai)
#pragma unroll
            for (int m = 0; m < 4; ++m) { bf16_t* rowp = O + (size_t)(row0 + ai * HALF + m * 16) * ldc + col0;
#pragma unroll
                for (int bj = 0; bj < 2; ++bj) { const f32x4 v0 = acc[ai][bj][m][0] * osc, v1 = acc[ai][bj][m][1] * osc;
                    u32x4 w; w.x = pk2(v0[0], v0[1]); w.y = pk2(v0[2], v0[3]); w.z = pk2(v1[0], v1[1]); w.w = pk2(v1[2], v1[3]);
                    *(u32x4*)(rowp + bj * HALF) = w; } }
    }
};
struct EpiBf16Rs {
    static constexpr bool PERM = true, AFTER_DRAIN = false;
    bf16_t* O; int ldc; const float* SSP;
    __device__ __forceinline__ void operator()(const Acc& acc, const Unit& u, int wr, int wc, int fr, int fq) const {
        const int row0 = u.pm * BM + wr * 64 + fr, col0 = u.pn * BM + wc * 32 + 8 * fq;
        float rsq[2][4];
#pragma unroll
        for (int ai = 0; ai < 2; ++ai) { f32x4 sa[4], sb[4];
#pragma unroll
            for (int m = 0; m < 4; ++m) { const float* sp = SSP + (size_t)(row0 + ai * HALF + m * 16) * 16 + 8; sa[m] = *(const f32x4*)sp; sb[m] = *(const f32x4*)(sp + 4); }
#pragma unroll
            for (int m = 0; m < 4; ++m) { const f32x4 t = sa[m] + sb[m]; rsq[ai][m] = 1.0f / sqrtf(((t[0] + t[1]) + (t[2] + t[3])) * (1.0f / 256.0f) + LN_EPS); } }
#pragma unroll
        for (int ai = 0; ai < 2; ++ai)
#pragma unroll
            for (int m = 0; m < 4; ++m) { bf16_t* rowp = O + (size_t)(row0 + ai * HALF + m * 16) * ldc + col0; const float osc = rsq[ai][m];
#pragma unroll
                for (int bj = 0; bj < 2; ++bj) { const f32x4 v0 = acc[ai][bj][m][0] * osc, v1 = acc[ai][bj][m][1] * osc;
                    u32x4 w; w.x = pk2(v0[0], v0[1]); w.y = pk2(v0[2], v0[3]); w.z = pk2(v1[0], v1[1]); w.w = pk2(v1[2], v1[3]);
                    *(u32x4*)(rowp + bj * HALF) = w; } }
    }
};
template <bool ADD> struct EpiGate {
    static constexpr bool PERM = true, AFTER_DRAIN = false;
    bf16_t* O; const bf16_t* Gt; const bf16_t* MT; int goff;
    __device__ __forceinline__ void operator()(const Acc& acc, const Unit& u, int wr, int wc, int fr, int fq) const {
        const int row0 = u.pm * BM + wr * 64 + fr, col0 = u.pn * BM + wc * 32 + 8 * fq;
#pragma unroll
        for (int ai = 0; ai < 2; ++ai) {
#if GATE_U8
            u32x2 gq[4][2]; u32x4 mq[4][2];
#else
            u32x4 gq[4][2], mq[4][2];
#endif
#pragma unroll
            for (int m = 0; m < 4; ++m)
#pragma unroll
                for (int bj = 0; bj < 2; ++bj) { const size_t row = (size_t)(row0 + ai * HALF + m * 16); const int col = col0 + bj * HALF;
#if GATE_U8
                    gq[m][bj] = *(const u32x2*)((const unsigned char*)Gt + row * 2048 + goff + col);
#else
                    gq[m][bj] = *(const u32x4*)(Gt + row * 2048 + goff + col);
#endif
                    if (ADD) mq[m][bj] = *(const u32x4*)(MT + row * 1024 + col); }
#pragma unroll
            for (int m = 0; m < 4; ++m)
#pragma unroll
                for (int bj = 0; bj < 2; ++bj) { const size_t row = (size_t)(row0 + ai * HALF + m * 16); const int col = col0 + bj * HALF;
                    f32x4 v0 = acc[ai][bj][m][0], v1 = acc[ai][bj][m][1];
#if GATE_U8
                    { const u32x2 gv = gq[m][bj]; const float k255 = 1.0f / 255.0f;
                      v0[0] *= (float)(gv.x & 0xffu) * k255; v0[1] *= (float)((gv.x >> 8) & 0xffu) * k255; v0[2] *= (float)((gv.x >> 16) & 0xffu) * k255; v0[3] *= (float)(gv.x >> 24) * k255;
                      v1[0] *= (float)(gv.y & 0xffu) * k255; v1[1] *= (float)((gv.y >> 8) & 0xffu) * k255; v1[2] *= (float)((gv.y >> 16) & 0xffu) * k255; v1[3] *= (float)(gv.y >> 24) * k255; }
#else
                    { const u32x4 gv = gq[m][bj];
                      v0[0] *= bflo(gv.x); v0[1] *= bfhi(gv.x); v0[2] *= bflo(gv.y); v0[3] *= bfhi(gv.y); v1[0] *= bflo(gv.z); v1[1] *= bfhi(gv.z); v1[2] *= bflo(gv.w); v1[3] *= bfhi(gv.w); }
#endif
                    if (ADD) { const u32x4 mv = mq[m][bj];
                        v0[0] += bflo(mv.x); v0[1] += bfhi(mv.x); v0[2] += bflo(mv.y); v0[3] += bfhi(mv.y); v1[0] += bflo(mv.z); v1[1] += bfhi(mv.z); v1[2] += bflo(mv.w); v1[3] += bfhi(mv.w); }
                    u32x4 w; w.x = pk2(v0[0], v0[1]); w.y = pk2(v0[2], v0[3]); w.z = pk2(v1[0], v1[1]); w.w = pk2(v1[2], v1[3]);
                    *(u32x4*)(O + row * 1024 + col) = w; }
        }
    }
};
template <int MODE> struct EpiPre {
    static constexpr bool PERM = true, AFTER_DRAIN = false;
    bf16_t* P; const bf16_t* XB; float alpha; float asc;
    __device__ __forceinline__ void operator()(const Acc& acc, const Unit& u, int wr, int wc, int fr, int fq) const {
        const int row0 = u.pm * BM + wr * 64 + fr, col0 = u.pn * BM + wc * 32 + 8 * fq;
        const float kk_ = -asc * LOG2E;
#define SG_(x) __builtin_amdgcn_rcpf(1.0f + __builtin_amdgcn_exp2f((x) * kk_))
#pragma unroll
        for (int ai = 0; ai < 2; ++ai)
#pragma unroll
          for (int mh = 0; mh < 2; ++mh) {
            u32x4 xq[2][2], pq[2][2];
#pragma unroll
            for (int mm = 0; mm < 2; ++mm)
#pragma unroll
                for (int bj = 0; bj < 2; ++bj) { const int m = 2 * mh + mm; const size_t o = (size_t)(row0 + ai * HALF + m * 16) * 1024 + col0 + bj * HALF;
                    if (MODE == 1 || MODE == 2) xq[mm][bj] = *(const u32x4*)(XB + o);
                    if (MODE == 2 || MODE == 3) pq[mm][bj] = *(const u32x4*)(P + o); }
            __builtin_amdgcn_sched_barrier(0);
#pragma unroll
            for (int mm = 0; mm < 2; ++mm)
#pragma unroll
                for (int bj = 0; bj < 2; ++bj) { const int m = 2 * mh + mm; const size_t o = (size_t)(row0 + ai * HALF + m * 16) * 1024 + col0 + bj * HALF; const f32x4 a0 = acc[ai][bj][m][0], a1 = acc[ai][bj][m][1]; float r[8];
                    if (MODE == 0) { r[0] = a0[0]; r[1] = a0[1]; r[2] = a0[2]; r[3] = a0[3]; r[4] = a1[0]; r[5] = a1[1]; r[6] = a1[2]; r[7] = a1[3]; }
                    else if (MODE == 1) { const u32x4 xv = xq[mm][bj];
                        r[0] = bflo(xv.x) * alpha + a0[0]; r[1] = bfhi(xv.x) * alpha + a0[1]; r[2] = bflo(xv.y) * alpha + a0[2]; r[3] = bfhi(xv.y) * alpha + a0[3];
                        r[4] = bflo(xv.z) * alpha + a1[0]; r[5] = bfhi(xv.z) * alpha + a1[1]; r[6] = bflo(xv.w) * alpha + a1[2]; r[7] = bfhi(xv.w) * alpha + a1[3]; }
                    else if (MODE == 2) { const u32x4 xv = xq[mm][bj]; const u32x4 pv = pq[mm][bj];
                        r[0] = bflo(xv.x) * alpha + SG_(a0[0]) * bflo(pv.x); r[1] = bfhi(xv.x) * alpha + SG_(a0[1]) * bfhi(pv.x); r[2] = bflo(xv.y) * alpha + SG_(a0[2]) * bflo(pv.y); r[3] = bfhi(xv.y) * alpha + SG_(a0[3]) * bfhi(pv.y);
                        r[4] = bflo(xv.z) * alpha + SG_(a1[0]) * bflo(pv.z); r[5] = bfhi(xv.z) * alpha + SG_(a1[1]) * bfhi(pv.z); r[6] = bflo(xv.w) * alpha + SG_(a1[2]) * bflo(pv.w); r[7] = bfhi(xv.w) * alpha + SG_(a1[3]) * bfhi(pv.w); }
                    else { const u32x4 pv = pq[mm][bj];
                        r[0] = bflo(pv.x) + a0[0]; r[1] = bfhi(pv.x) + a0[1]; r[2] = bflo(pv.y) + a0[2]; r[3] = bfhi(pv.y) + a0[3]; r[4] = bflo(pv.z) + a1[0]; r[5] = bfhi(pv.z) + a1[1]; r[6] = bflo(pv.w) + a1[2]; r[7] = bfhi(pv.w) + a1[3]; }
                    u32x4 w; w.x = pk2(r[0], r[1]); w.y = pk2(r[2], r[3]); w.z = pk2(r[4], r[5]); w.w = pk2(r[6], r[7]);
                    *(u32x4*)(P + o) = w; }
            __builtin_amdgcn_sched_barrier(0);
          }
    }
};
#undef SG_

template <int MODE> struct EpiPreLn {
    static constexpr bool PERM = true, AFTER_DRAIN = false;
    const bf16_t* P; bf16_t* XB; unsigned char* XB8; float alpha; const float* gam; const float* bet;
    unsigned long long* ST; unsigned* FLAG; LAS unsigned char* sl;
    __device__ __forceinline__ void operator()(const Acc& acc, const Unit& u, int wr, int wc, int fr, int fq) const {
        const int lane = fr | (fq << 4), t = ((wr * 4 + wc) << 6) | lane;
        const int row0 = u.pm * BM + wr * 64 + fr, col0 = u.pn * BM + wc * 32 + 8 * fq;
        Acc pre; float s1[2][4], s2[2][4];
#pragma unroll
        for (int ai = 0; ai < 2; ++ai)
#pragma unroll
          for (int mh = 0; mh < 2; ++mh) {
            u32x4 xq[2][2];
#pragma unroll
            for (int mm = 0; mm < 2; ++mm)
#pragma unroll
                for (int bj = 0; bj < 2; ++bj) { const int m = 2 * mh + mm; const size_t o = (size_t)(row0 + ai * HALF + m * 16) * 1024 + col0 + bj * HALF;
                    xq[mm][bj] = *(const u32x4*)((MODE == 1 ? (const bf16_t*)XB : P) + o); }
            __builtin_amdgcn_sched_barrier(0);
#pragma unroll
            for (int mm = 0; mm < 2; ++mm) { const int m = 2 * mh + mm; float a1 = 0.f, a2 = 0.f;
#pragma unroll
                for (int bj = 0; bj < 2; ++bj) { const f32x4 a0 = acc[ai][bj][m][0], b0 = acc[ai][bj][m][1]; const u32x4 xv = xq[mm][bj]; const float ka = (MODE == 1) ? alpha : 1.0f;
                    f32x4 r0, r1;
                    r0[0] = bflo(xv.x) * ka + a0[0]; r0[1] = bfhi(xv.x) * ka + a0[1]; r0[2] = bflo(xv.y) * ka + a0[2]; r0[3] = bfhi(xv.y) * ka + a0[3];
                    r1[0] = bflo(xv.z) * ka + b0[0]; r1[1] = bfhi(xv.z) * ka + b0[1]; r1[2] = bflo(xv.w) * ka + b0[2]; r1[3] = bfhi(xv.w) * ka + b0[3];
                    asm volatile("" : "+v"(r0), "+v"(r1));
                    pre[ai][bj][m][0] = r0; pre[ai][bj][m][1] = r1;
                    a1 += ((r0[0] + r0[1]) + (r0[2] + r0[3])) + ((r1[0] + r1[1]) + (r1[2] + r1[3]));
                    a2 += ((r0[0] * r0[0] + r0[1] * r0[1]) + (r0[2] * r0[2] + r0[3] * r0[3])) + ((r1[0] * r1[0] + r1[1] * r1[1]) + (r1[2] * r1[2] + r1[3] * r1[3])); }
                asm volatile("" : "+v"(a1), "+v"(a2)); s1[ai][m] = a1; s2[ai][m] = a2; }
            __builtin_amdgcn_sched_barrier(0);
          }
#pragma unroll
        for (int ai = 0; ai < 2; ++ai)
#pragma unroll
            for (int m = 0; m < 4; ++m) { float a = s1[ai][m], b = s2[ai][m]; a += shx(a, 16, lane); b += shx(b, 16, lane); a += shx(a, 32, lane); b += shx(b, 32, lane);
                if (fq == 0) { const int rl = ai * HALF + wr * 64 + m * 16 + fr; f32x2 w = {a, b}; *(LAS f32x2*)(sl + (rl * 4 + wc) * 8) = w; } }
        int row0b = row0, col0b = col0; asm volatile("" : "+v"(row0b), "+v"(col0b));
        f32x4 gv[2][2], bv[2][2];
#pragma unroll
        for (int bj = 0; bj < 2; ++bj)
#pragma unroll
            for (int n = 0; n < 2; ++n) { gv[bj][n] = *(const f32x4*)(gam + col0b + bj * HALF + 4 * n); bv[bj][n] = *(const f32x4*)(bet + col0b + bj * HALF + 4 * n); }
        __syncthreads();
        unsigned long long* stp = ST + ((size_t)u.pm * 4) * 256 + t;
        if (t < 256) { const LAS f32x2* p = (const LAS f32x2*)(sl + t * 32); const f32x2 w = (p[0] + p[1]) + (p[2] + p[3]);
            __hip_atomic_store(stp + (size_t)u.pn * 256, __builtin_bit_cast(unsigned long long, w), __ATOMIC_RELAXED, __HIP_MEMORY_SCOPE_AGENT); }
        asm volatile("s_waitcnt vmcnt(0)" ::: "memory");
        __syncthreads();
        if (t == 0) { __hip_atomic_fetch_add(FLAG + u.pm, 1u, __ATOMIC_RELAXED, __HIP_MEMORY_SCOPE_AGENT);
            for (int spin = 0; spin < (1 << 20) && __hip_atomic_load(FLAG + u.pm, __ATOMIC_RELAXED, __HIP_MEMORY_SCOPE_AGENT) < 4u; ++spin) __builtin_amdgcn_s_sleep(1); }
        __syncthreads();
        if (t < 256) {
            const unsigned long long q0 = __hip_atomic_load(stp, __ATOMIC_RELAXED, __HIP_MEMORY_SCOPE_AGENT), q1 = __hip_atomic_load(stp + 256, __ATOMIC_RELAXED, __HIP_MEMORY_SCOPE_AGENT),
                                     q2 = __hip_atomic_load(stp + 512, __ATOMIC_RELAXED, __HIP_MEMORY_SCOPE_AGENT), q3 = __hip_atomic_load(stp + 768, __ATOMIC_RELAXED, __HIP_MEMORY_SCOPE_AGENT);
            const f32x2 w = (__builtin_bit_cast(f32x2, q0) + __builtin_bit_cast(f32x2, q1)) + (__builtin_bit_cast(f32x2, q2) + __builtin_bit_cast(f32x2, q3));
            const float mean = w[0] * (1.0f / 1024.0f); float var = w[1] * (1.0f / 1024.0f) - mean * mean; var = var < 0.f ? 0.f : var;
            f32x2 mr = {mean, 1.0f / sqrtf(var + LN_EPS)}; *(LAS f32x2*)(sl + 8192 + t * 8) = mr; }
        __syncthreads();
        const int fqe = (col0b >> 3) & 1;
#pragma unroll
        for (int ai = 0; ai < 2; ++ai)
#pragma unroll
            for (int mp = 0; mp < 2; ++mp) { f32x2 mr[2];
#pragma unroll
                for (int e = 0; e < 2; ++e) mr[e] = *(const LAS f32x2*)(sl + 8192 + (ai * HALF + wr * 64 + (2 * mp + e) * 16 + fr) * 8);
#pragma unroll
                for (int bj = 0; bj < 2; ++bj) { u32x2 w8[2];
#pragma unroll
                    for (int e = 0; e < 2; ++e) { const int m = 2 * mp + e; const size_t o = (size_t)(row0b + ai * HALF + m * 16) * 1024 + col0b;
                        const f32x4 y0 = (pre[ai][bj][m][0] - mr[e][0]) * mr[e][1] * gv[bj][0] + bv[bj][0], y1 = (pre[ai][bj][m][1] - mr[e][0]) * mr[e][1] * gv[bj][1] + bv[bj][1];
                        u32x4 w; w.x = pk2(y0[0], y0[1]); w.y = pk2(y0[2], y0[3]); w.z = pk2(y1[0], y1[1]); w.w = pk2(y1[2], y1[3]);
                        *(u32x4*)(XB + o + bj * HALF) = w;
                        int q0 = __builtin_amdgcn_cvt_pk_fp8_f32(y0[0], y0[1], 0, false); q0 = __builtin_amdgcn_cvt_pk_fp8_f32(y0[2], y0[3], q0, true);
                        int q1 = __builtin_amdgcn_cvt_pk_fp8_f32(y1[0], y1[1], 0, false); q1 = __builtin_amdgcn_cvt_pk_fp8_f32(y1[2], y1[3], q1, true);
                        w8[e].x = (unsigned)q0; w8[e].y = (unsigned)q1; }
                    PG8_PAIR16(w8[0], w8[1]);
                    u32x4 q; q.x = w8[0].x; q.y = w8[0].y; q.z = w8[1].x; q.w = w8[1].y;
                    *(u32x4*)(XB8 + (size_t)(row0b + ai * HALF + (2 * mp + fqe) * 16) * 1024 + (col0b - 8 * fqe) + bj * HALF) = q; } }
    }
};
struct EpiSwiGLU {
    static constexpr bool PERM = true, AFTER_DRAIN = false;
    bf16_t* H; int ldc;
    __device__ __forceinline__ void operator()(const Acc& acc, const Unit& u, int wr, int wc, int fr, int fq) const {
        const int rowb = u.pm * BM + wr * 64 + fr + (fq & 1) * 16, colb = (u.pn * BM + wc * 32 + 8 * (fq & ~1)) >> 1;
#pragma unroll
        for (int ai = 0; ai < 2; ++ai)
#pragma unroll
            for (int mp = 0; mp < 2; ++mp)
#pragma unroll
                for (int bj = 0; bj < 2; ++bj) { u32x2 w[2];
#pragma unroll
                    for (int e = 0; e < 2; ++e) { const int m = 2 * mp + e; const f32x4 v0 = acc[ai][bj][m][0], v1 = acc[ai][bj][m][1];
                        const float h0 = v0[0] * sigmoidf_(v0[0]) * v0[1], h1 = v0[2] * sigmoidf_(v0[2]) * v0[3], h2 = v1[0] * sigmoidf_(v1[0]) * v1[1], h3 = v1[2] * sigmoidf_(v1[2]) * v1[3];
                        w[e].x = pk2(h0, h1); w[e].y = pk2(h2, h3); }
                    PG8_PAIR16(w[0], w[1]);
                    u32x4 q; q.x = w[0].x; q.y = w[0].y; q.z = w[1].x; q.w = w[1].y;
                    *(u32x4*)(H + (size_t)(rowb + ai * HALF + mp * 32) * ldc + colb + bj * (HALF / 2)) = q; }
    }
};

struct EpiSwiGLU8 {
    static constexpr bool PERM = true, AFTER_DRAIN = false;
    unsigned char* H; int ldc; float isc;
    __device__ __forceinline__ void operator()(const Acc& acc, const Unit& u, int wr, int wc, int fr, int fq) const {
        const int rowb = u.pm * BM + wr * 64 + fr + fq * 16, colb = (u.pn * BM + wc * 32) >> 1;
#pragma unroll
        for (int ai = 0; ai < 2; ++ai)
#pragma unroll
            for (int bj = 0; bj < 2; ++bj) { unsigned d[4];
#pragma unroll
                for (int m = 0; m < 4; ++m) { const f32x4 v0 = acc[ai][bj][m][0] * isc, v1 = acc[ai][bj][m][1] * isc;
                    const float h0 = v0[0] * sigmoidf_(v0[0]) * v0[1], h1 = v0[2] * sigmoidf_(v0[2]) * v0[3], h2 = v1[0] * sigmoidf_(v1[0]) * v1[1], h3 = v1[2] * sigmoidf_(v1[2]) * v1[3];
                    int w = __builtin_amdgcn_cvt_pk_fp8_f32(h0, h1, 0, false); w = __builtin_amdgcn_cvt_pk_fp8_f32(h2, h3, w, true); d[m] = (unsigned)w; }
                { const auto r = __builtin_amdgcn_permlane32_swap(d[0], d[2], false, false); d[0] = r[0]; d[2] = r[1]; }
                { const auto r = __builtin_amdgcn_permlane32_swap(d[1], d[3], false, false); d[1] = r[0]; d[3] = r[1]; }
                { const auto r = __builtin_amdgcn_permlane16_swap(d[0], d[1], false, false); d[0] = r[0]; d[1] = r[1]; }
                { const auto r = __builtin_amdgcn_permlane16_swap(d[2], d[3], false, false); d[2] = r[0]; d[3] = r[1]; }
                u32x4 q; q.x = d[0]; q.y = d[1]; q.z = d[2]; q.w = d[3];
                *(u32x4*)(H + (size_t)(rowb + ai * HALF) * ldc + colb + bj * (HALF / 2)) = q; }
    }
};

template <class Epi, class Sched, bool ALIGN_EPI = false, bool SP2 = false, int STAGGER_TICKS = 0>
__device__ __forceinline__ void gemm_phase(PG8_LAS unsigned char* lds, const Gemm g, const Sched& S, const Epi& E, const int tid_in) {
    int tid_ = tid_in; asm volatile("" : "+v"(tid_));
    const int tid = tid_, wid = __builtin_amdgcn_readfirstlane(tid >> 6), lane = tid & 63, wr = wid >> 2, wc = wid & 3, fr = lane & 15, fq = lane >> 4;
    int K_ = g.K; asm volatile("" : "+s"(K_)); const int K = K_, nt = K / BK;
    unsigned voffA[2], voffB[2];
#pragma unroll
    for (int i = 0; i < 2; ++i) { int R, C; stage_rc(tid * 16 + i * 8192, R, C); const int Rb = Epi::PERM ? ((R & ~31) + perm32(R & 31)) : R;
        voffA[i] = (unsigned)(R * K + C) * 2u; voffB[i] = (unsigned)(Rb * K + C) * 2u; }
    const size_t kstep = (size_t)(BK * 2);
    const size_t hstep = (size_t)HALF * K * 2;
    const size_t tstep = 2 * hstep;
    const unsigned ldsw = (unsigned)wid * 1024u;
    const int aoff = lds_byte(wr * 64 + fr, fq * 8), boff = lds_byte(wc * 32 + fr, fq * 8);
#define PG8_SA(b, h) (((b) * 2 + (h)) * HTB)
#define PG8_SB(b, h) ((4 + (b) * 2 + (h)) * HTB)
#define PG8_STAGE(bufoff, gbase, voff) do { _Pragma("unroll") for (int _i = 0; _i < 2; ++_i) \
        __builtin_amdgcn_global_load_lds((const unsigned*)((const char*)(gbase) + (voff)[_i]), (PG8_LAS unsigned*)(lds + (bufoff) + ldsw + _i * 8192), 16, 0, 0); } while (0)
#define PG8_LDA(dst, b, h) do { _Pragma("unroll") for (int m = 0; m < 4; ++m) _Pragma("unroll") for (int k = 0; k < 2; ++k) dst[m][k] = *(const PG8_LAS bf16x8*)(lds + PG8_SA(b, h) + aoff + m * 2048 + k * 1024); } while (0)
#define PG8_LDB(dst, b, h) do { _Pragma("unroll") for (int n = 0; n < 2; ++n) _Pragma("unroll") for (int k = 0; k < 2; ++k) dst[n][k] = *(const PG8_LAS bf16x8*)(lds + PG8_SB(b, h) + boff + n * 2048 + k * 1024); } while (0)
#define PG8_MMA(ai, bj, At, Bt) do { __builtin_amdgcn_s_setprio(1); _Pragma("unroll") for (int m = 0; m < 4; ++m) _Pragma("unroll") for (int n = 0; n < 2; ++n) _Pragma("unroll") for (int k = 0; k < 2; ++k) \
        acc[ai][bj][m][n] = __builtin_amdgcn_mfma_f32_16x16x32_bf16(Bt[n][k], At[m][k], acc[ai][bj][m][n], 0, 0, 0); __builtin_amdgcn_s_setprio(0); } while (0)
#define PG8_WAIT_V(n) asm volatile("s_waitcnt vmcnt(" #n ")" ::: "memory")
#define PG8_WAIT_L(n) asm volatile("s_waitcnt lgkmcnt(" #n ")" ::: "memory")
#define PG8_BAR __builtin_amdgcn_s_barrier()
#define PG8_SCHED __builtin_amdgcn_sched_barrier(0)
    Unit cur, nxt; int ui = 0;
    if (!S.next(0, cur)) return;
#if GEMM_STAGGER
    if (STAGGER_TICKS > 0 && ((blockIdx.x >> 3) & 1)) {
        const unsigned long long t0_ = __builtin_amdgcn_s_memrealtime(); while (__builtin_amdgcn_s_memrealtime() - t0_ < (unsigned long long)STAGGER_TICKS) __builtin_amdgcn_s_sleep(8); }
#endif
    f32x4 acc[2][2][4][2];
#pragma unroll
    for (int a = 0; a < 2; ++a)
#pragma unroll
        for (int b = 0; b < 2; ++b)
#pragma unroll
            for (int m = 0; m < 4; ++m)
#pragma unroll
                for (int n = 0; n < 2; ++n) acc[a][b][m][n] = (f32x4){0.f, 0.f, 0.f, 0.f};
    bf16x8 At[4][2], B0[2][2], B1[2][2];
    const char* cA = (const char*)g.A + (size_t)cur.pm * tstep; const char* cB = (const char*)g.Bt + (size_t)cur.pn * tstep + S.bofs(cur);
    S.a_ready(cur);
    if constexpr (SP2) {
        PG8_STAGE(PG8_SB(0, 0), cB, voffB); PG8_STAGE(PG8_SB(0, 1), cB + hstep, voffB); PG8_STAGE(PG8_SA(0, 0), cA, voffA); PG8_STAGE(PG8_SA(0, 1), cA + hstep, voffA);
        if (wr == 1) PG8_BAR;
        PG8_WAIT_V(2); PG8_BAR;
        PG8_STAGE(PG8_SB(1, 0), cB + kstep, voffB); PG8_STAGE(PG8_SA(1, 0), cA + kstep, voffA); PG8_STAGE(PG8_SB(1, 1), cB + hstep + kstep, voffB);
        PG8_WAIT_V(6); PG8_BAR;
    } else {
        PG8_STAGE(PG8_SB(0, 0), cB, voffB); PG8_STAGE(PG8_SA(0, 0), cA, voffA); PG8_STAGE(PG8_SB(0, 1), cB + hstep, voffB); PG8_STAGE(PG8_SA(0, 1), cA + hstep, voffA);
        if (wr == 1) PG8_BAR;
        PG8_WAIT_V(4); PG8_BAR;
        PG8_STAGE(PG8_SB(1, 0), cB + kstep, voffB); PG8_STAGE(PG8_SA(1, 0), cA + kstep, voffA); PG8_STAGE(PG8_SB(1, 1), cB + hstep + kstep, voffB);
        PG8_WAIT_V(6); PG8_BAR;
    }
    for (;;) {
        const bool has_next = S.next(ui + 1, nxt);
        const char* nA = has_next ? (const char*)g.A + (size_t)nxt.pm * tstep : cA; const char* nB = has_next ? (const char*)g.Bt + (size_t)nxt.pn * tstep + S.bofs(nxt) : cB;
#pragma nounroll
        for (int t = 0; t < nt; t += 2) {
            const bool last = (t == nt - 2);
            const char* a1 = cA + (size_t)(t + 1) * kstep;
            const char* a2 = last ? nA : cA + (size_t)(t + 2) * kstep; const char* b2 = last ? nB : cB + (size_t)(t + 2) * kstep;
            const char* a3 = a2 + kstep; const char* b3 = b2 + kstep;
            if (last && has_next) S.a_ready(nxt);
            if constexpr (SP2) {
            PG8_LDB(B0, 0, 0); PG8_LDB(B1, 0, 1); PG8_SCHED; PG8_LDA(At, 0, 0); PG8_STAGE(PG8_SA(1, 1), a1 + hstep, voffA);
            PG8_WAIT_V(8); PG8_WAIT_L(0); PG8_BAR; PG8_MMA(0, 0, At, B0); PG8_MMA(0, 1, At, B1); PG8_BAR; PG8_SCHED;
            PG8_LDA(At, 0, 1); PG8_STAGE(PG8_SB(0, 0), b2, voffB); PG8_STAGE(PG8_SB(0, 1), b2 + hstep, voffB); PG8_STAGE(PG8_SA(0, 0), a2, voffA);
            PG8_WAIT_V(8); PG8_WAIT_L(0); PG8_BAR; PG8_MMA(1, 0, At, B0); PG8_MMA(1, 1, At, B1); PG8_BAR; PG8_SCHED;
            PG8_LDB(B0, 1, 0); PG8_LDB(B1, 1, 1); PG8_SCHED; PG8_LDA(At, 1, 0); PG8_STAGE(PG8_SA(0, 1), a2 + hstep, voffA);
            PG8_WAIT_V(8); PG8_WAIT_L(0); PG8_BAR; PG8_MMA(0, 0, At, B0); PG8_MMA(0, 1, At, B1); PG8_BAR; PG8_SCHED;
            PG8_LDA(At, 1, 1); PG8_STAGE(PG8_SB(1, 0), b3, voffB); PG8_STAGE(PG8_SB(1, 1), b3 + hstep, voffB); PG8_STAGE(PG8_SA(1, 0), a3, voffA);
            PG8_WAIT_V(8); PG8_WAIT_L(0); PG8_BAR; PG8_MMA(1, 0, At, B0); PG8_MMA(1, 1, At, B1); PG8_BAR; PG8_SCHED;
            } else {
            PG8_LDB(B0, 0, 0); PG8_SCHED; PG8_LDA(At, 0, 0); PG8_STAGE(PG8_SA(1, 1), a1 + hstep, voffA);
            PG8_WAIT_L(8); PG8_BAR; PG8_WAIT_L(0); PG8_MMA(0, 0, At, B0); PG8_BAR; PG8_SCHED;
            PG8_LDB(B1, 0, 1); PG8_STAGE(PG8_SB(0, 0), b2, voffB);
            PG8_BAR; PG8_WAIT_L(0); PG8_MMA(0, 1, At, B1); PG8_BAR;
            PG8_LDA(At, 0, 1); PG8_STAGE(PG8_SA(0, 0), a2, voffA);
            PG8_BAR; PG8_WAIT_L(0); PG8_MMA(1, 0, At, B0); PG8_BAR; PG8_SCHED;
            PG8_STAGE(PG8_SB(0, 1), b2 + hstep, voffB);
            PG8_WAIT_V(6); PG8_BAR; PG8_MMA(1, 1, At, B1); PG8_BAR;
            PG8_LDB(B0, 1, 0); PG8_SCHED; PG8_LDA(At, 1, 0); PG8_STAGE(PG8_SA(0, 1), a2 + hstep, voffA);
            PG8_WAIT_L(8); PG8_BAR; PG8_WAIT_L(0); PG8_MMA(0, 0, At, B0); PG8_BAR; PG8_SCHED;
            PG8_LDB(B1, 1, 1); PG8_STAGE(PG8_SB(1, 0), b3, voffB);
            PG8_BAR; PG8_WAIT_L(0); PG8_MMA(0, 1, At, B1); PG8_BAR;
            PG8_LDA(At, 1, 1); PG8_STAGE(PG8_SA(1, 0), a3, voffA);
            PG8_BAR; PG8_WAIT_L(0); PG8_MMA(1, 0, At, B0); PG8_BAR; PG8_SCHED;
            PG8_STAGE(PG8_SB(1, 1), b3 + hstep, voffB);
            PG8_WAIT_V(6); PG8_BAR; PG8_MMA(1, 1, At, B1); PG8_BAR;
            }
        }
        if constexpr (ALIGN_EPI) { if (wr == 0) PG8_BAR; }
        if constexpr (!Epi::AFTER_DRAIN) { unsigned m1_ = ~0u; asm volatile("" : "+s"(m1_)); const int le_ = (int)__builtin_amdgcn_mbcnt_hi(m1_, __builtin_amdgcn_mbcnt_lo(m1_, 0u));
            E(acc, cur, wr, wc, le_ & 15, le_ >> 4); S.done(cur); }
        if (!has_next) break;
#pragma unroll
        for (int a = 0; a < 2; ++a)
#pragma unroll
            for (int b = 0; b < 2; ++b)
#pragma unroll
                for (int m = 0; m < 4; ++m)
#pragma unroll
                    for (int n = 0; n < 2; ++n) acc[a][b][m][n] = (f32x4){0.f, 0.f, 0.f, 0.f};
        cur = nxt; cA = nA; cB = nB; ++ui;
        if constexpr (ALIGN_EPI) { if (wr == 1) PG8_BAR; }
    }
    PG8_WAIT_V(0);
    if constexpr (!ALIGN_EPI) { if (wr == 0) PG8_BAR; }
    PG8_BAR;
    if constexpr (Epi::AFTER_DRAIN) { E.fused(acc, cur, wr, wc, fr, fq, lds, wid, lane); S.done(cur); }
#undef PG8_SA
#undef PG8_SB
#undef PG8_STAGE
#undef PG8_LDA
#undef PG8_LDB
#undef PG8_MMA
#undef PG8_WAIT_V
#undef PG8_WAIT_L
#undef PG8_BAR
#undef PG8_SCHED
}
typedef int i32x4_ __attribute__((ext_vector_type(4)));
typedef int i32x8_ __attribute__((ext_vector_type(8)));
template <class Epi, class Sched, bool ALIGN_EPI = false, bool SP2 = false, int STAGGER_TICKS = 0>
__device__ __forceinline__ void gemm_phase8(PG8_LAS unsigned char* lds, const Gemm g, const Sched& S, const Epi& E, const int sc1, const int tid_in) {
    int tid_ = tid_in; asm volatile("" : "+v"(tid_));
    const int tid = tid_, wid = __builtin_amdgcn_readfirstlane(tid >> 6), lane = tid & 63, wr = wid >> 2, wc = wid & 3, fr = lane & 15, fq = lane >> 4;
    int K_ = g.K; asm volatile("" : "+s"(K_)); const int K = K_, nt = K / BK;
    unsigned voffA[2], voffB[2];
#pragma unroll
    for (int i = 0; i < 2; ++i) { int R, C; stage_rc(tid * 16 + i * 8192, R, C); const int Rb = Epi::PERM ? ((R & ~31) + perm32(R & 31)) : R;
        voffA[i] = (unsigned)(R * K + C) * 2u; voffB[i] = (unsigned)(Rb * K + C) * 2u; }
    const size_t kstep = (size_t)(BK * 2);
    const size_t hstep = (size_t)HALF * K * 2;
    const size_t tstep = 2 * hstep;
    const unsigned ldsw = (unsigned)wid * 1024u;
    const int cq8 = (fq >> 1) * 32 + 16 * (fq & 1);
    const int aoff = lds_byte(wr * 64 + fr, cq8), boff = lds_byte(wc * 32 + fr, cq8);
#define PG8_SA(b, h) (((b) * 2 + (h)) * HTB)
#define PG8_SB(b, h) ((4 + (b) * 2 + (h)) * HTB)
#define PG8_STAGE(bufoff, gbase, voff) do { _Pragma("unroll") for (int _i = 0; _i < 2; ++_i) \
        __builtin_amdgcn_global_load_lds((const unsigned*)((const char*)(gbase) + (voff)[_i]), (PG8_LAS unsigned*)(lds + (bufoff) + ldsw + _i * 8192), 16, 0, 0); } while (0)
#define PG8_LD16(off) (*(const PG8_LAS i32x4_*)(lds + (off)))
#define PG8_LDA(dst, b, h) do { _Pragma("unroll") for (int m = 0; m < 4; ++m) dst[m] = __builtin_shufflevector(PG8_LD16(PG8_SA(b, h) + aoff + m * 2048), PG8_LD16(PG8_SA(b, h) + aoff + m * 2048 + 16), 0, 1, 2, 3, 4, 5, 6, 7); } while (0)
#define PG8_LDB(dst, b, h) do { _Pragma("unroll") for (int n = 0; n < 2; ++n) dst[n] = __builtin_shufflevector(PG8_LD16(PG8_SB(b, h) + boff + n * 2048), PG8_LD16(PG8_SB(b, h) + boff + n * 2048 + 16), 0, 1, 2, 3, 4, 5, 6, 7); } while (0)
#define PG8_MMA(ai, bj, At, Bt) do { __builtin_amdgcn_s_setprio(1); _Pragma("unroll") for (int m = 0; m < 4; ++m) _Pragma("unroll") for (int n = 0; n < 2; ++n) \
        asm volatile("v_mfma_scale_f32_16x16x128_f8f6f4 %0, %1, %2, %0, %3, %3 op_sel_hi:[0,0,0]" : "+v"(acc[ai][bj][m][n]) : "v"(Bt[n]), "v"(At[m]), "v"(sc1)); __builtin_amdgcn_s_setprio(0); } while (0)
#define PG8_WAIT_V(n) asm volatile("s_waitcnt vmcnt(" #n ")" ::: "memory")
#define PG8_WAIT_L(n) asm volatile("s_waitcnt lgkmcnt(" #n ")" ::: "memory")
#define PG8_BAR __builtin_amdgcn_s_barrier()
#define PG8_SCHED __builtin_amdgcn_sched_barrier(0)
    Unit cur, nxt; int ui = 0;
    if (!S.next(0, cur)) return;
#if GEMM_STAGGER
    if (STAGGER_TICKS > 0 && ((blockIdx.x >> 3) & 1)) {
        const unsigned long long t0_ = __builtin_amdgcn_s_memrealtime(); while (__builtin_amdgcn_s_memrealtime() - t0_ < (unsigned long long)STAGGER_TICKS) __builtin_amdgcn_s_sleep(8); }
#endif
    f32x4 acc[2][2][4][2];
#pragma unroll
    for (int a = 0; a < 2; ++a)
#pragma unroll
        for (int b = 0; b < 2; ++b)
#pragma unroll
            for (int m = 0; m < 4; ++m)
#pragma unroll
                for (int n = 0; n < 2; ++n) acc[a][b][m][n] = (f32x4){0.f, 0.f, 0.f, 0.f};
    i32x8_ At[4], B0[2], B1[2];
    const char* cA = (const char*)g.A + (size_t)cur.pm * tstep; const char* cB = (const char*)g.Bt + (size_t)cur.pn * tstep + S.bofs(cur);
    S.a_ready(cur);
    if constexpr (SP2) {
        PG8_STAGE(PG8_SB(0, 0), cB, voffB); PG8_STAGE(PG8_SB(0, 1), cB + hstep, voffB); PG8_STAGE(PG8_SA(0, 0), cA, voffA); PG8_STAGE(PG8_SA(0, 1), cA + hstep, voffA);
        if (wr == 1) PG8_BAR;
        PG8_WAIT_V(2); PG8_BAR;
        PG8_STAGE(PG8_SB(1, 0), cB + kstep, voffB); PG8_STAGE(PG8_SA(1, 0), cA + kstep, voffA); PG8_STAGE(PG8_SB(1, 1), cB + hstep + kstep, voffB);
        PG8_WAIT_V(6); PG8_BAR;
    } else {
        PG8_STAGE(PG8_SB(0, 0), cB, voffB); PG8_STAGE(PG8_SA(0, 0), cA, voffA); PG8_STAGE(PG8_SB(0, 1), cB + hstep, voffB); PG8_STAGE(PG8_SA(0, 1), cA + hstep, voffA);
        if (wr == 1) PG8_BAR;
        PG8_WAIT_V(4); PG8_BAR;
        PG8_STAGE(PG8_SB(1, 0), cB + kstep, voffB); PG8_STAGE(PG8_SA(1, 0), cA + kstep, voffA); PG8_STAGE(PG8_SB(1, 1), cB + hstep + kstep, voffB);
        PG8_WAIT_V(6); PG8_BAR;
    }
    for (;;) {
        const bool has_next = S.next(ui + 1, nxt);
        const char* nA = has_next ? (const char*)g.A + (size_t)nxt.pm * tstep : cA; const char* nB = has_next ? (const char*)g.Bt + (size_t)nxt.pn * tstep + S.bofs(nxt) : cB;
#pragma nounroll
        for (int t = 0; t < nt; t += 2) {
            const bool last = (t == nt - 2);
            const char* a1 = cA + (size_t)(t + 1) * kstep;
            const char* a2 = last ? nA : cA + (size_t)(t + 2) * kstep; const char* b2 = last ? nB : cB + (size_t)(t + 2) * kstep;
            const char* a3 = a2 + kstep; const char* b3 = b2 + kstep;
            if (last && has_next) S.a_ready(nxt);
            if constexpr (SP2) {
            PG8_LDB(B0, 0, 0); PG8_LDB(B1, 0, 1); PG8_SCHED; PG8_LDA(At, 0, 0); PG8_STAGE(PG8_SA(1, 1), a1 + hstep, voffA);
            PG8_WAIT_V(8); PG8_WAIT_L(0); PG8_BAR; PG8_MMA(0, 0, At, B0); PG8_MMA(0, 1, At, B1); PG8_BAR; PG8_SCHED;
            PG8_LDA(At, 0, 1); PG8_STAGE(PG8_SB(0, 0), b2, voffB); PG8_STAGE(PG8_SB(0, 1), b2 + hstep, voffB); PG8_STAGE(PG8_SA(0, 0), a2, voffA);
            PG8_WAIT_V(8); PG8_WAIT_L(0); PG8_BAR; PG8_MMA(1, 0, At, B0); PG8_MMA(1, 1, At, B1); PG8_BAR; PG8_SCHED;
            PG8_LDB(B0, 1, 0); PG8_LDB(B1, 1, 1); PG8_SCHED; PG8_LDA(At, 1, 0); PG8_STAGE(PG8_SA(0, 1), a2 + hstep, voffA);
            PG8_WAIT_V(8); PG8_WAIT_L(0); PG8_BAR; PG8_MMA(0, 0, At, B0); PG8_MMA(0, 1, At, B1); PG8_BAR; PG8_SCHED;
            PG8_LDA(At, 1, 1); PG8_STAGE(PG8_SB(1, 0), b3, voffB); PG8_STAGE(PG8_SB(1, 1), b3 + hstep, voffB); PG8_STAGE(PG8_SA(1, 0), a3, voffA);
            PG8_WAIT_V(8); PG8_WAIT_L(0); PG8_BAR; PG8_MMA(1, 0, At, B0); PG8_MMA(1, 1, At, B1); PG8_BAR; PG8_SCHED;
            } else {
            PG8_LDB(B0, 0, 0); PG8_SCHED; PG8_LDA(At, 0, 0); PG8_STAGE(PG8_SA(1, 1), a1 + hstep, voffA);
            PG8_WAIT_L(8); PG8_BAR; PG8_WAIT_L(0); PG8_MMA(0, 0, At, B0); PG8_BAR; PG8_SCHED;
            PG8_LDB(B1, 0, 1); PG8_STAGE(PG8_SB(0, 0), b2, voffB);
            PG8_BAR; PG8_WAIT_L(0); PG8_MMA(0, 1, At, B1); PG8_BAR;
            PG8_LDA(At, 0, 1); PG8_STAGE(PG8_SA(0, 0), a2, voffA);
            PG8_BAR; PG8_WAIT_L(0); PG8_MMA(1, 0, At, B0); PG8_BAR; PG8_SCHED;
            PG8_STAGE(PG8_SB(0, 1), b2 + hstep, voffB);
            PG8_WAIT_V(6); PG8_BAR; PG8_MMA(1, 1, At, B1); PG8_BAR;
            PG8_LDB(B0, 1, 0); PG8_SCHED; PG8_LDA(At, 1, 0); PG8_STAGE(PG8_SA(0, 1), a2 + hstep, voffA);
            PG8_WAIT_L(8); PG8_BAR; PG8_WAIT_L(0); PG8_MMA(0, 0, At, B0); PG8_BAR; PG8_SCHED;
            PG8_LDB(B1, 1, 1); PG8_STAGE(PG8_SB(1, 0), b3, voffB);
            PG8_BAR; PG8_WAIT_L(0); PG8_MMA(0, 1, At, B1); PG8_BAR;
            PG8_LDA(At, 1, 1); PG8_STAGE(PG8_SA(1, 0), a3, voffA);
            PG8_BAR; PG8_WAIT_L(0); PG8_MMA(1, 0, At, B0); PG8_BAR; PG8_SCHED;
            PG8_STAGE(PG8_SB(1, 1), b3 + hstep, voffB);
            PG8_WAIT_V(6); PG8_BAR; PG8_MMA(1, 1, At, B1); PG8_BAR;
            }
        }
        if constexpr (ALIGN_EPI) { if (wr == 0) PG8_BAR; }
        asm volatile("s_nop 15\n\ts_nop 15" ::: "memory");
        if constexpr (!Epi::AFTER_DRAIN) { unsigned m1_ = ~0u; asm volatile("" : "+s"(m1_)); const int le_ = (int)__builtin_amdgcn_mbcnt_hi(m1_, __builtin_amdgcn_mbcnt_lo(m1_, 0u));
            E(acc, cur, wr, wc, le_ & 15, le_ >> 4); S.done(cur); }
        if (!has_next) break;
#pragma unroll
        for (int a = 0; a < 2; ++a)
#pragma unroll
            for (int b = 0; b < 2; ++b)
#pragma unroll
                for (int m = 0; m < 4; ++m)
#pragma unroll
                    for (int n = 0; n < 2; ++n) acc[a][b][m][n] = (f32x4){0.f, 0.f, 0.f, 0.f};
        cur = nxt; cA = nA; cB = nB; ++ui;
        if constexpr (ALIGN_EPI) { if (wr == 1) PG8_BAR; }
    }
    PG8_WAIT_V(0);
    if constexpr (!ALIGN_EPI) { if (wr == 0) PG8_BAR; }
    PG8_BAR;
    if constexpr (Epi::AFTER_DRAIN) { E.fused(acc, cur, wr, wc, fr, fq, lds, wid, lane); S.done(cur); }
#undef PG8_SA
#undef PG8_SB
#undef PG8_STAGE
#undef PG8_LDA
#undef PG8_LD16
#undef PG8_LDB
#undef PG8_MMA
#undef PG8_WAIT_V
#undef PG8_WAIT_L
#undef PG8_BAR
#undef PG8_SCHED
}
}

namespace att {
#ifndef ATT_UNROLL_U
#define ATT_UNROLL_U "unroll 1"
#endif
#ifndef A6_VMASK
#define A6_VMASK 0x402
#endif
#ifndef ATT2_PINGPONG
#define ATT2_PINGPONG 1
#endif
#ifndef ATT_STATIC_PRIO
#define ATT_STATIC_PRIO 1
#endif
#ifndef ATT_PRIO
#define ATT_PRIO 0
#endif
#if ATT_PRIO
#define ATT_SETPRIO(x) __builtin_amdgcn_s_setprio(x)
#else
#define ATT_SETPRIO(x) do {} while (0)
#endif
#define MFMA32(a, b, c) __builtin_amdgcn_mfma_f32_32x32x16_bf16((a), (b), (c), 0, 0, 0)
typedef short v4i16_t __attribute__((ext_vector_type(4)));
struct AttnP {
    const bf16* Q; int ldq;
    const bf16* K1; int ldk1;
    const bf16* K2; int ldk2;
    const bf16* V; int ldv;
    bf16* O; int ldo;
    const int* pos;
    const int* blkmax;
    const float* lut;
    const bf16* TI; float lam, osc; const float* gsub;
};
__device__ __forceinline__ s16x4 vtr(const LAS unsigned char* p) { return __builtin_bit_cast(s16x4, __builtin_amdgcn_ds_read_tr16_b64_v4i16((LAS v4i16_t*)p)); }

template <int DQK, int KSPLIT, int DV, bool BIAS, int COMB = 0>
__device__ __forceinline__ void attn_unit(const AttnP& P, int b, int qt, int qcol, int kcol, int vcol, int ocol, int hb, LAS unsigned char* lds, const int tid_in) {
    constexpr int KROWB = DQK * 2 + 16;
    constexpr int VROWB = (DV == 128) ? 320 : 192;
    constexpr int KBYTES = 64 * KROWB, VBYTES = 64 * VROWB, STAGE = KBYTES + VBYTES + 256, LUT_OFF = 2 * STAGE;
    constexpr int ND = DQK / 16, NDB = DV / 32, KCH = DQK / 8, VCH = DV / 8, NKC = 64 * KCH, NVC = 64 * VCH, KL = (NKC + 511) / 512, VL = (NVC + 511) / 512;
    int tid_ = tid_in; asm volatile("" : "+v"(tid_));
    const int tid = tid_, lane = tid & 63, wid = __builtin_amdgcn_readfirstlane(tid >> 6), r = lane & 31, h = lane >> 5;
    const long tok0 = (long)b * SEQ; const int q0 = qt * 256; const int qrow = q0 + wid * 32 + r;
    bf16x8 qf[ND];
    { const bf16* qp = P.Q + (tok0 + qrow) * (long)P.ldq + qcol + 8 * h;
#pragma unroll
      for (int d = 0; d < ND; ++d) qf[d] = *(const bf16x8*)(qp + 16 * d); }
    int posq = 0, posq_min = 0;
    LAS float* lut = (LAS float*)(lds + LUT_OFF);
    if (BIAS) { posq = P.pos[tok0 + qrow]; int mn = posq;
#pragma unroll
        for (int o = 1; o < 64; o <<= 1) { const int t2 = shxi(mn, o, lane); mn = t2 < mn ? t2 : mn; }
        posq_min = mn;
        if (tid < 132) lut[tid] = P.lut[hb * 132 + tid]; }
    v4u kreg[KL], vreg[VL]; int preg = 0;
#define ATT_ISSUE(t) do { const long trow = tok0 + 64 * (long)(t); \
        _Pragma("unroll") for (int i = 0; i < KL; ++i) { const int c = tid + 512 * i; if (NKC % 512 == 0 || c < NKC) { const int row = c / KCH, col = (c % KCH) * 8; \
            const bf16* src = (col < KSPLIT) ? P.K1 + (trow + row) * (long)P.ldk1 + kcol + col : P.K2 + (trow + row) * (long)P.ldk2 + (col - KSPLIT); kreg[i] = *(const v4u*)src; } } \
        _Pragma("unroll") for (int i = 0; i < VL; ++i) { const int c = tid + 512 * i; if (NVC % 512 == 0 || c < NVC) { const int row = c / VCH, col = (c % VCH) * 8; vreg[i] = *(const v4u*)(P.V + (trow + row) * (long)P.ldv + vcol + col); } } \
        if (BIAS && tid < 64) preg = P.pos[trow + tid]; } while (0)
#define ATT_WRITE(t) do { LAS unsigned char* sb = lds + ((t) & 1) * STAGE; \
        _Pragma("unroll") for (int i = 0; i < KL; ++i) { const int c = tid + 512 * i; if (NKC % 512 == 0 || c < NKC) { const int row = c / KCH, cc = c % KCH; *(LAS v4u*)(sb + row * KROWB + cc * 16) = kreg[i]; } } \
        _Pragma("unroll") for (int i = 0; i < VL; ++i) { const int c = tid + 512 * i; if (NVC % 512 == 0 || c < NVC) { const int row = c / VCH, cc = c % VCH; *(LAS v4u*)(sb + KBYTES + row * VROWB + cc * 16) = vreg[i]; } } \
        if (BIAS && tid < 64) *(LAS int*)(sb + KBYTES + VBYTES + 4 * tid) = preg; } while (0)
    f32x16 o[NDB];
#pragma unroll
    for (int i = 0; i < NDB; ++i)
#pragma unroll
        for (int j = 0; j < 16; ++j) o[i][j] = 0.f;
    float m_run = 0.f, l_run = 0.f;
    const int ntiles = (q0 + 256) / 64, my_last = (q0 + wid * 32 + 31) / 64;
#if ATT_STATIC_PRIO
    if (wid >= 4) __builtin_amdgcn_s_setprio(1);
#endif
    ATT_ISSUE(0); ATT_WRITE(0); __syncthreads();
    const int kbase = r * KROWB + 16 * h;
    const int vbase = KBYTES + (4 * h + ((lane & 15) >> 2)) * VROWB + (((lane >> 4) & 1) * 16 + (lane & 3) * 4) * 2;
    for (int t = 0; t < ntiles; ++t) {
        const bool more = (t + 1 < ntiles);
        if (more) ATT_ISSUE(t + 1);
        if (t <= my_last) {
            const LAS unsigned char* sb = lds + (t & 1) * STAGE;
            bool plain = (64 * t + 63 <= q0 + wid * 32);
            float cinit = -m_run;
            if (BIAS) { const int kmax = P.blkmax[(int)(tok0 >> 6) + t]; if (plain && (posq_min - kmax >= 113)) cinit += lut[128]; else plain = false; }
            f32x16 x0, x1;
#pragma unroll
            for (int j = 0; j < 16; ++j) { x0[j] = cinit; x1[j] = cinit; }
            ATT_SETPRIO(1);
            { bf16x8 kf0[ND], kf1[ND];
#pragma unroll
              for (int d = 0; d < ND; ++d) { kf0[d] = *(const LAS bf16x8*)(sb + kbase + d * 32); kf1[d] = *(const LAS bf16x8*)(sb + kbase + 32 * KROWB + d * 32); }
              __builtin_amdgcn_sched_barrier(0);
#pragma unroll
              for (int d = 0; d < ND; ++d) { x0 = MFMA32(kf0[d], qf[d], x0); x1 = MFMA32(kf1[d], qf[d], x1); } }
            ATT_SETPRIO(0);
            if (!plain) {
#pragma unroll
                for (int g = 0; g < 4; ++g) {
                    int pk0[4] = {0, 0, 0, 0}, pk1[4] = {0, 0, 0, 0};
                    if (BIAS) { const LAS int* pp = (const LAS int*)(sb + KBYTES + VBYTES) + 8 * g + 4 * h;
                        const v4u a = *(const LAS v4u*)pp, c = *(const LAS v4u*)(pp + 32);
                        pk0[0] = a.x; pk0[1] = a.y; pk0[2] = a.z; pk0[3] = a.w; pk1[0] = c.x; pk1[1] = c.y; pk1[2] = c.z; pk1[3] = c.w; }
#pragma unroll
                    for (int j = 0; j < 4; ++j) { const int i = 4 * g + j; const int kidx = 64 * t + 8 * g + 4 * h + j;
                        float v0 = x0[i], v1 = x1[i];
                        if (BIAS) { int n0 = posq - pk0[j]; n0 = n0 < 0 ? 0 : (n0 > 128 ? 128 : n0); int n1 = posq - pk1[j]; n1 = n1 < 0 ? 0 : (n1 > 128 ? 128 : n1); v0 += lut[n0]; v1 += lut[n1]; }
                        if (kidx > qrow) v0 = -INFINITY; if (kidx + 32 > qrow) v1 = -INFINITY;
                        x0[i] = v0; x1[i] = v1; }
                }
            }
            float ma = fmaxf(fmaxf(x0[0], x0[1]), x0[2]), mb = fmaxf(fmaxf(x1[0], x1[1]), x1[2]);
#pragma unroll
            for (int j = 3; j < 15; j += 2) { ma = fmaxf(fmaxf(ma, x0[j]), x0[j + 1]); mb = fmaxf(fmaxf(mb, x1[j]), x1[j + 1]); }
            float mx = fmaxf(fmaxf(ma, mb), fmaxf(x0[15], x1[15]));
            { const auto rr = __builtin_amdgcn_permlane32_swap(__float_as_uint(mx), __float_as_uint(mx), false, false); mx = fmaxf(__uint_as_float(rr[0]), __uint_as_float(rr[1])); }
            if (t == 0 || __any(mx > 8.0f)) {
                const float delta = (t == 0) ? mx : fmaxf(mx, 0.f);
                if (t != 0) { const float alpha = __builtin_amdgcn_exp2f(-delta); l_run *= alpha;
#pragma unroll
                    for (int i = 0; i < NDB; ++i) o[i] = o[i] * alpha; }
                m_run += delta;
#pragma unroll
                for (int j = 0; j < 16; ++j) { x0[j] -= delta; x1[j] -= delta; }
            }
            f32x2 ls2 = {0.f, 0.f};
#pragma unroll
            for (int j = 0; j < 16; j += 2) { x0[j] = __builtin_amdgcn_exp2f(x0[j]); x0[j + 1] = __builtin_amdgcn_exp2f(x0[j + 1]); x1[j] = __builtin_amdgcn_exp2f(x1[j]); x1[j + 1] = __builtin_amdgcn_exp2f(x1[j + 1]);
                ls2 += (f32x2){x0[j], x0[j + 1]}; ls2 += (f32x2){x1[j], x1[j + 1]}; }
            l_run += ls2[0] + ls2[1];
            bf16x8 pf[4];
            { v4u w;
              w.x = pk2(x0[0], x0[1]); w.y = pk2(x0[2], x0[3]); w.z = pk2(x0[4], x0[5]); w.w = pk2(x0[6], x0[7]); pf[0] = __builtin_bit_cast(bf16x8, w);
              w.x = pk2(x0[8], x0[9]); w.y = pk2(x0[10], x0[11]); w.z = pk2(x0[12], x0[13]); w.w = pk2(x0[14], x0[15]); pf[1] = __builtin_bit_cast(bf16x8, w);
              w.x = pk2(x1[0], x1[1]); w.y = pk2(x1[2], x1[3]); w.z = pk2(x1[4], x1[5]); w.w = pk2(x1[6], x1[7]); pf[2] = __builtin_bit_cast(bf16x8, w);
              w.x = pk2(x1[8], x1[9]); w.y = pk2(x1[10], x1[11]); w.z = pk2(x1[12], x1[13]); w.w = pk2(x1[14], x1[15]); pf[3] = __builtin_bit_cast(bf16x8, w); }
            ATT_SETPRIO(1);
            { s16x4 vlo[2][4], vhi[2][4];
#define ATT_VLOAD(buf, db) do { _Pragma("unroll") for (int s = 0; s < 4; ++s) { vlo[buf][s] = vtr(sb + vbase + (16 * s) * VROWB + 64 * (db)); vhi[buf][s] = vtr(sb + vbase + (16 * s + 8) * VROWB + 64 * (db)); } } while (0)
              ATT_VLOAD(0, 0);
#pragma unroll
              for (int db = 0; db < NDB; ++db) {
                  if (db + 1 < NDB) ATT_VLOAD((db + 1) & 1, db + 1);
                  __builtin_amdgcn_sched_barrier(0);
#pragma unroll
                  for (int s = 0; s < 4; ++s) { const bf16x8 vf = __builtin_shufflevector(vlo[db & 1][s], vhi[db & 1][s], 0, 1, 2, 3, 4, 5, 6, 7); o[db] = MFMA32(vf, pf[s], o[db]); }
                  __builtin_amdgcn_sched_barrier(0);
              }
#undef ATT_VLOAD
            }
            ATT_SETPRIO(0);
        }
        if (more) ATT_WRITE(t + 1);
        __syncthreads();
    }
#undef ATT_ISSUE
#undef ATT_WRITE
#if ATT_STATIC_PRIO
    __builtin_amdgcn_s_setprio(0);
#endif
    const float lt = l_run + shx(l_run, 32, lane), inv = 1.0f / lt;
    if (COMB == 2) {
        const bf16* ip = P.TI + (tok0 + qrow) * (long)P.ldo + ocol + 4 * h; float ss = 0.f;
#pragma unroll
        for (int db = 0; db < NDB; ++db)
#pragma unroll
            for (int g = 0; g < 4; ++g) { const v2u a = *(const v2u*)(ip + 32 * db + 8 * g);
                const float c0 = bflo(a.x) - P.lam * (o[db][4 * g] * inv), c1 = bfhi(a.x) - P.lam * (o[db][4 * g + 1] * inv), c2 = bflo(a.y) - P.lam * (o[db][4 * g + 2] * inv), c3 = bfhi(a.y) - P.lam * (o[db][4 * g + 3] * inv);
                o[db][4 * g] = c0; o[db][4 * g + 1] = c1; o[db][4 * g + 2] = c2; o[db][4 * g + 3] = c3; ss += (c0 * c0 + c1 * c1) + (c2 * c2 + c3 * c3); }
        ss += shx(ss, 32, lane);
        const float rr = P.osc / sqrtf(ss * (1.0f / 128.0f) + LN_EPS);
        bf16* op = P.O + (tok0 + qrow) * (long)P.ldo + ocol + 4 * h;
#pragma unroll
        for (int db = 0; db < NDB; ++db)
#pragma unroll
            for (int g = 0; g < 4; ++g) { const f32x4 gg = *(const f32x4*)(P.gsub + 32 * db + 8 * g + 4 * h);
                v2u w; w.x = pk2(o[db][4 * g] * rr * gg[0], o[db][4 * g + 1] * rr * gg[1]); w.y = pk2(o[db][4 * g + 2] * rr * gg[2], o[db][4 * g + 3] * rr * gg[3]);
                *(v2u*)(op + 32 * db + 8 * g) = w; }
        return;
    }
    bf16* op = P.O + (tok0 + qrow) * (long)P.ldo + ocol + 4 * h;
#pragma unroll
    for (int db = 0; db < NDB; ++db)
#pragma unroll
        for (int g = 0; g < 4; ++g) { v2u w; w.x = pk2(o[db][4 * g] * inv, o[db][4 * g + 1] * inv); w.y = pk2(o[db][4 * g + 2] * inv, o[db][4 * g + 3] * inv);
            *(v2u*)(op + 32 * db + 8 * g) = w; }
}

template <int DQK, int KSPLIT, int DV, bool BIAS, int COMB = 0>
__device__ __forceinline__ void attn_unit6(const AttnP& P, int b, int qt, int qcol, int kcol, int vcol, int ocol, int hb, LAS unsigned char* lds, const int tid_in) {
    constexpr int KROWB = DQK * 2 + 16;
    constexpr int VROWB = (DV == 128) ? 320 : 192;
    constexpr int KBYTES = 64 * KROWB, VBYTES = 64 * VROWB, STAGE = KBYTES + VBYTES + 256, LUT_OFF = 2 * STAGE;
    constexpr int ND = DQK / 16, NDB = DV / 32, KCH = DQK / 8, VCH = DV / 8, NKC = 64 * KCH, NVC = 64 * VCH, KL = (NKC + 511) / 512, VL = (NVC + 511) / 512;
    int tid_ = tid_in; asm volatile("" : "+v"(tid_));
    const int tid = tid_, lane = tid & 63, wid = __builtin_amdgcn_readfirstlane(tid >> 6), r = lane & 31, h = lane >> 5;
    const long tok0 = (long)b * SEQ; const int q0 = qt * 256; const int qrow = q0 + wid * 32 + r;
    bf16x8 qf[ND];
    { const bf16* qp = P.Q + (tok0 + qrow) * (long)P.ldq + qcol + 8 * h;
#pragma unroll
      for (int d = 0; d < ND; ++d) qf[d] = *(const bf16x8*)(qp + 16 * d); }
    int posq = 0, posq_min = 0;
    LAS float* lut = (LAS float*)(lds + LUT_OFF);
    if (BIAS) { posq = P.pos[tok0 + qrow]; int mn = posq;
#pragma unroll
        for (int o = 1; o < 64; o <<= 1) { const int t2 = shxi(mn, o, lane); mn = t2 < mn ? t2 : mn; }
        posq_min = mn;
        if (tid < 132) lut[tid] = P.lut[hb * 132 + tid]; }
    v4u kreg[KL], vreg[VL]; int preg = 0;
#define ATT_ISSUE(t) do { const long trow = tok0 + 64 * (long)(t); \
        _Pragma("unroll") for (int i = 0; i < KL; ++i) { const int c = tid + 512 * i; if (NKC % 512 == 0 || c < NKC) { const int row = c / KCH, col = (c % KCH) * 8; \
            const bf16* src = (col < KSPLIT) ? P.K1 + (trow + row) * (long)P.ldk1 + kcol + col : P.K2 + (trow + row) * (long)P.ldk2 + (col - KSPLIT); kreg[i] = *(const v4u*)src; } } \
        _Pragma("unroll") for (int i = 0; i < VL; ++i) { const int c = tid + 512 * i; if (NVC % 512 == 0 || c < NVC) { const int row = c / VCH, col = (c % VCH) * 8; vreg[i] = *(const v4u*)(P.V + (trow + row) * (long)P.ldv + vcol + col); } } \
        if (BIAS && tid < 64) preg = P.pos[trow + tid]; } while (0)
#define ATT_WRITE(t) do { LAS unsigned char* sb = lds + ((t) & 1) * STAGE; \
        _Pragma("unroll") for (int i = 0; i < KL; ++i) { const int c = tid + 512 * i; if (NKC % 512 == 0 || c < NKC) { const int row = c / KCH, cc = c % KCH; *(LAS v4u*)(sb + row * KROWB + cc * 16) = kreg[i]; } } \
        _Pragma("unroll") for (int i = 0; i < VL; ++i) { const int c = tid + 512 * i; if (NVC % 512 == 0 || c < NVC) { const int row = c / VCH, cc = c % VCH; *(LAS v4u*)(sb + KBYTES + row * VROWB + cc * 16) = vreg[i]; } } \
        if (BIAS && tid < 64) *(LAS int*)(sb + KBYTES + VBYTES + 4 * tid) = preg; } while (0)
    f32x16 o[NDB];
#pragma unroll
    for (int i = 0; i < NDB; ++i)
#pragma unroll
        for (int j = 0; j < 16; ++j) o[i][j] = 0.f;
    float m_run = 0.f, l_run = 0.f;
    const int ntiles = (q0 + 256) / 64, my_last = (q0 + wid * 32 + 31) / 64;
#if ATT_STATIC_PRIO
    if (wid >= 4) __builtin_amdgcn_s_setprio(1);
#endif
    ATT_ISSUE(0); ATT_WRITE(0); __syncthreads();
    const int kbase = r * KROWB + 16 * h;
    const int vbase = KBYTES + (4 * h + ((lane & 15) >> 2)) * VROWB + (((lane >> 4) & 1) * 16 + (lane & 3) * 4) * 2;
    for (int t = 0; t < ntiles; ++t) {
        const bool more = (t + 1 < ntiles);
        if (more) ATT_ISSUE(t + 1);
        if (t <= my_last) {
            const LAS unsigned char* sb = lds + (t & 1) * STAGE;
            bool plain = (64 * t + 63 <= q0 + wid * 32);
            float cinit = -m_run;
            if (BIAS) { const int kmax = P.blkmax[(int)(tok0 >> 6) + t]; if (plain && (posq_min - kmax >= 113)) cinit += lut[128]; else plain = false; }
            f32x16 x0, x1;
#pragma unroll
            for (int j = 0; j < 16; ++j) { x0[j] = cinit; x1[j] = cinit; }
            ATT_SETPRIO(1);
            { bf16x8 kf0[ND], kf1[ND];
#pragma unroll
              for (int d = 0; d < ND; ++d) { kf0[d] = *(const LAS bf16x8*)(sb + kbase + d * 32); kf1[d] = *(const LAS bf16x8*)(sb + kbase + 32 * KROWB + d * 32); }
              __builtin_amdgcn_sched_barrier(0);
#pragma unroll
              for (int d = 0; d < ND; ++d) { x0 = MFMA32(kf0[d], qf[d], x0); x1 = MFMA32(kf1[d], qf[d], x1); } }
            ATT_SETPRIO(0);
            if (!plain) {
#pragma unroll
                for (int g = 0; g < 4; ++g) {
                    int pk0[4] = {0, 0, 0, 0}, pk1[4] = {0, 0, 0, 0};
                    if (BIAS) { const LAS int* pp = (const LAS int*)(sb + KBYTES + VBYTES) + 8 * g + 4 * h;
                        const v4u a = *(const LAS v4u*)pp, c = *(const LAS v4u*)(pp + 32);
                        pk0[0] = a.x; pk0[1] = a.y; pk0[2] = a.z; pk0[3] = a.w; pk1[0] = c.x; pk1[1] = c.y; pk1[2] = c.z; pk1[3] = c.w; }
#pragma unroll
                    for (int j = 0; j < 4; ++j) { const int i = 4 * g + j; const int kidx = 64 * t + 8 * g + 4 * h + j;
                        float v0 = x0[i], v1 = x1[i];
                        if (BIAS) { int n0 = posq - pk0[j]; n0 = n0 < 0 ? 0 : (n0 > 128 ? 128 : n0); int n1 = posq - pk1[j]; n1 = n1 < 0 ? 0 : (n1 > 128 ? 128 : n1); v0 += lut[n0]; v1 += lut[n1]; }
                        if (kidx > qrow) v0 = -INFINITY; if (kidx + 32 > qrow) v1 = -INFINITY;
                        x0[i] = v0; x1[i] = v1; }
                }
            }
            float ma = fmaxf(fmaxf(x0[0], x0[1]), x0[2]), mb = fmaxf(fmaxf(x1[0], x1[1]), x1[2]);
#pragma unroll
            for (int j = 3; j < 15; j += 2) { ma = fmaxf(fmaxf(ma, x0[j]), x0[j + 1]); mb = fmaxf(fmaxf(mb, x1[j]), x1[j + 1]); }
            float mx = fmaxf(fmaxf(ma, mb), fmaxf(x0[15], x1[15]));
            { const auto rr = __builtin_amdgcn_permlane32_swap(__float_as_uint(mx), __float_as_uint(mx), false, false); mx = fmaxf(__uint_as_float(rr[0]), __uint_as_float(rr[1])); }
            if (t == 0 || __any(mx > 8.0f)) {
                const float delta = (t == 0) ? mx : fmaxf(mx, 0.f);
                if (t != 0) { const float alpha = __builtin_amdgcn_exp2f(-delta); l_run *= alpha;
#pragma unroll
                    for (int i = 0; i < NDB; ++i) o[i] = o[i] * alpha; }
                m_run += delta;
#pragma unroll
                for (int j = 0; j < 16; ++j) { x0[j] -= delta; x1[j] -= delta; }
            }
            f32x2 ls2 = {0.f, 0.f};
            bf16x8 pf[4];
            s16x4 vl[2][NDB], vh[2][NDB];
#define A6_EXP(X, bb, PF) do { \
        X[bb + 0] = __builtin_amdgcn_exp2f(X[bb + 0]); X[bb + 1] = __builtin_amdgcn_exp2f(X[bb + 1]); X[bb + 2] = __builtin_amdgcn_exp2f(X[bb + 2]); X[bb + 3] = __builtin_amdgcn_exp2f(X[bb + 3]); \
        X[bb + 4] = __builtin_amdgcn_exp2f(X[bb + 4]); X[bb + 5] = __builtin_amdgcn_exp2f(X[bb + 5]); X[bb + 6] = __builtin_amdgcn_exp2f(X[bb + 6]); X[bb + 7] = __builtin_amdgcn_exp2f(X[bb + 7]); \
        ls2 += (f32x2){X[bb + 0], X[bb + 1]}; ls2 += (f32x2){X[bb + 2], X[bb + 3]}; ls2 += (f32x2){X[bb + 4], X[bb + 5]}; ls2 += (f32x2){X[bb + 6], X[bb + 7]}; \
        { v4u w_; w_.x = pk2(X[bb + 0], X[bb + 1]); w_.y = pk2(X[bb + 2], X[bb + 3]); w_.z = pk2(X[bb + 4], X[bb + 5]); w_.w = pk2(X[bb + 6], X[bb + 7]); PF = __builtin_bit_cast(bf16x8, w_); } } while (0)
#define A6_VLD(buf, ss) do { _Pragma("unroll") for (int db = 0; db < NDB; ++db) { vl[buf][db] = vtr(sb + vbase + (16 * (ss)) * VROWB + 64 * db); vh[buf][db] = vtr(sb + vbase + (16 * (ss) + 8) * VROWB + 64 * db); } } while (0)
#define A6_MMA(buf, ss) do { _Pragma("unroll") for (int db = 0; db < NDB; ++db) { const bf16x8 vf_ = __builtin_shufflevector(vl[buf][db], vh[buf][db], 0, 1, 2, 3, 4, 5, 6, 7); o[db] = MFMA32(vf_, pf[ss], o[db]); } } while (0)
#define A6_SGB(nv) do { _Pragma("unroll") for (int db = 0; db < NDB; ++db) { __builtin_amdgcn_sched_group_barrier(0x008, 1, 0); __builtin_amdgcn_sched_group_barrier(A6_VMASK, (nv), 0); __builtin_amdgcn_sched_group_barrier(0x100, 2, 0); } } while (0)
            A6_VLD(0, 0);
            A6_EXP(x0, 0, pf[0]);
            __builtin_amdgcn_sched_barrier(0);
            A6_VLD(1, 1); A6_EXP(x0, 8, pf[1]); A6_MMA(0, 0); A6_SGB(16 / NDB);
            __builtin_amdgcn_sched_barrier(0);
            A6_VLD(0, 2); A6_EXP(x1, 0, pf[2]); A6_MMA(1, 1); A6_SGB(16 / NDB);
            __builtin_amdgcn_sched_barrier(0);
            A6_VLD(1, 3); A6_EXP(x1, 8, pf[3]); A6_MMA(0, 2); A6_SGB(16 / NDB);
            __builtin_amdgcn_sched_barrier(0);
            A6_MMA(1, 3);
            __builtin_amdgcn_sched_barrier(0);
            l_run += ls2[0] + ls2[1];
#undef A6_EXP
#undef A6_VLD
#undef A6_MMA
#undef A6_SGB
            ATT_SETPRIO(0);
        }
        if (more) ATT_WRITE(t + 1);
        __syncthreads();
    }
#undef ATT_ISSUE
#undef ATT_WRITE
#if ATT_STATIC_PRIO
    __builtin_amdgcn_s_setprio(0);
#endif
    const float lt = l_run + shx(l_run, 32, lane), inv = 1.0f / lt;
    if (COMB == 2) {
        const bf16* ip = P.TI + (tok0 + qrow) * (long)P.ldo + ocol + 4 * h; float ss = 0.f;
#pragma unroll
        for (int db = 0; db < NDB; ++db)
#pragma unroll
            for (int g = 0; g < 4; ++g) { const v2u a = *(const v2u*)(ip + 32 * db + 8 * g);
                const float c0 = bflo(a.x) - P.lam * (o[db][4 * g] * inv), c1 = bfhi(a.x) - P.lam * (o[db][4 * g + 1] * inv), c2 = bflo(a.y) - P.lam * (o[db][4 * g + 2] * inv), c3 = bfhi(a.y) - P.lam * (o[db][4 * g + 3] * inv);
                o[db][4 * g] = c0; o[db][4 * g + 1] = c1; o[db][4 * g + 2] = c2; o[db][4 * g + 3] = c3; ss += (c0 * c0 + c1 * c1) + (c2 * c2 + c3 * c3); }
        ss += shx(ss, 32, lane);
        const float rr = P.osc / sqrtf(ss * (1.0f / 128.0f) + LN_EPS);
        bf16* op = P.O + (tok0 + qrow) * (long)P.ldo + ocol + 4 * h;
#pragma unroll
        for (int db = 0; db < NDB; ++db)
#pragma unroll
            for (int g = 0; g < 4; ++g) { const f32x4 gg = *(const f32x4*)(P.gsub + 32 * db + 8 * g + 4 * h);
                v2u w; w.x = pk2(o[db][4 * g] * rr * gg[0], o[db][4 * g + 1] * rr * gg[1]); w.y = pk2(o[db][4 * g + 2] * rr * gg[2], o[db][4 * g + 3] * rr * gg[3]);
                *(v2u*)(op + 32 * db + 8 * g) = w; }
        return;
    }
    bf16* op = P.O + (tok0 + qrow) * (long)P.ldo + ocol + 4 * h;
#pragma unroll
    for (int db = 0; db < NDB; ++db)
#pragma unroll
        for (int g = 0; g < 4; ++g) { v2u w; w.x = pk2(o[db][4 * g] * inv, o[db][4 * g + 1] * inv); w.y = pk2(o[db][4 * g + 2] * inv, o[db][4 * g + 3] * inv);
            *(v2u*)(op + 32 * db + 8 * g) = w; }
}

template <int DQK, int KSPLIT, int DV, bool BIAS, int COMB = 0>
__device__ __forceinline__ void attn_unit7(const AttnP& P, int b, int qt, int qcol, int kcol, int vcol, int ocol, int hb, LAS unsigned char* lds, const int tid_in) {
    constexpr int KROWB = DQK * 2 + 16;
    constexpr int VROWB = (DV == 128) ? 320 : 192;
    constexpr int KBYTES = 64 * KROWB, VBYTES = 64 * VROWB, STAGE = KBYTES + VBYTES + 256, LUT_OFF = 2 * STAGE;
    constexpr int ND = DQK / 16, NDB = DV / 32, KCH = DQK / 8, VCH = DV / 8, NKC = 64 * KCH, NVC = 64 * VCH, KL = (NKC + 511) / 512, VL = (NVC + 511) / 512;
    int tid_ = tid_in; asm volatile("" : "+v"(tid_));
    const int tid = tid_, lane = tid & 63, wid = __builtin_amdgcn_readfirstlane(tid >> 6), r = lane & 31, h = lane >> 5;
    const long tok0 = (long)b * SEQ; const int q0 = qt * 256; const int qrow = q0 + wid * 32 + r;
    bf16x8 qf[ND];
    { const bf16* qp = P.Q + (tok0 + qrow) * (long)P.ldq + qcol + 8 * h;
#pragma unroll
      for (int d = 0; d < ND; ++d) qf[d] = *(const bf16x8*)(qp + 16 * d); }
    int posq = 0, posq_min = 0;
    LAS float* lut = (LAS float*)(lds + LUT_OFF);
    if (BIAS) { posq = P.pos[tok0 + qrow]; int mn = posq;
#pragma unroll
        for (int o = 1; o < 64; o <<= 1) { const int t2 = shxi(mn, o, lane); mn = t2 < mn ? t2 : mn; }
        posq_min = mn;
        if (tid < 132) lut[tid] = P.lut[hb * 132 + tid] - P.lut[hb * 132 + 128]; }
    v4u kreg[KL], vreg[VL]; int preg = 0;
#define ATT_ISSUE(t) do { const long trow = tok0 + 64 * (long)(t); \
        _Pragma("unroll") for (int i = 0; i < KL; ++i) { const int c = tid + 512 * i; if (NKC % 512 == 0 || c < NKC) { const int row = c / KCH, col = (c % KCH) * 8; \
            const bf16* src = (col < KSPLIT) ? P.K1 + (trow + row) * (long)P.ldk1 + kcol + col : P.K2 + (trow + row) * (long)P.ldk2 + (col - KSPLIT); kreg[i] = *(const v4u*)src; } } \
        _Pragma("unroll") for (int i = 0; i < VL; ++i) { const int c = tid + 512 * i; if (NVC % 512 == 0 || c < NVC) { const int row = c / VCH, col = (c % VCH) * 8; vreg[i] = *(const v4u*)(P.V + (trow + row) * (long)P.ldv + vcol + col); } } \
        if (BIAS && tid < 64) preg = P.pos[trow + tid]; } while (0)
#define ATT_WRITE(t) do { LAS unsigned char* sb = lds + ((t) & 1) * STAGE; \
        _Pragma("unroll") for (int i = 0; i < KL; ++i) { const int c = tid + 512 * i; if (NKC % 512 == 0 || c < NKC) { const int row = c / KCH, cc = c % KCH; *(LAS v4u*)(sb + row * KROWB + cc * 16) = kreg[i]; } } \
        _Pragma("unroll") for (int i = 0; i < VL; ++i) { const int c = tid + 512 * i; if (NVC % 512 == 0 || c < NVC) { const int row = c / VCH, cc = c % VCH; *(LAS v4u*)(sb + KBYTES + row * VROWB + cc * 16) = vreg[i]; } } \
        if (BIAS && tid < 64) *(LAS int*)(sb + KBYTES + VBYTES + 4 * tid) = preg; } while (0)
    f32x16 o[NDB];
#pragma unroll
    for (int i = 0; i < NDB; ++i)
#pragma unroll
        for (int j = 0; j < 16; ++j) o[i][j] = 0.f;
    float m_run = 0.f, l_run = 0.f;
    f32x16 csp;
    { const float c0_ = BIAS ? P.lut[hb * 132 + 128] : 0.f;
#pragma unroll
      for (int j = 0; j < 16; ++j) csp[j] = c0_; }
    const int ntiles = (q0 + 256) / 64, my_last = (q0 + wid * 32 + 31) / 64;
#if ATT_STATIC_PRIO
    if (wid >= 4) __builtin_amdgcn_s_setprio(1);
#endif
    ATT_ISSUE(0); ATT_WRITE(0); __syncthreads();
    const int kbase = r * KROWB + 16 * h;
    const int vbase = KBYTES + (4 * h + ((lane & 15) >> 2)) * VROWB + (((lane >> 4) & 1) * 16 + (lane & 3) * 4) * 2;
    for (int t = 0; t < ntiles; ++t) {
        const bool more = (t + 1 < ntiles);
        if (more) ATT_ISSUE(t + 1);
        if (t <= my_last) {
            const LAS unsigned char* sb = lds + (t & 1) * STAGE;
            bool plain = (64 * t + 63 <= q0 + wid * 32);
            if (BIAS) { const int kmax = P.blkmax[(int)(tok0 >> 6) + t]; if (!(plain && (posq_min - kmax >= 113))) plain = false; }
            f32x16 x0 = csp, x1 = csp;
            ATT_SETPRIO(1);
            { bf16x8 kf0[ND], kf1[ND];
#pragma unroll
              for (int d = 0; d < ND; ++d) { kf0[d] = *(const LAS bf16x8*)(sb + kbase + d * 32); kf1[d] = *(const LAS bf16x8*)(sb + kbase + 32 * KROWB + d * 32); }
              __builtin_amdgcn_sched_barrier(0);
#pragma unroll
              for (int d = 0; d < ND; ++d) { x0 = MFMA32(kf0[d], qf[d], x0); x1 = MFMA32(kf1[d], qf[d], x1); } }
            ATT_SETPRIO(0);
            if (!plain) {
#pragma unroll
                for (int g = 0; g < 4; ++g) {
                    int pk0[4] = {0, 0, 0, 0}, pk1[4] = {0, 0, 0, 0};
                    if (BIAS) { const LAS int* pp = (const LAS int*)(sb + KBYTES + VBYTES) + 8 * g + 4 * h;
                        const v4u a = *(const LAS v4u*)pp, c = *(const LAS v4u*)(pp + 32);
                        pk0[0] = a.x; pk0[1] = a.y; pk0[2] = a.z; pk0[3] = a.w; pk1[0] = c.x; pk1[1] = c.y; pk1[2] = c.z; pk1[3] = c.w; }
#pragma unroll
                    for (int j = 0; j < 4; ++j) { const int i = 4 * g + j; const int kidx = 64 * t + 8 * g + 4 * h + j;
                        float v0 = x0[i], v1 = x1[i];
                        if (BIAS) { int n0 = posq - pk0[j]; n0 = n0 < 0 ? 0 : (n0 > 128 ? 128 : n0); int n1 = posq - pk1[j]; n1 = n1 < 0 ? 0 : (n1 > 128 ? 128 : n1); v0 += lut[n0]; v1 += lut[n1]; }
                        if (kidx > qrow) v0 = -INFINITY; if (kidx + 32 > qrow) v1 = -INFINITY;
                        x0[i] = v0; x1[i] = v1; }
                }
            }
            float ma = fmaxf(fmaxf(x0[0], x0[1]), x0[2]), mb = fmaxf(fmaxf(x1[0], x1[1]), x1[2]);
#pragma unroll
            for (int j = 3; j < 15; j += 2) { ma = fmaxf(fmaxf(ma, x0[j]), x0[j + 1]); mb = fmaxf(fmaxf(mb, x1[j]), x1[j + 1]); }
            float mx = fmaxf(fmaxf(ma, mb), fmaxf(x0[15], x1[15]));
            { const auto rr = __builtin_amdgcn_permlane32_swap(__float_as_uint(mx), __float_as_uint(mx), false, false); mx = fmaxf(__uint_as_float(rr[0]), __uint_as_float(rr[1])); }
            if (t == 0 || __any(mx > 8.0f)) {
                const float delta = (t == 0) ? mx : fmaxf(mx, 0.f);
                if (t != 0) { const float alpha = __builtin_amdgcn_exp2f(-delta); l_run *= alpha;
#pragma unroll
                    for (int i = 0; i < NDB; ++i) o[i] = o[i] * alpha; }
                m_run += delta;
#pragma unroll
                for (int j = 0; j < 16; ++j) { x0[j] -= delta; x1[j] -= delta; csp[j] -= delta; }
            }
            f32x2 ls2 = {0.f, 0.f};
            bf16x8 pf[4];
            s16x4 vl[2][NDB], vh[2][NDB];
#define A6_EXP(X, bb, PF) do { \
        X[bb + 0] = __builtin_amdgcn_exp2f(X[bb + 0]); X[bb + 1] = __builtin_amdgcn_exp2f(X[bb + 1]); X[bb + 2] = __builtin_amdgcn_exp2f(X[bb + 2]); X[bb + 3] = __builtin_amdgcn_exp2f(X[bb + 3]); \
        X[bb + 4] = __builtin_amdgcn_exp2f(X[bb + 4]); X[bb + 5] = __builtin_amdgcn_exp2f(X[bb + 5]); X[bb + 6] = __builtin_amdgcn_exp2f(X[bb + 6]); X[bb + 7] = __builtin_amdgcn_exp2f(X[bb + 7]); \
        ls2 += (f32x2){X[bb + 0], X[bb + 1]}; ls2 += (f32x2){X[bb + 2], X[bb + 3]}; ls2 += (f32x2){X[bb + 4], X[bb + 5]}; ls2 += (f32x2){X[bb + 6], X[bb + 7]}; \
        { v4u w_; w_.x = pk2(X[bb + 0], X[bb + 1]); w_.y = pk2(X[bb + 2], X[bb + 3]); w_.z = pk2(X[bb + 4], X[bb + 5]); w_.w = pk2(X[bb + 6], X[bb + 7]); PF = __builtin_bit_cast(bf16x8, w_); } } while (0)
#define A6_VLD(buf, ss) do { _Pragma("unroll") for (int db = 0; db < NDB; ++db) { vl[buf][db] = vtr(sb + vbase + (16 * (ss)) * VROWB + 64 * db); vh[buf][db] = vtr(sb + vbase + (16 * (ss) + 8) * VROWB + 64 * db); } } while (0)
#define A6_MMA(buf, ss) do { _Pragma("unroll") for (int db = 0; db < NDB; ++db) { const bf16x8 vf_ = __builtin_shufflevector(vl[buf][db], vh[buf][db], 0, 1, 2, 3, 4, 5, 6, 7); o[db] = MFMA32(vf_, pf[ss], o[db]); } } while (0)
#define A6_SGB(nv) do { _Pragma("unroll") for (int db = 0; db < NDB; ++db) { __builtin_amdgcn_sched_group_barrier(0x008, 1, 0); __builtin_amdgcn_sched_group_barrier(A6_VMASK, (nv), 0); __builtin_amdgcn_sched_group_barrier(0x100, 2, 0); } } while (0)
            A6_VLD(0, 0);
            A6_EXP(x0, 0, pf[0]);
            __builtin_amdgcn_sched_barrier(0);
            A6_VLD(1, 1); A6_EXP(x0, 8, pf[1]); A6_MMA(0, 0); A6_SGB(16 / NDB);
            __builtin_amdgcn_sched_barrier(0);
            A6_VLD(0, 2); A6_EXP(x1, 0, pf[2]); A6_MMA(1, 1); A6_SGB(16 / NDB);
            __builtin_amdgcn_sched_barrier(0);
            A6_VLD(1, 3); A6_EXP(x1, 8, pf[3]); A6_MMA(0, 2); A6_SGB(16 / NDB);
            __builtin_amdgcn_sched_barrier(0);
            A6_MMA(1, 3);
            __builtin_amdgcn_sched_barrier(0);
            l_run += ls2[0] + ls2[1];
#undef A6_EXP
#undef A6_VLD
#undef A6_MMA
#undef A6_SGB
            ATT_SETPRIO(0);
        }
        if (more) ATT_WRITE(t + 1);
        __syncthreads();
    }
#undef ATT_ISSUE
#undef ATT_WRITE
#if ATT_STATIC_PRIO
    __builtin_amdgcn_s_setprio(0);
#endif
    const float lt = l_run + shx(l_run, 32, lane), inv = 1.0f / lt;
    if (COMB == 2) {
        const bf16* ip = P.TI + (tok0 + qrow) * (long)P.ldo + ocol + 4 * h; float ss = 0.f;
#pragma unroll
        for (int db = 0; db < NDB; ++db)
#pragma unroll
            for (int g = 0; g < 4; ++g) { const v2u a = *(const v2u*)(ip + 32 * db + 8 * g);
                const float c0 = bflo(a.x) - P.lam * (o[db][4 * g] * inv), c1 = bfhi(a.x) - P.lam * (o[db][4 * g + 1] * inv), c2 = bflo(a.y) - P.lam * (o[db][4 * g + 2] * inv), c3 = bfhi(a.y) - P.lam * (o[db][4 * g + 3] * inv);
                o[db][4 * g] = c0; o[db][4 * g + 1] = c1; o[db][4 * g + 2] = c2; o[db][4 * g + 3] = c3; ss += (c0 * c0 + c1 * c1) + (c2 * c2 + c3 * c3); }
        ss += shx(ss, 32, lane);
        const float rr = P.osc / sqrtf(ss * (1.0f / 128.0f) + LN_EPS);
        bf16* op = P.O + (tok0 + qrow) * (long)P.ldo + ocol + 4 * h;
#pragma unroll
        for (int db = 0; db < NDB; ++db)
#pragma unroll
            for (int g = 0; g < 4; ++g) { const f32x4 gg = *(const f32x4*)(P.gsub + 32 * db + 8 * g + 4 * h);
                v2u w; w.x = pk2(o[db][4 * g] * rr * gg[0], o[db][4 * g + 1] * rr * gg[1]); w.y = pk2(o[db][4 * g + 2] * rr * gg[2], o[db][4 * g + 3] * rr * gg[3]);
                *(v2u*)(op + 32 * db + 8 * g) = w; }
        return;
    }
    bf16* op = P.O + (tok0 + qrow) * (long)P.ldo + ocol + 4 * h;
#pragma unroll
    for (int db = 0; db < NDB; ++db)
#pragma unroll
        for (int g = 0; g < 4; ++g) { v2u w; w.x = pk2(o[db][4 * g] * inv, o[db][4 * g + 1] * inv); w.y = pk2(o[db][4 * g + 2] * inv, o[db][4 * g + 3] * inv);
            *(v2u*)(op + 32 * db + 8 * g) = w; }
}

template <int DQK, int KSPLIT, int DV, bool BIAS, int COMB = 0>
__device__ __forceinline__ void attn_unit8(const AttnP& P, int b, int qt, int qcol, int kcol, int vcol, int ocol, int hb, LAS unsigned char* lds, const int tid_in) {
    constexpr int KROWB = DQK * 2 + 16;
    constexpr int VROWB = (DV == 128) ? 320 : 192;
    constexpr int KBYTES = 64 * KROWB, VBYTES = 64 * VROWB, STAGE = KBYTES + VBYTES + 256, LUT_OFF = 2 * STAGE;
    constexpr int ND = DQK / 16, NDB = DV / 32, KCH = DQK / 8, VCH = DV / 8, NKC = 64 * KCH, NVC = 64 * VCH, KL = (NKC + 511) / 512, VL = (NVC + 511) / 512;
    int tid_ = tid_in; asm volatile("" : "+v"(tid_));
    const int tid = tid_, lane = tid & 63, wid = __builtin_amdgcn_readfirstlane(tid >> 6), r = lane & 31, h = lane >> 5;
    const long tok0 = (long)b * SEQ; const int q0 = qt * 256; const int qrow = q0 + wid * 32 + r;
    bf16x8 qf[ND];
    { const bf16* qp = P.Q + (tok0 + qrow) * (long)P.ldq + qcol + 8 * h;
#pragma unroll
      for (int d = 0; d < ND; ++d) qf[d] = *(const bf16x8*)(qp + 16 * d); }
    int posq = 0, posq_min = 0;
    LAS float* lut = (LAS float*)(lds + LUT_OFF);
    if (BIAS) { posq = P.pos[tok0 + qrow]; int mn = posq;
#pragma unroll
        for (int o = 1; o < 64; o <<= 1) { const int t2 = shxi(mn, o, lane); mn = t2 < mn ? t2 : mn; }
        posq_min = mn;
        if (tid < 132) lut[tid] = P.lut[hb * 132 + tid] - P.lut[hb * 132 + 128]; }
    v4u kreg[KL], vreg[VL]; int preg = 0;
#define ATT_ISSUE(t) do { const long trow = tok0 + 64 * (long)(t); \
        _Pragma("unroll") for (int i = 0; i < KL; ++i) { const int c = tid + 512 * i; if (NKC % 512 == 0 || c < NKC) { const int row = c / KCH, col = (c % KCH) * 8; \
            const bf16* src = (col < KSPLIT) ? P.K1 + (trow + row) * (long)P.ldk1 + kcol + col : P.K2 + (trow + row) * (long)P.ldk2 + (col - KSPLIT); kreg[i] = *(const v4u*)src; } } \
        _Pragma("unroll") for (int i = 0; i < VL; ++i) { const int c = tid + 512 * i; if (NVC % 512 == 0 || c < NVC) { const int row = c / VCH, col = (c % VCH) * 8; vreg[i] = *(const v4u*)(P.V + (trow + row) * (long)P.ldv + vcol + col); } } \
        if (BIAS && tid < 64) preg = P.pos[trow + tid]; } while (0)
#define ATT_WRITE(t) do { LAS unsigned char* sb = lds + ((t) & 1) * STAGE; \
        _Pragma("unroll") for (int i = 0; i < KL; ++i) { const int c = tid + 512 * i; if (NKC % 512 == 0 || c < NKC) { const int row = c / KCH, cc = c % KCH; *(LAS v4u*)(sb + row * KROWB + cc * 16) = kreg[i]; } } \
        _Pragma("unroll") for (int i = 0; i < VL; ++i) { const int c = tid + 512 * i; if (NVC % 512 == 0 || c < NVC) { const int row = c / VCH, cc = c % VCH; *(LAS v4u*)(sb + KBYTES + row * VROWB + cc * 16) = vreg[i]; } } \
        if (BIAS && tid < 64) *(LAS int*)(sb + KBYTES + VBYTES + 4 * tid) = preg; } while (0)
    f32x16 o[NDB];
#pragma unroll
    for (int i = 0; i < NDB; ++i)
#pragma unroll
        for (int j = 0; j < 16; ++j) o[i][j] = 0.f;
    float m_run = 0.f, l_run = 0.f;
    f32x16 csp;
    { const float c0_ = BIAS ? P.lut[hb * 132 + 128] : 0.f;
#pragma unroll
      for (int j = 0; j < 16; ++j) csp[j] = c0_; }
    const int ntiles = (q0 + 256) / 64, my_last = (q0 + wid * 32 + 31) / 64;
#if ATT_STATIC_PRIO
    if (wid >= 4) __builtin_amdgcn_s_setprio(1);
#endif
    ATT_ISSUE(0); ATT_WRITE(0); __syncthreads();
    const int kbase = r * KROWB + 16 * h;
    const int vbase = KBYTES + (4 * h + ((lane & 15) >> 2)) * VROWB + (((lane >> 4) & 1) * 16 + (lane & 3) * 4) * 2;
    for (int t = 0; t < ntiles; ++t) {
        const bool more = (t + 1 < ntiles);
        if (more) ATT_ISSUE(t + 1);
        if (t <= my_last) {
            const LAS unsigned char* sb = lds + (t & 1) * STAGE;
            bool plain = (64 * t + 63 <= q0 + wid * 32);
            if (BIAS) { const int kmax = P.blkmax[(int)(tok0 >> 6) + t]; if (!(plain && (posq_min - kmax >= 113))) plain = false; }
            f32x16 x0 = csp, x1 = csp;
            ATT_SETPRIO(1);
            { bf16x8 kf0[ND], kf1[ND];
#pragma unroll
              for (int d = 0; d < ND; ++d) { kf0[d] = *(const LAS bf16x8*)(sb + kbase + d * 32); kf1[d] = *(const LAS bf16x8*)(sb + kbase + 32 * KROWB + d * 32); }
              __builtin_amdgcn_sched_barrier(0);
#pragma unroll
              for (int d = 0; d < ND; ++d) { x0 = MFMA32(kf0[d], qf[d], x0); x1 = MFMA32(kf1[d], qf[d], x1); } }
            ATT_SETPRIO(0);
            if (!plain) {
                const int qrel = qrow - 64 * t - 4 * h;
#pragma unroll
                for (int g = 0; g < 4; ++g) {
                    int pk0[4] = {0, 0, 0, 0}, pk1[4] = {0, 0, 0, 0};
                    if (BIAS) { const LAS int* pp = (const LAS int*)(sb + KBYTES + VBYTES) + 8 * g + 4 * h;
                        const v4u a = *(const LAS v4u*)pp, c = *(const LAS v4u*)(pp + 32);
                        pk0[0] = a.x; pk0[1] = a.y; pk0[2] = a.z; pk0[3] = a.w; pk1[0] = c.x; pk1[1] = c.y; pk1[2] = c.z; pk1[3] = c.w; }
#pragma unroll
                    for (int j = 0; j < 4; ++j) { const int i = 4 * g + j;
                        float v0 = x0[i], v1 = x1[i];
                        if (BIAS) { int n0 = posq - pk0[j]; n0 = n0 < 0 ? 0 : (n0 > 128 ? 128 : n0); int n1 = posq - pk1[j]; n1 = n1 < 0 ? 0 : (n1 > 128 ? 128 : n1); v0 += lut[n0]; v1 += lut[n1]; }
                        if (8 * g + j > qrel) v0 = -INFINITY; if (8 * g + j + 32 > qrel) v1 = -INFINITY;
                        x0[i] = v0; x1[i] = v1; }
                }
            }
            if (t == 0) {
                float ma = fmaxf(fmaxf(x0[0], x0[1]), x0[2]), mb = fmaxf(fmaxf(x1[0], x1[1]), x1[2]);
#pragma unroll
                for (int j = 3; j < 15; j += 2) { ma = fmaxf(fmaxf(ma, x0[j]), x0[j + 1]); mb = fmaxf(fmaxf(mb, x1[j]), x1[j + 1]); }
                float mx = fmaxf(fmaxf(ma, mb), fmaxf(x0[15], x1[15]));
                { const auto rr = __builtin_amdgcn_permlane32_swap(__float_as_uint(mx), __float_as_uint(mx), false, false); mx = fmaxf(__uint_as_float(rr[0]), __uint_as_float(rr[1])); }
                m_run += mx;
#pragma unroll
                for (int j = 0; j < 16; ++j) { x0[j] -= mx; x1[j] -= mx; csp[j] -= mx; }
            }
            f32x2 ls2 = {0.f, 0.f};
            bf16x8 pf[4];
            s16x4 vl[2][NDB], vh[2][NDB];
#define A6_EXP(X, bb, PF) do { \
        X[bb + 0] = __builtin_amdgcn_exp2f(X[bb + 0]); X[bb + 1] = __builtin_amdgcn_exp2f(X[bb + 1]); X[bb + 2] = __builtin_amdgcn_exp2f(X[bb + 2]); X[bb + 3] = __builtin_amdgcn_exp2f(X[bb + 3]); \
        X[bb + 4] = __builtin_amdgcn_exp2f(X[bb + 4]); X[bb + 5] = __builtin_amdgcn_exp2f(X[bb + 5]); X[bb + 6] = __builtin_amdgcn_exp2f(X[bb + 6]); X[bb + 7] = __builtin_amdgcn_exp2f(X[bb + 7]); \
        ls2 += (f32x2){X[bb + 0], X[bb + 1]}; ls2 += (f32x2){X[bb + 2], X[bb + 3]}; ls2 += (f32x2){X[bb + 4], X[bb + 5]}; ls2 += (f32x2){X[bb + 6], X[bb + 7]}; \
        { v4u w_; w_.x = pk2(X[bb + 0], X[bb + 1]); w_.y = pk2(X[bb + 2], X[bb + 3]); w_.z = pk2(X[bb + 4], X[bb + 5]); w_.w = pk2(X[bb + 6], X[bb + 7]); PF = __builtin_bit_cast(bf16x8, w_); } } while (0)
#define A6_VLD(buf, ss) do { _Pragma("unroll") for (int db = 0; db < NDB; ++db) { vl[buf][db] = vtr(sb + vbase + (16 * (ss)) * VROWB + 64 * db); vh[buf][db] = vtr(sb + vbase + (16 * (ss) + 8) * VROWB + 64 * db); } } while (0)
#define A6_MMA(buf, ss) do { _Pragma("unroll") for (int db = 0; db < NDB; ++db) { const bf16x8 vf_ = __builtin_shufflevector(vl[buf][db], vh[buf][db], 0, 1, 2, 3, 4, 5, 6, 7); o[db] = MFMA32(vf_, pf[ss], o[db]); } } while (0)
#define A6_SGB(nv) do { _Pragma("unroll") for (int db = 0; db < NDB; ++db) { __builtin_amdgcn_sched_group_barrier(0x008, 1, 0); __builtin_amdgcn_sched_group_barrier(A6_VMASK, (nv), 0); __builtin_amdgcn_sched_group_barrier(0x100, 2, 0); } } while (0)
            A6_VLD(0, 0);
            A6_EXP(x0, 0, pf[0]);
            __builtin_amdgcn_sched_barrier(0);
            A6_VLD(1, 1); A6_EXP(x0, 8, pf[1]); A6_MMA(0, 0); A6_SGB(16 / NDB);
            __builtin_amdgcn_sched_barrier(0);
            A6_VLD(0, 2); A6_EXP(x1, 0, pf[2]); A6_MMA(1, 1); A6_SGB(16 / NDB);
            __builtin_amdgcn_sched_barrier(0);
            A6_VLD(1, 3); A6_EXP(x1, 8, pf[3]); A6_MMA(0, 2); A6_SGB(16 / NDB);
            __builtin_amdgcn_sched_barrier(0);
            A6_MMA(1, 3);
            __builtin_amdgcn_sched_barrier(0);
            { const float ls = ls2[0] + ls2[1];
              l_run += ls;
              if (t != 0 && __any(ls > 256.0f)) {
                  float ma = fmaxf(fmaxf(x0[0], x0[1]), x0[2]), mb = fmaxf(fmaxf(x1[0], x1[1]), x1[2]);
#pragma unroll
                  for (int j = 3; j < 15; j += 2) { ma = fmaxf(fmaxf(ma, x0[j]), x0[j + 1]); mb = fmaxf(fmaxf(mb, x1[j]), x1[j + 1]); }
                  float mp = fmaxf(fmaxf(ma, mb), fmaxf(x0[15], x1[15]));
                  { const auto rr = __builtin_amdgcn_permlane32_swap(__float_as_uint(mp), __float_as_uint(mp), false, false); mp = fmaxf(__uint_as_float(rr[0]), __uint_as_float(rr[1])); }
                  const float delta = fmaxf(__builtin_amdgcn_logf(mp), 0.f), alpha = __builtin_amdgcn_exp2f(-delta);
                  l_run *= alpha; m_run += delta;
#pragma unroll
                  for (int i = 0; i < NDB; ++i) o[i] = o[i] * alpha;
#pragma unroll
                  for (int j = 0; j < 16; ++j) csp[j] -= delta;
              } }
#undef A6_EXP
#undef A6_VLD
#undef A6_MMA
#undef A6_SGB
            ATT_SETPRIO(0);
        }
        if (more) ATT_WRITE(t + 1);
        __syncthreads();
    }
#undef ATT_ISSUE
#undef ATT_WRITE
#if ATT_STATIC_PRIO
    __builtin_amdgcn_s_setprio(0);
#endif
    const float lt = l_run + shx(l_run, 32, lane), inv = 1.0f / lt;
    if (COMB == 2) {
        const bf16* ip = P.TI + (tok0 + qrow) * (long)P.ldo + ocol + 4 * h; float ss = 0.f;
#pragma unroll
        for (int db = 0; db < NDB; ++db)
#pragma unroll
            for (int g = 0; g < 4; ++g) { const v2u a = *(const v2u*)(ip + 32 * db + 8 * g);
                const float c0 = bflo(a.x) - P.lam * (o[db][4 * g] * inv), c1 = bfhi(a.x) - P.lam * (o[db][4 * g + 1] * inv), c2 = bflo(a.y) - P.lam * (o[db][4 * g + 2] * inv), c3 = bfhi(a.y) - P.lam * (o[db][4 * g + 3] * inv);
                o[db][4 * g] = c0; o[db][4 * g + 1] = c1; o[db][4 * g + 2] = c2; o[db][4 * g + 3] = c3; ss += (c0 * c0 + c1 * c1) + (c2 * c2 + c3 * c3); }
        ss += shx(ss, 32, lane);
        const float rr = P.osc / sqrtf(ss * (1.0f / 128.0f) + LN_EPS);
        bf16* op = P.O + (tok0 + qrow) * (long)P.ldo + ocol + 4 * h;
#pragma unroll
        for (int db = 0; db < NDB; ++db)
#pragma unroll
            for (int g = 0; g < 4; ++g) { const f32x4 gg = *(const f32x4*)(P.gsub + 32 * db + 8 * g + 4 * h);
                v2u w; w.x = pk2(o[db][4 * g] * rr * gg[0], o[db][4 * g + 1] * rr * gg[1]); w.y = pk2(o[db][4 * g + 2] * rr * gg[2], o[db][4 * g + 3] * rr * gg[3]);
                *(v2u*)(op + 32 * db + 8 * g) = w; }
        return;
    }
    bf16* op = P.O + (tok0 + qrow) * (long)P.ldo + ocol + 4 * h;
#pragma unroll
    for (int db = 0; db < NDB; ++db)
#pragma unroll
        for (int g = 0; g < 4; ++g) { v2u w; w.x = pk2(o[db][4 * g] * inv, o[db][4 * g + 1] * inv); w.y = pk2(o[db][4 * g + 2] * inv, o[db][4 * g + 3] * inv);
            *(v2u*)(op + 32 * db + 8 * g) = w; }
}

template <int KL, int VL, int ND> struct AttPre { v4u kA[KL], vA[VL], kB[KL], vB[VL]; int pA, pB; bf16x8 q[ND]; int posq; float lv, c0; int bv; bool valid; };
template <int DQK, int DV> struct AttPreOf { static constexpr int KCH = DQK / 8, VCH = DV / 8; typedef AttPre<(64 * KCH + 511) / 512, (64 * VCH + 511) / 512, DQK / 16> type; };
template <int DQK, int KSPLIT, int DV, bool BIAS, int COMB = 0, int VAR = 0>
__device__ __forceinline__ void attn_unit10(const AttnP& P, int b, int qt, int qcol, int kcol, int vcol, int ocol, int hb, LAS unsigned char* lds, const int tid_in,
                                            typename AttPreOf<DQK, DV>::type& pre, const bool has_next, const int nb, const int nqt, const int nqcol, const int nkcol, const int nvcol, const int nhb) {
    constexpr int KROWB = DQK * 2 + 16;
    constexpr int VROWB = (DV == 128) ? 320 : 192;
    constexpr int KBYTES = 64 * KROWB, VBYTES = 64 * VROWB, STAGE = KBYTES + VBYTES + 256, LUT_OFF = 4 * STAGE;
    constexpr int ND = DQK / 16, NDB = DV / 32, KCH = DQK / 8, VCH = DV / 8, NKC = 64 * KCH, NVC = 64 * VCH, KL = (NKC + 511) / 512, VL = (NVC + 511) / 512;
    int tid_ = tid_in; asm volatile("" : "+v"(tid_));
    const int tid = tid_, lane = tid & 63, wid = __builtin_amdgcn_readfirstlane(tid >> 6), r = lane & 31, h = lane >> 5;
    const long tok0 = (long)b * SEQ; const int q0 = qt * 256; const int qrow = q0 + wid * 32 + r;
    v4u (&kregA)[KL] = pre.kA; v4u (&vregA)[VL] = pre.vA; v4u (&kregB)[KL] = pre.kB; v4u (&vregB)[VL] = pre.vB; int& pregA = pre.pA; int& pregB = pre.pB;
#define ATT_ISSUE1X(t, kreg, vreg, preg, TOK0_, KCOL_, VCOL_) do { const long trow = (TOK0_) + 64 * (long)(t); \
        _Pragma("unroll") for (int i = 0; i < KL; ++i) { const int c = tid + 512 * i; if (NKC % 512 == 0 || c < NKC) { const int row = c / KCH, col = (c % KCH) * 8; \
            const bf16* src = (col < KSPLIT) ? P.K1 + (trow + row) * (long)P.ldk1 + (KCOL_) + col : P.K2 + (trow + row) * (long)P.ldk2 + (col - KSPLIT); kreg[i] = *(const v4u*)src; } } \
        _Pragma("unroll") for (int i = 0; i < VL; ++i) { const int c = tid + 512 * i; if (NVC % 512 == 0 || c < NVC) { const int row = c / VCH, col = (c % VCH) * 8; vreg[i] = *(const v4u*)(P.V + (trow + row) * (long)P.ldv + (VCOL_) + col); } } \
        if (BIAS && tid < 64) preg = P.pos[trow + tid]; } while (0)
#define ATT_ISSUE1(t, kreg, vreg, preg) ATT_ISSUE1X(t, kreg, vreg, preg, tok0, kcol, vcol)
#define ATT_PRELOAD(TOK0_, QROW_, QCOL_, KCOL_, VCOL_, HB_) do { ATT_ISSUE1X(0, kregA, vregA, pregA, TOK0_, KCOL_, VCOL_); ATT_ISSUE1X(1, kregB, vregB, pregB, TOK0_, KCOL_, VCOL_); \
        { const bf16* qp = P.Q + ((TOK0_) + (QROW_)) * (long)P.ldq + (QCOL_) + 8 * h; _Pragma("unroll") for (int d = 0; d < ND; ++d) pre.q[d] = *(const bf16x8*)(qp + 16 * d); } \
        pre.posq = 0; pre.lv = 0.f; pre.bv = 0; pre.c0 = 0.f; \
        if (BIAS) { pre.posq = P.pos[(TOK0_) + (QROW_)]; if (tid < 132) pre.lv = P.lut[(HB_) * 132 + tid]; if (tid >= 192 && tid < 256) pre.bv = P.blkmax[(int)((TOK0_) >> 6) + (tid - 192)]; \
                    pre.c0 = P.lut[(HB_) * 132 + 128]; } } while (0)
#define ATT_WRITE1(t, kreg, vreg, preg) do { LAS unsigned char* sb = lds + ((t) & 3) * STAGE; \
        _Pragma("unroll") for (int i = 0; i < KL; ++i) { const int c = tid + 512 * i; if (NKC % 512 == 0 || c < NKC) { const int row = c / KCH, cc = c % KCH; *(LAS v4u*)(sb + row * KROWB + cc * 16) = kreg[i]; } } \
        _Pragma("unroll") for (int i = 0; i < VL; ++i) { const int c = tid + 512 * i; if (NVC % 512 == 0 || c < NVC) { const int row = c / VCH, cc = c % VCH; *(LAS v4u*)(sb + KBYTES + row * VROWB + cc * 16) = vreg[i]; } } \
        if (BIAS && tid < 64) *(LAS int*)(sb + KBYTES + VBYTES + 4 * tid) = preg; } while (0)
#define ATT_ISSUE(T2) do { ATT_ISSUE1(2 * (T2), kregA, vregA, pregA); ATT_ISSUE1(2 * (T2) + 1, kregB, vregB, pregB); } while (0)
#define ATT_WRITE(T2) do { ATT_WRITE1(2 * (T2), kregA, vregA, pregA); ATT_WRITE1(2 * (T2) + 1, kregB, vregB, pregB); } while (0)
    if (!pre.valid) ATT_PRELOAD(tok0, qrow, qcol, kcol, vcol, hb);
    bf16x8 (&qf)[ND] = pre.q;
    int posq = 0, posq_min = 0;
    LAS float* lut = (LAS float*)(lds + LUT_OFF); LAS int* bmx = (LAS int*)(lds + LUT_OFF + 1024);
    if (BIAS) { posq = pre.posq; int mn = posq;
#pragma unroll
        for (int o = 1; o < 64; o <<= 1) { const int t2 = shxi(mn, o, lane); mn = t2 < mn ? t2 : mn; }
        posq_min = mn;
        if (tid < 132) lut[tid] = pre.lv - pre.c0;
        if (tid >= 192 && tid < 256) bmx[tid - 192] = pre.bv; }
    f32x16 o[NDB];
#pragma unroll
    for (int i = 0; i < NDB; ++i)
#pragma unroll
        for (int j = 0; j < 16; ++j) o[i][j] = 0.f;
    float m_run = 0.f, l_run = 0.f;
    f32x16 csp;
    { const float c0_ = BIAS ? pre.c0 : 0.f;
#pragma unroll
      for (int j = 0; j < 16; ++j) csp[j] = c0_; }
    const int ntiles = (q0 + 256) / 64, my_last = (q0 + wid * 32 + 31) / 64;
#if ATT_STATIC_PRIO
    if (wid >= 4) __builtin_amdgcn_s_setprio(1);
#endif
    ATT_WRITE(0); __syncthreads();
    const int kbase = r * KROWB + 16 * h;
    const int vbase = KBYTES + (4 * h + ((lane & 15) >> 2)) * VROWB + (((lane >> 4) & 1) * 16 + (lane & 3) * 4) * 2;
    for (int T2 = 0; T2 < ntiles / 2; ++T2) {
        const bool more = (2 * T2 + 2 < ntiles);
        if (more && !(VAR & 8)) ATT_ISSUE(T2 + 1);
#pragma unroll 1
        for (int u_ = 0; u_ < 2; ++u_) {
        const int t = 2 * T2 + u_;
        if (t <= my_last) {
            const LAS unsigned char* sb = lds + (t & 3) * STAGE;
            bool plain = (64 * t + 63 <= q0 + wid * 32);
            if (BIAS) { const int kmax = bmx[t]; if (!(plain && (posq_min - kmax >= 113))) plain = false; }
            f32x16 x0 = csp, x1 = csp;
            ATT_SETPRIO(1);
            if (!(VAR & 4)) { bf16x8 kf0[ND], kf1[ND];
#pragma unroll
              for (int d = 0; d < ND; ++d) { kf0[d] = *(const LAS bf16x8*)(sb + kbase + d * 32); kf1[d] = *(const LAS bf16x8*)(sb + kbase + 32 * KROWB + d * 32); }
              __builtin_amdgcn_sched_barrier(0);
#pragma unroll
              for (int d = 0; d < ND; ++d) { x0 = MFMA32(kf0[d], qf[d], x0); x1 = MFMA32(kf1[d], qf[d], x1); } }
            ATT_SETPRIO(0);
            if (!plain) {
                const int qrel = qrow - 64 * t - 4 * h;
#pragma unroll
                for (int g = 0; g < 4; ++g) {
                    int pk0[4] = {0, 0, 0, 0}, pk1[4] = {0, 0, 0, 0};
                    if (BIAS) { const LAS int* pp = (const LAS int*)(sb + KBYTES + VBYTES) + 8 * g + 4 * h;
                        const v4u a = *(const LAS v4u*)pp, c = *(const LAS v4u*)(pp + 32);
                        pk0[0] = a.x; pk0[1] = a.y; pk0[2] = a.z; pk0[3] = a.w; pk1[0] = c.x; pk1[1] = c.y; pk1[2] = c.z; pk1[3] = c.w; }
#pragma unroll
                    for (int j = 0; j < 4; ++j) { const int i = 4 * g + j;
                        float v0 = x0[i], v1 = x1[i];
                        if (BIAS) { int n0 = posq - pk0[j]; n0 = n0 < 0 ? 0 : (n0 > 128 ? 128 : n0); int n1 = posq - pk1[j]; n1 = n1 < 0 ? 0 : (n1 > 128 ? 128 : n1); v0 += lut[n0]; v1 += lut[n1]; }
                        if (8 * g + j > qrel) v0 = -INFINITY; if (8 * g + j + 32 > qrel) v1 = -INFINITY;
                        x0[i] = v0; x1[i] = v1; }
                }
            }
            if (t == 0) {
                float ma = fmaxf(fmaxf(x0[0], x0[1]), x0[2]), mb = fmaxf(fmaxf(x1[0], x1[1]), x1[2]);
#pragma unroll
                for (int j = 3; j < 15; j += 2) { ma = fmaxf(fmaxf(ma, x0[j]), x0[j + 1]); mb = fmaxf(fmaxf(mb, x1[j]), x1[j + 1]); }
                float mx = fmaxf(fmaxf(ma, mb), fmaxf(x0[15], x1[15]));
                { const auto rr = __builtin_amdgcn_permlane32_swap(__float_as_uint(mx), __float_as_uint(mx), false, false); mx = fmaxf(__uint_as_float(rr[0]), __uint_as_float(rr[1])); }
                m_run += mx;
#pragma unroll
                for (int j = 0; j < 16; ++j) { x0[j] -= mx; x1[j] -= mx; csp[j] -= mx; }
            }
            f32x2 ls2 = {0.f, 0.f};
            bf16x8 pf[4];
            s16x4 vl[2][NDB], vh[2][NDB];
#define A6_E2(v_) ((VAR & 1) ? (v_) : __builtin_amdgcn_exp2f(v_))
#define A6_EXP(X, bb, PF) do { \
        X[bb + 0] = A6_E2(X[bb + 0]); X[bb + 1] = A6_E2(X[bb + 1]); X[bb + 2] = A6_E2(X[bb + 2]); X[bb + 3] = A6_E2(X[bb + 3]); \
        X[bb + 4] = A6_E2(X[bb + 4]); X[bb + 5] = A6_E2(X[bb + 5]); X[bb + 6] = A6_E2(X[bb + 6]); X[bb + 7] = A6_E2(X[bb + 7]); \
        ls2 += (f32x2){X[bb + 0], X[bb + 1]}; ls2 += (f32x2){X[bb + 2], X[bb + 3]}; ls2 += (f32x2){X[bb + 4], X[bb + 5]}; ls2 += (f32x2){X[bb + 6], X[bb + 7]}; \
        { v4u w_; w_.x = pk2(X[bb + 0], X[bb + 1]); w_.y = pk2(X[bb + 2], X[bb + 3]); w_.z = pk2(X[bb + 4], X[bb + 5]); w_.w = pk2(X[bb + 6], X[bb + 7]); PF = __builtin_bit_cast(bf16x8, w_); } } while (0)
#define A6_VLD(buf, ss) do { _Pragma("unroll") for (int db = 0; db < NDB; ++db) { vl[buf][db] = vtr(sb + vbase + (16 * (ss)) * VROWB + 64 * db); vh[buf][db] = vtr(sb + vbase + (16 * (ss) + 8) * VROWB + 64 * db); } } while (0)
#define A6_MMA(buf, ss) do { if (VAR & 2) break; _Pragma("unroll") for (int db = 0; db < NDB; ++db) { const bf16x8 vf_ = __builtin_shufflevector(vl[buf][db], vh[buf][db], 0, 1, 2, 3, 4, 5, 6, 7); o[db] = MFMA32(vf_, pf[ss], o[db]); } } while (0)
#define A6_SGB(nv) do { _Pragma("unroll") for (int db = 0; db < NDB; ++db) { __builtin_amdgcn_sched_group_barrier(0x008, 1, 0); __builtin_amdgcn_sched_group_barrier(A6_VMASK, (nv), 0); __builtin_amdgcn_sched_group_barrier(0x100, 2, 0); } } while (0)
            A6_VLD(0, 0);
            A6_EXP(x0, 0, pf[0]);
            __builtin_amdgcn_sched_barrier(0);
            A6_VLD(1, 1); A6_EXP(x0, 8, pf[1]); A6_MMA(0, 0); A6_SGB(16 / NDB);
            __builtin_amdgcn_sched_barrier(0);
            A6_VLD(0, 2); A6_EXP(x1, 0, pf[2]); A6_MMA(1, 1); A6_SGB(16 / NDB);
            __builtin_amdgcn_sched_barrier(0);
            A6_VLD(1, 3); A6_EXP(x1, 8, pf[3]); A6_MMA(0, 2); A6_SGB(16 / NDB);
            __builtin_amdgcn_sched_barrier(0);
            A6_MMA(1, 3);
            __builtin_amdgcn_sched_barrier(0);
            { const float ls = ls2[0] + ls2[1];
              l_run += ls;
              if (t != 0 && __any(ls > 256.0f)) {
                  float ma = fmaxf(fmaxf(x0[0], x0[1]), x0[2]), mb = fmaxf(fmaxf(x1[0], x1[1]), x1[2]);
#pragma unroll
                  for (int j = 3; j < 15; j += 2) { ma = fmaxf(fmaxf(ma, x0[j]), x0[j + 1]); mb = fmaxf(fmaxf(mb, x1[j]), x1[j + 1]); }
                  float mp = fmaxf(fmaxf(ma, mb), fmaxf(x0[15], x1[15]));
                  { const auto rr = __builtin_amdgcn_permlane32_swap(__float_as_uint(mp), __float_as_uint(mp), false, false); mp = fmaxf(__uint_as_float(rr[0]), __uint_as_float(rr[1])); }
                  const float delta = fmaxf(__builtin_amdgcn_logf(mp), 0.f), alpha = __builtin_amdgcn_exp2f(-delta);
                  l_run *= alpha; m_run += delta;
#pragma unroll
                  for (int i = 0; i < NDB; ++i) o[i] = o[i] * alpha;
#pragma unroll
                  for (int j = 0; j < 16; ++j) csp[j] -= delta;
              } }
#undef A6_EXP
#undef A6_E2
#undef A6_VLD
#undef A6_MMA
#undef A6_SGB
            ATT_SETPRIO(0);
        }
        }
        if (more && !(VAR & 8)) ATT_WRITE(T2 + 1);
        if (!(VAR & 16)) __syncthreads();
    }
#if ATT_STATIC_PRIO
    __builtin_amdgcn_s_setprio(0);
#endif
    const long rowoff = (tok0 + qrow) * (long)P.ldo + ocol + 8 * h;
    v4u tiq[NDB][2];
    if (COMB == 2) { const bf16* ip = P.TI + rowoff;
#pragma unroll
        for (int db = 0; db < NDB; ++db)
#pragma unroll
            for (int gp = 0; gp < 2; ++gp) tiq[db][gp] = *(const v4u*)(ip + 32 * db + 16 * gp); }
    __builtin_amdgcn_sched_barrier(0);
    if (has_next) { const long ntok0 = (long)nb * SEQ; const int nqrow = nqt * 256 + wid * 32 + r;
        ATT_PRELOAD(ntok0, nqrow, nqcol, nkcol, nvcol, nhb); pre.valid = true; }
    else pre.valid = false;
    __builtin_amdgcn_sched_barrier(0);
#undef ATT_PRELOAD
#undef ATT_ISSUE
#undef ATT_ISSUE1
#undef ATT_ISSUE1X
#undef ATT_WRITE
#undef ATT_WRITE1
    const float lt = l_run + shx(l_run, 32, lane), inv = 1.0f / lt;
#define A10_SWAP(A_, B_) do { const auto r0_ = __builtin_amdgcn_permlane32_swap((A_).x, (B_).x, false, false); (A_).x = r0_[0]; (B_).x = r0_[1]; \
                              const auto r1_ = __builtin_amdgcn_permlane32_swap((A_).y, (B_).y, false, false); (A_).y = r1_[0]; (B_).y = r1_[1]; } while (0)
    if (COMB == 2) {
        float ss = 0.f;
#pragma unroll
        for (int db = 0; db < NDB; ++db)
#pragma unroll
            for (int gp = 0; gp < 2; ++gp) { const v4u q = tiq[db][gp]; v2u a, c; a.x = q.x; a.y = q.y; c.x = q.z; c.y = q.w; A10_SWAP(a, c);
#pragma unroll
                for (int e = 0; e < 2; ++e) { const int g = 2 * gp + e; const v2u t = e ? c : a;
                    const float c0 = bflo(t.x) - P.lam * (o[db][4 * g] * inv), c1 = bfhi(t.x) - P.lam * (o[db][4 * g + 1] * inv), c2 = bflo(t.y) - P.lam * (o[db][4 * g + 2] * inv), c3 = bfhi(t.y) - P.lam * (o[db][4 * g + 3] * inv);
                    o[db][4 * g] = c0; o[db][4 * g + 1] = c1; o[db][4 * g + 2] = c2; o[db][4 * g + 3] = c3; ss += (c0 * c0 + c1 * c1) + (c2 * c2 + c3 * c3); } }
        ss += shx(ss, 32, lane);
        const float rr = 1.0f / sqrtf(ss * (1.0f / 128.0f) + LN_EPS);
        bf16* op = P.O + rowoff;
#pragma unroll
        for (int db = 0; db < NDB; ++db)
#pragma unroll
            for (int gp = 0; gp < 2; ++gp) { v2u w[2];
#pragma unroll
                for (int e = 0; e < 2; ++e) { const int g = 2 * gp + e; const f32x4 gg = *(const f32x4*)(P.gsub + 32 * db + 8 * g + 4 * h);
                    w[e].x = pk2(o[db][4 * g] * rr * gg[0], o[db][4 * g + 1] * rr * gg[1]); w[e].y = pk2(o[db][4 * g + 2] * rr * gg[2], o[db][4 * g + 3] * rr * gg[3]); }
                A10_SWAP(w[0], w[1]);
                v4u q; q.x = w[0].x; q.y = w[0].y; q.z = w[1].x; q.w = w[1].y; *(v4u*)(op + 32 * db + 16 * gp) = q; }
        return;
    }
    bf16* op = P.O + rowoff;
#pragma unroll
    for (int db = 0; db < NDB; ++db)
#pragma unroll
        for (int gp = 0; gp < 2; ++gp) { v2u w[2];
#pragma unroll
            for (int e = 0; e < 2; ++e) { const int g = 2 * gp + e; w[e].x = pk2(o[db][4 * g] * inv, o[db][4 * g + 1] * inv); w[e].y = pk2(o[db][4 * g + 2] * inv, o[db][4 * g + 3] * inv); }
            A10_SWAP(w[0], w[1]);
            v4u q; q.x = w[0].x; q.y = w[0].y; q.z = w[1].x; q.w = w[1].y; *(v4u*)(op + 32 * db + 16 * gp) = q; }
#undef A10_SWAP
}

template <int DQK, int KSPLIT, int DV, bool BIAS, int COMB = 0>
__device__ __forceinline__ void attn_unit9(const AttnP& P, int b, int qt, int qcol, int kcol, int vcol, int ocol, int hb, LAS unsigned char* lds, const int tid_in) {
    constexpr int KROWB = DQK * 2 + 16;
    constexpr int VROWB = (DV == 128) ? 320 : 192;
    constexpr int KBYTES = 64 * KROWB, VBYTES = 64 * VROWB, STAGE = KBYTES + VBYTES + 256, LUT_OFF = 2 * STAGE;
    constexpr int ND = DQK / 16, NDB = DV / 32, KCH = DQK / 8, VCH = DV / 8, NKC = 64 * KCH, NVC = 64 * VCH, KL = (NKC + 511) / 512, VL = (NVC + 511) / 512;
    int tid_ = tid_in; asm volatile("" : "+v"(tid_));
    const int tid = tid_, lane = tid & 63, wid = __builtin_amdgcn_readfirstlane(tid >> 6), r = lane & 31, h = lane >> 5;
    const long tok0 = (long)b * SEQ; const int q0 = qt * 256; const int qrow = q0 + wid * 32 + r;
    bf16x8 qf[ND];
    { const bf16* qp = P.Q + (tok0 + qrow) * (long)P.ldq + qcol + 8 * h;
#pragma unroll
      for (int d = 0; d < ND; ++d) qf[d] = *(const bf16x8*)(qp + 16 * d); }
    int posq = 0, posq_min = 0;
    LAS float* lut = (LAS float*)(lds + LUT_OFF);
    if (BIAS) { posq = P.pos[tok0 + qrow]; int mn = posq;
#pragma unroll
        for (int o = 1; o < 64; o <<= 1) { const int t2 = shxi(mn, o, lane); mn = t2 < mn ? t2 : mn; }
        posq_min = mn;
        if (tid < 132) lut[tid] = P.lut[hb * 132 + tid] - P.lut[hb * 132 + 128]; }
    v4u kreg[KL], vreg[VL]; int preg = 0;
#define ATT_ISSUE(t) do { const long trow = tok0 + 64 * (long)(t); \
        _Pragma("unroll") for (int i = 0; i < KL; ++i) { const int c = tid + 512 * i; if (NKC % 512 == 0 || c < NKC) { const int row = c / KCH, col = (c % KCH) * 8; \
            const bf16* src = (col < KSPLIT) ? P.K1 + (trow + row) * (long)P.ldk1 + kcol + col : P.K2 + (trow + row) * (long)P.ldk2 + (col - KSPLIT); kreg[i] = *(const v4u*)src; } } \
        _Pragma("unroll") for (int i = 0; i < VL; ++i) { const int c = tid + 512 * i; if (NVC % 512 == 0 || c < NVC) { const int row = c / VCH, col = (c % VCH) * 8; vreg[i] = *(const v4u*)(P.V + (trow + row) * (long)P.ldv + vcol + col); } } \
        if (BIAS && tid < 64) preg = P.pos[trow + tid]; } while (0)
#define ATT_WRITE(t) do { LAS unsigned char* sb = lds + ((t) & 1) * STAGE; \
        _Pragma("unroll") for (int i = 0; i < KL; ++i) { const int c = tid + 512 * i; if (NKC % 512 == 0 || c < NKC) { const int row = c / KCH, cc = c % KCH; *(LAS v4u*)(sb + row * KROWB + cc * 16) = kreg[i]; } } \
        _Pragma("unroll") for (int i = 0; i < VL; ++i) { const int c = tid + 512 * i; if (NVC % 512 == 0 || c < NVC) { const int row = c / VCH, cc = c % VCH; *(LAS v4u*)(sb + KBYTES + row * VROWB + cc * 16) = vreg[i]; } } \
        if (BIAS && tid < 64) *(LAS int*)(sb + KBYTES + VBYTES + 4 * tid) = preg; } while (0)
    f32x16 o[NDB];
#pragma unroll
    for (int i = 0; i < NDB; ++i)
#pragma unroll
        for (int j = 0; j < 16; ++j) o[i][j] = 0.f;
    float m_run = 0.f, l_run = 0.f;
    f32x16 lacc;
#pragma unroll
    for (int j = 0; j < 16; ++j) lacc[j] = 0.f;
    const bf16x8 ones8 = {0x3f80, 0x3f80, 0x3f80, 0x3f80, 0x3f80, 0x3f80, 0x3f80, 0x3f80};
    f32x16 csp;
    { const float c0_ = BIAS ? P.lut[hb * 132 + 128] : 0.f;
#pragma unroll
      for (int j = 0; j < 16; ++j) csp[j] = c0_; }
    const int ntiles = (q0 + 256) / 64, my_last = (q0 + wid * 32 + 31) / 64;
#if ATT_STATIC_PRIO
    if (wid >= 4) __builtin_amdgcn_s_setprio(1);
#endif
    ATT_ISSUE(0); ATT_WRITE(0); __syncthreads();
    const int kbase = r * KROWB + 16 * h;
    const int vbase = KBYTES + (4 * h + ((lane & 15) >> 2)) * VROWB + (((lane >> 4) & 1) * 16 + (lane & 3) * 4) * 2;
    for (int t = 0; t < ntiles; ++t) {
        const bool more = (t + 1 < ntiles);
        if (more) ATT_ISSUE(t + 1);
        if (t <= my_last) {
            const LAS unsigned char* sb = lds + (t & 1) * STAGE;
            bool plain = (64 * t + 63 <= q0 + wid * 32);
            if (t >= 2) {
                const float lnow = lacc[0], ls = lnow - l_run;
                if (__any(ls > 1024.0f)) {
                    const float delta = fmaxf(__builtin_amdgcn_logf(ls) - 4.0f, 0.f), alpha = __builtin_amdgcn_exp2f(-delta);
                    m_run += delta; lacc = lacc * alpha;
#pragma unroll
                    for (int i = 0; i < NDB; ++i) o[i] = o[i] * alpha;
#pragma unroll
                    for (int j = 0; j < 16; ++j) csp[j] -= delta;
                }
                l_run = lacc[0];
            } else if (t == 1) l_run = lacc[0];
            if (BIAS) { const int kmax = P.blkmax[(int)(tok0 >> 6) + t]; if (!(plain && (posq_min - kmax >= 113))) plain = false; }
            f32x16 x0 = csp, x1 = csp;
            ATT_SETPRIO(1);
            { bf16x8 kf0[ND], kf1[ND];
#pragma unroll
              for (int d = 0; d < ND; ++d) { kf0[d] = *(const LAS bf16x8*)(sb + kbase + d * 32); kf1[d] = *(const LAS bf16x8*)(sb + kbase + 32 * KROWB + d * 32); }
              __builtin_amdgcn_sched_barrier(0);
#pragma unroll
              for (int d = 0; d < ND; ++d) { x0 = MFMA32(kf0[d], qf[d], x0); x1 = MFMA32(kf1[d], qf[d], x1); } }
            ATT_SETPRIO(0);
            if (!plain) {
#pragma unroll
                for (int g = 0; g < 4; ++g) {
                    int pk0[4] = {0, 0, 0, 0}, pk1[4] = {0, 0, 0, 0};
                    if (BIAS) { const LAS int* pp = (const LAS int*)(sb + KBYTES + VBYTES) + 8 * g + 4 * h;
                        const v4u a = *(const LAS v4u*)pp, c = *(const LAS v4u*)(pp + 32);
                        pk0[0] = a.x; pk0[1] = a.y; pk0[2] = a.z; pk0[3] = a.w; pk1[0] = c.x; pk1[1] = c.y; pk1[2] = c.z; pk1[3] = c.w; }
#pragma unroll
                    for (int j = 0; j < 4; ++j) { const int i = 4 * g + j; const int kidx = 64 * t + 8 * g + 4 * h + j;
                        float v0 = x0[i], v1 = x1[i];
                        if (BIAS) { int n0 = posq - pk0[j]; n0 = n0 < 0 ? 0 : (n0 > 128 ? 128 : n0); int n1 = posq - pk1[j]; n1 = n1 < 0 ? 0 : (n1 > 128 ? 128 : n1); v0 += lut[n0]; v1 += lut[n1]; }
                        if (kidx > qrow) v0 = -INFINITY; if (kidx + 32 > qrow) v1 = -INFINITY;
                        x0[i] = v0; x1[i] = v1; }
                }
            }
            if (t == 0) {
                float ma = fmaxf(fmaxf(x0[0], x0[1]), x0[2]), mb = fmaxf(fmaxf(x1[0], x1[1]), x1[2]);
#pragma unroll
                for (int j = 3; j < 15; j += 2) { ma = fmaxf(fmaxf(ma, x0[j]), x0[j + 1]); mb = fmaxf(fmaxf(mb, x1[j]), x1[j + 1]); }
                float mx = fmaxf(fmaxf(ma, mb), fmaxf(x0[15], x1[15]));
                { const auto rr = __builtin_amdgcn_permlane32_swap(__float_as_uint(mx), __float_as_uint(mx), false, false); mx = fmaxf(__uint_as_float(rr[0]), __uint_as_float(rr[1])); }
                m_run += mx;
#pragma unroll
                for (int j = 0; j < 16; ++j) { x0[j] -= mx; x1[j] -= mx; csp[j] -= mx; }
            }
            bf16x8 pf[4];
            s16x4 vl[2][NDB], vh[2][NDB];
#define A6_EXP(X, bb, PF) do { \
        X[bb + 0] = __builtin_amdgcn_exp2f(X[bb + 0]); X[bb + 1] = __builtin_amdgcn_exp2f(X[bb + 1]); X[bb + 2] = __builtin_amdgcn_exp2f(X[bb + 2]); X[bb + 3] = __builtin_amdgcn_exp2f(X[bb + 3]); \
        X[bb + 4] = __builtin_amdgcn_exp2f(X[bb + 4]); X[bb + 5] = __builtin_amdgcn_exp2f(X[bb + 5]); X[bb + 6] = __builtin_amdgcn_exp2f(X[bb + 6]); X[bb + 7] = __builtin_amdgcn_exp2f(X[bb + 7]); \
        { v4u w_; w_.x = pk2(X[bb + 0], X[bb + 1]); w_.y = pk2(X[bb + 2], X[bb + 3]); w_.z = pk2(X[bb + 4], X[bb + 5]); w_.w = pk2(X[bb + 6], X[bb + 7]); PF = __builtin_bit_cast(bf16x8, w_); } } while (0)
#define A6_VLD(buf, ss) do { _Pragma("unroll") for (int db = 0; db < NDB; ++db) { vl[buf][db] = vtr(sb + vbase + (16 * (ss)) * VROWB + 64 * db); vh[buf][db] = vtr(sb + vbase + (16 * (ss) + 8) * VROWB + 64 * db); } } while (0)
#define A6_MMA(buf, ss) do { _Pragma("unroll") for (int db = 0; db < NDB; ++db) { const bf16x8 vf_ = __builtin_shufflevector(vl[buf][db], vh[buf][db], 0, 1, 2, 3, 4, 5, 6, 7); o[db] = MFMA32(vf_, pf[ss], o[db]); } lacc = MFMA32(ones8, pf[ss], lacc); } while (0)
#define A6_SGB(nv) do { _Pragma("unroll") for (int db = 0; db < NDB; ++db) { __builtin_amdgcn_sched_group_barrier(0x008, 1, 0); __builtin_amdgcn_sched_group_barrier(A6_VMASK, (nv), 0); __builtin_amdgcn_sched_group_barrier(0x100, 2, 0); } __builtin_amdgcn_sched_group_barrier(0x008, 1, 0); } while (0)
            A6_VLD(0, 0);
            A6_EXP(x0, 0, pf[0]);
            __builtin_amdgcn_sched_barrier(0);
            A6_VLD(1, 1); A6_EXP(x0, 8, pf[1]); A6_MMA(0, 0); A6_SGB(12 / NDB);
            __builtin_amdgcn_sched_barrier(0);
            A6_VLD(0, 2); A6_EXP(x1, 0, pf[2]); A6_MMA(1, 1); A6_SGB(12 / NDB);
            __builtin_amdgcn_sched_barrier(0);
            A6_VLD(1, 3); A6_EXP(x1, 8, pf[3]); A6_MMA(0, 2); A6_SGB(12 / NDB);
            __builtin_amdgcn_sched_barrier(0);
            A6_MMA(1, 3);
            __builtin_amdgcn_sched_barrier(0);
#undef A6_EXP
#undef A6_VLD
#undef A6_MMA
#undef A6_SGB
            ATT_SETPRIO(0);
        }
        if (more) ATT_WRITE(t + 1);
        __syncthreads();
    }
#undef ATT_ISSUE
#undef ATT_WRITE
#if ATT_STATIC_PRIO
    __builtin_amdgcn_s_setprio(0);
#endif
    const float lt = lacc[0], inv = 1.0f / lt;
    if (COMB == 2) {
        const bf16* ip = P.TI + (tok0 + qrow) * (long)P.ldo + ocol + 4 * h; float ss = 0.f;
#pragma unroll
        for (int db = 0; db < NDB; ++db)
#pragma unroll
            for (int g = 0; g < 4; ++g) { const v2u a = *(const v2u*)(ip + 32 * db + 8 * g);
                const float c0 = bflo(a.x) - P.lam * (o[db][4 * g] * inv), c1 = bfhi(a.x) - P.lam * (o[db][4 * g + 1] * inv), c2 = bflo(a.y) - P.lam * (o[db][4 * g + 2] * inv), c3 = bfhi(a.y) - P.lam * (o[db][4 * g + 3] * inv);
                o[db][4 * g] = c0; o[db][4 * g + 1] = c1; o[db][4 * g + 2] = c2; o[db][4 * g + 3] = c3; ss += (c0 * c0 + c1 * c1) + (c2 * c2 + c3 * c3); }
        ss += shx(ss, 32, lane);
        const float rr = P.osc / sqrtf(ss * (1.0f / 128.0f) + LN_EPS);
        bf16* op = P.O + (tok0 + qrow) * (long)P.ldo + ocol + 4 * h;
#pragma unroll
        for (int db = 0; db < NDB; ++db)
#pragma unroll
            for (int g = 0; g < 4; ++g) { const f32x4 gg = *(const f32x4*)(P.gsub + 32 * db + 8 * g + 4 * h);
                v2u w; w.x = pk2(o[db][4 * g] * rr * gg[0], o[db][4 * g + 1] * rr * gg[1]); w.y = pk2(o[db][4 * g + 2] * rr * gg[2], o[db][4 * g + 3] * rr * gg[3]);
                *(v2u*)(op + 32 * db + 8 * g) = w; }
        return;
    }
    bf16* op = P.O + (tok0 + qrow) * (long)P.ldo + ocol + 4 * h;
#pragma unroll
    for (int db = 0; db < NDB; ++db)
#pragma unroll
        for (int g = 0; g < 4; ++g) { v2u w; w.x = pk2(o[db][4 * g] * inv, o[db][4 * g + 1] * inv); w.y = pk2(o[db][4 * g + 2] * inv, o[db][4 * g + 3] * inv);
            *(v2u*)(op + 32 * db + 8 * g) = w; }
}

#undef MFMA32
}

constexpr size_t MiB = 1u << 20;
constexpr size_t WS_CTL = 0, CTL_ZERO_BYTES = 1 * MiB;
constexpr size_t WS_ROPE = 1 * MiB;
constexpr size_t WS_MISC = 5 * MiB;
constexpr size_t WS_XB = 6 * MiB;
constexpr size_t WS_XB8 = 70 * MiB + 16 * MiB;
constexpr size_t WS_PB = 70 * MiB;
constexpr size_t WS_W = 118 * MiB;
constexpr size_t W_IN = WS_W, W_G8 = WS_W + 8 * MiB, W_UQ = WS_W + 12 * MiB, W_UKV = WS_W + 13 * MiB, W_BD = WS_W + 14 * MiB, W_BM = WS_W + 16 * MiB, W_OUT = WS_W + 17 * MiB,
                 W_PG = WS_W + 19 * MiB, W_PP = WS_W + 21 * MiB, W_F13 = WS_W + 22 * MiB  , W_F2E = WS_W + 134 * MiB;
constexpr size_t WS_ACT = 308 * MiB;
constexpr size_t A_DQ = WS_ACT, A_DK = WS_ACT + 64 * MiB, A_DV = WS_ACT + 128 * MiB, A_G = WS_ACT + 192 * MiB, A_C = WS_ACT + 320 * MiB;
constexpr size_t A_OA = A_C + 64 * MiB  , A_MT = A_DK, A_M = A_DV, A_CQ = A_C, A_OA2 = A_C, A_PRE = A_C;
constexpr size_t A_CQN = WS_ACT + 448 * MiB, A_CKVN = WS_ACT + 472 * MiB, A_OB = A_CQN, A_MKR = WS_ACT + 488 * MiB, A_MQ = WS_ACT + 490 * MiB, A_MKV = WS_ACT + 538 * MiB;
constexpr size_t A_H = WS_ACT;
constexpr size_t A_XG = WS_ACT, A_YG = A_XG  , A_TOK = WS_ACT + 264 * MiB, A_HG = WS_ACT + 270 * MiB  , A_PREM = WS_ACT + 512 * MiB;
constexpr size_t W_F13D = WS_ACT + 602 * MiB, W_F2D = WS_ACT + 613 * MiB;
constexpr size_t W_QKV8 = WS_W + 3 * MiB;
constexpr size_t WS_SSP = WS_ACT + 620 * MiB;
constexpr size_t WS_END = WS_ACT + 640 * MiB;
static_assert(MOE_FP8 == 1, "the workspace map assumes fp8 expert activations");
constexpr int CW_BAR = 4096, CW_MOE = 8192, CW_LN = 16384;
constexpr size_t WS_LNST = WS_W + 10 * MiB;
constexpr int CW_DUMMY_ = 0;

constexpr int RING_BYTES = 131072, MISC_OFF = RING_BYTES + 320, LDS_BYTES = 147456;
constexpr int NWAVES = 8;

#ifndef REP_ATTN_D
#define REP_ATTN_D 1
#endif
#ifndef REP_ATTN_M
#define REP_ATTN_M 1
#endif
#ifndef REP_CONV
#define REP_CONV 1
#endif
#ifndef REP_L1
#define REP_L1 1
#endif
#ifndef REP_EW
#define REP_EW 1
#endif
#ifndef REP_BAR
#define REP_BAR 1
#endif
#ifndef REP_LN
#define REP_LN 1
#endif
#ifndef REP_MOE
#define REP_MOE 1
#endif
#ifndef REP_MIX
#define REP_MIX 1
#endif
#ifndef REP_FFN
#define REP_FFN 1
#endif
#ifndef REP_P0
#define REP_P0 1
#endif
#ifndef REP_PPE
#define REP_PPE 1
#endif
#ifndef ATT_UNIT_D
#define ATT_UNIT_D attn_unit10
#endif
#ifndef ATT_UNIT_M
#define ATT_UNIT_M attn_unit10
#endif
#ifndef F8_SP2
#define F8_SP2 true
#endif
#ifndef GEMM_STAGGER
#define GEMM_STAGGER 0
#endif
#ifndef STAG_L1
#define STAG_L1 1500
#endif
#ifndef STAG_H
#define STAG_H 1500
#endif
#ifndef STAG_UP
#define STAG_UP 1000
#endif
#ifndef GEMM_ALIGN
#define GEMM_ALIGN true
#endif
#ifndef UP_ALIGN
#define UP_ALIGN true
#endif
#ifndef PROBE_D
#define PROBE_D -1
#endif
#ifndef PROBE_M
#define PROBE_M -1
#endif
#ifndef LN_FUSE
#define LN_FUSE 1
#endif
#ifndef CONV_IN_DOWN
#define CONV_IN_DOWN 1
#endif
#ifndef CONV_IN_ATTN
#define CONV_IN_ATTN 1
#endif
#ifndef PROBE_NULL_L1
#define PROBE_NULL_L1 0
#endif
#ifndef QKV_FP8
#define QKV_FP8 1
#endif
#define XB_TMO      128
#define XB_XCNT(j)  (256  + 64 * (j))
#define XB_XSUB(j)  (1280 + 64 * (j))
#define XB_XGEN(j)  (2304 + 64 * (j))
#define XB_TOP      3328
#define XB_TOPGEN   3392
#define XCD_BAR_WORDS 3456
#define XB_SPIN_CAP (1u << 18)

__device__ __forceinline__ unsigned xb_ld(unsigned* p)              { return __hip_atomic_load(p, __ATOMIC_RELAXED, __HIP_MEMORY_SCOPE_AGENT); }
__device__ __forceinline__ unsigned xb_add(unsigned* p, unsigned v) { return __hip_atomic_fetch_add(p, v, __ATOMIC_RELAXED, __HIP_MEMORY_SCOPE_AGENT); }
__device__ __forceinline__ unsigned xb_xcc_id() { return (unsigned)__builtin_amdgcn_s_getreg((3 << 11) | 20) & 0xFu; }
#define XB_SPIN(cond, bar) do { unsigned _sp = 0; while (cond) { __builtin_amdgcn_s_sleep(1); \
    if ((++_sp & 255u) == 0u) { if (xb_ld(&(bar)[XB_TMO])) break; if (_sp > XB_SPIN_CAP) { atomicAdd(&(bar)[XB_TMO], 1u); break; } } } } while (0)

struct XcdBarrier {
    unsigned* bar; unsigned x;
    volatile LAS unsigned* st;
};

__device__ __forceinline__ XcdBarrier xcd_barrier_post(unsigned* bar, volatile LAS unsigned* st, const bool t0  ) {
    XcdBarrier b; b.bar = bar; b.x = xb_xcc_id(); b.st = st;
    if (t0) (void)xb_add(&bar[XB_XCNT(b.x)], 1u);
    return b;
}
__device__ __forceinline__ void xcd_barrier_complete(unsigned* bar, unsigned x, unsigned& nloc, unsigned& nx) {
    const unsigned G = gridDim.x * gridDim.y * gridDim.z;
    unsigned sum, cnt, mine, sp = 0u;
    for (;;) {
        sum = 0u; cnt = 0u; mine = 0u;
#pragma unroll
        for (unsigned j = 0; j < 16; ++j) { const unsigned c = xb_ld(&bar[XB_XCNT(j)]); sum += c; cnt += (c > 0u) ? 1u : 0u; mine = (j == x) ? c : mine; }
        if (sum == G) break;
        __builtin_amdgcn_s_sleep(1);
        if ((++sp & 255u) == 0u) { if (xb_ld(&bar[XB_TMO])) break; if (sp > XB_SPIN_CAP) { atomicAdd(&bar[XB_TMO], 1u); break; } }
    }
    nloc = mine > 0u ? mine : 1u; nx = cnt > 0u ? cnt : 1u;
}

__device__ __forceinline__ void xcd_barrier(const XcdBarrier& b, const bool t0) {
    asm volatile("s_waitcnt vmcnt(0)" ::: "memory");
    __syncthreads();
    if (t0) {
        unsigned* bar = b.bar;
        __builtin_amdgcn_s_waitcnt(0);
        unsigned nloc = b.st[0], nx = b.st[1];
        if (nloc == 0u) { xcd_barrier_complete(bar, b.x, nloc, nx); b.st[0] = nloc; b.st[1] = nx; }
        const unsigned old = xb_add(&bar[XB_XSUB(b.x)], 1u);
        const unsigned gen = old / nloc;
        if (old + 1u == (gen + 1u) * nloc) {
            __builtin_amdgcn_fence(__ATOMIC_RELEASE, "agent");
            asm volatile("s_waitcnt vmcnt(0)" ::: "memory");
            const unsigned og = xb_add(&bar[XB_TOP], 1u);
            const unsigned tg = og / nx;
            if (og + 1u == (tg + 1u) * nx) xb_add(&bar[XB_TOPGEN], 1u);
            else XB_SPIN(xb_ld(&bar[XB_TOPGEN]) == tg, bar);
            __builtin_amdgcn_fence(__ATOMIC_ACQUIRE, "agent");
            xb_add(&bar[XB_XGEN(b.x)], 1u);
            asm volatile("s_waitcnt vmcnt(0)" ::: "memory");
        } else {
            XB_SPIN(xb_ld(&bar[XB_XGEN(b.x)]) == gen, bar);
            __builtin_amdgcn_fence(__ATOMIC_ACQUIRE, "agent");
            asm volatile("s_waitcnt vmcnt(0)" ::: "memory");
        }
    }
    __syncthreads();
}

struct Args { const void* in[31]; float* out; unsigned char* ws; int ph_lo, ph_hi, fuse; };

struct Frame {
    LAS unsigned char* lds;
    int tid, lane, wave, gw, NGW, G, vcu;
    const Args* a;
    unsigned char* ws;
};
#define FR_TID(F_) ({ unsigned m1_ = ~0u; asm volatile("" : "+s"(m1_)); (((F_).wave << 6) | (int)__builtin_amdgcn_mbcnt_hi(m1_, __builtin_amdgcn_mbcnt_lo(m1_, 0u))); })
#define INF(i) ((const float*)F.a->in[i])
#define WSP(T_, off) ((T_*)(F.ws + (off)))

__device__ __forceinline__ void conv_w(const Frame& F, const float* src, int ldn, int K, int ncols, int nbatch, size_t sbs, bf16* dst, int rmul, int roff, size_t dbs, const float* kscale) {
    LAS float* scr = (LAS float*)(F.lds + F.wave * 16384);
    const int lane = F.lane, nblk = ncols / 32, kblk = K / 64, per = nblk * kblk, total = per * nbatch;
    for (int it = F.gw; it < total; it += F.NGW) {
        const int bt = it / per, r = it % per, kb = r / nblk, nb = r % nblk, k0 = kb * 64, n0 = nb * 32;
        const float* W = src + (size_t)bt * sbs; bf16* WT = dst + (size_t)bt * dbs;
        float ld_[32];
#pragma unroll
        for (int i = 0; i < 32; ++i) ld_[i] = __builtin_nontemporal_load(W + (size_t)(k0 + 2 * i + (lane >> 5)) * ldn + n0 + (lane & 31));
#pragma unroll
        for (int i = 0; i < 32; ++i) scr[(2 * i + (lane >> 5)) * 33 + (lane & 31)] = ld_[i];
        LDS_WAIT(); asm volatile("" ::: "memory");
        const int c = lane & 7;
        float ks[8];
#pragma unroll
        for (int i = 0; i < 8; ++i) ks[i] = kscale ? kscale[k0 + 8 * c + i] : 1.0f;
#pragma unroll
        for (int j = 0; j < 4; ++j) { const int n = (lane >> 3) + 8 * j; const LAS float* s = scr + (8 * c) * 33 + n;
            v4u o; o.x = pk2(s[0 * 33] * ks[0], s[1 * 33] * ks[1]); o.y = pk2(s[2 * 33] * ks[2], s[3 * 33] * ks[3]); o.z = pk2(s[4 * 33] * ks[4], s[5 * 33] * ks[5]); o.w = pk2(s[6 * 33] * ks[6], s[7 * 33] * ks[7]);
            *(v4u*)(WT + (size_t)(rmul * (n0 + n) + roff) * K + k0 + 8 * c) = o; }
        LDS_WAIT(); asm volatile("" ::: "memory");
    }
}
__device__ __forceinline__ void conv_w8(const Frame& F, const float* src, int ldn, int K, int ncols, int nbatch, size_t sbs, unsigned char* dst, int rmul, int roff, size_t dbs, float scale) {
    LAS float* scr = (LAS float*)(F.lds + F.wave * 16384);
    const int lane = F.lane, nblk = ncols / 32, kblk = K / 64, per = nblk * kblk, total = per * nbatch;
    for (int it = F.gw; it < total; it += F.NGW) {
        const int bt = it / per, r = it % per, kb = r / nblk, nb = r % nblk, k0 = kb * 64, n0 = nb * 32;
        const float* W = src + (size_t)bt * sbs; unsigned char* WT = dst + (size_t)bt * dbs;
        float ld_[32];
#pragma unroll
        for (int i = 0; i < 32; ++i) ld_[i] = __builtin_nontemporal_load(W + (size_t)(k0 + 2 * i + (lane >> 5)) * ldn + n0 + (lane & 31));
#pragma unroll
        for (int i = 0; i < 32; ++i) scr[(2 * i + (lane >> 5)) * 33 + (lane & 31)] = ld_[i];
        LDS_WAIT(); asm volatile("" ::: "memory");
        const int c = lane & 7;
#pragma unroll
        for (int j = 0; j < 4; ++j) { const int n = (lane >> 3) + 8 * j; const LAS float* s = scr + (8 * c) * 33 + n;
            int lo = __builtin_amdgcn_cvt_pk_fp8_f32(s[0 * 33] * scale, s[1 * 33] * scale, 0, false); lo = __builtin_amdgcn_cvt_pk_fp8_f32(s[2 * 33] * scale, s[3 * 33] * scale, lo, true);
            int hi = __builtin_amdgcn_cvt_pk_fp8_f32(s[4 * 33] * scale, s[5 * 33] * scale, 0, false); hi = __builtin_amdgcn_cvt_pk_fp8_f32(s[6 * 33] * scale, s[7 * 33] * scale, hi, true);
            v2u o; o.x = (unsigned)lo; o.y = (unsigned)hi;
            *(v2u*)(WT + (size_t)(rmul * (n0 + n) + roff) * K + k0 + 8 * c) = o; }
        LDS_WAIT(); asm volatile("" ::: "memory");
    }
}
__device__ __forceinline__ void phase_convert(const Frame& F, int L, const int which = 0) {
    const int j = L >> 1;
    if (which != 2) {
    const float* win = INF(4) + (size_t)L * D * IN_COLS;
#if QKV_FP8
    conv_w8(F, win, IN_COLS, D, 3072, 1, 0, WSP(unsigned char, W_QKV8), 1, 0, 0, 32.0f);
    conv_w8(F, win + 3744, IN_COLS, D, 2048, 1, 0, WSP(unsigned char, W_QKV8), 1, 3072, 0, 32.0f);
    conv_w(F, win + 3072, IN_COLS, D, 672, 1, 0, WSP(bf16, W_IN), 1, 0, 0, nullptr);
    { bf16* padr = WSP(bf16, W_IN) + (size_t)672 * D;
#else
    conv_w(F, win, IN_COLS, D, 3072, 1, 0, WSP(bf16, W_IN), 1, 0, 0, nullptr);
    conv_w8(F, win + 3744, IN_COLS, D, 2048, 1, 0, WSP(unsigned char, W_G8), 1, 0, 0, 32.0f);
    conv_w(F, win + 3072, IN_COLS, D, 672, 1, 0, WSP(bf16, W_IN), 1, 3072, 0, nullptr);
    { bf16* padr = WSP(bf16, W_IN) + (size_t)3744 * D;
#endif
      unsigned z_ = 0u; asm volatile("" : "+v"(z_));
      for (int i = F.gw * 64 + F.lane; i < (NIN - IN_COLS) * D / 8; i += F.NGW * 64) ((v4u*)padr)[i] = (v4u){z_, z_, z_, z_}; }
    conv_w(F, INF(12) + (size_t)L * QR * 768, 768, QR, 768, 1, 0, WSP(bf16, W_UQ), 1, 0, 0, INF(11) + L * QR);
    conv_w(F, INF(14) + (size_t)L * KVR * 1024, 1024, KVR, 1024, 1, 0, WSP(bf16, W_UKV), 1, 0, 0, INF(13) + L * KVR);
    conv_w(F, INF(15) + (size_t)L * D * D, D, D, D, 1, 0, WSP(bf16, W_BD), 1, 0, 0, nullptr);
    conv_w(F, INF(16) + (size_t)L * 512 * D, D, 512, D, 1, 0, WSP(bf16, W_BM), 1, 0, 0, nullptr);
    conv_w(F, INF(17) + (size_t)L * D * D, D, D, D, 1, 0, WSP(bf16, W_OUT), 1, 0, 0, nullptr);
    conv_w8(F, INF(27) + (size_t)L * D * D, D, D, D, 1, 0, WSP(unsigned char, W_PG), 1, 0, 0, 32.0f);
    conv_w(F, INF(28) + (size_t)L * PLE * D, D, PLE, D, 1, 0, WSP(bf16, W_PP), 1, 0, 0, nullptr);
    }
    if ((L & 1) == 0) { if (which != 2) {
        conv_w(F, INF(20) + (size_t)j * D * DENSE_FF, DENSE_FF, D, DENSE_FF, 1, 0, WSP(bf16, W_F13D), 2, 0, 0, nullptr);
        conv_w(F, INF(21) + (size_t)j * D * DENSE_FF, DENSE_FF, D, DENSE_FF, 1, 0, WSP(bf16, W_F13D), 2, 1, 0, nullptr);
        conv_w(F, INF(22) + (size_t)j * DENSE_FF * D, D, DENSE_FF, D, 1, 0, WSP(bf16, W_F2D), 1, 0, 0, nullptr); }
    } else if (which != 1) {
        const size_t eo = (size_t)j * NEXP * D * EXPERT_FF;
#if MOE_FP8
        conv_w8(F, INF(24) + eo, EXPERT_FF, D, EXPERT_FF, NEXP, (size_t)D * EXPERT_FF, WSP(unsigned char, W_F13), 2, 0, (size_t)2 * EXPERT_FF * D, 32.0f);
        conv_w8(F, INF(25) + eo, EXPERT_FF, D, EXPERT_FF, NEXP, (size_t)D * EXPERT_FF, WSP(unsigned char, W_F13), 2, 1, (size_t)2 * EXPERT_FF * D, 32.0f);
        conv_w8(F, INF(26) + eo, D, EXPERT_FF, D, NEXP, (size_t)EXPERT_FF * D, WSP(unsigned char, W_F2E), 1, 0, (size_t)D * EXPERT_FF, 128.0f);
#else
        conv_w(F, INF(24) + eo, EXPERT_FF, D, EXPERT_FF, NEXP, (size_t)D * EXPERT_FF, WSP(bf16, W_F13), 2, 0, (size_t)2 * EXPERT_FF * D, nullptr);
        conv_w(F, INF(25) + eo, EXPERT_FF, D, EXPERT_FF, NEXP, (size_t)D * EXPERT_FF, WSP(bf16, W_F13), 2, 1, (size_t)2 * EXPERT_FF * D, nullptr);
        conv_w(F, INF(26) + eo, D, EXPERT_FF, D, NEXP, (size_t)EXPERT_FF * D, WSP(bf16, W_F2E), 1, 0, (size_t)D * EXPERT_FF, nullptr);
#endif
    }
    if (which != 2) { const f32x4* ps = (const f32x4*)(INF(1) + (size_t)L * T * PLE); v2u* pd = WSP(v2u, WS_PB);
      for (int i = F.gw * 64 + F.lane; i < T * PLE / 4; i += F.NGW * 64) { const f32x4 v = __builtin_nontemporal_load(ps + i); v2u o; o.x = pk2(v[0], v[1]); o.y = pk2(v[2], v[3]); pd[i] = o; } }
}

__device__ __forceinline__ void phase_prologue(const Frame& F) {
    const int* pos = (const int*)F.a->in[2];
    for (int m = F.gw; m < T; m += F.NGW) {
        const f32x4* xr = (const f32x4*)(INF(0) + (size_t)m * D) + 2 * F.lane; v4u* br = WSP(v4u, WS_XB) + (size_t)m * (D / 8) + F.lane; v2u* br8 = WSP(v2u, WS_XB8) + (size_t)m * (D / 8) + F.lane;
#pragma unroll
        for (int j = 0; j < 2; ++j) { const f32x4 va = __builtin_nontemporal_load(xr + 128 * j), vb = __builtin_nontemporal_load(xr + 128 * j + 1);
            v4u o; o.x = pk2(va[0], va[1]); o.y = pk2(va[2], va[3]); o.z = pk2(vb[0], vb[1]); o.w = pk2(vb[2], vb[3]); br[64 * j] = o;
            int wa = __builtin_amdgcn_cvt_pk_fp8_f32(va[0], va[1], 0, false); wa = __builtin_amdgcn_cvt_pk_fp8_f32(va[2], va[3], wa, true);
            int wb = __builtin_amdgcn_cvt_pk_fp8_f32(vb[0], vb[1], 0, false); wb = __builtin_amdgcn_cvt_pk_fp8_f32(vb[2], vb[3], wb, true);
            v2u o8; o8.x = (unsigned)wa; o8.y = (unsigned)wb; br8[64 * j] = o8; }
    }
    { float* rope = WSP(float, WS_ROPE);
      for (int idx = F.gw * 64 + F.lane; idx < T * 16; idx += F.NGW * 64) {
          const int t = idx >> 4, j = idx & 15;
          double inv = 1.0; for (int i = 0; i < j; ++i) inv *= 0.5623413251903491;
          const double ang = (double)pos[t] * inv;
          const double nq = __builtin_rint(ang * 0.6366197723675814);
          double y = __builtin_fma(-nq, 1.5707963267948966, ang); y = __builtin_fma(-nq, 6.123233995736766e-17, y);
          const double y2 = y * y;
          double sp = 1.0 / 6227020800.0; sp = sp * y2 - 1.0 / 39916800.0; sp = sp * y2 + 1.0 / 362880.0; sp = sp * y2 - 1.0 / 5040.0; sp = sp * y2 + 1.0 / 120.0; sp = sp * y2 - 1.0 / 6.0;
          const double sn = y + y * y2 * sp;
          double cp = -1.0 / 87178291200.0; cp = cp * y2 + 1.0 / 479001600.0; cp = cp * y2 - 1.0 / 3628800.0; cp = cp * y2 + 1.0 / 40320.0; cp = cp * y2 - 1.0 / 720.0; cp = cp * y2 + 1.0 / 24.0; cp = cp * y2 - 0.5;
          const double cs = 1.0 + y2 * cp;
          const int q = ((int)nq) & 3;
          const double c = (q == 0) ? cs : (q == 1) ? -sn : (q == 2) ? -cs : sn;
          const double s = (q == 0) ? sn : (q == 1) ? cs : (q == 2) ? -sn : -cs;
          rope[2 * idx] = (float)c; rope[2 * idx + 1] = (float)s;
      } }
    { int* bm = WSP(int, WS_MISC);
      for (int blk = F.gw; blk < T / 64; blk += F.NGW) { int v = pos[blk * 64 + F.lane];
#pragma unroll
          for (int o = 1; o < 64; o <<= 1) { const int t2 = shxi(v, o, F.lane); v = t2 > v ? t2 : v; }
          if (F.lane == 0) bm[blk] = v; } }
    { float* lut = WSP(float, WS_MISC + 4096); const float* tab = INF(3);
      for (int idx = F.gw * 64 + F.lane; idx < 8 * 132; idx += F.NGW * 64) { const int hh = idx / 132, n = idx % 132;
          int bk = n;
          if (n >= 16) bk = 16 + (n >= 19) + (n >= 21) + (n >= 24) + (n >= 27) + (n >= 31) + (n >= 35) + (n >= 40) + (n >= 46) + (n >= 52) + (n >= 59) + (n >= 67) + (n >= 77) + (n >= 87) + (n >= 99) + (n >= 113);
          lut[idx] = tab[bk * 8 + hh] * LOG2E; } }
    { float* gt = WSP(float, WS_MISC + 32768); const float* gs = INF(10);
      for (int idx = F.gw * 64 + F.lane; idx < DEPTH * 128; idx += F.NGW * 64) { const int L_ = idx >> 7; gt[idx] = gs[idx] * (1.0f - (0.8f - 0.6f * expf(-0.3f * (float)L_))); } }
    for (int rep = 0; rep < REP_CONV; ++rep) phase_convert(F, 0);
}

__device__ __forceinline__ void phase_rms_rope(const Frame& F) {
    const bf16* CQ = WSP(bf16, A_CQ); const float* rope = WSP(float, WS_ROPE);
    bf16* CQN = WSP(bf16, A_CQN); bf16* CKVN = WSP(bf16, A_CKVN); bf16* MKR = WSP(bf16, A_MKR);
    const int l = F.lane;
    for (int m0 = F.gw; m0 < T; m0 += 4 * F.NGW) {
        unsigned q0[4], q1[4], q2[4]; v2u kvp[4]; unsigned short k1[4], k2[4]; float rc[4], rs[4];
#pragma unroll
        for (int q = 0; q < 4; ++q) { const int m = (m0 + q * F.NGW < T) ? m0 + q * F.NGW : m0; const bf16* c = CQ + (size_t)m * 768;
            q0[q] = *(const unsigned*)(c + 6 * l); q1[q] = *(const unsigned*)(c + 6 * l + 2); q2[q] = *(const unsigned*)(c + 6 * l + 4);
            kvp[q] = *(const v2u*)(c + QR + 4 * l);
            k1[q] = 0; k2[q] = 0; rc[q] = 0.f; rs[q] = 0.f;
            if (l < 16) { k1[q] = c[QR + KVR + l]; k2[q] = c[QR + KVR + 16 + l]; rc[q] = rope[(size_t)m * 32 + 2 * l]; rs[q] = rope[(size_t)m * 32 + 2 * l + 1]; } }
#pragma unroll
        for (int q = 0; q < 4; ++q) { const int m = m0 + q * F.NGW; if (m >= T) break;
            const f32x2 a0 = {bflo(q0[q]), bfhi(q0[q])}, a1 = {bflo(q1[q]), bfhi(q1[q])}, a2 = {bflo(q2[q]), bfhi(q2[q])};
            const f32x4 kv = {bflo(kvp[q].x), bfhi(kvp[q].x), bflo(kvp[q].y), bfhi(kvp[q].y)};
            const float x1 = bflo((unsigned)k1[q]), x2 = bflo((unsigned)k2[q]);
            const float sq = wave_sum(l, a0[0] * a0[0] + a0[1] * a0[1] + a1[0] * a1[0] + a1[1] * a1[1] + a2[0] * a2[0] + a2[1] * a2[1]);
            const float sk = wave_sum(l, kv[0] * kv[0] + kv[1] * kv[1] + kv[2] * kv[2] + kv[3] * kv[3]);
            const float rq = 1.0f / sqrtf(sq * (1.0f / QR) + LN_EPS), rk = 1.0f / sqrtf(sk * (1.0f / KVR) + LN_EPS);
            unsigned* qo = (unsigned*)(CQN + (size_t)m * QR + 6 * l);
            qo[0] = pk2(a0[0] * rq, a0[1] * rq); qo[1] = pk2(a1[0] * rq, a1[1] * rq); qo[2] = pk2(a2[0] * rq, a2[1] * rq);
            v2u ko; ko.x = pk2(kv[0] * rk, kv[1] * rk); ko.y = pk2(kv[2] * rk, kv[3] * rk);
            *(v2u*)(CKVN + (size_t)m * KVR + 4 * l) = ko;
            if (l < 16) { const float o1 = x1 * rc[q] - x2 * rs[q], o2 = x1 * rs[q] + x2 * rc[q]; const unsigned w = pk2(o1, o2);
                MKR[(size_t)m * 32 + l] = (bf16)(w & 0xffffu); MKR[(size_t)m * 32 + 16 + l] = (bf16)(w >> 16); }
        }
    }
}

template <bool ROUTE, bool GATHER>
__device__ __forceinline__ void phase_ln(const Frame& F, const bf16* PRE, const float* gam, const float* bet, const float* wr, int moe_j, const bool write_f32) {
    const int l = F.lane;
    constexpr int R = GATHER ? 4 : 2;
    const bf16* YG = WSP(bf16, A_YG); int* TOKE = WSP(int, A_TOK); float* TOKG = WSP(float, A_TOK + 1 * MiB); const int* TOKR = WSP(int, A_TOK + 2 * MiB);
    int* TOKS = WSP(int, A_TOK + 3 * MiB); int* CNTW = WSP(int, A_TOK + 4 * MiB);
    int rc0 = 0, rc1 = 0, rc2 = 0, rc3 = 0, rc4 = 0, rc5 = 0, rc6 = 0, rc7 = 0; (void)moe_j;
    f32x4 gv[4], bv[4];
#pragma unroll
    for (int j = 0; j < 4; ++j) { const int cj = 8 * l + 512 * (j >> 1) + 4 * (j & 1); gv[j] = *(const f32x4*)(gam + cj); bv[j] = *(const f32x4*)(bet + cj); }
    f32x4 rw0[4][4], rw1[4][4];
    if (ROUTE) {
#pragma unroll
        for (int j = 0; j < 4; ++j)
#pragma unroll
            for (int c = 0; c < 4; ++c) { const float* w = wr + (size_t)(8 * l + 512 * (j >> 1) + 4 * (j & 1) + c) * 8; rw0[j][c] = *(const f32x4*)w; rw1[j][c] = *(const f32x4*)(w + 4); }
    }
    int pr0[R], pr1[R]; float pg0[R], pg1[R];
#pragma unroll
    for (int q = 0; q < R; ++q) { pr0[q] = 0; pr1[q] = 0; pg0[q] = 0.f; pg1[q] = 0.f; }
    if (GATHER) {
#pragma unroll
        for (int q = 0; q < R; ++q) { const int m = (F.gw + q * F.NGW < T) ? F.gw + q * F.NGW : F.gw; pr0[q] = TOKR[2 * m]; pr1[q] = TOKR[2 * m + 1]; pg0[q] = TOKG[2 * m]; pg1[q] = TOKG[2 * m + 1]; } }
    for (int m0 = F.gw; m0 < T; m0 += R * F.NGW) {
        v4u raw[R][2]; v4u y0[R][2], y1[R][2]; float g0[R], g1[R];
#pragma unroll
        for (int q = 0; q < R; ++q) { g0[q] = 0.f; g1[q] = 0.f; const int m = (m0 + q * F.NGW < T) ? m0 + q * F.NGW : m0;     const v4u* xr = (const v4u*)(PRE + (size_t)m * D) + l;
#pragma unroll
            for (int j = 0; j < 2; ++j) raw[q][j] = xr[64 * j];
            if (GATHER) { const int r0 = pr0[q], r1 = pr1[q]; g0[q] = pg0[q]; g1[q] = pg1[q];
                const v4u* p0 = (const v4u*)(YG + (size_t)r0 * D) + l; const v4u* p1 = (const v4u*)(YG + (size_t)r1 * D) + l;
#pragma unroll
                for (int j = 0; j < 2; ++j) { y0[q][j] = p0[64 * j]; y1[q][j] = p1[64 * j]; } } }
        if (GATHER && m0 + R * F.NGW < T) {
#pragma unroll
            for (int q = 0; q < R; ++q) { const int mb = m0 + R * F.NGW, m = (mb + q * F.NGW < T) ? mb + q * F.NGW : mb; pr0[q] = TOKR[2 * m]; pr1[q] = TOKR[2 * m + 1]; pg0[q] = TOKG[2 * m]; pg1[q] = TOKG[2 * m + 1]; } }
#pragma unroll
        for (int q = 0; q < R; ++q) { const int m = m0 + q * F.NGW; if (m >= T) break;
            f32x4 v[4]; float s = 0.f;
#pragma unroll
            for (int j = 0; j < 4; ++j) { const v4u a4 = raw[q][j >> 1]; v2u a; a.x = (j & 1) ? a4.z : a4.x; a.y = (j & 1) ? a4.w : a4.y; v[j][0] = bflo(a.x); v[j][1] = bfhi(a.x); v[j][2] = bflo(a.y); v[j][3] = bfhi(a.y); }
            if (GATHER) {
#pragma unroll
                for (int j = 0; j < 4; ++j) { const v4u a4 = y0[q][j >> 1], b4 = y1[q][j >> 1]; v2u a, b; a.x = (j & 1) ? a4.z : a4.x; a.y = (j & 1) ? a4.w : a4.y; b.x = (j & 1) ? b4.z : b4.x; b.y = (j & 1) ? b4.w : b4.y;
                    v[j][0] += g0[q] * bflo(a.x) + g1[q] * bflo(b.x); v[j][1] += g0[q] * bfhi(a.x) + g1[q] * bfhi(b.x); v[j][2] += g0[q] * bflo(a.y) + g1[q] * bflo(b.y); v[j][3] += g0[q] * bfhi(a.y) + g1[q] * bfhi(b.y); } }
#pragma unroll
            for (int j = 0; j < 4; ++j) s += (v[j][0] + v[j][1]) + (v[j][2] + v[j][3]);
            const float mean = wave_sum(l, s) * (1.f / D); float s2 = 0.f;
#pragma unroll
            for (int j = 0; j < 4; ++j) { v[j] = v[j] - mean; s2 += (v[j][0] * v[j][0] + v[j][1] * v[j][1]) + (v[j][2] * v[j][2] + v[j][3] * v[j][3]); }
            const float rstd = 1.f / sqrtf(wave_sum(l, s2) * (1.f / D) + LN_EPS);
            f32x4* orow = (f32x4*)(F.a->out + (size_t)m * D) + 2 * l; v4u* br = WSP(v4u, WS_XB) + (size_t)m * (D / 8) + l; v2u* br8 = WSP(v2u, WS_XB8) + (size_t)m * (D / 8) + l;
#pragma unroll
            for (int j = 0; j < 4; ++j) v[j] = v[j] * rstd * gv[j] + bv[j];
            if (write_f32) {
#pragma unroll
                for (int j = 0; j < 4; ++j) orow[128 * (j >> 1) + (j & 1)] = v[j];
            } else {
#pragma unroll
                for (int j2 = 0; j2 < 2; ++j2) { const f32x4 va = v[2 * j2], vb = v[2 * j2 + 1];
                    v4u o; o.x = pk2(va[0], va[1]); o.y = pk2(va[2], va[3]); o.z = pk2(vb[0], vb[1]); o.w = pk2(vb[2], vb[3]); br[64 * j2] = o;
                    int wa = __builtin_amdgcn_cvt_pk_fp8_f32(va[0], va[1], 0, false); wa = __builtin_amdgcn_cvt_pk_fp8_f32(va[2], va[3], wa, true);
                    int wb = __builtin_amdgcn_cvt_pk_fp8_f32(vb[0], vb[1], 0, false); wb = __builtin_amdgcn_cvt_pk_fp8_f32(vb[2], vb[3], wb, true);
                    v2u o8; o8.x = (unsigned)wa; o8.y = (unsigned)wb; br8[64 * j2] = o8; }
            }
            if (ROUTE) {
                float lg[8];
#pragma unroll
                for (int e = 0; e < 8; ++e) lg[e] = 0.f;
#pragma unroll
                for (int j = 0; j < 4; ++j)
#pragma unroll
                    for (int c = 0; c < 4; ++c) { const f32x4 w0 = rw0[j][c], w1 = rw1[j][c]; const float xv = v[j][c];
                        lg[0] += xv * w0[0]; lg[1] += xv * w0[1]; lg[2] += xv * w0[2]; lg[3] += xv * w0[3]; lg[4] += xv * w1[0]; lg[5] += xv * w1[1]; lg[6] += xv * w1[2]; lg[7] += xv * w1[3]; }
#pragma unroll
                for (int e = 0; e < 8; ++e) lg[e] = wave_sum(l, lg[e]);
                int e0 = 0; float v0 = lg[0];
#pragma unroll
                for (int e = 1; e < 8; ++e) if (lg[e] > v0) { v0 = lg[e]; e0 = e; }
                int e1 = -1; float v1 = -INFINITY;
#pragma unroll
                for (int e = 0; e < 8; ++e) if (e != e0 && lg[e] > v1) { v1 = lg[e]; e1 = e; }
                const float gg1 = 1.0f / (1.0f + expf(v0 - v1)), gg0 = 1.0f - gg1;
                const int s0 = (e0 == 0) ? rc0 : (e0 == 1) ? rc1 : (e0 == 2) ? rc2 : (e0 == 3) ? rc3 : (e0 == 4) ? rc4 : (e0 == 5) ? rc5 : (e0 == 6) ? rc6 : rc7;
                const int s1 = (e1 == 0) ? rc0 : (e1 == 1) ? rc1 : (e1 == 2) ? rc2 : (e1 == 3) ? rc3 : (e1 == 4) ? rc4 : (e1 == 5) ? rc5 : (e1 == 6) ? rc6 : rc7;
                rc0 += (e0 == 0) + (e1 == 0); rc1 += (e0 == 1) + (e1 == 1); rc2 += (e0 == 2) + (e1 == 2); rc3 += (e0 == 3) + (e1 == 3);
                rc4 += (e0 == 4) + (e1 == 4); rc5 += (e0 == 5) + (e1 == 5); rc6 += (e0 == 6) + (e1 == 6); rc7 += (e0 == 7) + (e1 == 7);
                if (l == 0) { TOKE[2 * m] = e0; TOKE[2 * m + 1] = e1; TOKG[2 * m] = gg0; TOKG[2 * m + 1] = gg1; TOKS[2 * m] = s0; TOKS[2 * m + 1] = s1; }
            }
        }
    }
    if (ROUTE && (FR_TID(F) & 63) == 0) { int* cw = CNTW + (size_t)F.gw * 8; cw[0] = rc0; cw[1] = rc1; cw[2] = rc2; cw[3] = rc3; cw[4] = rc4; cw[5] = rc5; cw[6] = rc6; cw[7] = rc7; }
}

struct MoeTiles { int pend[8]; int total; };
__device__ __forceinline__ void moe_tiles(const Frame& F, int moe_j, MoeTiles& mt) {
    const int* tot = WSP(int, A_TOK + 5 * MiB); int acc = 0; (void)moe_j;
#pragma unroll
    for (int e = 0; e < 8; ++e) { const int c = tot[e]; acc += (c + 255) >> 8; mt.pend[e] = acc; }
    mt.total = acc;
}
__device__ __forceinline__ void phase_scatter(const Frame& F, int moe_j) {
    (void)moe_j;
    const int* CNTW = WSP(int, A_TOK + 4 * MiB); const int* TOKS = WSP(int, A_TOK + 3 * MiB); int* TOT = WSP(int, A_TOK + 5 * MiB);
    const int* TOKE = WSP(int, A_TOK); int* TOKR = WSP(int, A_TOK + 2 * MiB);
    const v4u* XB = WSP(v4u, WS_XB); v4u* XG = WSP(v4u, A_XG); const int l = F.lane;
    LAS int* red = (LAS int*)F.lds;
    int tot[8], pre[8];
#pragma unroll
    for (int e = 0; e < 8; ++e) { tot[e] = 0; pre[e] = 0; }
    const int wg0 = F.vcu * NWAVES;
    for (int w = F.tid; w < F.NGW; w += NWAVES * 64) { const v4u a = *(const v4u*)(CNTW + (size_t)w * 8), b = *(const v4u*)(CNTW + (size_t)w * 8 + 4); const int below = (w < wg0) ? 1 : 0;
        tot[0] += a.x; tot[1] += a.y; tot[2] += a.z; tot[3] += a.w; tot[4] += b.x; tot[5] += b.y; tot[6] += b.z; tot[7] += b.w;
        pre[0] += below * (int)a.x; pre[1] += below * (int)a.y; pre[2] += below * (int)a.z; pre[3] += below * (int)a.w; pre[4] += below * (int)b.x; pre[5] += below * (int)b.y; pre[6] += below * (int)b.z; pre[7] += below * (int)b.w; }
#pragma unroll
    for (int e = 0; e < 8; ++e) {
#pragma unroll
        for (int o = 1; o < 64; o <<= 1) { tot[e] += shxi(tot[e], o, l); pre[e] += shxi(pre[e], o, l); } }
    if (l == 0) {
#pragma unroll
        for (int e = 0; e < 8; ++e) { red[F.wave * 16 + e] = tot[e]; red[F.wave * 16 + 8 + e] = pre[e]; } }
    __syncthreads();
    int base[8]; int acc = 0;
#pragma unroll
    for (int e = 0; e < 8; ++e) { int t = 0, p = 0;
#pragma unroll
        for (int w = 0; w < NWAVES; ++w) { t += red[w * 16 + e]; p += red[w * 16 + 8 + e]; }
        int mine = 0;
#pragma unroll
        for (int w = 0; w < NWAVES; ++w) { const int c = CNTW[(size_t)(wg0 + w) * 8 + e]; mine += (w < F.wave) ? c : 0; }
        base[e] = acc * 256 + p + mine; acc += (t + 255) >> 8;
        if (F.vcu == 0 && F.tid == 0) TOT[e] = t; }
    __syncthreads();
    static_assert(MOE_FP8 == 1, "scatter copies the fp8 rows");
    const v4u* X8 = WSP(v4u, WS_XB8);
    for (int m0 = F.gw; m0 < T; m0 += 4 * F.NGW) {
        int e_[4][2], s_[4][2]; v4u row_[4];
#pragma unroll
        for (int q = 0; q < 4; ++q) { const int m = (m0 + q * F.NGW < T) ? m0 + q * F.NGW : m0;
            e_[q][0] = TOKE[2 * m]; e_[q][1] = TOKE[2 * m + 1]; s_[q][0] = TOKS[2 * m]; s_[q][1] = TOKS[2 * m + 1]; row_[q] = X8[(size_t)m * 64 + l]; }
#pragma unroll
        for (int q = 0; q < 4; ++q) { const int m = m0 + q * F.NGW; if (m >= T) break;
            int rows[2];
#pragma unroll
            for (int k = 0; k < 2; ++k) { const int e = e_[q][k];
                const int bs = (e == 0) ? base[0] : (e == 1) ? base[1] : (e == 2) ? base[2] : (e == 3) ? base[3] : (e == 4) ? base[4] : (e == 5) ? base[5] : (e == 6) ? base[6] : base[7];
                rows[k] = bs + s_[q][k]; }
            ((v4u*)XG)[(size_t)rows[0] * 64 + l] = row_[q]; ((v4u*)XG)[(size_t)rows[1] * 64 + l] = row_[q];
            if (l == 0) { TOKR[2 * m] = rows[0]; TOKR[2 * m + 1] = rows[1]; } }
    }
}

template <int VAR>
__device__ __forceinline__ void phase_attn_diff(const Frame& F, int L) {
    const float lam_init = 0.8f - 0.6f * expf(-0.3f * (float)L);
    const int l = FR_TID(F) & 63;
    const float d1 = wave_sum(l, INF(6)[L * 64 + l] * INF(7)[L * 64 + l]), d2 = wave_sum(l, INF(8)[L * 64 + l] * INF(9)[L * 64 + l]);
    att::AttnP P; P.Q = WSP(bf16, A_DQ); P.ldq = 1024; P.K1 = WSP(bf16, A_DK); P.ldk1 = 1024; P.K2 = P.K1; P.ldk2 = 1024; P.V = WSP(bf16, A_DV); P.ldv = 1024; P.ldo = 1024;
    P.pos = (const int*)F.a->in[2]; P.blkmax = WSP(int, WS_MISC); P.lut = WSP(float, WS_MISC + 4096);
    P.TI = WSP(bf16, A_OA2); P.lam = expf(d1) - expf(d2) + lam_init; P.osc = 1.0f; P.gsub = WSP(float, WS_MISC + 32768) + L * 128;
    att::AttPreOf<64, 128>::type pre; pre.valid = false;
    for (int p = F.vcu; p < BATCH * 8 * 8; p += F.G) {
        const int bh = p >> 3, i = p & 7, b = bh >> 3, hh = bh & 7;
        const int p2 = p + F.G; const bool more_items = p2 < BATCH * 8 * 8; const int bh2 = p2 >> 3, i2 = p2 & 7, b2 = bh2 >> 3, hh2 = bh2 & 7;
#pragma unroll 1
        for (int s = 0; s < 2; ++s) { const int qt = s ? i : 15 - i;
            const bool hn = (s == 0) || more_items; const int nb = s == 0 ? b : b2, nqt = s == 0 ? i : 15 - i2, nhh = s == 0 ? hh : hh2;
            P.O = WSP(bf16, A_OA2); att::ATT_UNIT_D<64, 64, 128, true, 1, VAR>(P, b, qt, (2 * hh) * 64, (2 * hh) * 64, hh * 128, hh * 128, hh, F.lds, FR_TID(F),
                                                                               pre, true, b, qt, (2 * hh + 1) * 64, (2 * hh + 1) * 64, hh * 128, hh);
            P.O = WSP(bf16, A_OA);  att::ATT_UNIT_D<64, 64, 128, true, 2, VAR>(P, b, qt, (2 * hh + 1) * 64, (2 * hh + 1) * 64, hh * 128, hh * 128, hh, F.lds, FR_TID(F),
                                                                               pre, hn, nb, nqt, (2 * nhh) * 64, (2 * nhh) * 64, nhh * 128, nhh); }
    }
}
template <int VAR>
__device__ __forceinline__ void phase_attn_mla(const Frame& F) {
    att::AttnP P; P.Q = WSP(bf16, A_MQ); P.ldq = 768; P.K1 = WSP(bf16, A_MKV); P.ldk1 = 1024; P.K2 = WSP(bf16, A_MKR); P.ldk2 = 32; P.V = WSP(bf16, A_MKV); P.ldv = 1024; P.O = WSP(bf16, A_OB); P.ldo = 512;
    P.pos = (const int*)F.a->in[2]; P.blkmax = WSP(int, WS_MISC); P.lut = WSP(float, WS_MISC + 4096);
    att::AttPreOf<96, 64>::type pre; pre.valid = false;
    for (int p = F.vcu; p < BATCH * 8 * 8; p += F.G) {
        const int bh = p >> 3, i = p & 7, b = bh >> 3, hh = bh & 7;
        const int p2 = p + F.G; const bool more_items = p2 < BATCH * 8 * 8; const int bh2 = p2 >> 3, i2 = p2 & 7, b2 = bh2 >> 3, hh2 = bh2 & 7;
        att::ATT_UNIT_M<96, 64, 64, false, 0, VAR>(P, b, 15 - i, hh * 96, hh * 128, hh * 128 + 64, hh * 64, 0, F.lds, FR_TID(F), pre, true, b, i, hh * 96, hh * 128, hh * 128 + 64, 0);
        att::ATT_UNIT_M<96, 64, 64, false, 0, VAR>(P, b, i, hh * 96, hh * 128, hh * 128 + 64, hh * 64, 0, F.lds, FR_TID(F), pre, more_items, b2, 15 - i2, hh2 * 96, hh2 * 128, hh2 * 128 + 64, 0);
    }
}

constexpr int NPH_DENSE = 9, NPH_MOE = 8 + 2 * MOE_NCHUNK, NPH_TOTAL = 1 + 2 * NPH_DENSE + 2 * NPH_MOE;
#define GEMM_CALL(EPI, SCHED, gm, S_, E_) pg8::gemm_phase<EPI, SCHED, true, true>(F.lds, gm, S_, E_, MY_TID())

__global__ void __launch_bounds__(NWAVES * 64, 2) mega_fwd(Args args) {
    extern __shared__ __attribute__((aligned(16))) unsigned char lds_raw[];
    Frame F;
    F.lds = (LAS unsigned char*)lds_raw; F.a = &args; F.ws = args.ws;
    const int wave_s = __builtin_amdgcn_readfirstlane((int)threadIdx.x >> 6);
#define MY_TID() ({ unsigned m1_ = ~0u; asm volatile("" : "+s"(m1_)); ((wave_s << 6) | (int)__builtin_amdgcn_mbcnt_hi(m1_, __builtin_amdgcn_mbcnt_lo(m1_, 0u))); })
    F.tid = MY_TID(); F.lane = F.tid & 63; F.wave = wave_s;
    F.G = gridDim.x; { const int bx = blockIdx.x; F.vcu = (F.G % 8 == 0) ? (bx % 8) * (F.G / 8) + bx / 8 : bx; }
    F.gw = F.vcu * NWAVES + F.wave; F.NGW = F.G * NWAVES;
    volatile LAS unsigned* MISC = (volatile LAS unsigned*)(F.lds + MISC_OFF);
    for (int u = F.tid; u < (LDS_BYTES - RING_BYTES) / 4; u += NWAVES * 64) ((LAS unsigned*)(F.lds + RING_BYTES))[u] = 0u;
    __syncthreads();
    const int lo = args.ph_lo, hi = args.ph_hi; constexpr bool fuse_ln = (LN_FUSE != 0);
    XcdBarrier bar; bar.bar = WSP(unsigned, WS_CTL) + CW_BAR; bar.x = 0; bar.st = nullptr;
    if (hi - lo > 1) bar = xcd_barrier_post(WSP(unsigned, WS_CTL) + CW_BAR, MISC + 8, F.tid == 0);
    int pc = 0;
#define PH_BEGIN if (pc >= lo && pc < hi) { { int t_ = MY_TID(); asm volatile("" : "+v"(t_)); F.tid = t_; F.lane = t_ & 63; F.wave = wave_s; F.gw = F.vcu * NWAVES + F.wave; }
#define PH_END if (pc + 1 < hi) { for (int rb = 0; rb < REP_BAR; ++rb) xcd_barrier(bar, MY_TID() == 0); } } ++pc;
    const int bx = (int)blockIdx.x;
    const float ALPHA = 1.6817928305074290f;

    PH_BEGIN for (int rep = 0; rep < REP_P0; ++rep) phase_prologue(F); PH_END

    for (int L = 0; L < DEPTH; ++L) {
        const int mj = L >> 1;
        const int convL_ = (CONV_IN_ATTN && (L & 1) == 0 && L + 1 < DEPTH) ? L + 1 : -1;
        PH_BEGIN {
#if QKV_FP8
            int bxl = bx; asm volatile("" : "+s"(bxl));
            { pg8::Gemm g{WSP(bf16, WS_XB), WSP(bf16, W_IN), T, 768, D}; pg8::StaticOrder S; S.init(T, 768, F.G, bxl);
              pg8::EpiL1 E{WSP(bf16, A_DQ), WSP(bf16, A_CQN), WSP(bf16, A_CKVN), WSP(bf16, A_MKR), WSP(float, WS_SSP), WSP(float, WS_ROPE), 0.125f * LOG2E, 12};
              for (int rep = 0; rep < REP_L1; ++rep) pg8::gemm_phase<pg8::EpiL1, pg8::StaticOrder, true, true, 0>(F.lds, g, S, E, MY_TID()); }
            { pg8::Gemm g{WSP(bf16, WS_XB8), WSP(bf16, W_QKV8), T, 5120, D / 2};
              pg8::UnevenOrder S; S.init(T, 5120, F.G, bx);
              if (LN_FUSE || F.G == 256) { S.cut = 128; S.lo = 9; S.hi = 11; } else { S.cut = 0; S.lo = 0; S.hi = (S.nwg + F.G - 1) / F.G; }
              pg8::EpiQkvG8 E{WSP(bf16, A_DQ), WSP(bf16, A_G), INF(5) + L * 2048, 0.125f * LOG2E, 1.0f / 32.0f};
              for (int rep = 0; rep < REP_L1; ++rep) pg8::gemm_phase8<pg8::EpiQkvG8, pg8::UnevenOrder, true, F8_SP2, 0>(F.lds, g, S, E, 0x7F7F7F7F, MY_TID()); }
#else
            { pg8::Gemm g{WSP(bf16, WS_XB), WSP(bf16, W_IN), T, NIN_B, D}; pg8::StaticOrder S; S.init(T, NIN_B, F.G, bx);
              pg8::EpiL1 E{WSP(bf16, A_DQ), WSP(bf16, A_CQN), WSP(bf16, A_CKVN), WSP(bf16, A_MKR), WSP(float, WS_SSP), WSP(float, WS_ROPE), 0.125f * LOG2E};
              for (int rep = 0; rep < REP_L1; ++rep) pg8::gemm_phase<pg8::EpiL1, pg8::StaticOrder, true, true, STAG_L1>(F.lds, g, S, E, MY_TID()); }
            { pg8::Gemm g{WSP(bf16, WS_XB8), WSP(bf16, W_G8), T, 2048, D / 2};
              pg8::UnevenOrder S; S.init(T, 2048, F.G, bx);
              if (F.G == 256) { S.cut = 128; S.lo = 3; S.hi = 5; } else { S.cut = 0; S.lo = 0; S.hi = (S.nwg + F.G - 1) / F.G; }
              pg8::EpiGates8 E{WSP(bf16, A_G), INF(5) + L * 2048, 1.0f / 32.0f};
              for (int rep = 0; rep < REP_L1; ++rep) pg8::gemm_phase8<pg8::EpiGates8, pg8::UnevenOrder, true, F8_SP2, 0>(F.lds, g, S, E, 0x7F7F7F7F, MY_TID()); }
#endif
        } PH_END
        PH_BEGIN {
            for (int rep = 0; rep < REP_MIX; ++rep) {
            { pg8::Gemm g{WSP(bf16, A_CQN), WSP(bf16, W_UQ), T, 768, QR}; pg8::StaticOrder S; S.init(T, 768, F.G, bx);
              pg8::EpiRopeQ E{WSP(bf16, A_MQ), WSP(float, WS_ROPE), 0.10206207261596577f * LOG2E, WSP(float, WS_SSP)};
              GEMM_CALL(pg8::EpiRopeQ, pg8::StaticOrder, g, S, E); }
            { pg8::Gemm g{WSP(bf16, A_CKVN), WSP(bf16, W_UKV), T, 1024, KVR}; pg8::StaticOrder S; S.init(T, 1024, F.G, bx);
              pg8::EpiBf16Rs E{WSP(bf16, A_MKV), 1024, WSP(float, WS_SSP)};
              GEMM_CALL(pg8::EpiBf16Rs, pg8::StaticOrder, g, S, E); }
            }
#define CONV_HOOK() do { __syncthreads(); Frame F3 = F; { const int t3_ = MY_TID(); F3.tid = t3_; F3.lane = t3_ & 63; } phase_convert(F3, convL_, 2); __syncthreads(); } while (0)
            if (convL_ >= 0 && (bx & 1) == 0) CONV_HOOK();
            phase_attn_diff<0>(F, L);
            if (convL_ >= 0 && (bx & 1) != 0) CONV_HOOK();
#undef CONV_HOOK
        } PH_END
        PH_BEGIN { phase_attn_mla<0>(F); } PH_END
        PH_BEGIN {
            for (int rep = 0; rep < REP_MIX; ++rep) {
            { pg8::Gemm g{WSP(bf16, A_OB), WSP(bf16, W_BM), T, D, 512}; pg8::StaticOrder S; S.init(T, D, F.G, bx);
              pg8::EpiGate<false> E{WSP(bf16, A_MT), WSP(bf16, A_G), nullptr, 1024};
              GEMM_CALL(pg8::EpiGate<false>, pg8::StaticOrder, g, S, E); }
            { pg8::Gemm g{WSP(bf16, A_OA), WSP(bf16, W_BD), T, D, D}; pg8::StaticOrder S; S.init(T, D, F.G, bx);
              pg8::EpiGate<true> E{WSP(bf16, A_M), WSP(bf16, A_G), WSP(bf16, A_MT), 0};
              GEMM_CALL(pg8::EpiGate<true>, pg8::StaticOrder, g, S, E); }
            }
        } PH_END
        PH_BEGIN {
            pg8::Gemm g{WSP(bf16, A_M), WSP(bf16, W_OUT), T, D, D}; pg8::StaticOrder S; S.init(T, D, F.G, bx);
            if (fuse_ln && (L & 1) == 0) {
                pg8::EpiPreLn<1> E{nullptr, WSP(bf16, WS_XB), WSP(unsigned char, WS_XB8), ALPHA, INF(18) + L * D, INF(19) + L * D, WSP(unsigned long long, WS_LNST), WSP(unsigned, WS_CTL) + CW_LN + (2 * L) * 128, F.lds + RING_BYTES + 2048};
                GEMM_CALL(pg8::EpiPreLn<1>, pg8::StaticOrder, g, S, E);
            } else {
            pg8::EpiPre<1> E{WSP(bf16, A_PRE), WSP(bf16, WS_XB), ALPHA, 1.0f};
            for (int rep = 0; rep < REP_MIX; ++rep) GEMM_CALL(pg8::EpiPre<1>, pg8::StaticOrder, g, S, E);
            }
        } PH_END
        if (!(fuse_ln && (L & 1) == 0)) {
        PH_BEGIN {
            if (L & 1) phase_ln<true, false>(F, WSP(bf16, A_PRE), INF(18) + L * D, INF(19) + L * D, INF(23) + (size_t)mj * D * NEXP, mj, false);
            else for (int rep = 0; rep < REP_LN; ++rep) phase_ln<false, false>(F, WSP(bf16, A_PRE), INF(18) + L * D, INF(19) + L * D, nullptr, 0, false);
        } PH_END
        }
        if ((L & 1) == 0) {
            PH_BEGIN {
                for (int rep = 0; rep < REP_FFN; ++rep) {
                { pg8::Gemm g{WSP(bf16, WS_XB), WSP(bf16, W_F13D), T, 2 * DENSE_FF, D}; pg8::StaticOrder S; S.init(T, 2 * DENSE_FF, F.G, bx);
                  pg8::EpiSwiGLU E{WSP(bf16, A_H), DENSE_FF};
                  pg8::gemm_phase<pg8::EpiSwiGLU, pg8::StaticOrder, true, true, STAG_H>(F.lds, g, S, E, MY_TID()); }
                { pg8::Gemm g{WSP(bf16, WS_PB), WSP(bf16, W_PP), T, D, PLE}; pg8::StaticOrder S; S.init(T, D, F.G, bx);
                  pg8::EpiPre<0> E{WSP(bf16, A_PRE), nullptr, 0.f, 1.0f};
                  GEMM_CALL(pg8::EpiPre<0>, pg8::StaticOrder, g, S, E); }
                { pg8::Gemm g{WSP(bf16, WS_XB8), WSP(bf16, W_PG), T, D, D / 2}; pg8::StaticOrder S; S.init(T, D, F.G, bx);
                  pg8::EpiPre<2> E{WSP(bf16, A_PRE), WSP(bf16, WS_XB), ALPHA, 1.0f / 32.0f};
                  pg8::gemm_phase8<pg8::EpiPre<2>, pg8::StaticOrder, true, F8_SP2, 0>(F.lds, g, S, E, 0x7F7F7F7F, MY_TID()); }
                }
            } PH_END
            PH_BEGIN {
                pg8::Gemm g{WSP(bf16, A_H), WSP(bf16, W_F2D), T, D, DENSE_FF}; pg8::StaticOrder S; S.init(T, D, F.G, bx);
                if (fuse_ln) {
                    pg8::EpiPreLn<3> E{WSP(bf16, A_PRE), WSP(bf16, WS_XB), WSP(unsigned char, WS_XB8), 1.0f, INF(29) + L * D, INF(30) + L * D, WSP(unsigned long long, WS_LNST), WSP(unsigned, WS_CTL) + CW_LN + (2 * L + 1) * 128, F.lds + RING_BYTES + 2048};
                    GEMM_CALL(pg8::EpiPreLn<3>, pg8::StaticOrder, g, S, E);
                    if (L + 1 < DEPTH) { __syncthreads(); Frame F3 = F; { const int t3_ = MY_TID(); F3.tid = t3_; F3.lane = t3_ & 63; }
                        phase_convert(F3, L + 1, CONV_IN_ATTN ? 1 : 0); }
                } else {
                pg8::EpiPre<3> E{WSP(bf16, A_PRE), nullptr, 0.f, 1.0f};
                GEMM_CALL(pg8::EpiPre<3>, pg8::StaticOrder, g, S, E);
                }
            } PH_END
            if (!fuse_ln) {
            PH_BEGIN { if (!fuse_ln) for (int rep = 0; rep < REP_LN; ++rep) phase_ln<false, false>(F, WSP(bf16, A_PRE), INF(29) + L * D, INF(30) + L * D, nullptr, 0, L == DEPTH - 1); if (L + 1 < DEPTH) for (int rep = 0; rep < REP_CONV; ++rep) phase_convert(F, L + 1, CONV_IN_ATTN ? 1 : 0); } PH_END
            }
        } else {
            PH_BEGIN {
                phase_scatter(F, mj);
                for (int rep = 0; rep < REP_PPE; ++rep) {
                { pg8::Gemm g{WSP(bf16, WS_PB), WSP(bf16, W_PP), T, D, PLE}; pg8::StaticOrder S; S.init(T, D, F.G, bx);
                  pg8::EpiPre<0> E{WSP(bf16, A_PREM), nullptr, 0.f, 1.0f};
                  GEMM_CALL(pg8::EpiPre<0>, pg8::StaticOrder, g, S, E); }
                { pg8::Gemm g{WSP(bf16, WS_XB8), WSP(bf16, W_PG), T, D, D / 2}; pg8::StaticOrder S; S.init(T, D, F.G, bx);
                  pg8::EpiPre<2> E{WSP(bf16, A_PREM), WSP(bf16, WS_XB), ALPHA, 1.0f / 32.0f};
                  pg8::gemm_phase8<pg8::EpiPre<2>, pg8::StaticOrder, true, F8_SP2, 0>(F.lds, g, S, E, 0x7F7F7F7F, MY_TID()); }
                }
            } PH_END
            for (int ch = 0; ch < MOE_NCHUNK; ++ch) {
                PH_BEGIN {
                    MoeTiles mt; moe_tiles(F, mj, mt);
                    const int tlo = ch * MOE_CHUNK_TILES; int ntc = mt.total - tlo; ntc = ntc > MOE_CHUNK_TILES ? MOE_CHUNK_TILES : ntc;
                    if (ntc > 0) {
#if MOE_FP8
                        pg8::Gemm g{WSP(bf16, A_XG), WSP(bf16, W_F13), ntc * 256, 2 * EXPERT_FF, D / 2};
                        pg8::GroupedOrder S; S.init(ntc * 256, 2 * EXPERT_FF, F.G, bx); S.tile_lo = tlo; S.estride = (size_t)2 * EXPERT_FF * D;
#else
                        pg8::Gemm g{WSP(bf16, A_XG) + (size_t)tlo * 256 * D, WSP(bf16, W_F13), ntc * 256, 2 * EXPERT_FF, D};
                        pg8::GroupedOrder S; S.init(ntc * 256, 2 * EXPERT_FF, F.G, bx); S.tile_lo = tlo; S.estride = (size_t)2 * EXPERT_FF * D * 2;
#endif
                        S.pend0 = mt.pend[0]; S.pend1 = mt.pend[1]; S.pend2 = mt.pend[2]; S.pend3 = mt.pend[3]; S.pend4 = mt.pend[4]; S.pend5 = mt.pend[5]; S.pend6 = mt.pend[6]; S.pend7 = mt.pend[7];
#if MOE_FP8
                        pg8::EpiSwiGLU8 E{WSP(unsigned char, A_HG), EXPERT_FF, 1.0f / 32.0f};
                        for (int rep = 0; rep < REP_MOE; ++rep) pg8::gemm_phase8<pg8::EpiSwiGLU8, pg8::GroupedOrder, UP_ALIGN, F8_SP2, STAG_UP>(F.lds, g, S, E, 0x7F7F7F7F, MY_TID());
#else
                        pg8::EpiSwiGLU E{WSP(bf16, A_HG), EXPERT_FF};
                        for (int rep = 0; rep < REP_MOE; ++rep) GEMM_CALL(pg8::EpiSwiGLU, pg8::GroupedOrder, g, S, E);
#endif
                    }
                } PH_END
                PH_BEGIN {
                    MoeTiles mt; moe_tiles(F, mj, mt);
                    const int tlo = ch * MOE_CHUNK_TILES; int ntc = mt.total - tlo; ntc = ntc > MOE_CHUNK_TILES ? MOE_CHUNK_TILES : ntc;
                    if (ntc > 0) {
#if MOE_FP8
                        pg8::Gemm g{WSP(bf16, A_HG), WSP(bf16, W_F2E), ntc * 256, D, EXPERT_FF / 2};
                        pg8::GroupedOrder S; S.init(ntc * 256, D, F.G, bx); S.tile_lo = tlo; S.estride = (size_t)D * EXPERT_FF;
#else
                        pg8::Gemm g{WSP(bf16, A_HG), WSP(bf16, W_F2E), ntc * 256, D, EXPERT_FF};
                        pg8::GroupedOrder S; S.init(ntc * 256, D, F.G, bx); S.tile_lo = tlo; S.estride = (size_t)D * EXPERT_FF * 2;
#endif
                        S.pend0 = mt.pend[0]; S.pend1 = mt.pend[1]; S.pend2 = mt.pend[2]; S.pend3 = mt.pend[3]; S.pend4 = mt.pend[4]; S.pend5 = mt.pend[5]; S.pend6 = mt.pend[6]; S.pend7 = mt.pend[7];
                        pg8::EpiBf16 E{WSP(bf16, A_YG) + (size_t)tlo * 256 * D, D, MOE_FP8 ? 1.0f / 128.0f : 1.0f};
#if MOE_FP8
                        for (int rep = 0; rep < REP_MOE; ++rep) pg8::gemm_phase8<pg8::EpiBf16, pg8::GroupedOrder, true, F8_SP2>(F.lds, g, S, E, 0x7F7F7F7F, MY_TID());
#else
                        for (int rep = 0; rep < REP_MOE; ++rep) GEMM_CALL(pg8::EpiBf16, pg8::GroupedOrder, g, S, E);
#endif
                    }
                    if (CONV_IN_DOWN && ch == MOE_NCHUNK - 1 && L + 1 < DEPTH) {
                        const int nwg_ = (ntc > 0 ? ntc : 0) * (D / 256), r_ = nwg_ % F.G, nl_ = F.G - r_;
                        Frame F2 = F; { const int t2_ = MY_TID(); F2.tid = t2_; F2.lane = t2_ & 63; }
                        if (r_ != 0 && 2 * nl_ >= F.G) { if (bx >= r_) { F2.gw = (bx - r_) * NWAVES + F.wave; F2.NGW = nl_ * NWAVES; phase_convert(F2, L + 1); } }
                        else phase_convert(F2, L + 1);
                    }
                } PH_END
            }
            PH_BEGIN { for (int rep = 0; rep < REP_LN; ++rep) phase_ln<false, true>(F, WSP(bf16, A_PREM), INF(29) + L * D, INF(30) + L * D, nullptr, 0, L == DEPTH - 1); if (!CONV_IN_DOWN && L + 1 < DEPTH) for (int rep = 0; rep < REP_CONV; ++rep) phase_convert(F, L + 1); } PH_END
        }
    }
#undef PH_BEGIN
#undef PH_END
}

extern "C" void kernel_launch(void* const* d_in, const int* in_sizes, int n_in, void* d_out, int out_size, void* d_ws, size_t ws_size, hipStream_t stream) {
    static int grid = 0;
    if (grid == 0) {
        if (n_in != 31 || in_sizes[0] != T * D || out_size != T * D || ws_size < WS_END) { fprintf(stderr, "kernel_launch: unexpected shapes / workspace (n_in %d, ws %zu < %zu)\n", n_in, ws_size, (size_t)WS_END); grid = -1; return; }
        int dev = 0, cus = 0, per_cu = 0;
        if (hipGetDevice(&dev) != hipSuccess || hipDeviceGetAttribute(&cus, hipDeviceAttributeMultiprocessorCount, dev) != hipSuccess) { grid = -1; return; }
        if (hipFuncSetAttribute((const void*)mega_fwd, hipFuncAttributeMaxDynamicSharedMemorySize, LDS_BYTES) != hipSuccess) { fprintf(stderr, "kernel_launch: hipFuncSetAttribute failed\n"); grid = -1; return; }
        if (hipOccupancyMaxActiveBlocksPerMultiprocessor(&per_cu, (const void*)mega_fwd, NWAVES * 64, LDS_BYTES) != hipSuccess || per_cu < 1) { fprintf(stderr, "kernel_launch: occupancy query says %d\n", per_cu); (void)hipGetLastError(); grid = -1; return; }
        grid = cus;
    }
    if (grid < 0) return;
    if (hipMemsetAsync((char*)d_ws + WS_CTL, 0, CTL_ZERO_BYTES, stream) != hipSuccess) return;
    Args a{};
    for (int i = 0; i < 31; ++i) a.in[i] = d_in[i];
    a.out = (float*)d_out; a.ws = (unsigned char*)d_ws;
    a.fuse = LN_FUSE;
    if (LN_FUSE && grid != 256) { fprintf(stderr, "kernel_launch: the fused LayerNorm exchange needs a 256-workgroup grid (got %d); build with -DLN_FUSE=0\n", grid); return; }
    const int nph = NPH_TOTAL - (a.fuse ? 4 : 0);
#if MK_PER_PHASE
    for (int p = 0; p < nph; ++p) { a.ph_lo = p; a.ph_hi = p + 1; hipLaunchKernelGGL(mega_fwd, dim3(grid), dim3(NWAVES * 64), LDS_BYTES, stream, a); }
#else
    a.ph_lo = 0; a.ph_hi = nph;
    hipLaunchKernelGGL(mega_fwd, dim3(grid), dim3(NWAVES * 64), LDS_BYTES, stream, a);
#endif
}
```
